# Optimizing an MI355X kernel written in HIP

```python
import math
import functools
import jax
import jax.numpy as jnp
from jax import lax
import numpy as np

D_MODEL = 1024
BATCH = 16
SEQ = 2048
DEPTH = 1
DEC_BATCH = 32
DEC_SEQ = 1
PAST_LEN = 16384
PAGE_SIZE = 128

M_HEADS = 4
M_HEAD_DIM = 128
M_WIDTH = M_HEADS * M_HEAD_DIM
M_CONV = 4
M_CHUNK = 64
N_HEADS = 8
N_KV_HEADS = 2
N_GROUP = N_HEADS // N_KV_HEADS
N_HEAD_DIM = 64
N_WIDTH = N_HEADS * N_HEAD_DIM
N_KV_WIDTH = 2 * N_KV_HEADS * N_HEAD_DIM
CMP_BLOCK = 32
CMP_STRIDE = 16
SLC_BLOCK = 64
N_SELECT = 16
WINDOW = 512
WIN_QBLOCK = 128
SEL_QBLOCK = 32
ATTN_SCALE = N_HEAD_DIM ** -0.5
REL_BUCKETS = 32
REL_MAX_DIST = 128
PEER_HEADS = 8
PEER_KEYS = 128
PEER_EXPERTS = PEER_KEYS * PEER_KEYS
PEER_QDIM = 256
PEER_TOPK = 16
PEER_TOKEN_BLOCK = 128
DN_ALPHA = (2 * DEPTH) ** 0.25
DN_BETA = (8 * DEPTH) ** -0.25
LN_EPS = 1e-5
NEG = -1e30
FORCE_SCORE = 1e4

IN_WIDTHS = (M_WIDTH, M_WIDTH, M_WIDTH, M_HEADS, M_HEADS, N_WIDTH, N_KV_WIDTH, N_KV_WIDTH, N_KV_WIDTH, 3 * N_HEADS, D_MODEL, D_MODEL)
IN_DIM = sum(IN_WIDTHS)

kernel_name = 'hybrid_mlstm_nsa_peer_decode_step'


def layer_norm(x, g, b):
    xf = x.astype(jnp.float32)
    mu = xf.mean(-1, keepdims=True)
    var = jnp.square(xf - mu).mean(-1, keepdims=True)
    return ((xf - mu) * lax.rsqrt(var + LN_EPS) * g + b).astype(x.dtype)


def split_in(z):
    outs, off = [], 0
    for w in IN_WIDTHS:
        outs.append(z[..., off:off + w])
        off += w
    return outs


def pad_time(a, n):
    return jnp.pad(a, [(0, 0), (0, n)] + [(0, 0)] * (a.ndim - 2))


def to_blocks(a, qb):
    B, T = a.shape[:2]
    return jnp.swapaxes(a.reshape((B, T // qb, qb) + a.shape[2:]), 0, 1)


def from_blocks(a):
    a = jnp.swapaxes(a, 0, 1)
    return a.reshape((a.shape[0], a.shape[1] * a.shape[2]) + a.shape[3:])


def rel_bucket(dist):
    n = jnp.maximum(dist, 0)
    exact = REL_BUCKETS // 2
    nf = jnp.maximum(n, exact).astype(jnp.float32)
    large = exact + (jnp.log(nf / exact) / math.log(REL_MAX_DIST / exact) * (REL_BUCKETS - exact)).astype(jnp.int32)
    return jnp.where(n < exact, n, jnp.minimum(large, REL_BUCKETS - 1))


def rel_bias_lookup(rel_bias, dist):
    return rel_bias[rel_bucket(dist)].astype(jnp.float32).reshape(dist.shape + (N_KV_HEADS, N_GROUP))


def masked_softmax(s, mask):
    s = jnp.where(mask, s, NEG)
    e = jnp.where(mask, jnp.exp(s - s.max(-1, keepdims=True)), 0.0)
    return e / jnp.maximum(e.sum(-1, keepdims=True), 1e-30)


def attn_core(q, q_pos, kv, k_pos, mask, rel_bias):
    s = jnp.einsum('bthgd,bkhd->bthgk', q, kv[:, :, 0]).astype(jnp.float32) * ATTN_SCALE
    bias = jnp.transpose(rel_bias_lookup(rel_bias, q_pos[:, None] - k_pos[None, :]), (0, 2, 3, 1))
    p = masked_softmax(s + bias, mask[:, None, None, :])
    return jnp.einsum('bthgk,bkhd->bthgd', p.astype(kv.dtype), kv[:, :, 1]), p


def window_attn(q, q_pos, kv, k_pos, rel_bias):
    d = q_pos[:, None] - k_pos[None, :]
    mask = (d >= 0) & (d < WINDOW) & (k_pos[None, :] >= 0)
    return attn_core(q, q_pos, kv, k_pos, mask, rel_bias)[0]


def compress_blocks(kv, pe, w1, w2):
    B, T = kv.shape[:2]
    half = CMP_BLOCK // CMP_STRIDE
    nc = T // CMP_STRIDE
    ch = kv.reshape(B, nc, CMP_STRIDE, 2, N_KV_HEADS, N_HEAD_DIM)
    w1r = w1.reshape(2, half, CMP_STRIDE, N_HEAD_DIM, N_HEAD_DIM)
    per = pe.reshape(2, half, CMP_STRIDE, N_HEAD_DIM)
    proj = jnp.einsum('bnrchd,cprdo->bnpcho', ch, w1r)
    proj = proj + jnp.einsum('cprd,cprdo->pco', per, w1r)[:, :, None, :]
    nw = nc - half + 1
    hid = jax.nn.gelu(sum(proj[:, p:p + nw, p] for p in range(half)))
    return jnp.einsum('bnchi,cio->bncho', hid, w2)


def select_blocks(p_cmp, q_pos, n_sel):
    half = CMP_BLOCK // CMP_STRIDE
    pg = p_cmp.sum(axis=3)
    pads = [(0, 0)] * 3
    chunk = sum(jnp.pad(pg, pads + [(p, half - 1 - p)]) for p in range(half))
    ps = chunk.reshape(chunk.shape[:-1] + (n_sel, SLC_BLOCK // CMP_STRIDE)).sum(-1)
    blk = jnp.arange(n_sel, dtype=jnp.int32)[None, :]
    cur = (q_pos // SLC_BLOCK)[:, None]
    causal = blk * SLC_BLOCK <= q_pos[:, None]
    forced = (blk == 0) | (blk == cur) | (blk == cur - 1)
    score = jnp.where(causal[None, :, None, :], jnp.where(forced[None, :, None, :], FORCE_SCORE, ps), NEG)
    _, idx = lax.top_k(score, min(N_SELECT, n_sel))
    valid = idx * SLC_BLOCK <= q_pos[None, :, None, None]
    return idx, valid


def selected_attn(q, q_pos, idx, valid, kv_sel, rel_bias):
    B, Tq, H, K = idx.shape
    k_pos = idx[..., None] * SLC_BLOCK + jnp.arange(SLC_BLOCK, dtype=jnp.int32)
    qp = q_pos[None, :, None, None, None]
    mask = (valid[..., None] & (k_pos <= qp)).reshape(B, Tq, H, 1, K * SLC_BLOCK)
    s = jnp.einsum('bthgd,bthksd->bthgks', q, kv_sel[..., 0, :]).astype(jnp.float32) * ATTN_SCALE
    hidx = jnp.arange(N_KV_HEADS)[None, None, :, None, None]
    bias = rel_bias.reshape(REL_BUCKETS, N_KV_HEADS, N_GROUP)[rel_bucket(qp - k_pos), hidx].astype(jnp.float32)
    s = s + jnp.moveaxis(bias, -1, 3)
    p = masked_softmax(s.reshape(B, Tq, H, N_GROUP, K * SLC_BLOCK), mask).reshape(s.shape)
    return jnp.einsum('bthgks,bthksd->bthgd', p.astype(kv_sel.dtype), kv_sel[..., 1, :])


def combine_nsa(gates, o_cmp, o_slc, o_win):
    B, T = gates.shape[:2]
    g = jax.nn.sigmoid(gates.astype(jnp.float32)).reshape(B, T, 3, N_KV_HEADS, N_GROUP, 1)
    o = g[:, :, 0] * o_cmp + g[:, :, 1] * o_slc + g[:, :, 2] * o_win
    return o.reshape(B, T, N_WIDTH).astype(gates.dtype)


def nsa_prompt(q, gates, kv_cmp, kv_slc, kv_win, pe, w1, w2, rel_bias):
    B, T = q.shape[:2]
    q_pos = jnp.arange(T, dtype=jnp.int32)
    t_pad = -(-T // SLC_BLOCK) * SLC_BLOCK
    kc = compress_blocks(pad_time(kv_cmp, t_pad - T), pe, w1, w2)
    k_end = jnp.arange(kc.shape[1], dtype=jnp.int32) * CMP_STRIDE + (CMP_BLOCK - 1)
    o_cmp, p_cmp = attn_core(q, q_pos, kc, k_end, k_end[None, :] <= q_pos[:, None], rel_bias)
    n_sel = t_pad // SLC_BLOCK
    idx, valid = select_blocks(p_cmp, q_pos, n_sel)
    blocks = pad_time(kv_slc, t_pad - T).reshape(B, n_sel, SLC_BLOCK, 2, N_KV_HEADS, N_HEAD_DIM)
    bidx = jnp.arange(B)[:, None, None, None]
    hidx = jnp.arange(N_KV_HEADS)[None, None, :, None]
    qb = min(SEL_QBLOCK, T)

    def sel_block(args):
        q_b, pos_b, idx_b, val_b = args
        return selected_attn(q_b, pos_b, idx_b, val_b, blocks[bidx, idx_b, :, :, hidx], rel_bias)

    o_slc = from_blocks(lax.map(sel_block, (to_blocks(q, qb), q_pos.reshape(-1, qb), to_blocks(idx, qb), to_blocks(valid, qb))))
    wq = min(WIN_QBLOCK, T)
    kv_wp = jnp.pad(kv_win, [(0, 0), (WINDOW, 0), (0, 0), (0, 0), (0, 0)])

    def win_block(n):
        start = n * wq
        q_b = lax.dynamic_slice_in_dim(q, start, wq, axis=1)
        kv_b = lax.dynamic_slice_in_dim(kv_wp, start, wq + WINDOW, axis=1)
        pos_b = start + jnp.arange(wq, dtype=jnp.int32)
        kpos_b = start - WINDOW + jnp.arange(wq + WINDOW, dtype=jnp.int32)
        return window_attn(q_b, pos_b, kv_b, kpos_b, rel_bias)

    o_win = from_blocks(lax.map(win_block, jnp.arange(T // wq, dtype=jnp.int32)))
    return combine_nsa(gates, o_cmp, o_slc, o_win), kv_win[:, -min(WINDOW, T):]


def nsa_sample(q, gates, kv_cmp, kv_slc, kv_win, pool_cmp, pool_slc, win_buf, page_table, pe, w1, w2, rel_bias):
    B, T = q.shape[:2]
    past = page_table.shape[1] * PAGE_SIZE
    q_pos = past + jnp.arange(T, dtype=jnp.int32)
    total = past + T
    t_pad = -(-total // SLC_BLOCK) * SLC_BLOCK
    past_cmp = pool_cmp[page_table].reshape(B, past, 2, N_KV_HEADS, N_HEAD_DIM)
    full_cmp = pad_time(jnp.concatenate([past_cmp, kv_cmp], axis=1), t_pad - total)
    kc = compress_blocks(full_cmp, pe, w1, w2)
    k_end = jnp.arange(kc.shape[1], dtype=jnp.int32) * CMP_STRIDE + (CMP_BLOCK - 1)
    o_cmp, p_cmp = attn_core(q, q_pos, kc, k_end, k_end[None, :] <= q_pos[:, None], rel_bias)
    n_sel = t_pad // SLC_BLOCK
    idx, valid = select_blocks(p_cmp, q_pos, n_sel)
    bpp = PAGE_SIZE // SLC_BLOCK
    n_past_blk = past // SLC_BLOCK
    n_tail = n_sel - n_past_blk
    pool_blk = pool_slc.reshape(-1, SLC_BLOCK, 2, N_KV_HEADS, N_HEAD_DIM)
    tail = pad_time(kv_slc, n_tail * SLC_BLOCK - T).reshape(B, n_tail, SLC_BLOCK, 2, N_KV_HEADS, N_HEAD_DIM)
    bidx = jnp.arange(B)[:, None, None, None]
    hidx = jnp.arange(N_KV_HEADS)[None, None, :, None]
    pj = jnp.minimum(idx, n_past_blk - 1)
    phys = page_table[bidx, pj // bpp] * bpp + pj % bpp
    tj = jnp.clip(idx - n_past_blk, 0, n_tail - 1)
    kv_sel = jnp.where((idx < n_past_blk)[..., None, None, None], pool_blk[phys, :, :, hidx], tail[bidx, tj, :, :, hidx])
    o_slc = selected_attn(q, q_pos, idx, valid, kv_sel, rel_bias)
    wb = win_buf.shape[1]
    keys = jnp.concatenate([win_buf.astype(kv_win.dtype), kv_win], axis=1)
    k_pos = past - wb + jnp.arange(wb + T, dtype=jnp.int32)
    o_win = window_attn(q, q_pos, keys, k_pos, rel_bias)
    return combine_nsa(gates, o_cmp, o_slc, o_win), keys[:, T:]


def mlstm_scan(q, k, v, ig, lf, C0, n0, m0):
    B, T, H, D = q.shape
    L = min(M_CHUNK, T)
    nC = -(-T // L)
    tp = nC * L - T

    def prep(a, fill):
        a = jnp.pad(a, [(0, 0), (0, tp)] + [(0, 0)] * (a.ndim - 2), constant_values=fill)
        a = a.reshape((B, nC, L) + a.shape[2:])
        return jnp.swapaxes(jnp.moveaxis(a, 1, 0), 2, 3)

    tril = jnp.tril(jnp.ones((L, L), dtype=bool))

    def step(carry, xs):
        C, n, m = carry
        qc, kc, vc, igc, lfc = xs
        b = jnp.cumsum(lfc, axis=-1)
        logw = jnp.where(tril, b[..., :, None] - b[..., None, :] + igc[..., None, :], NEG)
        m_inter = b + m[..., None]
        m_t = jnp.maximum(m_inter, logw.max(-1))
        sw = jnp.einsum('bhtd,bhsd->bhts', qc, kc) * jnp.exp(logw - m_t[..., None])
        scale_in = jnp.exp(m_inter - m_t)
        num = scale_in[..., None] * jnp.einsum('bhvk,bhtk->bhtv', C, qc) + jnp.einsum('bhts,bhsv->bhtv', sw, vc)
        den = scale_in * jnp.einsum('bhk,bhtk->bht', n, qc) + sw.sum(-1)
        h = num / jnp.maximum(jnp.abs(den), jnp.exp(-m_t))[..., None]
        m_new = m_t[..., -1]
        wts = jnp.exp(b[..., -1:] - b + igc - m_new[..., None])
        decay = jnp.exp(b[..., -1] + m - m_new)
        C = decay[..., None, None] * C + jnp.einsum('bhs,bhsv,bhsk->bhvk', wts, vc, kc)
        n = decay[..., None] * n + jnp.einsum('bhs,bhsk->bhk', wts, kc)
        return (C, n, m_new), h

    (C, n, m), h = lax.scan(step, (C0, n0, m0), (prep(q, 0.0), prep(k, 0.0), prep(v, 0.0), prep(ig, NEG), prep(lf, 0.0)))
    h = jnp.moveaxis(jnp.swapaxes(h, 2, 3), 0, 1).reshape(B, nC * L, H, D)[:, :T]
    return h, C, n, m


def mlstm_branch(u, v, o_pre, i_pre, f_pre, conv_buf, C0, n0, m0, conv_w, conv_b, wq, wk, gate_bias, norm_g):
    B, T = u.shape[:2]
    f32 = jnp.float32
    full = jnp.concatenate([conv_buf.astype(u.dtype), u], axis=1)
    c = conv_b + sum(conv_w[j] * full[:, j:j + T] for j in range(M_CONV))
    c = jax.nn.silu(c).reshape(B, T, M_HEADS, M_HEAD_DIM)
    q = jnp.einsum('bthd,hde->bthe', c, wq).astype(f32)
    k = jnp.einsum('bthd,hde->bthe', c, wk).astype(f32) * (M_HEAD_DIM ** -0.5)
    vv = v.reshape(B, T, M_HEADS, M_HEAD_DIM).astype(f32)
    ig = i_pre.astype(f32) + gate_bias[0].astype(f32)
    lf = jax.nn.log_sigmoid(f_pre.astype(f32) + gate_bias[1].astype(f32))
    h, C, n, m = mlstm_scan(q, k, vv, ig, lf, C0.astype(f32), n0.astype(f32), m0.astype(f32))
    mu = h.mean(-1, keepdims=True)
    var = jnp.square(h - mu).mean(-1, keepdims=True)
    hn = (h - mu) * lax.rsqrt(var + LN_EPS) * norm_g.astype(f32).reshape(M_HEADS, M_HEAD_DIM)
    out = (jax.nn.sigmoid(o_pre.astype(f32)) * hn.reshape(B, T, M_WIDTH)).astype(u.dtype)
    return out, C, n, m, full[:, T:]


def peer_ffn(x, wq, subkeys, u_tab, v_tab):
    B, T, D = x.shape
    N = B * T
    blk = min(PEER_TOKEN_BLOCK, N)
    nb = -(-N // blk)
    xf = jnp.pad(x.reshape(N, D), [(0, nb * blk - N), (0, 0)]).reshape(nb, blk, D)
    half = PEER_QDIM // 2

    def one(xb):
        q = (xb @ wq).reshape(blk, PEER_HEADS, 2, half)
        s = jnp.einsum('nhpd,pkd->nhpk', q, subkeys).astype(jnp.float32)
        s1, i1 = lax.top_k(s[:, :, 0], PEER_TOPK)
        s2, i2 = lax.top_k(s[:, :, 1], PEER_TOPK)
        cand = (s1[..., :, None] + s2[..., None, :]).reshape(blk, PEER_HEADS, PEER_TOPK * PEER_TOPK)
        sc, ci = lax.top_k(cand, PEER_TOPK)
        e = jnp.take_along_axis(i1, ci // PEER_TOPK, -1) * PEER_KEYS + jnp.take_along_axis(i2, ci % PEER_TOPK, -1)
        g = jax.nn.softmax(sc, axis=-1)
        act = jax.nn.gelu(jnp.einsum('nhkd,nd->nhk', u_tab[e], xb).astype(jnp.float32))
        return jnp.einsum('nhk,nhkd->nd', (g * act).astype(v_tab.dtype), v_tab[e])

    return lax.map(one, xf).reshape(nb * blk, D)[:N].reshape(B, T, D).astype(x.dtype)


def trunk_layer(x, nsa_fn, conv_buf, C0, n0, m0, w_in, m_conv_w, m_conv_b, m_wq, m_wk, m_gate_bias, m_norm_g,
                w_up_m, w_up_n, w_out, ln1_g, ln1_b, ln2_g, ln2_b, peer_wq, peer_subkeys, peer_u, peer_v):
    B, T, _ = x.shape
    (u, v, o_pre, i_pre, f_pre, q_n, kv_c, kv_s, kv_w, g_n, gate_m, gate_n) = split_in(x @ w_in)
    m_out, C, n, m, conv_new = mlstm_branch(u, v, o_pre, i_pre, f_pre, conv_buf, C0, n0, m0,
                                            m_conv_w, m_conv_b, m_wq, m_wk, m_gate_bias, m_norm_g)
    kv_c = kv_c.reshape(B, T, 2, N_KV_HEADS, N_HEAD_DIM)
    kv_s = kv_s.reshape(B, T, 2, N_KV_HEADS, N_HEAD_DIM)
    kv_w = kv_w.reshape(B, T, 2, N_KV_HEADS, N_HEAD_DIM)
    n_out, win_state = nsa_fn(q_n.reshape(B, T, N_KV_HEADS, N_GROUP, N_HEAD_DIM), g_n, kv_c, kv_s, kv_w)
    mix = jax.nn.sigmoid(gate_m) * (m_out @ w_up_m) + jax.nn.sigmoid(gate_n) * (n_out @ w_up_n)
    x = layer_norm(DN_ALPHA * x + mix @ w_out, ln1_g, ln1_b)
    x = layer_norm(DN_ALPHA * x + peer_ffn(x, peer_wq, peer_subkeys, peer_u, peer_v), ln2_g, ln2_b)
    return x, (kv_c, kv_s, win_state, C, n, m, conv_new)


def setup_inputs(seed: int = 0) -> dict:
    key = jax.random.key(seed)
    kit = iter(jax.random.split(key, 48))
    f32 = jnp.float32

    def nrm(shape, scale):
        return jax.random.normal(next(kit), shape, f32) * scale

    n_pages = PAST_LEN // PAGE_SIZE
    n_phys = (5 * DEC_BATCH * n_pages + 3) // 4
    win_buf = min(WINDOW, PAST_LEN)
    page_table = jax.random.permutation(next(kit), n_phys)[:DEC_BATCH * n_pages].reshape(DEC_BATCH, n_pages).astype(jnp.int32)
    kv_tail = (2, N_KV_HEADS, N_HEAD_DIM)
    return {
        'x_prompt': nrm((BATCH, SEQ, D_MODEL), 1.0),
        'x_sample': nrm((DEC_BATCH, DEC_SEQ, D_MODEL), 1.0),
        'cache_cmp_kv': nrm((DEPTH, n_phys, PAGE_SIZE) + kv_tail, 1.0),
        'cache_slc_kv': nrm((DEPTH, n_phys, PAGE_SIZE) + kv_tail, 1.0),
        'page_table': page_table,
        'state_win_kv': nrm((DEPTH, DEC_BATCH, win_buf) + kv_tail, 1.0),
        'state_mlstm_C': nrm((DEPTH, DEC_BATCH, M_HEADS, M_HEAD_DIM, M_HEAD_DIM), M_HEAD_DIM ** -0.5),
        'state_mlstm_n': nrm((DEPTH, DEC_BATCH, M_HEADS, M_HEAD_DIM), M_HEAD_DIM ** -0.5),
        'state_mlstm_m': nrm((DEPTH, DEC_BATCH, M_HEADS), 0.5),
        'state_mlstm_conv': nrm((DEPTH, DEC_BATCH, M_CONV - 1, M_WIDTH), 1.0),
        'w_in': nrm((DEPTH, D_MODEL, IN_DIM), D_MODEL ** -0.5),
        'm_conv_w': nrm((DEPTH, M_CONV, M_WIDTH), 0.5),
        'm_conv_b': nrm((DEPTH, M_WIDTH), 0.01),
        'm_wq': nrm((DEPTH, M_HEADS, M_HEAD_DIM, M_HEAD_DIM), M_HEAD_DIM ** -0.5),
        'm_wk': nrm((DEPTH, M_HEADS, M_HEAD_DIM, M_HEAD_DIM), M_HEAD_DIM ** -0.5),
        'm_gate_bias': jnp.stack([nrm((DEPTH, M_HEADS), 0.1),
                                  jnp.linspace(3.0, 6.0, M_HEADS) + nrm((DEPTH, M_HEADS), 0.1)], axis=1),
        'm_norm_g': 1.0 + nrm((DEPTH, M_WIDTH), 0.01),
        'cmp_pe': nrm((DEPTH, 2, CMP_BLOCK, N_HEAD_DIM), 0.02),
        'cmp_w1': nrm((DEPTH, 2, CMP_BLOCK * N_HEAD_DIM, N_HEAD_DIM), (CMP_BLOCK * N_HEAD_DIM) ** -0.5),
        'cmp_w2': nrm((DEPTH, 2, N_HEAD_DIM, N_HEAD_DIM), N_HEAD_DIM ** -0.5),
        'rel_bias': nrm((REL_BUCKETS, N_HEADS), 0.1),
        'w_up_m': nrm((DEPTH, M_WIDTH, D_MODEL), M_WIDTH ** -0.5 * DN_BETA),
        'w_up_n': nrm((DEPTH, N_WIDTH, D_MODEL), N_WIDTH ** -0.5 * DN_BETA),
        'w_out': nrm((DEPTH, D_MODEL, D_MODEL), D_MODEL ** -0.5 * DN_BETA),
        'ln1_g': 1.0 + nrm((DEPTH, D_MODEL), 0.01),
        'ln1_b': nrm((DEPTH, D_MODEL), 0.01),
        'ln2_g': 1.0 + nrm((DEPTH, D_MODEL), 0.01),
        'ln2_b': nrm((DEPTH, D_MODEL), 0.01),
        'peer_wq': nrm((DEPTH, D_MODEL, PEER_HEADS * PEER_QDIM), D_MODEL ** -0.5),
        'peer_subkeys': nrm((DEPTH, 2, PEER_KEYS, PEER_QDIM // 2), (PEER_QDIM // 2) ** -0.5),
        'peer_u': nrm((DEPTH, PEER_EXPERTS, D_MODEL), D_MODEL ** -0.5),
        'peer_v': nrm((DEPTH, PEER_EXPERTS, D_MODEL), DN_BETA * PEER_HEADS ** -0.5),
    }


def reference(x_prompt, x_sample, cache_cmp_kv, cache_slc_kv, page_table, state_win_kv, state_mlstm_C, state_mlstm_n,
              state_mlstm_m, state_mlstm_conv, w_in, m_conv_w, m_conv_b, m_wq, m_wk, m_gate_bias, m_norm_g, cmp_pe,
              cmp_w1, cmp_w2, rel_bias, w_up_m, w_up_n, w_out, ln1_g, ln1_b, ln2_g, ln2_b, peer_wq, peer_subkeys,
              peer_u, peer_v):
    Bp = x_prompt.shape[0]
    xp, xs = x_prompt, x_sample
    states_p, states_s = [], []
    for l in range(DEPTH):
        shared = (w_in[l], m_conv_w[l], m_conv_b[l], m_wq[l], m_wk[l], m_gate_bias[l], m_norm_g[l],
                  w_up_m[l], w_up_n[l], w_out[l], ln1_g[l], ln1_b[l], ln2_g[l], ln2_b[l],
                  peer_wq[l], peer_subkeys[l], peer_u[l], peer_v[l])
        nsa_p = functools.partial(nsa_prompt, pe=cmp_pe[l], w1=cmp_w1[l], w2=cmp_w2[l], rel_bias=rel_bias)
        xp, st_p = trunk_layer(xp, nsa_p,
                               jnp.zeros((Bp, M_CONV - 1, M_WIDTH), xp.dtype),
                               jnp.zeros((Bp, M_HEADS, M_HEAD_DIM, M_HEAD_DIM), jnp.float32),
                               jnp.zeros((Bp, M_HEADS, M_HEAD_DIM), jnp.float32),
                               jnp.zeros((Bp, M_HEADS), jnp.float32), *shared)
        nsa_s = functools.partial(nsa_sample, pool_cmp=cache_cmp_kv[l], pool_slc=cache_slc_kv[l],
                                  win_buf=state_win_kv[l], page_table=page_table,
                                  pe=cmp_pe[l], w1=cmp_w1[l], w2=cmp_w2[l], rel_bias=rel_bias)
        xs, st_s = trunk_layer(xs, nsa_s, state_mlstm_conv[l], state_mlstm_C[l], state_mlstm_n[l],
                               state_mlstm_m[l], *shared)
        states_p.append(st_p)
        states_s.append(st_s)
    cmp_p, slc_p, win_p, C_p, n_p, m_p, conv_p = [jnp.stack(a) for a in zip(*states_p)]
    cmp_s, slc_s, win_s, C_s, n_s, m_s, conv_s = [jnp.stack(a) for a in zip(*states_s)]
    return (xp, xs, cmp_p, cmp_s, slc_p, slc_s, win_p, win_s, C_p, C_s, n_p, n_s, m_p, m_s, conv_p, conv_s)
```

```cpp
#include <hip/hip_runtime.h>
#include <stdint.h>
#include <cstdio>

#define DEV __device__ __forceinline__

constexpr int DM = 1024;
constexpr int BP = 16, TP = 2048, BS = 32;
constexpr int NP = BP * TP;
constexpr int NR = NP + BS;
constexpr int MP = 32896;
constexpr int IN_DIM = 4896;
constexpr int C_U = 0, C_V = 512, C_O = 1024, C_I = 1536, C_F = 1540, C_Q = 1544, C_KC = 2056, C_KS = 2312, C_KW = 2568, C_G = 2824, C_GM = 2848, C_GN = 3872;
constexpr int PAST = 16384;
constexpr float NEGF = -1e30f;
constexpr float DN_ALPHA = 1.189207115002721f;
constexpr float LN_EPS = 1e-5f;

constexpr size_t O_Y = 0;
constexpr size_t O_CMPP = (size_t)NR * DM;
constexpr size_t O_CMPS = O_CMPP + (size_t)NP * 256;
constexpr size_t O_SLCP = O_CMPS + (size_t)BS * 256;
constexpr size_t O_SLCS = O_SLCP + (size_t)NP * 256;
constexpr size_t O_WINP = O_SLCS + (size_t)BS * 256;
constexpr size_t O_WINS = O_WINP + (size_t)BP * 512 * 256;
constexpr size_t O_CP = O_WINS + (size_t)BS * 512 * 256;
constexpr size_t O_CS = O_CP + (size_t)BP * 4 * 128 * 128;
constexpr size_t O_NP = O_CS + (size_t)BS * 4 * 128 * 128;
constexpr size_t O_NS = O_NP + (size_t)BP * 4 * 128;
constexpr size_t O_MP = O_NS + (size_t)BS * 4 * 128;
constexpr size_t O_MS = O_MP + (size_t)BP * 4;
constexpr size_t O_CVP = O_MS + (size_t)BS * 4;
constexpr size_t O_CVS = O_CVP + (size_t)BP * 3 * 512;
constexpr size_t O_END = O_CVS + (size_t)BS * 3 * 512;
static_assert(O_END == 59916480, "output size");

constexpr size_t al256(size_t x) { return (x + 255) & ~(size_t)255; }
constexpr size_t WS_BAR = 0;
constexpr size_t WS_Z = 16384;
constexpr size_t WS_QK = al256(WS_Z + (size_t)MP * IN_DIM * 4);
constexpr size_t WS_HRAW = al256(WS_QK + (size_t)MP * 1024 * 4);
constexpr size_t WS_MOUT = al256(WS_HRAW + (size_t)MP * 512 * 4);
constexpr size_t WS_NOUT = al256(WS_MOUT + (size_t)MP * 512 * 4);
constexpr size_t WS_HIDP = al256(WS_NOUT + (size_t)MP * 512 * 4);
constexpr size_t WS_KCP = al256(WS_HIDP + (size_t)2 * 4096 * 64 * 4);
constexpr size_t WS_HIDS = al256(WS_KCP + (size_t)2 * 4096 * 64 * 4);
constexpr size_t WS_KCS = al256(WS_HIDS + (size_t)2 * 65536 * 64 * 4);
constexpr size_t WS_MIX = al256(WS_KCS + (size_t)2 * 65536 * 64 * 4);
constexpr size_t WS_T1 = al256(WS_MIX + (size_t)MP * 1024 * 4);
constexpr size_t WS_X1 = al256(WS_T1 + (size_t)MP * 1024 * 4);
constexpr size_t WS_QP = al256(WS_X1 + (size_t)MP * 1024 * 4);
constexpr size_t WS_S = al256(WS_QP + (size_t)MP * 2048 * 4);
constexpr size_t WS_PIDX = al256(WS_S + (size_t)MP * 2048 * 4);
constexpr size_t WS_PG = al256(WS_PIDX + (size_t)MP * 128 * 4);
constexpr size_t WS_CONV = al256(WS_PG + (size_t)MP * 128 * 4);
constexpr size_t WS_END = al256(WS_CONV + (size_t)MP * 512 * 4);

constexpr int LDS_BYTES = 73728;
constexpr int NTHREADS = 256;

struct Params {
    const float* x_prompt; const float* x_sample; const float* cache_cmp; const float* cache_slc; const int* page_table;
    const float* state_win; const float* state_C; const float* state_n; const float* state_m; const float* state_conv;
    const float* w_in; const float* conv_w; const float* conv_b; const float* wq; const float* wk; const float* gate_bias; const float* norm_g;
    const float* cmp_pe; const float* cmp_w1; const float* cmp_w2; const float* rel_bias; const float* w_up_m; const float* w_up_n; const float* w_out;
    const float* ln1_g; const float* ln1_b; const float* ln2_g; const float* ln2_b; const float* peer_wq; const float* peer_sub; const float* peer_u; const float* peer_v;
    float* out; unsigned char* ws;
};

#define XB_TMO      128
#define XB_XCNT(j)  (256  + 64 * (j))
#define XB_XSUB(j)  (1280 + 64 * (j))
#define XB_XGEN(j)  (2304 + 64 * (j))
#define XB_TOP      3328
#define XB_TOPGEN   3392
#define XCD_BAR_WORDS 3456
#define XB_SPIN_CAP (1u << 22)
#define LAS __attribute__((address_space(3)))

__device__ __forceinline__ unsigned xb_ld(unsigned* p)              { return __hip_atomic_load(p, __ATOMIC_RELAXED, __HIP_MEMORY_SCOPE_AGENT); }
__device__ __forceinline__ unsigned xb_add(unsigned* p, unsigned v) { return __hip_atomic_fetch_add(p, v, __ATOMIC_RELAXED, __HIP_MEMORY_SCOPE_AGENT); }
__device__ __forceinline__ unsigned xb_xcc_id() { return (unsigned)__builtin_amdgcn_s_getreg((3 << 11) | 20) & 0xFu; }
#define XB_SPIN(cond, bar) do { unsigned _sp = 0; while (cond) { __builtin_amdgcn_s_sleep(1); \
    if ((++_sp & 255u) == 0u) { if (xb_ld(&(bar)[XB_TMO])) break; if (_sp > XB_SPIN_CAP) { atomicAdd(&(bar)[XB_TMO], 1u); break; } } } } while (0)

struct XcdBarrier { unsigned* bar; unsigned x; volatile LAS unsigned* st; };

__device__ __forceinline__ XcdBarrier xcd_barrier_post(unsigned* bar, volatile LAS unsigned* st) {
    XcdBarrier b; b.bar = bar; b.x = xb_xcc_id(); b.st = st;
    if (threadIdx.x == 0) (void)xb_add(&bar[XB_XCNT(b.x)], 1u);
    return b;
}
__device__ __forceinline__ void xcd_barrier_complete(unsigned* bar, unsigned x, unsigned& nloc, unsigned& nx) {
    const unsigned G = gridDim.x * gridDim.y * gridDim.z;
    unsigned sum, cnt, mine, sp = 0u;
    for (;;) {
        sum = 0u; cnt = 0u; mine = 0u;
#pragma unroll
        for (unsigned j = 0; j < 16; ++j) { const unsigned c = xb_ld(&bar[XB_XCNT(j)]); sum += c; cnt += (c > 0u) ? 1u : 0u; mine = (j == x) ? c : mine; }
        if (sum == G) break;
        __builtin_amdgcn_s_sleep(1);
        if ((++sp & 255u) == 0u) { if (xb_ld(&bar[XB_TMO])) break; if (sp > XB_SPIN_CAP) { atomicAdd(&bar[XB_TMO], 1u); break; } }
    }
    nloc = mine > 0u ? mine : 1u; nx = cnt > 0u ? cnt : 1u;
}
__device__ __forceinline__ void xcd_barrier(const XcdBarrier& b) {
    asm volatile("s_waitcnt vmcnt(0)" ::: "memory");
    __syncthreads();
    if (threadIdx.x == 0) {
        unsigned* bar = b.bar;
        __builtin_amdgcn_s_waitcnt(0);
        unsigned nloc = b.st[0], nx = b.st[1];
        if (nloc == 0u) { xcd_barrier_complete(bar, b.x, nloc, nx); b.st[0] = nloc; b.st[1] = nx; }
        const unsigned old = xb_add(&bar[XB_XSUB(b.x)], 1u);
        const unsigned gen = old / nloc;
        if (old + 1u == (gen + 1u) * nloc) {
            __builtin_amdgcn_fence(__ATOMIC_RELEASE, "agent");
            asm volatile("s_waitcnt vmcnt(0)" ::: "memory");
            const unsigned og = xb_add(&bar[XB_TOP], 1u);
            const unsigned tg = og / nx;
            if (og + 1u == (tg + 1u) * nx) xb_add(&bar[XB_TOPGEN], 1u);
            else XB_SPIN(xb_ld(&bar[XB_TOPGEN]) == tg, bar);
            __builtin_amdgcn_fence(__ATOMIC_ACQUIRE, "agent");
            xb_add(&bar[XB_XGEN(b.x)], 1u);
            asm volatile("s_waitcnt vmcnt(0)" ::: "memory");
        } else {
            XB_SPIN(xb_ld(&bar[XB_XGEN(b.x)]) == gen, bar);
            __builtin_amdgcn_fence(__ATOMIC_ACQUIRE, "agent");
            asm volatile("s_waitcnt vmcnt(0)" ::: "memory");
        }
    }
    __syncthreads();
}

typedef float f32x4 __attribute__((ext_vector_type(4)));

__device__ const unsigned char REL_LUT[128] = {
    0, 1, 2, 3, 4, 5, 6, 7, 8, 9, 10, 11, 12, 13, 14, 15, 16, 16, 16, 17, 17, 18, 18, 18, 19, 19, 19, 20, 20, 20, 20, 21, 21, 21, 21, 22, 22, 22, 22, 22,
    23, 23, 23, 23, 23, 23, 24, 24, 24, 24, 24, 24, 25, 25, 25, 25, 25, 25, 25, 26, 26, 26, 26, 26, 26, 26, 26, 27, 27, 27, 27, 27, 27, 27, 27, 27, 27,
    28, 28, 28, 28, 28, 28, 28, 28, 28, 28, 29, 29, 29, 29, 29, 29, 29, 29, 29, 29, 29, 29, 30, 30, 30, 30, 30, 30, 30, 30, 30, 30, 30, 30, 30, 30,
    31, 31, 31, 31, 31, 31, 31, 31, 31, 31, 31, 31, 31, 31, 31};
DEV int rel_bucket(int n) { return n < 128 ? (int)REL_LUT[n < 0 ? 0 : n] : 31; }

DEV float sigmoidf_(float x) { return 1.0f / (1.0f + expf(-x)); }
DEV float gelu_tanh(float x) { return 0.5f * x * (1.0f + tanhf(0.7978845608028654f * (x + 0.044715f * x * x * x))); }
DEV float log_sigmoid(float x) { return x >= 0.f ? -log1pf(expf(-x)) : x - log1pf(expf(x)); }
DEV void wave_sync() { asm volatile("s_waitcnt lgkmcnt(0)" ::: "memory"); __builtin_amdgcn_wave_barrier(); asm volatile("" ::: "memory"); }
DEV float wave_sum(float v) {
#pragma unroll
    for (int o = 32; o >= 1; o >>= 1) v += __shfl_xor(v, o);
    return v;
}
DEV float wave_max(float v) {
#pragma unroll
    for (int o = 32; o >= 1; o >>= 1) v = fmaxf(v, __shfl_xor(v, o));
    return v;
}

template <bool B_KFAST, bool SERIAL_A = false, class AF, class BF, class EF>
DEV void gemm_f32(const int M, const int N, const int K, AF af, BF bf, EF ef, float* lds) {
    const int tid = threadIdx.x, lane = tid & 63, w = tid >> 6, wm = w >> 1, wn = w & 1;
    const int tm = (M + 127) >> 7, tn = (N + 127) >> 7;
    float* As = lds;
    float* Bs = lds + 128 * 34;
    for (int tile = blockIdx.x; tile < tm * tn; tile += gridDim.x) {
        const int bm = (tile / tn) * 128, bn = (tile % tn) * 128;
        f32x4 acc[4][4];
#pragma unroll
        for (int i = 0; i < 4; ++i)
#pragma unroll
            for (int j = 0; j < 4; ++j) acc[i][j] = (f32x4){0.f, 0.f, 0.f, 0.f};
        for (int k0_ = 0; k0_ < K; k0_ += 32) {
            float ra[16], rb[16];
            int k0 = k0_; asm volatile("" : "+v"(k0));
            const int kk = tid & 31, r0 = tid >> 5;
#pragma unroll
            for (int i = 0; i < 16; ++i) { const int r = bm + r0 + 8 * i; ra[i] = (r < M) ? af(r, k0 + kk) : 0.f; if (SERIAL_A) asm volatile("" : "+v"(ra[i]) :: "memory"); }
            if (B_KFAST) {
#pragma unroll
                for (int i = 0; i < 16; ++i) { const int n = bn + r0 + 8 * i; rb[i] = (n < N) ? bf(n, k0 + kk) : 0.f; }
            } else {
                const int nn = tid & 127, kq = tid >> 7, n = bn + nn;
#pragma unroll
                for (int i = 0; i < 16; ++i) rb[i] = (n < N) ? bf(n, k0 + kq + 2 * i) : 0.f;
            }
            __syncthreads();
#pragma unroll
            for (int i = 0; i < 16; ++i) As[(r0 + 8 * i) * 34 + kk] = ra[i];
            if (B_KFAST) {
#pragma unroll
                for (int i = 0; i < 16; ++i) Bs[(r0 + 8 * i) * 34 + kk] = rb[i];
            } else {
                const int nn = tid & 127, kq = tid >> 7;
#pragma unroll
                for (int i = 0; i < 16; ++i) Bs[nn * 34 + kq + 2 * i] = rb[i];
            }
            __syncthreads();
#pragma unroll
            for (int k4 = 0; k4 < 32; k4 += 4) {
                float a[4], b[4];
#pragma unroll
                for (int i = 0; i < 4; ++i) a[i] = As[(wm * 64 + i * 16 + (lane & 15)) * 34 + k4 + (lane >> 4)];
#pragma unroll
                for (int j = 0; j < 4; ++j) b[j] = Bs[(wn * 64 + j * 16 + (lane & 15)) * 34 + k4 + (lane >> 4)];
#pragma unroll
                for (int i = 0; i < 4; ++i)
#pragma unroll
                    for (int j = 0; j < 4; ++j) acc[i][j] = __builtin_amdgcn_mfma_f32_16x16x4f32(a[i], b[j], acc[i][j], 0, 0, 0);
            }
        }
#pragma unroll
        for (int i = 0; i < 4; ++i)
#pragma unroll
            for (int j = 0; j < 4; ++j)
#pragma unroll
                for (int g = 0; g < 4; ++g) {
                    const int r = bm + wm * 64 + i * 16 + (lane >> 4) * 4 + g, c = bn + wn * 64 + j * 16 + (lane & 15);
                    if (r < M && c < N) ef(r, c, acc[i][j][g]);
                }
    }
}

template <class KeyF>
DEV void wave_attn(const float* qs, float* sb, const int nkeys, KeyF keyf, const float* __restrict__ rel_bias, const int hkv, const int lane, float (&o)[4]) {
    float mx[4] = {NEGF, NEGF, NEGF, NEGF};
    for (int base = 0; base < nkeys; base += 64) {
        asm volatile("" ::: "memory");
        const int idx = base + lane;
        const float* kp = nullptr; const float* vp = nullptr; int dist = 0;
        bool valid = false;
        if (idx < nkeys) valid = keyf(idx, kp, vp, dist);
        float sc[4] = {0.f, 0.f, 0.f, 0.f};
        if (valid) {
#pragma unroll 1
            for (int d4 = 0; d4 < 16; ++d4) {
                asm volatile("" ::: "memory");
                const float4 kv = ((const float4*)kp)[d4];
#pragma unroll
                for (int g = 0; g < 4; ++g) {
                    const float4 qv = *(const float4*)(qs + g * 64 + d4 * 4);
                    sc[g] += qv.x * kv.x + qv.y * kv.y + qv.z * kv.z + qv.w * kv.w;
                }
            }
            const int bk = rel_bucket(dist);
#pragma unroll
            for (int g = 0; g < 4; ++g) sc[g] += rel_bias[bk * 8 + hkv * 4 + g];
        }
#pragma unroll
        for (int g = 0; g < 4; ++g) {
            const float v = valid ? sc[g] : NEGF;
            if (idx < nkeys) sb[g * 1024 + idx] = v;
            mx[g] = fmaxf(mx[g], v);
        }
    }
    float inv[4];
#pragma unroll
    for (int g = 0; g < 4; ++g) mx[g] = wave_max(mx[g]);
    wave_sync();
    float sum[4] = {0.f, 0.f, 0.f, 0.f};
    for (int idx = lane; idx < nkeys; idx += 64) {
#pragma unroll
        for (int g = 0; g < 4; ++g) {
            const float v = sb[g * 1024 + idx];
            const float e = (v > -1e29f) ? expf(v - mx[g]) : 0.f;
            sb[g * 1024 + idx] = e;
            sum[g] += e;
        }
    }
#pragma unroll
    for (int g = 0; g < 4; ++g) { sum[g] = wave_sum(sum[g]); inv[g] = 1.0f / fmaxf(sum[g], 1e-30f); }
    for (int idx = lane; idx < nkeys; idx += 64) {
#pragma unroll
        for (int g = 0; g < 4; ++g) sb[g * 1024 + idx] *= inv[g];
    }
    wave_sync();
#pragma unroll
    for (int g = 0; g < 4; ++g) o[g] = 0.f;
    for (int idx = 0; idx < nkeys; ++idx) {
        const float p0 = sb[idx], p1 = sb[1024 + idx], p2 = sb[2048 + idx], p3 = sb[3072 + idx];
        if (p0 + p1 + p2 + p3 == 0.f) continue;
        const float* kp = nullptr; const float* vp = nullptr; int dist = 0;
        (void)keyf(idx, kp, vp, dist);
        const float vv = vp[lane];
        o[0] += p0 * vv; o[1] += p1 * vv; o[2] += p2 * vv; o[3] += p3 * vv;
    }
}

DEV void nsa_item(const Params& p, const int row, const int hkv, float* wl, const int lane) {
    float* qs = wl; float* sb = wl + 256; int* sel = (int*)(wl + 256 + 4096);
    const float* Z = (const float*)(p.ws + WS_Z);
    float* NOUT = (float*)(p.ws + WS_NOUT);
    const float* KCP = (const float*)(p.ws + WS_KCP);
    const float* KCS = (const float*)(p.ws + WS_KCS);
    const bool pr = row < NP;
    const int b = pr ? (row >> 11) : (row - NP);
    const int t = pr ? (row & 2047) : 0;
    const int qpos = pr ? t : PAST;
    const float* zrow = Z + (size_t)row * IN_DIM;
    wave_sync();
    for (int i = lane; i < 256; i += 64) qs[i] = zrow[C_Q + hkv * 256 + i] * 0.125f;
    wave_sync();
    float o[4];
    float gate[3][4];
#pragma unroll
    for (int br = 0; br < 3; ++br)
#pragma unroll
        for (int g = 0; g < 4; ++g) gate[br][g] = sigmoidf_(zrow[C_G + br * 8 + hkv * 4 + g]);
    float* nrow = NOUT + (size_t)row * 512 + hkv * 256;
    float res[4];
    const int nkc = pr ? 127 : 1023;
    {
        const float* kbase = pr ? (KCP + ((size_t)(b * 128) * 2 + hkv) * 64) : (KCS + ((size_t)(b * 1024) * 2 + hkv) * 64);
        const size_t plane = pr ? (size_t)4096 * 64 : (size_t)65536 * 64;
        auto keyf = [&](int idx, const float*& kp, const float*& vp, int& dist) -> bool {
            kp = kbase + (size_t)idx * 128; vp = kp + plane; dist = qpos - (16 * idx + 31); return dist >= 0; };
        wave_attn(qs, sb, nkc, keyf, p.rel_bias, hkv, lane, o);
#pragma unroll
        for (int g = 0; g < 4; ++g) res[g] = gate[0][g] * o[g];
    }
    const int nblk = pr ? 32 : 257;
    for (int i = lane; i < nkc; i += 64) sb[i] = ((sb[i] + sb[1024 + i]) + sb[2048 + i]) + sb[3072 + i];
    wave_sync();
    {
        const int cur = qpos >> 6;
        for (int blk = lane; blk < nblk; blk += 64) {
            float s = 0.f;
#pragma unroll
            for (int cc = 0; cc < 4; ++cc) {
                const int c = 4 * blk + cc;
                const float a0 = (c < nkc) ? sb[c] : 0.f;
                const float a1 = (c >= 1 && c - 1 < nkc) ? sb[c - 1] : 0.f;
                s += a0 + a1;
            }
            const bool causal = blk * 64 <= qpos;
            const bool forced = (blk == 0) || (blk == cur) || (blk == cur - 1);
            sb[1024 + blk] = causal ? (forced ? 1e4f : s) : NEGF;
        }
        wave_sync();
        for (int blk = lane; blk < nblk; blk += 64) {
            const float my = sb[1024 + blk];
            int rank = 0;
            for (int j = 0; j < nblk; ++j) { const float o2 = sb[1024 + j]; rank += ((o2 > my) || (o2 == my && j < blk)) ? 1 : 0; }
            if (rank < 16) sel[rank] = (blk * 64 <= qpos) ? blk : -1;
        }
        wave_sync();
    }
    {
        const float* zb = Z + (size_t)(pr ? b * 2048 : 0) * IN_DIM;
        auto keyf = [&](int idx, const float*& kp, const float*& vp, int& dist) -> bool {
            const int blk = sel[idx >> 6], s = idx & 63;
            if (blk < 0) return false;
            const int kpos = blk * 64 + s;
            if (kpos > qpos) return false;
            dist = qpos - kpos;
            if (pr) { kp = zb + (size_t)kpos * IN_DIM + C_KS + hkv * 64; }
            else if (blk < 256) { const int page = p.page_table[b * 128 + (blk >> 1)]; kp = p.cache_slc + ((size_t)page * 128 + (blk & 1) * 64 + s) * 256 + hkv * 64; }
            else { kp = zrow + C_KS + hkv * 64; }
            vp = kp + 128; return true; };
        wave_attn(qs, sb, 1024, keyf, p.rel_bias, hkv, lane, o);
#pragma unroll
        for (int g = 0; g < 4; ++g) res[g] += gate[1][g] * o[g];
    }
    {
        const float* zb = Z + (size_t)(pr ? b * 2048 : 0) * IN_DIM;
        const int nk = pr ? ((t + 1 < 512) ? t + 1 : 512) : 512;
        auto keyf = [&](int idx, const float*& kp, const float*& vp, int& dist) -> bool {
            if (pr) { const int kpos = t - nk + 1 + idx; dist = t - kpos; kp = zb + (size_t)kpos * IN_DIM + C_KW + hkv * 64; }
            else { const int j = idx + 1; dist = 512 - j; kp = (j < 512) ? (p.state_win + ((size_t)b * 512 + j) * 256 + hkv * 64) : (zrow + C_KW + hkv * 64); }
            vp = kp + 128; return true; };
        wave_attn(qs, sb, nk, keyf, p.rel_bias, hkv, lane, o);
#pragma unroll
        for (int g = 0; g < 4; ++g) res[g] += gate[2][g] * o[g];
    }
#pragma unroll
    for (int g = 0; g < 4; ++g) nrow[g * 64 + lane] = res[g];
}

DEV void mlstm_scan_item(const Params& p, const int item, float* lds) {
    const int tid = threadIdx.x, v = tid >> 1, kh = tid & 1;
    const int seq = item >> 2, h = item & 3;
    const bool pr = seq < 16; const int b = pr ? seq : seq - 16;
    const int T = pr ? 2048 : 1; const int row0 = pr ? b * 2048 : NP + b;
    const float* Z = (const float*)(p.ws + WS_Z);
    const float* QK = (const float*)(p.ws + WS_QK);
    float* HRAW = (float*)(p.ws + WS_HRAW);
    float C[64], n[64]; float m;
    if (pr) {
#pragma unroll
        for (int j = 0; j < 64; ++j) { C[j] = 0.f; n[j] = 0.f; }
        m = 0.f;
    } else {
        const float* c0 = p.state_C + (((size_t)(b * 4 + h) * 128 + v) * 128 + kh * 64);
        const float* n0 = p.state_n + ((size_t)(b * 4 + h) * 128 + kh * 64);
#pragma unroll
        for (int j = 0; j < 64; ++j) { C[j] = c0[j]; n[j] = n0[j]; }
        m = p.state_m[b * 4 + h];
    }
    const float gb_i = p.gate_bias[h], gb_f = p.gate_bias[4 + h];
    auto load_tok = [&](int t, float* dst) {
        const size_t r = (size_t)(row0 + t);
        dst[tid] = QK[r * 1024 + h * 256 + tid];
        if (tid < 128) dst[256 + tid] = Z[r * IN_DIM + C_V + h * 128 + tid];
        if (tid == 128) dst[384] = Z[r * IN_DIM + C_I + h] + gb_i;
        if (tid == 129) dst[385] = log_sigmoid(Z[r * IN_DIM + C_F + h] + gb_f);
    };
    __syncthreads();
    load_tok(0, lds);
    __syncthreads();
    for (int t = 0; t < T; ++t) {
        const float* cur = lds + (t & 1) * 388;
        if (t + 1 < T) load_tok(t + 1, lds + ((t + 1) & 1) * 388);
        const float ig = cur[384], lf = cur[385];
        const float mn = fmaxf(lf + m, ig);
        const float fd = expf(lf + m - mn), iw = expf(ig - mn);
        const float vv = cur[256 + v] * iw;
        float nump = 0.f, denp = 0.f;
#pragma unroll
        for (int j = 0; j < 64; ++j) {
            const float kj = cur[128 + kh * 64 + j], qj = cur[kh * 64 + j];
            C[j] = fd * C[j] + vv * kj; n[j] = fd * n[j] + iw * kj;
            nump += C[j] * qj; denp += n[j] * qj;
        }
        nump += __shfl_xor(nump, 1); denp += __shfl_xor(denp, 1);
        const float hval = nump / fmaxf(fabsf(denp), expf(-mn));
        if (kh == 0) HRAW[(size_t)(row0 + t) * 512 + h * 128 + v] = hval;
        m = mn;
        __syncthreads();
    }
    float* co = p.out + (pr ? O_CP : O_CS) + (((size_t)(b * 4 + h) * 128 + v) * 128 + kh * 64);
#pragma unroll
    for (int j = 0; j < 64; ++j) co[j] = C[j];
    if (v == 0) {
        float* no = p.out + (pr ? O_NP : O_NS) + ((size_t)(b * 4 + h) * 128 + kh * 64);
#pragma unroll
        for (int j = 0; j < 64; ++j) no[j] = n[j];
    }
    if (tid == 0) p.out[(pr ? O_MP : O_MS) + b * 4 + h] = m;
}

DEV void peer_topk_item(const Params& p, const int row, const int h, const int lane) {
    const float* S = (const float*)(p.ws + WS_S) + (size_t)row * 2048 + h * 256;
    int* PIDX = (int*)(p.ws + WS_PIDX); float* PG = (float*)(p.ws + WS_PG);
    float ts[2]; int ti[2];
#pragma unroll
    for (int pp = 0; pp < 2; ++pp) {
        float v0 = S[pp * 128 + lane], v1 = S[pp * 128 + 64 + lane];
        float mys = 0.f; int myi = 0;
        for (int r = 0; r < 16; ++r) {
            float best = fmaxf(v0, v1); int bi = (v0 >= v1) ? lane : lane + 64;
#pragma unroll
            for (int off = 32; off >= 1; off >>= 1) {
                const float ob = __shfl_xor(best, off); const int oi = __shfl_xor(bi, off);
                if (ob > best || (ob == best && oi < bi)) { best = ob; bi = oi; }
            }
            if (lane == r) { mys = best; myi = bi; }
            if (bi == lane) v0 = -INFINITY;
            if (bi == lane + 64) v1 = -INFINITY;
        }
        ts[pp] = mys; ti[pp] = myi;
    }
    float cv[4];
#pragma unroll
    for (int jj = 0; jj < 4; ++jj) { const int c = lane * 4 + jj; cv[jj] = __shfl(ts[0], c >> 4) + __shfl(ts[1], c & 15); }
    float msc = 0.f; int mci = 0;
    for (int r = 0; r < 16; ++r) {
        float best = cv[0]; int bi = lane * 4;
#pragma unroll
        for (int jj = 1; jj < 4; ++jj) if (cv[jj] > best) { best = cv[jj]; bi = lane * 4 + jj; }
#pragma unroll
        for (int off = 32; off >= 1; off >>= 1) {
            const float ob = __shfl_xor(best, off); const int oi = __shfl_xor(bi, off);
            if (ob > best || (ob == best && oi < bi)) { best = ob; bi = oi; }
        }
        if (lane == r) { msc = best; mci = bi; }
#pragma unroll
        for (int jj = 0; jj < 4; ++jj) if (bi == lane * 4 + jj) cv[jj] = -INFINITY;
    }
    const int e = __shfl(ti[0], mci >> 4) * 128 + __shfl(ti[1], mci & 15);
    const float top = __shfl(msc, 0);
    float ex = (lane < 16) ? expf(msc - top) : 0.f;
    const float den = wave_sum(ex);
    if (lane < 16) { PIDX[(size_t)row * 128 + h * 16 + lane] = e; PG[(size_t)row * 128 + h * 16 + lane] = ex / den; }
}

DEV void peer_expert_item(const Params& p, const int row, float* lds) {
    const int tid = threadIdx.x, lane = tid & 63, w = tid >> 6;
    const float* X1 = (const float*)(p.ws + WS_X1) + (size_t)row * 1024;
    const int* PIDX = (const int*)(p.ws + WS_PIDX) + (size_t)row * 128;
    const float* PG = (const float*)(p.ws + WS_PG) + (size_t)row * 128;
    float4 x[4], acc[4];
#pragma unroll
    for (int j = 0; j < 4; ++j) { x[j] = *(const float4*)(X1 + j * 256 + lane * 4); acc[j] = make_float4(0.f, 0.f, 0.f, 0.f); }
    for (int k = 0; k < 32; ++k) {
        const int e = PIDX[w * 32 + k]; const float gk = PG[w * 32 + k];
        const float* ur = p.peer_u + (size_t)e * 1024; const float* vr = p.peer_v + (size_t)e * 1024;
        float d = 0.f;
#pragma unroll
        for (int j = 0; j < 4; ++j) { const float4 u = *(const float4*)(ur + j * 256 + lane * 4); d += u.x * x[j].x + u.y * x[j].y + u.z * x[j].z + u.w * x[j].w; }
        d = wave_sum(d);
        const float coef = gk * gelu_tanh(d);
#pragma unroll
        for (int j = 0; j < 4; ++j) { const float4 vv = *(const float4*)(vr + j * 256 + lane * 4);
            acc[j].x += coef * vv.x; acc[j].y += coef * vv.y; acc[j].z += coef * vv.z; acc[j].w += coef * vv.w; }
    }
    __syncthreads();
#pragma unroll
    for (int j = 0; j < 4; ++j) *(float4*)(lds + w * 1024 + j * 256 + lane * 4) = acc[j];
    __syncthreads();
    float tv[4]; float s = 0.f;
#pragma unroll
    for (int i = 0; i < 4; ++i) { const int c = tid * 4 + i; const float po = (lds[c] + lds[1024 + c]) + (lds[2048 + c] + lds[3072 + c]); tv[i] = DN_ALPHA * X1[c] + po; s += tv[i]; }
    float* red = lds + 4096;
    s = wave_sum(s);
    if (lane == 0) red[w] = s;
    __syncthreads();
    const float mu = (red[0] + red[1] + red[2] + red[3]) * (1.0f / 1024.0f);
    float q = 0.f;
#pragma unroll
    for (int i = 0; i < 4; ++i) { const float d = tv[i] - mu; q += d * d; }
    q = wave_sum(q);
    if (lane == 0) red[8 + w] = q;
    __syncthreads();
    const float var = (red[8] + red[9] + red[10] + red[11]) * (1.0f / 1024.0f);
    const float rstd = 1.0f / sqrtf(var + LN_EPS);
    float* y = p.out + O_Y + (size_t)row * 1024;
#pragma unroll
    for (int i = 0; i < 4; ++i) { const int c = tid * 4 + i; y[c] = (tv[i] - mu) * rstd * p.ln2_g[c] + p.ln2_b[c]; }
}

__global__ void __launch_bounds__(NTHREADS, 2) fwd_kernel(Params p) {
    extern __shared__ __attribute__((aligned(16))) unsigned char smem[];
    if (threadIdx.x == 0) { *(uint4*)smem = make_uint4(0u, 0u, 0u, 0u); }
    __syncthreads();
    XcdBarrier bar = xcd_barrier_post((unsigned*)(p.ws + WS_BAR), (volatile LAS unsigned*)smem);
    float* lds = (float*)(smem + 16);
    const int tid = threadIdx.x, lane = tid & 63, w = tid >> 6;
    const int gw = blockIdx.x * 4 + w, nw = gridDim.x * 4;
    const size_t gt = (size_t)blockIdx.x * NTHREADS + tid, nt = (size_t)gridDim.x * NTHREADS;

    float* Z = (float*)(p.ws + WS_Z);
    float* QK = (float*)(p.ws + WS_QK);
    float* HRAW = (float*)(p.ws + WS_HRAW);
    float* MOUT = (float*)(p.ws + WS_MOUT);
    float* NOUT = (float*)(p.ws + WS_NOUT);
    float* HIDP = (float*)(p.ws + WS_HIDP);
    float* KCP = (float*)(p.ws + WS_KCP);
    float* HIDS = (float*)(p.ws + WS_HIDS);
    float* KCS = (float*)(p.ws + WS_KCS);
    float* MIX = (float*)(p.ws + WS_MIX);
    float* T1 = (float*)(p.ws + WS_T1);
    float* X1 = (float*)(p.ws + WS_X1);
    float* QP = (float*)(p.ws + WS_QP);
    float* S = (float*)(p.ws + WS_S);
    float* CONV = (float*)(p.ws + WS_CONV);

    gemm_f32<false>(NR, IN_DIM, 1024,
        [&](int r, int k) { return r < NP ? p.x_prompt[(size_t)r * 1024 + k] : p.x_sample[(size_t)(r - NP) * 1024 + k]; },
        [&](int n, int k) { return p.w_in[(size_t)k * IN_DIM + n]; },
        [&](int r, int c, float v) { Z[(size_t)r * IN_DIM + c] = v; }, lds);
    xcd_barrier(bar);

    {
        for (size_t i = gt; i < (size_t)NP * 256; i += nt) {
            const size_t r = i >> 8; const int j = (int)(i & 255);
            p.out[O_CMPP + i] = Z[r * IN_DIM + C_KC + j];
            p.out[O_SLCP + i] = Z[r * IN_DIM + C_KS + j];
        }
        for (size_t i = gt; i < (size_t)BS * 256; i += nt) {
            const size_t r = NP + (i >> 8); const int j = (int)(i & 255);
            p.out[O_CMPS + i] = Z[r * IN_DIM + C_KC + j];
            p.out[O_SLCS + i] = Z[r * IN_DIM + C_KS + j];
        }
        for (size_t i = gt; i < (size_t)BP * 512 * 256; i += nt) {
            const int j = (int)(i & 255); const int wv = (int)((i >> 8) & 511); const int b = (int)(i >> 17);
            p.out[O_WINP + i] = Z[((size_t)b * 2048 + 1536 + wv) * IN_DIM + C_KW + j];
        }
        for (size_t i = gt; i < (size_t)BS * 512 * 256; i += nt) {
            const int j = (int)(i & 255); const int wv = (int)((i >> 8) & 511); const int b = (int)(i >> 17);
            p.out[O_WINS + i] = (wv < 511) ? p.state_win[((size_t)b * 512 + wv + 1) * 256 + j] : Z[(size_t)(NP + b) * IN_DIM + C_KW + j];
        }
        for (size_t i = gt; i < (size_t)BP * 3 * 512; i += nt) {
            const int ch = (int)(i % 512); const int jj = (int)((i / 512) % 3); const int b = (int)(i / 1536);
            p.out[O_CVP + i] = Z[((size_t)b * 2048 + 2045 + jj) * IN_DIM + C_U + ch];
        }
        for (size_t i = gt; i < (size_t)BS * 3 * 512; i += nt) {
            const int ch = (int)(i % 512); const int jj = (int)((i / 512) % 3); const int b = (int)(i / 1536);
            p.out[O_CVS + i] = (jj < 2) ? p.state_conv[((size_t)b * 3 + jj + 1) * 512 + ch] : Z[(size_t)(NP + b) * IN_DIM + C_U + ch];
        }
        for (size_t i = gt; i < (size_t)NR * 512; i += nt) {
            const int ch = (int)(i & 511); const int r = (int)(i >> 9);
            float a = p.conv_b[ch];
            if (r < NP) {
                const int t = r & 2047;
#pragma unroll
                for (int j = 0; j < 4; ++j) if (t + j - 3 >= 0) a += p.conv_w[j * 512 + ch] * Z[(size_t)(r + j - 3) * IN_DIM + C_U + ch];
            } else {
                const int b = r - NP;
#pragma unroll
                for (int j = 0; j < 3; ++j) a += p.conv_w[j * 512 + ch] * p.state_conv[((size_t)b * 3 + j) * 512 + ch];
                a += p.conv_w[3 * 512 + ch] * Z[(size_t)r * IN_DIM + C_U + ch];
            }
            CONV[i] = a / (1.0f + expf(-a));
        }
    }
    xcd_barrier(bar);

    {
        for (int h = 0; h < 4; ++h) {
            gemm_f32<false>(NR, 256, 128,
                [&](int r, int k) { return CONV[(size_t)r * 512 + h * 128 + k]; },
                [&](int n, int k) { return n < 128 ? p.wq[((size_t)h * 128 + k) * 128 + n] : p.wk[((size_t)h * 128 + k) * 128 + n - 128]; },
                [&](int r, int c, float v) { QK[(size_t)r * 1024 + h * 256 + c] = (c < 128) ? v : v * 0.08838834764831845f; }, lds);
        }
        for (int c = 0; c < 2; ++c) {
            gemm_f32<false>(4096, 64, 2048,
                [&](int row, int k) {
                    const int hh = row & 1, bi = row >> 1, i = bi & 127, b = bi >> 7, j = k >> 6, d = k & 63, tok = 16 * i + j;
                    float val = p.cmp_pe[(c * 32 + j) * 64 + d];
                    if (tok < 2048) val += Z[((size_t)b * 2048 + tok) * IN_DIM + C_KC + c * 128 + hh * 64 + d];
                    return val; },
                [&](int n, int k) { return p.cmp_w1[((size_t)c * 2048 + k) * 64 + n]; },
                [&](int row, int o, float v) { HIDP[((size_t)c * 4096 + row) * 64 + o] = gelu_tanh(v); }, lds);
            gemm_f32<false>(65536, 64, 2048,
                [&](int row, int k) {
                    const int hh = row & 1, bi = row >> 1, i = bi & 1023, b = bi >> 10, j = k >> 6, d = k & 63, tok = 16 * i + j;
                    float val = p.cmp_pe[(c * 32 + j) * 64 + d];
                    if (tok < PAST) { const int page = p.page_table[b * 128 + (tok >> 7)]; val += p.cache_cmp[((size_t)page * 128 + (tok & 127)) * 256 + c * 128 + hh * 64 + d]; }
                    return val; },
                [&](int n, int k) { return p.cmp_w1[((size_t)c * 2048 + k) * 64 + n]; },
                [&](int row, int o, float v) { HIDS[((size_t)c * 65536 + row) * 64 + o] = gelu_tanh(v); }, lds);
        }
    }
    xcd_barrier(bar);

    for (int item = blockIdx.x; item < 192; item += gridDim.x) mlstm_scan_item(p, item, lds);
    for (int c = 0; c < 2; ++c) {
        gemm_f32<false>(4096, 64, 64,
            [&](int row, int k) { return HIDP[((size_t)c * 4096 + row) * 64 + k]; },
            [&](int n, int k) { return p.cmp_w2[((size_t)c * 64 + k) * 64 + n]; },
            [&](int row, int o, float v) { KCP[((size_t)c * 4096 + row) * 64 + o] = v; }, lds);
        gemm_f32<false>(65536, 64, 64,
            [&](int row, int k) { return HIDS[((size_t)c * 65536 + row) * 64 + k]; },
            [&](int n, int k) { return p.cmp_w2[((size_t)c * 64 + k) * 64 + n]; },
            [&](int row, int o, float v) { KCS[((size_t)c * 65536 + row) * 64 + o] = v; }, lds);
    }
    xcd_barrier(bar);

    for (int it = gw; it < NR * 4; it += nw) {
        const int row = it >> 2, h = it & 3;
        const float x0 = HRAW[(size_t)row * 512 + h * 128 + lane], x1 = HRAW[(size_t)row * 512 + h * 128 + 64 + lane];
        const float mu = wave_sum(x0 + x1) * (1.0f / 128.0f);
        const float d0 = x0 - mu, d1 = x1 - mu;
        const float var = wave_sum(d0 * d0 + d1 * d1) * (1.0f / 128.0f);
        const float rstd = 1.0f / sqrtf(var + LN_EPS);
        const int c0 = h * 128 + lane, c1 = c0 + 64;
        MOUT[(size_t)row * 512 + c0] = sigmoidf_(Z[(size_t)row * IN_DIM + C_O + c0]) * (d0 * rstd * p.norm_g[c0]);
        MOUT[(size_t)row * 512 + c1] = sigmoidf_(Z[(size_t)row * IN_DIM + C_O + c1]) * (d1 * rstd * p.norm_g[c1]);
    }
    {
        float* wl = lds + w * 4416;
        for (int it = gw; it < NR * 2; it += nw) nsa_item(p, it >> 1, it & 1, wl, lane);
    }
    xcd_barrier(bar);

    gemm_f32<false>(NR, 1024, 512,
        [&](int r, int k) { return MOUT[(size_t)r * 512 + k]; },
        [&](int n, int k) { return p.w_up_m[(size_t)k * 1024 + n]; },
        [&](int r, int c, float v) { MIX[(size_t)r * 1024 + c] = sigmoidf_(Z[(size_t)r * IN_DIM + C_GM + c]) * v; }, lds);
    gemm_f32<false>(NR, 1024, 512,
        [&](int r, int k) { return NOUT[(size_t)r * 512 + k]; },
        [&](int n, int k) { return p.w_up_n[(size_t)k * 1024 + n]; },
        [&](int r, int c, float v) { MIX[(size_t)r * 1024 + c] += sigmoidf_(Z[(size_t)r * IN_DIM + C_GN + c]) * v; }, lds);
    xcd_barrier(bar);

    gemm_f32<false>(NR, 1024, 1024,
        [&](int r, int k) { return MIX[(size_t)r * 1024 + k]; },
        [&](int n, int k) { return p.w_out[(size_t)k * 1024 + n]; },
        [&](int r, int c, float v) { const float xv = r < NP ? p.x_prompt[(size_t)r * 1024 + c] : p.x_sample[(size_t)(r - NP) * 1024 + c]; T1[(size_t)r * 1024 + c] = DN_ALPHA * xv + v; }, lds);
    xcd_barrier(bar);

    for (int row = gw; row < NR; row += nw) {
        float tv[16]; float s = 0.f;
#pragma unroll
        for (int j = 0; j < 16; ++j) { tv[j] = T1[(size_t)row * 1024 + j * 64 + lane]; s += tv[j]; }
        const float mu = wave_sum(s) * (1.0f / 1024.0f);
        float q = 0.f;
#pragma unroll
        for (int j = 0; j < 16; ++j) { const float d = tv[j] - mu; q += d * d; }
        const float rstd = 1.0f / sqrtf(wave_sum(q) * (1.0f / 1024.0f) + LN_EPS);
#pragma unroll
        for (int j = 0; j < 16; ++j) { const int c = j * 64 + lane; X1[(size_t)row * 1024 + c] = (tv[j] - mu) * rstd * p.ln1_g[c] + p.ln1_b[c]; }
    }
    xcd_barrier(bar);

    gemm_f32<false>(NR, 2048, 1024,
        [&](int r, int k) { return X1[(size_t)r * 1024 + k]; },
        [&](int n, int k) { return p.peer_wq[(size_t)k * 2048 + n]; },
        [&](int r, int c, float v) { QP[(size_t)r * 2048 + c] = v; }, lds);
    xcd_barrier(bar);

    for (int hp = 0; hp < 16; ++hp) {
        const int pp = hp & 1;
        gemm_f32<true>(NR, 128, 128,
            [&](int r, int k) { return QP[(size_t)r * 2048 + hp * 128 + k]; },
            [&](int n, int k) { return p.peer_sub[((size_t)pp * 128 + n) * 128 + k]; },
            [&](int r, int c, float v) { S[(size_t)r * 2048 + hp * 128 + c] = v; }, lds);
    }
    xcd_barrier(bar);

    for (int it = gw; it < NR * 8; it += nw) peer_topk_item(p, it >> 3, it & 7, lane);
    xcd_barrier(bar);

    for (int row = blockIdx.x; row < NR; row += gridDim.x) peer_expert_item(p, row, lds);
}

extern "C" void kernel_launch(void* const* d_in, const int* in_sizes, int n_in, void* d_out, int out_size, void* d_ws, size_t ws_size, hipStream_t stream) {
    static int grid = 0;
    if (grid == 0) {
        if (n_in != 32 || (size_t)out_size != O_END || ws_size < WS_END) {
            fprintf(stderr, "kernel_launch: unexpected sizes n_in %d out %d ws %zu (need %zu)\n", n_in, out_size, ws_size, (size_t)WS_END); grid = -1; return; }
        int dev = 0, cus = 0, per_cu = 0;
        if (hipGetDevice(&dev) != hipSuccess || hipDeviceGetAttribute(&cus, hipDeviceAttributeMultiprocessorCount, dev) != hipSuccess) { grid = -1; return; }
        if (hipFuncSetAttribute((const void*)fwd_kernel, hipFuncAttributeMaxDynamicSharedMemorySize, LDS_BYTES) != hipSuccess) { fprintf(stderr, "hipFuncSetAttribute failed\n"); grid = -1; return; }
        if (hipOccupancyMaxActiveBlocksPerMultiprocessor(&per_cu, (const void*)fwd_kernel, NTHREADS, LDS_BYTES) != hipSuccess || per_cu < 1) { fprintf(stderr, "occupancy query failed (%d)\n", per_cu); (void)hipGetLastError(); per_cu = 1; }
        if (per_cu > 2) per_cu = 2;
        grid = cus * per_cu;
    }
    if (grid < 0) return;
    (void)hipMemsetAsync((char*)d_ws + WS_BAR, 0, XCD_BAR_WORDS * sizeof(unsigned), stream);
    Params p{};
    p.x_prompt = (const float*)d_in[0]; p.x_sample = (const float*)d_in[1]; p.cache_cmp = (const float*)d_in[2]; p.cache_slc = (const float*)d_in[3];
    p.page_table = (const int*)d_in[4]; p.state_win = (const float*)d_in[5]; p.state_C = (const float*)d_in[6]; p.state_n = (const float*)d_in[7];
    p.state_m = (const float*)d_in[8]; p.state_conv = (const float*)d_in[9]; p.w_in = (const float*)d_in[10]; p.conv_w = (const float*)d_in[11];
    p.conv_b = (const float*)d_in[12]; p.wq = (const float*)d_in[13]; p.wk = (const float*)d_in[14]; p.gate_bias = (const float*)d_in[15];
    p.norm_g = (const float*)d_in[16]; p.cmp_pe = (const float*)d_in[17]; p.cmp_w1 = (const float*)d_in[18]; p.cmp_w2 = (const float*)d_in[19];
    p.rel_bias = (const float*)d_in[20]; p.w_up_m = (const float*)d_in[21]; p.w_up_n = (const float*)d_in[22]; p.w_out = (const float*)d_in[23];
    p.ln1_g = (const float*)d_in[24]; p.ln1_b = (const float*)d_in[25]; p.ln2_g = (const float*)d_in[26]; p.ln2_b = (const float*)d_in[27];
    p.peer_wq = (const float*)d_in[28]; p.peer_sub = (const float*)d_in[29]; p.peer_u = (const float*)d_in[30]; p.peer_v = (const float*)d_in[31];
    p.out = (float*)d_out; p.ws = (unsigned char*)d_ws;
    hipLaunchKernelGGL(fwd_kernel, dim3(grid), dim3(NTHREADS), LDS_BYTES, stream, p);
}
```

```cpp
#include <hip/hip_runtime.h>
#include <stdint.h>
#include <cstdio>

#define DEV __device__ __forceinline__

constexpr int DM = 1024;
constexpr int BP = 16, TP = 2048, BS = 32;
constexpr int NP = BP * TP;
constexpr int NR = NP + BS;
constexpr int MP = 32896;
constexpr int IN_DIM = 4896;
constexpr int C_U = 0, C_V = 512, C_O = 1024, C_I = 1536, C_F = 1540, C_Q = 1544, C_KC = 2056, C_KS = 2312, C_KW = 2568, C_G = 2824, C_GM = 2848, C_GN = 3872;
constexpr int PAST = 16384;
constexpr float NEGF = -1e30f;
constexpr float DN_ALPHA = 1.189207115002721f;
constexpr float LN_EPS = 1e-5f;

constexpr size_t O_Y = 0;
constexpr size_t O_CMPP = (size_t)NR * DM;
constexpr size_t O_CMPS = O_CMPP + (size_t)NP * 256;
constexpr size_t O_SLCP = O_CMPS + (size_t)BS * 256;
constexpr size_t O_SLCS = O_SLCP + (size_t)NP * 256;
constexpr size_t O_WINP = O_SLCS + (size_t)BS * 256;
constexpr size_t O_WINS = O_WINP + (size_t)BP * 512 * 256;
constexpr size_t O_CP = O_WINS + (size_t)BS * 512 * 256;
constexpr size_t O_CS = O_CP + (size_t)BP * 4 * 128 * 128;
constexpr size_t O_NP = O_CS + (size_t)BS * 4 * 128 * 128;
constexpr size_t O_NS = O_NP + (size_t)BP * 4 * 128;
constexpr size_t O_MP = O_NS + (size_t)BS * 4 * 128;
constexpr size_t O_MS = O_MP + (size_t)BP * 4;
constexpr size_t O_CVP = O_MS + (size_t)BS * 4;
constexpr size_t O_CVS = O_CVP + (size_t)BP * 3 * 512;
constexpr size_t O_END = O_CVS + (size_t)BS * 3 * 512;
static_assert(O_END == 59916480, "output size");

constexpr size_t al256(size_t x) { return (x + 255) & ~(size_t)255; }
constexpr size_t WS_BAR = 0;
constexpr size_t WS_Z = 16384;
constexpr size_t WS_QK = al256(WS_Z + (size_t)MP * IN_DIM * 4);
constexpr size_t WS_HRAW = al256(WS_QK + (size_t)MP * 1024 * 4);
constexpr size_t WS_MOUTB = al256(WS_HRAW + (size_t)MP * 512 * 4);
constexpr size_t WS_NOUTB = al256(WS_MOUTB + (size_t)MP * 512 * 2);
constexpr size_t WS_HIDPB = al256(WS_NOUTB + (size_t)MP * 512 * 2);
constexpr size_t WS_KCP = al256(WS_HIDPB + (size_t)2 * 4096 * 64 * 2);
constexpr size_t WS_HIDSB = al256(WS_KCP + (size_t)2 * 4096 * 64 * 4);
constexpr size_t WS_KCS = al256(WS_HIDSB + (size_t)2 * 65536 * 64 * 2);
constexpr size_t WS_MIX = al256(WS_KCS + (size_t)2 * 65536 * 64 * 4);
constexpr size_t WS_MIXB = al256(WS_MIX + (size_t)MP * 1024 * 4);
constexpr size_t WS_T1 = al256(WS_MIXB + (size_t)MP * 1024 * 2);
constexpr size_t WS_X1 = al256(WS_T1 + (size_t)MP * 1024 * 4);
constexpr size_t WS_X1B = al256(WS_X1 + (size_t)MP * 1024 * 4);
constexpr size_t WS_QPB = al256(WS_X1B + (size_t)MP * 1024 * 2);
constexpr size_t WS_S = al256(WS_QPB + (size_t)MP * 2048 * 2);
constexpr size_t WS_PIDX = al256(WS_S + (size_t)MP * 2048 * 4);
constexpr size_t WS_PG = al256(WS_PIDX + (size_t)MP * 128 * 4);
constexpr size_t WS_CONVB = al256(WS_PG + (size_t)MP * 128 * 4);
constexpr size_t WS_XB = al256(WS_CONVB + (size_t)MP * 512 * 2);
constexpr size_t WS_WIN_T = al256(WS_XB + (size_t)MP * 1024 * 2);
constexpr size_t WS_WUPM_T = al256(WS_WIN_T + (size_t)IN_DIM * 1024 * 2);
constexpr size_t WS_WUPN_T = al256(WS_WUPM_T + (size_t)1024 * 512 * 2);
constexpr size_t WS_WOUT_T = al256(WS_WUPN_T + (size_t)1024 * 512 * 2);
constexpr size_t WS_PWQ_T = al256(WS_WOUT_T + (size_t)1024 * 1024 * 2);
constexpr size_t WS_WQK_T = al256(WS_PWQ_T + (size_t)2048 * 1024 * 2);
constexpr size_t WS_W1_T = al256(WS_WQK_T + (size_t)4 * 256 * 128 * 2);
constexpr size_t WS_W2_T = al256(WS_W1_T + (size_t)2 * 64 * 2048 * 2);
constexpr size_t WS_SUBK = al256(WS_W2_T + (size_t)2 * 64 * 64 * 2);
constexpr size_t WS_END = al256(WS_SUBK + (size_t)2 * 128 * 128 * 2);

constexpr int LDS_BYTES = 73728;
constexpr int NTHREADS = 256;

struct Params {
    const float* x_prompt; const float* x_sample; const float* cache_cmp; const float* cache_slc; const int* page_table;
    const float* state_win; const float* state_C; const float* state_n; const float* state_m; const float* state_conv;
    const float* w_in; const float* conv_w; const float* conv_b; const float* wq; const float* wk; const float* gate_bias; const float* norm_g;
    const float* cmp_pe; const float* cmp_w1; const float* cmp_w2; const float* rel_bias; const float* w_up_m; const float* w_up_n; const float* w_out;
    const float* ln1_g; const float* ln1_b; const float* ln2_g; const float* ln2_b; const float* peer_wq; const float* peer_sub; const float* peer_u; const float* peer_v;
    float* out; unsigned char* ws;
};

#define XB_TMO      128
#define XB_XCNT(j)  (256  + 64 * (j))
#define XB_XSUB(j)  (1280 + 64 * (j))
#define XB_XGEN(j)  (2304 + 64 * (j))
#define XB_TOP      3328
#define XB_TOPGEN   3392
#define XCD_BAR_WORDS 3456
#define XB_SPIN_CAP (1u << 22)
#define LAS __attribute__((address_space(3)))

__device__ __forceinline__ unsigned xb_ld(unsigned* p)              { return __hip_atomic_load(p, __ATOMIC_RELAXED, __HIP_MEMORY_SCOPE_AGENT); }
__device__ __forceinline__ unsigned xb_add(unsigned* p, unsigned v) { return __hip_atomic_fetch_add(p, v, __ATOMIC_RELAXED, __HIP_MEMORY_SCOPE_AGENT); }
__device__ __forceinline__ unsigned xb_xcc_id() { return (unsigned)__builtin_amdgcn_s_getreg((3 << 11) | 20) & 0xFu; }
#define XB_SPIN(cond, bar) do { unsigned _sp = 0; while (cond) { __builtin_amdgcn_s_sleep(1); \
    if ((++_sp & 255u) == 0u) { if (xb_ld(&(bar)[XB_TMO])) break; if (_sp > XB_SPIN_CAP) { atomicAdd(&(bar)[XB_TMO], 1u); break; } } } } while (0)

struct XcdBarrier { unsigned* bar; unsigned x; volatile LAS unsigned* st; };

__device__ __forceinline__ XcdBarrier xcd_barrier_post(unsigned* bar, volatile LAS unsigned* st) {
    XcdBarrier b; b.bar = bar; b.x = xb_xcc_id(); b.st = st;
    if (threadIdx.x == 0) (void)xb_add(&bar[XB_XCNT(b.x)], 1u);
    return b;
}
__device__ __forceinline__ void xcd_barrier_complete(unsigned* bar, unsigned x, unsigned& nloc, unsigned& nx) {
    const unsigned G = gridDim.x * gridDim.y * gridDim.z;
    unsigned sum, cnt, mine, sp = 0u;
    for (;;) {
        sum = 0u; cnt = 0u; mine = 0u;
#pragma unroll
        for (unsigned j = 0; j < 16; ++j) { const unsigned c = xb_ld(&bar[XB_XCNT(j)]); sum += c; cnt += (c > 0u) ? 1u : 0u; mine = (j == x) ? c : mine; }
        if (sum == G) break;
        __builtin_amdgcn_s_sleep(1);
        if ((++sp & 255u) == 0u) { if (xb_ld(&bar[XB_TMO])) break; if (sp > XB_SPIN_CAP) { atomicAdd(&bar[XB_TMO], 1u); break; } }
    }
    nloc = mine > 0u ? mine : 1u; nx = cnt > 0u ? cnt : 1u;
}
__device__ __forceinline__ void xcd_barrier(const XcdBarrier& b) {
    asm volatile("s_waitcnt vmcnt(0)" ::: "memory");
    __syncthreads();
    if (threadIdx.x == 0) {
        unsigned* bar = b.bar;
        __builtin_amdgcn_s_waitcnt(0);
        unsigned nloc = b.st[0], nx = b.st[1];
        if (nloc == 0u) { xcd_barrier_complete(bar, b.x, nloc, nx); b.st[0] = nloc; b.st[1] = nx; }
        const unsigned old = xb_add(&bar[XB_XSUB(b.x)], 1u);
        const unsigned gen = old / nloc;
        if (old + 1u == (gen + 1u) * nloc) {
            __builtin_amdgcn_fence(__ATOMIC_RELEASE, "agent");
            asm volatile("s_waitcnt vmcnt(0)" ::: "memory");
            const unsigned og = xb_add(&bar[XB_TOP], 1u);
            const unsigned tg = og / nx;
            if (og + 1u == (tg + 1u) * nx) xb_add(&bar[XB_TOPGEN], 1u);
            else XB_SPIN(xb_ld(&bar[XB_TOPGEN]) == tg, bar);
            __builtin_amdgcn_fence(__ATOMIC_ACQUIRE, "agent");
            xb_add(&bar[XB_XGEN(b.x)], 1u);
            asm volatile("s_waitcnt vmcnt(0)" ::: "memory");
        } else {
            XB_SPIN(xb_ld(&bar[XB_XGEN(b.x)]) == gen, bar);
            __builtin_amdgcn_fence(__ATOMIC_ACQUIRE, "agent");
            asm volatile("s_waitcnt vmcnt(0)" ::: "memory");
        }
    }
    __syncthreads();
}

typedef float f32x4 __attribute__((ext_vector_type(4)));

__device__ const unsigned char REL_LUT[128] = {
    0, 1, 2, 3, 4, 5, 6, 7, 8, 9, 10, 11, 12, 13, 14, 15, 16, 16, 16, 17, 17, 18, 18, 18, 19, 19, 19, 20, 20, 20, 20, 21, 21, 21, 21, 22, 22, 22, 22, 22,
    23, 23, 23, 23, 23, 23, 24, 24, 24, 24, 24, 24, 25, 25, 25, 25, 25, 25, 25, 26, 26, 26, 26, 26, 26, 26, 26, 27, 27, 27, 27, 27, 27, 27, 27, 27, 27,
    28, 28, 28, 28, 28, 28, 28, 28, 28, 28, 29, 29, 29, 29, 29, 29, 29, 29, 29, 29, 29, 29, 30, 30, 30, 30, 30, 30, 30, 30, 30, 30, 30, 30, 30, 30,
    31, 31, 31, 31, 31, 31, 31, 31, 31, 31, 31, 31, 31, 31, 31};
DEV int rel_bucket(int n) { return n < 128 ? (int)REL_LUT[n < 0 ? 0 : n] : 31; }

DEV float sigmoidf_(float x) { return 1.0f / (1.0f + expf(-x)); }
DEV float gelu_tanh(float x) { return 0.5f * x * (1.0f + tanhf(0.7978845608028654f * (x + 0.044715f * x * x * x))); }
DEV float log_sigmoid(float x) { return x >= 0.f ? -log1pf(expf(-x)) : x - log1pf(expf(x)); }
DEV void wave_sync() { asm volatile("s_waitcnt lgkmcnt(0)" ::: "memory"); __builtin_amdgcn_wave_barrier(); asm volatile("" ::: "memory"); }
DEV float wave_sum(float v) {
#pragma unroll
    for (int o = 32; o >= 1; o >>= 1) v += __shfl_xor(v, o);
    return v;
}
DEV float wave_max(float v) {
#pragma unroll
    for (int o = 32; o >= 1; o >>= 1) v = fmaxf(v, __shfl_xor(v, o));
    return v;
}

typedef unsigned short bf16_t;
typedef short bf16x8 __attribute__((ext_vector_type(8)));
DEV unsigned cvt_pk_bf16(float lo, float hi) { unsigned r; asm volatile("v_cvt_pk_bf16_f32 %0, %1, %2" : "=v"(r) : "v"(lo), "v"(hi)); return r; }
DEV float bf_lo(unsigned w) { return __uint_as_float(w << 16); }
DEV float bf_hi(unsigned w) { return __uint_as_float(w & 0xffff0000u); }
DEV uint4 pack8(const float* f) { uint4 r; r.x = cvt_pk_bf16(f[0], f[1]); r.y = cvt_pk_bf16(f[2], f[3]); r.z = cvt_pk_bf16(f[4], f[5]); r.w = cvt_pk_bf16(f[6], f[7]); return r; }
DEV void store_bf16x4(bf16_t* p, f32x4 v) { uint2 w; w.x = cvt_pk_bf16(v[0], v[1]); w.y = cvt_pk_bf16(v[2], v[3]); *(uint2*)p = w; }

DEV void transpose_to_bf16(const float* __restrict__ src, const int K, const int N, bf16_t* __restrict__ dst, const size_t gt, const size_t nt) {
    const size_t items = (size_t)N * (K >> 3);
    for (size_t id = gt; id < items; id += nt) {
        const int n = (int)(id % N), k8 = (int)(id / N) * 8;
        float f[8];
#pragma unroll
        for (int i = 0; i < 8; ++i) f[i] = src[(size_t)(k8 + i) * N + n];
        *(uint4*)(dst + (size_t)n * K + k8) = pack8(f);
    }
}

template <int BN, class LA, class LB, class EF>
DEV void gemm_bf16(const int M, const int N, const int K, LA la, LB lb, EF ef, unsigned char* lds) {
    constexpr int TJ = BN / 32;
    constexpr int NB = BN / 32;
    constexpr int LDR = 144;
    const int tid = threadIdx.x, lane = tid & 63, w = tid >> 6, wm = w >> 1, wn = w & 1;
    const int tm = (M + 127) >> 7, tn = (N + BN - 1) / BN;
    unsigned char* As = lds;
    unsigned char* Bs = lds + 128 * LDR;
    const int lr = lane & 15, lq = lane >> 4;
    for (int tile = blockIdx.x; tile < tm * tn; tile += gridDim.x) {
        const int bm = (tile / tn) * 128, bn = (tile % tn) * BN;
        f32x4 acc[4][TJ];
#pragma unroll
        for (int i = 0; i < 4; ++i)
#pragma unroll
            for (int j = 0; j < TJ; ++j) acc[i][j] = (f32x4){0.f, 0.f, 0.f, 0.f};
        uint4 ra[4], rb[NB];
        int arow[4], brow[NB];
#pragma unroll
        for (int i = 0; i < 4; ++i) { const int r = bm + ((tid + 256 * i) >> 3); arow[i] = r < M ? r : M - 1; }
#pragma unroll
        for (int i = 0; i < NB; ++i) { const int n = bn + ((tid + 256 * i) >> 3); brow[i] = n < N ? n : N - 1; }
        const int kc = (tid & 7) * 8;
#pragma unroll
        for (int i = 0; i < 4; ++i) ra[i] = la(arow[i], kc);
#pragma unroll
        for (int i = 0; i < NB; ++i) rb[i] = lb(brow[i], kc);
        for (int k0_ = 0; k0_ < K; k0_ += 64) {
            int k0 = k0_; asm volatile("" : "+v"(k0));
            __syncthreads();
#pragma unroll
            for (int i = 0; i < 4; ++i) *(uint4*)(As + ((tid + 256 * i) >> 3) * LDR + (tid & 7) * 16) = ra[i];
#pragma unroll
            for (int i = 0; i < NB; ++i) *(uint4*)(Bs + ((tid + 256 * i) >> 3) * LDR + (tid & 7) * 16) = rb[i];
            __syncthreads();
            if (k0_ + 64 < K) {
#pragma unroll
                for (int i = 0; i < 4; ++i) ra[i] = la(arow[i], k0 + 64 + kc);
#pragma unroll
                for (int i = 0; i < NB; ++i) rb[i] = lb(brow[i], k0 + 64 + kc);
            }
#pragma unroll
            for (int kk = 0; kk < 2; ++kk) {
                bf16x8 a[4], b[TJ];
#pragma unroll
                for (int i = 0; i < 4; ++i) a[i] = *(const bf16x8*)(As + (wm * 64 + i * 16 + lr) * LDR + kk * 64 + lq * 16);
#pragma unroll
                for (int j = 0; j < TJ; ++j) b[j] = *(const bf16x8*)(Bs + (wn * (BN / 2) + j * 16 + lr) * LDR + kk * 64 + lq * 16);
#pragma unroll
                for (int i = 0; i < 4; ++i)
#pragma unroll
                    for (int j = 0; j < TJ; ++j) acc[i][j] = __builtin_amdgcn_mfma_f32_16x16x32_bf16(b[j], a[i], acc[i][j], 0, 0, 0);
            }
        }
#pragma unroll
        for (int i = 0; i < 4; ++i)
#pragma unroll
            for (int j = 0; j < TJ; ++j) {
                const int r = bm + wm * 64 + i * 16 + lr, c0 = bn + wn * (BN / 2) + j * 16 + lq * 4;
                if (r < M && c0 < N) ef(r, c0, acc[i][j]);
            }
    }
}

template <class KeyF>
DEV void wave_attn(const float* qs, float* sb, const int nkeys, KeyF keyf, const float* __restrict__ rel_bias, const int hkv, const int lane, float (&o)[4]) {
    float mx[4] = {NEGF, NEGF, NEGF, NEGF};
    for (int base = 0; base < nkeys; base += 64) {
        asm volatile("" ::: "memory");
        const int idx = base + lane;
        const float* kp = nullptr; const float* vp = nullptr; int dist = 0;
        bool valid = false;
        if (idx < nkeys) valid = keyf(idx, kp, vp, dist);
        float sc[4] = {0.f, 0.f, 0.f, 0.f};
        if (valid) {
#pragma unroll 1
            for (int d4 = 0; d4 < 16; ++d4) {
                asm volatile("" ::: "memory");
                const float4 kv = ((const float4*)kp)[d4];
#pragma unroll
                for (int g = 0; g < 4; ++g) {
                    const float4 qv = *(const float4*)(qs + g * 64 + d4 * 4);
                    sc[g] += qv.x * kv.x + qv.y * kv.y + qv.z * kv.z + qv.w * kv.w;
                }
            }
            const int bk = rel_bucket(dist);
#pragma unroll
            for (int g = 0; g < 4; ++g) sc[g] += rel_bias[bk * 8 + hkv * 4 + g];
        }
#pragma unroll
        for (int g = 0; g < 4; ++g) {
            const float v = valid ? sc[g] : NEGF;
            if (idx < nkeys) sb[g * 1024 + idx] = v;
            mx[g] = fmaxf(mx[g], v);
        }
    }
    float inv[4];
#pragma unroll
    for (int g = 0; g < 4; ++g) mx[g] = wave_max(mx[g]);
    wave_sync();
    float sum[4] = {0.f, 0.f, 0.f, 0.f};
    for (int idx = lane; idx < nkeys; idx += 64) {
#pragma unroll
        for (int g = 0; g < 4; ++g) {
            const float v = sb[g * 1024 + idx];
            const float e = (v > -1e29f) ? expf(v - mx[g]) : 0.f;
            sb[g * 1024 + idx] = e;
            sum[g] += e;
        }
    }
#pragma unroll
    for (int g = 0; g < 4; ++g) { sum[g] = wave_sum(sum[g]); inv[g] = 1.0f / fmaxf(sum[g], 1e-30f); }
    for (int idx = lane; idx < nkeys; idx += 64) {
#pragma unroll
        for (int g = 0; g < 4; ++g) sb[g * 1024 + idx] *= inv[g];
    }
    wave_sync();
#pragma unroll
    for (int g = 0; g < 4; ++g) o[g] = 0.f;
    for (int idx = 0; idx < nkeys; ++idx) {
        const float p0 = sb[idx], p1 = sb[1024 + idx], p2 = sb[2048 + idx], p3 = sb[3072 + idx];
        if (p0 + p1 + p2 + p3 == 0.f) continue;
        const float* kp = nullptr; const float* vp = nullptr; int dist = 0;
        (void)keyf(idx, kp, vp, dist);
        const float vv = vp[lane];
        o[0] += p0 * vv; o[1] += p1 * vv; o[2] += p2 * vv; o[3] += p3 * vv;
    }
}

DEV void nsa_item(const Params& p, const int row, const int hkv, float* wl, const int lane) {
    float* qs = wl; float* sb = wl + 256; int* sel = (int*)(wl + 256 + 4096);
    const float* Z = (const float*)(p.ws + WS_Z);
    bf16_t* NOUT = (bf16_t*)(p.ws + WS_NOUTB);
    const float* KCP = (const float*)(p.ws + WS_KCP);
    const float* KCS = (const float*)(p.ws + WS_KCS);
    const bool pr = row < NP;
    const int b = pr ? (row >> 11) : (row - NP);
    const int t = pr ? (row & 2047) : 0;
    const int qpos = pr ? t : PAST;
    const float* zrow = Z + (size_t)row * IN_DIM;
    wave_sync();
    for (int i = lane; i < 256; i += 64) qs[i] = zrow[C_Q + hkv * 256 + i] * 0.125f;
    wave_sync();
    float o[4];
    float gate[3][4];
#pragma unroll
    for (int br = 0; br < 3; ++br)
#pragma unroll
        for (int g = 0; g < 4; ++g) gate[br][g] = sigmoidf_(zrow[C_G + br * 8 + hkv * 4 + g]);
    bf16_t* nrow = NOUT + (size_t)row * 512 + hkv * 256;
    float res[4];
    const int nkc = pr ? 127 : 1023;
    {
        const float* kbase = pr ? (KCP + ((size_t)(b * 128) * 2 + hkv) * 64) : (KCS + ((size_t)(b * 1024) * 2 + hkv) * 64);
        const size_t plane = pr ? (size_t)4096 * 64 : (size_t)65536 * 64;
        auto keyf = [&](int idx, const float*& kp, const float*& vp, int& dist) -> bool {
            kp = kbase + (size_t)idx * 128; vp = kp + plane; dist = qpos - (16 * idx + 31); return dist >= 0; };
        wave_attn(qs, sb, nkc, keyf, p.rel_bias, hkv, lane, o);
#pragma unroll
        for (int g = 0; g < 4; ++g) res[g] = gate[0][g] * o[g];
    }
    const int nblk = pr ? 32 : 257;
    for (int i = lane; i < nkc; i += 64) sb[i] = ((sb[i] + sb[1024 + i]) + sb[2048 + i]) + sb[3072 + i];
    wave_sync();
    {
        const int cur = qpos >> 6;
        for (int blk = lane; blk < nblk; blk += 64) {
            float s = 0.f;
#pragma unroll
            for (int cc = 0; cc < 4; ++cc) {
                const int c = 4 * blk + cc;
                const float a0 = (c < nkc) ? sb[c] : 0.f;
                const float a1 = (c >= 1 && c - 1 < nkc) ? sb[c - 1] : 0.f;
                s += a0 + a1;
            }
            const bool causal = blk * 64 <= qpos;
            const bool forced = (blk == 0) || (blk == cur) || (blk == cur - 1);
            sb[1024 + blk] = causal ? (forced ? 1e4f : s) : NEGF;
        }
        wave_sync();
        for (int blk = lane; blk < nblk; blk += 64) {
            const float my = sb[1024 + blk];
            int rank = 0;
            for (int j = 0; j < nblk; ++j) { const float o2 = sb[1024 + j]; rank += ((o2 > my) || (o2 == my && j < blk)) ? 1 : 0; }
            if (rank < 16) sel[rank] = (blk * 64 <= qpos) ? blk : -1;
        }
        wave_sync();
    }
    {
        const float* zb = Z + (size_t)(pr ? b * 2048 : 0) * IN_DIM;
        auto keyf = [&](int idx, const float*& kp, const float*& vp, int& dist) -> bool {
            const int blk = sel[idx >> 6], s = idx & 63;
            if (blk < 0) return false;
            const int kpos = blk * 64 + s;
            if (kpos > qpos) return false;
            dist = qpos - kpos;
            if (pr) { kp = zb + (size_t)kpos * IN_DIM + C_KS + hkv * 64; }
            else if (blk < 256) { const int page = p.page_table[b * 128 + (blk >> 1)]; kp = p.cache_slc + ((size_t)page * 128 + (blk & 1) * 64 + s) * 256 + hkv * 64; }
            else { kp = zrow + C_KS + hkv * 64; }
            vp = kp + 128; return true; };
        wave_attn(qs, sb, 1024, keyf, p.rel_bias, hkv, lane, o);
#pragma unroll
        for (int g = 0; g < 4; ++g) res[g] += gate[1][g] * o[g];
    }
    {
        const float* zb = Z + (size_t)(pr ? b * 2048 : 0) * IN_DIM;
        const int nk = pr ? ((t + 1 < 512) ? t + 1 : 512) : 512;
        auto keyf = [&](int idx, const float*& kp, const float*& vp, int& dist) -> bool {
            if (pr) { const int kpos = t - nk + 1 + idx; dist = t - kpos; kp = zb + (size_t)kpos * IN_DIM + C_KW + hkv * 64; }
            else { const int j = idx + 1; dist = 512 - j; kp = (j < 512) ? (p.state_win + ((size_t)b * 512 + j) * 256 + hkv * 64) : (zrow + C_KW + hkv * 64); }
            vp = kp + 128; return true; };
        wave_attn(qs, sb, nk, keyf, p.rel_bias, hkv, lane, o);
#pragma unroll
        for (int g = 0; g < 4; ++g) res[g] += gate[2][g] * o[g];
    }
#pragma unroll
    for (int g = 0; g < 4; ++g) nrow[g * 64 + lane] = (bf16_t)(cvt_pk_bf16(res[g], 0.f) & 0xffffu);
}

DEV void mlstm_scan_item(const Params& p, const int item, float* lds) {
    const int tid = threadIdx.x, v = tid >> 1, kh = tid & 1;
    const int seq = item >> 2, h = item & 3;
    const bool pr = seq < 16; const int b = pr ? seq : seq - 16;
    const int T = pr ? 2048 : 1; const int row0 = pr ? b * 2048 : NP + b;
    const float* Z = (const float*)(p.ws + WS_Z);
    const float* QK = (const float*)(p.ws + WS_QK);
    float* HRAW = (float*)(p.ws + WS_HRAW);
    float C[64], n[64]; float m;
    if (pr) {
#pragma unroll
        for (int j = 0; j < 64; ++j) { C[j] = 0.f; n[j] = 0.f; }
        m = 0.f;
    } else {
        const float* c0 = p.state_C + (((size_t)(b * 4 + h) * 128 + v) * 128 + kh * 64);
        const float* n0 = p.state_n + ((size_t)(b * 4 + h) * 128 + kh * 64);
#pragma unroll
        for (int j = 0; j < 64; ++j) { C[j] = c0[j]; n[j] = n0[j]; }
        m = p.state_m[b * 4 + h];
    }
    const float gb_i = p.gate_bias[h], gb_f = p.gate_bias[4 + h];
    auto load_tok = [&](int t, float* dst) {
        const size_t r = (size_t)(row0 + t);
        dst[tid] = QK[r * 1024 + h * 256 + tid];
        if (tid < 128) dst[256 + tid] = Z[r * IN_DIM + C_V + h * 128 + tid];
        if (tid == 128) dst[384] = Z[r * IN_DIM + C_I + h] + gb_i;
        if (tid == 129) dst[385] = log_sigmoid(Z[r * IN_DIM + C_F + h] + gb_f);
    };
    __syncthreads();
    load_tok(0, lds);
    __syncthreads();
    for (int t = 0; t < T; ++t) {
        const float* cur = lds + (t & 1) * 388;
        if (t + 1 < T) load_tok(t + 1, lds + ((t + 1) & 1) * 388);
        const float ig = cur[384], lf = cur[385];
        const float mn = fmaxf(lf + m, ig);
        const float fd = expf(lf + m - mn), iw = expf(ig - mn);
        const float vv = cur[256 + v] * iw;
        float nump = 0.f, denp = 0.f;
#pragma unroll
        for (int j = 0; j < 64; ++j) {
            const float kj = cur[128 + kh * 64 + j], qj = cur[kh * 64 + j];
            C[j] = fd * C[j] + vv * kj; n[j] = fd * n[j] + iw * kj;
            nump += C[j] * qj; denp += n[j] * qj;
        }
        nump += __shfl_xor(nump, 1); denp += __shfl_xor(denp, 1);
        const float hval = nump / fmaxf(fabsf(denp), expf(-mn));
        if (kh == 0) HRAW[(size_t)(row0 + t) * 512 + h * 128 + v] = hval;
        m = mn;
        __syncthreads();
    }
    float* co = p.out + (pr ? O_CP : O_CS) + (((size_t)(b * 4 + h) * 128 + v) * 128 + kh * 64);
#pragma unroll
    for (int j = 0; j < 64; ++j) co[j] = C[j];
    if (v == 0) {
        float* no = p.out + (pr ? O_NP : O_NS) + ((size_t)(b * 4 + h) * 128 + kh * 64);
#pragma unroll
        for (int j = 0; j < 64; ++j) no[j] = n[j];
    }
    if (tid == 0) p.out[(pr ? O_MP : O_MS) + b * 4 + h] = m;
}

DEV void peer_topk_item(const Params& p, const int row, const int h, const int lane) {
    const float* S = (const float*)(p.ws + WS_S) + (size_t)row * 2048 + h * 256;
    int* PIDX = (int*)(p.ws + WS_PIDX); float* PG = (float*)(p.ws + WS_PG);
    float ts[2]; int ti[2];
#pragma unroll
    for (int pp = 0; pp < 2; ++pp) {
        float v0 = S[pp * 128 + lane], v1 = S[pp * 128 + 64 + lane];
        float mys = 0.f; int myi = 0;
        for (int r = 0; r < 16; ++r) {
            float best = fmaxf(v0, v1); int bi = (v0 >= v1) ? lane : lane + 64;
#pragma unroll
            for (int off = 32; off >= 1; off >>= 1) {
                const float ob = __shfl_xor(best, off); const int oi = __shfl_xor(bi, off);
                if (ob > best || (ob == best && oi < bi)) { best = ob; bi = oi; }
            }
            if (lane == r) { mys = best; myi = bi; }
            if (bi == lane) v0 = -INFINITY;
            if (bi == lane + 64) v1 = -INFINITY;
        }
        ts[pp] = mys; ti[pp] = myi;
    }
    float cv[4];
#pragma unroll
    for (int jj = 0; jj < 4; ++jj) { const int c = lane * 4 + jj; cv[jj] = __shfl(ts[0], c >> 4) + __shfl(ts[1], c & 15); }
    float msc = 0.f; int mci = 0;
    for (int r = 0; r < 16; ++r) {
        float best = cv[0]; int bi = lane * 4;
#pragma unroll
        for (int jj = 1; jj < 4; ++jj) if (cv[jj] > best) { best = cv[jj]; bi = lane * 4 + jj; }
#pragma unroll
        for (int off = 32; off >= 1; off >>= 1) {
            const float ob = __shfl_xor(best, off); const int oi = __shfl_xor(bi, off);
            if (ob > best || (ob == best && oi < bi)) { best = ob; bi = oi; }
        }
        if (lane == r) { msc = best; mci = bi; }
#pragma unroll
        for (int jj = 0; jj < 4; ++jj) if (bi == lane * 4 + jj) cv[jj] = -INFINITY;
    }
    const int e = __shfl(ti[0], mci >> 4) * 128 + __shfl(ti[1], mci & 15);
    const float top = __shfl(msc, 0);
    float ex = (lane < 16) ? expf(msc - top) : 0.f;
    const float den = wave_sum(ex);
    if (lane < 16) { PIDX[(size_t)row * 128 + h * 16 + lane] = e; PG[(size_t)row * 128 + h * 16 + lane] = ex / den; }
}

DEV void peer_expert_item(const Params& p, const int row, float* lds) {
    const int tid = threadIdx.x, lane = tid & 63, w = tid >> 6;
    const float* X1 = (const float*)(p.ws + WS_X1) + (size_t)row * 1024;
    const int* PIDX = (const int*)(p.ws + WS_PIDX) + (size_t)row * 128;
    const float* PG = (const float*)(p.ws + WS_PG) + (size_t)row * 128;
    float4 x[4], acc[4];
#pragma unroll
    for (int j = 0; j < 4; ++j) { x[j] = *(const float4*)(X1 + j * 256 + lane * 4); acc[j] = make_float4(0.f, 0.f, 0.f, 0.f); }
    for (int k = 0; k < 32; ++k) {
        const int e = PIDX[w * 32 + k]; const float gk = PG[w * 32 + k];
        const float* ur = p.peer_u + (size_t)e * 1024; const float* vr = p.peer_v + (size_t)e * 1024;
        float d = 0.f;
#pragma unroll
        for (int j = 0; j < 4; ++j) { const float4 u = *(const float4*)(ur + j * 256 + lane * 4); d += u.x * x[j].x + u.y * x[j].y + u.z * x[j].z + u.w * x[j].w; }
        d = wave_sum(d);
        const float coef = gk * gelu_tanh(d);
#pragma unroll
        for (int j = 0; j < 4; ++j) { const float4 vv = *(const float4*)(vr + j * 256 + lane * 4);
            acc[j].x += coef * vv.x; acc[j].y += coef * vv.y; acc[j].z += coef * vv.z; acc[j].w += coef * vv.w; }
    }
    __syncthreads();
#pragma unroll
    for (int j = 0; j < 4; ++j) *(float4*)(lds + w * 1024 + j * 256 + lane * 4) = acc[j];
    __syncthreads();
    float tv[4]; float s = 0.f;
#pragma unroll
    for (int i = 0; i < 4; ++i) { const int c = tid * 4 + i; const float po = (lds[c] + lds[1024 + c]) + (lds[2048 + c] + lds[3072 + c]); tv[i] = DN_ALPHA * X1[c] + po; s += tv[i]; }
    float* red = lds + 4096;
    s = wave_sum(s);
    if (lane == 0) red[w] = s;
    __syncthreads();
    const float mu = (red[0] + red[1] + red[2] + red[3]) * (1.0f / 1024.0f);
    float q = 0.f;
#pragma unroll
    for (int i = 0; i < 4; ++i) { const float d = tv[i] - mu; q += d * d; }
    q = wave_sum(q);
    if (lane == 0) red[8 + w] = q;
    __syncthreads();
    const float var = (red[8] + red[9] + red[10] + red[11]) * (1.0f / 1024.0f);
    const float rstd = 1.0f / sqrtf(var + LN_EPS);
    float* y = p.out + O_Y + (size_t)row * 1024;
#pragma unroll
    for (int i = 0; i < 4; ++i) { const int c = tid * 4 + i; y[c] = (tv[i] - mu) * rstd * p.ln2_g[c] + p.ln2_b[c]; }
}

__global__ void __launch_bounds__(NTHREADS, 2) fwd_kernel(Params p) {
    extern __shared__ __attribute__((aligned(16))) unsigned char smem[];
    if (threadIdx.x == 0) { *(uint4*)smem = make_uint4(0u, 0u, 0u, 0u); }
    __syncthreads();
    XcdBarrier bar = xcd_barrier_post((unsigned*)(p.ws + WS_BAR), (volatile LAS unsigned*)smem);
    float* lds = (float*)(smem + 16);
    unsigned char* ldsb = smem + 16;
    const int tid = threadIdx.x, lane = tid & 63, w = tid >> 6;
    const int gw = blockIdx.x * 4 + w, nw = gridDim.x * 4;
    const size_t gt = (size_t)blockIdx.x * NTHREADS + tid, nt = (size_t)gridDim.x * NTHREADS;

    float* Z = (float*)(p.ws + WS_Z);
    float* QK = (float*)(p.ws + WS_QK);
    float* HRAW = (float*)(p.ws + WS_HRAW);
    bf16_t* MOUTB = (bf16_t*)(p.ws + WS_MOUTB);
    bf16_t* NOUTB = (bf16_t*)(p.ws + WS_NOUTB);
    bf16_t* HIDPB = (bf16_t*)(p.ws + WS_HIDPB);
    float* KCP = (float*)(p.ws + WS_KCP);
    bf16_t* HIDSB = (bf16_t*)(p.ws + WS_HIDSB);
    float* KCS = (float*)(p.ws + WS_KCS);
    float* MIX = (float*)(p.ws + WS_MIX);
    bf16_t* MIXB = (bf16_t*)(p.ws + WS_MIXB);
    float* T1 = (float*)(p.ws + WS_T1);
    float* X1 = (float*)(p.ws + WS_X1);
    bf16_t* X1B = (bf16_t*)(p.ws + WS_X1B);
    bf16_t* QPB = (bf16_t*)(p.ws + WS_QPB);
    float* S = (float*)(p.ws + WS_S);
    bf16_t* CONVB = (bf16_t*)(p.ws + WS_CONVB);
    bf16_t* XB = (bf16_t*)(p.ws + WS_XB);
    bf16_t* WIN_T = (bf16_t*)(p.ws + WS_WIN_T);
    bf16_t* WUPM_T = (bf16_t*)(p.ws + WS_WUPM_T);
    bf16_t* WUPN_T = (bf16_t*)(p.ws + WS_WUPN_T);
    bf16_t* WOUT_T = (bf16_t*)(p.ws + WS_WOUT_T);
    bf16_t* PWQ_T = (bf16_t*)(p.ws + WS_PWQ_T);
    bf16_t* WQK_T = (bf16_t*)(p.ws + WS_WQK_T);
    bf16_t* W1_T = (bf16_t*)(p.ws + WS_W1_T);
    bf16_t* W2_T = (bf16_t*)(p.ws + WS_W2_T);
    bf16_t* SUBK = (bf16_t*)(p.ws + WS_SUBK);

    {
        for (size_t id = gt; id < (size_t)MP * 128; id += nt) {
            const int row = (int)(id >> 7), k8 = (int)(id & 127) * 8;
            float f[8];
            if (row < NR) {
                const float* s = (row < NP ? p.x_prompt + (size_t)row * 1024 : p.x_sample + (size_t)(row - NP) * 1024) + k8;
                const float4 a = *(const float4*)s, b = *(const float4*)(s + 4);
                f[0] = a.x; f[1] = a.y; f[2] = a.z; f[3] = a.w; f[4] = b.x; f[5] = b.y; f[6] = b.z; f[7] = b.w;
            } else {
#pragma unroll
                for (int i = 0; i < 8; ++i) f[i] = 0.f;
            }
            *(uint4*)(XB + (size_t)row * 1024 + k8) = pack8(f);
        }
        transpose_to_bf16(p.w_in, 1024, IN_DIM, WIN_T, gt, nt);
        transpose_to_bf16(p.w_up_m, 512, 1024, WUPM_T, gt, nt);
        transpose_to_bf16(p.w_up_n, 512, 1024, WUPN_T, gt, nt);
        transpose_to_bf16(p.w_out, 1024, 1024, WOUT_T, gt, nt);
        transpose_to_bf16(p.peer_wq, 1024, 2048, PWQ_T, gt, nt);
        for (int h = 0; h < 4; ++h) {
            transpose_to_bf16(p.wq + (size_t)h * 16384, 128, 128, WQK_T + (size_t)(h * 256) * 128, gt, nt);
            transpose_to_bf16(p.wk + (size_t)h * 16384, 128, 128, WQK_T + (size_t)(h * 256 + 128) * 128, gt, nt);
        }
        for (int c = 0; c < 2; ++c) {
            transpose_to_bf16(p.cmp_w1 + (size_t)c * 2048 * 64, 2048, 64, W1_T + (size_t)c * 64 * 2048, gt, nt);
            transpose_to_bf16(p.cmp_w2 + (size_t)c * 4096, 64, 64, W2_T + (size_t)c * 4096, gt, nt);
        }
        for (size_t id = gt; id < (size_t)2 * 128 * 128 / 8; id += nt) {
            float f[8];
#pragma unroll
            for (int i = 0; i < 8; ++i) f[i] = p.peer_sub[id * 8 + i];
            *(uint4*)(SUBK + id * 8) = pack8(f);
        }
        for (size_t i = gt; i < (size_t)BS * 511 * 256; i += nt) {
            const int j = (int)(i & 255); const int wv = (int)((i >> 8) % 511); const int b = (int)((i >> 8) / 511);
            p.out[O_WINS + ((size_t)b * 512 + wv) * 256 + j] = p.state_win[((size_t)b * 512 + wv + 1) * 256 + j];
        }
        for (size_t i = gt; i < (size_t)BS * 2 * 512; i += nt) {
            const int ch = (int)(i & 511); const int jj = (int)((i >> 9) & 1); const int b = (int)(i >> 10);
            p.out[O_CVS + ((size_t)b * 3 + jj) * 512 + ch] = p.state_conv[((size_t)b * 3 + jj + 1) * 512 + ch];
        }
    }
    xcd_barrier(bar);

    gemm_bf16<128>(NR, IN_DIM, 1024,
        [&](int r, int k) { return *(const uint4*)(XB + (size_t)r * 1024 + k); },
        [&](int n, int k) { return *(const uint4*)(WIN_T + (size_t)n * 1024 + k); },
        [&](int r, int c0, f32x4 v) {
            *(f32x4*)(Z + (size_t)r * IN_DIM + c0) = v;
            if (c0 >= C_KC && c0 < C_KS) *(f32x4*)(p.out + O_CMPP + (size_t)r * 256 + (c0 - C_KC)) = v;
            else if (c0 >= C_KS && c0 < C_KW) *(f32x4*)(p.out + O_SLCP + (size_t)r * 256 + (c0 - C_KS)) = v;
            else if (c0 >= C_KW && c0 < C_G) {
                if (r < NP) { const int t = r & 2047; if (t >= 1536) *(f32x4*)(p.out + O_WINP + ((size_t)(r >> 11) * 512 + (t - 1536)) * 256 + (c0 - C_KW)) = v; }
                else *(f32x4*)(p.out + O_WINS + ((size_t)(r - NP) * 512 + 511) * 256 + (c0 - C_KW)) = v;
            } else if (c0 < C_V) {
                if (r < NP) { const int t = r & 2047; if (t >= 2045) *(f32x4*)(p.out + O_CVP + ((size_t)(r >> 11) * 3 + (t - 2045)) * 512 + c0) = v; }
                else *(f32x4*)(p.out + O_CVS + ((size_t)(r - NP) * 3 + 2) * 512 + c0) = v;
            }
        }, ldsb);
    xcd_barrier(bar);

    for (size_t i = gt; i < (size_t)NR * 512; i += nt) {
        const int ch = (int)(i & 511); const int r = (int)(i >> 9);
        float a = p.conv_b[ch];
        if (r < NP) {
            const int t = r & 2047;
#pragma unroll
            for (int j = 0; j < 4; ++j) if (t + j - 3 >= 0) a += p.conv_w[j * 512 + ch] * Z[(size_t)(r + j - 3) * IN_DIM + C_U + ch];
        } else {
            const int b = r - NP;
#pragma unroll
            for (int j = 0; j < 3; ++j) a += p.conv_w[j * 512 + ch] * p.state_conv[((size_t)b * 3 + j) * 512 + ch];
            a += p.conv_w[3 * 512 + ch] * Z[(size_t)r * IN_DIM + C_U + ch];
        }
        CONVB[i] = (bf16_t)(cvt_pk_bf16(a / (1.0f + expf(-a)), 0.f) & 0xffffu);
    }
    xcd_barrier(bar);

    for (int h = 0; h < 4; ++h) {
        gemm_bf16<128>(NR, 256, 128,
            [&](int r, int k) { return *(const uint4*)(CONVB + (size_t)r * 512 + h * 128 + k); },
            [&](int n, int k) { return *(const uint4*)(WQK_T + (size_t)(h * 256 + n) * 128 + k); },
            [&](int r, int c0, f32x4 v) { if (c0 >= 128) v = v * 0.08838834764831845f; *(f32x4*)(QK + (size_t)r * 1024 + h * 256 + c0) = v; }, ldsb);
    }
    for (int c = 0; c < 2; ++c) {
        gemm_bf16<64>(4096, 64, 2048,
            [&](int row, int k) {
                const int hh = row & 1, bi = row >> 1, i = bi & 127, b = bi >> 7, j = k >> 6, d0 = k & 63, tok = 16 * i + j;
                const float* pe = p.cmp_pe + (c * 32 + j) * 64 + d0;
                const float4 e0 = *(const float4*)pe, e1 = *(const float4*)(pe + 4);
                float f[8] = {e0.x, e0.y, e0.z, e0.w, e1.x, e1.y, e1.z, e1.w};
                if (tok < 2048) {
                    const float* s = Z + ((size_t)b * 2048 + tok) * IN_DIM + C_KC + c * 128 + hh * 64 + d0;
                    const float4 a0 = *(const float4*)s, a1 = *(const float4*)(s + 4);
                    f[0] += a0.x; f[1] += a0.y; f[2] += a0.z; f[3] += a0.w; f[4] += a1.x; f[5] += a1.y; f[6] += a1.z; f[7] += a1.w;
                }
                return pack8(f); },
            [&](int n, int k) { return *(const uint4*)(W1_T + ((size_t)c * 64 + n) * 2048 + k); },
            [&](int row, int c0, f32x4 v) {
                f32x4 g; g[0] = gelu_tanh(v[0]); g[1] = gelu_tanh(v[1]); g[2] = gelu_tanh(v[2]); g[3] = gelu_tanh(v[3]);
                store_bf16x4(HIDPB + ((size_t)c * 4096 + row) * 64 + c0, g); }, ldsb);
        gemm_bf16<64>(65536, 64, 2048,
            [&](int row, int k) {
                const int hh = row & 1, bi = row >> 1, i = bi & 1023, b = bi >> 10, j = k >> 6, d0 = k & 63, tok = 16 * i + j;
                const float* pe = p.cmp_pe + (c * 32 + j) * 64 + d0;
                const float4 e0 = *(const float4*)pe, e1 = *(const float4*)(pe + 4);
                float f[8] = {e0.x, e0.y, e0.z, e0.w, e1.x, e1.y, e1.z, e1.w};
                if (tok < PAST) {
                    const int page = p.page_table[b * 128 + (tok >> 7)];
                    const float* s = p.cache_cmp + ((size_t)page * 128 + (tok & 127)) * 256 + c * 128 + hh * 64 + d0;
                    const float4 a0 = *(const float4*)s, a1 = *(const float4*)(s + 4);
                    f[0] += a0.x; f[1] += a0.y; f[2] += a0.z; f[3] += a0.w; f[4] += a1.x; f[5] += a1.y; f[6] += a1.z; f[7] += a1.w;
                }
                return pack8(f); },
            [&](int n, int k) { return *(const uint4*)(W1_T + ((size_t)c * 64 + n) * 2048 + k); },
            [&](int row, int c0, f32x4 v) {
                f32x4 g; g[0] = gelu_tanh(v[0]); g[1] = gelu_tanh(v[1]); g[2] = gelu_tanh(v[2]); g[3] = gelu_tanh(v[3]);
                store_bf16x4(HIDSB + ((size_t)c * 65536 + row) * 64 + c0, g); }, ldsb);
    }
    xcd_barrier(bar);

    for (int item = blockIdx.x; item < 192; item += gridDim.x) mlstm_scan_item(p, item, lds);
    for (int c = 0; c < 2; ++c) {
        gemm_bf16<64>(4096, 64, 64,
            [&](int row, int k) { return *(const uint4*)(HIDPB + ((size_t)c * 4096 + row) * 64 + k); },
            [&](int n, int k) { return *(const uint4*)(W2_T + ((size_t)c * 64 + n) * 64 + k); },
            [&](int row, int c0, f32x4 v) { *(f32x4*)(KCP + ((size_t)c * 4096 + row) * 64 + c0) = v; }, ldsb);
        gemm_bf16<64>(65536, 64, 64,
            [&](int row, int k) { return *(const uint4*)(HIDSB + ((size_t)c * 65536 + row) * 64 + k); },
            [&](int n, int k) { return *(const uint4*)(W2_T + ((size_t)c * 64 + n) * 64 + k); },
            [&](int row, int c0, f32x4 v) { *(f32x4*)(KCS + ((size_t)c * 65536 + row) * 64 + c0) = v; }, ldsb);
    }
    xcd_barrier(bar);

    for (int it = gw; it < NR * 4; it += nw) {
        const int row = it >> 2, h = it & 3;
        const float x0 = HRAW[(size_t)row * 512 + h * 128 + lane], x1 = HRAW[(size_t)row * 512 + h * 128 + 64 + lane];
        const float mu = wave_sum(x0 + x1) * (1.0f / 128.0f);
        const float d0 = x0 - mu, d1 = x1 - mu;
        const float var = wave_sum(d0 * d0 + d1 * d1) * (1.0f / 128.0f);
        const float rstd = 1.0f / sqrtf(var + LN_EPS);
        const int c0 = h * 128 + lane, c1 = c0 + 64;
        MOUTB[(size_t)row * 512 + c0] = (bf16_t)(cvt_pk_bf16(sigmoidf_(Z[(size_t)row * IN_DIM + C_O + c0]) * (d0 * rstd * p.norm_g[c0]), 0.f) & 0xffffu);
        MOUTB[(size_t)row * 512 + c1] = (bf16_t)(cvt_pk_bf16(sigmoidf_(Z[(size_t)row * IN_DIM + C_O + c1]) * (d1 * rstd * p.norm_g[c1]), 0.f) & 0xffffu);
    }
    {
        float* wl = lds + w * 4416;
        for (int it = gw; it < NR * 2; it += nw) nsa_item(p, it >> 1, it & 1, wl, lane);
    }
    xcd_barrier(bar);

    gemm_bf16<128>(NR, 1024, 512,
        [&](int r, int k) { return *(const uint4*)(MOUTB + (size_t)r * 512 + k); },
        [&](int n, int k) { return *(const uint4*)(WUPM_T + (size_t)n * 512 + k); },
        [&](int r, int c0, f32x4 v) {
            const f32x4 g = *(const f32x4*)(Z + (size_t)r * IN_DIM + C_GM + c0);
            f32x4 o; o[0] = sigmoidf_(g[0]) * v[0]; o[1] = sigmoidf_(g[1]) * v[1]; o[2] = sigmoidf_(g[2]) * v[2]; o[3] = sigmoidf_(g[3]) * v[3];
            *(f32x4*)(MIX + (size_t)r * 1024 + c0) = o; }, ldsb);
    gemm_bf16<128>(NR, 1024, 512,
        [&](int r, int k) { return *(const uint4*)(NOUTB + (size_t)r * 512 + k); },
        [&](int n, int k) { return *(const uint4*)(WUPN_T + (size_t)n * 512 + k); },
        [&](int r, int c0, f32x4 v) {
            const f32x4 g = *(const f32x4*)(Z + (size_t)r * IN_DIM + C_GN + c0);
            f32x4 o = *(const f32x4*)(MIX + (size_t)r * 1024 + c0);
            o[0] += sigmoidf_(g[0]) * v[0]; o[1] += sigmoidf_(g[1]) * v[1]; o[2] += sigmoidf_(g[2]) * v[2]; o[3] += sigmoidf_(g[3]) * v[3];
            store_bf16x4(MIXB + (size_t)r * 1024 + c0, o); }, ldsb);
    xcd_barrier(bar);

    gemm_bf16<128>(NR, 1024, 1024,
        [&](int r, int k) { return *(const uint4*)(MIXB + (size_t)r * 1024 + k); },
        [&](int n, int k) { return *(const uint4*)(WOUT_T + (size_t)n * 1024 + k); },
        [&](int r, int c0, f32x4 v) {
            const f32x4 xv = *(const f32x4*)((r < NP ? p.x_prompt + (size_t)r * 1024 : p.x_sample + (size_t)(r - NP) * 1024) + c0);
            *(f32x4*)(T1 + (size_t)r * 1024 + c0) = xv * DN_ALPHA + v; }, ldsb);
    xcd_barrier(bar);

    for (int row = gw; row < NR; row += nw) {
        float tv[16]; float s = 0.f;
#pragma unroll
        for (int j = 0; j < 4; ++j) { const float4 t4 = *(const float4*)(T1 + (size_t)row * 1024 + j * 256 + lane * 4); tv[4 * j] = t4.x; tv[4 * j + 1] = t4.y; tv[4 * j + 2] = t4.z; tv[4 * j + 3] = t4.w; s += (t4.x + t4.y) + (t4.z + t4.w); }
        const float mu = wave_sum(s) * (1.0f / 1024.0f);
        float q = 0.f;
#pragma unroll
        for (int j = 0; j < 16; ++j) { const float d = tv[j] - mu; q += d * d; }
        const float rstd = 1.0f / sqrtf(wave_sum(q) * (1.0f / 1024.0f) + LN_EPS);
#pragma unroll
        for (int j = 0; j < 4; ++j) {
            const int c = j * 256 + lane * 4;
            const float4 g4 = *(const float4*)(p.ln1_g + c), b4 = *(const float4*)(p.ln1_b + c);
            f32x4 o; o[0] = (tv[4 * j] - mu) * rstd * g4.x + b4.x; o[1] = (tv[4 * j + 1] - mu) * rstd * g4.y + b4.y; o[2] = (tv[4 * j + 2] - mu) * rstd * g4.z + b4.z; o[3] = (tv[4 * j + 3] - mu) * rstd * g4.w + b4.w;
            *(f32x4*)(X1 + (size_t)row * 1024 + c) = o;
            store_bf16x4(X1B + (size_t)row * 1024 + c, o);
        }
    }
    xcd_barrier(bar);

    gemm_bf16<128>(NR, 2048, 1024,
        [&](int r, int k) { return *(const uint4*)(X1B + (size_t)r * 1024 + k); },
        [&](int n, int k) { return *(const uint4*)(PWQ_T + (size_t)n * 1024 + k); },
        [&](int r, int c0, f32x4 v) { store_bf16x4(QPB + (size_t)r * 2048 + c0, v); }, ldsb);
    xcd_barrier(bar);

    for (int hp = 0; hp < 16; ++hp) {
        const int pp = hp & 1;
        gemm_bf16<128>(NR, 128, 128,
            [&](int r, int k) { return *(const uint4*)(QPB + (size_t)r * 2048 + hp * 128 + k); },
            [&](int n, int k) { return *(const uint4*)(SUBK + ((size_t)pp * 128 + n) * 128 + k); },
            [&](int r, int c0, f32x4 v) { *(f32x4*)(S + (size_t)r * 2048 + hp * 128 + c0) = v; }, ldsb);
    }
    xcd_barrier(bar);

    for (int it = gw; it < NR * 8; it += nw) peer_topk_item(p, it >> 3, it & 7, lane);
    xcd_barrier(bar);

    for (int row = blockIdx.x; row < NR; row += gridDim.x) peer_expert_item(p, row, lds);
}

extern "C" void kernel_launch(void* const* d_in, const int* in_sizes, int n_in, void* d_out, int out_size, void* d_ws, size_t ws_size, hipStream_t stream) {
    static int grid = 0;
    if (grid == 0) {
        if (n_in != 32 || (size_t)out_size != O_END || ws_size < WS_END) {
            fprintf(stderr, "kernel_launch: unexpected sizes n_in %d out %d ws %zu (need %zu)\n", n_in, out_size, ws_size, (size_t)WS_END); grid = -1; return; }
        int dev = 0, cus = 0, per_cu = 0;
        if (hipGetDevice(&dev) != hipSuccess || hipDeviceGetAttribute(&cus, hipDeviceAttributeMultiprocessorCount, dev) != hipSuccess) { grid = -1; return; }
        if (hipFuncSetAttribute((const void*)fwd_kernel, hipFuncAttributeMaxDynamicSharedMemorySize, LDS_BYTES) != hipSuccess) { fprintf(stderr, "hipFuncSetAttribute failed\n"); grid = -1; return; }
        if (hipOccupancyMaxActiveBlocksPerMultiprocessor(&per_cu, (const void*)fwd_kernel, NTHREADS, LDS_BYTES) != hipSuccess || per_cu < 1) { fprintf(stderr, "occupancy query failed (%d)\n", per_cu); (void)hipGetLastError(); per_cu = 1; }
        if (per_cu > 2) per_cu = 2;
        grid = cus * per_cu;
    }
    if (grid < 0) return;
    (void)hipMemsetAsync((char*)d_ws + WS_BAR, 0, XCD_BAR_WORDS * sizeof(unsigned), stream);
    Params p{};
    p.x_prompt = (const float*)d_in[0]; p.x_sample = (const float*)d_in[1]; p.cache_cmp = (const float*)d_in[2]; p.cache_slc = (const float*)d_in[3];
    p.page_table = (const int*)d_in[4]; p.state_win = (const float*)d_in[5]; p.state_C = (const float*)d_in[6]; p.state_n = (const float*)d_in[7];
    p.state_m = (const float*)d_in[8]; p.state_conv = (const float*)d_in[9]; p.w_in = (const float*)d_in[10]; p.conv_w = (const float*)d_in[11];
    p.conv_b = (const float*)d_in[12]; p.wq = (const float*)d_in[13]; p.wk = (const float*)d_in[14]; p.gate_bias = (const float*)d_in[15];
    p.norm_g = (const float*)d_in[16]; p.cmp_pe = (const float*)d_in[17]; p.cmp_w1 = (const float*)d_in[18]; p.cmp_w2 = (const float*)d_in[19];
    p.rel_bias = (const float*)d_in[20]; p.w_up_m = (const float*)d_in[21]; p.w_up_n = (const float*)d_in[22]; p.w_out = (const float*)d_in[23];
    p.ln1_g = (const float*)d_in[24]; p.ln1_b = (const float*)d_in[25]; p.ln2_g = (const float*)d_in[26]; p.ln2_b = (const float*)d_in[27];
    p.peer_wq = (const float*)d_in[28]; p.peer_sub = (const float*)d_in[29]; p.peer_u = (const float*)d_in[30]; p.peer_v = (const float*)d_in[31];
    p.out = (float*)d_out; p.ws = (unsigned char*)d_ws;
    hipLaunchKernelGGL(fwd_kernel, dim3(grid), dim3(NTHREADS), LDS_BYTES, stream, p);
}
```

```cpp
#include <hip/hip_runtime.h>
#include <stdint.h>
#include <cstdio>

#define DEV __device__ __forceinline__

constexpr int DM = 1024;
constexpr int BP = 16, TP = 2048, BS = 32;
constexpr int NP = BP * TP;
constexpr int NR = NP + BS;
constexpr int MP = 32896;
constexpr int IN_DIM = 4896;
constexpr int C_U = 0, C_V = 512, C_O = 1024, C_I = 1536, C_F = 1540, C_Q = 1544, C_KC = 2056, C_KS = 2312, C_KW = 2568, C_G = 2824, C_GM = 2848, C_GN = 3872;
constexpr int PAST = 16384;
constexpr float NEGF = -1e30f;
constexpr float DN_ALPHA = 1.189207115002721f;
constexpr float LN_EPS = 1e-5f;

constexpr size_t O_Y = 0;
constexpr size_t O_CMPP = (size_t)NR * DM;
constexpr size_t O_CMPS = O_CMPP + (size_t)NP * 256;
constexpr size_t O_SLCP = O_CMPS + (size_t)BS * 256;
constexpr size_t O_SLCS = O_SLCP + (size_t)NP * 256;
constexpr size_t O_WINP = O_SLCS + (size_t)BS * 256;
constexpr size_t O_WINS = O_WINP + (size_t)BP * 512 * 256;
constexpr size_t O_CP = O_WINS + (size_t)BS * 512 * 256;
constexpr size_t O_CS = O_CP + (size_t)BP * 4 * 128 * 128;
constexpr size_t O_NP = O_CS + (size_t)BS * 4 * 128 * 128;
constexpr size_t O_NS = O_NP + (size_t)BP * 4 * 128;
constexpr size_t O_MP = O_NS + (size_t)BS * 4 * 128;
constexpr size_t O_MS = O_MP + (size_t)BP * 4;
constexpr size_t O_CVP = O_MS + (size_t)BS * 4;
constexpr size_t O_CVS = O_CVP + (size_t)BP * 3 * 512;
constexpr size_t O_END = O_CVS + (size_t)BS * 3 * 512;
static_assert(O_END == 59916480, "output size");

constexpr size_t al256(size_t x) { return (x + 255) & ~(size_t)255; }
constexpr size_t WS_BAR = 0;
constexpr size_t WS_Z = 16384;
constexpr size_t WS_QK = al256(WS_Z + (size_t)MP * IN_DIM * 4);
constexpr size_t WS_HRAW = al256(WS_QK + (size_t)MP * 1024 * 4);
constexpr size_t WS_MOUTB = al256(WS_HRAW + (size_t)MP * 512 * 4);
constexpr size_t WS_NOUTB = al256(WS_MOUTB + (size_t)MP * 512 * 2);
constexpr size_t WS_HIDPB = al256(WS_NOUTB + (size_t)MP * 512 * 2);
constexpr size_t WS_KCP = al256(WS_HIDPB + (size_t)2 * 4096 * 64 * 2);
constexpr size_t WS_HIDSB = al256(WS_KCP + 256);
constexpr size_t WS_KCS = al256(WS_HIDSB + (size_t)2 * 65536 * 64 * 2);
constexpr size_t WS_MIX = al256(WS_KCS + (size_t)2 * 65536 * 64 * 4);
constexpr size_t WS_MIXB = al256(WS_MIX + (size_t)MP * 1024 * 4);
constexpr size_t WS_T1 = al256(WS_MIXB + (size_t)MP * 1024 * 2);
constexpr size_t WS_X1 = al256(WS_T1 + (size_t)MP * 1024 * 4);
constexpr size_t WS_X1B = al256(WS_X1 + (size_t)MP * 1024 * 4);
constexpr size_t WS_QPB = al256(WS_X1B + (size_t)MP * 1024 * 2);
constexpr size_t WS_S = al256(WS_QPB + (size_t)MP * 2048 * 2);
constexpr size_t WS_PIDX = al256(WS_S + (size_t)MP * 2048 * 4);
constexpr size_t WS_PG = al256(WS_PIDX + (size_t)MP * 128 * 4);
constexpr size_t WS_CONVB = al256(WS_PG + (size_t)MP * 128 * 4);
constexpr size_t WS_XB = al256(WS_CONVB + (size_t)MP * 512 * 2);
constexpr size_t WS_WIN_T = al256(WS_XB + (size_t)MP * 1024 * 2);
constexpr size_t WS_WUPM_T = al256(WS_WIN_T + (size_t)IN_DIM * 1024 * 2);
constexpr size_t WS_WUPN_T = al256(WS_WUPM_T + (size_t)1024 * 512 * 2);
constexpr size_t WS_WOUT_T = al256(WS_WUPN_T + (size_t)1024 * 512 * 2);
constexpr size_t WS_PWQ_T = al256(WS_WOUT_T + (size_t)1024 * 1024 * 2);
constexpr size_t WS_WQK_T = al256(WS_PWQ_T + (size_t)2048 * 1024 * 2);
constexpr size_t WS_W1_T = al256(WS_WQK_T + (size_t)4 * 256 * 128 * 2);
constexpr size_t WS_W2_T = al256(WS_W1_T + (size_t)2 * 64 * 2048 * 2);
constexpr size_t WS_SUBK = al256(WS_W2_T + (size_t)2 * 64 * 64 * 2);
constexpr size_t WS_ZB = al256(WS_SUBK + (size_t)2 * 128 * 128 * 2);
constexpr size_t WS_VTS = al256(WS_ZB + (size_t)MP * IN_DIM * 2);
constexpr size_t WS_VTW = al256(WS_VTS + (size_t)16 * 2 * 64 * 2048 * 2);
constexpr size_t WS_KCB = al256(WS_VTW + (size_t)16 * 2 * 64 * 2048 * 2);
constexpr size_t WS_VTC = al256(WS_KCB + (size_t)16 * 2 * 128 * 64 * 2);
constexpr size_t WS_NOUTF = al256(WS_VTC + (size_t)16 * 2 * 64 * 128 * 2);
constexpr size_t WS_END = al256(WS_NOUTF + (size_t)NP * 512 * 4);

constexpr int LDS_BYTES = 73728;
constexpr int NTHREADS = 256;

struct Params {
    const float* x_prompt; const float* x_sample; const float* cache_cmp; const float* cache_slc; const int* page_table;
    const float* state_win; const float* state_C; const float* state_n; const float* state_m; const float* state_conv;
    const float* w_in; const float* conv_w; const float* conv_b; const float* wq; const float* wk; const float* gate_bias; const float* norm_g;
    const float* cmp_pe; const float* cmp_w1; const float* cmp_w2; const float* rel_bias; const float* w_up_m; const float* w_up_n; const float* w_out;
    const float* ln1_g; const float* ln1_b; const float* ln2_g; const float* ln2_b; const float* peer_wq; const float* peer_sub; const float* peer_u; const float* peer_v;
    float* out; unsigned char* ws;
};

#define XB_TMO      128
#define XB_XCNT(j)  (256  + 64 * (j))
#define XB_XSUB(j)  (1280 + 64 * (j))
#define XB_XGEN(j)  (2304 + 64 * (j))
#define XB_TOP      3328
#define XB_TOPGEN   3392
#define XCD_BAR_WORDS 3456
#define XB_SPIN_CAP (1u << 22)
#define LAS __attribute__((address_space(3)))

__device__ __forceinline__ unsigned xb_ld(unsigned* p)              { return __hip_atomic_load(p, __ATOMIC_RELAXED, __HIP_MEMORY_SCOPE_AGENT); }
__device__ __forceinline__ unsigned xb_add(unsigned* p, unsigned v) { return __hip_atomic_fetch_add(p, v, __ATOMIC_RELAXED, __HIP_MEMORY_SCOPE_AGENT); }
__device__ __forceinline__ unsigned xb_xcc_id() { return (unsigned)__builtin_amdgcn_s_getreg((3 << 11) | 20) & 0xFu; }
#define XB_SPIN(cond, bar) do { unsigned _sp = 0; while (cond) { __builtin_amdgcn_s_sleep(1); \
    if ((++_sp & 255u) == 0u) { if (xb_ld(&(bar)[XB_TMO])) break; if (_sp > XB_SPIN_CAP) { atomicAdd(&(bar)[XB_TMO], 1u); break; } } } } while (0)

struct XcdBarrier { unsigned* bar; unsigned x; volatile LAS unsigned* st; };

__device__ __forceinline__ XcdBarrier xcd_barrier_post(unsigned* bar, volatile LAS unsigned* st) {
    XcdBarrier b; b.bar = bar; b.x = xb_xcc_id(); b.st = st;
    if (threadIdx.x == 0) (void)xb_add(&bar[XB_XCNT(b.x)], 1u);
    return b;
}
__device__ __forceinline__ void xcd_barrier_complete(unsigned* bar, unsigned x, unsigned& nloc, unsigned& nx) {
    const unsigned G = gridDim.x * gridDim.y * gridDim.z;
    unsigned sum, cnt, mine, sp = 0u;
    for (;;) {
        sum = 0u; cnt = 0u; mine = 0u;
#pragma unroll
        for (unsigned j = 0; j < 16; ++j) { const unsigned c = xb_ld(&bar[XB_XCNT(j)]); sum += c; cnt += (c > 0u) ? 1u : 0u; mine = (j == x) ? c : mine; }
        if (sum == G) break;
        __builtin_amdgcn_s_sleep(1);
        if ((++sp & 255u) == 0u) { if (xb_ld(&bar[XB_TMO])) break; if (sp > XB_SPIN_CAP) { atomicAdd(&bar[XB_TMO], 1u); break; } }
    }
    nloc = mine > 0u ? mine : 1u; nx = cnt > 0u ? cnt : 1u;
}
__device__ __forceinline__ void xcd_barrier(const XcdBarrier& b) {
    asm volatile("s_waitcnt vmcnt(0)" ::: "memory");
    __syncthreads();
    if (threadIdx.x == 0) {
        unsigned* bar = b.bar;
        __builtin_amdgcn_s_waitcnt(0);
        unsigned nloc = b.st[0], nx = b.st[1];
        if (nloc == 0u) { xcd_barrier_complete(bar, b.x, nloc, nx); b.st[0] = nloc; b.st[1] = nx; }
        const unsigned old = xb_add(&bar[XB_XSUB(b.x)], 1u);
        const unsigned gen = old / nloc;
        if (old + 1u == (gen + 1u) * nloc) {
            __builtin_amdgcn_fence(__ATOMIC_RELEASE, "agent");
            asm volatile("s_waitcnt vmcnt(0)" ::: "memory");
            const unsigned og = xb_add(&bar[XB_TOP], 1u);
            const unsigned tg = og / nx;
            if (og + 1u == (tg + 1u) * nx) xb_add(&bar[XB_TOPGEN], 1u);
            else XB_SPIN(xb_ld(&bar[XB_TOPGEN]) == tg, bar);
            __builtin_amdgcn_fence(__ATOMIC_ACQUIRE, "agent");
            xb_add(&bar[XB_XGEN(b.x)], 1u);
            asm volatile("s_waitcnt vmcnt(0)" ::: "memory");
        } else {
            XB_SPIN(xb_ld(&bar[XB_XGEN(b.x)]) == gen, bar);
            __builtin_amdgcn_fence(__ATOMIC_ACQUIRE, "agent");
            asm volatile("s_waitcnt vmcnt(0)" ::: "memory");
        }
    }
    __syncthreads();
}

typedef float f32x4 __attribute__((ext_vector_type(4)));

__device__ const unsigned char REL_LUT[128] = {
    0, 1, 2, 3, 4, 5, 6, 7, 8, 9, 10, 11, 12, 13, 14, 15, 16, 16, 16, 17, 17, 18, 18, 18, 19, 19, 19, 20, 20, 20, 20, 21, 21, 21, 21, 22, 22, 22, 22, 22,
    23, 23, 23, 23, 23, 23, 24, 24, 24, 24, 24, 24, 25, 25, 25, 25, 25, 25, 25, 26, 26, 26, 26, 26, 26, 26, 26, 27, 27, 27, 27, 27, 27, 27, 27, 27, 27,
    28, 28, 28, 28, 28, 28, 28, 28, 28, 28, 29, 29, 29, 29, 29, 29, 29, 29, 29, 29, 29, 29, 30, 30, 30, 30, 30, 30, 30, 30, 30, 30, 30, 30, 30, 30,
    31, 31, 31, 31, 31, 31, 31, 31, 31, 31, 31, 31, 31, 31, 31};
DEV int rel_bucket(int n) { return n < 128 ? (int)REL_LUT[n < 0 ? 0 : n] : 31; }

DEV float sigmoidf_(float x) { return 1.0f / (1.0f + expf(-x)); }
DEV float gelu_tanh(float x) { return 0.5f * x * (1.0f + tanhf(0.7978845608028654f * (x + 0.044715f * x * x * x))); }
DEV float log_sigmoid(float x) { return x >= 0.f ? -log1pf(expf(-x)) : x - log1pf(expf(x)); }
DEV void wave_sync() { asm volatile("s_waitcnt lgkmcnt(0)" ::: "memory"); __builtin_amdgcn_wave_barrier(); asm volatile("" ::: "memory"); }
DEV float wave_sum(float v) {
#pragma unroll
    for (int o = 32; o >= 1; o >>= 1) v += __shfl_xor(v, o);
    return v;
}
DEV float wave_max(float v) {
#pragma unroll
    for (int o = 32; o >= 1; o >>= 1) v = fmaxf(v, __shfl_xor(v, o));
    return v;
}

typedef unsigned short bf16_t;
typedef short bf16x8 __attribute__((ext_vector_type(8)));
DEV unsigned cvt_pk_bf16(float lo, float hi) { unsigned r; asm volatile("v_cvt_pk_bf16_f32 %0, %1, %2" : "=v"(r) : "v"(lo), "v"(hi)); return r; }
DEV float bf_lo(unsigned w) { return __uint_as_float(w << 16); }
DEV float bf_hi(unsigned w) { return __uint_as_float(w & 0xffff0000u); }
DEV uint4 pack8(const float* f) { uint4 r; r.x = cvt_pk_bf16(f[0], f[1]); r.y = cvt_pk_bf16(f[2], f[3]); r.z = cvt_pk_bf16(f[4], f[5]); r.w = cvt_pk_bf16(f[6], f[7]); return r; }
DEV void store_bf16x4(bf16_t* p, f32x4 v) { uint2 w; w.x = cvt_pk_bf16(v[0], v[1]); w.y = cvt_pk_bf16(v[2], v[3]); *(uint2*)p = w; }

DEV void transpose_to_bf16(const float* __restrict__ src, const int K, const int N, bf16_t* __restrict__ dst, const size_t gt, const size_t nt) {
    const size_t items = (size_t)N * (K >> 3);
    for (size_t id = gt; id < items; id += nt) {
        const int n = (int)(id % N), k8 = (int)(id / N) * 8;
        float f[8];
#pragma unroll
        for (int i = 0; i < 8; ++i) f[i] = src[(size_t)(k8 + i) * N + n];
        *(uint4*)(dst + (size_t)n * K + k8) = pack8(f);
    }
}

template <int BN, class LA, class LB, class EF>
DEV void gemm_bf16(const int M, const int N, const int K, LA la, LB lb, EF ef, unsigned char* lds) {
    constexpr int TJ = BN / 32;
    constexpr int NB = BN / 32;
    constexpr int LDR = 144;
    const int tid = threadIdx.x, lane = tid & 63, w = tid >> 6, wm = w >> 1, wn = w & 1;
    const int tm = (M + 127) >> 7, tn = (N + BN - 1) / BN;
    unsigned char* As = lds;
    unsigned char* Bs = lds + 128 * LDR;
    const int lr = lane & 15, lq = lane >> 4;
    for (int tile = blockIdx.x; tile < tm * tn; tile += gridDim.x) {
        const int bm = (tile / tn) * 128, bn = (tile % tn) * BN;
        f32x4 acc[4][TJ];
#pragma unroll
        for (int i = 0; i < 4; ++i)
#pragma unroll
            for (int j = 0; j < TJ; ++j) acc[i][j] = (f32x4){0.f, 0.f, 0.f, 0.f};
        uint4 ra[4], rb[NB];
        int arow[4], brow[NB];
#pragma unroll
        for (int i = 0; i < 4; ++i) { const int r = bm + ((tid + 256 * i) >> 3); arow[i] = r < M ? r : M - 1; }
#pragma unroll
        for (int i = 0; i < NB; ++i) { const int n = bn + ((tid + 256 * i) >> 3); brow[i] = n < N ? n : N - 1; }
        const int kc = (tid & 7) * 8;
#pragma unroll
        for (int i = 0; i < 4; ++i) ra[i] = la(arow[i], kc);
#pragma unroll
        for (int i = 0; i < NB; ++i) rb[i] = lb(brow[i], kc);
        for (int k0_ = 0; k0_ < K; k0_ += 64) {
            int k0 = k0_; asm volatile("" : "+v"(k0));
            __syncthreads();
#pragma unroll
            for (int i = 0; i < 4; ++i) *(uint4*)(As + ((tid + 256 * i) >> 3) * LDR + (tid & 7) * 16) = ra[i];
#pragma unroll
            for (int i = 0; i < NB; ++i) *(uint4*)(Bs + ((tid + 256 * i) >> 3) * LDR + (tid & 7) * 16) = rb[i];
            __syncthreads();
            if (k0_ + 64 < K) {
#pragma unroll
                for (int i = 0; i < 4; ++i) ra[i] = la(arow[i], k0 + 64 + kc);
#pragma unroll
                for (int i = 0; i < NB; ++i) rb[i] = lb(brow[i], k0 + 64 + kc);
            }
#pragma unroll
            for (int kk = 0; kk < 2; ++kk) {
                bf16x8 a[4], b[TJ];
#pragma unroll
                for (int i = 0; i < 4; ++i) a[i] = *(const bf16x8*)(As + (wm * 64 + i * 16 + lr) * LDR + kk * 64 + lq * 16);
#pragma unroll
                for (int j = 0; j < TJ; ++j) b[j] = *(const bf16x8*)(Bs + (wn * (BN / 2) + j * 16 + lr) * LDR + kk * 64 + lq * 16);
#pragma unroll
                for (int i = 0; i < 4; ++i)
#pragma unroll
                    for (int j = 0; j < TJ; ++j) acc[i][j] = __builtin_amdgcn_mfma_f32_16x16x32_bf16(b[j], a[i], acc[i][j], 0, 0, 0);
            }
        }
#pragma unroll
        for (int i = 0; i < 4; ++i)
#pragma unroll
            for (int j = 0; j < TJ; ++j) {
                const int r = bm + wm * 64 + i * 16 + lr, c0 = bn + wn * (BN / 2) + j * 16 + lq * 4;
                if (r < M && c0 < N) ef(r, c0, acc[i][j]);
            }
    }
}

template <class KeyF>
DEV void wave_attn(const float* qs, float* sb, const int nkeys, KeyF keyf, const float* __restrict__ rel_bias, const int hkv, const int lane, float (&o)[4]) {
    float mx[4] = {NEGF, NEGF, NEGF, NEGF};
    for (int base = 0; base < nkeys; base += 64) {
        asm volatile("" ::: "memory");
        const int idx = base + lane;
        const float* kp = nullptr; const float* vp = nullptr; int dist = 0;
        bool valid = false;
        if (idx < nkeys) valid = keyf(idx, kp, vp, dist);
        float sc[4] = {0.f, 0.f, 0.f, 0.f};
        if (valid) {
#pragma unroll 1
            for (int d4 = 0; d4 < 16; ++d4) {
                asm volatile("" ::: "memory");
                const float4 kv = ((const float4*)kp)[d4];
#pragma unroll
                for (int g = 0; g < 4; ++g) {
                    const float4 qv = *(const float4*)(qs + g * 64 + d4 * 4);
                    sc[g] += qv.x * kv.x + qv.y * kv.y + qv.z * kv.z + qv.w * kv.w;
                }
            }
            const int bk = rel_bucket(dist);
#pragma unroll
            for (int g = 0; g < 4; ++g) sc[g] += rel_bias[bk * 8 + hkv * 4 + g];
        }
#pragma unroll
        for (int g = 0; g < 4; ++g) {
            const float v = valid ? sc[g] : NEGF;
            if (idx < nkeys) sb[g * 1024 + idx] = v;
            mx[g] = fmaxf(mx[g], v);
        }
    }
    float inv[4];
#pragma unroll
    for (int g = 0; g < 4; ++g) mx[g] = wave_max(mx[g]);
    wave_sync();
    float sum[4] = {0.f, 0.f, 0.f, 0.f};
    for (int idx = lane; idx < nkeys; idx += 64) {
#pragma unroll
        for (int g = 0; g < 4; ++g) {
            const float v = sb[g * 1024 + idx];
            const float e = (v > -1e29f) ? expf(v - mx[g]) : 0.f;
            sb[g * 1024 + idx] = e;
            sum[g] += e;
        }
    }
#pragma unroll
    for (int g = 0; g < 4; ++g) { sum[g] = wave_sum(sum[g]); inv[g] = 1.0f / fmaxf(sum[g], 1e-30f); }
    for (int idx = lane; idx < nkeys; idx += 64) {
#pragma unroll
        for (int g = 0; g < 4; ++g) sb[g * 1024 + idx] *= inv[g];
    }
    wave_sync();
#pragma unroll
    for (int g = 0; g < 4; ++g) o[g] = 0.f;
    for (int idx = 0; idx < nkeys; ++idx) {
        const float p0 = sb[idx], p1 = sb[1024 + idx], p2 = sb[2048 + idx], p3 = sb[3072 + idx];
        if (p0 + p1 + p2 + p3 == 0.f) continue;
        const float* kp = nullptr; const float* vp = nullptr; int dist = 0;
        (void)keyf(idx, kp, vp, dist);
        const float vv = vp[lane];
        o[0] += p0 * vv; o[1] += p1 * vv; o[2] += p2 * vv; o[3] += p3 * vv;
    }
}

DEV void nsa_item(const Params& p, const int row, const int hkv, float* wl, const int lane) {
    float* qs = wl; float* sb = wl + 256; int* sel = (int*)(wl + 256 + 4096);
    const float* Z = (const float*)(p.ws + WS_Z);
    bf16_t* NOUT = (bf16_t*)(p.ws + WS_NOUTB);
    const float* KCP = (const float*)(p.ws + WS_KCP);
    const float* KCS = (const float*)(p.ws + WS_KCS);
    const bool pr = row < NP;
    const int b = pr ? (row >> 11) : (row - NP);
    const int t = pr ? (row & 2047) : 0;
    const int qpos = pr ? t : PAST;
    const float* zrow = Z + (size_t)row * IN_DIM;
    wave_sync();
    for (int i = lane; i < 256; i += 64) qs[i] = zrow[C_Q + hkv * 256 + i] * 0.125f;
    wave_sync();
    float o[4];
    float gate[3][4];
#pragma unroll
    for (int br = 0; br < 3; ++br)
#pragma unroll
        for (int g = 0; g < 4; ++g) gate[br][g] = sigmoidf_(zrow[C_G + br * 8 + hkv * 4 + g]);
    bf16_t* nrow = NOUT + (size_t)row * 512 + hkv * 256;
    float res[4];
    const int nkc = pr ? 127 : 1023;
    {
        const float* kbase = pr ? (KCP + ((size_t)(b * 128) * 2 + hkv) * 64) : (KCS + ((size_t)(b * 1024) * 2 + hkv) * 64);
        const size_t plane = pr ? (size_t)4096 * 64 : (size_t)65536 * 64;
        auto keyf = [&](int idx, const float*& kp, const float*& vp, int& dist) -> bool {
            kp = kbase + (size_t)idx * 128; vp = kp + plane; dist = qpos - (16 * idx + 31); return dist >= 0; };
        wave_attn(qs, sb, nkc, keyf, p.rel_bias, hkv, lane, o);
#pragma unroll
        for (int g = 0; g < 4; ++g) res[g] = gate[0][g] * o[g];
    }
    const int nblk = pr ? 32 : 257;
    for (int i = lane; i < nkc; i += 64) sb[i] = ((sb[i] + sb[1024 + i]) + sb[2048 + i]) + sb[3072 + i];
    wave_sync();
    {
        const int cur = qpos >> 6;
        for (int blk = lane; blk < nblk; blk += 64) {
            float s = 0.f;
#pragma unroll
            for (int cc = 0; cc < 4; ++cc) {
                const int c = 4 * blk + cc;
                const float a0 = (c < nkc) ? sb[c] : 0.f;
                const float a1 = (c >= 1 && c - 1 < nkc) ? sb[c - 1] : 0.f;
                s += a0 + a1;
            }
            const bool causal = blk * 64 <= qpos;
            const bool forced = (blk == 0) || (blk == cur) || (blk == cur - 1);
            sb[1024 + blk] = causal ? (forced ? 1e4f : s) : NEGF;
        }
        wave_sync();
        for (int blk = lane; blk < nblk; blk += 64) {
            const float my = sb[1024 + blk];
            int rank = 0;
            for (int j = 0; j < nblk; ++j) { const float o2 = sb[1024 + j]; rank += ((o2 > my) || (o2 == my && j < blk)) ? 1 : 0; }
            if (rank < 16) sel[rank] = (blk * 64 <= qpos) ? blk : -1;
        }
        wave_sync();
    }
    {
        const float* zb = Z + (size_t)(pr ? b * 2048 : 0) * IN_DIM;
        auto keyf = [&](int idx, const float*& kp, const float*& vp, int& dist) -> bool {
            const int blk = sel[idx >> 6], s = idx & 63;
            if (blk < 0) return false;
            const int kpos = blk * 64 + s;
            if (kpos > qpos) return false;
            dist = qpos - kpos;
            if (pr) { kp = zb + (size_t)kpos * IN_DIM + C_KS + hkv * 64; }
            else if (blk < 256) { const int page = p.page_table[b * 128 + (blk >> 1)]; kp = p.cache_slc + ((size_t)page * 128 + (blk & 1) * 64 + s) * 256 + hkv * 64; }
            else { kp = zrow + C_KS + hkv * 64; }
            vp = kp + 128; return true; };
        wave_attn(qs, sb, 1024, keyf, p.rel_bias, hkv, lane, o);
#pragma unroll
        for (int g = 0; g < 4; ++g) res[g] += gate[1][g] * o[g];
    }
    {
        const float* zb = Z + (size_t)(pr ? b * 2048 : 0) * IN_DIM;
        const int nk = pr ? ((t + 1 < 512) ? t + 1 : 512) : 512;
        auto keyf = [&](int idx, const float*& kp, const float*& vp, int& dist) -> bool {
            if (pr) { const int kpos = t - nk + 1 + idx; dist = t - kpos; kp = zb + (size_t)kpos * IN_DIM + C_KW + hkv * 64; }
            else { const int j = idx + 1; dist = 512 - j; kp = (j < 512) ? (p.state_win + ((size_t)b * 512 + j) * 256 + hkv * 64) : (zrow + C_KW + hkv * 64); }
            vp = kp + 128; return true; };
        wave_attn(qs, sb, nk, keyf, p.rel_bias, hkv, lane, o);
#pragma unroll
        for (int g = 0; g < 4; ++g) res[g] += gate[2][g] * o[g];
    }
#pragma unroll
    for (int g = 0; g < 4; ++g) nrow[g * 64 + lane] = (bf16_t)(cvt_pk_bf16(res[g], 0.f) & 0xffffu);
}

DEV void mlstm_scan_item(const Params& p, const int item, float* lds) {
    const int tid = threadIdx.x, v = tid >> 1, kh = tid & 1;
    const int seq = item >> 2, h = item & 3;
    const bool pr = seq < 16; const int b = pr ? seq : seq - 16;
    const int T = pr ? 2048 : 1; const int row0 = pr ? b * 2048 : NP + b;
    const float* Z = (const float*)(p.ws + WS_Z);
    const float* QK = (const float*)(p.ws + WS_QK);
    float* HRAW = (float*)(p.ws + WS_HRAW);
    float C[64], n[64]; float m;
    if (pr) {
#pragma unroll
        for (int j = 0; j < 64; ++j) { C[j] = 0.f; n[j] = 0.f; }
        m = 0.f;
    } else {
        const float* c0 = p.state_C + (((size_t)(b * 4 + h) * 128 + v) * 128 + kh * 64);
        const float* n0 = p.state_n + ((size_t)(b * 4 + h) * 128 + kh * 64);
#pragma unroll
        for (int j = 0; j < 64; ++j) { C[j] = c0[j]; n[j] = n0[j]; }
        m = p.state_m[b * 4 + h];
    }
    const float gb_i = p.gate_bias[h], gb_f = p.gate_bias[4 + h];
    auto load_tok = [&](int t, float* dst) {
        const size_t r = (size_t)(row0 + t);
        dst[tid] = QK[r * 1024 + h * 256 + tid];
        if (tid < 128) dst[256 + tid] = Z[r * IN_DIM + C_V + h * 128 + tid];
        if (tid == 128) dst[384] = Z[r * IN_DIM + C_I + h] + gb_i;
        if (tid == 129) dst[385] = log_sigmoid(Z[r * IN_DIM + C_F + h] + gb_f);
    };
    __syncthreads();
    load_tok(0, lds);
    __syncthreads();
    for (int t = 0; t < T; ++t) {
        const float* cur = lds + (t & 1) * 388;
        if (t + 1 < T) load_tok(t + 1, lds + ((t + 1) & 1) * 388);
        const float ig = cur[384], lf = cur[385];
        const float mn = fmaxf(lf + m, ig);
        const float fd = expf(lf + m - mn), iw = expf(ig - mn);
        const float vv = cur[256 + v] * iw;
        float nump = 0.f, denp = 0.f;
#pragma unroll
        for (int j = 0; j < 64; ++j) {
            const float kj = cur[128 + kh * 64 + j], qj = cur[kh * 64 + j];
            C[j] = fd * C[j] + vv * kj; n[j] = fd * n[j] + iw * kj;
            nump += C[j] * qj; denp += n[j] * qj;
        }
        nump += __shfl_xor(nump, 1); denp += __shfl_xor(denp, 1);
        const float hval = nump / fmaxf(fabsf(denp), expf(-mn));
        if (kh == 0) HRAW[(size_t)(row0 + t) * 512 + h * 128 + v] = hval;
        m = mn;
        __syncthreads();
    }
    float* co = p.out + (pr ? O_CP : O_CS) + (((size_t)(b * 4 + h) * 128 + v) * 128 + kh * 64);
#pragma unroll
    for (int j = 0; j < 64; ++j) co[j] = C[j];
    if (v == 0) {
        float* no = p.out + (pr ? O_NP : O_NS) + ((size_t)(b * 4 + h) * 128 + kh * 64);
#pragma unroll
        for (int j = 0; j < 64; ++j) no[j] = n[j];
    }
    if (tid == 0) p.out[(pr ? O_MP : O_MS) + b * 4 + h] = m;
}

DEV void peer_topk_item(const Params& p, const int row, const int h, const int lane) {
    const float* S = (const float*)(p.ws + WS_S) + (size_t)row * 2048 + h * 256;
    int* PIDX = (int*)(p.ws + WS_PIDX); float* PG = (float*)(p.ws + WS_PG);
    float ts[2]; int ti[2];
#pragma unroll
    for (int pp = 0; pp < 2; ++pp) {
        float v0 = S[pp * 128 + lane], v1 = S[pp * 128 + 64 + lane];
        float mys = 0.f; int myi = 0;
        for (int r = 0; r < 16; ++r) {
            float best = fmaxf(v0, v1); int bi = (v0 >= v1) ? lane : lane + 64;
#pragma unroll
            for (int off = 32; off >= 1; off >>= 1) {
                const float ob = __shfl_xor(best, off); const int oi = __shfl_xor(bi, off);
                if (ob > best || (ob == best && oi < bi)) { best = ob; bi = oi; }
            }
            if (lane == r) { mys = best; myi = bi; }
            if (bi == lane) v0 = -INFINITY;
            if (bi == lane + 64) v1 = -INFINITY;
        }
        ts[pp] = mys; ti[pp] = myi;
    }
    float cv[4];
#pragma unroll
    for (int jj = 0; jj < 4; ++jj) { const int c = lane * 4 + jj; cv[jj] = __shfl(ts[0], c >> 4) + __shfl(ts[1], c & 15); }
    float msc = 0.f; int mci = 0;
    for (int r = 0; r < 16; ++r) {
        float best = cv[0]; int bi = lane * 4;
#pragma unroll
        for (int jj = 1; jj < 4; ++jj) if (cv[jj] > best) { best = cv[jj]; bi = lane * 4 + jj; }
#pragma unroll
        for (int off = 32; off >= 1; off >>= 1) {
            const float ob = __shfl_xor(best, off); const int oi = __shfl_xor(bi, off);
            if (ob > best || (ob == best && oi < bi)) { best = ob; bi = oi; }
        }
        if (lane == r) { msc = best; mci = bi; }
#pragma unroll
        for (int jj = 0; jj < 4; ++jj) if (bi == lane * 4 + jj) cv[jj] = -INFINITY;
    }
    const int e = __shfl(ti[0], mci >> 4) * 128 + __shfl(ti[1], mci & 15);
    const float top = __shfl(msc, 0);
    float ex = (lane < 16) ? expf(msc - top) : 0.f;
    const float den = wave_sum(ex);
    if (lane < 16) { PIDX[(size_t)row * 128 + h * 16 + lane] = e; PG[(size_t)row * 128 + h * 16 + lane] = ex / den; }
}

DEV void peer_expert_item(const Params& p, const int row, float* lds) {
    const int tid = threadIdx.x, lane = tid & 63, w = tid >> 6;
    const float* X1 = (const float*)(p.ws + WS_X1) + (size_t)row * 1024;
    const int* PIDX = (const int*)(p.ws + WS_PIDX) + (size_t)row * 128;
    const float* PG = (const float*)(p.ws + WS_PG) + (size_t)row * 128;
    float4 x[4], acc[4];
#pragma unroll
    for (int j = 0; j < 4; ++j) { x[j] = *(const float4*)(X1 + j * 256 + lane * 4); acc[j] = make_float4(0.f, 0.f, 0.f, 0.f); }
    for (int k = 0; k < 32; ++k) {
        const int e = PIDX[w * 32 + k]; const float gk = PG[w * 32 + k];
        const float* ur = p.peer_u + (size_t)e * 1024; const float* vr = p.peer_v + (size_t)e * 1024;
        float d = 0.f;
#pragma unroll
        for (int j = 0; j < 4; ++j) { const float4 u = *(const float4*)(ur + j * 256 + lane * 4); d += u.x * x[j].x + u.y * x[j].y + u.z * x[j].z + u.w * x[j].w; }
        d = wave_sum(d);
        const float coef = gk * gelu_tanh(d);
#pragma unroll
        for (int j = 0; j < 4; ++j) { const float4 vv = *(const float4*)(vr + j * 256 + lane * 4);
            acc[j].x += coef * vv.x; acc[j].y += coef * vv.y; acc[j].z += coef * vv.z; acc[j].w += coef * vv.w; }
    }
    __syncthreads();
#pragma unroll
    for (int j = 0; j < 4; ++j) *(float4*)(lds + w * 1024 + j * 256 + lane * 4) = acc[j];
    __syncthreads();
    float tv[4]; float s = 0.f;
#pragma unroll
    for (int i = 0; i < 4; ++i) { const int c = tid * 4 + i; const float po = (lds[c] + lds[1024 + c]) + (lds[2048 + c] + lds[3072 + c]); tv[i] = DN_ALPHA * X1[c] + po; s += tv[i]; }
    float* red = lds + 4096;
    s = wave_sum(s);
    if (lane == 0) red[w] = s;
    __syncthreads();
    const float mu = (red[0] + red[1] + red[2] + red[3]) * (1.0f / 1024.0f);
    float q = 0.f;
#pragma unroll
    for (int i = 0; i < 4; ++i) { const float d = tv[i] - mu; q += d * d; }
    q = wave_sum(q);
    if (lane == 0) red[8 + w] = q;
    __syncthreads();
    const float var = (red[8] + red[9] + red[10] + red[11]) * (1.0f / 1024.0f);
    const float rstd = 1.0f / sqrtf(var + LN_EPS);
    float* y = p.out + O_Y + (size_t)row * 1024;
#pragma unroll
    for (int i = 0; i < 4; ++i) { const int c = tid * 4 + i; y[c] = (tv[i] - mu) * rstd * p.ln2_g[c] + p.ln2_b[c]; }
}

constexpr float LOG2E = 1.4426950408889634f;
constexpr int QN = 2;
struct AttnState { f32x4 ot[4][QN]; float m[QN]; float l[QN]; };

DEV void attn_block(const unsigned char* Ks, const unsigned char* VTs, const bf16x8 (&Qf)[QN][2], AttnState& A, const int mode, const int dq, const float* blut,
                    const unsigned selbit0, const unsigned selbit1, const bool slc, const int lr, const int lq, const int t0, const int ci0) {
    f32x4 sc[4][QN];
#pragma unroll
    for (int kt = 0; kt < 4; ++kt) {
        const bf16x8 k0 = *(const bf16x8*)(Ks + (kt * 16 + lr) * 144 + lq * 16), k1 = *(const bf16x8*)(Ks + (kt * 16 + lr) * 144 + 64 + lq * 16);
#pragma unroll
        for (int qi = 0; qi < QN; ++qi) {
            f32x4 a = (f32x4){0.f, 0.f, 0.f, 0.f};
            a = __builtin_amdgcn_mfma_f32_16x16x32_bf16(k0, Qf[qi][0], a, 0, 0, 0);
            a = __builtin_amdgcn_mfma_f32_16x16x32_bf16(k1, Qf[qi][1], a, 0, 0, 0);
            sc[kt][qi] = a;
        }
    }
    asm volatile("" ::: "memory");
    if (mode != 0 || slc) {
#pragma unroll
        for (int kt = 0; kt < 4; ++kt)
#pragma unroll
            for (int qi = 0; qi < QN; ++qi)
#pragma unroll
                for (int g = 0; g < 4; ++g) {
                    const int kl = kt * 16 + lq * 4 + g, ql = qi * 16 + lr;
                    float v = sc[kt][qi][g];
                    bool ok = true;
                    if (mode == 1 || mode == 2) { const int di = dq + ql - kl; v += blut[di < 0 ? 0 : di]; }
                    if (mode == 2) ok = kl <= ql + dq;
                    if (mode == 3) ok = kl > ql + dq - 512;
                    if (mode == 4) { const int ci = ci0 + kl, dist = t0 + ql - (16 * ci + 31); ok = (dist >= 0) && (ci < 127); if (dist >= 0 && dist < 192) v += blut[dist]; }
                    if (slc) ok = ok && ((qi == 0 ? selbit0 : selbit1) != 0u);
                    sc[kt][qi][g] = ok ? v : NEGF;
                }
    }
    bf16x8 pf[QN][2];
#pragma unroll
    for (int qi = 0; qi < QN; ++qi) {
        float mb = NEGF;
#pragma unroll
        for (int kt = 0; kt < 4; ++kt) mb = fmaxf(mb, fmaxf(fmaxf(sc[kt][qi][0], sc[kt][qi][1]), fmaxf(sc[kt][qi][2], sc[kt][qi][3])));
        mb = fmaxf(mb, __shfl_xor(mb, 16)); mb = fmaxf(mb, __shfl_xor(mb, 32));
        const float mn = fmaxf(A.m[qi], mb);
        const float alpha = __builtin_amdgcn_exp2f(A.m[qi] - mn);
        A.m[qi] = mn;
        float rs = 0.f;
#pragma unroll
        for (int kt = 0; kt < 4; ++kt)
#pragma unroll
            for (int g = 0; g < 4; ++g) { const float v = sc[kt][qi][g]; const float e = (v > -1e29f) ? __builtin_amdgcn_exp2f(v - mn) : 0.f; sc[kt][qi][g] = e; rs += e; }
        A.l[qi] = A.l[qi] * alpha + rs;
#pragma unroll
        for (int dt = 0; dt < 4; ++dt) A.ot[dt][qi] = A.ot[dt][qi] * alpha;
#pragma unroll
        for (int ks = 0; ks < 2; ++ks) {
            union { bf16x8 v; unsigned u[4]; } pk;
            pk.u[0] = cvt_pk_bf16(sc[2 * ks][qi][0], sc[2 * ks][qi][1]); pk.u[1] = cvt_pk_bf16(sc[2 * ks][qi][2], sc[2 * ks][qi][3]);
            pk.u[2] = cvt_pk_bf16(sc[2 * ks + 1][qi][0], sc[2 * ks + 1][qi][1]); pk.u[3] = cvt_pk_bf16(sc[2 * ks + 1][qi][2], sc[2 * ks + 1][qi][3]);
            pf[qi][ks] = pk.v;
        }
    }
    asm volatile("" ::: "memory");
#pragma unroll
    for (int dt = 0; dt < 4; ++dt)
#pragma unroll
        for (int ks = 0; ks < 2; ++ks) {
            asm volatile("" ::: "memory");
            union { bf16x8 v; uint2 h[2]; } vf;
            vf.h[0] = *(const uint2*)(VTs + (dt * 16 + lr) * 144 + (32 * ks + lq * 4) * 2);
            vf.h[1] = *(const uint2*)(VTs + (dt * 16 + lr) * 144 + (32 * ks + 16 + lq * 4) * 2);
#pragma unroll
            for (int qi = 0; qi < QN; ++qi) A.ot[dt][qi] = __builtin_amdgcn_mfma_f32_16x16x32_bf16(vf.v, pf[qi][ks], A.ot[dt][qi], 0, 0, 0);
        }
}

DEV void nsa_prompt_item(const Params& p, const int b, const int hkv, const int q32, unsigned char* lds) {
    int tid_ = threadIdx.x; asm volatile("" : "+v"(tid_));
    const int tid = tid_, lane = tid & 63, g = tid >> 6, lr = lane & 15, lq = lane >> 4;
    const int hq = hkv * 4 + g, t0 = q32 * 32, kd = t0 >> 6;
    unsigned char* Ks = lds; unsigned char* VTs = lds + 9216;
    float* biasl = (float*)(lds + 18432); float* psl = (float*)(lds + 21504); unsigned* selm = (unsigned*)(lds + 29952); unsigned* misc = (unsigned*)(lds + 30208);
    const bf16_t* ZB = (const bf16_t*)(p.ws + WS_ZB);
    const bf16_t* VTS = (const bf16_t*)(p.ws + WS_VTS) + (size_t)(b * 2 + hkv) * 64 * 2048;
    const bf16_t* VTW = (const bf16_t*)(p.ws + WS_VTW) + (size_t)(b * 2 + hkv) * 64 * 2048;
    const bf16_t* KCB = (const bf16_t*)(p.ws + WS_KCB) + (size_t)(b * 2 + hkv) * 128 * 64;
    const bf16_t* VTC = (const bf16_t*)(p.ws + WS_VTC) + (size_t)(b * 2 + hkv) * 64 * 128;
    const float* Z = (const float*)(p.ws + WS_Z);
    float* NOUTF = (float*)(p.ws + WS_NOUTF);
    bf16_t* NOUTB = (bf16_t*)(p.ws + WS_NOUTB);
    __syncthreads();
    for (int i = tid; i < 4 * 192; i += 256) { const int gg = i / 192, d = i % 192; biasl[i] = (p.rel_bias[rel_bucket(d) * 8 + hkv * 4 + gg] - p.rel_bias[31 * 8 + hkv * 4 + gg]) * LOG2E; }
    for (int i = tid; i < 32 * 33; i += 256) psl[i] = 0.f;
    if (tid < 32) selm[tid] = 0u;
    if (tid == 0) misc[0] = 0u;
    const float* blut = biasl + g * 192;
    bf16x8 Qf[QN][2];
#pragma unroll
    for (int qi = 0; qi < QN; ++qi)
#pragma unroll
        for (int kk = 0; kk < 2; ++kk) Qf[qi][kk] = *(const bf16x8*)(ZB + (size_t)(b * 2048 + t0 + qi * 16 + lr) * IN_DIM + C_Q + hq * 64 + kk * 32 + lq * 8);

    uint4 trk0, trk1, trv0, trv1;
    auto load_tiles = [&](int kind, int kb) __attribute__((always_inline)) {
#pragma unroll
        for (int i = 0; i < 2; ++i) {
            const int id = tid + 256 * i, row = id >> 3, ch = id & 7;
            uint4 rk, rv;
            if (kind == 0) { rk = *(const uint4*)(KCB + (size_t)(kb * 64 + row) * 64 + ch * 8); rv = *(const uint4*)(VTC + (size_t)row * 128 + kb * 64 + ch * 8); }
            else {
                rk = *(const uint4*)(ZB + (size_t)(b * 2048 + kb * 64 + row) * IN_DIM + (kind == 1 ? C_KS : C_KW) + hkv * 64 + ch * 8);
                rv = *(const uint4*)((kind == 1 ? VTS : VTW) + (size_t)row * 2048 + kb * 64 + ch * 8);
            }
            if (i == 0) { trk0 = rk; trv0 = rv; } else { trk1 = rk; trv1 = rv; }
        }
    };
    auto store_tiles = [&]() __attribute__((always_inline)) {
#pragma unroll
        for (int i = 0; i < 2; ++i) { const int id = tid + 256 * i, row = id >> 3, ch = id & 7; *(uint4*)(Ks + row * 144 + ch * 16) = (i == 0 ? trk0 : trk1); *(uint4*)(VTs + row * 144 + ch * 16) = (i == 0 ? trv0 : trv1); }
    };
    auto reset = [&](AttnState& A) __attribute__((always_inline)) {
#pragma unroll
        for (int qi = 0; qi < QN; ++qi) { A.m[qi] = NEGF; A.l[qi] = 0.f;
#pragma unroll
            for (int dt = 0; dt < 4; ++dt) A.ot[dt][qi] = (f32x4){0.f, 0.f, 0.f, 0.f}; }
    };
    auto finish = [&](AttnState& A, int br) __attribute__((always_inline)) {
#pragma unroll
        for (int qi = 0; qi < QN; ++qi) {
            float lt = A.l[qi]; lt += __shfl_xor(lt, 16); lt += __shfl_xor(lt, 32);
            const float sc = (lt > 0.f) ? sigmoidf_(Z[(size_t)(b * 2048 + t0 + qi * 16 + lr) * IN_DIM + C_G + br * 8 + hq]) / lt : 0.f;
            const size_t row = (size_t)(b * 2048 + t0 + qi * 16 + lr);
#pragma unroll
            for (int dt = 0; dt < 4; ++dt) {
                const int col = hq * 64 + dt * 16 + lq * 4;
                f32x4 v = A.ot[dt][qi] * sc;
                if (br > 0) v = v + *(const f32x4*)(NOUTF + row * 512 + col);
                if (br < 2) *(f32x4*)(NOUTF + row * 512 + col) = v; else store_bf16x4(NOUTB + row * 512 + col, v);
            }
        }
    };

    AttnState A;
    const int ncb = ((t0 >> 4) >= 64) ? 2 : 1;
    reset(A);
    load_tiles(0, 0);
    for (int kb = 0; kb < ncb; ++kb) {
        __syncthreads(); store_tiles(); __syncthreads();
        if (kb + 1 < ncb) load_tiles(0, kb + 1);
        attn_block(Ks, VTs, Qf, A, 4, 0, blut, 1u, 1u, false, lr, lq, t0, kb * 64);
    }
    finish(A, 0);
    {
        float linv[QN];
#pragma unroll
        for (int qi = 0; qi < QN; ++qi) { float lt = A.l[qi]; lt += __shfl_xor(lt, 16); lt += __shfl_xor(lt, 32); linv[qi] = (lt > 0.f) ? 1.0f / lt : 0.f; }
        for (int kb = 0; kb < ncb; ++kb) {
            if (ncb > 1) { load_tiles(0, kb); __syncthreads(); store_tiles(); __syncthreads(); }
#pragma unroll
            for (int kt = 0; kt < 4; ++kt) {
                const bf16x8 k0 = *(const bf16x8*)(Ks + (kt * 16 + lr) * 144 + lq * 16), k1 = *(const bf16x8*)(Ks + (kt * 16 + lr) * 144 + 64 + lq * 16);
#pragma unroll
                for (int qi = 0; qi < QN; ++qi) {
                    f32x4 a = (f32x4){0.f, 0.f, 0.f, 0.f};
                    a = __builtin_amdgcn_mfma_f32_16x16x32_bf16(k0, Qf[qi][0], a, 0, 0, 0);
                    a = __builtin_amdgcn_mfma_f32_16x16x32_bf16(k1, Qf[qi][1], a, 0, 0, 0);
                    float pr[4];
#pragma unroll
                    for (int gg = 0; gg < 4; ++gg) {
                        const int ci = kb * 64 + kt * 16 + lq * 4 + gg, ql = qi * 16 + lr, dist = t0 + ql - (16 * ci + 31);
                        float v = a[gg];
                        if (dist >= 0 && dist < 192) v += blut[dist];
                        pr[gg] = (dist >= 0 && ci < 127) ? __builtin_amdgcn_exp2f(v - A.m[qi]) * linv[qi] : 0.f;
                    }
                    const int blk = kb * 16 + kt * 4 + lq, ql = qi * 16 + lr;
                    atomicAdd(&psl[ql * 33 + blk], 2.0f * (pr[0] + pr[1] + pr[2]) + pr[3]);
                    atomicAdd(&psl[ql * 33 + blk + 1], pr[3]);
                }
            }
        }
    }
    __syncthreads();
    {
        const int ql = tid >> 3, part = tid & 7, tq = t0 + ql, cur = tq >> 6;
        float scv[32];
#pragma unroll
        for (int j = 0; j < 32; ++j) {
            const bool causal = j * 64 <= tq, forced = (j == 0) || (j == cur) || (j == cur - 1);
            scv[j] = causal ? (forced ? 1e4f : psl[ql * 33 + j]) : NEGF;
        }
        unsigned mbits = 0u;
#pragma unroll
        for (int jj = 0; jj < 4; ++jj) {
            const int j = part * 4 + jj;
            float my = NEGF;
#pragma unroll
            for (int k = 0; k < 32; ++k) my = (k == j) ? scv[k] : my;
            int rank = 0;
#pragma unroll
            for (int k = 0; k < 32; ++k) rank += ((scv[k] > my) || (scv[k] == my && k < j)) ? 1 : 0;
            if (rank < 16 && j * 64 <= tq) mbits |= (1u << j);
        }
        atomicOr(&selm[ql], mbits);
        atomicOr(&misc[0], mbits);
    }
    __syncthreads();
    const unsigned msk0 = selm[lr], msk1 = selm[16 + lr];
    const unsigned anym = misc[0];
    reset(A);
    {
        int kb = kd;
        load_tiles(1, kb);
        for (;;) {
            __syncthreads(); store_tiles(); __syncthreads();
            int nxt = (kb == kd) ? 0 : kb + 1;
            while (nxt < kd && !((anym >> nxt) & 1u)) ++nxt;
            const bool more = nxt < kd;
            if (more) load_tiles(1, nxt);
            const int mode = (kb == kd) ? 2 : ((kb >= kd - 2) ? 1 : 0);
            attn_block(Ks, VTs, Qf, A, mode, t0 - kb * 64, blut, (msk0 >> kb) & 1u, (msk1 >> kb) & 1u, true, lr, lq, t0, 0);
            if (!more) break;
            kb = nxt;
        }
    }
    finish(A, 1);
    reset(A);
    {
        const int klo = (t0 >= 511) ? ((t0 - 511) >> 6) : 0;
        int kb = kd;
        load_tiles(2, kb);
        for (;;) {
            __syncthreads(); store_tiles(); __syncthreads();
            const bool more = kb > klo;
            if (more) load_tiles(2, kb - 1);
            const int dq = t0 - kb * 64;
            const int mode = (kb == kd) ? 2 : ((kb >= kd - 2) ? 1 : ((dq + 31 >= 512) ? 3 : 0));
            attn_block(Ks, VTs, Qf, A, mode, dq, blut, 1u, 1u, false, lr, lq, t0, 0);
            if (!more) break;
            --kb;
        }
    }
    finish(A, 2);
}

#define Z ((float*)(p.ws + WS_Z))
#define QK ((float*)(p.ws + WS_QK))
#define HRAW ((float*)(p.ws + WS_HRAW))
#define MOUTB ((bf16_t*)(p.ws + WS_MOUTB))
#define NOUTB ((bf16_t*)(p.ws + WS_NOUTB))
#define HIDPB ((bf16_t*)(p.ws + WS_HIDPB))
#define HIDSB ((bf16_t*)(p.ws + WS_HIDSB))
#define KCS ((float*)(p.ws + WS_KCS))
#define MIX ((float*)(p.ws + WS_MIX))
#define MIXB ((bf16_t*)(p.ws + WS_MIXB))
#define T1 ((float*)(p.ws + WS_T1))
#define X1 ((float*)(p.ws + WS_X1))
#define X1B ((bf16_t*)(p.ws + WS_X1B))
#define QPB ((bf16_t*)(p.ws + WS_QPB))
#define S ((float*)(p.ws + WS_S))
#define CONVB ((bf16_t*)(p.ws + WS_CONVB))
#define XB ((bf16_t*)(p.ws + WS_XB))
#define WIN_T ((bf16_t*)(p.ws + WS_WIN_T))
#define WUPM_T ((bf16_t*)(p.ws + WS_WUPM_T))
#define WUPN_T ((bf16_t*)(p.ws + WS_WUPN_T))
#define WOUT_T ((bf16_t*)(p.ws + WS_WOUT_T))
#define PWQ_T ((bf16_t*)(p.ws + WS_PWQ_T))
#define WQK_T ((bf16_t*)(p.ws + WS_WQK_T))
#define W1_T ((bf16_t*)(p.ws + WS_W1_T))
#define W2_T ((bf16_t*)(p.ws + WS_W2_T))
#define SUBK ((bf16_t*)(p.ws + WS_SUBK))
#define ZB ((bf16_t*)(p.ws + WS_ZB))
#define VTS ((bf16_t*)(p.ws + WS_VTS))
#define VTW ((bf16_t*)(p.ws + WS_VTW))
#define KCB ((bf16_t*)(p.ws + WS_KCB))
#define VTC ((bf16_t*)(p.ws + WS_VTC))
__global__ void __launch_bounds__(NTHREADS, 2) fwd_kernel(Params p) {
    extern __shared__ __attribute__((aligned(16))) unsigned char smem[];
    if (threadIdx.x == 0) { *(uint4*)smem = make_uint4(0u, 0u, 0u, 0u); }
    __syncthreads();
    XcdBarrier bar = xcd_barrier_post((unsigned*)(p.ws + WS_BAR), (volatile LAS unsigned*)smem);
    float* lds = (float*)(smem + 16);
    unsigned char* ldsb = smem + 16;
    const int tid = threadIdx.x, lane = tid & 63, w = tid >> 6;
    const int gw = blockIdx.x * 4 + w, nw = gridDim.x * 4;
    const size_t gt = (size_t)blockIdx.x * NTHREADS + tid, nt = (size_t)gridDim.x * NTHREADS;


    {
        for (size_t id = gt; id < (size_t)MP * 128; id += nt) {
            const int row = (int)(id >> 7), k8 = (int)(id & 127) * 8;
            float f[8];
            if (row < NR) {
                const float* s = (row < NP ? p.x_prompt + (size_t)row * 1024 : p.x_sample + (size_t)(row - NP) * 1024) + k8;
                const float4 a = *(const float4*)s, b = *(const float4*)(s + 4);
                f[0] = a.x; f[1] = a.y; f[2] = a.z; f[3] = a.w; f[4] = b.x; f[5] = b.y; f[6] = b.z; f[7] = b.w;
            } else {
#pragma unroll
                for (int i = 0; i < 8; ++i) f[i] = 0.f;
            }
            *(uint4*)(XB + (size_t)row * 1024 + k8) = pack8(f);
        }
        transpose_to_bf16(p.w_in, 1024, IN_DIM, WIN_T, gt, nt);
        transpose_to_bf16(p.w_up_m, 512, 1024, WUPM_T, gt, nt);
        transpose_to_bf16(p.w_up_n, 512, 1024, WUPN_T, gt, nt);
        transpose_to_bf16(p.w_out, 1024, 1024, WOUT_T, gt, nt);
        transpose_to_bf16(p.peer_wq, 1024, 2048, PWQ_T, gt, nt);
        for (int h = 0; h < 4; ++h) {
            transpose_to_bf16(p.wq + (size_t)h * 16384, 128, 128, WQK_T + (size_t)(h * 256) * 128, gt, nt);
            transpose_to_bf16(p.wk + (size_t)h * 16384, 128, 128, WQK_T + (size_t)(h * 256 + 128) * 128, gt, nt);
        }
        for (int c = 0; c < 2; ++c) {
            transpose_to_bf16(p.cmp_w1 + (size_t)c * 2048 * 64, 2048, 64, W1_T + (size_t)c * 64 * 2048, gt, nt);
            transpose_to_bf16(p.cmp_w2 + (size_t)c * 4096, 64, 64, W2_T + (size_t)c * 4096, gt, nt);
        }
        for (size_t id = gt; id < (size_t)2 * 128 * 128 / 8; id += nt) {
            float f[8];
#pragma unroll
            for (int i = 0; i < 8; ++i) f[i] = p.peer_sub[id * 8 + i];
            *(uint4*)(SUBK + id * 8) = pack8(f);
        }
        for (size_t i = gt; i < (size_t)BS * 511 * 256; i += nt) {
            const int j = (int)(i & 255); const int wv = (int)((i >> 8) % 511); const int b = (int)((i >> 8) / 511);
            p.out[O_WINS + ((size_t)b * 512 + wv) * 256 + j] = p.state_win[((size_t)b * 512 + wv + 1) * 256 + j];
        }
        for (size_t i = gt; i < (size_t)BS * 2 * 512; i += nt) {
            const int ch = (int)(i & 511); const int jj = (int)((i >> 9) & 1); const int b = (int)(i >> 10);
            p.out[O_CVS + ((size_t)b * 3 + jj) * 512 + ch] = p.state_conv[((size_t)b * 3 + jj + 1) * 512 + ch];
        }
    }
    xcd_barrier(bar);

    gemm_bf16<128>(NR, IN_DIM, 1024,
        [&](int r, int k) { return *(const uint4*)(XB + (size_t)r * 1024 + k); },
        [&](int n, int k) { return *(const uint4*)(WIN_T + (size_t)n * 1024 + k); },
        [&](int r, int c0, f32x4 v) {
            *(f32x4*)(Z + (size_t)r * IN_DIM + c0) = v;
            store_bf16x4(ZB + (size_t)r * IN_DIM + c0, (c0 >= C_Q && c0 < C_KC) ? v * (0.125f * LOG2E) : v);
            if (r < NP && ((c0 >= C_KS + 128 && c0 < C_KW) || (c0 >= C_KW + 128 && c0 < C_G))) {
                const bool isw = c0 >= C_KW; const int cc = c0 - (isw ? C_KW : C_KS) - 128;
                bf16_t* vt = (isw ? VTW : VTS) + ((size_t)((r >> 11) * 2) * 64 + cc) * 2048 + (r & 2047);
                const unsigned w0 = cvt_pk_bf16(v[0], v[1]), w1 = cvt_pk_bf16(v[2], v[3]);
                vt[0] = (bf16_t)(w0 & 0xffffu); vt[2048] = (bf16_t)(w0 >> 16); vt[4096] = (bf16_t)(w1 & 0xffffu); vt[6144] = (bf16_t)(w1 >> 16);
            }
            if (c0 >= C_KC && c0 < C_KS) *(f32x4*)(p.out + O_CMPP + (size_t)r * 256 + (c0 - C_KC)) = v;
            else if (c0 >= C_KS && c0 < C_KW) *(f32x4*)(p.out + O_SLCP + (size_t)r * 256 + (c0 - C_KS)) = v;
            else if (c0 >= C_KW && c0 < C_G) {
                if (r < NP) { const int t = r & 2047; if (t >= 1536) *(f32x4*)(p.out + O_WINP + ((size_t)(r >> 11) * 512 + (t - 1536)) * 256 + (c0 - C_KW)) = v; }
                else *(f32x4*)(p.out + O_WINS + ((size_t)(r - NP) * 512 + 511) * 256 + (c0 - C_KW)) = v;
            } else if (c0 < C_V) {
                if (r < NP) { const int t = r & 2047; if (t >= 2045) *(f32x4*)(p.out + O_CVP + ((size_t)(r >> 11) * 3 + (t - 2045)) * 512 + c0) = v; }
                else *(f32x4*)(p.out + O_CVS + ((size_t)(r - NP) * 3 + 2) * 512 + c0) = v;
            }
        }, ldsb);
    xcd_barrier(bar);

    for (size_t i = gt; i < (size_t)NR * 512; i += nt) {
        const int ch = (int)(i & 511); const int r = (int)(i >> 9);
        float a = p.conv_b[ch];
        if (r < NP) {
            const int t = r & 2047;
#pragma unroll
            for (int j = 0; j < 4; ++j) if (t + j - 3 >= 0) a += p.conv_w[j * 512 + ch] * Z[(size_t)(r + j - 3) * IN_DIM + C_U + ch];
        } else {
            const int b = r - NP;
#pragma unroll
            for (int j = 0; j < 3; ++j) a += p.conv_w[j * 512 + ch] * p.state_conv[((size_t)b * 3 + j) * 512 + ch];
            a += p.conv_w[3 * 512 + ch] * Z[(size_t)r * IN_DIM + C_U + ch];
        }
        CONVB[i] = (bf16_t)(cvt_pk_bf16(a / (1.0f + expf(-a)), 0.f) & 0xffffu);
    }
    xcd_barrier(bar);

    for (int h = 0; h < 4; ++h) {
        gemm_bf16<128>(NR, 256, 128,
            [&](int r, int k) { return *(const uint4*)(CONVB + (size_t)r * 512 + h * 128 + k); },
            [&](int n, int k) { return *(const uint4*)(WQK_T + (size_t)(h * 256 + n) * 128 + k); },
            [&](int r, int c0, f32x4 v) { if (c0 >= 128) v = v * 0.08838834764831845f; *(f32x4*)(QK + (size_t)r * 1024 + h * 256 + c0) = v; }, ldsb);
    }
    for (int c = 0; c < 2; ++c) {
        gemm_bf16<64>(4096, 64, 2048,
            [&](int row, int k) {
                const int hh = row & 1, bi = row >> 1, i = bi & 127, b = bi >> 7, j = k >> 6, d0 = k & 63, tok = 16 * i + j;
                const float* pe = p.cmp_pe + (c * 32 + j) * 64 + d0;
                const float4 e0 = *(const float4*)pe, e1 = *(const float4*)(pe + 4);
                float f[8] = {e0.x, e0.y, e0.z, e0.w, e1.x, e1.y, e1.z, e1.w};
                if (tok < 2048) {
                    const float* s = Z + ((size_t)b * 2048 + tok) * IN_DIM + C_KC + c * 128 + hh * 64 + d0;
                    const float4 a0 = *(const float4*)s, a1 = *(const float4*)(s + 4);
                    f[0] += a0.x; f[1] += a0.y; f[2] += a0.z; f[3] += a0.w; f[4] += a1.x; f[5] += a1.y; f[6] += a1.z; f[7] += a1.w;
                }
                return pack8(f); },
            [&](int n, int k) { return *(const uint4*)(W1_T + ((size_t)c * 64 + n) * 2048 + k); },
            [&](int row, int c0, f32x4 v) {
                f32x4 g; g[0] = gelu_tanh(v[0]); g[1] = gelu_tanh(v[1]); g[2] = gelu_tanh(v[2]); g[3] = gelu_tanh(v[3]);
                store_bf16x4(HIDPB + ((size_t)c * 4096 + row) * 64 + c0, g); }, ldsb);
        gemm_bf16<64>(65536, 64, 2048,
            [&](int row, int k) {
                const int hh = row & 1, bi = row >> 1, i = bi & 1023, b = bi >> 10, j = k >> 6, d0 = k & 63, tok = 16 * i + j;
                const float* pe = p.cmp_pe + (c * 32 + j) * 64 + d0;
                const float4 e0 = *(const float4*)pe, e1 = *(const float4*)(pe + 4);
                float f[8] = {e0.x, e0.y, e0.z, e0.w, e1.x, e1.y, e1.z, e1.w};
                if (tok < PAST) {
                    const int page = p.page_table[b * 128 + (tok >> 7)];
                    const float* s = p.cache_cmp + ((size_t)page * 128 + (tok & 127)) * 256 + c * 128 + hh * 64 + d0;
                    const float4 a0 = *(const float4*)s, a1 = *(const float4*)(s + 4);
                    f[0] += a0.x; f[1] += a0.y; f[2] += a0.z; f[3] += a0.w; f[4] += a1.x; f[5] += a1.y; f[6] += a1.z; f[7] += a1.w;
                }
                return pack8(f); },
            [&](int n, int k) { return *(const uint4*)(W1_T + ((size_t)c * 64 + n) * 2048 + k); },
            [&](int row, int c0, f32x4 v) {
                f32x4 g; g[0] = gelu_tanh(v[0]); g[1] = gelu_tanh(v[1]); g[2] = gelu_tanh(v[2]); g[3] = gelu_tanh(v[3]);
                store_bf16x4(HIDSB + ((size_t)c * 65536 + row) * 64 + c0, g); }, ldsb);
    }
    xcd_barrier(bar);

    for (int item = blockIdx.x; item < 192; item += gridDim.x) mlstm_scan_item(p, item, lds);
    for (int c = 0; c < 2; ++c) {
        gemm_bf16<64>(4096, 64, 64,
            [&](int row, int k) { return *(const uint4*)(HIDPB + ((size_t)c * 4096 + row) * 64 + k); },
            [&](int n, int k) { return *(const uint4*)(W2_T + ((size_t)c * 64 + n) * 64 + k); },
            [&](int row, int c0, f32x4 v) {
                const int hh = row & 1, bi = row >> 1, i = bi & 127, b = bi >> 7;
                if (c == 0) store_bf16x4(KCB + ((size_t)(b * 2 + hh) * 128 + i) * 64 + c0, v);
                else { bf16_t* vt = VTC + ((size_t)(b * 2 + hh) * 64 + c0) * 128 + i; const unsigned w0 = cvt_pk_bf16(v[0], v[1]), w1 = cvt_pk_bf16(v[2], v[3]);
                       vt[0] = (bf16_t)(w0 & 0xffffu); vt[128] = (bf16_t)(w0 >> 16); vt[256] = (bf16_t)(w1 & 0xffffu); vt[384] = (bf16_t)(w1 >> 16); } }, ldsb);
        gemm_bf16<64>(65536, 64, 64,
            [&](int row, int k) { return *(const uint4*)(HIDSB + ((size_t)c * 65536 + row) * 64 + k); },
            [&](int n, int k) { return *(const uint4*)(W2_T + ((size_t)c * 64 + n) * 64 + k); },
            [&](int row, int c0, f32x4 v) { *(f32x4*)(KCS + ((size_t)c * 65536 + row) * 64 + c0) = v; }, ldsb);
    }
    xcd_barrier(bar);

    for (int it = gw; it < NR * 4; it += nw) {
        const int row = it >> 2, h = it & 3;
        const float x0 = HRAW[(size_t)row * 512 + h * 128 + lane], x1 = HRAW[(size_t)row * 512 + h * 128 + 64 + lane];
        const float mu = wave_sum(x0 + x1) * (1.0f / 128.0f);
        const float d0 = x0 - mu, d1 = x1 - mu;
        const float var = wave_sum(d0 * d0 + d1 * d1) * (1.0f / 128.0f);
        const float rstd = 1.0f / sqrtf(var + LN_EPS);
        const int c0 = h * 128 + lane, c1 = c0 + 64;
        MOUTB[(size_t)row * 512 + c0] = (bf16_t)(cvt_pk_bf16(sigmoidf_(Z[(size_t)row * IN_DIM + C_O + c0]) * (d0 * rstd * p.norm_g[c0]), 0.f) & 0xffffu);
        MOUTB[(size_t)row * 512 + c1] = (bf16_t)(cvt_pk_bf16(sigmoidf_(Z[(size_t)row * IN_DIM + C_O + c1]) * (d1 * rstd * p.norm_g[c1]), 0.f) & 0xffffu);
    }
    if (blockIdx.x < 16) {
        float* wl = lds + w * 4416;
        const int it = blockIdx.x * 4 + w;
        nsa_item(p, NP + (it >> 1), it & 1, wl, lane);
    }
    for (;;) {
        __syncthreads();
        if (tid == 0) *(volatile int*)(ldsb + 30464) = (int)atomicAdd((unsigned*)(p.ws + WS_BAR) + 2, 1u);
        __syncthreads();
        const int idx = *(volatile int*)(ldsb + 30464);
        if (idx >= 2048) break;
        nsa_prompt_item(p, (idx & 31) >> 1, idx & 1, 63 - (idx >> 5), ldsb);
    }
    xcd_barrier(bar);

    gemm_bf16<128>(NR, 1024, 512,
        [&](int r, int k) { return *(const uint4*)(MOUTB + (size_t)r * 512 + k); },
        [&](int n, int k) { return *(const uint4*)(WUPM_T + (size_t)n * 512 + k); },
        [&](int r, int c0, f32x4 v) {
            const f32x4 g = *(const f32x4*)(Z + (size_t)r * IN_DIM + C_GM + c0);
            f32x4 o; o[0] = sigmoidf_(g[0]) * v[0]; o[1] = sigmoidf_(g[1]) * v[1]; o[2] = sigmoidf_(g[2]) * v[2]; o[3] = sigmoidf_(g[3]) * v[3];
            *(f32x4*)(MIX + (size_t)r * 1024 + c0) = o; }, ldsb);
    gemm_bf16<128>(NR, 1024, 512,
        [&](int r, int k) { return *(const uint4*)(NOUTB + (size_t)r * 512 + k); },
        [&](int n, int k) { return *(const uint4*)(WUPN_T + (size_t)n * 512 + k); },
        [&](int r, int c0, f32x4 v) {
            const f32x4 g = *(const f32x4*)(Z + (size_t)r * IN_DIM + C_GN + c0);
            f32x4 o = *(const f32x4*)(MIX + (size_t)r * 1024 + c0);
            o[0] += sigmoidf_(g[0]) * v[0]; o[1] += sigmoidf_(g[1]) * v[1]; o[2] += sigmoidf_(g[2]) * v[2]; o[3] += sigmoidf_(g[3]) * v[3];
            store_bf16x4(MIXB + (size_t)r * 1024 + c0, o); }, ldsb);
    xcd_barrier(bar);

    gemm_bf16<128>(NR, 1024, 1024,
        [&](int r, int k) { return *(const uint4*)(MIXB + (size_t)r * 1024 + k); },
        [&](int n, int k) { return *(const uint4*)(WOUT_T + (size_t)n * 1024 + k); },
        [&](int r, int c0, f32x4 v) {
            const f32x4 xv = *(const f32x4*)((r < NP ? p.x_prompt + (size_t)r * 1024 : p.x_sample + (size_t)(r - NP) * 1024) + c0);
            *(f32x4*)(T1 + (size_t)r * 1024 + c0) = xv * DN_ALPHA + v; }, ldsb);
    xcd_barrier(bar);

    for (int row = gw; row < NR; row += nw) {
        float tv[16]; float s = 0.f;
#pragma unroll
        for (int j = 0; j < 4; ++j) { const float4 t4 = *(const float4*)(T1 + (size_t)row * 1024 + j * 256 + lane * 4); tv[4 * j] = t4.x; tv[4 * j + 1] = t4.y; tv[4 * j + 2] = t4.z; tv[4 * j + 3] = t4.w; s += (t4.x + t4.y) + (t4.z + t4.w); }
        const float mu = wave_sum(s) * (1.0f / 1024.0f);
        float q = 0.f;
#pragma unroll
        for (int j = 0; j < 16; ++j) { const float d = tv[j] - mu; q += d * d; }
        const float rstd = 1.0f / sqrtf(wave_sum(q) * (1.0f / 1024.0f) + LN_EPS);
#pragma unroll
        for (int j = 0; j < 4; ++j) {
            const int c = j * 256 + lane * 4;
            const float4 g4 = *(const float4*)(p.ln1_g + c), b4 = *(const float4*)(p.ln1_b + c);
            f32x4 o; o[0] = (tv[4 * j] - mu) * rstd * g4.x + b4.x; o[1] = (tv[4 * j + 1] - mu) * rstd * g4.y + b4.y; o[2] = (tv[4 * j + 2] - mu) * rstd * g4.z + b4.z; o[3] = (tv[4 * j + 3] - mu) * rstd * g4.w + b4.w;
            *(f32x4*)(X1 + (size_t)row * 1024 + c) = o;
            store_bf16x4(X1B + (size_t)row * 1024 + c, o);
        }
    }
    xcd_barrier(bar);

    gemm_bf16<128>(NR, 2048, 1024,
        [&](int r, int k) { return *(const uint4*)(X1B + (size_t)r * 1024 + k); },
        [&](int n, int k) { return *(const uint4*)(PWQ_T + (size_t)n * 1024 + k); },
        [&](int r, int c0, f32x4 v) { store_bf16x4(QPB + (size_t)r * 2048 + c0, v); }, ldsb);
    xcd_barrier(bar);

    for (int hp = 0; hp < 16; ++hp) {
        const int pp = hp & 1;
        gemm_bf16<128>(NR, 128, 128,
            [&](int r, int k) { return *(const uint4*)(QPB + (size_t)r * 2048 + hp * 128 + k); },
            [&](int n, int k) { return *(const uint4*)(SUBK + ((size_t)pp * 128 + n) * 128 + k); },
            [&](int r, int c0, f32x4 v) { *(f32x4*)(S + (size_t)r * 2048 + hp * 128 + c0) = v; }, ldsb);
    }
    xcd_barrier(bar);

    for (int it = gw; it < NR * 8; it += nw) peer_topk_item(p, it >> 3, it & 7, lane);
    xcd_barrier(bar);

    for (int row = blockIdx.x; row < NR; row += gridDim.x) peer_expert_item(p, row, lds);
}

extern "C" void kernel_launch(void* const* d_in, const int* in_sizes, int n_in, void* d_out, int out_size, void* d_ws, size_t ws_size, hipStream_t stream) {
    static int grid = 0;
    if (grid == 0) {
        if (n_in != 32 || (size_t)out_size != O_END || ws_size < WS_END) {
            fprintf(stderr, "kernel_launch: unexpected sizes n_in %d out %d ws %zu (need %zu)\n", n_in, out_size, ws_size, (size_t)WS_END); grid = -1; return; }
        int dev = 0, cus = 0, per_cu = 0;
        if (hipGetDevice(&dev) != hipSuccess || hipDeviceGetAttribute(&cus, hipDeviceAttributeMultiprocessorCount, dev) != hipSuccess) { grid = -1; return; }
        if (hipFuncSetAttribute((const void*)fwd_kernel, hipFuncAttributeMaxDynamicSharedMemorySize, LDS_BYTES) != hipSuccess) { fprintf(stderr, "hipFuncSetAttribute failed\n"); grid = -1; return; }
        if (hipOccupancyMaxActiveBlocksPerMultiprocessor(&per_cu, (const void*)fwd_kernel, NTHREADS, LDS_BYTES) != hipSuccess || per_cu < 1) { fprintf(stderr, "occupancy query failed (%d)\n", per_cu); (void)hipGetLastError(); per_cu = 1; }
        if (per_cu > 2) per_cu = 2;
        grid = cus * per_cu;
    }
    if (grid < 0) return;
    (void)hipMemsetAsync((char*)d_ws + WS_BAR, 0, XCD_BAR_WORDS * sizeof(unsigned), stream);
    Params p{};
    p.x_prompt = (const float*)d_in[0]; p.x_sample = (const float*)d_in[1]; p.cache_cmp = (const float*)d_in[2]; p.cache_slc = (const float*)d_in[3];
    p.page_table = (const int*)d_in[4]; p.state_win = (const float*)d_in[5]; p.state_C = (const float*)d_in[6]; p.state_n = (const float*)d_in[7];
    p.state_m = (const float*)d_in[8]; p.state_conv = (const float*)d_in[9]; p.w_in = (const float*)d_in[10]; p.conv_w = (const float*)d_in[11];
    p.conv_b = (const float*)d_in[12]; p.wq = (const float*)d_in[13]; p.wk = (const float*)d_in[14]; p.gate_bias = (const float*)d_in[15];
    p.norm_g = (const float*)d_in[16]; p.cmp_pe = (const float*)d_in[17]; p.cmp_w1 = (const float*)d_in[18]; p.cmp_w2 = (const float*)d_in[19];
    p.rel_bias = (const float*)d_in[20]; p.w_up_m = (const float*)d_in[21]; p.w_up_n = (const float*)d_in[22]; p.w_out = (const float*)d_in[23];
    p.ln1_g = (const float*)d_in[24]; p.ln1_b = (const float*)d_in[25]; p.ln2_g = (const float*)d_in[26]; p.ln2_b = (const float*)d_in[27];
    p.peer_wq = (const float*)d_in[28]; p.peer_sub = (const float*)d_in[29]; p.peer_u = (const float*)d_in[30]; p.peer_v = (const float*)d_in[31];
    p.out = (float*)d_out; p.ws = (unsigned char*)d_ws;
    hipLaunchKernelGGL(fwd_kernel, dim3(grid), dim3(NTHREADS), LDS_BYTES, stream, p);
}
```

```cpp
#include <hip/hip_runtime.h>
#include <stdint.h>
#include <cstdio>

#define DEV __device__ __forceinline__

constexpr int DM = 1024;
constexpr int BP = 16, TP = 2048, BS = 32;
constexpr int NP = BP * TP;
constexpr int NR = NP + BS;
constexpr int MP = 32896;
constexpr int IN_DIM = 4896;
constexpr int C_U = 0, C_V = 512, C_O = 1024, C_I = 1536, C_F = 1540, C_Q = 1544, C_KC = 2056, C_KS = 2312, C_KW = 2568, C_G = 2824, C_GM = 2848, C_GN = 3872;
constexpr int PAST = 16384;
constexpr float NEGF = -1e30f;
constexpr float DN_ALPHA = 1.189207115002721f;
constexpr float LN_EPS = 1e-5f;
constexpr float LOG2E = 1.4426950408889634f;

constexpr size_t O_Y = 0;
constexpr size_t O_CMPP = (size_t)NR * DM;
constexpr size_t O_CMPS = O_CMPP + (size_t)NP * 256;
constexpr size_t O_SLCP = O_CMPS + (size_t)BS * 256;
constexpr size_t O_SLCS = O_SLCP + (size_t)NP * 256;
constexpr size_t O_WINP = O_SLCS + (size_t)BS * 256;
constexpr size_t O_WINS = O_WINP + (size_t)BP * 512 * 256;
constexpr size_t O_CP = O_WINS + (size_t)BS * 512 * 256;
constexpr size_t O_CS = O_CP + (size_t)BP * 4 * 128 * 128;
constexpr size_t O_NP = O_CS + (size_t)BS * 4 * 128 * 128;
constexpr size_t O_NS = O_NP + (size_t)BP * 4 * 128;
constexpr size_t O_MP = O_NS + (size_t)BS * 4 * 128;
constexpr size_t O_MS = O_MP + (size_t)BP * 4;
constexpr size_t O_CVP = O_MS + (size_t)BS * 4;
constexpr size_t O_CVS = O_CVP + (size_t)BP * 3 * 512;
constexpr size_t O_END = O_CVS + (size_t)BS * 3 * 512;
static_assert(O_END == 59916480, "output size");

constexpr size_t al256(size_t x) { return (x + 255) & ~(size_t)255; }
constexpr size_t WS_BAR = 0;
constexpr size_t WS_Z = 16384;
constexpr size_t WS_QK = al256(WS_Z + (size_t)MP * IN_DIM * 4);
constexpr size_t WS_HRAW = al256(WS_QK + (size_t)MP * 1024 * 4);
constexpr size_t WS_MOUTB = al256(WS_HRAW + (size_t)MP * 512 * 4);
constexpr size_t WS_NOUTB = al256(WS_MOUTB + (size_t)MP * 512 * 2);
constexpr size_t WS_HIDPB = al256(WS_NOUTB + (size_t)MP * 512 * 2);
constexpr size_t WS_KCP = al256(WS_HIDPB + (size_t)2 * 4096 * 64 * 2);
constexpr size_t WS_HIDSB = al256(WS_KCP + 256);
constexpr size_t WS_KCS = al256(WS_HIDSB + (size_t)2 * 65536 * 64 * 2);
constexpr size_t WS_MIX = al256(WS_KCS + (size_t)2 * 65536 * 64 * 4);
constexpr size_t WS_MIXB = al256(WS_MIX + (size_t)MP * 1024 * 4);
constexpr size_t WS_T1 = al256(WS_MIXB + (size_t)MP * 1024 * 2);
constexpr size_t WS_X1 = al256(WS_T1 + (size_t)MP * 1024 * 4);
constexpr size_t WS_X1B = al256(WS_X1 + (size_t)MP * 1024 * 4);
constexpr size_t WS_QPB = al256(WS_X1B + (size_t)MP * 1024 * 2);
constexpr size_t WS_S = al256(WS_QPB + (size_t)MP * 2048 * 2);
constexpr size_t WS_PIDX = al256(WS_S + (size_t)MP * 2048 * 4);
constexpr size_t WS_PG = al256(WS_PIDX + (size_t)MP * 128 * 4);
constexpr size_t WS_CONVB = al256(WS_PG + (size_t)MP * 128 * 4);
constexpr size_t WS_XB = al256(WS_CONVB + (size_t)MP * 512 * 2);
constexpr size_t WS_WIN_T = al256(WS_XB + (size_t)MP * 1024 * 2);
constexpr size_t WS_WUPM_T = al256(WS_WIN_T + (size_t)IN_DIM * 1024 * 2);
constexpr size_t WS_WUPN_T = al256(WS_WUPM_T + (size_t)1024 * 512 * 2);
constexpr size_t WS_WOUT_T = al256(WS_WUPN_T + (size_t)1024 * 512 * 2);
constexpr size_t WS_PWQ_T = al256(WS_WOUT_T + (size_t)1024 * 1024 * 2);
constexpr size_t WS_WQK_T = al256(WS_PWQ_T + (size_t)2048 * 1024 * 2);
constexpr size_t WS_W1_T = al256(WS_WQK_T + (size_t)4 * 256 * 128 * 2);
constexpr size_t WS_W2_T = al256(WS_W1_T + (size_t)2 * 64 * 2048 * 2);
constexpr size_t WS_SUBK = al256(WS_W2_T + (size_t)2 * 64 * 64 * 2);
constexpr size_t WS_ZB = al256(WS_SUBK + (size_t)2 * 128 * 128 * 2);
constexpr size_t WS_VTS = al256(WS_ZB + (size_t)MP * IN_DIM * 2);
constexpr size_t WS_VTW = al256(WS_VTS + (size_t)16 * 2 * 64 * 2048 * 2);
constexpr size_t WS_KCB = al256(WS_VTW + (size_t)16 * 2 * 64 * 2048 * 2);
constexpr size_t WS_VTC = al256(WS_KCB + (size_t)16 * 2 * 128 * 64 * 2);
constexpr size_t WS_NOUTF = al256(WS_VTC + (size_t)16 * 2 * 64 * 128 * 2);
constexpr size_t WS_UB = al256(WS_NOUTF + (size_t)NP * 512 * 4);
constexpr size_t WS_VB = al256(WS_UB + (size_t)16384 * 1024 * 2);
constexpr size_t WS_QB = al256(WS_VB + (size_t)16384 * 1024 * 2);
constexpr size_t WS_KB = al256(WS_QB + (size_t)MP * 512 * 2);
constexpr size_t WS_KTB = al256(WS_KB + (size_t)MP * 512 * 2);
constexpr size_t WS_VTM = al256(WS_KTB + (size_t)16 * 512 * 2048 * 2);
constexpr size_t WS_END = al256(WS_VTM + (size_t)16 * 512 * 2048 * 2);

static_assert(WS_END <= 2684354560ull, "workspace too large");
constexpr int LDS_BYTES = 73728;
constexpr int NTHREADS = 256;

struct Params {
    const float* x_prompt; const float* x_sample; const float* cache_cmp; const float* cache_slc; const int* page_table;
    const float* state_win; const float* state_C; const float* state_n; const float* state_m; const float* state_conv;
    const float* w_in; const float* conv_w; const float* conv_b; const float* wq; const float* wk; const float* gate_bias; const float* norm_g;
    const float* cmp_pe; const float* cmp_w1; const float* cmp_w2; const float* rel_bias; const float* w_up_m; const float* w_up_n; const float* w_out;
    const float* ln1_g; const float* ln1_b; const float* ln2_g; const float* ln2_b; const float* peer_wq; const float* peer_sub; const float* peer_u; const float* peer_v;
    float* out; unsigned char* ws;
};

#define XB_TMO      128
#define XB_XCNT(j)  (256  + 64 * (j))
#define XB_XSUB(j)  (1280 + 64 * (j))
#define XB_XGEN(j)  (2304 + 64 * (j))
#define XB_TOP      3328
#define XB_TOPGEN   3392
#define XCD_BAR_WORDS 3456
#define XB_SPIN_CAP (1u << 22)
#define LAS __attribute__((address_space(3)))

__device__ __forceinline__ unsigned xb_ld(unsigned* p)              { return __hip_atomic_load(p, __ATOMIC_RELAXED, __HIP_MEMORY_SCOPE_AGENT); }
__device__ __forceinline__ unsigned xb_add(unsigned* p, unsigned v) { return __hip_atomic_fetch_add(p, v, __ATOMIC_RELAXED, __HIP_MEMORY_SCOPE_AGENT); }
__device__ __forceinline__ unsigned xb_xcc_id() { return (unsigned)__builtin_amdgcn_s_getreg((3 << 11) | 20) & 0xFu; }
#define XB_SPIN(cond, bar) do { unsigned _sp = 0; while (cond) { __builtin_amdgcn_s_sleep(1); \
    if ((++_sp & 255u) == 0u) { if (xb_ld(&(bar)[XB_TMO])) break; if (_sp > XB_SPIN_CAP) { atomicAdd(&(bar)[XB_TMO], 1u); break; } } } } while (0)

struct XcdBarrier { unsigned* bar; unsigned x; volatile LAS unsigned* st; };

__device__ __forceinline__ XcdBarrier xcd_barrier_post(unsigned* bar, volatile LAS unsigned* st) {
    XcdBarrier b; b.bar = bar; b.x = xb_xcc_id(); b.st = st;
    if (threadIdx.x == 0) (void)xb_add(&bar[XB_XCNT(b.x)], 1u);
    return b;
}
__device__ __forceinline__ void xcd_barrier_complete(unsigned* bar, unsigned x, unsigned& nloc, unsigned& nx) {
    const unsigned G = gridDim.x * gridDim.y * gridDim.z;
    unsigned sum, cnt, mine, sp = 0u;
    for (;;) {
        sum = 0u; cnt = 0u; mine = 0u;
#pragma unroll
        for (unsigned j = 0; j < 16; ++j) { const unsigned c = xb_ld(&bar[XB_XCNT(j)]); sum += c; cnt += (c > 0u) ? 1u : 0u; mine = (j == x) ? c : mine; }
        if (sum == G) break;
        __builtin_amdgcn_s_sleep(1);
        if ((++sp & 255u) == 0u) { if (xb_ld(&bar[XB_TMO])) break; if (sp > XB_SPIN_CAP) { atomicAdd(&bar[XB_TMO], 1u); break; } }
    }
    nloc = mine > 0u ? mine : 1u; nx = cnt > 0u ? cnt : 1u;
}
__device__ __forceinline__ void xcd_barrier(const XcdBarrier& b) {
    asm volatile("s_waitcnt vmcnt(0)" ::: "memory");
    __syncthreads();
    if (threadIdx.x == 0) {
        unsigned* bar = b.bar;
        __builtin_amdgcn_s_waitcnt(0);
        unsigned nloc = b.st[0], nx = b.st[1];
        if (nloc == 0u) { xcd_barrier_complete(bar, b.x, nloc, nx); b.st[0] = nloc; b.st[1] = nx; }
        const unsigned old = xb_add(&bar[XB_XSUB(b.x)], 1u);
        const unsigned gen = old / nloc;
        if (old + 1u == (gen + 1u) * nloc) {
            __builtin_amdgcn_fence(__ATOMIC_RELEASE, "agent");
            asm volatile("s_waitcnt vmcnt(0)" ::: "memory");
            const unsigned og = xb_add(&bar[XB_TOP], 1u);
            const unsigned tg = og / nx;
            if (og + 1u == (tg + 1u) * nx) xb_add(&bar[XB_TOPGEN], 1u);
            else XB_SPIN(xb_ld(&bar[XB_TOPGEN]) == tg, bar);
            __builtin_amdgcn_fence(__ATOMIC_ACQUIRE, "agent");
            xb_add(&bar[XB_XGEN(b.x)], 1u);
            asm volatile("s_waitcnt vmcnt(0)" ::: "memory");
        } else {
            XB_SPIN(xb_ld(&bar[XB_XGEN(b.x)]) == gen, bar);
            __builtin_amdgcn_fence(__ATOMIC_ACQUIRE, "agent");
            asm volatile("s_waitcnt vmcnt(0)" ::: "memory");
        }
    }
    __syncthreads();
}

typedef float f32x4 __attribute__((ext_vector_type(4)));

__device__ const unsigned char REL_LUT[128] = {
    0, 1, 2, 3, 4, 5, 6, 7, 8, 9, 10, 11, 12, 13, 14, 15, 16, 16, 16, 17, 17, 18, 18, 18, 19, 19, 19, 20, 20, 20, 20, 21, 21, 21, 21, 22, 22, 22, 22, 22,
    23, 23, 23, 23, 23, 23, 24, 24, 24, 24, 24, 24, 25, 25, 25, 25, 25, 25, 25, 26, 26, 26, 26, 26, 26, 26, 26, 27, 27, 27, 27, 27, 27, 27, 27, 27, 27,
    28, 28, 28, 28, 28, 28, 28, 28, 28, 28, 29, 29, 29, 29, 29, 29, 29, 29, 29, 29, 29, 29, 30, 30, 30, 30, 30, 30, 30, 30, 30, 30, 30, 30, 30, 30,
    31, 31, 31, 31, 31, 31, 31, 31, 31, 31, 31, 31, 31, 31, 31};
DEV int rel_bucket(int n) { return n < 128 ? (int)REL_LUT[n < 0 ? 0 : n] : 31; }

DEV float sigmoidf_(float x) { return 1.0f / (1.0f + expf(-x)); }
DEV float gelu_tanh(float x) { return 0.5f * x * (1.0f + tanhf(0.7978845608028654f * (x + 0.044715f * x * x * x))); }
DEV float log_sigmoid(float x) { return x >= 0.f ? -log1pf(expf(-x)) : x - log1pf(expf(x)); }
DEV void wave_sync() { asm volatile("s_waitcnt lgkmcnt(0)" ::: "memory"); __builtin_amdgcn_wave_barrier(); asm volatile("" ::: "memory"); }
DEV float wave_sum(float v) {
#pragma unroll
    for (int o = 32; o >= 1; o >>= 1) v += __shfl_xor(v, o);
    return v;
}
DEV float wave_max(float v) {
#pragma unroll
    for (int o = 32; o >= 1; o >>= 1) v = fmaxf(v, __shfl_xor(v, o));
    return v;
}

typedef unsigned short bf16_t;
typedef short bf16x8 __attribute__((ext_vector_type(8)));
typedef float f32x2_ __attribute__((ext_vector_type(2)));
typedef __bf16 bf16x2_ __attribute__((ext_vector_type(2)));
DEV unsigned cvt_pk_bf16(float lo, float hi) { const f32x2_ v = {lo, hi}; return __builtin_bit_cast(unsigned, __builtin_convertvector(v, bf16x2_)); }
DEV float bf_lo(unsigned w) { return __uint_as_float(w << 16); }
DEV float bf_hi(unsigned w) { return __uint_as_float(w & 0xffff0000u); }
DEV uint4 pack8(const float* f) { uint4 r; r.x = cvt_pk_bf16(f[0], f[1]); r.y = cvt_pk_bf16(f[2], f[3]); r.z = cvt_pk_bf16(f[4], f[5]); r.w = cvt_pk_bf16(f[6], f[7]); return r; }
DEV void store_bf16x4(bf16_t* p, f32x4 v) { uint2 w; w.x = cvt_pk_bf16(v[0], v[1]); w.y = cvt_pk_bf16(v[2], v[3]); *(uint2*)p = w; }

DEV void transpose_to_bf16(const float* __restrict__ src, const int K, const int N, bf16_t* __restrict__ dst, const size_t gt, const size_t nt) {
    const size_t items = (size_t)N * (K >> 3);
    for (size_t id = gt; id < items; id += nt) {
        const int n = (int)(id % N), k8 = (int)(id / N) * 8;
        float f[8];
#pragma unroll
        for (int i = 0; i < 8; ++i) f[i] = src[(size_t)(k8 + i) * N + n];
        *(uint4*)(dst + (size_t)n * K + k8) = pack8(f);
    }
}

template <int BN, class LA, class LB, class EF>
DEV void gemm_bf16(const int M, const int N, const int K, LA la, LB lb, EF ef, unsigned char* lds) {
    constexpr int TJ = BN / 32;
    constexpr int NB = BN / 32;
    constexpr int LDR = 144;
    const int tid = threadIdx.x, lane = tid & 63, w = tid >> 6, wm = w >> 1, wn = w & 1;
    const int tm = (M + 127) >> 7, tn = (N + BN - 1) / BN;
    unsigned char* As = lds;
    unsigned char* Bs = lds + 128 * LDR;
    const int lr = lane & 15, lq = lane >> 4;
    for (int tile = blockIdx.x; tile < tm * tn; tile += gridDim.x) {
        const int bm = (tile / tn) * 128, bn = (tile % tn) * BN;
        f32x4 acc[4][TJ];
#pragma unroll
        for (int i = 0; i < 4; ++i)
#pragma unroll
            for (int j = 0; j < TJ; ++j) acc[i][j] = (f32x4){0.f, 0.f, 0.f, 0.f};
        uint4 ra[4], rb[NB];
        int arow[4], brow[NB];
#pragma unroll
        for (int i = 0; i < 4; ++i) { const int r = bm + ((tid + 256 * i) >> 3); arow[i] = r < M ? r : M - 1; }
#pragma unroll
        for (int i = 0; i < NB; ++i) { const int n = bn + ((tid + 256 * i) >> 3); brow[i] = n < N ? n : N - 1; }
        const int kc = (tid & 7) * 8;
#pragma unroll
        for (int i = 0; i < 4; ++i) ra[i] = la(arow[i], kc);
#pragma unroll
        for (int i = 0; i < NB; ++i) rb[i] = lb(brow[i], kc);
        for (int k0_ = 0; k0_ < K; k0_ += 64) {
            int k0 = k0_; asm volatile("" : "+v"(k0));
            __syncthreads();
#pragma unroll
            for (int i = 0; i < 4; ++i) *(uint4*)(As + ((tid + 256 * i) >> 3) * LDR + (tid & 7) * 16) = ra[i];
#pragma unroll
            for (int i = 0; i < NB; ++i) *(uint4*)(Bs + ((tid + 256 * i) >> 3) * LDR + (tid & 7) * 16) = rb[i];
            __syncthreads();
            if (k0_ + 64 < K) {
#pragma unroll
                for (int i = 0; i < 4; ++i) ra[i] = la(arow[i], k0 + 64 + kc);
#pragma unroll
                for (int i = 0; i < NB; ++i) rb[i] = lb(brow[i], k0 + 64 + kc);
            }
#pragma unroll
            for (int kk = 0; kk < 2; ++kk) {
                bf16x8 a[4], b[TJ];
#pragma unroll
                for (int i = 0; i < 4; ++i) a[i] = *(const bf16x8*)(As + (wm * 64 + i * 16 + lr) * LDR + kk * 64 + lq * 16);
#pragma unroll
                for (int j = 0; j < TJ; ++j) b[j] = *(const bf16x8*)(Bs + (wn * (BN / 2) + j * 16 + lr) * LDR + kk * 64 + lq * 16);
#pragma unroll
                for (int i = 0; i < 4; ++i)
#pragma unroll
                    for (int j = 0; j < TJ; ++j) acc[i][j] = __builtin_amdgcn_mfma_f32_16x16x32_bf16(b[j], a[i], acc[i][j], 0, 0, 0);
            }
        }
#pragma unroll
        for (int i = 0; i < 4; ++i)
#pragma unroll
            for (int j = 0; j < TJ; ++j) {
                const int r = bm + wm * 64 + i * 16 + lr, c0 = bn + wn * (BN / 2) + j * 16 + lq * 4;
                if (r < M && c0 < N) ef(r, c0, acc[i][j]);
            }
    }
}

template <class KeyF>
DEV void wave_attn(const float* qs, float* sb, const int nkeys, KeyF keyf, const float* __restrict__ rel_bias, const int hkv, const int lane, float (&o)[4]) {
    float mx[4] = {NEGF, NEGF, NEGF, NEGF};
    for (int base = 0; base < nkeys; base += 64) {
        asm volatile("" ::: "memory");
        const int idx = base + lane;
        const float* kp = nullptr; const float* vp = nullptr; int dist = 0;
        bool valid = false;
        if (idx < nkeys) valid = keyf(idx, kp, vp, dist);
        float sc[4] = {0.f, 0.f, 0.f, 0.f};
        if (valid) {
#pragma unroll 1
            for (int d4 = 0; d4 < 16; ++d4) {
                asm volatile("" ::: "memory");
                const float4 kv = ((const float4*)kp)[d4];
#pragma unroll
                for (int g = 0; g < 4; ++g) {
                    const float4 qv = *(const float4*)(qs + g * 64 + d4 * 4);
                    sc[g] += qv.x * kv.x + qv.y * kv.y + qv.z * kv.z + qv.w * kv.w;
                }
            }
            const int bk = rel_bucket(dist);
#pragma unroll
            for (int g = 0; g < 4; ++g) sc[g] += rel_bias[bk * 8 + hkv * 4 + g];
        }
#pragma unroll
        for (int g = 0; g < 4; ++g) {
            const float v = valid ? sc[g] : NEGF;
            if (idx < nkeys) sb[g * 1024 + idx] = v;
            mx[g] = fmaxf(mx[g], v);
        }
    }
    float inv[4];
#pragma unroll
    for (int g = 0; g < 4; ++g) mx[g] = wave_max(mx[g]);
    wave_sync();
    float sum[4] = {0.f, 0.f, 0.f, 0.f};
    for (int idx = lane; idx < nkeys; idx += 64) {
#pragma unroll
        for (int g = 0; g < 4; ++g) {
            const float v = sb[g * 1024 + idx];
            const float e = (v > -1e29f) ? expf(v - mx[g]) : 0.f;
            sb[g * 1024 + idx] = e;
            sum[g] += e;
        }
    }
#pragma unroll
    for (int g = 0; g < 4; ++g) { sum[g] = wave_sum(sum[g]); inv[g] = 1.0f / fmaxf(sum[g], 1e-30f); }
    for (int idx = lane; idx < nkeys; idx += 64) {
#pragma unroll
        for (int g = 0; g < 4; ++g) sb[g * 1024 + idx] *= inv[g];
    }
    wave_sync();
#pragma unroll
    for (int g = 0; g < 4; ++g) o[g] = 0.f;
    for (int idx = 0; idx < nkeys; ++idx) {
        const float p0 = sb[idx], p1 = sb[1024 + idx], p2 = sb[2048 + idx], p3 = sb[3072 + idx];
        if (p0 + p1 + p2 + p3 == 0.f) continue;
        const float* kp = nullptr; const float* vp = nullptr; int dist = 0;
        (void)keyf(idx, kp, vp, dist);
        const float vv = vp[lane];
        o[0] += p0 * vv; o[1] += p1 * vv; o[2] += p2 * vv; o[3] += p3 * vv;
    }
}

DEV void nsa_item(const Params& p, const int row, const int hkv, float* wl, const int lane) {
    float* qs = wl; float* sb = wl + 256; int* sel = (int*)(wl + 256 + 4096);
    const float* Z = (const float*)(p.ws + WS_Z);
    bf16_t* NOUT = (bf16_t*)(p.ws + WS_NOUTB);
    const float* KCP = (const float*)(p.ws + WS_KCP);
    const float* KCS = (const float*)(p.ws + WS_KCS);
    const bool pr = row < NP;
    const int b = pr ? (row >> 11) : (row - NP);
    const int t = pr ? (row & 2047) : 0;
    const int qpos = pr ? t : PAST;
    const float* zrow = Z + (size_t)row * IN_DIM;
    wave_sync();
    for (int i = lane; i < 256; i += 64) qs[i] = zrow[C_Q + hkv * 256 + i] * 0.125f;
    wave_sync();
    float o[4];
    float gate[3][4];
#pragma unroll
    for (int br = 0; br < 3; ++br)
#pragma unroll
        for (int g = 0; g < 4; ++g) gate[br][g] = sigmoidf_(zrow[C_G + br * 8 + hkv * 4 + g]);
    bf16_t* nrow = NOUT + (size_t)row * 512 + hkv * 256;
    float res[4];
    const int nkc = pr ? 127 : 1023;
    {
        const float* kbase = pr ? (KCP + ((size_t)(b * 128) * 2 + hkv) * 64) : (KCS + ((size_t)(b * 1024) * 2 + hkv) * 64);
        const size_t plane = pr ? (size_t)4096 * 64 : (size_t)65536 * 64;
        auto keyf = [&](int idx, const float*& kp, const float*& vp, int& dist) -> bool {
            kp = kbase + (size_t)idx * 128; vp = kp + plane; dist = qpos - (16 * idx + 31); return dist >= 0; };
        wave_attn(qs, sb, nkc, keyf, p.rel_bias, hkv, lane, o);
#pragma unroll
        for (int g = 0; g < 4; ++g) res[g] = gate[0][g] * o[g];
    }
    const int nblk = pr ? 32 : 257;
    for (int i = lane; i < nkc; i += 64) sb[i] = ((sb[i] + sb[1024 + i]) + sb[2048 + i]) + sb[3072 + i];
    wave_sync();
    {
        const int cur = qpos >> 6;
        for (int blk = lane; blk < nblk; blk += 64) {
            float s = 0.f;
#pragma unroll
            for (int cc = 0; cc < 4; ++cc) {
                const int c = 4 * blk + cc;
                const float a0 = (c < nkc) ? sb[c] : 0.f;
                const float a1 = (c >= 1 && c - 1 < nkc) ? sb[c - 1] : 0.f;
                s += a0 + a1;
            }
            const bool causal = blk * 64 <= qpos;
            const bool forced = (blk == 0) || (blk == cur) || (blk == cur - 1);
            sb[1024 + blk] = causal ? (forced ? 1e4f : s) : NEGF;
        }
        wave_sync();
        for (int blk = lane; blk < nblk; blk += 64) {
            const float my = sb[1024 + blk];
            int rank = 0;
            for (int j = 0; j < nblk; ++j) { const float o2 = sb[1024 + j]; rank += ((o2 > my) || (o2 == my && j < blk)) ? 1 : 0; }
            if (rank < 16) sel[rank] = (blk * 64 <= qpos) ? blk : -1;
        }
        wave_sync();
    }
    {
        const float* zb = Z + (size_t)(pr ? b * 2048 : 0) * IN_DIM;
        auto keyf = [&](int idx, const float*& kp, const float*& vp, int& dist) -> bool {
            const int blk = sel[idx >> 6], s = idx & 63;
            if (blk < 0) return false;
            const int kpos = blk * 64 + s;
            if (kpos > qpos) return false;
            dist = qpos - kpos;
            if (pr) { kp = zb + (size_t)kpos * IN_DIM + C_KS + hkv * 64; }
            else if (blk < 256) { const int page = p.page_table[b * 128 + (blk >> 1)]; kp = p.cache_slc + ((size_t)page * 128 + (blk & 1) * 64 + s) * 256 + hkv * 64; }
            else { kp = zrow + C_KS + hkv * 64; }
            vp = kp + 128; return true; };
        wave_attn(qs, sb, 1024, keyf, p.rel_bias, hkv, lane, o);
#pragma unroll
        for (int g = 0; g < 4; ++g) res[g] += gate[1][g] * o[g];
    }
    {
        const float* zb = Z + (size_t)(pr ? b * 2048 : 0) * IN_DIM;
        const int nk = pr ? ((t + 1 < 512) ? t + 1 : 512) : 512;
        auto keyf = [&](int idx, const float*& kp, const float*& vp, int& dist) -> bool {
            if (pr) { const int kpos = t - nk + 1 + idx; dist = t - kpos; kp = zb + (size_t)kpos * IN_DIM + C_KW + hkv * 64; }
            else { const int j = idx + 1; dist = 512 - j; kp = (j < 512) ? (p.state_win + ((size_t)b * 512 + j) * 256 + hkv * 64) : (zrow + C_KW + hkv * 64); }
            vp = kp + 128; return true; };
        wave_attn(qs, sb, nk, keyf, p.rel_bias, hkv, lane, o);
#pragma unroll
        for (int g = 0; g < 4; ++g) res[g] += gate[2][g] * o[g];
    }
#pragma unroll
    for (int g = 0; g < 4; ++g) nrow[g * 64 + lane] = (bf16_t)(cvt_pk_bf16(res[g], 0.f) & 0xffffu);
}

DEV void mlstm_scan_item(const Params& p, const int item, float* lds) {
    const int tid = threadIdx.x, v = tid >> 1, kh = tid & 1;
    const int seq = item >> 2, h = item & 3;
    const bool pr = seq < 16; const int b = pr ? seq : seq - 16;
    const int T = pr ? 2048 : 1; const int row0 = pr ? b * 2048 : NP + b;
    const float* Z = (const float*)(p.ws + WS_Z);
    const float* QK = (const float*)(p.ws + WS_QK);
    float* HRAW = (float*)(p.ws + WS_HRAW);
    float C[64], n[64]; float m;
    if (pr) {
#pragma unroll
        for (int j = 0; j < 64; ++j) { C[j] = 0.f; n[j] = 0.f; }
        m = 0.f;
    } else {
        const float* c0 = p.state_C + (((size_t)(b * 4 + h) * 128 + v) * 128 + kh * 64);
        const float* n0 = p.state_n + ((size_t)(b * 4 + h) * 128 + kh * 64);
#pragma unroll
        for (int j = 0; j < 64; ++j) { C[j] = c0[j]; n[j] = n0[j]; }
        m = p.state_m[b * 4 + h];
    }
    const float gb_i = p.gate_bias[h], gb_f = p.gate_bias[4 + h];
    auto load_tok = [&](int t, float* dst) {
        const size_t r = (size_t)(row0 + t);
        dst[tid] = QK[r * 1024 + h * 256 + tid];
        if (tid < 128) dst[256 + tid] = Z[r * IN_DIM + C_V + h * 128 + tid];
        if (tid == 128) dst[384] = Z[r * IN_DIM + C_I + h] + gb_i;
        if (tid == 129) dst[385] = log_sigmoid(Z[r * IN_DIM + C_F + h] + gb_f);
    };
    __syncthreads();
    load_tok(0, lds);
    __syncthreads();
    for (int t = 0; t < T; ++t) {
        const float* cur = lds + (t & 1) * 388;
        if (t + 1 < T) load_tok(t + 1, lds + ((t + 1) & 1) * 388);
        const float ig = cur[384], lf = cur[385];
        const float mn = fmaxf(lf + m, ig);
        const float fd = expf(lf + m - mn), iw = expf(ig - mn);
        const float vv = cur[256 + v] * iw;
        float nump = 0.f, denp = 0.f;
#pragma unroll
        for (int j = 0; j < 64; ++j) {
            const float kj = cur[128 + kh * 64 + j], qj = cur[kh * 64 + j];
            C[j] = fd * C[j] + vv * kj; n[j] = fd * n[j] + iw * kj;
            nump += C[j] * qj; denp += n[j] * qj;
        }
        nump += __shfl_xor(nump, 1); denp += __shfl_xor(denp, 1);
        const float hval = nump / fmaxf(fabsf(denp), expf(-mn));
        if (kh == 0) HRAW[(size_t)(row0 + t) * 512 + h * 128 + v] = hval;
        m = mn;
        __syncthreads();
    }
    float* co = p.out + (pr ? O_CP : O_CS) + (((size_t)(b * 4 + h) * 128 + v) * 128 + kh * 64);
#pragma unroll
    for (int j = 0; j < 64; ++j) co[j] = C[j];
    if (v == 0) {
        float* no = p.out + (pr ? O_NP : O_NS) + ((size_t)(b * 4 + h) * 128 + kh * 64);
#pragma unroll
        for (int j = 0; j < 64; ++j) no[j] = n[j];
    }
    if (tid == 0) p.out[(pr ? O_MP : O_MS) + b * 4 + h] = m;
}

DEV void peer_topk_item(const Params& p, const int row, const int h, const int lane) {
    const float* S = (const float*)(p.ws + WS_S) + (size_t)row * 2048 + h * 256;
    int* PIDX = (int*)(p.ws + WS_PIDX); float* PG = (float*)(p.ws + WS_PG);
    float ts[2]; int ti[2];
#pragma unroll
    for (int pp = 0; pp < 2; ++pp) {
        float v0 = S[pp * 128 + lane], v1 = S[pp * 128 + 64 + lane];
        float mys = 0.f; int myi = 0;
        for (int r = 0; r < 16; ++r) {
            float best = fmaxf(v0, v1); int bi = (v0 >= v1) ? lane : lane + 64;
#pragma unroll
            for (int off = 32; off >= 1; off >>= 1) {
                const float ob = __shfl_xor(best, off); const int oi = __shfl_xor(bi, off);
                if (ob > best || (ob == best && oi < bi)) { best = ob; bi = oi; }
            }
            if (lane == r) { mys = best; myi = bi; }
            if (bi == lane) v0 = -INFINITY;
            if (bi == lane + 64) v1 = -INFINITY;
        }
        ts[pp] = mys; ti[pp] = myi;
    }
    float cv[4];
#pragma unroll
    for (int jj = 0; jj < 4; ++jj) { const int c = lane * 4 + jj; cv[jj] = __shfl(ts[0], c >> 4) + __shfl(ts[1], c & 15); }
    float msc = 0.f; int mci = 0;
    for (int r = 0; r < 16; ++r) {
        float best = cv[0]; int bi = lane * 4;
#pragma unroll
        for (int jj = 1; jj < 4; ++jj) if (cv[jj] > best) { best = cv[jj]; bi = lane * 4 + jj; }
#pragma unroll
        for (int off = 32; off >= 1; off >>= 1) {
            const float ob = __shfl_xor(best, off); const int oi = __shfl_xor(bi, off);
            if (ob > best || (ob == best && oi < bi)) { best = ob; bi = oi; }
        }
        if (lane == r) { msc = best; mci = bi; }
#pragma unroll
        for (int jj = 0; jj < 4; ++jj) if (bi == lane * 4 + jj) cv[jj] = -INFINITY;
    }
    const int e = __shfl(ti[0], mci >> 4) * 128 + __shfl(ti[1], mci & 15);
    const float top = __shfl(msc, 0);
    float ex = (lane < 16) ? expf(msc - top) : 0.f;
    const float den = wave_sum(ex);
    if (lane < 16) { PIDX[(size_t)row * 128 + h * 16 + lane] = e; PG[(size_t)row * 128 + h * 16 + lane] = ex / den; }
}

DEV void peer_expert_item(const Params& p, const int row, float* lds) {
    const int tid = threadIdx.x, lane = tid & 63, w = tid >> 6;
    const float* X1 = (const float*)(p.ws + WS_X1) + (size_t)row * 1024;
    const int* PIDX = (const int*)(p.ws + WS_PIDX) + (size_t)row * 128;
    const float* PG = (const float*)(p.ws + WS_PG) + (size_t)row * 128;
    float4 x[4], acc[4];
#pragma unroll
    for (int j = 0; j < 4; ++j) { x[j] = *(const float4*)(X1 + j * 256 + lane * 4); acc[j] = make_float4(0.f, 0.f, 0.f, 0.f); }
    for (int k = 0; k < 32; ++k) {
        const int e = PIDX[w * 32 + k]; const float gk = PG[w * 32 + k];
        const float* ur = p.peer_u + (size_t)e * 1024; const float* vr = p.peer_v + (size_t)e * 1024;
        float d = 0.f;
#pragma unroll
        for (int j = 0; j < 4; ++j) { const float4 u = *(const float4*)(ur + j * 256 + lane * 4); d += u.x * x[j].x + u.y * x[j].y + u.z * x[j].z + u.w * x[j].w; }
        d = wave_sum(d);
        const float coef = gk * gelu_tanh(d);
#pragma unroll
        for (int j = 0; j < 4; ++j) { const float4 vv = *(const float4*)(vr + j * 256 + lane * 4);
            acc[j].x += coef * vv.x; acc[j].y += coef * vv.y; acc[j].z += coef * vv.z; acc[j].w += coef * vv.w; }
    }
    __syncthreads();
#pragma unroll
    for (int j = 0; j < 4; ++j) *(float4*)(lds + w * 1024 + j * 256 + lane * 4) = acc[j];
    __syncthreads();
    float tv[4]; float s = 0.f;
#pragma unroll
    for (int i = 0; i < 4; ++i) { const int c = tid * 4 + i; const float po = (lds[c] + lds[1024 + c]) + (lds[2048 + c] + lds[3072 + c]); tv[i] = DN_ALPHA * X1[c] + po; s += tv[i]; }
    float* red = lds + 4096;
    s = wave_sum(s);
    if (lane == 0) red[w] = s;
    __syncthreads();
    const float mu = (red[0] + red[1] + red[2] + red[3]) * (1.0f / 1024.0f);
    float q = 0.f;
#pragma unroll
    for (int i = 0; i < 4; ++i) { const float d = tv[i] - mu; q += d * d; }
    q = wave_sum(q);
    if (lane == 0) red[8 + w] = q;
    __syncthreads();
    const float var = (red[8] + red[9] + red[10] + red[11]) * (1.0f / 1024.0f);
    const float rstd = 1.0f / sqrtf(var + LN_EPS);
    float* y = p.out + O_Y + (size_t)row * 1024;
#pragma unroll
    for (int i = 0; i < 4; ++i) { const int c = tid * 4 + i; y[c] = (tv[i] - mu) * rstd * p.ln2_g[c] + p.ln2_b[c]; }
}

DEV void mlstm_chunk_item(const Params& p, const int item, unsigned char* lds) {
    int tid_ = threadIdx.x; asm volatile("" : "+v"(tid_));
    const int tid = tid_, lane = tid & 63, w = tid >> 6, lr = lane & 15, lq = lane >> 4;
    const int b = item >> 4, h = (item >> 2) & 3, vs = item & 3;
    bf16_t* Cl = (bf16_t*)lds;
    bf16_t* nl = (bf16_t*)(lds + 8704);
    float* uL = (float*)(lds + 8960); float* ML = uL + 64; float* scin = uL + 128; float* expm = uL + 192; float* wts = uL + 256; float* misc = uL + 320;
    const bf16_t* QB = (const bf16_t*)(p.ws + WS_QB) + (size_t)(b * 2048) * 512 + h * 128;
    const bf16_t* KB = (const bf16_t*)(p.ws + WS_KB) + (size_t)(b * 2048) * 512 + h * 128;
    const bf16_t* KTB = (const bf16_t*)(p.ws + WS_KTB) + (size_t)((b * 4 + h) * 128) * 2048;
    const bf16_t* VTM = (const bf16_t*)(p.ws + WS_VTM) + (size_t)(b * 512 + h * 128 + vs * 32) * 2048;
    const float* Z = (const float*)(p.ws + WS_Z);
    float* HRAW = (float*)(p.ws + WS_HRAW);
    const float gb_i = p.gate_bias[h], gb_f = p.gate_bias[4 + h];
    f32x4 Cm[2][2], nm[2];
#pragma unroll
    for (int i = 0; i < 2; ++i) { nm[i] = (f32x4){0.f, 0.f, 0.f, 0.f};
#pragma unroll
        for (int j = 0; j < 2; ++j) Cm[i][j] = (f32x4){0.f, 0.f, 0.f, 0.f}; }
    float m_prev = 0.f;
    __syncthreads();
    for (int i = tid; i < (8704 + 256) / 4; i += 256) ((unsigned*)lds)[i] = 0u;
    __syncthreads();
    for (int c = 0; c < 32; ++c) {
        const int t0 = c * 64;
        if (w == 0) {
            const size_t row = (size_t)(b * 2048 + t0 + lane);
            const float ig = Z[row * IN_DIM + C_I + h] + gb_i;
            const float lf = log_sigmoid(Z[row * IN_DIM + C_F + h] + gb_f);
            float bc = lf;
#pragma unroll
            for (int o = 1; o < 64; o <<= 1) { const float t = __shfl_up(bc, o); if (lane >= o) bc += t; }
            const float u = ig - bc;
            float pm = u;
#pragma unroll
            for (int o = 1; o < 64; o <<= 1) { const float t = __shfl_up(pm, o); if (lane >= o) pm = fmaxf(pm, t); }
            const float M = fmaxf(m_prev, pm);
            const float M63 = __shfl(M, 63), b63 = __shfl(bc, 63);
            uL[lane] = u; ML[lane] = M; scin[lane] = expf(m_prev - M); expm[lane] = expf(-(bc + M)); wts[lane] = expf(u - M63);
            if (lane == 0) { misc[0] = expf(m_prev - M63); misc[1] = b63 + M63; }
        }
        __syncthreads();
        {
            const size_t row_t = (size_t)(t0 + w * 16 + lr);
            bf16x8 Qf[4];
#pragma unroll
            for (int ks = 0; ks < 4; ++ks) Qf[ks] = *(const bf16x8*)(QB + row_t * 512 + ks * 32 + lq * 8);
            const float M_t = ML[w * 16 + lr], sc_in = scin[w * 16 + lr], em = expm[w * 16 + lr];
            f32x4 sw[4];
            float dsum = 0.f;
#pragma unroll
            for (int st = 0; st < 4; ++st) {
                f32x4 a = (f32x4){0.f, 0.f, 0.f, 0.f};
                if (st <= w) {
#pragma unroll
                    for (int ks = 0; ks < 4; ++ks) { const bf16x8 kf = *(const bf16x8*)(KB + (size_t)(t0 + st * 16 + lr) * 512 + ks * 32 + lq * 8); a = __builtin_amdgcn_mfma_f32_16x16x32_bf16(kf, Qf[ks], a, 0, 0, 0); }
#pragma unroll
                    for (int g = 0; g < 4; ++g) {
                        const int sl = st * 16 + lq * 4 + g, tl = w * 16 + lr;
                        const float wg = (sl <= tl) ? __builtin_amdgcn_exp2f((uL[sl] - M_t) * LOG2E) : 0.f;
                        a[g] *= wg; dsum += a[g];
                    }
                }
                sw[st] = a;
            }
            dsum += __shfl_xor(dsum, 16); dsum += __shfl_xor(dsum, 32);
            bf16x8 pf[2];
#pragma unroll
            for (int ks = 0; ks < 2; ++ks) {
                union { bf16x8 v; unsigned u[4]; } pk;
                pk.u[0] = cvt_pk_bf16(sw[2 * ks][0], sw[2 * ks][1]); pk.u[1] = cvt_pk_bf16(sw[2 * ks][2], sw[2 * ks][3]);
                pk.u[2] = cvt_pk_bf16(sw[2 * ks + 1][0], sw[2 * ks + 1][1]); pk.u[3] = cvt_pk_bf16(sw[2 * ks + 1][2], sw[2 * ks + 1][3]);
                pf[ks] = pk.v;
            }
            f32x4 dI = (f32x4){0.f, 0.f, 0.f, 0.f};
#pragma unroll
            for (int ks = 0; ks < 4; ++ks) { const bf16x8 nf = *(const bf16x8*)(nl + ks * 32 + lq * 8); dI = __builtin_amdgcn_mfma_f32_16x16x32_bf16(nf, Qf[ks], dI, 0, 0, 0); }
            const float den = sc_in * dI[0] + dsum;
            const float rdd = 1.0f / fmaxf(fabsf(den), em);
#pragma unroll
            for (int vt = 0; vt < 2; ++vt) {
                f32x4 ni = (f32x4){0.f, 0.f, 0.f, 0.f}, nI = (f32x4){0.f, 0.f, 0.f, 0.f};
#pragma unroll
                for (int ks = 0; ks < 2; ++ks) if (2 * ks <= w) {
                    union { bf16x8 v; uint2 hh[2]; } vf;
                    const bf16_t* vp = VTM + (size_t)(vt * 16 + lr) * 2048 + t0 + 32 * ks + lq * 4;
                    vf.hh[0] = *(const uint2*)vp; vf.hh[1] = *(const uint2*)(vp + 16);
                    ni = __builtin_amdgcn_mfma_f32_16x16x32_bf16(vf.v, pf[ks], ni, 0, 0, 0);
                }
#pragma unroll
                for (int ks = 0; ks < 4; ++ks) { const bf16x8 cf = *(const bf16x8*)(Cl + (vt * 16 + lr) * 136 + ks * 32 + lq * 8); nI = __builtin_amdgcn_mfma_f32_16x16x32_bf16(cf, Qf[ks], nI, 0, 0, 0); }
                const f32x4 hv = (nI * sc_in + ni) * rdd;
                *(f32x4*)(HRAW + ((size_t)(b * 2048) + row_t) * 512 + h * 128 + vs * 32 + vt * 16 + lq * 4) = hv;
            }
        }
        __syncthreads();
        {
            const float decay = misc[0];
            bf16x8 Af[2][2], Wf[2], Kt[2][2];
#pragma unroll
            for (int ks = 0; ks < 2; ++ks) {
                const float4 w0 = *(const float4*)(wts + ks * 32 + lq * 8), w1 = *(const float4*)(wts + ks * 32 + lq * 8 + 4);
                float wv[8] = {w0.x, w0.y, w0.z, w0.w, w1.x, w1.y, w1.z, w1.w};
                { union { bf16x8 v; uint4 q; } t; t.q = pack8(wv); Wf[ks] = t.v; }
#pragma unroll
                for (int vt = 0; vt < 2; ++vt) {
                    const uint4 raw = *(const uint4*)(VTM + (size_t)(vt * 16 + lr) * 2048 + t0 + ks * 32 + lq * 8);
                    float f[8] = {bf_lo(raw.x) * wv[0], bf_hi(raw.x) * wv[1], bf_lo(raw.y) * wv[2], bf_hi(raw.y) * wv[3], bf_lo(raw.z) * wv[4], bf_hi(raw.z) * wv[5], bf_lo(raw.w) * wv[6], bf_hi(raw.w) * wv[7]};
                    union { bf16x8 v; uint4 q; } t; t.q = pack8(f); Af[vt][ks] = t.v;
                }
#pragma unroll
                for (int kt = 0; kt < 2; ++kt) Kt[kt][ks] = *(const bf16x8*)(KTB + (size_t)((2 * w + kt) * 16 + lr) * 2048 + t0 + ks * 32 + lq * 8);
            }
#pragma unroll
            for (int kt = 0; kt < 2; ++kt) {
                nm[kt] = nm[kt] * decay;
#pragma unroll
                for (int ks = 0; ks < 2; ++ks) nm[kt] = __builtin_amdgcn_mfma_f32_16x16x32_bf16(Wf[ks], Kt[kt][ks], nm[kt], 0, 0, 0);
                if (lq == 0) nl[(2 * w + kt) * 16 + lr] = (bf16_t)(cvt_pk_bf16(nm[kt][0], 0.f) & 0xffffu);
#pragma unroll
                for (int vt = 0; vt < 2; ++vt) {
                    Cm[vt][kt] = Cm[vt][kt] * decay;
#pragma unroll
                    for (int ks = 0; ks < 2; ++ks) Cm[vt][kt] = __builtin_amdgcn_mfma_f32_16x16x32_bf16(Af[vt][ks], Kt[kt][ks], Cm[vt][kt], 0, 0, 0);
                    const unsigned c01 = cvt_pk_bf16(Cm[vt][kt][0], Cm[vt][kt][1]), c23 = cvt_pk_bf16(Cm[vt][kt][2], Cm[vt][kt][3]);
                    bf16_t* cp = Cl + (vt * 16 + lq * 4) * 136 + (2 * w + kt) * 16 + lr;
                    cp[0] = (bf16_t)(c01 & 0xffffu); cp[136] = (bf16_t)(c01 >> 16); cp[272] = (bf16_t)(c23 & 0xffffu); cp[408] = (bf16_t)(c23 >> 16);
                }
            }
            m_prev = misc[1];
        }
        __syncthreads();
    }
#pragma unroll
    for (int vt = 0; vt < 2; ++vt)
#pragma unroll
        for (int kt = 0; kt < 2; ++kt)
#pragma unroll
            for (int g = 0; g < 4; ++g)
                p.out[O_CP + ((size_t)((b * 4 + h) * 128) + vs * 32 + vt * 16 + lq * 4 + g) * 128 + (2 * w + kt) * 16 + lr] = Cm[vt][kt][g];
    if (vs == 0) {
        if (lq == 0) { p.out[O_NP + (size_t)(b * 4 + h) * 128 + (2 * w) * 16 + lr] = nm[0][0]; p.out[O_NP + (size_t)(b * 4 + h) * 128 + (2 * w + 1) * 16 + lr] = nm[1][0]; }
        if (tid == 0) p.out[O_MP + b * 4 + h] = m_prev;
    }
}

DEV void peer_expert_wave(const Params& p, const int row, unsigned char* wl, const int lane) {
    const int lr = lane & 15, lq = lane >> 4;
    bf16_t* xl = (bf16_t*)wl;
    float* coefl = (float*)(wl + 2048);
    int* idxl = (int*)(wl + 2048 + 512);
    const bf16_t* X1B = (const bf16_t*)(p.ws + WS_X1B) + (size_t)row * 1024;
    const float* X1 = (const float*)(p.ws + WS_X1) + (size_t)row * 1024;
    const int* PIDX = (const int*)(p.ws + WS_PIDX) + (size_t)row * 128;
    const float* PG = (const float*)(p.ws + WS_PG) + (size_t)row * 128;
    const bf16_t* UB = (const bf16_t*)(p.ws + WS_UB);
    const bf16_t* VB = (const bf16_t*)(p.ws + WS_VB);
    wave_sync();
    *(uint4*)(xl + lane * 8) = *(const uint4*)(X1B + lane * 8);
    *(uint4*)(xl + 512 + lane * 8) = *(const uint4*)(X1B + 512 + lane * 8);
    idxl[lane] = PIDX[lane]; idxl[64 + lane] = PIDX[64 + lane];
    wave_sync();
    for (int h = 0; h < 8; ++h) {
        const bf16_t* ub = UB + (size_t)idxl[h * 16 + lr] * 1024 + lq * 8;
        f32x4 acc = (f32x4){0.f, 0.f, 0.f, 0.f};
#pragma unroll
        for (int kb = 0; kb < 4; ++kb) {
            bf16x8 uf[8];
#pragma unroll
            for (int i = 0; i < 8; ++i) uf[i] = *(const bf16x8*)(ub + (kb * 8 + i) * 32);
#pragma unroll
            for (int i = 0; i < 8; ++i) { const bf16x8 a = *(const bf16x8*)(xl + (kb * 8 + i) * 32 + lq * 8); acc = __builtin_amdgcn_mfma_f32_16x16x32_bf16(a, uf[i], acc, 0, 0, 0); }
        }
        if (lq == 0) coefl[h * 16 + lr] = PG[h * 16 + lr] * gelu_tanh(acc[0]);
    }
    wave_sync();
    float o[16];
#pragma unroll
    for (int i = 0; i < 16; ++i) o[i] = 0.f;
    for (int j = 0; j < 128; j += 4) {
        uint4 va[4], vb[4]; float c[4];
#pragma unroll
        for (int u = 0; u < 4; ++u) { const bf16_t* vr = VB + (size_t)idxl[j + u] * 1024 + lane * 8; c[u] = coefl[j + u]; va[u] = *(const uint4*)vr; vb[u] = *(const uint4*)(vr + 512); }
#pragma unroll
        for (int u = 0; u < 4; ++u) {
            o[0] += c[u] * bf_lo(va[u].x); o[1] += c[u] * bf_hi(va[u].x); o[2] += c[u] * bf_lo(va[u].y); o[3] += c[u] * bf_hi(va[u].y);
            o[4] += c[u] * bf_lo(va[u].z); o[5] += c[u] * bf_hi(va[u].z); o[6] += c[u] * bf_lo(va[u].w); o[7] += c[u] * bf_hi(va[u].w);
            o[8] += c[u] * bf_lo(vb[u].x); o[9] += c[u] * bf_hi(vb[u].x); o[10] += c[u] * bf_lo(vb[u].y); o[11] += c[u] * bf_hi(vb[u].y);
            o[12] += c[u] * bf_lo(vb[u].z); o[13] += c[u] * bf_hi(vb[u].z); o[14] += c[u] * bf_lo(vb[u].w); o[15] += c[u] * bf_hi(vb[u].w);
        }
    }
    float tv[16]; float s = 0.f;
#pragma unroll
    for (int hb = 0; hb < 2; ++hb) {
        const float4 x0 = *(const float4*)(X1 + hb * 512 + lane * 8), x1v = *(const float4*)(X1 + hb * 512 + lane * 8 + 4);
        tv[hb * 8 + 0] = DN_ALPHA * x0.x + o[hb * 8 + 0]; tv[hb * 8 + 1] = DN_ALPHA * x0.y + o[hb * 8 + 1]; tv[hb * 8 + 2] = DN_ALPHA * x0.z + o[hb * 8 + 2]; tv[hb * 8 + 3] = DN_ALPHA * x0.w + o[hb * 8 + 3];
        tv[hb * 8 + 4] = DN_ALPHA * x1v.x + o[hb * 8 + 4]; tv[hb * 8 + 5] = DN_ALPHA * x1v.y + o[hb * 8 + 5]; tv[hb * 8 + 6] = DN_ALPHA * x1v.z + o[hb * 8 + 6]; tv[hb * 8 + 7] = DN_ALPHA * x1v.w + o[hb * 8 + 7];
    }
#pragma unroll
    for (int i = 0; i < 16; ++i) s += tv[i];
    const float mu = wave_sum(s) * (1.0f / 1024.0f);
    float q = 0.f;
#pragma unroll
    for (int i = 0; i < 16; ++i) { const float d = tv[i] - mu; q += d * d; }
    const float rstd = 1.0f / sqrtf(wave_sum(q) * (1.0f / 1024.0f) + LN_EPS);
    float* y = p.out + O_Y + (size_t)row * 1024;
#pragma unroll
    for (int hb = 0; hb < 2; ++hb) {
        const int c = hb * 512 + lane * 8;
        const float4 g0 = *(const float4*)(p.ln2_g + c), g1 = *(const float4*)(p.ln2_g + c + 4), b0 = *(const float4*)(p.ln2_b + c), b1 = *(const float4*)(p.ln2_b + c + 4);
        float4 y0, y1;
        y0.x = (tv[hb * 8 + 0] - mu) * rstd * g0.x + b0.x; y0.y = (tv[hb * 8 + 1] - mu) * rstd * g0.y + b0.y; y0.z = (tv[hb * 8 + 2] - mu) * rstd * g0.z + b0.z; y0.w = (tv[hb * 8 + 3] - mu) * rstd * g0.w + b0.w;
        y1.x = (tv[hb * 8 + 4] - mu) * rstd * g1.x + b1.x; y1.y = (tv[hb * 8 + 5] - mu) * rstd * g1.y + b1.y; y1.z = (tv[hb * 8 + 6] - mu) * rstd * g1.z + b1.z; y1.w = (tv[hb * 8 + 7] - mu) * rstd * g1.w + b1.w;
        *(float4*)(y + c) = y0; *(float4*)(y + c + 4) = y1;
    }
}

constexpr int QN = 2;
struct AttnState { f32x4 ot[4][QN]; float m[QN]; float l[QN]; };

DEV void attn_block(const unsigned char* Ks, const unsigned char* VTs, const bf16x8 (&Qf)[QN][2], AttnState& A, const int mode, const int dq, const float* blut,
                    const unsigned selbit0, const unsigned selbit1, const bool slc, const int lr, const int lq, const int t0, const int ci0) {
    f32x4 sc[4][QN];
#pragma unroll
    for (int kt = 0; kt < 4; ++kt) {
        const bf16x8 k0 = *(const bf16x8*)(Ks + (kt * 16 + lr) * 144 + lq * 16), k1 = *(const bf16x8*)(Ks + (kt * 16 + lr) * 144 + 64 + lq * 16);
#pragma unroll
        for (int qi = 0; qi < QN; ++qi) {
            f32x4 a = (f32x4){0.f, 0.f, 0.f, 0.f};
            a = __builtin_amdgcn_mfma_f32_16x16x32_bf16(k0, Qf[qi][0], a, 0, 0, 0);
            a = __builtin_amdgcn_mfma_f32_16x16x32_bf16(k1, Qf[qi][1], a, 0, 0, 0);
            sc[kt][qi] = a;
        }
    }
    asm volatile("" ::: "memory");
    if (mode != 0 || slc) {
#pragma unroll
        for (int kt = 0; kt < 4; ++kt)
#pragma unroll
            for (int qi = 0; qi < QN; ++qi)
#pragma unroll
                for (int g = 0; g < 4; ++g) {
                    const int kl = kt * 16 + lq * 4 + g, ql = qi * 16 + lr;
                    float v = sc[kt][qi][g];
                    bool ok = true;
                    if (mode == 1 || mode == 2) { const int di = dq + ql - kl; v += blut[di < 0 ? 0 : di]; }
                    if (mode == 2) ok = kl <= ql + dq;
                    if (mode == 3) ok = kl > ql + dq - 512;
                    if (mode == 4) { const int ci = ci0 + kl, dist = t0 + ql - (16 * ci + 31); ok = (dist >= 0) && (ci < 127); if (dist >= 0 && dist < 192) v += blut[dist]; }
                    if (slc) ok = ok && ((qi == 0 ? selbit0 : selbit1) != 0u);
                    sc[kt][qi][g] = ok ? v : NEGF;
                }
    }
    bf16x8 pf[QN][2];
#pragma unroll
    for (int qi = 0; qi < QN; ++qi) {
        float mb = NEGF;
#pragma unroll
        for (int kt = 0; kt < 4; ++kt) mb = fmaxf(mb, fmaxf(fmaxf(sc[kt][qi][0], sc[kt][qi][1]), fmaxf(sc[kt][qi][2], sc[kt][qi][3])));
        mb = fmaxf(mb, __shfl_xor(mb, 16)); mb = fmaxf(mb, __shfl_xor(mb, 32));
        const float mn = fmaxf(A.m[qi], mb);
        const float alpha = __builtin_amdgcn_exp2f(A.m[qi] - mn);
        A.m[qi] = mn;
        float rs = 0.f;
#pragma unroll
        for (int kt = 0; kt < 4; ++kt)
#pragma unroll
            for (int g = 0; g < 4; ++g) { const float v = sc[kt][qi][g]; const float e = (v > -1e29f) ? __builtin_amdgcn_exp2f(v - mn) : 0.f; sc[kt][qi][g] = e; rs += e; }
        A.l[qi] = A.l[qi] * alpha + rs;
#pragma unroll
        for (int dt = 0; dt < 4; ++dt) A.ot[dt][qi] = A.ot[dt][qi] * alpha;
#pragma unroll
        for (int ks = 0; ks < 2; ++ks) {
            union { bf16x8 v; unsigned u[4]; } pk;
            pk.u[0] = cvt_pk_bf16(sc[2 * ks][qi][0], sc[2 * ks][qi][1]); pk.u[1] = cvt_pk_bf16(sc[2 * ks][qi][2], sc[2 * ks][qi][3]);
            pk.u[2] = cvt_pk_bf16(sc[2 * ks + 1][qi][0], sc[2 * ks + 1][qi][1]); pk.u[3] = cvt_pk_bf16(sc[2 * ks + 1][qi][2], sc[2 * ks + 1][qi][3]);
            pf[qi][ks] = pk.v;
        }
    }
    asm volatile("" ::: "memory");
#pragma unroll
    for (int dt = 0; dt < 4; ++dt)
#pragma unroll
        for (int ks = 0; ks < 2; ++ks) {
            asm volatile("" ::: "memory");
            union { bf16x8 v; uint2 h[2]; } vf;
            vf.h[0] = *(const uint2*)(VTs + (dt * 16 + lr) * 144 + (32 * ks + lq * 4) * 2);
            vf.h[1] = *(const uint2*)(VTs + (dt * 16 + lr) * 144 + (32 * ks + 16 + lq * 4) * 2);
#pragma unroll
            for (int qi = 0; qi < QN; ++qi) A.ot[dt][qi] = __builtin_amdgcn_mfma_f32_16x16x32_bf16(vf.v, pf[qi][ks], A.ot[dt][qi], 0, 0, 0);
        }
}

DEV void nsa_prompt_item(const Params& p, const int b, const int hkv, const int q32, unsigned char* lds) {
    int tid_ = threadIdx.x; asm volatile("" : "+v"(tid_));
    const int tid = tid_, lane = tid & 63, g = tid >> 6, lr = lane & 15, lq = lane >> 4;
    const int hq = hkv * 4 + g, t0 = q32 * 32, kd = t0 >> 6;
    unsigned char* Ks = lds; unsigned char* VTs = lds + 9216;
    float* biasl = (float*)(lds + 18432); float* psl = (float*)(lds + 21504); unsigned* selm = (unsigned*)(lds + 29952); unsigned* misc = (unsigned*)(lds + 30208);
    const bf16_t* ZB = (const bf16_t*)(p.ws + WS_ZB);
    const bf16_t* VTS = (const bf16_t*)(p.ws + WS_VTS) + (size_t)(b * 2 + hkv) * 64 * 2048;
    const bf16_t* VTW = (const bf16_t*)(p.ws + WS_VTW) + (size_t)(b * 2 + hkv) * 64 * 2048;
    const bf16_t* KCB = (const bf16_t*)(p.ws + WS_KCB) + (size_t)(b * 2 + hkv) * 128 * 64;
    const bf16_t* VTC = (const bf16_t*)(p.ws + WS_VTC) + (size_t)(b * 2 + hkv) * 64 * 128;
    const float* Z = (const float*)(p.ws + WS_Z);
    float* NOUTF = (float*)(p.ws + WS_NOUTF);
    bf16_t* NOUTB = (bf16_t*)(p.ws + WS_NOUTB);
    __syncthreads();
    for (int i = tid; i < 4 * 192; i += 256) { const int gg = i / 192, d = i % 192; biasl[i] = (p.rel_bias[rel_bucket(d) * 8 + hkv * 4 + gg] - p.rel_bias[31 * 8 + hkv * 4 + gg]) * LOG2E; }
    for (int i = tid; i < 32 * 33; i += 256) psl[i] = 0.f;
    if (tid < 32) selm[tid] = 0u;
    if (tid == 0) misc[0] = 0u;
    const float* blut = biasl + g * 192;
    bf16x8 Qf[QN][2];
#pragma unroll
    for (int qi = 0; qi < QN; ++qi)
#pragma unroll
        for (int kk = 0; kk < 2; ++kk) Qf[qi][kk] = *(const bf16x8*)(ZB + (size_t)(b * 2048 + t0 + qi * 16 + lr) * IN_DIM + C_Q + hq * 64 + kk * 32 + lq * 8);

    uint4 trk0, trk1, trv0, trv1;
    auto load_tiles = [&](int kind, int kb) __attribute__((always_inline)) {
#pragma unroll
        for (int i = 0; i < 2; ++i) {
            const int id = tid + 256 * i, row = id >> 3, ch = id & 7;
            uint4 rk, rv;
            if (kind == 0) { rk = *(const uint4*)(KCB + (size_t)(kb * 64 + row) * 64 + ch * 8); rv = *(const uint4*)(VTC + (size_t)row * 128 + kb * 64 + ch * 8); }
            else {
                rk = *(const uint4*)(ZB + (size_t)(b * 2048 + kb * 64 + row) * IN_DIM + (kind == 1 ? C_KS : C_KW) + hkv * 64 + ch * 8);
                rv = *(const uint4*)((kind == 1 ? VTS : VTW) + (size_t)row * 2048 + kb * 64 + ch * 8);
            }
            if (i == 0) { trk0 = rk; trv0 = rv; } else { trk1 = rk; trv1 = rv; }
        }
    };
    auto store_tiles = [&]() __attribute__((always_inline)) {
#pragma unroll
        for (int i = 0; i < 2; ++i) { const int id = tid + 256 * i, row = id >> 3, ch = id & 7; *(uint4*)(Ks + row * 144 + ch * 16) = (i == 0 ? trk0 : trk1); *(uint4*)(VTs + row * 144 + ch * 16) = (i == 0 ? trv0 : trv1); }
    };
    auto reset = [&](AttnState& A) __attribute__((always_inline)) {
#pragma unroll
        for (int qi = 0; qi < QN; ++qi) { A.m[qi] = NEGF; A.l[qi] = 0.f;
#pragma unroll
            for (int dt = 0; dt < 4; ++dt) A.ot[dt][qi] = (f32x4){0.f, 0.f, 0.f, 0.f}; }
    };
    auto finish = [&](AttnState& A, int br) __attribute__((always_inline)) {
#pragma unroll
        for (int qi = 0; qi < QN; ++qi) {
            float lt = A.l[qi]; lt += __shfl_xor(lt, 16); lt += __shfl_xor(lt, 32);
            const float sc = (lt > 0.f) ? sigmoidf_(Z[(size_t)(b * 2048 + t0 + qi * 16 + lr) * IN_DIM + C_G + br * 8 + hq]) / lt : 0.f;
            const size_t row = (size_t)(b * 2048 + t0 + qi * 16 + lr);
#pragma unroll
            for (int dt = 0; dt < 4; ++dt) {
                const int col = hq * 64 + dt * 16 + lq * 4;
                f32x4 v = A.ot[dt][qi] * sc;
                if (br > 0) v = v + *(const f32x4*)(NOUTF + row * 512 + col);
                if (br < 2) *(f32x4*)(NOUTF + row * 512 + col) = v; else store_bf16x4(NOUTB + row * 512 + col, v);
            }
        }
    };

    AttnState A;
    const int ncb = ((t0 >> 4) >= 64) ? 2 : 1;
    reset(A);
    load_tiles(0, 0);
    for (int kb = 0; kb < ncb; ++kb) {
        __syncthreads(); store_tiles(); __syncthreads();
        if (kb + 1 < ncb) load_tiles(0, kb + 1);
        attn_block(Ks, VTs, Qf, A, 4, 0, blut, 1u, 1u, false, lr, lq, t0, kb * 64);
    }
    finish(A, 0);
    {
        float linv[QN];
#pragma unroll
        for (int qi = 0; qi < QN; ++qi) { float lt = A.l[qi]; lt += __shfl_xor(lt, 16); lt += __shfl_xor(lt, 32); linv[qi] = (lt > 0.f) ? 1.0f / lt : 0.f; }
        for (int kb = 0; kb < ncb; ++kb) {
            if (ncb > 1) { load_tiles(0, kb); __syncthreads(); store_tiles(); __syncthreads(); }
#pragma unroll
            for (int kt = 0; kt < 4; ++kt) {
                const bf16x8 k0 = *(const bf16x8*)(Ks + (kt * 16 + lr) * 144 + lq * 16), k1 = *(const bf16x8*)(Ks + (kt * 16 + lr) * 144 + 64 + lq * 16);
#pragma unroll
                for (int qi = 0; qi < QN; ++qi) {
                    f32x4 a = (f32x4){0.f, 0.f, 0.f, 0.f};
                    a = __builtin_amdgcn_mfma_f32_16x16x32_bf16(k0, Qf[qi][0], a, 0, 0, 0);
                    a = __builtin_amdgcn_mfma_f32_16x16x32_bf16(k1, Qf[qi][1], a, 0, 0, 0);
                    float pr[4];
#pragma unroll
                    for (int gg = 0; gg < 4; ++gg) {
                        const int ci = kb * 64 + kt * 16 + lq * 4 + gg, ql = qi * 16 + lr, dist = t0 + ql - (16 * ci + 31);
                        float v = a[gg];
                        if (dist >= 0 && dist < 192) v += blut[dist];
                        pr[gg] = (dist >= 0 && ci < 127) ? __builtin_amdgcn_exp2f(v - A.m[qi]) * linv[qi] : 0.f;
                    }
                    const int blk = kb * 16 + kt * 4 + lq, ql = qi * 16 + lr;
                    atomicAdd(&psl[ql * 33 + blk], 2.0f * (pr[0] + pr[1] + pr[2]) + pr[3]);
                    atomicAdd(&psl[ql * 33 + blk + 1], pr[3]);
                }
            }
        }
    }
    __syncthreads();
    {
        const int ql = tid >> 3, part = tid & 7, tq = t0 + ql, cur = tq >> 6;
        float scv[32];
#pragma unroll
        for (int j = 0; j < 32; ++j) {
            const bool causal = j * 64 <= tq, forced = (j == 0) || (j == cur) || (j == cur - 1);
            scv[j] = causal ? (forced ? 1e4f : psl[ql * 33 + j]) : NEGF;
        }
        unsigned mbits = 0u;
#pragma unroll
        for (int jj = 0; jj < 4; ++jj) {
            const int j = part * 4 + jj;
            float my = NEGF;
#pragma unroll
            for (int k = 0; k < 32; ++k) my = (k == j) ? scv[k] : my;
            int rank = 0;
#pragma unroll
            for (int k = 0; k < 32; ++k) rank += ((scv[k] > my) || (scv[k] == my && k < j)) ? 1 : 0;
            if (rank < 16 && j * 64 <= tq) mbits |= (1u << j);
        }
        atomicOr(&selm[ql], mbits);
        atomicOr(&misc[0], mbits);
    }
    __syncthreads();
    const unsigned msk0 = selm[lr], msk1 = selm[16 + lr];
    const unsigned anym = misc[0];
    reset(A);
    {
        int kb = kd;
        load_tiles(1, kb);
        for (;;) {
            __syncthreads(); store_tiles(); __syncthreads();
            int nxt = (kb == kd) ? 0 : kb + 1;
            while (nxt < kd && !((anym >> nxt) & 1u)) ++nxt;
            const bool more = nxt < kd;
            if (more) load_tiles(1, nxt);
            const int mode = (kb == kd) ? 2 : ((kb >= kd - 2) ? 1 : 0);
            attn_block(Ks, VTs, Qf, A, mode, t0 - kb * 64, blut, (msk0 >> kb) & 1u, (msk1 >> kb) & 1u, true, lr, lq, t0, 0);
            if (!more) break;
            kb = nxt;
        }
    }
    finish(A, 1);
    reset(A);
    {
        const int klo = (t0 >= 511) ? ((t0 - 511) >> 6) : 0;
        int kb = kd;
        load_tiles(2, kb);
        for (;;) {
            __syncthreads(); store_tiles(); __syncthreads();
            const bool more = kb > klo;
            if (more) load_tiles(2, kb - 1);
            const int dq = t0 - kb * 64;
            const int mode = (kb == kd) ? 2 : ((kb >= kd - 2) ? 1 : ((dq + 31 >= 512) ? 3 : 0));
            attn_block(Ks, VTs, Qf, A, mode, dq, blut, 1u, 1u, false, lr, lq, t0, 0);
            if (!more) break;
            --kb;
        }
    }
    finish(A, 2);
}

#define Z ((float*)(p.ws + WS_Z))
#define QK ((float*)(p.ws + WS_QK))
#define HRAW ((float*)(p.ws + WS_HRAW))
#define MOUTB ((bf16_t*)(p.ws + WS_MOUTB))
#define NOUTB ((bf16_t*)(p.ws + WS_NOUTB))
#define HIDPB ((bf16_t*)(p.ws + WS_HIDPB))
#define HIDSB ((bf16_t*)(p.ws + WS_HIDSB))
#define KCS ((float*)(p.ws + WS_KCS))
#define MIX ((float*)(p.ws + WS_MIX))
#define MIXB ((bf16_t*)(p.ws + WS_MIXB))
#define T1 ((float*)(p.ws + WS_T1))
#define X1 ((float*)(p.ws + WS_X1))
#define X1B ((bf16_t*)(p.ws + WS_X1B))
#define QPB ((bf16_t*)(p.ws + WS_QPB))
#define S ((float*)(p.ws + WS_S))
#define CONVB ((bf16_t*)(p.ws + WS_CONVB))
#define XB ((bf16_t*)(p.ws + WS_XB))
#define WIN_T ((bf16_t*)(p.ws + WS_WIN_T))
#define WUPM_T ((bf16_t*)(p.ws + WS_WUPM_T))
#define WUPN_T ((bf16_t*)(p.ws + WS_WUPN_T))
#define WOUT_T ((bf16_t*)(p.ws + WS_WOUT_T))
#define PWQ_T ((bf16_t*)(p.ws + WS_PWQ_T))
#define WQK_T ((bf16_t*)(p.ws + WS_WQK_T))
#define W1_T ((bf16_t*)(p.ws + WS_W1_T))
#define W2_T ((bf16_t*)(p.ws + WS_W2_T))
#define SUBK ((bf16_t*)(p.ws + WS_SUBK))
#define ZB ((bf16_t*)(p.ws + WS_ZB))
#define VTS ((bf16_t*)(p.ws + WS_VTS))
#define VTW ((bf16_t*)(p.ws + WS_VTW))
#define KCB ((bf16_t*)(p.ws + WS_KCB))
#define VTC ((bf16_t*)(p.ws + WS_VTC))
__global__ void __launch_bounds__(NTHREADS, 2) fwd_kernel(Params p) {
    extern __shared__ __attribute__((aligned(16))) unsigned char smem[];
    if (threadIdx.x == 0) { *(uint4*)smem = make_uint4(0u, 0u, 0u, 0u); }
    __syncthreads();
    XcdBarrier bar = xcd_barrier_post((unsigned*)(p.ws + WS_BAR), (volatile LAS unsigned*)smem);
    float* lds = (float*)(smem + 16);
    unsigned char* ldsb = smem + 16;
    const int tid = threadIdx.x, lane = tid & 63, w = tid >> 6;
    const int gw = blockIdx.x * 4 + w, nw = gridDim.x * 4;
    const size_t gt = (size_t)blockIdx.x * NTHREADS + tid, nt = (size_t)gridDim.x * NTHREADS;


    {
        for (size_t id = gt; id < (size_t)MP * 128; id += nt) {
            const int row = (int)(id >> 7), k8 = (int)(id & 127) * 8;
            float f[8];
            if (row < NR) {
                const float* s = (row < NP ? p.x_prompt + (size_t)row * 1024 : p.x_sample + (size_t)(row - NP) * 1024) + k8;
                const float4 a = *(const float4*)s, b = *(const float4*)(s + 4);
                f[0] = a.x; f[1] = a.y; f[2] = a.z; f[3] = a.w; f[4] = b.x; f[5] = b.y; f[6] = b.z; f[7] = b.w;
            } else {
#pragma unroll
                for (int i = 0; i < 8; ++i) f[i] = 0.f;
            }
            *(uint4*)(XB + (size_t)row * 1024 + k8) = pack8(f);
        }
        transpose_to_bf16(p.w_in, 1024, IN_DIM, WIN_T, gt, nt);
        transpose_to_bf16(p.w_up_m, 512, 1024, WUPM_T, gt, nt);
        transpose_to_bf16(p.w_up_n, 512, 1024, WUPN_T, gt, nt);
        transpose_to_bf16(p.w_out, 1024, 1024, WOUT_T, gt, nt);
        transpose_to_bf16(p.peer_wq, 1024, 2048, PWQ_T, gt, nt);
        for (int h = 0; h < 4; ++h) {
            transpose_to_bf16(p.wq + (size_t)h * 16384, 128, 128, WQK_T + (size_t)(h * 256) * 128, gt, nt);
            transpose_to_bf16(p.wk + (size_t)h * 16384, 128, 128, WQK_T + (size_t)(h * 256 + 128) * 128, gt, nt);
        }
        for (int c = 0; c < 2; ++c) {
            transpose_to_bf16(p.cmp_w1 + (size_t)c * 2048 * 64, 2048, 64, W1_T + (size_t)c * 64 * 2048, gt, nt);
            transpose_to_bf16(p.cmp_w2 + (size_t)c * 4096, 64, 64, W2_T + (size_t)c * 4096, gt, nt);
        }
        for (size_t id = gt; id < (size_t)2 * 128 * 128 / 8; id += nt) {
            float f[8];
#pragma unroll
            for (int i = 0; i < 8; ++i) f[i] = p.peer_sub[id * 8 + i];
            *(uint4*)(SUBK + id * 8) = pack8(f);
        }
        for (size_t id = gt; id < (size_t)16384 * 128; id += nt) {
            const float* su = p.peer_u + id * 8; const float* sv = p.peer_v + id * 8;
            const float4 a0 = *(const float4*)su, a1 = *(const float4*)(su + 4), c0 = *(const float4*)sv, c1 = *(const float4*)(sv + 4);
            float f[8] = {a0.x, a0.y, a0.z, a0.w, a1.x, a1.y, a1.z, a1.w}; float g8[8] = {c0.x, c0.y, c0.z, c0.w, c1.x, c1.y, c1.z, c1.w};
            *(uint4*)((bf16_t*)(p.ws + WS_UB) + id * 8) = pack8(f); *(uint4*)((bf16_t*)(p.ws + WS_VB) + id * 8) = pack8(g8);
        }
        for (size_t i = gt; i < (size_t)BS * 511 * 256; i += nt) {
            const int j = (int)(i & 255); const int wv = (int)((i >> 8) % 511); const int b = (int)((i >> 8) / 511);
            p.out[O_WINS + ((size_t)b * 512 + wv) * 256 + j] = p.state_win[((size_t)b * 512 + wv + 1) * 256 + j];
        }
        for (size_t i = gt; i < (size_t)BS * 2 * 512; i += nt) {
            const int ch = (int)(i & 511); const int jj = (int)((i >> 9) & 1); const int b = (int)(i >> 10);
            p.out[O_CVS + ((size_t)b * 3 + jj) * 512 + ch] = p.state_conv[((size_t)b * 3 + jj + 1) * 512 + ch];
        }
    }
    xcd_barrier(bar);

    gemm_bf16<128>(NR, IN_DIM, 1024,
        [&](int r, int k) { return *(const uint4*)(XB + (size_t)r * 1024 + k); },
        [&](int n, int k) { return *(const uint4*)(WIN_T + (size_t)n * 1024 + k); },
        [&](int r, int c0, f32x4 v) {
            *(f32x4*)(Z + (size_t)r * IN_DIM + c0) = v;
            store_bf16x4(ZB + (size_t)r * IN_DIM + c0, (c0 >= C_Q && c0 < C_KC) ? v * (0.125f * LOG2E) : v);
            if (r < NP && ((c0 >= C_KS + 128 && c0 < C_KW) || (c0 >= C_KW + 128 && c0 < C_G))) {
                const bool isw = c0 >= C_KW; const int cc = c0 - (isw ? C_KW : C_KS) - 128;
                bf16_t* vt = (isw ? VTW : VTS) + ((size_t)((r >> 11) * 2) * 64 + cc) * 2048 + (r & 2047);
                const unsigned w0 = cvt_pk_bf16(v[0], v[1]), w1 = cvt_pk_bf16(v[2], v[3]);
                vt[0] = (bf16_t)(w0 & 0xffffu); vt[2048] = (bf16_t)(w0 >> 16); vt[4096] = (bf16_t)(w1 & 0xffffu); vt[6144] = (bf16_t)(w1 >> 16);
            }
            if (r < NP && c0 >= C_V && c0 < C_O) {
                bf16_t* vt = (bf16_t*)(p.ws + WS_VTM) + ((size_t)(r >> 11) * 512 + (c0 - C_V)) * 2048 + (r & 2047);
                const unsigned w0 = cvt_pk_bf16(v[0], v[1]), w1 = cvt_pk_bf16(v[2], v[3]);
                vt[0] = (bf16_t)(w0 & 0xffffu); vt[2048] = (bf16_t)(w0 >> 16); vt[4096] = (bf16_t)(w1 & 0xffffu); vt[6144] = (bf16_t)(w1 >> 16);
            }
            if (c0 >= C_KC && c0 < C_KS) *(f32x4*)(p.out + O_CMPP + (size_t)r * 256 + (c0 - C_KC)) = v;
            else if (c0 >= C_KS && c0 < C_KW) *(f32x4*)(p.out + O_SLCP + (size_t)r * 256 + (c0 - C_KS)) = v;
            else if (c0 >= C_KW && c0 < C_G) {
                if (r < NP) { const int t = r & 2047; if (t >= 1536) *(f32x4*)(p.out + O_WINP + ((size_t)(r >> 11) * 512 + (t - 1536)) * 256 + (c0 - C_KW)) = v; }
                else *(f32x4*)(p.out + O_WINS + ((size_t)(r - NP) * 512 + 511) * 256 + (c0 - C_KW)) = v;
            } else if (c0 < C_V) {
                if (r < NP) { const int t = r & 2047; if (t >= 2045) *(f32x4*)(p.out + O_CVP + ((size_t)(r >> 11) * 3 + (t - 2045)) * 512 + c0) = v; }
                else *(f32x4*)(p.out + O_CVS + ((size_t)(r - NP) * 3 + 2) * 512 + c0) = v;
            }
        }, ldsb);
    xcd_barrier(bar);

    for (size_t i = gt; i < (size_t)NR * 512; i += nt) {
        const int ch = (int)(i & 511); const int r = (int)(i >> 9);
        float a = p.conv_b[ch];
        if (r < NP) {
            const int t = r & 2047;
#pragma unroll
            for (int j = 0; j < 4; ++j) if (t + j - 3 >= 0) a += p.conv_w[j * 512 + ch] * Z[(size_t)(r + j - 3) * IN_DIM + C_U + ch];
        } else {
            const int b = r - NP;
#pragma unroll
            for (int j = 0; j < 3; ++j) a += p.conv_w[j * 512 + ch] * p.state_conv[((size_t)b * 3 + j) * 512 + ch];
            a += p.conv_w[3 * 512 + ch] * Z[(size_t)r * IN_DIM + C_U + ch];
        }
        CONVB[i] = (bf16_t)(cvt_pk_bf16(a / (1.0f + expf(-a)), 0.f) & 0xffffu);
    }
    xcd_barrier(bar);

    for (int h = 0; h < 4; ++h) {
        gemm_bf16<128>(NR, 256, 128,
            [&](int r, int k) { return *(const uint4*)(CONVB + (size_t)r * 512 + h * 128 + k); },
            [&](int n, int k) { return *(const uint4*)(WQK_T + (size_t)(h * 256 + n) * 128 + k); },
            [&](int r, int c0, f32x4 v) {
                if (c0 >= 128) v = v * 0.08838834764831845f;
                *(f32x4*)(QK + (size_t)r * 1024 + h * 256 + c0) = v;
                if (c0 < 128) store_bf16x4((bf16_t*)(p.ws + WS_QB) + (size_t)r * 512 + h * 128 + c0, v);
                else {
                    store_bf16x4((bf16_t*)(p.ws + WS_KB) + (size_t)r * 512 + h * 128 + (c0 - 128), v);
                    if (r < NP) {
                        bf16_t* kt = (bf16_t*)(p.ws + WS_KTB) + ((size_t)((r >> 11) * 4 + h) * 128 + (c0 - 128)) * 2048 + (r & 2047);
                        const unsigned w0 = cvt_pk_bf16(v[0], v[1]), w1 = cvt_pk_bf16(v[2], v[3]);
                        kt[0] = (bf16_t)(w0 & 0xffffu); kt[2048] = (bf16_t)(w0 >> 16); kt[4096] = (bf16_t)(w1 & 0xffffu); kt[6144] = (bf16_t)(w1 >> 16);
                    }
                } }, ldsb);
    }
    for (int c = 0; c < 2; ++c) {
        gemm_bf16<64>(4096, 64, 2048,
            [&](int row, int k) {
                const int hh = row & 1, bi = row >> 1, i = bi & 127, b = bi >> 7, j = k >> 6, d0 = k & 63, tok = 16 * i + j;
                const float* pe = p.cmp_pe + (c * 32 + j) * 64 + d0;
                const float4 e0 = *(const float4*)pe, e1 = *(const float4*)(pe + 4);
                float f[8] = {e0.x, e0.y, e0.z, e0.w, e1.x, e1.y, e1.z, e1.w};
                if (tok < 2048) {
                    const float* s = Z + ((size_t)b * 2048 + tok) * IN_DIM + C_KC + c * 128 + hh * 64 + d0;
                    const float4 a0 = *(const float4*)s, a1 = *(const float4*)(s + 4);
                    f[0] += a0.x; f[1] += a0.y; f[2] += a0.z; f[3] += a0.w; f[4] += a1.x; f[5] += a1.y; f[6] += a1.z; f[7] += a1.w;
                }
                return pack8(f); },
            [&](int n, int k) { return *(const uint4*)(W1_T + ((size_t)c * 64 + n) * 2048 + k); },
            [&](int row, int c0, f32x4 v) {
                f32x4 g; g[0] = gelu_tanh(v[0]); g[1] = gelu_tanh(v[1]); g[2] = gelu_tanh(v[2]); g[3] = gelu_tanh(v[3]);
                store_bf16x4(HIDPB + ((size_t)c * 4096 + row) * 64 + c0, g); }, ldsb);
        gemm_bf16<64>(65536, 64, 2048,
            [&](int row, int k) {
                const int hh = row & 1, bi = row >> 1, i = bi & 1023, b = bi >> 10, j = k >> 6, d0 = k & 63, tok = 16 * i + j;
                const float* pe = p.cmp_pe + (c * 32 + j) * 64 + d0;
                const float4 e0 = *(const float4*)pe, e1 = *(const float4*)(pe + 4);
                float f[8] = {e0.x, e0.y, e0.z, e0.w, e1.x, e1.y, e1.z, e1.w};
                if (tok < PAST) {
                    const int page = p.page_table[b * 128 + (tok >> 7)];
                    const float* s = p.cache_cmp + ((size_t)page * 128 + (tok & 127)) * 256 + c * 128 + hh * 64 + d0;
                    const float4 a0 = *(const float4*)s, a1 = *(const float4*)(s + 4);
                    f[0] += a0.x; f[1] += a0.y; f[2] += a0.z; f[3] += a0.w; f[4] += a1.x; f[5] += a1.y; f[6] += a1.z; f[7] += a1.w;
                }
                return pack8(f); },
            [&](int n, int k) { return *(const uint4*)(W1_T + ((size_t)c * 64 + n) * 2048 + k); },
            [&](int row, int c0, f32x4 v) {
                f32x4 g; g[0] = gelu_tanh(v[0]); g[1] = gelu_tanh(v[1]); g[2] = gelu_tanh(v[2]); g[3] = gelu_tanh(v[3]);
                store_bf16x4(HIDSB + ((size_t)c * 65536 + row) * 64 + c0, g); }, ldsb);
    }
    xcd_barrier(bar);

    for (int item = blockIdx.x; item < 256 + 128; item += gridDim.x) {
        if (item < 256) mlstm_chunk_item(p, item, ldsb); else mlstm_scan_item(p, 64 + (item - 256), lds);
    }
    for (int c = 0; c < 2; ++c) {
        gemm_bf16<64>(4096, 64, 64,
            [&](int row, int k) { return *(const uint4*)(HIDPB + ((size_t)c * 4096 + row) * 64 + k); },
            [&](int n, int k) { return *(const uint4*)(W2_T + ((size_t)c * 64 + n) * 64 + k); },
            [&](int row, int c0, f32x4 v) {
                const int hh = row & 1, bi = row >> 1, i = bi & 127, b = bi >> 7;
                if (c == 0) store_bf16x4(KCB + ((size_t)(b * 2 + hh) * 128 + i) * 64 + c0, v);
                else { bf16_t* vt = VTC + ((size_t)(b * 2 + hh) * 64 + c0) * 128 + i; const unsigned w0 = cvt_pk_bf16(v[0], v[1]), w1 = cvt_pk_bf16(v[2], v[3]);
                       vt[0] = (bf16_t)(w0 & 0xffffu); vt[128] = (bf16_t)(w0 >> 16); vt[256] = (bf16_t)(w1 & 0xffffu); vt[384] = (bf16_t)(w1 >> 16); } }, ldsb);
        gemm_bf16<64>(65536, 64, 64,
            [&](int row, int k) { return *(const uint4*)(HIDSB + ((size_t)c * 65536 + row) * 64 + k); },
            [&](int n, int k) { return *(const uint4*)(W2_T + ((size_t)c * 64 + n) * 64 + k); },
            [&](int row, int c0, f32x4 v) { *(f32x4*)(KCS + ((size_t)c * 65536 + row) * 64 + c0) = v; }, ldsb);
    }
    xcd_barrier(bar);

    for (int it = gw; it < NR * 4; it += nw) {
        const int row = it >> 2, h = it & 3;
        const float x0 = HRAW[(size_t)row * 512 + h * 128 + lane], x1 = HRAW[(size_t)row * 512 + h * 128 + 64 + lane];
        const float mu = wave_sum(x0 + x1) * (1.0f / 128.0f);
        const float d0 = x0 - mu, d1 = x1 - mu;
        const float var = wave_sum(d0 * d0 + d1 * d1) * (1.0f / 128.0f);
        const float rstd = 1.0f / sqrtf(var + LN_EPS);
        const int c0 = h * 128 + lane, c1 = c0 + 64;
        MOUTB[(size_t)row * 512 + c0] = (bf16_t)(cvt_pk_bf16(sigmoidf_(Z[(size_t)row * IN_DIM + C_O + c0]) * (d0 * rstd * p.norm_g[c0]), 0.f) & 0xffffu);
        MOUTB[(size_t)row * 512 + c1] = (bf16_t)(cvt_pk_bf16(sigmoidf_(Z[(size_t)row * IN_DIM + C_O + c1]) * (d1 * rstd * p.norm_g[c1]), 0.f) & 0xffffu);
    }
    if (blockIdx.x < 16) {
        float* wl = lds + w * 4416;
        const int it = blockIdx.x * 4 + w;
        nsa_item(p, NP + (it >> 1), it & 1, wl, lane);
    }
    for (;;) {
        __syncthreads();
        if (tid == 0) *(volatile int*)(ldsb + 30464) = (int)atomicAdd((unsigned*)(p.ws + WS_BAR) + 2, 1u);
        __syncthreads();
        const int idx = *(volatile int*)(ldsb + 30464);
        if (idx >= 2048) break;
        nsa_prompt_item(p, (idx & 31) >> 1, idx & 1, 63 - (idx >> 5), ldsb);
    }
    xcd_barrier(bar);

    gemm_bf16<128>(NR, 1024, 512,
        [&](int r, int k) { return *(const uint4*)(MOUTB + (size_t)r * 512 + k); },
        [&](int n, int k) { return *(const uint4*)(WUPM_T + (size_t)n * 512 + k); },
        [&](int r, int c0, f32x4 v) {
            const f32x4 g = *(const f32x4*)(Z + (size_t)r * IN_DIM + C_GM + c0);
            f32x4 o; o[0] = sigmoidf_(g[0]) * v[0]; o[1] = sigmoidf_(g[1]) * v[1]; o[2] = sigmoidf_(g[2]) * v[2]; o[3] = sigmoidf_(g[3]) * v[3];
            *(f32x4*)(MIX + (size_t)r * 1024 + c0) = o; }, ldsb);
    gemm_bf16<128>(NR, 1024, 512,
        [&](int r, int k) { return *(const uint4*)(NOUTB + (size_t)r * 512 + k); },
        [&](int n, int k) { return *(const uint4*)(WUPN_T + (size_t)n * 512 + k); },
        [&](int r, int c0, f32x4 v) {
            const f32x4 g = *(const f32x4*)(Z + (size_t)r * IN_DIM + C_GN + c0);
            f32x4 o = *(const f32x4*)(MIX + (size_t)r * 1024 + c0);
            o[0] += sigmoidf_(g[0]) * v[0]; o[1] += sigmoidf_(g[1]) * v[1]; o[2] += sigmoidf_(g[2]) * v[2]; o[3] += sigmoidf_(g[3]) * v[3];
            store_bf16x4(MIXB + (size_t)r * 1024 + c0, o); }, ldsb);
    xcd_barrier(bar);

    gemm_bf16<128>(NR, 1024, 1024,
        [&](int r, int k) { return *(const uint4*)(MIXB + (size_t)r * 1024 + k); },
        [&](int n, int k) { return *(const uint4*)(WOUT_T + (size_t)n * 1024 + k); },
        [&](int r, int c0, f32x4 v) {
            const f32x4 xv = *(const f32x4*)((r < NP ? p.x_prompt + (size_t)r * 1024 : p.x_sample + (size_t)(r - NP) * 1024) + c0);
            *(f32x4*)(T1 + (size_t)r * 1024 + c0) = xv * DN_ALPHA + v; }, ldsb);
    xcd_barrier(bar);

    for (int row = gw; row < NR; row += nw) {
        float tv[16]; float s = 0.f;
#pragma unroll
        for (int j = 0; j < 4; ++j) { const float4 t4 = *(const float4*)(T1 + (size_t)row * 1024 + j * 256 + lane * 4); tv[4 * j] = t4.x; tv[4 * j + 1] = t4.y; tv[4 * j + 2] = t4.z; tv[4 * j + 3] = t4.w; s += (t4.x + t4.y) + (t4.z + t4.w); }
        const float mu = wave_sum(s) * (1.0f / 1024.0f);
        float q = 0.f;
#pragma unroll
        for (int j = 0; j < 16; ++j) { const float d = tv[j] - mu; q += d * d; }
        const float rstd = 1.0f / sqrtf(wave_sum(q) * (1.0f / 1024.0f) + LN_EPS);
#pragma unroll
        for (int j = 0; j < 4; ++j) {
            const int c = j * 256 + lane * 4;
            const float4 g4 = *(const float4*)(p.ln1_g + c), b4 = *(const float4*)(p.ln1_b + c);
            f32x4 o; o[0] = (tv[4 * j] - mu) * rstd * g4.x + b4.x; o[1] = (tv[4 * j + 1] - mu) * rstd * g4.y + b4.y; o[2] = (tv[4 * j + 2] - mu) * rstd * g4.z + b4.z; o[3] = (tv[4 * j + 3] - mu) * rstd * g4.w + b4.w;
            *(f32x4*)(X1 + (size_t)row * 1024 + c) = o;
            store_bf16x4(X1B + (size_t)row * 1024 + c, o);
        }
    }
    xcd_barrier(bar);

    gemm_bf16<128>(NR, 2048, 1024,
        [&](int r, int k) { return *(const uint4*)(X1B + (size_t)r * 1024 + k); },
        [&](int n, int k) { return *(const uint4*)(PWQ_T + (size_t)n * 1024 + k); },
        [&](int r, int c0, f32x4 v) { store_bf16x4(QPB + (size_t)r * 2048 + c0, v); }, ldsb);
    xcd_barrier(bar);

    for (int hp = 0; hp < 16; ++hp) {
        const int pp = hp & 1;
        gemm_bf16<128>(NR, 128, 128,
            [&](int r, int k) { return *(const uint4*)(QPB + (size_t)r * 2048 + hp * 128 + k); },
            [&](int n, int k) { return *(const uint4*)(SUBK + ((size_t)pp * 128 + n) * 128 + k); },
            [&](int r, int c0, f32x4 v) { *(f32x4*)(S + (size_t)r * 2048 + hp * 128 + c0) = v; }, ldsb);
    }
    xcd_barrier(bar);

    for (int it = gw; it < NR * 8; it += nw) peer_topk_item(p, it >> 3, it & 7, lane);
    xcd_barrier(bar);

    for (int row = gw; row < NR; row += nw) peer_expert_wave(p, row, ldsb + w * 3072, lane);
}

extern "C" void kernel_launch(void* const* d_in, const int* in_sizes, int n_in, void* d_out, int out_size, void* d_ws, size_t ws_size, hipStream_t stream) {
    static int grid = 0;
    if (grid == 0) {
        if (n_in != 32 || (size_t)out_size != O_END || ws_size < WS_END) {
            fprintf(stderr, "kernel_launch: unexpected sizes n_in %d out %d ws %zu (need %zu)\n", n_in, out_size, ws_size, (size_t)WS_END); grid = -1; return; }
        int dev = 0, cus = 0, per_cu = 0;
        if (hipGetDevice(&dev) != hipSuccess || hipDeviceGetAttribute(&cus, hipDeviceAttributeMultiprocessorCount, dev) != hipSuccess) { grid = -1; return; }
        if (hipFuncSetAttribute((const void*)fwd_kernel, hipFuncAttributeMaxDynamicSharedMemorySize, LDS_BYTES) != hipSuccess) { fprintf(stderr, "hipFuncSetAttribute failed\n"); grid = -1; return; }
        if (hipOccupancyMaxActiveBlocksPerMultiprocessor(&per_cu, (const void*)fwd_kernel, NTHREADS, LDS_BYTES) != hipSuccess || per_cu < 1) { fprintf(stderr, "occupancy query failed (%d)\n", per_cu); (void)hipGetLastError(); per_cu = 1; }
        if (per_cu > 2) per_cu = 2;
        grid = cus * per_cu;
    }
    if (grid < 0) return;
    (void)hipMemsetAsync((char*)d_ws + WS_BAR, 0, XCD_BAR_WORDS * sizeof(unsigned), stream);
    Params p{};
    p.x_prompt = (const float*)d_in[0]; p.x_sample = (const float*)d_in[1]; p.cache_cmp = (const float*)d_in[2]; p.cache_slc = (const float*)d_in[3];
    p.page_table = (const int*)d_in[4]; p.state_win = (const float*)d_in[5]; p.state_C = (const float*)d_in[6]; p.state_n = (const float*)d_in[7];
    p.state_m = (const float*)d_in[8]; p.state_conv = (const float*)d_in[9]; p.w_in = (const float*)d_in[10]; p.conv_w = (const float*)d_in[11];
    p.conv_b = (const float*)d_in[12]; p.wq = (const float*)d_in[13]; p.wk = (const float*)d_in[14]; p.gate_bias = (const float*)d_in[15];
    p.norm_g = (const float*)d_in[16]; p.cmp_pe = (const float*)d_in[17]; p.cmp_w1 = (const float*)d_in[18]; p.cmp_w2 = (const float*)d_in[19];
    p.rel_bias = (const float*)d_in[20]; p.w_up_m = (const float*)d_in[21]; p.w_up_n = (const float*)d_in[22]; p.w_out = (const float*)d_in[23];
    p.ln1_g = (const float*)d_in[24]; p.ln1_b = (const float*)d_in[25]; p.ln2_g = (const float*)d_in[26]; p.ln2_b = (const float*)d_in[27];
    p.peer_wq = (const float*)d_in[28]; p.peer_sub = (const float*)d_in[29]; p.peer_u = (const float*)d_in[30]; p.peer_v = (const float*)d_in[31];
    p.out = (float*)d_out; p.ws = (unsigned char*)d_ws;
    hipLaunchKernelGGL(fwd_kernel, dim3(grid), dim3(NTHREADS), LDS_BYTES, stream, p);
}
```

```cpp
#include <hip/hip_runtime.h>
#include <stdint.h>
#include <cstdio>

#define DEV __device__ __forceinline__

constexpr int DM = 1024;
constexpr int BP = 16, TP = 2048, BS = 32;
constexpr int NP = BP * TP;
constexpr int NR = NP + BS;
constexpr int MP = 32896;
constexpr int IN_DIM = 4896;
constexpr int C_U = 0, C_V = 512, C_O = 1024, C_I = 1536, C_F = 1540, C_Q = 1544, C_KC = 2056, C_KS = 2312, C_KW = 2568, C_G = 2824, C_GM = 2848, C_GN = 3872;
constexpr int PAST = 16384;
constexpr float NEGF = -1e30f;
constexpr float DN_ALPHA = 1.189207115002721f;
constexpr float LN_EPS = 1e-5f;
constexpr float LOG2E = 1.4426950408889634f;

constexpr size_t O_Y = 0;
constexpr size_t O_CMPP = (size_t)NR * DM;
constexpr size_t O_CMPS = O_CMPP + (size_t)NP * 256;
constexpr size_t O_SLCP = O_CMPS + (size_t)BS * 256;
constexpr size_t O_SLCS = O_SLCP + (size_t)NP * 256;
constexpr size_t O_WINP = O_SLCS + (size_t)BS * 256;
constexpr size_t O_WINS = O_WINP + (size_t)BP * 512 * 256;
constexpr size_t O_CP = O_WINS + (size_t)BS * 512 * 256;
constexpr size_t O_CS = O_CP + (size_t)BP * 4 * 128 * 128;
constexpr size_t O_NP = O_CS + (size_t)BS * 4 * 128 * 128;
constexpr size_t O_NS = O_NP + (size_t)BP * 4 * 128;
constexpr size_t O_MP = O_NS + (size_t)BS * 4 * 128;
constexpr size_t O_MS = O_MP + (size_t)BP * 4;
constexpr size_t O_CVP = O_MS + (size_t)BS * 4;
constexpr size_t O_CVS = O_CVP + (size_t)BP * 3 * 512;
constexpr size_t O_END = O_CVS + (size_t)BS * 3 * 512;
static_assert(O_END == 59916480, "output size");

constexpr size_t al256(size_t x) { return (x + 255) & ~(size_t)255; }
constexpr size_t WS_BAR = 0;
constexpr size_t WS_Z = 16384;
constexpr size_t WS_QK = al256(WS_Z + (size_t)MP * IN_DIM * 4);
constexpr size_t WS_HRAW = al256(WS_QK + (size_t)MP * 1024 * 4);
constexpr size_t WS_MOUTB = al256(WS_HRAW + (size_t)MP * 512 * 4);
constexpr size_t WS_NOUTB = al256(WS_MOUTB + (size_t)MP * 512 * 2);
constexpr size_t WS_HIDPB = al256(WS_NOUTB + (size_t)MP * 512 * 2);
constexpr size_t WS_KCP = al256(WS_HIDPB + (size_t)2 * 4096 * 64 * 2);
constexpr size_t WS_HIDSB = al256(WS_KCP + 256);
constexpr size_t WS_KCS = al256(WS_HIDSB + (size_t)2 * 65536 * 64 * 2);
constexpr size_t WS_MIX = al256(WS_KCS + (size_t)2 * 65536 * 64 * 4);
constexpr size_t WS_MIXB = al256(WS_MIX + (size_t)MP * 1024 * 4);
constexpr size_t WS_T1 = al256(WS_MIXB + (size_t)MP * 1024 * 2);
constexpr size_t WS_X1 = al256(WS_T1 + (size_t)MP * 1024 * 4);
constexpr size_t WS_X1B = al256(WS_X1 + (size_t)MP * 1024 * 4);
constexpr size_t WS_QPB = al256(WS_X1B + (size_t)MP * 1024 * 2);
constexpr size_t WS_S = al256(WS_QPB + (size_t)MP * 2048 * 2);
constexpr size_t WS_PIDX = al256(WS_S + (size_t)MP * 2048 * 4);
constexpr size_t WS_PG = al256(WS_PIDX + (size_t)MP * 128 * 4);
constexpr size_t WS_CONVB = al256(WS_PG + (size_t)MP * 128 * 4);
constexpr size_t WS_XB = al256(WS_CONVB + (size_t)MP * 512 * 2);
constexpr size_t WS_WIN_T = al256(WS_XB + (size_t)MP * 1024 * 2);
constexpr size_t WS_WUPM_T = al256(WS_WIN_T + (size_t)IN_DIM * 1024 * 2);
constexpr size_t WS_WUPN_T = al256(WS_WUPM_T + (size_t)1024 * 512 * 2);
constexpr size_t WS_WOUT_T = al256(WS_WUPN_T + (size_t)1024 * 512 * 2);
constexpr size_t WS_PWQ_T = al256(WS_WOUT_T + (size_t)1024 * 1024 * 2);
constexpr size_t WS_WQK_T = al256(WS_PWQ_T + (size_t)2048 * 1024 * 2);
constexpr size_t WS_W1_T = al256(WS_WQK_T + (size_t)4 * 256 * 128 * 2);
constexpr size_t WS_W2_T = al256(WS_W1_T + (size_t)2 * 64 * 2048 * 2);
constexpr size_t WS_SUBK = al256(WS_W2_T + (size_t)2 * 64 * 64 * 2);
constexpr size_t WS_ZB = al256(WS_SUBK + (size_t)2 * 128 * 128 * 2);
constexpr size_t WS_VTS = al256(WS_ZB + (size_t)MP * IN_DIM * 2);
constexpr size_t WS_VTW = al256(WS_VTS + (size_t)16 * 2 * 64 * 2048 * 2);
constexpr size_t WS_KCB = al256(WS_VTW + (size_t)16 * 2 * 64 * 2048 * 2);
constexpr size_t WS_VTC = al256(WS_KCB + (size_t)16 * 2 * 128 * 64 * 2);
constexpr size_t WS_NOUTF = al256(WS_VTC + (size_t)16 * 2 * 64 * 128 * 2);
constexpr size_t WS_UB = al256(WS_NOUTF + (size_t)NP * 512 * 4);
constexpr size_t WS_VB = al256(WS_UB + (size_t)16384 * 1024 * 2);
constexpr size_t WS_QB = al256(WS_VB + (size_t)16384 * 1024 * 2);
constexpr size_t WS_KB = al256(WS_QB + (size_t)MP * 512 * 2);
constexpr size_t WS_KTB = al256(WS_KB + (size_t)MP * 512 * 2);
constexpr size_t WS_VTM = al256(WS_KTB + (size_t)16 * 512 * 2048 * 2);
constexpr size_t WS_END = al256(WS_VTM + (size_t)16 * 512 * 2048 * 2);

static_assert(WS_END <= 2684354560ull, "workspace too large");
constexpr int LDS_BYTES = 73728;
constexpr int NTHREADS = 256;

struct Params {
    const float* x_prompt; const float* x_sample; const float* cache_cmp; const float* cache_slc; const int* page_table;
    const float* state_win; const float* state_C; const float* state_n; const float* state_m; const float* state_conv;
    const float* w_in; const float* conv_w; const float* conv_b; const float* wq; const float* wk; const float* gate_bias; const float* norm_g;
    const float* cmp_pe; const float* cmp_w1; const float* cmp_w2; const float* rel_bias; const float* w_up_m; const float* w_up_n; const float* w_out;
    const float* ln1_g; const float* ln1_b; const float* ln2_g; const float* ln2_b; const float* peer_wq; const float* peer_sub; const float* peer_u; const float* peer_v;
    float* out; unsigned char* ws;
};

#define XB_TMO      128
#define XB_XCNT(j)  (256  + 64 * (j))
#define XB_XSUB(j)  (1280 + 64 * (j))
#define XB_XGEN(j)  (2304 + 64 * (j))
#define XB_TOP      3328
#define XB_TOPGEN   3392
#define XCD_BAR_WORDS 3456
#define XB_SPIN_CAP (1u << 22)
#define LAS __attribute__((address_space(3)))

__device__ __forceinline__ unsigned xb_ld(unsigned* p)              { return __hip_atomic_load(p, __ATOMIC_RELAXED, __HIP_MEMORY_SCOPE_AGENT); }
__device__ __forceinline__ unsigned xb_add(unsigned* p, unsigned v) { return __hip_atomic_fetch_add(p, v, __ATOMIC_RELAXED, __HIP_MEMORY_SCOPE_AGENT); }
__device__ __forceinline__ unsigned xb_xcc_id() { return (unsigned)__builtin_amdgcn_s_getreg((3 << 11) | 20) & 0xFu; }
#define XB_SPIN(cond, bar) do { unsigned _sp = 0; while (cond) { __builtin_amdgcn_s_sleep(1); \
    if ((++_sp & 255u) == 0u) { if (xb_ld(&(bar)[XB_TMO])) break; if (_sp > XB_SPIN_CAP) { atomicAdd(&(bar)[XB_TMO], 1u); break; } } } } while (0)

struct XcdBarrier { unsigned* bar; unsigned x; volatile LAS unsigned* st; };

__device__ __forceinline__ XcdBarrier xcd_barrier_post(unsigned* bar, volatile LAS unsigned* st) {
    XcdBarrier b; b.bar = bar; b.x = xb_xcc_id(); b.st = st;
    if (threadIdx.x == 0) (void)xb_add(&bar[XB_XCNT(b.x)], 1u);
    return b;
}
__device__ __forceinline__ void xcd_barrier_complete(unsigned* bar, unsigned x, unsigned& nloc, unsigned& nx) {
    const unsigned G = gridDim.x * gridDim.y * gridDim.z;
    unsigned sum, cnt, mine, sp = 0u;
    for (;;) {
        sum = 0u; cnt = 0u; mine = 0u;
#pragma unroll
        for (unsigned j = 0; j < 16; ++j) { const unsigned c = xb_ld(&bar[XB_XCNT(j)]); sum += c; cnt += (c > 0u) ? 1u : 0u; mine = (j == x) ? c : mine; }
        if (sum == G) break;
        __builtin_amdgcn_s_sleep(1);
        if ((++sp & 255u) == 0u) { if (xb_ld(&bar[XB_TMO])) break; if (sp > XB_SPIN_CAP) { atomicAdd(&bar[XB_TMO], 1u); break; } }
    }
    nloc = mine > 0u ? mine : 1u; nx = cnt > 0u ? cnt : 1u;
}
__device__ __forceinline__ void xcd_barrier(const XcdBarrier& b) {
    asm volatile("s_waitcnt vmcnt(0)" ::: "memory");
    __syncthreads();
    if (threadIdx.x == 0) {
        unsigned* bar = b.bar;
        __builtin_amdgcn_s_waitcnt(0);
        unsigned nloc = b.st[0], nx = b.st[1];
        if (nloc == 0u) { xcd_barrier_complete(bar, b.x, nloc, nx); b.st[0] = nloc; b.st[1] = nx; }
        const unsigned old = xb_add(&bar[XB_XSUB(b.x)], 1u);
        const unsigned gen = old / nloc;
        if (old + 1u == (gen + 1u) * nloc) {
            __builtin_amdgcn_fence(__ATOMIC_RELEASE, "agent");
            asm volatile("s_waitcnt vmcnt(0)" ::: "memory");
            const unsigned og = xb_add(&bar[XB_TOP], 1u);
            const unsigned tg = og / nx;
            if (og + 1u == (tg + 1u) * nx) xb_add(&bar[XB_TOPGEN], 1u);
            else XB_SPIN(xb_ld(&bar[XB_TOPGEN]) == tg, bar);
            __builtin_amdgcn_fence(__ATOMIC_ACQUIRE, "agent");
            xb_add(&bar[XB_XGEN(b.x)], 1u);
            asm volatile("s_waitcnt vmcnt(0)" ::: "memory");
        } else {
            XB_SPIN(xb_ld(&bar[XB_XGEN(b.x)]) == gen, bar);
            __builtin_amdgcn_fence(__ATOMIC_ACQUIRE, "agent");
            asm volatile("s_waitcnt vmcnt(0)" ::: "memory");
        }
    }
    __syncthreads();
}

typedef float f32x4 __attribute__((ext_vector_type(4)));

__device__ const unsigned char REL_LUT[128] = {
    0, 1, 2, 3, 4, 5, 6, 7, 8, 9, 10, 11, 12, 13, 14, 15, 16, 16, 16, 17, 17, 18, 18, 18, 19, 19, 19, 20, 20, 20, 20, 21, 21, 21, 21, 22, 22, 22, 22, 22,
    23, 23, 23, 23, 23, 23, 24, 24, 24, 24, 24, 24, 25, 25, 25, 25, 25, 25, 25, 26, 26, 26, 26, 26, 26, 26, 26, 27, 27, 27, 27, 27, 27, 27, 27, 27, 27,
    28, 28, 28, 28, 28, 28, 28, 28, 28, 28, 29, 29, 29, 29, 29, 29, 29, 29, 29, 29, 29, 29, 30, 30, 30, 30, 30, 30, 30, 30, 30, 30, 30, 30, 30, 30,
    31, 31, 31, 31, 31, 31, 31, 31, 31, 31, 31, 31, 31, 31, 31};
DEV int rel_bucket(int n) { return n < 128 ? (int)REL_LUT[n < 0 ? 0 : n] : 31; }

DEV float sigmoidf_(float x) { return 1.0f / (1.0f + expf(-x)); }
DEV float gelu_tanh(float x) { return 0.5f * x * (1.0f + tanhf(0.7978845608028654f * (x + 0.044715f * x * x * x))); }
DEV float log_sigmoid(float x) { return x >= 0.f ? -log1pf(expf(-x)) : x - log1pf(expf(x)); }
DEV void wave_sync() { asm volatile("s_waitcnt lgkmcnt(0)" ::: "memory"); __builtin_amdgcn_wave_barrier(); asm volatile("" ::: "memory"); }
DEV float wave_sum(float v) {
#pragma unroll
    for (int o = 32; o >= 1; o >>= 1) v += __shfl_xor(v, o);
    return v;
}
DEV float wave_max(float v) {
#pragma unroll
    for (int o = 32; o >= 1; o >>= 1) v = fmaxf(v, __shfl_xor(v, o));
    return v;
}

typedef unsigned short bf16_t;
typedef short bf16x8 __attribute__((ext_vector_type(8)));
typedef float f32x2_ __attribute__((ext_vector_type(2)));
typedef __bf16 bf16x2_ __attribute__((ext_vector_type(2)));
DEV unsigned cvt_pk_bf16(float lo, float hi) { const f32x2_ v = {lo, hi}; return __builtin_bit_cast(unsigned, __builtin_convertvector(v, bf16x2_)); }
DEV float bf_lo(unsigned w) { return __uint_as_float(w << 16); }
DEV float bf_hi(unsigned w) { return __uint_as_float(w & 0xffff0000u); }
DEV uint4 pack8(const float* f) { uint4 r; r.x = cvt_pk_bf16(f[0], f[1]); r.y = cvt_pk_bf16(f[2], f[3]); r.z = cvt_pk_bf16(f[4], f[5]); r.w = cvt_pk_bf16(f[6], f[7]); return r; }
DEV void store_bf16x4(bf16_t* p, f32x4 v) { uint2 w; w.x = cvt_pk_bf16(v[0], v[1]); w.y = cvt_pk_bf16(v[2], v[3]); *(uint2*)p = w; }

DEV void transpose_to_bf16(const float* __restrict__ src, const int K, const int N, bf16_t* __restrict__ dst, const size_t gt, const size_t nt) {
    const size_t items = (size_t)N * (K >> 3);
    for (size_t id = gt; id < items; id += nt) {
        const int n = (int)(id % N), k8 = (int)(id / N) * 8;
        float f[8];
#pragma unroll
        for (int i = 0; i < 8; ++i) f[i] = src[(size_t)(k8 + i) * N + n];
        *(uint4*)(dst + (size_t)n * K + k8) = pack8(f);
    }
}

template <int BN, class LA, class LB, class EF>
DEV void gemm_bf16(const int M, const int N, const int K, LA la, LB lb, EF ef, unsigned char* lds) {
    constexpr int TJ = BN / 32;
    constexpr int NB = BN / 32;
    constexpr int LDR = 144;
    const int tid = threadIdx.x, lane = tid & 63, w = tid >> 6, wm = w >> 1, wn = w & 1;
    const int tm = (M + 127) >> 7, tn = (N + BN - 1) / BN;
    unsigned char* As = lds;
    unsigned char* Bs = lds + 128 * LDR;
    const int lr = lane & 15, lq = lane >> 4;
    for (int tile = blockIdx.x; tile < tm * tn; tile += gridDim.x) {
        const int bm = (tile / tn) * 128, bn = (tile % tn) * BN;
        f32x4 acc[4][TJ];
#pragma unroll
        for (int i = 0; i < 4; ++i)
#pragma unroll
            for (int j = 0; j < TJ; ++j) acc[i][j] = (f32x4){0.f, 0.f, 0.f, 0.f};
        uint4 ra[4], rb[NB];
        int arow[4], brow[NB];
#pragma unroll
        for (int i = 0; i < 4; ++i) { const int r = bm + ((tid + 256 * i) >> 3); arow[i] = r < M ? r : M - 1; }
#pragma unroll
        for (int i = 0; i < NB; ++i) { const int n = bn + ((tid + 256 * i) >> 3); brow[i] = n < N ? n : N - 1; }
        const int kc = (tid & 7) * 8;
#pragma unroll
        for (int i = 0; i < 4; ++i) ra[i] = la(arow[i], kc);
#pragma unroll
        for (int i = 0; i < NB; ++i) rb[i] = lb(brow[i], kc);
        for (int k0_ = 0; k0_ < K; k0_ += 64) {
            int k0 = k0_; asm volatile("" : "+v"(k0));
            __syncthreads();
#pragma unroll
            for (int i = 0; i < 4; ++i) *(uint4*)(As + ((tid + 256 * i) >> 3) * LDR + (tid & 7) * 16) = ra[i];
#pragma unroll
            for (int i = 0; i < NB; ++i) *(uint4*)(Bs + ((tid + 256 * i) >> 3) * LDR + (tid & 7) * 16) = rb[i];
            __syncthreads();
            if (k0_ + 64 < K) {
#pragma unroll
                for (int i = 0; i < 4; ++i) ra[i] = la(arow[i], k0 + 64 + kc);
#pragma unroll
                for (int i = 0; i < NB; ++i) rb[i] = lb(brow[i], k0 + 64 + kc);
            }
#pragma unroll
            for (int kk = 0; kk < 2; ++kk) {
                bf16x8 a[4], b[TJ];
#pragma unroll
                for (int i = 0; i < 4; ++i) a[i] = *(const bf16x8*)(As + (wm * 64 + i * 16 + lr) * LDR + kk * 64 + lq * 16);
#pragma unroll
                for (int j = 0; j < TJ; ++j) b[j] = *(const bf16x8*)(Bs + (wn * (BN / 2) + j * 16 + lr) * LDR + kk * 64 + lq * 16);
#pragma unroll
                for (int i = 0; i < 4; ++i)
#pragma unroll
                    for (int j = 0; j < TJ; ++j) acc[i][j] = __builtin_amdgcn_mfma_f32_16x16x32_bf16(b[j], a[i], acc[i][j], 0, 0, 0);
            }
        }
#pragma unroll
        for (int i = 0; i < 4; ++i)
#pragma unroll
            for (int j = 0; j < TJ; ++j) {
                const int r = bm + wm * 64 + i * 16 + lr, c0 = bn + wn * (BN / 2) + j * 16 + lq * 4;
                if (r < M && c0 < N) ef(r, c0, acc[i][j]);
            }
    }
}

template <class KeyF>
DEV void wave_attn(const float* qs, float* sb, const int nkeys, KeyF keyf, const float* __restrict__ rel_bias, const int hkv, const int lane, float (&o)[4]) {
    float mx[4] = {NEGF, NEGF, NEGF, NEGF};
    for (int base = 0; base < nkeys; base += 64) {
        asm volatile("" ::: "memory");
        const int idx = base + lane;
        const float* kp = nullptr; const float* vp = nullptr; int dist = 0;
        bool valid = false;
        if (idx < nkeys) valid = keyf(idx, kp, vp, dist);
        float sc[4] = {0.f, 0.f, 0.f, 0.f};
        if (valid) {
#pragma unroll 1
            for (int d4 = 0; d4 < 16; ++d4) {
                asm volatile("" ::: "memory");
                const float4 kv = ((const float4*)kp)[d4];
#pragma unroll
                for (int g = 0; g < 4; ++g) {
                    const float4 qv = *(const float4*)(qs + g * 64 + d4 * 4);
                    sc[g] += qv.x * kv.x + qv.y * kv.y + qv.z * kv.z + qv.w * kv.w;
                }
            }
            const int bk = rel_bucket(dist);
#pragma unroll
            for (int g = 0; g < 4; ++g) sc[g] += rel_bias[bk * 8 + hkv * 4 + g];
        }
#pragma unroll
        for (int g = 0; g < 4; ++g) {
            const float v = valid ? sc[g] : NEGF;
            if (idx < nkeys) sb[g * 1024 + idx] = v;
            mx[g] = fmaxf(mx[g], v);
        }
    }
    float inv[4];
#pragma unroll
    for (int g = 0; g < 4; ++g) mx[g] = wave_max(mx[g]);
    wave_sync();
    float sum[4] = {0.f, 0.f, 0.f, 0.f};
    for (int idx = lane; idx < nkeys; idx += 64) {
#pragma unroll
        for (int g = 0; g < 4; ++g) {
            const float v = sb[g * 1024 + idx];
            const float e = (v > -1e29f) ? expf(v - mx[g]) : 0.f;
            sb[g * 1024 + idx] = e;
            sum[g] += e;
        }
    }
#pragma unroll
    for (int g = 0; g < 4; ++g) { sum[g] = wave_sum(sum[g]); inv[g] = 1.0f / fmaxf(sum[g], 1e-30f); }
    for (int idx = lane; idx < nkeys; idx += 64) {
#pragma unroll
        for (int g = 0; g < 4; ++g) sb[g * 1024 + idx] *= inv[g];
    }
    wave_sync();
#pragma unroll
    for (int g = 0; g < 4; ++g) o[g] = 0.f;
    for (int idx = 0; idx < nkeys; ++idx) {
        const float p0 = sb[idx], p1 = sb[1024 + idx], p2 = sb[2048 + idx], p3 = sb[3072 + idx];
        if (p0 + p1 + p2 + p3 == 0.f) continue;
        const float* kp = nullptr; const float* vp = nullptr; int dist = 0;
        (void)keyf(idx, kp, vp, dist);
        const float vv = vp[lane];
        o[0] += p0 * vv; o[1] += p1 * vv; o[2] += p2 * vv; o[3] += p3 * vv;
    }
}

DEV void nsa_item(const Params& p, const int row, const int hkv, float* wl, const int lane) {
    float* qs = wl; float* sb = wl + 256; int* sel = (int*)(wl + 256 + 4096);
    const float* Z = (const float*)(p.ws + WS_Z);
    bf16_t* NOUT = (bf16_t*)(p.ws + WS_NOUTB);
    const float* KCP = (const float*)(p.ws + WS_KCP);
    const float* KCS = (const float*)(p.ws + WS_KCS);
    const bool pr = row < NP;
    const int b = pr ? (row >> 11) : (row - NP);
    const int t = pr ? (row & 2047) : 0;
    const int qpos = pr ? t : PAST;
    const float* zrow = Z + (size_t)row * IN_DIM;
    wave_sync();
    for (int i = lane; i < 256; i += 64) qs[i] = zrow[C_Q + hkv * 256 + i] * 0.125f;
    wave_sync();
    float o[4];
    float gate[3][4];
#pragma unroll
    for (int br = 0; br < 3; ++br)
#pragma unroll
        for (int g = 0; g < 4; ++g) gate[br][g] = sigmoidf_(zrow[C_G + br * 8 + hkv * 4 + g]);
    bf16_t* nrow = NOUT + (size_t)row * 512 + hkv * 256;
    float res[4];
    const int nkc = pr ? 127 : 1023;
    {
        const float* kbase = pr ? (KCP + ((size_t)(b * 128) * 2 + hkv) * 64) : (KCS + ((size_t)(b * 1024) * 2 + hkv) * 64);
        const size_t plane = pr ? (size_t)4096 * 64 : (size_t)65536 * 64;
        auto keyf = [&](int idx, const float*& kp, const float*& vp, int& dist) -> bool {
            kp = kbase + (size_t)idx * 128; vp = kp + plane; dist = qpos - (16 * idx + 31); return dist >= 0; };
        wave_attn(qs, sb, nkc, keyf, p.rel_bias, hkv, lane, o);
#pragma unroll
        for (int g = 0; g < 4; ++g) res[g] = gate[0][g] * o[g];
    }
    const int nblk = pr ? 32 : 257;
    for (int i = lane; i < nkc; i += 64) sb[i] = ((sb[i] + sb[1024 + i]) + sb[2048 + i]) + sb[3072 + i];
    wave_sync();
    {
        const int cur = qpos >> 6;
        for (int blk = lane; blk < nblk; blk += 64) {
            float s = 0.f;
#pragma unroll
            for (int cc = 0; cc < 4; ++cc) {
                const int c = 4 * blk + cc;
                const float a0 = (c < nkc) ? sb[c] : 0.f;
                const float a1 = (c >= 1 && c - 1 < nkc) ? sb[c - 1] : 0.f;
                s += a0 + a1;
            }
            const bool causal = blk * 64 <= qpos;
            const bool forced = (blk == 0) || (blk == cur) || (blk == cur - 1);
            sb[1024 + blk] = causal ? (forced ? 1e4f : s) : NEGF;
        }
        wave_sync();
        for (int blk = lane; blk < nblk; blk += 64) {
            const float my = sb[1024 + blk];
            int rank = 0;
            for (int j = 0; j < nblk; ++j) { const float o2 = sb[1024 + j]; rank += ((o2 > my) || (o2 == my && j < blk)) ? 1 : 0; }
            if (rank < 16) sel[rank] = (blk * 64 <= qpos) ? blk : -1;
        }
        wave_sync();
    }
    {
        const float* zb = Z + (size_t)(pr ? b * 2048 : 0) * IN_DIM;
        auto keyf = [&](int idx, const float*& kp, const float*& vp, int& dist) -> bool {
            const int blk = sel[idx >> 6], s = idx & 63;
            if (blk < 0) return false;
            const int kpos = blk * 64 + s;
            if (kpos > qpos) return false;
            dist = qpos - kpos;
            if (pr) { kp = zb + (size_t)kpos * IN_DIM + C_KS + hkv * 64; }
            else if (blk < 256) { const int page = p.page_table[b * 128 + (blk >> 1)]; kp = p.cache_slc + ((size_t)page * 128 + (blk & 1) * 64 + s) * 256 + hkv * 64; }
            else { kp = zrow + C_KS + hkv * 64; }
            vp = kp + 128; return true; };
        wave_attn(qs, sb, 1024, keyf, p.rel_bias, hkv, lane, o);
#pragma unroll
        for (int g = 0; g < 4; ++g) res[g] += gate[1][g] * o[g];
    }
    {
        const float* zb = Z + (size_t)(pr ? b * 2048 : 0) * IN_DIM;
        const int nk = pr ? ((t + 1 < 512) ? t + 1 : 512) : 512;
        auto keyf = [&](int idx, const float*& kp, const float*& vp, int& dist) -> bool {
            if (pr) { const int kpos = t - nk + 1 + idx; dist = t - kpos; kp = zb + (size_t)kpos * IN_DIM + C_KW + hkv * 64; }
            else { const int j = idx + 1; dist = 512 - j; kp = (j < 512) ? (p.state_win + ((size_t)b * 512 + j) * 256 + hkv * 64) : (zrow + C_KW + hkv * 64); }
            vp = kp + 128; return true; };
        wave_attn(qs, sb, nk, keyf, p.rel_bias, hkv, lane, o);
#pragma unroll
        for (int g = 0; g < 4; ++g) res[g] += gate[2][g] * o[g];
    }
#pragma unroll
    for (int g = 0; g < 4; ++g) nrow[g * 64 + lane] = (bf16_t)(cvt_pk_bf16(res[g], 0.f) & 0xffffu);
}

DEV void mlstm_scan_item(const Params& p, const int item, float* lds) {
    const int tid = threadIdx.x, v = tid >> 1, kh = tid & 1;
    const int seq = item >> 2, h = item & 3;
    const bool pr = seq < 16; const int b = pr ? seq : seq - 16;
    const int T = pr ? 2048 : 1; const int row0 = pr ? b * 2048 : NP + b;
    const float* Z = (const float*)(p.ws + WS_Z);
    const float* QK = (const float*)(p.ws + WS_QK);
    float* HRAW = (float*)(p.ws + WS_HRAW);
    float C[64], n[64]; float m;
    if (pr) {
#pragma unroll
        for (int j = 0; j < 64; ++j) { C[j] = 0.f; n[j] = 0.f; }
        m = 0.f;
    } else {
        const float* c0 = p.state_C + (((size_t)(b * 4 + h) * 128 + v) * 128 + kh * 64);
        const float* n0 = p.state_n + ((size_t)(b * 4 + h) * 128 + kh * 64);
#pragma unroll
        for (int j = 0; j < 64; ++j) { C[j] = c0[j]; n[j] = n0[j]; }
        m = p.state_m[b * 4 + h];
    }
    const float gb_i = p.gate_bias[h], gb_f = p.gate_bias[4 + h];
    auto load_tok = [&](int t, float* dst) {
        const size_t r = (size_t)(row0 + t);
        dst[tid] = QK[r * 1024 + h * 256 + tid];
        if (tid < 128) dst[256 + tid] = Z[r * IN_DIM + C_V + h * 128 + tid];
        if (tid == 128) dst[384] = Z[r * IN_DIM + C_I + h] + gb_i;
        if (tid == 129) dst[385] = log_sigmoid(Z[r * IN_DIM + C_F + h] + gb_f);
    };
    __syncthreads();
    load_tok(0, lds);
    __syncthreads();
    for (int t = 0; t < T; ++t) {
        const float* cur = lds + (t & 1) * 388;
        if (t + 1 < T) load_tok(t + 1, lds + ((t + 1) & 1) * 388);
        const float ig = cur[384], lf = cur[385];
        const float mn = fmaxf(lf + m, ig);
        const float fd = expf(lf + m - mn), iw = expf(ig - mn);
        const float vv = cur[256 + v] * iw;
        float nump = 0.f, denp = 0.f;
#pragma unroll
        for (int j = 0; j < 64; ++j) {
            const float kj = cur[128 + kh * 64 + j], qj = cur[kh * 64 + j];
            C[j] = fd * C[j] + vv * kj; n[j] = fd * n[j] + iw * kj;
            nump += C[j] * qj; denp += n[j] * qj;
        }
        nump += __shfl_xor(nump, 1); denp += __shfl_xor(denp, 1);
        const float hval = nump / fmaxf(fabsf(denp), expf(-mn));
        if (kh == 0) HRAW[(size_t)(row0 + t) * 512 + h * 128 + v] = hval;
        m = mn;
        __syncthreads();
    }
    float* co = p.out + (pr ? O_CP : O_CS) + (((size_t)(b * 4 + h) * 128 + v) * 128 + kh * 64);
#pragma unroll
    for (int j = 0; j < 64; ++j) co[j] = C[j];
    if (v == 0) {
        float* no = p.out + (pr ? O_NP : O_NS) + ((size_t)(b * 4 + h) * 128 + kh * 64);
#pragma unroll
        for (int j = 0; j < 64; ++j) no[j] = n[j];
    }
    if (tid == 0) p.out[(pr ? O_MP : O_MS) + b * 4 + h] = m;
}

DEV void peer_topk_item(const Params& p, const int row, const int h, const int lane) {
    const float* S = (const float*)(p.ws + WS_S) + (size_t)row * 2048 + h * 256;
    int* PIDX = (int*)(p.ws + WS_PIDX); float* PG = (float*)(p.ws + WS_PG);
    float ts[2]; int ti[2];
#pragma unroll
    for (int pp = 0; pp < 2; ++pp) {
        float v0 = S[pp * 128 + lane], v1 = S[pp * 128 + 64 + lane];
        float mys = 0.f; int myi = 0;
        for (int r = 0; r < 16; ++r) {
            float best = fmaxf(v0, v1); int bi = (v0 >= v1) ? lane : lane + 64;
#pragma unroll
            for (int off = 32; off >= 1; off >>= 1) {
                const float ob = __shfl_xor(best, off); const int oi = __shfl_xor(bi, off);
                if (ob > best || (ob == best && oi < bi)) { best = ob; bi = oi; }
            }
            if (lane == r) { mys = best; myi = bi; }
            if (bi == lane) v0 = -INFINITY;
            if (bi == lane + 64) v1 = -INFINITY;
        }
        ts[pp] = mys; ti[pp] = myi;
    }
    float cv[4];
#pragma unroll
    for (int jj = 0; jj < 4; ++jj) { const int c = lane * 4 + jj; cv[jj] = __shfl(ts[0], c >> 4) + __shfl(ts[1], c & 15); }
    float msc = 0.f; int mci = 0;
    for (int r = 0; r < 16; ++r) {
        float best = cv[0]; int bi = lane * 4;
#pragma unroll
        for (int jj = 1; jj < 4; ++jj) if (cv[jj] > best) { best = cv[jj]; bi = lane * 4 + jj; }
#pragma unroll
        for (int off = 32; off >= 1; off >>= 1) {
            const float ob = __shfl_xor(best, off); const int oi = __shfl_xor(bi, off);
            if (ob > best || (ob == best && oi < bi)) { best = ob; bi = oi; }
        }
        if (lane == r) { msc = best; mci = bi; }
#pragma unroll
        for (int jj = 0; jj < 4; ++jj) if (bi == lane * 4 + jj) cv[jj] = -INFINITY;
    }
    const int e = __shfl(ti[0], mci >> 4) * 128 + __shfl(ti[1], mci & 15);
    const float top = __shfl(msc, 0);
    float ex = (lane < 16) ? expf(msc - top) : 0.f;
    const float den = wave_sum(ex);
    if (lane < 16) { PIDX[(size_t)row * 128 + h * 16 + lane] = e; PG[(size_t)row * 128 + h * 16 + lane] = ex / den; }
}

DEV void peer_expert_item(const Params& p, const int row, float* lds) {
    const int tid = threadIdx.x, lane = tid & 63, w = tid >> 6;
    const float* X1 = (const float*)(p.ws + WS_X1) + (size_t)row * 1024;
    const int* PIDX = (const int*)(p.ws + WS_PIDX) + (size_t)row * 128;
    const float* PG = (const float*)(p.ws + WS_PG) + (size_t)row * 128;
    float4 x[4], acc[4];
#pragma unroll
    for (int j = 0; j < 4; ++j) { x[j] = *(const float4*)(X1 + j * 256 + lane * 4); acc[j] = make_float4(0.f, 0.f, 0.f, 0.f); }
    for (int k = 0; k < 32; ++k) {
        const int e = PIDX[w * 32 + k]; const float gk = PG[w * 32 + k];
        const float* ur = p.peer_u + (size_t)e * 1024; const float* vr = p.peer_v + (size_t)e * 1024;
        float d = 0.f;
#pragma unroll
        for (int j = 0; j < 4; ++j) { const float4 u = *(const float4*)(ur + j * 256 + lane * 4); d += u.x * x[j].x + u.y * x[j].y + u.z * x[j].z + u.w * x[j].w; }
        d = wave_sum(d);
        const float coef = gk * gelu_tanh(d);
#pragma unroll
        for (int j = 0; j < 4; ++j) { const float4 vv = *(const float4*)(vr + j * 256 + lane * 4);
            acc[j].x += coef * vv.x; acc[j].y += coef * vv.y; acc[j].z += coef * vv.z; acc[j].w += coef * vv.w; }
    }
    __syncthreads();
#pragma unroll
    for (int j = 0; j < 4; ++j) *(float4*)(lds + w * 1024 + j * 256 + lane * 4) = acc[j];
    __syncthreads();
    float tv[4]; float s = 0.f;
#pragma unroll
    for (int i = 0; i < 4; ++i) { const int c = tid * 4 + i; const float po = (lds[c] + lds[1024 + c]) + (lds[2048 + c] + lds[3072 + c]); tv[i] = DN_ALPHA * X1[c] + po; s += tv[i]; }
    float* red = lds + 4096;
    s = wave_sum(s);
    if (lane == 0) red[w] = s;
    __syncthreads();
    const float mu = (red[0] + red[1] + red[2] + red[3]) * (1.0f / 1024.0f);
    float q = 0.f;
#pragma unroll
    for (int i = 0; i < 4; ++i) { const float d = tv[i] - mu; q += d * d; }
    q = wave_sum(q);
    if (lane == 0) red[8 + w] = q;
    __syncthreads();
    const float var = (red[8] + red[9] + red[10] + red[11]) * (1.0f / 1024.0f);
    const float rstd = 1.0f / sqrtf(var + LN_EPS);
    float* y = p.out + O_Y + (size_t)row * 1024;
#pragma unroll
    for (int i = 0; i < 4; ++i) { const int c = tid * 4 + i; y[c] = (tv[i] - mu) * rstd * p.ln2_g[c] + p.ln2_b[c]; }
}

DEV void mlstm_chunk_item(const Params& p, const int item, unsigned char* lds) {
    int tid_ = threadIdx.x; asm volatile("" : "+v"(tid_));
    const int tid = tid_, lane = tid & 63, w = tid >> 6, lr = lane & 15, lq = lane >> 4;
    const int b = item >> 4, h = (item >> 2) & 3, vs = item & 3;
    bf16_t* Cl = (bf16_t*)lds;
    bf16_t* nl = (bf16_t*)(lds + 8704);
    float* uL = (float*)(lds + 8960); float* ML = uL + 64; float* scin = uL + 128; float* expm = uL + 192; float* wts = uL + 256; float* misc = uL + 320;
    const bf16_t* QB = (const bf16_t*)(p.ws + WS_QB) + (size_t)(b * 2048) * 512 + h * 128;
    const bf16_t* KB = (const bf16_t*)(p.ws + WS_KB) + (size_t)(b * 2048) * 512 + h * 128;
    const bf16_t* KTB = (const bf16_t*)(p.ws + WS_KTB) + (size_t)((b * 4 + h) * 128) * 2048;
    const bf16_t* VTM = (const bf16_t*)(p.ws + WS_VTM) + (size_t)(b * 512 + h * 128 + vs * 32) * 2048;
    const float* Z = (const float*)(p.ws + WS_Z);
    float* HRAW = (float*)(p.ws + WS_HRAW);
    const float gb_i = p.gate_bias[h], gb_f = p.gate_bias[4 + h];
    f32x4 Cm[2][2], nm[2];
#pragma unroll
    for (int i = 0; i < 2; ++i) { nm[i] = (f32x4){0.f, 0.f, 0.f, 0.f};
#pragma unroll
        for (int j = 0; j < 2; ++j) Cm[i][j] = (f32x4){0.f, 0.f, 0.f, 0.f}; }
    float m_prev = 0.f;
    __syncthreads();
    for (int i = tid; i < (8704 + 256) / 4; i += 256) ((unsigned*)lds)[i] = 0u;
    __syncthreads();
    for (int c = 0; c < 32; ++c) {
        const int t0 = c * 64;
        if (w == 0) {
            const size_t row = (size_t)(b * 2048 + t0 + lane);
            const float ig = Z[row * IN_DIM + C_I + h] + gb_i;
            const float lf = log_sigmoid(Z[row * IN_DIM + C_F + h] + gb_f);
            float bc = lf;
#pragma unroll
            for (int o = 1; o < 64; o <<= 1) { const float t = __shfl_up(bc, o); if (lane >= o) bc += t; }
            const float u = ig - bc;
            float pm = u;
#pragma unroll
            for (int o = 1; o < 64; o <<= 1) { const float t = __shfl_up(pm, o); if (lane >= o) pm = fmaxf(pm, t); }
            const float M = fmaxf(m_prev, pm);
            const float M63 = __shfl(M, 63), b63 = __shfl(bc, 63);
            uL[lane] = u; ML[lane] = M; scin[lane] = expf(m_prev - M); expm[lane] = expf(-(bc + M)); wts[lane] = expf(u - M63);
            if (lane == 0) { misc[0] = expf(m_prev - M63); misc[1] = b63 + M63; }
        }
        __syncthreads();
        {
            const size_t row_t = (size_t)(t0 + w * 16 + lr);
            bf16x8 Qf[4];
#pragma unroll
            for (int ks = 0; ks < 4; ++ks) Qf[ks] = *(const bf16x8*)(QB + row_t * 512 + ks * 32 + lq * 8);
            const float M_t = ML[w * 16 + lr], sc_in = scin[w * 16 + lr], em = expm[w * 16 + lr];
            f32x4 sw[4];
            float dsum = 0.f;
#pragma unroll
            for (int st = 0; st < 4; ++st) {
                f32x4 a = (f32x4){0.f, 0.f, 0.f, 0.f};
                if (st <= w) {
#pragma unroll
                    for (int ks = 0; ks < 4; ++ks) { const bf16x8 kf = *(const bf16x8*)(KB + (size_t)(t0 + st * 16 + lr) * 512 + ks * 32 + lq * 8); a = __builtin_amdgcn_mfma_f32_16x16x32_bf16(kf, Qf[ks], a, 0, 0, 0); }
#pragma unroll
                    for (int g = 0; g < 4; ++g) {
                        const int sl = st * 16 + lq * 4 + g, tl = w * 16 + lr;
                        const float wg = (sl <= tl) ? __builtin_amdgcn_exp2f((uL[sl] - M_t) * LOG2E) : 0.f;
                        a[g] *= wg; dsum += a[g];
                    }
                }
                sw[st] = a;
            }
            dsum += __shfl_xor(dsum, 16); dsum += __shfl_xor(dsum, 32);
            bf16x8 pf[2];
#pragma unroll
            for (int ks = 0; ks < 2; ++ks) {
                union { bf16x8 v; unsigned u[4]; } pk;
                pk.u[0] = cvt_pk_bf16(sw[2 * ks][0], sw[2 * ks][1]); pk.u[1] = cvt_pk_bf16(sw[2 * ks][2], sw[2 * ks][3]);
                pk.u[2] = cvt_pk_bf16(sw[2 * ks + 1][0], sw[2 * ks + 1][1]); pk.u[3] = cvt_pk_bf16(sw[2 * ks + 1][2], sw[2 * ks + 1][3]);
                pf[ks] = pk.v;
            }
            f32x4 dI = (f32x4){0.f, 0.f, 0.f, 0.f};
#pragma unroll
            for (int ks = 0; ks < 4; ++ks) { const bf16x8 nf = *(const bf16x8*)(nl + ks * 32 + lq * 8); dI = __builtin_amdgcn_mfma_f32_16x16x32_bf16(nf, Qf[ks], dI, 0, 0, 0); }
            const float den = sc_in * dI[0] + dsum;
            const float rdd = 1.0f / fmaxf(fabsf(den), em);
#pragma unroll
            for (int vt = 0; vt < 2; ++vt) {
                f32x4 ni = (f32x4){0.f, 0.f, 0.f, 0.f}, nI = (f32x4){0.f, 0.f, 0.f, 0.f};
#pragma unroll
                for (int ks = 0; ks < 2; ++ks) if (2 * ks <= w) {
                    union { bf16x8 v; uint2 hh[2]; } vf;
                    const bf16_t* vp = VTM + (size_t)(vt * 16 + lr) * 2048 + t0 + 32 * ks + lq * 4;
                    vf.hh[0] = *(const uint2*)vp; vf.hh[1] = *(const uint2*)(vp + 16);
                    ni = __builtin_amdgcn_mfma_f32_16x16x32_bf16(vf.v, pf[ks], ni, 0, 0, 0);
                }
#pragma unroll
                for (int ks = 0; ks < 4; ++ks) { const bf16x8 cf = *(const bf16x8*)(Cl + (vt * 16 + lr) * 136 + ks * 32 + lq * 8); nI = __builtin_amdgcn_mfma_f32_16x16x32_bf16(cf, Qf[ks], nI, 0, 0, 0); }
                const f32x4 hv = (nI * sc_in + ni) * rdd;
                *(f32x4*)(HRAW + ((size_t)(b * 2048) + row_t) * 512 + h * 128 + vs * 32 + vt * 16 + lq * 4) = hv;
            }
        }
        __syncthreads();
        {
            const float decay = misc[0];
            bf16x8 Af[2][2], Wf[2], Kt[2][2];
#pragma unroll
            for (int ks = 0; ks < 2; ++ks) {
                const float4 w0 = *(const float4*)(wts + ks * 32 + lq * 8), w1 = *(const float4*)(wts + ks * 32 + lq * 8 + 4);
                float wv[8] = {w0.x, w0.y, w0.z, w0.w, w1.x, w1.y, w1.z, w1.w};
                { union { bf16x8 v; uint4 q; } t; t.q = pack8(wv); Wf[ks] = t.v; }
#pragma unroll
                for (int vt = 0; vt < 2; ++vt) {
                    const uint4 raw = *(const uint4*)(VTM + (size_t)(vt * 16 + lr) * 2048 + t0 + ks * 32 + lq * 8);
                    float f[8] = {bf_lo(raw.x) * wv[0], bf_hi(raw.x) * wv[1], bf_lo(raw.y) * wv[2], bf_hi(raw.y) * wv[3], bf_lo(raw.z) * wv[4], bf_hi(raw.z) * wv[5], bf_lo(raw.w) * wv[6], bf_hi(raw.w) * wv[7]};
                    union { bf16x8 v; uint4 q; } t; t.q = pack8(f); Af[vt][ks] = t.v;
                }
#pragma unroll
                for (int kt = 0; kt < 2; ++kt) Kt[kt][ks] = *(const bf16x8*)(KTB + (size_t)((2 * w + kt) * 16 + lr) * 2048 + t0 + ks * 32 + lq * 8);
            }
#pragma unroll
            for (int kt = 0; kt < 2; ++kt) {
                nm[kt] = nm[kt] * decay;
#pragma unroll
                for (int ks = 0; ks < 2; ++ks) nm[kt] = __builtin_amdgcn_mfma_f32_16x16x32_bf16(Wf[ks], Kt[kt][ks], nm[kt], 0, 0, 0);
                if (lq == 0) nl[(2 * w + kt) * 16 + lr] = (bf16_t)(cvt_pk_bf16(nm[kt][0], 0.f) & 0xffffu);
#pragma unroll
                for (int vt = 0; vt < 2; ++vt) {
                    Cm[vt][kt] = Cm[vt][kt] * decay;
#pragma unroll
                    for (int ks = 0; ks < 2; ++ks) Cm[vt][kt] = __builtin_amdgcn_mfma_f32_16x16x32_bf16(Af[vt][ks], Kt[kt][ks], Cm[vt][kt], 0, 0, 0);
                    const unsigned c01 = cvt_pk_bf16(Cm[vt][kt][0], Cm[vt][kt][1]), c23 = cvt_pk_bf16(Cm[vt][kt][2], Cm[vt][kt][3]);
                    bf16_t* cp = Cl + (vt * 16 + lq * 4) * 136 + (2 * w + kt) * 16 + lr;
                    cp[0] = (bf16_t)(c01 & 0xffffu); cp[136] = (bf16_t)(c01 >> 16); cp[272] = (bf16_t)(c23 & 0xffffu); cp[408] = (bf16_t)(c23 >> 16);
                }
            }
            m_prev = misc[1];
        }
        __syncthreads();
    }
#pragma unroll
    for (int vt = 0; vt < 2; ++vt)
#pragma unroll
        for (int kt = 0; kt < 2; ++kt)
#pragma unroll
            for (int g = 0; g < 4; ++g)
                p.out[O_CP + ((size_t)((b * 4 + h) * 128) + vs * 32 + vt * 16 + lq * 4 + g) * 128 + (2 * w + kt) * 16 + lr] = Cm[vt][kt][g];
    if (vs == 0) {
        if (lq == 0) { p.out[O_NP + (size_t)(b * 4 + h) * 128 + (2 * w) * 16 + lr] = nm[0][0]; p.out[O_NP + (size_t)(b * 4 + h) * 128 + (2 * w + 1) * 16 + lr] = nm[1][0]; }
        if (tid == 0) p.out[O_MP + b * 4 + h] = m_prev;
    }
}

DEV unsigned dpp_max16(unsigned x) {
    x = max(x, (unsigned)__builtin_amdgcn_update_dpp(0, (int)x, 0xB1, 0xF, 0xF, false));
    x = max(x, (unsigned)__builtin_amdgcn_update_dpp(0, (int)x, 0x4E, 0xF, 0xF, false));
    x = max(x, (unsigned)__builtin_amdgcn_update_dpp(0, (int)x, 0x141, 0xF, 0xF, false));
    x = max(x, (unsigned)__builtin_amdgcn_update_dpp(0, (int)x, 0x140, 0xF, 0xF, false));
    return x;
}
DEV float dpp_sum16(float x) {
    x += __builtin_bit_cast(float, __builtin_amdgcn_update_dpp(0, __builtin_bit_cast(int, x), 0xB1, 0xF, 0xF, false));
    x += __builtin_bit_cast(float, __builtin_amdgcn_update_dpp(0, __builtin_bit_cast(int, x), 0x4E, 0xF, 0xF, false));
    x += __builtin_bit_cast(float, __builtin_amdgcn_update_dpp(0, __builtin_bit_cast(int, x), 0x141, 0xF, 0xF, false));
    x += __builtin_bit_cast(float, __builtin_amdgcn_update_dpp(0, __builtin_bit_cast(int, x), 0x140, 0xF, 0xF, false));
    return x;
}
DEV unsigned mono_key(float v) { const unsigned b = __float_as_uint(v); return (b & 0x80000000u) ? ~b : (b | 0x80000000u); }
#define CE_DESC(a, b) { const unsigned hi_ = max(a, b), lo_ = min(a, b); a = hi_; b = lo_; }

DEV void peer_score_topk_item(const Params& p, const int tile, const int h, unsigned char* lds) {
    int tid_ = threadIdx.x; asm volatile("" : "+v"(tid_));
    const int tid = tid_, lane = tid & 63, w = tid >> 6, lr = lane & 15, lq = lane >> 4;
    float* sc = (float*)(lds + w * 12416);
    float* ts = sc + 16 * 129;
    int* ti = (int*)(ts + 512);
    const bf16_t* QPB = (const bf16_t*)(p.ws + WS_QPB);
    const bf16_t* SUBK = (const bf16_t*)(p.ws + WS_SUBK);
    int* PIDX = (int*)(p.ws + WS_PIDX); float* PG = (float*)(p.ws + WS_PG);
    const int row0 = tile * 64 + w * 16;
    const int arow = (row0 + lr < NR) ? row0 + lr : NR - 1;
    wave_sync();
#pragma unroll 1
    for (int pp = 0; pp < 2; ++pp) {
        bf16x8 qf[4];
#pragma unroll
        for (int ks = 0; ks < 4; ++ks) qf[ks] = *(const bf16x8*)(QPB + (size_t)arow * 2048 + h * 256 + pp * 128 + ks * 32 + lq * 8);
#pragma unroll
        for (int j = 0; j < 8; ++j) {
            f32x4 a = (f32x4){0.f, 0.f, 0.f, 0.f};
#pragma unroll
            for (int ks = 0; ks < 4; ++ks) { const bf16x8 kf = *(const bf16x8*)(SUBK + ((size_t)pp * 128 + j * 16 + lr) * 128 + ks * 32 + lq * 8); a = __builtin_amdgcn_mfma_f32_16x16x32_bf16(qf[ks], kf, a, 0, 0, 0); }
#pragma unroll
            for (int g = 0; g < 4; ++g) sc[(lq * 4 + g) * 129 + j * 16 + lr] = a[g];
        }
        wave_sync();
#pragma unroll 1
        for (int rr = 0; rr < 4; ++rr) {
            const int row = rr * 4 + lq;
            unsigned k0, k1, k2, k3, k4, k5, k6, k7;
            { const float* sr = sc + row * 129 + lr;
              k0 = (mono_key(sr[0]) & ~0x7Fu) | (unsigned)(127 - lr);        k1 = (mono_key(sr[16]) & ~0x7Fu) | (unsigned)(127 - 16 - lr);
              k2 = (mono_key(sr[32]) & ~0x7Fu) | (unsigned)(127 - 32 - lr);  k3 = (mono_key(sr[48]) & ~0x7Fu) | (unsigned)(127 - 48 - lr);
              k4 = (mono_key(sr[64]) & ~0x7Fu) | (unsigned)(127 - 64 - lr);  k5 = (mono_key(sr[80]) & ~0x7Fu) | (unsigned)(127 - 80 - lr);
              k6 = (mono_key(sr[96]) & ~0x7Fu) | (unsigned)(127 - 96 - lr);  k7 = (mono_key(sr[112]) & ~0x7Fu) | (unsigned)(127 - 112 - lr); }
            CE_DESC(k0, k1) CE_DESC(k2, k3) CE_DESC(k4, k5) CE_DESC(k6, k7)
            CE_DESC(k0, k2) CE_DESC(k1, k3) CE_DESC(k4, k6) CE_DESC(k5, k7)
            CE_DESC(k1, k2) CE_DESC(k5, k6)
            CE_DESC(k0, k4) CE_DESC(k1, k5) CE_DESC(k2, k6) CE_DESC(k3, k7)
            CE_DESC(k2, k4) CE_DESC(k3, k5)
            CE_DESC(k1, k2) CE_DESC(k3, k4) CE_DESC(k5, k6)
            unsigned mine = 0u;
#pragma unroll
            for (int r = 0; r < 16; ++r) {
                const unsigned best = dpp_max16(k0);
                if (lr == r) mine = best;
                const bool own = (k0 == best);
                k0 = own ? k1 : k0; k1 = own ? k2 : k1; k2 = own ? k3 : k2; k3 = own ? k4 : k3; k4 = own ? k5 : k4; k5 = own ? k6 : k5; k6 = own ? k7 : k6; k7 = own ? 0u : k7;
            }
            const int idx = 127 - (int)(mine & 0x7Fu);
            ts[(pp * 16 + row) * 16 + lr] = sc[row * 129 + idx];
            ti[(pp * 16 + row) * 16 + lr] = idx;
        }
        wave_sync();
    }
#pragma unroll 1
    for (int rr = 0; rr < 4; ++rr) {
        const int row = rr * 4 + lq;
        const float s1a = ts[row * 16 + lr];
        const float* s2 = ts + (16 + row) * 16;
        int ptr = 0;
        unsigned key = (mono_key(s1a + s2[0]) & ~0xFFu) | (unsigned)(255 - lr * 16);
        unsigned mine = 0u;
#pragma unroll
        for (int r = 0; r < 16; ++r) {
            const unsigned best = dpp_max16(key);
            if (lr == r) mine = best;
            if (key == best) { ++ptr; key = (ptr < 16) ? ((mono_key(s1a + s2[ptr & 15]) & ~0xFFu) | (unsigned)(255 - lr * 16 - ptr)) : 0u; }
        }
        const int ci = 255 - (int)(mine & 0xFFu), a = ci >> 4, bb = ci & 15;
        const float scv = ts[row * 16 + a] + s2[bb];
        const int e = ti[row * 16 + a] * 128 + ti[(16 + row) * 16 + bb];
        float m16 = scv;
        m16 = fmaxf(m16, __builtin_bit_cast(float, __builtin_amdgcn_update_dpp(0, __builtin_bit_cast(int, m16), 0xB1, 0xF, 0xF, false)));
        m16 = fmaxf(m16, __builtin_bit_cast(float, __builtin_amdgcn_update_dpp(0, __builtin_bit_cast(int, m16), 0x4E, 0xF, 0xF, false)));
        m16 = fmaxf(m16, __builtin_bit_cast(float, __builtin_amdgcn_update_dpp(0, __builtin_bit_cast(int, m16), 0x141, 0xF, 0xF, false)));
        m16 = fmaxf(m16, __builtin_bit_cast(float, __builtin_amdgcn_update_dpp(0, __builtin_bit_cast(int, m16), 0x140, 0xF, 0xF, false)));
        const float ex = expf(scv - m16);
        const float den = dpp_sum16(ex);
        const int grow = row0 + row;
        if (grow < NR) { PIDX[(size_t)grow * 128 + h * 16 + lr] = e; PG[(size_t)grow * 128 + h * 16 + lr] = ex / den; }
    }
}

DEV void peer_expert_wave(const Params& p, const int row, unsigned char* wl, const int lane) {
    const int lr = lane & 15, lq = lane >> 4;
    bf16_t* xl = (bf16_t*)wl;
    float* coefl = (float*)(wl + 2048);
    int* idxl = (int*)(wl + 2048 + 512);
    const bf16_t* X1B = (const bf16_t*)(p.ws + WS_X1B) + (size_t)row * 1024;
    const float* X1 = (const float*)(p.ws + WS_X1) + (size_t)row * 1024;
    const int* PIDX = (const int*)(p.ws + WS_PIDX) + (size_t)row * 128;
    const float* PG = (const float*)(p.ws + WS_PG) + (size_t)row * 128;
    const bf16_t* UB = (const bf16_t*)(p.ws + WS_UB);
    const bf16_t* VB = (const bf16_t*)(p.ws + WS_VB);
    wave_sync();
    *(uint4*)(xl + lane * 8) = *(const uint4*)(X1B + lane * 8);
    *(uint4*)(xl + 512 + lane * 8) = *(const uint4*)(X1B + 512 + lane * 8);
    idxl[lane] = PIDX[lane]; idxl[64 + lane] = PIDX[64 + lane];
    wave_sync();
    for (int h = 0; h < 8; ++h) {
        const bf16_t* ub = UB + (size_t)idxl[h * 16 + lr] * 1024 + lq * 8;
        f32x4 acc = (f32x4){0.f, 0.f, 0.f, 0.f};
#pragma unroll
        for (int kb = 0; kb < 4; ++kb) {
            bf16x8 uf[8];
#pragma unroll
            for (int i = 0; i < 8; ++i) uf[i] = *(const bf16x8*)(ub + (kb * 8 + i) * 32);
#pragma unroll
            for (int i = 0; i < 8; ++i) { const bf16x8 a = *(const bf16x8*)(xl + (kb * 8 + i) * 32 + lq * 8); acc = __builtin_amdgcn_mfma_f32_16x16x32_bf16(a, uf[i], acc, 0, 0, 0); }
        }
        if (lq == 0) coefl[h * 16 + lr] = PG[h * 16 + lr] * gelu_tanh(acc[0]);
    }
    wave_sync();
    float o[16];
#pragma unroll
    for (int i = 0; i < 16; ++i) o[i] = 0.f;
    for (int j = 0; j < 128; j += 4) {
        uint4 va[4], vb[4]; float c[4];
#pragma unroll
        for (int u = 0; u < 4; ++u) { const bf16_t* vr = VB + (size_t)idxl[j + u] * 1024 + lane * 8; c[u] = coefl[j + u]; va[u] = *(const uint4*)vr; vb[u] = *(const uint4*)(vr + 512); }
#pragma unroll
        for (int u = 0; u < 4; ++u) {
            o[0] += c[u] * bf_lo(va[u].x); o[1] += c[u] * bf_hi(va[u].x); o[2] += c[u] * bf_lo(va[u].y); o[3] += c[u] * bf_hi(va[u].y);
            o[4] += c[u] * bf_lo(va[u].z); o[5] += c[u] * bf_hi(va[u].z); o[6] += c[u] * bf_lo(va[u].w); o[7] += c[u] * bf_hi(va[u].w);
            o[8] += c[u] * bf_lo(vb[u].x); o[9] += c[u] * bf_hi(vb[u].x); o[10] += c[u] * bf_lo(vb[u].y); o[11] += c[u] * bf_hi(vb[u].y);
            o[12] += c[u] * bf_lo(vb[u].z); o[13] += c[u] * bf_hi(vb[u].z); o[14] += c[u] * bf_lo(vb[u].w); o[15] += c[u] * bf_hi(vb[u].w);
        }
    }
    float tv[16]; float s = 0.f;
#pragma unroll
    for (int hb = 0; hb < 2; ++hb) {
        const float4 x0 = *(const float4*)(X1 + hb * 512 + lane * 8), x1v = *(const float4*)(X1 + hb * 512 + lane * 8 + 4);
        tv[hb * 8 + 0] = DN_ALPHA * x0.x + o[hb * 8 + 0]; tv[hb * 8 + 1] = DN_ALPHA * x0.y + o[hb * 8 + 1]; tv[hb * 8 + 2] = DN_ALPHA * x0.z + o[hb * 8 + 2]; tv[hb * 8 + 3] = DN_ALPHA * x0.w + o[hb * 8 + 3];
        tv[hb * 8 + 4] = DN_ALPHA * x1v.x + o[hb * 8 + 4]; tv[hb * 8 + 5] = DN_ALPHA * x1v.y + o[hb * 8 + 5]; tv[hb * 8 + 6] = DN_ALPHA * x1v.z + o[hb * 8 + 6]; tv[hb * 8 + 7] = DN_ALPHA * x1v.w + o[hb * 8 + 7];
    }
#pragma unroll
    for (int i = 0; i < 16; ++i) s += tv[i];
    const float mu = wave_sum(s) * (1.0f / 1024.0f);
    float q = 0.f;
#pragma unroll
    for (int i = 0; i < 16; ++i) { const float d = tv[i] - mu; q += d * d; }
    const float rstd = 1.0f / sqrtf(wave_sum(q) * (1.0f / 1024.0f) + LN_EPS);
    float* y = p.out + O_Y + (size_t)row * 1024;
#pragma unroll
    for (int hb = 0; hb < 2; ++hb) {
        const int c = hb * 512 + lane * 8;
        const float4 g0 = *(const float4*)(p.ln2_g + c), g1 = *(const float4*)(p.ln2_g + c + 4), b0 = *(const float4*)(p.ln2_b + c), b1 = *(const float4*)(p.ln2_b + c + 4);
        float4 y0, y1;
        y0.x = (tv[hb * 8 + 0] - mu) * rstd * g0.x + b0.x; y0.y = (tv[hb * 8 + 1] - mu) * rstd * g0.y + b0.y; y0.z = (tv[hb * 8 + 2] - mu) * rstd * g0.z + b0.z; y0.w = (tv[hb * 8 + 3] - mu) * rstd * g0.w + b0.w;
        y1.x = (tv[hb * 8 + 4] - mu) * rstd * g1.x + b1.x; y1.y = (tv[hb * 8 + 5] - mu) * rstd * g1.y + b1.y; y1.z = (tv[hb * 8 + 6] - mu) * rstd * g1.z + b1.z; y1.w = (tv[hb * 8 + 7] - mu) * rstd * g1.w + b1.w;
        *(float4*)(y + c) = y0; *(float4*)(y + c + 4) = y1;
    }
}

constexpr int QN = 2;
struct AttnState { f32x4 ot[4][QN]; float m[QN]; float l[QN]; };

DEV void attn_block(const unsigned char* Ks, const unsigned char* VTs, const bf16x8 (&Qf)[QN][2], AttnState& A, const int mode, const int dq, const float* blut,
                    const unsigned selbit0, const unsigned selbit1, const bool slc, const int lr, const int lq, const int t0, const int ci0) {
    f32x4 sc[4][QN];
#pragma unroll
    for (int kt = 0; kt < 4; ++kt) {
        const bf16x8 k0 = *(const bf16x8*)(Ks + (kt * 16 + lr) * 144 + lq * 16), k1 = *(const bf16x8*)(Ks + (kt * 16 + lr) * 144 + 64 + lq * 16);
#pragma unroll
        for (int qi = 0; qi < QN; ++qi) {
            f32x4 a = (f32x4){0.f, 0.f, 0.f, 0.f};
            a = __builtin_amdgcn_mfma_f32_16x16x32_bf16(k0, Qf[qi][0], a, 0, 0, 0);
            a = __builtin_amdgcn_mfma_f32_16x16x32_bf16(k1, Qf[qi][1], a, 0, 0, 0);
            sc[kt][qi] = a;
        }
    }
    asm volatile("" ::: "memory");
    if (mode != 0 || slc) {
#pragma unroll
        for (int kt = 0; kt < 4; ++kt)
#pragma unroll
            for (int qi = 0; qi < QN; ++qi)
#pragma unroll
                for (int g = 0; g < 4; ++g) {
                    const int kl = kt * 16 + lq * 4 + g, ql = qi * 16 + lr;
                    float v = sc[kt][qi][g];
                    bool ok = true;
                    if (mode == 1 || mode == 2) { const int di = dq + ql - kl; v += blut[di < 0 ? 0 : di]; }
                    if (mode == 2) ok = kl <= ql + dq;
                    if (mode == 3) ok = kl > ql + dq - 512;
                    if (mode == 4) { const int ci = ci0 + kl, dist = t0 + ql - (16 * ci + 31); ok = (dist >= 0) && (ci < 127); if (dist >= 0 && dist < 192) v += blut[dist]; }
                    if (slc) ok = ok && ((qi == 0 ? selbit0 : selbit1) != 0u);
                    sc[kt][qi][g] = ok ? v : NEGF;
                }
    }
    bf16x8 pf[QN][2];
#pragma unroll
    for (int qi = 0; qi < QN; ++qi) {
        float mb = NEGF;
#pragma unroll
        for (int kt = 0; kt < 4; ++kt) mb = fmaxf(mb, fmaxf(fmaxf(sc[kt][qi][0], sc[kt][qi][1]), fmaxf(sc[kt][qi][2], sc[kt][qi][3])));
        mb = fmaxf(mb, __shfl_xor(mb, 16)); mb = fmaxf(mb, __shfl_xor(mb, 32));
        const float mn = fmaxf(A.m[qi], mb);
        const float alpha = __builtin_amdgcn_exp2f(A.m[qi] - mn);
        A.m[qi] = mn;
        float rs = 0.f;
#pragma unroll
        for (int kt = 0; kt < 4; ++kt)
#pragma unroll
            for (int g = 0; g < 4; ++g) { const float v = sc[kt][qi][g]; const float e = (v > -1e29f) ? __builtin_amdgcn_exp2f(v - mn) : 0.f; sc[kt][qi][g] = e; rs += e; }
        A.l[qi] = A.l[qi] * alpha + rs;
#pragma unroll
        for (int dt = 0; dt < 4; ++dt) A.ot[dt][qi] = A.ot[dt][qi] * alpha;
#pragma unroll
        for (int ks = 0; ks < 2; ++ks) {
            union { bf16x8 v; unsigned u[4]; } pk;
            pk.u[0] = cvt_pk_bf16(sc[2 * ks][qi][0], sc[2 * ks][qi][1]); pk.u[1] = cvt_pk_bf16(sc[2 * ks][qi][2], sc[2 * ks][qi][3]);
            pk.u[2] = cvt_pk_bf16(sc[2 * ks + 1][qi][0], sc[2 * ks + 1][qi][1]); pk.u[3] = cvt_pk_bf16(sc[2 * ks + 1][qi][2], sc[2 * ks + 1][qi][3]);
            pf[qi][ks] = pk.v;
        }
    }
    asm volatile("" ::: "memory");
#pragma unroll
    for (int dt = 0; dt < 4; ++dt)
#pragma unroll
        for (int ks = 0; ks < 2; ++ks) {
            asm volatile("" ::: "memory");
            union { bf16x8 v; uint2 h[2]; } vf;
            vf.h[0] = *(const uint2*)(VTs + (dt * 16 + lr) * 144 + (32 * ks + lq * 4) * 2);
            vf.h[1] = *(const uint2*)(VTs + (dt * 16 + lr) * 144 + (32 * ks + 16 + lq * 4) * 2);
#pragma unroll
            for (int qi = 0; qi < QN; ++qi) A.ot[dt][qi] = __builtin_amdgcn_mfma_f32_16x16x32_bf16(vf.v, pf[qi][ks], A.ot[dt][qi], 0, 0, 0);
        }
}

DEV void nsa_prompt_item(const Params& p, const int b, const int hkv, const int q32, unsigned char* lds) {
    int tid_ = threadIdx.x; asm volatile("" : "+v"(tid_));
    const int tid = tid_, lane = tid & 63, g = tid >> 6, lr = lane & 15, lq = lane >> 4;
    const int hq = hkv * 4 + g, t0 = q32 * 32, kd = t0 >> 6;
    unsigned char* Ks = lds; unsigned char* VTs = lds + 9216;
    float* biasl = (float*)(lds + 18432); float* psl = (float*)(lds + 21504); unsigned* selm = (unsigned*)(lds + 29952); unsigned* misc = (unsigned*)(lds + 30208);
    const bf16_t* ZB = (const bf16_t*)(p.ws + WS_ZB);
    const bf16_t* VTS = (const bf16_t*)(p.ws + WS_VTS) + (size_t)(b * 2 + hkv) * 64 * 2048;
    const bf16_t* VTW = (const bf16_t*)(p.ws + WS_VTW) + (size_t)(b * 2 + hkv) * 64 * 2048;
    const bf16_t* KCB = (const bf16_t*)(p.ws + WS_KCB) + (size_t)(b * 2 + hkv) * 128 * 64;
    const bf16_t* VTC = (const bf16_t*)(p.ws + WS_VTC) + (size_t)(b * 2 + hkv) * 64 * 128;
    const float* Z = (const float*)(p.ws + WS_Z);
    float* NOUTF = (float*)(p.ws + WS_NOUTF);
    bf16_t* NOUTB = (bf16_t*)(p.ws + WS_NOUTB);
    __syncthreads();
    for (int i = tid; i < 4 * 192; i += 256) { const int gg = i / 192, d = i % 192; biasl[i] = (p.rel_bias[rel_bucket(d) * 8 + hkv * 4 + gg] - p.rel_bias[31 * 8 + hkv * 4 + gg]) * LOG2E; }
    for (int i = tid; i < 32 * 33; i += 256) psl[i] = 0.f;
    if (tid < 32) selm[tid] = 0u;
    if (tid == 0) misc[0] = 0u;
    const float* blut = biasl + g * 192;
    bf16x8 Qf[QN][2];
#pragma unroll
    for (int qi = 0; qi < QN; ++qi)
#pragma unroll
        for (int kk = 0; kk < 2; ++kk) Qf[qi][kk] = *(const bf16x8*)(ZB + (size_t)(b * 2048 + t0 + qi * 16 + lr) * IN_DIM + C_Q + hq * 64 + kk * 32 + lq * 8);

    uint4 trk0, trk1, trv0, trv1;
    auto load_tiles = [&](int kind, int kb) __attribute__((always_inline)) {
#pragma unroll
        for (int i = 0; i < 2; ++i) {
            const int id = tid + 256 * i, row = id >> 3, ch = id & 7;
            uint4 rk, rv;
            if (kind == 0) { rk = *(const uint4*)(KCB + (size_t)(kb * 64 + row) * 64 + ch * 8); rv = *(const uint4*)(VTC + (size_t)row * 128 + kb * 64 + ch * 8); }
            else {
                rk = *(const uint4*)(ZB + (size_t)(b * 2048 + kb * 64 + row) * IN_DIM + (kind == 1 ? C_KS : C_KW) + hkv * 64 + ch * 8);
                rv = *(const uint4*)((kind == 1 ? VTS : VTW) + (size_t)row * 2048 + kb * 64 + ch * 8);
            }
            if (i == 0) { trk0 = rk; trv0 = rv; } else { trk1 = rk; trv1 = rv; }
        }
    };
    auto store_tiles = [&]() __attribute__((always_inline)) {
#pragma unroll
        for (int i = 0; i < 2; ++i) { const int id = tid + 256 * i, row = id >> 3, ch = id & 7; *(uint4*)(Ks + row * 144 + ch * 16) = (i == 0 ? trk0 : trk1); *(uint4*)(VTs + row * 144 + ch * 16) = (i == 0 ? trv0 : trv1); }
    };
    auto reset = [&](AttnState& A) __attribute__((always_inline)) {
#pragma unroll
        for (int qi = 0; qi < QN; ++qi) { A.m[qi] = NEGF; A.l[qi] = 0.f;
#pragma unroll
            for (int dt = 0; dt < 4; ++dt) A.ot[dt][qi] = (f32x4){0.f, 0.f, 0.f, 0.f}; }
    };
    auto finish = [&](AttnState& A, int br) __attribute__((always_inline)) {
#pragma unroll
        for (int qi = 0; qi < QN; ++qi) {
            float lt = A.l[qi]; lt += __shfl_xor(lt, 16); lt += __shfl_xor(lt, 32);
            const float sc = (lt > 0.f) ? sigmoidf_(Z[(size_t)(b * 2048 + t0 + qi * 16 + lr) * IN_DIM + C_G + br * 8 + hq]) / lt : 0.f;
            const size_t row = (size_t)(b * 2048 + t0 + qi * 16 + lr);
#pragma unroll
            for (int dt = 0; dt < 4; ++dt) {
                const int col = hq * 64 + dt * 16 + lq * 4;
                f32x4 v = A.ot[dt][qi] * sc;
                if (br > 0) v = v + *(const f32x4*)(NOUTF + row * 512 + col);
                if (br < 2) *(f32x4*)(NOUTF + row * 512 + col) = v; else store_bf16x4(NOUTB + row * 512 + col, v);
            }
        }
    };

    AttnState A;
    const int ncb = ((t0 >> 4) >= 64) ? 2 : 1;
    reset(A);
    load_tiles(0, 0);
    for (int kb = 0; kb < ncb; ++kb) {
        __syncthreads(); store_tiles(); __syncthreads();
        if (kb + 1 < ncb) load_tiles(0, kb + 1);
        attn_block(Ks, VTs, Qf, A, 4, 0, blut, 1u, 1u, false, lr, lq, t0, kb * 64);
    }
    finish(A, 0);
    {
        float linv[QN];
#pragma unroll
        for (int qi = 0; qi < QN; ++qi) { float lt = A.l[qi]; lt += __shfl_xor(lt, 16); lt += __shfl_xor(lt, 32); linv[qi] = (lt > 0.f) ? 1.0f / lt : 0.f; }
        for (int kb = 0; kb < ncb; ++kb) {
            if (ncb > 1) { load_tiles(0, kb); __syncthreads(); store_tiles(); __syncthreads(); }
#pragma unroll
            for (int kt = 0; kt < 4; ++kt) {
                const bf16x8 k0 = *(const bf16x8*)(Ks + (kt * 16 + lr) * 144 + lq * 16), k1 = *(const bf16x8*)(Ks + (kt * 16 + lr) * 144 + 64 + lq * 16);
#pragma unroll
                for (int qi = 0; qi < QN; ++qi) {
                    f32x4 a = (f32x4){0.f, 0.f, 0.f, 0.f};
                    a = __builtin_amdgcn_mfma_f32_16x16x32_bf16(k0, Qf[qi][0], a, 0, 0, 0);
                    a = __builtin_amdgcn_mfma_f32_16x16x32_bf16(k1, Qf[qi][1], a, 0, 0, 0);
                    float pr[4];
#pragma unroll
                    for (int gg = 0; gg < 4; ++gg) {
                        const int ci = kb * 64 + kt * 16 + lq * 4 + gg, ql = qi * 16 + lr, dist = t0 + ql - (16 * ci + 31);
                        float v = a[gg];
                        if (dist >= 0 && dist < 192) v += blut[dist];
                        pr[gg] = (dist >= 0 && ci < 127) ? __builtin_amdgcn_exp2f(v - A.m[qi]) * linv[qi] : 0.f;
                    }
                    const int blk = kb * 16 + kt * 4 + lq, ql = qi * 16 + lr;
                    atomicAdd(&psl[ql * 33 + blk], 2.0f * (pr[0] + pr[1] + pr[2]) + pr[3]);
                    atomicAdd(&psl[ql * 33 + blk + 1], pr[3]);
                }
            }
        }
    }
    __syncthreads();
    {
        const int ql = tid >> 3, part = tid & 7, tq = t0 + ql, cur = tq >> 6;
        float scv[32];
#pragma unroll
        for (int j = 0; j < 32; ++j) {
            const bool causal = j * 64 <= tq, forced = (j == 0) || (j == cur) || (j == cur - 1);
            scv[j] = causal ? (forced ? 1e4f : psl[ql * 33 + j]) : NEGF;
        }
        unsigned mbits = 0u;
#pragma unroll
        for (int jj = 0; jj < 4; ++jj) {
            const int j = part * 4 + jj;
            float my = NEGF;
#pragma unroll
            for (int k = 0; k < 32; ++k) my = (k == j) ? scv[k] : my;
            int rank = 0;
#pragma unroll
            for (int k = 0; k < 32; ++k) rank += ((scv[k] > my) || (scv[k] == my && k < j)) ? 1 : 0;
            if (rank < 16 && j * 64 <= tq) mbits |= (1u << j);
        }
        atomicOr(&selm[ql], mbits);
        atomicOr(&misc[0], mbits);
    }
    __syncthreads();
    const unsigned msk0 = selm[lr], msk1 = selm[16 + lr];
    const unsigned anym = misc[0];
    reset(A);
    {
        int kb = kd;
        load_tiles(1, kb);
        for (;;) {
            __syncthreads(); store_tiles(); __syncthreads();
            int nxt = (kb == kd) ? 0 : kb + 1;
            while (nxt < kd && !((anym >> nxt) & 1u)) ++nxt;
            const bool more = nxt < kd;
            if (more) load_tiles(1, nxt);
            const int mode = (kb == kd) ? 2 : ((kb >= kd - 2) ? 1 : 0);
            attn_block(Ks, VTs, Qf, A, mode, t0 - kb * 64, blut, (msk0 >> kb) & 1u, (msk1 >> kb) & 1u, true, lr, lq, t0, 0);
            if (!more) break;
            kb = nxt;
        }
    }
    finish(A, 1);
    reset(A);
    {
        const int klo = (t0 >= 511) ? ((t0 - 511) >> 6) : 0;
        int kb = kd;
        load_tiles(2, kb);
        for (;;) {
            __syncthreads(); store_tiles(); __syncthreads();
            const bool more = kb > klo;
            if (more) load_tiles(2, kb - 1);
            const int dq = t0 - kb * 64;
            const int mode = (kb == kd) ? 2 : ((kb >= kd - 2) ? 1 : ((dq + 31 >= 512) ? 3 : 0));
            attn_block(Ks, VTs, Qf, A, mode, dq, blut, 1u, 1u, false, lr, lq, t0, 0);
            if (!more) break;
            --kb;
        }
    }
    finish(A, 2);
}

#define Z ((float*)(p.ws + WS_Z))
#define QK ((float*)(p.ws + WS_QK))
#define HRAW ((float*)(p.ws + WS_HRAW))
#define MOUTB ((bf16_t*)(p.ws + WS_MOUTB))
#define NOUTB ((bf16_t*)(p.ws + WS_NOUTB))
#define HIDPB ((bf16_t*)(p.ws + WS_HIDPB))
#define HIDSB ((bf16_t*)(p.ws + WS_HIDSB))
#define KCS ((float*)(p.ws + WS_KCS))
#define MIX ((float*)(p.ws + WS_MIX))
#define MIXB ((bf16_t*)(p.ws + WS_MIXB))
#define T1 ((float*)(p.ws + WS_T1))
#define X1 ((float*)(p.ws + WS_X1))
#define X1B ((bf16_t*)(p.ws + WS_X1B))
#define QPB ((bf16_t*)(p.ws + WS_QPB))
#define S ((float*)(p.ws + WS_S))
#define CONVB ((bf16_t*)(p.ws + WS_CONVB))
#define XB ((bf16_t*)(p.ws + WS_XB))
#define WIN_T ((bf16_t*)(p.ws + WS_WIN_T))
#define WUPM_T ((bf16_t*)(p.ws + WS_WUPM_T))
#define WUPN_T ((bf16_t*)(p.ws + WS_WUPN_T))
#define WOUT_T ((bf16_t*)(p.ws + WS_WOUT_T))
#define PWQ_T ((bf16_t*)(p.ws + WS_PWQ_T))
#define WQK_T ((bf16_t*)(p.ws + WS_WQK_T))
#define W1_T ((bf16_t*)(p.ws + WS_W1_T))
#define W2_T ((bf16_t*)(p.ws + WS_W2_T))
#define SUBK ((bf16_t*)(p.ws + WS_SUBK))
#define ZB ((bf16_t*)(p.ws + WS_ZB))
#define VTS ((bf16_t*)(p.ws + WS_VTS))
#define VTW ((bf16_t*)(p.ws + WS_VTW))
#define KCB ((bf16_t*)(p.ws + WS_KCB))
#define VTC ((bf16_t*)(p.ws + WS_VTC))
__global__ void __launch_bounds__(NTHREADS, 2) fwd_kernel(Params p) {
    extern __shared__ __attribute__((aligned(16))) unsigned char smem[];
    if (threadIdx.x == 0) { *(uint4*)smem = make_uint4(0u, 0u, 0u, 0u); }
    __syncthreads();
    XcdBarrier bar = xcd_barrier_post((unsigned*)(p.ws + WS_BAR), (volatile LAS unsigned*)smem);
    float* lds = (float*)(smem + 16);
    unsigned char* ldsb = smem + 16;
    const int tid = threadIdx.x, lane = tid & 63, w = tid >> 6;
    const int gw = blockIdx.x * 4 + w, nw = gridDim.x * 4;
    const size_t gt = (size_t)blockIdx.x * NTHREADS + tid, nt = (size_t)gridDim.x * NTHREADS;


    {
        for (size_t id = gt; id < (size_t)MP * 128; id += nt) {
            const int row = (int)(id >> 7), k8 = (int)(id & 127) * 8;
            float f[8];
            if (row < NR) {
                const float* s = (row < NP ? p.x_prompt + (size_t)row * 1024 : p.x_sample + (size_t)(row - NP) * 1024) + k8;
                const float4 a = *(const float4*)s, b = *(const float4*)(s + 4);
                f[0] = a.x; f[1] = a.y; f[2] = a.z; f[3] = a.w; f[4] = b.x; f[5] = b.y; f[6] = b.z; f[7] = b.w;
            } else {
#pragma unroll
                for (int i = 0; i < 8; ++i) f[i] = 0.f;
            }
            *(uint4*)(XB + (size_t)row * 1024 + k8) = pack8(f);
        }
        transpose_to_bf16(p.w_in, 1024, IN_DIM, WIN_T, gt, nt);
        transpose_to_bf16(p.w_up_m, 512, 1024, WUPM_T, gt, nt);
        transpose_to_bf16(p.w_up_n, 512, 1024, WUPN_T, gt, nt);
        transpose_to_bf16(p.w_out, 1024, 1024, WOUT_T, gt, nt);
        transpose_to_bf16(p.peer_wq, 1024, 2048, PWQ_T, gt, nt);
        for (int h = 0; h < 4; ++h) {
            transpose_to_bf16(p.wq + (size_t)h * 16384, 128, 128, WQK_T + (size_t)(h * 256) * 128, gt, nt);
            transpose_to_bf16(p.wk + (size_t)h * 16384, 128, 128, WQK_T + (size_t)(h * 256 + 128) * 128, gt, nt);
        }
        for (int c = 0; c < 2; ++c) {
            transpose_to_bf16(p.cmp_w1 + (size_t)c * 2048 * 64, 2048, 64, W1_T + (size_t)c * 64 * 2048, gt, nt);
            transpose_to_bf16(p.cmp_w2 + (size_t)c * 4096, 64, 64, W2_T + (size_t)c * 4096, gt, nt);
        }
        for (size_t id = gt; id < (size_t)2 * 128 * 128 / 8; id += nt) {
            float f[8];
#pragma unroll
            for (int i = 0; i < 8; ++i) f[i] = p.peer_sub[id * 8 + i];
            *(uint4*)(SUBK + id * 8) = pack8(f);
        }
        for (size_t id = gt; id < (size_t)16384 * 128; id += nt) {
            const float* su = p.peer_u + id * 8; const float* sv = p.peer_v + id * 8;
            const float4 a0 = *(const float4*)su, a1 = *(const float4*)(su + 4), c0 = *(const float4*)sv, c1 = *(const float4*)(sv + 4);
            float f[8] = {a0.x, a0.y, a0.z, a0.w, a1.x, a1.y, a1.z, a1.w}; float g8[8] = {c0.x, c0.y, c0.z, c0.w, c1.x, c1.y, c1.z, c1.w};
            *(uint4*)((bf16_t*)(p.ws + WS_UB) + id * 8) = pack8(f); *(uint4*)((bf16_t*)(p.ws + WS_VB) + id * 8) = pack8(g8);
        }
        for (size_t i = gt; i < (size_t)BS * 511 * 256; i += nt) {
            const int j = (int)(i & 255); const int wv = (int)((i >> 8) % 511); const int b = (int)((i >> 8) / 511);
            p.out[O_WINS + ((size_t)b * 512 + wv) * 256 + j] = p.state_win[((size_t)b * 512 + wv + 1) * 256 + j];
        }
        for (size_t i = gt; i < (size_t)BS * 2 * 512; i += nt) {
            const int ch = (int)(i & 511); const int jj = (int)((i >> 9) & 1); const int b = (int)(i >> 10);
            p.out[O_CVS + ((size_t)b * 3 + jj) * 512 + ch] = p.state_conv[((size_t)b * 3 + jj + 1) * 512 + ch];
        }
    }
    xcd_barrier(bar);

    gemm_bf16<128>(NR, IN_DIM, 1024,
        [&](int r, int k) { return *(const uint4*)(XB + (size_t)r * 1024 + k); },
        [&](int n, int k) { return *(const uint4*)(WIN_T + (size_t)n * 1024 + k); },
        [&](int r, int c0, f32x4 v) {
            *(f32x4*)(Z + (size_t)r * IN_DIM + c0) = v;
            store_bf16x4(ZB + (size_t)r * IN_DIM + c0, (c0 >= C_Q && c0 < C_KC) ? v * (0.125f * LOG2E) : v);
            if (r < NP && ((c0 >= C_KS + 128 && c0 < C_KW) || (c0 >= C_KW + 128 && c0 < C_G))) {
                const bool isw = c0 >= C_KW; const int cc = c0 - (isw ? C_KW : C_KS) - 128;
                bf16_t* vt = (isw ? VTW : VTS) + ((size_t)((r >> 11) * 2) * 64 + cc) * 2048 + (r & 2047);
                const unsigned w0 = cvt_pk_bf16(v[0], v[1]), w1 = cvt_pk_bf16(v[2], v[3]);
                vt[0] = (bf16_t)(w0 & 0xffffu); vt[2048] = (bf16_t)(w0 >> 16); vt[4096] = (bf16_t)(w1 & 0xffffu); vt[6144] = (bf16_t)(w1 >> 16);
            }
            if (r < NP && c0 >= C_V && c0 < C_O) {
                bf16_t* vt = (bf16_t*)(p.ws + WS_VTM) + ((size_t)(r >> 11) * 512 + (c0 - C_V)) * 2048 + (r & 2047);
                const unsigned w0 = cvt_pk_bf16(v[0], v[1]), w1 = cvt_pk_bf16(v[2], v[3]);
                vt[0] = (bf16_t)(w0 & 0xffffu); vt[2048] = (bf16_t)(w0 >> 16); vt[4096] = (bf16_t)(w1 & 0xffffu); vt[6144] = (bf16_t)(w1 >> 16);
            }
            if (c0 >= C_KC && c0 < C_KS) *(f32x4*)(p.out + O_CMPP + (size_t)r * 256 + (c0 - C_KC)) = v;
            else if (c0 >= C_KS && c0 < C_KW) *(f32x4*)(p.out + O_SLCP + (size_t)r * 256 + (c0 - C_KS)) = v;
            else if (c0 >= C_KW && c0 < C_G) {
                if (r < NP) { const int t = r & 2047; if (t >= 1536) *(f32x4*)(p.out + O_WINP + ((size_t)(r >> 11) * 512 + (t - 1536)) * 256 + (c0 - C_KW)) = v; }
                else *(f32x4*)(p.out + O_WINS + ((size_t)(r - NP) * 512 + 511) * 256 + (c0 - C_KW)) = v;
            } else if (c0 < C_V) {
                if (r < NP) { const int t = r & 2047; if (t >= 2045) *(f32x4*)(p.out + O_CVP + ((size_t)(r >> 11) * 3 + (t - 2045)) * 512 + c0) = v; }
                else *(f32x4*)(p.out + O_CVS + ((size_t)(r - NP) * 3 + 2) * 512 + c0) = v;
            }
        }, ldsb);
    xcd_barrier(bar);

    for (size_t i = gt; i < (size_t)NR * 512; i += nt) {
        const int ch = (int)(i & 511); const int r = (int)(i >> 9);
        float a = p.conv_b[ch];
        if (r < NP) {
            const int t = r & 2047;
#pragma unroll
            for (int j = 0; j < 4; ++j) if (t + j - 3 >= 0) a += p.conv_w[j * 512 + ch] * Z[(size_t)(r + j - 3) * IN_DIM + C_U + ch];
        } else {
            const int b = r - NP;
#pragma unroll
            for (int j = 0; j < 3; ++j) a += p.conv_w[j * 512 + ch] * p.state_conv[((size_t)b * 3 + j) * 512 + ch];
            a += p.conv_w[3 * 512 + ch] * Z[(size_t)r * IN_DIM + C_U + ch];
        }
        CONVB[i] = (bf16_t)(cvt_pk_bf16(a / (1.0f + expf(-a)), 0.f) & 0xffffu);
    }
    xcd_barrier(bar);

    for (int h = 0; h < 4; ++h) {
        gemm_bf16<128>(NR, 256, 128,
            [&](int r, int k) { return *(const uint4*)(CONVB + (size_t)r * 512 + h * 128 + k); },
            [&](int n, int k) { return *(const uint4*)(WQK_T + (size_t)(h * 256 + n) * 128 + k); },
            [&](int r, int c0, f32x4 v) {
                if (c0 >= 128) v = v * 0.08838834764831845f;
                *(f32x4*)(QK + (size_t)r * 1024 + h * 256 + c0) = v;
                if (c0 < 128) store_bf16x4((bf16_t*)(p.ws + WS_QB) + (size_t)r * 512 + h * 128 + c0, v);
                else {
                    store_bf16x4((bf16_t*)(p.ws + WS_KB) + (size_t)r * 512 + h * 128 + (c0 - 128), v);
                    if (r < NP) {
                        bf16_t* kt = (bf16_t*)(p.ws + WS_KTB) + ((size_t)((r >> 11) * 4 + h) * 128 + (c0 - 128)) * 2048 + (r & 2047);
                        const unsigned w0 = cvt_pk_bf16(v[0], v[1]), w1 = cvt_pk_bf16(v[2], v[3]);
                        kt[0] = (bf16_t)(w0 & 0xffffu); kt[2048] = (bf16_t)(w0 >> 16); kt[4096] = (bf16_t)(w1 & 0xffffu); kt[6144] = (bf16_t)(w1 >> 16);
                    }
                } }, ldsb);
    }
    for (int c = 0; c < 2; ++c) {
        gemm_bf16<64>(4096, 64, 2048,
            [&](int row, int k) {
                const int hh = row & 1, bi = row >> 1, i = bi & 127, b = bi >> 7, j = k >> 6, d0 = k & 63, tok = 16 * i + j;
                const float* pe = p.cmp_pe + (c * 32 + j) * 64 + d0;
                const float4 e0 = *(const float4*)pe, e1 = *(const float4*)(pe + 4);
                float f[8] = {e0.x, e0.y, e0.z, e0.w, e1.x, e1.y, e1.z, e1.w};
                if (tok < 2048) {
                    const float* s = Z + ((size_t)b * 2048 + tok) * IN_DIM + C_KC + c * 128 + hh * 64 + d0;
                    const float4 a0 = *(const float4*)s, a1 = *(const float4*)(s + 4);
                    f[0] += a0.x; f[1] += a0.y; f[2] += a0.z; f[3] += a0.w; f[4] += a1.x; f[5] += a1.y; f[6] += a1.z; f[7] += a1.w;
                }
                return pack8(f); },
            [&](int n, int k) { return *(const uint4*)(W1_T + ((size_t)c * 64 + n) * 2048 + k); },
            [&](int row, int c0, f32x4 v) {
                f32x4 g; g[0] = gelu_tanh(v[0]); g[1] = gelu_tanh(v[1]); g[2] = gelu_tanh(v[2]); g[3] = gelu_tanh(v[3]);
                store_bf16x4(HIDPB + ((size_t)c * 4096 + row) * 64 + c0, g); }, ldsb);
        gemm_bf16<64>(65536, 64, 2048,
            [&](int row, int k) {
                const int hh = row & 1, bi = row >> 1, i = bi & 1023, b = bi >> 10, j = k >> 6, d0 = k & 63, tok = 16 * i + j;
                const float* pe = p.cmp_pe + (c * 32 + j) * 64 + d0;
                const float4 e0 = *(const float4*)pe, e1 = *(const float4*)(pe + 4);
                float f[8] = {e0.x, e0.y, e0.z, e0.w, e1.x, e1.y, e1.z, e1.w};
                if (tok < PAST) {
                    const int page = p.page_table[b * 128 + (tok >> 7)];
                    const float* s = p.cache_cmp + ((size_t)page * 128 + (tok & 127)) * 256 + c * 128 + hh * 64 + d0;
                    const float4 a0 = *(const float4*)s, a1 = *(const float4*)(s + 4);
                    f[0] += a0.x; f[1] += a0.y; f[2] += a0.z; f[3] += a0.w; f[4] += a1.x; f[5] += a1.y; f[6] += a1.z; f[7] += a1.w;
                }
                return pack8(f); },
            [&](int n, int k) { return *(const uint4*)(W1_T + ((size_t)c * 64 + n) * 2048 + k); },
            [&](int row, int c0, f32x4 v) {
                f32x4 g; g[0] = gelu_tanh(v[0]); g[1] = gelu_tanh(v[1]); g[2] = gelu_tanh(v[2]); g[3] = gelu_tanh(v[3]);
                store_bf16x4(HIDSB + ((size_t)c * 65536 + row) * 64 + c0, g); }, ldsb);
    }
    xcd_barrier(bar);

    for (int item = blockIdx.x; item < 256 + 128; item += gridDim.x) {
        if (item < 256) mlstm_chunk_item(p, item, ldsb); else mlstm_scan_item(p, 64 + (item - 256), lds);
    }
    for (int c = 0; c < 2; ++c) {
        gemm_bf16<64>(4096, 64, 64,
            [&](int row, int k) { return *(const uint4*)(HIDPB + ((size_t)c * 4096 + row) * 64 + k); },
            [&](int n, int k) { return *(const uint4*)(W2_T + ((size_t)c * 64 + n) * 64 + k); },
            [&](int row, int c0, f32x4 v) {
                const int hh = row & 1, bi = row >> 1, i = bi & 127, b = bi >> 7;
                if (c == 0) store_bf16x4(KCB + ((size_t)(b * 2 + hh) * 128 + i) * 64 + c0, v);
                else { bf16_t* vt = VTC + ((size_t)(b * 2 + hh) * 64 + c0) * 128 + i; const unsigned w0 = cvt_pk_bf16(v[0], v[1]), w1 = cvt_pk_bf16(v[2], v[3]);
                       vt[0] = (bf16_t)(w0 & 0xffffu); vt[128] = (bf16_t)(w0 >> 16); vt[256] = (bf16_t)(w1 & 0xffffu); vt[384] = (bf16_t)(w1 >> 16); } }, ldsb);
        gemm_bf16<64>(65536, 64, 64,
            [&](int row, int k) { return *(const uint4*)(HIDSB + ((size_t)c * 65536 + row) * 64 + k); },
            [&](int n, int k) { return *(const uint4*)(W2_T + ((size_t)c * 64 + n) * 64 + k); },
            [&](int row, int c0, f32x4 v) { *(f32x4*)(KCS + ((size_t)c * 65536 + row) * 64 + c0) = v; }, ldsb);
    }
    xcd_barrier(bar);

    for (int it = gw; it < NR * 4; it += nw) {
        const int row = it >> 2, h = it & 3;
        const float x0 = HRAW[(size_t)row * 512 + h * 128 + lane], x1 = HRAW[(size_t)row * 512 + h * 128 + 64 + lane];
        const float mu = wave_sum(x0 + x1) * (1.0f / 128.0f);
        const float d0 = x0 - mu, d1 = x1 - mu;
        const float var = wave_sum(d0 * d0 + d1 * d1) * (1.0f / 128.0f);
        const float rstd = 1.0f / sqrtf(var + LN_EPS);
        const int c0 = h * 128 + lane, c1 = c0 + 64;
        MOUTB[(size_t)row * 512 + c0] = (bf16_t)(cvt_pk_bf16(sigmoidf_(Z[(size_t)row * IN_DIM + C_O + c0]) * (d0 * rstd * p.norm_g[c0]), 0.f) & 0xffffu);
        MOUTB[(size_t)row * 512 + c1] = (bf16_t)(cvt_pk_bf16(sigmoidf_(Z[(size_t)row * IN_DIM + C_O + c1]) * (d1 * rstd * p.norm_g[c1]), 0.f) & 0xffffu);
    }
    if (blockIdx.x < 16) {
        float* wl = lds + w * 4416;
        const int it = blockIdx.x * 4 + w;
        nsa_item(p, NP + (it >> 1), it & 1, wl, lane);
    }
    for (;;) {
        __syncthreads();
        if (tid == 0) *(volatile int*)(ldsb + 30464) = (int)atomicAdd((unsigned*)(p.ws + WS_BAR) + 2, 1u);
        __syncthreads();
        const int idx = *(volatile int*)(ldsb + 30464);
        if (idx >= 2048) break;
        nsa_prompt_item(p, (idx & 31) >> 1, idx & 1, 63 - (idx >> 5), ldsb);
    }
    xcd_barrier(bar);

    gemm_bf16<128>(NR, 1024, 512,
        [&](int r, int k) { return *(const uint4*)(MOUTB + (size_t)r * 512 + k); },
        [&](int n, int k) { return *(const uint4*)(WUPM_T + (size_t)n * 512 + k); },
        [&](int r, int c0, f32x4 v) {
            const f32x4 g = *(const f32x4*)(Z + (size_t)r * IN_DIM + C_GM + c0);
            f32x4 o; o[0] = sigmoidf_(g[0]) * v[0]; o[1] = sigmoidf_(g[1]) * v[1]; o[2] = sigmoidf_(g[2]) * v[2]; o[3] = sigmoidf_(g[3]) * v[3];
            *(f32x4*)(MIX + (size_t)r * 1024 + c0) = o; }, ldsb);
    gemm_bf16<128>(NR, 1024, 512,
        [&](int r, int k) { return *(const uint4*)(NOUTB + (size_t)r * 512 + k); },
        [&](int n, int k) { return *(const uint4*)(WUPN_T + (size_t)n * 512 + k); },
        [&](int r, int c0, f32x4 v) {
            const f32x4 g = *(const f32x4*)(Z + (size_t)r * IN_DIM + C_GN + c0);
            f32x4 o = *(const f32x4*)(MIX + (size_t)r * 1024 + c0);
            o[0] += sigmoidf_(g[0]) * v[0]; o[1] += sigmoidf_(g[1]) * v[1]; o[2] += sigmoidf_(g[2]) * v[2]; o[3] += sigmoidf_(g[3]) * v[3];
            store_bf16x4(MIXB + (size_t)r * 1024 + c0, o); }, ldsb);
    xcd_barrier(bar);

    gemm_bf16<128>(NR, 1024, 1024,
        [&](int r, int k) { return *(const uint4*)(MIXB + (size_t)r * 1024 + k); },
        [&](int n, int k) { return *(const uint4*)(WOUT_T + (size_t)n * 1024 + k); },
        [&](int r, int c0, f32x4 v) {
            const f32x4 xv = *(const f32x4*)((r < NP ? p.x_prompt + (size_t)r * 1024 : p.x_sample + (size_t)(r - NP) * 1024) + c0);
            *(f32x4*)(T1 + (size_t)r * 1024 + c0) = xv * DN_ALPHA + v; }, ldsb);
    xcd_barrier(bar);

    for (int row = gw; row < NR; row += nw) {
        float tv[16]; float s = 0.f;
#pragma unroll
        for (int j = 0; j < 4; ++j) { const float4 t4 = *(const float4*)(T1 + (size_t)row * 1024 + j * 256 + lane * 4); tv[4 * j] = t4.x; tv[4 * j + 1] = t4.y; tv[4 * j + 2] = t4.z; tv[4 * j + 3] = t4.w; s += (t4.x + t4.y) + (t4.z + t4.w); }
        const float mu = wave_sum(s) * (1.0f / 1024.0f);
        float q = 0.f;
#pragma unroll
        for (int j = 0; j < 16; ++j) { const float d = tv[j] - mu; q += d * d; }
        const float rstd = 1.0f / sqrtf(wave_sum(q) * (1.0f / 1024.0f) + LN_EPS);
#pragma unroll
        for (int j = 0; j < 4; ++j) {
            const int c = j * 256 + lane * 4;
            const float4 g4 = *(const float4*)(p.ln1_g + c), b4 = *(const float4*)(p.ln1_b + c);
            f32x4 o; o[0] = (tv[4 * j] - mu) * rstd * g4.x + b4.x; o[1] = (tv[4 * j + 1] - mu) * rstd * g4.y + b4.y; o[2] = (tv[4 * j + 2] - mu) * rstd * g4.z + b4.z; o[3] = (tv[4 * j + 3] - mu) * rstd * g4.w + b4.w;
            *(f32x4*)(X1 + (size_t)row * 1024 + c) = o;
            store_bf16x4(X1B + (size_t)row * 1024 + c, o);
        }
    }
    xcd_barrier(bar);

    gemm_bf16<128>(NR, 2048, 1024,
        [&](int r, int k) { return *(const uint4*)(X1B + (size_t)r * 1024 + k); },
        [&](int n, int k) { return *(const uint4*)(PWQ_T + (size_t)n * 1024 + k); },
        [&](int r, int c0, f32x4 v) { store_bf16x4(QPB + (size_t)r * 2048 + c0, v); }, ldsb);
    xcd_barrier(bar);

    for (int it = blockIdx.x; it < 513 * 8; it += gridDim.x) { __syncthreads(); peer_score_topk_item(p, it >> 3, it & 7, ldsb); }
    xcd_barrier(bar);

    for (int row = gw; row < NR; row += nw) peer_expert_wave(p, row, ldsb + w * 3072, lane);
}

extern "C" void kernel_launch(void* const* d_in, const int* in_sizes, int n_in, void* d_out, int out_size, void* d_ws, size_t ws_size, hipStream_t stream) {
    static int grid = 0;
    if (grid == 0) {
        if (n_in != 32 || (size_t)out_size != O_END || ws_size < WS_END) {
            fprintf(stderr, "kernel_launch: unexpected sizes n_in %d out %d ws %zu (need %zu)\n", n_in, out_size, ws_size, (size_t)WS_END); grid = -1; return; }
        int dev = 0, cus = 0, per_cu = 0;
        if (hipGetDevice(&dev) != hipSuccess || hipDeviceGetAttribute(&cus, hipDeviceAttributeMultiprocessorCount, dev) != hipSuccess) { grid = -1; return; }
        if (hipFuncSetAttribute((const void*)fwd_kernel, hipFuncAttributeMaxDynamicSharedMemorySize, LDS_BYTES) != hipSuccess) { fprintf(stderr, "hipFuncSetAttribute failed\n"); grid = -1; return; }
        if (hipOccupancyMaxActiveBlocksPerMultiprocessor(&per_cu, (const void*)fwd_kernel, NTHREADS, LDS_BYTES) != hipSuccess || per_cu < 1) { fprintf(stderr, "occupancy query failed (%d)\n", per_cu); (void)hipGetLastError(); per_cu = 1; }
        if (per_cu > 2) per_cu = 2;
        grid = cus * per_cu;
    }
    if (grid < 0) return;
    (void)hipMemsetAsync((char*)d_ws + WS_BAR, 0, XCD_BAR_WORDS * sizeof(unsigned), stream);
    Params p{};
    p.x_prompt = (const float*)d_in[0]; p.x_sample = (const float*)d_in[1]; p.cache_cmp = (const float*)d_in[2]; p.cache_slc = (const float*)d_in[3];
    p.page_table = (const int*)d_in[4]; p.state_win = (const float*)d_in[5]; p.state_C = (const float*)d_in[6]; p.state_n = (const float*)d_in[7];
    p.state_m = (const float*)d_in[8]; p.state_conv = (const float*)d_in[9]; p.w_in = (const float*)d_in[10]; p.conv_w = (const float*)d_in[11];
    p.conv_b = (const float*)d_in[12]; p.wq = (const float*)d_in[13]; p.wk = (const float*)d_in[14]; p.gate_bias = (const float*)d_in[15];
    p.norm_g = (const float*)d_in[16]; p.cmp_pe = (const float*)d_in[17]; p.cmp_w1 = (const float*)d_in[18]; p.cmp_w2 = (const float*)d_in[19];
    p.rel_bias = (const float*)d_in[20]; p.w_up_m = (const float*)d_in[21]; p.w_up_n = (const float*)d_in[22]; p.w_out = (const float*)d_in[23];
    p.ln1_g = (const float*)d_in[24]; p.ln1_b = (const float*)d_in[25]; p.ln2_g = (const float*)d_in[26]; p.ln2_b = (const float*)d_in[27];
    p.peer_wq = (const float*)d_in[28]; p.peer_sub = (const float*)d_in[29]; p.peer_u = (const float*)d_in[30]; p.peer_v = (const float*)d_in[31];
    p.out = (float*)d_out; p.ws = (unsigned char*)d_ws;
    hipLaunchKernelGGL(fwd_kernel, dim3(grid), dim3(NTHREADS), LDS_BYTES, stream, p);
}
```

```cpp
#include <hip/hip_runtime.h>
#include <stdint.h>
#include <cstdio>

#define DEV __device__ __forceinline__

constexpr int DM = 1024;
constexpr int BP = 16, TP = 2048, BS = 32;
constexpr int NP = BP * TP;
constexpr int NR = NP + BS;
constexpr int MP = 32896;
constexpr int IN_DIM = 4896;
constexpr int C_U = 0, C_V = 512, C_O = 1024, C_I = 1536, C_F = 1540, C_Q = 1544, C_KC = 2056, C_KS = 2312, C_KW = 2568, C_G = 2824, C_GM = 2848, C_GN = 3872;
constexpr int PAST = 16384;
constexpr float NEGF = -1e30f;
constexpr float DN_ALPHA = 1.189207115002721f;
constexpr float LN_EPS = 1e-5f;
constexpr float LOG2E = 1.4426950408889634f;

constexpr size_t O_Y = 0;
constexpr size_t O_CMPP = (size_t)NR * DM;
constexpr size_t O_CMPS = O_CMPP + (size_t)NP * 256;
constexpr size_t O_SLCP = O_CMPS + (size_t)BS * 256;
constexpr size_t O_SLCS = O_SLCP + (size_t)NP * 256;
constexpr size_t O_WINP = O_SLCS + (size_t)BS * 256;
constexpr size_t O_WINS = O_WINP + (size_t)BP * 512 * 256;
constexpr size_t O_CP = O_WINS + (size_t)BS * 512 * 256;
constexpr size_t O_CS = O_CP + (size_t)BP * 4 * 128 * 128;
constexpr size_t O_NP = O_CS + (size_t)BS * 4 * 128 * 128;
constexpr size_t O_NS = O_NP + (size_t)BP * 4 * 128;
constexpr size_t O_MP = O_NS + (size_t)BS * 4 * 128;
constexpr size_t O_MS = O_MP + (size_t)BP * 4;
constexpr size_t O_CVP = O_MS + (size_t)BS * 4;
constexpr size_t O_CVS = O_CVP + (size_t)BP * 3 * 512;
constexpr size_t O_END = O_CVS + (size_t)BS * 3 * 512;
static_assert(O_END == 59916480, "output size");

constexpr size_t al256(size_t x) { return (x + 255) & ~(size_t)255; }
constexpr size_t WS_BAR = 0;
constexpr size_t WS_Z = 16384;
constexpr size_t WS_QK = al256(WS_Z + (size_t)MP * IN_DIM * 4);
constexpr size_t WS_HRAW = al256(WS_QK + (size_t)MP * 1024 * 4);
constexpr size_t WS_MOUTB = al256(WS_HRAW + (size_t)MP * 512 * 4);
constexpr size_t WS_NOUTB = al256(WS_MOUTB + (size_t)MP * 512 * 2);
constexpr size_t WS_HIDPB = al256(WS_NOUTB + (size_t)MP * 512 * 2);
constexpr size_t WS_KCP = al256(WS_HIDPB + (size_t)2 * 4096 * 64 * 2);
constexpr size_t WS_HIDSB = al256(WS_KCP + 256);
constexpr size_t WS_KCS = al256(WS_HIDSB + (size_t)2 * 65536 * 64 * 2);
constexpr size_t WS_MIX = al256(WS_KCS + (size_t)2 * 65536 * 64 * 4);
constexpr size_t WS_MIXB = al256(WS_MIX + (size_t)MP * 1024 * 4);
constexpr size_t WS_T1 = al256(WS_MIXB + (size_t)MP * 1024 * 2);
constexpr size_t WS_X1 = al256(WS_T1 + (size_t)MP * 1024 * 4);
constexpr size_t WS_X1B = al256(WS_X1 + (size_t)MP * 1024 * 4);
constexpr size_t WS_QPB = al256(WS_X1B + (size_t)MP * 1024 * 2);
constexpr size_t WS_S = al256(WS_QPB + (size_t)MP * 2048 * 2);
constexpr size_t WS_PIDX = al256(WS_S + (size_t)MP * 2048 * 4);
constexpr size_t WS_PG = al256(WS_PIDX + (size_t)MP * 128 * 4);
constexpr size_t WS_CONVB = al256(WS_PG + (size_t)MP * 128 * 4);
constexpr size_t WS_XB = al256(WS_CONVB + (size_t)MP * 512 * 2);
constexpr size_t WS_WIN_T = al256(WS_XB + (size_t)MP * 1024 * 2);
constexpr size_t WS_WUPM_T = al256(WS_WIN_T + (size_t)IN_DIM * 1024 * 2);
constexpr size_t WS_WUPN_T = al256(WS_WUPM_T + (size_t)1024 * 512 * 2);
constexpr size_t WS_WOUT_T = al256(WS_WUPN_T + (size_t)1024 * 512 * 2);
constexpr size_t WS_PWQ_T = al256(WS_WOUT_T + (size_t)1024 * 1024 * 2);
constexpr size_t WS_WQK_T = al256(WS_PWQ_T + (size_t)2048 * 1024 * 2);
constexpr size_t WS_W1_T = al256(WS_WQK_T + (size_t)4 * 256 * 128 * 2);
constexpr size_t WS_W2_T = al256(WS_W1_T + (size_t)2 * 64 * 2048 * 2);
constexpr size_t WS_SUBK = al256(WS_W2_T + (size_t)2 * 64 * 64 * 2);
constexpr size_t WS_ZB = al256(WS_SUBK + (size_t)2 * 128 * 128 * 2);
constexpr size_t WS_VTS = al256(WS_ZB + (size_t)MP * IN_DIM * 2);
constexpr size_t WS_VTW = al256(WS_VTS + (size_t)16 * 2 * 64 * 2048 * 2);
constexpr size_t WS_KCB = al256(WS_VTW + (size_t)16 * 2 * 64 * 2048 * 2);
constexpr size_t WS_VTC = al256(WS_KCB + (size_t)16 * 2 * 128 * 64 * 2);
constexpr size_t WS_NOUTF = al256(WS_VTC + (size_t)16 * 2 * 64 * 128 * 2);
constexpr size_t WS_U8 = al256(WS_NOUTF + (size_t)NP * 512 * 4);
constexpr size_t WS_V8 = al256(WS_U8 + (size_t)16384 * 1024);
constexpr size_t WS_QB = al256(WS_V8 + (size_t)16384 * 1024);
constexpr size_t WS_KB = al256(WS_QB + (size_t)MP * 512 * 2);
constexpr size_t WS_KTB = al256(WS_KB + (size_t)MP * 512 * 2);
constexpr size_t WS_VTM = al256(WS_KTB + (size_t)16 * 512 * 2048 * 2);
constexpr size_t WS_END = al256(WS_VTM + (size_t)16 * 512 * 2048 * 2);

static_assert(WS_END <= 2684354560ull, "workspace too large");
constexpr int LDS_BYTES = 73728;
constexpr int NTHREADS = 256;

struct Params {
    const float* x_prompt; const float* x_sample; const float* cache_cmp; const float* cache_slc; const int* page_table;
    const float* state_win; const float* state_C; const float* state_n; const float* state_m; const float* state_conv;
    const float* w_in; const float* conv_w; const float* conv_b; const float* wq; const float* wk; const float* gate_bias; const float* norm_g;
    const float* cmp_pe; const float* cmp_w1; const float* cmp_w2; const float* rel_bias; const float* w_up_m; const float* w_up_n; const float* w_out;
    const float* ln1_g; const float* ln1_b; const float* ln2_g; const float* ln2_b; const float* peer_wq; const float* peer_sub; const float* peer_u; const float* peer_v;
    float* out; unsigned char* ws;
};

#define XB_TMO      128
#define XB_XCNT(j)  (256  + 64 * (j))
#define XB_XSUB(j)  (1280 + 64 * (j))
#define XB_XGEN(j)  (2304 + 64 * (j))
#define XB_TOP      3328
#define XB_TOPGEN   3392
#define XCD_BAR_WORDS 3456
#define XB_SPIN_CAP (1u << 22)
#define LAS __attribute__((address_space(3)))

__device__ __forceinline__ unsigned xb_ld(unsigned* p)              { return __hip_atomic_load(p, __ATOMIC_RELAXED, __HIP_MEMORY_SCOPE_AGENT); }
__device__ __forceinline__ unsigned xb_add(unsigned* p, unsigned v) { return __hip_atomic_fetch_add(p, v, __ATOMIC_RELAXED, __HIP_MEMORY_SCOPE_AGENT); }
__device__ __forceinline__ unsigned xb_xcc_id() { return (unsigned)__builtin_amdgcn_s_getreg((3 << 11) | 20) & 0xFu; }
#define XB_SPIN(cond, bar) do { unsigned _sp = 0; while (cond) { __builtin_amdgcn_s_sleep(1); \
    if ((++_sp & 255u) == 0u) { if (xb_ld(&(bar)[XB_TMO])) break; if (_sp > XB_SPIN_CAP) { atomicAdd(&(bar)[XB_TMO], 1u); break; } } } } while (0)

struct XcdBarrier { unsigned* bar; unsigned x; volatile LAS unsigned* st; };

__device__ __forceinline__ XcdBarrier xcd_barrier_post(unsigned* bar, volatile LAS unsigned* st) {
    XcdBarrier b; b.bar = bar; b.x = xb_xcc_id(); b.st = st;
    if (threadIdx.x == 0) (void)xb_add(&bar[XB_XCNT(b.x)], 1u);
    return b;
}
__device__ __forceinline__ void xcd_barrier_complete(unsigned* bar, unsigned x, unsigned& nloc, unsigned& nx) {
    const unsigned G = gridDim.x * gridDim.y * gridDim.z;
    unsigned sum, cnt, mine, sp = 0u;
    for (;;) {
        sum = 0u; cnt = 0u; mine = 0u;
#pragma unroll
        for (unsigned j = 0; j < 16; ++j) { const unsigned c = xb_ld(&bar[XB_XCNT(j)]); sum += c; cnt += (c > 0u) ? 1u : 0u; mine = (j == x) ? c : mine; }
        if (sum == G) break;
        __builtin_amdgcn_s_sleep(1);
        if ((++sp & 255u) == 0u) { if (xb_ld(&bar[XB_TMO])) break; if (sp > XB_SPIN_CAP) { atomicAdd(&bar[XB_TMO], 1u); break; } }
    }
    nloc = mine > 0u ? mine : 1u; nx = cnt > 0u ? cnt : 1u;
}
__device__ __forceinline__ void xcd_barrier(const XcdBarrier& b) {
    asm volatile("s_waitcnt vmcnt(0)" ::: "memory");
    __syncthreads();
    if (threadIdx.x == 0) {
        unsigned* bar = b.bar;
        __builtin_amdgcn_s_waitcnt(0);
        unsigned nloc = b.st[0], nx = b.st[1];
        if (nloc == 0u) { xcd_barrier_complete(bar, b.x, nloc, nx); b.st[0] = nloc; b.st[1] = nx; }
        const unsigned old = xb_add(&bar[XB_XSUB(b.x)], 1u);
        const unsigned gen = old / nloc;
        if (old + 1u == (gen + 1u) * nloc) {
            __builtin_amdgcn_fence(__ATOMIC_RELEASE, "agent");
            asm volatile("s_waitcnt vmcnt(0)" ::: "memory");
            const unsigned og = xb_add(&bar[XB_TOP], 1u);
            const unsigned tg = og / nx;
            if (og + 1u == (tg + 1u) * nx) xb_add(&bar[XB_TOPGEN], 1u);
            else XB_SPIN(xb_ld(&bar[XB_TOPGEN]) == tg, bar);
            __builtin_amdgcn_fence(__ATOMIC_ACQUIRE, "agent");
            xb_add(&bar[XB_XGEN(b.x)], 1u);
            asm volatile("s_waitcnt vmcnt(0)" ::: "memory");
        } else {
            XB_SPIN(xb_ld(&bar[XB_XGEN(b.x)]) == gen, bar);
            __builtin_amdgcn_fence(__ATOMIC_ACQUIRE, "agent");
            asm volatile("s_waitcnt vmcnt(0)" ::: "memory");
        }
    }
    __syncthreads();
}

typedef float f32x4 __attribute__((ext_vector_type(4)));

__device__ const unsigned char REL_LUT[128] = {
    0, 1, 2, 3, 4, 5, 6, 7, 8, 9, 10, 11, 12, 13, 14, 15, 16, 16, 16, 17, 17, 18, 18, 18, 19, 19, 19, 20, 20, 20, 20, 21, 21, 21, 21, 22, 22, 22, 22, 22,
    23, 23, 23, 23, 23, 23, 24, 24, 24, 24, 24, 24, 25, 25, 25, 25, 25, 25, 25, 26, 26, 26, 26, 26, 26, 26, 26, 27, 27, 27, 27, 27, 27, 27, 27, 27, 27,
    28, 28, 28, 28, 28, 28, 28, 28, 28, 28, 29, 29, 29, 29, 29, 29, 29, 29, 29, 29, 29, 29, 30, 30, 30, 30, 30, 30, 30, 30, 30, 30, 30, 30, 30, 30,
    31, 31, 31, 31, 31, 31, 31, 31, 31, 31, 31, 31, 31, 31, 31};
DEV int rel_bucket(int n) { return n < 128 ? (int)REL_LUT[n < 0 ? 0 : n] : 31; }

DEV float sigmoidf_(float x) { return 1.0f / (1.0f + expf(-x)); }
DEV float gelu_tanh(float x) { return 0.5f * x * (1.0f + tanhf(0.7978845608028654f * (x + 0.044715f * x * x * x))); }
DEV float log_sigmoid(float x) { return x >= 0.f ? -log1pf(expf(-x)) : x - log1pf(expf(x)); }
DEV void wave_sync() { asm volatile("s_waitcnt lgkmcnt(0)" ::: "memory"); __builtin_amdgcn_wave_barrier(); asm volatile("" ::: "memory"); }
DEV float wave_sum(float v) {
#pragma unroll
    for (int o = 32; o >= 1; o >>= 1) v += __shfl_xor(v, o);
    return v;
}
DEV float wave_max(float v) {
#pragma unroll
    for (int o = 32; o >= 1; o >>= 1) v = fmaxf(v, __shfl_xor(v, o));
    return v;
}

typedef unsigned short bf16_t;
typedef short bf16x8 __attribute__((ext_vector_type(8)));
typedef float f32x2_ __attribute__((ext_vector_type(2)));
typedef __bf16 bf16x2_ __attribute__((ext_vector_type(2)));
DEV unsigned cvt_pk_bf16(float lo, float hi) { const f32x2_ v = {lo, hi}; return __builtin_bit_cast(unsigned, __builtin_convertvector(v, bf16x2_)); }
DEV float bf_lo(unsigned w) { return __uint_as_float(w << 16); }
DEV float bf_hi(unsigned w) { return __uint_as_float(w & 0xffff0000u); }
DEV uint4 pack8(const float* f) { uint4 r; r.x = cvt_pk_bf16(f[0], f[1]); r.y = cvt_pk_bf16(f[2], f[3]); r.z = cvt_pk_bf16(f[4], f[5]); r.w = cvt_pk_bf16(f[6], f[7]); return r; }
DEV void store_bf16x4(bf16_t* p, f32x4 v) { uint2 w; w.x = cvt_pk_bf16(v[0], v[1]); w.y = cvt_pk_bf16(v[2], v[3]); *(uint2*)p = w; }

DEV void transpose_to_bf16(const float* __restrict__ src, const int K, const int N, bf16_t* __restrict__ dst, const size_t gt, const size_t nt) {
    const size_t items = (size_t)N * (K >> 3);
    for (size_t id = gt; id < items; id += nt) {
        const int n = (int)(id % N), k8 = (int)(id / N) * 8;
        float f[8];
#pragma unroll
        for (int i = 0; i < 8; ++i) f[i] = src[(size_t)(k8 + i) * N + n];
        *(uint4*)(dst + (size_t)n * K + k8) = pack8(f);
    }
}

template <int BN, class LA, class LB, class EF>
DEV void gemm_bf16(const int M, const int N, const int K, LA la, LB lb, EF ef, unsigned char* lds) {
    constexpr int TJ = BN / 32;
    constexpr int NB = BN / 32;
    constexpr int LDR = 144;
    const int tid = threadIdx.x, lane = tid & 63, w = tid >> 6, wm = w >> 1, wn = w & 1;
    const int tm = (M + 127) >> 7, tn = (N + BN - 1) / BN;
    unsigned char* As = lds;
    unsigned char* Bs = lds + 128 * LDR;
    const int lr = lane & 15, lq = lane >> 4;
    for (int tile = blockIdx.x; tile < tm * tn; tile += gridDim.x) {
        const int bm = (tile / tn) * 128, bn = (tile % tn) * BN;
        f32x4 acc[4][TJ];
#pragma unroll
        for (int i = 0; i < 4; ++i)
#pragma unroll
            for (int j = 0; j < TJ; ++j) acc[i][j] = (f32x4){0.f, 0.f, 0.f, 0.f};
        uint4 ra[4], rb[NB];
        int arow[4], brow[NB];
#pragma unroll
        for (int i = 0; i < 4; ++i) { const int r = bm + ((tid + 256 * i) >> 3); arow[i] = r < M ? r : M - 1; }
#pragma unroll
        for (int i = 0; i < NB; ++i) { const int n = bn + ((tid + 256 * i) >> 3); brow[i] = n < N ? n : N - 1; }
        const int kc = (tid & 7) * 8;
#pragma unroll
        for (int i = 0; i < 4; ++i) ra[i] = la(arow[i], kc);
#pragma unroll
        for (int i = 0; i < NB; ++i) rb[i] = lb(brow[i], kc);
        for (int k0_ = 0; k0_ < K; k0_ += 64) {
            int k0 = k0_; asm volatile("" : "+v"(k0));
            __syncthreads();
#pragma unroll
            for (int i = 0; i < 4; ++i) *(uint4*)(As + ((tid + 256 * i) >> 3) * LDR + (tid & 7) * 16) = ra[i];
#pragma unroll
            for (int i = 0; i < NB; ++i) *(uint4*)(Bs + ((tid + 256 * i) >> 3) * LDR + (tid & 7) * 16) = rb[i];
            __syncthreads();
            if (k0_ + 64 < K) {
#pragma unroll
                for (int i = 0; i < 4; ++i) ra[i] = la(arow[i], k0 + 64 + kc);
#pragma unroll
                for (int i = 0; i < NB; ++i) rb[i] = lb(brow[i], k0 + 64 + kc);
            }
#pragma unroll
            for (int kk = 0; kk < 2; ++kk) {
                bf16x8 a[4], b[TJ];
#pragma unroll
                for (int i = 0; i < 4; ++i) a[i] = *(const bf16x8*)(As + (wm * 64 + i * 16 + lr) * LDR + kk * 64 + lq * 16);
#pragma unroll
                for (int j = 0; j < TJ; ++j) b[j] = *(const bf16x8*)(Bs + (wn * (BN / 2) + j * 16 + lr) * LDR + kk * 64 + lq * 16);
#pragma unroll
                for (int i = 0; i < 4; ++i)
#pragma unroll
                    for (int j = 0; j < TJ; ++j) acc[i][j] = __builtin_amdgcn_mfma_f32_16x16x32_bf16(b[j], a[i], acc[i][j], 0, 0, 0);
            }
        }
#pragma unroll
        for (int i = 0; i < 4; ++i)
#pragma unroll
            for (int j = 0; j < TJ; ++j) {
                const int r = bm + wm * 64 + i * 16 + lr, c0 = bn + wn * (BN / 2) + j * 16 + lq * 4;
                if (r < M && c0 < N) ef(r, c0, acc[i][j]);
            }
    }
}

template <class KeyF>
DEV void wave_attn(const float* qs, float* sb, const int nkeys, KeyF keyf, const float* __restrict__ rel_bias, const int hkv, const int lane, float (&o)[4]) {
    float mx[4] = {NEGF, NEGF, NEGF, NEGF};
    for (int base = 0; base < nkeys; base += 64) {
        asm volatile("" ::: "memory");
        const int idx = base + lane;
        const float* kp = nullptr; const float* vp = nullptr; int dist = 0;
        bool valid = false;
        if (idx < nkeys) valid = keyf(idx, kp, vp, dist);
        float sc[4] = {0.f, 0.f, 0.f, 0.f};
        if (valid) {
#pragma unroll 1
            for (int d4 = 0; d4 < 16; ++d4) {
                asm volatile("" ::: "memory");
                const float4 kv = ((const float4*)kp)[d4];
#pragma unroll
                for (int g = 0; g < 4; ++g) {
                    const float4 qv = *(const float4*)(qs + g * 64 + d4 * 4);
                    sc[g] += qv.x * kv.x + qv.y * kv.y + qv.z * kv.z + qv.w * kv.w;
                }
            }
            const int bk = rel_bucket(dist);
#pragma unroll
            for (int g = 0; g < 4; ++g) sc[g] += rel_bias[bk * 8 + hkv * 4 + g];
        }
#pragma unroll
        for (int g = 0; g < 4; ++g) {
            const float v = valid ? sc[g] : NEGF;
            if (idx < nkeys) sb[g * 1024 + idx] = v;
            mx[g] = fmaxf(mx[g], v);
        }
    }
    float inv[4];
#pragma unroll
    for (int g = 0; g < 4; ++g) mx[g] = wave_max(mx[g]);
    wave_sync();
    float sum[4] = {0.f, 0.f, 0.f, 0.f};
    for (int idx = lane; idx < nkeys; idx += 64) {
#pragma unroll
        for (int g = 0; g < 4; ++g) {
            const float v = sb[g * 1024 + idx];
            const float e = (v > -1e29f) ? expf(v - mx[g]) : 0.f;
            sb[g * 1024 + idx] = e;
            sum[g] += e;
        }
    }
#pragma unroll
    for (int g = 0; g < 4; ++g) { sum[g] = wave_sum(sum[g]); inv[g] = 1.0f / fmaxf(sum[g], 1e-30f); }
    for (int idx = lane; idx < nkeys; idx += 64) {
#pragma unroll
        for (int g = 0; g < 4; ++g) sb[g * 1024 + idx] *= inv[g];
    }
    wave_sync();
#pragma unroll
    for (int g = 0; g < 4; ++g) o[g] = 0.f;
    for (int idx = 0; idx < nkeys; ++idx) {
        const float p0 = sb[idx], p1 = sb[1024 + idx], p2 = sb[2048 + idx], p3 = sb[3072 + idx];
        if (p0 + p1 + p2 + p3 == 0.f) continue;
        const float* kp = nullptr; const float* vp = nullptr; int dist = 0;
        (void)keyf(idx, kp, vp, dist);
        const float vv = vp[lane];
        o[0] += p0 * vv; o[1] += p1 * vv; o[2] += p2 * vv; o[3] += p3 * vv;
    }
}

DEV void nsa_item(const Params& p, const int row, const int hkv, float* wl, const int lane) {
    float* qs = wl; float* sb = wl + 256; int* sel = (int*)(wl + 256 + 4096);
    const float* Z = (const float*)(p.ws + WS_Z);
    bf16_t* NOUT = (bf16_t*)(p.ws + WS_NOUTB);
    const float* KCP = (const float*)(p.ws + WS_KCP);
    const float* KCS = (const float*)(p.ws + WS_KCS);
    const bool pr = row < NP;
    const int b = pr ? (row >> 11) : (row - NP);
    const int t = pr ? (row & 2047) : 0;
    const int qpos = pr ? t : PAST;
    const float* zrow = Z + (size_t)row * IN_DIM;
    wave_sync();
    for (int i = lane; i < 256; i += 64) qs[i] = zrow[C_Q + hkv * 256 + i] * 0.125f;
    wave_sync();
    float o[4];
    float gate[3][4];
#pragma unroll
    for (int br = 0; br < 3; ++br)
#pragma unroll
        for (int g = 0; g < 4; ++g) gate[br][g] = sigmoidf_(zrow[C_G + br * 8 + hkv * 4 + g]);
    bf16_t* nrow = NOUT + (size_t)row * 512 + hkv * 256;
    float res[4];
    const int nkc = pr ? 127 : 1023;
    {
        const float* kbase = pr ? (KCP + ((size_t)(b * 128) * 2 + hkv) * 64) : (KCS + ((size_t)(b * 1024) * 2 + hkv) * 64);
        const size_t plane = pr ? (size_t)4096 * 64 : (size_t)65536 * 64;
        auto keyf = [&](int idx, const float*& kp, const float*& vp, int& dist) -> bool {
            kp = kbase + (size_t)idx * 128; vp = kp + plane; dist = qpos - (16 * idx + 31); return dist >= 0; };
        wave_attn(qs, sb, nkc, keyf, p.rel_bias, hkv, lane, o);
#pragma unroll
        for (int g = 0; g < 4; ++g) res[g] = gate[0][g] * o[g];
    }
    const int nblk = pr ? 32 : 257;
    for (int i = lane; i < nkc; i += 64) sb[i] = ((sb[i] + sb[1024 + i]) + sb[2048 + i]) + sb[3072 + i];
    wave_sync();
    {
        const int cur = qpos >> 6;
        for (int blk = lane; blk < nblk; blk += 64) {
            float s = 0.f;
#pragma unroll
            for (int cc = 0; cc < 4; ++cc) {
                const int c = 4 * blk + cc;
                const float a0 = (c < nkc) ? sb[c] : 0.f;
                const float a1 = (c >= 1 && c - 1 < nkc) ? sb[c - 1] : 0.f;
                s += a0 + a1;
            }
            const bool causal = blk * 64 <= qpos;
            const bool forced = (blk == 0) || (blk == cur) || (blk == cur - 1);
            sb[1024 + blk] = causal ? (forced ? 1e4f : s) : NEGF;
        }
        wave_sync();
        for (int blk = lane; blk < nblk; blk += 64) {
            const float my = sb[1024 + blk];
            int rank = 0;
            for (int j = 0; j < nblk; ++j) { const float o2 = sb[1024 + j]; rank += ((o2 > my) || (o2 == my && j < blk)) ? 1 : 0; }
            if (rank < 16) sel[rank] = (blk * 64 <= qpos) ? blk : -1;
        }
        wave_sync();
    }
    {
        const float* zb = Z + (size_t)(pr ? b * 2048 : 0) * IN_DIM;
        auto keyf = [&](int idx, const float*& kp, const float*& vp, int& dist) -> bool {
            const int blk = sel[idx >> 6], s = idx & 63;
            if (blk < 0) return false;
            const int kpos = blk * 64 + s;
            if (kpos > qpos) return false;
            dist = qpos - kpos;
            if (pr) { kp = zb + (size_t)kpos * IN_DIM + C_KS + hkv * 64; }
            else if (blk < 256) { const int page = p.page_table[b * 128 + (blk >> 1)]; kp = p.cache_slc + ((size_t)page * 128 + (blk & 1) * 64 + s) * 256 + hkv * 64; }
            else { kp = zrow + C_KS + hkv * 64; }
            vp = kp + 128; return true; };
        wave_attn(qs, sb, 1024, keyf, p.rel_bias, hkv, lane, o);
#pragma unroll
        for (int g = 0; g < 4; ++g) res[g] += gate[1][g] * o[g];
    }
    {
        const float* zb = Z + (size_t)(pr ? b * 2048 : 0) * IN_DIM;
        const int nk = pr ? ((t + 1 < 512) ? t + 1 : 512) : 512;
        auto keyf = [&](int idx, const float*& kp, const float*& vp, int& dist) -> bool {
            if (pr) { const int kpos = t - nk + 1 + idx; dist = t - kpos; kp = zb + (size_t)kpos * IN_DIM + C_KW + hkv * 64; }
            else { const int j = idx + 1; dist = 512 - j; kp = (j < 512) ? (p.state_win + ((size_t)b * 512 + j) * 256 + hkv * 64) : (zrow + C_KW + hkv * 64); }
            vp = kp + 128; return true; };
        wave_attn(qs, sb, nk, keyf, p.rel_bias, hkv, lane, o);
#pragma unroll
        for (int g = 0; g < 4; ++g) res[g] += gate[2][g] * o[g];
    }
#pragma unroll
    for (int g = 0; g < 4; ++g) nrow[g * 64 + lane] = (bf16_t)(cvt_pk_bf16(res[g], 0.f) & 0xffffu);
}

DEV void mlstm_scan_item(const Params& p, const int item, float* lds) {
    const int tid = threadIdx.x, v = tid >> 1, kh = tid & 1;
    const int seq = item >> 2, h = item & 3;
    const bool pr = seq < 16; const int b = pr ? seq : seq - 16;
    const int T = pr ? 2048 : 1; const int row0 = pr ? b * 2048 : NP + b;
    const float* Z = (const float*)(p.ws + WS_Z);
    const float* QK = (const float*)(p.ws + WS_QK);
    float* HRAW = (float*)(p.ws + WS_HRAW);
    float C[64], n[64]; float m;
    if (pr) {
#pragma unroll
        for (int j = 0; j < 64; ++j) { C[j] = 0.f; n[j] = 0.f; }
        m = 0.f;
    } else {
        const float* c0 = p.state_C + (((size_t)(b * 4 + h) * 128 + v) * 128 + kh * 64);
        const float* n0 = p.state_n + ((size_t)(b * 4 + h) * 128 + kh * 64);
#pragma unroll
        for (int j = 0; j < 64; ++j) { C[j] = c0[j]; n[j] = n0[j]; }
        m = p.state_m[b * 4 + h];
    }
    const float gb_i = p.gate_bias[h], gb_f = p.gate_bias[4 + h];
    auto load_tok = [&](int t, float* dst) {
        const size_t r = (size_t)(row0 + t);
        dst[tid] = QK[r * 1024 + h * 256 + tid];
        if (tid < 128) dst[256 + tid] = Z[r * IN_DIM + C_V + h * 128 + tid];
        if (tid == 128) dst[384] = Z[r * IN_DIM + C_I + h] + gb_i;
        if (tid == 129) dst[385] = log_sigmoid(Z[r * IN_DIM + C_F + h] + gb_f);
    };
    __syncthreads();
    load_tok(0, lds);
    __syncthreads();
    for (int t = 0; t < T; ++t) {
        const float* cur = lds + (t & 1) * 388;
        if (t + 1 < T) load_tok(t + 1, lds + ((t + 1) & 1) * 388);
        const float ig = cur[384], lf = cur[385];
        const float mn = fmaxf(lf + m, ig);
        const float fd = expf(lf + m - mn), iw = expf(ig - mn);
        const float vv = cur[256 + v] * iw;
        float nump = 0.f, denp = 0.f;
#pragma unroll
        for (int j = 0; j < 64; ++j) {
            const float kj = cur[128 + kh * 64 + j], qj = cur[kh * 64 + j];
            C[j] = fd * C[j] + vv * kj; n[j] = fd * n[j] + iw * kj;
            nump += C[j] * qj; denp += n[j] * qj;
        }
        nump += __shfl_xor(nump, 1); denp += __shfl_xor(denp, 1);
        const float hval = nump / fmaxf(fabsf(denp), expf(-mn));
        if (kh == 0) HRAW[(size_t)(row0 + t) * 512 + h * 128 + v] = hval;
        m = mn;
        __syncthreads();
    }
    float* co = p.out + (pr ? O_CP : O_CS) + (((size_t)(b * 4 + h) * 128 + v) * 128 + kh * 64);
#pragma unroll
    for (int j = 0; j < 64; ++j) co[j] = C[j];
    if (v == 0) {
        float* no = p.out + (pr ? O_NP : O_NS) + ((size_t)(b * 4 + h) * 128 + kh * 64);
#pragma unroll
        for (int j = 0; j < 64; ++j) no[j] = n[j];
    }
    if (tid == 0) p.out[(pr ? O_MP : O_MS) + b * 4 + h] = m;
}

DEV void peer_topk_item(const Params& p, const int row, const int h, const int lane) {
    const float* S = (const float*)(p.ws + WS_S) + (size_t)row * 2048 + h * 256;
    int* PIDX = (int*)(p.ws + WS_PIDX); float* PG = (float*)(p.ws + WS_PG);
    float ts[2]; int ti[2];
#pragma unroll
    for (int pp = 0; pp < 2; ++pp) {
        float v0 = S[pp * 128 + lane], v1 = S[pp * 128 + 64 + lane];
        float mys = 0.f; int myi = 0;
        for (int r = 0; r < 16; ++r) {
            float best = fmaxf(v0, v1); int bi = (v0 >= v1) ? lane : lane + 64;
#pragma unroll
            for (int off = 32; off >= 1; off >>= 1) {
                const float ob = __shfl_xor(best, off); const int oi = __shfl_xor(bi, off);
                if (ob > best || (ob == best && oi < bi)) { best = ob; bi = oi; }
            }
            if (lane == r) { mys = best; myi = bi; }
            if (bi == lane) v0 = -INFINITY;
            if (bi == lane + 64) v1 = -INFINITY;
        }
        ts[pp] = mys; ti[pp] = myi;
    }
    float cv[4];
#pragma unroll
    for (int jj = 0; jj < 4; ++jj) { const int c = lane * 4 + jj; cv[jj] = __shfl(ts[0], c >> 4) + __shfl(ts[1], c & 15); }
    float msc = 0.f; int mci = 0;
    for (int r = 0; r < 16; ++r) {
        float best = cv[0]; int bi = lane * 4;
#pragma unroll
        for (int jj = 1; jj < 4; ++jj) if (cv[jj] > best) { best = cv[jj]; bi = lane * 4 + jj; }
#pragma unroll
        for (int off = 32; off >= 1; off >>= 1) {
            const float ob = __shfl_xor(best, off); const int oi = __shfl_xor(bi, off);
            if (ob > best || (ob == best && oi < bi)) { best = ob; bi = oi; }
        }
        if (lane == r) { msc = best; mci = bi; }
#pragma unroll
        for (int jj = 0; jj < 4; ++jj) if (bi == lane * 4 + jj) cv[jj] = -INFINITY;
    }
    const int e = __shfl(ti[0], mci >> 4) * 128 + __shfl(ti[1], mci & 15);
    const float top = __shfl(msc, 0);
    float ex = (lane < 16) ? expf(msc - top) : 0.f;
    const float den = wave_sum(ex);
    if (lane < 16) { PIDX[(size_t)row * 128 + h * 16 + lane] = e; PG[(size_t)row * 128 + h * 16 + lane] = ex / den; }
}

DEV void peer_expert_item(const Params& p, const int row, float* lds) {
    const int tid = threadIdx.x, lane = tid & 63, w = tid >> 6;
    const float* X1 = (const float*)(p.ws + WS_X1) + (size_t)row * 1024;
    const int* PIDX = (const int*)(p.ws + WS_PIDX) + (size_t)row * 128;
    const float* PG = (const float*)(p.ws + WS_PG) + (size_t)row * 128;
    float4 x[4], acc[4];
#pragma unroll
    for (int j = 0; j < 4; ++j) { x[j] = *(const float4*)(X1 + j * 256 + lane * 4); acc[j] = make_float4(0.f, 0.f, 0.f, 0.f); }
    for (int k = 0; k < 32; ++k) {
        const int e = PIDX[w * 32 + k]; const float gk = PG[w * 32 + k];
        const float* ur = p.peer_u + (size_t)e * 1024; const float* vr = p.peer_v + (size_t)e * 1024;
        float d = 0.f;
#pragma unroll
        for (int j = 0; j < 4; ++j) { const float4 u = *(const float4*)(ur + j * 256 + lane * 4); d += u.x * x[j].x + u.y * x[j].y + u.z * x[j].z + u.w * x[j].w; }
        d = wave_sum(d);
        const float coef = gk * gelu_tanh(d);
#pragma unroll
        for (int j = 0; j < 4; ++j) { const float4 vv = *(const float4*)(vr + j * 256 + lane * 4);
            acc[j].x += coef * vv.x; acc[j].y += coef * vv.y; acc[j].z += coef * vv.z; acc[j].w += coef * vv.w; }
    }
    __syncthreads();
#pragma unroll
    for (int j = 0; j < 4; ++j) *(float4*)(lds + w * 1024 + j * 256 + lane * 4) = acc[j];
    __syncthreads();
    float tv[4]; float s = 0.f;
#pragma unroll
    for (int i = 0; i < 4; ++i) { const int c = tid * 4 + i; const float po = (lds[c] + lds[1024 + c]) + (lds[2048 + c] + lds[3072 + c]); tv[i] = DN_ALPHA * X1[c] + po; s += tv[i]; }
    float* red = lds + 4096;
    s = wave_sum(s);
    if (lane == 0) red[w] = s;
    __syncthreads();
    const float mu = (red[0] + red[1] + red[2] + red[3]) * (1.0f / 1024.0f);
    float q = 0.f;
#pragma unroll
    for (int i = 0; i < 4; ++i) { const float d = tv[i] - mu; q += d * d; }
    q = wave_sum(q);
    if (lane == 0) red[8 + w] = q;
    __syncthreads();
    const float var = (red[8] + red[9] + red[10] + red[11]) * (1.0f / 1024.0f);
    const float rstd = 1.0f / sqrtf(var + LN_EPS);
    float* y = p.out + O_Y + (size_t)row * 1024;
#pragma unroll
    for (int i = 0; i < 4; ++i) { const int c = tid * 4 + i; y[c] = (tv[i] - mu) * rstd * p.ln2_g[c] + p.ln2_b[c]; }
}

DEV void mlstm_chunk_item(const Params& p, const int item, unsigned char* lds) {
    int tid_ = threadIdx.x; asm volatile("" : "+v"(tid_));
    const int tid = tid_, lane = tid & 63, w = tid >> 6, lr = lane & 15, lq = lane >> 4;
    const int b = item >> 4, h = (item >> 2) & 3, vs = item & 3;
    bf16_t* Cl = (bf16_t*)lds;
    bf16_t* nl = (bf16_t*)(lds + 8704);
    float* uL = (float*)(lds + 8960); float* ML = uL + 64; float* scin = uL + 128; float* expm = uL + 192; float* wts = uL + 256; float* misc = uL + 320;
    const bf16_t* QB = (const bf16_t*)(p.ws + WS_QB) + (size_t)(b * 2048) * 512 + h * 128;
    const bf16_t* KB = (const bf16_t*)(p.ws + WS_KB) + (size_t)(b * 2048) * 512 + h * 128;
    const bf16_t* KTB = (const bf16_t*)(p.ws + WS_KTB) + (size_t)((b * 4 + h) * 128) * 2048;
    const bf16_t* VTM = (const bf16_t*)(p.ws + WS_VTM) + (size_t)(b * 512 + h * 128 + vs * 32) * 2048;
    const float* Z = (const float*)(p.ws + WS_Z);
    float* HRAW = (float*)(p.ws + WS_HRAW);
    const float gb_i = p.gate_bias[h], gb_f = p.gate_bias[4 + h];
    f32x4 Cm[2][2], nm[2];
#pragma unroll
    for (int i = 0; i < 2; ++i) { nm[i] = (f32x4){0.f, 0.f, 0.f, 0.f};
#pragma unroll
        for (int j = 0; j < 2; ++j) Cm[i][j] = (f32x4){0.f, 0.f, 0.f, 0.f}; }
    float m_prev = 0.f;
    __syncthreads();
    for (int i = tid; i < (8704 + 256) / 4; i += 256) ((unsigned*)lds)[i] = 0u;
    __syncthreads();
    for (int c = 0; c < 32; ++c) {
        const int t0 = c * 64;
        if (w == 0) {
            const size_t row = (size_t)(b * 2048 + t0 + lane);
            const float ig = Z[row * IN_DIM + C_I + h] + gb_i;
            const float lf = log_sigmoid(Z[row * IN_DIM + C_F + h] + gb_f);
            float bc = lf;
#pragma unroll
            for (int o = 1; o < 64; o <<= 1) { const float t = __shfl_up(bc, o); if (lane >= o) bc += t; }
            const float u = ig - bc;
            float pm = u;
#pragma unroll
            for (int o = 1; o < 64; o <<= 1) { const float t = __shfl_up(pm, o); if (lane >= o) pm = fmaxf(pm, t); }
            const float M = fmaxf(m_prev, pm);
            const float M63 = __shfl(M, 63), b63 = __shfl(bc, 63);
            uL[lane] = u; ML[lane] = M; scin[lane] = expf(m_prev - M); expm[lane] = expf(-(bc + M)); wts[lane] = expf(u - M63);
            if (lane == 0) { misc[0] = expf(m_prev - M63); misc[1] = b63 + M63; }
        }
        __syncthreads();
        {
            const size_t row_t = (size_t)(t0 + w * 16 + lr);
            bf16x8 Qf[4];
#pragma unroll
            for (int ks = 0; ks < 4; ++ks) Qf[ks] = *(const bf16x8*)(QB + row_t * 512 + ks * 32 + lq * 8);
            const float M_t = ML[w * 16 + lr], sc_in = scin[w * 16 + lr], em = expm[w * 16 + lr];
            f32x4 sw[4];
            float dsum = 0.f;
#pragma unroll
            for (int st = 0; st < 4; ++st) {
                f32x4 a = (f32x4){0.f, 0.f, 0.f, 0.f};
                if (st <= w) {
#pragma unroll
                    for (int ks = 0; ks < 4; ++ks) { const bf16x8 kf = *(const bf16x8*)(KB + (size_t)(t0 + st * 16 + lr) * 512 + ks * 32 + lq * 8); a = __builtin_amdgcn_mfma_f32_16x16x32_bf16(kf, Qf[ks], a, 0, 0, 0); }
#pragma unroll
                    for (int g = 0; g < 4; ++g) {
                        const int sl = st * 16 + lq * 4 + g, tl = w * 16 + lr;
                        const float wg = (sl <= tl) ? __builtin_amdgcn_exp2f((uL[sl] - M_t) * LOG2E) : 0.f;
                        a[g] *= wg; dsum += a[g];
                    }
                }
                sw[st] = a;
            }
            dsum += __shfl_xor(dsum, 16); dsum += __shfl_xor(dsum, 32);
            bf16x8 pf[2];
#pragma unroll
            for (int ks = 0; ks < 2; ++ks) {
                union { bf16x8 v; unsigned u[4]; } pk;
                pk.u[0] = cvt_pk_bf16(sw[2 * ks][0], sw[2 * ks][1]); pk.u[1] = cvt_pk_bf16(sw[2 * ks][2], sw[2 * ks][3]);
                pk.u[2] = cvt_pk_bf16(sw[2 * ks + 1][0], sw[2 * ks + 1][1]); pk.u[3] = cvt_pk_bf16(sw[2 * ks + 1][2], sw[2 * ks + 1][3]);
                pf[ks] = pk.v;
            }
            f32x4 dI = (f32x4){0.f, 0.f, 0.f, 0.f};
#pragma unroll
            for (int ks = 0; ks < 4; ++ks) { const bf16x8 nf = *(const bf16x8*)(nl + ks * 32 + lq * 8); dI = __builtin_amdgcn_mfma_f32_16x16x32_bf16(nf, Qf[ks], dI, 0, 0, 0); }
            const float den = sc_in * dI[0] + dsum;
            const float rdd = 1.0f / fmaxf(fabsf(den), em);
#pragma unroll
            for (int vt = 0; vt < 2; ++vt) {
                f32x4 ni = (f32x4){0.f, 0.f, 0.f, 0.f}, nI = (f32x4){0.f, 0.f, 0.f, 0.f};
#pragma unroll
                for (int ks = 0; ks < 2; ++ks) if (2 * ks <= w) {
                    union { bf16x8 v; uint2 hh[2]; } vf;
                    const bf16_t* vp = VTM + (size_t)(vt * 16 + lr) * 2048 + t0 + 32 * ks + lq * 4;
                    vf.hh[0] = *(const uint2*)vp; vf.hh[1] = *(const uint2*)(vp + 16);
                    ni = __builtin_amdgcn_mfma_f32_16x16x32_bf16(vf.v, pf[ks], ni, 0, 0, 0);
                }
#pragma unroll
                for (int ks = 0; ks < 4; ++ks) { const bf16x8 cf = *(const bf16x8*)(Cl + (vt * 16 + lr) * 136 + ks * 32 + lq * 8); nI = __builtin_amdgcn_mfma_f32_16x16x32_bf16(cf, Qf[ks], nI, 0, 0, 0); }
                const f32x4 hv = (nI * sc_in + ni) * rdd;
                *(f32x4*)(HRAW + ((size_t)(b * 2048) + row_t) * 512 + h * 128 + vs * 32 + vt * 16 + lq * 4) = hv;
            }
        }
        __syncthreads();
        {
            const float decay = misc[0];
            bf16x8 Af[2][2], Wf[2], Kt[2][2];
#pragma unroll
            for (int ks = 0; ks < 2; ++ks) {
                const float4 w0 = *(const float4*)(wts + ks * 32 + lq * 8), w1 = *(const float4*)(wts + ks * 32 + lq * 8 + 4);
                float wv[8] = {w0.x, w0.y, w0.z, w0.w, w1.x, w1.y, w1.z, w1.w};
                { union { bf16x8 v; uint4 q; } t; t.q = pack8(wv); Wf[ks] = t.v; }
#pragma unroll
                for (int vt = 0; vt < 2; ++vt) {
                    const uint4 raw = *(const uint4*)(VTM + (size_t)(vt * 16 + lr) * 2048 + t0 + ks * 32 + lq * 8);
                    float f[8] = {bf_lo(raw.x) * wv[0], bf_hi(raw.x) * wv[1], bf_lo(raw.y) * wv[2], bf_hi(raw.y) * wv[3], bf_lo(raw.z) * wv[4], bf_hi(raw.z) * wv[5], bf_lo(raw.w) * wv[6], bf_hi(raw.w) * wv[7]};
                    union { bf16x8 v; uint4 q; } t; t.q = pack8(f); Af[vt][ks] = t.v;
                }
#pragma unroll
                for (int kt = 0; kt < 2; ++kt) Kt[kt][ks] = *(const bf16x8*)(KTB + (size_t)((2 * w + kt) * 16 + lr) * 2048 + t0 + ks * 32 + lq * 8);
            }
#pragma unroll
            for (int kt = 0; kt < 2; ++kt) {
                nm[kt] = nm[kt] * decay;
#pragma unroll
                for (int ks = 0; ks < 2; ++ks) nm[kt] = __builtin_amdgcn_mfma_f32_16x16x32_bf16(Wf[ks], Kt[kt][ks], nm[kt], 0, 0, 0);
                if (lq == 0) nl[(2 * w + kt) * 16 + lr] = (bf16_t)(cvt_pk_bf16(nm[kt][0], 0.f) & 0xffffu);
#pragma unroll
                for (int vt = 0; vt < 2; ++vt) {
                    Cm[vt][kt] = Cm[vt][kt] * decay;
#pragma unroll
                    for (int ks = 0; ks < 2; ++ks) Cm[vt][kt] = __builtin_amdgcn_mfma_f32_16x16x32_bf16(Af[vt][ks], Kt[kt][ks], Cm[vt][kt], 0, 0, 0);
                    const unsigned c01 = cvt_pk_bf16(Cm[vt][kt][0], Cm[vt][kt][1]), c23 = cvt_pk_bf16(Cm[vt][kt][2], Cm[vt][kt][3]);
                    bf16_t* cp = Cl + (vt * 16 + lq * 4) * 136 + (2 * w + kt) * 16 + lr;
                    cp[0] = (bf16_t)(c01 & 0xffffu); cp[136] = (bf16_t)(c01 >> 16); cp[272] = (bf16_t)(c23 & 0xffffu); cp[408] = (bf16_t)(c23 >> 16);
                }
            }
            m_prev = misc[1];
        }
        __syncthreads();
    }
#pragma unroll
    for (int vt = 0; vt < 2; ++vt)
#pragma unroll
        for (int kt = 0; kt < 2; ++kt)
#pragma unroll
            for (int g = 0; g < 4; ++g)
                p.out[O_CP + ((size_t)((b * 4 + h) * 128) + vs * 32 + vt * 16 + lq * 4 + g) * 128 + (2 * w + kt) * 16 + lr] = Cm[vt][kt][g];
    if (vs == 0) {
        if (lq == 0) { p.out[O_NP + (size_t)(b * 4 + h) * 128 + (2 * w) * 16 + lr] = nm[0][0]; p.out[O_NP + (size_t)(b * 4 + h) * 128 + (2 * w + 1) * 16 + lr] = nm[1][0]; }
        if (tid == 0) p.out[O_MP + b * 4 + h] = m_prev;
    }
}

DEV unsigned dpp_max16(unsigned x) {
    x = max(x, (unsigned)__builtin_amdgcn_update_dpp(0, (int)x, 0xB1, 0xF, 0xF, false));
    x = max(x, (unsigned)__builtin_amdgcn_update_dpp(0, (int)x, 0x4E, 0xF, 0xF, false));
    x = max(x, (unsigned)__builtin_amdgcn_update_dpp(0, (int)x, 0x141, 0xF, 0xF, false));
    x = max(x, (unsigned)__builtin_amdgcn_update_dpp(0, (int)x, 0x140, 0xF, 0xF, false));
    return x;
}
DEV float dpp_sum16(float x) {
    x += __builtin_bit_cast(float, __builtin_amdgcn_update_dpp(0, __builtin_bit_cast(int, x), 0xB1, 0xF, 0xF, false));
    x += __builtin_bit_cast(float, __builtin_amdgcn_update_dpp(0, __builtin_bit_cast(int, x), 0x4E, 0xF, 0xF, false));
    x += __builtin_bit_cast(float, __builtin_amdgcn_update_dpp(0, __builtin_bit_cast(int, x), 0x141, 0xF, 0xF, false));
    x += __builtin_bit_cast(float, __builtin_amdgcn_update_dpp(0, __builtin_bit_cast(int, x), 0x140, 0xF, 0xF, false));
    return x;
}
DEV unsigned mono_key(float v) { const unsigned b = __float_as_uint(v); return (b & 0x80000000u) ? ~b : (b | 0x80000000u); }
#define CE_DESC(a, b) { const unsigned hi_ = max(a, b), lo_ = min(a, b); a = hi_; b = lo_; }

DEV void peer_score_topk_item(const Params& p, const int tile, const int h, unsigned char* lds) {
    int tid_ = threadIdx.x; asm volatile("" : "+v"(tid_));
    const int tid = tid_, lane = tid & 63, w = tid >> 6, lr = lane & 15, lq = lane >> 4;
    float* sc = (float*)(lds + w * 12416);
    float* ts = sc + 16 * 129;
    int* ti = (int*)(ts + 512);
    const bf16_t* QPB = (const bf16_t*)(p.ws + WS_QPB);
    const bf16_t* SUBK = (const bf16_t*)(p.ws + WS_SUBK);
    int* PIDX = (int*)(p.ws + WS_PIDX); float* PG = (float*)(p.ws + WS_PG);
    const int row0 = tile * 64 + w * 16;
    const int arow = (row0 + lr < NR) ? row0 + lr : NR - 1;
    wave_sync();
#pragma unroll 1
    for (int pp = 0; pp < 2; ++pp) {
        bf16x8 qf[4];
#pragma unroll
        for (int ks = 0; ks < 4; ++ks) qf[ks] = *(const bf16x8*)(QPB + (size_t)arow * 2048 + h * 256 + pp * 128 + ks * 32 + lq * 8);
#pragma unroll
        for (int j = 0; j < 8; ++j) {
            f32x4 a = (f32x4){0.f, 0.f, 0.f, 0.f};
#pragma unroll
            for (int ks = 0; ks < 4; ++ks) { const bf16x8 kf = *(const bf16x8*)(SUBK + ((size_t)pp * 128 + j * 16 + lr) * 128 + ks * 32 + lq * 8); a = __builtin_amdgcn_mfma_f32_16x16x32_bf16(qf[ks], kf, a, 0, 0, 0); }
#pragma unroll
            for (int g = 0; g < 4; ++g) sc[(lq * 4 + g) * 129 + j * 16 + lr] = a[g];
        }
        wave_sync();
#pragma unroll 1
        for (int rr = 0; rr < 4; ++rr) {
            const int row = rr * 4 + lq;
            unsigned k0, k1, k2, k3, k4, k5, k6, k7;
            { const float* sr = sc + row * 129 + lr;
              k0 = (mono_key(sr[0]) & ~0x7Fu) | (unsigned)(127 - lr);        k1 = (mono_key(sr[16]) & ~0x7Fu) | (unsigned)(127 - 16 - lr);
              k2 = (mono_key(sr[32]) & ~0x7Fu) | (unsigned)(127 - 32 - lr);  k3 = (mono_key(sr[48]) & ~0x7Fu) | (unsigned)(127 - 48 - lr);
              k4 = (mono_key(sr[64]) & ~0x7Fu) | (unsigned)(127 - 64 - lr);  k5 = (mono_key(sr[80]) & ~0x7Fu) | (unsigned)(127 - 80 - lr);
              k6 = (mono_key(sr[96]) & ~0x7Fu) | (unsigned)(127 - 96 - lr);  k7 = (mono_key(sr[112]) & ~0x7Fu) | (unsigned)(127 - 112 - lr); }
            CE_DESC(k0, k1) CE_DESC(k2, k3) CE_DESC(k4, k5) CE_DESC(k6, k7)
            CE_DESC(k0, k2) CE_DESC(k1, k3) CE_DESC(k4, k6) CE_DESC(k5, k7)
            CE_DESC(k1, k2) CE_DESC(k5, k6)
            CE_DESC(k0, k4) CE_DESC(k1, k5) CE_DESC(k2, k6) CE_DESC(k3, k7)
            CE_DESC(k2, k4) CE_DESC(k3, k5)
            CE_DESC(k1, k2) CE_DESC(k3, k4) CE_DESC(k5, k6)
            unsigned mine = 0u;
#pragma unroll
            for (int r = 0; r < 16; ++r) {
                const unsigned best = dpp_max16(k0);
                if (lr == r) mine = best;
                const bool own = (k0 == best);
                k0 = own ? k1 : k0; k1 = own ? k2 : k1; k2 = own ? k3 : k2; k3 = own ? k4 : k3; k4 = own ? k5 : k4; k5 = own ? k6 : k5; k6 = own ? k7 : k6; k7 = own ? 0u : k7;
            }
            const int idx = 127 - (int)(mine & 0x7Fu);
            ts[(pp * 16 + row) * 16 + lr] = sc[row * 129 + idx];
            ti[(pp * 16 + row) * 16 + lr] = idx;
        }
        wave_sync();
    }
#pragma unroll 1
    for (int rr = 0; rr < 4; ++rr) {
        const int row = rr * 4 + lq;
        const float s1a = ts[row * 16 + lr];
        const float* s2 = ts + (16 + row) * 16;
        int ptr = 0;
        unsigned key = (mono_key(s1a + s2[0]) & ~0xFFu) | (unsigned)(255 - lr * 16);
        unsigned mine = 0u;
#pragma unroll
        for (int r = 0; r < 16; ++r) {
            const unsigned best = dpp_max16(key);
            if (lr == r) mine = best;
            if (key == best) { ++ptr; key = (ptr < 16) ? ((mono_key(s1a + s2[ptr & 15]) & ~0xFFu) | (unsigned)(255 - lr * 16 - ptr)) : 0u; }
        }
        const int ci = 255 - (int)(mine & 0xFFu), a = ci >> 4, bb = ci & 15;
        const float scv = ts[row * 16 + a] + s2[bb];
        const int e = ti[row * 16 + a] * 128 + ti[(16 + row) * 16 + bb];
        float m16 = scv;
        m16 = fmaxf(m16, __builtin_bit_cast(float, __builtin_amdgcn_update_dpp(0, __builtin_bit_cast(int, m16), 0xB1, 0xF, 0xF, false)));
        m16 = fmaxf(m16, __builtin_bit_cast(float, __builtin_amdgcn_update_dpp(0, __builtin_bit_cast(int, m16), 0x4E, 0xF, 0xF, false)));
        m16 = fmaxf(m16, __builtin_bit_cast(float, __builtin_amdgcn_update_dpp(0, __builtin_bit_cast(int, m16), 0x141, 0xF, 0xF, false)));
        m16 = fmaxf(m16, __builtin_bit_cast(float, __builtin_amdgcn_update_dpp(0, __builtin_bit_cast(int, m16), 0x140, 0xF, 0xF, false)));
        const float ex = expf(scv - m16);
        const float den = dpp_sum16(ex);
        const int grow = row0 + row;
        if (grow < NR) { PIDX[(size_t)grow * 128 + h * 16 + lr] = e; PG[(size_t)grow * 128 + h * 16 + lr] = ex / den; }
    }
}

constexpr float PEER_U_SCALE = 64.0f, PEER_V_SCALE = 8.0f;
DEV unsigned pack4_fp8(float a, float b, float c, float d) { int w = 0; w = __builtin_amdgcn_cvt_pk_fp8_f32(a, b, w, false); w = __builtin_amdgcn_cvt_pk_fp8_f32(c, d, w, true); return (unsigned)w; }
DEV void peer_expert_wave(const Params& p, const int row, unsigned char* wl, const int lane) {
    const int lr = lane & 15, lq = lane >> 4;
    unsigned char* xh = wl;
    unsigned char* xo = wl + 1024;
    float* coefl = (float*)(wl + 2048);
    int* idxl = (int*)(wl + 2048 + 512);
    const float* X1 = (const float*)(p.ws + WS_X1) + (size_t)row * 1024;
    const int* PIDX = (const int*)(p.ws + WS_PIDX) + (size_t)row * 128;
    const float* PG = (const float*)(p.ws + WS_PG) + (size_t)row * 128;
    const unsigned char* U8 = p.ws + WS_U8;
    const unsigned char* V8 = p.ws + WS_V8;
    float xv[16];
#pragma unroll
    for (int j = 0; j < 4; ++j) { const float4 t = *(const float4*)(X1 + lane * 16 + j * 4); xv[4 * j] = t.x; xv[4 * j + 1] = t.y; xv[4 * j + 2] = t.z; xv[4 * j + 3] = t.w; }
    wave_sync();
    {
        uint4 hi, lo; unsigned* hp = (unsigned*)&hi; unsigned* lp = (unsigned*)&lo;
#pragma unroll
        for (int j = 0; j < 4; ++j) {
            const unsigned hw = pack4_fp8(xv[4 * j], xv[4 * j + 1], xv[4 * j + 2], xv[4 * j + 3]);
            const f32x2_ b0 = __builtin_amdgcn_cvt_pk_f32_fp8((int)hw, false), b1 = __builtin_amdgcn_cvt_pk_f32_fp8((int)hw, true);
            hp[j] = hw;
            lp[j] = pack4_fp8(16.f * (xv[4 * j] - b0[0]), 16.f * (xv[4 * j + 1] - b0[1]), 16.f * (xv[4 * j + 2] - b1[0]), 16.f * (xv[4 * j + 3] - b1[1]));
        }
        *(uint4*)(xh + lane * 16) = hi; *(uint4*)(xo + lane * 16) = lo;
    }
    idxl[lane] = PIDX[lane]; idxl[64 + lane] = PIDX[64 + lane];
    wave_sync();
    for (int h = 0; h < 8; ++h) {
        const unsigned char* ub = U8 + (size_t)idxl[h * 16 + lr] * 1024 + lq * 16;
        f32x4 ah = (f32x4){0.f, 0.f, 0.f, 0.f}, al = (f32x4){0.f, 0.f, 0.f, 0.f};
#pragma unroll
        for (int kb = 0; kb < 2; ++kb) {
            uint4 uf[8];
#pragma unroll
            for (int i = 0; i < 8; ++i) uf[i] = *(const uint4*)(ub + (kb * 8 + i) * 64);
#pragma unroll
            for (int i = 0; i < 8; ++i) {
                const int off = (kb * 8 + i) * 64 + lq * 16;
                const long b0 = (long)(((unsigned long long)uf[i].y << 32) | uf[i].x), b1 = (long)(((unsigned long long)uf[i].w << 32) | uf[i].z);
                const long h0 = *(const long*)(xh + off), h1 = *(const long*)(xh + off + 8), l0 = *(const long*)(xo + off), l1 = *(const long*)(xo + off + 8);
                ah = __builtin_amdgcn_mfma_f32_16x16x32_fp8_fp8(h0, b0, ah, 0, 0, 0); ah = __builtin_amdgcn_mfma_f32_16x16x32_fp8_fp8(h1, b1, ah, 0, 0, 0);
                al = __builtin_amdgcn_mfma_f32_16x16x32_fp8_fp8(l0, b0, al, 0, 0, 0); al = __builtin_amdgcn_mfma_f32_16x16x32_fp8_fp8(l1, b1, al, 0, 0, 0);
            }
        }
        if (lq == 0) coefl[h * 16 + lr] = PG[h * 16 + lr] * gelu_tanh((ah[0] + al[0] * 0.0625f) * (1.0f / PEER_U_SCALE)) * (1.0f / PEER_V_SCALE);
    }
    wave_sync();
    float o[16];
#pragma unroll
    for (int i = 0; i < 16; ++i) o[i] = 0.f;
    for (int j = 0; j < 128; j += 8) {
        uint4 va[8]; float c[8];
#pragma unroll
        for (int u = 0; u < 8; ++u) { c[u] = coefl[j + u]; va[u] = *(const uint4*)(V8 + (size_t)idxl[j + u] * 1024 + lane * 16); }
#pragma unroll
        for (int u = 0; u < 8; ++u) {
            const unsigned wds[4] = {va[u].x, va[u].y, va[u].z, va[u].w};
#pragma unroll
            for (int q = 0; q < 4; ++q) {
                const f32x2_ f0 = __builtin_amdgcn_cvt_pk_f32_fp8((int)wds[q], false), f1 = __builtin_amdgcn_cvt_pk_f32_fp8((int)wds[q], true);
                o[4 * q] += c[u] * f0[0]; o[4 * q + 1] += c[u] * f0[1]; o[4 * q + 2] += c[u] * f1[0]; o[4 * q + 3] += c[u] * f1[1];
            }
        }
    }
    float tv[16]; float s = 0.f;
#pragma unroll
    for (int i = 0; i < 16; ++i) { tv[i] = DN_ALPHA * xv[i] + o[i]; s += tv[i]; }
    const float mu = wave_sum(s) * (1.0f / 1024.0f);
    float q = 0.f;
#pragma unroll
    for (int i = 0; i < 16; ++i) { const float d = tv[i] - mu; q += d * d; }
    const float rstd = 1.0f / sqrtf(wave_sum(q) * (1.0f / 1024.0f) + LN_EPS);
    float* y = p.out + O_Y + (size_t)row * 1024 + lane * 16;
#pragma unroll
    for (int j = 0; j < 4; ++j) {
        const float4 g4 = *(const float4*)(p.ln2_g + lane * 16 + j * 4), b4 = *(const float4*)(p.ln2_b + lane * 16 + j * 4);
        float4 yo;
        yo.x = (tv[4 * j] - mu) * rstd * g4.x + b4.x; yo.y = (tv[4 * j + 1] - mu) * rstd * g4.y + b4.y; yo.z = (tv[4 * j + 2] - mu) * rstd * g4.z + b4.z; yo.w = (tv[4 * j + 3] - mu) * rstd * g4.w + b4.w;
        *(float4*)(y + j * 4) = yo;
    }
}

constexpr int QN = 2;
struct AttnState { f32x4 ot[4][QN]; float m[QN]; float l[QN]; };

DEV void attn_block(const unsigned char* Ks, const unsigned char* VTs, const bf16x8 (&Qf)[QN][2], AttnState& A, const int mode, const int dq, const float* blut,
                    const unsigned selbit0, const unsigned selbit1, const bool slc, const int lr, const int lq, const int t0, const int ci0) {
    f32x4 sc[4][QN];
#pragma unroll
    for (int kt = 0; kt < 4; ++kt) {
        const bf16x8 k0 = *(const bf16x8*)(Ks + (kt * 16 + lr) * 144 + lq * 16), k1 = *(const bf16x8*)(Ks + (kt * 16 + lr) * 144 + 64 + lq * 16);
#pragma unroll
        for (int qi = 0; qi < QN; ++qi) {
            f32x4 a = (f32x4){0.f, 0.f, 0.f, 0.f};
            a = __builtin_amdgcn_mfma_f32_16x16x32_bf16(k0, Qf[qi][0], a, 0, 0, 0);
            a = __builtin_amdgcn_mfma_f32_16x16x32_bf16(k1, Qf[qi][1], a, 0, 0, 0);
            sc[kt][qi] = a;
        }
    }
    asm volatile("" ::: "memory");
    if (mode != 0 || slc) {
#pragma unroll
        for (int kt = 0; kt < 4; ++kt)
#pragma unroll
            for (int qi = 0; qi < QN; ++qi)
#pragma unroll
                for (int g = 0; g < 4; ++g) {
                    const int kl = kt * 16 + lq * 4 + g, ql = qi * 16 + lr;
                    float v = sc[kt][qi][g];
                    bool ok = true;
                    if (mode == 1 || mode == 2) { const int di = dq + ql - kl; v += blut[di < 0 ? 0 : di]; }
                    if (mode == 2) ok = kl <= ql + dq;
                    if (mode == 3) ok = kl > ql + dq - 512;
                    if (mode == 4) { const int ci = ci0 + kl, dist = t0 + ql - (16 * ci + 31); ok = (dist >= 0) && (ci < 127); if (dist >= 0 && dist < 192) v += blut[dist]; }
                    if (slc) ok = ok && ((qi == 0 ? selbit0 : selbit1) != 0u);
                    sc[kt][qi][g] = ok ? v : NEGF;
                }
    }
    bf16x8 pf[QN][2];
#pragma unroll
    for (int qi = 0; qi < QN; ++qi) {
        float mb = NEGF;
#pragma unroll
        for (int kt = 0; kt < 4; ++kt) mb = fmaxf(mb, fmaxf(fmaxf(sc[kt][qi][0], sc[kt][qi][1]), fmaxf(sc[kt][qi][2], sc[kt][qi][3])));
        mb = fmaxf(mb, __shfl_xor(mb, 16)); mb = fmaxf(mb, __shfl_xor(mb, 32));
        const float mn = fmaxf(A.m[qi], mb);
        const float alpha = __builtin_amdgcn_exp2f(A.m[qi] - mn);
        A.m[qi] = mn;
        float rs = 0.f;
#pragma unroll
        for (int kt = 0; kt < 4; ++kt)
#pragma unroll
            for (int g = 0; g < 4; ++g) { const float v = sc[kt][qi][g]; const float e = (v > -1e29f) ? __builtin_amdgcn_exp2f(v - mn) : 0.f; sc[kt][qi][g] = e; rs += e; }
        A.l[qi] = A.l[qi] * alpha + rs;
#pragma unroll
        for (int dt = 0; dt < 4; ++dt) A.ot[dt][qi] = A.ot[dt][qi] * alpha;
#pragma unroll
        for (int ks = 0; ks < 2; ++ks) {
            union { bf16x8 v; unsigned u[4]; } pk;
            pk.u[0] = cvt_pk_bf16(sc[2 * ks][qi][0], sc[2 * ks][qi][1]); pk.u[1] = cvt_pk_bf16(sc[2 * ks][qi][2], sc[2 * ks][qi][3]);
            pk.u[2] = cvt_pk_bf16(sc[2 * ks + 1][qi][0], sc[2 * ks + 1][qi][1]); pk.u[3] = cvt_pk_bf16(sc[2 * ks + 1][qi][2], sc[2 * ks + 1][qi][3]);
            pf[qi][ks] = pk.v;
        }
    }
    asm volatile("" ::: "memory");
#pragma unroll
    for (int dt = 0; dt < 4; ++dt)
#pragma unroll
        for (int ks = 0; ks < 2; ++ks) {
            asm volatile("" ::: "memory");
            union { bf16x8 v; uint2 h[2]; } vf;
            vf.h[0] = *(const uint2*)(VTs + (dt * 16 + lr) * 144 + (32 * ks + lq * 4) * 2);
            vf.h[1] = *(const uint2*)(VTs + (dt * 16 + lr) * 144 + (32 * ks + 16 + lq * 4) * 2);
#pragma unroll
            for (int qi = 0; qi < QN; ++qi) A.ot[dt][qi] = __builtin_amdgcn_mfma_f32_16x16x32_bf16(vf.v, pf[qi][ks], A.ot[dt][qi], 0, 0, 0);
        }
}

DEV void nsa_prompt_item(const Params& p, const int b, const int hkv, const int q32, unsigned char* lds) {
    int tid_ = threadIdx.x; asm volatile("" : "+v"(tid_));
    const int tid = tid_, lane = tid & 63, g = tid >> 6, lr = lane & 15, lq = lane >> 4;
    const int hq = hkv * 4 + g, t0 = q32 * 32, kd = t0 >> 6;
    unsigned char* Ks = lds; unsigned char* VTs = lds + 9216;
    float* biasl = (float*)(lds + 18432); float* psl = (float*)(lds + 21504); unsigned* selm = (unsigned*)(lds + 29952); unsigned* misc = (unsigned*)(lds + 30208);
    const bf16_t* ZB = (const bf16_t*)(p.ws + WS_ZB);
    const bf16_t* VTS = (const bf16_t*)(p.ws + WS_VTS) + (size_t)(b * 2 + hkv) * 64 * 2048;
    const bf16_t* VTW = (const bf16_t*)(p.ws + WS_VTW) + (size_t)(b * 2 + hkv) * 64 * 2048;
    const bf16_t* KCB = (const bf16_t*)(p.ws + WS_KCB) + (size_t)(b * 2 + hkv) * 128 * 64;
    const bf16_t* VTC = (const bf16_t*)(p.ws + WS_VTC) + (size_t)(b * 2 + hkv) * 64 * 128;
    const float* Z = (const float*)(p.ws + WS_Z);
    float* NOUTF = (float*)(p.ws + WS_NOUTF);
    bf16_t* NOUTB = (bf16_t*)(p.ws + WS_NOUTB);
    __syncthreads();
    for (int i = tid; i < 4 * 192; i += 256) { const int gg = i / 192, d = i % 192; biasl[i] = (p.rel_bias[rel_bucket(d) * 8 + hkv * 4 + gg] - p.rel_bias[31 * 8 + hkv * 4 + gg]) * LOG2E; }
    for (int i = tid; i < 32 * 33; i += 256) psl[i] = 0.f;
    if (tid < 32) selm[tid] = 0u;
    if (tid == 0) misc[0] = 0u;
    const float* blut = biasl + g * 192;
    bf16x8 Qf[QN][2];
#pragma unroll
    for (int qi = 0; qi < QN; ++qi)
#pragma unroll
        for (int kk = 0; kk < 2; ++kk) Qf[qi][kk] = *(const bf16x8*)(ZB + (size_t)(b * 2048 + t0 + qi * 16 + lr) * IN_DIM + C_Q + hq * 64 + kk * 32 + lq * 8);

    uint4 trk0, trk1, trv0, trv1;
    auto load_tiles = [&](int kind, int kb) __attribute__((always_inline)) {
#pragma unroll
        for (int i = 0; i < 2; ++i) {
            const int id = tid + 256 * i, row = id >> 3, ch = id & 7;
            uint4 rk, rv;
            if (kind == 0) { rk = *(const uint4*)(KCB + (size_t)(kb * 64 + row) * 64 + ch * 8); rv = *(const uint4*)(VTC + (size_t)row * 128 + kb * 64 + ch * 8); }
            else {
                rk = *(const uint4*)(ZB + (size_t)(b * 2048 + kb * 64 + row) * IN_DIM + (kind == 1 ? C_KS : C_KW) + hkv * 64 + ch * 8);
                rv = *(const uint4*)((kind == 1 ? VTS : VTW) + (size_t)row * 2048 + kb * 64 + ch * 8);
            }
            if (i == 0) { trk0 = rk; trv0 = rv; } else { trk1 = rk; trv1 = rv; }
        }
    };
    auto store_tiles = [&]() __attribute__((always_inline)) {
#pragma unroll
        for (int i = 0; i < 2; ++i) { const int id = tid + 256 * i, row = id >> 3, ch = id & 7; *(uint4*)(Ks + row * 144 + ch * 16) = (i == 0 ? trk0 : trk1); *(uint4*)(VTs + row * 144 + ch * 16) = (i == 0 ? trv0 : trv1); }
    };
    auto reset = [&](AttnState& A) __attribute__((always_inline)) {
#pragma unroll
        for (int qi = 0; qi < QN; ++qi) { A.m[qi] = NEGF; A.l[qi] = 0.f;
#pragma unroll
            for (int dt = 0; dt < 4; ++dt) A.ot[dt][qi] = (f32x4){0.f, 0.f, 0.f, 0.f}; }
    };
    auto finish = [&](AttnState& A, int br) __attribute__((always_inline)) {
#pragma unroll
        for (int qi = 0; qi < QN; ++qi) {
            float lt = A.l[qi]; lt += __shfl_xor(lt, 16); lt += __shfl_xor(lt, 32);
            const float sc = (lt > 0.f) ? sigmoidf_(Z[(size_t)(b * 2048 + t0 + qi * 16 + lr) * IN_DIM + C_G + br * 8 + hq]) / lt : 0.f;
            const size_t row = (size_t)(b * 2048 + t0 + qi * 16 + lr);
#pragma unroll
            for (int dt = 0; dt < 4; ++dt) {
                const int col = hq * 64 + dt * 16 + lq * 4;
                f32x4 v = A.ot[dt][qi] * sc;
                if (br > 0) v = v + *(const f32x4*)(NOUTF + row * 512 + col);
                if (br < 2) *(f32x4*)(NOUTF + row * 512 + col) = v; else store_bf16x4(NOUTB + row * 512 + col, v);
            }
        }
    };

    AttnState A;
    const int ncb = ((t0 >> 4) >= 64) ? 2 : 1;
    reset(A);
    load_tiles(0, 0);
    for (int kb = 0; kb < ncb; ++kb) {
        __syncthreads(); store_tiles(); __syncthreads();
        if (kb + 1 < ncb) load_tiles(0, kb + 1);
        attn_block(Ks, VTs, Qf, A, 4, 0, blut, 1u, 1u, false, lr, lq, t0, kb * 64);
    }
    finish(A, 0);
    {
        float linv[QN];
#pragma unroll
        for (int qi = 0; qi < QN; ++qi) { float lt = A.l[qi]; lt += __shfl_xor(lt, 16); lt += __shfl_xor(lt, 32); linv[qi] = (lt > 0.f) ? 1.0f / lt : 0.f; }
        for (int kb = 0; kb < ncb; ++kb) {
            if (ncb > 1) { load_tiles(0, kb); __syncthreads(); store_tiles(); __syncthreads(); }
#pragma unroll
            for (int kt = 0; kt < 4; ++kt) {
                const bf16x8 k0 = *(const bf16x8*)(Ks + (kt * 16 + lr) * 144 + lq * 16), k1 = *(const bf16x8*)(Ks + (kt * 16 + lr) * 144 + 64 + lq * 16);
#pragma unroll
                for (int qi = 0; qi < QN; ++qi) {
                    f32x4 a = (f32x4){0.f, 0.f, 0.f, 0.f};
                    a = __builtin_amdgcn_mfma_f32_16x16x32_bf16(k0, Qf[qi][0], a, 0, 0, 0);
                    a = __builtin_amdgcn_mfma_f32_16x16x32_bf16(k1, Qf[qi][1], a, 0, 0, 0);
                    float pr[4];
#pragma unroll
                    for (int gg = 0; gg < 4; ++gg) {
                        const int ci = kb * 64 + kt * 16 + lq * 4 + gg, ql = qi * 16 + lr, dist = t0 + ql - (16 * ci + 31);
                        float v = a[gg];
                        if (dist >= 0 && dist < 192) v += blut[dist];
                        pr[gg] = (dist >= 0 && ci < 127) ? __builtin_amdgcn_exp2f(v - A.m[qi]) * linv[qi] : 0.f;
                    }
                    const int blk = kb * 16 + kt * 4 + lq, ql = qi * 16 + lr;
                    atomicAdd(&psl[ql * 33 + blk], 2.0f * (pr[0] + pr[1] + pr[2]) + pr[3]);
                    atomicAdd(&psl[ql * 33 + blk + 1], pr[3]);
                }
            }
        }
    }
    __syncthreads();
    {
        const int ql = tid >> 3, part = tid & 7, tq = t0 + ql, cur = tq >> 6;
        float scv[32];
#pragma unroll
        for (int j = 0; j < 32; ++j) {
            const bool causal = j * 64 <= tq, forced = (j == 0) || (j == cur) || (j == cur - 1);
            scv[j] = causal ? (forced ? 1e4f : psl[ql * 33 + j]) : NEGF;
        }
        unsigned mbits = 0u;
#pragma unroll
        for (int jj = 0; jj < 4; ++jj) {
            const int j = part * 4 + jj;
            float my = NEGF;
#pragma unroll
            for (int k = 0; k < 32; ++k) my = (k == j) ? scv[k] : my;
            int rank = 0;
#pragma unroll
            for (int k = 0; k < 32; ++k) rank += ((scv[k] > my) || (scv[k] == my && k < j)) ? 1 : 0;
            if (rank < 16 && j * 64 <= tq) mbits |= (1u << j);
        }
        atomicOr(&selm[ql], mbits);
        atomicOr(&misc[0], mbits);
    }
    __syncthreads();
    const unsigned msk0 = selm[lr], msk1 = selm[16 + lr];
    const unsigned anym = misc[0];
    reset(A);
    {
        int kb = kd;
        load_tiles(1, kb);
        for (;;) {
            __syncthreads(); store_tiles(); __syncthreads();
            int nxt = (kb == kd) ? 0 : kb + 1;
            while (nxt < kd && !((anym >> nxt) & 1u)) ++nxt;
            const bool more = nxt < kd;
            if (more) load_tiles(1, nxt);
            const int mode = (kb == kd) ? 2 : ((kb >= kd - 2) ? 1 : 0);
            attn_block(Ks, VTs, Qf, A, mode, t0 - kb * 64, blut, (msk0 >> kb) & 1u, (msk1 >> kb) & 1u, true, lr, lq, t0, 0);
            if (!more) break;
            kb = nxt;
        }
    }
    finish(A, 1);
    reset(A);
    {
        const int klo = (t0 >= 511) ? ((t0 - 511) >> 6) : 0;
        int kb = kd;
        load_tiles(2, kb);
        for (;;) {
            __syncthreads(); store_tiles(); __syncthreads();
            const bool more = kb > klo;
            if (more) load_tiles(2, kb - 1);
            const int dq = t0 - kb * 64;
            const int mode = (kb == kd) ? 2 : ((kb >= kd - 2) ? 1 : ((dq + 31 >= 512) ? 3 : 0));
            attn_block(Ks, VTs, Qf, A, mode, dq, blut, 1u, 1u, false, lr, lq, t0, 0);
            if (!more) break;
            --kb;
        }
    }
    finish(A, 2);
}

#define Z ((float*)(p.ws + WS_Z))
#define QK ((float*)(p.ws + WS_QK))
#define HRAW ((float*)(p.ws + WS_HRAW))
#define MOUTB ((bf16_t*)(p.ws + WS_MOUTB))
#define NOUTB ((bf16_t*)(p.ws + WS_NOUTB))
#define HIDPB ((bf16_t*)(p.ws + WS_HIDPB))
#define HIDSB ((bf16_t*)(p.ws + WS_HIDSB))
#define KCS ((float*)(p.ws + WS_KCS))
#define MIX ((float*)(p.ws + WS_MIX))
#define MIXB ((bf16_t*)(p.ws + WS_MIXB))
#define T1 ((float*)(p.ws + WS_T1))
#define X1 ((float*)(p.ws + WS_X1))
#define X1B ((bf16_t*)(p.ws + WS_X1B))
#define QPB ((bf16_t*)(p.ws + WS_QPB))
#define S ((float*)(p.ws + WS_S))
#define CONVB ((bf16_t*)(p.ws + WS_CONVB))
#define XB ((bf16_t*)(p.ws + WS_XB))
#define WIN_T ((bf16_t*)(p.ws + WS_WIN_T))
#define WUPM_T ((bf16_t*)(p.ws + WS_WUPM_T))
#define WUPN_T ((bf16_t*)(p.ws + WS_WUPN_T))
#define WOUT_T ((bf16_t*)(p.ws + WS_WOUT_T))
#define PWQ_T ((bf16_t*)(p.ws + WS_PWQ_T))
#define WQK_T ((bf16_t*)(p.ws + WS_WQK_T))
#define W1_T ((bf16_t*)(p.ws + WS_W1_T))
#define W2_T ((bf16_t*)(p.ws + WS_W2_T))
#define SUBK ((bf16_t*)(p.ws + WS_SUBK))
#define ZB ((bf16_t*)(p.ws + WS_ZB))
#define VTS ((bf16_t*)(p.ws + WS_VTS))
#define VTW ((bf16_t*)(p.ws + WS_VTW))
#define KCB ((bf16_t*)(p.ws + WS_KCB))
#define VTC ((bf16_t*)(p.ws + WS_VTC))
__global__ void __launch_bounds__(NTHREADS, 2) fwd_kernel(Params p) {
    extern __shared__ __attribute__((aligned(16))) unsigned char smem[];
    if (threadIdx.x == 0) { *(uint4*)smem = make_uint4(0u, 0u, 0u, 0u); }
    __syncthreads();
    XcdBarrier bar = xcd_barrier_post((unsigned*)(p.ws + WS_BAR), (volatile LAS unsigned*)smem);
    float* lds = (float*)(smem + 16);
    unsigned char* ldsb = smem + 16;
    const int tid = threadIdx.x, lane = tid & 63, w = tid >> 6;
    const int gw = blockIdx.x * 4 + w, nw = gridDim.x * 4;
    const size_t gt = (size_t)blockIdx.x * NTHREADS + tid, nt = (size_t)gridDim.x * NTHREADS;


    {
        for (size_t id = gt; id < (size_t)MP * 128; id += nt) {
            const int row = (int)(id >> 7), k8 = (int)(id & 127) * 8;
            float f[8];
            if (row < NR) {
                const float* s = (row < NP ? p.x_prompt + (size_t)row * 1024 : p.x_sample + (size_t)(row - NP) * 1024) + k8;
                const float4 a = *(const float4*)s, b = *(const float4*)(s + 4);
                f[0] = a.x; f[1] = a.y; f[2] = a.z; f[3] = a.w; f[4] = b.x; f[5] = b.y; f[6] = b.z; f[7] = b.w;
            } else {
#pragma unroll
                for (int i = 0; i < 8; ++i) f[i] = 0.f;
            }
            *(uint4*)(XB + (size_t)row * 1024 + k8) = pack8(f);
        }
        transpose_to_bf16(p.w_in, 1024, IN_DIM, WIN_T, gt, nt);
        transpose_to_bf16(p.w_up_m, 512, 1024, WUPM_T, gt, nt);
        transpose_to_bf16(p.w_up_n, 512, 1024, WUPN_T, gt, nt);
        transpose_to_bf16(p.w_out, 1024, 1024, WOUT_T, gt, nt);
        transpose_to_bf16(p.peer_wq, 1024, 2048, PWQ_T, gt, nt);
        for (int h = 0; h < 4; ++h) {
            transpose_to_bf16(p.wq + (size_t)h * 16384, 128, 128, WQK_T + (size_t)(h * 256) * 128, gt, nt);
            transpose_to_bf16(p.wk + (size_t)h * 16384, 128, 128, WQK_T + (size_t)(h * 256 + 128) * 128, gt, nt);
        }
        for (int c = 0; c < 2; ++c) {
            transpose_to_bf16(p.cmp_w1 + (size_t)c * 2048 * 64, 2048, 64, W1_T + (size_t)c * 64 * 2048, gt, nt);
            transpose_to_bf16(p.cmp_w2 + (size_t)c * 4096, 64, 64, W2_T + (size_t)c * 4096, gt, nt);
        }
        for (size_t id = gt; id < (size_t)2 * 128 * 128 / 8; id += nt) {
            float f[8];
#pragma unroll
            for (int i = 0; i < 8; ++i) f[i] = p.peer_sub[id * 8 + i];
            *(uint4*)(SUBK + id * 8) = pack8(f);
        }
        for (size_t id = gt; id < (size_t)16384 * 64; id += nt) {
            const float* su = p.peer_u + id * 16; const float* sv = p.peer_v + id * 16;
            uint4 ou, ov; unsigned* pu = (unsigned*)&ou; unsigned* pv = (unsigned*)&ov;
#pragma unroll
            for (int j = 0; j < 4; ++j) {
                const float4 a4 = *(const float4*)(su + j * 4), c4 = *(const float4*)(sv + j * 4);
                pu[j] = pack4_fp8(a4.x * PEER_U_SCALE, a4.y * PEER_U_SCALE, a4.z * PEER_U_SCALE, a4.w * PEER_U_SCALE);
                pv[j] = pack4_fp8(c4.x * PEER_V_SCALE, c4.y * PEER_V_SCALE, c4.z * PEER_V_SCALE, c4.w * PEER_V_SCALE);
            }
            *(uint4*)(p.ws + WS_U8 + id * 16) = ou; *(uint4*)(p.ws + WS_V8 + id * 16) = ov;
        }
        for (size_t i = gt; i < (size_t)BS * 511 * 256; i += nt) {
            const int j = (int)(i & 255); const int wv = (int)((i >> 8) % 511); const int b = (int)((i >> 8) / 511);
            p.out[O_WINS + ((size_t)b * 512 + wv) * 256 + j] = p.state_win[((size_t)b * 512 + wv + 1) * 256 + j];
        }
        for (size_t i = gt; i < (size_t)BS * 2 * 512; i += nt) {
            const int ch = (int)(i & 511); const int jj = (int)((i >> 9) & 1); const int b = (int)(i >> 10);
            p.out[O_CVS + ((size_t)b * 3 + jj) * 512 + ch] = p.state_conv[((size_t)b * 3 + jj + 1) * 512 + ch];
        }
    }
    xcd_barrier(bar);

    gemm_bf16<128>(NR, IN_DIM, 1024,
        [&](int r, int k) { return *(const uint4*)(XB + (size_t)r * 1024 + k); },
        [&](int n, int k) { return *(const uint4*)(WIN_T + (size_t)n * 1024 + k); },
        [&](int r, int c0, f32x4 v) {
            *(f32x4*)(Z + (size_t)r * IN_DIM + c0) = v;
            store_bf16x4(ZB + (size_t)r * IN_DIM + c0, (c0 >= C_Q && c0 < C_KC) ? v * (0.125f * LOG2E) : v);
            if (r < NP && ((c0 >= C_KS + 128 && c0 < C_KW) || (c0 >= C_KW + 128 && c0 < C_G))) {
                const bool isw = c0 >= C_KW; const int cc = c0 - (isw ? C_KW : C_KS) - 128;
                bf16_t* vt = (isw ? VTW : VTS) + ((size_t)((r >> 11) * 2) * 64 + cc) * 2048 + (r & 2047);
                const unsigned w0 = cvt_pk_bf16(v[0], v[1]), w1 = cvt_pk_bf16(v[2], v[3]);
                vt[0] = (bf16_t)(w0 & 0xffffu); vt[2048] = (bf16_t)(w0 >> 16); vt[4096] = (bf16_t)(w1 & 0xffffu); vt[6144] = (bf16_t)(w1 >> 16);
            }
            if (r < NP && c0 >= C_V && c0 < C_O) {
                bf16_t* vt = (bf16_t*)(p.ws + WS_VTM) + ((size_t)(r >> 11) * 512 + (c0 - C_V)) * 2048 + (r & 2047);
                const unsigned w0 = cvt_pk_bf16(v[0], v[1]), w1 = cvt_pk_bf16(v[2], v[3]);
                vt[0] = (bf16_t)(w0 & 0xffffu); vt[2048] = (bf16_t)(w0 >> 16); vt[4096] = (bf16_t)(w1 & 0xffffu); vt[6144] = (bf16_t)(w1 >> 16);
            }
            if (c0 >= C_KC && c0 < C_KS) *(f32x4*)(p.out + O_CMPP + (size_t)r * 256 + (c0 - C_KC)) = v;
            else if (c0 >= C_KS && c0 < C_KW) *(f32x4*)(p.out + O_SLCP + (size_t)r * 256 + (c0 - C_KS)) = v;
            else if (c0 >= C_KW && c0 < C_G) {
                if (r < NP) { const int t = r & 2047; if (t >= 1536) *(f32x4*)(p.out + O_WINP + ((size_t)(r >> 11) * 512 + (t - 1536)) * 256 + (c0 - C_KW)) = v; }
                else *(f32x4*)(p.out + O_WINS + ((size_t)(r - NP) * 512 + 511) * 256 + (c0 - C_KW)) = v;
            } else if (c0 < C_V) {
                if (r < NP) { const int t = r & 2047; if (t >= 2045) *(f32x4*)(p.out + O_CVP + ((size_t)(r >> 11) * 3 + (t - 2045)) * 512 + c0) = v; }
                else *(f32x4*)(p.out + O_CVS + ((size_t)(r - NP) * 3 + 2) * 512 + c0) = v;
            }
        }, ldsb);
    xcd_barrier(bar);

    for (size_t i = gt; i < (size_t)NR * 512; i += nt) {
        const int ch = (int)(i & 511); const int r = (int)(i >> 9);
        float a = p.conv_b[ch];
        if (r < NP) {
            const int t = r & 2047;
#pragma unroll
            for (int j = 0; j < 4; ++j) if (t + j - 3 >= 0) a += p.conv_w[j * 512 + ch] * Z[(size_t)(r + j - 3) * IN_DIM + C_U + ch];
        } else {
            const int b = r - NP;
#pragma unroll
            for (int j = 0; j < 3; ++j) a += p.conv_w[j * 512 + ch] * p.state_conv[((size_t)b * 3 + j) * 512 + ch];
            a += p.conv_w[3 * 512 + ch] * Z[(size_t)r * IN_DIM + C_U + ch];
        }
        CONVB[i] = (bf16_t)(cvt_pk_bf16(a / (1.0f + expf(-a)), 0.f) & 0xffffu);
    }
    xcd_barrier(bar);

    for (int h = 0; h < 4; ++h) {
        gemm_bf16<128>(NR, 256, 128,
            [&](int r, int k) { return *(const uint4*)(CONVB + (size_t)r * 512 + h * 128 + k); },
            [&](int n, int k) { return *(const uint4*)(WQK_T + (size_t)(h * 256 + n) * 128 + k); },
            [&](int r, int c0, f32x4 v) {
                if (c0 >= 128) v = v * 0.08838834764831845f;
                *(f32x4*)(QK + (size_t)r * 1024 + h * 256 + c0) = v;
                if (c0 < 128) store_bf16x4((bf16_t*)(p.ws + WS_QB) + (size_t)r * 512 + h * 128 + c0, v);
                else {
                    store_bf16x4((bf16_t*)(p.ws + WS_KB) + (size_t)r * 512 + h * 128 + (c0 - 128), v);
                    if (r < NP) {
                        bf16_t* kt = (bf16_t*)(p.ws + WS_KTB) + ((size_t)((r >> 11) * 4 + h) * 128 + (c0 - 128)) * 2048 + (r & 2047);
                        const unsigned w0 = cvt_pk_bf16(v[0], v[1]), w1 = cvt_pk_bf16(v[2], v[3]);
                        kt[0] = (bf16_t)(w0 & 0xffffu); kt[2048] = (bf16_t)(w0 >> 16); kt[4096] = (bf16_t)(w1 & 0xffffu); kt[6144] = (bf16_t)(w1 >> 16);
                    }
                } }, ldsb);
    }
    for (int c = 0; c < 2; ++c) {
        gemm_bf16<64>(4096, 64, 2048,
            [&](int row, int k) {
                const int hh = row & 1, bi = row >> 1, i = bi & 127, b = bi >> 7, j = k >> 6, d0 = k & 63, tok = 16 * i + j;
                const float* pe = p.cmp_pe + (c * 32 + j) * 64 + d0;
                const float4 e0 = *(const float4*)pe, e1 = *(const float4*)(pe + 4);
                float f[8] = {e0.x, e0.y, e0.z, e0.w, e1.x, e1.y, e1.z, e1.w};
                if (tok < 2048) {
                    const float* s = Z + ((size_t)b * 2048 + tok) * IN_DIM + C_KC + c * 128 + hh * 64 + d0;
                    const float4 a0 = *(const float4*)s, a1 = *(const float4*)(s + 4);
                    f[0] += a0.x; f[1] += a0.y; f[2] += a0.z; f[3] += a0.w; f[4] += a1.x; f[5] += a1.y; f[6] += a1.z; f[7] += a1.w;
                }
                return pack8(f); },
            [&](int n, int k) { return *(const uint4*)(W1_T + ((size_t)c * 64 + n) * 2048 + k); },
            [&](int row, int c0, f32x4 v) {
                f32x4 g; g[0] = gelu_tanh(v[0]); g[1] = gelu_tanh(v[1]); g[2] = gelu_tanh(v[2]); g[3] = gelu_tanh(v[3]);
                store_bf16x4(HIDPB + ((size_t)c * 4096 + row) * 64 + c0, g); }, ldsb);
        gemm_bf16<64>(65536, 64, 2048,
            [&](int row, int k) {
                const int hh = row & 1, bi = row >> 1, i = bi & 1023, b = bi >> 10, j = k >> 6, d0 = k & 63, tok = 16 * i + j;
                const float* pe = p.cmp_pe + (c * 32 + j) * 64 + d0;
                const float4 e0 = *(const float4*)pe, e1 = *(const float4*)(pe + 4);
                float f[8] = {e0.x, e0.y, e0.z, e0.w, e1.x, e1.y, e1.z, e1.w};
                if (tok < PAST) {
                    const int page = p.page_table[b * 128 + (tok >> 7)];
                    const float* s = p.cache_cmp + ((size_t)page * 128 + (tok & 127)) * 256 + c * 128 + hh * 64 + d0;
                    const float4 a0 = *(const float4*)s, a1 = *(const float4*)(s + 4);
                    f[0] += a0.x; f[1] += a0.y; f[2] += a0.z; f[3] += a0.w; f[4] += a1.x; f[5] += a1.y; f[6] += a1.z; f[7] += a1.w;
                }
                return pack8(f); },
            [&](int n, int k) { return *(const uint4*)(W1_T + ((size_t)c * 64 + n) * 2048 + k); },
            [&](int row, int c0, f32x4 v) {
                f32x4 g; g[0] = gelu_tanh(v[0]); g[1] = gelu_tanh(v[1]); g[2] = gelu_tanh(v[2]); g[3] = gelu_tanh(v[3]);
                store_bf16x4(HIDSB + ((size_t)c * 65536 + row) * 64 + c0, g); }, ldsb);
    }
    xcd_barrier(bar);

    for (int item = blockIdx.x; item < 256 + 128; item += gridDim.x) {
        if (item < 256) mlstm_chunk_item(p, item, ldsb); else mlstm_scan_item(p, 64 + (item - 256), lds);
    }
    for (int c = 0; c < 2; ++c) {
        gemm_bf16<64>(4096, 64, 64,
            [&](int row, int k) { return *(const uint4*)(HIDPB + ((size_t)c * 4096 + row) * 64 + k); },
            [&](int n, int k) { return *(const uint4*)(W2_T + ((size_t)c * 64 + n) * 64 + k); },
            [&](int row, int c0, f32x4 v) {
                const int hh = row & 1, bi = row >> 1, i = bi & 127, b = bi >> 7;
                if (c == 0) store_bf16x4(KCB + ((size_t)(b * 2 + hh) * 128 + i) * 64 + c0, v);
                else { bf16_t* vt = VTC + ((size_t)(b * 2 + hh) * 64 + c0) * 128 + i; const unsigned w0 = cvt_pk_bf16(v[0], v[1]), w1 = cvt_pk_bf16(v[2], v[3]);
                       vt[0] = (bf16_t)(w0 & 0xffffu); vt[128] = (bf16_t)(w0 >> 16); vt[256] = (bf16_t)(w1 & 0xffffu); vt[384] = (bf16_t)(w1 >> 16); } }, ldsb);
        gemm_bf16<64>(65536, 64, 64,
            [&](int row, int k) { return *(const uint4*)(HIDSB + ((size_t)c * 65536 + row) * 64 + k); },
            [&](int n, int k) { return *(const uint4*)(W2_T + ((size_t)c * 64 + n) * 64 + k); },
            [&](int row, int c0, f32x4 v) { *(f32x4*)(KCS + ((size_t)c * 65536 + row) * 64 + c0) = v; }, ldsb);
    }
    xcd_barrier(bar);

    for (int it = gw; it < NR * 4; it += nw) {
        const int row = it >> 2, h = it & 3;
        const float x0 = HRAW[(size_t)row * 512 + h * 128 + lane], x1 = HRAW[(size_t)row * 512 + h * 128 + 64 + lane];
        const float mu = wave_sum(x0 + x1) * (1.0f / 128.0f);
        const float d0 = x0 - mu, d1 = x1 - mu;
        const float var = wave_sum(d0 * d0 + d1 * d1) * (1.0f / 128.0f);
        const float rstd = 1.0f / sqrtf(var + LN_EPS);
        const int c0 = h * 128 + lane, c1 = c0 + 64;
        MOUTB[(size_t)row * 512 + c0] = (bf16_t)(cvt_pk_bf16(sigmoidf_(Z[(size_t)row * IN_DIM + C_O + c0]) * (d0 * rstd * p.norm_g[c0]), 0.f) & 0xffffu);
        MOUTB[(size_t)row * 512 + c1] = (bf16_t)(cvt_pk_bf16(sigmoidf_(Z[(size_t)row * IN_DIM + C_O + c1]) * (d1 * rstd * p.norm_g[c1]), 0.f) & 0xffffu);
    }
    if (blockIdx.x < 16) {
        float* wl = lds + w * 4416;
        const int it = blockIdx.x * 4 + w;
        nsa_item(p, NP + (it >> 1), it & 1, wl, lane);
    }
    for (;;) {
        __syncthreads();
        if (tid == 0) *(volatile int*)(ldsb + 30464) = (int)atomicAdd((unsigned*)(p.ws + WS_BAR) + 2, 1u);
        __syncthreads();
        const int idx = *(volatile int*)(ldsb + 30464);
        if (idx >= 2048) break;
        nsa_prompt_item(p, (idx & 31) >> 1, idx & 1, 63 - (idx >> 5), ldsb);
    }
    xcd_barrier(bar);

    gemm_bf16<128>(NR, 1024, 512,
        [&](int r, int k) { return *(const uint4*)(MOUTB + (size_t)r * 512 + k); },
        [&](int n, int k) { return *(const uint4*)(WUPM_T + (size_t)n * 512 + k); },
        [&](int r, int c0, f32x4 v) {
            const f32x4 g = *(const f32x4*)(Z + (size_t)r * IN_DIM + C_GM + c0);
            f32x4 o; o[0] = sigmoidf_(g[0]) * v[0]; o[1] = sigmoidf_(g[1]) * v[1]; o[2] = sigmoidf_(g[2]) * v[2]; o[3] = sigmoidf_(g[3]) * v[3];
            *(f32x4*)(MIX + (size_t)r * 1024 + c0) = o; }, ldsb);
    gemm_bf16<128>(NR, 1024, 512,
        [&](int r, int k) { return *(const uint4*)(NOUTB + (size_t)r * 512 + k); },
        [&](int n, int k) { return *(const uint4*)(WUPN_T + (size_t)n * 512 + k); },
        [&](int r, int c0, f32x4 v) {
            const f32x4 g = *(const f32x4*)(Z + (size_t)r * IN_DIM + C_GN + c0);
            f32x4 o = *(const f32x4*)(MIX + (size_t)r * 1024 + c0);
            o[0] += sigmoidf_(g[0]) * v[0]; o[1] += sigmoidf_(g[1]) * v[1]; o[2] += sigmoidf_(g[2]) * v[2]; o[3] += sigmoidf_(g[3]) * v[3];
            store_bf16x4(MIXB + (size_t)r * 1024 + c0, o); }, ldsb);
    xcd_barrier(bar);

    gemm_bf16<128>(NR, 1024, 1024,
        [&](int r, int k) { return *(const uint4*)(MIXB + (size_t)r * 1024 + k); },
        [&](int n, int k) { return *(const uint4*)(WOUT_T + (size_t)n * 1024 + k); },
        [&](int r, int c0, f32x4 v) {
            const f32x4 xv = *(const f32x4*)((r < NP ? p.x_prompt + (size_t)r * 1024 : p.x_sample + (size_t)(r - NP) * 1024) + c0);
            *(f32x4*)(T1 + (size_t)r * 1024 + c0) = xv * DN_ALPHA + v; }, ldsb);
    xcd_barrier(bar);

    for (int row = gw; row < NR; row += nw) {
        float tv[16]; float s = 0.f;
#pragma unroll
        for (int j = 0; j < 4; ++j) { const float4 t4 = *(const float4*)(T1 + (size_t)row * 1024 + j * 256 + lane * 4); tv[4 * j] = t4.x; tv[4 * j + 1] = t4.y; tv[4 * j + 2] = t4.z; tv[4 * j + 3] = t4.w; s += (t4.x + t4.y) + (t4.z + t4.w); }
        const float mu = wave_sum(s) * (1.0f / 1024.0f);
        float q = 0.f;
#pragma unroll
        for (int j = 0; j < 16; ++j) { const float d = tv[j] - mu; q += d * d; }
        const float rstd = 1.0f / sqrtf(wave_sum(q) * (1.0f / 1024.0f) + LN_EPS);
#pragma unroll
        for (int j = 0; j < 4; ++j) {
            const int c = j * 256 + lane * 4;
            const float4 g4 = *(const float4*)(p.ln1_g + c), b4 = *(const float4*)(p.ln1_b + c);
            f32x4 o; o[0] = (tv[4 * j] - mu) * rstd * g4.x + b4.x; o[1] = (tv[4 * j + 1] - mu) * rstd * g4.y + b4.y; o[2] = (tv[4 * j + 2] - mu) * rstd * g4.z + b4.z; o[3] = (tv[4 * j + 3] - mu) * rstd * g4.w + b4.w;
            *(f32x4*)(X1 + (size_t)row * 1024 + c) = o;
            store_bf16x4(X1B + (size_t)row * 1024 + c, o);
        }
    }
    xcd_barrier(bar);

    gemm_bf16<128>(NR, 2048, 1024,
        [&](int r, int k) { return *(const uint4*)(X1B + (size_t)r * 1024 + k); },
        [&](int n, int k) { return *(const uint4*)(PWQ_T + (size_t)n * 1024 + k); },
        [&](int r, int c0, f32x4 v) { store_bf16x4(QPB + (size_t)r * 2048 + c0, v); }, ldsb);
    xcd_barrier(bar);

    for (int it = blockIdx.x; it < 513 * 8; it += gridDim.x) { __syncthreads(); peer_score_topk_item(p, it >> 3, it & 7, ldsb); }
    xcd_barrier(bar);

    for (int row = gw; row < NR; row += nw) peer_expert_wave(p, row, ldsb + w * 3072, lane);
}

extern "C" void kernel_launch(void* const* d_in, const int* in_sizes, int n_in, void* d_out, int out_size, void* d_ws, size_t ws_size, hipStream_t stream) {
    static int grid = 0;
    if (grid == 0) {
        if (n_in != 32 || (size_t)out_size != O_END || ws_size < WS_END) {
            fprintf(stderr, "kernel_launch: unexpected sizes n_in %d out %d ws %zu (need %zu)\n", n_in, out_size, ws_size, (size_t)WS_END); grid = -1; return; }
        int dev = 0, cus = 0, per_cu = 0;
        if (hipGetDevice(&dev) != hipSuccess || hipDeviceGetAttribute(&cus, hipDeviceAttributeMultiprocessorCount, dev) != hipSuccess) { grid = -1; return; }
        if (hipFuncSetAttribute((const void*)fwd_kernel, hipFuncAttributeMaxDynamicSharedMemorySize, LDS_BYTES) != hipSuccess) { fprintf(stderr, "hipFuncSetAttribute failed\n"); grid = -1; return; }
        if (hipOccupancyMaxActiveBlocksPerMultiprocessor(&per_cu, (const void*)fwd_kernel, NTHREADS, LDS_BYTES) != hipSuccess || per_cu < 1) { fprintf(stderr, "occupancy query failed (%d)\n", per_cu); (void)hipGetLastError(); per_cu = 1; }
        if (per_cu > 2) per_cu = 2;
        grid = cus * per_cu;
    }
    if (grid < 0) return;
    (void)hipMemsetAsync((char*)d_ws + WS_BAR, 0, XCD_BAR_WORDS * sizeof(unsigned), stream);
    Params p{};
    p.x_prompt = (const float*)d_in[0]; p.x_sample = (const float*)d_in[1]; p.cache_cmp = (const float*)d_in[2]; p.cache_slc = (const float*)d_in[3];
    p.page_table = (const int*)d_in[4]; p.state_win = (const float*)d_in[5]; p.state_C = (const float*)d_in[6]; p.state_n = (const float*)d_in[7];
    p.state_m = (const float*)d_in[8]; p.state_conv = (const float*)d_in[9]; p.w_in = (const float*)d_in[10]; p.conv_w = (const float*)d_in[11];
    p.conv_b = (const float*)d_in[12]; p.wq = (const float*)d_in[13]; p.wk = (const float*)d_in[14]; p.gate_bias = (const float*)d_in[15];
    p.norm_g = (const float*)d_in[16]; p.cmp_pe = (const float*)d_in[17]; p.cmp_w1 = (const float*)d_in[18]; p.cmp_w2 = (const float*)d_in[19];
    p.rel_bias = (const float*)d_in[20]; p.w_up_m = (const float*)d_in[21]; p.w_up_n = (const float*)d_in[22]; p.w_out = (const float*)d_in[23];
    p.ln1_g = (const float*)d_in[24]; p.ln1_b = (const float*)d_in[25]; p.ln2_g = (const float*)d_in[26]; p.ln2_b = (const float*)d_in[27];
    p.peer_wq = (const float*)d_in[28]; p.peer_sub = (const float*)d_in[29]; p.peer_u = (const float*)d_in[30]; p.peer_v = (const float*)d_in[31];
    p.out = (float*)d_out; p.ws = (unsigned char*)d_ws;
    hipLaunchKernelGGL(fwd_kernel, dim3(grid), dim3(NTHREADS), LDS_BYTES, stream, p);
}
```

```cpp
#include <hip/hip_runtime.h>
#include <stdint.h>
#include <cstdio>

#define DEV __device__ __forceinline__

constexpr int DM = 1024;
constexpr int BP = 16, TP = 2048, BS = 32;
constexpr int NP = BP * TP;
constexpr int NR = NP + BS;
constexpr int MP = 32896;
constexpr int IN_DIM = 4896;
constexpr int C_U = 0, C_V = 512, C_O = 1024, C_I = 1536, C_F = 1540, C_Q = 1544, C_KC = 2056, C_KS = 2312, C_KW = 2568, C_G = 2824, C_GM = 2848, C_GN = 3872;
constexpr int PAST = 16384;
constexpr float NEGF = -1e30f;
constexpr float DN_ALPHA = 1.189207115002721f;
constexpr float LN_EPS = 1e-5f;
constexpr float LOG2E = 1.4426950408889634f;

constexpr size_t O_Y = 0;
constexpr size_t O_CMPP = (size_t)NR * DM;
constexpr size_t O_CMPS = O_CMPP + (size_t)NP * 256;
constexpr size_t O_SLCP = O_CMPS + (size_t)BS * 256;
constexpr size_t O_SLCS = O_SLCP + (size_t)NP * 256;
constexpr size_t O_WINP = O_SLCS + (size_t)BS * 256;
constexpr size_t O_WINS = O_WINP + (size_t)BP * 512 * 256;
constexpr size_t O_CP = O_WINS + (size_t)BS * 512 * 256;
constexpr size_t O_CS = O_CP + (size_t)BP * 4 * 128 * 128;
constexpr size_t O_NP = O_CS + (size_t)BS * 4 * 128 * 128;
constexpr size_t O_NS = O_NP + (size_t)BP * 4 * 128;
constexpr size_t O_MP = O_NS + (size_t)BS * 4 * 128;
constexpr size_t O_MS = O_MP + (size_t)BP * 4;
constexpr size_t O_CVP = O_MS + (size_t)BS * 4;
constexpr size_t O_CVS = O_CVP + (size_t)BP * 3 * 512;
constexpr size_t O_END = O_CVS + (size_t)BS * 3 * 512;
static_assert(O_END == 59916480, "output size");

constexpr size_t al256(size_t x) { return (x + 255) & ~(size_t)255; }
constexpr size_t WS_BAR = 0;
constexpr size_t WS_Z = 16384;
constexpr size_t WS_QK = al256(WS_Z + (size_t)MP * IN_DIM * 4);
constexpr size_t WS_HRAW = al256(WS_QK + (size_t)MP * 1024 * 4);
constexpr size_t WS_MOUTB = al256(WS_HRAW + (size_t)MP * 512 * 4);
constexpr size_t WS_NOUTB = al256(WS_MOUTB + (size_t)MP * 512 * 2);
constexpr size_t WS_HIDPB = al256(WS_NOUTB + (size_t)MP * 512 * 2);
constexpr size_t WS_KCP = al256(WS_HIDPB + (size_t)2 * 4096 * 64 * 2);
constexpr size_t WS_HIDSB = al256(WS_KCP + 256);
constexpr size_t WS_KCS = al256(WS_HIDSB + (size_t)2 * 65536 * 64 * 2);
constexpr size_t WS_MIX = al256(WS_KCS + (size_t)2 * 65536 * 64 * 4);
constexpr size_t WS_MIXB = al256(WS_MIX + (size_t)MP * 1024 * 4);
constexpr size_t WS_T1 = al256(WS_MIXB + (size_t)MP * 1024 * 2);
constexpr size_t WS_X1 = al256(WS_T1 + (size_t)MP * 1024 * 4);
constexpr size_t WS_X1B = al256(WS_X1 + (size_t)MP * 1024 * 4);
constexpr size_t WS_QPB = al256(WS_X1B + (size_t)MP * 1024 * 2);
constexpr size_t WS_S = al256(WS_QPB + (size_t)MP * 2048 * 2);
constexpr size_t WS_PIDX = al256(WS_S + (size_t)MP * 2048 * 4);
constexpr size_t WS_PG = al256(WS_PIDX + (size_t)MP * 128 * 4);
constexpr size_t WS_CONVB = al256(WS_PG + (size_t)MP * 128 * 4);
constexpr size_t WS_XB = al256(WS_CONVB + (size_t)MP * 512 * 2);
constexpr size_t WS_WIN_T = al256(WS_XB + (size_t)MP * 1024 * 2);
constexpr size_t WS_WUPM_T = al256(WS_WIN_T + (size_t)IN_DIM * 1024 * 2);
constexpr size_t WS_WUPN_T = al256(WS_WUPM_T + (size_t)1024 * 512 * 2);
constexpr size_t WS_WOUT_T = al256(WS_WUPN_T + (size_t)1024 * 512 * 2);
constexpr size_t WS_PWQ_T = al256(WS_WOUT_T + (size_t)1024 * 1024 * 2);
constexpr size_t WS_WQK_T = al256(WS_PWQ_T + (size_t)2048 * 1024 * 2);
constexpr size_t WS_W1_T = al256(WS_WQK_T + (size_t)4 * 256 * 128 * 2);
constexpr size_t WS_W2_T = al256(WS_W1_T + (size_t)2 * 64 * 2048 * 2);
constexpr size_t WS_SUBK = al256(WS_W2_T + (size_t)2 * 64 * 64 * 2);
constexpr size_t WS_ZB = al256(WS_SUBK + (size_t)2 * 128 * 128 * 2);
constexpr size_t WS_VTS = al256(WS_ZB + (size_t)MP * IN_DIM * 2);
constexpr size_t WS_VTW = al256(WS_VTS + (size_t)16 * 2 * 64 * 2048 * 2);
constexpr size_t WS_KCB = al256(WS_VTW + (size_t)16 * 2 * 64 * 2048 * 2);
constexpr size_t WS_VTC = al256(WS_KCB + (size_t)16 * 2 * 128 * 64 * 2);
constexpr size_t WS_NOUTF = al256(WS_VTC + (size_t)16 * 2 * 64 * 128 * 2);
constexpr size_t WS_U8 = al256(WS_NOUTF + (size_t)NP * 512 * 4);
constexpr size_t WS_V8 = al256(WS_U8 + (size_t)16384 * 1024);
constexpr size_t WS_QB = al256(WS_V8 + (size_t)16384 * 1024);
constexpr size_t WS_KB = al256(WS_QB + (size_t)MP * 512 * 2);
constexpr size_t WS_KTB = al256(WS_KB + (size_t)MP * 512 * 2);
constexpr size_t WS_VTM = al256(WS_KTB + (size_t)16 * 512 * 2048 * 2);
constexpr size_t WS_KCSB = al256(WS_VTM + (size_t)16 * 512 * 2048 * 2);
constexpr size_t WS_VTCS = al256(WS_KCSB + (size_t)32 * 2 * 1024 * 64 * 2);
constexpr size_t WS_END = al256(WS_VTCS + (size_t)32 * 2 * 64 * 1024 * 2);

static_assert(WS_END <= 2684354560ull, "workspace too large");
constexpr int LDS_BYTES = 73728;
constexpr int NTHREADS = 256;

struct Params {
    const float* x_prompt; const float* x_sample; const float* cache_cmp; const float* cache_slc; const int* page_table;
    const float* state_win; const float* state_C; const float* state_n; const float* state_m; const float* state_conv;
    const float* w_in; const float* conv_w; const float* conv_b; const float* wq; const float* wk; const float* gate_bias; const float* norm_g;
    const float* cmp_pe; const float* cmp_w1; const float* cmp_w2; const float* rel_bias; const float* w_up_m; const float* w_up_n; const float* w_out;
    const float* ln1_g; const float* ln1_b; const float* ln2_g; const float* ln2_b; const float* peer_wq; const float* peer_sub; const float* peer_u; const float* peer_v;
    float* out; unsigned char* ws;
};

#define XB_TMO      128
#define XB_XCNT(j)  (256  + 64 * (j))
#define XB_XSUB(j)  (1280 + 64 * (j))
#define XB_XGEN(j)  (2304 + 64 * (j))
#define XB_TOP      3328
#define XB_TOPGEN   3392
#define XCD_BAR_WORDS 3456
#define XB_SPIN_CAP (1u << 22)
#define LAS __attribute__((address_space(3)))

__device__ __forceinline__ unsigned xb_ld(unsigned* p)              { return __hip_atomic_load(p, __ATOMIC_RELAXED, __HIP_MEMORY_SCOPE_AGENT); }
__device__ __forceinline__ unsigned xb_add(unsigned* p, unsigned v) { return __hip_atomic_fetch_add(p, v, __ATOMIC_RELAXED, __HIP_MEMORY_SCOPE_AGENT); }
__device__ __forceinline__ unsigned xb_xcc_id() { return (unsigned)__builtin_amdgcn_s_getreg((3 << 11) | 20) & 0xFu; }
#define XB_SPIN(cond, bar) do { unsigned _sp = 0; while (cond) { __builtin_amdgcn_s_sleep(1); \
    if ((++_sp & 255u) == 0u) { if (xb_ld(&(bar)[XB_TMO])) break; if (_sp > XB_SPIN_CAP) { atomicAdd(&(bar)[XB_TMO], 1u); break; } } } } while (0)

struct XcdBarrier { unsigned* bar; unsigned x; volatile LAS unsigned* st; };

__device__ __forceinline__ XcdBarrier xcd_barrier_post(unsigned* bar, volatile LAS unsigned* st) {
    XcdBarrier b; b.bar = bar; b.x = xb_xcc_id(); b.st = st;
    if (threadIdx.x == 0) (void)xb_add(&bar[XB_XCNT(b.x)], 1u);
    return b;
}
__device__ __forceinline__ void xcd_barrier_complete(unsigned* bar, unsigned x, unsigned& nloc, unsigned& nx) {
    const unsigned G = gridDim.x * gridDim.y * gridDim.z;
    unsigned sum, cnt, mine, sp = 0u;
    for (;;) {
        sum = 0u; cnt = 0u; mine = 0u;
#pragma unroll
        for (unsigned j = 0; j < 16; ++j) { const unsigned c = xb_ld(&bar[XB_XCNT(j)]); sum += c; cnt += (c > 0u) ? 1u : 0u; mine = (j == x) ? c : mine; }
        if (sum == G) break;
        __builtin_amdgcn_s_sleep(1);
        if ((++sp & 255u) == 0u) { if (xb_ld(&bar[XB_TMO])) break; if (sp > XB_SPIN_CAP) { atomicAdd(&bar[XB_TMO], 1u); break; } }
    }
    nloc = mine > 0u ? mine : 1u; nx = cnt > 0u ? cnt : 1u;
}
__device__ __forceinline__ void xcd_barrier(const XcdBarrier& b) {
    asm volatile("s_waitcnt vmcnt(0)" ::: "memory");
    __syncthreads();
    if (threadIdx.x == 0) {
        unsigned* bar = b.bar;
        __builtin_amdgcn_s_waitcnt(0);
        unsigned nloc = b.st[0], nx = b.st[1];
        if (nloc == 0u) { xcd_barrier_complete(bar, b.x, nloc, nx); b.st[0] = nloc; b.st[1] = nx; }
        const unsigned old = xb_add(&bar[XB_XSUB(b.x)], 1u);
        const unsigned gen = old / nloc;
        if (old + 1u == (gen + 1u) * nloc) {
            __builtin_amdgcn_fence(__ATOMIC_RELEASE, "agent");
            asm volatile("s_waitcnt vmcnt(0)" ::: "memory");
            const unsigned og = xb_add(&bar[XB_TOP], 1u);
            const unsigned tg = og / nx;
            if (og + 1u == (tg + 1u) * nx) xb_add(&bar[XB_TOPGEN], 1u);
            else XB_SPIN(xb_ld(&bar[XB_TOPGEN]) == tg, bar);
            __builtin_amdgcn_fence(__ATOMIC_ACQUIRE, "agent");
            xb_add(&bar[XB_XGEN(b.x)], 1u);
            asm volatile("s_waitcnt vmcnt(0)" ::: "memory");
        } else {
            XB_SPIN(xb_ld(&bar[XB_XGEN(b.x)]) == gen, bar);
            __builtin_amdgcn_fence(__ATOMIC_ACQUIRE, "agent");
            asm volatile("s_waitcnt vmcnt(0)" ::: "memory");
        }
    }
    __syncthreads();
}

typedef float f32x4 __attribute__((ext_vector_type(4)));

__device__ const unsigned char REL_LUT[128] = {
    0, 1, 2, 3, 4, 5, 6, 7, 8, 9, 10, 11, 12, 13, 14, 15, 16, 16, 16, 17, 17, 18, 18, 18, 19, 19, 19, 20, 20, 20, 20, 21, 21, 21, 21, 22, 22, 22, 22, 22,
    23, 23, 23, 23, 23, 23, 24, 24, 24, 24, 24, 24, 25, 25, 25, 25, 25, 25, 25, 26, 26, 26, 26, 26, 26, 26, 26, 27, 27, 27, 27, 27, 27, 27, 27, 27, 27,
    28, 28, 28, 28, 28, 28, 28, 28, 28, 28, 29, 29, 29, 29, 29, 29, 29, 29, 29, 29, 29, 29, 30, 30, 30, 30, 30, 30, 30, 30, 30, 30, 30, 30, 30, 30,
    31, 31, 31, 31, 31, 31, 31, 31, 31, 31, 31, 31, 31, 31, 31};
DEV int rel_bucket(int n) { return n < 128 ? (int)REL_LUT[n < 0 ? 0 : n] : 31; }

DEV float sigmoidf_(float x) { return 1.0f / (1.0f + expf(-x)); }
DEV float gelu_tanh(float x) { return 0.5f * x * (1.0f + tanhf(0.7978845608028654f * (x + 0.044715f * x * x * x))); }
DEV float log_sigmoid(float x) { return x >= 0.f ? -log1pf(expf(-x)) : x - log1pf(expf(x)); }
DEV void wave_sync() { asm volatile("s_waitcnt lgkmcnt(0)" ::: "memory"); __builtin_amdgcn_wave_barrier(); asm volatile("" ::: "memory"); }
DEV float wave_sum(float v) {
#pragma unroll
    for (int o = 32; o >= 1; o >>= 1) v += __shfl_xor(v, o);
    return v;
}
DEV float wave_max(float v) {
#pragma unroll
    for (int o = 32; o >= 1; o >>= 1) v = fmaxf(v, __shfl_xor(v, o));
    return v;
}

typedef unsigned short bf16_t;
typedef short bf16x8 __attribute__((ext_vector_type(8)));
typedef float f32x2_ __attribute__((ext_vector_type(2)));
typedef __bf16 bf16x2_ __attribute__((ext_vector_type(2)));
DEV unsigned cvt_pk_bf16(float lo, float hi) { const f32x2_ v = {lo, hi}; return __builtin_bit_cast(unsigned, __builtin_convertvector(v, bf16x2_)); }
DEV float bf_lo(unsigned w) { return __uint_as_float(w << 16); }
DEV float bf_hi(unsigned w) { return __uint_as_float(w & 0xffff0000u); }
DEV uint4 pack8(const float* f) { uint4 r; r.x = cvt_pk_bf16(f[0], f[1]); r.y = cvt_pk_bf16(f[2], f[3]); r.z = cvt_pk_bf16(f[4], f[5]); r.w = cvt_pk_bf16(f[6], f[7]); return r; }
DEV void store_bf16x4(bf16_t* p, f32x4 v) { uint2 w; w.x = cvt_pk_bf16(v[0], v[1]); w.y = cvt_pk_bf16(v[2], v[3]); *(uint2*)p = w; }

DEV void transpose_to_bf16(const float* __restrict__ src, const int K, const int N, bf16_t* __restrict__ dst, const size_t gt, const size_t nt) {
    const size_t items = (size_t)N * (K >> 3);
    for (size_t id = gt; id < items; id += nt) {
        const int n = (int)(id % N), k8 = (int)(id / N) * 8;
        float f[8];
#pragma unroll
        for (int i = 0; i < 8; ++i) f[i] = src[(size_t)(k8 + i) * N + n];
        *(uint4*)(dst + (size_t)n * K + k8) = pack8(f);
    }
}

template <int BN, class LA, class LB, class EF>
DEV void gemm_bf16(const int M, const int N, const int K, LA la, LB lb, EF ef, unsigned char* lds) {
    constexpr int TJ = BN / 32;
    constexpr int NB = BN / 32;
    constexpr int LDR = 144;
    const int tid = threadIdx.x, lane = tid & 63, w = tid >> 6, wm = w >> 1, wn = w & 1;
    const int tm = (M + 127) >> 7, tn = (N + BN - 1) / BN;
    unsigned char* As = lds;
    unsigned char* Bs = lds + 128 * LDR;
    const int lr = lane & 15, lq = lane >> 4;
    for (int tile = blockIdx.x; tile < tm * tn; tile += gridDim.x) {
        const int bm = (tile / tn) * 128, bn = (tile % tn) * BN;
        f32x4 acc[4][TJ];
#pragma unroll
        for (int i = 0; i < 4; ++i)
#pragma unroll
            for (int j = 0; j < TJ; ++j) acc[i][j] = (f32x4){0.f, 0.f, 0.f, 0.f};
        uint4 ra[4], rb[NB];
        int arow[4], brow[NB];
#pragma unroll
        for (int i = 0; i < 4; ++i) { const int r = bm + ((tid + 256 * i) >> 3); arow[i] = r < M ? r : M - 1; }
#pragma unroll
        for (int i = 0; i < NB; ++i) { const int n = bn + ((tid + 256 * i) >> 3); brow[i] = n < N ? n : N - 1; }
        const int kc = (tid & 7) * 8;
#pragma unroll
        for (int i = 0; i < 4; ++i) ra[i] = la(arow[i], kc);
#pragma unroll
        for (int i = 0; i < NB; ++i) rb[i] = lb(brow[i], kc);
        for (int k0_ = 0; k0_ < K; k0_ += 64) {
            int k0 = k0_; asm volatile("" : "+v"(k0));
            __syncthreads();
#pragma unroll
            for (int i = 0; i < 4; ++i) *(uint4*)(As + ((tid + 256 * i) >> 3) * LDR + (tid & 7) * 16) = ra[i];
#pragma unroll
            for (int i = 0; i < NB; ++i) *(uint4*)(Bs + ((tid + 256 * i) >> 3) * LDR + (tid & 7) * 16) = rb[i];
            __syncthreads();
            if (k0_ + 64 < K) {
#pragma unroll
                for (int i = 0; i < 4; ++i) ra[i] = la(arow[i], k0 + 64 + kc);
#pragma unroll
                for (int i = 0; i < NB; ++i) rb[i] = lb(brow[i], k0 + 64 + kc);
            }
#pragma unroll
            for (int kk = 0; kk < 2; ++kk) {
                bf16x8 a[4], b[TJ];
#pragma unroll
                for (int i = 0; i < 4; ++i) a[i] = *(const bf16x8*)(As + (wm * 64 + i * 16 + lr) * LDR + kk * 64 + lq * 16);
#pragma unroll
                for (int j = 0; j < TJ; ++j) b[j] = *(const bf16x8*)(Bs + (wn * (BN / 2) + j * 16 + lr) * LDR + kk * 64 + lq * 16);
#pragma unroll
                for (int i = 0; i < 4; ++i)
#pragma unroll
                    for (int j = 0; j < TJ; ++j) acc[i][j] = __builtin_amdgcn_mfma_f32_16x16x32_bf16(b[j], a[i], acc[i][j], 0, 0, 0);
            }
        }
#pragma unroll
        for (int i = 0; i < 4; ++i)
#pragma unroll
            for (int j = 0; j < TJ; ++j) {
                const int r = bm + wm * 64 + i * 16 + lr, c0 = bn + wn * (BN / 2) + j * 16 + lq * 4;
                if (r < M && c0 < N) ef(r, c0, acc[i][j]);
            }
    }
}

template <class KeyF>
DEV void wave_attn(const float* qs, float* sb, const int nkeys, KeyF keyf, const float* __restrict__ rel_bias, const int hkv, const int lane, float (&o)[4]) {
    float mx[4] = {NEGF, NEGF, NEGF, NEGF};
    for (int base = 0; base < nkeys; base += 64) {
        asm volatile("" ::: "memory");
        const int idx = base + lane;
        const float* kp = nullptr; const float* vp = nullptr; int dist = 0;
        bool valid = false;
        if (idx < nkeys) valid = keyf(idx, kp, vp, dist);
        float sc[4] = {0.f, 0.f, 0.f, 0.f};
        if (valid) {
#pragma unroll 1
            for (int d4 = 0; d4 < 16; ++d4) {
                asm volatile("" ::: "memory");
                const float4 kv = ((const float4*)kp)[d4];
#pragma unroll
                for (int g = 0; g < 4; ++g) {
                    const float4 qv = *(const float4*)(qs + g * 64 + d4 * 4);
                    sc[g] += qv.x * kv.x + qv.y * kv.y + qv.z * kv.z + qv.w * kv.w;
                }
            }
            const int bk = rel_bucket(dist);
#pragma unroll
            for (int g = 0; g < 4; ++g) sc[g] += rel_bias[bk * 8 + hkv * 4 + g];
        }
#pragma unroll
        for (int g = 0; g < 4; ++g) {
            const float v = valid ? sc[g] : NEGF;
            if (idx < nkeys) sb[g * 1024 + idx] = v;
            mx[g] = fmaxf(mx[g], v);
        }
    }
    float inv[4];
#pragma unroll
    for (int g = 0; g < 4; ++g) mx[g] = wave_max(mx[g]);
    wave_sync();
    float sum[4] = {0.f, 0.f, 0.f, 0.f};
    for (int idx = lane; idx < nkeys; idx += 64) {
#pragma unroll
        for (int g = 0; g < 4; ++g) {
            const float v = sb[g * 1024 + idx];
            const float e = (v > -1e29f) ? expf(v - mx[g]) : 0.f;
            sb[g * 1024 + idx] = e;
            sum[g] += e;
        }
    }
#pragma unroll
    for (int g = 0; g < 4; ++g) { sum[g] = wave_sum(sum[g]); inv[g] = 1.0f / fmaxf(sum[g], 1e-30f); }
    for (int idx = lane; idx < nkeys; idx += 64) {
#pragma unroll
        for (int g = 0; g < 4; ++g) sb[g * 1024 + idx] *= inv[g];
    }
    wave_sync();
#pragma unroll
    for (int g = 0; g < 4; ++g) o[g] = 0.f;
    for (int idx = 0; idx < nkeys; ++idx) {
        const float p0 = sb[idx], p1 = sb[1024 + idx], p2 = sb[2048 + idx], p3 = sb[3072 + idx];
        if (p0 + p1 + p2 + p3 == 0.f) continue;
        const float* kp = nullptr; const float* vp = nullptr; int dist = 0;
        (void)keyf(idx, kp, vp, dist);
        const float vv = vp[lane];
        o[0] += p0 * vv; o[1] += p1 * vv; o[2] += p2 * vv; o[3] += p3 * vv;
    }
}

DEV void nsa_item(const Params& p, const int row, const int hkv, float* wl, const int lane) {
    float* qs = wl; float* sb = wl + 256; int* sel = (int*)(wl + 256 + 4096);
    const float* Z = (const float*)(p.ws + WS_Z);
    bf16_t* NOUT = (bf16_t*)(p.ws + WS_NOUTB);
    const float* KCP = (const float*)(p.ws + WS_KCP);
    const float* KCS = (const float*)(p.ws + WS_KCS);
    const bool pr = row < NP;
    const int b = pr ? (row >> 11) : (row - NP);
    const int t = pr ? (row & 2047) : 0;
    const int qpos = pr ? t : PAST;
    const float* zrow = Z + (size_t)row * IN_DIM;
    wave_sync();
    for (int i = lane; i < 256; i += 64) qs[i] = zrow[C_Q + hkv * 256 + i] * 0.125f;
    wave_sync();
    float o[4];
    float gate[3][4];
#pragma unroll
    for (int br = 0; br < 3; ++br)
#pragma unroll
        for (int g = 0; g < 4; ++g) gate[br][g] = sigmoidf_(zrow[C_G + br * 8 + hkv * 4 + g]);
    bf16_t* nrow = NOUT + (size_t)row * 512 + hkv * 256;
    float res[4];
    const int nkc = pr ? 127 : 1023;
    {
        const float* kbase = pr ? (KCP + ((size_t)(b * 128) * 2 + hkv) * 64) : (KCS + ((size_t)(b * 1024) * 2 + hkv) * 64);
        const size_t plane = pr ? (size_t)4096 * 64 : (size_t)65536 * 64;
        auto keyf = [&](int idx, const float*& kp, const float*& vp, int& dist) -> bool {
            kp = kbase + (size_t)idx * 128; vp = kp + plane; dist = qpos - (16 * idx + 31); return dist >= 0; };
        wave_attn(qs, sb, nkc, keyf, p.rel_bias, hkv, lane, o);
#pragma unroll
        for (int g = 0; g < 4; ++g) res[g] = gate[0][g] * o[g];
    }
    const int nblk = pr ? 32 : 257;
    for (int i = lane; i < nkc; i += 64) sb[i] = ((sb[i] + sb[1024 + i]) + sb[2048 + i]) + sb[3072 + i];
    wave_sync();
    {
        const int cur = qpos >> 6;
        for (int blk = lane; blk < nblk; blk += 64) {
            float s = 0.f;
#pragma unroll
            for (int cc = 0; cc < 4; ++cc) {
                const int c = 4 * blk + cc;
                const float a0 = (c < nkc) ? sb[c] : 0.f;
                const float a1 = (c >= 1 && c - 1 < nkc) ? sb[c - 1] : 0.f;
                s += a0 + a1;
            }
            const bool causal = blk * 64 <= qpos;
            const bool forced = (blk == 0) || (blk == cur) || (blk == cur - 1);
            sb[1024 + blk] = causal ? (forced ? 1e4f : s) : NEGF;
        }
        wave_sync();
        for (int blk = lane; blk < nblk; blk += 64) {
            const float my = sb[1024 + blk];
            int rank = 0;
            for (int j = 0; j < nblk; ++j) { const float o2 = sb[1024 + j]; rank += ((o2 > my) || (o2 == my && j < blk)) ? 1 : 0; }
            if (rank < 16) sel[rank] = (blk * 64 <= qpos) ? blk : -1;
        }
        wave_sync();
    }
    {
        const float* zb = Z + (size_t)(pr ? b * 2048 : 0) * IN_DIM;
        auto keyf = [&](int idx, const float*& kp, const float*& vp, int& dist) -> bool {
            const int blk = sel[idx >> 6], s = idx & 63;
            if (blk < 0) return false;
            const int kpos = blk * 64 + s;
            if (kpos > qpos) return false;
            dist = qpos - kpos;
            if (pr) { kp = zb + (size_t)kpos * IN_DIM + C_KS + hkv * 64; }
            else if (blk < 256) { const int page = p.page_table[b * 128 + (blk >> 1)]; kp = p.cache_slc + ((size_t)page * 128 + (blk & 1) * 64 + s) * 256 + hkv * 64; }
            else { kp = zrow + C_KS + hkv * 64; }
            vp = kp + 128; return true; };
        wave_attn(qs, sb, 1024, keyf, p.rel_bias, hkv, lane, o);
#pragma unroll
        for (int g = 0; g < 4; ++g) res[g] += gate[1][g] * o[g];
    }
    {
        const float* zb = Z + (size_t)(pr ? b * 2048 : 0) * IN_DIM;
        const int nk = pr ? ((t + 1 < 512) ? t + 1 : 512) : 512;
        auto keyf = [&](int idx, const float*& kp, const float*& vp, int& dist) -> bool {
            if (pr) { const int kpos = t - nk + 1 + idx; dist = t - kpos; kp = zb + (size_t)kpos * IN_DIM + C_KW + hkv * 64; }
            else { const int j = idx + 1; dist = 512 - j; kp = (j < 512) ? (p.state_win + ((size_t)b * 512 + j) * 256 + hkv * 64) : (zrow + C_KW + hkv * 64); }
            vp = kp + 128; return true; };
        wave_attn(qs, sb, nk, keyf, p.rel_bias, hkv, lane, o);
#pragma unroll
        for (int g = 0; g < 4; ++g) res[g] += gate[2][g] * o[g];
    }
#pragma unroll
    for (int g = 0; g < 4; ++g) nrow[g * 64 + lane] = (bf16_t)(cvt_pk_bf16(res[g], 0.f) & 0xffffu);
}

DEV void mlstm_scan_item(const Params& p, const int item, float* lds) {
    const int tid = threadIdx.x, v = tid >> 1, kh = tid & 1;
    const int seq = item >> 2, h = item & 3;
    const bool pr = seq < 16; const int b = pr ? seq : seq - 16;
    const int T = pr ? 2048 : 1; const int row0 = pr ? b * 2048 : NP + b;
    const float* Z = (const float*)(p.ws + WS_Z);
    const float* QK = (const float*)(p.ws + WS_QK);
    float* HRAW = (float*)(p.ws + WS_HRAW);
    float C[64], n[64]; float m;
    if (pr) {
#pragma unroll
        for (int j = 0; j < 64; ++j) { C[j] = 0.f; n[j] = 0.f; }
        m = 0.f;
    } else {
        const float* c0 = p.state_C + (((size_t)(b * 4 + h) * 128 + v) * 128 + kh * 64);
        const float* n0 = p.state_n + ((size_t)(b * 4 + h) * 128 + kh * 64);
#pragma unroll
        for (int j = 0; j < 64; ++j) { C[j] = c0[j]; n[j] = n0[j]; }
        m = p.state_m[b * 4 + h];
    }
    const float gb_i = p.gate_bias[h], gb_f = p.gate_bias[4 + h];
    auto load_tok = [&](int t, float* dst) {
        const size_t r = (size_t)(row0 + t);
        dst[tid] = QK[r * 1024 + h * 256 + tid];
        if (tid < 128) dst[256 + tid] = Z[r * IN_DIM + C_V + h * 128 + tid];
        if (tid == 128) dst[384] = Z[r * IN_DIM + C_I + h] + gb_i;
        if (tid == 129) dst[385] = log_sigmoid(Z[r * IN_DIM + C_F + h] + gb_f);
    };
    __syncthreads();
    load_tok(0, lds);
    __syncthreads();
    for (int t = 0; t < T; ++t) {
        const float* cur = lds + (t & 1) * 388;
        if (t + 1 < T) load_tok(t + 1, lds + ((t + 1) & 1) * 388);
        const float ig = cur[384], lf = cur[385];
        const float mn = fmaxf(lf + m, ig);
        const float fd = expf(lf + m - mn), iw = expf(ig - mn);
        const float vv = cur[256 + v] * iw;
        float nump = 0.f, denp = 0.f;
#pragma unroll
        for (int j = 0; j < 64; ++j) {
            const float kj = cur[128 + kh * 64 + j], qj = cur[kh * 64 + j];
            C[j] = fd * C[j] + vv * kj; n[j] = fd * n[j] + iw * kj;
            nump += C[j] * qj; denp += n[j] * qj;
        }
        nump += __shfl_xor(nump, 1); denp += __shfl_xor(denp, 1);
        const float hval = nump / fmaxf(fabsf(denp), expf(-mn));
        if (kh == 0) HRAW[(size_t)(row0 + t) * 512 + h * 128 + v] = hval;
        m = mn;
        __syncthreads();
    }
    float* co = p.out + (pr ? O_CP : O_CS) + (((size_t)(b * 4 + h) * 128 + v) * 128 + kh * 64);
#pragma unroll
    for (int j = 0; j < 64; ++j) co[j] = C[j];
    if (v == 0) {
        float* no = p.out + (pr ? O_NP : O_NS) + ((size_t)(b * 4 + h) * 128 + kh * 64);
#pragma unroll
        for (int j = 0; j < 64; ++j) no[j] = n[j];
    }
    if (tid == 0) p.out[(pr ? O_MP : O_MS) + b * 4 + h] = m;
}

DEV void peer_topk_item(const Params& p, const int row, const int h, const int lane) {
    const float* S = (const float*)(p.ws + WS_S) + (size_t)row * 2048 + h * 256;
    int* PIDX = (int*)(p.ws + WS_PIDX); float* PG = (float*)(p.ws + WS_PG);
    float ts[2]; int ti[2];
#pragma unroll
    for (int pp = 0; pp < 2; ++pp) {
        float v0 = S[pp * 128 + lane], v1 = S[pp * 128 + 64 + lane];
        float mys = 0.f; int myi = 0;
        for (int r = 0; r < 16; ++r) {
            float best = fmaxf(v0, v1); int bi = (v0 >= v1) ? lane : lane + 64;
#pragma unroll
            for (int off = 32; off >= 1; off >>= 1) {
                const float ob = __shfl_xor(best, off); const int oi = __shfl_xor(bi, off);
                if (ob > best || (ob == best && oi < bi)) { best = ob; bi = oi; }
            }
            if (lane == r) { mys = best; myi = bi; }
            if (bi == lane) v0 = -INFINITY;
            if (bi == lane + 64) v1 = -INFINITY;
        }
        ts[pp] = mys; ti[pp] = myi;
    }
    float cv[4];
#pragma unroll
    for (int jj = 0; jj < 4; ++jj) { const int c = lane * 4 + jj; cv[jj] = __shfl(ts[0], c >> 4) + __shfl(ts[1], c & 15); }
    float msc = 0.f; int mci = 0;
    for (int r = 0; r < 16; ++r) {
        float best = cv[0]; int bi = lane * 4;
#pragma unroll
        for (int jj = 1; jj < 4; ++jj) if (cv[jj] > best) { best = cv[jj]; bi = lane * 4 + jj; }
#pragma unroll
        for (int off = 32; off >= 1; off >>= 1) {
            const float ob = __shfl_xor(best, off); const int oi = __shfl_xor(bi, off);
            if (ob > best || (ob == best && oi < bi)) { best = ob; bi = oi; }
        }
        if (lane == r) { msc = best; mci = bi; }
#pragma unroll
        for (int jj = 0; jj < 4; ++jj) if (bi == lane * 4 + jj) cv[jj] = -INFINITY;
    }
    const int e = __shfl(ti[0], mci >> 4) * 128 + __shfl(ti[1], mci & 15);
    const float top = __shfl(msc, 0);
    float ex = (lane < 16) ? expf(msc - top) : 0.f;
    const float den = wave_sum(ex);
    if (lane < 16) { PIDX[(size_t)row * 128 + h * 16 + lane] = e; PG[(size_t)row * 128 + h * 16 + lane] = ex / den; }
}

DEV void peer_expert_item(const Params& p, const int row, float* lds) {
    const int tid = threadIdx.x, lane = tid & 63, w = tid >> 6;
    const float* X1 = (const float*)(p.ws + WS_X1) + (size_t)row * 1024;
    const int* PIDX = (const int*)(p.ws + WS_PIDX) + (size_t)row * 128;
    const float* PG = (const float*)(p.ws + WS_PG) + (size_t)row * 128;
    float4 x[4], acc[4];
#pragma unroll
    for (int j = 0; j < 4; ++j) { x[j] = *(const float4*)(X1 + j * 256 + lane * 4); acc[j] = make_float4(0.f, 0.f, 0.f, 0.f); }
    for (int k = 0; k < 32; ++k) {
        const int e = PIDX[w * 32 + k]; const float gk = PG[w * 32 + k];
        const float* ur = p.peer_u + (size_t)e * 1024; const float* vr = p.peer_v + (size_t)e * 1024;
        float d = 0.f;
#pragma unroll
        for (int j = 0; j < 4; ++j) { const float4 u = *(const float4*)(ur + j * 256 + lane * 4); d += u.x * x[j].x + u.y * x[j].y + u.z * x[j].z + u.w * x[j].w; }
        d = wave_sum(d);
        const float coef = gk * gelu_tanh(d);
#pragma unroll
        for (int j = 0; j < 4; ++j) { const float4 vv = *(const float4*)(vr + j * 256 + lane * 4);
            acc[j].x += coef * vv.x; acc[j].y += coef * vv.y; acc[j].z += coef * vv.z; acc[j].w += coef * vv.w; }
    }
    __syncthreads();
#pragma unroll
    for (int j = 0; j < 4; ++j) *(float4*)(lds + w * 1024 + j * 256 + lane * 4) = acc[j];
    __syncthreads();
    float tv[4]; float s = 0.f;
#pragma unroll
    for (int i = 0; i < 4; ++i) { const int c = tid * 4 + i; const float po = (lds[c] + lds[1024 + c]) + (lds[2048 + c] + lds[3072 + c]); tv[i] = DN_ALPHA * X1[c] + po; s += tv[i]; }
    float* red = lds + 4096;
    s = wave_sum(s);
    if (lane == 0) red[w] = s;
    __syncthreads();
    const float mu = (red[0] + red[1] + red[2] + red[3]) * (1.0f / 1024.0f);
    float q = 0.f;
#pragma unroll
    for (int i = 0; i < 4; ++i) { const float d = tv[i] - mu; q += d * d; }
    q = wave_sum(q);
    if (lane == 0) red[8 + w] = q;
    __syncthreads();
    const float var = (red[8] + red[9] + red[10] + red[11]) * (1.0f / 1024.0f);
    const float rstd = 1.0f / sqrtf(var + LN_EPS);
    float* y = p.out + O_Y + (size_t)row * 1024;
#pragma unroll
    for (int i = 0; i < 4; ++i) { const int c = tid * 4 + i; y[c] = (tv[i] - mu) * rstd * p.ln2_g[c] + p.ln2_b[c]; }
}

DEV void mlstm_chunk_item(const Params& p, const int item, unsigned char* lds) {
    int tid_ = threadIdx.x; asm volatile("" : "+v"(tid_));
    const int tid = tid_, lane = tid & 63, w = tid >> 6, lr = lane & 15, lq = lane >> 4;
    const int b = item >> 4, h = (item >> 2) & 3, vs = item & 3;
    bf16_t* Cl = (bf16_t*)lds;
    bf16_t* nl = (bf16_t*)(lds + 8704);
    float* uL = (float*)(lds + 8960); float* ML = uL + 64; float* scin = uL + 128; float* expm = uL + 192; float* wts = uL + 256; float* misc = uL + 320;
    const bf16_t* QB = (const bf16_t*)(p.ws + WS_QB) + (size_t)(b * 2048) * 512 + h * 128;
    const bf16_t* KB = (const bf16_t*)(p.ws + WS_KB) + (size_t)(b * 2048) * 512 + h * 128;
    const bf16_t* KTB = (const bf16_t*)(p.ws + WS_KTB) + (size_t)((b * 4 + h) * 128) * 2048;
    const bf16_t* VTM = (const bf16_t*)(p.ws + WS_VTM) + (size_t)(b * 512 + h * 128 + vs * 32) * 2048;
    const float* Z = (const float*)(p.ws + WS_Z);
    float* HRAW = (float*)(p.ws + WS_HRAW);
    const float gb_i = p.gate_bias[h], gb_f = p.gate_bias[4 + h];
    f32x4 Cm[2][2], nm[2];
#pragma unroll
    for (int i = 0; i < 2; ++i) { nm[i] = (f32x4){0.f, 0.f, 0.f, 0.f};
#pragma unroll
        for (int j = 0; j < 2; ++j) Cm[i][j] = (f32x4){0.f, 0.f, 0.f, 0.f}; }
    float m_prev = 0.f;
    __syncthreads();
    for (int i = tid; i < (8704 + 256) / 4; i += 256) ((unsigned*)lds)[i] = 0u;
    __syncthreads();
    for (int c = 0; c < 32; ++c) {
        const int t0 = c * 64;
        if (w == 0) {
            const size_t row = (size_t)(b * 2048 + t0 + lane);
            const float ig = Z[row * IN_DIM + C_I + h] + gb_i;
            const float lf = log_sigmoid(Z[row * IN_DIM + C_F + h] + gb_f);
            float bc = lf;
#pragma unroll
            for (int o = 1; o < 64; o <<= 1) { const float t = __shfl_up(bc, o); if (lane >= o) bc += t; }
            const float u = ig - bc;
            float pm = u;
#pragma unroll
            for (int o = 1; o < 64; o <<= 1) { const float t = __shfl_up(pm, o); if (lane >= o) pm = fmaxf(pm, t); }
            const float M = fmaxf(m_prev, pm);
            const float M63 = __shfl(M, 63), b63 = __shfl(bc, 63);
            uL[lane] = u; ML[lane] = M; scin[lane] = expf(m_prev - M); expm[lane] = expf(-(bc + M)); wts[lane] = expf(u - M63);
            if (lane == 0) { misc[0] = expf(m_prev - M63); misc[1] = b63 + M63; }
        }
        __syncthreads();
        {
            const size_t row_t = (size_t)(t0 + w * 16 + lr);
            bf16x8 Qf[4];
#pragma unroll
            for (int ks = 0; ks < 4; ++ks) Qf[ks] = *(const bf16x8*)(QB + row_t * 512 + ks * 32 + lq * 8);
            const float M_t = ML[w * 16 + lr], sc_in = scin[w * 16 + lr], em = expm[w * 16 + lr];
            f32x4 sw[4];
            float dsum = 0.f;
#pragma unroll
            for (int st = 0; st < 4; ++st) {
                f32x4 a = (f32x4){0.f, 0.f, 0.f, 0.f};
                if (st <= w) {
#pragma unroll
                    for (int ks = 0; ks < 4; ++ks) { const bf16x8 kf = *(const bf16x8*)(KB + (size_t)(t0 + st * 16 + lr) * 512 + ks * 32 + lq * 8); a = __builtin_amdgcn_mfma_f32_16x16x32_bf16(kf, Qf[ks], a, 0, 0, 0); }
#pragma unroll
                    for (int g = 0; g < 4; ++g) {
                        const int sl = st * 16 + lq * 4 + g, tl = w * 16 + lr;
                        const float wg = (sl <= tl) ? __builtin_amdgcn_exp2f((uL[sl] - M_t) * LOG2E) : 0.f;
                        a[g] *= wg; dsum += a[g];
                    }
                }
                sw[st] = a;
            }
            dsum += __shfl_xor(dsum, 16); dsum += __shfl_xor(dsum, 32);
            bf16x8 pf[2];
#pragma unroll
            for (int ks = 0; ks < 2; ++ks) {
                union { bf16x8 v; unsigned u[4]; } pk;
                pk.u[0] = cvt_pk_bf16(sw[2 * ks][0], sw[2 * ks][1]); pk.u[1] = cvt_pk_bf16(sw[2 * ks][2], sw[2 * ks][3]);
                pk.u[2] = cvt_pk_bf16(sw[2 * ks + 1][0], sw[2 * ks + 1][1]); pk.u[3] = cvt_pk_bf16(sw[2 * ks + 1][2], sw[2 * ks + 1][3]);
                pf[ks] = pk.v;
            }
            f32x4 dI = (f32x4){0.f, 0.f, 0.f, 0.f};
#pragma unroll
            for (int ks = 0; ks < 4; ++ks) { const bf16x8 nf = *(const bf16x8*)(nl + ks * 32 + lq * 8); dI = __builtin_amdgcn_mfma_f32_16x16x32_bf16(nf, Qf[ks], dI, 0, 0, 0); }
            const float den = sc_in * dI[0] + dsum;
            const float rdd = 1.0f / fmaxf(fabsf(den), em);
#pragma unroll
            for (int vt = 0; vt < 2; ++vt) {
                f32x4 ni = (f32x4){0.f, 0.f, 0.f, 0.f}, nI = (f32x4){0.f, 0.f, 0.f, 0.f};
#pragma unroll
                for (int ks = 0; ks < 2; ++ks) if (2 * ks <= w) {
                    union { bf16x8 v; uint2 hh[2]; } vf;
                    const bf16_t* vp = VTM + (size_t)(vt * 16 + lr) * 2048 + t0 + 32 * ks + lq * 4;
                    vf.hh[0] = *(const uint2*)vp; vf.hh[1] = *(const uint2*)(vp + 16);
                    ni = __builtin_amdgcn_mfma_f32_16x16x32_bf16(vf.v, pf[ks], ni, 0, 0, 0);
                }
#pragma unroll
                for (int ks = 0; ks < 4; ++ks) { const bf16x8 cf = *(const bf16x8*)(Cl + (vt * 16 + lr) * 136 + ks * 32 + lq * 8); nI = __builtin_amdgcn_mfma_f32_16x16x32_bf16(cf, Qf[ks], nI, 0, 0, 0); }
                const f32x4 hv = (nI * sc_in + ni) * rdd;
                *(f32x4*)(HRAW + ((size_t)(b * 2048) + row_t) * 512 + h * 128 + vs * 32 + vt * 16 + lq * 4) = hv;
            }
        }
        __syncthreads();
        {
            const float decay = misc[0];
            bf16x8 Af[2][2], Wf[2], Kt[2][2];
#pragma unroll
            for (int ks = 0; ks < 2; ++ks) {
                const float4 w0 = *(const float4*)(wts + ks * 32 + lq * 8), w1 = *(const float4*)(wts + ks * 32 + lq * 8 + 4);
                float wv[8] = {w0.x, w0.y, w0.z, w0.w, w1.x, w1.y, w1.z, w1.w};
                { union { bf16x8 v; uint4 q; } t; t.q = pack8(wv); Wf[ks] = t.v; }
#pragma unroll
                for (int vt = 0; vt < 2; ++vt) {
                    const uint4 raw = *(const uint4*)(VTM + (size_t)(vt * 16 + lr) * 2048 + t0 + ks * 32 + lq * 8);
                    float f[8] = {bf_lo(raw.x) * wv[0], bf_hi(raw.x) * wv[1], bf_lo(raw.y) * wv[2], bf_hi(raw.y) * wv[3], bf_lo(raw.z) * wv[4], bf_hi(raw.z) * wv[5], bf_lo(raw.w) * wv[6], bf_hi(raw.w) * wv[7]};
                    union { bf16x8 v; uint4 q; } t; t.q = pack8(f); Af[vt][ks] = t.v;
                }
#pragma unroll
                for (int kt = 0; kt < 2; ++kt) Kt[kt][ks] = *(const bf16x8*)(KTB + (size_t)((2 * w + kt) * 16 + lr) * 2048 + t0 + ks * 32 + lq * 8);
            }
#pragma unroll
            for (int kt = 0; kt < 2; ++kt) {
                nm[kt] = nm[kt] * decay;
#pragma unroll
                for (int ks = 0; ks < 2; ++ks) nm[kt] = __builtin_amdgcn_mfma_f32_16x16x32_bf16(Wf[ks], Kt[kt][ks], nm[kt], 0, 0, 0);
                if (lq == 0) nl[(2 * w + kt) * 16 + lr] = (bf16_t)(cvt_pk_bf16(nm[kt][0], 0.f) & 0xffffu);
#pragma unroll
                for (int vt = 0; vt < 2; ++vt) {
                    Cm[vt][kt] = Cm[vt][kt] * decay;
#pragma unroll
                    for (int ks = 0; ks < 2; ++ks) Cm[vt][kt] = __builtin_amdgcn_mfma_f32_16x16x32_bf16(Af[vt][ks], Kt[kt][ks], Cm[vt][kt], 0, 0, 0);
                    const unsigned c01 = cvt_pk_bf16(Cm[vt][kt][0], Cm[vt][kt][1]), c23 = cvt_pk_bf16(Cm[vt][kt][2], Cm[vt][kt][3]);
                    bf16_t* cp = Cl + (vt * 16 + lq * 4) * 136 + (2 * w + kt) * 16 + lr;
                    cp[0] = (bf16_t)(c01 & 0xffffu); cp[136] = (bf16_t)(c01 >> 16); cp[272] = (bf16_t)(c23 & 0xffffu); cp[408] = (bf16_t)(c23 >> 16);
                }
            }
            m_prev = misc[1];
        }
        __syncthreads();
    }
#pragma unroll
    for (int vt = 0; vt < 2; ++vt)
#pragma unroll
        for (int kt = 0; kt < 2; ++kt)
#pragma unroll
            for (int g = 0; g < 4; ++g)
                p.out[O_CP + ((size_t)((b * 4 + h) * 128) + vs * 32 + vt * 16 + lq * 4 + g) * 128 + (2 * w + kt) * 16 + lr] = Cm[vt][kt][g];
    if (vs == 0) {
        if (lq == 0) { p.out[O_NP + (size_t)(b * 4 + h) * 128 + (2 * w) * 16 + lr] = nm[0][0]; p.out[O_NP + (size_t)(b * 4 + h) * 128 + (2 * w + 1) * 16 + lr] = nm[1][0]; }
        if (tid == 0) p.out[O_MP + b * 4 + h] = m_prev;
    }
}

DEV unsigned dpp_max16(unsigned x) {
    x = max(x, (unsigned)__builtin_amdgcn_update_dpp(0, (int)x, 0xB1, 0xF, 0xF, false));
    x = max(x, (unsigned)__builtin_amdgcn_update_dpp(0, (int)x, 0x4E, 0xF, 0xF, false));
    x = max(x, (unsigned)__builtin_amdgcn_update_dpp(0, (int)x, 0x141, 0xF, 0xF, false));
    x = max(x, (unsigned)__builtin_amdgcn_update_dpp(0, (int)x, 0x140, 0xF, 0xF, false));
    return x;
}
DEV float dpp_sum16(float x) {
    x += __builtin_bit_cast(float, __builtin_amdgcn_update_dpp(0, __builtin_bit_cast(int, x), 0xB1, 0xF, 0xF, false));
    x += __builtin_bit_cast(float, __builtin_amdgcn_update_dpp(0, __builtin_bit_cast(int, x), 0x4E, 0xF, 0xF, false));
    x += __builtin_bit_cast(float, __builtin_amdgcn_update_dpp(0, __builtin_bit_cast(int, x), 0x141, 0xF, 0xF, false));
    x += __builtin_bit_cast(float, __builtin_amdgcn_update_dpp(0, __builtin_bit_cast(int, x), 0x140, 0xF, 0xF, false));
    return x;
}
DEV unsigned mono_key(float v) { const unsigned b = __float_as_uint(v); return (b & 0x80000000u) ? ~b : (b | 0x80000000u); }
#define CE_DESC(a, b) { const unsigned hi_ = max(a, b), lo_ = min(a, b); a = hi_; b = lo_; }

DEV void peer_score_topk_item(const Params& p, const int tile, const int h, unsigned char* lds) {
    int tid_ = threadIdx.x; asm volatile("" : "+v"(tid_));
    const int tid = tid_, lane = tid & 63, w = tid >> 6, lr = lane & 15, lq = lane >> 4;
    float* sc = (float*)(lds + w * 12416);
    float* ts = sc + 16 * 129;
    int* ti = (int*)(ts + 512);
    const bf16_t* QPB = (const bf16_t*)(p.ws + WS_QPB);
    const bf16_t* SUBK = (const bf16_t*)(p.ws + WS_SUBK);
    int* PIDX = (int*)(p.ws + WS_PIDX); float* PG = (float*)(p.ws + WS_PG);
    const int row0 = tile * 64 + w * 16;
    const int arow = (row0 + lr < NR) ? row0 + lr : NR - 1;
    wave_sync();
#pragma unroll 1
    for (int pp = 0; pp < 2; ++pp) {
        bf16x8 qf[4];
#pragma unroll
        for (int ks = 0; ks < 4; ++ks) qf[ks] = *(const bf16x8*)(QPB + (size_t)arow * 2048 + h * 256 + pp * 128 + ks * 32 + lq * 8);
#pragma unroll
        for (int j = 0; j < 8; ++j) {
            f32x4 a = (f32x4){0.f, 0.f, 0.f, 0.f};
#pragma unroll
            for (int ks = 0; ks < 4; ++ks) { const bf16x8 kf = *(const bf16x8*)(SUBK + ((size_t)pp * 128 + j * 16 + lr) * 128 + ks * 32 + lq * 8); a = __builtin_amdgcn_mfma_f32_16x16x32_bf16(qf[ks], kf, a, 0, 0, 0); }
#pragma unroll
            for (int g = 0; g < 4; ++g) sc[(lq * 4 + g) * 129 + j * 16 + lr] = a[g];
        }
        wave_sync();
#pragma unroll 1
        for (int rr = 0; rr < 4; ++rr) {
            const int row = rr * 4 + lq;
            unsigned k0, k1, k2, k3, k4, k5, k6, k7;
            { const float* sr = sc + row * 129 + lr;
              k0 = (mono_key(sr[0]) & ~0x7Fu) | (unsigned)(127 - lr);        k1 = (mono_key(sr[16]) & ~0x7Fu) | (unsigned)(127 - 16 - lr);
              k2 = (mono_key(sr[32]) & ~0x7Fu) | (unsigned)(127 - 32 - lr);  k3 = (mono_key(sr[48]) & ~0x7Fu) | (unsigned)(127 - 48 - lr);
              k4 = (mono_key(sr[64]) & ~0x7Fu) | (unsigned)(127 - 64 - lr);  k5 = (mono_key(sr[80]) & ~0x7Fu) | (unsigned)(127 - 80 - lr);
              k6 = (mono_key(sr[96]) & ~0x7Fu) | (unsigned)(127 - 96 - lr);  k7 = (mono_key(sr[112]) & ~0x7Fu) | (unsigned)(127 - 112 - lr); }
            CE_DESC(k0, k1) CE_DESC(k2, k3) CE_DESC(k4, k5) CE_DESC(k6, k7)
            CE_DESC(k0, k2) CE_DESC(k1, k3) CE_DESC(k4, k6) CE_DESC(k5, k7)
            CE_DESC(k1, k2) CE_DESC(k5, k6)
            CE_DESC(k0, k4) CE_DESC(k1, k5) CE_DESC(k2, k6) CE_DESC(k3, k7)
            CE_DESC(k2, k4) CE_DESC(k3, k5)
            CE_DESC(k1, k2) CE_DESC(k3, k4) CE_DESC(k5, k6)
            unsigned mine = 0u;
#pragma unroll
            for (int r = 0; r < 16; ++r) {
                const unsigned best = dpp_max16(k0);
                if (lr == r) mine = best;
                const bool own = (k0 == best);
                k0 = own ? k1 : k0; k1 = own ? k2 : k1; k2 = own ? k3 : k2; k3 = own ? k4 : k3; k4 = own ? k5 : k4; k5 = own ? k6 : k5; k6 = own ? k7 : k6; k7 = own ? 0u : k7;
            }
            const int idx = 127 - (int)(mine & 0x7Fu);
            ts[(pp * 16 + row) * 16 + lr] = sc[row * 129 + idx];
            ti[(pp * 16 + row) * 16 + lr] = idx;
        }
        wave_sync();
    }
#pragma unroll 1
    for (int rr = 0; rr < 4; ++rr) {
        const int row = rr * 4 + lq;
        const float s1a = ts[row * 16 + lr];
        const float* s2 = ts + (16 + row) * 16;
        int ptr = 0;
        unsigned key = (mono_key(s1a + s2[0]) & ~0xFFu) | (unsigned)(255 - lr * 16);
        unsigned mine = 0u;
#pragma unroll
        for (int r = 0; r < 16; ++r) {
            const unsigned best = dpp_max16(key);
            if (lr == r) mine = best;
            if (key == best) { ++ptr; key = (ptr < 16) ? ((mono_key(s1a + s2[ptr & 15]) & ~0xFFu) | (unsigned)(255 - lr * 16 - ptr)) : 0u; }
        }
        const int ci = 255 - (int)(mine & 0xFFu), a = ci >> 4, bb = ci & 15;
        const float scv = ts[row * 16 + a] + s2[bb];
        const int e = ti[row * 16 + a] * 128 + ti[(16 + row) * 16 + bb];
        float m16 = scv;
        m16 = fmaxf(m16, __builtin_bit_cast(float, __builtin_amdgcn_update_dpp(0, __builtin_bit_cast(int, m16), 0xB1, 0xF, 0xF, false)));
        m16 = fmaxf(m16, __builtin_bit_cast(float, __builtin_amdgcn_update_dpp(0, __builtin_bit_cast(int, m16), 0x4E, 0xF, 0xF, false)));
        m16 = fmaxf(m16, __builtin_bit_cast(float, __builtin_amdgcn_update_dpp(0, __builtin_bit_cast(int, m16), 0x141, 0xF, 0xF, false)));
        m16 = fmaxf(m16, __builtin_bit_cast(float, __builtin_amdgcn_update_dpp(0, __builtin_bit_cast(int, m16), 0x140, 0xF, 0xF, false)));
        const float ex = expf(scv - m16);
        const float den = dpp_sum16(ex);
        const int grow = row0 + row;
        if (grow < NR) { PIDX[(size_t)grow * 128 + h * 16 + lr] = e; PG[(size_t)grow * 128 + h * 16 + lr] = ex / den; }
    }
}

constexpr float PEER_U_SCALE = 64.0f, PEER_V_SCALE = 8.0f;
DEV unsigned pack4_fp8(float a, float b, float c, float d) { int w = 0; w = __builtin_amdgcn_cvt_pk_fp8_f32(a, b, w, false); w = __builtin_amdgcn_cvt_pk_fp8_f32(c, d, w, true); return (unsigned)w; }
DEV void peer_expert_wave(const Params& p, const int row, unsigned char* wl, const int lane) {
    const int lr = lane & 15, lq = lane >> 4;
    unsigned char* xh = wl;
    unsigned char* xo = wl + 1024;
    float* coefl = (float*)(wl + 2048);
    int* idxl = (int*)(wl + 2048 + 512);
    const float* X1 = (const float*)(p.ws + WS_X1) + (size_t)row * 1024;
    const int* PIDX = (const int*)(p.ws + WS_PIDX) + (size_t)row * 128;
    const float* PG = (const float*)(p.ws + WS_PG) + (size_t)row * 128;
    const unsigned char* U8 = p.ws + WS_U8;
    const unsigned char* V8 = p.ws + WS_V8;
    float xv[16];
#pragma unroll
    for (int j = 0; j < 4; ++j) { const float4 t = *(const float4*)(X1 + lane * 16 + j * 4); xv[4 * j] = t.x; xv[4 * j + 1] = t.y; xv[4 * j + 2] = t.z; xv[4 * j + 3] = t.w; }
    wave_sync();
    {
        uint4 hi, lo; unsigned* hp = (unsigned*)&hi; unsigned* lp = (unsigned*)&lo;
#pragma unroll
        for (int j = 0; j < 4; ++j) {
            const unsigned hw = pack4_fp8(xv[4 * j], xv[4 * j + 1], xv[4 * j + 2], xv[4 * j + 3]);
            const f32x2_ b0 = __builtin_amdgcn_cvt_pk_f32_fp8((int)hw, false), b1 = __builtin_amdgcn_cvt_pk_f32_fp8((int)hw, true);
            hp[j] = hw;
            lp[j] = pack4_fp8(16.f * (xv[4 * j] - b0[0]), 16.f * (xv[4 * j + 1] - b0[1]), 16.f * (xv[4 * j + 2] - b1[0]), 16.f * (xv[4 * j + 3] - b1[1]));
        }
        *(uint4*)(xh + lane * 16) = hi; *(uint4*)(xo + lane * 16) = lo;
    }
    idxl[lane] = PIDX[lane]; idxl[64 + lane] = PIDX[64 + lane];
    wave_sync();
    for (int h = 0; h < 8; ++h) {
        const unsigned char* ub = U8 + (size_t)idxl[h * 16 + lr] * 1024 + lq * 16;
        f32x4 ah = (f32x4){0.f, 0.f, 0.f, 0.f}, al = (f32x4){0.f, 0.f, 0.f, 0.f};
#pragma unroll
        for (int kb = 0; kb < 2; ++kb) {
            uint4 uf[8];
#pragma unroll
            for (int i = 0; i < 8; ++i) uf[i] = *(const uint4*)(ub + (kb * 8 + i) * 64);
#pragma unroll
            for (int i = 0; i < 8; ++i) {
                const int off = (kb * 8 + i) * 64 + lq * 16;
                const long b0 = (long)(((unsigned long long)uf[i].y << 32) | uf[i].x), b1 = (long)(((unsigned long long)uf[i].w << 32) | uf[i].z);
                const long h0 = *(const long*)(xh + off), h1 = *(const long*)(xh + off + 8), l0 = *(const long*)(xo + off), l1 = *(const long*)(xo + off + 8);
                ah = __builtin_amdgcn_mfma_f32_16x16x32_fp8_fp8(h0, b0, ah, 0, 0, 0); ah = __builtin_amdgcn_mfma_f32_16x16x32_fp8_fp8(h1, b1, ah, 0, 0, 0);
                al = __builtin_amdgcn_mfma_f32_16x16x32_fp8_fp8(l0, b0, al, 0, 0, 0); al = __builtin_amdgcn_mfma_f32_16x16x32_fp8_fp8(l1, b1, al, 0, 0, 0);
            }
        }
        if (lq == 0) coefl[h * 16 + lr] = PG[h * 16 + lr] * gelu_tanh((ah[0] + al[0] * 0.0625f) * (1.0f / PEER_U_SCALE)) * (1.0f / PEER_V_SCALE);
    }
    wave_sync();
    float o[16];
#pragma unroll
    for (int i = 0; i < 16; ++i) o[i] = 0.f;
    for (int j = 0; j < 128; j += 8) {
        uint4 va[8]; float c[8];
#pragma unroll
        for (int u = 0; u < 8; ++u) { c[u] = coefl[j + u]; va[u] = *(const uint4*)(V8 + (size_t)idxl[j + u] * 1024 + lane * 16); }
#pragma unroll
        for (int u = 0; u < 8; ++u) {
            const unsigned wds[4] = {va[u].x, va[u].y, va[u].z, va[u].w};
#pragma unroll
            for (int q = 0; q < 4; ++q) {
                const f32x2_ f0 = __builtin_amdgcn_cvt_pk_f32_fp8((int)wds[q], false), f1 = __builtin_amdgcn_cvt_pk_f32_fp8((int)wds[q], true);
                o[4 * q] += c[u] * f0[0]; o[4 * q + 1] += c[u] * f0[1]; o[4 * q + 2] += c[u] * f1[0]; o[4 * q + 3] += c[u] * f1[1];
            }
        }
    }
    float tv[16]; float s = 0.f;
#pragma unroll
    for (int i = 0; i < 16; ++i) { tv[i] = DN_ALPHA * xv[i] + o[i]; s += tv[i]; }
    const float mu = wave_sum(s) * (1.0f / 1024.0f);
    float q = 0.f;
#pragma unroll
    for (int i = 0; i < 16; ++i) { const float d = tv[i] - mu; q += d * d; }
    const float rstd = 1.0f / sqrtf(wave_sum(q) * (1.0f / 1024.0f) + LN_EPS);
    float* y = p.out + O_Y + (size_t)row * 1024 + lane * 16;
#pragma unroll
    for (int j = 0; j < 4; ++j) {
        const float4 g4 = *(const float4*)(p.ln2_g + lane * 16 + j * 4), b4 = *(const float4*)(p.ln2_b + lane * 16 + j * 4);
        float4 yo;
        yo.x = (tv[4 * j] - mu) * rstd * g4.x + b4.x; yo.y = (tv[4 * j + 1] - mu) * rstd * g4.y + b4.y; yo.z = (tv[4 * j + 2] - mu) * rstd * g4.z + b4.z; yo.w = (tv[4 * j + 3] - mu) * rstd * g4.w + b4.w;
        *(float4*)(y + j * 4) = yo;
    }
}

constexpr int QN = 2;
struct AttnState { f32x4 ot[4][QN]; float m[QN]; float l[QN]; };

DEV void attn_block(const unsigned char* Ks, const unsigned char* VTs, const bf16x8 (&Qf)[QN][2], AttnState& A, const int mode, const int dq, const float* blut,
                    const unsigned selbit0, const unsigned selbit1, const bool slc, const int lr, const int lq, const int t0, const int ci0) {
    f32x4 sc[4][QN];
#pragma unroll
    for (int kt = 0; kt < 4; ++kt) {
        const bf16x8 k0 = *(const bf16x8*)(Ks + (kt * 16 + lr) * 144 + lq * 16), k1 = *(const bf16x8*)(Ks + (kt * 16 + lr) * 144 + 64 + lq * 16);
#pragma unroll
        for (int qi = 0; qi < QN; ++qi) {
            f32x4 a = (f32x4){0.f, 0.f, 0.f, 0.f};
            a = __builtin_amdgcn_mfma_f32_16x16x32_bf16(k0, Qf[qi][0], a, 0, 0, 0);
            a = __builtin_amdgcn_mfma_f32_16x16x32_bf16(k1, Qf[qi][1], a, 0, 0, 0);
            sc[kt][qi] = a;
        }
    }
    asm volatile("" ::: "memory");
    if (mode != 0 || slc) {
#pragma unroll
        for (int kt = 0; kt < 4; ++kt)
#pragma unroll
            for (int qi = 0; qi < QN; ++qi)
#pragma unroll
                for (int g = 0; g < 4; ++g) {
                    const int kl = kt * 16 + lq * 4 + g, ql = qi * 16 + lr;
                    float v = sc[kt][qi][g];
                    bool ok = true;
                    if (mode == 1 || mode == 2) { const int di = dq + ql - kl; v += blut[di < 0 ? 0 : di]; }
                    if (mode == 2) ok = kl <= ql + dq;
                    if (mode == 3) ok = kl > ql + dq - 512;
                    if (mode == 4) { const int ci = ci0 + kl, dist = t0 + ql - (16 * ci + 31); ok = (dist >= 0) && (ci < 127); if (dist >= 0 && dist < 192) v += blut[dist]; }
                    if (mode == 5) { const int dist = dq - ci0 * kl; ok = (kl < t0) && (dist >= 0); if (dist >= 0 && dist < 192) v += blut[dist]; }
                    if (slc) ok = ok && ((qi == 0 ? selbit0 : selbit1) != 0u);
                    sc[kt][qi][g] = ok ? v : NEGF;
                }
    }
    bf16x8 pf[QN][2];
#pragma unroll
    for (int qi = 0; qi < QN; ++qi) {
        float mb = NEGF;
#pragma unroll
        for (int kt = 0; kt < 4; ++kt) mb = fmaxf(mb, fmaxf(fmaxf(sc[kt][qi][0], sc[kt][qi][1]), fmaxf(sc[kt][qi][2], sc[kt][qi][3])));
        mb = fmaxf(mb, __shfl_xor(mb, 16)); mb = fmaxf(mb, __shfl_xor(mb, 32));
        const float mn = fmaxf(A.m[qi], mb);
        const float alpha = __builtin_amdgcn_exp2f(A.m[qi] - mn);
        A.m[qi] = mn;
        float rs = 0.f;
#pragma unroll
        for (int kt = 0; kt < 4; ++kt)
#pragma unroll
            for (int g = 0; g < 4; ++g) { const float v = sc[kt][qi][g]; const float e = (v > -1e29f) ? __builtin_amdgcn_exp2f(v - mn) : 0.f; sc[kt][qi][g] = e; rs += e; }
        A.l[qi] = A.l[qi] * alpha + rs;
#pragma unroll
        for (int dt = 0; dt < 4; ++dt) A.ot[dt][qi] = A.ot[dt][qi] * alpha;
#pragma unroll
        for (int ks = 0; ks < 2; ++ks) {
            union { bf16x8 v; unsigned u[4]; } pk;
            pk.u[0] = cvt_pk_bf16(sc[2 * ks][qi][0], sc[2 * ks][qi][1]); pk.u[1] = cvt_pk_bf16(sc[2 * ks][qi][2], sc[2 * ks][qi][3]);
            pk.u[2] = cvt_pk_bf16(sc[2 * ks + 1][qi][0], sc[2 * ks + 1][qi][1]); pk.u[3] = cvt_pk_bf16(sc[2 * ks + 1][qi][2], sc[2 * ks + 1][qi][3]);
            pf[qi][ks] = pk.v;
        }
    }
    asm volatile("" ::: "memory");
#pragma unroll
    for (int dt = 0; dt < 4; ++dt)
#pragma unroll
        for (int ks = 0; ks < 2; ++ks) {
            asm volatile("" ::: "memory");
            union { bf16x8 v; uint2 h[2]; } vf;
            vf.h[0] = *(const uint2*)(VTs + (dt * 16 + lr) * 144 + (32 * ks + lq * 4) * 2);
            vf.h[1] = *(const uint2*)(VTs + (dt * 16 + lr) * 144 + (32 * ks + 16 + lq * 4) * 2);
#pragma unroll
            for (int qi = 0; qi < QN; ++qi) A.ot[dt][qi] = __builtin_amdgcn_mfma_f32_16x16x32_bf16(vf.v, pf[qi][ks], A.ot[dt][qi], 0, 0, 0);
        }
}

DEV void nsa_prompt_item(const Params& p, const int b, const int hkv, const int q32, unsigned char* lds) {
    int tid_ = threadIdx.x; asm volatile("" : "+v"(tid_));
    const int tid = tid_, lane = tid & 63, g = tid >> 6, lr = lane & 15, lq = lane >> 4;
    const int hq = hkv * 4 + g, t0 = q32 * 32, kd = t0 >> 6;
    unsigned char* Ks = lds; unsigned char* VTs = lds + 9216;
    float* biasl = (float*)(lds + 18432); float* psl = (float*)(lds + 21504); unsigned* selm = (unsigned*)(lds + 29952); unsigned* misc = (unsigned*)(lds + 30208);
    const bf16_t* ZB = (const bf16_t*)(p.ws + WS_ZB);
    const bf16_t* VTS = (const bf16_t*)(p.ws + WS_VTS) + (size_t)(b * 2 + hkv) * 64 * 2048;
    const bf16_t* VTW = (const bf16_t*)(p.ws + WS_VTW) + (size_t)(b * 2 + hkv) * 64 * 2048;
    const bf16_t* KCB = (const bf16_t*)(p.ws + WS_KCB) + (size_t)(b * 2 + hkv) * 128 * 64;
    const bf16_t* VTC = (const bf16_t*)(p.ws + WS_VTC) + (size_t)(b * 2 + hkv) * 64 * 128;
    const float* Z = (const float*)(p.ws + WS_Z);
    float* NOUTF = (float*)(p.ws + WS_NOUTF);
    bf16_t* NOUTB = (bf16_t*)(p.ws + WS_NOUTB);
    __syncthreads();
    for (int i = tid; i < 4 * 192; i += 256) { const int gg = i / 192, d = i % 192; biasl[i] = (p.rel_bias[rel_bucket(d) * 8 + hkv * 4 + gg] - p.rel_bias[31 * 8 + hkv * 4 + gg]) * LOG2E; }
    for (int i = tid; i < 32 * 33; i += 256) psl[i] = 0.f;
    if (tid < 32) selm[tid] = 0u;
    if (tid == 0) misc[0] = 0u;
    const float* blut = biasl + g * 192;
    bf16x8 Qf[QN][2];
#pragma unroll
    for (int qi = 0; qi < QN; ++qi)
#pragma unroll
        for (int kk = 0; kk < 2; ++kk) Qf[qi][kk] = *(const bf16x8*)(ZB + (size_t)(b * 2048 + t0 + qi * 16 + lr) * IN_DIM + C_Q + hq * 64 + kk * 32 + lq * 8);

    uint4 trk0, trk1, trv0, trv1;
    auto load_tiles = [&](int kind, int kb) __attribute__((always_inline)) {
#pragma unroll
        for (int i = 0; i < 2; ++i) {
            const int id = tid + 256 * i, row = id >> 3, ch = id & 7;
            uint4 rk, rv;
            if (kind == 0) { rk = *(const uint4*)(KCB + (size_t)(kb * 64 + row) * 64 + ch * 8); rv = *(const uint4*)(VTC + (size_t)row * 128 + kb * 64 + ch * 8); }
            else {
                rk = *(const uint4*)(ZB + (size_t)(b * 2048 + kb * 64 + row) * IN_DIM + (kind == 1 ? C_KS : C_KW) + hkv * 64 + ch * 8);
                rv = *(const uint4*)((kind == 1 ? VTS : VTW) + (size_t)row * 2048 + kb * 64 + ch * 8);
            }
            if (i == 0) { trk0 = rk; trv0 = rv; } else { trk1 = rk; trv1 = rv; }
        }
    };
    auto store_tiles = [&]() __attribute__((always_inline)) {
#pragma unroll
        for (int i = 0; i < 2; ++i) { const int id = tid + 256 * i, row = id >> 3, ch = id & 7; *(uint4*)(Ks + row * 144 + ch * 16) = (i == 0 ? trk0 : trk1); *(uint4*)(VTs + row * 144 + ch * 16) = (i == 0 ? trv0 : trv1); }
    };
    auto reset = [&](AttnState& A) __attribute__((always_inline)) {
#pragma unroll
        for (int qi = 0; qi < QN; ++qi) { A.m[qi] = NEGF; A.l[qi] = 0.f;
#pragma unroll
            for (int dt = 0; dt < 4; ++dt) A.ot[dt][qi] = (f32x4){0.f, 0.f, 0.f, 0.f}; }
    };
    auto finish = [&](AttnState& A, int br) __attribute__((always_inline)) {
#pragma unroll
        for (int qi = 0; qi < QN; ++qi) {
            float lt = A.l[qi]; lt += __shfl_xor(lt, 16); lt += __shfl_xor(lt, 32);
            const float sc = (lt > 0.f) ? sigmoidf_(Z[(size_t)(b * 2048 + t0 + qi * 16 + lr) * IN_DIM + C_G + br * 8 + hq]) / lt : 0.f;
            const size_t row = (size_t)(b * 2048 + t0 + qi * 16 + lr);
#pragma unroll
            for (int dt = 0; dt < 4; ++dt) {
                const int col = hq * 64 + dt * 16 + lq * 4;
                f32x4 v = A.ot[dt][qi] * sc;
                if (br > 0) v = v + *(const f32x4*)(NOUTF + row * 512 + col);
                if (br < 2) *(f32x4*)(NOUTF + row * 512 + col) = v; else store_bf16x4(NOUTB + row * 512 + col, v);
            }
        }
    };

    AttnState A;
    const int ncb = ((t0 >> 4) >= 64) ? 2 : 1;
    reset(A);
    load_tiles(0, 0);
    for (int kb = 0; kb < ncb; ++kb) {
        __syncthreads(); store_tiles(); __syncthreads();
        if (kb + 1 < ncb) load_tiles(0, kb + 1);
        attn_block(Ks, VTs, Qf, A, 4, 0, blut, 1u, 1u, false, lr, lq, t0, kb * 64);
    }
    finish(A, 0);
    {
        float linv[QN];
#pragma unroll
        for (int qi = 0; qi < QN; ++qi) { float lt = A.l[qi]; lt += __shfl_xor(lt, 16); lt += __shfl_xor(lt, 32); linv[qi] = (lt > 0.f) ? 1.0f / lt : 0.f; }
        for (int kb = 0; kb < ncb; ++kb) {
            if (ncb > 1) { load_tiles(0, kb); __syncthreads(); store_tiles(); __syncthreads(); }
#pragma unroll
            for (int kt = 0; kt < 4; ++kt) {
                const bf16x8 k0 = *(const bf16x8*)(Ks + (kt * 16 + lr) * 144 + lq * 16), k1 = *(const bf16x8*)(Ks + (kt * 16 + lr) * 144 + 64 + lq * 16);
#pragma unroll
                for (int qi = 0; qi < QN; ++qi) {
                    f32x4 a = (f32x4){0.f, 0.f, 0.f, 0.f};
                    a = __builtin_amdgcn_mfma_f32_16x16x32_bf16(k0, Qf[qi][0], a, 0, 0, 0);
                    a = __builtin_amdgcn_mfma_f32_16x16x32_bf16(k1, Qf[qi][1], a, 0, 0, 0);
                    float pr[4];
#pragma unroll
                    for (int gg = 0; gg < 4; ++gg) {
                        const int ci = kb * 64 + kt * 16 + lq * 4 + gg, ql = qi * 16 + lr, dist = t0 + ql - (16 * ci + 31);
                        float v = a[gg];
                        if (dist >= 0 && dist < 192) v += blut[dist];
                        pr[gg] = (dist >= 0 && ci < 127) ? __builtin_amdgcn_exp2f(v - A.m[qi]) * linv[qi] : 0.f;
                    }
                    const int blk = kb * 16 + kt * 4 + lq, ql = qi * 16 + lr;
                    atomicAdd(&psl[ql * 33 + blk], 2.0f * (pr[0] + pr[1] + pr[2]) + pr[3]);
                    atomicAdd(&psl[ql * 33 + blk + 1], pr[3]);
                }
            }
        }
    }
    __syncthreads();
    {
        const int ql = tid >> 3, part = tid & 7, tq = t0 + ql, cur = tq >> 6;
        float scv[32];
#pragma unroll
        for (int j = 0; j < 32; ++j) {
            const bool causal = j * 64 <= tq, forced = (j == 0) || (j == cur) || (j == cur - 1);
            scv[j] = causal ? (forced ? 1e4f : psl[ql * 33 + j]) : NEGF;
        }
        unsigned mbits = 0u;
#pragma unroll
        for (int jj = 0; jj < 4; ++jj) {
            const int j = part * 4 + jj;
            float my = NEGF;
#pragma unroll
            for (int k = 0; k < 32; ++k) my = (k == j) ? scv[k] : my;
            int rank = 0;
#pragma unroll
            for (int k = 0; k < 32; ++k) rank += ((scv[k] > my) || (scv[k] == my && k < j)) ? 1 : 0;
            if (rank < 16 && j * 64 <= tq) mbits |= (1u << j);
        }
        atomicOr(&selm[ql], mbits);
        atomicOr(&misc[0], mbits);
    }
    __syncthreads();
    const unsigned msk0 = selm[lr], msk1 = selm[16 + lr];
    const unsigned anym = misc[0];
    reset(A);
    {
        int kb = kd;
        load_tiles(1, kb);
        for (;;) {
            __syncthreads(); store_tiles(); __syncthreads();
            int nxt = (kb == kd) ? 0 : kb + 1;
            while (nxt < kd && !((anym >> nxt) & 1u)) ++nxt;
            const bool more = nxt < kd;
            if (more) load_tiles(1, nxt);
            const int mode = (kb == kd) ? 2 : ((kb >= kd - 2) ? 1 : 0);
            attn_block(Ks, VTs, Qf, A, mode, t0 - kb * 64, blut, (msk0 >> kb) & 1u, (msk1 >> kb) & 1u, true, lr, lq, t0, 0);
            if (!more) break;
            kb = nxt;
        }
    }
    finish(A, 1);
    reset(A);
    {
        const int klo = (t0 >= 511) ? ((t0 - 511) >> 6) : 0;
        int kb = kd;
        load_tiles(2, kb);
        for (;;) {
            __syncthreads(); store_tiles(); __syncthreads();
            const bool more = kb > klo;
            if (more) load_tiles(2, kb - 1);
            const int dq = t0 - kb * 64;
            const int mode = (kb == kd) ? 2 : ((kb >= kd - 2) ? 1 : ((dq + 31 >= 512) ? 3 : 0));
            attn_block(Ks, VTs, Qf, A, mode, dq, blut, 1u, 1u, false, lr, lq, t0, 0);
            if (!more) break;
            --kb;
        }
    }
    finish(A, 2);
}

DEV void nsa_sample_item(const Params& p, const int b, const int hkv, unsigned char* lds) {
    int tid_ = threadIdx.x; asm volatile("" : "+v"(tid_));
    const int tid = tid_, lane = tid & 63, g = tid >> 6, lr = lane & 15, lq = lane >> 4;
    const int hq = hkv * 4 + g;
    unsigned char* Ks = lds; unsigned char* VTs = lds + 9216;
    float* biasl = (float*)(lds + 18432); float* psl = (float*)(lds + 21504); int* sell = (int*)(lds + 29952); float* scl = (float*)(lds + 30720);
    const bf16_t* ZB = (const bf16_t*)(p.ws + WS_ZB);
    const float* zrow = (const float*)(p.ws + WS_Z) + (size_t)(NP + b) * IN_DIM;
    const bf16_t* KCSB = (const bf16_t*)(p.ws + WS_KCSB) + (size_t)(b * 2 + hkv) * 1024 * 64;
    const bf16_t* VTCS = (const bf16_t*)(p.ws + WS_VTCS) + (size_t)(b * 2 + hkv) * 64 * 1024;
    bf16_t* NOUTB = (bf16_t*)(p.ws + WS_NOUTB);
    __syncthreads();
    for (int i = tid; i < 4 * 192; i += 256) { const int gg = i / 192, d = i % 192; biasl[i] = (p.rel_bias[rel_bucket(d) * 8 + hkv * 4 + gg] - p.rel_bias[31 * 8 + hkv * 4 + gg]) * LOG2E; }
    for (int i = tid; i < 260; i += 256) psl[i] = 0.f;
    const float* blut = biasl + g * 192;
    bf16x8 Qf[QN][2];
#pragma unroll
    for (int kk = 0; kk < 2; ++kk) { Qf[0][kk] = *(const bf16x8*)(ZB + (size_t)(NP + b) * IN_DIM + C_Q + hq * 64 + kk * 32 + lq * 8); Qf[1][kk] = Qf[0][kk]; }
    AttnState A;
    auto reset = [&](AttnState& S_) __attribute__((always_inline)) {
#pragma unroll
        for (int qi = 0; qi < QN; ++qi) { S_.m[qi] = NEGF; S_.l[qi] = 0.f;
#pragma unroll
            for (int dt = 0; dt < 4; ++dt) S_.ot[dt][qi] = (f32x4){0.f, 0.f, 0.f, 0.f}; }
    };
    f32x4 res[4];
#pragma unroll
    for (int dt = 0; dt < 4; ++dt) res[dt] = (f32x4){0.f, 0.f, 0.f, 0.f};
    auto finish = [&](AttnState& S_, int br) __attribute__((always_inline)) {
        float lt = S_.l[0]; lt += __shfl_xor(lt, 16); lt += __shfl_xor(lt, 32);
        const float sc = (lt > 0.f) ? sigmoidf_(zrow[C_G + br * 8 + hq]) / lt : 0.f;
#pragma unroll
        for (int dt = 0; dt < 4; ++dt) res[dt] = res[dt] + S_.ot[dt][0] * sc;
    };
    uint4 trk0, trk1, trv0, trv1;
    auto load_cmp = [&](int kb) __attribute__((always_inline)) {
#pragma unroll
        for (int i = 0; i < 2; ++i) {
            const int id = tid + 256 * i, row = id >> 3, ch = id & 7;
            const uint4 rk = *(const uint4*)(KCSB + (size_t)(kb * 64 + row) * 64 + ch * 8), rv = *(const uint4*)(VTCS + (size_t)row * 1024 + kb * 64 + ch * 8);
            if (i == 0) { trk0 = rk; trv0 = rv; } else { trk1 = rk; trv1 = rv; }
        }
    };
    auto store_cmp = [&]() __attribute__((always_inline)) {
#pragma unroll
        for (int i = 0; i < 2; ++i) { const int id = tid + 256 * i, row = id >> 3, ch = id & 7; *(uint4*)(Ks + row * 144 + ch * 16) = (i == 0 ? trk0 : trk1); *(uint4*)(VTs + row * 144 + ch * 16) = (i == 0 ? trv0 : trv1); }
    };
    reset(A);
    load_cmp(0);
    for (int kb = 0; kb < 16; ++kb) {
        __syncthreads(); store_cmp(); __syncthreads();
        if (kb + 1 < 16) load_cmp(kb + 1);
        attn_block(Ks, VTs, Qf, A, 5, PAST - 31 - 16 * (kb * 64), blut, 1u, 1u, false, lr, lq, (kb == 15) ? 63 : 64, 16);
    }
    finish(A, 0);
    {
        float lt = A.l[0]; lt += __shfl_xor(lt, 16); lt += __shfl_xor(lt, 32);
        const float linv = (lt > 0.f) ? 1.0f / lt : 0.f;
        for (int kb = 0; kb < 16; ++kb) {
            load_cmp(kb); __syncthreads(); store_cmp(); __syncthreads();
#pragma unroll
            for (int kt = 0; kt < 4; ++kt) {
                const bf16x8 k0 = *(const bf16x8*)(Ks + (kt * 16 + lr) * 144 + lq * 16), k1 = *(const bf16x8*)(Ks + (kt * 16 + lr) * 144 + 64 + lq * 16);
                f32x4 a = (f32x4){0.f, 0.f, 0.f, 0.f};
                a = __builtin_amdgcn_mfma_f32_16x16x32_bf16(k0, Qf[0][0], a, 0, 0, 0);
                a = __builtin_amdgcn_mfma_f32_16x16x32_bf16(k1, Qf[0][1], a, 0, 0, 0);
                float pr[4];
#pragma unroll
                for (int gg = 0; gg < 4; ++gg) {
                    const int ci = kb * 64 + kt * 16 + lq * 4 + gg, dist = PAST - 31 - 16 * ci;
                    float v = a[gg];
                    if (dist >= 0 && dist < 192) v += blut[dist];
                    pr[gg] = (ci < 1023) ? __builtin_amdgcn_exp2f(v - A.m[0]) * linv : 0.f;
                }
                if (lr == 0) {
                    const int blk = kb * 16 + kt * 4 + lq;
                    atomicAdd(&psl[blk], 2.0f * (pr[0] + pr[1] + pr[2]) + pr[3]);
                    atomicAdd(&psl[blk + 1], pr[3]);
                }
            }
        }
    }
    __syncthreads();
    for (int j = tid; j < 257; j += 256) scl[j] = (j == 0 || j == 256 || j == 255) ? 1e4f : psl[j];
    __syncthreads();
    for (int j = tid; j < 257; j += 256) {
        const float my = scl[j];
        int rank = 0;
        for (int k = 0; k < 257; ++k) { const float o2 = scl[k]; rank += ((o2 > my) || (o2 == my && k < j)) ? 1 : 0; }
        if (rank < 16) sell[rank] = j;
    }
    __syncthreads();
    uint4 rk0, rk1; unsigned rv0, rv1, rv2, rv3, rv4, rv5, rv6, rv7;
    auto load_rows = [&](const float* src) __attribute__((always_inline)) {
        const int seg = tid & 3;
        const bool nz = src != nullptr;
        const float* kp = (nz ? src : zrow) + hkv * 64 + seg * 16; const float* vp = kp + 128;
        const float4 a0 = *(const float4*)kp, a1 = *(const float4*)(kp + 4), a2 = *(const float4*)(kp + 8), a3 = *(const float4*)(kp + 12);
        const float4 c0 = *(const float4*)vp, c1 = *(const float4*)(vp + 4), c2 = *(const float4*)(vp + 8), c3 = *(const float4*)(vp + 12);
        const unsigned mk = nz ? 0xffffffffu : 0u;
        rk0.x = cvt_pk_bf16(a0.x, a0.y) & mk; rk0.y = cvt_pk_bf16(a0.z, a0.w) & mk; rk0.z = cvt_pk_bf16(a1.x, a1.y) & mk; rk0.w = cvt_pk_bf16(a1.z, a1.w) & mk;
        rk1.x = cvt_pk_bf16(a2.x, a2.y) & mk; rk1.y = cvt_pk_bf16(a2.z, a2.w) & mk; rk1.z = cvt_pk_bf16(a3.x, a3.y) & mk; rk1.w = cvt_pk_bf16(a3.z, a3.w) & mk;
        rv0 = cvt_pk_bf16(c0.x, c0.y) & mk; rv1 = cvt_pk_bf16(c0.z, c0.w) & mk; rv2 = cvt_pk_bf16(c1.x, c1.y) & mk; rv3 = cvt_pk_bf16(c1.z, c1.w) & mk;
        rv4 = cvt_pk_bf16(c2.x, c2.y) & mk; rv5 = cvt_pk_bf16(c2.z, c2.w) & mk; rv6 = cvt_pk_bf16(c3.x, c3.y) & mk; rv7 = cvt_pk_bf16(c3.z, c3.w) & mk;
    };
    auto store_rows = [&]() __attribute__((always_inline)) {
        const int kl = tid >> 2, seg = tid & 3;
        *(uint4*)(Ks + kl * 144 + seg * 32) = rk0; *(uint4*)(Ks + kl * 144 + seg * 32 + 16) = rk1;
#define VT_PUT(i_, w_) { *(bf16_t*)(VTs + (seg * 16 + (i_)) * 144 + kl * 2) = (bf16_t)((w_) & 0xffffu); *(bf16_t*)(VTs + (seg * 16 + (i_) + 1) * 144 + kl * 2) = (bf16_t)((w_) >> 16); }
        VT_PUT(0, rv0) VT_PUT(2, rv1) VT_PUT(4, rv2) VT_PUT(6, rv3) VT_PUT(8, rv4) VT_PUT(10, rv5) VT_PUT(12, rv6) VT_PUT(14, rv7)
#undef VT_PUT
    };
    auto slc_row = [&](int blk) __attribute__((always_inline)) -> const float* {
        const int kl = tid >> 2;
        if (blk < 256) { const int page = p.page_table[b * 128 + (blk >> 1)]; return p.cache_slc + ((size_t)page * 128 + (blk & 1) * 64 + kl) * 256; }
        return (kl == 0) ? zrow + C_KS : nullptr;
    };
    reset(A);
    load_rows(slc_row(sell[0]));
    for (int si = 0; si < 16; ++si) {
        const int blk = sell[si];
        __syncthreads(); store_rows(); __syncthreads();
        if (si + 1 < 16) load_rows(slc_row(sell[si + 1]));
        attn_block(Ks, VTs, Qf, A, 5, PAST - blk * 64, blut, 1u, 1u, false, lr, lq, (blk == 256) ? 1 : 64, 1);
    }
    finish(A, 1);
    auto win_row = [&](int wb) __attribute__((always_inline)) -> const float* {
        const int j = 1 + wb * 64 + (tid >> 2);
        return (j < 512) ? p.state_win + ((size_t)b * 512 + j) * 256 : zrow + C_KW;
    };
    reset(A);
    load_rows(win_row(0));
    for (int wb = 0; wb < 8; ++wb) {
        __syncthreads(); store_rows(); __syncthreads();
        if (wb + 1 < 8) load_rows(win_row(wb + 1));
        attn_block(Ks, VTs, Qf, A, 5, 511 - wb * 64, blut, 1u, 1u, false, lr, lq, 64, 1);
    }
    finish(A, 2);
    if (lr == 0) {
#pragma unroll
        for (int dt = 0; dt < 4; ++dt) store_bf16x4(NOUTB + (size_t)(NP + b) * 512 + hq * 64 + dt * 16 + lq * 4, res[dt]);
    }
}

#define Z ((float*)(p.ws + WS_Z))
#define QK ((float*)(p.ws + WS_QK))
#define HRAW ((float*)(p.ws + WS_HRAW))
#define MOUTB ((bf16_t*)(p.ws + WS_MOUTB))
#define NOUTB ((bf16_t*)(p.ws + WS_NOUTB))
#define HIDPB ((bf16_t*)(p.ws + WS_HIDPB))
#define HIDSB ((bf16_t*)(p.ws + WS_HIDSB))
#define KCS ((float*)(p.ws + WS_KCS))
#define MIX ((float*)(p.ws + WS_MIX))
#define MIXB ((bf16_t*)(p.ws + WS_MIXB))
#define T1 ((float*)(p.ws + WS_T1))
#define X1 ((float*)(p.ws + WS_X1))
#define X1B ((bf16_t*)(p.ws + WS_X1B))
#define QPB ((bf16_t*)(p.ws + WS_QPB))
#define S ((float*)(p.ws + WS_S))
#define CONVB ((bf16_t*)(p.ws + WS_CONVB))
#define XB ((bf16_t*)(p.ws + WS_XB))
#define WIN_T ((bf16_t*)(p.ws + WS_WIN_T))
#define WUPM_T ((bf16_t*)(p.ws + WS_WUPM_T))
#define WUPN_T ((bf16_t*)(p.ws + WS_WUPN_T))
#define WOUT_T ((bf16_t*)(p.ws + WS_WOUT_T))
#define PWQ_T ((bf16_t*)(p.ws + WS_PWQ_T))
#define WQK_T ((bf16_t*)(p.ws + WS_WQK_T))
#define W1_T ((bf16_t*)(p.ws + WS_W1_T))
#define W2_T ((bf16_t*)(p.ws + WS_W2_T))
#define SUBK ((bf16_t*)(p.ws + WS_SUBK))
#define ZB ((bf16_t*)(p.ws + WS_ZB))
#define VTS ((bf16_t*)(p.ws + WS_VTS))
#define VTW ((bf16_t*)(p.ws + WS_VTW))
#define KCB ((bf16_t*)(p.ws + WS_KCB))
#define VTC ((bf16_t*)(p.ws + WS_VTC))
__global__ void __launch_bounds__(NTHREADS, 2) fwd_kernel(Params p) {
    extern __shared__ __attribute__((aligned(16))) unsigned char smem[];
    if (threadIdx.x == 0) { *(uint4*)smem = make_uint4(0u, 0u, 0u, 0u); }
    __syncthreads();
    XcdBarrier bar = xcd_barrier_post((unsigned*)(p.ws + WS_BAR), (volatile LAS unsigned*)smem);
    float* lds = (float*)(smem + 16);
    unsigned char* ldsb = smem + 16;
    const int tid = threadIdx.x, lane = tid & 63, w = tid >> 6;
    const int gw = blockIdx.x * 4 + w, nw = gridDim.x * 4;
    const size_t gt = (size_t)blockIdx.x * NTHREADS + tid, nt = (size_t)gridDim.x * NTHREADS;


    {
        for (size_t id = gt; id < (size_t)MP * 128; id += nt) {
            const int row = (int)(id >> 7), k8 = (int)(id & 127) * 8;
            float f[8];
            if (row < NR) {
                const float* s = (row < NP ? p.x_prompt + (size_t)row * 1024 : p.x_sample + (size_t)(row - NP) * 1024) + k8;
                const float4 a = *(const float4*)s, b = *(const float4*)(s + 4);
                f[0] = a.x; f[1] = a.y; f[2] = a.z; f[3] = a.w; f[4] = b.x; f[5] = b.y; f[6] = b.z; f[7] = b.w;
            } else {
#pragma unroll
                for (int i = 0; i < 8; ++i) f[i] = 0.f;
            }
            *(uint4*)(XB + (size_t)row * 1024 + k8) = pack8(f);
        }
        transpose_to_bf16(p.w_in, 1024, IN_DIM, WIN_T, gt, nt);
        transpose_to_bf16(p.w_up_m, 512, 1024, WUPM_T, gt, nt);
        transpose_to_bf16(p.w_up_n, 512, 1024, WUPN_T, gt, nt);
        transpose_to_bf16(p.w_out, 1024, 1024, WOUT_T, gt, nt);
        transpose_to_bf16(p.peer_wq, 1024, 2048, PWQ_T, gt, nt);
        for (int h = 0; h < 4; ++h) {
            transpose_to_bf16(p.wq + (size_t)h * 16384, 128, 128, WQK_T + (size_t)(h * 256) * 128, gt, nt);
            transpose_to_bf16(p.wk + (size_t)h * 16384, 128, 128, WQK_T + (size_t)(h * 256 + 128) * 128, gt, nt);
        }
        for (int c = 0; c < 2; ++c) {
            transpose_to_bf16(p.cmp_w1 + (size_t)c * 2048 * 64, 2048, 64, W1_T + (size_t)c * 64 * 2048, gt, nt);
            transpose_to_bf16(p.cmp_w2 + (size_t)c * 4096, 64, 64, W2_T + (size_t)c * 4096, gt, nt);
        }
        for (size_t id = gt; id < (size_t)2 * 128 * 128 / 8; id += nt) {
            float f[8];
#pragma unroll
            for (int i = 0; i < 8; ++i) f[i] = p.peer_sub[id * 8 + i];
            *(uint4*)(SUBK + id * 8) = pack8(f);
        }
        for (size_t id = gt; id < (size_t)16384 * 64; id += nt) {
            const float* su = p.peer_u + id * 16; const float* sv = p.peer_v + id * 16;
            uint4 ou, ov; unsigned* pu = (unsigned*)&ou; unsigned* pv = (unsigned*)&ov;
#pragma unroll
            for (int j = 0; j < 4; ++j) {
                const float4 a4 = *(const float4*)(su + j * 4), c4 = *(const float4*)(sv + j * 4);
                pu[j] = pack4_fp8(a4.x * PEER_U_SCALE, a4.y * PEER_U_SCALE, a4.z * PEER_U_SCALE, a4.w * PEER_U_SCALE);
                pv[j] = pack4_fp8(c4.x * PEER_V_SCALE, c4.y * PEER_V_SCALE, c4.z * PEER_V_SCALE, c4.w * PEER_V_SCALE);
            }
            *(uint4*)(p.ws + WS_U8 + id * 16) = ou; *(uint4*)(p.ws + WS_V8 + id * 16) = ov;
        }
        for (size_t i = gt; i < (size_t)BS * 511 * 256; i += nt) {
            const int j = (int)(i & 255); const int wv = (int)((i >> 8) % 511); const int b = (int)((i >> 8) / 511);
            p.out[O_WINS + ((size_t)b * 512 + wv) * 256 + j] = p.state_win[((size_t)b * 512 + wv + 1) * 256 + j];
        }
        for (size_t i = gt; i < (size_t)BS * 2 * 512; i += nt) {
            const int ch = (int)(i & 511); const int jj = (int)((i >> 9) & 1); const int b = (int)(i >> 10);
            p.out[O_CVS + ((size_t)b * 3 + jj) * 512 + ch] = p.state_conv[((size_t)b * 3 + jj + 1) * 512 + ch];
        }
    }
    xcd_barrier(bar);

    gemm_bf16<128>(NR, IN_DIM, 1024,
        [&](int r, int k) { return *(const uint4*)(XB + (size_t)r * 1024 + k); },
        [&](int n, int k) { return *(const uint4*)(WIN_T + (size_t)n * 1024 + k); },
        [&](int r, int c0, f32x4 v) {
            *(f32x4*)(Z + (size_t)r * IN_DIM + c0) = v;
            store_bf16x4(ZB + (size_t)r * IN_DIM + c0, (c0 >= C_Q && c0 < C_KC) ? v * (0.125f * LOG2E) : v);
            if (r < NP && ((c0 >= C_KS + 128 && c0 < C_KW) || (c0 >= C_KW + 128 && c0 < C_G))) {
                const bool isw = c0 >= C_KW; const int cc = c0 - (isw ? C_KW : C_KS) - 128;
                bf16_t* vt = (isw ? VTW : VTS) + ((size_t)((r >> 11) * 2) * 64 + cc) * 2048 + (r & 2047);
                const unsigned w0 = cvt_pk_bf16(v[0], v[1]), w1 = cvt_pk_bf16(v[2], v[3]);
                vt[0] = (bf16_t)(w0 & 0xffffu); vt[2048] = (bf16_t)(w0 >> 16); vt[4096] = (bf16_t)(w1 & 0xffffu); vt[6144] = (bf16_t)(w1 >> 16);
            }
            if (r < NP && c0 >= C_V && c0 < C_O) {
                bf16_t* vt = (bf16_t*)(p.ws + WS_VTM) + ((size_t)(r >> 11) * 512 + (c0 - C_V)) * 2048 + (r & 2047);
                const unsigned w0 = cvt_pk_bf16(v[0], v[1]), w1 = cvt_pk_bf16(v[2], v[3]);
                vt[0] = (bf16_t)(w0 & 0xffffu); vt[2048] = (bf16_t)(w0 >> 16); vt[4096] = (bf16_t)(w1 & 0xffffu); vt[6144] = (bf16_t)(w1 >> 16);
            }
            if (c0 >= C_KC && c0 < C_KS) *(f32x4*)(p.out + O_CMPP + (size_t)r * 256 + (c0 - C_KC)) = v;
            else if (c0 >= C_KS && c0 < C_KW) *(f32x4*)(p.out + O_SLCP + (size_t)r * 256 + (c0 - C_KS)) = v;
            else if (c0 >= C_KW && c0 < C_G) {
                if (r < NP) { const int t = r & 2047; if (t >= 1536) *(f32x4*)(p.out + O_WINP + ((size_t)(r >> 11) * 512 + (t - 1536)) * 256 + (c0 - C_KW)) = v; }
                else *(f32x4*)(p.out + O_WINS + ((size_t)(r - NP) * 512 + 511) * 256 + (c0 - C_KW)) = v;
            } else if (c0 < C_V) {
                if (r < NP) { const int t = r & 2047; if (t >= 2045) *(f32x4*)(p.out + O_CVP + ((size_t)(r >> 11) * 3 + (t - 2045)) * 512 + c0) = v; }
                else *(f32x4*)(p.out + O_CVS + ((size_t)(r - NP) * 3 + 2) * 512 + c0) = v;
            }
        }, ldsb);
    xcd_barrier(bar);

    for (size_t i = gt; i < (size_t)NR * 512; i += nt) {
        const int ch = (int)(i & 511); const int r = (int)(i >> 9);
        float a = p.conv_b[ch];
        if (r < NP) {
            const int t = r & 2047;
#pragma unroll
            for (int j = 0; j < 4; ++j) if (t + j - 3 >= 0) a += p.conv_w[j * 512 + ch] * Z[(size_t)(r + j - 3) * IN_DIM + C_U + ch];
        } else {
            const int b = r - NP;
#pragma unroll
            for (int j = 0; j < 3; ++j) a += p.conv_w[j * 512 + ch] * p.state_conv[((size_t)b * 3 + j) * 512 + ch];
            a += p.conv_w[3 * 512 + ch] * Z[(size_t)r * IN_DIM + C_U + ch];
        }
        CONVB[i] = (bf16_t)(cvt_pk_bf16(a / (1.0f + expf(-a)), 0.f) & 0xffffu);
    }
    xcd_barrier(bar);

    for (int h = 0; h < 4; ++h) {
        gemm_bf16<128>(NR, 256, 128,
            [&](int r, int k) { return *(const uint4*)(CONVB + (size_t)r * 512 + h * 128 + k); },
            [&](int n, int k) { return *(const uint4*)(WQK_T + (size_t)(h * 256 + n) * 128 + k); },
            [&](int r, int c0, f32x4 v) {
                if (c0 >= 128) v = v * 0.08838834764831845f;
                *(f32x4*)(QK + (size_t)r * 1024 + h * 256 + c0) = v;
                if (c0 < 128) store_bf16x4((bf16_t*)(p.ws + WS_QB) + (size_t)r * 512 + h * 128 + c0, v);
                else {
                    store_bf16x4((bf16_t*)(p.ws + WS_KB) + (size_t)r * 512 + h * 128 + (c0 - 128), v);
                    if (r < NP) {
                        bf16_t* kt = (bf16_t*)(p.ws + WS_KTB) + ((size_t)((r >> 11) * 4 + h) * 128 + (c0 - 128)) * 2048 + (r & 2047);
                        const unsigned w0 = cvt_pk_bf16(v[0], v[1]), w1 = cvt_pk_bf16(v[2], v[3]);
                        kt[0] = (bf16_t)(w0 & 0xffffu); kt[2048] = (bf16_t)(w0 >> 16); kt[4096] = (bf16_t)(w1 & 0xffffu); kt[6144] = (bf16_t)(w1 >> 16);
                    }
                } }, ldsb);
    }
    for (int c = 0; c < 2; ++c) {
        gemm_bf16<64>(4096, 64, 2048,
            [&](int row, int k) {
                const int hh = row & 1, bi = row >> 1, i = bi & 127, b = bi >> 7, j = k >> 6, d0 = k & 63, tok = 16 * i + j;
                const float* pe = p.cmp_pe + (c * 32 + j) * 64 + d0;
                const float4 e0 = *(const float4*)pe, e1 = *(const float4*)(pe + 4);
                float f[8] = {e0.x, e0.y, e0.z, e0.w, e1.x, e1.y, e1.z, e1.w};
                if (tok < 2048) {
                    const float* s = Z + ((size_t)b * 2048 + tok) * IN_DIM + C_KC + c * 128 + hh * 64 + d0;
                    const float4 a0 = *(const float4*)s, a1 = *(const float4*)(s + 4);
                    f[0] += a0.x; f[1] += a0.y; f[2] += a0.z; f[3] += a0.w; f[4] += a1.x; f[5] += a1.y; f[6] += a1.z; f[7] += a1.w;
                }
                return pack8(f); },
            [&](int n, int k) { return *(const uint4*)(W1_T + ((size_t)c * 64 + n) * 2048 + k); },
            [&](int row, int c0, f32x4 v) {
                f32x4 g; g[0] = gelu_tanh(v[0]); g[1] = gelu_tanh(v[1]); g[2] = gelu_tanh(v[2]); g[3] = gelu_tanh(v[3]);
                store_bf16x4(HIDPB + ((size_t)c * 4096 + row) * 64 + c0, g); }, ldsb);
        gemm_bf16<64>(65536, 64, 2048,
            [&](int row, int k) {
                const int hh = row & 1, bi = row >> 1, i = bi & 1023, b = bi >> 10, j = k >> 6, d0 = k & 63, tok = 16 * i + j;
                const float* pe = p.cmp_pe + (c * 32 + j) * 64 + d0;
                const float4 e0 = *(const float4*)pe, e1 = *(const float4*)(pe + 4);
                float f[8] = {e0.x, e0.y, e0.z, e0.w, e1.x, e1.y, e1.z, e1.w};
                if (tok < PAST) {
                    const int page = p.page_table[b * 128 + (tok >> 7)];
                    const float* s = p.cache_cmp + ((size_t)page * 128 + (tok & 127)) * 256 + c * 128 + hh * 64 + d0;
                    const float4 a0 = *(const float4*)s, a1 = *(const float4*)(s + 4);
                    f[0] += a0.x; f[1] += a0.y; f[2] += a0.z; f[3] += a0.w; f[4] += a1.x; f[5] += a1.y; f[6] += a1.z; f[7] += a1.w;
                }
                return pack8(f); },
            [&](int n, int k) { return *(const uint4*)(W1_T + ((size_t)c * 64 + n) * 2048 + k); },
            [&](int row, int c0, f32x4 v) {
                f32x4 g; g[0] = gelu_tanh(v[0]); g[1] = gelu_tanh(v[1]); g[2] = gelu_tanh(v[2]); g[3] = gelu_tanh(v[3]);
                store_bf16x4(HIDSB + ((size_t)c * 65536 + row) * 64 + c0, g); }, ldsb);
    }
    xcd_barrier(bar);

    for (int item = blockIdx.x; item < 256 + 128; item += gridDim.x) {
        if (item < 256) mlstm_chunk_item(p, item, ldsb); else mlstm_scan_item(p, 64 + (item - 256), lds);
    }
    for (int c = 0; c < 2; ++c) {
        gemm_bf16<64>(4096, 64, 64,
            [&](int row, int k) { return *(const uint4*)(HIDPB + ((size_t)c * 4096 + row) * 64 + k); },
            [&](int n, int k) { return *(const uint4*)(W2_T + ((size_t)c * 64 + n) * 64 + k); },
            [&](int row, int c0, f32x4 v) {
                const int hh = row & 1, bi = row >> 1, i = bi & 127, b = bi >> 7;
                if (c == 0) store_bf16x4(KCB + ((size_t)(b * 2 + hh) * 128 + i) * 64 + c0, v);
                else { bf16_t* vt = VTC + ((size_t)(b * 2 + hh) * 64 + c0) * 128 + i; const unsigned w0 = cvt_pk_bf16(v[0], v[1]), w1 = cvt_pk_bf16(v[2], v[3]);
                       vt[0] = (bf16_t)(w0 & 0xffffu); vt[128] = (bf16_t)(w0 >> 16); vt[256] = (bf16_t)(w1 & 0xffffu); vt[384] = (bf16_t)(w1 >> 16); } }, ldsb);
        gemm_bf16<64>(65536, 64, 64,
            [&](int row, int k) { return *(const uint4*)(HIDSB + ((size_t)c * 65536 + row) * 64 + k); },
            [&](int n, int k) { return *(const uint4*)(W2_T + ((size_t)c * 64 + n) * 64 + k); },
            [&](int row, int c0, f32x4 v) {
                const int hh = row & 1, bi = row >> 1, i = bi & 1023, b = bi >> 10;
                if (c == 0) store_bf16x4((bf16_t*)(p.ws + WS_KCSB) + ((size_t)(b * 2 + hh) * 1024 + i) * 64 + c0, v);
                else { bf16_t* vt = (bf16_t*)(p.ws + WS_VTCS) + ((size_t)(b * 2 + hh) * 64 + c0) * 1024 + i; const unsigned w0 = cvt_pk_bf16(v[0], v[1]), w1 = cvt_pk_bf16(v[2], v[3]);
                       vt[0] = (bf16_t)(w0 & 0xffffu); vt[1024] = (bf16_t)(w0 >> 16); vt[2048] = (bf16_t)(w1 & 0xffffu); vt[3072] = (bf16_t)(w1 >> 16); } }, ldsb);
    }
    xcd_barrier(bar);

    for (int it = gw; it < NR * 4; it += nw) {
        const int row = it >> 2, h = it & 3;
        const float x0 = HRAW[(size_t)row * 512 + h * 128 + lane], x1 = HRAW[(size_t)row * 512 + h * 128 + 64 + lane];
        const float mu = wave_sum(x0 + x1) * (1.0f / 128.0f);
        const float d0 = x0 - mu, d1 = x1 - mu;
        const float var = wave_sum(d0 * d0 + d1 * d1) * (1.0f / 128.0f);
        const float rstd = 1.0f / sqrtf(var + LN_EPS);
        const int c0 = h * 128 + lane, c1 = c0 + 64;
        MOUTB[(size_t)row * 512 + c0] = (bf16_t)(cvt_pk_bf16(sigmoidf_(Z[(size_t)row * IN_DIM + C_O + c0]) * (d0 * rstd * p.norm_g[c0]), 0.f) & 0xffffu);
        MOUTB[(size_t)row * 512 + c1] = (bf16_t)(cvt_pk_bf16(sigmoidf_(Z[(size_t)row * IN_DIM + C_O + c1]) * (d1 * rstd * p.norm_g[c1]), 0.f) & 0xffffu);
    }
    for (;;) {
        __syncthreads();
        if (tid == 0) *(volatile int*)(ldsb + 32768) = (int)atomicAdd((unsigned*)(p.ws + WS_BAR) + 2, 1u);
        __syncthreads();
        const int idx = *(volatile int*)(ldsb + 32768);
        if (idx >= 64 + 2048) break;
        if (idx < 64) nsa_sample_item(p, idx >> 1, idx & 1, ldsb);
        else { const int i2 = idx - 64; nsa_prompt_item(p, (i2 & 31) >> 1, i2 & 1, 63 - (i2 >> 5), ldsb); }
    }
    xcd_barrier(bar);

    gemm_bf16<128>(NR, 1024, 512,
        [&](int r, int k) { return *(const uint4*)(MOUTB + (size_t)r * 512 + k); },
        [&](int n, int k) { return *(const uint4*)(WUPM_T + (size_t)n * 512 + k); },
        [&](int r, int c0, f32x4 v) {
            const f32x4 g = *(const f32x4*)(Z + (size_t)r * IN_DIM + C_GM + c0);
            f32x4 o; o[0] = sigmoidf_(g[0]) * v[0]; o[1] = sigmoidf_(g[1]) * v[1]; o[2] = sigmoidf_(g[2]) * v[2]; o[3] = sigmoidf_(g[3]) * v[3];
            *(f32x4*)(MIX + (size_t)r * 1024 + c0) = o; }, ldsb);
    gemm_bf16<128>(NR, 1024, 512,
        [&](int r, int k) { return *(const uint4*)(NOUTB + (size_t)r * 512 + k); },
        [&](int n, int k) { return *(const uint4*)(WUPN_T + (size_t)n * 512 + k); },
        [&](int r, int c0, f32x4 v) {
            const f32x4 g = *(const f32x4*)(Z + (size_t)r * IN_DIM + C_GN + c0);
            f32x4 o = *(const f32x4*)(MIX + (size_t)r * 1024 + c0);
            o[0] += sigmoidf_(g[0]) * v[0]; o[1] += sigmoidf_(g[1]) * v[1]; o[2] += sigmoidf_(g[2]) * v[2]; o[3] += sigmoidf_(g[3]) * v[3];
            store_bf16x4(MIXB + (size_t)r * 1024 + c0, o); }, ldsb);
    xcd_barrier(bar);

    gemm_bf16<128>(NR, 1024, 1024,
        [&](int r, int k) { return *(const uint4*)(MIXB + (size_t)r * 1024 + k); },
        [&](int n, int k) { return *(const uint4*)(WOUT_T + (size_t)n * 1024 + k); },
        [&](int r, int c0, f32x4 v) {
            const f32x4 xv = *(const f32x4*)((r < NP ? p.x_prompt + (size_t)r * 1024 : p.x_sample + (size_t)(r - NP) * 1024) + c0);
            *(f32x4*)(T1 + (size_t)r * 1024 + c0) = xv * DN_ALPHA + v; }, ldsb);
    xcd_barrier(bar);

    for (int row = gw; row < NR; row += nw) {
        float tv[16]; float s = 0.f;
#pragma unroll
        for (int j = 0; j < 4; ++j) { const float4 t4 = *(const float4*)(T1 + (size_t)row * 1024 + j * 256 + lane * 4); tv[4 * j] = t4.x; tv[4 * j + 1] = t4.y; tv[4 * j + 2] = t4.z; tv[4 * j + 3] = t4.w; s += (t4.x + t4.y) + (t4.z + t4.w); }
        const float mu = wave_sum(s) * (1.0f / 1024.0f);
        float q = 0.f;
#pragma unroll
        for (int j = 0; j < 16; ++j) { const float d = tv[j] - mu; q += d * d; }
        const float rstd = 1.0f / sqrtf(wave_sum(q) * (1.0f / 1024.0f) + LN_EPS);
#pragma unroll
        for (int j = 0; j < 4; ++j) {
            const int c = j * 256 + lane * 4;
            const float4 g4 = *(const float4*)(p.ln1_g + c), b4 = *(const float4*)(p.ln1_b + c);
            f32x4 o; o[0] = (tv[4 * j] - mu) * rstd * g4.x + b4.x; o[1] = (tv[4 * j + 1] - mu) * rstd * g4.y + b4.y; o[2] = (tv[4 * j + 2] - mu) * rstd * g4.z + b4.z; o[3] = (tv[4 * j + 3] - mu) * rstd * g4.w + b4.w;
            *(f32x4*)(X1 + (size_t)row * 1024 + c) = o;
            store_bf16x4(X1B + (size_t)row * 1024 + c, o);
        }
    }
    xcd_barrier(bar);

    gemm_bf16<128>(NR, 2048, 1024,
        [&](int r, int k) { return *(const uint4*)(X1B + (size_t)r * 1024 + k); },
        [&](int n, int k) { return *(const uint4*)(PWQ_T + (size_t)n * 1024 + k); },
        [&](int r, int c0, f32x4 v) { store_bf16x4(QPB + (size_t)r * 2048 + c0, v); }, ldsb);
    xcd_barrier(bar);

    for (int it = blockIdx.x; it < 513 * 8; it += gridDim.x) { __syncthreads(); peer_score_topk_item(p, it >> 3, it & 7, ldsb); }
    xcd_barrier(bar);

    for (int row = gw; row < NR; row += nw) peer_expert_wave(p, row, ldsb + w * 3072, lane);
}

extern "C" void kernel_launch(void* const* d_in, const int* in_sizes, int n_in, void* d_out, int out_size, void* d_ws, size_t ws_size, hipStream_t stream) {
    static int grid = 0;
    if (grid == 0) {
        if (n_in != 32 || (size_t)out_size != O_END || ws_size < WS_END) {
            fprintf(stderr, "kernel_launch: unexpected sizes n_in %d out %d ws %zu (need %zu)\n", n_in, out_size, ws_size, (size_t)WS_END); grid = -1; return; }
        int dev = 0, cus = 0, per_cu = 0;
        if (hipGetDevice(&dev) != hipSuccess || hipDeviceGetAttribute(&cus, hipDeviceAttributeMultiprocessorCount, dev) != hipSuccess) { grid = -1; return; }
        if (hipFuncSetAttribute((const void*)fwd_kernel, hipFuncAttributeMaxDynamicSharedMemorySize, LDS_BYTES) != hipSuccess) { fprintf(stderr, "hipFuncSetAttribute failed\n"); grid = -1; return; }
        if (hipOccupancyMaxActiveBlocksPerMultiprocessor(&per_cu, (const void*)fwd_kernel, NTHREADS, LDS_BYTES) != hipSuccess || per_cu < 1) { fprintf(stderr, "occupancy query failed (%d)\n", per_cu); (void)hipGetLastError(); per_cu = 1; }
        if (per_cu > 2) per_cu = 2;
        grid = cus * per_cu;
    }
    if (grid < 0) return;
    (void)hipMemsetAsync((char*)d_ws + WS_BAR, 0, XCD_BAR_WORDS * sizeof(unsigned), stream);
    Params p{};
    p.x_prompt = (const float*)d_in[0]; p.x_sample = (const float*)d_in[1]; p.cache_cmp = (const float*)d_in[2]; p.cache_slc = (const float*)d_in[3];
    p.page_table = (const int*)d_in[4]; p.state_win = (const float*)d_in[5]; p.state_C = (const float*)d_in[6]; p.state_n = (const float*)d_in[7];
    p.state_m = (const float*)d_in[8]; p.state_conv = (const float*)d_in[9]; p.w_in = (const float*)d_in[10]; p.conv_w = (const float*)d_in[11];
    p.conv_b = (const float*)d_in[12]; p.wq = (const float*)d_in[13]; p.wk = (const float*)d_in[14]; p.gate_bias = (const float*)d_in[15];
    p.norm_g = (const float*)d_in[16]; p.cmp_pe = (const float*)d_in[17]; p.cmp_w1 = (const float*)d_in[18]; p.cmp_w2 = (const float*)d_in[19];
    p.rel_bias = (const float*)d_in[20]; p.w_up_m = (const float*)d_in[21]; p.w_up_n = (const float*)d_in[22]; p.w_out = (const float*)d_in[23];
    p.ln1_g = (const float*)d_in[24]; p.ln1_b = (const float*)d_in[25]; p.ln2_g = (const float*)d_in[26]; p.ln2_b = (const float*)d_in[27];
    p.peer_wq = (const float*)d_in[28]; p.peer_sub = (const float*)d_in[29]; p.peer_u = (const float*)d_in[30]; p.peer_v = (const float*)d_in[31];
    p.out = (float*)d_out; p.ws = (unsigned char*)d_ws;
    hipLaunchKernelGGL(fwd_kernel, dim3(grid), dim3(NTHREADS), LDS_BYTES, stream, p);
}
```

```cpp
#include <hip/hip_runtime.h>
#include <stdint.h>
#include <cstdio>

#define DEV __device__ __forceinline__

constexpr int DM = 1024;
constexpr int BP = 16, TP = 2048, BS = 32;
constexpr int NP = BP * TP;
constexpr int NR = NP + BS;
constexpr int MP = 32896;
constexpr int IN_DIM = 4896;
constexpr int C_U = 0, C_V = 512, C_O = 1024, C_I = 1536, C_F = 1540, C_Q = 1544, C_KC = 2056, C_KS = 2312, C_KW = 2568, C_G = 2824, C_GM = 2848, C_GN = 3872;
constexpr int PAST = 16384;
constexpr float NEGF = -1e30f;
constexpr float DN_ALPHA = 1.189207115002721f;
constexpr float LN_EPS = 1e-5f;
constexpr float LOG2E = 1.4426950408889634f;

constexpr size_t O_Y = 0;
constexpr size_t O_CMPP = (size_t)NR * DM;
constexpr size_t O_CMPS = O_CMPP + (size_t)NP * 256;
constexpr size_t O_SLCP = O_CMPS + (size_t)BS * 256;
constexpr size_t O_SLCS = O_SLCP + (size_t)NP * 256;
constexpr size_t O_WINP = O_SLCS + (size_t)BS * 256;
constexpr size_t O_WINS = O_WINP + (size_t)BP * 512 * 256;
constexpr size_t O_CP = O_WINS + (size_t)BS * 512 * 256;
constexpr size_t O_CS = O_CP + (size_t)BP * 4 * 128 * 128;
constexpr size_t O_NP = O_CS + (size_t)BS * 4 * 128 * 128;
constexpr size_t O_NS = O_NP + (size_t)BP * 4 * 128;
constexpr size_t O_MP = O_NS + (size_t)BS * 4 * 128;
constexpr size_t O_MS = O_MP + (size_t)BP * 4;
constexpr size_t O_CVP = O_MS + (size_t)BS * 4;
constexpr size_t O_CVS = O_CVP + (size_t)BP * 3 * 512;
constexpr size_t O_END = O_CVS + (size_t)BS * 3 * 512;
static_assert(O_END == 59916480, "output size");

constexpr size_t al256(size_t x) { return (x + 255) & ~(size_t)255; }
constexpr size_t WS_BAR = 0;
constexpr size_t WS_Z = 16384;
constexpr size_t WS_QK = al256(WS_Z + (size_t)MP * IN_DIM * 4);
constexpr size_t WS_HRAW = al256(WS_QK + (size_t)MP * 1024 * 4);
constexpr size_t WS_MOUTB = al256(WS_HRAW + (size_t)MP * 512 * 4);
constexpr size_t WS_NOUTB = al256(WS_MOUTB + (size_t)MP * 512 * 2);
constexpr size_t WS_HIDPB = al256(WS_NOUTB + (size_t)MP * 512 * 2);
constexpr size_t WS_KCP = al256(WS_HIDPB + (size_t)2 * 4096 * 64 * 2);
constexpr size_t WS_HIDSB = al256(WS_KCP + 256);
constexpr size_t WS_KCS = al256(WS_HIDSB + (size_t)2 * 65536 * 64 * 2);
constexpr size_t WS_MIX = al256(WS_KCS + (size_t)2 * 65536 * 64 * 4);
constexpr size_t WS_MIXB = al256(WS_MIX + (size_t)MP * 1024 * 4);
constexpr size_t WS_T1 = al256(WS_MIXB + (size_t)MP * 1024 * 2);
constexpr size_t WS_X1 = al256(WS_T1 + (size_t)MP * 1024 * 4);
constexpr size_t WS_X1B = al256(WS_X1 + (size_t)MP * 1024 * 4);
constexpr size_t WS_QPB = al256(WS_X1B + (size_t)MP * 1024 * 2);
constexpr size_t WS_S = al256(WS_QPB + (size_t)MP * 2048 * 2);
constexpr size_t WS_PIDX = al256(WS_S + (size_t)MP * 2048 * 4);
constexpr size_t WS_PG = al256(WS_PIDX + (size_t)MP * 128 * 4);
constexpr size_t WS_CONVB = al256(WS_PG + (size_t)MP * 128 * 4);
constexpr size_t WS_XB = al256(WS_CONVB + (size_t)MP * 512 * 2);
constexpr size_t WS_WIN_T = al256(WS_XB + (size_t)MP * 1024 * 2);
constexpr size_t WS_WUPM_T = al256(WS_WIN_T + (size_t)IN_DIM * 1024 * 2);
constexpr size_t WS_WUPN_T = al256(WS_WUPM_T + (size_t)1024 * 512 * 2);
constexpr size_t WS_WOUT_T = al256(WS_WUPN_T + (size_t)1024 * 512 * 2);
constexpr size_t WS_PWQ_T = al256(WS_WOUT_T + (size_t)1024 * 1024 * 2);
constexpr size_t WS_WQK_T = al256(WS_PWQ_T + (size_t)2048 * 1024 * 2);
constexpr size_t WS_W1_T = al256(WS_WQK_T + (size_t)4 * 256 * 128 * 2);
constexpr size_t WS_W2_T = al256(WS_W1_T + (size_t)2 * 64 * 2048 * 2);
constexpr size_t WS_SUBK = al256(WS_W2_T + (size_t)2 * 64 * 64 * 2);
constexpr size_t WS_ZB = al256(WS_SUBK + (size_t)2 * 128 * 128 * 2);
constexpr size_t WS_VTS = al256(WS_ZB + (size_t)MP * IN_DIM * 2);
constexpr size_t WS_VTW = al256(WS_VTS + (size_t)16 * 2 * 64 * 2048 * 2);
constexpr size_t WS_KCB = al256(WS_VTW + (size_t)16 * 2 * 64 * 2048 * 2);
constexpr size_t WS_VTC = al256(WS_KCB + (size_t)16 * 2 * 128 * 64 * 2);
constexpr size_t WS_NOUTF = al256(WS_VTC + (size_t)16 * 2 * 64 * 128 * 2);
constexpr size_t WS_U8 = al256(WS_NOUTF + (size_t)NP * 512 * 4);
constexpr size_t WS_V8 = al256(WS_U8 + (size_t)16384 * 1024);
constexpr size_t WS_QB = al256(WS_V8 + (size_t)16384 * 1024);
constexpr size_t WS_KB = al256(WS_QB + (size_t)MP * 512 * 2);
constexpr size_t WS_KTB = al256(WS_KB + (size_t)MP * 512 * 2);
constexpr size_t WS_VTM = al256(WS_KTB + (size_t)16 * 512 * 2048 * 2);
constexpr size_t WS_KCSB = al256(WS_VTM + (size_t)16 * 512 * 2048 * 2);
constexpr size_t WS_VTCS = al256(WS_KCSB + (size_t)32 * 2 * 1024 * 64 * 2);
constexpr size_t WS_END = al256(WS_VTCS + (size_t)32 * 2 * 64 * 1024 * 2);

static_assert(WS_END <= 2684354560ull, "workspace too large");
constexpr int LDS_BYTES = 73728;
constexpr int NTHREADS = 256;

struct Params {
    const float* x_prompt; const float* x_sample; const float* cache_cmp; const float* cache_slc; const int* page_table;
    const float* state_win; const float* state_C; const float* state_n; const float* state_m; const float* state_conv;
    const float* w_in; const float* conv_w; const float* conv_b; const float* wq; const float* wk; const float* gate_bias; const float* norm_g;
    const float* cmp_pe; const float* cmp_w1; const float* cmp_w2; const float* rel_bias; const float* w_up_m; const float* w_up_n; const float* w_out;
    const float* ln1_g; const float* ln1_b; const float* ln2_g; const float* ln2_b; const float* peer_wq; const float* peer_sub; const float* peer_u; const float* peer_v;
    float* out; unsigned char* ws;
};

#define XB_TMO      128
#define XB_XCNT(j)  (256  + 64 * (j))
#define XB_XSUB(j)  (1280 + 64 * (j))
#define XB_XGEN(j)  (2304 + 64 * (j))
#define XB_TOP      3328
#define XB_TOPGEN   3392
#define XCD_BAR_WORDS 3456
#define XB_SPIN_CAP (1u << 22)
#define LAS __attribute__((address_space(3)))

__device__ __forceinline__ unsigned xb_ld(unsigned* p)              { return __hip_atomic_load(p, __ATOMIC_RELAXED, __HIP_MEMORY_SCOPE_AGENT); }
__device__ __forceinline__ unsigned xb_add(unsigned* p, unsigned v) { return __hip_atomic_fetch_add(p, v, __ATOMIC_RELAXED, __HIP_MEMORY_SCOPE_AGENT); }
__device__ __forceinline__ unsigned xb_xcc_id() { return (unsigned)__builtin_amdgcn_s_getreg((3 << 11) | 20) & 0xFu; }
#define XB_SPIN(cond, bar) do { unsigned _sp = 0; while (cond) { __builtin_amdgcn_s_sleep(1); \
    if ((++_sp & 255u) == 0u) { if (xb_ld(&(bar)[XB_TMO])) break; if (_sp > XB_SPIN_CAP) { atomicAdd(&(bar)[XB_TMO], 1u); break; } } } } while (0)

struct XcdBarrier { unsigned* bar; unsigned x; volatile LAS unsigned* st; };

__device__ __forceinline__ XcdBarrier xcd_barrier_post(unsigned* bar, volatile LAS unsigned* st) {
    XcdBarrier b; b.bar = bar; b.x = xb_xcc_id(); b.st = st;
    if (threadIdx.x == 0) (void)xb_add(&bar[XB_XCNT(b.x)], 1u);
    return b;
}
__device__ __forceinline__ void xcd_barrier_complete(unsigned* bar, unsigned x, unsigned& nloc, unsigned& nx) {
    const unsigned G = gridDim.x * gridDim.y * gridDim.z;
    unsigned sum, cnt, mine, sp = 0u;
    for (;;) {
        sum = 0u; cnt = 0u; mine = 0u;
#pragma unroll
        for (unsigned j = 0; j < 16; ++j) { const unsigned c = xb_ld(&bar[XB_XCNT(j)]); sum += c; cnt += (c > 0u) ? 1u : 0u; mine = (j == x) ? c : mine; }
        if (sum == G) break;
        __builtin_amdgcn_s_sleep(1);
        if ((++sp & 255u) == 0u) { if (xb_ld(&bar[XB_TMO])) break; if (sp > XB_SPIN_CAP) { atomicAdd(&bar[XB_TMO], 1u); break; } }
    }
    nloc = mine > 0u ? mine : 1u; nx = cnt > 0u ? cnt : 1u;
}
__device__ __forceinline__ void xcd_barrier(const XcdBarrier& b) {
    asm volatile("s_waitcnt vmcnt(0)" ::: "memory");
    __syncthreads();
    if (threadIdx.x == 0) {
        unsigned* bar = b.bar;
        __builtin_amdgcn_s_waitcnt(0);
        unsigned nloc = b.st[0], nx = b.st[1];
        if (nloc == 0u) { xcd_barrier_complete(bar, b.x, nloc, nx); b.st[0] = nloc; b.st[1] = nx; }
        const unsigned old = xb_add(&bar[XB_XSUB(b.x)], 1u);
        const unsigned gen = old / nloc;
        if (old + 1u == (gen + 1u) * nloc) {
            __builtin_amdgcn_fence(__ATOMIC_RELEASE, "agent");
            asm volatile("s_waitcnt vmcnt(0)" ::: "memory");
            const unsigned og = xb_add(&bar[XB_TOP], 1u);
            const unsigned tg = og / nx;
            if (og + 1u == (tg + 1u) * nx) xb_add(&bar[XB_TOPGEN], 1u);
            else XB_SPIN(xb_ld(&bar[XB_TOPGEN]) == tg, bar);
            __builtin_amdgcn_fence(__ATOMIC_ACQUIRE, "agent");
            xb_add(&bar[XB_XGEN(b.x)], 1u);
            asm volatile("s_waitcnt vmcnt(0)" ::: "memory");
        } else {
            XB_SPIN(xb_ld(&bar[XB_XGEN(b.x)]) == gen, bar);
            __builtin_amdgcn_fence(__ATOMIC_ACQUIRE, "agent");
            asm volatile("s_waitcnt vmcnt(0)" ::: "memory");
        }
    }
    __syncthreads();
}

typedef float f32x4 __attribute__((ext_vector_type(4)));

__device__ const unsigned char REL_LUT[128] = {
    0, 1, 2, 3, 4, 5, 6, 7, 8, 9, 10, 11, 12, 13, 14, 15, 16, 16, 16, 17, 17, 18, 18, 18, 19, 19, 19, 20, 20, 20, 20, 21, 21, 21, 21, 22, 22, 22, 22, 22,
    23, 23, 23, 23, 23, 23, 24, 24, 24, 24, 24, 24, 25, 25, 25, 25, 25, 25, 25, 26, 26, 26, 26, 26, 26, 26, 26, 27, 27, 27, 27, 27, 27, 27, 27, 27, 27,
    28, 28, 28, 28, 28, 28, 28, 28, 28, 28, 29, 29, 29, 29, 29, 29, 29, 29, 29, 29, 29, 29, 30, 30, 30, 30, 30, 30, 30, 30, 30, 30, 30, 30, 30, 30,
    31, 31, 31, 31, 31, 31, 31, 31, 31, 31, 31, 31, 31, 31, 31};
DEV int rel_bucket(int n) { return n < 128 ? (int)REL_LUT[n < 0 ? 0 : n] : 31; }

DEV float sigmoidf_(float x) { return 1.0f / (1.0f + expf(-x)); }
DEV float gelu_tanh(float x) { return 0.5f * x * (1.0f + tanhf(0.7978845608028654f * (x + 0.044715f * x * x * x))); }
DEV float log_sigmoid(float x) { return x >= 0.f ? -log1pf(expf(-x)) : x - log1pf(expf(x)); }
DEV void wave_sync() { asm volatile("s_waitcnt lgkmcnt(0)" ::: "memory"); __builtin_amdgcn_wave_barrier(); asm volatile("" ::: "memory"); }
DEV float wave_sum(float v) {
#pragma unroll
    for (int o = 32; o >= 1; o >>= 1) v += __shfl_xor(v, o);
    return v;
}
DEV float wave_max(float v) {
#pragma unroll
    for (int o = 32; o >= 1; o >>= 1) v = fmaxf(v, __shfl_xor(v, o));
    return v;
}

typedef unsigned short bf16_t;
typedef short bf16x8 __attribute__((ext_vector_type(8)));
typedef float f32x2_ __attribute__((ext_vector_type(2)));
typedef __bf16 bf16x2_ __attribute__((ext_vector_type(2)));
DEV unsigned cvt_pk_bf16(float lo, float hi) { const f32x2_ v = {lo, hi}; return __builtin_bit_cast(unsigned, __builtin_convertvector(v, bf16x2_)); }
DEV float bf_lo(unsigned w) { return __uint_as_float(w << 16); }
DEV float bf_hi(unsigned w) { return __uint_as_float(w & 0xffff0000u); }
DEV uint4 pack8(const float* f) { uint4 r; r.x = cvt_pk_bf16(f[0], f[1]); r.y = cvt_pk_bf16(f[2], f[3]); r.z = cvt_pk_bf16(f[4], f[5]); r.w = cvt_pk_bf16(f[6], f[7]); return r; }
DEV void store_bf16x4(bf16_t* p, f32x4 v) { uint2 w; w.x = cvt_pk_bf16(v[0], v[1]); w.y = cvt_pk_bf16(v[2], v[3]); *(uint2*)p = w; }

DEV void transpose_to_bf16(const float* __restrict__ src, const int K, const int N, bf16_t* __restrict__ dst, const size_t gt, const size_t nt) {
    const size_t items = (size_t)N * (K >> 3);
    for (size_t id = gt; id < items; id += nt) {
        const int n = (int)(id % N), k8 = (int)(id / N) * 8;
        float f[8];
#pragma unroll
        for (int i = 0; i < 8; ++i) f[i] = src[(size_t)(k8 + i) * N + n];
        *(uint4*)(dst + (size_t)n * K + k8) = pack8(f);
    }
}

template <int BN, class LA, class LB, class EF>
DEV void gemm_bf16(const int M, const int N, const int K, LA la, LB lb, EF ef, unsigned char* lds) {
    constexpr int TJ = BN / 32;
    constexpr int NB = BN / 32;
    constexpr int LDR = 144;
    const int tid = threadIdx.x, lane = tid & 63, w = tid >> 6, wm = w >> 1, wn = w & 1;
    const int tm = (M + 127) >> 7, tn = (N + BN - 1) / BN;
    unsigned char* As = lds;
    unsigned char* Bs = lds + 128 * LDR;
    const int lr = lane & 15, lq = lane >> 4;
    for (int tile = blockIdx.x; tile < tm * tn; tile += gridDim.x) {
        const int bm = (tile / tn) * 128, bn = (tile % tn) * BN;
        f32x4 acc[4][TJ];
#pragma unroll
        for (int i = 0; i < 4; ++i)
#pragma unroll
            for (int j = 0; j < TJ; ++j) acc[i][j] = (f32x4){0.f, 0.f, 0.f, 0.f};
        uint4 ra[4], rb[NB];
        int arow[4], brow[NB];
#pragma unroll
        for (int i = 0; i < 4; ++i) { const int r = bm + ((tid + 256 * i) >> 3); arow[i] = r < M ? r : M - 1; }
#pragma unroll
        for (int i = 0; i < NB; ++i) { const int n = bn + ((tid + 256 * i) >> 3); brow[i] = n < N ? n : N - 1; }
        const int kc = (tid & 7) * 8;
#pragma unroll
        for (int i = 0; i < 4; ++i) ra[i] = la(arow[i], kc);
#pragma unroll
        for (int i = 0; i < NB; ++i) rb[i] = lb(brow[i], kc);
        for (int k0_ = 0; k0_ < K; k0_ += 64) {
            int k0 = k0_; asm volatile("" : "+v"(k0));
            __syncthreads();
#pragma unroll
            for (int i = 0; i < 4; ++i) *(uint4*)(As + ((tid + 256 * i) >> 3) * LDR + (tid & 7) * 16) = ra[i];
#pragma unroll
            for (int i = 0; i < NB; ++i) *(uint4*)(Bs + ((tid + 256 * i) >> 3) * LDR + (tid & 7) * 16) = rb[i];
            __syncthreads();
            if (k0_ + 64 < K) {
#pragma unroll
                for (int i = 0; i < 4; ++i) ra[i] = la(arow[i], k0 + 64 + kc);
#pragma unroll
                for (int i = 0; i < NB; ++i) rb[i] = lb(brow[i], k0 + 64 + kc);
            }
#pragma unroll
            for (int kk = 0; kk < 2; ++kk) {
                bf16x8 a[4], b[TJ];
#pragma unroll
                for (int i = 0; i < 4; ++i) a[i] = *(const bf16x8*)(As + (wm * 64 + i * 16 + lr) * LDR + kk * 64 + lq * 16);
#pragma unroll
                for (int j = 0; j < TJ; ++j) b[j] = *(const bf16x8*)(Bs + (wn * (BN / 2) + j * 16 + lr) * LDR + kk * 64 + lq * 16);
#pragma unroll
                for (int i = 0; i < 4; ++i)
#pragma unroll
                    for (int j = 0; j < TJ; ++j) acc[i][j] = __builtin_amdgcn_mfma_f32_16x16x32_bf16(b[j], a[i], acc[i][j], 0, 0, 0);
            }
        }
#pragma unroll
        for (int i = 0; i < 4; ++i)
#pragma unroll
            for (int j = 0; j < TJ; ++j) {
                const int r = bm + wm * 64 + i * 16 + lr, c0 = bn + wn * (BN / 2) + j * 16 + lq * 4;
                if (r < M && c0 < N) ef(r, c0, acc[i][j]);
            }
    }
}

template <class KeyF>
DEV void wave_attn(const float* qs, float* sb, const int nkeys, KeyF keyf, const float* __restrict__ rel_bias, const int hkv, const int lane, float (&o)[4]) {
    float mx[4] = {NEGF, NEGF, NEGF, NEGF};
    for (int base = 0; base < nkeys; base += 64) {
        asm volatile("" ::: "memory");
        const int idx = base + lane;
        const float* kp = nullptr; const float* vp = nullptr; int dist = 0;
        bool valid = false;
        if (idx < nkeys) valid = keyf(idx, kp, vp, dist);
        float sc[4] = {0.f, 0.f, 0.f, 0.f};
        if (valid) {
#pragma unroll 1
            for (int d4 = 0; d4 < 16; ++d4) {
                asm volatile("" ::: "memory");
                const float4 kv = ((const float4*)kp)[d4];
#pragma unroll
                for (int g = 0; g < 4; ++g) {
                    const float4 qv = *(const float4*)(qs + g * 64 + d4 * 4);
                    sc[g] += qv.x * kv.x + qv.y * kv.y + qv.z * kv.z + qv.w * kv.w;
                }
            }
            const int bk = rel_bucket(dist);
#pragma unroll
            for (int g = 0; g < 4; ++g) sc[g] += rel_bias[bk * 8 + hkv * 4 + g];
        }
#pragma unroll
        for (int g = 0; g < 4; ++g) {
            const float v = valid ? sc[g] : NEGF;
            if (idx < nkeys) sb[g * 1024 + idx] = v;
            mx[g] = fmaxf(mx[g], v);
        }
    }
    float inv[4];
#pragma unroll
    for (int g = 0; g < 4; ++g) mx[g] = wave_max(mx[g]);
    wave_sync();
    float sum[4] = {0.f, 0.f, 0.f, 0.f};
    for (int idx = lane; idx < nkeys; idx += 64) {
#pragma unroll
        for (int g = 0; g < 4; ++g) {
            const float v = sb[g * 1024 + idx];
            const float e = (v > -1e29f) ? expf(v - mx[g]) : 0.f;
            sb[g * 1024 + idx] = e;
            sum[g] += e;
        }
    }
#pragma unroll
    for (int g = 0; g < 4; ++g) { sum[g] = wave_sum(sum[g]); inv[g] = 1.0f / fmaxf(sum[g], 1e-30f); }
    for (int idx = lane; idx < nkeys; idx += 64) {
#pragma unroll
        for (int g = 0; g < 4; ++g) sb[g * 1024 + idx] *= inv[g];
    }
    wave_sync();
#pragma unroll
    for (int g = 0; g < 4; ++g) o[g] = 0.f;
    for (int idx = 0; idx < nkeys; ++idx) {
        const float p0 = sb[idx], p1 = sb[1024 + idx], p2 = sb[2048 + idx], p3 = sb[3072 + idx];
        if (p0 + p1 + p2 + p3 == 0.f) continue;
        const float* kp = nullptr; const float* vp = nullptr; int dist = 0;
        (void)keyf(idx, kp, vp, dist);
        const float vv = vp[lane];
        o[0] += p0 * vv; o[1] += p1 * vv; o[2] += p2 * vv; o[3] += p3 * vv;
    }
}

DEV void nsa_item(const Params& p, const int row, const int hkv, float* wl, const int lane) {
    float* qs = wl; float* sb = wl + 256; int* sel = (int*)(wl + 256 + 4096);
    const float* Z = (const float*)(p.ws + WS_Z);
    bf16_t* NOUT = (bf16_t*)(p.ws + WS_NOUTB);
    const float* KCP = (const float*)(p.ws + WS_KCP);
    const float* KCS = (const float*)(p.ws + WS_KCS);
    const bool pr = row < NP;
    const int b = pr ? (row >> 11) : (row - NP);
    const int t = pr ? (row & 2047) : 0;
    const int qpos = pr ? t : PAST;
    const float* zrow = Z + (size_t)row * IN_DIM;
    wave_sync();
    for (int i = lane; i < 256; i += 64) qs[i] = zrow[C_Q + hkv * 256 + i] * 0.125f;
    wave_sync();
    float o[4];
    float gate[3][4];
#pragma unroll
    for (int br = 0; br < 3; ++br)
#pragma unroll
        for (int g = 0; g < 4; ++g) gate[br][g] = sigmoidf_(zrow[C_G + br * 8 + hkv * 4 + g]);
    bf16_t* nrow = NOUT + (size_t)row * 512 + hkv * 256;
    float res[4];
    const int nkc = pr ? 127 : 1023;
    {
        const float* kbase = pr ? (KCP + ((size_t)(b * 128) * 2 + hkv) * 64) : (KCS + ((size_t)(b * 1024) * 2 + hkv) * 64);
        const size_t plane = pr ? (size_t)4096 * 64 : (size_t)65536 * 64;
        auto keyf = [&](int idx, const float*& kp, const float*& vp, int& dist) -> bool {
            kp = kbase + (size_t)idx * 128; vp = kp + plane; dist = qpos - (16 * idx + 31); return dist >= 0; };
        wave_attn(qs, sb, nkc, keyf, p.rel_bias, hkv, lane, o);
#pragma unroll
        for (int g = 0; g < 4; ++g) res[g] = gate[0][g] * o[g];
    }
    const int nblk = pr ? 32 : 257;
    for (int i = lane; i < nkc; i += 64) sb[i] = ((sb[i] + sb[1024 + i]) + sb[2048 + i]) + sb[3072 + i];
    wave_sync();
    {
        const int cur = qpos >> 6;
        for (int blk = lane; blk < nblk; blk += 64) {
            float s = 0.f;
#pragma unroll
            for (int cc = 0; cc < 4; ++cc) {
                const int c = 4 * blk + cc;
                const float a0 = (c < nkc) ? sb[c] : 0.f;
                const float a1 = (c >= 1 && c - 1 < nkc) ? sb[c - 1] : 0.f;
                s += a0 + a1;
            }
            const bool causal = blk * 64 <= qpos;
            const bool forced = (blk == 0) || (blk == cur) || (blk == cur - 1);
            sb[1024 + blk] = causal ? (forced ? 1e4f : s) : NEGF;
        }
        wave_sync();
        for (int blk = lane; blk < nblk; blk += 64) {
            const float my = sb[1024 + blk];
            int rank = 0;
            for (int j = 0; j < nblk; ++j) { const float o2 = sb[1024 + j]; rank += ((o2 > my) || (o2 == my && j < blk)) ? 1 : 0; }
            if (rank < 16) sel[rank] = (blk * 64 <= qpos) ? blk : -1;
        }
        wave_sync();
    }
    {
        const float* zb = Z + (size_t)(pr ? b * 2048 : 0) * IN_DIM;
        auto keyf = [&](int idx, const float*& kp, const float*& vp, int& dist) -> bool {
            const int blk = sel[idx >> 6], s = idx & 63;
            if (blk < 0) return false;
            const int kpos = blk * 64 + s;
            if (kpos > qpos) return false;
            dist = qpos - kpos;
            if (pr) { kp = zb + (size_t)kpos * IN_DIM + C_KS + hkv * 64; }
            else if (blk < 256) { const int page = p.page_table[b * 128 + (blk >> 1)]; kp = p.cache_slc + ((size_t)page * 128 + (blk & 1) * 64 + s) * 256 + hkv * 64; }
            else { kp = zrow + C_KS + hkv * 64; }
            vp = kp + 128; return true; };
        wave_attn(qs, sb, 1024, keyf, p.rel_bias, hkv, lane, o);
#pragma unroll
        for (int g = 0; g < 4; ++g) res[g] += gate[1][g] * o[g];
    }
    {
        const float* zb = Z + (size_t)(pr ? b * 2048 : 0) * IN_DIM;
        const int nk = pr ? ((t + 1 < 512) ? t + 1 : 512) : 512;
        auto keyf = [&](int idx, const float*& kp, const float*& vp, int& dist) -> bool {
            if (pr) { const int kpos = t - nk + 1 + idx; dist = t - kpos; kp = zb + (size_t)kpos * IN_DIM + C_KW + hkv * 64; }
            else { const int j = idx + 1; dist = 512 - j; kp = (j < 512) ? (p.state_win + ((size_t)b * 512 + j) * 256 + hkv * 64) : (zrow + C_KW + hkv * 64); }
            vp = kp + 128; return true; };
        wave_attn(qs, sb, nk, keyf, p.rel_bias, hkv, lane, o);
#pragma unroll
        for (int g = 0; g < 4; ++g) res[g] += gate[2][g] * o[g];
    }
#pragma unroll
    for (int g = 0; g < 4; ++g) nrow[g * 64 + lane] = (bf16_t)(cvt_pk_bf16(res[g], 0.f) & 0xffffu);
}

DEV void mlstm_scan_item(const Params& p, const int item, float* lds) {
    const int tid = threadIdx.x, v = tid >> 1, kh = tid & 1;
    const int seq = item >> 2, h = item & 3;
    const bool pr = seq < 16; const int b = pr ? seq : seq - 16;
    const int T = pr ? 2048 : 1; const int row0 = pr ? b * 2048 : NP + b;
    const float* Z = (const float*)(p.ws + WS_Z);
    const float* QK = (const float*)(p.ws + WS_QK);
    float* HRAW = (float*)(p.ws + WS_HRAW);
    float C[64], n[64]; float m;
    if (pr) {
#pragma unroll
        for (int j = 0; j < 64; ++j) { C[j] = 0.f; n[j] = 0.f; }
        m = 0.f;
    } else {
        const float* c0 = p.state_C + (((size_t)(b * 4 + h) * 128 + v) * 128 + kh * 64);
        const float* n0 = p.state_n + ((size_t)(b * 4 + h) * 128 + kh * 64);
#pragma unroll
        for (int j = 0; j < 64; ++j) { C[j] = c0[j]; n[j] = n0[j]; }
        m = p.state_m[b * 4 + h];
    }
    const float gb_i = p.gate_bias[h], gb_f = p.gate_bias[4 + h];
    auto load_tok = [&](int t, float* dst) {
        const size_t r = (size_t)(row0 + t);
        dst[tid] = QK[r * 1024 + h * 256 + tid];
        if (tid < 128) dst[256 + tid] = Z[r * IN_DIM + C_V + h * 128 + tid];
        if (tid == 128) dst[384] = Z[r * IN_DIM + C_I + h] + gb_i;
        if (tid == 129) dst[385] = log_sigmoid(Z[r * IN_DIM + C_F + h] + gb_f);
    };
    __syncthreads();
    load_tok(0, lds);
    __syncthreads();
    for (int t = 0; t < T; ++t) {
        const float* cur = lds + (t & 1) * 388;
        if (t + 1 < T) load_tok(t + 1, lds + ((t + 1) & 1) * 388);
        const float ig = cur[384], lf = cur[385];
        const float mn = fmaxf(lf + m, ig);
        const float fd = expf(lf + m - mn), iw = expf(ig - mn);
        const float vv = cur[256 + v] * iw;
        float nump = 0.f, denp = 0.f;
#pragma unroll
        for (int j = 0; j < 64; ++j) {
            const float kj = cur[128 + kh * 64 + j], qj = cur[kh * 64 + j];
            C[j] = fd * C[j] + vv * kj; n[j] = fd * n[j] + iw * kj;
            nump += C[j] * qj; denp += n[j] * qj;
        }
        nump += __shfl_xor(nump, 1); denp += __shfl_xor(denp, 1);
        const float hval = nump / fmaxf(fabsf(denp), expf(-mn));
        if (kh == 0) HRAW[(size_t)(row0 + t) * 512 + h * 128 + v] = hval;
        m = mn;
        __syncthreads();
    }
    float* co = p.out + (pr ? O_CP : O_CS) + (((size_t)(b * 4 + h) * 128 + v) * 128 + kh * 64);
#pragma unroll
    for (int j = 0; j < 64; ++j) co[j] = C[j];
    if (v == 0) {
        float* no = p.out + (pr ? O_NP : O_NS) + ((size_t)(b * 4 + h) * 128 + kh * 64);
#pragma unroll
        for (int j = 0; j < 64; ++j) no[j] = n[j];
    }
    if (tid == 0) p.out[(pr ? O_MP : O_MS) + b * 4 + h] = m;
}

DEV void peer_topk_item(const Params& p, const int row, const int h, const int lane) {
    const float* S = (const float*)(p.ws + WS_S) + (size_t)row * 2048 + h * 256;
    int* PIDX = (int*)(p.ws + WS_PIDX); float* PG = (float*)(p.ws + WS_PG);
    float ts[2]; int ti[2];
#pragma unroll
    for (int pp = 0; pp < 2; ++pp) {
        float v0 = S[pp * 128 + lane], v1 = S[pp * 128 + 64 + lane];
        float mys = 0.f; int myi = 0;
        for (int r = 0; r < 16; ++r) {
            float best = fmaxf(v0, v1); int bi = (v0 >= v1) ? lane : lane + 64;
#pragma unroll
            for (int off = 32; off >= 1; off >>= 1) {
                const float ob = __shfl_xor(best, off); const int oi = __shfl_xor(bi, off);
                if (ob > best || (ob == best && oi < bi)) { best = ob; bi = oi; }
            }
            if (lane == r) { mys = best; myi = bi; }
            if (bi == lane) v0 = -INFINITY;
            if (bi == lane + 64) v1 = -INFINITY;
        }
        ts[pp] = mys; ti[pp] = myi;
    }
    float cv[4];
#pragma unroll
    for (int jj = 0; jj < 4; ++jj) { const int c = lane * 4 + jj; cv[jj] = __shfl(ts[0], c >> 4) + __shfl(ts[1], c & 15); }
    float msc = 0.f; int mci = 0;
    for (int r = 0; r < 16; ++r) {
        float best = cv[0]; int bi = lane * 4;
#pragma unroll
        for (int jj = 1; jj < 4; ++jj) if (cv[jj] > best) { best = cv[jj]; bi = lane * 4 + jj; }
#pragma unroll
        for (int off = 32; off >= 1; off >>= 1) {
            const float ob = __shfl_xor(best, off); const int oi = __shfl_xor(bi, off);
            if (ob > best || (ob == best && oi < bi)) { best = ob; bi = oi; }
        }
        if (lane == r) { msc = best; mci = bi; }
#pragma unroll
        for (int jj = 0; jj < 4; ++jj) if (bi == lane * 4 + jj) cv[jj] = -INFINITY;
    }
    const int e = __shfl(ti[0], mci >> 4) * 128 + __shfl(ti[1], mci & 15);
    const float top = __shfl(msc, 0);
    float ex = (lane < 16) ? expf(msc - top) : 0.f;
    const float den = wave_sum(ex);
    if (lane < 16) { PIDX[(size_t)row * 128 + h * 16 + lane] = e; PG[(size_t)row * 128 + h * 16 + lane] = ex / den; }
}

DEV void peer_expert_item(const Params& p, const int row, float* lds) {
    const int tid = threadIdx.x, lane = tid & 63, w = tid >> 6;
    const float* X1 = (const float*)(p.ws + WS_X1) + (size_t)row * 1024;
    const int* PIDX = (const int*)(p.ws + WS_PIDX) + (size_t)row * 128;
    const float* PG = (const float*)(p.ws + WS_PG) + (size_t)row * 128;
    float4 x[4], acc[4];
#pragma unroll
    for (int j = 0; j < 4; ++j) { x[j] = *(const float4*)(X1 + j * 256 + lane * 4); acc[j] = make_float4(0.f, 0.f, 0.f, 0.f); }
    for (int k = 0; k < 32; ++k) {
        const int e = PIDX[w * 32 + k]; const float gk = PG[w * 32 + k];
        const float* ur = p.peer_u + (size_t)e * 1024; const float* vr = p.peer_v + (size_t)e * 1024;
        float d = 0.f;
#pragma unroll
        for (int j = 0; j < 4; ++j) { const float4 u = *(const float4*)(ur + j * 256 + lane * 4); d += u.x * x[j].x + u.y * x[j].y + u.z * x[j].z + u.w * x[j].w; }
        d = wave_sum(d);
        const float coef = gk * gelu_tanh(d);
#pragma unroll
        for (int j = 0; j < 4; ++j) { const float4 vv = *(const float4*)(vr + j * 256 + lane * 4);
            acc[j].x += coef * vv.x; acc[j].y += coef * vv.y; acc[j].z += coef * vv.z; acc[j].w += coef * vv.w; }
    }
    __syncthreads();
#pragma unroll
    for (int j = 0; j < 4; ++j) *(float4*)(lds + w * 1024 + j * 256 + lane * 4) = acc[j];
    __syncthreads();
    float tv[4]; float s = 0.f;
#pragma unroll
    for (int i = 0; i < 4; ++i) { const int c = tid * 4 + i; const float po = (lds[c] + lds[1024 + c]) + (lds[2048 + c] + lds[3072 + c]); tv[i] = DN_ALPHA * X1[c] + po; s += tv[i]; }
    float* red = lds + 4096;
    s = wave_sum(s);
    if (lane == 0) red[w] = s;
    __syncthreads();
    const float mu = (red[0] + red[1] + red[2] + red[3]) * (1.0f / 1024.0f);
    float q = 0.f;
#pragma unroll
    for (int i = 0; i < 4; ++i) { const float d = tv[i] - mu; q += d * d; }
    q = wave_sum(q);
    if (lane == 0) red[8 + w] = q;
    __syncthreads();
    const float var = (red[8] + red[9] + red[10] + red[11]) * (1.0f / 1024.0f);
    const float rstd = 1.0f / sqrtf(var + LN_EPS);
    float* y = p.out + O_Y + (size_t)row * 1024;
#pragma unroll
    for (int i = 0; i < 4; ++i) { const int c = tid * 4 + i; y[c] = (tv[i] - mu) * rstd * p.ln2_g[c] + p.ln2_b[c]; }
}

DEV void mlstm_chunk_item(const Params& p, const int item, unsigned char* lds) {
    int tid_ = threadIdx.x; asm volatile("" : "+v"(tid_));
    const int tid = tid_, lane = tid & 63, w = tid >> 6, lr = lane & 15, lq = lane >> 4;
    const int b = item >> 4, h = (item >> 2) & 3, vs = item & 3;
    bf16_t* Cl = (bf16_t*)lds;
    bf16_t* nl = (bf16_t*)(lds + 8704);
    float* uL = (float*)(lds + 8960); float* ML = uL + 64; float* scin = uL + 128; float* expm = uL + 192; float* wts = uL + 256; float* misc = uL + 320;
    const bf16_t* QB = (const bf16_t*)(p.ws + WS_QB) + (size_t)(b * 2048) * 512 + h * 128;
    const bf16_t* KB = (const bf16_t*)(p.ws + WS_KB) + (size_t)(b * 2048) * 512 + h * 128;
    const bf16_t* KTB = (const bf16_t*)(p.ws + WS_KTB) + (size_t)((b * 4 + h) * 128) * 2048;
    const bf16_t* VTM = (const bf16_t*)(p.ws + WS_VTM) + (size_t)(b * 512 + h * 128 + vs * 32) * 2048;
    const float* Z = (const float*)(p.ws + WS_Z);
    float* HRAW = (float*)(p.ws + WS_HRAW);
    const float gb_i = p.gate_bias[h], gb_f = p.gate_bias[4 + h];
    f32x4 Cm[2][2], nm[2];
#pragma unroll
    for (int i = 0; i < 2; ++i) { nm[i] = (f32x4){0.f, 0.f, 0.f, 0.f};
#pragma unroll
        for (int j = 0; j < 2; ++j) Cm[i][j] = (f32x4){0.f, 0.f, 0.f, 0.f}; }
    float m_prev = 0.f;
    __syncthreads();
    for (int i = tid; i < (8704 + 256) / 4; i += 256) ((unsigned*)lds)[i] = 0u;
    __syncthreads();
    for (int c = 0; c < 32; ++c) {
        const int t0 = c * 64;
        if (w == 0) {
            const size_t row = (size_t)(b * 2048 + t0 + lane);
            const float ig = Z[row * IN_DIM + C_I + h] + gb_i;
            const float lf = log_sigmoid(Z[row * IN_DIM + C_F + h] + gb_f);
            float bc = lf;
#pragma unroll
            for (int o = 1; o < 64; o <<= 1) { const float t = __shfl_up(bc, o); if (lane >= o) bc += t; }
            const float u = ig - bc;
            float pm = u;
#pragma unroll
            for (int o = 1; o < 64; o <<= 1) { const float t = __shfl_up(pm, o); if (lane >= o) pm = fmaxf(pm, t); }
            const float M = fmaxf(m_prev, pm);
            const float M63 = __shfl(M, 63), b63 = __shfl(bc, 63);
            uL[lane] = u; ML[lane] = M; scin[lane] = expf(m_prev - M); expm[lane] = expf(-(bc + M)); wts[lane] = expf(u - M63);
            if (lane == 0) { misc[0] = expf(m_prev - M63); misc[1] = b63 + M63; }
        }
        __syncthreads();
        {
            const size_t row_t = (size_t)(t0 + w * 16 + lr);
            bf16x8 Qf[4];
#pragma unroll
            for (int ks = 0; ks < 4; ++ks) Qf[ks] = *(const bf16x8*)(QB + row_t * 512 + ks * 32 + lq * 8);
            const float M_t = ML[w * 16 + lr], sc_in = scin[w * 16 + lr], em = expm[w * 16 + lr];
            f32x4 sw[4];
            float dsum = 0.f;
#pragma unroll
            for (int st = 0; st < 4; ++st) {
                f32x4 a = (f32x4){0.f, 0.f, 0.f, 0.f};
                if (st <= w) {
#pragma unroll
                    for (int ks = 0; ks < 4; ++ks) { const bf16x8 kf = *(const bf16x8*)(KB + (size_t)(t0 + st * 16 + lr) * 512 + ks * 32 + lq * 8); a = __builtin_amdgcn_mfma_f32_16x16x32_bf16(kf, Qf[ks], a, 0, 0, 0); }
#pragma unroll
                    for (int g = 0; g < 4; ++g) {
                        const int sl = st * 16 + lq * 4 + g, tl = w * 16 + lr;
                        const float wg = (sl <= tl) ? __builtin_amdgcn_exp2f((uL[sl] - M_t) * LOG2E) : 0.f;
                        a[g] *= wg; dsum += a[g];
                    }
                }
                sw[st] = a;
            }
            dsum += __shfl_xor(dsum, 16); dsum += __shfl_xor(dsum, 32);
            bf16x8 pf[2];
#pragma unroll
            for (int ks = 0; ks < 2; ++ks) {
                union { bf16x8 v; unsigned u[4]; } pk;
                pk.u[0] = cvt_pk_bf16(sw[2 * ks][0], sw[2 * ks][1]); pk.u[1] = cvt_pk_bf16(sw[2 * ks][2], sw[2 * ks][3]);
                pk.u[2] = cvt_pk_bf16(sw[2 * ks + 1][0], sw[2 * ks + 1][1]); pk.u[3] = cvt_pk_bf16(sw[2 * ks + 1][2], sw[2 * ks + 1][3]);
                pf[ks] = pk.v;
            }
            f32x4 dI = (f32x4){0.f, 0.f, 0.f, 0.f};
#pragma unroll
            for (int ks = 0; ks < 4; ++ks) { const bf16x8 nf = *(const bf16x8*)(nl + ks * 32 + lq * 8); dI = __builtin_amdgcn_mfma_f32_16x16x32_bf16(nf, Qf[ks], dI, 0, 0, 0); }
            const float den = sc_in * dI[0] + dsum;
            const float rdd = 1.0f / fmaxf(fabsf(den), em);
#pragma unroll
            for (int vt = 0; vt < 2; ++vt) {
                f32x4 ni = (f32x4){0.f, 0.f, 0.f, 0.f}, nI = (f32x4){0.f, 0.f, 0.f, 0.f};
#pragma unroll
                for (int ks = 0; ks < 2; ++ks) if (2 * ks <= w) {
                    union { bf16x8 v; uint2 hh[2]; } vf;
                    const bf16_t* vp = VTM + (size_t)(vt * 16 + lr) * 2048 + t0 + 32 * ks + lq * 4;
                    vf.hh[0] = *(const uint2*)vp; vf.hh[1] = *(const uint2*)(vp + 16);
                    ni = __builtin_amdgcn_mfma_f32_16x16x32_bf16(vf.v, pf[ks], ni, 0, 0, 0);
                }
#pragma unroll
                for (int ks = 0; ks < 4; ++ks) { const bf16x8 cf = *(const bf16x8*)(Cl + (vt * 16 + lr) * 136 + ks * 32 + lq * 8); nI = __builtin_amdgcn_mfma_f32_16x16x32_bf16(cf, Qf[ks], nI, 0, 0, 0); }
                const f32x4 hv = (nI * sc_in + ni) * rdd;
                *(f32x4*)(HRAW + ((size_t)(b * 2048) + row_t) * 512 + h * 128 + vs * 32 + vt * 16 + lq * 4) = hv;
            }
        }
        __syncthreads();
        {
            const float decay = misc[0];
            bf16x8 Af[2][2], Wf[2], Kt[2][2];
#pragma unroll
            for (int ks = 0; ks < 2; ++ks) {
                const float4 w0 = *(const float4*)(wts + ks * 32 + lq * 8), w1 = *(const float4*)(wts + ks * 32 + lq * 8 + 4);
                float wv[8] = {w0.x, w0.y, w0.z, w0.w, w1.x, w1.y, w1.z, w1.w};
                { union { bf16x8 v; uint4 q; } t; t.q = pack8(wv); Wf[ks] = t.v; }
#pragma unroll
                for (int vt = 0; vt < 2; ++vt) {
                    const uint4 raw = *(const uint4*)(VTM + (size_t)(vt * 16 + lr) * 2048 + t0 + ks * 32 + lq * 8);
                    float f[8] = {bf_lo(raw.x) * wv[0], bf_hi(raw.x) * wv[1], bf_lo(raw.y) * wv[2], bf_hi(raw.y) * wv[3], bf_lo(raw.z) * wv[4], bf_hi(raw.z) * wv[5], bf_lo(raw.w) * wv[6], bf_hi(raw.w) * wv[7]};
                    union { bf16x8 v; uint4 q; } t; t.q = pack8(f); Af[vt][ks] = t.v;
                }
#pragma unroll
                for (int kt = 0; kt < 2; ++kt) Kt[kt][ks] = *(const bf16x8*)(KTB + (size_t)((2 * w + kt) * 16 + lr) * 2048 + t0 + ks * 32 + lq * 8);
            }
#pragma unroll
            for (int kt = 0; kt < 2; ++kt) {
                nm[kt] = nm[kt] * decay;
#pragma unroll
                for (int ks = 0; ks < 2; ++ks) nm[kt] = __builtin_amdgcn_mfma_f32_16x16x32_bf16(Wf[ks], Kt[kt][ks], nm[kt], 0, 0, 0);
                if (lq == 0) nl[(2 * w + kt) * 16 + lr] = (bf16_t)(cvt_pk_bf16(nm[kt][0], 0.f) & 0xffffu);
#pragma unroll
                for (int vt = 0; vt < 2; ++vt) {
                    Cm[vt][kt] = Cm[vt][kt] * decay;
#pragma unroll
                    for (int ks = 0; ks < 2; ++ks) Cm[vt][kt] = __builtin_amdgcn_mfma_f32_16x16x32_bf16(Af[vt][ks], Kt[kt][ks], Cm[vt][kt], 0, 0, 0);
                    const unsigned c01 = cvt_pk_bf16(Cm[vt][kt][0], Cm[vt][kt][1]), c23 = cvt_pk_bf16(Cm[vt][kt][2], Cm[vt][kt][3]);
                    bf16_t* cp = Cl + (vt * 16 + lq * 4) * 136 + (2 * w + kt) * 16 + lr;
                    cp[0] = (bf16_t)(c01 & 0xffffu); cp[136] = (bf16_t)(c01 >> 16); cp[272] = (bf16_t)(c23 & 0xffffu); cp[408] = (bf16_t)(c23 >> 16);
                }
            }
            m_prev = misc[1];
        }
        __syncthreads();
    }
#pragma unroll
    for (int vt = 0; vt < 2; ++vt)
#pragma unroll
        for (int kt = 0; kt < 2; ++kt)
#pragma unroll
            for (int g = 0; g < 4; ++g)
                p.out[O_CP + ((size_t)((b * 4 + h) * 128) + vs * 32 + vt * 16 + lq * 4 + g) * 128 + (2 * w + kt) * 16 + lr] = Cm[vt][kt][g];
    if (vs == 0) {
        if (lq == 0) { p.out[O_NP + (size_t)(b * 4 + h) * 128 + (2 * w) * 16 + lr] = nm[0][0]; p.out[O_NP + (size_t)(b * 4 + h) * 128 + (2 * w + 1) * 16 + lr] = nm[1][0]; }
        if (tid == 0) p.out[O_MP + b * 4 + h] = m_prev;
    }
}

DEV unsigned dpp_max16(unsigned x) {
    x = max(x, (unsigned)__builtin_amdgcn_update_dpp(0, (int)x, 0xB1, 0xF, 0xF, false));
    x = max(x, (unsigned)__builtin_amdgcn_update_dpp(0, (int)x, 0x4E, 0xF, 0xF, false));
    x = max(x, (unsigned)__builtin_amdgcn_update_dpp(0, (int)x, 0x141, 0xF, 0xF, false));
    x = max(x, (unsigned)__builtin_amdgcn_update_dpp(0, (int)x, 0x140, 0xF, 0xF, false));
    return x;
}
DEV float dpp_sum16(float x) {
    x += __builtin_bit_cast(float, __builtin_amdgcn_update_dpp(0, __builtin_bit_cast(int, x), 0xB1, 0xF, 0xF, false));
    x += __builtin_bit_cast(float, __builtin_amdgcn_update_dpp(0, __builtin_bit_cast(int, x), 0x4E, 0xF, 0xF, false));
    x += __builtin_bit_cast(float, __builtin_amdgcn_update_dpp(0, __builtin_bit_cast(int, x), 0x141, 0xF, 0xF, false));
    x += __builtin_bit_cast(float, __builtin_amdgcn_update_dpp(0, __builtin_bit_cast(int, x), 0x140, 0xF, 0xF, false));
    return x;
}
DEV unsigned mono_key(float v) { const unsigned b = __float_as_uint(v); return (b & 0x80000000u) ? ~b : (b | 0x80000000u); }
#define CE_DESC(a, b) { const unsigned hi_ = max(a, b), lo_ = min(a, b); a = hi_; b = lo_; }

DEV void peer_score_topk_item(const Params& p, const int tile, const int h, unsigned char* lds) {
    int tid_ = threadIdx.x; asm volatile("" : "+v"(tid_));
    const int tid = tid_, lane = tid & 63, w = tid >> 6, lr = lane & 15, lq = lane >> 4;
    float* sc = (float*)(lds + w * 12416);
    float* ts = sc + 16 * 129;
    int* ti = (int*)(ts + 512);
    const bf16_t* QPB = (const bf16_t*)(p.ws + WS_QPB);
    const bf16_t* SUBK = (const bf16_t*)(p.ws + WS_SUBK);
    int* PIDX = (int*)(p.ws + WS_PIDX); float* PG = (float*)(p.ws + WS_PG);
    const int row0 = tile * 64 + w * 16;
    const int arow = (row0 + lr < NR) ? row0 + lr : NR - 1;
    wave_sync();
#pragma unroll 1
    for (int pp = 0; pp < 2; ++pp) {
        bf16x8 qf[4];
#pragma unroll
        for (int ks = 0; ks < 4; ++ks) qf[ks] = *(const bf16x8*)(QPB + (size_t)arow * 2048 + h * 256 + pp * 128 + ks * 32 + lq * 8);
#pragma unroll
        for (int j = 0; j < 8; ++j) {
            f32x4 a = (f32x4){0.f, 0.f, 0.f, 0.f};
#pragma unroll
            for (int ks = 0; ks < 4; ++ks) { const bf16x8 kf = *(const bf16x8*)(SUBK + ((size_t)pp * 128 + j * 16 + lr) * 128 + ks * 32 + lq * 8); a = __builtin_amdgcn_mfma_f32_16x16x32_bf16(qf[ks], kf, a, 0, 0, 0); }
#pragma unroll
            for (int g = 0; g < 4; ++g) sc[(lq * 4 + g) * 129 + j * 16 + lr] = a[g];
        }
        wave_sync();
#pragma unroll 1
        for (int rr = 0; rr < 4; ++rr) {
            const int row = rr * 4 + lq;
            unsigned k0, k1, k2, k3, k4, k5, k6, k7;
            { const float* sr = sc + row * 129 + lr;
              k0 = (mono_key(sr[0]) & ~0x7Fu) | (unsigned)(127 - lr);        k1 = (mono_key(sr[16]) & ~0x7Fu) | (unsigned)(127 - 16 - lr);
              k2 = (mono_key(sr[32]) & ~0x7Fu) | (unsigned)(127 - 32 - lr);  k3 = (mono_key(sr[48]) & ~0x7Fu) | (unsigned)(127 - 48 - lr);
              k4 = (mono_key(sr[64]) & ~0x7Fu) | (unsigned)(127 - 64 - lr);  k5 = (mono_key(sr[80]) & ~0x7Fu) | (unsigned)(127 - 80 - lr);
              k6 = (mono_key(sr[96]) & ~0x7Fu) | (unsigned)(127 - 96 - lr);  k7 = (mono_key(sr[112]) & ~0x7Fu) | (unsigned)(127 - 112 - lr); }
            CE_DESC(k0, k1) CE_DESC(k2, k3) CE_DESC(k4, k5) CE_DESC(k6, k7)
            CE_DESC(k0, k2) CE_DESC(k1, k3) CE_DESC(k4, k6) CE_DESC(k5, k7)
            CE_DESC(k1, k2) CE_DESC(k5, k6)
            CE_DESC(k0, k4) CE_DESC(k1, k5) CE_DESC(k2, k6) CE_DESC(k3, k7)
            CE_DESC(k2, k4) CE_DESC(k3, k5)
            CE_DESC(k1, k2) CE_DESC(k3, k4) CE_DESC(k5, k6)
            unsigned mine = 0u;
#pragma unroll
            for (int r = 0; r < 16; ++r) {
                const unsigned best = dpp_max16(k0);
                if (lr == r) mine = best;
                const bool own = (k0 == best);
                k0 = own ? k1 : k0; k1 = own ? k2 : k1; k2 = own ? k3 : k2; k3 = own ? k4 : k3; k4 = own ? k5 : k4; k5 = own ? k6 : k5; k6 = own ? k7 : k6; k7 = own ? 0u : k7;
            }
            const int idx = 127 - (int)(mine & 0x7Fu);
            ts[(pp * 16 + row) * 16 + lr] = sc[row * 129 + idx];
            ti[(pp * 16 + row) * 16 + lr] = idx;
        }
        wave_sync();
    }
#pragma unroll 1
    for (int rr = 0; rr < 4; ++rr) {
        const int row = rr * 4 + lq;
        const float s1a = ts[row * 16 + lr];
        const float* s2 = ts + (16 + row) * 16;
        int ptr = 0;
        unsigned key = (mono_key(s1a + s2[0]) & ~0xFFu) | (unsigned)(255 - lr * 16);
        unsigned mine = 0u;
#pragma unroll
        for (int r = 0; r < 16; ++r) {
            const unsigned best = dpp_max16(key);
            if (lr == r) mine = best;
            if (key == best) { ++ptr; key = (ptr < 16) ? ((mono_key(s1a + s2[ptr & 15]) & ~0xFFu) | (unsigned)(255 - lr * 16 - ptr)) : 0u; }
        }
        const int ci = 255 - (int)(mine & 0xFFu), a = ci >> 4, bb = ci & 15;
        const float scv = ts[row * 16 + a] + s2[bb];
        const int e = ti[row * 16 + a] * 128 + ti[(16 + row) * 16 + bb];
        float m16 = scv;
        m16 = fmaxf(m16, __builtin_bit_cast(float, __builtin_amdgcn_update_dpp(0, __builtin_bit_cast(int, m16), 0xB1, 0xF, 0xF, false)));
        m16 = fmaxf(m16, __builtin_bit_cast(float, __builtin_amdgcn_update_dpp(0, __builtin_bit_cast(int, m16), 0x4E, 0xF, 0xF, false)));
        m16 = fmaxf(m16, __builtin_bit_cast(float, __builtin_amdgcn_update_dpp(0, __builtin_bit_cast(int, m16), 0x141, 0xF, 0xF, false)));
        m16 = fmaxf(m16, __builtin_bit_cast(float, __builtin_amdgcn_update_dpp(0, __builtin_bit_cast(int, m16), 0x140, 0xF, 0xF, false)));
        const float ex = expf(scv - m16);
        const float den = dpp_sum16(ex);
        const int grow = row0 + row;
        if (grow < NR) { PIDX[(size_t)grow * 128 + h * 16 + lr] = e; PG[(size_t)grow * 128 + h * 16 + lr] = ex / den; }
    }
}

constexpr float PEER_U_SCALE = 64.0f, PEER_V_SCALE = 8.0f;
DEV unsigned pack4_fp8(float a, float b, float c, float d) { int w = 0; w = __builtin_amdgcn_cvt_pk_fp8_f32(a, b, w, false); w = __builtin_amdgcn_cvt_pk_fp8_f32(c, d, w, true); return (unsigned)w; }
DEV void peer_expert_wave(const Params& p, const int row, unsigned char* wl, const int lane_in) {
    int lane = lane_in; asm volatile("" : "+v"(lane));
    const int lr = lane & 15, lq = lane >> 4;
    unsigned char* xh = wl;
    unsigned char* xo = wl + 1024;
    float* coefl = (float*)(wl + 2048);
    int* idxl = (int*)(wl + 2048 + 512);
    const float* X1 = (const float*)(p.ws + WS_X1) + (size_t)row * 1024;
    const int* PIDX = (const int*)(p.ws + WS_PIDX) + (size_t)row * 128;
    const float* PG = (const float*)(p.ws + WS_PG) + (size_t)row * 128;
    const unsigned char* U8 = p.ws + WS_U8;
    const unsigned char* V8 = p.ws + WS_V8;
    float xv[16];
#pragma unroll
    for (int j = 0; j < 4; ++j) { const float4 t = *(const float4*)(X1 + lane * 16 + j * 4); xv[4 * j] = t.x; xv[4 * j + 1] = t.y; xv[4 * j + 2] = t.z; xv[4 * j + 3] = t.w; }
    wave_sync();
    {
        uint4 hi, lo; unsigned* hp = (unsigned*)&hi; unsigned* lp = (unsigned*)&lo;
#pragma unroll
        for (int j = 0; j < 4; ++j) {
            const unsigned hw = pack4_fp8(xv[4 * j], xv[4 * j + 1], xv[4 * j + 2], xv[4 * j + 3]);
            const f32x2_ b0 = __builtin_amdgcn_cvt_pk_f32_fp8((int)hw, false), b1 = __builtin_amdgcn_cvt_pk_f32_fp8((int)hw, true);
            hp[j] = hw;
            lp[j] = pack4_fp8(16.f * (xv[4 * j] - b0[0]), 16.f * (xv[4 * j + 1] - b0[1]), 16.f * (xv[4 * j + 2] - b1[0]), 16.f * (xv[4 * j + 3] - b1[1]));
        }
        *(uint4*)(xh + lane * 16) = hi; *(uint4*)(xo + lane * 16) = lo;
    }
    idxl[lane] = PIDX[lane]; idxl[64 + lane] = PIDX[64 + lane];
    wave_sync();
    uint4 ufa[8], ufb[8];
    f32x4 ah = (f32x4){0.f, 0.f, 0.f, 0.f}, al = (f32x4){0.f, 0.f, 0.f, 0.f};
#define U_LOAD(DST, HH) { const unsigned char* ub_ = U8 + (size_t)idxl[((HH) >> 1) * 16 + lr] * 1024 + ((HH) & 1) * 512 + lq * 16; \
        _Pragma("unroll") for (int i = 0; i < 8; ++i) DST[i] = *(const uint4*)(ub_ + i * 64); }
#define U_HALF(SRC, HH) { \
        _Pragma("unroll") for (int i = 0; i < 8; ++i) { \
            const int off = ((HH) & 1) * 512 + i * 64 + lq * 16; \
            const long b0 = (long)(((unsigned long long)SRC[i].y << 32) | SRC[i].x), b1 = (long)(((unsigned long long)SRC[i].w << 32) | SRC[i].z); \
            const long h0 = *(const long*)(xh + off), h1 = *(const long*)(xh + off + 8), l0 = *(const long*)(xo + off), l1 = *(const long*)(xo + off + 8); \
            ah = __builtin_amdgcn_mfma_f32_16x16x32_fp8_fp8(h0, b0, ah, 0, 0, 0); ah = __builtin_amdgcn_mfma_f32_16x16x32_fp8_fp8(h1, b1, ah, 0, 0, 0); \
            al = __builtin_amdgcn_mfma_f32_16x16x32_fp8_fp8(l0, b0, al, 0, 0, 0); al = __builtin_amdgcn_mfma_f32_16x16x32_fp8_fp8(l1, b1, al, 0, 0, 0); } \
        if ((HH) & 1) { if (lq == 0) coefl[((HH) >> 1) * 16 + lr] = PG[((HH) >> 1) * 16 + lr] * gelu_tanh((ah[0] + al[0] * 0.0625f) * (1.0f / PEER_U_SCALE)) * (1.0f / PEER_V_SCALE); \
            ah = (f32x4){0.f, 0.f, 0.f, 0.f}; al = (f32x4){0.f, 0.f, 0.f, 0.f}; } }
    U_LOAD(ufa, 0)
#pragma unroll 1
    for (int hh = 0; hh < 16; hh += 2) {
        U_LOAD(ufb, hh + 1)
        U_HALF(ufa, hh)
        if (hh + 2 < 16) U_LOAD(ufa, hh + 2)
        U_HALF(ufb, hh + 1)
    }
#undef U_LOAD
#undef U_HALF
    wave_sync();
    float o[16];
#pragma unroll
    for (int i = 0; i < 16; ++i) o[i] = 0.f;
    uint4 vfa[8], vfb[8];
#define V_LOAD(DST, J) { _Pragma("unroll") for (int u = 0; u < 8; ++u) DST[u] = *(const uint4*)(V8 + (size_t)idxl[(J) + u] * 1024 + lane * 16); }
#define V_ACC(SRC, J) { _Pragma("unroll") for (int u = 0; u < 8; ++u) { const float c_ = coefl[(J) + u]; \
            const unsigned w0_ = SRC[u].x, w1_ = SRC[u].y, w2_ = SRC[u].z, w3_ = SRC[u].w; \
            f32x2_ f0, f1; \
            f0 = __builtin_amdgcn_cvt_pk_f32_fp8((int)w0_, false); f1 = __builtin_amdgcn_cvt_pk_f32_fp8((int)w0_, true); o[0] += c_ * f0[0]; o[1] += c_ * f0[1]; o[2] += c_ * f1[0]; o[3] += c_ * f1[1]; \
            f0 = __builtin_amdgcn_cvt_pk_f32_fp8((int)w1_, false); f1 = __builtin_amdgcn_cvt_pk_f32_fp8((int)w1_, true); o[4] += c_ * f0[0]; o[5] += c_ * f0[1]; o[6] += c_ * f1[0]; o[7] += c_ * f1[1]; \
            f0 = __builtin_amdgcn_cvt_pk_f32_fp8((int)w2_, false); f1 = __builtin_amdgcn_cvt_pk_f32_fp8((int)w2_, true); o[8] += c_ * f0[0]; o[9] += c_ * f0[1]; o[10] += c_ * f1[0]; o[11] += c_ * f1[1]; \
            f0 = __builtin_amdgcn_cvt_pk_f32_fp8((int)w3_, false); f1 = __builtin_amdgcn_cvt_pk_f32_fp8((int)w3_, true); o[12] += c_ * f0[0]; o[13] += c_ * f0[1]; o[14] += c_ * f1[0]; o[15] += c_ * f1[1]; } }
    V_LOAD(vfa, 0)
#pragma unroll 1
    for (int j = 0; j < 128; j += 16) {
        V_LOAD(vfb, j + 8)
        V_ACC(vfa, j)
        if (j + 16 < 128) V_LOAD(vfa, j + 16)
        V_ACC(vfb, j + 8)
    }
#undef V_LOAD
#undef V_ACC
    float tv[16]; float s = 0.f;
#pragma unroll
    for (int i = 0; i < 16; ++i) { tv[i] = DN_ALPHA * xv[i] + o[i]; s += tv[i]; }
    const float mu = wave_sum(s) * (1.0f / 1024.0f);
    float q = 0.f;
#pragma unroll
    for (int i = 0; i < 16; ++i) { const float d = tv[i] - mu; q += d * d; }
    const float rstd = 1.0f / sqrtf(wave_sum(q) * (1.0f / 1024.0f) + LN_EPS);
    float* y = p.out + O_Y + (size_t)row * 1024 + lane * 16;
#pragma unroll
    for (int j = 0; j < 4; ++j) {
        const float4 g4 = *(const float4*)(p.ln2_g + lane * 16 + j * 4), b4 = *(const float4*)(p.ln2_b + lane * 16 + j * 4);
        float4 yo;
        yo.x = (tv[4 * j] - mu) * rstd * g4.x + b4.x; yo.y = (tv[4 * j + 1] - mu) * rstd * g4.y + b4.y; yo.z = (tv[4 * j + 2] - mu) * rstd * g4.z + b4.z; yo.w = (tv[4 * j + 3] - mu) * rstd * g4.w + b4.w;
        *(float4*)(y + j * 4) = yo;
    }
}

constexpr int QN = 2;
struct AttnState { f32x4 ot[4][QN]; float m[QN]; float l[QN]; };

DEV void attn_block(const unsigned char* Ks, const unsigned char* VTs, const bf16x8 (&Qf)[QN][2], AttnState& A, const int mode, const int dq, const float* blut,
                    const unsigned selbit0, const unsigned selbit1, const bool slc, const int lr, const int lq, const int t0, const int ci0) {
    f32x4 sc[4][QN];
#pragma unroll
    for (int kt = 0; kt < 4; ++kt) {
        const bf16x8 k0 = *(const bf16x8*)(Ks + (kt * 16 + lr) * 144 + lq * 16), k1 = *(const bf16x8*)(Ks + (kt * 16 + lr) * 144 + 64 + lq * 16);
#pragma unroll
        for (int qi = 0; qi < QN; ++qi) {
            f32x4 a = (f32x4){0.f, 0.f, 0.f, 0.f};
            a = __builtin_amdgcn_mfma_f32_16x16x32_bf16(k0, Qf[qi][0], a, 0, 0, 0);
            a = __builtin_amdgcn_mfma_f32_16x16x32_bf16(k1, Qf[qi][1], a, 0, 0, 0);
            sc[kt][qi] = a;
        }
    }
    asm volatile("" ::: "memory");
    if (mode != 0 || slc) {
#pragma unroll
        for (int kt = 0; kt < 4; ++kt)
#pragma unroll
            for (int qi = 0; qi < QN; ++qi)
#pragma unroll
                for (int g = 0; g < 4; ++g) {
                    const int kl = kt * 16 + lq * 4 + g, ql = qi * 16 + lr;
                    float v = sc[kt][qi][g];
                    bool ok = true;
                    if (mode == 1 || mode == 2) { const int di = dq + ql - kl; v += blut[di < 0 ? 0 : di]; }
                    if (mode == 2) ok = kl <= ql + dq;
                    if (mode == 3) ok = kl > ql + dq - 512;
                    if (mode == 4) { const int ci = ci0 + kl, dist = t0 + ql - (16 * ci + 31); ok = (dist >= 0) && (ci < 127); if (dist >= 0 && dist < 192) v += blut[dist]; }
                    if (mode == 5) { const int dist = dq - ci0 * kl; ok = (kl < t0) && (dist >= 0); if (dist >= 0 && dist < 192) v += blut[dist]; }
                    if (slc) ok = ok && ((qi == 0 ? selbit0 : selbit1) != 0u);
                    sc[kt][qi][g] = ok ? v : NEGF;
                }
    }
    bf16x8 pf[QN][2];
#pragma unroll
    for (int qi = 0; qi < QN; ++qi) {
        float mb = NEGF;
#pragma unroll
        for (int kt = 0; kt < 4; ++kt) mb = fmaxf(mb, fmaxf(fmaxf(sc[kt][qi][0], sc[kt][qi][1]), fmaxf(sc[kt][qi][2], sc[kt][qi][3])));
        mb = fmaxf(mb, __shfl_xor(mb, 16)); mb = fmaxf(mb, __shfl_xor(mb, 32));
        const float mn = fmaxf(A.m[qi], mb);
        const float alpha = __builtin_amdgcn_exp2f(A.m[qi] - mn);
        A.m[qi] = mn;
        float rs = 0.f;
#pragma unroll
        for (int kt = 0; kt < 4; ++kt)
#pragma unroll
            for (int g = 0; g < 4; ++g) { const float v = sc[kt][qi][g]; const float e = (v > -1e29f) ? __builtin_amdgcn_exp2f(v - mn) : 0.f; sc[kt][qi][g] = e; rs += e; }
        A.l[qi] = A.l[qi] * alpha + rs;
#pragma unroll
        for (int dt = 0; dt < 4; ++dt) A.ot[dt][qi] = A.ot[dt][qi] * alpha;
#pragma unroll
        for (int ks = 0; ks < 2; ++ks) {
            union { bf16x8 v; unsigned u[4]; } pk;
            pk.u[0] = cvt_pk_bf16(sc[2 * ks][qi][0], sc[2 * ks][qi][1]); pk.u[1] = cvt_pk_bf16(sc[2 * ks][qi][2], sc[2 * ks][qi][3]);
            pk.u[2] = cvt_pk_bf16(sc[2 * ks + 1][qi][0], sc[2 * ks + 1][qi][1]); pk.u[3] = cvt_pk_bf16(sc[2 * ks + 1][qi][2], sc[2 * ks + 1][qi][3]);
            pf[qi][ks] = pk.v;
        }
    }
    asm volatile("" ::: "memory");
#pragma unroll
    for (int dt = 0; dt < 4; ++dt)
#pragma unroll
        for (int ks = 0; ks < 2; ++ks) {
            asm volatile("" ::: "memory");
            union { bf16x8 v; uint2 h[2]; } vf;
            vf.h[0] = *(const uint2*)(VTs + (dt * 16 + lr) * 144 + (32 * ks + lq * 4) * 2);
            vf.h[1] = *(const uint2*)(VTs + (dt * 16 + lr) * 144 + (32 * ks + 16 + lq * 4) * 2);
#pragma unroll
            for (int qi = 0; qi < QN; ++qi) A.ot[dt][qi] = __builtin_amdgcn_mfma_f32_16x16x32_bf16(vf.v, pf[qi][ks], A.ot[dt][qi], 0, 0, 0);
        }
}

DEV void nsa_prompt_item(const Params& p, const int b, const int hkv, const int q32, unsigned char* lds) {
    int tid_ = threadIdx.x; asm volatile("" : "+v"(tid_));
    const int tid = tid_, lane = tid & 63, g = tid >> 6, lr = lane & 15, lq = lane >> 4;
    const int hq = hkv * 4 + g, t0 = q32 * 32, kd = t0 >> 6;
    unsigned char* Ks = lds; unsigned char* VTs = lds + 9216;
    float* biasl = (float*)(lds + 18432); float* psl = (float*)(lds + 21504); unsigned* selm = (unsigned*)(lds + 29952); unsigned* misc = (unsigned*)(lds + 30208);
    const bf16_t* ZB = (const bf16_t*)(p.ws + WS_ZB);
    const bf16_t* VTS = (const bf16_t*)(p.ws + WS_VTS) + (size_t)(b * 2 + hkv) * 64 * 2048;
    const bf16_t* VTW = (const bf16_t*)(p.ws + WS_VTW) + (size_t)(b * 2 + hkv) * 64 * 2048;
    const bf16_t* KCB = (const bf16_t*)(p.ws + WS_KCB) + (size_t)(b * 2 + hkv) * 128 * 64;
    const bf16_t* VTC = (const bf16_t*)(p.ws + WS_VTC) + (size_t)(b * 2 + hkv) * 64 * 128;
    const float* Z = (const float*)(p.ws + WS_Z);
    float* NOUTF = (float*)(p.ws + WS_NOUTF);
    bf16_t* NOUTB = (bf16_t*)(p.ws + WS_NOUTB);
    __syncthreads();
    for (int i = tid; i < 4 * 192; i += 256) { const int gg = i / 192, d = i % 192; biasl[i] = (p.rel_bias[rel_bucket(d) * 8 + hkv * 4 + gg] - p.rel_bias[31 * 8 + hkv * 4 + gg]) * LOG2E; }
    for (int i = tid; i < 32 * 33; i += 256) psl[i] = 0.f;
    if (tid < 32) selm[tid] = 0u;
    if (tid == 0) misc[0] = 0u;
    const float* blut = biasl + g * 192;
    bf16x8 Qf[QN][2];
#pragma unroll
    for (int qi = 0; qi < QN; ++qi)
#pragma unroll
        for (int kk = 0; kk < 2; ++kk) Qf[qi][kk] = *(const bf16x8*)(ZB + (size_t)(b * 2048 + t0 + qi * 16 + lr) * IN_DIM + C_Q + hq * 64 + kk * 32 + lq * 8);

    uint4 trk0, trk1, trv0, trv1;
    auto load_tiles = [&](int kind, int kb) __attribute__((always_inline)) {
#pragma unroll
        for (int i = 0; i < 2; ++i) {
            const int id = tid + 256 * i, row = id >> 3, ch = id & 7;
            uint4 rk, rv;
            if (kind == 0) { rk = *(const uint4*)(KCB + (size_t)(kb * 64 + row) * 64 + ch * 8); rv = *(const uint4*)(VTC + (size_t)row * 128 + kb * 64 + ch * 8); }
            else {
                rk = *(const uint4*)(ZB + (size_t)(b * 2048 + kb * 64 + row) * IN_DIM + (kind == 1 ? C_KS : C_KW) + hkv * 64 + ch * 8);
                rv = *(const uint4*)((kind == 1 ? VTS : VTW) + (size_t)row * 2048 + kb * 64 + ch * 8);
            }
            if (i == 0) { trk0 = rk; trv0 = rv; } else { trk1 = rk; trv1 = rv; }
        }
    };
    auto store_tiles = [&]() __attribute__((always_inline)) {
#pragma unroll
        for (int i = 0; i < 2; ++i) { const int id = tid + 256 * i, row = id >> 3, ch = id & 7; *(uint4*)(Ks + row * 144 + ch * 16) = (i == 0 ? trk0 : trk1); *(uint4*)(VTs + row * 144 + ch * 16) = (i == 0 ? trv0 : trv1); }
    };
    auto reset = [&](AttnState& A) __attribute__((always_inline)) {
#pragma unroll
        for (int qi = 0; qi < QN; ++qi) { A.m[qi] = NEGF; A.l[qi] = 0.f;
#pragma unroll
            for (int dt = 0; dt < 4; ++dt) A.ot[dt][qi] = (f32x4){0.f, 0.f, 0.f, 0.f}; }
    };
    auto finish = [&](AttnState& A, int br) __attribute__((always_inline)) {
#pragma unroll
        for (int qi = 0; qi < QN; ++qi) {
            float lt = A.l[qi]; lt += __shfl_xor(lt, 16); lt += __shfl_xor(lt, 32);
            const float sc = (lt > 0.f) ? sigmoidf_(Z[(size_t)(b * 2048 + t0 + qi * 16 + lr) * IN_DIM + C_G + br * 8 + hq]) / lt : 0.f;
            const size_t row = (size_t)(b * 2048 + t0 + qi * 16 + lr);
#pragma unroll
            for (int dt = 0; dt < 4; ++dt) {
                const int col = hq * 64 + dt * 16 + lq * 4;
                f32x4 v = A.ot[dt][qi] * sc;
                if (br > 0) v = v + *(const f32x4*)(NOUTF + row * 512 + col);
                if (br < 2) *(f32x4*)(NOUTF + row * 512 + col) = v; else store_bf16x4(NOUTB + row * 512 + col, v);
            }
        }
    };

    AttnState A;
    const int ncb = ((t0 >> 4) >= 64) ? 2 : 1;
    reset(A);
    load_tiles(0, 0);
    for (int kb = 0; kb < ncb; ++kb) {
        __syncthreads(); store_tiles(); __syncthreads();
        if (kb + 1 < ncb) load_tiles(0, kb + 1);
        attn_block(Ks, VTs, Qf, A, 4, 0, blut, 1u, 1u, false, lr, lq, t0, kb * 64);
    }
    finish(A, 0);
    {
        float linv[QN];
#pragma unroll
        for (int qi = 0; qi < QN; ++qi) { float lt = A.l[qi]; lt += __shfl_xor(lt, 16); lt += __shfl_xor(lt, 32); linv[qi] = (lt > 0.f) ? 1.0f / lt : 0.f; }
        for (int kb = 0; kb < ncb; ++kb) {
            if (ncb > 1) { load_tiles(0, kb); __syncthreads(); store_tiles(); __syncthreads(); }
#pragma unroll
            for (int kt = 0; kt < 4; ++kt) {
                const bf16x8 k0 = *(const bf16x8*)(Ks + (kt * 16 + lr) * 144 + lq * 16), k1 = *(const bf16x8*)(Ks + (kt * 16 + lr) * 144 + 64 + lq * 16);
#pragma unroll
                for (int qi = 0; qi < QN; ++qi) {
                    f32x4 a = (f32x4){0.f, 0.f, 0.f, 0.f};
                    a = __builtin_amdgcn_mfma_f32_16x16x32_bf16(k0, Qf[qi][0], a, 0, 0, 0);
                    a = __builtin_amdgcn_mfma_f32_16x16x32_bf16(k1, Qf[qi][1], a, 0, 0, 0);
                    float pr[4];
#pragma unroll
                    for (int gg = 0; gg < 4; ++gg) {
                        const int ci = kb * 64 + kt * 16 + lq * 4 + gg, ql = qi * 16 + lr, dist = t0 + ql - (16 * ci + 31);
                        float v = a[gg];
                        if (dist >= 0 && dist < 192) v += blut[dist];
                        pr[gg] = (dist >= 0 && ci < 127) ? __builtin_amdgcn_exp2f(v - A.m[qi]) * linv[qi] : 0.f;
                    }
                    const int blk = kb * 16 + kt * 4 + lq, ql = qi * 16 + lr;
                    atomicAdd(&psl[ql * 33 + blk], 2.0f * (pr[0] + pr[1] + pr[2]) + pr[3]);
                    atomicAdd(&psl[ql * 33 + blk + 1], pr[3]);
                }
            }
        }
    }
    __syncthreads();
    {
        const int ql = tid >> 3, part = tid & 7, tq = t0 + ql, cur = tq >> 6;
        float scv[32];
#pragma unroll
        for (int j = 0; j < 32; ++j) {
            const bool causal = j * 64 <= tq, forced = (j == 0) || (j == cur) || (j == cur - 1);
            scv[j] = causal ? (forced ? 1e4f : psl[ql * 33 + j]) : NEGF;
        }
        unsigned mbits = 0u;
#pragma unroll
        for (int jj = 0; jj < 4; ++jj) {
            const int j = part * 4 + jj;
            float my = NEGF;
#pragma unroll
            for (int k = 0; k < 32; ++k) my = (k == j) ? scv[k] : my;
            int rank = 0;
#pragma unroll
            for (int k = 0; k < 32; ++k) rank += ((scv[k] > my) || (scv[k] == my && k < j)) ? 1 : 0;
            if (rank < 16 && j * 64 <= tq) mbits |= (1u << j);
        }
        atomicOr(&selm[ql], mbits);
        atomicOr(&misc[0], mbits);
    }
    __syncthreads();
    const unsigned msk0 = selm[lr], msk1 = selm[16 + lr];
    const unsigned anym = misc[0];
    reset(A);
    {
        int kb = kd;
        load_tiles(1, kb);
        for (;;) {
            __syncthreads(); store_tiles(); __syncthreads();
            int nxt = (kb == kd) ? 0 : kb + 1;
            while (nxt < kd && !((anym >> nxt) & 1u)) ++nxt;
            const bool more = nxt < kd;
            if (more) load_tiles(1, nxt);
            const int mode = (kb == kd) ? 2 : ((kb >= kd - 2) ? 1 : 0);
            attn_block(Ks, VTs, Qf, A, mode, t0 - kb * 64, blut, (msk0 >> kb) & 1u, (msk1 >> kb) & 1u, true, lr, lq, t0, 0);
            if (!more) break;
            kb = nxt;
        }
    }
    finish(A, 1);
    reset(A);
    {
        const int klo = (t0 >= 511) ? ((t0 - 511) >> 6) : 0;
        int kb = kd;
        load_tiles(2, kb);
        for (;;) {
            __syncthreads(); store_tiles(); __syncthreads();
            const bool more = kb > klo;
            if (more) load_tiles(2, kb - 1);
            const int dq = t0 - kb * 64;
            const int mode = (kb == kd) ? 2 : ((kb >= kd - 2) ? 1 : ((dq + 31 >= 512) ? 3 : 0));
            attn_block(Ks, VTs, Qf, A, mode, dq, blut, 1u, 1u, false, lr, lq, t0, 0);
            if (!more) break;
            --kb;
        }
    }
    finish(A, 2);
}

DEV void nsa_sample_item(const Params& p, const int b, const int hkv, unsigned char* lds) {
    int tid_ = threadIdx.x; asm volatile("" : "+v"(tid_));
    const int tid = tid_, lane = tid & 63, g = tid >> 6, lr = lane & 15, lq = lane >> 4;
    const int hq = hkv * 4 + g;
    unsigned char* Ks = lds; unsigned char* VTs = lds + 9216;
    float* biasl = (float*)(lds + 18432); float* psl = (float*)(lds + 21504); int* sell = (int*)(lds + 29952); float* scl = (float*)(lds + 30720);
    const bf16_t* ZB = (const bf16_t*)(p.ws + WS_ZB);
    const float* zrow = (const float*)(p.ws + WS_Z) + (size_t)(NP + b) * IN_DIM;
    const bf16_t* KCSB = (const bf16_t*)(p.ws + WS_KCSB) + (size_t)(b * 2 + hkv) * 1024 * 64;
    const bf16_t* VTCS = (const bf16_t*)(p.ws + WS_VTCS) + (size_t)(b * 2 + hkv) * 64 * 1024;
    bf16_t* NOUTB = (bf16_t*)(p.ws + WS_NOUTB);
    __syncthreads();
    for (int i = tid; i < 4 * 192; i += 256) { const int gg = i / 192, d = i % 192; biasl[i] = (p.rel_bias[rel_bucket(d) * 8 + hkv * 4 + gg] - p.rel_bias[31 * 8 + hkv * 4 + gg]) * LOG2E; }
    for (int i = tid; i < 260; i += 256) psl[i] = 0.f;
    const float* blut = biasl + g * 192;
    bf16x8 Qf[QN][2];
#pragma unroll
    for (int kk = 0; kk < 2; ++kk) { Qf[0][kk] = *(const bf16x8*)(ZB + (size_t)(NP + b) * IN_DIM + C_Q + hq * 64 + kk * 32 + lq * 8); Qf[1][kk] = Qf[0][kk]; }
    AttnState A;
    auto reset = [&](AttnState& S_) __attribute__((always_inline)) {
#pragma unroll
        for (int qi = 0; qi < QN; ++qi) { S_.m[qi] = NEGF; S_.l[qi] = 0.f;
#pragma unroll
            for (int dt = 0; dt < 4; ++dt) S_.ot[dt][qi] = (f32x4){0.f, 0.f, 0.f, 0.f}; }
    };
    f32x4 res[4];
#pragma unroll
    for (int dt = 0; dt < 4; ++dt) res[dt] = (f32x4){0.f, 0.f, 0.f, 0.f};
    auto finish = [&](AttnState& S_, int br) __attribute__((always_inline)) {
        float lt = S_.l[0]; lt += __shfl_xor(lt, 16); lt += __shfl_xor(lt, 32);
        const float sc = (lt > 0.f) ? sigmoidf_(zrow[C_G + br * 8 + hq]) / lt : 0.f;
#pragma unroll
        for (int dt = 0; dt < 4; ++dt) res[dt] = res[dt] + S_.ot[dt][0] * sc;
    };
    uint4 trk0, trk1, trv0, trv1;
    auto load_cmp = [&](int kb) __attribute__((always_inline)) {
#pragma unroll
        for (int i = 0; i < 2; ++i) {
            const int id = tid + 256 * i, row = id >> 3, ch = id & 7;
            const uint4 rk = *(const uint4*)(KCSB + (size_t)(kb * 64 + row) * 64 + ch * 8), rv = *(const uint4*)(VTCS + (size_t)row * 1024 + kb * 64 + ch * 8);
            if (i == 0) { trk0 = rk; trv0 = rv; } else { trk1 = rk; trv1 = rv; }
        }
    };
    auto store_cmp = [&]() __attribute__((always_inline)) {
#pragma unroll
        for (int i = 0; i < 2; ++i) { const int id = tid + 256 * i, row = id >> 3, ch = id & 7; *(uint4*)(Ks + row * 144 + ch * 16) = (i == 0 ? trk0 : trk1); *(uint4*)(VTs + row * 144 + ch * 16) = (i == 0 ? trv0 : trv1); }
    };
    reset(A);
    load_cmp(0);
    for (int kb = 0; kb < 16; ++kb) {
        __syncthreads(); store_cmp(); __syncthreads();
        if (kb + 1 < 16) load_cmp(kb + 1);
        attn_block(Ks, VTs, Qf, A, 5, PAST - 31 - 16 * (kb * 64), blut, 1u, 1u, false, lr, lq, (kb == 15) ? 63 : 64, 16);
    }
    finish(A, 0);
    {
        float lt = A.l[0]; lt += __shfl_xor(lt, 16); lt += __shfl_xor(lt, 32);
        const float linv = (lt > 0.f) ? 1.0f / lt : 0.f;
        for (int kb = 0; kb < 16; ++kb) {
            load_cmp(kb); __syncthreads(); store_cmp(); __syncthreads();
#pragma unroll
            for (int kt = 0; kt < 4; ++kt) {
                const bf16x8 k0 = *(const bf16x8*)(Ks + (kt * 16 + lr) * 144 + lq * 16), k1 = *(const bf16x8*)(Ks + (kt * 16 + lr) * 144 + 64 + lq * 16);
                f32x4 a = (f32x4){0.f, 0.f, 0.f, 0.f};
                a = __builtin_amdgcn_mfma_f32_16x16x32_bf16(k0, Qf[0][0], a, 0, 0, 0);
                a = __builtin_amdgcn_mfma_f32_16x16x32_bf16(k1, Qf[0][1], a, 0, 0, 0);
                float pr[4];
#pragma unroll
                for (int gg = 0; gg < 4; ++gg) {
                    const int ci = kb * 64 + kt * 16 + lq * 4 + gg, dist = PAST - 31 - 16 * ci;
                    float v = a[gg];
                    if (dist >= 0 && dist < 192) v += blut[dist];
                    pr[gg] = (ci < 1023) ? __builtin_amdgcn_exp2f(v - A.m[0]) * linv : 0.f;
                }
                if (lr == 0) {
                    const int blk = kb * 16 + kt * 4 + lq;
                    atomicAdd(&psl[blk], 2.0f * (pr[0] + pr[1] + pr[2]) + pr[3]);
                    atomicAdd(&psl[blk + 1], pr[3]);
                }
            }
        }
    }
    __syncthreads();
    for (int j = tid; j < 257; j += 256) scl[j] = (j == 0 || j == 256 || j == 255) ? 1e4f : psl[j];
    __syncthreads();
    for (int j = tid; j < 257; j += 256) {
        const float my = scl[j];
        int rank = 0;
        for (int k = 0; k < 257; ++k) { const float o2 = scl[k]; rank += ((o2 > my) || (o2 == my && k < j)) ? 1 : 0; }
        if (rank < 16) sell[rank] = j;
    }
    __syncthreads();
    uint4 rk0, rk1; unsigned rv0, rv1, rv2, rv3, rv4, rv5, rv6, rv7;
    auto load_rows = [&](const float* src) __attribute__((always_inline)) {
        const int seg = tid & 3;
        const bool nz = src != nullptr;
        const float* kp = (nz ? src : zrow) + hkv * 64 + seg * 16; const float* vp = kp + 128;
        const float4 a0 = *(const float4*)kp, a1 = *(const float4*)(kp + 4), a2 = *(const float4*)(kp + 8), a3 = *(const float4*)(kp + 12);
        const float4 c0 = *(const float4*)vp, c1 = *(const float4*)(vp + 4), c2 = *(const float4*)(vp + 8), c3 = *(const float4*)(vp + 12);
        const unsigned mk = nz ? 0xffffffffu : 0u;
        rk0.x = cvt_pk_bf16(a0.x, a0.y) & mk; rk0.y = cvt_pk_bf16(a0.z, a0.w) & mk; rk0.z = cvt_pk_bf16(a1.x, a1.y) & mk; rk0.w = cvt_pk_bf16(a1.z, a1.w) & mk;
        rk1.x = cvt_pk_bf16(a2.x, a2.y) & mk; rk1.y = cvt_pk_bf16(a2.z, a2.w) & mk; rk1.z = cvt_pk_bf16(a3.x, a3.y) & mk; rk1.w = cvt_pk_bf16(a3.z, a3.w) & mk;
        rv0 = cvt_pk_bf16(c0.x, c0.y) & mk; rv1 = cvt_pk_bf16(c0.z, c0.w) & mk; rv2 = cvt_pk_bf16(c1.x, c1.y) & mk; rv3 = cvt_pk_bf16(c1.z, c1.w) & mk;
        rv4 = cvt_pk_bf16(c2.x, c2.y) & mk; rv5 = cvt_pk_bf16(c2.z, c2.w) & mk; rv6 = cvt_pk_bf16(c3.x, c3.y) & mk; rv7 = cvt_pk_bf16(c3.z, c3.w) & mk;
    };
    auto store_rows = [&]() __attribute__((always_inline)) {
        const int kl = tid >> 2, seg = tid & 3;
        *(uint4*)(Ks + kl * 144 + seg * 32) = rk0; *(uint4*)(Ks + kl * 144 + seg * 32 + 16) = rk1;
#define VT_PUT(i_, w_) { *(bf16_t*)(VTs + (seg * 16 + (i_)) * 144 + kl * 2) = (bf16_t)((w_) & 0xffffu); *(bf16_t*)(VTs + (seg * 16 + (i_) + 1) * 144 + kl * 2) = (bf16_t)((w_) >> 16); }
        VT_PUT(0, rv0) VT_PUT(2, rv1) VT_PUT(4, rv2) VT_PUT(6, rv3) VT_PUT(8, rv4) VT_PUT(10, rv5) VT_PUT(12, rv6) VT_PUT(14, rv7)
#undef VT_PUT
    };
    auto slc_row = [&](int blk) __attribute__((always_inline)) -> const float* {
        const int kl = tid >> 2;
        if (blk < 256) { const int page = p.page_table[b * 128 + (blk >> 1)]; return p.cache_slc + ((size_t)page * 128 + (blk & 1) * 64 + kl) * 256; }
        return (kl == 0) ? zrow + C_KS : nullptr;
    };
    reset(A);
    load_rows(slc_row(sell[0]));
    for (int si = 0; si < 16; ++si) {
        const int blk = sell[si];
        __syncthreads(); store_rows(); __syncthreads();
        if (si + 1 < 16) load_rows(slc_row(sell[si + 1]));
        attn_block(Ks, VTs, Qf, A, 5, PAST - blk * 64, blut, 1u, 1u, false, lr, lq, (blk == 256) ? 1 : 64, 1);
    }
    finish(A, 1);
    auto win_row = [&](int wb) __attribute__((always_inline)) -> const float* {
        const int j = 1 + wb * 64 + (tid >> 2);
        return (j < 512) ? p.state_win + ((size_t)b * 512 + j) * 256 : zrow + C_KW;
    };
    reset(A);
    load_rows(win_row(0));
    for (int wb = 0; wb < 8; ++wb) {
        __syncthreads(); store_rows(); __syncthreads();
        if (wb + 1 < 8) load_rows(win_row(wb + 1));
        attn_block(Ks, VTs, Qf, A, 5, 511 - wb * 64, blut, 1u, 1u, false, lr, lq, 64, 1);
    }
    finish(A, 2);
    if (lr == 0) {
#pragma unroll
        for (int dt = 0; dt < 4; ++dt) store_bf16x4(NOUTB + (size_t)(NP + b) * 512 + hq * 64 + dt * 16 + lq * 4, res[dt]);
    }
}

#define Z ((float*)(p.ws + WS_Z))
#define QK ((float*)(p.ws + WS_QK))
#define HRAW ((float*)(p.ws + WS_HRAW))
#define MOUTB ((bf16_t*)(p.ws + WS_MOUTB))
#define NOUTB ((bf16_t*)(p.ws + WS_NOUTB))
#define HIDPB ((bf16_t*)(p.ws + WS_HIDPB))
#define HIDSB ((bf16_t*)(p.ws + WS_HIDSB))
#define KCS ((float*)(p.ws + WS_KCS))
#define MIX ((float*)(p.ws + WS_MIX))
#define MIXB ((bf16_t*)(p.ws + WS_MIXB))
#define T1 ((float*)(p.ws + WS_T1))
#define X1 ((float*)(p.ws + WS_X1))
#define X1B ((bf16_t*)(p.ws + WS_X1B))
#define QPB ((bf16_t*)(p.ws + WS_QPB))
#define S ((float*)(p.ws + WS_S))
#define CONVB ((bf16_t*)(p.ws + WS_CONVB))
#define XB ((bf16_t*)(p.ws + WS_XB))
#define WIN_T ((bf16_t*)(p.ws + WS_WIN_T))
#define WUPM_T ((bf16_t*)(p.ws + WS_WUPM_T))
#define WUPN_T ((bf16_t*)(p.ws + WS_WUPN_T))
#define WOUT_T ((bf16_t*)(p.ws + WS_WOUT_T))
#define PWQ_T ((bf16_t*)(p.ws + WS_PWQ_T))
#define WQK_T ((bf16_t*)(p.ws + WS_WQK_T))
#define W1_T ((bf16_t*)(p.ws + WS_W1_T))
#define W2_T ((bf16_t*)(p.ws + WS_W2_T))
#define SUBK ((bf16_t*)(p.ws + WS_SUBK))
#define ZB ((bf16_t*)(p.ws + WS_ZB))
#define VTS ((bf16_t*)(p.ws + WS_VTS))
#define VTW ((bf16_t*)(p.ws + WS_VTW))
#define KCB ((bf16_t*)(p.ws + WS_KCB))
#define VTC ((bf16_t*)(p.ws + WS_VTC))
__global__ void __launch_bounds__(NTHREADS, 2) fwd_kernel(Params p) {
    extern __shared__ __attribute__((aligned(16))) unsigned char smem[];
    if (threadIdx.x == 0) { *(uint4*)smem = make_uint4(0u, 0u, 0u, 0u); }
    __syncthreads();
    XcdBarrier bar = xcd_barrier_post((unsigned*)(p.ws + WS_BAR), (volatile LAS unsigned*)smem);
    float* lds = (float*)(smem + 16);
    unsigned char* ldsb = smem + 16;
    const int tid = threadIdx.x, lane = tid & 63, w = tid >> 6;
    const int gw = blockIdx.x * 4 + w, nw = gridDim.x * 4;
    const size_t gt = (size_t)blockIdx.x * NTHREADS + tid, nt = (size_t)gridDim.x * NTHREADS;


    {
        for (size_t id = gt; id < (size_t)MP * 128; id += nt) {
            const int row = (int)(id >> 7), k8 = (int)(id & 127) * 8;
            float f[8];
            if (row < NR) {
                const float* s = (row < NP ? p.x_prompt + (size_t)row * 1024 : p.x_sample + (size_t)(row - NP) * 1024) + k8;
                const float4 a = *(const float4*)s, b = *(const float4*)(s + 4);
                f[0] = a.x; f[1] = a.y; f[2] = a.z; f[3] = a.w; f[4] = b.x; f[5] = b.y; f[6] = b.z; f[7] = b.w;
            } else {
#pragma unroll
                for (int i = 0; i < 8; ++i) f[i] = 0.f;
            }
            *(uint4*)(XB + (size_t)row * 1024 + k8) = pack8(f);
        }
        transpose_to_bf16(p.w_in, 1024, IN_DIM, WIN_T, gt, nt);
        transpose_to_bf16(p.w_up_m, 512, 1024, WUPM_T, gt, nt);
        transpose_to_bf16(p.w_up_n, 512, 1024, WUPN_T, gt, nt);
        transpose_to_bf16(p.w_out, 1024, 1024, WOUT_T, gt, nt);
        transpose_to_bf16(p.peer_wq, 1024, 2048, PWQ_T, gt, nt);
        for (int h = 0; h < 4; ++h) {
            transpose_to_bf16(p.wq + (size_t)h * 16384, 128, 128, WQK_T + (size_t)(h * 256) * 128, gt, nt);
            transpose_to_bf16(p.wk + (size_t)h * 16384, 128, 128, WQK_T + (size_t)(h * 256 + 128) * 128, gt, nt);
        }
        for (int c = 0; c < 2; ++c) {
            transpose_to_bf16(p.cmp_w1 + (size_t)c * 2048 * 64, 2048, 64, W1_T + (size_t)c * 64 * 2048, gt, nt);
            transpose_to_bf16(p.cmp_w2 + (size_t)c * 4096, 64, 64, W2_T + (size_t)c * 4096, gt, nt);
        }
        for (size_t id = gt; id < (size_t)2 * 128 * 128 / 8; id += nt) {
            float f[8];
#pragma unroll
            for (int i = 0; i < 8; ++i) f[i] = p.peer_sub[id * 8 + i];
            *(uint4*)(SUBK + id * 8) = pack8(f);
        }
        for (size_t id = gt; id < (size_t)16384 * 64; id += nt) {
            const float* su = p.peer_u + id * 16; const float* sv = p.peer_v + id * 16;
            uint4 ou, ov; unsigned* pu = (unsigned*)&ou; unsigned* pv = (unsigned*)&ov;
#pragma unroll
            for (int j = 0; j < 4; ++j) {
                const float4 a4 = *(const float4*)(su + j * 4), c4 = *(const float4*)(sv + j * 4);
                pu[j] = pack4_fp8(a4.x * PEER_U_SCALE, a4.y * PEER_U_SCALE, a4.z * PEER_U_SCALE, a4.w * PEER_U_SCALE);
                pv[j] = pack4_fp8(c4.x * PEER_V_SCALE, c4.y * PEER_V_SCALE, c4.z * PEER_V_SCALE, c4.w * PEER_V_SCALE);
            }
            *(uint4*)(p.ws + WS_U8 + id * 16) = ou; *(uint4*)(p.ws + WS_V8 + id * 16) = ov;
        }
        for (size_t i = gt; i < (size_t)BS * 511 * 256; i += nt) {
            const int j = (int)(i & 255); const int wv = (int)((i >> 8) % 511); const int b = (int)((i >> 8) / 511);
            p.out[O_WINS + ((size_t)b * 512 + wv) * 256 + j] = p.state_win[((size_t)b * 512 + wv + 1) * 256 + j];
        }
        for (size_t i = gt; i < (size_t)BS * 2 * 512; i += nt) {
            const int ch = (int)(i & 511); const int jj = (int)((i >> 9) & 1); const int b = (int)(i >> 10);
            p.out[O_CVS + ((size_t)b * 3 + jj) * 512 + ch] = p.state_conv[((size_t)b * 3 + jj + 1) * 512 + ch];
        }
    }
    xcd_barrier(bar);

    gemm_bf16<128>(NR, IN_DIM, 1024,
        [&](int r, int k) { return *(const uint4*)(XB + (size_t)r * 1024 + k); },
        [&](int n, int k) { return *(const uint4*)(WIN_T + (size_t)n * 1024 + k); },
        [&](int r, int c0, f32x4 v) {
            *(f32x4*)(Z + (size_t)r * IN_DIM + c0) = v;
            store_bf16x4(ZB + (size_t)r * IN_DIM + c0, (c0 >= C_Q && c0 < C_KC) ? v * (0.125f * LOG2E) : v);
            if (r < NP && ((c0 >= C_KS + 128 && c0 < C_KW) || (c0 >= C_KW + 128 && c0 < C_G))) {
                const bool isw = c0 >= C_KW; const int cc = c0 - (isw ? C_KW : C_KS) - 128;
                bf16_t* vt = (isw ? VTW : VTS) + ((size_t)((r >> 11) * 2) * 64 + cc) * 2048 + (r & 2047);
                const unsigned w0 = cvt_pk_bf16(v[0], v[1]), w1 = cvt_pk_bf16(v[2], v[3]);
                vt[0] = (bf16_t)(w0 & 0xffffu); vt[2048] = (bf16_t)(w0 >> 16); vt[4096] = (bf16_t)(w1 & 0xffffu); vt[6144] = (bf16_t)(w1 >> 16);
            }
            if (r < NP && c0 >= C_V && c0 < C_O) {
                bf16_t* vt = (bf16_t*)(p.ws + WS_VTM) + ((size_t)(r >> 11) * 512 + (c0 - C_V)) * 2048 + (r & 2047);
                const unsigned w0 = cvt_pk_bf16(v[0], v[1]), w1 = cvt_pk_bf16(v[2], v[3]);
                vt[0] = (bf16_t)(w0 & 0xffffu); vt[2048] = (bf16_t)(w0 >> 16); vt[4096] = (bf16_t)(w1 & 0xffffu); vt[6144] = (bf16_t)(w1 >> 16);
            }
            if (c0 >= C_KC && c0 < C_KS) *(f32x4*)(p.out + O_CMPP + (size_t)r * 256 + (c0 - C_KC)) = v;
            else if (c0 >= C_KS && c0 < C_KW) *(f32x4*)(p.out + O_SLCP + (size_t)r * 256 + (c0 - C_KS)) = v;
            else if (c0 >= C_KW && c0 < C_G) {
                if (r < NP) { const int t = r & 2047; if (t >= 1536) *(f32x4*)(p.out + O_WINP + ((size_t)(r >> 11) * 512 + (t - 1536)) * 256 + (c0 - C_KW)) = v; }
                else *(f32x4*)(p.out + O_WINS + ((size_t)(r - NP) * 512 + 511) * 256 + (c0 - C_KW)) = v;
            } else if (c0 < C_V) {
                if (r < NP) { const int t = r & 2047; if (t >= 2045) *(f32x4*)(p.out + O_CVP + ((size_t)(r >> 11) * 3 + (t - 2045)) * 512 + c0) = v; }
                else *(f32x4*)(p.out + O_CVS + ((size_t)(r - NP) * 3 + 2) * 512 + c0) = v;
            }
        }, ldsb);
    xcd_barrier(bar);

    for (size_t i = gt; i < (size_t)NR * 512; i += nt) {
        const int ch = (int)(i & 511); const int r = (int)(i >> 9);
        float a = p.conv_b[ch];
        if (r < NP) {
            const int t = r & 2047;
#pragma unroll
            for (int j = 0; j < 4; ++j) if (t + j - 3 >= 0) a += p.conv_w[j * 512 + ch] * Z[(size_t)(r + j - 3) * IN_DIM + C_U + ch];
        } else {
            const int b = r - NP;
#pragma unroll
            for (int j = 0; j < 3; ++j) a += p.conv_w[j * 512 + ch] * p.state_conv[((size_t)b * 3 + j) * 512 + ch];
            a += p.conv_w[3 * 512 + ch] * Z[(size_t)r * IN_DIM + C_U + ch];
        }
        CONVB[i] = (bf16_t)(cvt_pk_bf16(a / (1.0f + expf(-a)), 0.f) & 0xffffu);
    }
    xcd_barrier(bar);

    for (int h = 0; h < 4; ++h) {
        gemm_bf16<128>(NR, 256, 128,
            [&](int r, int k) { return *(const uint4*)(CONVB + (size_t)r * 512 + h * 128 + k); },
            [&](int n, int k) { return *(const uint4*)(WQK_T + (size_t)(h * 256 + n) * 128 + k); },
            [&](int r, int c0, f32x4 v) {
                if (c0 >= 128) v = v * 0.08838834764831845f;
                *(f32x4*)(QK + (size_t)r * 1024 + h * 256 + c0) = v;
                if (c0 < 128) store_bf16x4((bf16_t*)(p.ws + WS_QB) + (size_t)r * 512 + h * 128 + c0, v);
                else {
                    store_bf16x4((bf16_t*)(p.ws + WS_KB) + (size_t)r * 512 + h * 128 + (c0 - 128), v);
                    if (r < NP) {
                        bf16_t* kt = (bf16_t*)(p.ws + WS_KTB) + ((size_t)((r >> 11) * 4 + h) * 128 + (c0 - 128)) * 2048 + (r & 2047);
                        const unsigned w0 = cvt_pk_bf16(v[0], v[1]), w1 = cvt_pk_bf16(v[2], v[3]);
                        kt[0] = (bf16_t)(w0 & 0xffffu); kt[2048] = (bf16_t)(w0 >> 16); kt[4096] = (bf16_t)(w1 & 0xffffu); kt[6144] = (bf16_t)(w1 >> 16);
                    }
                } }, ldsb);
    }
    for (int c = 0; c < 2; ++c) {
        gemm_bf16<64>(4096, 64, 2048,
            [&](int row, int k) {
                const int hh = row & 1, bi = row >> 1, i = bi & 127, b = bi >> 7, j = k >> 6, d0 = k & 63, tok = 16 * i + j;
                const float* pe = p.cmp_pe + (c * 32 + j) * 64 + d0;
                const float4 e0 = *(const float4*)pe, e1 = *(const float4*)(pe + 4);
                float f[8] = {e0.x, e0.y, e0.z, e0.w, e1.x, e1.y, e1.z, e1.w};
                if (tok < 2048) {
                    const float* s = Z + ((size_t)b * 2048 + tok) * IN_DIM + C_KC + c * 128 + hh * 64 + d0;
                    const float4 a0 = *(const float4*)s, a1 = *(const float4*)(s + 4);
                    f[0] += a0.x; f[1] += a0.y; f[2] += a0.z; f[3] += a0.w; f[4] += a1.x; f[5] += a1.y; f[6] += a1.z; f[7] += a1.w;
                }
                return pack8(f); },
            [&](int n, int k) { return *(const uint4*)(W1_T + ((size_t)c * 64 + n) * 2048 + k); },
            [&](int row, int c0, f32x4 v) {
                f32x4 g; g[0] = gelu_tanh(v[0]); g[1] = gelu_tanh(v[1]); g[2] = gelu_tanh(v[2]); g[3] = gelu_tanh(v[3]);
                store_bf16x4(HIDPB + ((size_t)c * 4096 + row) * 64 + c0, g); }, ldsb);
        gemm_bf16<64>(65536, 64, 2048,
            [&](int row, int k) {
                const int hh = row & 1, bi = row >> 1, i = bi & 1023, b = bi >> 10, j = k >> 6, d0 = k & 63, tok = 16 * i + j;
                const float* pe = p.cmp_pe + (c * 32 + j) * 64 + d0;
                const float4 e0 = *(const float4*)pe, e1 = *(const float4*)(pe + 4);
                float f[8] = {e0.x, e0.y, e0.z, e0.w, e1.x, e1.y, e1.z, e1.w};
                if (tok < PAST) {
                    const int page = p.page_table[b * 128 + (tok >> 7)];
                    const float* s = p.cache_cmp + ((size_t)page * 128 + (tok & 127)) * 256 + c * 128 + hh * 64 + d0;
                    const float4 a0 = *(const float4*)s, a1 = *(const float4*)(s + 4);
                    f[0] += a0.x; f[1] += a0.y; f[2] += a0.z; f[3] += a0.w; f[4] += a1.x; f[5] += a1.y; f[6] += a1.z; f[7] += a1.w;
                }
                return pack8(f); },
            [&](int n, int k) { return *(const uint4*)(W1_T + ((size_t)c * 64 + n) * 2048 + k); },
            [&](int row, int c0, f32x4 v) {
                f32x4 g; g[0] = gelu_tanh(v[0]); g[1] = gelu_tanh(v[1]); g[2] = gelu_tanh(v[2]); g[3] = gelu_tanh(v[3]);
                store_bf16x4(HIDSB + ((size_t)c * 65536 + row) * 64 + c0, g); }, ldsb);
    }
    xcd_barrier(bar);

    for (int item = blockIdx.x; item < 256 + 128; item += gridDim.x) {
        if (item < 256) mlstm_chunk_item(p, item, ldsb); else mlstm_scan_item(p, 64 + (item - 256), lds);
    }
    for (int c = 0; c < 2; ++c) {
        gemm_bf16<64>(4096, 64, 64,
            [&](int row, int k) { return *(const uint4*)(HIDPB + ((size_t)c * 4096 + row) * 64 + k); },
            [&](int n, int k) { return *(const uint4*)(W2_T + ((size_t)c * 64 + n) * 64 + k); },
            [&](int row, int c0, f32x4 v) {
                const int hh = row & 1, bi = row >> 1, i = bi & 127, b = bi >> 7;
                if (c == 0) store_bf16x4(KCB + ((size_t)(b * 2 + hh) * 128 + i) * 64 + c0, v);
                else { bf16_t* vt = VTC + ((size_t)(b * 2 + hh) * 64 + c0) * 128 + i; const unsigned w0 = cvt_pk_bf16(v[0], v[1]), w1 = cvt_pk_bf16(v[2], v[3]);
                       vt[0] = (bf16_t)(w0 & 0xffffu); vt[128] = (bf16_t)(w0 >> 16); vt[256] = (bf16_t)(w1 & 0xffffu); vt[384] = (bf16_t)(w1 >> 16); } }, ldsb);
        gemm_bf16<64>(65536, 64, 64,
            [&](int row, int k) { return *(const uint4*)(HIDSB + ((size_t)c * 65536 + row) * 64 + k); },
            [&](int n, int k) { return *(const uint4*)(W2_T + ((size_t)c * 64 + n) * 64 + k); },
            [&](int row, int c0, f32x4 v) {
                const int hh = row & 1, bi = row >> 1, i = bi & 1023, b = bi >> 10;
                if (c == 0) store_bf16x4((bf16_t*)(p.ws + WS_KCSB) + ((size_t)(b * 2 + hh) * 1024 + i) * 64 + c0, v);
                else { bf16_t* vt = (bf16_t*)(p.ws + WS_VTCS) + ((size_t)(b * 2 + hh) * 64 + c0) * 1024 + i; const unsigned w0 = cvt_pk_bf16(v[0], v[1]), w1 = cvt_pk_bf16(v[2], v[3]);
                       vt[0] = (bf16_t)(w0 & 0xffffu); vt[1024] = (bf16_t)(w0 >> 16); vt[2048] = (bf16_t)(w1 & 0xffffu); vt[3072] = (bf16_t)(w1 >> 16); } }, ldsb);
    }
    xcd_barrier(bar);

    for (int it = gw; it < NR * 4; it += nw) {
        const int row = it >> 2, h = it & 3;
        const float x0 = HRAW[(size_t)row * 512 + h * 128 + lane], x1 = HRAW[(size_t)row * 512 + h * 128 + 64 + lane];
        const float mu = wave_sum(x0 + x1) * (1.0f / 128.0f);
        const float d0 = x0 - mu, d1 = x1 - mu;
        const float var = wave_sum(d0 * d0 + d1 * d1) * (1.0f / 128.0f);
        const float rstd = 1.0f / sqrtf(var + LN_EPS);
        const int c0 = h * 128 + lane, c1 = c0 + 64;
        MOUTB[(size_t)row * 512 + c0] = (bf16_t)(cvt_pk_bf16(sigmoidf_(Z[(size_t)row * IN_DIM + C_O + c0]) * (d0 * rstd * p.norm_g[c0]), 0.f) & 0xffffu);
        MOUTB[(size_t)row * 512 + c1] = (bf16_t)(cvt_pk_bf16(sigmoidf_(Z[(size_t)row * IN_DIM + C_O + c1]) * (d1 * rstd * p.norm_g[c1]), 0.f) & 0xffffu);
    }
    for (;;) {
        __syncthreads();
        if (tid == 0) *(volatile int*)(ldsb + 32768) = (int)atomicAdd((unsigned*)(p.ws + WS_BAR) + 2, 1u);
        __syncthreads();
        const int idx = *(volatile int*)(ldsb + 32768);
        if (idx >= 64 + 2048) break;
        if (idx < 64) nsa_sample_item(p, idx >> 1, idx & 1, ldsb);
        else { const int i2 = idx - 64; nsa_prompt_item(p, (i2 & 31) >> 1, i2 & 1, 63 - (i2 >> 5), ldsb); }
    }
    xcd_barrier(bar);

    gemm_bf16<128>(NR, 1024, 512,
        [&](int r, int k) { return *(const uint4*)(MOUTB + (size_t)r * 512 + k); },
        [&](int n, int k) { return *(const uint4*)(WUPM_T + (size_t)n * 512 + k); },
        [&](int r, int c0, f32x4 v) {
            const f32x4 g = *(const f32x4*)(Z + (size_t)r * IN_DIM + C_GM + c0);
            f32x4 o; o[0] = sigmoidf_(g[0]) * v[0]; o[1] = sigmoidf_(g[1]) * v[1]; o[2] = sigmoidf_(g[2]) * v[2]; o[3] = sigmoidf_(g[3]) * v[3];
            *(f32x4*)(MIX + (size_t)r * 1024 + c0) = o; }, ldsb);
    gemm_bf16<128>(NR, 1024, 512,
        [&](int r, int k) { return *(const uint4*)(NOUTB + (size_t)r * 512 + k); },
        [&](int n, int k) { return *(const uint4*)(WUPN_T + (size_t)n * 512 + k); },
        [&](int r, int c0, f32x4 v) {
            const f32x4 g = *(const f32x4*)(Z + (size_t)r * IN_DIM + C_GN + c0);
            f32x4 o = *(const f32x4*)(MIX + (size_t)r * 1024 + c0);
            o[0] += sigmoidf_(g[0]) * v[0]; o[1] += sigmoidf_(g[1]) * v[1]; o[2] += sigmoidf_(g[2]) * v[2]; o[3] += sigmoidf_(g[3]) * v[3];
            store_bf16x4(MIXB + (size_t)r * 1024 + c0, o); }, ldsb);
    xcd_barrier(bar);

    gemm_bf16<128>(NR, 1024, 1024,
        [&](int r, int k) { return *(const uint4*)(MIXB + (size_t)r * 1024 + k); },
        [&](int n, int k) { return *(const uint4*)(WOUT_T + (size_t)n * 1024 + k); },
        [&](int r, int c0, f32x4 v) {
            const f32x4 xv = *(const f32x4*)((r < NP ? p.x_prompt + (size_t)r * 1024 : p.x_sample + (size_t)(r - NP) * 1024) + c0);
            *(f32x4*)(T1 + (size_t)r * 1024 + c0) = xv * DN_ALPHA + v; }, ldsb);
    xcd_barrier(bar);

    for (int row = gw; row < NR; row += nw) {
        float tv[16]; float s = 0.f;
#pragma unroll
        for (int j = 0; j < 4; ++j) { const float4 t4 = *(const float4*)(T1 + (size_t)row * 1024 + j * 256 + lane * 4); tv[4 * j] = t4.x; tv[4 * j + 1] = t4.y; tv[4 * j + 2] = t4.z; tv[4 * j + 3] = t4.w; s += (t4.x + t4.y) + (t4.z + t4.w); }
        const float mu = wave_sum(s) * (1.0f / 1024.0f);
        float q = 0.f;
#pragma unroll
        for (int j = 0; j < 16; ++j) { const float d = tv[j] - mu; q += d * d; }
        const float rstd = 1.0f / sqrtf(wave_sum(q) * (1.0f / 1024.0f) + LN_EPS);
#pragma unroll
        for (int j = 0; j < 4; ++j) {
            const int c = j * 256 + lane * 4;
            const float4 g4 = *(const float4*)(p.ln1_g + c), b4 = *(const float4*)(p.ln1_b + c);
            f32x4 o; o[0] = (tv[4 * j] - mu) * rstd * g4.x + b4.x; o[1] = (tv[4 * j + 1] - mu) * rstd * g4.y + b4.y; o[2] = (tv[4 * j + 2] - mu) * rstd * g4.z + b4.z; o[3] = (tv[4 * j + 3] - mu) * rstd * g4.w + b4.w;
            *(f32x4*)(X1 + (size_t)row * 1024 + c) = o;
            store_bf16x4(X1B + (size_t)row * 1024 + c, o);
        }
    }
    xcd_barrier(bar);

    gemm_bf16<128>(NR, 2048, 1024,
        [&](int r, int k) { return *(const uint4*)(X1B + (size_t)r * 1024 + k); },
        [&](int n, int k) { return *(const uint4*)(PWQ_T + (size_t)n * 1024 + k); },
        [&](int r, int c0, f32x4 v) { store_bf16x4(QPB + (size_t)r * 2048 + c0, v); }, ldsb);
    xcd_barrier(bar);

    for (int it = blockIdx.x; it < 513 * 8; it += gridDim.x) { __syncthreads(); peer_score_topk_item(p, it >> 3, it & 7, ldsb); }
    xcd_barrier(bar);

    for (int row = gw; row < NR; row += nw) peer_expert_wave(p, row, ldsb + w * 3072, lane);
}

extern "C" void kernel_launch(void* const* d_in, const int* in_sizes, int n_in, void* d_out, int out_size, void* d_ws, size_t ws_size, hipStream_t stream) {
    static int grid = 0;
    if (grid == 0) {
        if (n_in != 32 || (size_t)out_size != O_END || ws_size < WS_END) {
            fprintf(stderr, "kernel_launch: unexpected sizes n_in %d out %d ws %zu (need %zu)\n", n_in, out_size, ws_size, (size_t)WS_END); grid = -1; return; }
        int dev = 0, cus = 0, per_cu = 0;
        if (hipGetDevice(&dev) != hipSuccess || hipDeviceGetAttribute(&cus, hipDeviceAttributeMultiprocessorCount, dev) != hipSuccess) { grid = -1; return; }
        if (hipFuncSetAttribute((const void*)fwd_kernel, hipFuncAttributeMaxDynamicSharedMemorySize, LDS_BYTES) != hipSuccess) { fprintf(stderr, "hipFuncSetAttribute failed\n"); grid = -1; return; }
        if (hipOccupancyMaxActiveBlocksPerMultiprocessor(&per_cu, (const void*)fwd_kernel, NTHREADS, LDS_BYTES) != hipSuccess || per_cu < 1) { fprintf(stderr, "occupancy query failed (%d)\n", per_cu); (void)hipGetLastError(); per_cu = 1; }
        if (per_cu > 2) per_cu = 2;
        grid = cus * per_cu;
    }
    if (grid < 0) return;
    (void)hipMemsetAsync((char*)d_ws + WS_BAR, 0, XCD_BAR_WORDS * sizeof(unsigned), stream);
    Params p{};
    p.x_prompt = (const float*)d_in[0]; p.x_sample = (const float*)d_in[1]; p.cache_cmp = (const float*)d_in[2]; p.cache_slc = (const float*)d_in[3];
    p.page_table = (const int*)d_in[4]; p.state_win = (const float*)d_in[5]; p.state_C = (const float*)d_in[6]; p.state_n = (const float*)d_in[7];
    p.state_m = (const float*)d_in[8]; p.state_conv = (const float*)d_in[9]; p.w_in = (const float*)d_in[10]; p.conv_w = (const float*)d_in[11];
    p.conv_b = (const float*)d_in[12]; p.wq = (const float*)d_in[13]; p.wk = (const float*)d_in[14]; p.gate_bias = (const float*)d_in[15];
    p.norm_g = (const float*)d_in[16]; p.cmp_pe = (const float*)d_in[17]; p.cmp_w1 = (const float*)d_in[18]; p.cmp_w2 = (const float*)d_in[19];
    p.rel_bias = (const float*)d_in[20]; p.w_up_m = (const float*)d_in[21]; p.w_up_n = (const float*)d_in[22]; p.w_out = (const float*)d_in[23];
    p.ln1_g = (const float*)d_in[24]; p.ln1_b = (const float*)d_in[25]; p.ln2_g = (const float*)d_in[26]; p.ln2_b = (const float*)d_in[27];
    p.peer_wq = (const float*)d_in[28]; p.peer_sub = (const float*)d_in[29]; p.peer_u = (const float*)d_in[30]; p.peer_v = (const float*)d_in[31];
    p.out = (float*)d_out; p.ws = (unsigned char*)d_ws;
    hipLaunchKernelGGL(fwd_kernel, dim3(grid), dim3(NTHREADS), LDS_BYTES, stream, p);
}
```

```cpp
#include <hip/hip_runtime.h>
#include <stdint.h>
#include <cstdio>

#define DEV __device__ __forceinline__

constexpr int DM = 1024;
constexpr int BP = 16, TP = 2048, BS = 32;
constexpr int NP = BP * TP;
constexpr int NR = NP + BS;
constexpr int MP = 32896;
constexpr int IN_DIM = 4896;
constexpr int C_U = 0, C_V = 512, C_O = 1024, C_I = 1536, C_F = 1540, C_Q = 1544, C_KC = 2056, C_KS = 2312, C_KW = 2568, C_G = 2824, C_GM = 2848, C_GN = 3872;
constexpr int PAST = 16384;
constexpr float NEGF = -1e30f;
constexpr float DN_ALPHA = 1.189207115002721f;
constexpr float LN_EPS = 1e-5f;
constexpr float LOG2E = 1.4426950408889634f;

constexpr size_t O_Y = 0;
constexpr size_t O_CMPP = (size_t)NR * DM;
constexpr size_t O_CMPS = O_CMPP + (size_t)NP * 256;
constexpr size_t O_SLCP = O_CMPS + (size_t)BS * 256;
constexpr size_t O_SLCS = O_SLCP + (size_t)NP * 256;
constexpr size_t O_WINP = O_SLCS + (size_t)BS * 256;
constexpr size_t O_WINS = O_WINP + (size_t)BP * 512 * 256;
constexpr size_t O_CP = O_WINS + (size_t)BS * 512 * 256;
constexpr size_t O_CS = O_CP + (size_t)BP * 4 * 128 * 128;
constexpr size_t O_NP = O_CS + (size_t)BS * 4 * 128 * 128;
constexpr size_t O_NS = O_NP + (size_t)BP * 4 * 128;
constexpr size_t O_MP = O_NS + (size_t)BS * 4 * 128;
constexpr size_t O_MS = O_MP + (size_t)BP * 4;
constexpr size_t O_CVP = O_MS + (size_t)BS * 4;
constexpr size_t O_CVS = O_CVP + (size_t)BP * 3 * 512;
constexpr size_t O_END = O_CVS + (size_t)BS * 3 * 512;
static_assert(O_END == 59916480, "output size");

constexpr size_t al256(size_t x) { return (x + 255) & ~(size_t)255; }
constexpr size_t WS_BAR = 0;
constexpr size_t WS_Z = 16384;
constexpr size_t WS_QK = al256(WS_Z + (size_t)MP * IN_DIM * 4);
constexpr size_t WS_HRAW = al256(WS_QK + (size_t)MP * 1024 * 4);
constexpr size_t WS_MOUTB = al256(WS_HRAW + (size_t)MP * 512 * 4);
constexpr size_t WS_NOUTB = al256(WS_MOUTB + (size_t)MP * 512 * 2);
constexpr size_t WS_HIDPB = al256(WS_NOUTB + (size_t)MP * 512 * 2);
constexpr size_t WS_KCP = al256(WS_HIDPB + (size_t)2 * 4096 * 64 * 2);
constexpr size_t WS_HIDSB = al256(WS_KCP + 256);
constexpr size_t WS_KCS = al256(WS_HIDSB + (size_t)2 * 65536 * 64 * 2);
constexpr size_t WS_MIX = al256(WS_KCS + (size_t)2 * 65536 * 64 * 4);
constexpr size_t WS_MIXB = al256(WS_MIX + (size_t)MP * 1024 * 4);
constexpr size_t WS_T1 = al256(WS_MIXB + (size_t)MP * 1024 * 2);
constexpr size_t WS_X1 = al256(WS_T1 + (size_t)MP * 1024 * 4);
constexpr size_t WS_X1B = al256(WS_X1 + (size_t)MP * 1024 * 4);
constexpr size_t WS_QPB = al256(WS_X1B + (size_t)MP * 1024 * 2);
constexpr size_t WS_S = al256(WS_QPB + (size_t)MP * 2048 * 2);
constexpr size_t WS_PIDX = al256(WS_S + (size_t)MP * 2048 * 4);
constexpr size_t WS_PG = al256(WS_PIDX + (size_t)MP * 128 * 4);
constexpr size_t WS_CONVB = al256(WS_PG + (size_t)MP * 128 * 4);
constexpr size_t WS_XB = al256(WS_CONVB + (size_t)MP * 512 * 2);
constexpr size_t WS_WIN_T = al256(WS_XB + (size_t)MP * 1024 * 2);
constexpr size_t WS_WUPM_T = al256(WS_WIN_T + (size_t)IN_DIM * 1024 * 2);
constexpr size_t WS_WUPN_T = al256(WS_WUPM_T + (size_t)1024 * 512 * 2);
constexpr size_t WS_WOUT_T = al256(WS_WUPN_T + (size_t)1024 * 512 * 2);
constexpr size_t WS_PWQ_T = al256(WS_WOUT_T + (size_t)1024 * 1024 * 2);
constexpr size_t WS_WQK_T = al256(WS_PWQ_T + (size_t)2048 * 1024 * 2);
constexpr size_t WS_W1_T = al256(WS_WQK_T + (size_t)4 * 256 * 128 * 2);
constexpr size_t WS_PESUM = al256(WS_W1_T + (size_t)2 * 128 * 1024 * 2);
constexpr size_t WS_W2_T = al256(WS_PESUM + 512);
constexpr size_t WS_SUBK = al256(WS_W2_T + (size_t)2 * 64 * 64 * 2);
constexpr size_t WS_ZB = al256(WS_SUBK + (size_t)2 * 128 * 128 * 2);
constexpr size_t WS_VTS = al256(WS_ZB + (size_t)MP * IN_DIM * 2);
constexpr size_t WS_VTW = al256(WS_VTS + (size_t)16 * 2 * 64 * 2048 * 2);
constexpr size_t WS_KCB = al256(WS_VTW + (size_t)16 * 2 * 64 * 2048 * 2);
constexpr size_t WS_VTC = al256(WS_KCB + (size_t)16 * 2 * 128 * 64 * 2);
constexpr size_t WS_NOUTF = al256(WS_VTC + (size_t)16 * 2 * 64 * 128 * 2);
constexpr size_t WS_U8 = al256(WS_NOUTF + (size_t)NP * 512 * 4);
constexpr size_t WS_V8 = al256(WS_U8 + (size_t)16384 * 1024);
constexpr size_t WS_QB = al256(WS_V8 + (size_t)16384 * 1024);
constexpr size_t WS_KB = al256(WS_QB + (size_t)MP * 512 * 2);
constexpr size_t WS_KTB = al256(WS_KB + (size_t)MP * 512 * 2);
constexpr size_t WS_VTM = al256(WS_KTB + (size_t)16 * 512 * 2048 * 2);
constexpr size_t WS_KCSB = al256(WS_VTM + (size_t)16 * 512 * 2048 * 2);
constexpr size_t WS_VTCS = al256(WS_KCSB + (size_t)32 * 2 * 1024 * 64 * 2);
constexpr size_t WS_END = al256(WS_VTCS + (size_t)32 * 2 * 64 * 1024 * 2);

static_assert(WS_END <= 2684354560ull, "workspace too large");
constexpr int LDS_BYTES = 73728;
constexpr int NTHREADS = 256;

struct Params {
    const float* x_prompt; const float* x_sample; const float* cache_cmp; const float* cache_slc; const int* page_table;
    const float* state_win; const float* state_C; const float* state_n; const float* state_m; const float* state_conv;
    const float* w_in; const float* conv_w; const float* conv_b; const float* wq; const float* wk; const float* gate_bias; const float* norm_g;
    const float* cmp_pe; const float* cmp_w1; const float* cmp_w2; const float* rel_bias; const float* w_up_m; const float* w_up_n; const float* w_out;
    const float* ln1_g; const float* ln1_b; const float* ln2_g; const float* ln2_b; const float* peer_wq; const float* peer_sub; const float* peer_u; const float* peer_v;
    float* out; unsigned char* ws;
};

#define XB_TMO      128
#define XB_XCNT(j)  (256  + 64 * (j))
#define XB_XSUB(j)  (1280 + 64 * (j))
#define XB_XGEN(j)  (2304 + 64 * (j))
#define XB_TOP      3328
#define XB_TOPGEN   3392
#define XCD_BAR_WORDS 3456
#define XB_SPIN_CAP (1u << 22)
#define LAS __attribute__((address_space(3)))

__device__ __forceinline__ unsigned xb_ld(unsigned* p)              { return __hip_atomic_load(p, __ATOMIC_RELAXED, __HIP_MEMORY_SCOPE_AGENT); }
__device__ __forceinline__ unsigned xb_add(unsigned* p, unsigned v) { return __hip_atomic_fetch_add(p, v, __ATOMIC_RELAXED, __HIP_MEMORY_SCOPE_AGENT); }
__device__ __forceinline__ unsigned xb_xcc_id() { return (unsigned)__builtin_amdgcn_s_getreg((3 << 11) | 20) & 0xFu; }
#define XB_SPIN(cond, bar) do { unsigned _sp = 0; while (cond) { __builtin_amdgcn_s_sleep(1); \
    if ((++_sp & 255u) == 0u) { if (xb_ld(&(bar)[XB_TMO])) break; if (_sp > XB_SPIN_CAP) { atomicAdd(&(bar)[XB_TMO], 1u); break; } } } } while (0)

struct XcdBarrier { unsigned* bar; unsigned x; volatile LAS unsigned* st; };

__device__ __forceinline__ XcdBarrier xcd_barrier_post(unsigned* bar, volatile LAS unsigned* st) {
    XcdBarrier b; b.bar = bar; b.x = xb_xcc_id(); b.st = st;
    if (threadIdx.x == 0) (void)xb_add(&bar[XB_XCNT(b.x)], 1u);
    return b;
}
__device__ __forceinline__ void xcd_barrier_complete(unsigned* bar, unsigned x, unsigned& nloc, unsigned& nx) {
    const unsigned G = gridDim.x * gridDim.y * gridDim.z;
    unsigned sum, cnt, mine, sp = 0u;
    for (;;) {
        sum = 0u; cnt = 0u; mine = 0u;
#pragma unroll
        for (unsigned j = 0; j < 16; ++j) { const unsigned c = xb_ld(&bar[XB_XCNT(j)]); sum += c; cnt += (c > 0u) ? 1u : 0u; mine = (j == x) ? c : mine; }
        if (sum == G) break;
        __builtin_amdgcn_s_sleep(1);
        if ((++sp & 255u) == 0u) { if (xb_ld(&bar[XB_TMO])) break; if (sp > XB_SPIN_CAP) { atomicAdd(&bar[XB_TMO], 1u); break; } }
    }
    nloc = mine > 0u ? mine : 1u; nx = cnt > 0u ? cnt : 1u;
}
__device__ __forceinline__ void xcd_barrier(const XcdBarrier& b) {
    asm volatile("s_waitcnt vmcnt(0)" ::: "memory");
    __syncthreads();
    if (threadIdx.x == 0) {
        unsigned* bar = b.bar;
        __builtin_amdgcn_s_waitcnt(0);
        unsigned nloc = b.st[0], nx = b.st[1];
        if (nloc == 0u) { xcd_barrier_complete(bar, b.x, nloc, nx); b.st[0] = nloc; b.st[1] = nx; }
        const unsigned old = xb_add(&bar[XB_XSUB(b.x)], 1u);
        const unsigned gen = old / nloc;
        if (old + 1u == (gen + 1u) * nloc) {
            __builtin_amdgcn_fence(__ATOMIC_RELEASE, "agent");
            asm volatile("s_waitcnt vmcnt(0)" ::: "memory");
            const unsigned og = xb_add(&bar[XB_TOP], 1u);
            const unsigned tg = og / nx;
            if (og + 1u == (tg + 1u) * nx) xb_add(&bar[XB_TOPGEN], 1u);
            else XB_SPIN(xb_ld(&bar[XB_TOPGEN]) == tg, bar);
            __builtin_amdgcn_fence(__ATOMIC_ACQUIRE, "agent");
            xb_add(&bar[XB_XGEN(b.x)], 1u);
            asm volatile("s_waitcnt vmcnt(0)" ::: "memory");
        } else {
            XB_SPIN(xb_ld(&bar[XB_XGEN(b.x)]) == gen, bar);
            __builtin_amdgcn_fence(__ATOMIC_ACQUIRE, "agent");
            asm volatile("s_waitcnt vmcnt(0)" ::: "memory");
        }
    }
    __syncthreads();
}

typedef float f32x4 __attribute__((ext_vector_type(4)));

__device__ const unsigned char REL_LUT[128] = {
    0, 1, 2, 3, 4, 5, 6, 7, 8, 9, 10, 11, 12, 13, 14, 15, 16, 16, 16, 17, 17, 18, 18, 18, 19, 19, 19, 20, 20, 20, 20, 21, 21, 21, 21, 22, 22, 22, 22, 22,
    23, 23, 23, 23, 23, 23, 24, 24, 24, 24, 24, 24, 25, 25, 25, 25, 25, 25, 25, 26, 26, 26, 26, 26, 26, 26, 26, 27, 27, 27, 27, 27, 27, 27, 27, 27, 27,
    28, 28, 28, 28, 28, 28, 28, 28, 28, 28, 29, 29, 29, 29, 29, 29, 29, 29, 29, 29, 29, 29, 30, 30, 30, 30, 30, 30, 30, 30, 30, 30, 30, 30, 30, 30,
    31, 31, 31, 31, 31, 31, 31, 31, 31, 31, 31, 31, 31, 31, 31};
DEV int rel_bucket(int n) { return n < 128 ? (int)REL_LUT[n < 0 ? 0 : n] : 31; }

DEV float sigmoidf_(float x) { return 1.0f / (1.0f + expf(-x)); }
DEV float gelu_tanh(float x) { return 0.5f * x * (1.0f + tanhf(0.7978845608028654f * (x + 0.044715f * x * x * x))); }
DEV float log_sigmoid(float x) { return x >= 0.f ? -log1pf(expf(-x)) : x - log1pf(expf(x)); }
DEV void wave_sync() { asm volatile("s_waitcnt lgkmcnt(0)" ::: "memory"); __builtin_amdgcn_wave_barrier(); asm volatile("" ::: "memory"); }
DEV float wave_sum(float v) {
#pragma unroll
    for (int o = 32; o >= 1; o >>= 1) v += __shfl_xor(v, o);
    return v;
}
DEV float wave_max(float v) {
#pragma unroll
    for (int o = 32; o >= 1; o >>= 1) v = fmaxf(v, __shfl_xor(v, o));
    return v;
}

typedef unsigned short bf16_t;
typedef short bf16x8 __attribute__((ext_vector_type(8)));
typedef float f32x2_ __attribute__((ext_vector_type(2)));
typedef __bf16 bf16x2_ __attribute__((ext_vector_type(2)));
DEV unsigned cvt_pk_bf16(float lo, float hi) { const f32x2_ v = {lo, hi}; return __builtin_bit_cast(unsigned, __builtin_convertvector(v, bf16x2_)); }
DEV float bf_lo(unsigned w) { return __uint_as_float(w << 16); }
DEV float bf_hi(unsigned w) { return __uint_as_float(w & 0xffff0000u); }
DEV uint4 pack8(const float* f) { uint4 r; r.x = cvt_pk_bf16(f[0], f[1]); r.y = cvt_pk_bf16(f[2], f[3]); r.z = cvt_pk_bf16(f[4], f[5]); r.w = cvt_pk_bf16(f[6], f[7]); return r; }
DEV void store_bf16x4(bf16_t* p, f32x4 v) { uint2 w; w.x = cvt_pk_bf16(v[0], v[1]); w.y = cvt_pk_bf16(v[2], v[3]); *(uint2*)p = w; }

DEV void transpose_to_bf16(const float* __restrict__ src, const int K, const int N, bf16_t* __restrict__ dst, const size_t gt, const size_t nt) {
    const size_t items = (size_t)N * (K >> 3);
    for (size_t id = gt; id < items; id += nt) {
        const int n = (int)(id % N), k8 = (int)(id / N) * 8;
        float f[8];
#pragma unroll
        for (int i = 0; i < 8; ++i) f[i] = src[(size_t)(k8 + i) * N + n];
        *(uint4*)(dst + (size_t)n * K + k8) = pack8(f);
    }
}

template <int BN, bool TILE_EPI = false, class LA, class LB, class EF>
DEV void gemm_bf16(const int M, const int N, const int K, LA la, LB lb, EF ef, unsigned char* lds, const int toff = 0) {
    constexpr int TJ = BN / 32;
    constexpr int NB = BN / 32;
    constexpr int LDR = 144;
    const int tid = threadIdx.x, lane = tid & 63, w = tid >> 6, wm = w >> 1, wn = w & 1;
    const int tm = (M + 127) >> 7, tn = (N + BN - 1) / BN;
    unsigned char* As = lds;
    unsigned char* Bs = lds + 128 * LDR;
    const int lr = lane & 15, lq = lane >> 4;
    for (int tile = (int)((blockIdx.x + gridDim.x - (unsigned)toff % gridDim.x) % gridDim.x); tile < tm * tn; tile += gridDim.x) {
        const int bm = (tile / tn) * 128, bn = (tile % tn) * BN;
        f32x4 acc[4][TJ];
#pragma unroll
        for (int i = 0; i < 4; ++i)
#pragma unroll
            for (int j = 0; j < TJ; ++j) acc[i][j] = (f32x4){0.f, 0.f, 0.f, 0.f};
        uint4 ra[4], rb[NB];
        int arow[4], brow[NB];
#pragma unroll
        for (int i = 0; i < 4; ++i) { const int r = bm + ((tid + 256 * i) >> 3); arow[i] = r < M ? r : M - 1; }
#pragma unroll
        for (int i = 0; i < NB; ++i) { const int n = bn + ((tid + 256 * i) >> 3); brow[i] = n < N ? n : N - 1; }
        const int kc = (tid & 7) * 8;
#pragma unroll
        for (int i = 0; i < 4; ++i) ra[i] = la(arow[i], kc);
#pragma unroll
        for (int i = 0; i < NB; ++i) rb[i] = lb(brow[i], kc);
        for (int k0_ = 0; k0_ < K; k0_ += 64) {
            int k0 = k0_; asm volatile("" : "+v"(k0));
            __syncthreads();
#pragma unroll
            for (int i = 0; i < 4; ++i) *(uint4*)(As + ((tid + 256 * i) >> 3) * LDR + (tid & 7) * 16) = ra[i];
#pragma unroll
            for (int i = 0; i < NB; ++i) *(uint4*)(Bs + ((tid + 256 * i) >> 3) * LDR + (tid & 7) * 16) = rb[i];
            __syncthreads();
            if (k0_ + 64 < K) {
#pragma unroll
                for (int i = 0; i < 4; ++i) ra[i] = la(arow[i], k0 + 64 + kc);
#pragma unroll
                for (int i = 0; i < NB; ++i) rb[i] = lb(brow[i], k0 + 64 + kc);
            }
#pragma unroll
            for (int kk = 0; kk < 2; ++kk) {
                bf16x8 a[4], b[TJ];
#pragma unroll
                for (int i = 0; i < 4; ++i) a[i] = *(const bf16x8*)(As + (wm * 64 + i * 16 + lr) * LDR + kk * 64 + lq * 16);
#pragma unroll
                for (int j = 0; j < TJ; ++j) b[j] = *(const bf16x8*)(Bs + (wn * (BN / 2) + j * 16 + lr) * LDR + kk * 64 + lq * 16);
#pragma unroll
                for (int i = 0; i < 4; ++i)
#pragma unroll
                    for (int j = 0; j < TJ; ++j) acc[i][j] = __builtin_amdgcn_mfma_f32_16x16x32_bf16(b[j], a[i], acc[i][j], 0, 0, 0);
            }
        }
        if constexpr (TILE_EPI) { ef(acc, bm); }
        else {
#pragma unroll
            for (int i = 0; i < 4; ++i)
#pragma unroll
                for (int j = 0; j < TJ; ++j) {
                    const int r = bm + wm * 64 + i * 16 + lr, c0 = bn + wn * (BN / 2) + j * 16 + lq * 4;
                    if (r < M && c0 < N) ef(r, c0, acc[i][j]);
                }
        }
    }
}

template <class KeyF>
DEV void wave_attn(const float* qs, float* sb, const int nkeys, KeyF keyf, const float* __restrict__ rel_bias, const int hkv, const int lane, float (&o)[4]) {
    float mx[4] = {NEGF, NEGF, NEGF, NEGF};
    for (int base = 0; base < nkeys; base += 64) {
        asm volatile("" ::: "memory");
        const int idx = base + lane;
        const float* kp = nullptr; const float* vp = nullptr; int dist = 0;
        bool valid = false;
        if (idx < nkeys) valid = keyf(idx, kp, vp, dist);
        float sc[4] = {0.f, 0.f, 0.f, 0.f};
        if (valid) {
#pragma unroll 1
            for (int d4 = 0; d4 < 16; ++d4) {
                asm volatile("" ::: "memory");
                const float4 kv = ((const float4*)kp)[d4];
#pragma unroll
                for (int g = 0; g < 4; ++g) {
                    const float4 qv = *(const float4*)(qs + g * 64 + d4 * 4);
                    sc[g] += qv.x * kv.x + qv.y * kv.y + qv.z * kv.z + qv.w * kv.w;
                }
            }
            const int bk = rel_bucket(dist);
#pragma unroll
            for (int g = 0; g < 4; ++g) sc[g] += rel_bias[bk * 8 + hkv * 4 + g];
        }
#pragma unroll
        for (int g = 0; g < 4; ++g) {
            const float v = valid ? sc[g] : NEGF;
            if (idx < nkeys) sb[g * 1024 + idx] = v;
            mx[g] = fmaxf(mx[g], v);
        }
    }
    float inv[4];
#pragma unroll
    for (int g = 0; g < 4; ++g) mx[g] = wave_max(mx[g]);
    wave_sync();
    float sum[4] = {0.f, 0.f, 0.f, 0.f};
    for (int idx = lane; idx < nkeys; idx += 64) {
#pragma unroll
        for (int g = 0; g < 4; ++g) {
            const float v = sb[g * 1024 + idx];
            const float e = (v > -1e29f) ? expf(v - mx[g]) : 0.f;
            sb[g * 1024 + idx] = e;
            sum[g] += e;
        }
    }
#pragma unroll
    for (int g = 0; g < 4; ++g) { sum[g] = wave_sum(sum[g]); inv[g] = 1.0f / fmaxf(sum[g], 1e-30f); }
    for (int idx = lane; idx < nkeys; idx += 64) {
#pragma unroll
        for (int g = 0; g < 4; ++g) sb[g * 1024 + idx] *= inv[g];
    }
    wave_sync();
#pragma unroll
    for (int g = 0; g < 4; ++g) o[g] = 0.f;
    for (int idx = 0; idx < nkeys; ++idx) {
        const float p0 = sb[idx], p1 = sb[1024 + idx], p2 = sb[2048 + idx], p3 = sb[3072 + idx];
        if (p0 + p1 + p2 + p3 == 0.f) continue;
        const float* kp = nullptr; const float* vp = nullptr; int dist = 0;
        (void)keyf(idx, kp, vp, dist);
        const float vv = vp[lane];
        o[0] += p0 * vv; o[1] += p1 * vv; o[2] += p2 * vv; o[3] += p3 * vv;
    }
}

DEV void nsa_item(const Params& p, const int row, const int hkv, float* wl, const int lane) {
    float* qs = wl; float* sb = wl + 256; int* sel = (int*)(wl + 256 + 4096);
    const float* Z = (const float*)(p.ws + WS_Z);
    bf16_t* NOUT = (bf16_t*)(p.ws + WS_NOUTB);
    const float* KCP = (const float*)(p.ws + WS_KCP);
    const float* KCS = (const float*)(p.ws + WS_KCS);
    const bool pr = row < NP;
    const int b = pr ? (row >> 11) : (row - NP);
    const int t = pr ? (row & 2047) : 0;
    const int qpos = pr ? t : PAST;
    const float* zrow = Z + (size_t)row * IN_DIM;
    wave_sync();
    for (int i = lane; i < 256; i += 64) qs[i] = zrow[C_Q + hkv * 256 + i] * 0.125f;
    wave_sync();
    float o[4];
    float gate[3][4];
#pragma unroll
    for (int br = 0; br < 3; ++br)
#pragma unroll
        for (int g = 0; g < 4; ++g) gate[br][g] = sigmoidf_(zrow[C_G + br * 8 + hkv * 4 + g]);
    bf16_t* nrow = NOUT + (size_t)row * 512 + hkv * 256;
    float res[4];
    const int nkc = pr ? 127 : 1023;
    {
        const float* kbase = pr ? (KCP + ((size_t)(b * 128) * 2 + hkv) * 64) : (KCS + ((size_t)(b * 1024) * 2 + hkv) * 64);
        const size_t plane = pr ? (size_t)4096 * 64 : (size_t)65536 * 64;
        auto keyf = [&](int idx, const float*& kp, const float*& vp, int& dist) -> bool {
            kp = kbase + (size_t)idx * 128; vp = kp + plane; dist = qpos - (16 * idx + 31); return dist >= 0; };
        wave_attn(qs, sb, nkc, keyf, p.rel_bias, hkv, lane, o);
#pragma unroll
        for (int g = 0; g < 4; ++g) res[g] = gate[0][g] * o[g];
    }
    const int nblk = pr ? 32 : 257;
    for (int i = lane; i < nkc; i += 64) sb[i] = ((sb[i] + sb[1024 + i]) + sb[2048 + i]) + sb[3072 + i];
    wave_sync();
    {
        const int cur = qpos >> 6;
        for (int blk = lane; blk < nblk; blk += 64) {
            float s = 0.f;
#pragma unroll
            for (int cc = 0; cc < 4; ++cc) {
                const int c = 4 * blk + cc;
                const float a0 = (c < nkc) ? sb[c] : 0.f;
                const float a1 = (c >= 1 && c - 1 < nkc) ? sb[c - 1] : 0.f;
                s += a0 + a1;
            }
            const bool causal = blk * 64 <= qpos;
            const bool forced = (blk == 0) || (blk == cur) || (blk == cur - 1);
            sb[1024 + blk] = causal ? (forced ? 1e4f : s) : NEGF;
        }
        wave_sync();
        for (int blk = lane; blk < nblk; blk += 64) {
            const float my = sb[1024 + blk];
            int rank = 0;
            for (int j = 0; j < nblk; ++j) { const float o2 = sb[1024 + j]; rank += ((o2 > my) || (o2 == my && j < blk)) ? 1 : 0; }
            if (rank < 16) sel[rank] = (blk * 64 <= qpos) ? blk : -1;
        }
        wave_sync();
    }
    {
        const float* zb = Z + (size_t)(pr ? b * 2048 : 0) * IN_DIM;
        auto keyf = [&](int idx, const float*& kp, const float*& vp, int& dist) -> bool {
            const int blk = sel[idx >> 6], s = idx & 63;
            if (blk < 0) return false;
            const int kpos = blk * 64 + s;
            if (kpos > qpos) return false;
            dist = qpos - kpos;
            if (pr) { kp = zb + (size_t)kpos * IN_DIM + C_KS + hkv * 64; }
            else if (blk < 256) { const int page = p.page_table[b * 128 + (blk >> 1)]; kp = p.cache_slc + ((size_t)page * 128 + (blk & 1) * 64 + s) * 256 + hkv * 64; }
            else { kp = zrow + C_KS + hkv * 64; }
            vp = kp + 128; return true; };
        wave_attn(qs, sb, 1024, keyf, p.rel_bias, hkv, lane, o);
#pragma unroll
        for (int g = 0; g < 4; ++g) res[g] += gate[1][g] * o[g];
    }
    {
        const float* zb = Z + (size_t)(pr ? b * 2048 : 0) * IN_DIM;
        const int nk = pr ? ((t + 1 < 512) ? t + 1 : 512) : 512;
        auto keyf = [&](int idx, const float*& kp, const float*& vp, int& dist) -> bool {
            if (pr) { const int kpos = t - nk + 1 + idx; dist = t - kpos; kp = zb + (size_t)kpos * IN_DIM + C_KW + hkv * 64; }
            else { const int j = idx + 1; dist = 512 - j; kp = (j < 512) ? (p.state_win + ((size_t)b * 512 + j) * 256 + hkv * 64) : (zrow + C_KW + hkv * 64); }
            vp = kp + 128; return true; };
        wave_attn(qs, sb, nk, keyf, p.rel_bias, hkv, lane, o);
#pragma unroll
        for (int g = 0; g < 4; ++g) res[g] += gate[2][g] * o[g];
    }
#pragma unroll
    for (int g = 0; g < 4; ++g) nrow[g * 64 + lane] = (bf16_t)(cvt_pk_bf16(res[g], 0.f) & 0xffffu);
}

DEV void mlstm_scan_item(const Params& p, const int item, float* lds) {
    const int tid = threadIdx.x, v = tid >> 1, kh = tid & 1;
    const int seq = item >> 2, h = item & 3;
    const bool pr = seq < 16; const int b = pr ? seq : seq - 16;
    const int T = pr ? 2048 : 1; const int row0 = pr ? b * 2048 : NP + b;
    const float* Z = (const float*)(p.ws + WS_Z);
    const float* QK = (const float*)(p.ws + WS_QK);
    float* HRAW = (float*)(p.ws + WS_HRAW);
    float C[64], n[64]; float m;
    if (pr) {
#pragma unroll
        for (int j = 0; j < 64; ++j) { C[j] = 0.f; n[j] = 0.f; }
        m = 0.f;
    } else {
        const float* c0 = p.state_C + (((size_t)(b * 4 + h) * 128 + v) * 128 + kh * 64);
        const float* n0 = p.state_n + ((size_t)(b * 4 + h) * 128 + kh * 64);
#pragma unroll
        for (int j = 0; j < 64; ++j) { C[j] = c0[j]; n[j] = n0[j]; }
        m = p.state_m[b * 4 + h];
    }
    const float gb_i = p.gate_bias[h], gb_f = p.gate_bias[4 + h];
    auto load_tok = [&](int t, float* dst) {
        const size_t r = (size_t)(row0 + t);
        dst[tid] = QK[r * 1024 + h * 256 + tid];
        if (tid < 128) dst[256 + tid] = Z[r * IN_DIM + C_V + h * 128 + tid];
        if (tid == 128) dst[384] = Z[r * IN_DIM + C_I + h] + gb_i;
        if (tid == 129) dst[385] = log_sigmoid(Z[r * IN_DIM + C_F + h] + gb_f);
    };
    __syncthreads();
    load_tok(0, lds);
    __syncthreads();
    for (int t = 0; t < T; ++t) {
        const float* cur = lds + (t & 1) * 388;
        if (t + 1 < T) load_tok(t + 1, lds + ((t + 1) & 1) * 388);
        const float ig = cur[384], lf = cur[385];
        const float mn = fmaxf(lf + m, ig);
        const float fd = expf(lf + m - mn), iw = expf(ig - mn);
        const float vv = cur[256 + v] * iw;
        float nump = 0.f, denp = 0.f;
#pragma unroll
        for (int j = 0; j < 64; ++j) {
            const float kj = cur[128 + kh * 64 + j], qj = cur[kh * 64 + j];
            C[j] = fd * C[j] + vv * kj; n[j] = fd * n[j] + iw * kj;
            nump += C[j] * qj; denp += n[j] * qj;
        }
        nump += __shfl_xor(nump, 1); denp += __shfl_xor(denp, 1);
        const float hval = nump / fmaxf(fabsf(denp), expf(-mn));
        if (kh == 0) HRAW[(size_t)(row0 + t) * 512 + h * 128 + v] = hval;
        m = mn;
        __syncthreads();
    }
    float* co = p.out + (pr ? O_CP : O_CS) + (((size_t)(b * 4 + h) * 128 + v) * 128 + kh * 64);
#pragma unroll
    for (int j = 0; j < 64; ++j) co[j] = C[j];
    if (v == 0) {
        float* no = p.out + (pr ? O_NP : O_NS) + ((size_t)(b * 4 + h) * 128 + kh * 64);
#pragma unroll
        for (int j = 0; j < 64; ++j) no[j] = n[j];
    }
    if (tid == 0) p.out[(pr ? O_MP : O_MS) + b * 4 + h] = m;
}

DEV void peer_topk_item(const Params& p, const int row, const int h, const int lane) {
    const float* S = (const float*)(p.ws + WS_S) + (size_t)row * 2048 + h * 256;
    int* PIDX = (int*)(p.ws + WS_PIDX); float* PG = (float*)(p.ws + WS_PG);
    float ts[2]; int ti[2];
#pragma unroll
    for (int pp = 0; pp < 2; ++pp) {
        float v0 = S[pp * 128 + lane], v1 = S[pp * 128 + 64 + lane];
        float mys = 0.f; int myi = 0;
        for (int r = 0; r < 16; ++r) {
            float best = fmaxf(v0, v1); int bi = (v0 >= v1) ? lane : lane + 64;
#pragma unroll
            for (int off = 32; off >= 1; off >>= 1) {
                const float ob = __shfl_xor(best, off); const int oi = __shfl_xor(bi, off);
                if (ob > best || (ob == best && oi < bi)) { best = ob; bi = oi; }
            }
            if (lane == r) { mys = best; myi = bi; }
            if (bi == lane) v0 = -INFINITY;
            if (bi == lane + 64) v1 = -INFINITY;
        }
        ts[pp] = mys; ti[pp] = myi;
    }
    float cv[4];
#pragma unroll
    for (int jj = 0; jj < 4; ++jj) { const int c = lane * 4 + jj; cv[jj] = __shfl(ts[0], c >> 4) + __shfl(ts[1], c & 15); }
    float msc = 0.f; int mci = 0;
    for (int r = 0; r < 16; ++r) {
        float best = cv[0]; int bi = lane * 4;
#pragma unroll
        for (int jj = 1; jj < 4; ++jj) if (cv[jj] > best) { best = cv[jj]; bi = lane * 4 + jj; }
#pragma unroll
        for (int off = 32; off >= 1; off >>= 1) {
            const float ob = __shfl_xor(best, off); const int oi = __shfl_xor(bi, off);
            if (ob > best || (ob == best && oi < bi)) { best = ob; bi = oi; }
        }
        if (lane == r) { msc = best; mci = bi; }
#pragma unroll
        for (int jj = 0; jj < 4; ++jj) if (bi == lane * 4 + jj) cv[jj] = -INFINITY;
    }
    const int e = __shfl(ti[0], mci >> 4) * 128 + __shfl(ti[1], mci & 15);
    const float top = __shfl(msc, 0);
    float ex = (lane < 16) ? expf(msc - top) : 0.f;
    const float den = wave_sum(ex);
    if (lane < 16) { PIDX[(size_t)row * 128 + h * 16 + lane] = e; PG[(size_t)row * 128 + h * 16 + lane] = ex / den; }
}

DEV void peer_expert_item(const Params& p, const int row, float* lds) {
    const int tid = threadIdx.x, lane = tid & 63, w = tid >> 6;
    const float* X1 = (const float*)(p.ws + WS_X1) + (size_t)row * 1024;
    const int* PIDX = (const int*)(p.ws + WS_PIDX) + (size_t)row * 128;
    const float* PG = (const float*)(p.ws + WS_PG) + (size_t)row * 128;
    float4 x[4], acc[4];
#pragma unroll
    for (int j = 0; j < 4; ++j) { x[j] = *(const float4*)(X1 + j * 256 + lane * 4); acc[j] = make_float4(0.f, 0.f, 0.f, 0.f); }
    for (int k = 0; k < 32; ++k) {
        const int e = PIDX[w * 32 + k]; const float gk = PG[w * 32 + k];
        const float* ur = p.peer_u + (size_t)e * 1024; const float* vr = p.peer_v + (size_t)e * 1024;
        float d = 0.f;
#pragma unroll
        for (int j = 0; j < 4; ++j) { const float4 u = *(const float4*)(ur + j * 256 + lane * 4); d += u.x * x[j].x + u.y * x[j].y + u.z * x[j].z + u.w * x[j].w; }
        d = wave_sum(d);
        const float coef = gk * gelu_tanh(d);
#pragma unroll
        for (int j = 0; j < 4; ++j) { const float4 vv = *(const float4*)(vr + j * 256 + lane * 4);
            acc[j].x += coef * vv.x; acc[j].y += coef * vv.y; acc[j].z += coef * vv.z; acc[j].w += coef * vv.w; }
    }
    __syncthreads();
#pragma unroll
    for (int j = 0; j < 4; ++j) *(float4*)(lds + w * 1024 + j * 256 + lane * 4) = acc[j];
    __syncthreads();
    float tv[4]; float s = 0.f;
#pragma unroll
    for (int i = 0; i < 4; ++i) { const int c = tid * 4 + i; const float po = (lds[c] + lds[1024 + c]) + (lds[2048 + c] + lds[3072 + c]); tv[i] = DN_ALPHA * X1[c] + po; s += tv[i]; }
    float* red = lds + 4096;
    s = wave_sum(s);
    if (lane == 0) red[w] = s;
    __syncthreads();
    const float mu = (red[0] + red[1] + red[2] + red[3]) * (1.0f / 1024.0f);
    float q = 0.f;
#pragma unroll
    for (int i = 0; i < 4; ++i) { const float d = tv[i] - mu; q += d * d; }
    q = wave_sum(q);
    if (lane == 0) red[8 + w] = q;
    __syncthreads();
    const float var = (red[8] + red[9] + red[10] + red[11]) * (1.0f / 1024.0f);
    const float rstd = 1.0f / sqrtf(var + LN_EPS);
    float* y = p.out + O_Y + (size_t)row * 1024;
#pragma unroll
    for (int i = 0; i < 4; ++i) { const int c = tid * 4 + i; y[c] = (tv[i] - mu) * rstd * p.ln2_g[c] + p.ln2_b[c]; }
}

DEV void mlstm_chunk_item(const Params& p, const int item, unsigned char* lds) {
    int tid_ = threadIdx.x; asm volatile("" : "+v"(tid_));
    const int tid = tid_, lane = tid & 63, w = tid >> 6, lr = lane & 15, lq = lane >> 4;
    const int b = item >> 4, h = (item >> 2) & 3, vs = item & 3;
    bf16_t* Cl = (bf16_t*)lds;
    bf16_t* nl = (bf16_t*)(lds + 8704);
    float* uL = (float*)(lds + 8960); float* ML = uL + 64; float* scin = uL + 128; float* expm = uL + 192; float* wts = uL + 256; float* misc = uL + 320;
    const bf16_t* QB = (const bf16_t*)(p.ws + WS_QB) + (size_t)(b * 2048) * 512 + h * 128;
    const bf16_t* KB = (const bf16_t*)(p.ws + WS_KB) + (size_t)(b * 2048) * 512 + h * 128;
    const bf16_t* KTB = (const bf16_t*)(p.ws + WS_KTB) + (size_t)((b * 4 + h) * 128) * 2048;
    const bf16_t* VTM = (const bf16_t*)(p.ws + WS_VTM) + (size_t)(b * 512 + h * 128 + vs * 32) * 2048;
    const float* Z = (const float*)(p.ws + WS_Z);
    float* HRAW = (float*)(p.ws + WS_HRAW);
    const float gb_i = p.gate_bias[h], gb_f = p.gate_bias[4 + h];
    f32x4 Cm[2][2], nm[2];
#pragma unroll
    for (int i = 0; i < 2; ++i) { nm[i] = (f32x4){0.f, 0.f, 0.f, 0.f};
#pragma unroll
        for (int j = 0; j < 2; ++j) Cm[i][j] = (f32x4){0.f, 0.f, 0.f, 0.f}; }
    float m_prev = 0.f;
    __syncthreads();
    for (int i = tid; i < (8704 + 256) / 4; i += 256) ((unsigned*)lds)[i] = 0u;
    __syncthreads();
    for (int c = 0; c < 32; ++c) {
        const int t0 = c * 64;
        if (w == 0) {
            const size_t row = (size_t)(b * 2048 + t0 + lane);
            const float ig = Z[row * IN_DIM + C_I + h] + gb_i;
            const float lf = log_sigmoid(Z[row * IN_DIM + C_F + h] + gb_f);
            float bc = lf;
#pragma unroll
            for (int o = 1; o < 64; o <<= 1) { const float t = __shfl_up(bc, o); if (lane >= o) bc += t; }
            const float u = ig - bc;
            float pm = u;
#pragma unroll
            for (int o = 1; o < 64; o <<= 1) { const float t = __shfl_up(pm, o); if (lane >= o) pm = fmaxf(pm, t); }
            const float M = fmaxf(m_prev, pm);
            const float M63 = __shfl(M, 63), b63 = __shfl(bc, 63);
            uL[lane] = u; ML[lane] = M; scin[lane] = expf(m_prev - M); expm[lane] = expf(-(bc + M)); wts[lane] = expf(u - M63);
            if (lane == 0) { misc[0] = expf(m_prev - M63); misc[1] = b63 + M63; }
        }
        __syncthreads();
        {
            const size_t row_t = (size_t)(t0 + w * 16 + lr);
            bf16x8 Qf[4];
#pragma unroll
            for (int ks = 0; ks < 4; ++ks) Qf[ks] = *(const bf16x8*)(QB + row_t * 512 + ks * 32 + lq * 8);
            const float M_t = ML[w * 16 + lr], sc_in = scin[w * 16 + lr], em = expm[w * 16 + lr];
            f32x4 sw[4];
            float dsum = 0.f;
#pragma unroll
            for (int st = 0; st < 4; ++st) {
                f32x4 a = (f32x4){0.f, 0.f, 0.f, 0.f};
                if (st <= w) {
#pragma unroll
                    for (int ks = 0; ks < 4; ++ks) { const bf16x8 kf = *(const bf16x8*)(KB + (size_t)(t0 + st * 16 + lr) * 512 + ks * 32 + lq * 8); a = __builtin_amdgcn_mfma_f32_16x16x32_bf16(kf, Qf[ks], a, 0, 0, 0); }
#pragma unroll
                    for (int g = 0; g < 4; ++g) {
                        const int sl = st * 16 + lq * 4 + g, tl = w * 16 + lr;
                        const float wg = (sl <= tl) ? __builtin_amdgcn_exp2f((uL[sl] - M_t) * LOG2E) : 0.f;
                        a[g] *= wg; dsum += a[g];
                    }
                }
                sw[st] = a;
            }
            dsum += __shfl_xor(dsum, 16); dsum += __shfl_xor(dsum, 32);
            bf16x8 pf[2];
#pragma unroll
            for (int ks = 0; ks < 2; ++ks) {
                union { bf16x8 v; unsigned u[4]; } pk;
                pk.u[0] = cvt_pk_bf16(sw[2 * ks][0], sw[2 * ks][1]); pk.u[1] = cvt_pk_bf16(sw[2 * ks][2], sw[2 * ks][3]);
                pk.u[2] = cvt_pk_bf16(sw[2 * ks + 1][0], sw[2 * ks + 1][1]); pk.u[3] = cvt_pk_bf16(sw[2 * ks + 1][2], sw[2 * ks + 1][3]);
                pf[ks] = pk.v;
            }
            f32x4 dI = (f32x4){0.f, 0.f, 0.f, 0.f};
#pragma unroll
            for (int ks = 0; ks < 4; ++ks) { const bf16x8 nf = *(const bf16x8*)(nl + ks * 32 + lq * 8); dI = __builtin_amdgcn_mfma_f32_16x16x32_bf16(nf, Qf[ks], dI, 0, 0, 0); }
            const float den = sc_in * dI[0] + dsum;
            const float rdd = 1.0f / fmaxf(fabsf(den), em);
#pragma unroll
            for (int vt = 0; vt < 2; ++vt) {
                f32x4 ni = (f32x4){0.f, 0.f, 0.f, 0.f}, nI = (f32x4){0.f, 0.f, 0.f, 0.f};
#pragma unroll
                for (int ks = 0; ks < 2; ++ks) if (2 * ks <= w) {
                    union { bf16x8 v; uint2 hh[2]; } vf;
                    const bf16_t* vp = VTM + (size_t)(vt * 16 + lr) * 2048 + t0 + 32 * ks + lq * 4;
                    vf.hh[0] = *(const uint2*)vp; vf.hh[1] = *(const uint2*)(vp + 16);
                    ni = __builtin_amdgcn_mfma_f32_16x16x32_bf16(vf.v, pf[ks], ni, 0, 0, 0);
                }
#pragma unroll
                for (int ks = 0; ks < 4; ++ks) { const bf16x8 cf = *(const bf16x8*)(Cl + (vt * 16 + lr) * 136 + ks * 32 + lq * 8); nI = __builtin_amdgcn_mfma_f32_16x16x32_bf16(cf, Qf[ks], nI, 0, 0, 0); }
                const f32x4 hv = (nI * sc_in + ni) * rdd;
                *(f32x4*)(HRAW + ((size_t)(b * 2048) + row_t) * 512 + h * 128 + vs * 32 + vt * 16 + lq * 4) = hv;
            }
        }
        __syncthreads();
        {
            const float decay = misc[0];
            bf16x8 Af[2][2], Wf[2], Kt[2][2];
#pragma unroll
            for (int ks = 0; ks < 2; ++ks) {
                const float4 w0 = *(const float4*)(wts + ks * 32 + lq * 8), w1 = *(const float4*)(wts + ks * 32 + lq * 8 + 4);
                float wv[8] = {w0.x, w0.y, w0.z, w0.w, w1.x, w1.y, w1.z, w1.w};
                { union { bf16x8 v; uint4 q; } t; t.q = pack8(wv); Wf[ks] = t.v; }
#pragma unroll
                for (int vt = 0; vt < 2; ++vt) {
                    const uint4 raw = *(const uint4*)(VTM + (size_t)(vt * 16 + lr) * 2048 + t0 + ks * 32 + lq * 8);
                    float f[8] = {bf_lo(raw.x) * wv[0], bf_hi(raw.x) * wv[1], bf_lo(raw.y) * wv[2], bf_hi(raw.y) * wv[3], bf_lo(raw.z) * wv[4], bf_hi(raw.z) * wv[5], bf_lo(raw.w) * wv[6], bf_hi(raw.w) * wv[7]};
                    union { bf16x8 v; uint4 q; } t; t.q = pack8(f); Af[vt][ks] = t.v;
                }
#pragma unroll
                for (int kt = 0; kt < 2; ++kt) Kt[kt][ks] = *(const bf16x8*)(KTB + (size_t)((2 * w + kt) * 16 + lr) * 2048 + t0 + ks * 32 + lq * 8);
            }
#pragma unroll
            for (int kt = 0; kt < 2; ++kt) {
                nm[kt] = nm[kt] * decay;
#pragma unroll
                for (int ks = 0; ks < 2; ++ks) nm[kt] = __builtin_amdgcn_mfma_f32_16x16x32_bf16(Wf[ks], Kt[kt][ks], nm[kt], 0, 0, 0);
                if (lq == 0) nl[(2 * w + kt) * 16 + lr] = (bf16_t)(cvt_pk_bf16(nm[kt][0], 0.f) & 0xffffu);
#pragma unroll
                for (int vt = 0; vt < 2; ++vt) {
                    Cm[vt][kt] = Cm[vt][kt] * decay;
#pragma unroll
                    for (int ks = 0; ks < 2; ++ks) Cm[vt][kt] = __builtin_amdgcn_mfma_f32_16x16x32_bf16(Af[vt][ks], Kt[kt][ks], Cm[vt][kt], 0, 0, 0);
                    const unsigned c01 = cvt_pk_bf16(Cm[vt][kt][0], Cm[vt][kt][1]), c23 = cvt_pk_bf16(Cm[vt][kt][2], Cm[vt][kt][3]);
                    bf16_t* cp = Cl + (vt * 16 + lq * 4) * 136 + (2 * w + kt) * 16 + lr;
                    cp[0] = (bf16_t)(c01 & 0xffffu); cp[136] = (bf16_t)(c01 >> 16); cp[272] = (bf16_t)(c23 & 0xffffu); cp[408] = (bf16_t)(c23 >> 16);
                }
            }
            m_prev = misc[1];
        }
        __syncthreads();
    }
#pragma unroll
    for (int vt = 0; vt < 2; ++vt)
#pragma unroll
        for (int kt = 0; kt < 2; ++kt)
#pragma unroll
            for (int g = 0; g < 4; ++g)
                p.out[O_CP + ((size_t)((b * 4 + h) * 128) + vs * 32 + vt * 16 + lq * 4 + g) * 128 + (2 * w + kt) * 16 + lr] = Cm[vt][kt][g];
    if (vs == 0) {
        if (lq == 0) { p.out[O_NP + (size_t)(b * 4 + h) * 128 + (2 * w) * 16 + lr] = nm[0][0]; p.out[O_NP + (size_t)(b * 4 + h) * 128 + (2 * w + 1) * 16 + lr] = nm[1][0]; }
        if (tid == 0) p.out[O_MP + b * 4 + h] = m_prev;
    }
}

DEV unsigned dpp_max16(unsigned x) {
    x = max(x, (unsigned)__builtin_amdgcn_update_dpp(0, (int)x, 0xB1, 0xF, 0xF, false));
    x = max(x, (unsigned)__builtin_amdgcn_update_dpp(0, (int)x, 0x4E, 0xF, 0xF, false));
    x = max(x, (unsigned)__builtin_amdgcn_update_dpp(0, (int)x, 0x141, 0xF, 0xF, false));
    x = max(x, (unsigned)__builtin_amdgcn_update_dpp(0, (int)x, 0x140, 0xF, 0xF, false));
    return x;
}
DEV float dpp_sum16(float x) {
    x += __builtin_bit_cast(float, __builtin_amdgcn_update_dpp(0, __builtin_bit_cast(int, x), 0xB1, 0xF, 0xF, false));
    x += __builtin_bit_cast(float, __builtin_amdgcn_update_dpp(0, __builtin_bit_cast(int, x), 0x4E, 0xF, 0xF, false));
    x += __builtin_bit_cast(float, __builtin_amdgcn_update_dpp(0, __builtin_bit_cast(int, x), 0x141, 0xF, 0xF, false));
    x += __builtin_bit_cast(float, __builtin_amdgcn_update_dpp(0, __builtin_bit_cast(int, x), 0x140, 0xF, 0xF, false));
    return x;
}
DEV unsigned mono_key(float v) { const unsigned b = __float_as_uint(v); return (b & 0x80000000u) ? ~b : (b | 0x80000000u); }
#define CE_DESC(a, b) { const unsigned hi_ = max(a, b), lo_ = min(a, b); a = hi_; b = lo_; }

DEV void peer_score_topk_item(const Params& p, const int tile, const int h, unsigned char* lds) {
    int tid_ = threadIdx.x; asm volatile("" : "+v"(tid_));
    const int tid = tid_, lane = tid & 63, w = tid >> 6, lr = lane & 15, lq = lane >> 4;
    float* sc = (float*)(lds + w * 12416);
    float* ts = sc + 16 * 129;
    int* ti = (int*)(ts + 512);
    const bf16_t* QPB = (const bf16_t*)(p.ws + WS_QPB);
    const bf16_t* SUBK = (const bf16_t*)(p.ws + WS_SUBK);
    int* PIDX = (int*)(p.ws + WS_PIDX); float* PG = (float*)(p.ws + WS_PG);
    const int row0 = tile * 64 + w * 16;
    const int arow = (row0 + lr < NR) ? row0 + lr : NR - 1;
    wave_sync();
#pragma unroll 1
    for (int pp = 0; pp < 2; ++pp) {
        bf16x8 qf[4];
#pragma unroll
        for (int ks = 0; ks < 4; ++ks) qf[ks] = *(const bf16x8*)(QPB + (size_t)arow * 2048 + h * 256 + pp * 128 + ks * 32 + lq * 8);
#pragma unroll
        for (int j = 0; j < 8; ++j) {
            f32x4 a = (f32x4){0.f, 0.f, 0.f, 0.f};
#pragma unroll
            for (int ks = 0; ks < 4; ++ks) { const bf16x8 kf = *(const bf16x8*)(SUBK + ((size_t)pp * 128 + j * 16 + lr) * 128 + ks * 32 + lq * 8); a = __builtin_amdgcn_mfma_f32_16x16x32_bf16(qf[ks], kf, a, 0, 0, 0); }
#pragma unroll
            for (int g = 0; g < 4; ++g) sc[(lq * 4 + g) * 129 + j * 16 + lr] = a[g];
        }
        wave_sync();
#pragma unroll 1
        for (int rr = 0; rr < 4; ++rr) {
            const int row = rr * 4 + lq;
            unsigned k0, k1, k2, k3, k4, k5, k6, k7;
            { const float* sr = sc + row * 129 + lr;
              k0 = (mono_key(sr[0]) & ~0x7Fu) | (unsigned)(127 - lr);        k1 = (mono_key(sr[16]) & ~0x7Fu) | (unsigned)(127 - 16 - lr);
              k2 = (mono_key(sr[32]) & ~0x7Fu) | (unsigned)(127 - 32 - lr);  k3 = (mono_key(sr[48]) & ~0x7Fu) | (unsigned)(127 - 48 - lr);
              k4 = (mono_key(sr[64]) & ~0x7Fu) | (unsigned)(127 - 64 - lr);  k5 = (mono_key(sr[80]) & ~0x7Fu) | (unsigned)(127 - 80 - lr);
              k6 = (mono_key(sr[96]) & ~0x7Fu) | (unsigned)(127 - 96 - lr);  k7 = (mono_key(sr[112]) & ~0x7Fu) | (unsigned)(127 - 112 - lr); }
            CE_DESC(k0, k1) CE_DESC(k2, k3) CE_DESC(k4, k5) CE_DESC(k6, k7)
            CE_DESC(k0, k2) CE_DESC(k1, k3) CE_DESC(k4, k6) CE_DESC(k5, k7)
            CE_DESC(k1, k2) CE_DESC(k5, k6)
            CE_DESC(k0, k4) CE_DESC(k1, k5) CE_DESC(k2, k6) CE_DESC(k3, k7)
            CE_DESC(k2, k4) CE_DESC(k3, k5)
            CE_DESC(k1, k2) CE_DESC(k3, k4) CE_DESC(k5, k6)
            unsigned mine = 0u;
#pragma unroll
            for (int r = 0; r < 16; ++r) {
                const unsigned best = dpp_max16(k0);
                if (lr == r) mine = best;
                const bool own = (k0 == best);
                k0 = own ? k1 : k0; k1 = own ? k2 : k1; k2 = own ? k3 : k2; k3 = own ? k4 : k3; k4 = own ? k5 : k4; k5 = own ? k6 : k5; k6 = own ? k7 : k6; k7 = own ? 0u : k7;
            }
            const int idx = 127 - (int)(mine & 0x7Fu);
            ts[(pp * 16 + row) * 16 + lr] = sc[row * 129 + idx];
            ti[(pp * 16 + row) * 16 + lr] = idx;
        }
        wave_sync();
    }
#pragma unroll 1
    for (int rr = 0; rr < 4; ++rr) {
        const int row = rr * 4 + lq;
        const float s1a = ts[row * 16 + lr];
        const float* s2 = ts + (16 + row) * 16;
        int ptr = 0;
        unsigned key = (mono_key(s1a + s2[0]) & ~0xFFu) | (unsigned)(255 - lr * 16);
        unsigned mine = 0u;
#pragma unroll
        for (int r = 0; r < 16; ++r) {
            const unsigned best = dpp_max16(key);
            if (lr == r) mine = best;
            if (key == best) { ++ptr; key = (ptr < 16) ? ((mono_key(s1a + s2[ptr & 15]) & ~0xFFu) | (unsigned)(255 - lr * 16 - ptr)) : 0u; }
        }
        const int ci = 255 - (int)(mine & 0xFFu), a = ci >> 4, bb = ci & 15;
        const float scv = ts[row * 16 + a] + s2[bb];
        const int e = ti[row * 16 + a] * 128 + ti[(16 + row) * 16 + bb];
        float m16 = scv;
        m16 = fmaxf(m16, __builtin_bit_cast(float, __builtin_amdgcn_update_dpp(0, __builtin_bit_cast(int, m16), 0xB1, 0xF, 0xF, false)));
        m16 = fmaxf(m16, __builtin_bit_cast(float, __builtin_amdgcn_update_dpp(0, __builtin_bit_cast(int, m16), 0x4E, 0xF, 0xF, false)));
        m16 = fmaxf(m16, __builtin_bit_cast(float, __builtin_amdgcn_update_dpp(0, __builtin_bit_cast(int, m16), 0x141, 0xF, 0xF, false)));
        m16 = fmaxf(m16, __builtin_bit_cast(float, __builtin_amdgcn_update_dpp(0, __builtin_bit_cast(int, m16), 0x140, 0xF, 0xF, false)));
        const float ex = expf(scv - m16);
        const float den = dpp_sum16(ex);
        const int grow = row0 + row;
        if (grow < NR) { PIDX[(size_t)grow * 128 + h * 16 + lr] = e; PG[(size_t)grow * 128 + h * 16 + lr] = ex / den; }
    }
}

constexpr float PEER_U_SCALE = 64.0f, PEER_V_SCALE = 8.0f;
DEV unsigned pack4_fp8(float a, float b, float c, float d) { int w = 0; w = __builtin_amdgcn_cvt_pk_fp8_f32(a, b, w, false); w = __builtin_amdgcn_cvt_pk_fp8_f32(c, d, w, true); return (unsigned)w; }
DEV void peer_expert_wave(const Params& p, const int row, unsigned char* wl, const int lane_in) {
    int lane = lane_in; asm volatile("" : "+v"(lane));
    const int lr = lane & 15, lq = lane >> 4;
    unsigned char* xh = wl;
    unsigned char* xo = wl + 1024;
    float* coefl = (float*)(wl + 2048);
    int* idxl = (int*)(wl + 2048 + 512);
    const float* X1 = (const float*)(p.ws + WS_X1) + (size_t)row * 1024;
    const int* PIDX = (const int*)(p.ws + WS_PIDX) + (size_t)row * 128;
    const float* PG = (const float*)(p.ws + WS_PG) + (size_t)row * 128;
    const unsigned char* U8 = p.ws + WS_U8;
    const unsigned char* V8 = p.ws + WS_V8;
    float xv[16];
#pragma unroll
    for (int j = 0; j < 4; ++j) { const float4 t = *(const float4*)(X1 + lane * 16 + j * 4); xv[4 * j] = t.x; xv[4 * j + 1] = t.y; xv[4 * j + 2] = t.z; xv[4 * j + 3] = t.w; }
    wave_sync();
    {
        uint4 hi, lo; unsigned* hp = (unsigned*)&hi; unsigned* lp = (unsigned*)&lo;
#pragma unroll
        for (int j = 0; j < 4; ++j) {
            const unsigned hw = pack4_fp8(xv[4 * j], xv[4 * j + 1], xv[4 * j + 2], xv[4 * j + 3]);
            const f32x2_ b0 = __builtin_amdgcn_cvt_pk_f32_fp8((int)hw, false), b1 = __builtin_amdgcn_cvt_pk_f32_fp8((int)hw, true);
            hp[j] = hw;
            lp[j] = pack4_fp8(16.f * (xv[4 * j] - b0[0]), 16.f * (xv[4 * j + 1] - b0[1]), 16.f * (xv[4 * j + 2] - b1[0]), 16.f * (xv[4 * j + 3] - b1[1]));
        }
        *(uint4*)(xh + lane * 16) = hi; *(uint4*)(xo + lane * 16) = lo;
    }
    idxl[lane] = PIDX[lane]; idxl[64 + lane] = PIDX[64 + lane];
    wave_sync();
    uint4 ufa[8], ufb[8];
    f32x4 ah = (f32x4){0.f, 0.f, 0.f, 0.f}, al = (f32x4){0.f, 0.f, 0.f, 0.f};
#define U_LOAD(DST, HH) { const unsigned char* ub_ = U8 + (size_t)idxl[((HH) >> 1) * 16 + lr] * 1024 + ((HH) & 1) * 512 + lq * 16; \
        _Pragma("unroll") for (int i = 0; i < 8; ++i) DST[i] = *(const uint4*)(ub_ + i * 64); }
#define U_HALF(SRC, HH) { \
        _Pragma("unroll") for (int i = 0; i < 8; ++i) { \
            const int off = ((HH) & 1) * 512 + i * 64 + lq * 16; \
            const long b0 = (long)(((unsigned long long)SRC[i].y << 32) | SRC[i].x), b1 = (long)(((unsigned long long)SRC[i].w << 32) | SRC[i].z); \
            const long h0 = *(const long*)(xh + off), h1 = *(const long*)(xh + off + 8), l0 = *(const long*)(xo + off), l1 = *(const long*)(xo + off + 8); \
            ah = __builtin_amdgcn_mfma_f32_16x16x32_fp8_fp8(h0, b0, ah, 0, 0, 0); ah = __builtin_amdgcn_mfma_f32_16x16x32_fp8_fp8(h1, b1, ah, 0, 0, 0); \
            al = __builtin_amdgcn_mfma_f32_16x16x32_fp8_fp8(l0, b0, al, 0, 0, 0); al = __builtin_amdgcn_mfma_f32_16x16x32_fp8_fp8(l1, b1, al, 0, 0, 0); } \
        if ((HH) & 1) { if (lq == 0) coefl[((HH) >> 1) * 16 + lr] = PG[((HH) >> 1) * 16 + lr] * gelu_tanh((ah[0] + al[0] * 0.0625f) * (1.0f / PEER_U_SCALE)) * (1.0f / PEER_V_SCALE); \
            ah = (f32x4){0.f, 0.f, 0.f, 0.f}; al = (f32x4){0.f, 0.f, 0.f, 0.f}; } }
    U_LOAD(ufa, 0)
#pragma unroll 1
    for (int hh = 0; hh < 16; hh += 2) {
        U_LOAD(ufb, hh + 1)
        U_HALF(ufa, hh)
        if (hh + 2 < 16) U_LOAD(ufa, hh + 2)
        U_HALF(ufb, hh + 1)
    }
#undef U_LOAD
#undef U_HALF
    wave_sync();
    float o[16];
#pragma unroll
    for (int i = 0; i < 16; ++i) o[i] = 0.f;
    uint4 vfa[8], vfb[8];
#define V_LOAD(DST, J) { _Pragma("unroll") for (int u = 0; u < 8; ++u) DST[u] = *(const uint4*)(V8 + (size_t)idxl[(J) + u] * 1024 + lane * 16); }
#define V_ACC(SRC, J) { _Pragma("unroll") for (int u = 0; u < 8; ++u) { const float c_ = coefl[(J) + u]; \
            const unsigned w0_ = SRC[u].x, w1_ = SRC[u].y, w2_ = SRC[u].z, w3_ = SRC[u].w; \
            f32x2_ f0, f1; \
            f0 = __builtin_amdgcn_cvt_pk_f32_fp8((int)w0_, false); f1 = __builtin_amdgcn_cvt_pk_f32_fp8((int)w0_, true); o[0] += c_ * f0[0]; o[1] += c_ * f0[1]; o[2] += c_ * f1[0]; o[3] += c_ * f1[1]; \
            f0 = __builtin_amdgcn_cvt_pk_f32_fp8((int)w1_, false); f1 = __builtin_amdgcn_cvt_pk_f32_fp8((int)w1_, true); o[4] += c_ * f0[0]; o[5] += c_ * f0[1]; o[6] += c_ * f1[0]; o[7] += c_ * f1[1]; \
            f0 = __builtin_amdgcn_cvt_pk_f32_fp8((int)w2_, false); f1 = __builtin_amdgcn_cvt_pk_f32_fp8((int)w2_, true); o[8] += c_ * f0[0]; o[9] += c_ * f0[1]; o[10] += c_ * f1[0]; o[11] += c_ * f1[1]; \
            f0 = __builtin_amdgcn_cvt_pk_f32_fp8((int)w3_, false); f1 = __builtin_amdgcn_cvt_pk_f32_fp8((int)w3_, true); o[12] += c_ * f0[0]; o[13] += c_ * f0[1]; o[14] += c_ * f1[0]; o[15] += c_ * f1[1]; } }
    V_LOAD(vfa, 0)
#pragma unroll 1
    for (int j = 0; j < 128; j += 16) {
        V_LOAD(vfb, j + 8)
        V_ACC(vfa, j)
        if (j + 16 < 128) V_LOAD(vfa, j + 16)
        V_ACC(vfb, j + 8)
    }
#undef V_LOAD
#undef V_ACC
    float tv[16]; float s = 0.f;
#pragma unroll
    for (int i = 0; i < 16; ++i) { tv[i] = DN_ALPHA * xv[i] + o[i]; s += tv[i]; }
    const float mu = wave_sum(s) * (1.0f / 1024.0f);
    float q = 0.f;
#pragma unroll
    for (int i = 0; i < 16; ++i) { const float d = tv[i] - mu; q += d * d; }
    const float rstd = 1.0f / sqrtf(wave_sum(q) * (1.0f / 1024.0f) + LN_EPS);
    float* y = p.out + O_Y + (size_t)row * 1024 + lane * 16;
#pragma unroll
    for (int j = 0; j < 4; ++j) {
        const float4 g4 = *(const float4*)(p.ln2_g + lane * 16 + j * 4), b4 = *(const float4*)(p.ln2_b + lane * 16 + j * 4);
        float4 yo;
        yo.x = (tv[4 * j] - mu) * rstd * g4.x + b4.x; yo.y = (tv[4 * j + 1] - mu) * rstd * g4.y + b4.y; yo.z = (tv[4 * j + 2] - mu) * rstd * g4.z + b4.z; yo.w = (tv[4 * j + 3] - mu) * rstd * g4.w + b4.w;
        *(float4*)(y + j * 4) = yo;
    }
}

constexpr int QN = 2;
struct AttnState { f32x4 ot[4][QN]; float m[QN]; float l[QN]; };

DEV void attn_block(const unsigned char* Ks, const unsigned char* VTs, const bf16x8 (&Qf)[QN][2], AttnState& A, const int mode, const int dq, const float* blut,
                    const unsigned selbit0, const unsigned selbit1, const bool slc, const int lr, const int lq, const int t0, const int ci0) {
    f32x4 sc[4][QN];
#pragma unroll
    for (int kt = 0; kt < 4; ++kt) {
        const bf16x8 k0 = *(const bf16x8*)(Ks + (kt * 16 + lr) * 144 + lq * 16), k1 = *(const bf16x8*)(Ks + (kt * 16 + lr) * 144 + 64 + lq * 16);
#pragma unroll
        for (int qi = 0; qi < QN; ++qi) {
            f32x4 a = (f32x4){0.f, 0.f, 0.f, 0.f};
            a = __builtin_amdgcn_mfma_f32_16x16x32_bf16(k0, Qf[qi][0], a, 0, 0, 0);
            a = __builtin_amdgcn_mfma_f32_16x16x32_bf16(k1, Qf[qi][1], a, 0, 0, 0);
            sc[kt][qi] = a;
        }
    }
    asm volatile("" ::: "memory");
    if (mode != 0 || slc) {
#pragma unroll
        for (int kt = 0; kt < 4; ++kt)
#pragma unroll
            for (int qi = 0; qi < QN; ++qi)
#pragma unroll
                for (int g = 0; g < 4; ++g) {
                    const int kl = kt * 16 + lq * 4 + g, ql = qi * 16 + lr;
                    float v = sc[kt][qi][g];
                    bool ok = true;
                    if (mode == 1 || mode == 2) { const int di = dq + ql - kl; v += blut[di < 0 ? 0 : di]; }
                    if (mode == 2) ok = kl <= ql + dq;
                    if (mode == 3) ok = kl > ql + dq - 512;
                    if (mode == 4) { const int ci = ci0 + kl, dist = t0 + ql - (16 * ci + 31); ok = (dist >= 0) && (ci < 127); if (dist >= 0 && dist < 192) v += blut[dist]; }
                    if (mode == 5) { const int dist = dq - ci0 * kl; ok = (kl < t0) && (dist >= 0); if (dist >= 0 && dist < 192) v += blut[dist]; }
                    if (slc) ok = ok && ((qi == 0 ? selbit0 : selbit1) != 0u);
                    sc[kt][qi][g] = ok ? v : NEGF;
                }
    }
    bf16x8 pf[QN][2];
#pragma unroll
    for (int qi = 0; qi < QN; ++qi) {
        float mb = NEGF;
#pragma unroll
        for (int kt = 0; kt < 4; ++kt) mb = fmaxf(mb, fmaxf(fmaxf(sc[kt][qi][0], sc[kt][qi][1]), fmaxf(sc[kt][qi][2], sc[kt][qi][3])));
        mb = fmaxf(mb, __shfl_xor(mb, 16)); mb = fmaxf(mb, __shfl_xor(mb, 32));
        const float mn = fmaxf(A.m[qi], mb);
        const float alpha = __builtin_amdgcn_exp2f(A.m[qi] - mn);
        A.m[qi] = mn;
        float rs = 0.f;
#pragma unroll
        for (int kt = 0; kt < 4; ++kt)
#pragma unroll
            for (int g = 0; g < 4; ++g) { const float v = sc[kt][qi][g]; const float e = (v > -1e29f) ? __builtin_amdgcn_exp2f(v - mn) : 0.f; sc[kt][qi][g] = e; rs += e; }
        A.l[qi] = A.l[qi] * alpha + rs;
#pragma unroll
        for (int dt = 0; dt < 4; ++dt) A.ot[dt][qi] = A.ot[dt][qi] * alpha;
#pragma unroll
        for (int ks = 0; ks < 2; ++ks) {
            union { bf16x8 v; unsigned u[4]; } pk;
            pk.u[0] = cvt_pk_bf16(sc[2 * ks][qi][0], sc[2 * ks][qi][1]); pk.u[1] = cvt_pk_bf16(sc[2 * ks][qi][2], sc[2 * ks][qi][3]);
            pk.u[2] = cvt_pk_bf16(sc[2 * ks + 1][qi][0], sc[2 * ks + 1][qi][1]); pk.u[3] = cvt_pk_bf16(sc[2 * ks + 1][qi][2], sc[2 * ks + 1][qi][3]);
            pf[qi][ks] = pk.v;
        }
    }
    asm volatile("" ::: "memory");
#pragma unroll
    for (int dt = 0; dt < 4; ++dt)
#pragma unroll
        for (int ks = 0; ks < 2; ++ks) {
            asm volatile("" ::: "memory");
            union { bf16x8 v; uint2 h[2]; } vf;
            vf.h[0] = *(const uint2*)(VTs + (dt * 16 + lr) * 144 + (32 * ks + lq * 4) * 2);
            vf.h[1] = *(const uint2*)(VTs + (dt * 16 + lr) * 144 + (32 * ks + 16 + lq * 4) * 2);
#pragma unroll
            for (int qi = 0; qi < QN; ++qi) A.ot[dt][qi] = __builtin_amdgcn_mfma_f32_16x16x32_bf16(vf.v, pf[qi][ks], A.ot[dt][qi], 0, 0, 0);
        }
}

DEV void nsa_prompt_item(const Params& p, const int b, const int hkv, const int q32, unsigned char* lds) {
    int tid_ = threadIdx.x; asm volatile("" : "+v"(tid_));
    const int tid = tid_, lane = tid & 63, g = tid >> 6, lr = lane & 15, lq = lane >> 4;
    const int hq = hkv * 4 + g, t0 = q32 * 32, kd = t0 >> 6;
    unsigned char* Ks = lds; unsigned char* VTs = lds + 9216;
    float* biasl = (float*)(lds + 18432); float* psl = (float*)(lds + 21504); unsigned* selm = (unsigned*)(lds + 29952); unsigned* misc = (unsigned*)(lds + 30208);
    const bf16_t* ZB = (const bf16_t*)(p.ws + WS_ZB);
    const bf16_t* VTS = (const bf16_t*)(p.ws + WS_VTS) + (size_t)(b * 2 + hkv) * 64 * 2048;
    const bf16_t* VTW = (const bf16_t*)(p.ws + WS_VTW) + (size_t)(b * 2 + hkv) * 64 * 2048;
    const bf16_t* KCB = (const bf16_t*)(p.ws + WS_KCB) + (size_t)(b * 2 + hkv) * 128 * 64;
    const bf16_t* VTC = (const bf16_t*)(p.ws + WS_VTC) + (size_t)(b * 2 + hkv) * 64 * 128;
    const float* Z = (const float*)(p.ws + WS_Z);
    float* NOUTF = (float*)(p.ws + WS_NOUTF);
    bf16_t* NOUTB = (bf16_t*)(p.ws + WS_NOUTB);
    __syncthreads();
    for (int i = tid; i < 4 * 192; i += 256) { const int gg = i / 192, d = i % 192; biasl[i] = (p.rel_bias[rel_bucket(d) * 8 + hkv * 4 + gg] - p.rel_bias[31 * 8 + hkv * 4 + gg]) * LOG2E; }
    for (int i = tid; i < 32 * 33; i += 256) psl[i] = 0.f;
    if (tid < 32) selm[tid] = 0u;
    if (tid == 0) misc[0] = 0u;
    const float* blut = biasl + g * 192;
    bf16x8 Qf[QN][2];
#pragma unroll
    for (int qi = 0; qi < QN; ++qi)
#pragma unroll
        for (int kk = 0; kk < 2; ++kk) Qf[qi][kk] = *(const bf16x8*)(ZB + (size_t)(b * 2048 + t0 + qi * 16 + lr) * IN_DIM + C_Q + hq * 64 + kk * 32 + lq * 8);

    uint4 trk0, trk1, trv0, trv1;
    auto load_tiles = [&](int kind, int kb) __attribute__((always_inline)) {
#pragma unroll
        for (int i = 0; i < 2; ++i) {
            const int id = tid + 256 * i, row = id >> 3, ch = id & 7;
            uint4 rk, rv;
            if (kind == 0) { rk = *(const uint4*)(KCB + (size_t)(kb * 64 + row) * 64 + ch * 8); rv = *(const uint4*)(VTC + (size_t)row * 128 + kb * 64 + ch * 8); }
            else {
                rk = *(const uint4*)(ZB + (size_t)(b * 2048 + kb * 64 + row) * IN_DIM + (kind == 1 ? C_KS : C_KW) + hkv * 64 + ch * 8);
                rv = *(const uint4*)((kind == 1 ? VTS : VTW) + (size_t)row * 2048 + kb * 64 + ch * 8);
            }
            if (i == 0) { trk0 = rk; trv0 = rv; } else { trk1 = rk; trv1 = rv; }
        }
    };
    auto store_tiles = [&]() __attribute__((always_inline)) {
#pragma unroll
        for (int i = 0; i < 2; ++i) { const int id = tid + 256 * i, row = id >> 3, ch = id & 7; *(uint4*)(Ks + row * 144 + ch * 16) = (i == 0 ? trk0 : trk1); *(uint4*)(VTs + row * 144 + ch * 16) = (i == 0 ? trv0 : trv1); }
    };
    auto reset = [&](AttnState& A) __attribute__((always_inline)) {
#pragma unroll
        for (int qi = 0; qi < QN; ++qi) { A.m[qi] = NEGF; A.l[qi] = 0.f;
#pragma unroll
            for (int dt = 0; dt < 4; ++dt) A.ot[dt][qi] = (f32x4){0.f, 0.f, 0.f, 0.f}; }
    };
    auto finish = [&](AttnState& A, int br) __attribute__((always_inline)) {
#pragma unroll
        for (int qi = 0; qi < QN; ++qi) {
            float lt = A.l[qi]; lt += __shfl_xor(lt, 16); lt += __shfl_xor(lt, 32);
            const float sc = (lt > 0.f) ? sigmoidf_(Z[(size_t)(b * 2048 + t0 + qi * 16 + lr) * IN_DIM + C_G + br * 8 + hq]) / lt : 0.f;
            const size_t row = (size_t)(b * 2048 + t0 + qi * 16 + lr);
#pragma unroll
            for (int dt = 0; dt < 4; ++dt) {
                const int col = hq * 64 + dt * 16 + lq * 4;
                f32x4 v = A.ot[dt][qi] * sc;
                if (br > 0) v = v + *(const f32x4*)(NOUTF + row * 512 + col);
                if (br < 2) *(f32x4*)(NOUTF + row * 512 + col) = v; else store_bf16x4(NOUTB + row * 512 + col, v);
            }
        }
    };

    AttnState A;
    const int ncb = ((t0 >> 4) >= 64) ? 2 : 1;
    reset(A);
    load_tiles(0, 0);
    for (int kb = 0; kb < ncb; ++kb) {
        __syncthreads(); store_tiles(); __syncthreads();
        if (kb + 1 < ncb) load_tiles(0, kb + 1);
        attn_block(Ks, VTs, Qf, A, 4, 0, blut, 1u, 1u, false, lr, lq, t0, kb * 64);
    }
    finish(A, 0);
    {
        float linv[QN];
#pragma unroll
        for (int qi = 0; qi < QN; ++qi) { float lt = A.l[qi]; lt += __shfl_xor(lt, 16); lt += __shfl_xor(lt, 32); linv[qi] = (lt > 0.f) ? 1.0f / lt : 0.f; }
        for (int kb = 0; kb < ncb; ++kb) {
            if (ncb > 1) { load_tiles(0, kb); __syncthreads(); store_tiles(); __syncthreads(); }
#pragma unroll
            for (int kt = 0; kt < 4; ++kt) {
                const bf16x8 k0 = *(const bf16x8*)(Ks + (kt * 16 + lr) * 144 + lq * 16), k1 = *(const bf16x8*)(Ks + (kt * 16 + lr) * 144 + 64 + lq * 16);
#pragma unroll
                for (int qi = 0; qi < QN; ++qi) {
                    f32x4 a = (f32x4){0.f, 0.f, 0.f, 0.f};
                    a = __builtin_amdgcn_mfma_f32_16x16x32_bf16(k0, Qf[qi][0], a, 0, 0, 0);
                    a = __builtin_amdgcn_mfma_f32_16x16x32_bf16(k1, Qf[qi][1], a, 0, 0, 0);
                    float pr[4];
#pragma unroll
                    for (int gg = 0; gg < 4; ++gg) {
                        const int ci = kb * 64 + kt * 16 + lq * 4 + gg, ql = qi * 16 + lr, dist = t0 + ql - (16 * ci + 31);
                        float v = a[gg];
                        if (dist >= 0 && dist < 192) v += blut[dist];
                        pr[gg] = (dist >= 0 && ci < 127) ? __builtin_amdgcn_exp2f(v - A.m[qi]) * linv[qi] : 0.f;
                    }
                    const int blk = kb * 16 + kt * 4 + lq, ql = qi * 16 + lr;
                    atomicAdd(&psl[ql * 33 + blk], 2.0f * (pr[0] + pr[1] + pr[2]) + pr[3]);
                    atomicAdd(&psl[ql * 33 + blk + 1], pr[3]);
                }
            }
        }
    }
    __syncthreads();
    {
        const int ql = tid >> 3, part = tid & 7, tq = t0 + ql, cur = tq >> 6;
        float scv[32];
#pragma unroll
        for (int j = 0; j < 32; ++j) {
            const bool causal = j * 64 <= tq, forced = (j == 0) || (j == cur) || (j == cur - 1);
            scv[j] = causal ? (forced ? 1e4f : psl[ql * 33 + j]) : NEGF;
        }
        unsigned mbits = 0u;
#pragma unroll
        for (int jj = 0; jj < 4; ++jj) {
            const int j = part * 4 + jj;
            float my = NEGF;
#pragma unroll
            for (int k = 0; k < 32; ++k) my = (k == j) ? scv[k] : my;
            int rank = 0;
#pragma unroll
            for (int k = 0; k < 32; ++k) rank += ((scv[k] > my) || (scv[k] == my && k < j)) ? 1 : 0;
            if (rank < 16 && j * 64 <= tq) mbits |= (1u << j);
        }
        atomicOr(&selm[ql], mbits);
        atomicOr(&misc[0], mbits);
    }
    __syncthreads();
    const unsigned msk0 = selm[lr], msk1 = selm[16 + lr];
    const unsigned anym = misc[0];
    reset(A);
    {
        int kb = kd;
        load_tiles(1, kb);
        for (;;) {
            __syncthreads(); store_tiles(); __syncthreads();
            int nxt = (kb == kd) ? 0 : kb + 1;
            while (nxt < kd && !((anym >> nxt) & 1u)) ++nxt;
            const bool more = nxt < kd;
            if (more) load_tiles(1, nxt);
            const int mode = (kb == kd) ? 2 : ((kb >= kd - 2) ? 1 : 0);
            attn_block(Ks, VTs, Qf, A, mode, t0 - kb * 64, blut, (msk0 >> kb) & 1u, (msk1 >> kb) & 1u, true, lr, lq, t0, 0);
            if (!more) break;
            kb = nxt;
        }
    }
    finish(A, 1);
    reset(A);
    {
        const int klo = (t0 >= 511) ? ((t0 - 511) >> 6) : 0;
        int kb = kd;
        load_tiles(2, kb);
        for (;;) {
            __syncthreads(); store_tiles(); __syncthreads();
            const bool more = kb > klo;
            if (more) load_tiles(2, kb - 1);
            const int dq = t0 - kb * 64;
            const int mode = (kb == kd) ? 2 : ((kb >= kd - 2) ? 1 : ((dq + 31 >= 512) ? 3 : 0));
            attn_block(Ks, VTs, Qf, A, mode, dq, blut, 1u, 1u, false, lr, lq, t0, 0);
            if (!more) break;
            --kb;
        }
    }
    finish(A, 2);
}

DEV void nsa_sample_item(const Params& p, const int b, const int hkv, unsigned char* lds) {
    int tid_ = threadIdx.x; asm volatile("" : "+v"(tid_));
    const int tid = tid_, lane = tid & 63, g = tid >> 6, lr = lane & 15, lq = lane >> 4;
    const int hq = hkv * 4 + g;
    unsigned char* Ks = lds; unsigned char* VTs = lds + 9216;
    float* biasl = (float*)(lds + 18432); float* psl = (float*)(lds + 21504); int* sell = (int*)(lds + 29952); float* scl = (float*)(lds + 30720);
    const bf16_t* ZB = (const bf16_t*)(p.ws + WS_ZB);
    const float* zrow = (const float*)(p.ws + WS_Z) + (size_t)(NP + b) * IN_DIM;
    const bf16_t* KCSB = (const bf16_t*)(p.ws + WS_KCSB) + (size_t)(b * 2 + hkv) * 1024 * 64;
    const bf16_t* VTCS = (const bf16_t*)(p.ws + WS_VTCS) + (size_t)(b * 2 + hkv) * 64 * 1024;
    bf16_t* NOUTB = (bf16_t*)(p.ws + WS_NOUTB);
    __syncthreads();
    for (int i = tid; i < 4 * 192; i += 256) { const int gg = i / 192, d = i % 192; biasl[i] = (p.rel_bias[rel_bucket(d) * 8 + hkv * 4 + gg] - p.rel_bias[31 * 8 + hkv * 4 + gg]) * LOG2E; }
    for (int i = tid; i < 260; i += 256) psl[i] = 0.f;
    const float* blut = biasl + g * 192;
    bf16x8 Qf[QN][2];
#pragma unroll
    for (int kk = 0; kk < 2; ++kk) { Qf[0][kk] = *(const bf16x8*)(ZB + (size_t)(NP + b) * IN_DIM + C_Q + hq * 64 + kk * 32 + lq * 8); Qf[1][kk] = Qf[0][kk]; }
    AttnState A;
    auto reset = [&](AttnState& S_) __attribute__((always_inline)) {
#pragma unroll
        for (int qi = 0; qi < QN; ++qi) { S_.m[qi] = NEGF; S_.l[qi] = 0.f;
#pragma unroll
            for (int dt = 0; dt < 4; ++dt) S_.ot[dt][qi] = (f32x4){0.f, 0.f, 0.f, 0.f}; }
    };
    f32x4 res[4];
#pragma unroll
    for (int dt = 0; dt < 4; ++dt) res[dt] = (f32x4){0.f, 0.f, 0.f, 0.f};
    auto finish = [&](AttnState& S_, int br) __attribute__((always_inline)) {
        float lt = S_.l[0]; lt += __shfl_xor(lt, 16); lt += __shfl_xor(lt, 32);
        const float sc = (lt > 0.f) ? sigmoidf_(zrow[C_G + br * 8 + hq]) / lt : 0.f;
#pragma unroll
        for (int dt = 0; dt < 4; ++dt) res[dt] = res[dt] + S_.ot[dt][0] * sc;
    };
    uint4 trk0, trk1, trv0, trv1;
    auto load_cmp = [&](int kb) __attribute__((always_inline)) {
#pragma unroll
        for (int i = 0; i < 2; ++i) {
            const int id = tid + 256 * i, row = id >> 3, ch = id & 7;
            const uint4 rk = *(const uint4*)(KCSB + (size_t)(kb * 64 + row) * 64 + ch * 8), rv = *(const uint4*)(VTCS + (size_t)row * 1024 + kb * 64 + ch * 8);
            if (i == 0) { trk0 = rk; trv0 = rv; } else { trk1 = rk; trv1 = rv; }
        }
    };
    auto store_cmp = [&]() __attribute__((always_inline)) {
#pragma unroll
        for (int i = 0; i < 2; ++i) { const int id = tid + 256 * i, row = id >> 3, ch = id & 7; *(uint4*)(Ks + row * 144 + ch * 16) = (i == 0 ? trk0 : trk1); *(uint4*)(VTs + row * 144 + ch * 16) = (i == 0 ? trv0 : trv1); }
    };
    reset(A);
    load_cmp(0);
    for (int kb = 0; kb < 16; ++kb) {
        __syncthreads(); store_cmp(); __syncthreads();
        if (kb + 1 < 16) load_cmp(kb + 1);
        attn_block(Ks, VTs, Qf, A, 5, PAST - 31 - 16 * (kb * 64), blut, 1u, 1u, false, lr, lq, (kb == 15) ? 63 : 64, 16);
    }
    finish(A, 0);
    {
        float lt = A.l[0]; lt += __shfl_xor(lt, 16); lt += __shfl_xor(lt, 32);
        const float linv = (lt > 0.f) ? 1.0f / lt : 0.f;
        for (int kb = 0; kb < 16; ++kb) {
            load_cmp(kb); __syncthreads(); store_cmp(); __syncthreads();
#pragma unroll
            for (int kt = 0; kt < 4; ++kt) {
                const bf16x8 k0 = *(const bf16x8*)(Ks + (kt * 16 + lr) * 144 + lq * 16), k1 = *(const bf16x8*)(Ks + (kt * 16 + lr) * 144 + 64 + lq * 16);
                f32x4 a = (f32x4){0.f, 0.f, 0.f, 0.f};
                a = __builtin_amdgcn_mfma_f32_16x16x32_bf16(k0, Qf[0][0], a, 0, 0, 0);
                a = __builtin_amdgcn_mfma_f32_16x16x32_bf16(k1, Qf[0][1], a, 0, 0, 0);
                float pr[4];
#pragma unroll
                for (int gg = 0; gg < 4; ++gg) {
                    const int ci = kb * 64 + kt * 16 + lq * 4 + gg, dist = PAST - 31 - 16 * ci;
                    float v = a[gg];
                    if (dist >= 0 && dist < 192) v += blut[dist];
                    pr[gg] = (ci < 1023) ? __builtin_amdgcn_exp2f(v - A.m[0]) * linv : 0.f;
                }
                if (lr == 0) {
                    const int blk = kb * 16 + kt * 4 + lq;
                    atomicAdd(&psl[blk], 2.0f * (pr[0] + pr[1] + pr[2]) + pr[3]);
                    atomicAdd(&psl[blk + 1], pr[3]);
                }
            }
        }
    }
    __syncthreads();
    for (int j = tid; j < 257; j += 256) scl[j] = (j == 0 || j == 256 || j == 255) ? 1e4f : psl[j];
    __syncthreads();
    for (int j = tid; j < 257; j += 256) {
        const float my = scl[j];
        int rank = 0;
        for (int k = 0; k < 257; ++k) { const float o2 = scl[k]; rank += ((o2 > my) || (o2 == my && k < j)) ? 1 : 0; }
        if (rank < 16) sell[rank] = j;
    }
    __syncthreads();
    uint4 rk0, rk1; unsigned rv0, rv1, rv2, rv3, rv4, rv5, rv6, rv7;
    auto load_rows = [&](const float* src) __attribute__((always_inline)) {
        const int seg = tid & 3;
        const bool nz = src != nullptr;
        const float* kp = (nz ? src : zrow) + hkv * 64 + seg * 16; const float* vp = kp + 128;
        const float4 a0 = *(const float4*)kp, a1 = *(const float4*)(kp + 4), a2 = *(const float4*)(kp + 8), a3 = *(const float4*)(kp + 12);
        const float4 c0 = *(const float4*)vp, c1 = *(const float4*)(vp + 4), c2 = *(const float4*)(vp + 8), c3 = *(const float4*)(vp + 12);
        const unsigned mk = nz ? 0xffffffffu : 0u;
        rk0.x = cvt_pk_bf16(a0.x, a0.y) & mk; rk0.y = cvt_pk_bf16(a0.z, a0.w) & mk; rk0.z = cvt_pk_bf16(a1.x, a1.y) & mk; rk0.w = cvt_pk_bf16(a1.z, a1.w) & mk;
        rk1.x = cvt_pk_bf16(a2.x, a2.y) & mk; rk1.y = cvt_pk_bf16(a2.z, a2.w) & mk; rk1.z = cvt_pk_bf16(a3.x, a3.y) & mk; rk1.w = cvt_pk_bf16(a3.z, a3.w) & mk;
        rv0 = cvt_pk_bf16(c0.x, c0.y) & mk; rv1 = cvt_pk_bf16(c0.z, c0.w) & mk; rv2 = cvt_pk_bf16(c1.x, c1.y) & mk; rv3 = cvt_pk_bf16(c1.z, c1.w) & mk;
        rv4 = cvt_pk_bf16(c2.x, c2.y) & mk; rv5 = cvt_pk_bf16(c2.z, c2.w) & mk; rv6 = cvt_pk_bf16(c3.x, c3.y) & mk; rv7 = cvt_pk_bf16(c3.z, c3.w) & mk;
    };
    auto store_rows = [&]() __attribute__((always_inline)) {
        const int kl = tid >> 2, seg = tid & 3;
        *(uint4*)(Ks + kl * 144 + seg * 32) = rk0; *(uint4*)(Ks + kl * 144 + seg * 32 + 16) = rk1;
#define VT_PUT(i_, w_) { *(bf16_t*)(VTs + (seg * 16 + (i_)) * 144 + kl * 2) = (bf16_t)((w_) & 0xffffu); *(bf16_t*)(VTs + (seg * 16 + (i_) + 1) * 144 + kl * 2) = (bf16_t)((w_) >> 16); }
        VT_PUT(0, rv0) VT_PUT(2, rv1) VT_PUT(4, rv2) VT_PUT(6, rv3) VT_PUT(8, rv4) VT_PUT(10, rv5) VT_PUT(12, rv6) VT_PUT(14, rv7)
#undef VT_PUT
    };
    auto slc_row = [&](int blk) __attribute__((always_inline)) -> const float* {
        const int kl = tid >> 2;
        if (blk < 256) { const int page = p.page_table[b * 128 + (blk >> 1)]; return p.cache_slc + ((size_t)page * 128 + (blk & 1) * 64 + kl) * 256; }
        return (kl == 0) ? zrow + C_KS : nullptr;
    };
    reset(A);
    load_rows(slc_row(sell[0]));
    for (int si = 0; si < 16; ++si) {
        const int blk = sell[si];
        __syncthreads(); store_rows(); __syncthreads();
        if (si + 1 < 16) load_rows(slc_row(sell[si + 1]));
        attn_block(Ks, VTs, Qf, A, 5, PAST - blk * 64, blut, 1u, 1u, false, lr, lq, (blk == 256) ? 1 : 64, 1);
    }
    finish(A, 1);
    auto win_row = [&](int wb) __attribute__((always_inline)) -> const float* {
        const int j = 1 + wb * 64 + (tid >> 2);
        return (j < 512) ? p.state_win + ((size_t)b * 512 + j) * 256 : zrow + C_KW;
    };
    reset(A);
    load_rows(win_row(0));
    for (int wb = 0; wb < 8; ++wb) {
        __syncthreads(); store_rows(); __syncthreads();
        if (wb + 1 < 8) load_rows(win_row(wb + 1));
        attn_block(Ks, VTs, Qf, A, 5, 511 - wb * 64, blut, 1u, 1u, false, lr, lq, 64, 1);
    }
    finish(A, 2);
    if (lr == 0) {
#pragma unroll
        for (int dt = 0; dt < 4; ++dt) store_bf16x4(NOUTB + (size_t)(NP + b) * 512 + hq * 64 + dt * 16 + lq * 4, res[dt]);
    }
}

#define Z ((float*)(p.ws + WS_Z))
#define QK ((float*)(p.ws + WS_QK))
#define HRAW ((float*)(p.ws + WS_HRAW))
#define MOUTB ((bf16_t*)(p.ws + WS_MOUTB))
#define NOUTB ((bf16_t*)(p.ws + WS_NOUTB))
#define HIDPB ((bf16_t*)(p.ws + WS_HIDPB))
#define HIDSB ((bf16_t*)(p.ws + WS_HIDSB))
#define KCS ((float*)(p.ws + WS_KCS))
#define MIX ((float*)(p.ws + WS_MIX))
#define MIXB ((bf16_t*)(p.ws + WS_MIXB))
#define T1 ((float*)(p.ws + WS_T1))
#define X1 ((float*)(p.ws + WS_X1))
#define X1B ((bf16_t*)(p.ws + WS_X1B))
#define QPB ((bf16_t*)(p.ws + WS_QPB))
#define S ((float*)(p.ws + WS_S))
#define CONVB ((bf16_t*)(p.ws + WS_CONVB))
#define XB ((bf16_t*)(p.ws + WS_XB))
#define WIN_T ((bf16_t*)(p.ws + WS_WIN_T))
#define WUPM_T ((bf16_t*)(p.ws + WS_WUPM_T))
#define WUPN_T ((bf16_t*)(p.ws + WS_WUPN_T))
#define WOUT_T ((bf16_t*)(p.ws + WS_WOUT_T))
#define PWQ_T ((bf16_t*)(p.ws + WS_PWQ_T))
#define WQK_T ((bf16_t*)(p.ws + WS_WQK_T))
#define W1_T ((bf16_t*)(p.ws + WS_W1_T))
#define W2_T ((bf16_t*)(p.ws + WS_W2_T))
#define SUBK ((bf16_t*)(p.ws + WS_SUBK))
#define ZB ((bf16_t*)(p.ws + WS_ZB))
#define VTS ((bf16_t*)(p.ws + WS_VTS))
#define VTW ((bf16_t*)(p.ws + WS_VTW))
#define KCB ((bf16_t*)(p.ws + WS_KCB))
#define VTC ((bf16_t*)(p.ws + WS_VTC))
__global__ void __launch_bounds__(NTHREADS, 2) fwd_kernel(Params p) {
    extern __shared__ __attribute__((aligned(16))) unsigned char smem[];
    if (threadIdx.x == 0) { *(uint4*)smem = make_uint4(0u, 0u, 0u, 0u); }
    __syncthreads();
    XcdBarrier bar = xcd_barrier_post((unsigned*)(p.ws + WS_BAR), (volatile LAS unsigned*)smem);
    float* lds = (float*)(smem + 16);
    unsigned char* ldsb = smem + 16;
    const int tid = threadIdx.x, lane = tid & 63, w = tid >> 6;
    const int gw = blockIdx.x * 4 + w, nw = gridDim.x * 4;
    const size_t gt = (size_t)blockIdx.x * NTHREADS + tid, nt = (size_t)gridDim.x * NTHREADS;


    {
        for (size_t id = gt; id < (size_t)MP * 128; id += nt) {
            const int row = (int)(id >> 7), k8 = (int)(id & 127) * 8;
            float f[8];
            if (row < NR) {
                const float* s = (row < NP ? p.x_prompt + (size_t)row * 1024 : p.x_sample + (size_t)(row - NP) * 1024) + k8;
                const float4 a = *(const float4*)s, b = *(const float4*)(s + 4);
                f[0] = a.x; f[1] = a.y; f[2] = a.z; f[3] = a.w; f[4] = b.x; f[5] = b.y; f[6] = b.z; f[7] = b.w;
            } else {
#pragma unroll
                for (int i = 0; i < 8; ++i) f[i] = 0.f;
            }
            *(uint4*)(XB + (size_t)row * 1024 + k8) = pack8(f);
        }
        transpose_to_bf16(p.w_in, 1024, IN_DIM, WIN_T, gt, nt);
        transpose_to_bf16(p.w_up_m, 512, 1024, WUPM_T, gt, nt);
        transpose_to_bf16(p.w_up_n, 512, 1024, WUPN_T, gt, nt);
        transpose_to_bf16(p.w_out, 1024, 1024, WOUT_T, gt, nt);
        transpose_to_bf16(p.peer_wq, 1024, 2048, PWQ_T, gt, nt);
        for (int h = 0; h < 4; ++h) {
            transpose_to_bf16(p.wq + (size_t)h * 16384, 128, 128, WQK_T + (size_t)(h * 256) * 128, gt, nt);
            transpose_to_bf16(p.wk + (size_t)h * 16384, 128, 128, WQK_T + (size_t)(h * 256 + 128) * 128, gt, nt);
        }
        for (size_t id = gt; id < (size_t)2 * 128 * 128; id += nt) {
            const int k8 = (int)(id & 127) * 8, np = (int)((id >> 7) & 127), c = (int)(id >> 14);
            const int pp = np >> 6, o = np & 63, r = k8 >> 6, d = k8 & 63;
            float f[8];
#pragma unroll
            for (int e = 0; e < 8; ++e) f[e] = p.cmp_w1[((size_t)c * 2048 + (pp * 16 + r) * 64 + d + e) * 64 + o];
            *(uint4*)(W1_T + ((size_t)c * 128 + np) * 1024 + k8) = pack8(f);
        }
        if (gt < 128) {
            const int c = (int)gt >> 6, o = (int)gt & 63;
            float a = 0.f;
            for (int k = 0; k < 2048; ++k) a += p.cmp_pe[c * 2048 + k] * p.cmp_w1[((size_t)c * 2048 + k) * 64 + o];
            ((float*)(p.ws + WS_PESUM))[gt] = a;
        }
        for (int c = 0; c < 2; ++c) transpose_to_bf16(p.cmp_w2 + (size_t)c * 4096, 64, 64, W2_T + (size_t)c * 4096, gt, nt);
        for (size_t id = gt; id < (size_t)2 * 128 * 128 / 8; id += nt) {
            float f[8];
#pragma unroll
            for (int i = 0; i < 8; ++i) f[i] = p.peer_sub[id * 8 + i];
            *(uint4*)(SUBK + id * 8) = pack8(f);
        }
        for (size_t id = gt; id < (size_t)16384 * 64; id += nt) {
            const float* su = p.peer_u + id * 16; const float* sv = p.peer_v + id * 16;
            uint4 ou, ov; unsigned* pu = (unsigned*)&ou; unsigned* pv = (unsigned*)&ov;
#pragma unroll
            for (int j = 0; j < 4; ++j) {
                const float4 a4 = *(const float4*)(su + j * 4), c4 = *(const float4*)(sv + j * 4);
                pu[j] = pack4_fp8(a4.x * PEER_U_SCALE, a4.y * PEER_U_SCALE, a4.z * PEER_U_SCALE, a4.w * PEER_U_SCALE);
                pv[j] = pack4_fp8(c4.x * PEER_V_SCALE, c4.y * PEER_V_SCALE, c4.z * PEER_V_SCALE, c4.w * PEER_V_SCALE);
            }
            *(uint4*)(p.ws + WS_U8 + id * 16) = ou; *(uint4*)(p.ws + WS_V8 + id * 16) = ov;
        }
        for (size_t i = gt; i < (size_t)BS * 511 * 256; i += nt) {
            const int j = (int)(i & 255); const int wv = (int)((i >> 8) % 511); const int b = (int)((i >> 8) / 511);
            p.out[O_WINS + ((size_t)b * 512 + wv) * 256 + j] = p.state_win[((size_t)b * 512 + wv + 1) * 256 + j];
        }
        for (size_t i = gt; i < (size_t)BS * 2 * 512; i += nt) {
            const int ch = (int)(i & 511); const int jj = (int)((i >> 9) & 1); const int b = (int)(i >> 10);
            p.out[O_CVS + ((size_t)b * 3 + jj) * 512 + ch] = p.state_conv[((size_t)b * 3 + jj + 1) * 512 + ch];
        }
    }
    xcd_barrier(bar);

    gemm_bf16<128>(NR, IN_DIM, 1024,
        [&](int r, int k) { return *(const uint4*)(XB + (size_t)r * 1024 + k); },
        [&](int n, int k) { return *(const uint4*)(WIN_T + (size_t)n * 1024 + k); },
        [&](int r, int c0, f32x4 v) {
            *(f32x4*)(Z + (size_t)r * IN_DIM + c0) = v;
            store_bf16x4(ZB + (size_t)r * IN_DIM + c0, (c0 >= C_Q && c0 < C_KC) ? v * (0.125f * LOG2E) : v);
            if (r < NP && ((c0 >= C_KS + 128 && c0 < C_KW) || (c0 >= C_KW + 128 && c0 < C_G))) {
                const bool isw = c0 >= C_KW; const int cc = c0 - (isw ? C_KW : C_KS) - 128;
                bf16_t* vt = (isw ? VTW : VTS) + ((size_t)((r >> 11) * 2) * 64 + cc) * 2048 + (r & 2047);
                const unsigned w0 = cvt_pk_bf16(v[0], v[1]), w1 = cvt_pk_bf16(v[2], v[3]);
                vt[0] = (bf16_t)(w0 & 0xffffu); vt[2048] = (bf16_t)(w0 >> 16); vt[4096] = (bf16_t)(w1 & 0xffffu); vt[6144] = (bf16_t)(w1 >> 16);
            }
            if (r < NP && c0 >= C_V && c0 < C_O) {
                bf16_t* vt = (bf16_t*)(p.ws + WS_VTM) + ((size_t)(r >> 11) * 512 + (c0 - C_V)) * 2048 + (r & 2047);
                const unsigned w0 = cvt_pk_bf16(v[0], v[1]), w1 = cvt_pk_bf16(v[2], v[3]);
                vt[0] = (bf16_t)(w0 & 0xffffu); vt[2048] = (bf16_t)(w0 >> 16); vt[4096] = (bf16_t)(w1 & 0xffffu); vt[6144] = (bf16_t)(w1 >> 16);
            }
            if (c0 >= C_KC && c0 < C_KS) *(f32x4*)(p.out + O_CMPP + (size_t)r * 256 + (c0 - C_KC)) = v;
            else if (c0 >= C_KS && c0 < C_KW) *(f32x4*)(p.out + O_SLCP + (size_t)r * 256 + (c0 - C_KS)) = v;
            else if (c0 >= C_KW && c0 < C_G) {
                if (r < NP) { const int t = r & 2047; if (t >= 1536) *(f32x4*)(p.out + O_WINP + ((size_t)(r >> 11) * 512 + (t - 1536)) * 256 + (c0 - C_KW)) = v; }
                else *(f32x4*)(p.out + O_WINS + ((size_t)(r - NP) * 512 + 511) * 256 + (c0 - C_KW)) = v;
            } else if (c0 < C_V) {
                if (r < NP) { const int t = r & 2047; if (t >= 2045) *(f32x4*)(p.out + O_CVP + ((size_t)(r >> 11) * 3 + (t - 2045)) * 512 + c0) = v; }
                else *(f32x4*)(p.out + O_CVS + ((size_t)(r - NP) * 3 + 2) * 512 + c0) = v;
            }
        }, ldsb);
    xcd_barrier(bar);

    for (size_t i = gt; i < (size_t)NR * 512; i += nt) {
        const int ch = (int)(i & 511); const int r = (int)(i >> 9);
        float a = p.conv_b[ch];
        if (r < NP) {
            const int t = r & 2047;
#pragma unroll
            for (int j = 0; j < 4; ++j) if (t + j - 3 >= 0) a += p.conv_w[j * 512 + ch] * Z[(size_t)(r + j - 3) * IN_DIM + C_U + ch];
        } else {
            const int b = r - NP;
#pragma unroll
            for (int j = 0; j < 3; ++j) a += p.conv_w[j * 512 + ch] * p.state_conv[((size_t)b * 3 + j) * 512 + ch];
            a += p.conv_w[3 * 512 + ch] * Z[(size_t)r * IN_DIM + C_U + ch];
        }
        CONVB[i] = (bf16_t)(cvt_pk_bf16(a / (1.0f + expf(-a)), 0.f) & 0xffffu);
    }
    xcd_barrier(bar);

    for (int h = 0; h < 4; ++h) {
        gemm_bf16<128>(NR, 256, 128,
            [&](int r, int k) { return *(const uint4*)(CONVB + (size_t)r * 512 + h * 128 + k); },
            [&](int n, int k) { return *(const uint4*)(WQK_T + (size_t)(h * 256 + n) * 128 + k); },
            [&](int r, int c0, f32x4 v) {
                if (c0 >= 128) v = v * 0.08838834764831845f;
                *(f32x4*)(QK + (size_t)r * 1024 + h * 256 + c0) = v;
                if (c0 < 128) store_bf16x4((bf16_t*)(p.ws + WS_QB) + (size_t)r * 512 + h * 128 + c0, v);
                else {
                    store_bf16x4((bf16_t*)(p.ws + WS_KB) + (size_t)r * 512 + h * 128 + (c0 - 128), v);
                    if (r < NP) {
                        bf16_t* kt = (bf16_t*)(p.ws + WS_KTB) + ((size_t)((r >> 11) * 4 + h) * 128 + (c0 - 128)) * 2048 + (r & 2047);
                        const unsigned w0 = cvt_pk_bf16(v[0], v[1]), w1 = cvt_pk_bf16(v[2], v[3]);
                        kt[0] = (bf16_t)(w0 & 0xffffu); kt[2048] = (bf16_t)(w0 >> 16); kt[4096] = (bf16_t)(w1 & 0xffffu); kt[6144] = (bf16_t)(w1 >> 16);
                    }
                } }, ldsb, h * 514);
    }
    for (int c = 0; c < 2; ++c) {
        for (int grp = 0; grp < 2; ++grp) {
            const int TPB = grp ? 9 : 1, NCH = grp ? 1024 : 128, NBH = grp ? 64 : 32;
            gemm_bf16<128, true>(NBH * TPB * 128, 128, 1024,
                [&](int vrow, int k) {
                    const int tile = vrow >> 7, bh = tile / TPB, n_ = 127 * (tile % TPB) + (vrow & 127), n = n_ < NCH ? n_ : NCH - 1;
                    const int b = bh >> 1, hh = bh & 1, tok = 16 * n + (k >> 6), d0 = k & 63;
                    if (!grp) return *(const uint4*)(ZB + ((size_t)b * 2048 + tok) * IN_DIM + C_KC + c * 128 + hh * 64 + d0);
                    const int page = p.page_table[b * 128 + (tok >> 7)];
                    const float* sp = p.cache_cmp + ((size_t)page * 128 + (tok & 127)) * 256 + c * 128 + hh * 64 + d0;
                    const float4 a0 = *(const float4*)sp, a1 = *(const float4*)(sp + 4);
                    float f[8] = {a0.x, a0.y, a0.z, a0.w, a1.x, a1.y, a1.z, a1.w};
                    return pack8(f); },
                [&](int n, int k) { return *(const uint4*)(W1_T + ((size_t)c * 128 + n) * 1024 + k); },
                [&](f32x4 (&acc)[4][4], int bm) {
                    const int lr = lane & 15, lq = lane >> 4, wm = w >> 1, wn = w & 1;
                    const int tile = bm >> 7, bh = tile / TPB, n0 = 127 * (tile % TPB);
                    float* P1 = (float*)ldsb;
                    bf16_t* HL = (bf16_t*)(ldsb + 128 * 68 * 4);
                    __syncthreads();
                    if (wn == 1) {
#pragma unroll
                        for (int i = 0; i < 4; ++i)
#pragma unroll
                            for (int j = 0; j < 4; ++j) *(f32x4*)(P1 + (wm * 64 + i * 16 + lr) * 68 + j * 16 + lq * 4) = acc[i][j];
                    }
                    __syncthreads();
                    if (wn == 0) {
                        const float* pes = (const float*)(p.ws + WS_PESUM) + c * 64;
#pragma unroll
                        for (int i = 0; i < 4; ++i)
#pragma unroll
                            for (int j = 0; j < 4; ++j) {
                                const int rl = wm * 64 + i * 16 + lr, o0 = j * 16 + lq * 4;
                                const f32x4 nx = (rl < 127) ? *(const f32x4*)(P1 + (rl + 1) * 68 + o0) : (f32x4){0.f, 0.f, 0.f, 0.f};
                                const f32x4 pe4 = *(const f32x4*)(pes + o0);
                                f32x4 hv = acc[i][j] + nx + pe4;
                                hv[0] = gelu_tanh(hv[0]); hv[1] = gelu_tanh(hv[1]); hv[2] = gelu_tanh(hv[2]); hv[3] = gelu_tanh(hv[3]);
                                store_bf16x4(HL + rl * 72 + o0, hv);
                            }
                    }
                    __syncthreads();
                    f32x4 kc[2][4];
#pragma unroll
                    for (int i = 0; i < 2; ++i)
#pragma unroll
                        for (int j = 0; j < 4; ++j) kc[i][j] = (f32x4){0.f, 0.f, 0.f, 0.f};
#pragma unroll
                    for (int ks = 0; ks < 2; ++ks) {
                        bf16x8 hf[2], wf[4];
#pragma unroll
                        for (int i = 0; i < 2; ++i) hf[i] = *(const bf16x8*)(HL + (w * 32 + i * 16 + lr) * 72 + ks * 32 + lq * 8);
#pragma unroll
                        for (int j = 0; j < 4; ++j) wf[j] = *(const bf16x8*)(W2_T + ((size_t)c * 64 + j * 16 + lr) * 64 + ks * 32 + lq * 8);
#pragma unroll
                        for (int i = 0; i < 2; ++i)
#pragma unroll
                            for (int j = 0; j < 4; ++j) kc[i][j] = __builtin_amdgcn_mfma_f32_16x16x32_bf16(wf[j], hf[i], kc[i][j], 0, 0, 0);
                    }
#pragma unroll
                    for (int i = 0; i < 2; ++i) {
                        const int rl = w * 32 + i * 16 + lr, blk = n0 + rl;
                        if (rl < 127 && blk <= NCH - 2) {
#pragma unroll
                            for (int j = 0; j < 4; ++j) {
                                const int o2 = j * 16 + lq * 4;
                                if (c == 0) store_bf16x4((grp ? (bf16_t*)(p.ws + WS_KCSB) : KCB) + ((size_t)bh * NCH + blk) * 64 + o2, kc[i][j]);
                                else { bf16_t* vt = (grp ? (bf16_t*)(p.ws + WS_VTCS) : VTC) + ((size_t)bh * 64 + o2) * NCH + blk;
                                       const unsigned w0 = cvt_pk_bf16(kc[i][j][0], kc[i][j][1]), w1 = cvt_pk_bf16(kc[i][j][2], kc[i][j][3]);
                                       vt[0] = (bf16_t)(w0 & 0xffffu); vt[NCH] = (bf16_t)(w0 >> 16); vt[2 * NCH] = (bf16_t)(w1 & 0xffffu); vt[3 * NCH] = (bf16_t)(w1 >> 16); }
                            }
                        }
                    }
                    __syncthreads();
                }, ldsb, 4 * 514 + c * 608 + grp * 32);
        }
    }
    xcd_barrier(bar);

    for (int item = blockIdx.x; item < 256 + 128; item += gridDim.x) {
        if (item < 256) mlstm_chunk_item(p, item, ldsb); else mlstm_scan_item(p, 64 + (item - 256), lds);
    }
    xcd_barrier(bar);

    for (int it = gw; it < NR * 4; it += nw) {
        const int row = it >> 2, h = it & 3;
        const float x0 = HRAW[(size_t)row * 512 + h * 128 + lane], x1 = HRAW[(size_t)row * 512 + h * 128 + 64 + lane];
        const float mu = wave_sum(x0 + x1) * (1.0f / 128.0f);
        const float d0 = x0 - mu, d1 = x1 - mu;
        const float var = wave_sum(d0 * d0 + d1 * d1) * (1.0f / 128.0f);
        const float rstd = 1.0f / sqrtf(var + LN_EPS);
        const int c0 = h * 128 + lane, c1 = c0 + 64;
        MOUTB[(size_t)row * 512 + c0] = (bf16_t)(cvt_pk_bf16(sigmoidf_(Z[(size_t)row * IN_DIM + C_O + c0]) * (d0 * rstd * p.norm_g[c0]), 0.f) & 0xffffu);
        MOUTB[(size_t)row * 512 + c1] = (bf16_t)(cvt_pk_bf16(sigmoidf_(Z[(size_t)row * IN_DIM + C_O + c1]) * (d1 * rstd * p.norm_g[c1]), 0.f) & 0xffffu);
    }
    for (;;) {
        __syncthreads();
        if (tid == 0) *(volatile int*)(ldsb + 32768) = (int)atomicAdd((unsigned*)(p.ws + WS_BAR) + 2, 1u);
        __syncthreads();
        const int idx = *(volatile int*)(ldsb + 32768);
        if (idx >= 64 + 2048) break;
        if (idx < 64) nsa_sample_item(p, idx >> 1, idx & 1, ldsb);
        else { const int i2 = idx - 64; nsa_prompt_item(p, (i2 & 31) >> 1, i2 & 1, 63 - (i2 >> 5), ldsb); }
    }
    xcd_barrier(bar);

    gemm_bf16<128>(NR, 1024, 512,
        [&](int r, int k) { return *(const uint4*)(MOUTB + (size_t)r * 512 + k); },
        [&](int n, int k) { return *(const uint4*)(WUPM_T + (size_t)n * 512 + k); },
        [&](int r, int c0, f32x4 v) {
            const f32x4 g = *(const f32x4*)(Z + (size_t)r * IN_DIM + C_GM + c0);
            f32x4 o; o[0] = sigmoidf_(g[0]) * v[0]; o[1] = sigmoidf_(g[1]) * v[1]; o[2] = sigmoidf_(g[2]) * v[2]; o[3] = sigmoidf_(g[3]) * v[3];
            *(f32x4*)(MIX + (size_t)r * 1024 + c0) = o; }, ldsb);
    gemm_bf16<128>(NR, 1024, 512,
        [&](int r, int k) { return *(const uint4*)(NOUTB + (size_t)r * 512 + k); },
        [&](int n, int k) { return *(const uint4*)(WUPN_T + (size_t)n * 512 + k); },
        [&](int r, int c0, f32x4 v) {
            const f32x4 g = *(const f32x4*)(Z + (size_t)r * IN_DIM + C_GN + c0);
            f32x4 o = *(const f32x4*)(MIX + (size_t)r * 1024 + c0);
            o[0] += sigmoidf_(g[0]) * v[0]; o[1] += sigmoidf_(g[1]) * v[1]; o[2] += sigmoidf_(g[2]) * v[2]; o[3] += sigmoidf_(g[3]) * v[3];
            store_bf16x4(MIXB + (size_t)r * 1024 + c0, o); }, ldsb);
    xcd_barrier(bar);

    gemm_bf16<128>(NR, 1024, 1024,
        [&](int r, int k) { return *(const uint4*)(MIXB + (size_t)r * 1024 + k); },
        [&](int n, int k) { return *(const uint4*)(WOUT_T + (size_t)n * 1024 + k); },
        [&](int r, int c0, f32x4 v) {
            const f32x4 xv = *(const f32x4*)((r < NP ? p.x_prompt + (size_t)r * 1024 : p.x_sample + (size_t)(r - NP) * 1024) + c0);
            *(f32x4*)(T1 + (size_t)r * 1024 + c0) = xv * DN_ALPHA + v; }, ldsb);
    xcd_barrier(bar);

    for (int row = gw; row < NR; row += nw) {
        float tv[16]; float s = 0.f;
#pragma unroll
        for (int j = 0; j < 4; ++j) { const float4 t4 = *(const float4*)(T1 + (size_t)row * 1024 + j * 256 + lane * 4); tv[4 * j] = t4.x; tv[4 * j + 1] = t4.y; tv[4 * j + 2] = t4.z; tv[4 * j + 3] = t4.w; s += (t4.x + t4.y) + (t4.z + t4.w); }
        const float mu = wave_sum(s) * (1.0f / 1024.0f);
        float q = 0.f;
#pragma unroll
        for (int j = 0; j < 16; ++j) { const float d = tv[j] - mu; q += d * d; }
        const float rstd = 1.0f / sqrtf(wave_sum(q) * (1.0f / 1024.0f) + LN_EPS);
#pragma unroll
        for (int j = 0; j < 4; ++j) {
            const int c = j * 256 + lane * 4;
            const float4 g4 = *(const float4*)(p.ln1_g + c), b4 = *(const float4*)(p.ln1_b + c);
            f32x4 o; o[0] = (tv[4 * j] - mu) * rstd * g4.x + b4.x; o[1] = (tv[4 * j + 1] - mu) * rstd * g4.y + b4.y; o[2] = (tv[4 * j + 2] - mu) * rstd * g4.z + b4.z; o[3] = (tv[4 * j + 3] - mu) * rstd * g4.w + b4.w;
            *(f32x4*)(X1 + (size_t)row * 1024 + c) = o;
            store_bf16x4(X1B + (size_t)row * 1024 + c, o);
        }
    }
    xcd_barrier(bar);

    gemm_bf16<128>(NR, 2048, 1024,
        [&](int r, int k) { return *(const uint4*)(X1B + (size_t)r * 1024 + k); },
        [&](int n, int k) { return *(const uint4*)(PWQ_T + (size_t)n * 1024 + k); },
        [&](int r, int c0, f32x4 v) { store_bf16x4(QPB + (size_t)r * 2048 + c0, v); }, ldsb);
    xcd_barrier(bar);

    for (int it = blockIdx.x; it < 513 * 8; it += gridDim.x) { __syncthreads(); peer_score_topk_item(p, it >> 3, it & 7, ldsb); }
    xcd_barrier(bar);

    for (int row = gw; row < NR; row += nw) peer_expert_wave(p, row, ldsb + w * 3072, lane);
}

extern "C" void kernel_launch(void* const* d_in, const int* in_sizes, int n_in, void* d_out, int out_size, void* d_ws, size_t ws_size, hipStream_t stream) {
    static int grid = 0;
    if (grid == 0) {
        if (n_in != 32 || (size_t)out_size != O_END || ws_size < WS_END) {
            fprintf(stderr, "kernel_launch: unexpected sizes n_in %d out %d ws %zu (need %zu)\n", n_in, out_size, ws_size, (size_t)WS_END); grid = -1; return; }
        int dev = 0, cus = 0, per_cu = 0;
        if (hipGetDevice(&dev) != hipSuccess || hipDeviceGetAttribute(&cus, hipDeviceAttributeMultiprocessorCount, dev) != hipSuccess) { grid = -1; return; }
        if (hipFuncSetAttribute((const void*)fwd_kernel, hipFuncAttributeMaxDynamicSharedMemorySize, LDS_BYTES) != hipSuccess) { fprintf(stderr, "hipFuncSetAttribute failed\n"); grid = -1; return; }
        if (hipOccupancyMaxActiveBlocksPerMultiprocessor(&per_cu, (const void*)fwd_kernel, NTHREADS, LDS_BYTES) != hipSuccess || per_cu < 1) { fprintf(stderr, "occupancy query failed (%d)\n", per_cu); (void)hipGetLastError(); per_cu = 1; }
        if (per_cu > 2) per_cu = 2;
        grid = cus * per_cu;
    }
    if (grid < 0) return;
    (void)hipMemsetAsync((char*)d_ws + WS_BAR, 0, XCD_BAR_WORDS * sizeof(unsigned), stream);
    Params p{};
    p.x_prompt = (const float*)d_in[0]; p.x_sample = (const float*)d_in[1]; p.cache_cmp = (const float*)d_in[2]; p.cache_slc = (const float*)d_in[3];
    p.page_table = (const int*)d_in[4]; p.state_win = (const float*)d_in[5]; p.state_C = (const float*)d_in[6]; p.state_n = (const float*)d_in[7];
    p.state_m = (const float*)d_in[8]; p.state_conv = (const float*)d_in[9]; p.w_in = (const float*)d_in[10]; p.conv_w = (const float*)d_in[11];
    p.conv_b = (const float*)d_in[12]; p.wq = (const float*)d_in[13]; p.wk = (const float*)d_in[14]; p.gate_bias = (const float*)d_in[15];
    p.norm_g = (const float*)d_in[16]; p.cmp_pe = (const float*)d_in[17]; p.cmp_w1 = (const float*)d_in[18]; p.cmp_w2 = (const float*)d_in[19];
    p.rel_bias = (const float*)d_in[20]; p.w_up_m = (const float*)d_in[21]; p.w_up_n = (const float*)d_in[22]; p.w_out = (const float*)d_in[23];
    p.ln1_g = (const float*)d_in[24]; p.ln1_b = (const float*)d_in[25]; p.ln2_g = (const float*)d_in[26]; p.ln2_b = (const float*)d_in[27];
    p.peer_wq = (const float*)d_in[28]; p.peer_sub = (const float*)d_in[29]; p.peer_u = (const float*)d_in[30]; p.peer_v = (const float*)d_in[31];
    p.out = (float*)d_out; p.ws = (unsigned char*)d_ws;
    hipLaunchKernelGGL(fwd_kernel, dim3(grid), dim3(NTHREADS), LDS_BYTES, stream, p);
}
```

```cpp
#include <hip/hip_runtime.h>
#include <stdint.h>
#include <cstdio>

#define DEV __device__ __forceinline__

constexpr int DM = 1024;
constexpr int BP = 16, TP = 2048, BS = 32;
constexpr int NP = BP * TP;
constexpr int NR = NP + BS;
constexpr int MP = 32896;
constexpr int IN_DIM = 4896;
constexpr int C_U = 0, C_V = 512, C_O = 1024, C_I = 1536, C_F = 1540, C_Q = 1544, C_KC = 2056, C_KS = 2312, C_KW = 2568, C_G = 2824, C_GM = 2848, C_GN = 3872;
constexpr int PAST = 16384;
constexpr float NEGF = -1e30f;
constexpr float DN_ALPHA = 1.189207115002721f;
constexpr float LN_EPS = 1e-5f;
constexpr float LOG2E = 1.4426950408889634f;

constexpr size_t O_Y = 0;
constexpr size_t O_CMPP = (size_t)NR * DM;
constexpr size_t O_CMPS = O_CMPP + (size_t)NP * 256;
constexpr size_t O_SLCP = O_CMPS + (size_t)BS * 256;
constexpr size_t O_SLCS = O_SLCP + (size_t)NP * 256;
constexpr size_t O_WINP = O_SLCS + (size_t)BS * 256;
constexpr size_t O_WINS = O_WINP + (size_t)BP * 512 * 256;
constexpr size_t O_CP = O_WINS + (size_t)BS * 512 * 256;
constexpr size_t O_CS = O_CP + (size_t)BP * 4 * 128 * 128;
constexpr size_t O_NP = O_CS + (size_t)BS * 4 * 128 * 128;
constexpr size_t O_NS = O_NP + (size_t)BP * 4 * 128;
constexpr size_t O_MP = O_NS + (size_t)BS * 4 * 128;
constexpr size_t O_MS = O_MP + (size_t)BP * 4;
constexpr size_t O_CVP = O_MS + (size_t)BS * 4;
constexpr size_t O_CVS = O_CVP + (size_t)BP * 3 * 512;
constexpr size_t O_END = O_CVS + (size_t)BS * 3 * 512;
static_assert(O_END == 59916480, "output size");

constexpr size_t al256(size_t x) { return (x + 255) & ~(size_t)255; }
constexpr size_t WS_BAR = 0;
constexpr size_t WS_Z = 16384;
constexpr size_t WS_QK = al256(WS_Z + (size_t)MP * 32 * 4);
constexpr size_t WS_HRAW = al256(WS_QK + 256);
constexpr size_t WS_MOUTB = al256(WS_HRAW + (size_t)MP * 512 * 4);
constexpr size_t WS_NOUTB = al256(WS_MOUTB + (size_t)MP * 512 * 2);
constexpr size_t WS_HIDPB = al256(WS_NOUTB + (size_t)MP * 512 * 2);
constexpr size_t WS_KCP = al256(WS_HIDPB + (size_t)2 * 4096 * 64 * 2);
constexpr size_t WS_HIDSB = al256(WS_KCP + 256);
constexpr size_t WS_KCS = al256(WS_HIDSB + (size_t)2 * 65536 * 64 * 2);
constexpr size_t WS_MIX = al256(WS_KCS + (size_t)2 * 65536 * 64 * 4);
constexpr size_t WS_MIXB = al256(WS_MIX + (size_t)MP * 1024 * 4);
constexpr size_t WS_T1 = al256(WS_MIXB + (size_t)MP * 1024 * 2);
constexpr size_t WS_X1 = al256(WS_T1 + (size_t)MP * 1024 * 4);
constexpr size_t WS_X1B = al256(WS_X1 + (size_t)MP * 1024 * 4);
constexpr size_t WS_QPB = al256(WS_X1B + (size_t)MP * 1024 * 2);
constexpr size_t WS_S = al256(WS_QPB + (size_t)MP * 2048 * 2);
constexpr size_t WS_PIDX = al256(WS_S + (size_t)MP * 2048 * 4);
constexpr size_t WS_PG = al256(WS_PIDX + (size_t)MP * 128 * 4);
constexpr size_t WS_CONVB = al256(WS_PG + (size_t)MP * 128 * 4);
constexpr size_t WS_XB = al256(WS_CONVB + (size_t)MP * 512 * 2);
constexpr size_t WS_WIN_T = al256(WS_XB + (size_t)MP * 1024 * 2);
constexpr size_t WS_WUPM_T = al256(WS_WIN_T + (size_t)IN_DIM * 1024 * 2);
constexpr size_t WS_WUPN_T = al256(WS_WUPM_T + (size_t)1024 * 512 * 2);
constexpr size_t WS_WOUT_T = al256(WS_WUPN_T + (size_t)1024 * 512 * 2);
constexpr size_t WS_PWQ_T = al256(WS_WOUT_T + (size_t)1024 * 1024 * 2);
constexpr size_t WS_WQK_T = al256(WS_PWQ_T + (size_t)2048 * 1024 * 2);
constexpr size_t WS_W1_T = al256(WS_WQK_T + (size_t)4 * 256 * 128 * 2);
constexpr size_t WS_PESUM = al256(WS_W1_T + (size_t)2 * 128 * 1024 * 2);
constexpr size_t WS_W2_T = al256(WS_PESUM + 512);
constexpr size_t WS_SUBK = al256(WS_W2_T + (size_t)2 * 64 * 64 * 2);
constexpr size_t WS_ZB = al256(WS_SUBK + (size_t)2 * 128 * 128 * 2);
constexpr size_t WS_VTS = al256(WS_ZB + (size_t)MP * IN_DIM * 2);
constexpr size_t WS_VTW = al256(WS_VTS + (size_t)16 * 2 * 64 * 2048 * 2);
constexpr size_t WS_KCB = al256(WS_VTW + (size_t)16 * 2 * 64 * 2048 * 2);
constexpr size_t WS_VTC = al256(WS_KCB + (size_t)16 * 2 * 128 * 64 * 2);
constexpr size_t WS_NOUTF = al256(WS_VTC + (size_t)16 * 2 * 64 * 128 * 2);
constexpr size_t WS_U8 = al256(WS_NOUTF + (size_t)NP * 512 * 4);
constexpr size_t WS_V8 = al256(WS_U8 + (size_t)16384 * 1024);
constexpr size_t WS_QB = al256(WS_V8 + (size_t)16384 * 1024);
constexpr size_t WS_KB = al256(WS_QB + (size_t)MP * 512 * 2);
constexpr size_t WS_KTB = al256(WS_KB + (size_t)MP * 512 * 2);
constexpr size_t WS_VTM = al256(WS_KTB + (size_t)16 * 512 * 2048 * 2);
constexpr size_t WS_KCSB = al256(WS_VTM + (size_t)16 * 512 * 2048 * 2);
constexpr size_t WS_VTCS = al256(WS_KCSB + (size_t)32 * 2 * 1024 * 64 * 2);
constexpr size_t WS_END = al256(WS_VTCS + (size_t)32 * 2 * 64 * 1024 * 2);

static_assert(WS_END <= 2684354560ull, "workspace too large");
constexpr int LDS_BYTES = 73728;
constexpr int NTHREADS = 256;

struct Params {
    const float* x_prompt; const float* x_sample; const float* cache_cmp; const float* cache_slc; const int* page_table;
    const float* state_win; const float* state_C; const float* state_n; const float* state_m; const float* state_conv;
    const float* w_in; const float* conv_w; const float* conv_b; const float* wq; const float* wk; const float* gate_bias; const float* norm_g;
    const float* cmp_pe; const float* cmp_w1; const float* cmp_w2; const float* rel_bias; const float* w_up_m; const float* w_up_n; const float* w_out;
    const float* ln1_g; const float* ln1_b; const float* ln2_g; const float* ln2_b; const float* peer_wq; const float* peer_sub; const float* peer_u; const float* peer_v;
    float* out; unsigned char* ws;
};

#define XB_TMO      128
#define XB_XCNT(j)  (256  + 64 * (j))
#define XB_XSUB(j)  (1280 + 64 * (j))
#define XB_XGEN(j)  (2304 + 64 * (j))
#define XB_TOP      3328
#define XB_TOPGEN   3392
#define XCD_BAR_WORDS 3456
#define XB_SPIN_CAP (1u << 22)
#define LAS __attribute__((address_space(3)))

__device__ __forceinline__ unsigned xb_ld(unsigned* p)              { return __hip_atomic_load(p, __ATOMIC_RELAXED, __HIP_MEMORY_SCOPE_AGENT); }
__device__ __forceinline__ unsigned xb_add(unsigned* p, unsigned v) { return __hip_atomic_fetch_add(p, v, __ATOMIC_RELAXED, __HIP_MEMORY_SCOPE_AGENT); }
__device__ __forceinline__ unsigned xb_xcc_id() { return (unsigned)__builtin_amdgcn_s_getreg((3 << 11) | 20) & 0xFu; }
#define XB_SPIN(cond, bar) do { unsigned _sp = 0; while (cond) { __builtin_amdgcn_s_sleep(1); \
    if ((++_sp & 255u) == 0u) { if (xb_ld(&(bar)[XB_TMO])) break; if (_sp > XB_SPIN_CAP) { atomicAdd(&(bar)[XB_TMO], 1u); break; } } } } while (0)

struct XcdBarrier { unsigned* bar; unsigned x; volatile LAS unsigned* st; };

__device__ __forceinline__ XcdBarrier xcd_barrier_post(unsigned* bar, volatile LAS unsigned* st) {
    XcdBarrier b; b.bar = bar; b.x = xb_xcc_id(); b.st = st;
    if (threadIdx.x == 0) (void)xb_add(&bar[XB_XCNT(b.x)], 1u);
    return b;
}
__device__ __forceinline__ void xcd_barrier_complete(unsigned* bar, unsigned x, unsigned& nloc, unsigned& nx) {
    const unsigned G = gridDim.x * gridDim.y * gridDim.z;
    unsigned sum, cnt, mine, sp = 0u;
    for (;;) {
        sum = 0u; cnt = 0u; mine = 0u;
#pragma unroll
        for (unsigned j = 0; j < 16; ++j) { const unsigned c = xb_ld(&bar[XB_XCNT(j)]); sum += c; cnt += (c > 0u) ? 1u : 0u; mine = (j == x) ? c : mine; }
        if (sum == G) break;
        __builtin_amdgcn_s_sleep(1);
        if ((++sp & 255u) == 0u) { if (xb_ld(&bar[XB_TMO])) break; if (sp > XB_SPIN_CAP) { atomicAdd(&bar[XB_TMO], 1u); break; } }
    }
    nloc = mine > 0u ? mine : 1u; nx = cnt > 0u ? cnt : 1u;
}
__device__ __forceinline__ void xcd_barrier(const XcdBarrier& b) {
    asm volatile("s_waitcnt vmcnt(0)" ::: "memory");
    __syncthreads();
    if (threadIdx.x == 0) {
        unsigned* bar = b.bar;
        __builtin_amdgcn_s_waitcnt(0);
        unsigned nloc = b.st[0], nx = b.st[1];
        if (nloc == 0u) { xcd_barrier_complete(bar, b.x, nloc, nx); b.st[0] = nloc; b.st[1] = nx; }
        const unsigned old = xb_add(&bar[XB_XSUB(b.x)], 1u);
        const unsigned gen = old / nloc;
        if (old + 1u == (gen + 1u) * nloc) {
            __builtin_amdgcn_fence(__ATOMIC_RELEASE, "agent");
            asm volatile("s_waitcnt vmcnt(0)" ::: "memory");
            const unsigned og = xb_add(&bar[XB_TOP], 1u);
            const unsigned tg = og / nx;
            if (og + 1u == (tg + 1u) * nx) xb_add(&bar[XB_TOPGEN], 1u);
            else XB_SPIN(xb_ld(&bar[XB_TOPGEN]) == tg, bar);
            __builtin_amdgcn_fence(__ATOMIC_ACQUIRE, "agent");
            xb_add(&bar[XB_XGEN(b.x)], 1u);
            asm volatile("s_waitcnt vmcnt(0)" ::: "memory");
        } else {
            XB_SPIN(xb_ld(&bar[XB_XGEN(b.x)]) == gen, bar);
            __builtin_amdgcn_fence(__ATOMIC_ACQUIRE, "agent");
            asm volatile("s_waitcnt vmcnt(0)" ::: "memory");
        }
    }
    __syncthreads();
}

typedef float f32x4 __attribute__((ext_vector_type(4)));

__device__ const unsigned char REL_LUT[128] = {
    0, 1, 2, 3, 4, 5, 6, 7, 8, 9, 10, 11, 12, 13, 14, 15, 16, 16, 16, 17, 17, 18, 18, 18, 19, 19, 19, 20, 20, 20, 20, 21, 21, 21, 21, 22, 22, 22, 22, 22,
    23, 23, 23, 23, 23, 23, 24, 24, 24, 24, 24, 24, 25, 25, 25, 25, 25, 25, 25, 26, 26, 26, 26, 26, 26, 26, 26, 27, 27, 27, 27, 27, 27, 27, 27, 27, 27,
    28, 28, 28, 28, 28, 28, 28, 28, 28, 28, 29, 29, 29, 29, 29, 29, 29, 29, 29, 29, 29, 29, 30, 30, 30, 30, 30, 30, 30, 30, 30, 30, 30, 30, 30, 30,
    31, 31, 31, 31, 31, 31, 31, 31, 31, 31, 31, 31, 31, 31, 31};
DEV int rel_bucket(int n) { return n < 128 ? (int)REL_LUT[n < 0 ? 0 : n] : 31; }

DEV float sigmoidf_(float x) { return 1.0f / (1.0f + expf(-x)); }
DEV float gelu_tanh(float x) { return 0.5f * x * (1.0f + tanhf(0.7978845608028654f * (x + 0.044715f * x * x * x))); }
DEV float log_sigmoid(float x) { return x >= 0.f ? -log1pf(expf(-x)) : x - log1pf(expf(x)); }
DEV void wave_sync() { asm volatile("s_waitcnt lgkmcnt(0)" ::: "memory"); __builtin_amdgcn_wave_barrier(); asm volatile("" ::: "memory"); }
DEV float wave_sum(float v) {
#pragma unroll
    for (int o = 32; o >= 1; o >>= 1) v += __shfl_xor(v, o);
    return v;
}
DEV float wave_max(float v) {
#pragma unroll
    for (int o = 32; o >= 1; o >>= 1) v = fmaxf(v, __shfl_xor(v, o));
    return v;
}

typedef unsigned short bf16_t;
typedef short bf16x8 __attribute__((ext_vector_type(8)));
typedef float f32x2_ __attribute__((ext_vector_type(2)));
typedef __bf16 bf16x2_ __attribute__((ext_vector_type(2)));
DEV unsigned cvt_pk_bf16(float lo, float hi) { const f32x2_ v = {lo, hi}; return __builtin_bit_cast(unsigned, __builtin_convertvector(v, bf16x2_)); }
DEV float bf_lo(unsigned w) { return __uint_as_float(w << 16); }
DEV float bf_hi(unsigned w) { return __uint_as_float(w & 0xffff0000u); }
DEV uint4 pack8(const float* f) { uint4 r; r.x = cvt_pk_bf16(f[0], f[1]); r.y = cvt_pk_bf16(f[2], f[3]); r.z = cvt_pk_bf16(f[4], f[5]); r.w = cvt_pk_bf16(f[6], f[7]); return r; }
DEV void store_bf16x4(bf16_t* p, f32x4 v) { uint2 w; w.x = cvt_pk_bf16(v[0], v[1]); w.y = cvt_pk_bf16(v[2], v[3]); *(uint2*)p = w; }

DEV void transpose_to_bf16(const float* __restrict__ src, const int K, const int N, bf16_t* __restrict__ dst, const size_t gt, const size_t nt) {
    const size_t items = (size_t)N * (K >> 3);
    for (size_t id = gt; id < items; id += nt) {
        const int n = (int)(id % N), k8 = (int)(id / N) * 8;
        float f[8];
#pragma unroll
        for (int i = 0; i < 8; ++i) f[i] = src[(size_t)(k8 + i) * N + n];
        *(uint4*)(dst + (size_t)n * K + k8) = pack8(f);
    }
}

template <int BN, bool TILE_EPI = false, class LA, class LB, class EF>
DEV void gemm_bf16(const int M, const int N, const int K, LA la, LB lb, EF ef, unsigned char* lds, const int toff = 0) {
    constexpr int TJ = BN / 32;
    constexpr int NB = BN / 32;
    constexpr int LDR = 144;
    const int tid = threadIdx.x, lane = tid & 63, w = tid >> 6, wm = w >> 1, wn = w & 1;
    const int tm = (M + 127) >> 7, tn = (N + BN - 1) / BN;
    unsigned char* As = lds;
    unsigned char* Bs = lds + 128 * LDR;
    const int lr = lane & 15, lq = lane >> 4;
    for (int tile = (int)((blockIdx.x + gridDim.x - (unsigned)toff % gridDim.x) % gridDim.x); tile < tm * tn; tile += gridDim.x) {
        const int bm = (tile / tn) * 128, bn = (tile % tn) * BN;
        f32x4 acc[4][TJ];
#pragma unroll
        for (int i = 0; i < 4; ++i)
#pragma unroll
            for (int j = 0; j < TJ; ++j) acc[i][j] = (f32x4){0.f, 0.f, 0.f, 0.f};
        uint4 ra[4], rb[NB];
        int arow[4], brow[NB];
#pragma unroll
        for (int i = 0; i < 4; ++i) { const int r = bm + ((tid + 256 * i) >> 3); arow[i] = r < M ? r : M - 1; }
#pragma unroll
        for (int i = 0; i < NB; ++i) { const int n = bn + ((tid + 256 * i) >> 3); brow[i] = n < N ? n : N - 1; }
        const int kc = (tid & 7) * 8;
#pragma unroll
        for (int i = 0; i < 4; ++i) ra[i] = la(arow[i], kc);
#pragma unroll
        for (int i = 0; i < NB; ++i) rb[i] = lb(brow[i], kc);
        for (int k0_ = 0; k0_ < K; k0_ += 64) {
            int k0 = k0_; asm volatile("" : "+v"(k0));
            __syncthreads();
#pragma unroll
            for (int i = 0; i < 4; ++i) *(uint4*)(As + ((tid + 256 * i) >> 3) * LDR + (tid & 7) * 16) = ra[i];
#pragma unroll
            for (int i = 0; i < NB; ++i) *(uint4*)(Bs + ((tid + 256 * i) >> 3) * LDR + (tid & 7) * 16) = rb[i];
            __syncthreads();
            if (k0_ + 64 < K) {
#pragma unroll
                for (int i = 0; i < 4; ++i) ra[i] = la(arow[i], k0 + 64 + kc);
#pragma unroll
                for (int i = 0; i < NB; ++i) rb[i] = lb(brow[i], k0 + 64 + kc);
            }
#pragma unroll
            for (int kk = 0; kk < 2; ++kk) {
                bf16x8 a[4], b[TJ];
#pragma unroll
                for (int i = 0; i < 4; ++i) a[i] = *(const bf16x8*)(As + (wm * 64 + i * 16 + lr) * LDR + kk * 64 + lq * 16);
#pragma unroll
                for (int j = 0; j < TJ; ++j) b[j] = *(const bf16x8*)(Bs + (wn * (BN / 2) + j * 16 + lr) * LDR + kk * 64 + lq * 16);
#pragma unroll
                for (int i = 0; i < 4; ++i)
#pragma unroll
                    for (int j = 0; j < TJ; ++j) acc[i][j] = __builtin_amdgcn_mfma_f32_16x16x32_bf16(b[j], a[i], acc[i][j], 0, 0, 0);
            }
        }
        if constexpr (TILE_EPI) { ef(acc, bm); }
        else {
#pragma unroll
            for (int i = 0; i < 4; ++i)
#pragma unroll
                for (int j = 0; j < TJ; ++j) {
                    const int r = bm + wm * 64 + i * 16 + lr, c0 = bn + wn * (BN / 2) + j * 16 + lq * 4;
                    if (r < M && c0 < N) ef(r, c0, acc[i][j]);
                }
        }
    }
}

DEV void mlstm_scan_item(const Params& p, const int item, float* lds) {
    const int tid = threadIdx.x, v = tid >> 1, kh = tid & 1;
    const int seq = item >> 2, h = item & 3;
    const bool pr = seq < 16; const int b = pr ? seq : seq - 16;
    const int T = pr ? 2048 : 1; const int row0 = pr ? b * 2048 : NP + b;
    const float* Z = (const float*)(p.ws + WS_Z);
    const bf16_t* QBp = (const bf16_t*)(p.ws + WS_QB); const bf16_t* KBp = (const bf16_t*)(p.ws + WS_KB); const bf16_t* ZBp = (const bf16_t*)(p.ws + WS_ZB);
    float* HRAW = (float*)(p.ws + WS_HRAW);
    float C[64], n[64]; float m;
    if (pr) {
#pragma unroll
        for (int j = 0; j < 64; ++j) { C[j] = 0.f; n[j] = 0.f; }
        m = 0.f;
    } else {
        const float* c0 = p.state_C + (((size_t)(b * 4 + h) * 128 + v) * 128 + kh * 64);
        const float* n0 = p.state_n + ((size_t)(b * 4 + h) * 128 + kh * 64);
#pragma unroll
        for (int j = 0; j < 64; ++j) { C[j] = c0[j]; n[j] = n0[j]; }
        m = p.state_m[b * 4 + h];
    }
    const float gb_i = p.gate_bias[h], gb_f = p.gate_bias[4 + h];
    auto load_tok = [&](int t, float* dst) {
        const size_t r = (size_t)(row0 + t);
        dst[tid] = bf_lo((unsigned)(tid < 128 ? QBp[r * 512 + h * 128 + tid] : KBp[r * 512 + h * 128 + tid - 128]));
        if (tid < 128) dst[256 + tid] = bf_lo((unsigned)ZBp[r * IN_DIM + C_V + h * 128 + tid]);
        if (tid == 128) dst[384] = Z[r * 32 + h] + gb_i;
        if (tid == 129) dst[385] = log_sigmoid(Z[r * 32 + 4 + h] + gb_f);
    };
    __syncthreads();
    load_tok(0, lds);
    __syncthreads();
    for (int t = 0; t < T; ++t) {
        const float* cur = lds + (t & 1) * 388;
        if (t + 1 < T) load_tok(t + 1, lds + ((t + 1) & 1) * 388);
        const float ig = cur[384], lf = cur[385];
        const float mn = fmaxf(lf + m, ig);
        const float fd = expf(lf + m - mn), iw = expf(ig - mn);
        const float vv = cur[256 + v] * iw;
        float nump = 0.f, denp = 0.f;
#pragma unroll
        for (int j = 0; j < 64; ++j) {
            const float kj = cur[128 + kh * 64 + j], qj = cur[kh * 64 + j];
            C[j] = fd * C[j] + vv * kj; n[j] = fd * n[j] + iw * kj;
            nump += C[j] * qj; denp += n[j] * qj;
        }
        nump += __shfl_xor(nump, 1); denp += __shfl_xor(denp, 1);
        const float hval = nump / fmaxf(fabsf(denp), expf(-mn));
        if (kh == 0) HRAW[(size_t)(row0 + t) * 512 + h * 128 + v] = hval;
        m = mn;
        __syncthreads();
    }
    float* co = p.out + (pr ? O_CP : O_CS) + (((size_t)(b * 4 + h) * 128 + v) * 128 + kh * 64);
#pragma unroll
    for (int j = 0; j < 64; ++j) co[j] = C[j];
    if (v == 0) {
        float* no = p.out + (pr ? O_NP : O_NS) + ((size_t)(b * 4 + h) * 128 + kh * 64);
#pragma unroll
        for (int j = 0; j < 64; ++j) no[j] = n[j];
    }
    if (tid == 0) p.out[(pr ? O_MP : O_MS) + b * 4 + h] = m;
}

DEV void peer_topk_item(const Params& p, const int row, const int h, const int lane) {
    const float* S = (const float*)(p.ws + WS_S) + (size_t)row * 2048 + h * 256;
    int* PIDX = (int*)(p.ws + WS_PIDX); float* PG = (float*)(p.ws + WS_PG);
    float ts[2]; int ti[2];
#pragma unroll
    for (int pp = 0; pp < 2; ++pp) {
        float v0 = S[pp * 128 + lane], v1 = S[pp * 128 + 64 + lane];
        float mys = 0.f; int myi = 0;
        for (int r = 0; r < 16; ++r) {
            float best = fmaxf(v0, v1); int bi = (v0 >= v1) ? lane : lane + 64;
#pragma unroll
            for (int off = 32; off >= 1; off >>= 1) {
                const float ob = __shfl_xor(best, off); const int oi = __shfl_xor(bi, off);
                if (ob > best || (ob == best && oi < bi)) { best = ob; bi = oi; }
            }
            if (lane == r) { mys = best; myi = bi; }
            if (bi == lane) v0 = -INFINITY;
            if (bi == lane + 64) v1 = -INFINITY;
        }
        ts[pp] = mys; ti[pp] = myi;
    }
    float cv[4];
#pragma unroll
    for (int jj = 0; jj < 4; ++jj) { const int c = lane * 4 + jj; cv[jj] = __shfl(ts[0], c >> 4) + __shfl(ts[1], c & 15); }
    float msc = 0.f; int mci = 0;
    for (int r = 0; r < 16; ++r) {
        float best = cv[0]; int bi = lane * 4;
#pragma unroll
        for (int jj = 1; jj < 4; ++jj) if (cv[jj] > best) { best = cv[jj]; bi = lane * 4 + jj; }
#pragma unroll
        for (int off = 32; off >= 1; off >>= 1) {
            const float ob = __shfl_xor(best, off); const int oi = __shfl_xor(bi, off);
            if (ob > best || (ob == best && oi < bi)) { best = ob; bi = oi; }
        }
        if (lane == r) { msc = best; mci = bi; }
#pragma unroll
        for (int jj = 0; jj < 4; ++jj) if (bi == lane * 4 + jj) cv[jj] = -INFINITY;
    }
    const int e = __shfl(ti[0], mci >> 4) * 128 + __shfl(ti[1], mci & 15);
    const float top = __shfl(msc, 0);
    float ex = (lane < 16) ? expf(msc - top) : 0.f;
    const float den = wave_sum(ex);
    if (lane < 16) { PIDX[(size_t)row * 128 + h * 16 + lane] = e; PG[(size_t)row * 128 + h * 16 + lane] = ex / den; }
}

DEV void peer_expert_item(const Params& p, const int row, float* lds) {
    const int tid = threadIdx.x, lane = tid & 63, w = tid >> 6;
    const float* X1 = (const float*)(p.ws + WS_X1) + (size_t)row * 1024;
    const int* PIDX = (const int*)(p.ws + WS_PIDX) + (size_t)row * 128;
    const float* PG = (const float*)(p.ws + WS_PG) + (size_t)row * 128;
    float4 x[4], acc[4];
#pragma unroll
    for (int j = 0; j < 4; ++j) { x[j] = *(const float4*)(X1 + j * 256 + lane * 4); acc[j] = make_float4(0.f, 0.f, 0.f, 0.f); }
    for (int k = 0; k < 32; ++k) {
        const int e = PIDX[w * 32 + k]; const float gk = PG[w * 32 + k];
        const float* ur = p.peer_u + (size_t)e * 1024; const float* vr = p.peer_v + (size_t)e * 1024;
        float d = 0.f;
#pragma unroll
        for (int j = 0; j < 4; ++j) { const float4 u = *(const float4*)(ur + j * 256 + lane * 4); d += u.x * x[j].x + u.y * x[j].y + u.z * x[j].z + u.w * x[j].w; }
        d = wave_sum(d);
        const float coef = gk * gelu_tanh(d);
#pragma unroll
        for (int j = 0; j < 4; ++j) { const float4 vv = *(const float4*)(vr + j * 256 + lane * 4);
            acc[j].x += coef * vv.x; acc[j].y += coef * vv.y; acc[j].z += coef * vv.z; acc[j].w += coef * vv.w; }
    }
    __syncthreads();
#pragma unroll
    for (int j = 0; j < 4; ++j) *(float4*)(lds + w * 1024 + j * 256 + lane * 4) = acc[j];
    __syncthreads();
    float tv[4]; float s = 0.f;
#pragma unroll
    for (int i = 0; i < 4; ++i) { const int c = tid * 4 + i; const float po = (lds[c] + lds[1024 + c]) + (lds[2048 + c] + lds[3072 + c]); tv[i] = DN_ALPHA * X1[c] + po; s += tv[i]; }
    float* red = lds + 4096;
    s = wave_sum(s);
    if (lane == 0) red[w] = s;
    __syncthreads();
    const float mu = (red[0] + red[1] + red[2] + red[3]) * (1.0f / 1024.0f);
    float q = 0.f;
#pragma unroll
    for (int i = 0; i < 4; ++i) { const float d = tv[i] - mu; q += d * d; }
    q = wave_sum(q);
    if (lane == 0) red[8 + w] = q;
    __syncthreads();
    const float var = (red[8] + red[9] + red[10] + red[11]) * (1.0f / 1024.0f);
    const float rstd = 1.0f / sqrtf(var + LN_EPS);
    float* y = p.out + O_Y + (size_t)row * 1024;
#pragma unroll
    for (int i = 0; i < 4; ++i) { const int c = tid * 4 + i; y[c] = (tv[i] - mu) * rstd * p.ln2_g[c] + p.ln2_b[c]; }
}

DEV void mlstm_chunk_item(const Params& p, const int item, unsigned char* lds) {
    int tid_ = threadIdx.x; asm volatile("" : "+v"(tid_));
    const int tid = tid_, lane = tid & 63, w = tid >> 6, lr = lane & 15, lq = lane >> 4;
    const int b = item >> 4, h = (item >> 2) & 3, vs = item & 3;
    bf16_t* Cl = (bf16_t*)lds;
    bf16_t* nl = (bf16_t*)(lds + 8704);
    float* uL = (float*)(lds + 8960); float* ML = uL + 64; float* scin = uL + 128; float* expm = uL + 192; float* wts = uL + 256; float* misc = uL + 320;
    const bf16_t* QB = (const bf16_t*)(p.ws + WS_QB) + (size_t)(b * 2048) * 512 + h * 128;
    const bf16_t* KB = (const bf16_t*)(p.ws + WS_KB) + (size_t)(b * 2048) * 512 + h * 128;
    const bf16_t* KTB = (const bf16_t*)(p.ws + WS_KTB) + (size_t)((b * 4 + h) * 128) * 2048;
    const bf16_t* VTM = (const bf16_t*)(p.ws + WS_VTM) + (size_t)(b * 512 + h * 128 + vs * 32) * 2048;
    const float* Z = (const float*)(p.ws + WS_Z);
    float* HRAW = (float*)(p.ws + WS_HRAW);
    const float gb_i = p.gate_bias[h], gb_f = p.gate_bias[4 + h];
    f32x4 Cm[2][2], nm[2];
#pragma unroll
    for (int i = 0; i < 2; ++i) { nm[i] = (f32x4){0.f, 0.f, 0.f, 0.f};
#pragma unroll
        for (int j = 0; j < 2; ++j) Cm[i][j] = (f32x4){0.f, 0.f, 0.f, 0.f}; }
    float m_prev = 0.f;
    __syncthreads();
    for (int i = tid; i < (8704 + 256) / 4; i += 256) ((unsigned*)lds)[i] = 0u;
    __syncthreads();
    for (int c = 0; c < 32; ++c) {
        const int t0 = c * 64;
        if (w == 0) {
            const size_t row = (size_t)(b * 2048 + t0 + lane);
            const float ig = Z[row * 32 + h] + gb_i;
            const float lf = log_sigmoid(Z[row * 32 + 4 + h] + gb_f);
            float bc = lf;
#pragma unroll
            for (int o = 1; o < 64; o <<= 1) { const float t = __shfl_up(bc, o); if (lane >= o) bc += t; }
            const float u = ig - bc;
            float pm = u;
#pragma unroll
            for (int o = 1; o < 64; o <<= 1) { const float t = __shfl_up(pm, o); if (lane >= o) pm = fmaxf(pm, t); }
            const float M = fmaxf(m_prev, pm);
            const float M63 = __shfl(M, 63), b63 = __shfl(bc, 63);
            uL[lane] = u; ML[lane] = M; scin[lane] = expf(m_prev - M); expm[lane] = expf(-(bc + M)); wts[lane] = expf(u - M63);
            if (lane == 0) { misc[0] = expf(m_prev - M63); misc[1] = b63 + M63; }
        }
        __syncthreads();
        {
            const size_t row_t = (size_t)(t0 + w * 16 + lr);
            bf16x8 Qf[4];
#pragma unroll
            for (int ks = 0; ks < 4; ++ks) Qf[ks] = *(const bf16x8*)(QB + row_t * 512 + ks * 32 + lq * 8);
            const float M_t = ML[w * 16 + lr], sc_in = scin[w * 16 + lr], em = expm[w * 16 + lr];
            f32x4 sw[4];
            float dsum = 0.f;
#pragma unroll
            for (int st = 0; st < 4; ++st) {
                f32x4 a = (f32x4){0.f, 0.f, 0.f, 0.f};
                if (st <= w) {
#pragma unroll
                    for (int ks = 0; ks < 4; ++ks) { const bf16x8 kf = *(const bf16x8*)(KB + (size_t)(t0 + st * 16 + lr) * 512 + ks * 32 + lq * 8); a = __builtin_amdgcn_mfma_f32_16x16x32_bf16(kf, Qf[ks], a, 0, 0, 0); }
#pragma unroll
                    for (int g = 0; g < 4; ++g) {
                        const int sl = st * 16 + lq * 4 + g, tl = w * 16 + lr;
                        const float wg = (sl <= tl) ? __builtin_amdgcn_exp2f((uL[sl] - M_t) * LOG2E) : 0.f;
                        a[g] *= wg; dsum += a[g];
                    }
                }
                sw[st] = a;
            }
            dsum += __shfl_xor(dsum, 16); dsum += __shfl_xor(dsum, 32);
            bf16x8 pf[2];
#pragma unroll
            for (int ks = 0; ks < 2; ++ks) {
                union { bf16x8 v; unsigned u[4]; } pk;
                pk.u[0] = cvt_pk_bf16(sw[2 * ks][0], sw[2 * ks][1]); pk.u[1] = cvt_pk_bf16(sw[2 * ks][2], sw[2 * ks][3]);
                pk.u[2] = cvt_pk_bf16(sw[2 * ks + 1][0], sw[2 * ks + 1][1]); pk.u[3] = cvt_pk_bf16(sw[2 * ks + 1][2], sw[2 * ks + 1][3]);
                pf[ks] = pk.v;
            }
            f32x4 dI = (f32x4){0.f, 0.f, 0.f, 0.f};
#pragma unroll
            for (int ks = 0; ks < 4; ++ks) { const bf16x8 nf = *(const bf16x8*)(nl + ks * 32 + lq * 8); dI = __builtin_amdgcn_mfma_f32_16x16x32_bf16(nf, Qf[ks], dI, 0, 0, 0); }
            const float den = sc_in * dI[0] + dsum;
            const float rdd = 1.0f / fmaxf(fabsf(den), em);
#pragma unroll
            for (int vt = 0; vt < 2; ++vt) {
                f32x4 ni = (f32x4){0.f, 0.f, 0.f, 0.f}, nI = (f32x4){0.f, 0.f, 0.f, 0.f};
#pragma unroll
                for (int ks = 0; ks < 2; ++ks) if (2 * ks <= w) {
                    union { bf16x8 v; uint2 hh[2]; } vf;
                    const bf16_t* vp = VTM + (size_t)(vt * 16 + lr) * 2048 + t0 + 32 * ks + lq * 4;
                    vf.hh[0] = *(const uint2*)vp; vf.hh[1] = *(const uint2*)(vp + 16);
                    ni = __builtin_amdgcn_mfma_f32_16x16x32_bf16(vf.v, pf[ks], ni, 0, 0, 0);
                }
#pragma unroll
                for (int ks = 0; ks < 4; ++ks) { const bf16x8 cf = *(const bf16x8*)(Cl + (vt * 16 + lr) * 136 + ks * 32 + lq * 8); nI = __builtin_amdgcn_mfma_f32_16x16x32_bf16(cf, Qf[ks], nI, 0, 0, 0); }
                const f32x4 hv = (nI * sc_in + ni) * rdd;
                *(f32x4*)(HRAW + ((size_t)(b * 2048) + row_t) * 512 + h * 128 + vs * 32 + vt * 16 + lq * 4) = hv;
            }
        }
        __syncthreads();
        {
            const float decay = misc[0];
            bf16x8 Af[2][2], Wf[2], Kt[2][2];
#pragma unroll
            for (int ks = 0; ks < 2; ++ks) {
                const float4 w0 = *(const float4*)(wts + ks * 32 + lq * 8), w1 = *(const float4*)(wts + ks * 32 + lq * 8 + 4);
                float wv[8] = {w0.x, w0.y, w0.z, w0.w, w1.x, w1.y, w1.z, w1.w};
                { union { bf16x8 v; uint4 q; } t; t.q = pack8(wv); Wf[ks] = t.v; }
#pragma unroll
                for (int vt = 0; vt < 2; ++vt) {
                    const uint4 raw = *(const uint4*)(VTM + (size_t)(vt * 16 + lr) * 2048 + t0 + ks * 32 + lq * 8);
                    float f[8] = {bf_lo(raw.x) * wv[0], bf_hi(raw.x) * wv[1], bf_lo(raw.y) * wv[2], bf_hi(raw.y) * wv[3], bf_lo(raw.z) * wv[4], bf_hi(raw.z) * wv[5], bf_lo(raw.w) * wv[6], bf_hi(raw.w) * wv[7]};
                    union { bf16x8 v; uint4 q; } t; t.q = pack8(f); Af[vt][ks] = t.v;
                }
#pragma unroll
                for (int kt = 0; kt < 2; ++kt) Kt[kt][ks] = *(const bf16x8*)(KTB + (size_t)((2 * w + kt) * 16 + lr) * 2048 + t0 + ks * 32 + lq * 8);
            }
#pragma unroll
            for (int kt = 0; kt < 2; ++kt) {
                nm[kt] = nm[kt] * decay;
#pragma unroll
                for (int ks = 0; ks < 2; ++ks) nm[kt] = __builtin_amdgcn_mfma_f32_16x16x32_bf16(Wf[ks], Kt[kt][ks], nm[kt], 0, 0, 0);
                if (lq == 0) nl[(2 * w + kt) * 16 + lr] = (bf16_t)(cvt_pk_bf16(nm[kt][0], 0.f) & 0xffffu);
#pragma unroll
                for (int vt = 0; vt < 2; ++vt) {
                    Cm[vt][kt] = Cm[vt][kt] * decay;
#pragma unroll
                    for (int ks = 0; ks < 2; ++ks) Cm[vt][kt] = __builtin_amdgcn_mfma_f32_16x16x32_bf16(Af[vt][ks], Kt[kt][ks], Cm[vt][kt], 0, 0, 0);
                    const unsigned c01 = cvt_pk_bf16(Cm[vt][kt][0], Cm[vt][kt][1]), c23 = cvt_pk_bf16(Cm[vt][kt][2], Cm[vt][kt][3]);
                    bf16_t* cp = Cl + (vt * 16 + lq * 4) * 136 + (2 * w + kt) * 16 + lr;
                    cp[0] = (bf16_t)(c01 & 0xffffu); cp[136] = (bf16_t)(c01 >> 16); cp[272] = (bf16_t)(c23 & 0xffffu); cp[408] = (bf16_t)(c23 >> 16);
                }
            }
            m_prev = misc[1];
        }
        __syncthreads();
    }
#pragma unroll
    for (int vt = 0; vt < 2; ++vt)
#pragma unroll
        for (int kt = 0; kt < 2; ++kt)
#pragma unroll
            for (int g = 0; g < 4; ++g)
                p.out[O_CP + ((size_t)((b * 4 + h) * 128) + vs * 32 + vt * 16 + lq * 4 + g) * 128 + (2 * w + kt) * 16 + lr] = Cm[vt][kt][g];
    if (vs == 0) {
        if (lq == 0) { p.out[O_NP + (size_t)(b * 4 + h) * 128 + (2 * w) * 16 + lr] = nm[0][0]; p.out[O_NP + (size_t)(b * 4 + h) * 128 + (2 * w + 1) * 16 + lr] = nm[1][0]; }
        if (tid == 0) p.out[O_MP + b * 4 + h] = m_prev;
    }
}

DEV unsigned dpp_max16(unsigned x) {
    x = max(x, (unsigned)__builtin_amdgcn_update_dpp(0, (int)x, 0xB1, 0xF, 0xF, false));
    x = max(x, (unsigned)__builtin_amdgcn_update_dpp(0, (int)x, 0x4E, 0xF, 0xF, false));
    x = max(x, (unsigned)__builtin_amdgcn_update_dpp(0, (int)x, 0x141, 0xF, 0xF, false));
    x = max(x, (unsigned)__builtin_amdgcn_update_dpp(0, (int)x, 0x140, 0xF, 0xF, false));
    return x;
}
DEV float dpp_sum16(float x) {
    x += __builtin_bit_cast(float, __builtin_amdgcn_update_dpp(0, __builtin_bit_cast(int, x), 0xB1, 0xF, 0xF, false));
    x += __builtin_bit_cast(float, __builtin_amdgcn_update_dpp(0, __builtin_bit_cast(int, x), 0x4E, 0xF, 0xF, false));
    x += __builtin_bit_cast(float, __builtin_amdgcn_update_dpp(0, __builtin_bit_cast(int, x), 0x141, 0xF, 0xF, false));
    x += __builtin_bit_cast(float, __builtin_amdgcn_update_dpp(0, __builtin_bit_cast(int, x), 0x140, 0xF, 0xF, false));
    return x;
}
DEV unsigned mono_key(float v) { const unsigned b = __float_as_uint(v); return (b & 0x80000000u) ? ~b : (b | 0x80000000u); }
#define CE_DESC(a, b) { const unsigned hi_ = max(a, b), lo_ = min(a, b); a = hi_; b = lo_; }

DEV void peer_score_topk_item(const Params& p, const int tile, const int h, unsigned char* lds) {
    int tid_ = threadIdx.x; asm volatile("" : "+v"(tid_));
    const int tid = tid_, lane = tid & 63, w = tid >> 6, lr = lane & 15, lq = lane >> 4;
    float* sc = (float*)(lds + w * 12416);
    float* ts = sc + 16 * 129;
    int* ti = (int*)(ts + 512);
    const bf16_t* QPB = (const bf16_t*)(p.ws + WS_QPB);
    const bf16_t* SUBK = (const bf16_t*)(p.ws + WS_SUBK);
    int* PIDX = (int*)(p.ws + WS_PIDX); float* PG = (float*)(p.ws + WS_PG);
    const int row0 = tile * 64 + w * 16;
    const int arow = (row0 + lr < NR) ? row0 + lr : NR - 1;
    wave_sync();
#pragma unroll 1
    for (int pp = 0; pp < 2; ++pp) {
        bf16x8 qf[4];
#pragma unroll
        for (int ks = 0; ks < 4; ++ks) qf[ks] = *(const bf16x8*)(QPB + (size_t)arow * 2048 + h * 256 + pp * 128 + ks * 32 + lq * 8);
#pragma unroll
        for (int j = 0; j < 8; ++j) {
            f32x4 a = (f32x4){0.f, 0.f, 0.f, 0.f};
#pragma unroll
            for (int ks = 0; ks < 4; ++ks) { const bf16x8 kf = *(const bf16x8*)(SUBK + ((size_t)pp * 128 + j * 16 + lr) * 128 + ks * 32 + lq * 8); a = __builtin_amdgcn_mfma_f32_16x16x32_bf16(qf[ks], kf, a, 0, 0, 0); }
#pragma unroll
            for (int g = 0; g < 4; ++g) sc[(lq * 4 + g) * 129 + j * 16 + lr] = a[g];
        }
        wave_sync();
#pragma unroll 1
        for (int rr = 0; rr < 4; ++rr) {
            const int row = rr * 4 + lq;
            unsigned k0, k1, k2, k3, k4, k5, k6, k7;
            { const float* sr = sc + row * 129 + lr;
              k0 = (mono_key(sr[0]) & ~0x7Fu) | (unsigned)(127 - lr);        k1 = (mono_key(sr[16]) & ~0x7Fu) | (unsigned)(127 - 16 - lr);
              k2 = (mono_key(sr[32]) & ~0x7Fu) | (unsigned)(127 - 32 - lr);  k3 = (mono_key(sr[48]) & ~0x7Fu) | (unsigned)(127 - 48 - lr);
              k4 = (mono_key(sr[64]) & ~0x7Fu) | (unsigned)(127 - 64 - lr);  k5 = (mono_key(sr[80]) & ~0x7Fu) | (unsigned)(127 - 80 - lr);
              k6 = (mono_key(sr[96]) & ~0x7Fu) | (unsigned)(127 - 96 - lr);  k7 = (mono_key(sr[112]) & ~0x7Fu) | (unsigned)(127 - 112 - lr); }
            CE_DESC(k0, k1) CE_DESC(k2, k3) CE_DESC(k4, k5) CE_DESC(k6, k7)
            CE_DESC(k0, k2) CE_DESC(k1, k3) CE_DESC(k4, k6) CE_DESC(k5, k7)
            CE_DESC(k1, k2) CE_DESC(k5, k6)
            CE_DESC(k0, k4) CE_DESC(k1, k5) CE_DESC(k2, k6) CE_DESC(k3, k7)
            CE_DESC(k2, k4) CE_DESC(k3, k5)
            CE_DESC(k1, k2) CE_DESC(k3, k4) CE_DESC(k5, k6)
            unsigned mine = 0u;
#pragma unroll
            for (int r = 0; r < 16; ++r) {
                const unsigned best = dpp_max16(k0);
                if (lr == r) mine = best;
                const bool own = (k0 == best);
                k0 = own ? k1 : k0; k1 = own ? k2 : k1; k2 = own ? k3 : k2; k3 = own ? k4 : k3; k4 = own ? k5 : k4; k5 = own ? k6 : k5; k6 = own ? k7 : k6; k7 = own ? 0u : k7;
            }
            const int idx = 127 - (int)(mine & 0x7Fu);
            ts[(pp * 16 + row) * 16 + lr] = sc[row * 129 + idx];
            ti[(pp * 16 + row) * 16 + lr] = idx;
        }
        wave_sync();
    }
#pragma unroll 1
    for (int rr = 0; rr < 4; ++rr) {
        const int row = rr * 4 + lq;
        const float s1a = ts[row * 16 + lr];
        const float* s2 = ts + (16 + row) * 16;
        int ptr = 0;
        unsigned key = (mono_key(s1a + s2[0]) & ~0xFFu) | (unsigned)(255 - lr * 16);
        unsigned mine = 0u;
#pragma unroll
        for (int r = 0; r < 16; ++r) {
            const unsigned best = dpp_max16(key);
            if (lr == r) mine = best;
            if (key == best) { ++ptr; key = (ptr < 16) ? ((mono_key(s1a + s2[ptr & 15]) & ~0xFFu) | (unsigned)(255 - lr * 16 - ptr)) : 0u; }
        }
        const int ci = 255 - (int)(mine & 0xFFu), a = ci >> 4, bb = ci & 15;
        const float scv = ts[row * 16 + a] + s2[bb];
        const int e = ti[row * 16 + a] * 128 + ti[(16 + row) * 16 + bb];
        float m16 = scv;
        m16 = fmaxf(m16, __builtin_bit_cast(float, __builtin_amdgcn_update_dpp(0, __builtin_bit_cast(int, m16), 0xB1, 0xF, 0xF, false)));
        m16 = fmaxf(m16, __builtin_bit_cast(float, __builtin_amdgcn_update_dpp(0, __builtin_bit_cast(int, m16), 0x4E, 0xF, 0xF, false)));
        m16 = fmaxf(m16, __builtin_bit_cast(float, __builtin_amdgcn_update_dpp(0, __builtin_bit_cast(int, m16), 0x141, 0xF, 0xF, false)));
        m16 = fmaxf(m16, __builtin_bit_cast(float, __builtin_amdgcn_update_dpp(0, __builtin_bit_cast(int, m16), 0x140, 0xF, 0xF, false)));
        const float ex = expf(scv - m16);
        const float den = dpp_sum16(ex);
        const int grow = row0 + row;
        if (grow < NR) { PIDX[(size_t)grow * 128 + h * 16 + lr] = e; PG[(size_t)grow * 128 + h * 16 + lr] = ex / den; }
    }
}

constexpr float PEER_U_SCALE = 64.0f, PEER_V_SCALE = 8.0f;
DEV unsigned pack4_fp8(float a, float b, float c, float d) { int w = 0; w = __builtin_amdgcn_cvt_pk_fp8_f32(a, b, w, false); w = __builtin_amdgcn_cvt_pk_fp8_f32(c, d, w, true); return (unsigned)w; }
DEV void peer_expert_wave(const Params& p, const int row, unsigned char* wl, const int lane_in) {
    int lane = lane_in; asm volatile("" : "+v"(lane));
    const int lr = lane & 15, lq = lane >> 4;
    unsigned char* xh = wl;
    unsigned char* xo = wl + 1024;
    float* coefl = (float*)(wl + 2048);
    int* idxl = (int*)(wl + 2048 + 512);
    const float* X1 = (const float*)(p.ws + WS_X1) + (size_t)row * 1024;
    const int* PIDX = (const int*)(p.ws + WS_PIDX) + (size_t)row * 128;
    const float* PG = (const float*)(p.ws + WS_PG) + (size_t)row * 128;
    const unsigned char* U8 = p.ws + WS_U8;
    const unsigned char* V8 = p.ws + WS_V8;
    float xv[16];
#pragma unroll
    for (int j = 0; j < 4; ++j) { const float4 t = *(const float4*)(X1 + lane * 16 + j * 4); xv[4 * j] = t.x; xv[4 * j + 1] = t.y; xv[4 * j + 2] = t.z; xv[4 * j + 3] = t.w; }
    wave_sync();
    {
        uint4 hi, lo; unsigned* hp = (unsigned*)&hi; unsigned* lp = (unsigned*)&lo;
#pragma unroll
        for (int j = 0; j < 4; ++j) {
            const unsigned hw = pack4_fp8(xv[4 * j], xv[4 * j + 1], xv[4 * j + 2], xv[4 * j + 3]);
            const f32x2_ b0 = __builtin_amdgcn_cvt_pk_f32_fp8((int)hw, false), b1 = __builtin_amdgcn_cvt_pk_f32_fp8((int)hw, true);
            hp[j] = hw;
            lp[j] = pack4_fp8(16.f * (xv[4 * j] - b0[0]), 16.f * (xv[4 * j + 1] - b0[1]), 16.f * (xv[4 * j + 2] - b1[0]), 16.f * (xv[4 * j + 3] - b1[1]));
        }
        *(uint4*)(xh + lane * 16) = hi; *(uint4*)(xo + lane * 16) = lo;
    }
    idxl[lane] = PIDX[lane]; idxl[64 + lane] = PIDX[64 + lane];
    wave_sync();
    uint4 ufa[8], ufb[8];
    f32x4 ah = (f32x4){0.f, 0.f, 0.f, 0.f}, al = (f32x4){0.f, 0.f, 0.f, 0.f};
#define U_LOAD(DST, HH) { const unsigned char* ub_ = U8 + (size_t)idxl[((HH) >> 1) * 16 + lr] * 1024 + ((HH) & 1) * 512 + lq * 16; \
        _Pragma("unroll") for (int i = 0; i < 8; ++i) DST[i] = *(const uint4*)(ub_ + i * 64); }
#define U_HALF(SRC, HH) { \
        _Pragma("unroll") for (int i = 0; i < 8; ++i) { \
            const int off = ((HH) & 1) * 512 + i * 64 + lq * 16; \
            const long b0 = (long)(((unsigned long long)SRC[i].y << 32) | SRC[i].x), b1 = (long)(((unsigned long long)SRC[i].w << 32) | SRC[i].z); \
            const long h0 = *(const long*)(xh + off), h1 = *(const long*)(xh + off + 8), l0 = *(const long*)(xo + off), l1 = *(const long*)(xo + off + 8); \
            ah = __builtin_amdgcn_mfma_f32_16x16x32_fp8_fp8(h0, b0, ah, 0, 0, 0); ah = __builtin_amdgcn_mfma_f32_16x16x32_fp8_fp8(h1, b1, ah, 0, 0, 0); \
            al = __builtin_amdgcn_mfma_f32_16x16x32_fp8_fp8(l0, b0, al, 0, 0, 0); al = __builtin_amdgcn_mfma_f32_16x16x32_fp8_fp8(l1, b1, al, 0, 0, 0); } \
        if ((HH) & 1) { if (lq == 0) coefl[((HH) >> 1) * 16 + lr] = PG[((HH) >> 1) * 16 + lr] * gelu_tanh((ah[0] + al[0] * 0.0625f) * (1.0f / PEER_U_SCALE)) * (1.0f / PEER_V_SCALE); \
            ah = (f32x4){0.f, 0.f, 0.f, 0.f}; al = (f32x4){0.f, 0.f, 0.f, 0.f}; } }
    U_LOAD(ufa, 0)
#pragma unroll 1
    for (int hh = 0; hh < 16; hh += 2) {
        U_LOAD(ufb, hh + 1)
        U_HALF(ufa, hh)
        if (hh + 2 < 16) U_LOAD(ufa, hh + 2)
        U_HALF(ufb, hh + 1)
    }
#undef U_LOAD
#undef U_HALF
    wave_sync();
    float o[16];
#pragma unroll
    for (int i = 0; i < 16; ++i) o[i] = 0.f;
    uint4 vfa[8], vfb[8];
#define V_LOAD(DST, J) { _Pragma("unroll") for (int u = 0; u < 8; ++u) DST[u] = *(const uint4*)(V8 + (size_t)idxl[(J) + u] * 1024 + lane * 16); }
#define V_ACC(SRC, J) { _Pragma("unroll") for (int u = 0; u < 8; ++u) { const float c_ = coefl[(J) + u]; \
            const unsigned w0_ = SRC[u].x, w1_ = SRC[u].y, w2_ = SRC[u].z, w3_ = SRC[u].w; \
            f32x2_ f0, f1; \
            f0 = __builtin_amdgcn_cvt_pk_f32_fp8((int)w0_, false); f1 = __builtin_amdgcn_cvt_pk_f32_fp8((int)w0_, true); o[0] += c_ * f0[0]; o[1] += c_ * f0[1]; o[2] += c_ * f1[0]; o[3] += c_ * f1[1]; \
            f0 = __builtin_amdgcn_cvt_pk_f32_fp8((int)w1_, false); f1 = __builtin_amdgcn_cvt_pk_f32_fp8((int)w1_, true); o[4] += c_ * f0[0]; o[5] += c_ * f0[1]; o[6] += c_ * f1[0]; o[7] += c_ * f1[1]; \
            f0 = __builtin_amdgcn_cvt_pk_f32_fp8((int)w2_, false); f1 = __builtin_amdgcn_cvt_pk_f32_fp8((int)w2_, true); o[8] += c_ * f0[0]; o[9] += c_ * f0[1]; o[10] += c_ * f1[0]; o[11] += c_ * f1[1]; \
            f0 = __builtin_amdgcn_cvt_pk_f32_fp8((int)w3_, false); f1 = __builtin_amdgcn_cvt_pk_f32_fp8((int)w3_, true); o[12] += c_ * f0[0]; o[13] += c_ * f0[1]; o[14] += c_ * f1[0]; o[15] += c_ * f1[1]; } }
    V_LOAD(vfa, 0)
#pragma unroll 1
    for (int j = 0; j < 128; j += 16) {
        V_LOAD(vfb, j + 8)
        V_ACC(vfa, j)
        if (j + 16 < 128) V_LOAD(vfa, j + 16)
        V_ACC(vfb, j + 8)
    }
#undef V_LOAD
#undef V_ACC
    float tv[16]; float s = 0.f;
#pragma unroll
    for (int i = 0; i < 16; ++i) { tv[i] = DN_ALPHA * xv[i] + o[i]; s += tv[i]; }
    const float mu = wave_sum(s) * (1.0f / 1024.0f);
    float q = 0.f;
#pragma unroll
    for (int i = 0; i < 16; ++i) { const float d = tv[i] - mu; q += d * d; }
    const float rstd = 1.0f / sqrtf(wave_sum(q) * (1.0f / 1024.0f) + LN_EPS);
    float* y = p.out + O_Y + (size_t)row * 1024 + lane * 16;
#pragma unroll
    for (int j = 0; j < 4; ++j) {
        const float4 g4 = *(const float4*)(p.ln2_g + lane * 16 + j * 4), b4 = *(const float4*)(p.ln2_b + lane * 16 + j * 4);
        float4 yo;
        yo.x = (tv[4 * j] - mu) * rstd * g4.x + b4.x; yo.y = (tv[4 * j + 1] - mu) * rstd * g4.y + b4.y; yo.z = (tv[4 * j + 2] - mu) * rstd * g4.z + b4.z; yo.w = (tv[4 * j + 3] - mu) * rstd * g4.w + b4.w;
        *(float4*)(y + j * 4) = yo;
    }
}

constexpr int QN = 2;
struct AttnState { f32x4 ot[4][QN]; float m[QN]; float l[QN]; };

DEV void attn_block(const unsigned char* Ks, const unsigned char* VTs, const bf16x8 (&Qf)[QN][2], AttnState& A, const int mode, const int dq, const float* blut,
                    const unsigned selbit0, const unsigned selbit1, const bool slc, const int lr, const int lq, const int t0, const int ci0) {
    f32x4 sc[4][QN];
#pragma unroll
    for (int kt = 0; kt < 4; ++kt) {
        const bf16x8 k0 = *(const bf16x8*)(Ks + (kt * 16 + lr) * 144 + lq * 16), k1 = *(const bf16x8*)(Ks + (kt * 16 + lr) * 144 + 64 + lq * 16);
#pragma unroll
        for (int qi = 0; qi < QN; ++qi) {
            f32x4 a = (f32x4){0.f, 0.f, 0.f, 0.f};
            a = __builtin_amdgcn_mfma_f32_16x16x32_bf16(k0, Qf[qi][0], a, 0, 0, 0);
            a = __builtin_amdgcn_mfma_f32_16x16x32_bf16(k1, Qf[qi][1], a, 0, 0, 0);
            sc[kt][qi] = a;
        }
    }
    asm volatile("" ::: "memory");
    if (mode != 0 || slc) {
#pragma unroll
        for (int kt = 0; kt < 4; ++kt)
#pragma unroll
            for (int qi = 0; qi < QN; ++qi)
#pragma unroll
                for (int g = 0; g < 4; ++g) {
                    const int kl = kt * 16 + lq * 4 + g, ql = qi * 16 + lr;
                    float v = sc[kt][qi][g];
                    bool ok = true;
                    if (mode == 1 || mode == 2) { const int di = dq + ql - kl; v += blut[di < 0 ? 0 : di]; }
                    if (mode == 2) ok = kl <= ql + dq;
                    if (mode == 3) ok = kl > ql + dq - 512;
                    if (mode == 4) { const int ci = ci0 + kl, dist = t0 + ql - (16 * ci + 31); ok = (dist >= 0) && (ci < 127); if (dist >= 0 && dist < 192) v += blut[dist]; }
                    if (mode == 5) { const int dist = dq - ci0 * kl; ok = (kl < t0) && (dist >= 0); if (dist >= 0 && dist < 192) v += blut[dist]; }
                    if (slc) ok = ok && ((qi == 0 ? selbit0 : selbit1) != 0u);
                    sc[kt][qi][g] = ok ? v : NEGF;
                }
    }
    bf16x8 pf[QN][2];
#pragma unroll
    for (int qi = 0; qi < QN; ++qi) {
        float mb = NEGF;
#pragma unroll
        for (int kt = 0; kt < 4; ++kt) mb = fmaxf(mb, fmaxf(fmaxf(sc[kt][qi][0], sc[kt][qi][1]), fmaxf(sc[kt][qi][2], sc[kt][qi][3])));
        mb = fmaxf(mb, __shfl_xor(mb, 16)); mb = fmaxf(mb, __shfl_xor(mb, 32));
        const float mn = fmaxf(A.m[qi], mb);
        const float alpha = __builtin_amdgcn_exp2f(A.m[qi] - mn);
        A.m[qi] = mn;
        float rs = 0.f;
#pragma unroll
        for (int kt = 0; kt < 4; ++kt)
#pragma unroll
            for (int g = 0; g < 4; ++g) { const float v = sc[kt][qi][g]; const float e = (v > -1e29f) ? __builtin_amdgcn_exp2f(v - mn) : 0.f; sc[kt][qi][g] = e; rs += e; }
        A.l[qi] = A.l[qi] * alpha + rs;
#pragma unroll
        for (int dt = 0; dt < 4; ++dt) A.ot[dt][qi] = A.ot[dt][qi] * alpha;
#pragma unroll
        for (int ks = 0; ks < 2; ++ks) {
            union { bf16x8 v; unsigned u[4]; } pk;
            pk.u[0] = cvt_pk_bf16(sc[2 * ks][qi][0], sc[2 * ks][qi][1]); pk.u[1] = cvt_pk_bf16(sc[2 * ks][qi][2], sc[2 * ks][qi][3]);
            pk.u[2] = cvt_pk_bf16(sc[2 * ks + 1][qi][0], sc[2 * ks + 1][qi][1]); pk.u[3] = cvt_pk_bf16(sc[2 * ks + 1][qi][2], sc[2 * ks + 1][qi][3]);
            pf[qi][ks] = pk.v;
        }
    }
    asm volatile("" ::: "memory");
#pragma unroll
    for (int dt = 0; dt < 4; ++dt)
#pragma unroll
        for (int ks = 0; ks < 2; ++ks) {
            asm volatile("" ::: "memory");
            union { bf16x8 v; uint2 h[2]; } vf;
            vf.h[0] = *(const uint2*)(VTs + (dt * 16 + lr) * 144 + (32 * ks + lq * 4) * 2);
            vf.h[1] = *(const uint2*)(VTs + (dt * 16 + lr) * 144 + (32 * ks + 16 + lq * 4) * 2);
#pragma unroll
            for (int qi = 0; qi < QN; ++qi) A.ot[dt][qi] = __builtin_amdgcn_mfma_f32_16x16x32_bf16(vf.v, pf[qi][ks], A.ot[dt][qi], 0, 0, 0);
        }
}

DEV void nsa_prompt_item(const Params& p, const int b, const int hkv, const int q32, unsigned char* lds) {
    int tid_ = threadIdx.x; asm volatile("" : "+v"(tid_));
    const int tid = tid_, lane = tid & 63, g = tid >> 6, lr = lane & 15, lq = lane >> 4;
    const int hq = hkv * 4 + g, t0 = q32 * 32, kd = t0 >> 6;
    unsigned char* Ks = lds; unsigned char* VTs = lds + 9216;
    float* biasl = (float*)(lds + 18432); float* psl = (float*)(lds + 21504); unsigned* selm = (unsigned*)(lds + 29952); unsigned* misc = (unsigned*)(lds + 30208);
    const bf16_t* ZB = (const bf16_t*)(p.ws + WS_ZB);
    const bf16_t* VTS = (const bf16_t*)(p.ws + WS_VTS) + (size_t)(b * 2 + hkv) * 64 * 2048;
    const bf16_t* VTW = (const bf16_t*)(p.ws + WS_VTW) + (size_t)(b * 2 + hkv) * 64 * 2048;
    const bf16_t* KCB = (const bf16_t*)(p.ws + WS_KCB) + (size_t)(b * 2 + hkv) * 128 * 64;
    const bf16_t* VTC = (const bf16_t*)(p.ws + WS_VTC) + (size_t)(b * 2 + hkv) * 64 * 128;
    const float* Z = (const float*)(p.ws + WS_Z);
    float* NOUTF = (float*)(p.ws + WS_NOUTF);
    bf16_t* NOUTB = (bf16_t*)(p.ws + WS_NOUTB);
    __syncthreads();
    for (int i = tid; i < 4 * 192; i += 256) { const int gg = i / 192, d = i % 192; biasl[i] = (p.rel_bias[rel_bucket(d) * 8 + hkv * 4 + gg] - p.rel_bias[31 * 8 + hkv * 4 + gg]) * LOG2E; }
    for (int i = tid; i < 32 * 33; i += 256) psl[i] = 0.f;
    if (tid < 32) selm[tid] = 0u;
    if (tid == 0) misc[0] = 0u;
    const float* blut = biasl + g * 192;
    bf16x8 Qf[QN][2];
#pragma unroll
    for (int qi = 0; qi < QN; ++qi)
#pragma unroll
        for (int kk = 0; kk < 2; ++kk) Qf[qi][kk] = *(const bf16x8*)(ZB + (size_t)(b * 2048 + t0 + qi * 16 + lr) * IN_DIM + C_Q + hq * 64 + kk * 32 + lq * 8);

    uint4 trk0, trk1, trv0, trv1;
    auto load_tiles = [&](int kind, int kb) __attribute__((always_inline)) {
#pragma unroll
        for (int i = 0; i < 2; ++i) {
            const int id = tid + 256 * i, row = id >> 3, ch = id & 7;
            uint4 rk, rv;
            if (kind == 0) { rk = *(const uint4*)(KCB + (size_t)(kb * 64 + row) * 64 + ch * 8); rv = *(const uint4*)(VTC + (size_t)row * 128 + kb * 64 + ch * 8); }
            else {
                rk = *(const uint4*)(ZB + (size_t)(b * 2048 + kb * 64 + row) * IN_DIM + (kind == 1 ? C_KS : C_KW) + hkv * 64 + ch * 8);
                rv = *(const uint4*)((kind == 1 ? VTS : VTW) + (size_t)row * 2048 + kb * 64 + ch * 8);
            }
            if (i == 0) { trk0 = rk; trv0 = rv; } else { trk1 = rk; trv1 = rv; }
        }
    };
    auto store_tiles = [&]() __attribute__((always_inline)) {
#pragma unroll
        for (int i = 0; i < 2; ++i) { const int id = tid + 256 * i, row = id >> 3, ch = id & 7; *(uint4*)(Ks + row * 144 + ch * 16) = (i == 0 ? trk0 : trk1); *(uint4*)(VTs + row * 144 + ch * 16) = (i == 0 ? trv0 : trv1); }
    };
    auto reset = [&](AttnState& A) __attribute__((always_inline)) {
#pragma unroll
        for (int qi = 0; qi < QN; ++qi) { A.m[qi] = NEGF; A.l[qi] = 0.f;
#pragma unroll
            for (int dt = 0; dt < 4; ++dt) A.ot[dt][qi] = (f32x4){0.f, 0.f, 0.f, 0.f}; }
    };
    auto finish = [&](AttnState& A, int br) __attribute__((always_inline)) {
#pragma unroll
        for (int qi = 0; qi < QN; ++qi) {
            float lt = A.l[qi]; lt += __shfl_xor(lt, 16); lt += __shfl_xor(lt, 32);
            const float sc = (lt > 0.f) ? sigmoidf_(Z[(size_t)(b * 2048 + t0 + qi * 16 + lr) * 32 + 8 + br * 8 + hq]) / lt : 0.f;
            const size_t row = (size_t)(b * 2048 + t0 + qi * 16 + lr);
#pragma unroll
            for (int dt = 0; dt < 4; ++dt) {
                const int col = hq * 64 + dt * 16 + lq * 4;
                f32x4 v = A.ot[dt][qi] * sc;
                if (br > 0) v = v + *(const f32x4*)(NOUTF + row * 512 + col);
                if (br < 2) *(f32x4*)(NOUTF + row * 512 + col) = v; else store_bf16x4(NOUTB + row * 512 + col, v);
            }
        }
    };

    AttnState A;
    const int ncb = ((t0 >> 4) >= 64) ? 2 : 1;
    reset(A);
    load_tiles(0, 0);
    for (int kb = 0; kb < ncb; ++kb) {
        __syncthreads(); store_tiles(); __syncthreads();
        if (kb + 1 < ncb) load_tiles(0, kb + 1);
        attn_block(Ks, VTs, Qf, A, 4, 0, blut, 1u, 1u, false, lr, lq, t0, kb * 64);
    }
    finish(A, 0);
    {
        float linv[QN];
#pragma unroll
        for (int qi = 0; qi < QN; ++qi) { float lt = A.l[qi]; lt += __shfl_xor(lt, 16); lt += __shfl_xor(lt, 32); linv[qi] = (lt > 0.f) ? 1.0f / lt : 0.f; }
        for (int kb = 0; kb < ncb; ++kb) {
            if (ncb > 1) { load_tiles(0, kb); __syncthreads(); store_tiles(); __syncthreads(); }
#pragma unroll
            for (int kt = 0; kt < 4; ++kt) {
                const bf16x8 k0 = *(const bf16x8*)(Ks + (kt * 16 + lr) * 144 + lq * 16), k1 = *(const bf16x8*)(Ks + (kt * 16 + lr) * 144 + 64 + lq * 16);
#pragma unroll
                for (int qi = 0; qi < QN; ++qi) {
                    f32x4 a = (f32x4){0.f, 0.f, 0.f, 0.f};
                    a = __builtin_amdgcn_mfma_f32_16x16x32_bf16(k0, Qf[qi][0], a, 0, 0, 0);
                    a = __builtin_amdgcn_mfma_f32_16x16x32_bf16(k1, Qf[qi][1], a, 0, 0, 0);
                    float pr[4];
#pragma unroll
                    for (int gg = 0; gg < 4; ++gg) {
                        const int ci = kb * 64 + kt * 16 + lq * 4 + gg, ql = qi * 16 + lr, dist = t0 + ql - (16 * ci + 31);
                        float v = a[gg];
                        if (dist >= 0 && dist < 192) v += blut[dist];
                        pr[gg] = (dist >= 0 && ci < 127) ? __builtin_amdgcn_exp2f(v - A.m[qi]) * linv[qi] : 0.f;
                    }
                    const int blk = kb * 16 + kt * 4 + lq, ql = qi * 16 + lr;
                    atomicAdd(&psl[ql * 33 + blk], 2.0f * (pr[0] + pr[1] + pr[2]) + pr[3]);
                    atomicAdd(&psl[ql * 33 + blk + 1], pr[3]);
                }
            }
        }
    }
    __syncthreads();
    {
        const int ql = tid >> 3, part = tid & 7, tq = t0 + ql, cur = tq >> 6;
        float scv[32];
#pragma unroll
        for (int j = 0; j < 32; ++j) {
            const bool causal = j * 64 <= tq, forced = (j == 0) || (j == cur) || (j == cur - 1);
            scv[j] = causal ? (forced ? 1e4f : psl[ql * 33 + j]) : NEGF;
        }
        unsigned mbits = 0u;
#pragma unroll
        for (int jj = 0; jj < 4; ++jj) {
            const int j = part * 4 + jj;
            float my = NEGF;
#pragma unroll
            for (int k = 0; k < 32; ++k) my = (k == j) ? scv[k] : my;
            int rank = 0;
#pragma unroll
            for (int k = 0; k < 32; ++k) rank += ((scv[k] > my) || (scv[k] == my && k < j)) ? 1 : 0;
            if (rank < 16 && j * 64 <= tq) mbits |= (1u << j);
        }
        atomicOr(&selm[ql], mbits);
        atomicOr(&misc[0], mbits);
    }
    __syncthreads();
    const unsigned msk0 = selm[lr], msk1 = selm[16 + lr];
    const unsigned anym = misc[0];
    reset(A);
    {
        int kb = kd;
        load_tiles(1, kb);
        for (;;) {
            __syncthreads(); store_tiles(); __syncthreads();
            int nxt = (kb == kd) ? 0 : kb + 1;
            while (nxt < kd && !((anym >> nxt) & 1u)) ++nxt;
            const bool more = nxt < kd;
            if (more) load_tiles(1, nxt);
            const int mode = (kb == kd) ? 2 : ((kb >= kd - 2) ? 1 : 0);
            attn_block(Ks, VTs, Qf, A, mode, t0 - kb * 64, blut, (msk0 >> kb) & 1u, (msk1 >> kb) & 1u, true, lr, lq, t0, 0);
            if (!more) break;
            kb = nxt;
        }
    }
    finish(A, 1);
    reset(A);
    {
        const int klo = (t0 >= 511) ? ((t0 - 511) >> 6) : 0;
        int kb = kd;
        load_tiles(2, kb);
        for (;;) {
            __syncthreads(); store_tiles(); __syncthreads();
            const bool more = kb > klo;
            if (more) load_tiles(2, kb - 1);
            const int dq = t0 - kb * 64;
            const int mode = (kb == kd) ? 2 : ((kb >= kd - 2) ? 1 : ((dq + 31 >= 512) ? 3 : 0));
            attn_block(Ks, VTs, Qf, A, mode, dq, blut, 1u, 1u, false, lr, lq, t0, 0);
            if (!more) break;
            --kb;
        }
    }
    finish(A, 2);
}

DEV void nsa_sample_item(const Params& p, const int b, const int hkv, unsigned char* lds) {
    int tid_ = threadIdx.x; asm volatile("" : "+v"(tid_));
    const int tid = tid_, lane = tid & 63, g = tid >> 6, lr = lane & 15, lq = lane >> 4;
    const int hq = hkv * 4 + g;
    unsigned char* Ks = lds; unsigned char* VTs = lds + 9216;
    float* biasl = (float*)(lds + 18432); float* psl = (float*)(lds + 21504); int* sell = (int*)(lds + 29952); float* scl = (float*)(lds + 30720);
    const bf16_t* ZB = (const bf16_t*)(p.ws + WS_ZB);
    const float* zgate = (const float*)(p.ws + WS_Z) + (size_t)(NP + b) * 32 + 8;
    const bf16_t* zbrow = ZB + (size_t)(NP + b) * IN_DIM;
    const bf16_t* KCSB = (const bf16_t*)(p.ws + WS_KCSB) + (size_t)(b * 2 + hkv) * 1024 * 64;
    const bf16_t* VTCS = (const bf16_t*)(p.ws + WS_VTCS) + (size_t)(b * 2 + hkv) * 64 * 1024;
    bf16_t* NOUTB = (bf16_t*)(p.ws + WS_NOUTB);
    __syncthreads();
    for (int i = tid; i < 4 * 192; i += 256) { const int gg = i / 192, d = i % 192; biasl[i] = (p.rel_bias[rel_bucket(d) * 8 + hkv * 4 + gg] - p.rel_bias[31 * 8 + hkv * 4 + gg]) * LOG2E; }
    for (int i = tid; i < 260; i += 256) psl[i] = 0.f;
    const float* blut = biasl + g * 192;
    bf16x8 Qf[QN][2];
#pragma unroll
    for (int kk = 0; kk < 2; ++kk) { Qf[0][kk] = *(const bf16x8*)(ZB + (size_t)(NP + b) * IN_DIM + C_Q + hq * 64 + kk * 32 + lq * 8); Qf[1][kk] = Qf[0][kk]; }
    AttnState A;
    auto reset = [&](AttnState& S_) __attribute__((always_inline)) {
#pragma unroll
        for (int qi = 0; qi < QN; ++qi) { S_.m[qi] = NEGF; S_.l[qi] = 0.f;
#pragma unroll
            for (int dt = 0; dt < 4; ++dt) S_.ot[dt][qi] = (f32x4){0.f, 0.f, 0.f, 0.f}; }
    };
    f32x4 res[4];
#pragma unroll
    for (int dt = 0; dt < 4; ++dt) res[dt] = (f32x4){0.f, 0.f, 0.f, 0.f};
    auto finish = [&](AttnState& S_, int br) __attribute__((always_inline)) {
        float lt = S_.l[0]; lt += __shfl_xor(lt, 16); lt += __shfl_xor(lt, 32);
        const float sc = (lt > 0.f) ? sigmoidf_(zgate[br * 8 + hq]) / lt : 0.f;
#pragma unroll
        for (int dt = 0; dt < 4; ++dt) res[dt] = res[dt] + S_.ot[dt][0] * sc;
    };
    uint4 trk0, trk1, trv0, trv1;
    auto load_cmp = [&](int kb) __attribute__((always_inline)) {
#pragma unroll
        for (int i = 0; i < 2; ++i) {
            const int id = tid + 256 * i, row = id >> 3, ch = id & 7;
            const uint4 rk = *(const uint4*)(KCSB + (size_t)(kb * 64 + row) * 64 + ch * 8), rv = *(const uint4*)(VTCS + (size_t)row * 1024 + kb * 64 + ch * 8);
            if (i == 0) { trk0 = rk; trv0 = rv; } else { trk1 = rk; trv1 = rv; }
        }
    };
    auto store_cmp = [&]() __attribute__((always_inline)) {
#pragma unroll
        for (int i = 0; i < 2; ++i) { const int id = tid + 256 * i, row = id >> 3, ch = id & 7; *(uint4*)(Ks + row * 144 + ch * 16) = (i == 0 ? trk0 : trk1); *(uint4*)(VTs + row * 144 + ch * 16) = (i == 0 ? trv0 : trv1); }
    };
    reset(A);
    load_cmp(0);
    for (int kb = 0; kb < 16; ++kb) {
        __syncthreads(); store_cmp(); __syncthreads();
        if (kb + 1 < 16) load_cmp(kb + 1);
        attn_block(Ks, VTs, Qf, A, 5, PAST - 31 - 16 * (kb * 64), blut, 1u, 1u, false, lr, lq, (kb == 15) ? 63 : 64, 16);
    }
    finish(A, 0);
    {
        float lt = A.l[0]; lt += __shfl_xor(lt, 16); lt += __shfl_xor(lt, 32);
        const float linv = (lt > 0.f) ? 1.0f / lt : 0.f;
        for (int kb = 0; kb < 16; ++kb) {
            load_cmp(kb); __syncthreads(); store_cmp(); __syncthreads();
#pragma unroll
            for (int kt = 0; kt < 4; ++kt) {
                const bf16x8 k0 = *(const bf16x8*)(Ks + (kt * 16 + lr) * 144 + lq * 16), k1 = *(const bf16x8*)(Ks + (kt * 16 + lr) * 144 + 64 + lq * 16);
                f32x4 a = (f32x4){0.f, 0.f, 0.f, 0.f};
                a = __builtin_amdgcn_mfma_f32_16x16x32_bf16(k0, Qf[0][0], a, 0, 0, 0);
                a = __builtin_amdgcn_mfma_f32_16x16x32_bf16(k1, Qf[0][1], a, 0, 0, 0);
                float pr[4];
#pragma unroll
                for (int gg = 0; gg < 4; ++gg) {
                    const int ci = kb * 64 + kt * 16 + lq * 4 + gg, dist = PAST - 31 - 16 * ci;
                    float v = a[gg];
                    if (dist >= 0 && dist < 192) v += blut[dist];
                    pr[gg] = (ci < 1023) ? __builtin_amdgcn_exp2f(v - A.m[0]) * linv : 0.f;
                }
                if (lr == 0) {
                    const int blk = kb * 16 + kt * 4 + lq;
                    atomicAdd(&psl[blk], 2.0f * (pr[0] + pr[1] + pr[2]) + pr[3]);
                    atomicAdd(&psl[blk + 1], pr[3]);
                }
            }
        }
    }
    __syncthreads();
    for (int j = tid; j < 257; j += 256) scl[j] = (j == 0 || j == 256 || j == 255) ? 1e4f : psl[j];
    __syncthreads();
    for (int j = tid; j < 257; j += 256) {
        const float my = scl[j];
        int rank = 0;
        for (int k = 0; k < 257; ++k) { const float o2 = scl[k]; rank += ((o2 > my) || (o2 == my && k < j)) ? 1 : 0; }
        if (rank < 16) sell[rank] = j;
    }
    __syncthreads();
    uint4 rk0, rk1; unsigned rv0, rv1, rv2, rv3, rv4, rv5, rv6, rv7;
    auto load_rows = [&](const float* src, const bf16_t* srcb) __attribute__((always_inline)) {
        const int seg = tid & 3;
        if (srcb) {
            const bf16_t* kp = srcb + hkv * 64 + seg * 16; const bf16_t* vp = kp + 128;
            rk0 = *(const uint4*)kp; rk1 = *(const uint4*)(kp + 8);
            const uint4 v0 = *(const uint4*)vp, v1 = *(const uint4*)(vp + 8);
            rv0 = v0.x; rv1 = v0.y; rv2 = v0.z; rv3 = v0.w; rv4 = v1.x; rv5 = v1.y; rv6 = v1.z; rv7 = v1.w;
        } else {
            const bool nz = src != nullptr;
            const float* kp = (nz ? src : p.state_win) + hkv * 64 + seg * 16; const float* vp = kp + 128;
            const float4 a0 = *(const float4*)kp, a1 = *(const float4*)(kp + 4), a2 = *(const float4*)(kp + 8), a3 = *(const float4*)(kp + 12);
            const float4 c0 = *(const float4*)vp, c1 = *(const float4*)(vp + 4), c2 = *(const float4*)(vp + 8), c3 = *(const float4*)(vp + 12);
            const unsigned mk = nz ? 0xffffffffu : 0u;
            rk0.x = cvt_pk_bf16(a0.x, a0.y) & mk; rk0.y = cvt_pk_bf16(a0.z, a0.w) & mk; rk0.z = cvt_pk_bf16(a1.x, a1.y) & mk; rk0.w = cvt_pk_bf16(a1.z, a1.w) & mk;
            rk1.x = cvt_pk_bf16(a2.x, a2.y) & mk; rk1.y = cvt_pk_bf16(a2.z, a2.w) & mk; rk1.z = cvt_pk_bf16(a3.x, a3.y) & mk; rk1.w = cvt_pk_bf16(a3.z, a3.w) & mk;
            rv0 = cvt_pk_bf16(c0.x, c0.y) & mk; rv1 = cvt_pk_bf16(c0.z, c0.w) & mk; rv2 = cvt_pk_bf16(c1.x, c1.y) & mk; rv3 = cvt_pk_bf16(c1.z, c1.w) & mk;
            rv4 = cvt_pk_bf16(c2.x, c2.y) & mk; rv5 = cvt_pk_bf16(c2.z, c2.w) & mk; rv6 = cvt_pk_bf16(c3.x, c3.y) & mk; rv7 = cvt_pk_bf16(c3.z, c3.w) & mk;
        }
    };
    auto store_rows = [&]() __attribute__((always_inline)) {
        const int kl = tid >> 2, seg = tid & 3;
        *(uint4*)(Ks + kl * 144 + seg * 32) = rk0; *(uint4*)(Ks + kl * 144 + seg * 32 + 16) = rk1;
#define VT_PUT(i_, w_) { *(bf16_t*)(VTs + (seg * 16 + (i_)) * 144 + kl * 2) = (bf16_t)((w_) & 0xffffu); *(bf16_t*)(VTs + (seg * 16 + (i_) + 1) * 144 + kl * 2) = (bf16_t)((w_) >> 16); }
        VT_PUT(0, rv0) VT_PUT(2, rv1) VT_PUT(4, rv2) VT_PUT(6, rv3) VT_PUT(8, rv4) VT_PUT(10, rv5) VT_PUT(12, rv6) VT_PUT(14, rv7)
#undef VT_PUT
    };
    auto slc_row = [&](int blk) __attribute__((always_inline)) -> const float* {
        const int kl = tid >> 2;
        if (blk < 256) { const int page = p.page_table[b * 128 + (blk >> 1)]; return p.cache_slc + ((size_t)page * 128 + (blk & 1) * 64 + kl) * 256; }
        return nullptr;
    };
    auto slc_rowb = [&](int blk) __attribute__((always_inline)) -> const bf16_t* { return (blk == 256 && (tid >> 2) == 0) ? zbrow + C_KS : nullptr; };
    reset(A);
    load_rows(slc_row(sell[0]), slc_rowb(sell[0]));
    for (int si = 0; si < 16; ++si) {
        const int blk = sell[si];
        __syncthreads(); store_rows(); __syncthreads();
        if (si + 1 < 16) load_rows(slc_row(sell[si + 1]), slc_rowb(sell[si + 1]));
        attn_block(Ks, VTs, Qf, A, 5, PAST - blk * 64, blut, 1u, 1u, false, lr, lq, (blk == 256) ? 1 : 64, 1);
    }
    finish(A, 1);
    auto win_row = [&](int wb) __attribute__((always_inline)) -> const float* {
        const int j = 1 + wb * 64 + (tid >> 2);
        return (j < 512) ? p.state_win + ((size_t)b * 512 + j) * 256 : nullptr;
    };
    auto win_rowb = [&](int wb) __attribute__((always_inline)) -> const bf16_t* { return (1 + wb * 64 + (tid >> 2) == 512) ? zbrow + C_KW : nullptr; };
    reset(A);
    load_rows(win_row(0), win_rowb(0));
    for (int wb = 0; wb < 8; ++wb) {
        __syncthreads(); store_rows(); __syncthreads();
        if (wb + 1 < 8) load_rows(win_row(wb + 1), win_rowb(wb + 1));
        attn_block(Ks, VTs, Qf, A, 5, 511 - wb * 64, blut, 1u, 1u, false, lr, lq, 64, 1);
    }
    finish(A, 2);
    if (lr == 0) {
#pragma unroll
        for (int dt = 0; dt < 4; ++dt) store_bf16x4(NOUTB + (size_t)(NP + b) * 512 + hq * 64 + dt * 16 + lq * 4, res[dt]);
    }
}

#define Z ((float*)(p.ws + WS_Z))
#define QK ((float*)(p.ws + WS_QK))
#define HRAW ((float*)(p.ws + WS_HRAW))
#define MOUTB ((bf16_t*)(p.ws + WS_MOUTB))
#define NOUTB ((bf16_t*)(p.ws + WS_NOUTB))
#define HIDPB ((bf16_t*)(p.ws + WS_HIDPB))
#define HIDSB ((bf16_t*)(p.ws + WS_HIDSB))
#define KCS ((float*)(p.ws + WS_KCS))
#define MIX ((float*)(p.ws + WS_MIX))
#define MIXB ((bf16_t*)(p.ws + WS_MIXB))
#define T1 ((float*)(p.ws + WS_T1))
#define X1 ((float*)(p.ws + WS_X1))
#define X1B ((bf16_t*)(p.ws + WS_X1B))
#define QPB ((bf16_t*)(p.ws + WS_QPB))
#define S ((float*)(p.ws + WS_S))
#define CONVB ((bf16_t*)(p.ws + WS_CONVB))
#define XB ((bf16_t*)(p.ws + WS_XB))
#define WIN_T ((bf16_t*)(p.ws + WS_WIN_T))
#define WUPM_T ((bf16_t*)(p.ws + WS_WUPM_T))
#define WUPN_T ((bf16_t*)(p.ws + WS_WUPN_T))
#define WOUT_T ((bf16_t*)(p.ws + WS_WOUT_T))
#define PWQ_T ((bf16_t*)(p.ws + WS_PWQ_T))
#define WQK_T ((bf16_t*)(p.ws + WS_WQK_T))
#define W1_T ((bf16_t*)(p.ws + WS_W1_T))
#define W2_T ((bf16_t*)(p.ws + WS_W2_T))
#define SUBK ((bf16_t*)(p.ws + WS_SUBK))
#define ZB ((bf16_t*)(p.ws + WS_ZB))
#define VTS ((bf16_t*)(p.ws + WS_VTS))
#define VTW ((bf16_t*)(p.ws + WS_VTW))
#define KCB ((bf16_t*)(p.ws + WS_KCB))
#define VTC ((bf16_t*)(p.ws + WS_VTC))
__global__ void __launch_bounds__(NTHREADS, 2) fwd_kernel(Params p) {
    extern __shared__ __attribute__((aligned(16))) unsigned char smem[];
    if (threadIdx.x == 0) { *(uint4*)smem = make_uint4(0u, 0u, 0u, 0u); }
    __syncthreads();
    XcdBarrier bar = xcd_barrier_post((unsigned*)(p.ws + WS_BAR), (volatile LAS unsigned*)smem);
    float* lds = (float*)(smem + 16);
    unsigned char* ldsb = smem + 16;
    const int tid = threadIdx.x, lane = tid & 63, w = tid >> 6;
    const int gw = blockIdx.x * 4 + w, nw = gridDim.x * 4;
    const size_t gt = (size_t)blockIdx.x * NTHREADS + tid, nt = (size_t)gridDim.x * NTHREADS;


    {
        for (size_t id = gt; id < (size_t)MP * 128; id += nt) {
            const int row = (int)(id >> 7), k8 = (int)(id & 127) * 8;
            float f[8];
            if (row < NR) {
                const float* s = (row < NP ? p.x_prompt + (size_t)row * 1024 : p.x_sample + (size_t)(row - NP) * 1024) + k8;
                const float4 a = *(const float4*)s, b = *(const float4*)(s + 4);
                f[0] = a.x; f[1] = a.y; f[2] = a.z; f[3] = a.w; f[4] = b.x; f[5] = b.y; f[6] = b.z; f[7] = b.w;
            } else {
#pragma unroll
                for (int i = 0; i < 8; ++i) f[i] = 0.f;
            }
            *(uint4*)(XB + (size_t)row * 1024 + k8) = pack8(f);
        }
        transpose_to_bf16(p.w_in, 1024, IN_DIM, WIN_T, gt, nt);
        transpose_to_bf16(p.w_up_m, 512, 1024, WUPM_T, gt, nt);
        transpose_to_bf16(p.w_up_n, 512, 1024, WUPN_T, gt, nt);
        transpose_to_bf16(p.w_out, 1024, 1024, WOUT_T, gt, nt);
        transpose_to_bf16(p.peer_wq, 1024, 2048, PWQ_T, gt, nt);
        for (int h = 0; h < 4; ++h) {
            transpose_to_bf16(p.wq + (size_t)h * 16384, 128, 128, WQK_T + (size_t)(h * 256) * 128, gt, nt);
            transpose_to_bf16(p.wk + (size_t)h * 16384, 128, 128, WQK_T + (size_t)(h * 256 + 128) * 128, gt, nt);
        }
        for (size_t id = gt; id < (size_t)2 * 128 * 128; id += nt) {
            const int k8 = (int)(id & 127) * 8, np = (int)((id >> 7) & 127), c = (int)(id >> 14);
            const int pp = np >> 6, o = np & 63, r = k8 >> 6, d = k8 & 63;
            float f[8];
#pragma unroll
            for (int e = 0; e < 8; ++e) f[e] = p.cmp_w1[((size_t)c * 2048 + (pp * 16 + r) * 64 + d + e) * 64 + o];
            *(uint4*)(W1_T + ((size_t)c * 128 + np) * 1024 + k8) = pack8(f);
        }
        if (gt < 128) {
            const int c = (int)gt >> 6, o = (int)gt & 63;
            float a = 0.f;
            for (int k = 0; k < 2048; ++k) a += p.cmp_pe[c * 2048 + k] * p.cmp_w1[((size_t)c * 2048 + k) * 64 + o];
            ((float*)(p.ws + WS_PESUM))[gt] = a;
        }
        for (int c = 0; c < 2; ++c) transpose_to_bf16(p.cmp_w2 + (size_t)c * 4096, 64, 64, W2_T + (size_t)c * 4096, gt, nt);
        for (size_t id = gt; id < (size_t)2 * 128 * 128 / 8; id += nt) {
            float f[8];
#pragma unroll
            for (int i = 0; i < 8; ++i) f[i] = p.peer_sub[id * 8 + i];
            *(uint4*)(SUBK + id * 8) = pack8(f);
        }
        for (size_t id = gt; id < (size_t)16384 * 64; id += nt) {
            const float* su = p.peer_u + id * 16; const float* sv = p.peer_v + id * 16;
            uint4 ou, ov; unsigned* pu = (unsigned*)&ou; unsigned* pv = (unsigned*)&ov;
#pragma unroll
            for (int j = 0; j < 4; ++j) {
                const float4 a4 = *(const float4*)(su + j * 4), c4 = *(const float4*)(sv + j * 4);
                pu[j] = pack4_fp8(a4.x * PEER_U_SCALE, a4.y * PEER_U_SCALE, a4.z * PEER_U_SCALE, a4.w * PEER_U_SCALE);
                pv[j] = pack4_fp8(c4.x * PEER_V_SCALE, c4.y * PEER_V_SCALE, c4.z * PEER_V_SCALE, c4.w * PEER_V_SCALE);
            }
            *(uint4*)(p.ws + WS_U8 + id * 16) = ou; *(uint4*)(p.ws + WS_V8 + id * 16) = ov;
        }
        for (size_t i = gt; i < (size_t)BS * 511 * 256; i += nt) {
            const int j = (int)(i & 255); const int wv = (int)((i >> 8) % 511); const int b = (int)((i >> 8) / 511);
            p.out[O_WINS + ((size_t)b * 512 + wv) * 256 + j] = p.state_win[((size_t)b * 512 + wv + 1) * 256 + j];
        }
        for (size_t i = gt; i < (size_t)BS * 2 * 512; i += nt) {
            const int ch = (int)(i & 511); const int jj = (int)((i >> 9) & 1); const int b = (int)(i >> 10);
            p.out[O_CVS + ((size_t)b * 3 + jj) * 512 + ch] = p.state_conv[((size_t)b * 3 + jj + 1) * 512 + ch];
        }
    }
    xcd_barrier(bar);

    gemm_bf16<128>(NR, IN_DIM, 1024,
        [&](int r, int k) { return *(const uint4*)(XB + (size_t)r * 1024 + k); },
        [&](int n, int k) { return *(const uint4*)(WIN_T + (size_t)n * 1024 + k); },
        [&](int r, int c0, f32x4 v) {
            if (c0 >= C_I && c0 < C_Q) *(f32x4*)(Z + (size_t)r * 32 + (c0 - C_I)) = v;
            else if (c0 >= C_G && c0 < C_GM) *(f32x4*)(Z + (size_t)r * 32 + 8 + (c0 - C_G)) = v;
            store_bf16x4(ZB + (size_t)r * IN_DIM + c0, (c0 >= C_Q && c0 < C_KC) ? v * (0.125f * LOG2E) : v);
            if (r < NP && ((c0 >= C_KS + 128 && c0 < C_KW) || (c0 >= C_KW + 128 && c0 < C_G))) {
                const bool isw = c0 >= C_KW; const int cc = c0 - (isw ? C_KW : C_KS) - 128;
                bf16_t* vt = (isw ? VTW : VTS) + ((size_t)((r >> 11) * 2) * 64 + cc) * 2048 + (r & 2047);
                const unsigned w0 = cvt_pk_bf16(v[0], v[1]), w1 = cvt_pk_bf16(v[2], v[3]);
                vt[0] = (bf16_t)(w0 & 0xffffu); vt[2048] = (bf16_t)(w0 >> 16); vt[4096] = (bf16_t)(w1 & 0xffffu); vt[6144] = (bf16_t)(w1 >> 16);
            }
            if (r < NP && c0 >= C_V && c0 < C_O) {
                bf16_t* vt = (bf16_t*)(p.ws + WS_VTM) + ((size_t)(r >> 11) * 512 + (c0 - C_V)) * 2048 + (r & 2047);
                const unsigned w0 = cvt_pk_bf16(v[0], v[1]), w1 = cvt_pk_bf16(v[2], v[3]);
                vt[0] = (bf16_t)(w0 & 0xffffu); vt[2048] = (bf16_t)(w0 >> 16); vt[4096] = (bf16_t)(w1 & 0xffffu); vt[6144] = (bf16_t)(w1 >> 16);
            }
            if (c0 >= C_KC && c0 < C_KS) *(f32x4*)(p.out + O_CMPP + (size_t)r * 256 + (c0 - C_KC)) = v;
            else if (c0 >= C_KS && c0 < C_KW) *(f32x4*)(p.out + O_SLCP + (size_t)r * 256 + (c0 - C_KS)) = v;
            else if (c0 >= C_KW && c0 < C_G) {
                if (r < NP) { const int t = r & 2047; if (t >= 1536) *(f32x4*)(p.out + O_WINP + ((size_t)(r >> 11) * 512 + (t - 1536)) * 256 + (c0 - C_KW)) = v; }
                else *(f32x4*)(p.out + O_WINS + ((size_t)(r - NP) * 512 + 511) * 256 + (c0 - C_KW)) = v;
            } else if (c0 < C_V) {
                if (r < NP) { const int t = r & 2047; if (t >= 2045) *(f32x4*)(p.out + O_CVP + ((size_t)(r >> 11) * 3 + (t - 2045)) * 512 + c0) = v; }
                else *(f32x4*)(p.out + O_CVS + ((size_t)(r - NP) * 3 + 2) * 512 + c0) = v;
            }
        }, ldsb);
    xcd_barrier(bar);

    for (size_t i = gt; i < (size_t)NR * 512; i += nt) {
        const int ch = (int)(i & 511); const int r = (int)(i >> 9);
        float a = p.conv_b[ch];
        if (r < NP) {
            const int t = r & 2047;
#pragma unroll
            for (int j = 0; j < 4; ++j) if (t + j - 3 >= 0) a += p.conv_w[j * 512 + ch] * bf_lo((unsigned)ZB[(size_t)(r + j - 3) * IN_DIM + C_U + ch]);
        } else {
            const int b = r - NP;
#pragma unroll
            for (int j = 0; j < 3; ++j) a += p.conv_w[j * 512 + ch] * p.state_conv[((size_t)b * 3 + j) * 512 + ch];
            a += p.conv_w[3 * 512 + ch] * bf_lo((unsigned)ZB[(size_t)r * IN_DIM + C_U + ch]);
        }
        CONVB[i] = (bf16_t)(cvt_pk_bf16(a / (1.0f + expf(-a)), 0.f) & 0xffffu);
    }
    xcd_barrier(bar);

    for (int h = 0; h < 4; ++h) {
        gemm_bf16<128>(NR, 256, 128,
            [&](int r, int k) { return *(const uint4*)(CONVB + (size_t)r * 512 + h * 128 + k); },
            [&](int n, int k) { return *(const uint4*)(WQK_T + (size_t)(h * 256 + n) * 128 + k); },
            [&](int r, int c0, f32x4 v) {
                if (c0 >= 128) v = v * 0.08838834764831845f;
                if (c0 < 128) store_bf16x4((bf16_t*)(p.ws + WS_QB) + (size_t)r * 512 + h * 128 + c0, v);
                else {
                    store_bf16x4((bf16_t*)(p.ws + WS_KB) + (size_t)r * 512 + h * 128 + (c0 - 128), v);
                    if (r < NP) {
                        bf16_t* kt = (bf16_t*)(p.ws + WS_KTB) + ((size_t)((r >> 11) * 4 + h) * 128 + (c0 - 128)) * 2048 + (r & 2047);
                        const unsigned w0 = cvt_pk_bf16(v[0], v[1]), w1 = cvt_pk_bf16(v[2], v[3]);
                        kt[0] = (bf16_t)(w0 & 0xffffu); kt[2048] = (bf16_t)(w0 >> 16); kt[4096] = (bf16_t)(w1 & 0xffffu); kt[6144] = (bf16_t)(w1 >> 16);
                    }
                } }, ldsb, h * 514);
    }
    for (int c = 0; c < 2; ++c) {
        for (int grp = 0; grp < 2; ++grp) {
            const int TPB = grp ? 9 : 1, NCH = grp ? 1024 : 128, NBH = grp ? 64 : 32;
            gemm_bf16<128, true>(NBH * TPB * 128, 128, 1024,
                [&](int vrow, int k) {
                    const int tile = vrow >> 7, bh = tile / TPB, n_ = 127 * (tile % TPB) + (vrow & 127), n = n_ < NCH ? n_ : NCH - 1;
                    const int b = bh >> 1, hh = bh & 1, tok = 16 * n + (k >> 6), d0 = k & 63;
                    if (!grp) return *(const uint4*)(ZB + ((size_t)b * 2048 + tok) * IN_DIM + C_KC + c * 128 + hh * 64 + d0);
                    const int page = p.page_table[b * 128 + (tok >> 7)];
                    const float* sp = p.cache_cmp + ((size_t)page * 128 + (tok & 127)) * 256 + c * 128 + hh * 64 + d0;
                    const float4 a0 = *(const float4*)sp, a1 = *(const float4*)(sp + 4);
                    float f[8] = {a0.x, a0.y, a0.z, a0.w, a1.x, a1.y, a1.z, a1.w};
                    return pack8(f); },
                [&](int n, int k) { return *(const uint4*)(W1_T + ((size_t)c * 128 + n) * 1024 + k); },
                [&](f32x4 (&acc)[4][4], int bm) {
                    const int lr = lane & 15, lq = lane >> 4, wm = w >> 1, wn = w & 1;
                    const int tile = bm >> 7, bh = tile / TPB, n0 = 127 * (tile % TPB);
                    float* P1 = (float*)ldsb;
                    bf16_t* HL = (bf16_t*)(ldsb + 128 * 68 * 4);
                    __syncthreads();
                    if (wn == 1) {
#pragma unroll
                        for (int i = 0; i < 4; ++i)
#pragma unroll
                            for (int j = 0; j < 4; ++j) *(f32x4*)(P1 + (wm * 64 + i * 16 + lr) * 68 + j * 16 + lq * 4) = acc[i][j];
                    }
                    __syncthreads();
                    if (wn == 0) {
                        const float* pes = (const float*)(p.ws + WS_PESUM) + c * 64;
#pragma unroll
                        for (int i = 0; i < 4; ++i)
#pragma unroll
                            for (int j = 0; j < 4; ++j) {
                                const int rl = wm * 64 + i * 16 + lr, o0 = j * 16 + lq * 4;
                                const f32x4 nx = (rl < 127) ? *(const f32x4*)(P1 + (rl + 1) * 68 + o0) : (f32x4){0.f, 0.f, 0.f, 0.f};
                                const f32x4 pe4 = *(const f32x4*)(pes + o0);
                                f32x4 hv = acc[i][j] + nx + pe4;
                                hv[0] = gelu_tanh(hv[0]); hv[1] = gelu_tanh(hv[1]); hv[2] = gelu_tanh(hv[2]); hv[3] = gelu_tanh(hv[3]);
                                store_bf16x4(HL + rl * 72 + o0, hv);
                            }
                    }
                    __syncthreads();
                    f32x4 kc[2][4];
#pragma unroll
                    for (int i = 0; i < 2; ++i)
#pragma unroll
                        for (int j = 0; j < 4; ++j) kc[i][j] = (f32x4){0.f, 0.f, 0.f, 0.f};
#pragma unroll
                    for (int ks = 0; ks < 2; ++ks) {
                        bf16x8 hf[2], wf[4];
#pragma unroll
                        for (int i = 0; i < 2; ++i) hf[i] = *(const bf16x8*)(HL + (w * 32 + i * 16 + lr) * 72 + ks * 32 + lq * 8);
#pragma unroll
                        for (int j = 0; j < 4; ++j) wf[j] = *(const bf16x8*)(W2_T + ((size_t)c * 64 + j * 16 + lr) * 64 + ks * 32 + lq * 8);
#pragma unroll
                        for (int i = 0; i < 2; ++i)
#pragma unroll
                            for (int j = 0; j < 4; ++j) kc[i][j] = __builtin_amdgcn_mfma_f32_16x16x32_bf16(wf[j], hf[i], kc[i][j], 0, 0, 0);
                    }
#pragma unroll
                    for (int i = 0; i < 2; ++i) {
                        const int rl = w * 32 + i * 16 + lr, blk = n0 + rl;
                        if (rl < 127 && blk <= NCH - 2) {
#pragma unroll
                            for (int j = 0; j < 4; ++j) {
                                const int o2 = j * 16 + lq * 4;
                                if (c == 0) store_bf16x4((grp ? (bf16_t*)(p.ws + WS_KCSB) : KCB) + ((size_t)bh * NCH + blk) * 64 + o2, kc[i][j]);
                                else { bf16_t* vt = (grp ? (bf16_t*)(p.ws + WS_VTCS) : VTC) + ((size_t)bh * 64 + o2) * NCH + blk;
                                       const unsigned w0 = cvt_pk_bf16(kc[i][j][0], kc[i][j][1]), w1 = cvt_pk_bf16(kc[i][j][2], kc[i][j][3]);
                                       vt[0] = (bf16_t)(w0 & 0xffffu); vt[NCH] = (bf16_t)(w0 >> 16); vt[2 * NCH] = (bf16_t)(w1 & 0xffffu); vt[3 * NCH] = (bf16_t)(w1 >> 16); }
                            }
                        }
                    }
                    __syncthreads();
                }, ldsb, 4 * 514 + c * 608 + grp * 32);
        }
    }
    xcd_barrier(bar);

    for (;;) {
        __syncthreads();
        if (tid == 0) *(volatile int*)(ldsb + 32768) = (int)atomicAdd((unsigned*)(p.ws + WS_BAR) + 2, 1u);
        __syncthreads();
        const int idx = *(volatile int*)(ldsb + 32768);
        if (idx >= 448 + 2048) break;
        if (idx < 256) mlstm_chunk_item(p, idx, ldsb);
        else if (idx < 384) mlstm_scan_item(p, 64 + (idx - 256), lds);
        else if (idx < 448) nsa_sample_item(p, (idx - 384) >> 1, idx & 1, ldsb);
        else { const int i2 = idx - 448; nsa_prompt_item(p, (i2 & 31) >> 1, i2 & 1, 63 - (i2 >> 5), ldsb); }
    }
    xcd_barrier(bar);

    for (int it = gw; it < NR * 4; it += nw) {
        const int row = it >> 2, h = it & 3;
        const float x0 = HRAW[(size_t)row * 512 + h * 128 + lane], x1 = HRAW[(size_t)row * 512 + h * 128 + 64 + lane];
        const float mu = wave_sum(x0 + x1) * (1.0f / 128.0f);
        const float d0 = x0 - mu, d1 = x1 - mu;
        const float var = wave_sum(d0 * d0 + d1 * d1) * (1.0f / 128.0f);
        const float rstd = 1.0f / sqrtf(var + LN_EPS);
        const int c0 = h * 128 + lane, c1 = c0 + 64;
        MOUTB[(size_t)row * 512 + c0] = (bf16_t)(cvt_pk_bf16(sigmoidf_(bf_lo((unsigned)ZB[(size_t)row * IN_DIM + C_O + c0])) * (d0 * rstd * p.norm_g[c0]), 0.f) & 0xffffu);
        MOUTB[(size_t)row * 512 + c1] = (bf16_t)(cvt_pk_bf16(sigmoidf_(bf_lo((unsigned)ZB[(size_t)row * IN_DIM + C_O + c1])) * (d1 * rstd * p.norm_g[c1]), 0.f) & 0xffffu);
    }
    xcd_barrier(bar);

    gemm_bf16<128>(NR, 1024, 512,
        [&](int r, int k) { return *(const uint4*)(MOUTB + (size_t)r * 512 + k); },
        [&](int n, int k) { return *(const uint4*)(WUPM_T + (size_t)n * 512 + k); },
        [&](int r, int c0, f32x4 v) {
            const uint2 gw2 = *(const uint2*)(ZB + (size_t)r * IN_DIM + C_GM + c0); const f32x4 g = {bf_lo(gw2.x), bf_hi(gw2.x), bf_lo(gw2.y), bf_hi(gw2.y)};
            f32x4 o; o[0] = sigmoidf_(g[0]) * v[0]; o[1] = sigmoidf_(g[1]) * v[1]; o[2] = sigmoidf_(g[2]) * v[2]; o[3] = sigmoidf_(g[3]) * v[3];
            *(f32x4*)(MIX + (size_t)r * 1024 + c0) = o; }, ldsb);
    gemm_bf16<128>(NR, 1024, 512,
        [&](int r, int k) { return *(const uint4*)(NOUTB + (size_t)r * 512 + k); },
        [&](int n, int k) { return *(const uint4*)(WUPN_T + (size_t)n * 512 + k); },
        [&](int r, int c0, f32x4 v) {
            const uint2 gw2 = *(const uint2*)(ZB + (size_t)r * IN_DIM + C_GN + c0); const f32x4 g = {bf_lo(gw2.x), bf_hi(gw2.x), bf_lo(gw2.y), bf_hi(gw2.y)};
            f32x4 o = *(const f32x4*)(MIX + (size_t)r * 1024 + c0);
            o[0] += sigmoidf_(g[0]) * v[0]; o[1] += sigmoidf_(g[1]) * v[1]; o[2] += sigmoidf_(g[2]) * v[2]; o[3] += sigmoidf_(g[3]) * v[3];
            store_bf16x4(MIXB + (size_t)r * 1024 + c0, o); }, ldsb);
    xcd_barrier(bar);

    gemm_bf16<128>(NR, 1024, 1024,
        [&](int r, int k) { return *(const uint4*)(MIXB + (size_t)r * 1024 + k); },
        [&](int n, int k) { return *(const uint4*)(WOUT_T + (size_t)n * 1024 + k); },
        [&](int r, int c0, f32x4 v) {
            const f32x4 xv = *(const f32x4*)((r < NP ? p.x_prompt + (size_t)r * 1024 : p.x_sample + (size_t)(r - NP) * 1024) + c0);
            *(f32x4*)(T1 + (size_t)r * 1024 + c0) = xv * DN_ALPHA + v; }, ldsb);
    xcd_barrier(bar);

    for (int row = gw; row < NR; row += nw) {
        float tv[16]; float s = 0.f;
#pragma unroll
        for (int j = 0; j < 4; ++j) { const float4 t4 = *(const float4*)(T1 + (size_t)row * 1024 + j * 256 + lane * 4); tv[4 * j] = t4.x; tv[4 * j + 1] = t4.y; tv[4 * j + 2] = t4.z; tv[4 * j + 3] = t4.w; s += (t4.x + t4.y) + (t4.z + t4.w); }
        const float mu = wave_sum(s) * (1.0f / 1024.0f);
        float q = 0.f;
#pragma unroll
        for (int j = 0; j < 16; ++j) { const float d = tv[j] - mu; q += d * d; }
        const float rstd = 1.0f / sqrtf(wave_sum(q) * (1.0f / 1024.0f) + LN_EPS);
#pragma unroll
        for (int j = 0; j < 4; ++j) {
            const int c = j * 256 + lane * 4;
            const float4 g4 = *(const float4*)(p.ln1_g + c), b4 = *(const float4*)(p.ln1_b + c);
            f32x4 o; o[0] = (tv[4 * j] - mu) * rstd * g4.x + b4.x; o[1] = (tv[4 * j + 1] - mu) * rstd * g4.y + b4.y; o[2] = (tv[4 * j + 2] - mu) * rstd * g4.z + b4.z; o[3] = (tv[4 * j + 3] - mu) * rstd * g4.w + b4.w;
            *(f32x4*)(X1 + (size_t)row * 1024 + c) = o;
            store_bf16x4(X1B + (size_t)row * 1024 + c, o);
        }
    }
    xcd_barrier(bar);

    gemm_bf16<128>(NR, 2048, 1024,
        [&](int r, int k) { return *(const uint4*)(X1B + (size_t)r * 1024 + k); },
        [&](int n, int k) { return *(const uint4*)(PWQ_T + (size_t)n * 1024 + k); },
        [&](int r, int c0, f32x4 v) { store_bf16x4(QPB + (size_t)r * 2048 + c0, v); }, ldsb);
    xcd_barrier(bar);

    for (int it = blockIdx.x; it < 513 * 8; it += gridDim.x) { __syncthreads(); peer_score_topk_item(p, it >> 3, it & 7, ldsb); }
    xcd_barrier(bar);

    for (int row = gw; row < NR; row += nw) peer_expert_wave(p, row, ldsb + w * 3072, lane);
}

extern "C" void kernel_launch(void* const* d_in, const int* in_sizes, int n_in, void* d_out, int out_size, void* d_ws, size_t ws_size, hipStream_t stream) {
    static int grid = 0;
    if (grid == 0) {
        if (n_in != 32 || (size_t)out_size != O_END || ws_size < WS_END) {
            fprintf(stderr, "kernel_launch: unexpected sizes n_in %d out %d ws %zu (need %zu)\n", n_in, out_size, ws_size, (size_t)WS_END); grid = -1; return; }
        int dev = 0, cus = 0, per_cu = 0;
        if (hipGetDevice(&dev) != hipSuccess || hipDeviceGetAttribute(&cus, hipDeviceAttributeMultiprocessorCount, dev) != hipSuccess) { grid = -1; return; }
        if (hipFuncSetAttribute((const void*)fwd_kernel, hipFuncAttributeMaxDynamicSharedMemorySize, LDS_BYTES) != hipSuccess) { fprintf(stderr, "hipFuncSetAttribute failed\n"); grid = -1; return; }
        if (hipOccupancyMaxActiveBlocksPerMultiprocessor(&per_cu, (const void*)fwd_kernel, NTHREADS, LDS_BYTES) != hipSuccess || per_cu < 1) { fprintf(stderr, "occupancy query failed (%d)\n", per_cu); (void)hipGetLastError(); per_cu = 1; }
        if (per_cu > 2) per_cu = 2;
        grid = cus * per_cu;
    }
    if (grid < 0) return;
    (void)hipMemsetAsync((char*)d_ws + WS_BAR, 0, XCD_BAR_WORDS * sizeof(unsigned), stream);
    Params p{};
    p.x_prompt = (const float*)d_in[0]; p.x_sample = (const float*)d_in[1]; p.cache_cmp = (const float*)d_in[2]; p.cache_slc = (const float*)d_in[3];
    p.page_table = (const int*)d_in[4]; p.state_win = (const float*)d_in[5]; p.state_C = (const float*)d_in[6]; p.state_n = (const float*)d_in[7];
    p.state_m = (const float*)d_in[8]; p.state_conv = (const float*)d_in[9]; p.w_in = (const float*)d_in[10]; p.conv_w = (const float*)d_in[11];
    p.conv_b = (const float*)d_in[12]; p.wq = (const float*)d_in[13]; p.wk = (const float*)d_in[14]; p.gate_bias = (const float*)d_in[15];
    p.norm_g = (const float*)d_in[16]; p.cmp_pe = (const float*)d_in[17]; p.cmp_w1 = (const float*)d_in[18]; p.cmp_w2 = (const float*)d_in[19];
    p.rel_bias = (const float*)d_in[20]; p.w_up_m = (const float*)d_in[21]; p.w_up_n = (const float*)d_in[22]; p.w_out = (const float*)d_in[23];
    p.ln1_g = (const float*)d_in[24]; p.ln1_b = (const float*)d_in[25]; p.ln2_g = (const float*)d_in[26]; p.ln2_b = (const float*)d_in[27];
    p.peer_wq = (const float*)d_in[28]; p.peer_sub = (const float*)d_in[29]; p.peer_u = (const float*)d_in[30]; p.peer_v = (const float*)d_in[31];
    p.out = (float*)d_out; p.ws = (unsigned char*)d_ws;
    hipLaunchKernelGGL(fwd_kernel, dim3(grid), dim3(NTHREADS), LDS_BYTES, stream, p);
}
```

```cpp
#include <hip/hip_runtime.h>
#include <stdint.h>
#include <cstdio>

#define DEV __device__ __forceinline__

constexpr int DM = 1024;
constexpr int BP = 16, TP = 2048, BS = 32;
constexpr int NP = BP * TP;
constexpr int NR = NP + BS;
constexpr int MP = 32896;
constexpr int IN_DIM = 4896;
constexpr int C_U = 0, C_V = 512, C_O = 1024, C_I = 1536, C_F = 1540, C_Q = 1544, C_KC = 2056, C_KS = 2312, C_KW = 2568, C_G = 2824, C_GM = 2848, C_GN = 3872;
constexpr int PAST = 16384;
constexpr float NEGF = -1e30f;
constexpr float DN_ALPHA = 1.189207115002721f;
constexpr float LN_EPS = 1e-5f;
constexpr float LOG2E = 1.4426950408889634f;

constexpr size_t O_Y = 0;
constexpr size_t O_CMPP = (size_t)NR * DM;
constexpr size_t O_CMPS = O_CMPP + (size_t)NP * 256;
constexpr size_t O_SLCP = O_CMPS + (size_t)BS * 256;
constexpr size_t O_SLCS = O_SLCP + (size_t)NP * 256;
constexpr size_t O_WINP = O_SLCS + (size_t)BS * 256;
constexpr size_t O_WINS = O_WINP + (size_t)BP * 512 * 256;
constexpr size_t O_CP = O_WINS + (size_t)BS * 512 * 256;
constexpr size_t O_CS = O_CP + (size_t)BP * 4 * 128 * 128;
constexpr size_t O_NP = O_CS + (size_t)BS * 4 * 128 * 128;
constexpr size_t O_NS = O_NP + (size_t)BP * 4 * 128;
constexpr size_t O_MP = O_NS + (size_t)BS * 4 * 128;
constexpr size_t O_MS = O_MP + (size_t)BP * 4;
constexpr size_t O_CVP = O_MS + (size_t)BS * 4;
constexpr size_t O_CVS = O_CVP + (size_t)BP * 3 * 512;
constexpr size_t O_END = O_CVS + (size_t)BS * 3 * 512;
static_assert(O_END == 59916480, "output size");

constexpr size_t al256(size_t x) { return (x + 255) & ~(size_t)255; }
constexpr size_t WS_BAR = 0;
constexpr size_t WS_Z = 16384;
constexpr size_t WS_QK = al256(WS_Z + (size_t)MP * 32 * 4);
constexpr size_t WS_HRAW = al256(WS_QK + 256);
constexpr size_t WS_MOUTB = al256(WS_HRAW + (size_t)MP * 512 * 4);
constexpr size_t WS_NOUTB = al256(WS_MOUTB + (size_t)MP * 512 * 2);
constexpr size_t WS_HIDPB = al256(WS_NOUTB + (size_t)MP * 512 * 2);
constexpr size_t WS_KCP = al256(WS_HIDPB + (size_t)2 * 4096 * 64 * 2);
constexpr size_t WS_HIDSB = al256(WS_KCP + 256);
constexpr size_t WS_KCS = al256(WS_HIDSB + (size_t)2 * 65536 * 64 * 2);
constexpr size_t WS_MIX = al256(WS_KCS + (size_t)2 * 65536 * 64 * 4);
constexpr size_t WS_MIXB = al256(WS_MIX + (size_t)MP * 1024 * 4);
constexpr size_t WS_T1 = al256(WS_MIXB + (size_t)MP * 1024 * 2);
constexpr size_t WS_X1 = al256(WS_T1 + (size_t)MP * 1024 * 4);
constexpr size_t WS_X1B = al256(WS_X1 + (size_t)MP * 1024 * 4);
constexpr size_t WS_QPB = al256(WS_X1B + (size_t)MP * 1024 * 2);
constexpr size_t WS_S = al256(WS_QPB + (size_t)MP * 2048 * 2);
constexpr size_t WS_PIDX = al256(WS_S + (size_t)MP * 2048 * 4);
constexpr size_t WS_PG = al256(WS_PIDX + (size_t)MP * 128 * 4);
constexpr size_t WS_CONVB = al256(WS_PG + (size_t)MP * 128 * 4);
constexpr size_t WS_XB = al256(WS_CONVB + (size_t)MP * 512 * 2);
constexpr size_t WS_WIN_T = al256(WS_XB + (size_t)MP * 1024 * 2);
constexpr size_t WS_WUPM_T = al256(WS_WIN_T + (size_t)IN_DIM * 1024 * 2);
constexpr size_t WS_WUPN_T = al256(WS_WUPM_T + (size_t)1024 * 512 * 2);
constexpr size_t WS_WOUT_T = al256(WS_WUPN_T + (size_t)1024 * 512 * 2);
constexpr size_t WS_PWQ_T = al256(WS_WOUT_T + (size_t)1024 * 1024 * 2);
constexpr size_t WS_WQK_T = al256(WS_PWQ_T + (size_t)2048 * 1024 * 2);
constexpr size_t WS_W1_T = al256(WS_WQK_T + (size_t)4 * 256 * 128 * 2);
constexpr size_t WS_PESUM = al256(WS_W1_T + (size_t)2 * 128 * 1024 * 2);
constexpr size_t WS_W2_T = al256(WS_PESUM + 512);
constexpr size_t WS_SUBK = al256(WS_W2_T + (size_t)2 * 64 * 64 * 2);
constexpr size_t WS_ZB = al256(WS_SUBK + (size_t)2 * 128 * 128 * 2);
constexpr size_t WS_VTS = al256(WS_ZB + (size_t)MP * IN_DIM * 2);
constexpr size_t WS_VTW = al256(WS_VTS + (size_t)16 * 2 * 64 * 2048 * 2);
constexpr size_t WS_KCB = al256(WS_VTW + (size_t)16 * 2 * 64 * 2048 * 2);
constexpr size_t WS_VTC = al256(WS_KCB + (size_t)16 * 2 * 128 * 64 * 2);
constexpr size_t WS_NOUTF = al256(WS_VTC + (size_t)16 * 2 * 64 * 128 * 2);
constexpr size_t WS_U8 = al256(WS_NOUTF + (size_t)NP * 512 * 4);
constexpr size_t WS_V8 = al256(WS_U8 + (size_t)16384 * 1024);
constexpr size_t WS_QB = al256(WS_V8 + (size_t)16384 * 1024);
constexpr size_t WS_KB = al256(WS_QB + (size_t)MP * 512 * 2);
constexpr size_t WS_KTB = al256(WS_KB + (size_t)MP * 512 * 2);
constexpr size_t WS_VTM = al256(WS_KTB + (size_t)16 * 512 * 2048 * 2);
constexpr size_t WS_KCSB = al256(WS_VTM + (size_t)16 * 512 * 2048 * 2);
constexpr size_t WS_VTCS = al256(WS_KCSB + (size_t)32 * 2 * 1024 * 64 * 2);
constexpr size_t WS_END = al256(WS_VTCS + (size_t)32 * 2 * 64 * 1024 * 2);

static_assert(WS_END <= 2684354560ull, "workspace too large");
constexpr int LDS_BYTES = 73728;
constexpr int NTHREADS = 256;

struct Params {
    const float* x_prompt; const float* x_sample; const float* cache_cmp; const float* cache_slc; const int* page_table;
    const float* state_win; const float* state_C; const float* state_n; const float* state_m; const float* state_conv;
    const float* w_in; const float* conv_w; const float* conv_b; const float* wq; const float* wk; const float* gate_bias; const float* norm_g;
    const float* cmp_pe; const float* cmp_w1; const float* cmp_w2; const float* rel_bias; const float* w_up_m; const float* w_up_n; const float* w_out;
    const float* ln1_g; const float* ln1_b; const float* ln2_g; const float* ln2_b; const float* peer_wq; const float* peer_sub; const float* peer_u; const float* peer_v;
    float* out; unsigned char* ws;
};

#define XB_TMO      128
#define XB_XCNT(j)  (256  + 64 * (j))
#define XB_XSUB(j)  (1280 + 64 * (j))
#define XB_XGEN(j)  (2304 + 64 * (j))
#define XB_TOP      3328
#define XB_TOPGEN   3392
#define XCD_BAR_WORDS 3456
#define XB_SPIN_CAP (1u << 22)
#define LAS __attribute__((address_space(3)))

__device__ __forceinline__ unsigned xb_ld(unsigned* p)              { return __hip_atomic_load(p, __ATOMIC_RELAXED, __HIP_MEMORY_SCOPE_AGENT); }
__device__ __forceinline__ unsigned xb_add(unsigned* p, unsigned v) { return __hip_atomic_fetch_add(p, v, __ATOMIC_RELAXED, __HIP_MEMORY_SCOPE_AGENT); }
__device__ __forceinline__ unsigned xb_xcc_id() { return (unsigned)__builtin_amdgcn_s_getreg((3 << 11) | 20) & 0xFu; }
#define XB_SPIN(cond, bar) do { unsigned _sp = 0; while (cond) { __builtin_amdgcn_s_sleep(1); \
    if ((++_sp & 255u) == 0u) { if (xb_ld(&(bar)[XB_TMO])) break; if (_sp > XB_SPIN_CAP) { atomicAdd(&(bar)[XB_TMO], 1u); break; } } } } while (0)

struct XcdBarrier { unsigned* bar; unsigned x; volatile LAS unsigned* st; };

__device__ __forceinline__ XcdBarrier xcd_barrier_post(unsigned* bar, volatile LAS unsigned* st) {
    XcdBarrier b; b.bar = bar; b.x = xb_xcc_id(); b.st = st;
    if (threadIdx.x == 0) (void)xb_add(&bar[XB_XCNT(b.x)], 1u);
    return b;
}
__device__ __forceinline__ void xcd_barrier_complete(unsigned* bar, unsigned x, unsigned& nloc, unsigned& nx) {
    const unsigned G = gridDim.x * gridDim.y * gridDim.z;
    unsigned sum, cnt, mine, sp = 0u;
    for (;;) {
        sum = 0u; cnt = 0u; mine = 0u;
#pragma unroll
        for (unsigned j = 0; j < 16; ++j) { const unsigned c = xb_ld(&bar[XB_XCNT(j)]); sum += c; cnt += (c > 0u) ? 1u : 0u; mine = (j == x) ? c : mine; }
        if (sum == G) break;
        __builtin_amdgcn_s_sleep(1);
        if ((++sp & 255u) == 0u) { if (xb_ld(&bar[XB_TMO])) break; if (sp > XB_SPIN_CAP) { atomicAdd(&bar[XB_TMO], 1u); break; } }
    }
    nloc = mine > 0u ? mine : 1u; nx = cnt > 0u ? cnt : 1u;
}
__device__ __forceinline__ void xcd_barrier(const XcdBarrier& b) {
    asm volatile("s_waitcnt vmcnt(0)" ::: "memory");
    __syncthreads();
    if (threadIdx.x == 0) {
        unsigned* bar = b.bar;
        __builtin_amdgcn_s_waitcnt(0);
        unsigned nloc = b.st[0], nx = b.st[1];
        if (nloc == 0u) { xcd_barrier_complete(bar, b.x, nloc, nx); b.st[0] = nloc; b.st[1] = nx; }
        const unsigned old = xb_add(&bar[XB_XSUB(b.x)], 1u);
        const unsigned gen = old / nloc;
        if (old + 1u == (gen + 1u) * nloc) {
            __builtin_amdgcn_fence(__ATOMIC_RELEASE, "agent");
            asm volatile("s_waitcnt vmcnt(0)" ::: "memory");
            const unsigned og = xb_add(&bar[XB_TOP], 1u);
            const unsigned tg = og / nx;
            if (og + 1u == (tg + 1u) * nx) xb_add(&bar[XB_TOPGEN], 1u);
            else XB_SPIN(xb_ld(&bar[XB_TOPGEN]) == tg, bar);
            __builtin_amdgcn_fence(__ATOMIC_ACQUIRE, "agent");
            xb_add(&bar[XB_XGEN(b.x)], 1u);
            asm volatile("s_waitcnt vmcnt(0)" ::: "memory");
        } else {
            XB_SPIN(xb_ld(&bar[XB_XGEN(b.x)]) == gen, bar);
            __builtin_amdgcn_fence(__ATOMIC_ACQUIRE, "agent");
            asm volatile("s_waitcnt vmcnt(0)" ::: "memory");
        }
    }
    __syncthreads();
}

typedef float f32x4 __attribute__((ext_vector_type(4)));

__device__ const unsigned char REL_LUT[128] = {
    0, 1, 2, 3, 4, 5, 6, 7, 8, 9, 10, 11, 12, 13, 14, 15, 16, 16, 16, 17, 17, 18, 18, 18, 19, 19, 19, 20, 20, 20, 20, 21, 21, 21, 21, 22, 22, 22, 22, 22,
    23, 23, 23, 23, 23, 23, 24, 24, 24, 24, 24, 24, 25, 25, 25, 25, 25, 25, 25, 26, 26, 26, 26, 26, 26, 26, 26, 27, 27, 27, 27, 27, 27, 27, 27, 27, 27,
    28, 28, 28, 28, 28, 28, 28, 28, 28, 28, 29, 29, 29, 29, 29, 29, 29, 29, 29, 29, 29, 29, 30, 30, 30, 30, 30, 30, 30, 30, 30, 30, 30, 30, 30, 30,
    31, 31, 31, 31, 31, 31, 31, 31, 31, 31, 31, 31, 31, 31, 31};
DEV int rel_bucket(int n) { return n < 128 ? (int)REL_LUT[n < 0 ? 0 : n] : 31; }

DEV float sigmoidf_(float x) { return 1.0f / (1.0f + expf(-x)); }
DEV float gelu_tanh(float x) { return 0.5f * x * (1.0f + tanhf(0.7978845608028654f * (x + 0.044715f * x * x * x))); }
DEV float log_sigmoid(float x) { return x >= 0.f ? -log1pf(expf(-x)) : x - log1pf(expf(x)); }
DEV void wave_sync() { asm volatile("s_waitcnt lgkmcnt(0)" ::: "memory"); __builtin_amdgcn_wave_barrier(); asm volatile("" ::: "memory"); }
DEV float wave_sum(float v) {
#pragma unroll
    for (int o = 32; o >= 1; o >>= 1) v += __shfl_xor(v, o);
    return v;
}
DEV float wave_max(float v) {
#pragma unroll
    for (int o = 32; o >= 1; o >>= 1) v = fmaxf(v, __shfl_xor(v, o));
    return v;
}

typedef unsigned short bf16_t;
typedef short bf16x8 __attribute__((ext_vector_type(8)));
typedef float f32x2_ __attribute__((ext_vector_type(2)));
typedef __bf16 bf16x2_ __attribute__((ext_vector_type(2)));
DEV unsigned cvt_pk_bf16(float lo, float hi) { const f32x2_ v = {lo, hi}; return __builtin_bit_cast(unsigned, __builtin_convertvector(v, bf16x2_)); }
DEV float bf_lo(unsigned w) { return __uint_as_float(w << 16); }
DEV float bf_hi(unsigned w) { return __uint_as_float(w & 0xffff0000u); }
DEV uint4 pack8(const float* f) { uint4 r; r.x = cvt_pk_bf16(f[0], f[1]); r.y = cvt_pk_bf16(f[2], f[3]); r.z = cvt_pk_bf16(f[4], f[5]); r.w = cvt_pk_bf16(f[6], f[7]); return r; }
DEV void store_bf16x4(bf16_t* p, f32x4 v) { uint2 w; w.x = cvt_pk_bf16(v[0], v[1]); w.y = cvt_pk_bf16(v[2], v[3]); *(uint2*)p = w; }

DEV void transpose_to_bf16(const float* __restrict__ src, const int K, const int N, bf16_t* __restrict__ dst, const size_t gt, const size_t nt) {
    const size_t items = (size_t)N * (K >> 3);
    for (size_t id = gt; id < items; id += nt) {
        const int n = (int)(id % N), k8 = (int)(id / N) * 8;
        float f[8];
#pragma unroll
        for (int i = 0; i < 8; ++i) f[i] = src[(size_t)(k8 + i) * N + n];
        *(uint4*)(dst + (size_t)n * K + k8) = pack8(f);
    }
}

template <int BN, bool TILE_EPI = false, class LA, class LB, class EF>
DEV void gemm_bf16(const int M, const int N, const int K, LA la, LB lb, EF ef, unsigned char* lds, const int toff = 0) {
    constexpr int TJ = BN / 32;
    constexpr int NB = BN / 32;
    constexpr int LDR = 144;
    const int tid = threadIdx.x, lane = tid & 63, w = tid >> 6, wm = w >> 1, wn = w & 1;
    const int tm = (M + 127) >> 7, tn = (N + BN - 1) / BN;
    unsigned char* As = lds;
    unsigned char* Bs = lds + 128 * LDR;
    const int lr = lane & 15, lq = lane >> 4;
    for (int tile = (int)((blockIdx.x + gridDim.x - (unsigned)toff % gridDim.x) % gridDim.x); tile < tm * tn; tile += gridDim.x) {
        const int bm = (tile / tn) * 128, bn = (tile % tn) * BN;
        f32x4 acc[4][TJ];
#pragma unroll
        for (int i = 0; i < 4; ++i)
#pragma unroll
            for (int j = 0; j < TJ; ++j) acc[i][j] = (f32x4){0.f, 0.f, 0.f, 0.f};
        uint4 ra[4], rb[NB];
        int arow[4], brow[NB];
#pragma unroll
        for (int i = 0; i < 4; ++i) { const int r = bm + ((tid + 256 * i) >> 3); arow[i] = r < M ? r : M - 1; }
#pragma unroll
        for (int i = 0; i < NB; ++i) { const int n = bn + ((tid + 256 * i) >> 3); brow[i] = n < N ? n : N - 1; }
        const int kc = (tid & 7) * 8;
#pragma unroll
        for (int i = 0; i < 4; ++i) ra[i] = la(arow[i], kc);
#pragma unroll
        for (int i = 0; i < NB; ++i) rb[i] = lb(brow[i], kc);
        for (int k0_ = 0; k0_ < K; k0_ += 64) {
            int k0 = k0_; asm volatile("" : "+v"(k0));
            __syncthreads();
#pragma unroll
            for (int i = 0; i < 4; ++i) *(uint4*)(As + ((tid + 256 * i) >> 3) * LDR + (tid & 7) * 16) = ra[i];
#pragma unroll
            for (int i = 0; i < NB; ++i) *(uint4*)(Bs + ((tid + 256 * i) >> 3) * LDR + (tid & 7) * 16) = rb[i];
            __syncthreads();
            if (k0_ + 64 < K) {
#pragma unroll
                for (int i = 0; i < 4; ++i) ra[i] = la(arow[i], k0 + 64 + kc);
#pragma unroll
                for (int i = 0; i < NB; ++i) rb[i] = lb(brow[i], k0 + 64 + kc);
            }
#pragma unroll
            for (int kk = 0; kk < 2; ++kk) {
                bf16x8 a[4], b[TJ];
#pragma unroll
                for (int i = 0; i < 4; ++i) a[i] = *(const bf16x8*)(As + (wm * 64 + i * 16 + lr) * LDR + kk * 64 + lq * 16);
#pragma unroll
                for (int j = 0; j < TJ; ++j) b[j] = *(const bf16x8*)(Bs + (wn * (BN / 2) + j * 16 + lr) * LDR + kk * 64 + lq * 16);
#pragma unroll
                for (int i = 0; i < 4; ++i)
#pragma unroll
                    for (int j = 0; j < TJ; ++j) acc[i][j] = __builtin_amdgcn_mfma_f32_16x16x32_bf16(b[j], a[i], acc[i][j], 0, 0, 0);
            }
        }
        if constexpr (TILE_EPI) { ef(acc, bm); }
        else {
#pragma unroll
            for (int i = 0; i < 4; ++i)
#pragma unroll
                for (int j = 0; j < TJ; ++j) {
                    const int r = bm + wm * 64 + i * 16 + lr, c0 = bn + wn * (BN / 2) + j * 16 + lq * 4;
                    if (r < M && c0 < N) ef(r, c0, acc[i][j]);
                }
        }
    }
}

DEV int lds_byte2(int r, int c) { const int st = (r >> 4) * 2 + (c >> 5), ob = (r & 15) * 64 + (c & 31) * 2; return st * 1024 + (ob ^ (((ob >> 9) & 1) << 5)); }
DEV void stage_rc2(int b, int& R, int& C) { const int st = b >> 10, sb = b & 1023, swz = sb ^ (((sb >> 9) & 1) << 5); R = (st >> 1) * 16 + swz / 64; C = (st & 1) * 32 + (swz % 64) / 2; }
template <class PA, class PB, class EF>
DEV void gemm_glds(const int M, const int N, const int K, PA pa, PB pb, EF ef, unsigned char* lds, const int toff = 0) {
    const int tid = threadIdx.x, lane = tid & 63, w = tid >> 6, wm = w >> 1, wn = w & 1;
    const int tm = (M + 127) >> 7, tn = (N + 127) >> 7;
    const int lr = lane & 15, lq = lane >> 4;
    const int nk = K >> 6;
    int sR[4], sC[4];
#pragma unroll
    for (int i = 0; i < 4; ++i) stage_rc2((w + 4 * i) * 1024 + lane * 16, sR[i], sC[i]);
    for (int tile = (int)((blockIdx.x + gridDim.x - (unsigned)toff % gridDim.x) % gridDim.x); tile < tm * tn; tile += gridDim.x) {
        const int bm = (tile / tn) * 128, bn = (tile % tn) * 128;
        f32x4 acc[4][4];
#pragma unroll
        for (int i = 0; i < 4; ++i)
#pragma unroll
            for (int j = 0; j < 4; ++j) acc[i][j] = (f32x4){0.f, 0.f, 0.f, 0.f};
        int arow[4], brow[4];
#pragma unroll
        for (int i = 0; i < 4; ++i) { const int r = bm + sR[i], n = bn + sR[i]; arow[i] = r < M ? r : M - 1; brow[i] = n < N ? n : N - 1; }
#define GLDS_STAGE(BUF, KT) { _Pragma("unroll") for (int i = 0; i < 4; ++i) { \
            __builtin_amdgcn_global_load_lds((const unsigned*)pa(arow[i], (KT) * 64 + sC[i]), (LAS unsigned*)(lds + (BUF) * 32768 + (w + 4 * i) * 1024), 16, 0, 0); \
            __builtin_amdgcn_global_load_lds((const unsigned*)pb(brow[i], (KT) * 64 + sC[i]), (LAS unsigned*)(lds + (BUF) * 32768 + 16384 + (w + 4 * i) * 1024), 16, 0, 0); } }
        __syncthreads();
        GLDS_STAGE(0, 0)
        asm volatile("s_waitcnt vmcnt(0)" ::: "memory");
        __syncthreads();
        for (int kt = 0; kt < nk; ++kt) {
            const int cur = kt & 1;
            if (kt + 1 < nk) GLDS_STAGE(cur ^ 1, kt + 1)
            const unsigned char* SA = lds + cur * 32768;
            const unsigned char* SB = SA + 16384;
#pragma unroll
            for (int kk = 0; kk < 2; ++kk) {
                bf16x8 a[4], b[4];
#pragma unroll
                for (int i = 0; i < 4; ++i) a[i] = *(const bf16x8*)(SA + lds_byte2(wm * 64 + i * 16 + lr, kk * 32 + lq * 8));
#pragma unroll
                for (int j = 0; j < 4; ++j) b[j] = *(const bf16x8*)(SB + lds_byte2(wn * 64 + j * 16 + lr, kk * 32 + lq * 8));
#pragma unroll
                for (int i = 0; i < 4; ++i)
#pragma unroll
                    for (int j = 0; j < 4; ++j) acc[i][j] = __builtin_amdgcn_mfma_f32_16x16x32_bf16(b[j], a[i], acc[i][j], 0, 0, 0);
            }
            asm volatile("s_waitcnt vmcnt(0)" ::: "memory");
            __syncthreads();
        }
#undef GLDS_STAGE
#pragma unroll
        for (int i = 0; i < 4; ++i)
#pragma unroll
            for (int j = 0; j < 4; ++j) {
                const int r = bm + wm * 64 + i * 16 + lr, c0 = bn + wn * 64 + j * 16 + lq * 4;
                if (r < M && c0 < N) ef(r, c0, acc[i][j]);
            }
    }
}

DEV void mlstm_scan_item(const Params& p, const int item, float* lds) {
    const int tid = threadIdx.x, v = tid >> 1, kh = tid & 1;
    const int seq = item >> 2, h = item & 3;
    const bool pr = seq < 16; const int b = pr ? seq : seq - 16;
    const int T = pr ? 2048 : 1; const int row0 = pr ? b * 2048 : NP + b;
    const float* Z = (const float*)(p.ws + WS_Z);
    const bf16_t* QBp = (const bf16_t*)(p.ws + WS_QB); const bf16_t* KBp = (const bf16_t*)(p.ws + WS_KB); const bf16_t* ZBp = (const bf16_t*)(p.ws + WS_ZB);
    float* HRAW = (float*)(p.ws + WS_HRAW);
    float C[64], n[64]; float m;
    if (pr) {
#pragma unroll
        for (int j = 0; j < 64; ++j) { C[j] = 0.f; n[j] = 0.f; }
        m = 0.f;
    } else {
        const float* c0 = p.state_C + (((size_t)(b * 4 + h) * 128 + v) * 128 + kh * 64);
        const float* n0 = p.state_n + ((size_t)(b * 4 + h) * 128 + kh * 64);
#pragma unroll
        for (int j = 0; j < 64; ++j) { C[j] = c0[j]; n[j] = n0[j]; }
        m = p.state_m[b * 4 + h];
    }
    const float gb_i = p.gate_bias[h], gb_f = p.gate_bias[4 + h];
    auto load_tok = [&](int t, float* dst) {
        const size_t r = (size_t)(row0 + t);
        dst[tid] = bf_lo((unsigned)(tid < 128 ? QBp[r * 512 + h * 128 + tid] : KBp[r * 512 + h * 128 + tid - 128]));
        if (tid < 128) dst[256 + tid] = bf_lo((unsigned)ZBp[r * IN_DIM + C_V + h * 128 + tid]);
        if (tid == 128) dst[384] = Z[r * 32 + h] + gb_i;
        if (tid == 129) dst[385] = log_sigmoid(Z[r * 32 + 4 + h] + gb_f);
    };
    __syncthreads();
    load_tok(0, lds);
    __syncthreads();
    for (int t = 0; t < T; ++t) {
        const float* cur = lds + (t & 1) * 388;
        if (t + 1 < T) load_tok(t + 1, lds + ((t + 1) & 1) * 388);
        const float ig = cur[384], lf = cur[385];
        const float mn = fmaxf(lf + m, ig);
        const float fd = expf(lf + m - mn), iw = expf(ig - mn);
        const float vv = cur[256 + v] * iw;
        float nump = 0.f, denp = 0.f;
#pragma unroll
        for (int j = 0; j < 64; ++j) {
            const float kj = cur[128 + kh * 64 + j], qj = cur[kh * 64 + j];
            C[j] = fd * C[j] + vv * kj; n[j] = fd * n[j] + iw * kj;
            nump += C[j] * qj; denp += n[j] * qj;
        }
        nump += __shfl_xor(nump, 1); denp += __shfl_xor(denp, 1);
        const float hval = nump / fmaxf(fabsf(denp), expf(-mn));
        if (kh == 0) HRAW[(size_t)(row0 + t) * 512 + h * 128 + v] = hval;
        m = mn;
        __syncthreads();
    }
    float* co = p.out + (pr ? O_CP : O_CS) + (((size_t)(b * 4 + h) * 128 + v) * 128 + kh * 64);
#pragma unroll
    for (int j = 0; j < 64; ++j) co[j] = C[j];
    if (v == 0) {
        float* no = p.out + (pr ? O_NP : O_NS) + ((size_t)(b * 4 + h) * 128 + kh * 64);
#pragma unroll
        for (int j = 0; j < 64; ++j) no[j] = n[j];
    }
    if (tid == 0) p.out[(pr ? O_MP : O_MS) + b * 4 + h] = m;
}

DEV void peer_topk_item(const Params& p, const int row, const int h, const int lane) {
    const float* S = (const float*)(p.ws + WS_S) + (size_t)row * 2048 + h * 256;
    int* PIDX = (int*)(p.ws + WS_PIDX); float* PG = (float*)(p.ws + WS_PG);
    float ts[2]; int ti[2];
#pragma unroll
    for (int pp = 0; pp < 2; ++pp) {
        float v0 = S[pp * 128 + lane], v1 = S[pp * 128 + 64 + lane];
        float mys = 0.f; int myi = 0;
        for (int r = 0; r < 16; ++r) {
            float best = fmaxf(v0, v1); int bi = (v0 >= v1) ? lane : lane + 64;
#pragma unroll
            for (int off = 32; off >= 1; off >>= 1) {
                const float ob = __shfl_xor(best, off); const int oi = __shfl_xor(bi, off);
                if (ob > best || (ob == best && oi < bi)) { best = ob; bi = oi; }
            }
            if (lane == r) { mys = best; myi = bi; }
            if (bi == lane) v0 = -INFINITY;
            if (bi == lane + 64) v1 = -INFINITY;
        }
        ts[pp] = mys; ti[pp] = myi;
    }
    float cv[4];
#pragma unroll
    for (int jj = 0; jj < 4; ++jj) { const int c = lane * 4 + jj; cv[jj] = __shfl(ts[0], c >> 4) + __shfl(ts[1], c & 15); }
    float msc = 0.f; int mci = 0;
    for (int r = 0; r < 16; ++r) {
        float best = cv[0]; int bi = lane * 4;
#pragma unroll
        for (int jj = 1; jj < 4; ++jj) if (cv[jj] > best) { best = cv[jj]; bi = lane * 4 + jj; }
#pragma unroll
        for (int off = 32; off >= 1; off >>= 1) {
            const float ob = __shfl_xor(best, off); const int oi = __shfl_xor(bi, off);
            if (ob > best || (ob == best && oi < bi)) { best = ob; bi = oi; }
        }
        if (lane == r) { msc = best; mci = bi; }
#pragma unroll
        for (int jj = 0; jj < 4; ++jj) if (bi == lane * 4 + jj) cv[jj] = -INFINITY;
    }
    const int e = __shfl(ti[0], mci >> 4) * 128 + __shfl(ti[1], mci & 15);
    const float top = __shfl(msc, 0);
    float ex = (lane < 16) ? expf(msc - top) : 0.f;
    const float den = wave_sum(ex);
    if (lane < 16) { PIDX[(size_t)row * 128 + h * 16 + lane] = e; PG[(size_t)row * 128 + h * 16 + lane] = ex / den; }
}

DEV void peer_expert_item(const Params& p, const int row, float* lds) {
    const int tid = threadIdx.x, lane = tid & 63, w = tid >> 6;
    const float* X1 = (const float*)(p.ws + WS_X1) + (size_t)row * 1024;
    const int* PIDX = (const int*)(p.ws + WS_PIDX) + (size_t)row * 128;
    const float* PG = (const float*)(p.ws + WS_PG) + (size_t)row * 128;
    float4 x[4], acc[4];
#pragma unroll
    for (int j = 0; j < 4; ++j) { x[j] = *(const float4*)(X1 + j * 256 + lane * 4); acc[j] = make_float4(0.f, 0.f, 0.f, 0.f); }
    for (int k = 0; k < 32; ++k) {
        const int e = PIDX[w * 32 + k]; const float gk = PG[w * 32 + k];
        const float* ur = p.peer_u + (size_t)e * 1024; const float* vr = p.peer_v + (size_t)e * 1024;
        float d = 0.f;
#pragma unroll
        for (int j = 0; j < 4; ++j) { const float4 u = *(const float4*)(ur + j * 256 + lane * 4); d += u.x * x[j].x + u.y * x[j].y + u.z * x[j].z + u.w * x[j].w; }
        d = wave_sum(d);
        const float coef = gk * gelu_tanh(d);
#pragma unroll
        for (int j = 0; j < 4; ++j) { const float4 vv = *(const float4*)(vr + j * 256 + lane * 4);
            acc[j].x += coef * vv.x; acc[j].y += coef * vv.y; acc[j].z += coef * vv.z; acc[j].w += coef * vv.w; }
    }
    __syncthreads();
#pragma unroll
    for (int j = 0; j < 4; ++j) *(float4*)(lds + w * 1024 + j * 256 + lane * 4) = acc[j];
    __syncthreads();
    float tv[4]; float s = 0.f;
#pragma unroll
    for (int i = 0; i < 4; ++i) { const int c = tid * 4 + i; const float po = (lds[c] + lds[1024 + c]) + (lds[2048 + c] + lds[3072 + c]); tv[i] = DN_ALPHA * X1[c] + po; s += tv[i]; }
    float* red = lds + 4096;
    s = wave_sum(s);
    if (lane == 0) red[w] = s;
    __syncthreads();
    const float mu = (red[0] + red[1] + red[2] + red[3]) * (1.0f / 1024.0f);
    float q = 0.f;
#pragma unroll
    for (int i = 0; i < 4; ++i) { const float d = tv[i] - mu; q += d * d; }
    q = wave_sum(q);
    if (lane == 0) red[8 + w] = q;
    __syncthreads();
    const float var = (red[8] + red[9] + red[10] + red[11]) * (1.0f / 1024.0f);
    const float rstd = 1.0f / sqrtf(var + LN_EPS);
    float* y = p.out + O_Y + (size_t)row * 1024;
#pragma unroll
    for (int i = 0; i < 4; ++i) { const int c = tid * 4 + i; y[c] = (tv[i] - mu) * rstd * p.ln2_g[c] + p.ln2_b[c]; }
}

DEV void mlstm_chunk_item(const Params& p, const int item, unsigned char* lds) {
    int tid_ = threadIdx.x; asm volatile("" : "+v"(tid_));
    const int tid = tid_, lane = tid & 63, w = tid >> 6, lr = lane & 15, lq = lane >> 4;
    const int b = item >> 4, h = (item >> 2) & 3, vs = item & 3;
    bf16_t* Cl = (bf16_t*)lds;
    bf16_t* nl = (bf16_t*)(lds + 8704);
    float* uL = (float*)(lds + 8960); float* ML = uL + 64; float* scin = uL + 128; float* expm = uL + 192; float* wts = uL + 256; float* misc = uL + 320;
    const bf16_t* QB = (const bf16_t*)(p.ws + WS_QB) + (size_t)(b * 2048) * 512 + h * 128;
    const bf16_t* KB = (const bf16_t*)(p.ws + WS_KB) + (size_t)(b * 2048) * 512 + h * 128;
    const bf16_t* KTB = (const bf16_t*)(p.ws + WS_KTB) + (size_t)((b * 4 + h) * 128) * 2048;
    const bf16_t* VTM = (const bf16_t*)(p.ws + WS_VTM) + (size_t)(b * 512 + h * 128 + vs * 32) * 2048;
    const float* Z = (const float*)(p.ws + WS_Z);
    float* HRAW = (float*)(p.ws + WS_HRAW);
    const float gb_i = p.gate_bias[h], gb_f = p.gate_bias[4 + h];
    f32x4 Cm[2][2], nm[2];
#pragma unroll
    for (int i = 0; i < 2; ++i) { nm[i] = (f32x4){0.f, 0.f, 0.f, 0.f};
#pragma unroll
        for (int j = 0; j < 2; ++j) Cm[i][j] = (f32x4){0.f, 0.f, 0.f, 0.f}; }
    float m_prev = 0.f;
    __syncthreads();
    for (int i = tid; i < (8704 + 256) / 4; i += 256) ((unsigned*)lds)[i] = 0u;
    __syncthreads();
    for (int c = 0; c < 32; ++c) {
        const int t0 = c * 64;
        if (w == 0) {
            const size_t row = (size_t)(b * 2048 + t0 + lane);
            const float ig = Z[row * 32 + h] + gb_i;
            const float lf = log_sigmoid(Z[row * 32 + 4 + h] + gb_f);
            float bc = lf;
#pragma unroll
            for (int o = 1; o < 64; o <<= 1) { const float t = __shfl_up(bc, o); if (lane >= o) bc += t; }
            const float u = ig - bc;
            float pm = u;
#pragma unroll
            for (int o = 1; o < 64; o <<= 1) { const float t = __shfl_up(pm, o); if (lane >= o) pm = fmaxf(pm, t); }
            const float M = fmaxf(m_prev, pm);
            const float M63 = __shfl(M, 63), b63 = __shfl(bc, 63);
            uL[lane] = u; ML[lane] = M; scin[lane] = expf(m_prev - M); expm[lane] = expf(-(bc + M)); wts[lane] = expf(u - M63);
            if (lane == 0) { misc[0] = expf(m_prev - M63); misc[1] = b63 + M63; }
        }
        __syncthreads();
        {
            const size_t row_t = (size_t)(t0 + w * 16 + lr);
            bf16x8 Qf[4];
#pragma unroll
            for (int ks = 0; ks < 4; ++ks) Qf[ks] = *(const bf16x8*)(QB + row_t * 512 + ks * 32 + lq * 8);
            const float M_t = ML[w * 16 + lr], sc_in = scin[w * 16 + lr], em = expm[w * 16 + lr];
            f32x4 sw[4];
            float dsum = 0.f;
#pragma unroll
            for (int st = 0; st < 4; ++st) {
                f32x4 a = (f32x4){0.f, 0.f, 0.f, 0.f};
                if (st <= w) {
#pragma unroll
                    for (int ks = 0; ks < 4; ++ks) { const bf16x8 kf = *(const bf16x8*)(KB + (size_t)(t0 + st * 16 + lr) * 512 + ks * 32 + lq * 8); a = __builtin_amdgcn_mfma_f32_16x16x32_bf16(kf, Qf[ks], a, 0, 0, 0); }
#pragma unroll
                    for (int g = 0; g < 4; ++g) {
                        const int sl = st * 16 + lq * 4 + g, tl = w * 16 + lr;
                        const float wg = (sl <= tl) ? __builtin_amdgcn_exp2f((uL[sl] - M_t) * LOG2E) : 0.f;
                        a[g] *= wg; dsum += a[g];
                    }
                }
                sw[st] = a;
            }
            dsum += __shfl_xor(dsum, 16); dsum += __shfl_xor(dsum, 32);
            bf16x8 pf[2];
#pragma unroll
            for (int ks = 0; ks < 2; ++ks) {
                union { bf16x8 v; unsigned u[4]; } pk;
                pk.u[0] = cvt_pk_bf16(sw[2 * ks][0], sw[2 * ks][1]); pk.u[1] = cvt_pk_bf16(sw[2 * ks][2], sw[2 * ks][3]);
                pk.u[2] = cvt_pk_bf16(sw[2 * ks + 1][0], sw[2 * ks + 1][1]); pk.u[3] = cvt_pk_bf16(sw[2 * ks + 1][2], sw[2 * ks + 1][3]);
                pf[ks] = pk.v;
            }
            f32x4 dI = (f32x4){0.f, 0.f, 0.f, 0.f};
#pragma unroll
            for (int ks = 0; ks < 4; ++ks) { const bf16x8 nf = *(const bf16x8*)(nl + ks * 32 + lq * 8); dI = __builtin_amdgcn_mfma_f32_16x16x32_bf16(nf, Qf[ks], dI, 0, 0, 0); }
            const float den = sc_in * dI[0] + dsum;
            const float rdd = 1.0f / fmaxf(fabsf(den), em);
#pragma unroll
            for (int vt = 0; vt < 2; ++vt) {
                f32x4 ni = (f32x4){0.f, 0.f, 0.f, 0.f}, nI = (f32x4){0.f, 0.f, 0.f, 0.f};
#pragma unroll
                for (int ks = 0; ks < 2; ++ks) if (2 * ks <= w) {
                    union { bf16x8 v; uint2 hh[2]; } vf;
                    const bf16_t* vp = VTM + (size_t)(vt * 16 + lr) * 2048 + t0 + 32 * ks + lq * 4;
                    vf.hh[0] = *(const uint2*)vp; vf.hh[1] = *(const uint2*)(vp + 16);
                    ni = __builtin_amdgcn_mfma_f32_16x16x32_bf16(vf.v, pf[ks], ni, 0, 0, 0);
                }
#pragma unroll
                for (int ks = 0; ks < 4; ++ks) { const bf16x8 cf = *(const bf16x8*)(Cl + (vt * 16 + lr) * 136 + ks * 32 + lq * 8); nI = __builtin_amdgcn_mfma_f32_16x16x32_bf16(cf, Qf[ks], nI, 0, 0, 0); }
                const f32x4 hv = (nI * sc_in + ni) * rdd;
                *(f32x4*)(HRAW + ((size_t)(b * 2048) + row_t) * 512 + h * 128 + vs * 32 + vt * 16 + lq * 4) = hv;
            }
        }
        __syncthreads();
        {
            const float decay = misc[0];
            bf16x8 Af[2][2], Wf[2], Kt[2][2];
#pragma unroll
            for (int ks = 0; ks < 2; ++ks) {
                const float4 w0 = *(const float4*)(wts + ks * 32 + lq * 8), w1 = *(const float4*)(wts + ks * 32 + lq * 8 + 4);
                float wv[8] = {w0.x, w0.y, w0.z, w0.w, w1.x, w1.y, w1.z, w1.w};
                { union { bf16x8 v; uint4 q; } t; t.q = pack8(wv); Wf[ks] = t.v; }
#pragma unroll
                for (int vt = 0; vt < 2; ++vt) {
                    const uint4 raw = *(const uint4*)(VTM + (size_t)(vt * 16 + lr) * 2048 + t0 + ks * 32 + lq * 8);
                    float f[8] = {bf_lo(raw.x) * wv[0], bf_hi(raw.x) * wv[1], bf_lo(raw.y) * wv[2], bf_hi(raw.y) * wv[3], bf_lo(raw.z) * wv[4], bf_hi(raw.z) * wv[5], bf_lo(raw.w) * wv[6], bf_hi(raw.w) * wv[7]};
                    union { bf16x8 v; uint4 q; } t; t.q = pack8(f); Af[vt][ks] = t.v;
                }
#pragma unroll
                for (int kt = 0; kt < 2; ++kt) Kt[kt][ks] = *(const bf16x8*)(KTB + (size_t)((2 * w + kt) * 16 + lr) * 2048 + t0 + ks * 32 + lq * 8);
            }
#pragma unroll
            for (int kt = 0; kt < 2; ++kt) {
                nm[kt] = nm[kt] * decay;
#pragma unroll
                for (int ks = 0; ks < 2; ++ks) nm[kt] = __builtin_amdgcn_mfma_f32_16x16x32_bf16(Wf[ks], Kt[kt][ks], nm[kt], 0, 0, 0);
                if (lq == 0) nl[(2 * w + kt) * 16 + lr] = (bf16_t)(cvt_pk_bf16(nm[kt][0], 0.f) & 0xffffu);
#pragma unroll
                for (int vt = 0; vt < 2; ++vt) {
                    Cm[vt][kt] = Cm[vt][kt] * decay;
#pragma unroll
                    for (int ks = 0; ks < 2; ++ks) Cm[vt][kt] = __builtin_amdgcn_mfma_f32_16x16x32_bf16(Af[vt][ks], Kt[kt][ks], Cm[vt][kt], 0, 0, 0);
                    const unsigned c01 = cvt_pk_bf16(Cm[vt][kt][0], Cm[vt][kt][1]), c23 = cvt_pk_bf16(Cm[vt][kt][2], Cm[vt][kt][3]);
                    bf16_t* cp = Cl + (vt * 16 + lq * 4) * 136 + (2 * w + kt) * 16 + lr;
                    cp[0] = (bf16_t)(c01 & 0xffffu); cp[136] = (bf16_t)(c01 >> 16); cp[272] = (bf16_t)(c23 & 0xffffu); cp[408] = (bf16_t)(c23 >> 16);
                }
            }
            m_prev = misc[1];
        }
        __syncthreads();
    }
#pragma unroll
    for (int vt = 0; vt < 2; ++vt)
#pragma unroll
        for (int kt = 0; kt < 2; ++kt)
#pragma unroll
            for (int g = 0; g < 4; ++g)
                p.out[O_CP + ((size_t)((b * 4 + h) * 128) + vs * 32 + vt * 16 + lq * 4 + g) * 128 + (2 * w + kt) * 16 + lr] = Cm[vt][kt][g];
    if (vs == 0) {
        if (lq == 0) { p.out[O_NP + (size_t)(b * 4 + h) * 128 + (2 * w) * 16 + lr] = nm[0][0]; p.out[O_NP + (size_t)(b * 4 + h) * 128 + (2 * w + 1) * 16 + lr] = nm[1][0]; }
        if (tid == 0) p.out[O_MP + b * 4 + h] = m_prev;
    }
}

DEV unsigned dpp_max16(unsigned x) {
    x = max(x, (unsigned)__builtin_amdgcn_update_dpp(0, (int)x, 0xB1, 0xF, 0xF, false));
    x = max(x, (unsigned)__builtin_amdgcn_update_dpp(0, (int)x, 0x4E, 0xF, 0xF, false));
    x = max(x, (unsigned)__builtin_amdgcn_update_dpp(0, (int)x, 0x141, 0xF, 0xF, false));
    x = max(x, (unsigned)__builtin_amdgcn_update_dpp(0, (int)x, 0x140, 0xF, 0xF, false));
    return x;
}
DEV float dpp_sum16(float x) {
    x += __builtin_bit_cast(float, __builtin_amdgcn_update_dpp(0, __builtin_bit_cast(int, x), 0xB1, 0xF, 0xF, false));
    x += __builtin_bit_cast(float, __builtin_amdgcn_update_dpp(0, __builtin_bit_cast(int, x), 0x4E, 0xF, 0xF, false));
    x += __builtin_bit_cast(float, __builtin_amdgcn_update_dpp(0, __builtin_bit_cast(int, x), 0x141, 0xF, 0xF, false));
    x += __builtin_bit_cast(float, __builtin_amdgcn_update_dpp(0, __builtin_bit_cast(int, x), 0x140, 0xF, 0xF, false));
    return x;
}
DEV unsigned mono_key(float v) { const unsigned b = __float_as_uint(v); return (b & 0x80000000u) ? ~b : (b | 0x80000000u); }
#define CE_DESC(a, b) { const unsigned hi_ = max(a, b), lo_ = min(a, b); a = hi_; b = lo_; }

DEV void peer_score_topk_item(const Params& p, const int tile, const int h, unsigned char* lds) {
    int tid_ = threadIdx.x; asm volatile("" : "+v"(tid_));
    const int tid = tid_, lane = tid & 63, w = tid >> 6, lr = lane & 15, lq = lane >> 4;
    float* sc = (float*)(lds + w * 12416);
    float* ts = sc + 16 * 129;
    int* ti = (int*)(ts + 512);
    const bf16_t* QPB = (const bf16_t*)(p.ws + WS_QPB);
    const bf16_t* SUBK = (const bf16_t*)(p.ws + WS_SUBK);
    int* PIDX = (int*)(p.ws + WS_PIDX); float* PG = (float*)(p.ws + WS_PG);
    const int row0 = tile * 64 + w * 16;
    const int arow = (row0 + lr < NR) ? row0 + lr : NR - 1;
    wave_sync();
#pragma unroll 1
    for (int pp = 0; pp < 2; ++pp) {
        bf16x8 qf[4];
#pragma unroll
        for (int ks = 0; ks < 4; ++ks) qf[ks] = *(const bf16x8*)(QPB + (size_t)arow * 2048 + h * 256 + pp * 128 + ks * 32 + lq * 8);
#pragma unroll
        for (int j = 0; j < 8; ++j) {
            f32x4 a = (f32x4){0.f, 0.f, 0.f, 0.f};
#pragma unroll
            for (int ks = 0; ks < 4; ++ks) { const bf16x8 kf = *(const bf16x8*)(SUBK + ((size_t)pp * 128 + j * 16 + lr) * 128 + ks * 32 + lq * 8); a = __builtin_amdgcn_mfma_f32_16x16x32_bf16(qf[ks], kf, a, 0, 0, 0); }
#pragma unroll
            for (int g = 0; g < 4; ++g) sc[(lq * 4 + g) * 129 + j * 16 + lr] = a[g];
        }
        wave_sync();
#pragma unroll 1
        for (int rr = 0; rr < 4; ++rr) {
            const int row = rr * 4 + lq;
            unsigned k0, k1, k2, k3, k4, k5, k6, k7;
            { const float* sr = sc + row * 129 + lr;
              k0 = (mono_key(sr[0]) & ~0x7Fu) | (unsigned)(127 - lr);        k1 = (mono_key(sr[16]) & ~0x7Fu) | (unsigned)(127 - 16 - lr);
              k2 = (mono_key(sr[32]) & ~0x7Fu) | (unsigned)(127 - 32 - lr);  k3 = (mono_key(sr[48]) & ~0x7Fu) | (unsigned)(127 - 48 - lr);
              k4 = (mono_key(sr[64]) & ~0x7Fu) | (unsigned)(127 - 64 - lr);  k5 = (mono_key(sr[80]) & ~0x7Fu) | (unsigned)(127 - 80 - lr);
              k6 = (mono_key(sr[96]) & ~0x7Fu) | (unsigned)(127 - 96 - lr);  k7 = (mono_key(sr[112]) & ~0x7Fu) | (unsigned)(127 - 112 - lr); }
            CE_DESC(k0, k1) CE_DESC(k2, k3) CE_DESC(k4, k5) CE_DESC(k6, k7)
            CE_DESC(k0, k2) CE_DESC(k1, k3) CE_DESC(k4, k6) CE_DESC(k5, k7)
            CE_DESC(k1, k2) CE_DESC(k5, k6)
            CE_DESC(k0, k4) CE_DESC(k1, k5) CE_DESC(k2, k6) CE_DESC(k3, k7)
            CE_DESC(k2, k4) CE_DESC(k3, k5)
            CE_DESC(k1, k2) CE_DESC(k3, k4) CE_DESC(k5, k6)
            unsigned mine = 0u;
#pragma unroll
            for (int r = 0; r < 16; ++r) {
                const unsigned best = dpp_max16(k0);
                if (lr == r) mine = best;
                const bool own = (k0 == best);
                k0 = own ? k1 : k0; k1 = own ? k2 : k1; k2 = own ? k3 : k2; k3 = own ? k4 : k3; k4 = own ? k5 : k4; k5 = own ? k6 : k5; k6 = own ? k7 : k6; k7 = own ? 0u : k7;
            }
            const int idx = 127 - (int)(mine & 0x7Fu);
            ts[(pp * 16 + row) * 16 + lr] = sc[row * 129 + idx];
            ti[(pp * 16 + row) * 16 + lr] = idx;
        }
        wave_sync();
    }
#pragma unroll 1
    for (int rr = 0; rr < 4; ++rr) {
        const int row = rr * 4 + lq;
        const float s1a = ts[row * 16 + lr];
        const float* s2 = ts + (16 + row) * 16;
        int ptr = 0;
        unsigned key = (mono_key(s1a + s2[0]) & ~0xFFu) | (unsigned)(255 - lr * 16);
        unsigned mine = 0u;
#pragma unroll
        for (int r = 0; r < 16; ++r) {
            const unsigned best = dpp_max16(key);
            if (lr == r) mine = best;
            if (key == best) { ++ptr; key = (ptr < 16) ? ((mono_key(s1a + s2[ptr & 15]) & ~0xFFu) | (unsigned)(255 - lr * 16 - ptr)) : 0u; }
        }
        const int ci = 255 - (int)(mine & 0xFFu), a = ci >> 4, bb = ci & 15;
        const float scv = ts[row * 16 + a] + s2[bb];
        const int e = ti[row * 16 + a] * 128 + ti[(16 + row) * 16 + bb];
        float m16 = scv;
        m16 = fmaxf(m16, __builtin_bit_cast(float, __builtin_amdgcn_update_dpp(0, __builtin_bit_cast(int, m16), 0xB1, 0xF, 0xF, false)));
        m16 = fmaxf(m16, __builtin_bit_cast(float, __builtin_amdgcn_update_dpp(0, __builtin_bit_cast(int, m16), 0x4E, 0xF, 0xF, false)));
        m16 = fmaxf(m16, __builtin_bit_cast(float, __builtin_amdgcn_update_dpp(0, __builtin_bit_cast(int, m16), 0x141, 0xF, 0xF, false)));
        m16 = fmaxf(m16, __builtin_bit_cast(float, __builtin_amdgcn_update_dpp(0, __builtin_bit_cast(int, m16), 0x140, 0xF, 0xF, false)));
        const float ex = expf(scv - m16);
        const float den = dpp_sum16(ex);
        const int grow = row0 + row;
        if (grow < NR) { PIDX[(size_t)grow * 128 + h * 16 + lr] = e; PG[(size_t)grow * 128 + h * 16 + lr] = ex / den; }
    }
}

constexpr float PEER_U_SCALE = 64.0f, PEER_V_SCALE = 8.0f;
DEV unsigned pack4_fp8(float a, float b, float c, float d) { int w = 0; w = __builtin_amdgcn_cvt_pk_fp8_f32(a, b, w, false); w = __builtin_amdgcn_cvt_pk_fp8_f32(c, d, w, true); return (unsigned)w; }
DEV void peer_expert_wave(const Params& p, const int row, unsigned char* wl, const int lane_in) {
    int lane = lane_in; asm volatile("" : "+v"(lane));
    const int lr = lane & 15, lq = lane >> 4;
    unsigned char* xh = wl;
    unsigned char* xo = wl + 1024;
    float* coefl = (float*)(wl + 2048);
    int* idxl = (int*)(wl + 2048 + 512);
    const float* X1 = (const float*)(p.ws + WS_X1) + (size_t)row * 1024;
    const int* PIDX = (const int*)(p.ws + WS_PIDX) + (size_t)row * 128;
    const float* PG = (const float*)(p.ws + WS_PG) + (size_t)row * 128;
    const unsigned char* U8 = p.ws + WS_U8;
    const unsigned char* V8 = p.ws + WS_V8;
    float xv[16];
#pragma unroll
    for (int j = 0; j < 4; ++j) { const float4 t = *(const float4*)(X1 + lane * 16 + j * 4); xv[4 * j] = t.x; xv[4 * j + 1] = t.y; xv[4 * j + 2] = t.z; xv[4 * j + 3] = t.w; }
    wave_sync();
    {
        uint4 hi, lo; unsigned* hp = (unsigned*)&hi; unsigned* lp = (unsigned*)&lo;
#pragma unroll
        for (int j = 0; j < 4; ++j) {
            const unsigned hw = pack4_fp8(xv[4 * j], xv[4 * j + 1], xv[4 * j + 2], xv[4 * j + 3]);
            const f32x2_ b0 = __builtin_amdgcn_cvt_pk_f32_fp8((int)hw, false), b1 = __builtin_amdgcn_cvt_pk_f32_fp8((int)hw, true);
            hp[j] = hw;
            lp[j] = pack4_fp8(16.f * (xv[4 * j] - b0[0]), 16.f * (xv[4 * j + 1] - b0[1]), 16.f * (xv[4 * j + 2] - b1[0]), 16.f * (xv[4 * j + 3] - b1[1]));
        }
        *(uint4*)(xh + lane * 16) = hi; *(uint4*)(xo + lane * 16) = lo;
    }
    idxl[lane] = PIDX[lane]; idxl[64 + lane] = PIDX[64 + lane];
    wave_sync();
    uint4 ufa[8], ufb[8];
    f32x4 ah = (f32x4){0.f, 0.f, 0.f, 0.f}, al = (f32x4){0.f, 0.f, 0.f, 0.f};
#define U_LOAD(DST, HH) { const unsigned char* ub_ = U8 + (size_t)idxl[((HH) >> 1) * 16 + lr] * 1024 + ((HH) & 1) * 512 + lq * 16; \
        _Pragma("unroll") for (int i = 0; i < 8; ++i) DST[i] = *(const uint4*)(ub_ + i * 64); }
#define U_HALF(SRC, HH) { \
        _Pragma("unroll") for (int i = 0; i < 8; ++i) { \
            const int off = ((HH) & 1) * 512 + i * 64 + lq * 16; \
            const long b0 = (long)(((unsigned long long)SRC[i].y << 32) | SRC[i].x), b1 = (long)(((unsigned long long)SRC[i].w << 32) | SRC[i].z); \
            const long h0 = *(const long*)(xh + off), h1 = *(const long*)(xh + off + 8), l0 = *(const long*)(xo + off), l1 = *(const long*)(xo + off + 8); \
            ah = __builtin_amdgcn_mfma_f32_16x16x32_fp8_fp8(h0, b0, ah, 0, 0, 0); ah = __builtin_amdgcn_mfma_f32_16x16x32_fp8_fp8(h1, b1, ah, 0, 0, 0); \
            al = __builtin_amdgcn_mfma_f32_16x16x32_fp8_fp8(l0, b0, al, 0, 0, 0); al = __builtin_amdgcn_mfma_f32_16x16x32_fp8_fp8(l1, b1, al, 0, 0, 0); } \
        if ((HH) & 1) { if (lq == 0) coefl[((HH) >> 1) * 16 + lr] = PG[((HH) >> 1) * 16 + lr] * gelu_tanh((ah[0] + al[0] * 0.0625f) * (1.0f / PEER_U_SCALE)) * (1.0f / PEER_V_SCALE); \
            ah = (f32x4){0.f, 0.f, 0.f, 0.f}; al = (f32x4){0.f, 0.f, 0.f, 0.f}; } }
    U_LOAD(ufa, 0)
#pragma unroll 1
    for (int hh = 0; hh < 16; hh += 2) {
        U_LOAD(ufb, hh + 1)
        U_HALF(ufa, hh)
        if (hh + 2 < 16) U_LOAD(ufa, hh + 2)
        U_HALF(ufb, hh + 1)
    }
#undef U_LOAD
#undef U_HALF
    wave_sync();
    float o[16];
#pragma unroll
    for (int i = 0; i < 16; ++i) o[i] = 0.f;
    uint4 vfa[8], vfb[8];
#define V_LOAD(DST, J) { _Pragma("unroll") for (int u = 0; u < 8; ++u) DST[u] = *(const uint4*)(V8 + (size_t)idxl[(J) + u] * 1024 + lane * 16); }
#define V_ACC(SRC, J) { _Pragma("unroll") for (int u = 0; u < 8; ++u) { const float c_ = coefl[(J) + u]; \
            const unsigned w0_ = SRC[u].x, w1_ = SRC[u].y, w2_ = SRC[u].z, w3_ = SRC[u].w; \
            f32x2_ f0, f1; \
            f0 = __builtin_amdgcn_cvt_pk_f32_fp8((int)w0_, false); f1 = __builtin_amdgcn_cvt_pk_f32_fp8((int)w0_, true); o[0] += c_ * f0[0]; o[1] += c_ * f0[1]; o[2] += c_ * f1[0]; o[3] += c_ * f1[1]; \
            f0 = __builtin_amdgcn_cvt_pk_f32_fp8((int)w1_, false); f1 = __builtin_amdgcn_cvt_pk_f32_fp8((int)w1_, true); o[4] += c_ * f0[0]; o[5] += c_ * f0[1]; o[6] += c_ * f1[0]; o[7] += c_ * f1[1]; \
            f0 = __builtin_amdgcn_cvt_pk_f32_fp8((int)w2_, false); f1 = __builtin_amdgcn_cvt_pk_f32_fp8((int)w2_, true); o[8] += c_ * f0[0]; o[9] += c_ * f0[1]; o[10] += c_ * f1[0]; o[11] += c_ * f1[1]; \
            f0 = __builtin_amdgcn_cvt_pk_f32_fp8((int)w3_, false); f1 = __builtin_amdgcn_cvt_pk_f32_fp8((int)w3_, true); o[12] += c_ * f0[0]; o[13] += c_ * f0[1]; o[14] += c_ * f1[0]; o[15] += c_ * f1[1]; } }
    V_LOAD(vfa, 0)
#pragma unroll 1
    for (int j = 0; j < 128; j += 16) {
        V_LOAD(vfb, j + 8)
        V_ACC(vfa, j)
        if (j + 16 < 128) V_LOAD(vfa, j + 16)
        V_ACC(vfb, j + 8)
    }
#undef V_LOAD
#undef V_ACC
    float tv[16]; float s = 0.f;
#pragma unroll
    for (int i = 0; i < 16; ++i) { tv[i] = DN_ALPHA * xv[i] + o[i]; s += tv[i]; }
    const float mu = wave_sum(s) * (1.0f / 1024.0f);
    float q = 0.f;
#pragma unroll
    for (int i = 0; i < 16; ++i) { const float d = tv[i] - mu; q += d * d; }
    const float rstd = 1.0f / sqrtf(wave_sum(q) * (1.0f / 1024.0f) + LN_EPS);
    float* y = p.out + O_Y + (size_t)row * 1024 + lane * 16;
#pragma unroll
    for (int j = 0; j < 4; ++j) {
        const float4 g4 = *(const float4*)(p.ln2_g + lane * 16 + j * 4), b4 = *(const float4*)(p.ln2_b + lane * 16 + j * 4);
        float4 yo;
        yo.x = (tv[4 * j] - mu) * rstd * g4.x + b4.x; yo.y = (tv[4 * j + 1] - mu) * rstd * g4.y + b4.y; yo.z = (tv[4 * j + 2] - mu) * rstd * g4.z + b4.z; yo.w = (tv[4 * j + 3] - mu) * rstd * g4.w + b4.w;
        *(float4*)(y + j * 4) = yo;
    }
}

constexpr int QN = 2;
struct AttnState { f32x4 ot[4][QN]; float m[QN]; float l[QN]; };

DEV void attn_block(const unsigned char* Ks, const unsigned char* VTs, const bf16x8 (&Qf)[QN][2], AttnState& A, const int mode, const int dq, const float* blut,
                    const unsigned selbit0, const unsigned selbit1, const bool slc, const int lr, const int lq, const int t0, const int ci0) {
    f32x4 sc[4][QN];
#pragma unroll
    for (int kt = 0; kt < 4; ++kt) {
        const bf16x8 k0 = *(const bf16x8*)(Ks + (kt * 16 + lr) * 144 + lq * 16), k1 = *(const bf16x8*)(Ks + (kt * 16 + lr) * 144 + 64 + lq * 16);
#pragma unroll
        for (int qi = 0; qi < QN; ++qi) {
            f32x4 a = (f32x4){0.f, 0.f, 0.f, 0.f};
            a = __builtin_amdgcn_mfma_f32_16x16x32_bf16(k0, Qf[qi][0], a, 0, 0, 0);
            a = __builtin_amdgcn_mfma_f32_16x16x32_bf16(k1, Qf[qi][1], a, 0, 0, 0);
            sc[kt][qi] = a;
        }
    }
    asm volatile("" ::: "memory");
    if (mode != 0 || slc) {
#pragma unroll
        for (int kt = 0; kt < 4; ++kt)
#pragma unroll
            for (int qi = 0; qi < QN; ++qi)
#pragma unroll
                for (int g = 0; g < 4; ++g) {
                    const int kl = kt * 16 + lq * 4 + g, ql = qi * 16 + lr;
                    float v = sc[kt][qi][g];
                    bool ok = true;
                    if (mode == 1 || mode == 2) { const int di = dq + ql - kl; v += blut[di < 0 ? 0 : di]; }
                    if (mode == 2) ok = kl <= ql + dq;
                    if (mode == 3) ok = kl > ql + dq - 512;
                    if (mode == 4) { const int ci = ci0 + kl, dist = t0 + ql - (16 * ci + 31); ok = (dist >= 0) && (ci < 127); if (dist >= 0 && dist < 192) v += blut[dist]; }
                    if (mode == 5) { const int dist = dq - ci0 * kl; ok = (kl < t0) && (dist >= 0); if (dist >= 0 && dist < 192) v += blut[dist]; }
                    if (slc) ok = ok && ((qi == 0 ? selbit0 : selbit1) != 0u);
                    sc[kt][qi][g] = ok ? v : NEGF;
                }
    }
    bf16x8 pf[QN][2];
#pragma unroll
    for (int qi = 0; qi < QN; ++qi) {
        float mb = NEGF;
#pragma unroll
        for (int kt = 0; kt < 4; ++kt) mb = fmaxf(mb, fmaxf(fmaxf(sc[kt][qi][0], sc[kt][qi][1]), fmaxf(sc[kt][qi][2], sc[kt][qi][3])));
        mb = fmaxf(mb, __shfl_xor(mb, 16)); mb = fmaxf(mb, __shfl_xor(mb, 32));
        const float mn = fmaxf(A.m[qi], mb);
        const float alpha = __builtin_amdgcn_exp2f(A.m[qi] - mn);
        A.m[qi] = mn;
        float rs = 0.f;
#pragma unroll
        for (int kt = 0; kt < 4; ++kt)
#pragma unroll
            for (int g = 0; g < 4; ++g) { const float v = sc[kt][qi][g]; const float e = (v > -1e29f) ? __builtin_amdgcn_exp2f(v - mn) : 0.f; sc[kt][qi][g] = e; rs += e; }
        A.l[qi] = A.l[qi] * alpha + rs;
#pragma unroll
        for (int dt = 0; dt < 4; ++dt) A.ot[dt][qi] = A.ot[dt][qi] * alpha;
#pragma unroll
        for (int ks = 0; ks < 2; ++ks) {
            union { bf16x8 v; unsigned u[4]; } pk;
            pk.u[0] = cvt_pk_bf16(sc[2 * ks][qi][0], sc[2 * ks][qi][1]); pk.u[1] = cvt_pk_bf16(sc[2 * ks][qi][2], sc[2 * ks][qi][3]);
            pk.u[2] = cvt_pk_bf16(sc[2 * ks + 1][qi][0], sc[2 * ks + 1][qi][1]); pk.u[3] = cvt_pk_bf16(sc[2 * ks + 1][qi][2], sc[2 * ks + 1][qi][3]);
            pf[qi][ks] = pk.v;
        }
    }
    asm volatile("" ::: "memory");
#pragma unroll
    for (int dt = 0; dt < 4; ++dt)
#pragma unroll
        for (int ks = 0; ks < 2; ++ks) {
            asm volatile("" ::: "memory");
            union { bf16x8 v; uint2 h[2]; } vf;
            vf.h[0] = *(const uint2*)(VTs + (dt * 16 + lr) * 144 + (32 * ks + lq * 4) * 2);
            vf.h[1] = *(const uint2*)(VTs + (dt * 16 + lr) * 144 + (32 * ks + 16 + lq * 4) * 2);
#pragma unroll
            for (int qi = 0; qi < QN; ++qi) A.ot[dt][qi] = __builtin_amdgcn_mfma_f32_16x16x32_bf16(vf.v, pf[qi][ks], A.ot[dt][qi], 0, 0, 0);
        }
}

DEV void nsa_prompt_item(const Params& p, const int b, const int hkv, const int q32, unsigned char* lds) {
    int tid_ = threadIdx.x; asm volatile("" : "+v"(tid_));
    const int tid = tid_, lane = tid & 63, g = tid >> 6, lr = lane & 15, lq = lane >> 4;
    const int hq = hkv * 4 + g, t0 = q32 * 32, kd = t0 >> 6;
    unsigned char* Ks = lds; unsigned char* VTs = lds + 9216;
    float* biasl = (float*)(lds + 18432); float* psl = (float*)(lds + 21504); unsigned* selm = (unsigned*)(lds + 29952); unsigned* misc = (unsigned*)(lds + 30208);
    const bf16_t* ZB = (const bf16_t*)(p.ws + WS_ZB);
    const bf16_t* VTS = (const bf16_t*)(p.ws + WS_VTS) + (size_t)(b * 2 + hkv) * 64 * 2048;
    const bf16_t* VTW = (const bf16_t*)(p.ws + WS_VTW) + (size_t)(b * 2 + hkv) * 64 * 2048;
    const bf16_t* KCB = (const bf16_t*)(p.ws + WS_KCB) + (size_t)(b * 2 + hkv) * 128 * 64;
    const bf16_t* VTC = (const bf16_t*)(p.ws + WS_VTC) + (size_t)(b * 2 + hkv) * 64 * 128;
    const float* Z = (const float*)(p.ws + WS_Z);
    float* NOUTF = (float*)(p.ws + WS_NOUTF);
    bf16_t* NOUTB = (bf16_t*)(p.ws + WS_NOUTB);
    __syncthreads();
    for (int i = tid; i < 4 * 192; i += 256) { const int gg = i / 192, d = i % 192; biasl[i] = (p.rel_bias[rel_bucket(d) * 8 + hkv * 4 + gg] - p.rel_bias[31 * 8 + hkv * 4 + gg]) * LOG2E; }
    for (int i = tid; i < 32 * 33; i += 256) psl[i] = 0.f;
    if (tid < 32) selm[tid] = 0u;
    if (tid == 0) misc[0] = 0u;
    const float* blut = biasl + g * 192;
    bf16x8 Qf[QN][2];
#pragma unroll
    for (int qi = 0; qi < QN; ++qi)
#pragma unroll
        for (int kk = 0; kk < 2; ++kk) Qf[qi][kk] = *(const bf16x8*)(ZB + (size_t)(b * 2048 + t0 + qi * 16 + lr) * IN_DIM + C_Q + hq * 64 + kk * 32 + lq * 8);

    uint4 trk0, trk1, trv0, trv1;
    auto load_tiles = [&](int kind, int kb) __attribute__((always_inline)) {
#pragma unroll
        for (int i = 0; i < 2; ++i) {
            const int id = tid + 256 * i, row = id >> 3, ch = id & 7;
            uint4 rk, rv;
            if (kind == 0) { rk = *(const uint4*)(KCB + (size_t)(kb * 64 + row) * 64 + ch * 8); rv = *(const uint4*)(VTC + (size_t)row * 128 + kb * 64 + ch * 8); }
            else {
                rk = *(const uint4*)(ZB + (size_t)(b * 2048 + kb * 64 + row) * IN_DIM + (kind == 1 ? C_KS : C_KW) + hkv * 64 + ch * 8);
                rv = *(const uint4*)((kind == 1 ? VTS : VTW) + (size_t)row * 2048 + kb * 64 + ch * 8);
            }
            if (i == 0) { trk0 = rk; trv0 = rv; } else { trk1 = rk; trv1 = rv; }
        }
    };
    auto store_tiles = [&]() __attribute__((always_inline)) {
#pragma unroll
        for (int i = 0; i < 2; ++i) { const int id = tid + 256 * i, row = id >> 3, ch = id & 7; *(uint4*)(Ks + row * 144 + ch * 16) = (i == 0 ? trk0 : trk1); *(uint4*)(VTs + row * 144 + ch * 16) = (i == 0 ? trv0 : trv1); }
    };
    auto reset = [&](AttnState& A) __attribute__((always_inline)) {
#pragma unroll
        for (int qi = 0; qi < QN; ++qi) { A.m[qi] = NEGF; A.l[qi] = 0.f;
#pragma unroll
            for (int dt = 0; dt < 4; ++dt) A.ot[dt][qi] = (f32x4){0.f, 0.f, 0.f, 0.f}; }
    };
    auto finish = [&](AttnState& A, int br) __attribute__((always_inline)) {
#pragma unroll
        for (int qi = 0; qi < QN; ++qi) {
            float lt = A.l[qi]; lt += __shfl_xor(lt, 16); lt += __shfl_xor(lt, 32);
            const float sc = (lt > 0.f) ? sigmoidf_(Z[(size_t)(b * 2048 + t0 + qi * 16 + lr) * 32 + 8 + br * 8 + hq]) / lt : 0.f;
            const size_t row = (size_t)(b * 2048 + t0 + qi * 16 + lr);
#pragma unroll
            for (int dt = 0; dt < 4; ++dt) {
                const int col = hq * 64 + dt * 16 + lq * 4;
                f32x4 v = A.ot[dt][qi] * sc;
                if (br > 0) v = v + *(const f32x4*)(NOUTF + row * 512 + col);
                if (br < 2) *(f32x4*)(NOUTF + row * 512 + col) = v; else store_bf16x4(NOUTB + row * 512 + col, v);
            }
        }
    };

    AttnState A;
    const int ncb = ((t0 >> 4) >= 64) ? 2 : 1;
    reset(A);
    load_tiles(0, 0);
    for (int kb = 0; kb < ncb; ++kb) {
        __syncthreads(); store_tiles(); __syncthreads();
        if (kb + 1 < ncb) load_tiles(0, kb + 1);
        attn_block(Ks, VTs, Qf, A, 4, 0, blut, 1u, 1u, false, lr, lq, t0, kb * 64);
    }
    finish(A, 0);
    {
        float linv[QN];
#pragma unroll
        for (int qi = 0; qi < QN; ++qi) { float lt = A.l[qi]; lt += __shfl_xor(lt, 16); lt += __shfl_xor(lt, 32); linv[qi] = (lt > 0.f) ? 1.0f / lt : 0.f; }
        for (int kb = 0; kb < ncb; ++kb) {
            if (ncb > 1) { load_tiles(0, kb); __syncthreads(); store_tiles(); __syncthreads(); }
#pragma unroll
            for (int kt = 0; kt < 4; ++kt) {
                const bf16x8 k0 = *(const bf16x8*)(Ks + (kt * 16 + lr) * 144 + lq * 16), k1 = *(const bf16x8*)(Ks + (kt * 16 + lr) * 144 + 64 + lq * 16);
#pragma unroll
                for (int qi = 0; qi < QN; ++qi) {
                    f32x4 a = (f32x4){0.f, 0.f, 0.f, 0.f};
                    a = __builtin_amdgcn_mfma_f32_16x16x32_bf16(k0, Qf[qi][0], a, 0, 0, 0);
                    a = __builtin_amdgcn_mfma_f32_16x16x32_bf16(k1, Qf[qi][1], a, 0, 0, 0);
                    float pr[4];
#pragma unroll
                    for (int gg = 0; gg < 4; ++gg) {
                        const int ci = kb * 64 + kt * 16 + lq * 4 + gg, ql = qi * 16 + lr, dist = t0 + ql - (16 * ci + 31);
                        float v = a[gg];
                        if (dist >= 0 && dist < 192) v += blut[dist];
                        pr[gg] = (dist >= 0 && ci < 127) ? __builtin_amdgcn_exp2f(v - A.m[qi]) * linv[qi] : 0.f;
                    }
                    const int blk = kb * 16 + kt * 4 + lq, ql = qi * 16 + lr;
                    atomicAdd(&psl[ql * 33 + blk], 2.0f * (pr[0] + pr[1] + pr[2]) + pr[3]);
                    atomicAdd(&psl[ql * 33 + blk + 1], pr[3]);
                }
            }
        }
    }
    __syncthreads();
    {
        const int ql = tid >> 3, part = tid & 7, tq = t0 + ql, cur = tq >> 6;
        float scv[32];
#pragma unroll
        for (int j = 0; j < 32; ++j) {
            const bool causal = j * 64 <= tq, forced = (j == 0) || (j == cur) || (j == cur - 1);
            scv[j] = causal ? (forced ? 1e4f : psl[ql * 33 + j]) : NEGF;
        }
        unsigned mbits = 0u;
#pragma unroll
        for (int jj = 0; jj < 4; ++jj) {
            const int j = part * 4 + jj;
            float my = NEGF;
#pragma unroll
            for (int k = 0; k < 32; ++k) my = (k == j) ? scv[k] : my;
            int rank = 0;
#pragma unroll
            for (int k = 0; k < 32; ++k) rank += ((scv[k] > my) || (scv[k] == my && k < j)) ? 1 : 0;
            if (rank < 16 && j * 64 <= tq) mbits |= (1u << j);
        }
        atomicOr(&selm[ql], mbits);
        atomicOr(&misc[0], mbits);
    }
    __syncthreads();
    const unsigned msk0 = selm[lr], msk1 = selm[16 + lr];
    const unsigned anym = misc[0];
    reset(A);
    {
        int kb = kd;
        load_tiles(1, kb);
        for (;;) {
            __syncthreads(); store_tiles(); __syncthreads();
            int nxt = (kb == kd) ? 0 : kb + 1;
            while (nxt < kd && !((anym >> nxt) & 1u)) ++nxt;
            const bool more = nxt < kd;
            if (more) load_tiles(1, nxt);
            const int mode = (kb == kd) ? 2 : ((kb >= kd - 2) ? 1 : 0);
            attn_block(Ks, VTs, Qf, A, mode, t0 - kb * 64, blut, (msk0 >> kb) & 1u, (msk1 >> kb) & 1u, true, lr, lq, t0, 0);
            if (!more) break;
            kb = nxt;
        }
    }
    finish(A, 1);
    reset(A);
    {
        const int klo = (t0 >= 511) ? ((t0 - 511) >> 6) : 0;
        int kb = kd;
        load_tiles(2, kb);
        for (;;) {
            __syncthreads(); store_tiles(); __syncthreads();
            const bool more = kb > klo;
            if (more) load_tiles(2, kb - 1);
            const int dq = t0 - kb * 64;
            const int mode = (kb == kd) ? 2 : ((kb >= kd - 2) ? 1 : ((dq + 31 >= 512) ? 3 : 0));
            attn_block(Ks, VTs, Qf, A, mode, dq, blut, 1u, 1u, false, lr, lq, t0, 0);
            if (!more) break;
            --kb;
        }
    }
    finish(A, 2);
}

DEV void nsa_sample_item(const Params& p, const int b, const int hkv, unsigned char* lds) {
    int tid_ = threadIdx.x; asm volatile("" : "+v"(tid_));
    const int tid = tid_, lane = tid & 63, g = tid >> 6, lr = lane & 15, lq = lane >> 4;
    const int hq = hkv * 4 + g;
    unsigned char* Ks = lds; unsigned char* VTs = lds + 9216;
    float* biasl = (float*)(lds + 18432); float* psl = (float*)(lds + 21504); int* sell = (int*)(lds + 29952); float* scl = (float*)(lds + 30720);
    const bf16_t* ZB = (const bf16_t*)(p.ws + WS_ZB);
    const float* zgate = (const float*)(p.ws + WS_Z) + (size_t)(NP + b) * 32 + 8;
    const bf16_t* zbrow = ZB + (size_t)(NP + b) * IN_DIM;
    const bf16_t* KCSB = (const bf16_t*)(p.ws + WS_KCSB) + (size_t)(b * 2 + hkv) * 1024 * 64;
    const bf16_t* VTCS = (const bf16_t*)(p.ws + WS_VTCS) + (size_t)(b * 2 + hkv) * 64 * 1024;
    bf16_t* NOUTB = (bf16_t*)(p.ws + WS_NOUTB);
    __syncthreads();
    for (int i = tid; i < 4 * 192; i += 256) { const int gg = i / 192, d = i % 192; biasl[i] = (p.rel_bias[rel_bucket(d) * 8 + hkv * 4 + gg] - p.rel_bias[31 * 8 + hkv * 4 + gg]) * LOG2E; }
    for (int i = tid; i < 260; i += 256) psl[i] = 0.f;
    const float* blut = biasl + g * 192;
    bf16x8 Qf[QN][2];
#pragma unroll
    for (int kk = 0; kk < 2; ++kk) { Qf[0][kk] = *(const bf16x8*)(ZB + (size_t)(NP + b) * IN_DIM + C_Q + hq * 64 + kk * 32 + lq * 8); Qf[1][kk] = Qf[0][kk]; }
    AttnState A;
    auto reset = [&](AttnState& S_) __attribute__((always_inline)) {
#pragma unroll
        for (int qi = 0; qi < QN; ++qi) { S_.m[qi] = NEGF; S_.l[qi] = 0.f;
#pragma unroll
            for (int dt = 0; dt < 4; ++dt) S_.ot[dt][qi] = (f32x4){0.f, 0.f, 0.f, 0.f}; }
    };
    f32x4 res[4];
#pragma unroll
    for (int dt = 0; dt < 4; ++dt) res[dt] = (f32x4){0.f, 0.f, 0.f, 0.f};
    auto finish = [&](AttnState& S_, int br) __attribute__((always_inline)) {
        float lt = S_.l[0]; lt += __shfl_xor(lt, 16); lt += __shfl_xor(lt, 32);
        const float sc = (lt > 0.f) ? sigmoidf_(zgate[br * 8 + hq]) / lt : 0.f;
#pragma unroll
        for (int dt = 0; dt < 4; ++dt) res[dt] = res[dt] + S_.ot[dt][0] * sc;
    };
    uint4 trk0, trk1, trv0, trv1;
    auto load_cmp = [&](int kb) __attribute__((always_inline)) {
#pragma unroll
        for (int i = 0; i < 2; ++i) {
            const int id = tid + 256 * i, row = id >> 3, ch = id & 7;
            const uint4 rk = *(const uint4*)(KCSB + (size_t)(kb * 64 + row) * 64 + ch * 8), rv = *(const uint4*)(VTCS + (size_t)row * 1024 + kb * 64 + ch * 8);
            if (i == 0) { trk0 = rk; trv0 = rv; } else { trk1 = rk; trv1 = rv; }
        }
    };
    auto store_cmp = [&]() __attribute__((always_inline)) {
#pragma unroll
        for (int i = 0; i < 2; ++i) { const int id = tid + 256 * i, row = id >> 3, ch = id & 7; *(uint4*)(Ks + row * 144 + ch * 16) = (i == 0 ? trk0 : trk1); *(uint4*)(VTs + row * 144 + ch * 16) = (i == 0 ? trv0 : trv1); }
    };
    reset(A);
    load_cmp(0);
    for (int kb = 0; kb < 16; ++kb) {
        __syncthreads(); store_cmp(); __syncthreads();
        if (kb + 1 < 16) load_cmp(kb + 1);
        attn_block(Ks, VTs, Qf, A, 5, PAST - 31 - 16 * (kb * 64), blut, 1u, 1u, false, lr, lq, (kb == 15) ? 63 : 64, 16);
    }
    finish(A, 0);
    {
        float lt = A.l[0]; lt += __shfl_xor(lt, 16); lt += __shfl_xor(lt, 32);
        const float linv = (lt > 0.f) ? 1.0f / lt : 0.f;
        for (int kb = 0; kb < 16; ++kb) {
            load_cmp(kb); __syncthreads(); store_cmp(); __syncthreads();
#pragma unroll
            for (int kt = 0; kt < 4; ++kt) {
                const bf16x8 k0 = *(const bf16x8*)(Ks + (kt * 16 + lr) * 144 + lq * 16), k1 = *(const bf16x8*)(Ks + (kt * 16 + lr) * 144 + 64 + lq * 16);
                f32x4 a = (f32x4){0.f, 0.f, 0.f, 0.f};
                a = __builtin_amdgcn_mfma_f32_16x16x32_bf16(k0, Qf[0][0], a, 0, 0, 0);
                a = __builtin_amdgcn_mfma_f32_16x16x32_bf16(k1, Qf[0][1], a, 0, 0, 0);
                float pr[4];
#pragma unroll
                for (int gg = 0; gg < 4; ++gg) {
                    const int ci = kb * 64 + kt * 16 + lq * 4 + gg, dist = PAST - 31 - 16 * ci;
                    float v = a[gg];
                    if (dist >= 0 && dist < 192) v += blut[dist];
                    pr[gg] = (ci < 1023) ? __builtin_amdgcn_exp2f(v - A.m[0]) * linv : 0.f;
                }
                if (lr == 0) {
                    const int blk = kb * 16 + kt * 4 + lq;
                    atomicAdd(&psl[blk], 2.0f * (pr[0] + pr[1] + pr[2]) + pr[3]);
                    atomicAdd(&psl[blk + 1], pr[3]);
                }
            }
        }
    }
    __syncthreads();
    for (int j = tid; j < 257; j += 256) scl[j] = (j == 0 || j == 256 || j == 255) ? 1e4f : psl[j];
    __syncthreads();
    for (int j = tid; j < 257; j += 256) {
        const float my = scl[j];
        int rank = 0;
        for (int k = 0; k < 257; ++k) { const float o2 = scl[k]; rank += ((o2 > my) || (o2 == my && k < j)) ? 1 : 0; }
        if (rank < 16) sell[rank] = j;
    }
    __syncthreads();
    uint4 rk0, rk1; unsigned rv0, rv1, rv2, rv3, rv4, rv5, rv6, rv7;
    auto load_rows = [&](const float* src, const bf16_t* srcb) __attribute__((always_inline)) {
        const int seg = tid & 3;
        if (srcb) {
            const bf16_t* kp = srcb + hkv * 64 + seg * 16; const bf16_t* vp = kp + 128;
            rk0 = *(const uint4*)kp; rk1 = *(const uint4*)(kp + 8);
            const uint4 v0 = *(const uint4*)vp, v1 = *(const uint4*)(vp + 8);
            rv0 = v0.x; rv1 = v0.y; rv2 = v0.z; rv3 = v0.w; rv4 = v1.x; rv5 = v1.y; rv6 = v1.z; rv7 = v1.w;
        } else {
            const bool nz = src != nullptr;
            const float* kp = (nz ? src : p.state_win) + hkv * 64 + seg * 16; const float* vp = kp + 128;
            const float4 a0 = *(const float4*)kp, a1 = *(const float4*)(kp + 4), a2 = *(const float4*)(kp + 8), a3 = *(const float4*)(kp + 12);
            const float4 c0 = *(const float4*)vp, c1 = *(const float4*)(vp + 4), c2 = *(const float4*)(vp + 8), c3 = *(const float4*)(vp + 12);
            const unsigned mk = nz ? 0xffffffffu : 0u;
            rk0.x = cvt_pk_bf16(a0.x, a0.y) & mk; rk0.y = cvt_pk_bf16(a0.z, a0.w) & mk; rk0.z = cvt_pk_bf16(a1.x, a1.y) & mk; rk0.w = cvt_pk_bf16(a1.z, a1.w) & mk;
            rk1.x = cvt_pk_bf16(a2.x, a2.y) & mk; rk1.y = cvt_pk_bf16(a2.z, a2.w) & mk; rk1.z = cvt_pk_bf16(a3.x, a3.y) & mk; rk1.w = cvt_pk_bf16(a3.z, a3.w) & mk;
            rv0 = cvt_pk_bf16(c0.x, c0.y) & mk; rv1 = cvt_pk_bf16(c0.z, c0.w) & mk; rv2 = cvt_pk_bf16(c1.x, c1.y) & mk; rv3 = cvt_pk_bf16(c1.z, c1.w) & mk;
            rv4 = cvt_pk_bf16(c2.x, c2.y) & mk; rv5 = cvt_pk_bf16(c2.z, c2.w) & mk; rv6 = cvt_pk_bf16(c3.x, c3.y) & mk; rv7 = cvt_pk_bf16(c3.z, c3.w) & mk;
        }
    };
    auto store_rows = [&]() __attribute__((always_inline)) {
        const int kl = tid >> 2, seg = tid & 3;
        *(uint4*)(Ks + kl * 144 + seg * 32) = rk0; *(uint4*)(Ks + kl * 144 + seg * 32 + 16) = rk1;
#define VT_PUT(i_, w_) { *(bf16_t*)(VTs + (seg * 16 + (i_)) * 144 + kl * 2) = (bf16_t)((w_) & 0xffffu); *(bf16_t*)(VTs + (seg * 16 + (i_) + 1) * 144 + kl * 2) = (bf16_t)((w_) >> 16); }
        VT_PUT(0, rv0) VT_PUT(2, rv1) VT_PUT(4, rv2) VT_PUT(6, rv3) VT_PUT(8, rv4) VT_PUT(10, rv5) VT_PUT(12, rv6) VT_PUT(14, rv7)
#undef VT_PUT
    };
    auto slc_row = [&](int blk) __attribute__((always_inline)) -> const float* {
        const int kl = tid >> 2;
        if (blk < 256) { const int page = p.page_table[b * 128 + (blk >> 1)]; return p.cache_slc + ((size_t)page * 128 + (blk & 1) * 64 + kl) * 256; }
        return nullptr;
    };
    auto slc_rowb = [&](int blk) __attribute__((always_inline)) -> const bf16_t* { return (blk == 256 && (tid >> 2) == 0) ? zbrow + C_KS : nullptr; };
    reset(A);
    load_rows(slc_row(sell[0]), slc_rowb(sell[0]));
    for (int si = 0; si < 16; ++si) {
        const int blk = sell[si];
        __syncthreads(); store_rows(); __syncthreads();
        if (si + 1 < 16) load_rows(slc_row(sell[si + 1]), slc_rowb(sell[si + 1]));
        attn_block(Ks, VTs, Qf, A, 5, PAST - blk * 64, blut, 1u, 1u, false, lr, lq, (blk == 256) ? 1 : 64, 1);
    }
    finish(A, 1);
    auto win_row = [&](int wb) __attribute__((always_inline)) -> const float* {
        const int j = 1 + wb * 64 + (tid >> 2);
        return (j < 512) ? p.state_win + ((size_t)b * 512 + j) * 256 : nullptr;
    };
    auto win_rowb = [&](int wb) __attribute__((always_inline)) -> const bf16_t* { return (1 + wb * 64 + (tid >> 2) == 512) ? zbrow + C_KW : nullptr; };
    reset(A);
    load_rows(win_row(0), win_rowb(0));
    for (int wb = 0; wb < 8; ++wb) {
        __syncthreads(); store_rows(); __syncthreads();
        if (wb + 1 < 8) load_rows(win_row(wb + 1), win_rowb(wb + 1));
        attn_block(Ks, VTs, Qf, A, 5, 511 - wb * 64, blut, 1u, 1u, false, lr, lq, 64, 1);
    }
    finish(A, 2);
    if (lr == 0) {
#pragma unroll
        for (int dt = 0; dt < 4; ++dt) store_bf16x4(NOUTB + (size_t)(NP + b) * 512 + hq * 64 + dt * 16 + lq * 4, res[dt]);
    }
}

#define Z ((float*)(p.ws + WS_Z))
#define QK ((float*)(p.ws + WS_QK))
#define HRAW ((float*)(p.ws + WS_HRAW))
#define MOUTB ((bf16_t*)(p.ws + WS_MOUTB))
#define NOUTB ((bf16_t*)(p.ws + WS_NOUTB))
#define HIDPB ((bf16_t*)(p.ws + WS_HIDPB))
#define HIDSB ((bf16_t*)(p.ws + WS_HIDSB))
#define KCS ((float*)(p.ws + WS_KCS))
#define MIX ((float*)(p.ws + WS_MIX))
#define MIXB ((bf16_t*)(p.ws + WS_MIXB))
#define T1 ((float*)(p.ws + WS_T1))
#define X1 ((float*)(p.ws + WS_X1))
#define X1B ((bf16_t*)(p.ws + WS_X1B))
#define QPB ((bf16_t*)(p.ws + WS_QPB))
#define S ((float*)(p.ws + WS_S))
#define CONVB ((bf16_t*)(p.ws + WS_CONVB))
#define XB ((bf16_t*)(p.ws + WS_XB))
#define WIN_T ((bf16_t*)(p.ws + WS_WIN_T))
#define WUPM_T ((bf16_t*)(p.ws + WS_WUPM_T))
#define WUPN_T ((bf16_t*)(p.ws + WS_WUPN_T))
#define WOUT_T ((bf16_t*)(p.ws + WS_WOUT_T))
#define PWQ_T ((bf16_t*)(p.ws + WS_PWQ_T))
#define WQK_T ((bf16_t*)(p.ws + WS_WQK_T))
#define W1_T ((bf16_t*)(p.ws + WS_W1_T))
#define W2_T ((bf16_t*)(p.ws + WS_W2_T))
#define SUBK ((bf16_t*)(p.ws + WS_SUBK))
#define ZB ((bf16_t*)(p.ws + WS_ZB))
#define VTS ((bf16_t*)(p.ws + WS_VTS))
#define VTW ((bf16_t*)(p.ws + WS_VTW))
#define KCB ((bf16_t*)(p.ws + WS_KCB))
#define VTC ((bf16_t*)(p.ws + WS_VTC))
__global__ void __launch_bounds__(NTHREADS, 2) fwd_kernel(Params p) {
    extern __shared__ __attribute__((aligned(16))) unsigned char smem[];
    if (threadIdx.x == 0) { *(uint4*)smem = make_uint4(0u, 0u, 0u, 0u); }
    __syncthreads();
    XcdBarrier bar = xcd_barrier_post((unsigned*)(p.ws + WS_BAR), (volatile LAS unsigned*)smem);
    float* lds = (float*)(smem + 16);
    unsigned char* ldsb = smem + 16;
    const int tid = threadIdx.x, lane = tid & 63, w = tid >> 6;
    const int gw = blockIdx.x * 4 + w, nw = gridDim.x * 4;
    const size_t gt = (size_t)blockIdx.x * NTHREADS + tid, nt = (size_t)gridDim.x * NTHREADS;


    {
        for (size_t id = gt; id < (size_t)MP * 128; id += nt) {
            const int row = (int)(id >> 7), k8 = (int)(id & 127) * 8;
            float f[8];
            if (row < NR) {
                const float* s = (row < NP ? p.x_prompt + (size_t)row * 1024 : p.x_sample + (size_t)(row - NP) * 1024) + k8;
                const float4 a = *(const float4*)s, b = *(const float4*)(s + 4);
                f[0] = a.x; f[1] = a.y; f[2] = a.z; f[3] = a.w; f[4] = b.x; f[5] = b.y; f[6] = b.z; f[7] = b.w;
            } else {
#pragma unroll
                for (int i = 0; i < 8; ++i) f[i] = 0.f;
            }
            *(uint4*)(XB + (size_t)row * 1024 + k8) = pack8(f);
        }
        transpose_to_bf16(p.w_in, 1024, IN_DIM, WIN_T, gt, nt);
        transpose_to_bf16(p.w_up_m, 512, 1024, WUPM_T, gt, nt);
        transpose_to_bf16(p.w_up_n, 512, 1024, WUPN_T, gt, nt);
        transpose_to_bf16(p.w_out, 1024, 1024, WOUT_T, gt, nt);
        transpose_to_bf16(p.peer_wq, 1024, 2048, PWQ_T, gt, nt);
        for (int h = 0; h < 4; ++h) {
            transpose_to_bf16(p.wq + (size_t)h * 16384, 128, 128, WQK_T + (size_t)(h * 256) * 128, gt, nt);
            transpose_to_bf16(p.wk + (size_t)h * 16384, 128, 128, WQK_T + (size_t)(h * 256 + 128) * 128, gt, nt);
        }
        for (size_t id = gt; id < (size_t)2 * 128 * 128; id += nt) {
            const int k8 = (int)(id & 127) * 8, np = (int)((id >> 7) & 127), c = (int)(id >> 14);
            const int pp = np >> 6, o = np & 63, r = k8 >> 6, d = k8 & 63;
            float f[8];
#pragma unroll
            for (int e = 0; e < 8; ++e) f[e] = p.cmp_w1[((size_t)c * 2048 + (pp * 16 + r) * 64 + d + e) * 64 + o];
            *(uint4*)(W1_T + ((size_t)c * 128 + np) * 1024 + k8) = pack8(f);
        }
        if (gt < 128) {
            const int c = (int)gt >> 6, o = (int)gt & 63;
            float a = 0.f;
            for (int k = 0; k < 2048; ++k) a += p.cmp_pe[c * 2048 + k] * p.cmp_w1[((size_t)c * 2048 + k) * 64 + o];
            ((float*)(p.ws + WS_PESUM))[gt] = a;
        }
        for (int c = 0; c < 2; ++c) transpose_to_bf16(p.cmp_w2 + (size_t)c * 4096, 64, 64, W2_T + (size_t)c * 4096, gt, nt);
        for (size_t id = gt; id < (size_t)2 * 128 * 128 / 8; id += nt) {
            float f[8];
#pragma unroll
            for (int i = 0; i < 8; ++i) f[i] = p.peer_sub[id * 8 + i];
            *(uint4*)(SUBK + id * 8) = pack8(f);
        }
        for (size_t id = gt; id < (size_t)16384 * 64; id += nt) {
            const float* su = p.peer_u + id * 16; const float* sv = p.peer_v + id * 16;
            uint4 ou, ov; unsigned* pu = (unsigned*)&ou; unsigned* pv = (unsigned*)&ov;
#pragma unroll
            for (int j = 0; j < 4; ++j) {
                const float4 a4 = *(const float4*)(su + j * 4), c4 = *(const float4*)(sv + j * 4);
                pu[j] = pack4_fp8(a4.x * PEER_U_SCALE, a4.y * PEER_U_SCALE, a4.z * PEER_U_SCALE, a4.w * PEER_U_SCALE);
                pv[j] = pack4_fp8(c4.x * PEER_V_SCALE, c4.y * PEER_V_SCALE, c4.z * PEER_V_SCALE, c4.w * PEER_V_SCALE);
            }
            *(uint4*)(p.ws + WS_U8 + id * 16) = ou; *(uint4*)(p.ws + WS_V8 + id * 16) = ov;
        }
        for (size_t i = gt; i < (size_t)BS * 511 * 256; i += nt) {
            const int j = (int)(i & 255); const int wv = (int)((i >> 8) % 511); const int b = (int)((i >> 8) / 511);
            p.out[O_WINS + ((size_t)b * 512 + wv) * 256 + j] = p.state_win[((size_t)b * 512 + wv + 1) * 256 + j];
        }
        for (size_t i = gt; i < (size_t)BS * 2 * 512; i += nt) {
            const int ch = (int)(i & 511); const int jj = (int)((i >> 9) & 1); const int b = (int)(i >> 10);
            p.out[O_CVS + ((size_t)b * 3 + jj) * 512 + ch] = p.state_conv[((size_t)b * 3 + jj + 1) * 512 + ch];
        }
    }
    xcd_barrier(bar);

    gemm_glds(NR, IN_DIM, 1024,
        [&](int r, int k) { return XB + (size_t)r * 1024 + k; },
        [&](int n, int k) { return WIN_T + (size_t)n * 1024 + k; },
        [&](int r, int c0, f32x4 v) {
            if (c0 >= C_I && c0 < C_Q) *(f32x4*)(Z + (size_t)r * 32 + (c0 - C_I)) = v;
            else if (c0 >= C_G && c0 < C_GM) *(f32x4*)(Z + (size_t)r * 32 + 8 + (c0 - C_G)) = v;
            store_bf16x4(ZB + (size_t)r * IN_DIM + c0, (c0 >= C_Q && c0 < C_KC) ? v * (0.125f * LOG2E) : v);
            if (r < NP && ((c0 >= C_KS + 128 && c0 < C_KW) || (c0 >= C_KW + 128 && c0 < C_G))) {
                const bool isw = c0 >= C_KW; const int cc = c0 - (isw ? C_KW : C_KS) - 128;
                bf16_t* vt = (isw ? VTW : VTS) + ((size_t)((r >> 11) * 2) * 64 + cc) * 2048 + (r & 2047);
                const unsigned w0 = cvt_pk_bf16(v[0], v[1]), w1 = cvt_pk_bf16(v[2], v[3]);
                vt[0] = (bf16_t)(w0 & 0xffffu); vt[2048] = (bf16_t)(w0 >> 16); vt[4096] = (bf16_t)(w1 & 0xffffu); vt[6144] = (bf16_t)(w1 >> 16);
            }
            if (r < NP && c0 >= C_V && c0 < C_O) {
                bf16_t* vt = (bf16_t*)(p.ws + WS_VTM) + ((size_t)(r >> 11) * 512 + (c0 - C_V)) * 2048 + (r & 2047);
                const unsigned w0 = cvt_pk_bf16(v[0], v[1]), w1 = cvt_pk_bf16(v[2], v[3]);
                vt[0] = (bf16_t)(w0 & 0xffffu); vt[2048] = (bf16_t)(w0 >> 16); vt[4096] = (bf16_t)(w1 & 0xffffu); vt[6144] = (bf16_t)(w1 >> 16);
            }
            if (c0 >= C_KC && c0 < C_KS) *(f32x4*)(p.out + O_CMPP + (size_t)r * 256 + (c0 - C_KC)) = v;
            else if (c0 >= C_KS && c0 < C_KW) *(f32x4*)(p.out + O_SLCP + (size_t)r * 256 + (c0 - C_KS)) = v;
            else if (c0 >= C_KW && c0 < C_G) {
                if (r < NP) { const int t = r & 2047; if (t >= 1536) *(f32x4*)(p.out + O_WINP + ((size_t)(r >> 11) * 512 + (t - 1536)) * 256 + (c0 - C_KW)) = v; }
                else *(f32x4*)(p.out + O_WINS + ((size_t)(r - NP) * 512 + 511) * 256 + (c0 - C_KW)) = v;
            } else if (c0 < C_V) {
                if (r < NP) { const int t = r & 2047; if (t >= 2045) *(f32x4*)(p.out + O_CVP + ((size_t)(r >> 11) * 3 + (t - 2045)) * 512 + c0) = v; }
                else *(f32x4*)(p.out + O_CVS + ((size_t)(r - NP) * 3 + 2) * 512 + c0) = v;
            }
        }, smem + 1024);
    xcd_barrier(bar);

    for (size_t i = gt; i < (size_t)NR * 512; i += nt) {
        const int ch = (int)(i & 511); const int r = (int)(i >> 9);
        float a = p.conv_b[ch];
        if (r < NP) {
            const int t = r & 2047;
#pragma unroll
            for (int j = 0; j < 4; ++j) if (t + j - 3 >= 0) a += p.conv_w[j * 512 + ch] * bf_lo((unsigned)ZB[(size_t)(r + j - 3) * IN_DIM + C_U + ch]);
        } else {
            const int b = r - NP;
#pragma unroll
            for (int j = 0; j < 3; ++j) a += p.conv_w[j * 512 + ch] * p.state_conv[((size_t)b * 3 + j) * 512 + ch];
            a += p.conv_w[3 * 512 + ch] * bf_lo((unsigned)ZB[(size_t)r * IN_DIM + C_U + ch]);
        }
        CONVB[i] = (bf16_t)(cvt_pk_bf16(a / (1.0f + expf(-a)), 0.f) & 0xffffu);
    }
    xcd_barrier(bar);

    for (int h = 0; h < 4; ++h) {
        gemm_glds(NR, 256, 128,
            [&](int r, int k) { return CONVB + (size_t)r * 512 + h * 128 + k; },
            [&](int n, int k) { return WQK_T + (size_t)(h * 256 + n) * 128 + k; },
            [&](int r, int c0, f32x4 v) {
                if (c0 >= 128) v = v * 0.08838834764831845f;
                if (c0 < 128) store_bf16x4((bf16_t*)(p.ws + WS_QB) + (size_t)r * 512 + h * 128 + c0, v);
                else {
                    store_bf16x4((bf16_t*)(p.ws + WS_KB) + (size_t)r * 512 + h * 128 + (c0 - 128), v);
                    if (r < NP) {
                        bf16_t* kt = (bf16_t*)(p.ws + WS_KTB) + ((size_t)((r >> 11) * 4 + h) * 128 + (c0 - 128)) * 2048 + (r & 2047);
                        const unsigned w0 = cvt_pk_bf16(v[0], v[1]), w1 = cvt_pk_bf16(v[2], v[3]);
                        kt[0] = (bf16_t)(w0 & 0xffffu); kt[2048] = (bf16_t)(w0 >> 16); kt[4096] = (bf16_t)(w1 & 0xffffu); kt[6144] = (bf16_t)(w1 >> 16);
                    }
                } }, smem + 1024, h * 514);
    }
    for (int c = 0; c < 2; ++c) {
        for (int grp = 0; grp < 2; ++grp) {
            const int TPB = grp ? 9 : 1, NCH = grp ? 1024 : 128, NBH = grp ? 64 : 32;
            gemm_bf16<128, true>(NBH * TPB * 128, 128, 1024,
                [&](int vrow, int k) {
                    const int tile = vrow >> 7, bh = tile / TPB, n_ = 127 * (tile % TPB) + (vrow & 127), n = n_ < NCH ? n_ : NCH - 1;
                    const int b = bh >> 1, hh = bh & 1, tok = 16 * n + (k >> 6), d0 = k & 63;
                    if (!grp) return *(const uint4*)(ZB + ((size_t)b * 2048 + tok) * IN_DIM + C_KC + c * 128 + hh * 64 + d0);
                    const int page = p.page_table[b * 128 + (tok >> 7)];
                    const float* sp = p.cache_cmp + ((size_t)page * 128 + (tok & 127)) * 256 + c * 128 + hh * 64 + d0;
                    const float4 a0 = *(const float4*)sp, a1 = *(const float4*)(sp + 4);
                    float f[8] = {a0.x, a0.y, a0.z, a0.w, a1.x, a1.y, a1.z, a1.w};
                    return pack8(f); },
                [&](int n, int k) { return *(const uint4*)(W1_T + ((size_t)c * 128 + n) * 1024 + k); },
                [&](f32x4 (&acc)[4][4], int bm) {
                    const int lr = lane & 15, lq = lane >> 4, wm = w >> 1, wn = w & 1;
                    const int tile = bm >> 7, bh = tile / TPB, n0 = 127 * (tile % TPB);
                    float* P1 = (float*)ldsb;
                    bf16_t* HL = (bf16_t*)(ldsb + 128 * 68 * 4);
                    __syncthreads();
                    if (wn == 1) {
#pragma unroll
                        for (int i = 0; i < 4; ++i)
#pragma unroll
                            for (int j = 0; j < 4; ++j) *(f32x4*)(P1 + (wm * 64 + i * 16 + lr) * 68 + j * 16 + lq * 4) = acc[i][j];
                    }
                    __syncthreads();
                    if (wn == 0) {
                        const float* pes = (const float*)(p.ws + WS_PESUM) + c * 64;
#pragma unroll
                        for (int i = 0; i < 4; ++i)
#pragma unroll
                            for (int j = 0; j < 4; ++j) {
                                const int rl = wm * 64 + i * 16 + lr, o0 = j * 16 + lq * 4;
                                const f32x4 nx = (rl < 127) ? *(const f32x4*)(P1 + (rl + 1) * 68 + o0) : (f32x4){0.f, 0.f, 0.f, 0.f};
                                const f32x4 pe4 = *(const f32x4*)(pes + o0);
                                f32x4 hv = acc[i][j] + nx + pe4;
                                hv[0] = gelu_tanh(hv[0]); hv[1] = gelu_tanh(hv[1]); hv[2] = gelu_tanh(hv[2]); hv[3] = gelu_tanh(hv[3]);
                                store_bf16x4(HL + rl * 72 + o0, hv);
                            }
                    }
                    __syncthreads();
                    f32x4 kc[2][4];
#pragma unroll
                    for (int i = 0; i < 2; ++i)
#pragma unroll
                        for (int j = 0; j < 4; ++j) kc[i][j] = (f32x4){0.f, 0.f, 0.f, 0.f};
#pragma unroll
                    for (int ks = 0; ks < 2; ++ks) {
                        bf16x8 hf[2], wf[4];
#pragma unroll
                        for (int i = 0; i < 2; ++i) hf[i] = *(const bf16x8*)(HL + (w * 32 + i * 16 + lr) * 72 + ks * 32 + lq * 8);
#pragma unroll
                        for (int j = 0; j < 4; ++j) wf[j] = *(const bf16x8*)(W2_T + ((size_t)c * 64 + j * 16 + lr) * 64 + ks * 32 + lq * 8);
#pragma unroll
                        for (int i = 0; i < 2; ++i)
#pragma unroll
                            for (int j = 0; j < 4; ++j) kc[i][j] = __builtin_amdgcn_mfma_f32_16x16x32_bf16(wf[j], hf[i], kc[i][j], 0, 0, 0);
                    }
#pragma unroll
                    for (int i = 0; i < 2; ++i) {
                        const int rl = w * 32 + i * 16 + lr, blk = n0 + rl;
                        if (rl < 127 && blk <= NCH - 2) {
#pragma unroll
                            for (int j = 0; j < 4; ++j) {
                                const int o2 = j * 16 + lq * 4;
                                if (c == 0) store_bf16x4((grp ? (bf16_t*)(p.ws + WS_KCSB) : KCB) + ((size_t)bh * NCH + blk) * 64 + o2, kc[i][j]);
                                else { bf16_t* vt = (grp ? (bf16_t*)(p.ws + WS_VTCS) : VTC) + ((size_t)bh * 64 + o2) * NCH + blk;
                                       const unsigned w0 = cvt_pk_bf16(kc[i][j][0], kc[i][j][1]), w1 = cvt_pk_bf16(kc[i][j][2], kc[i][j][3]);
                                       vt[0] = (bf16_t)(w0 & 0xffffu); vt[NCH] = (bf16_t)(w0 >> 16); vt[2 * NCH] = (bf16_t)(w1 & 0xffffu); vt[3 * NCH] = (bf16_t)(w1 >> 16); }
                            }
                        }
                    }
                    __syncthreads();
                }, ldsb, 4 * 514 + c * 608 + grp * 32);
        }
    }
    xcd_barrier(bar);

    for (;;) {
        __syncthreads();
        if (tid == 0) *(volatile int*)(ldsb + 32768) = (int)atomicAdd((unsigned*)(p.ws + WS_BAR) + 2, 1u);
        __syncthreads();
        const int idx = *(volatile int*)(ldsb + 32768);
        if (idx >= 448 + 2048) break;
        if (idx < 256) mlstm_chunk_item(p, idx, ldsb);
        else if (idx < 384) mlstm_scan_item(p, 64 + (idx - 256), lds);
        else if (idx < 448) nsa_sample_item(p, (idx - 384) >> 1, idx & 1, ldsb);
        else { const int i2 = idx - 448; nsa_prompt_item(p, (i2 & 31) >> 1, i2 & 1, 63 - (i2 >> 5), ldsb); }
    }
    xcd_barrier(bar);

    for (int it = gw; it < NR * 4; it += nw) {
        const int row = it >> 2, h = it & 3;
        const float x0 = HRAW[(size_t)row * 512 + h * 128 + lane], x1 = HRAW[(size_t)row * 512 + h * 128 + 64 + lane];
        const float mu = wave_sum(x0 + x1) * (1.0f / 128.0f);
        const float d0 = x0 - mu, d1 = x1 - mu;
        const float var = wave_sum(d0 * d0 + d1 * d1) * (1.0f / 128.0f);
        const float rstd = 1.0f / sqrtf(var + LN_EPS);
        const int c0 = h * 128 + lane, c1 = c0 + 64;
        MOUTB[(size_t)row * 512 + c0] = (bf16_t)(cvt_pk_bf16(sigmoidf_(bf_lo((unsigned)ZB[(size_t)row * IN_DIM + C_O + c0])) * (d0 * rstd * p.norm_g[c0]), 0.f) & 0xffffu);
        MOUTB[(size_t)row * 512 + c1] = (bf16_t)(cvt_pk_bf16(sigmoidf_(bf_lo((unsigned)ZB[(size_t)row * IN_DIM + C_O + c1])) * (d1 * rstd * p.norm_g[c1]), 0.f) & 0xffffu);
    }
    xcd_barrier(bar);

    gemm_glds(NR, 1024, 512,
        [&](int r, int k) { return MOUTB + (size_t)r * 512 + k; },
        [&](int n, int k) { return WUPM_T + (size_t)n * 512 + k; },
        [&](int r, int c0, f32x4 v) {
            const uint2 gw2 = *(const uint2*)(ZB + (size_t)r * IN_DIM + C_GM + c0); const f32x4 g = {bf_lo(gw2.x), bf_hi(gw2.x), bf_lo(gw2.y), bf_hi(gw2.y)};
            f32x4 o; o[0] = sigmoidf_(g[0]) * v[0]; o[1] = sigmoidf_(g[1]) * v[1]; o[2] = sigmoidf_(g[2]) * v[2]; o[3] = sigmoidf_(g[3]) * v[3];
            *(f32x4*)(MIX + (size_t)r * 1024 + c0) = o; }, smem + 1024);
    gemm_glds(NR, 1024, 512,
        [&](int r, int k) { return NOUTB + (size_t)r * 512 + k; },
        [&](int n, int k) { return WUPN_T + (size_t)n * 512 + k; },
        [&](int r, int c0, f32x4 v) {
            const uint2 gw2 = *(const uint2*)(ZB + (size_t)r * IN_DIM + C_GN + c0); const f32x4 g = {bf_lo(gw2.x), bf_hi(gw2.x), bf_lo(gw2.y), bf_hi(gw2.y)};
            f32x4 o = *(const f32x4*)(MIX + (size_t)r * 1024 + c0);
            o[0] += sigmoidf_(g[0]) * v[0]; o[1] += sigmoidf_(g[1]) * v[1]; o[2] += sigmoidf_(g[2]) * v[2]; o[3] += sigmoidf_(g[3]) * v[3];
            store_bf16x4(MIXB + (size_t)r * 1024 + c0, o); }, smem + 1024);
    xcd_barrier(bar);

    gemm_glds(NR, 1024, 1024,
        [&](int r, int k) { return MIXB + (size_t)r * 1024 + k; },
        [&](int n, int k) { return WOUT_T + (size_t)n * 1024 + k; },
        [&](int r, int c0, f32x4 v) {
            const f32x4 xv = *(const f32x4*)((r < NP ? p.x_prompt + (size_t)r * 1024 : p.x_sample + (size_t)(r - NP) * 1024) + c0);
            *(f32x4*)(T1 + (size_t)r * 1024 + c0) = xv * DN_ALPHA + v; }, smem + 1024);
    xcd_barrier(bar);

    for (int row = gw; row < NR; row += nw) {
        float tv[16]; float s = 0.f;
#pragma unroll
        for (int j = 0; j < 4; ++j) { const float4 t4 = *(const float4*)(T1 + (size_t)row * 1024 + j * 256 + lane * 4); tv[4 * j] = t4.x; tv[4 * j + 1] = t4.y; tv[4 * j + 2] = t4.z; tv[4 * j + 3] = t4.w; s += (t4.x + t4.y) + (t4.z + t4.w); }
        const float mu = wave_sum(s) * (1.0f / 1024.0f);
        float q = 0.f;
#pragma unroll
        for (int j = 0; j < 16; ++j) { const float d = tv[j] - mu; q += d * d; }
        const float rstd = 1.0f / sqrtf(wave_sum(q) * (1.0f / 1024.0f) + LN_EPS);
#pragma unroll
        for (int j = 0; j < 4; ++j) {
            const int c = j * 256 + lane * 4;
            const float4 g4 = *(const float4*)(p.ln1_g + c), b4 = *(const float4*)(p.ln1_b + c);
            f32x4 o; o[0] = (tv[4 * j] - mu) * rstd * g4.x + b4.x; o[1] = (tv[4 * j + 1] - mu) * rstd * g4.y + b4.y; o[2] = (tv[4 * j + 2] - mu) * rstd * g4.z + b4.z; o[3] = (tv[4 * j + 3] - mu) * rstd * g4.w + b4.w;
            *(f32x4*)(X1 + (size_t)row * 1024 + c) = o;
            store_bf16x4(X1B + (size_t)row * 1024 + c, o);
        }
    }
    xcd_barrier(bar);

    gemm_glds(NR, 2048, 1024,
        [&](int r, int k) { return X1B + (size_t)r * 1024 + k; },
        [&](int n, int k) { return PWQ_T + (size_t)n * 1024 + k; },
        [&](int r, int c0, f32x4 v) { store_bf16x4(QPB + (size_t)r * 2048 + c0, v); }, smem + 1024);
    xcd_barrier(bar);

    for (int it = blockIdx.x; it < 513 * 8; it += gridDim.x) { __syncthreads(); peer_score_topk_item(p, it >> 3, it & 7, ldsb); }
    xcd_barrier(bar);

    for (int row = gw; row < NR; row += nw) peer_expert_wave(p, row, ldsb + w * 3072, lane);
}

extern "C" void kernel_launch(void* const* d_in, const int* in_sizes, int n_in, void* d_out, int out_size, void* d_ws, size_t ws_size, hipStream_t stream) {
    static int grid = 0;
    if (grid == 0) {
        if (n_in != 32 || (size_t)out_size != O_END || ws_size < WS_END) {
            fprintf(stderr, "kernel_launch: unexpected sizes n_in %d out %d ws %zu (need %zu)\n", n_in, out_size, ws_size, (size_t)WS_END); grid = -1; return; }
        int dev = 0, cus = 0, per_cu = 0;
        if (hipGetDevice(&dev) != hipSuccess || hipDeviceGetAttribute(&cus, hipDeviceAttributeMultiprocessorCount, dev) != hipSuccess) { grid = -1; return; }
        if (hipFuncSetAttribute((const void*)fwd_kernel, hipFuncAttributeMaxDynamicSharedMemorySize, LDS_BYTES) != hipSuccess) { fprintf(stderr, "hipFuncSetAttribute failed\n"); grid = -1; return; }
        if (hipOccupancyMaxActiveBlocksPerMultiprocessor(&per_cu, (const void*)fwd_kernel, NTHREADS, LDS_BYTES) != hipSuccess || per_cu < 1) { fprintf(stderr, "occupancy query failed (%d)\n", per_cu); (void)hipGetLastError(); per_cu = 1; }
        if (per_cu > 2) per_cu = 2;
        grid = cus * per_cu;
    }
    if (grid < 0) return;
    (void)hipMemsetAsync((char*)d_ws + WS_BAR, 0, XCD_BAR_WORDS * sizeof(unsigned), stream);
    Params p{};
    p.x_prompt = (const float*)d_in[0]; p.x_sample = (const float*)d_in[1]; p.cache_cmp = (const float*)d_in[2]; p.cache_slc = (const float*)d_in[3];
    p.page_table = (const int*)d_in[4]; p.state_win = (const float*)d_in[5]; p.state_C = (const float*)d_in[6]; p.state_n = (const float*)d_in[7];
    p.state_m = (const float*)d_in[8]; p.state_conv = (const float*)d_in[9]; p.w_in = (const float*)d_in[10]; p.conv_w = (const float*)d_in[11];
    p.conv_b = (const float*)d_in[12]; p.wq = (const float*)d_in[13]; p.wk = (const float*)d_in[14]; p.gate_bias = (const float*)d_in[15];
    p.norm_g = (const float*)d_in[16]; p.cmp_pe = (const float*)d_in[17]; p.cmp_w1 = (const float*)d_in[18]; p.cmp_w2 = (const float*)d_in[19];
    p.rel_bias = (const float*)d_in[20]; p.w_up_m = (const float*)d_in[21]; p.w_up_n = (const float*)d_in[22]; p.w_out = (const float*)d_in[23];
    p.ln1_g = (const float*)d_in[24]; p.ln1_b = (const float*)d_in[25]; p.ln2_g = (const float*)d_in[26]; p.ln2_b = (const float*)d_in[27];
    p.peer_wq = (const float*)d_in[28]; p.peer_sub = (const float*)d_in[29]; p.peer_u = (const float*)d_in[30]; p.peer_v = (const float*)d_in[31];
    p.out = (float*)d_out; p.ws = (unsigned char*)d_ws;
    hipLaunchKernelGGL(fwd_kernel, dim3(grid), dim3(NTHREADS), LDS_BYTES, stream, p);
}
```

```cpp
#include <hip/hip_runtime.h>
#include <stdint.h>
#include <cstdio>

#define DEV __device__ __forceinline__

constexpr int DM = 1024;
constexpr int BP = 16, TP = 2048, BS = 32;
constexpr int NP = BP * TP;
constexpr int NR = NP + BS;
constexpr int MP = 32896;
constexpr int IN_DIM = 4896;
constexpr int C_U = 0, C_V = 512, C_O = 1024, C_I = 1536, C_F = 1540, C_Q = 1544, C_KC = 2056, C_KS = 2312, C_KW = 2568, C_G = 2824, C_GM = 2848, C_GN = 3872;
constexpr int PAST = 16384;
constexpr float NEGF = -1e30f;
constexpr float DN_ALPHA = 1.189207115002721f;
constexpr float LN_EPS = 1e-5f;
constexpr float LOG2E = 1.4426950408889634f;

constexpr size_t O_Y = 0;
constexpr size_t O_CMPP = (size_t)NR * DM;
constexpr size_t O_CMPS = O_CMPP + (size_t)NP * 256;
constexpr size_t O_SLCP = O_CMPS + (size_t)BS * 256;
constexpr size_t O_SLCS = O_SLCP + (size_t)NP * 256;
constexpr size_t O_WINP = O_SLCS + (size_t)BS * 256;
constexpr size_t O_WINS = O_WINP + (size_t)BP * 512 * 256;
constexpr size_t O_CP = O_WINS + (size_t)BS * 512 * 256;
constexpr size_t O_CS = O_CP + (size_t)BP * 4 * 128 * 128;
constexpr size_t O_NP = O_CS + (size_t)BS * 4 * 128 * 128;
constexpr size_t O_NS = O_NP + (size_t)BP * 4 * 128;
constexpr size_t O_MP = O_NS + (size_t)BS * 4 * 128;
constexpr size_t O_MS = O_MP + (size_t)BP * 4;
constexpr size_t O_CVP = O_MS + (size_t)BS * 4;
constexpr size_t O_CVS = O_CVP + (size_t)BP * 3 * 512;
constexpr size_t O_END = O_CVS + (size_t)BS * 3 * 512;
static_assert(O_END == 59916480, "output size");

constexpr size_t al256(size_t x) { return (x + 255) & ~(size_t)255; }
constexpr size_t WS_BAR = 0;
constexpr size_t WS_Z = 16384;
constexpr size_t WS_QK = al256(WS_Z + (size_t)MP * 32 * 4);
constexpr size_t WS_HRAW = al256(WS_QK + 256);
constexpr size_t WS_MOUTB = al256(WS_HRAW + (size_t)MP * 512 * 4);
constexpr size_t WS_NOUTB = al256(WS_MOUTB + (size_t)MP * 512 * 2);
constexpr size_t WS_HIDPB = al256(WS_NOUTB + (size_t)MP * 512 * 2);
constexpr size_t WS_KCP = al256(WS_HIDPB + (size_t)2 * 4096 * 64 * 2);
constexpr size_t WS_HIDSB = al256(WS_KCP + 256);
constexpr size_t WS_KCS = al256(WS_HIDSB + (size_t)2 * 65536 * 64 * 2);
constexpr size_t WS_MIX = al256(WS_KCS + (size_t)2 * 65536 * 64 * 4);
constexpr size_t WS_MIXB = al256(WS_MIX + (size_t)MP * 1024 * 4);
constexpr size_t WS_T1 = al256(WS_MIXB + (size_t)MP * 1024 * 2);
constexpr size_t WS_X1 = al256(WS_T1 + (size_t)MP * 1024 * 4);
constexpr size_t WS_X1B = al256(WS_X1 + (size_t)MP * 1024 * 4);
constexpr size_t WS_QPB = al256(WS_X1B + (size_t)MP * 1024 * 2);
constexpr size_t WS_S = al256(WS_QPB + (size_t)MP * 2048 * 2);
constexpr size_t WS_PIDX = al256(WS_S + (size_t)MP * 2048 * 4);
constexpr size_t WS_PG = al256(WS_PIDX + (size_t)MP * 128 * 4);
constexpr size_t WS_CONVB = al256(WS_PG + (size_t)MP * 128 * 4);
constexpr size_t WS_XB = al256(WS_CONVB + (size_t)MP * 512 * 2);
constexpr size_t WS_WIN_T = al256(WS_XB + (size_t)MP * 1024 * 2);
constexpr size_t WS_WUPM_T = al256(WS_WIN_T + (size_t)IN_DIM * 1024 * 2);
constexpr size_t WS_WUPN_T = al256(WS_WUPM_T + (size_t)1024 * 512 * 2);
constexpr size_t WS_WOUT_T = al256(WS_WUPN_T + (size_t)1024 * 512 * 2);
constexpr size_t WS_PWQ_T = al256(WS_WOUT_T + (size_t)1024 * 1024 * 2);
constexpr size_t WS_WQK_T = al256(WS_PWQ_T + (size_t)2048 * 1024 * 2);
constexpr size_t WS_W1_T = al256(WS_WQK_T + (size_t)4 * 256 * 128 * 2);
constexpr size_t WS_PESUM = al256(WS_W1_T + (size_t)2 * 128 * 1024 * 2);
constexpr size_t WS_W2_T = al256(WS_PESUM + 512);
constexpr size_t WS_SUBK = al256(WS_W2_T + (size_t)2 * 64 * 64 * 2);
constexpr size_t WS_ZB = al256(WS_SUBK + (size_t)2 * 128 * 128 * 2);
constexpr size_t WS_VTS = al256(WS_ZB + (size_t)MP * IN_DIM * 2);
constexpr size_t WS_VTW = al256(WS_VTS + (size_t)16 * 2 * 64 * 2048 * 2);
constexpr size_t WS_KCB = al256(WS_VTW + (size_t)16 * 2 * 64 * 2048 * 2);
constexpr size_t WS_VTC = al256(WS_KCB + (size_t)16 * 2 * 128 * 64 * 2);
constexpr size_t WS_NOUTF = al256(WS_VTC + (size_t)16 * 2 * 64 * 128 * 2);
constexpr size_t WS_U8 = al256(WS_NOUTF + (size_t)NP * 512 * 4);
constexpr size_t WS_V8 = al256(WS_U8 + (size_t)16384 * 1024);
constexpr size_t WS_QB = al256(WS_V8 + (size_t)16384 * 1024);
constexpr size_t WS_KB = al256(WS_QB + (size_t)MP * 512 * 2);
constexpr size_t WS_KTB = al256(WS_KB + (size_t)MP * 512 * 2);
constexpr size_t WS_VTM = al256(WS_KTB + (size_t)16 * 512 * 2048 * 2);
constexpr size_t WS_KCSB = al256(WS_VTM + (size_t)16 * 512 * 2048 * 2);
constexpr size_t WS_VTCS = al256(WS_KCSB + (size_t)32 * 2 * 1024 * 64 * 2);
constexpr size_t WS_END = al256(WS_VTCS + (size_t)32 * 2 * 64 * 1024 * 2);

static_assert(WS_END <= 2684354560ull, "workspace too large");
constexpr int LDS_BYTES = 73728;
constexpr int NTHREADS = 256;

struct Params {
    const float* x_prompt; const float* x_sample; const float* cache_cmp; const float* cache_slc; const int* page_table;
    const float* state_win; const float* state_C; const float* state_n; const float* state_m; const float* state_conv;
    const float* w_in; const float* conv_w; const float* conv_b; const float* wq; const float* wk; const float* gate_bias; const float* norm_g;
    const float* cmp_pe; const float* cmp_w1; const float* cmp_w2; const float* rel_bias; const float* w_up_m; const float* w_up_n; const float* w_out;
    const float* ln1_g; const float* ln1_b; const float* ln2_g; const float* ln2_b; const float* peer_wq; const float* peer_sub; const float* peer_u; const float* peer_v;
    float* out; unsigned char* ws;
};

#define XB_TMO      128
#define XB_XCNT(j)  (256  + 64 * (j))
#define XB_XSUB(j)  (1280 + 64 * (j))
#define XB_XGEN(j)  (2304 + 64 * (j))
#define XB_TOP      3328
#define XB_TOPGEN   3392
#define XCD_BAR_WORDS 3456
#define XB_SPIN_CAP (1u << 22)
#define LAS __attribute__((address_space(3)))

__device__ __forceinline__ unsigned xb_ld(unsigned* p)              { return __hip_atomic_load(p, __ATOMIC_RELAXED, __HIP_MEMORY_SCOPE_AGENT); }
__device__ __forceinline__ unsigned xb_add(unsigned* p, unsigned v) { return __hip_atomic_fetch_add(p, v, __ATOMIC_RELAXED, __HIP_MEMORY_SCOPE_AGENT); }
__device__ __forceinline__ unsigned xb_xcc_id() { return (unsigned)__builtin_amdgcn_s_getreg((3 << 11) | 20) & 0xFu; }
#define XB_SPIN(cond, bar) do { unsigned _sp = 0; while (cond) { __builtin_amdgcn_s_sleep(1); \
    if ((++_sp & 255u) == 0u) { if (xb_ld(&(bar)[XB_TMO])) break; if (_sp > XB_SPIN_CAP) { atomicAdd(&(bar)[XB_TMO], 1u); break; } } } } while (0)

struct XcdBarrier { unsigned* bar; unsigned x; volatile LAS unsigned* st; };

__device__ __forceinline__ XcdBarrier xcd_barrier_post(unsigned* bar, volatile LAS unsigned* st) {
    XcdBarrier b; b.bar = bar; b.x = xb_xcc_id(); b.st = st;
    if (threadIdx.x == 0) (void)xb_add(&bar[XB_XCNT(b.x)], 1u);
    return b;
}
__device__ __forceinline__ void xcd_barrier_complete(unsigned* bar, unsigned x, unsigned& nloc, unsigned& nx) {
    const unsigned G = gridDim.x * gridDim.y * gridDim.z;
    unsigned sum, cnt, mine, sp = 0u;
    for (;;) {
        sum = 0u; cnt = 0u; mine = 0u;
#pragma unroll
        for (unsigned j = 0; j < 16; ++j) { const unsigned c = xb_ld(&bar[XB_XCNT(j)]); sum += c; cnt += (c > 0u) ? 1u : 0u; mine = (j == x) ? c : mine; }
        if (sum == G) break;
        __builtin_amdgcn_s_sleep(1);
        if ((++sp & 255u) == 0u) { if (xb_ld(&bar[XB_TMO])) break; if (sp > XB_SPIN_CAP) { atomicAdd(&bar[XB_TMO], 1u); break; } }
    }
    nloc = mine > 0u ? mine : 1u; nx = cnt > 0u ? cnt : 1u;
}
__device__ __forceinline__ void xcd_barrier(const XcdBarrier& b) {
    asm volatile("s_waitcnt vmcnt(0)" ::: "memory");
    __syncthreads();
    if (threadIdx.x == 0) {
        unsigned* bar = b.bar;
        __builtin_amdgcn_s_waitcnt(0);
        unsigned nloc = b.st[0], nx = b.st[1];
        if (nloc == 0u) { xcd_barrier_complete(bar, b.x, nloc, nx); b.st[0] = nloc; b.st[1] = nx; }
        const unsigned old = xb_add(&bar[XB_XSUB(b.x)], 1u);
        const unsigned gen = old / nloc;
        if (old + 1u == (gen + 1u) * nloc) {
            __builtin_amdgcn_fence(__ATOMIC_RELEASE, "agent");
            asm volatile("s_waitcnt vmcnt(0)" ::: "memory");
            const unsigned og = xb_add(&bar[XB_TOP], 1u);
            const unsigned tg = og / nx;
            if (og + 1u == (tg + 1u) * nx) xb_add(&bar[XB_TOPGEN], 1u);
            else XB_SPIN(xb_ld(&bar[XB_TOPGEN]) == tg, bar);
            __builtin_amdgcn_fence(__ATOMIC_ACQUIRE, "agent");
            xb_add(&bar[XB_XGEN(b.x)], 1u);
            asm volatile("s_waitcnt vmcnt(0)" ::: "memory");
        } else {
            XB_SPIN(xb_ld(&bar[XB_XGEN(b.x)]) == gen, bar);
            __builtin_amdgcn_fence(__ATOMIC_ACQUIRE, "agent");
            asm volatile("s_waitcnt vmcnt(0)" ::: "memory");
        }
    }
    __syncthreads();
}

typedef float f32x4 __attribute__((ext_vector_type(4)));

__device__ const unsigned char REL_LUT[128] = {
    0, 1, 2, 3, 4, 5, 6, 7, 8, 9, 10, 11, 12, 13, 14, 15, 16, 16, 16, 17, 17, 18, 18, 18, 19, 19, 19, 20, 20, 20, 20, 21, 21, 21, 21, 22, 22, 22, 22, 22,
    23, 23, 23, 23, 23, 23, 24, 24, 24, 24, 24, 24, 25, 25, 25, 25, 25, 25, 25, 26, 26, 26, 26, 26, 26, 26, 26, 27, 27, 27, 27, 27, 27, 27, 27, 27, 27,
    28, 28, 28, 28, 28, 28, 28, 28, 28, 28, 29, 29, 29, 29, 29, 29, 29, 29, 29, 29, 29, 29, 30, 30, 30, 30, 30, 30, 30, 30, 30, 30, 30, 30, 30, 30,
    31, 31, 31, 31, 31, 31, 31, 31, 31, 31, 31, 31, 31, 31, 31};
DEV int rel_bucket(int n) { return n < 128 ? (int)REL_LUT[n < 0 ? 0 : n] : 31; }

DEV float sigmoidf_(float x) { return 1.0f / (1.0f + expf(-x)); }
DEV float gelu_tanh(float x) { return 0.5f * x * (1.0f + tanhf(0.7978845608028654f * (x + 0.044715f * x * x * x))); }
DEV float log_sigmoid(float x) { return x >= 0.f ? -log1pf(expf(-x)) : x - log1pf(expf(x)); }
DEV void wave_sync() { asm volatile("s_waitcnt lgkmcnt(0)" ::: "memory"); __builtin_amdgcn_wave_barrier(); asm volatile("" ::: "memory"); }
DEV float wave_sum(float v) {
#pragma unroll
    for (int o = 32; o >= 1; o >>= 1) v += __shfl_xor(v, o);
    return v;
}
DEV float wave_max(float v) {
#pragma unroll
    for (int o = 32; o >= 1; o >>= 1) v = fmaxf(v, __shfl_xor(v, o));
    return v;
}

typedef unsigned short bf16_t;
typedef short bf16x8 __attribute__((ext_vector_type(8)));
typedef float f32x2_ __attribute__((ext_vector_type(2)));
typedef __bf16 bf16x2_ __attribute__((ext_vector_type(2)));
DEV unsigned cvt_pk_bf16(float lo, float hi) { const f32x2_ v = {lo, hi}; return __builtin_bit_cast(unsigned, __builtin_convertvector(v, bf16x2_)); }
DEV float bf_lo(unsigned w) { return __uint_as_float(w << 16); }
DEV float bf_hi(unsigned w) { return __uint_as_float(w & 0xffff0000u); }
DEV uint4 pack8(const float* f) { uint4 r; r.x = cvt_pk_bf16(f[0], f[1]); r.y = cvt_pk_bf16(f[2], f[3]); r.z = cvt_pk_bf16(f[4], f[5]); r.w = cvt_pk_bf16(f[6], f[7]); return r; }
DEV void store_bf16x4(bf16_t* p, f32x4 v) { uint2 w; w.x = cvt_pk_bf16(v[0], v[1]); w.y = cvt_pk_bf16(v[2], v[3]); *(uint2*)p = w; }

DEV void transpose_to_bf16(const float* __restrict__ src, const int K, const int N, bf16_t* __restrict__ dst, const size_t gt, const size_t nt) {
    const size_t items = (size_t)N * (K >> 3);
    for (size_t id = gt; id < items; id += nt) {
        const int n = (int)(id % N), k8 = (int)(id / N) * 8;
        float f[8];
#pragma unroll
        for (int i = 0; i < 8; ++i) f[i] = src[(size_t)(k8 + i) * N + n];
        *(uint4*)(dst + (size_t)n * K + k8) = pack8(f);
    }
}

template <int BN, bool TILE_EPI = false, class LA, class LB, class EF>
DEV void gemm_bf16(const int M, const int N, const int K, LA la, LB lb, EF ef, unsigned char* lds, const int toff = 0) {
    constexpr int TJ = BN / 32;
    constexpr int NB = BN / 32;
    constexpr int LDR = 144;
    const int tid = threadIdx.x, lane = tid & 63, w = tid >> 6, wm = w >> 1, wn = w & 1;
    const int tm = (M + 127) >> 7, tn = (N + BN - 1) / BN;
    unsigned char* As = lds;
    unsigned char* Bs = lds + 128 * LDR;
    const int lr = lane & 15, lq = lane >> 4;
    for (int tile = (int)((blockIdx.x + gridDim.x - (unsigned)toff % gridDim.x) % gridDim.x); tile < tm * tn; tile += gridDim.x) {
        const int bm = (tile / tn) * 128, bn = (tile % tn) * BN;
        f32x4 acc[4][TJ];
#pragma unroll
        for (int i = 0; i < 4; ++i)
#pragma unroll
            for (int j = 0; j < TJ; ++j) acc[i][j] = (f32x4){0.f, 0.f, 0.f, 0.f};
        uint4 ra[4], rb[NB];
        int arow[4], brow[NB];
#pragma unroll
        for (int i = 0; i < 4; ++i) { const int r = bm + ((tid + 256 * i) >> 3); arow[i] = r < M ? r : M - 1; }
#pragma unroll
        for (int i = 0; i < NB; ++i) { const int n = bn + ((tid + 256 * i) >> 3); brow[i] = n < N ? n : N - 1; }
        const int kc = (tid & 7) * 8;
#pragma unroll
        for (int i = 0; i < 4; ++i) ra[i] = la(arow[i], kc);
#pragma unroll
        for (int i = 0; i < NB; ++i) rb[i] = lb(brow[i], kc);
        for (int k0_ = 0; k0_ < K; k0_ += 64) {
            int k0 = k0_; asm volatile("" : "+v"(k0));
            __syncthreads();
#pragma unroll
            for (int i = 0; i < 4; ++i) *(uint4*)(As + ((tid + 256 * i) >> 3) * LDR + (tid & 7) * 16) = ra[i];
#pragma unroll
            for (int i = 0; i < NB; ++i) *(uint4*)(Bs + ((tid + 256 * i) >> 3) * LDR + (tid & 7) * 16) = rb[i];
            __syncthreads();
            if (k0_ + 64 < K) {
#pragma unroll
                for (int i = 0; i < 4; ++i) ra[i] = la(arow[i], k0 + 64 + kc);
#pragma unroll
                for (int i = 0; i < NB; ++i) rb[i] = lb(brow[i], k0 + 64 + kc);
            }
#pragma unroll
            for (int kk = 0; kk < 2; ++kk) {
                bf16x8 a[4], b[TJ];
#pragma unroll
                for (int i = 0; i < 4; ++i) a[i] = *(const bf16x8*)(As + (wm * 64 + i * 16 + lr) * LDR + kk * 64 + lq * 16);
#pragma unroll
                for (int j = 0; j < TJ; ++j) b[j] = *(const bf16x8*)(Bs + (wn * (BN / 2) + j * 16 + lr) * LDR + kk * 64 + lq * 16);
#pragma unroll
                for (int i = 0; i < 4; ++i)
#pragma unroll
                    for (int j = 0; j < TJ; ++j) acc[i][j] = __builtin_amdgcn_mfma_f32_16x16x32_bf16(b[j], a[i], acc[i][j], 0, 0, 0);
            }
        }
        if constexpr (TILE_EPI) { ef(acc, bm); }
        else {
#pragma unroll
            for (int i = 0; i < 4; ++i)
#pragma unroll
                for (int j = 0; j < TJ; ++j) {
                    const int r = bm + wm * 64 + i * 16 + lr, c0 = bn + wn * (BN / 2) + j * 16 + lq * 4;
                    if (r < M && c0 < N) ef(r, c0, acc[i][j]);
                }
        }
    }
}

DEV int lds_byte2(int r, int c) { const int st = (r >> 4) * 2 + (c >> 5), ob = (r & 15) * 64 + (c & 31) * 2; return st * 1024 + (ob ^ (((ob >> 9) & 1) << 5)); }
DEV void stage_rc2(int b, int& R, int& C) { const int st = b >> 10, sb = b & 1023, swz = sb ^ (((sb >> 9) & 1) << 5); R = (st >> 1) * 16 + swz / 64; C = (st & 1) * 32 + (swz % 64) / 2; }
struct NoMid { DEV void operator()(int, int, f32x4&, f32x4&) const {} };
template <class PA, class PB, class EF, class MF = NoMid>
DEV void gemm_glds(const int M, const int N, const int K, PA pa, PB pb, EF ef, unsigned char* lds, const int toff = 0, const int ksplit = 0, MF mf = MF()) {
    const int tid = threadIdx.x, lane = tid & 63, w = tid >> 6, wm = w >> 1, wn = w & 1;
    const int tm = (M + 127) >> 7, tn = (N + 127) >> 7;
    const int lr = lane & 15, lq = lane >> 4;
    const int nk = K >> 6;
    int sR[4], sC[4];
#pragma unroll
    for (int i = 0; i < 4; ++i) stage_rc2((w + 4 * i) * 1024 + lane * 16, sR[i], sC[i]);
    for (int tile = (int)((blockIdx.x + gridDim.x - (unsigned)toff % gridDim.x) % gridDim.x); tile < tm * tn; tile += gridDim.x) {
        const int bm = (tile / tn) * 128, bn = (tile % tn) * 128;
        f32x4 acc[4][4], keep[4][4];
#pragma unroll
        for (int i = 0; i < 4; ++i)
#pragma unroll
            for (int j = 0; j < 4; ++j) { acc[i][j] = (f32x4){0.f, 0.f, 0.f, 0.f}; keep[i][j] = (f32x4){0.f, 0.f, 0.f, 0.f}; }
        int arow[4], brow[4];
#pragma unroll
        for (int i = 0; i < 4; ++i) { const int r = bm + sR[i], n = bn + sR[i]; arow[i] = r < M ? r : M - 1; brow[i] = n < N ? n : N - 1; }
#define GLDS_STAGE(BUF, KT) { _Pragma("unroll") for (int i = 0; i < 4; ++i) { \
            __builtin_amdgcn_global_load_lds((const unsigned*)pa(arow[i], (KT) * 64 + sC[i]), (LAS unsigned*)(lds + (BUF) * 32768 + (w + 4 * i) * 1024), 16, 0, 0); \
            __builtin_amdgcn_global_load_lds((const unsigned*)pb(brow[i], (KT) * 64 + sC[i]), (LAS unsigned*)(lds + (BUF) * 32768 + 16384 + (w + 4 * i) * 1024), 16, 0, 0); } }
        __syncthreads();
        GLDS_STAGE(0, 0)
        asm volatile("s_waitcnt vmcnt(0)" ::: "memory");
        __syncthreads();
        for (int kt = 0; kt < nk; ++kt) {
            const int cur = kt & 1;
            if (kt + 1 < nk) GLDS_STAGE(cur ^ 1, kt + 1)
            const unsigned char* SA = lds + cur * 32768;
            const unsigned char* SB = SA + 16384;
#pragma unroll
            for (int kk = 0; kk < 2; ++kk) {
                bf16x8 a[4], b[4];
#pragma unroll
                for (int i = 0; i < 4; ++i) a[i] = *(const bf16x8*)(SA + lds_byte2(wm * 64 + i * 16 + lr, kk * 32 + lq * 8));
#pragma unroll
                for (int j = 0; j < 4; ++j) b[j] = *(const bf16x8*)(SB + lds_byte2(wn * 64 + j * 16 + lr, kk * 32 + lq * 8));
#pragma unroll
                for (int i = 0; i < 4; ++i)
#pragma unroll
                    for (int j = 0; j < 4; ++j) acc[i][j] = __builtin_amdgcn_mfma_f32_16x16x32_bf16(b[j], a[i], acc[i][j], 0, 0, 0);
            }
            if constexpr (!__is_same(MF, NoMid)) {
                if (kt + 1 == ksplit) {
#pragma unroll
                    for (int i = 0; i < 4; ++i)
#pragma unroll
                        for (int j = 0; j < 4; ++j) {
                            const int r = bm + wm * 64 + i * 16 + lr, c0 = bn + wn * 64 + j * 16 + lq * 4;
                            if (r < M && c0 < N) mf(r, c0, acc[i][j], keep[i][j]);
                            acc[i][j] = (f32x4){0.f, 0.f, 0.f, 0.f};
                        }
                }
            }
            asm volatile("s_waitcnt vmcnt(0)" ::: "memory");
            __syncthreads();
        }
#undef GLDS_STAGE
#pragma unroll
        for (int i = 0; i < 4; ++i)
#pragma unroll
            for (int j = 0; j < 4; ++j) {
                const int r = bm + wm * 64 + i * 16 + lr, c0 = bn + wn * 64 + j * 16 + lq * 4;
                if (r < M && c0 < N) { if constexpr (!__is_same(MF, NoMid)) ef(r, c0, acc[i][j], keep[i][j]); else ef(r, c0, acc[i][j]); }
            }
    }
}

DEV void mlstm_scan_item(const Params& p, const int item, float* lds) {
    const int tid = threadIdx.x, v = tid >> 1, kh = tid & 1;
    const int seq = item >> 2, h = item & 3;
    const bool pr = seq < 16; const int b = pr ? seq : seq - 16;
    const int T = pr ? 2048 : 1; const int row0 = pr ? b * 2048 : NP + b;
    const float* Z = (const float*)(p.ws + WS_Z);
    const bf16_t* QBp = (const bf16_t*)(p.ws + WS_QB); const bf16_t* KBp = (const bf16_t*)(p.ws + WS_KB); const bf16_t* ZBp = (const bf16_t*)(p.ws + WS_ZB);
    float* HRAW = (float*)(p.ws + WS_HRAW);
    float C[64], n[64]; float m;
    if (pr) {
#pragma unroll
        for (int j = 0; j < 64; ++j) { C[j] = 0.f; n[j] = 0.f; }
        m = 0.f;
    } else {
        const float* c0 = p.state_C + (((size_t)(b * 4 + h) * 128 + v) * 128 + kh * 64);
        const float* n0 = p.state_n + ((size_t)(b * 4 + h) * 128 + kh * 64);
#pragma unroll
        for (int j = 0; j < 64; ++j) { C[j] = c0[j]; n[j] = n0[j]; }
        m = p.state_m[b * 4 + h];
    }
    const float gb_i = p.gate_bias[h], gb_f = p.gate_bias[4 + h];
    auto load_tok = [&](int t, float* dst) {
        const size_t r = (size_t)(row0 + t);
        dst[tid] = bf_lo((unsigned)(tid < 128 ? QBp[r * 512 + h * 128 + tid] : KBp[r * 512 + h * 128 + tid - 128]));
        if (tid < 128) dst[256 + tid] = bf_lo((unsigned)ZBp[r * IN_DIM + C_V + h * 128 + tid]);
        if (tid == 128) dst[384] = Z[r * 32 + h] + gb_i;
        if (tid == 129) dst[385] = log_sigmoid(Z[r * 32 + 4 + h] + gb_f);
    };
    __syncthreads();
    load_tok(0, lds);
    __syncthreads();
    for (int t = 0; t < T; ++t) {
        const float* cur = lds + (t & 1) * 388;
        if (t + 1 < T) load_tok(t + 1, lds + ((t + 1) & 1) * 388);
        const float ig = cur[384], lf = cur[385];
        const float mn = fmaxf(lf + m, ig);
        const float fd = expf(lf + m - mn), iw = expf(ig - mn);
        const float vv = cur[256 + v] * iw;
        float nump = 0.f, denp = 0.f;
#pragma unroll
        for (int j = 0; j < 64; ++j) {
            const float kj = cur[128 + kh * 64 + j], qj = cur[kh * 64 + j];
            C[j] = fd * C[j] + vv * kj; n[j] = fd * n[j] + iw * kj;
            nump += C[j] * qj; denp += n[j] * qj;
        }
        nump += __shfl_xor(nump, 1); denp += __shfl_xor(denp, 1);
        const float hval = nump / fmaxf(fabsf(denp), expf(-mn));
        if (kh == 0) HRAW[(size_t)(row0 + t) * 512 + h * 128 + v] = hval;
        m = mn;
        __syncthreads();
    }
    float* co = p.out + (pr ? O_CP : O_CS) + (((size_t)(b * 4 + h) * 128 + v) * 128 + kh * 64);
#pragma unroll
    for (int j = 0; j < 64; ++j) co[j] = C[j];
    if (v == 0) {
        float* no = p.out + (pr ? O_NP : O_NS) + ((size_t)(b * 4 + h) * 128 + kh * 64);
#pragma unroll
        for (int j = 0; j < 64; ++j) no[j] = n[j];
    }
    if (tid == 0) p.out[(pr ? O_MP : O_MS) + b * 4 + h] = m;
}

DEV void peer_topk_item(const Params& p, const int row, const int h, const int lane) {
    const float* S = (const float*)(p.ws + WS_S) + (size_t)row * 2048 + h * 256;
    int* PIDX = (int*)(p.ws + WS_PIDX); float* PG = (float*)(p.ws + WS_PG);
    float ts[2]; int ti[2];
#pragma unroll
    for (int pp = 0; pp < 2; ++pp) {
        float v0 = S[pp * 128 + lane], v1 = S[pp * 128 + 64 + lane];
        float mys = 0.f; int myi = 0;
        for (int r = 0; r < 16; ++r) {
            float best = fmaxf(v0, v1); int bi = (v0 >= v1) ? lane : lane + 64;
#pragma unroll
            for (int off = 32; off >= 1; off >>= 1) {
                const float ob = __shfl_xor(best, off); const int oi = __shfl_xor(bi, off);
                if (ob > best || (ob == best && oi < bi)) { best = ob; bi = oi; }
            }
            if (lane == r) { mys = best; myi = bi; }
            if (bi == lane) v0 = -INFINITY;
            if (bi == lane + 64) v1 = -INFINITY;
        }
        ts[pp] = mys; ti[pp] = myi;
    }
    float cv[4];
#pragma unroll
    for (int jj = 0; jj < 4; ++jj) { const int c = lane * 4 + jj; cv[jj] = __shfl(ts[0], c >> 4) + __shfl(ts[1], c & 15); }
    float msc = 0.f; int mci = 0;
    for (int r = 0; r < 16; ++r) {
        float best = cv[0]; int bi = lane * 4;
#pragma unroll
        for (int jj = 1; jj < 4; ++jj) if (cv[jj] > best) { best = cv[jj]; bi = lane * 4 + jj; }
#pragma unroll
        for (int off = 32; off >= 1; off >>= 1) {
            const float ob = __shfl_xor(best, off); const int oi = __shfl_xor(bi, off);
            if (ob > best || (ob == best && oi < bi)) { best = ob; bi = oi; }
        }
        if (lane == r) { msc = best; mci = bi; }
#pragma unroll
        for (int jj = 0; jj < 4; ++jj) if (bi == lane * 4 + jj) cv[jj] = -INFINITY;
    }
    const int e = __shfl(ti[0], mci >> 4) * 128 + __shfl(ti[1], mci & 15);
    const float top = __shfl(msc, 0);
    float ex = (lane < 16) ? expf(msc - top) : 0.f;
    const float den = wave_sum(ex);
    if (lane < 16) { PIDX[(size_t)row * 128 + h * 16 + lane] = e; PG[(size_t)row * 128 + h * 16 + lane] = ex / den; }
}

DEV void peer_expert_item(const Params& p, const int row, float* lds) {
    const int tid = threadIdx.x, lane = tid & 63, w = tid >> 6;
    const float* X1 = (const float*)(p.ws + WS_X1) + (size_t)row * 1024;
    const int* PIDX = (const int*)(p.ws + WS_PIDX) + (size_t)row * 128;
    const float* PG = (const float*)(p.ws + WS_PG) + (size_t)row * 128;
    float4 x[4], acc[4];
#pragma unroll
    for (int j = 0; j < 4; ++j) { x[j] = *(const float4*)(X1 + j * 256 + lane * 4); acc[j] = make_float4(0.f, 0.f, 0.f, 0.f); }
    for (int k = 0; k < 32; ++k) {
        const int e = PIDX[w * 32 + k]; const float gk = PG[w * 32 + k];
        const float* ur = p.peer_u + (size_t)e * 1024; const float* vr = p.peer_v + (size_t)e * 1024;
        float d = 0.f;
#pragma unroll
        for (int j = 0; j < 4; ++j) { const float4 u = *(const float4*)(ur + j * 256 + lane * 4); d += u.x * x[j].x + u.y * x[j].y + u.z * x[j].z + u.w * x[j].w; }
        d = wave_sum(d);
        const float coef = gk * gelu_tanh(d);
#pragma unroll
        for (int j = 0; j < 4; ++j) { const float4 vv = *(const float4*)(vr + j * 256 + lane * 4);
            acc[j].x += coef * vv.x; acc[j].y += coef * vv.y; acc[j].z += coef * vv.z; acc[j].w += coef * vv.w; }
    }
    __syncthreads();
#pragma unroll
    for (int j = 0; j < 4; ++j) *(float4*)(lds + w * 1024 + j * 256 + lane * 4) = acc[j];
    __syncthreads();
    float tv[4]; float s = 0.f;
#pragma unroll
    for (int i = 0; i < 4; ++i) { const int c = tid * 4 + i; const float po = (lds[c] + lds[1024 + c]) + (lds[2048 + c] + lds[3072 + c]); tv[i] = DN_ALPHA * X1[c] + po; s += tv[i]; }
    float* red = lds + 4096;
    s = wave_sum(s);
    if (lane == 0) red[w] = s;
    __syncthreads();
    const float mu = (red[0] + red[1] + red[2] + red[3]) * (1.0f / 1024.0f);
    float q = 0.f;
#pragma unroll
    for (int i = 0; i < 4; ++i) { const float d = tv[i] - mu; q += d * d; }
    q = wave_sum(q);
    if (lane == 0) red[8 + w] = q;
    __syncthreads();
    const float var = (red[8] + red[9] + red[10] + red[11]) * (1.0f / 1024.0f);
    const float rstd = 1.0f / sqrtf(var + LN_EPS);
    float* y = p.out + O_Y + (size_t)row * 1024;
#pragma unroll
    for (int i = 0; i < 4; ++i) { const int c = tid * 4 + i; y[c] = (tv[i] - mu) * rstd * p.ln2_g[c] + p.ln2_b[c]; }
}

DEV void mlstm_chunk_item(const Params& p, const int item, unsigned char* lds) {
    int tid_ = threadIdx.x; asm volatile("" : "+v"(tid_));
    const int tid = tid_, lane = tid & 63, w = tid >> 6, lr = lane & 15, lq = lane >> 4;
    const int b = item >> 4, h = (item >> 2) & 3, vs = item & 3;
    bf16_t* Cl = (bf16_t*)lds;
    bf16_t* nl = (bf16_t*)(lds + 8704);
    float* uL = (float*)(lds + 8960); float* ML = uL + 64; float* scin = uL + 128; float* expm = uL + 192; float* wts = uL + 256; float* misc = uL + 320;
    const bf16_t* QB = (const bf16_t*)(p.ws + WS_QB) + (size_t)(b * 2048) * 512 + h * 128;
    const bf16_t* KB = (const bf16_t*)(p.ws + WS_KB) + (size_t)(b * 2048) * 512 + h * 128;
    const bf16_t* KTB = (const bf16_t*)(p.ws + WS_KTB) + (size_t)((b * 4 + h) * 128) * 2048;
    const bf16_t* VTM = (const bf16_t*)(p.ws + WS_VTM) + (size_t)(b * 512 + h * 128 + vs * 32) * 2048;
    const float* Z = (const float*)(p.ws + WS_Z);
    float* HRAW = (float*)(p.ws + WS_HRAW);
    const float gb_i = p.gate_bias[h], gb_f = p.gate_bias[4 + h];
    f32x4 Cm[2][2], nm[2];
#pragma unroll
    for (int i = 0; i < 2; ++i) { nm[i] = (f32x4){0.f, 0.f, 0.f, 0.f};
#pragma unroll
        for (int j = 0; j < 2; ++j) Cm[i][j] = (f32x4){0.f, 0.f, 0.f, 0.f}; }
    float m_prev = 0.f;
    __syncthreads();
    for (int i = tid; i < (8704 + 256) / 4; i += 256) ((unsigned*)lds)[i] = 0u;
    __syncthreads();
    for (int c = 0; c < 32; ++c) {
        const int t0 = c * 64;
        if (w == 0) {
            const size_t row = (size_t)(b * 2048 + t0 + lane);
            const float ig = Z[row * 32 + h] + gb_i;
            const float lf = log_sigmoid(Z[row * 32 + 4 + h] + gb_f);
            float bc = lf;
#pragma unroll
            for (int o = 1; o < 64; o <<= 1) { const float t = __shfl_up(bc, o); if (lane >= o) bc += t; }
            const float u = ig - bc;
            float pm = u;
#pragma unroll
            for (int o = 1; o < 64; o <<= 1) { const float t = __shfl_up(pm, o); if (lane >= o) pm = fmaxf(pm, t); }
            const float M = fmaxf(m_prev, pm);
            const float M63 = __shfl(M, 63), b63 = __shfl(bc, 63);
            uL[lane] = u; ML[lane] = M; scin[lane] = expf(m_prev - M); expm[lane] = expf(-(bc + M)); wts[lane] = expf(u - M63);
            if (lane == 0) { misc[0] = expf(m_prev - M63); misc[1] = b63 + M63; }
        }
        __syncthreads();
        {
            const size_t row_t = (size_t)(t0 + w * 16 + lr);
            bf16x8 Qf[4];
#pragma unroll
            for (int ks = 0; ks < 4; ++ks) Qf[ks] = *(const bf16x8*)(QB + row_t * 512 + ks * 32 + lq * 8);
            const float M_t = ML[w * 16 + lr], sc_in = scin[w * 16 + lr], em = expm[w * 16 + lr];
            f32x4 sw[4];
            float dsum = 0.f;
#pragma unroll
            for (int st = 0; st < 4; ++st) {
                f32x4 a = (f32x4){0.f, 0.f, 0.f, 0.f};
                if (st <= w) {
#pragma unroll
                    for (int ks = 0; ks < 4; ++ks) { const bf16x8 kf = *(const bf16x8*)(KB + (size_t)(t0 + st * 16 + lr) * 512 + ks * 32 + lq * 8); a = __builtin_amdgcn_mfma_f32_16x16x32_bf16(kf, Qf[ks], a, 0, 0, 0); }
#pragma unroll
                    for (int g = 0; g < 4; ++g) {
                        const int sl = st * 16 + lq * 4 + g, tl = w * 16 + lr;
                        const float wg = (sl <= tl) ? __builtin_amdgcn_exp2f((uL[sl] - M_t) * LOG2E) : 0.f;
                        a[g] *= wg; dsum += a[g];
                    }
                }
                sw[st] = a;
            }
            dsum += __shfl_xor(dsum, 16); dsum += __shfl_xor(dsum, 32);
            bf16x8 pf[2];
#pragma unroll
            for (int ks = 0; ks < 2; ++ks) {
                union { bf16x8 v; unsigned u[4]; } pk;
                pk.u[0] = cvt_pk_bf16(sw[2 * ks][0], sw[2 * ks][1]); pk.u[1] = cvt_pk_bf16(sw[2 * ks][2], sw[2 * ks][3]);
                pk.u[2] = cvt_pk_bf16(sw[2 * ks + 1][0], sw[2 * ks + 1][1]); pk.u[3] = cvt_pk_bf16(sw[2 * ks + 1][2], sw[2 * ks + 1][3]);
                pf[ks] = pk.v;
            }
            f32x4 dI = (f32x4){0.f, 0.f, 0.f, 0.f};
#pragma unroll
            for (int ks = 0; ks < 4; ++ks) { const bf16x8 nf = *(const bf16x8*)(nl + ks * 32 + lq * 8); dI = __builtin_amdgcn_mfma_f32_16x16x32_bf16(nf, Qf[ks], dI, 0, 0, 0); }
            const float den = sc_in * dI[0] + dsum;
            const float rdd = 1.0f / fmaxf(fabsf(den), em);
#pragma unroll
            for (int vt = 0; vt < 2; ++vt) {
                f32x4 ni = (f32x4){0.f, 0.f, 0.f, 0.f}, nI = (f32x4){0.f, 0.f, 0.f, 0.f};
#pragma unroll
                for (int ks = 0; ks < 2; ++ks) if (2 * ks <= w) {
                    union { bf16x8 v; uint2 hh[2]; } vf;
                    const bf16_t* vp = VTM + (size_t)(vt * 16 + lr) * 2048 + t0 + 32 * ks + lq * 4;
                    vf.hh[0] = *(const uint2*)vp; vf.hh[1] = *(const uint2*)(vp + 16);
                    ni = __builtin_amdgcn_mfma_f32_16x16x32_bf16(vf.v, pf[ks], ni, 0, 0, 0);
                }
#pragma unroll
                for (int ks = 0; ks < 4; ++ks) { const bf16x8 cf = *(const bf16x8*)(Cl + (vt * 16 + lr) * 136 + ks * 32 + lq * 8); nI = __builtin_amdgcn_mfma_f32_16x16x32_bf16(cf, Qf[ks], nI, 0, 0, 0); }
                const f32x4 hv = (nI * sc_in + ni) * rdd;
                *(f32x4*)(HRAW + ((size_t)(b * 2048) + row_t) * 512 + h * 128 + vs * 32 + vt * 16 + lq * 4) = hv;
            }
        }
        __syncthreads();
        {
            const float decay = misc[0];
            bf16x8 Af[2][2], Wf[2], Kt[2][2];
#pragma unroll
            for (int ks = 0; ks < 2; ++ks) {
                const float4 w0 = *(const float4*)(wts + ks * 32 + lq * 8), w1 = *(const float4*)(wts + ks * 32 + lq * 8 + 4);
                float wv[8] = {w0.x, w0.y, w0.z, w0.w, w1.x, w1.y, w1.z, w1.w};
                { union { bf16x8 v; uint4 q; } t; t.q = pack8(wv); Wf[ks] = t.v; }
#pragma unroll
                for (int vt = 0; vt < 2; ++vt) {
                    const uint4 raw = *(const uint4*)(VTM + (size_t)(vt * 16 + lr) * 2048 + t0 + ks * 32 + lq * 8);
                    float f[8] = {bf_lo(raw.x) * wv[0], bf_hi(raw.x) * wv[1], bf_lo(raw.y) * wv[2], bf_hi(raw.y) * wv[3], bf_lo(raw.z) * wv[4], bf_hi(raw.z) * wv[5], bf_lo(raw.w) * wv[6], bf_hi(raw.w) * wv[7]};
                    union { bf16x8 v; uint4 q; } t; t.q = pack8(f); Af[vt][ks] = t.v;
                }
#pragma unroll
                for (int kt = 0; kt < 2; ++kt) Kt[kt][ks] = *(const bf16x8*)(KTB + (size_t)((2 * w + kt) * 16 + lr) * 2048 + t0 + ks * 32 + lq * 8);
            }
#pragma unroll
            for (int kt = 0; kt < 2; ++kt) {
                nm[kt] = nm[kt] * decay;
#pragma unroll
                for (int ks = 0; ks < 2; ++ks) nm[kt] = __builtin_amdgcn_mfma_f32_16x16x32_bf16(Wf[ks], Kt[kt][ks], nm[kt], 0, 0, 0);
                if (lq == 0) nl[(2 * w + kt) * 16 + lr] = (bf16_t)(cvt_pk_bf16(nm[kt][0], 0.f) & 0xffffu);
#pragma unroll
                for (int vt = 0; vt < 2; ++vt) {
                    Cm[vt][kt] = Cm[vt][kt] * decay;
#pragma unroll
                    for (int ks = 0; ks < 2; ++ks) Cm[vt][kt] = __builtin_amdgcn_mfma_f32_16x16x32_bf16(Af[vt][ks], Kt[kt][ks], Cm[vt][kt], 0, 0, 0);
                    const unsigned c01 = cvt_pk_bf16(Cm[vt][kt][0], Cm[vt][kt][1]), c23 = cvt_pk_bf16(Cm[vt][kt][2], Cm[vt][kt][3]);
                    bf16_t* cp = Cl + (vt * 16 + lq * 4) * 136 + (2 * w + kt) * 16 + lr;
                    cp[0] = (bf16_t)(c01 & 0xffffu); cp[136] = (bf16_t)(c01 >> 16); cp[272] = (bf16_t)(c23 & 0xffffu); cp[408] = (bf16_t)(c23 >> 16);
                }
            }
            m_prev = misc[1];
        }
        __syncthreads();
    }
#pragma unroll
    for (int vt = 0; vt < 2; ++vt)
#pragma unroll
        for (int kt = 0; kt < 2; ++kt)
#pragma unroll
            for (int g = 0; g < 4; ++g)
                p.out[O_CP + ((size_t)((b * 4 + h) * 128) + vs * 32 + vt * 16 + lq * 4 + g) * 128 + (2 * w + kt) * 16 + lr] = Cm[vt][kt][g];
    if (vs == 0) {
        if (lq == 0) { p.out[O_NP + (size_t)(b * 4 + h) * 128 + (2 * w) * 16 + lr] = nm[0][0]; p.out[O_NP + (size_t)(b * 4 + h) * 128 + (2 * w + 1) * 16 + lr] = nm[1][0]; }
        if (tid == 0) p.out[O_MP + b * 4 + h] = m_prev;
    }
}

DEV unsigned dpp_max16(unsigned x) {
    x = max(x, (unsigned)__builtin_amdgcn_update_dpp(0, (int)x, 0xB1, 0xF, 0xF, false));
    x = max(x, (unsigned)__builtin_amdgcn_update_dpp(0, (int)x, 0x4E, 0xF, 0xF, false));
    x = max(x, (unsigned)__builtin_amdgcn_update_dpp(0, (int)x, 0x141, 0xF, 0xF, false));
    x = max(x, (unsigned)__builtin_amdgcn_update_dpp(0, (int)x, 0x140, 0xF, 0xF, false));
    return x;
}
DEV float dpp_sum16(float x) {
    x += __builtin_bit_cast(float, __builtin_amdgcn_update_dpp(0, __builtin_bit_cast(int, x), 0xB1, 0xF, 0xF, false));
    x += __builtin_bit_cast(float, __builtin_amdgcn_update_dpp(0, __builtin_bit_cast(int, x), 0x4E, 0xF, 0xF, false));
    x += __builtin_bit_cast(float, __builtin_amdgcn_update_dpp(0, __builtin_bit_cast(int, x), 0x141, 0xF, 0xF, false));
    x += __builtin_bit_cast(float, __builtin_amdgcn_update_dpp(0, __builtin_bit_cast(int, x), 0x140, 0xF, 0xF, false));
    return x;
}
DEV unsigned mono_key(float v) { const unsigned b = __float_as_uint(v); return (b & 0x80000000u) ? ~b : (b | 0x80000000u); }
#define CE_DESC(a, b) { const unsigned hi_ = max(a, b), lo_ = min(a, b); a = hi_; b = lo_; }

DEV void peer_score_topk_item(const Params& p, const int tile, const int h, unsigned char* lds) {
    int tid_ = threadIdx.x; asm volatile("" : "+v"(tid_));
    const int tid = tid_, lane = tid & 63, w = tid >> 6, lr = lane & 15, lq = lane >> 4;
    float* sc = (float*)(lds + w * 12416);
    float* ts = sc + 16 * 129;
    int* ti = (int*)(ts + 512);
    const bf16_t* QPB = (const bf16_t*)(p.ws + WS_QPB);
    const bf16_t* SUBK = (const bf16_t*)(p.ws + WS_SUBK);
    int* PIDX = (int*)(p.ws + WS_PIDX); float* PG = (float*)(p.ws + WS_PG);
    const int row0 = tile * 64 + w * 16;
    const int arow = (row0 + lr < NR) ? row0 + lr : NR - 1;
    wave_sync();
#pragma unroll 1
    for (int pp = 0; pp < 2; ++pp) {
        bf16x8 qf[4];
#pragma unroll
        for (int ks = 0; ks < 4; ++ks) qf[ks] = *(const bf16x8*)(QPB + (size_t)arow * 2048 + h * 256 + pp * 128 + ks * 32 + lq * 8);
#pragma unroll
        for (int j = 0; j < 8; ++j) {
            f32x4 a = (f32x4){0.f, 0.f, 0.f, 0.f};
#pragma unroll
            for (int ks = 0; ks < 4; ++ks) { const bf16x8 kf = *(const bf16x8*)(SUBK + ((size_t)pp * 128 + j * 16 + lr) * 128 + ks * 32 + lq * 8); a = __builtin_amdgcn_mfma_f32_16x16x32_bf16(qf[ks], kf, a, 0, 0, 0); }
#pragma unroll
            for (int g = 0; g < 4; ++g) sc[(lq * 4 + g) * 129 + j * 16 + lr] = a[g];
        }
        wave_sync();
#pragma unroll 1
        for (int rr = 0; rr < 4; ++rr) {
            const int row = rr * 4 + lq;
            unsigned k0, k1, k2, k3, k4, k5, k6, k7;
            { const float* sr = sc + row * 129 + lr;
              k0 = (mono_key(sr[0]) & ~0x7Fu) | (unsigned)(127 - lr);        k1 = (mono_key(sr[16]) & ~0x7Fu) | (unsigned)(127 - 16 - lr);
              k2 = (mono_key(sr[32]) & ~0x7Fu) | (unsigned)(127 - 32 - lr);  k3 = (mono_key(sr[48]) & ~0x7Fu) | (unsigned)(127 - 48 - lr);
              k4 = (mono_key(sr[64]) & ~0x7Fu) | (unsigned)(127 - 64 - lr);  k5 = (mono_key(sr[80]) & ~0x7Fu) | (unsigned)(127 - 80 - lr);
              k6 = (mono_key(sr[96]) & ~0x7Fu) | (unsigned)(127 - 96 - lr);  k7 = (mono_key(sr[112]) & ~0x7Fu) | (unsigned)(127 - 112 - lr); }
            CE_DESC(k0, k1) CE_DESC(k2, k3) CE_DESC(k4, k5) CE_DESC(k6, k7)
            CE_DESC(k0, k2) CE_DESC(k1, k3) CE_DESC(k4, k6) CE_DESC(k5, k7)
            CE_DESC(k1, k2) CE_DESC(k5, k6)
            CE_DESC(k0, k4) CE_DESC(k1, k5) CE_DESC(k2, k6) CE_DESC(k3, k7)
            CE_DESC(k2, k4) CE_DESC(k3, k5)
            CE_DESC(k1, k2) CE_DESC(k3, k4) CE_DESC(k5, k6)
            unsigned mine = 0u;
#pragma unroll
            for (int r = 0; r < 16; ++r) {
                const unsigned best = dpp_max16(k0);
                if (lr == r) mine = best;
                const bool own = (k0 == best);
                k0 = own ? k1 : k0; k1 = own ? k2 : k1; k2 = own ? k3 : k2; k3 = own ? k4 : k3; k4 = own ? k5 : k4; k5 = own ? k6 : k5; k6 = own ? k7 : k6; k7 = own ? 0u : k7;
            }
            const int idx = 127 - (int)(mine & 0x7Fu);
            ts[(pp * 16 + row) * 16 + lr] = sc[row * 129 + idx];
            ti[(pp * 16 + row) * 16 + lr] = idx;
        }
        wave_sync();
    }
#pragma unroll 1
    for (int rr = 0; rr < 4; ++rr) {
        const int row = rr * 4 + lq;
        const float s1a = ts[row * 16 + lr];
        const float* s2 = ts + (16 + row) * 16;
        int ptr = 0;
        unsigned key = (mono_key(s1a + s2[0]) & ~0xFFu) | (unsigned)(255 - lr * 16);
        unsigned mine = 0u;
#pragma unroll
        for (int r = 0; r < 16; ++r) {
            const unsigned best = dpp_max16(key);
            if (lr == r) mine = best;
            if (key == best) { ++ptr; key = (ptr < 16) ? ((mono_key(s1a + s2[ptr & 15]) & ~0xFFu) | (unsigned)(255 - lr * 16 - ptr)) : 0u; }
        }
        const int ci = 255 - (int)(mine & 0xFFu), a = ci >> 4, bb = ci & 15;
        const float scv = ts[row * 16 + a] + s2[bb];
        const int e = ti[row * 16 + a] * 128 + ti[(16 + row) * 16 + bb];
        float m16 = scv;
        m16 = fmaxf(m16, __builtin_bit_cast(float, __builtin_amdgcn_update_dpp(0, __builtin_bit_cast(int, m16), 0xB1, 0xF, 0xF, false)));
        m16 = fmaxf(m16, __builtin_bit_cast(float, __builtin_amdgcn_update_dpp(0, __builtin_bit_cast(int, m16), 0x4E, 0xF, 0xF, false)));
        m16 = fmaxf(m16, __builtin_bit_cast(float, __builtin_amdgcn_update_dpp(0, __builtin_bit_cast(int, m16), 0x141, 0xF, 0xF, false)));
        m16 = fmaxf(m16, __builtin_bit_cast(float, __builtin_amdgcn_update_dpp(0, __builtin_bit_cast(int, m16), 0x140, 0xF, 0xF, false)));
        const float ex = expf(scv - m16);
        const float den = dpp_sum16(ex);
        const int grow = row0 + row;
        if (grow < NR) { PIDX[(size_t)grow * 128 + h * 16 + lr] = e; PG[(size_t)grow * 128 + h * 16 + lr] = ex / den; }
    }
}

constexpr float PEER_U_SCALE = 64.0f, PEER_V_SCALE = 8.0f;
DEV unsigned pack4_fp8(float a, float b, float c, float d) { int w = 0; w = __builtin_amdgcn_cvt_pk_fp8_f32(a, b, w, false); w = __builtin_amdgcn_cvt_pk_fp8_f32(c, d, w, true); return (unsigned)w; }
DEV void peer_expert_wave(const Params& p, const int row, unsigned char* wl, const int lane_in) {
    int lane = lane_in; asm volatile("" : "+v"(lane));
    const int lr = lane & 15, lq = lane >> 4;
    unsigned char* xh = wl;
    unsigned char* xo = wl + 1024;
    float* coefl = (float*)(wl + 2048);
    int* idxl = (int*)(wl + 2048 + 512);
    const float* X1 = (const float*)(p.ws + WS_X1) + (size_t)row * 1024;
    const int* PIDX = (const int*)(p.ws + WS_PIDX) + (size_t)row * 128;
    const float* PG = (const float*)(p.ws + WS_PG) + (size_t)row * 128;
    const unsigned char* U8 = p.ws + WS_U8;
    const unsigned char* V8 = p.ws + WS_V8;
    float xv[16];
#pragma unroll
    for (int j = 0; j < 4; ++j) { const float4 t = *(const float4*)(X1 + lane * 16 + j * 4); xv[4 * j] = t.x; xv[4 * j + 1] = t.y; xv[4 * j + 2] = t.z; xv[4 * j + 3] = t.w; }
    wave_sync();
    {
        uint4 hi, lo; unsigned* hp = (unsigned*)&hi; unsigned* lp = (unsigned*)&lo;
#pragma unroll
        for (int j = 0; j < 4; ++j) {
            const unsigned hw = pack4_fp8(xv[4 * j], xv[4 * j + 1], xv[4 * j + 2], xv[4 * j + 3]);
            const f32x2_ b0 = __builtin_amdgcn_cvt_pk_f32_fp8((int)hw, false), b1 = __builtin_amdgcn_cvt_pk_f32_fp8((int)hw, true);
            hp[j] = hw;
            lp[j] = pack4_fp8(16.f * (xv[4 * j] - b0[0]), 16.f * (xv[4 * j + 1] - b0[1]), 16.f * (xv[4 * j + 2] - b1[0]), 16.f * (xv[4 * j + 3] - b1[1]));
        }
        *(uint4*)(xh + lane * 16) = hi; *(uint4*)(xo + lane * 16) = lo;
    }
    idxl[lane] = PIDX[lane]; idxl[64 + lane] = PIDX[64 + lane];
    wave_sync();
    uint4 ufa[8], ufb[8];
    f32x4 ah = (f32x4){0.f, 0.f, 0.f, 0.f}, al = (f32x4){0.f, 0.f, 0.f, 0.f};
#define U_LOAD(DST, HH) { const unsigned char* ub_ = U8 + (size_t)idxl[((HH) >> 1) * 16 + lr] * 1024 + ((HH) & 1) * 512 + lq * 16; \
        _Pragma("unroll") for (int i = 0; i < 8; ++i) DST[i] = *(const uint4*)(ub_ + i * 64); }
#define U_HALF(SRC, HH) { \
        _Pragma("unroll") for (int i = 0; i < 8; ++i) { \
            const int off = ((HH) & 1) * 512 + i * 64 + lq * 16; \
            const long b0 = (long)(((unsigned long long)SRC[i].y << 32) | SRC[i].x), b1 = (long)(((unsigned long long)SRC[i].w << 32) | SRC[i].z); \
            const long h0 = *(const long*)(xh + off), h1 = *(const long*)(xh + off + 8), l0 = *(const long*)(xo + off), l1 = *(const long*)(xo + off + 8); \
            ah = __builtin_amdgcn_mfma_f32_16x16x32_fp8_fp8(h0, b0, ah, 0, 0, 0); ah = __builtin_amdgcn_mfma_f32_16x16x32_fp8_fp8(h1, b1, ah, 0, 0, 0); \
            al = __builtin_amdgcn_mfma_f32_16x16x32_fp8_fp8(l0, b0, al, 0, 0, 0); al = __builtin_amdgcn_mfma_f32_16x16x32_fp8_fp8(l1, b1, al, 0, 0, 0); } \
        if ((HH) & 1) { if (lq == 0) coefl[((HH) >> 1) * 16 + lr] = PG[((HH) >> 1) * 16 + lr] * gelu_tanh((ah[0] + al[0] * 0.0625f) * (1.0f / PEER_U_SCALE)) * (1.0f / PEER_V_SCALE); \
            ah = (f32x4){0.f, 0.f, 0.f, 0.f}; al = (f32x4){0.f, 0.f, 0.f, 0.f}; } }
    U_LOAD(ufa, 0)
#pragma unroll 1
    for (int hh = 0; hh < 16; hh += 2) {
        U_LOAD(ufb, hh + 1)
        U_HALF(ufa, hh)
        if (hh + 2 < 16) U_LOAD(ufa, hh + 2)
        U_HALF(ufb, hh + 1)
    }
#undef U_LOAD
#undef U_HALF
    wave_sync();
    float o[16];
#pragma unroll
    for (int i = 0; i < 16; ++i) o[i] = 0.f;
    uint4 vfa[8], vfb[8];
#define V_LOAD(DST, J) { _Pragma("unroll") for (int u = 0; u < 8; ++u) DST[u] = *(const uint4*)(V8 + (size_t)idxl[(J) + u] * 1024 + lane * 16); }
#define V_ACC(SRC, J) { _Pragma("unroll") for (int u = 0; u < 8; ++u) { const float c_ = coefl[(J) + u]; \
            const unsigned w0_ = SRC[u].x, w1_ = SRC[u].y, w2_ = SRC[u].z, w3_ = SRC[u].w; \
            f32x2_ f0, f1; \
            f0 = __builtin_amdgcn_cvt_pk_f32_fp8((int)w0_, false); f1 = __builtin_amdgcn_cvt_pk_f32_fp8((int)w0_, true); o[0] += c_ * f0[0]; o[1] += c_ * f0[1]; o[2] += c_ * f1[0]; o[3] += c_ * f1[1]; \
            f0 = __builtin_amdgcn_cvt_pk_f32_fp8((int)w1_, false); f1 = __builtin_amdgcn_cvt_pk_f32_fp8((int)w1_, true); o[4] += c_ * f0[0]; o[5] += c_ * f0[1]; o[6] += c_ * f1[0]; o[7] += c_ * f1[1]; \
            f0 = __builtin_amdgcn_cvt_pk_f32_fp8((int)w2_, false); f1 = __builtin_amdgcn_cvt_pk_f32_fp8((int)w2_, true); o[8] += c_ * f0[0]; o[9] += c_ * f0[1]; o[10] += c_ * f1[0]; o[11] += c_ * f1[1]; \
            f0 = __builtin_amdgcn_cvt_pk_f32_fp8((int)w3_, false); f1 = __builtin_amdgcn_cvt_pk_f32_fp8((int)w3_, true); o[12] += c_ * f0[0]; o[13] += c_ * f0[1]; o[14] += c_ * f1[0]; o[15] += c_ * f1[1]; } }
    V_LOAD(vfa, 0)
#pragma unroll 1
    for (int j = 0; j < 128; j += 16) {
        V_LOAD(vfb, j + 8)
        V_ACC(vfa, j)
        if (j + 16 < 128) V_LOAD(vfa, j + 16)
        V_ACC(vfb, j + 8)
    }
#undef V_LOAD
#undef V_ACC
    float tv[16]; float s = 0.f;
#pragma unroll
    for (int i = 0; i < 16; ++i) { tv[i] = DN_ALPHA * xv[i] + o[i]; s += tv[i]; }
    const float mu = wave_sum(s) * (1.0f / 1024.0f);
    float q = 0.f;
#pragma unroll
    for (int i = 0; i < 16; ++i) { const float d = tv[i] - mu; q += d * d; }
    const float rstd = 1.0f / sqrtf(wave_sum(q) * (1.0f / 1024.0f) + LN_EPS);
    float* y = p.out + O_Y + (size_t)row * 1024 + lane * 16;
#pragma unroll
    for (int j = 0; j < 4; ++j) {
        const float4 g4 = *(const float4*)(p.ln2_g + lane * 16 + j * 4), b4 = *(const float4*)(p.ln2_b + lane * 16 + j * 4);
        float4 yo;
        yo.x = (tv[4 * j] - mu) * rstd * g4.x + b4.x; yo.y = (tv[4 * j + 1] - mu) * rstd * g4.y + b4.y; yo.z = (tv[4 * j + 2] - mu) * rstd * g4.z + b4.z; yo.w = (tv[4 * j + 3] - mu) * rstd * g4.w + b4.w;
        *(float4*)(y + j * 4) = yo;
    }
}

constexpr int QN = 2;
struct AttnState { f32x4 ot[4][QN]; float m[QN]; float l[QN]; };

DEV void attn_block(const unsigned char* Ks, const unsigned char* VTs, const bf16x8 (&Qf)[QN][2], AttnState& A, const int mode, const int dq, const float* blut,
                    const unsigned selbit0, const unsigned selbit1, const bool slc, const int lr, const int lq, const int t0, const int ci0) {
    f32x4 sc[4][QN];
#pragma unroll
    for (int kt = 0; kt < 4; ++kt) {
        const bf16x8 k0 = *(const bf16x8*)(Ks + (kt * 16 + lr) * 144 + lq * 16), k1 = *(const bf16x8*)(Ks + (kt * 16 + lr) * 144 + 64 + lq * 16);
#pragma unroll
        for (int qi = 0; qi < QN; ++qi) {
            f32x4 a = (f32x4){0.f, 0.f, 0.f, 0.f};
            a = __builtin_amdgcn_mfma_f32_16x16x32_bf16(k0, Qf[qi][0], a, 0, 0, 0);
            a = __builtin_amdgcn_mfma_f32_16x16x32_bf16(k1, Qf[qi][1], a, 0, 0, 0);
            sc[kt][qi] = a;
        }
    }
    asm volatile("" ::: "memory");
    if (mode != 0 || slc) {
#pragma unroll
        for (int kt = 0; kt < 4; ++kt)
#pragma unroll
            for (int qi = 0; qi < QN; ++qi)
#pragma unroll
                for (int g = 0; g < 4; ++g) {
                    const int kl = kt * 16 + lq * 4 + g, ql = qi * 16 + lr;
                    float v = sc[kt][qi][g];
                    bool ok = true;
                    if (mode == 1 || mode == 2) { const int di = dq + ql - kl; v += blut[di < 0 ? 0 : di]; }
                    if (mode == 2) ok = kl <= ql + dq;
                    if (mode == 3) ok = kl > ql + dq - 512;
                    if (mode == 4) { const int ci = ci0 + kl, dist = t0 + ql - (16 * ci + 31); ok = (dist >= 0) && (ci < 127); if (dist >= 0 && dist < 192) v += blut[dist]; }
                    if (mode == 5) { const int dist = dq - ci0 * kl; ok = (kl < t0) && (dist >= 0); if (dist >= 0 && dist < 192) v += blut[dist]; }
                    if (slc) ok = ok && ((qi == 0 ? selbit0 : selbit1) != 0u);
                    sc[kt][qi][g] = ok ? v : NEGF;
                }
    }
    bf16x8 pf[QN][2];
#pragma unroll
    for (int qi = 0; qi < QN; ++qi) {
        float mb = NEGF;
#pragma unroll
        for (int kt = 0; kt < 4; ++kt) mb = fmaxf(mb, fmaxf(fmaxf(sc[kt][qi][0], sc[kt][qi][1]), fmaxf(sc[kt][qi][2], sc[kt][qi][3])));
        mb = fmaxf(mb, __shfl_xor(mb, 16)); mb = fmaxf(mb, __shfl_xor(mb, 32));
        const float mn = fmaxf(A.m[qi], mb);
        const float alpha = __builtin_amdgcn_exp2f(A.m[qi] - mn);
        A.m[qi] = mn;
        float rs = 0.f;
#pragma unroll
        for (int kt = 0; kt < 4; ++kt)
#pragma unroll
            for (int g = 0; g < 4; ++g) { const float v = sc[kt][qi][g]; const float e = (v > -1e29f) ? __builtin_amdgcn_exp2f(v - mn) : 0.f; sc[kt][qi][g] = e; rs += e; }
        A.l[qi] = A.l[qi] * alpha + rs;
#pragma unroll
        for (int dt = 0; dt < 4; ++dt) A.ot[dt][qi] = A.ot[dt][qi] * alpha;
#pragma unroll
        for (int ks = 0; ks < 2; ++ks) {
            union { bf16x8 v; unsigned u[4]; } pk;
            pk.u[0] = cvt_pk_bf16(sc[2 * ks][qi][0], sc[2 * ks][qi][1]); pk.u[1] = cvt_pk_bf16(sc[2 * ks][qi][2], sc[2 * ks][qi][3]);
            pk.u[2] = cvt_pk_bf16(sc[2 * ks + 1][qi][0], sc[2 * ks + 1][qi][1]); pk.u[3] = cvt_pk_bf16(sc[2 * ks + 1][qi][2], sc[2 * ks + 1][qi][3]);
            pf[qi][ks] = pk.v;
        }
    }
    asm volatile("" ::: "memory");
#pragma unroll
    for (int dt = 0; dt < 4; ++dt)
#pragma unroll
        for (int ks = 0; ks < 2; ++ks) {
            asm volatile("" ::: "memory");
            union { bf16x8 v; uint2 h[2]; } vf;
            vf.h[0] = *(const uint2*)(VTs + (dt * 16 + lr) * 144 + (32 * ks + lq * 4) * 2);
            vf.h[1] = *(const uint2*)(VTs + (dt * 16 + lr) * 144 + (32 * ks + 16 + lq * 4) * 2);
#pragma unroll
            for (int qi = 0; qi < QN; ++qi) A.ot[dt][qi] = __builtin_amdgcn_mfma_f32_16x16x32_bf16(vf.v, pf[qi][ks], A.ot[dt][qi], 0, 0, 0);
        }
}

DEV void nsa_prompt_item(const Params& p, const int b, const int hkv, const int q32, unsigned char* lds) {
    int tid_ = threadIdx.x; asm volatile("" : "+v"(tid_));
    const int tid = tid_, lane = tid & 63, g = tid >> 6, lr = lane & 15, lq = lane >> 4;
    const int hq = hkv * 4 + g, t0 = q32 * 32, kd = t0 >> 6;
    unsigned char* Ks = lds; unsigned char* VTs = lds + 9216;
    float* biasl = (float*)(lds + 18432); float* psl = (float*)(lds + 21504); unsigned* selm = (unsigned*)(lds + 29952); unsigned* misc = (unsigned*)(lds + 30208);
    const bf16_t* ZB = (const bf16_t*)(p.ws + WS_ZB);
    const bf16_t* VTS = (const bf16_t*)(p.ws + WS_VTS) + (size_t)(b * 2 + hkv) * 64 * 2048;
    const bf16_t* VTW = (const bf16_t*)(p.ws + WS_VTW) + (size_t)(b * 2 + hkv) * 64 * 2048;
    const bf16_t* KCB = (const bf16_t*)(p.ws + WS_KCB) + (size_t)(b * 2 + hkv) * 128 * 64;
    const bf16_t* VTC = (const bf16_t*)(p.ws + WS_VTC) + (size_t)(b * 2 + hkv) * 64 * 128;
    const float* Z = (const float*)(p.ws + WS_Z);
    float* NOUTF = (float*)(p.ws + WS_NOUTF);
    bf16_t* NOUTB = (bf16_t*)(p.ws + WS_NOUTB);
    __syncthreads();
    for (int i = tid; i < 4 * 192; i += 256) { const int gg = i / 192, d = i % 192; biasl[i] = (p.rel_bias[rel_bucket(d) * 8 + hkv * 4 + gg] - p.rel_bias[31 * 8 + hkv * 4 + gg]) * LOG2E; }
    for (int i = tid; i < 32 * 33; i += 256) psl[i] = 0.f;
    if (tid < 32) selm[tid] = 0u;
    if (tid == 0) misc[0] = 0u;
    const float* blut = biasl + g * 192;
    bf16x8 Qf[QN][2];
#pragma unroll
    for (int qi = 0; qi < QN; ++qi)
#pragma unroll
        for (int kk = 0; kk < 2; ++kk) Qf[qi][kk] = *(const bf16x8*)(ZB + (size_t)(b * 2048 + t0 + qi * 16 + lr) * IN_DIM + C_Q + hq * 64 + kk * 32 + lq * 8);

    uint4 trk0, trk1, trv0, trv1;
    auto load_tiles = [&](int kind, int kb) __attribute__((always_inline)) {
#pragma unroll
        for (int i = 0; i < 2; ++i) {
            const int id = tid + 256 * i, row = id >> 3, ch = id & 7;
            uint4 rk, rv;
            if (kind == 0) { rk = *(const uint4*)(KCB + (size_t)(kb * 64 + row) * 64 + ch * 8); rv = *(const uint4*)(VTC + (size_t)row * 128 + kb * 64 + ch * 8); }
            else {
                rk = *(const uint4*)(ZB + (size_t)(b * 2048 + kb * 64 + row) * IN_DIM + (kind == 1 ? C_KS : C_KW) + hkv * 64 + ch * 8);
                rv = *(const uint4*)((kind == 1 ? VTS : VTW) + (size_t)row * 2048 + kb * 64 + ch * 8);
            }
            if (i == 0) { trk0 = rk; trv0 = rv; } else { trk1 = rk; trv1 = rv; }
        }
    };
    auto store_tiles = [&]() __attribute__((always_inline)) {
#pragma unroll
        for (int i = 0; i < 2; ++i) { const int id = tid + 256 * i, row = id >> 3, ch = id & 7; *(uint4*)(Ks + row * 144 + ch * 16) = (i == 0 ? trk0 : trk1); *(uint4*)(VTs + row * 144 + ch * 16) = (i == 0 ? trv0 : trv1); }
    };
    auto reset = [&](AttnState& A) __attribute__((always_inline)) {
#pragma unroll
        for (int qi = 0; qi < QN; ++qi) { A.m[qi] = NEGF; A.l[qi] = 0.f;
#pragma unroll
            for (int dt = 0; dt < 4; ++dt) A.ot[dt][qi] = (f32x4){0.f, 0.f, 0.f, 0.f}; }
    };
    auto finish = [&](AttnState& A, int br) __attribute__((always_inline)) {
#pragma unroll
        for (int qi = 0; qi < QN; ++qi) {
            float lt = A.l[qi]; lt += __shfl_xor(lt, 16); lt += __shfl_xor(lt, 32);
            const float sc = (lt > 0.f) ? sigmoidf_(Z[(size_t)(b * 2048 + t0 + qi * 16 + lr) * 32 + 8 + br * 8 + hq]) / lt : 0.f;
            const size_t row = (size_t)(b * 2048 + t0 + qi * 16 + lr);
#pragma unroll
            for (int dt = 0; dt < 4; ++dt) {
                const int col = hq * 64 + dt * 16 + lq * 4;
                f32x4 v = A.ot[dt][qi] * sc;
                if (br > 0) v = v + *(const f32x4*)(NOUTF + row * 512 + col);
                if (br < 2) *(f32x4*)(NOUTF + row * 512 + col) = v; else store_bf16x4(NOUTB + row * 512 + col, v);
            }
        }
    };

    AttnState A;
    const int ncb = ((t0 >> 4) >= 64) ? 2 : 1;
    reset(A);
    load_tiles(0, 0);
    for (int kb = 0; kb < ncb; ++kb) {
        __syncthreads(); store_tiles(); __syncthreads();
        if (kb + 1 < ncb) load_tiles(0, kb + 1);
        attn_block(Ks, VTs, Qf, A, 4, 0, blut, 1u, 1u, false, lr, lq, t0, kb * 64);
    }
    finish(A, 0);
    {
        float linv[QN];
#pragma unroll
        for (int qi = 0; qi < QN; ++qi) { float lt = A.l[qi]; lt += __shfl_xor(lt, 16); lt += __shfl_xor(lt, 32); linv[qi] = (lt > 0.f) ? 1.0f / lt : 0.f; }
        for (int kb = 0; kb < ncb; ++kb) {
            if (ncb > 1) { load_tiles(0, kb); __syncthreads(); store_tiles(); __syncthreads(); }
#pragma unroll
            for (int kt = 0; kt < 4; ++kt) {
                const bf16x8 k0 = *(const bf16x8*)(Ks + (kt * 16 + lr) * 144 + lq * 16), k1 = *(const bf16x8*)(Ks + (kt * 16 + lr) * 144 + 64 + lq * 16);
#pragma unroll
                for (int qi = 0; qi < QN; ++qi) {
                    f32x4 a = (f32x4){0.f, 0.f, 0.f, 0.f};
                    a = __builtin_amdgcn_mfma_f32_16x16x32_bf16(k0, Qf[qi][0], a, 0, 0, 0);
                    a = __builtin_amdgcn_mfma_f32_16x16x32_bf16(k1, Qf[qi][1], a, 0, 0, 0);
                    float pr[4];
#pragma unroll
                    for (int gg = 0; gg < 4; ++gg) {
                        const int ci = kb * 64 + kt * 16 + lq * 4 + gg, ql = qi * 16 + lr, dist = t0 + ql - (16 * ci + 31);
                        float v = a[gg];
                        if (dist >= 0 && dist < 192) v += blut[dist];
                        pr[gg] = (dist >= 0 && ci < 127) ? __builtin_amdgcn_exp2f(v - A.m[qi]) * linv[qi] : 0.f;
                    }
                    const int blk = kb * 16 + kt * 4 + lq, ql = qi * 16 + lr;
                    atomicAdd(&psl[ql * 33 + blk], 2.0f * (pr[0] + pr[1] + pr[2]) + pr[3]);
                    atomicAdd(&psl[ql * 33 + blk + 1], pr[3]);
                }
            }
        }
    }
    __syncthreads();
    {
        const int ql = tid >> 3, part = tid & 7, tq = t0 + ql, cur = tq >> 6;
        float scv[32];
#pragma unroll
        for (int j = 0; j < 32; ++j) {
            const bool causal = j * 64 <= tq, forced = (j == 0) || (j == cur) || (j == cur - 1);
            scv[j] = causal ? (forced ? 1e4f : psl[ql * 33 + j]) : NEGF;
        }
        unsigned mbits = 0u;
#pragma unroll
        for (int jj = 0; jj < 4; ++jj) {
            const int j = part * 4 + jj;
            float my = NEGF;
#pragma unroll
            for (int k = 0; k < 32; ++k) my = (k == j) ? scv[k] : my;
            int rank = 0;
#pragma unroll
            for (int k = 0; k < 32; ++k) rank += ((scv[k] > my) || (scv[k] == my && k < j)) ? 1 : 0;
            if (rank < 16 && j * 64 <= tq) mbits |= (1u << j);
        }
        atomicOr(&selm[ql], mbits);
        atomicOr(&misc[0], mbits);
    }
    __syncthreads();
    const unsigned msk0 = selm[lr], msk1 = selm[16 + lr];
    const unsigned anym = misc[0];
    reset(A);
    {
        int kb = kd;
        load_tiles(1, kb);
        for (;;) {
            __syncthreads(); store_tiles(); __syncthreads();
            int nxt = (kb == kd) ? 0 : kb + 1;
            while (nxt < kd && !((anym >> nxt) & 1u)) ++nxt;
            const bool more = nxt < kd;
            if (more) load_tiles(1, nxt);
            const int mode = (kb == kd) ? 2 : ((kb >= kd - 2) ? 1 : 0);
            attn_block(Ks, VTs, Qf, A, mode, t0 - kb * 64, blut, (msk0 >> kb) & 1u, (msk1 >> kb) & 1u, true, lr, lq, t0, 0);
            if (!more) break;
            kb = nxt;
        }
    }
    finish(A, 1);
    reset(A);
    {
        const int klo = (t0 >= 511) ? ((t0 - 511) >> 6) : 0;
        int kb = kd;
        load_tiles(2, kb);
        for (;;) {
            __syncthreads(); store_tiles(); __syncthreads();
            const bool more = kb > klo;
            if (more) load_tiles(2, kb - 1);
            const int dq = t0 - kb * 64;
            const int mode = (kb == kd) ? 2 : ((kb >= kd - 2) ? 1 : ((dq + 31 >= 512) ? 3 : 0));
            attn_block(Ks, VTs, Qf, A, mode, dq, blut, 1u, 1u, false, lr, lq, t0, 0);
            if (!more) break;
            --kb;
        }
    }
    finish(A, 2);
}

DEV void nsa_sample_item(const Params& p, const int b, const int hkv, unsigned char* lds) {
    int tid_ = threadIdx.x; asm volatile("" : "+v"(tid_));
    const int tid = tid_, lane = tid & 63, g = tid >> 6, lr = lane & 15, lq = lane >> 4;
    const int hq = hkv * 4 + g;
    unsigned char* Ks = lds; unsigned char* VTs = lds + 9216;
    float* biasl = (float*)(lds + 18432); float* psl = (float*)(lds + 21504); int* sell = (int*)(lds + 29952); float* scl = (float*)(lds + 30720);
    const bf16_t* ZB = (const bf16_t*)(p.ws + WS_ZB);
    const float* zgate = (const float*)(p.ws + WS_Z) + (size_t)(NP + b) * 32 + 8;
    const bf16_t* zbrow = ZB + (size_t)(NP + b) * IN_DIM;
    const bf16_t* KCSB = (const bf16_t*)(p.ws + WS_KCSB) + (size_t)(b * 2 + hkv) * 1024 * 64;
    const bf16_t* VTCS = (const bf16_t*)(p.ws + WS_VTCS) + (size_t)(b * 2 + hkv) * 64 * 1024;
    bf16_t* NOUTB = (bf16_t*)(p.ws + WS_NOUTB);
    __syncthreads();
    for (int i = tid; i < 4 * 192; i += 256) { const int gg = i / 192, d = i % 192; biasl[i] = (p.rel_bias[rel_bucket(d) * 8 + hkv * 4 + gg] - p.rel_bias[31 * 8 + hkv * 4 + gg]) * LOG2E; }
    for (int i = tid; i < 260; i += 256) psl[i] = 0.f;
    const float* blut = biasl + g * 192;
    bf16x8 Qf[QN][2];
#pragma unroll
    for (int kk = 0; kk < 2; ++kk) { Qf[0][kk] = *(const bf16x8*)(ZB + (size_t)(NP + b) * IN_DIM + C_Q + hq * 64 + kk * 32 + lq * 8); Qf[1][kk] = Qf[0][kk]; }
    AttnState A;
    auto reset = [&](AttnState& S_) __attribute__((always_inline)) {
#pragma unroll
        for (int qi = 0; qi < QN; ++qi) { S_.m[qi] = NEGF; S_.l[qi] = 0.f;
#pragma unroll
            for (int dt = 0; dt < 4; ++dt) S_.ot[dt][qi] = (f32x4){0.f, 0.f, 0.f, 0.f}; }
    };
    f32x4 res[4];
#pragma unroll
    for (int dt = 0; dt < 4; ++dt) res[dt] = (f32x4){0.f, 0.f, 0.f, 0.f};
    auto finish = [&](AttnState& S_, int br) __attribute__((always_inline)) {
        float lt = S_.l[0]; lt += __shfl_xor(lt, 16); lt += __shfl_xor(lt, 32);
        const float sc = (lt > 0.f) ? sigmoidf_(zgate[br * 8 + hq]) / lt : 0.f;
#pragma unroll
        for (int dt = 0; dt < 4; ++dt) res[dt] = res[dt] + S_.ot[dt][0] * sc;
    };
    uint4 trk0, trk1, trv0, trv1;
    auto load_cmp = [&](int kb) __attribute__((always_inline)) {
#pragma unroll
        for (int i = 0; i < 2; ++i) {
            const int id = tid + 256 * i, row = id >> 3, ch = id & 7;
            const uint4 rk = *(const uint4*)(KCSB + (size_t)(kb * 64 + row) * 64 + ch * 8), rv = *(const uint4*)(VTCS + (size_t)row * 1024 + kb * 64 + ch * 8);
            if (i == 0) { trk0 = rk; trv0 = rv; } else { trk1 = rk; trv1 = rv; }
        }
    };
    auto store_cmp = [&]() __attribute__((always_inline)) {
#pragma unroll
        for (int i = 0; i < 2; ++i) { const int id = tid + 256 * i, row = id >> 3, ch = id & 7; *(uint4*)(Ks + row * 144 + ch * 16) = (i == 0 ? trk0 : trk1); *(uint4*)(VTs + row * 144 + ch * 16) = (i == 0 ? trv0 : trv1); }
    };
    reset(A);
    load_cmp(0);
    for (int kb = 0; kb < 16; ++kb) {
        __syncthreads(); store_cmp(); __syncthreads();
        if (kb + 1 < 16) load_cmp(kb + 1);
        attn_block(Ks, VTs, Qf, A, 5, PAST - 31 - 16 * (kb * 64), blut, 1u, 1u, false, lr, lq, (kb == 15) ? 63 : 64, 16);
    }
    finish(A, 0);
    {
        float lt = A.l[0]; lt += __shfl_xor(lt, 16); lt += __shfl_xor(lt, 32);
        const float linv = (lt > 0.f) ? 1.0f / lt : 0.f;
        for (int kb = 0; kb < 16; ++kb) {
            load_cmp(kb); __syncthreads(); store_cmp(); __syncthreads();
#pragma unroll
            for (int kt = 0; kt < 4; ++kt) {
                const bf16x8 k0 = *(const bf16x8*)(Ks + (kt * 16 + lr) * 144 + lq * 16), k1 = *(const bf16x8*)(Ks + (kt * 16 + lr) * 144 + 64 + lq * 16);
                f32x4 a = (f32x4){0.f, 0.f, 0.f, 0.f};
                a = __builtin_amdgcn_mfma_f32_16x16x32_bf16(k0, Qf[0][0], a, 0, 0, 0);
                a = __builtin_amdgcn_mfma_f32_16x16x32_bf16(k1, Qf[0][1], a, 0, 0, 0);
                float pr[4];
#pragma unroll
                for (int gg = 0; gg < 4; ++gg) {
                    const int ci = kb * 64 + kt * 16 + lq * 4 + gg, dist = PAST - 31 - 16 * ci;
                    float v = a[gg];
                    if (dist >= 0 && dist < 192) v += blut[dist];
                    pr[gg] = (ci < 1023) ? __builtin_amdgcn_exp2f(v - A.m[0]) * linv : 0.f;
                }
                if (lr == 0) {
                    const int blk = kb * 16 + kt * 4 + lq;
                    atomicAdd(&psl[blk], 2.0f * (pr[0] + pr[1] + pr[2]) + pr[3]);
                    atomicAdd(&psl[blk + 1], pr[3]);
                }
            }
        }
    }
    __syncthreads();
    for (int j = tid; j < 257; j += 256) scl[j] = (j == 0 || j == 256 || j == 255) ? 1e4f : psl[j];
    __syncthreads();
    for (int j = tid; j < 257; j += 256) {
        const float my = scl[j];
        int rank = 0;
        for (int k = 0; k < 257; ++k) { const float o2 = scl[k]; rank += ((o2 > my) || (o2 == my && k < j)) ? 1 : 0; }
        if (rank < 16) sell[rank] = j;
    }
    __syncthreads();
    uint4 rk0, rk1; unsigned rv0, rv1, rv2, rv3, rv4, rv5, rv6, rv7;
    auto load_rows = [&](const float* src, const bf16_t* srcb) __attribute__((always_inline)) {
        const int seg = tid & 3;
        if (srcb) {
            const bf16_t* kp = srcb + hkv * 64 + seg * 16; const bf16_t* vp = kp + 128;
            rk0 = *(const uint4*)kp; rk1 = *(const uint4*)(kp + 8);
            const uint4 v0 = *(const uint4*)vp, v1 = *(const uint4*)(vp + 8);
            rv0 = v0.x; rv1 = v0.y; rv2 = v0.z; rv3 = v0.w; rv4 = v1.x; rv5 = v1.y; rv6 = v1.z; rv7 = v1.w;
        } else {
            const bool nz = src != nullptr;
            const float* kp = (nz ? src : p.state_win) + hkv * 64 + seg * 16; const float* vp = kp + 128;
            const float4 a0 = *(const float4*)kp, a1 = *(const float4*)(kp + 4), a2 = *(const float4*)(kp + 8), a3 = *(const float4*)(kp + 12);
            const float4 c0 = *(const float4*)vp, c1 = *(const float4*)(vp + 4), c2 = *(const float4*)(vp + 8), c3 = *(const float4*)(vp + 12);
            const unsigned mk = nz ? 0xffffffffu : 0u;
            rk0.x = cvt_pk_bf16(a0.x, a0.y) & mk; rk0.y = cvt_pk_bf16(a0.z, a0.w) & mk; rk0.z = cvt_pk_bf16(a1.x, a1.y) & mk; rk0.w = cvt_pk_bf16(a1.z, a1.w) & mk;
            rk1.x = cvt_pk_bf16(a2.x, a2.y) & mk; rk1.y = cvt_pk_bf16(a2.z, a2.w) & mk; rk1.z = cvt_pk_bf16(a3.x, a3.y) & mk; rk1.w = cvt_pk_bf16(a3.z, a3.w) & mk;
            rv0 = cvt_pk_bf16(c0.x, c0.y) & mk; rv1 = cvt_pk_bf16(c0.z, c0.w) & mk; rv2 = cvt_pk_bf16(c1.x, c1.y) & mk; rv3 = cvt_pk_bf16(c1.z, c1.w) & mk;
            rv4 = cvt_pk_bf16(c2.x, c2.y) & mk; rv5 = cvt_pk_bf16(c2.z, c2.w) & mk; rv6 = cvt_pk_bf16(c3.x, c3.y) & mk; rv7 = cvt_pk_bf16(c3.z, c3.w) & mk;
        }
    };
    auto store_rows = [&]() __attribute__((always_inline)) {
        const int kl = tid >> 2, seg = tid & 3;
        *(uint4*)(Ks + kl * 144 + seg * 32) = rk0; *(uint4*)(Ks + kl * 144 + seg * 32 + 16) = rk1;
#define VT_PUT(i_, w_) { *(bf16_t*)(VTs + (seg * 16 + (i_)) * 144 + kl * 2) = (bf16_t)((w_) & 0xffffu); *(bf16_t*)(VTs + (seg * 16 + (i_) + 1) * 144 + kl * 2) = (bf16_t)((w_) >> 16); }
        VT_PUT(0, rv0) VT_PUT(2, rv1) VT_PUT(4, rv2) VT_PUT(6, rv3) VT_PUT(8, rv4) VT_PUT(10, rv5) VT_PUT(12, rv6) VT_PUT(14, rv7)
#undef VT_PUT
    };
    auto slc_row = [&](int blk) __attribute__((always_inline)) -> const float* {
        const int kl = tid >> 2;
        if (blk < 256) { const int page = p.page_table[b * 128 + (blk >> 1)]; return p.cache_slc + ((size_t)page * 128 + (blk & 1) * 64 + kl) * 256; }
        return nullptr;
    };
    auto slc_rowb = [&](int blk) __attribute__((always_inline)) -> const bf16_t* { return (blk == 256 && (tid >> 2) == 0) ? zbrow + C_KS : nullptr; };
    reset(A);
    load_rows(slc_row(sell[0]), slc_rowb(sell[0]));
    for (int si = 0; si < 16; ++si) {
        const int blk = sell[si];
        __syncthreads(); store_rows(); __syncthreads();
        if (si + 1 < 16) load_rows(slc_row(sell[si + 1]), slc_rowb(sell[si + 1]));
        attn_block(Ks, VTs, Qf, A, 5, PAST - blk * 64, blut, 1u, 1u, false, lr, lq, (blk == 256) ? 1 : 64, 1);
    }
    finish(A, 1);
    auto win_row = [&](int wb) __attribute__((always_inline)) -> const float* {
        const int j = 1 + wb * 64 + (tid >> 2);
        return (j < 512) ? p.state_win + ((size_t)b * 512 + j) * 256 : nullptr;
    };
    auto win_rowb = [&](int wb) __attribute__((always_inline)) -> const bf16_t* { return (1 + wb * 64 + (tid >> 2) == 512) ? zbrow + C_KW : nullptr; };
    reset(A);
    load_rows(win_row(0), win_rowb(0));
    for (int wb = 0; wb < 8; ++wb) {
        __syncthreads(); store_rows(); __syncthreads();
        if (wb + 1 < 8) load_rows(win_row(wb + 1), win_rowb(wb + 1));
        attn_block(Ks, VTs, Qf, A, 5, 511 - wb * 64, blut, 1u, 1u, false, lr, lq, 64, 1);
    }
    finish(A, 2);
    if (lr == 0) {
#pragma unroll
        for (int dt = 0; dt < 4; ++dt) store_bf16x4(NOUTB + (size_t)(NP + b) * 512 + hq * 64 + dt * 16 + lq * 4, res[dt]);
    }
}

#define Z ((float*)(p.ws + WS_Z))
#define QK ((float*)(p.ws + WS_QK))
#define HRAW ((float*)(p.ws + WS_HRAW))
#define MOUTB ((bf16_t*)(p.ws + WS_MOUTB))
#define NOUTB ((bf16_t*)(p.ws + WS_NOUTB))
#define HIDPB ((bf16_t*)(p.ws + WS_HIDPB))
#define HIDSB ((bf16_t*)(p.ws + WS_HIDSB))
#define KCS ((float*)(p.ws + WS_KCS))
#define MIX ((float*)(p.ws + WS_MIX))
#define MIXB ((bf16_t*)(p.ws + WS_MIXB))
#define T1 ((float*)(p.ws + WS_T1))
#define X1 ((float*)(p.ws + WS_X1))
#define X1B ((bf16_t*)(p.ws + WS_X1B))
#define QPB ((bf16_t*)(p.ws + WS_QPB))
#define S ((float*)(p.ws + WS_S))
#define CONVB ((bf16_t*)(p.ws + WS_CONVB))
#define XB ((bf16_t*)(p.ws + WS_XB))
#define WIN_T ((bf16_t*)(p.ws + WS_WIN_T))
#define WUPM_T ((bf16_t*)(p.ws + WS_WUPM_T))
#define WUPN_T ((bf16_t*)(p.ws + WS_WUPN_T))
#define WOUT_T ((bf16_t*)(p.ws + WS_WOUT_T))
#define PWQ_T ((bf16_t*)(p.ws + WS_PWQ_T))
#define WQK_T ((bf16_t*)(p.ws + WS_WQK_T))
#define W1_T ((bf16_t*)(p.ws + WS_W1_T))
#define W2_T ((bf16_t*)(p.ws + WS_W2_T))
#define SUBK ((bf16_t*)(p.ws + WS_SUBK))
#define ZB ((bf16_t*)(p.ws + WS_ZB))
#define VTS ((bf16_t*)(p.ws + WS_VTS))
#define VTW ((bf16_t*)(p.ws + WS_VTW))
#define KCB ((bf16_t*)(p.ws + WS_KCB))
#define VTC ((bf16_t*)(p.ws + WS_VTC))
__global__ void __launch_bounds__(NTHREADS, 2) fwd_kernel(Params p) {
    extern __shared__ __attribute__((aligned(16))) unsigned char smem[];
    if (threadIdx.x == 0) { *(uint4*)smem = make_uint4(0u, 0u, 0u, 0u); }
    __syncthreads();
    XcdBarrier bar = xcd_barrier_post((unsigned*)(p.ws + WS_BAR), (volatile LAS unsigned*)smem);
    float* lds = (float*)(smem + 16);
    unsigned char* ldsb = smem + 16;
    const int tid = threadIdx.x, lane = tid & 63, w = tid >> 6;
    const int gw = blockIdx.x * 4 + w, nw = gridDim.x * 4;
    const size_t gt = (size_t)blockIdx.x * NTHREADS + tid, nt = (size_t)gridDim.x * NTHREADS;


    {
        for (size_t id = gt; id < (size_t)MP * 128; id += nt) {
            const int row = (int)(id >> 7), k8 = (int)(id & 127) * 8;
            float f[8];
            if (row < NR) {
                const float* s = (row < NP ? p.x_prompt + (size_t)row * 1024 : p.x_sample + (size_t)(row - NP) * 1024) + k8;
                const float4 a = *(const float4*)s, b = *(const float4*)(s + 4);
                f[0] = a.x; f[1] = a.y; f[2] = a.z; f[3] = a.w; f[4] = b.x; f[5] = b.y; f[6] = b.z; f[7] = b.w;
            } else {
#pragma unroll
                for (int i = 0; i < 8; ++i) f[i] = 0.f;
            }
            *(uint4*)(XB + (size_t)row * 1024 + k8) = pack8(f);
        }
        transpose_to_bf16(p.w_in, 1024, IN_DIM, WIN_T, gt, nt);
        transpose_to_bf16(p.w_up_m, 512, 1024, WUPM_T, gt, nt);
        transpose_to_bf16(p.w_up_n, 512, 1024, WUPN_T, gt, nt);
        transpose_to_bf16(p.w_out, 1024, 1024, WOUT_T, gt, nt);
        transpose_to_bf16(p.peer_wq, 1024, 2048, PWQ_T, gt, nt);
        for (int h = 0; h < 4; ++h) {
            transpose_to_bf16(p.wq + (size_t)h * 16384, 128, 128, WQK_T + (size_t)(h * 256) * 128, gt, nt);
            transpose_to_bf16(p.wk + (size_t)h * 16384, 128, 128, WQK_T + (size_t)(h * 256 + 128) * 128, gt, nt);
        }
        for (size_t id = gt; id < (size_t)2 * 128 * 128; id += nt) {
            const int k8 = (int)(id & 127) * 8, np = (int)((id >> 7) & 127), c = (int)(id >> 14);
            const int pp = np >> 6, o = np & 63, r = k8 >> 6, d = k8 & 63;
            float f[8];
#pragma unroll
            for (int e = 0; e < 8; ++e) f[e] = p.cmp_w1[((size_t)c * 2048 + (pp * 16 + r) * 64 + d + e) * 64 + o];
            *(uint4*)(W1_T + ((size_t)c * 128 + np) * 1024 + k8) = pack8(f);
        }
        if (gt < 128) {
            const int c = (int)gt >> 6, o = (int)gt & 63;
            float a = 0.f;
            for (int k = 0; k < 2048; ++k) a += p.cmp_pe[c * 2048 + k] * p.cmp_w1[((size_t)c * 2048 + k) * 64 + o];
            ((float*)(p.ws + WS_PESUM))[gt] = a;
        }
        for (int c = 0; c < 2; ++c) transpose_to_bf16(p.cmp_w2 + (size_t)c * 4096, 64, 64, W2_T + (size_t)c * 4096, gt, nt);
        for (size_t id = gt; id < (size_t)2 * 128 * 128 / 8; id += nt) {
            float f[8];
#pragma unroll
            for (int i = 0; i < 8; ++i) f[i] = p.peer_sub[id * 8 + i];
            *(uint4*)(SUBK + id * 8) = pack8(f);
        }
        for (size_t id = gt; id < (size_t)16384 * 64; id += nt) {
            const float* su = p.peer_u + id * 16; const float* sv = p.peer_v + id * 16;
            uint4 ou, ov; unsigned* pu = (unsigned*)&ou; unsigned* pv = (unsigned*)&ov;
#pragma unroll
            for (int j = 0; j < 4; ++j) {
                const float4 a4 = *(const float4*)(su + j * 4), c4 = *(const float4*)(sv + j * 4);
                pu[j] = pack4_fp8(a4.x * PEER_U_SCALE, a4.y * PEER_U_SCALE, a4.z * PEER_U_SCALE, a4.w * PEER_U_SCALE);
                pv[j] = pack4_fp8(c4.x * PEER_V_SCALE, c4.y * PEER_V_SCALE, c4.z * PEER_V_SCALE, c4.w * PEER_V_SCALE);
            }
            *(uint4*)(p.ws + WS_U8 + id * 16) = ou; *(uint4*)(p.ws + WS_V8 + id * 16) = ov;
        }
        for (size_t i = gt; i < (size_t)BS * 511 * 256; i += nt) {
            const int j = (int)(i & 255); const int wv = (int)((i >> 8) % 511); const int b = (int)((i >> 8) / 511);
            p.out[O_WINS + ((size_t)b * 512 + wv) * 256 + j] = p.state_win[((size_t)b * 512 + wv + 1) * 256 + j];
        }
        for (size_t i = gt; i < (size_t)BS * 2 * 512; i += nt) {
            const int ch = (int)(i & 511); const int jj = (int)((i >> 9) & 1); const int b = (int)(i >> 10);
            p.out[O_CVS + ((size_t)b * 3 + jj) * 512 + ch] = p.state_conv[((size_t)b * 3 + jj + 1) * 512 + ch];
        }
    }
    xcd_barrier(bar);

    gemm_glds(NR, IN_DIM, 1024,
        [&](int r, int k) { return XB + (size_t)r * 1024 + k; },
        [&](int n, int k) { return WIN_T + (size_t)n * 1024 + k; },
        [&](int r, int c0, f32x4 v) {
            if (c0 >= C_I && c0 < C_Q) *(f32x4*)(Z + (size_t)r * 32 + (c0 - C_I)) = v;
            else if (c0 >= C_G && c0 < C_GM) *(f32x4*)(Z + (size_t)r * 32 + 8 + (c0 - C_G)) = v;
            store_bf16x4(ZB + (size_t)r * IN_DIM + c0, (c0 >= C_Q && c0 < C_KC) ? v * (0.125f * LOG2E) : v);
            if (r < NP && ((c0 >= C_KS + 128 && c0 < C_KW) || (c0 >= C_KW + 128 && c0 < C_G))) {
                const bool isw = c0 >= C_KW; const int cc = c0 - (isw ? C_KW : C_KS) - 128;
                bf16_t* vt = (isw ? VTW : VTS) + ((size_t)((r >> 11) * 2) * 64 + cc) * 2048 + (r & 2047);
                const unsigned w0 = cvt_pk_bf16(v[0], v[1]), w1 = cvt_pk_bf16(v[2], v[3]);
                vt[0] = (bf16_t)(w0 & 0xffffu); vt[2048] = (bf16_t)(w0 >> 16); vt[4096] = (bf16_t)(w1 & 0xffffu); vt[6144] = (bf16_t)(w1 >> 16);
            }
            if (r < NP && c0 >= C_V && c0 < C_O) {
                bf16_t* vt = (bf16_t*)(p.ws + WS_VTM) + ((size_t)(r >> 11) * 512 + (c0 - C_V)) * 2048 + (r & 2047);
                const unsigned w0 = cvt_pk_bf16(v[0], v[1]), w1 = cvt_pk_bf16(v[2], v[3]);
                vt[0] = (bf16_t)(w0 & 0xffffu); vt[2048] = (bf16_t)(w0 >> 16); vt[4096] = (bf16_t)(w1 & 0xffffu); vt[6144] = (bf16_t)(w1 >> 16);
            }
            if (c0 >= C_KC && c0 < C_KS) *(f32x4*)(p.out + O_CMPP + (size_t)r * 256 + (c0 - C_KC)) = v;
            else if (c0 >= C_KS && c0 < C_KW) *(f32x4*)(p.out + O_SLCP + (size_t)r * 256 + (c0 - C_KS)) = v;
            else if (c0 >= C_KW && c0 < C_G) {
                if (r < NP) { const int t = r & 2047; if (t >= 1536) *(f32x4*)(p.out + O_WINP + ((size_t)(r >> 11) * 512 + (t - 1536)) * 256 + (c0 - C_KW)) = v; }
                else *(f32x4*)(p.out + O_WINS + ((size_t)(r - NP) * 512 + 511) * 256 + (c0 - C_KW)) = v;
            } else if (c0 < C_V) {
                if (r < NP) { const int t = r & 2047; if (t >= 2045) *(f32x4*)(p.out + O_CVP + ((size_t)(r >> 11) * 3 + (t - 2045)) * 512 + c0) = v; }
                else *(f32x4*)(p.out + O_CVS + ((size_t)(r - NP) * 3 + 2) * 512 + c0) = v;
            }
        }, smem + 1024);
    xcd_barrier(bar);

    for (size_t i = gt; i < (size_t)NR * 64; i += nt) {
        const int ch = (int)(i & 63) * 8; const int r = (int)(i >> 6);
        float a[8];
        { const float4 b0 = *(const float4*)(p.conv_b + ch), b1 = *(const float4*)(p.conv_b + ch + 4); a[0] = b0.x; a[1] = b0.y; a[2] = b0.z; a[3] = b0.w; a[4] = b1.x; a[5] = b1.y; a[6] = b1.z; a[7] = b1.w; }
#pragma unroll
        for (int j = 0; j < 4; ++j) {
            const float4 w0 = *(const float4*)(p.conv_w + j * 512 + ch), w1 = *(const float4*)(p.conv_w + j * 512 + ch + 4);
            float u[8]; bool have = true;
            if (r < NP) {
                const int t = r & 2047;
                if (t + j - 3 >= 0) { const uint4 q = *(const uint4*)(ZB + (size_t)(r + j - 3) * IN_DIM + C_U + ch);
                    u[0] = bf_lo(q.x); u[1] = bf_hi(q.x); u[2] = bf_lo(q.y); u[3] = bf_hi(q.y); u[4] = bf_lo(q.z); u[5] = bf_hi(q.z); u[6] = bf_lo(q.w); u[7] = bf_hi(q.w); }
                else have = false;
            } else if (j < 3) {
                const float* sc = p.state_conv + ((size_t)(r - NP) * 3 + j) * 512 + ch;
                const float4 s0 = *(const float4*)sc, s1 = *(const float4*)(sc + 4);
                u[0] = s0.x; u[1] = s0.y; u[2] = s0.z; u[3] = s0.w; u[4] = s1.x; u[5] = s1.y; u[6] = s1.z; u[7] = s1.w;
            } else { const uint4 q = *(const uint4*)(ZB + (size_t)r * IN_DIM + C_U + ch);
                u[0] = bf_lo(q.x); u[1] = bf_hi(q.x); u[2] = bf_lo(q.y); u[3] = bf_hi(q.y); u[4] = bf_lo(q.z); u[5] = bf_hi(q.z); u[6] = bf_lo(q.w); u[7] = bf_hi(q.w); }
            if (have) { a[0] += w0.x * u[0]; a[1] += w0.y * u[1]; a[2] += w0.z * u[2]; a[3] += w0.w * u[3]; a[4] += w1.x * u[4]; a[5] += w1.y * u[5]; a[6] += w1.z * u[6]; a[7] += w1.w * u[7]; }
        }
#pragma unroll
        for (int e = 0; e < 8; ++e) a[e] = a[e] / (1.0f + expf(-a[e]));
        *(uint4*)(CONVB + (size_t)r * 512 + ch) = pack8(a);
    }
    xcd_barrier(bar);

    for (int h = 0; h < 4; ++h) {
        gemm_glds(NR, 256, 128,
            [&](int r, int k) { return CONVB + (size_t)r * 512 + h * 128 + k; },
            [&](int n, int k) { return WQK_T + (size_t)(h * 256 + n) * 128 + k; },
            [&](int r, int c0, f32x4 v) {
                if (c0 >= 128) v = v * 0.08838834764831845f;
                if (c0 < 128) store_bf16x4((bf16_t*)(p.ws + WS_QB) + (size_t)r * 512 + h * 128 + c0, v);
                else {
                    store_bf16x4((bf16_t*)(p.ws + WS_KB) + (size_t)r * 512 + h * 128 + (c0 - 128), v);
                    if (r < NP) {
                        bf16_t* kt = (bf16_t*)(p.ws + WS_KTB) + ((size_t)((r >> 11) * 4 + h) * 128 + (c0 - 128)) * 2048 + (r & 2047);
                        const unsigned w0 = cvt_pk_bf16(v[0], v[1]), w1 = cvt_pk_bf16(v[2], v[3]);
                        kt[0] = (bf16_t)(w0 & 0xffffu); kt[2048] = (bf16_t)(w0 >> 16); kt[4096] = (bf16_t)(w1 & 0xffffu); kt[6144] = (bf16_t)(w1 >> 16);
                    }
                } }, smem + 1024, h * 514);
    }
    for (int c = 0; c < 2; ++c) {
        for (int grp = 0; grp < 2; ++grp) {
            const int TPB = grp ? 9 : 1, NCH = grp ? 1024 : 128, NBH = grp ? 64 : 32;
            gemm_bf16<128, true>(NBH * TPB * 128, 128, 1024,
                [&](int vrow, int k) {
                    const int tile = vrow >> 7, bh = tile / TPB, n_ = 127 * (tile % TPB) + (vrow & 127), n = n_ < NCH ? n_ : NCH - 1;
                    const int b = bh >> 1, hh = bh & 1, tok = 16 * n + (k >> 6), d0 = k & 63;
                    if (!grp) return *(const uint4*)(ZB + ((size_t)b * 2048 + tok) * IN_DIM + C_KC + c * 128 + hh * 64 + d0);
                    const int page = p.page_table[b * 128 + (tok >> 7)];
                    const float* sp = p.cache_cmp + ((size_t)page * 128 + (tok & 127)) * 256 + c * 128 + hh * 64 + d0;
                    const float4 a0 = *(const float4*)sp, a1 = *(const float4*)(sp + 4);
                    float f[8] = {a0.x, a0.y, a0.z, a0.w, a1.x, a1.y, a1.z, a1.w};
                    return pack8(f); },
                [&](int n, int k) { return *(const uint4*)(W1_T + ((size_t)c * 128 + n) * 1024 + k); },
                [&](f32x4 (&acc)[4][4], int bm) {
                    const int lr = lane & 15, lq = lane >> 4, wm = w >> 1, wn = w & 1;
                    const int tile = bm >> 7, bh = tile / TPB, n0 = 127 * (tile % TPB);
                    float* P1 = (float*)ldsb;
                    bf16_t* HL = (bf16_t*)(ldsb + 128 * 68 * 4);
                    __syncthreads();
                    if (wn == 1) {
#pragma unroll
                        for (int i = 0; i < 4; ++i)
#pragma unroll
                            for (int j = 0; j < 4; ++j) *(f32x4*)(P1 + (wm * 64 + i * 16 + lr) * 68 + j * 16 + lq * 4) = acc[i][j];
                    }
                    __syncthreads();
                    if (wn == 0) {
                        const float* pes = (const float*)(p.ws + WS_PESUM) + c * 64;
#pragma unroll
                        for (int i = 0; i < 4; ++i)
#pragma unroll
                            for (int j = 0; j < 4; ++j) {
                                const int rl = wm * 64 + i * 16 + lr, o0 = j * 16 + lq * 4;
                                const f32x4 nx = (rl < 127) ? *(const f32x4*)(P1 + (rl + 1) * 68 + o0) : (f32x4){0.f, 0.f, 0.f, 0.f};
                                const f32x4 pe4 = *(const f32x4*)(pes + o0);
                                f32x4 hv = acc[i][j] + nx + pe4;
                                hv[0] = gelu_tanh(hv[0]); hv[1] = gelu_tanh(hv[1]); hv[2] = gelu_tanh(hv[2]); hv[3] = gelu_tanh(hv[3]);
                                store_bf16x4(HL + rl * 72 + o0, hv);
                            }
                    }
                    __syncthreads();
                    f32x4 kc[2][4];
#pragma unroll
                    for (int i = 0; i < 2; ++i)
#pragma unroll
                        for (int j = 0; j < 4; ++j) kc[i][j] = (f32x4){0.f, 0.f, 0.f, 0.f};
#pragma unroll
                    for (int ks = 0; ks < 2; ++ks) {
                        bf16x8 hf[2], wf[4];
#pragma unroll
                        for (int i = 0; i < 2; ++i) hf[i] = *(const bf16x8*)(HL + (w * 32 + i * 16 + lr) * 72 + ks * 32 + lq * 8);
#pragma unroll
                        for (int j = 0; j < 4; ++j) wf[j] = *(const bf16x8*)(W2_T + ((size_t)c * 64 + j * 16 + lr) * 64 + ks * 32 + lq * 8);
#pragma unroll
                        for (int i = 0; i < 2; ++i)
#pragma unroll
                            for (int j = 0; j < 4; ++j) kc[i][j] = __builtin_amdgcn_mfma_f32_16x16x32_bf16(wf[j], hf[i], kc[i][j], 0, 0, 0);
                    }
#pragma unroll
                    for (int i = 0; i < 2; ++i) {
                        const int rl = w * 32 + i * 16 + lr, blk = n0 + rl;
                        if (rl < 127 && blk <= NCH - 2) {
#pragma unroll
                            for (int j = 0; j < 4; ++j) {
                                const int o2 = j * 16 + lq * 4;
                                if (c == 0) store_bf16x4((grp ? (bf16_t*)(p.ws + WS_KCSB) : KCB) + ((size_t)bh * NCH + blk) * 64 + o2, kc[i][j]);
                                else { bf16_t* vt = (grp ? (bf16_t*)(p.ws + WS_VTCS) : VTC) + ((size_t)bh * 64 + o2) * NCH + blk;
                                       const unsigned w0 = cvt_pk_bf16(kc[i][j][0], kc[i][j][1]), w1 = cvt_pk_bf16(kc[i][j][2], kc[i][j][3]);
                                       vt[0] = (bf16_t)(w0 & 0xffffu); vt[NCH] = (bf16_t)(w0 >> 16); vt[2 * NCH] = (bf16_t)(w1 & 0xffffu); vt[3 * NCH] = (bf16_t)(w1 >> 16); }
                            }
                        }
                    }
                    __syncthreads();
                }, ldsb, 4 * 514 + c * 608 + grp * 32);
        }
    }
    xcd_barrier(bar);

    for (;;) {
        __syncthreads();
        if (tid == 0) *(volatile int*)(ldsb + 32768) = (int)atomicAdd((unsigned*)(p.ws + WS_BAR) + 2, 1u);
        __syncthreads();
        const int idx = *(volatile int*)(ldsb + 32768);
        if (idx >= 448 + 2048) break;
        if (idx < 256) mlstm_chunk_item(p, idx, ldsb);
        else if (idx < 384) mlstm_scan_item(p, 64 + (idx - 256), lds);
        else if (idx < 448) nsa_sample_item(p, (idx - 384) >> 1, idx & 1, ldsb);
        else { const int i2 = idx - 448; nsa_prompt_item(p, (i2 & 31) >> 1, i2 & 1, 63 - (i2 >> 5), ldsb); }
    }
    xcd_barrier(bar);

    for (int row = gw; row < NR; row += nw) {
        const float* hr = HRAW + (size_t)row * 512 + lane * 8;
        const float4 h0 = *(const float4*)hr, h1 = *(const float4*)(hr + 4);
        float x[8] = {h0.x, h0.y, h0.z, h0.w, h1.x, h1.y, h1.z, h1.w};
        float sm = 0.f;
#pragma unroll
        for (int e = 0; e < 8; ++e) sm += x[e];
        const float mu = dpp_sum16(sm) * (1.0f / 128.0f);
        float q = 0.f;
#pragma unroll
        for (int e = 0; e < 8; ++e) { x[e] -= mu; q += x[e] * x[e]; }
        const float rstd = 1.0f / sqrtf(dpp_sum16(q) * (1.0f / 128.0f) + LN_EPS);
        const uint4 og = *(const uint4*)(ZB + (size_t)row * IN_DIM + C_O + lane * 8);
        const float4 g0 = *(const float4*)(p.norm_g + lane * 8), g1 = *(const float4*)(p.norm_g + lane * 8 + 4);
        float o[8];
        o[0] = sigmoidf_(bf_lo(og.x)) * (x[0] * rstd * g0.x); o[1] = sigmoidf_(bf_hi(og.x)) * (x[1] * rstd * g0.y); o[2] = sigmoidf_(bf_lo(og.y)) * (x[2] * rstd * g0.z); o[3] = sigmoidf_(bf_hi(og.y)) * (x[3] * rstd * g0.w);
        o[4] = sigmoidf_(bf_lo(og.z)) * (x[4] * rstd * g1.x); o[5] = sigmoidf_(bf_hi(og.z)) * (x[5] * rstd * g1.y); o[6] = sigmoidf_(bf_lo(og.w)) * (x[6] * rstd * g1.z); o[7] = sigmoidf_(bf_hi(og.w)) * (x[7] * rstd * g1.w);
        *(uint4*)(MOUTB + (size_t)row * 512 + lane * 8) = pack8(o);
    }
    xcd_barrier(bar);

    gemm_glds(NR, 1024, 1024,
        [&](int r, int k) { return (k < 512) ? MOUTB + (size_t)r * 512 + k : NOUTB + (size_t)r * 512 + (k - 512); },
        [&](int n, int k) { return (k < 512) ? WUPM_T + (size_t)n * 512 + k : WUPN_T + (size_t)n * 512 + (k - 512); },
        [&](int r, int c0, f32x4 v, f32x4 kp) {
            const uint2 gw2 = *(const uint2*)(ZB + (size_t)r * IN_DIM + C_GN + c0);
            f32x4 o; o[0] = kp[0] + sigmoidf_(bf_lo(gw2.x)) * v[0]; o[1] = kp[1] + sigmoidf_(bf_hi(gw2.x)) * v[1]; o[2] = kp[2] + sigmoidf_(bf_lo(gw2.y)) * v[2]; o[3] = kp[3] + sigmoidf_(bf_hi(gw2.y)) * v[3];
            store_bf16x4(MIXB + (size_t)r * 1024 + c0, o); },
        smem + 1024, 0, 8,
        [&](int r, int c0, f32x4& v, f32x4& kp) {
            const uint2 gw2 = *(const uint2*)(ZB + (size_t)r * IN_DIM + C_GM + c0);
            kp[0] = sigmoidf_(bf_lo(gw2.x)) * v[0]; kp[1] = sigmoidf_(bf_hi(gw2.x)) * v[1]; kp[2] = sigmoidf_(bf_lo(gw2.y)) * v[2]; kp[3] = sigmoidf_(bf_hi(gw2.y)) * v[3]; });
    xcd_barrier(bar);

    gemm_glds(NR, 1024, 1024,
        [&](int r, int k) { return MIXB + (size_t)r * 1024 + k; },
        [&](int n, int k) { return WOUT_T + (size_t)n * 1024 + k; },
        [&](int r, int c0, f32x4 v) {
            const f32x4 xv = *(const f32x4*)((r < NP ? p.x_prompt + (size_t)r * 1024 : p.x_sample + (size_t)(r - NP) * 1024) + c0);
            *(f32x4*)(T1 + (size_t)r * 1024 + c0) = xv * DN_ALPHA + v; }, smem + 1024);
    xcd_barrier(bar);

    for (int row = gw; row < NR; row += nw) {
        float tv[16]; float s = 0.f;
#pragma unroll
        for (int j = 0; j < 4; ++j) { const float4 t4 = *(const float4*)(T1 + (size_t)row * 1024 + j * 256 + lane * 4); tv[4 * j] = t4.x; tv[4 * j + 1] = t4.y; tv[4 * j + 2] = t4.z; tv[4 * j + 3] = t4.w; s += (t4.x + t4.y) + (t4.z + t4.w); }
        const float mu = wave_sum(s) * (1.0f / 1024.0f);
        float q = 0.f;
#pragma unroll
        for (int j = 0; j < 16; ++j) { const float d = tv[j] - mu; q += d * d; }
        const float rstd = 1.0f / sqrtf(wave_sum(q) * (1.0f / 1024.0f) + LN_EPS);
#pragma unroll
        for (int j = 0; j < 4; ++j) {
            const int c = j * 256 + lane * 4;
            const float4 g4 = *(const float4*)(p.ln1_g + c), b4 = *(const float4*)(p.ln1_b + c);
            f32x4 o; o[0] = (tv[4 * j] - mu) * rstd * g4.x + b4.x; o[1] = (tv[4 * j + 1] - mu) * rstd * g4.y + b4.y; o[2] = (tv[4 * j + 2] - mu) * rstd * g4.z + b4.z; o[3] = (tv[4 * j + 3] - mu) * rstd * g4.w + b4.w;
            *(f32x4*)(X1 + (size_t)row * 1024 + c) = o;
            store_bf16x4(X1B + (size_t)row * 1024 + c, o);
        }
    }
    xcd_barrier(bar);

    gemm_glds(NR, 2048, 1024,
        [&](int r, int k) { return X1B + (size_t)r * 1024 + k; },
        [&](int n, int k) { return PWQ_T + (size_t)n * 1024 + k; },
        [&](int r, int c0, f32x4 v) { store_bf16x4(QPB + (size_t)r * 2048 + c0, v); }, smem + 1024);
    xcd_barrier(bar);

    for (int it = blockIdx.x; it < 513 * 8; it += gridDim.x) { __syncthreads(); peer_score_topk_item(p, it >> 3, it & 7, ldsb); }
    xcd_barrier(bar);

    for (int row = gw; row < NR; row += nw) peer_expert_wave(p, row, ldsb + w * 3072, lane);
}

extern "C" void kernel_launch(void* const* d_in, const int* in_sizes, int n_in, void* d_out, int out_size, void* d_ws, size_t ws_size, hipStream_t stream) {
    static int grid = 0;
    if (grid == 0) {
        if (n_in != 32 || (size_t)out_size != O_END || ws_size < WS_END) {
            fprintf(stderr, "kernel_launch: unexpected sizes n_in %d out %d ws %zu (need %zu)\n", n_in, out_size, ws_size, (size_t)WS_END); grid = -1; return; }
        int dev = 0, cus = 0, per_cu = 0;
        if (hipGetDevice(&dev) != hipSuccess || hipDeviceGetAttribute(&cus, hipDeviceAttributeMultiprocessorCount, dev) != hipSuccess) { grid = -1; return; }
        if (hipFuncSetAttribute((const void*)fwd_kernel, hipFuncAttributeMaxDynamicSharedMemorySize, LDS_BYTES) != hipSuccess) { fprintf(stderr, "hipFuncSetAttribute failed\n"); grid = -1; return; }
        if (hipOccupancyMaxActiveBlocksPerMultiprocessor(&per_cu, (const void*)fwd_kernel, NTHREADS, LDS_BYTES) != hipSuccess || per_cu < 1) { fprintf(stderr, "occupancy query failed (%d)\n", per_cu); (void)hipGetLastError(); per_cu = 1; }
        if (per_cu > 2) per_cu = 2;
        grid = cus * per_cu;
    }
    if (grid < 0) return;
    (void)hipMemsetAsync((char*)d_ws + WS_BAR, 0, XCD_BAR_WORDS * sizeof(unsigned), stream);
    Params p{};
    p.x_prompt = (const float*)d_in[0]; p.x_sample = (const float*)d_in[1]; p.cache_cmp = (const float*)d_in[2]; p.cache_slc = (const float*)d_in[3];
    p.page_table = (const int*)d_in[4]; p.state_win = (const float*)d_in[5]; p.state_C = (const float*)d_in[6]; p.state_n = (const float*)d_in[7];
    p.state_m = (const float*)d_in[8]; p.state_conv = (const float*)d_in[9]; p.w_in = (const float*)d_in[10]; p.conv_w = (const float*)d_in[11];
    p.conv_b = (const float*)d_in[12]; p.wq = (const float*)d_in[13]; p.wk = (const float*)d_in[14]; p.gate_bias = (const float*)d_in[15];
    p.norm_g = (const float*)d_in[16]; p.cmp_pe = (const float*)d_in[17]; p.cmp_w1 = (const float*)d_in[18]; p.cmp_w2 = (const float*)d_in[19];
    p.rel_bias = (const float*)d_in[20]; p.w_up_m = (const float*)d_in[21]; p.w_up_n = (const float*)d_in[22]; p.w_out = (const float*)d_in[23];
    p.ln1_g = (const float*)d_in[24]; p.ln1_b = (const float*)d_in[25]; p.ln2_g = (const float*)d_in[26]; p.ln2_b = (const float*)d_in[27];
    p.peer_wq = (const float*)d_in[28]; p.peer_sub = (const float*)d_in[29]; p.peer_u = (const float*)d_in[30]; p.peer_v = (const float*)d_in[31];
    p.out = (float*)d_out; p.ws = (unsigned char*)d_ws;
    hipLaunchKernelGGL(fwd_kernel, dim3(grid), dim3(NTHREADS), LDS_BYTES, stream, p);
}
```

```cpp
#include <hip/hip_runtime.h>
#include <stdint.h>
#include <cstdio>

#define DEV __device__ __forceinline__

constexpr int DM = 1024;
constexpr int BP = 16, TP = 2048, BS = 32;
constexpr int NP = BP * TP;
constexpr int NR = NP + BS;
constexpr int MP = 32896;
constexpr int IN_DIM = 4896;
constexpr int C_U = 0, C_V = 512, C_O = 1024, C_I = 1536, C_F = 1540, C_Q = 1544, C_KC = 2056, C_KS = 2312, C_KW = 2568, C_G = 2824, C_GM = 2848, C_GN = 3872;
constexpr int PAST = 16384;
constexpr float NEGF = -1e30f;
constexpr float DN_ALPHA = 1.189207115002721f;
constexpr float LN_EPS = 1e-5f;
constexpr float LOG2E = 1.4426950408889634f;

constexpr size_t O_Y = 0;
constexpr size_t O_CMPP = (size_t)NR * DM;
constexpr size_t O_CMPS = O_CMPP + (size_t)NP * 256;
constexpr size_t O_SLCP = O_CMPS + (size_t)BS * 256;
constexpr size_t O_SLCS = O_SLCP + (size_t)NP * 256;
constexpr size_t O_WINP = O_SLCS + (size_t)BS * 256;
constexpr size_t O_WINS = O_WINP + (size_t)BP * 512 * 256;
constexpr size_t O_CP = O_WINS + (size_t)BS * 512 * 256;
constexpr size_t O_CS = O_CP + (size_t)BP * 4 * 128 * 128;
constexpr size_t O_NP = O_CS + (size_t)BS * 4 * 128 * 128;
constexpr size_t O_NS = O_NP + (size_t)BP * 4 * 128;
constexpr size_t O_MP = O_NS + (size_t)BS * 4 * 128;
constexpr size_t O_MS = O_MP + (size_t)BP * 4;
constexpr size_t O_CVP = O_MS + (size_t)BS * 4;
constexpr size_t O_CVS = O_CVP + (size_t)BP * 3 * 512;
constexpr size_t O_END = O_CVS + (size_t)BS * 3 * 512;
static_assert(O_END == 59916480, "output size");

constexpr size_t al256(size_t x) { return (x + 255) & ~(size_t)255; }
constexpr size_t WS_BAR = 0;
constexpr size_t WS_Z = 16384;
constexpr size_t WS_QK = al256(WS_Z + (size_t)MP * 32 * 4);
constexpr size_t WS_HRAW = al256(WS_QK + 256);
constexpr size_t WS_MOUTB = al256(WS_HRAW + (size_t)MP * 512 * 4);
constexpr size_t WS_NOUTB = al256(WS_MOUTB + (size_t)MP * 512 * 2);
constexpr size_t WS_HIDPB = al256(WS_NOUTB + (size_t)MP * 512 * 2);
constexpr size_t WS_KCP = al256(WS_HIDPB + (size_t)2 * 4096 * 64 * 2);
constexpr size_t WS_HIDSB = al256(WS_KCP + 256);
constexpr size_t WS_KCS = al256(WS_HIDSB + (size_t)2 * 65536 * 64 * 2);
constexpr size_t WS_MIX = al256(WS_KCS + (size_t)2 * 65536 * 64 * 4);
constexpr size_t WS_MIXB = al256(WS_MIX + (size_t)MP * 1024 * 4);
constexpr size_t WS_T1 = al256(WS_MIXB + (size_t)MP * 1024 * 2);
constexpr size_t WS_X1 = al256(WS_T1 + (size_t)MP * 1024 * 4);
constexpr size_t WS_X1B = al256(WS_X1 + (size_t)MP * 1024 * 4);
constexpr size_t WS_QPB = al256(WS_X1B + (size_t)MP * 1024 * 2);
constexpr size_t WS_S = al256(WS_QPB + (size_t)MP * 2048 * 2);
constexpr size_t WS_PIDX = al256(WS_S + (size_t)MP * 2048 * 4);
constexpr size_t WS_PG = al256(WS_PIDX + (size_t)MP * 128 * 4);
constexpr size_t WS_CONVB = al256(WS_PG + (size_t)MP * 128 * 4);
constexpr size_t WS_XB = al256(WS_CONVB + (size_t)MP * 512 * 2);
constexpr size_t WS_WIN_T = al256(WS_XB + (size_t)MP * 1024 * 2);
constexpr size_t WS_WUPM_T = al256(WS_WIN_T + (size_t)IN_DIM * 1024 * 2);
constexpr size_t WS_WUPN_T = al256(WS_WUPM_T + (size_t)1024 * 512 * 2);
constexpr size_t WS_WOUT_T = al256(WS_WUPN_T + (size_t)1024 * 512 * 2);
constexpr size_t WS_PWQ_T = al256(WS_WOUT_T + (size_t)1024 * 1024 * 2);
constexpr size_t WS_WQK_T = al256(WS_PWQ_T + (size_t)2048 * 1024 * 2);
constexpr size_t WS_W1_T = al256(WS_WQK_T + (size_t)4 * 256 * 128 * 2);
constexpr size_t WS_PESUM = al256(WS_W1_T + (size_t)2 * 128 * 1024 * 2);
constexpr size_t WS_W2_T = al256(WS_PESUM + 512);
constexpr size_t WS_SUBK = al256(WS_W2_T + (size_t)2 * 64 * 64 * 2);
constexpr size_t WS_ZB = al256(WS_SUBK + (size_t)2 * 128 * 128 * 2);
constexpr size_t WS_VTS = al256(WS_ZB + (size_t)MP * IN_DIM * 2);
constexpr size_t WS_VTW = al256(WS_VTS + (size_t)16 * 2 * 64 * 2048 * 2);
constexpr size_t WS_KCB = al256(WS_VTW + (size_t)16 * 2 * 64 * 2048 * 2);
constexpr size_t WS_VTC = al256(WS_KCB + (size_t)16 * 2 * 128 * 64 * 2);
constexpr size_t WS_NOUTF = al256(WS_VTC + (size_t)16 * 2 * 64 * 128 * 2);
constexpr size_t WS_U8 = al256(WS_NOUTF + (size_t)NP * 512 * 4);
constexpr size_t WS_V8 = al256(WS_U8 + (size_t)16384 * 1024);
constexpr size_t WS_QB = al256(WS_V8 + (size_t)16384 * 1024);
constexpr size_t WS_KB = al256(WS_QB + (size_t)MP * 512 * 2);
constexpr size_t WS_KTB = al256(WS_KB + (size_t)MP * 512 * 2);
constexpr size_t WS_VTM = al256(WS_KTB + (size_t)16 * 512 * 2048 * 2);
constexpr size_t WS_KCSB = al256(WS_VTM + (size_t)16 * 512 * 2048 * 2);
constexpr size_t WS_VTCS = al256(WS_KCSB + (size_t)32 * 2 * 1024 * 64 * 2);
constexpr size_t WS_END = al256(WS_VTCS + (size_t)32 * 2 * 64 * 1024 * 2);

static_assert(WS_END <= 2684354560ull, "workspace too large");
constexpr int LDS_BYTES = 73728;
constexpr int NTHREADS = 256;

struct Params {
    const float* x_prompt; const float* x_sample; const float* cache_cmp; const float* cache_slc; const int* page_table;
    const float* state_win; const float* state_C; const float* state_n; const float* state_m; const float* state_conv;
    const float* w_in; const float* conv_w; const float* conv_b; const float* wq; const float* wk; const float* gate_bias; const float* norm_g;
    const float* cmp_pe; const float* cmp_w1; const float* cmp_w2; const float* rel_bias; const float* w_up_m; const float* w_up_n; const float* w_out;
    const float* ln1_g; const float* ln1_b; const float* ln2_g; const float* ln2_b; const float* peer_wq; const float* peer_sub; const float* peer_u; const float* peer_v;
    float* out; unsigned char* ws;
};

#define XB_TMO      128
#define XB_XCNT(j)  (256  + 64 * (j))
#define XB_XSUB(j)  (1280 + 64 * (j))
#define XB_XGEN(j)  (2304 + 64 * (j))
#define XB_TOP      3328
#define XB_TOPGEN   3392
#define XCD_BAR_WORDS 3456
#define XB_SPIN_CAP (1u << 22)
#define LAS __attribute__((address_space(3)))

__device__ __forceinline__ unsigned xb_ld(unsigned* p)              { return __hip_atomic_load(p, __ATOMIC_RELAXED, __HIP_MEMORY_SCOPE_AGENT); }
__device__ __forceinline__ unsigned xb_add(unsigned* p, unsigned v) { return __hip_atomic_fetch_add(p, v, __ATOMIC_RELAXED, __HIP_MEMORY_SCOPE_AGENT); }
__device__ __forceinline__ unsigned xb_xcc_id() { return (unsigned)__builtin_amdgcn_s_getreg((3 << 11) | 20) & 0xFu; }
#define XB_SPIN(cond, bar) do { unsigned _sp = 0; while (cond) { __builtin_amdgcn_s_sleep(1); \
    if ((++_sp & 255u) == 0u) { if (xb_ld(&(bar)[XB_TMO])) break; if (_sp > XB_SPIN_CAP) { atomicAdd(&(bar)[XB_TMO], 1u); break; } } } } while (0)

struct XcdBarrier { unsigned* bar; unsigned x; volatile LAS unsigned* st; };

__device__ __forceinline__ XcdBarrier xcd_barrier_post(unsigned* bar, volatile LAS unsigned* st) {
    XcdBarrier b; b.bar = bar; b.x = xb_xcc_id(); b.st = st;
    if (threadIdx.x == 0) (void)xb_add(&bar[XB_XCNT(b.x)], 1u);
    return b;
}
__device__ __forceinline__ void xcd_barrier_complete(unsigned* bar, unsigned x, unsigned& nloc, unsigned& nx) {
    const unsigned G = gridDim.x * gridDim.y * gridDim.z;
    unsigned sum, cnt, mine, sp = 0u;
    for (;;) {
        sum = 0u; cnt = 0u; mine = 0u;
#pragma unroll
        for (unsigned j = 0; j < 16; ++j) { const unsigned c = xb_ld(&bar[XB_XCNT(j)]); sum += c; cnt += (c > 0u) ? 1u : 0u; mine = (j == x) ? c : mine; }
        if (sum == G) break;
        __builtin_amdgcn_s_sleep(1);
        if ((++sp & 255u) == 0u) { if (xb_ld(&bar[XB_TMO])) break; if (sp > XB_SPIN_CAP) { atomicAdd(&bar[XB_TMO], 1u); break; } }
    }
    nloc = mine > 0u ? mine : 1u; nx = cnt > 0u ? cnt : 1u;
}
__device__ __forceinline__ void xcd_barrier(const XcdBarrier& b) {
    asm volatile("s_waitcnt vmcnt(0)" ::: "memory");
    __syncthreads();
    if (threadIdx.x == 0) {
        unsigned* bar = b.bar;
        __builtin_amdgcn_s_waitcnt(0);
        unsigned nloc = b.st[0], nx = b.st[1];
        if (nloc == 0u) { xcd_barrier_complete(bar, b.x, nloc, nx); b.st[0] = nloc; b.st[1] = nx; }
        const unsigned old = xb_add(&bar[XB_XSUB(b.x)], 1u);
        const unsigned gen = old / nloc;
        if (old + 1u == (gen + 1u) * nloc) {
            __builtin_amdgcn_fence(__ATOMIC_RELEASE, "agent");
            asm volatile("s_waitcnt vmcnt(0)" ::: "memory");
            const unsigned og = xb_add(&bar[XB_TOP], 1u);
            const unsigned tg = og / nx;
            if (og + 1u == (tg + 1u) * nx) xb_add(&bar[XB_TOPGEN], 1u);
            else XB_SPIN(xb_ld(&bar[XB_TOPGEN]) == tg, bar);
            __builtin_amdgcn_fence(__ATOMIC_ACQUIRE, "agent");
            xb_add(&bar[XB_XGEN(b.x)], 1u);
            asm volatile("s_waitcnt vmcnt(0)" ::: "memory");
        } else {
            XB_SPIN(xb_ld(&bar[XB_XGEN(b.x)]) == gen, bar);
            __builtin_amdgcn_fence(__ATOMIC_ACQUIRE, "agent");
            asm volatile("s_waitcnt vmcnt(0)" ::: "memory");
        }
    }
    __syncthreads();
}

typedef float f32x4 __attribute__((ext_vector_type(4)));

__device__ const unsigned char REL_LUT[128] = {
    0, 1, 2, 3, 4, 5, 6, 7, 8, 9, 10, 11, 12, 13, 14, 15, 16, 16, 16, 17, 17, 18, 18, 18, 19, 19, 19, 20, 20, 20, 20, 21, 21, 21, 21, 22, 22, 22, 22, 22,
    23, 23, 23, 23, 23, 23, 24, 24, 24, 24, 24, 24, 25, 25, 25, 25, 25, 25, 25, 26, 26, 26, 26, 26, 26, 26, 26, 27, 27, 27, 27, 27, 27, 27, 27, 27, 27,
    28, 28, 28, 28, 28, 28, 28, 28, 28, 28, 29, 29, 29, 29, 29, 29, 29, 29, 29, 29, 29, 29, 30, 30, 30, 30, 30, 30, 30, 30, 30, 30, 30, 30, 30, 30,
    31, 31, 31, 31, 31, 31, 31, 31, 31, 31, 31, 31, 31, 31, 31};
DEV int rel_bucket(int n) { return n < 128 ? (int)REL_LUT[n < 0 ? 0 : n] : 31; }

DEV float sigmoidf_(float x) { return 1.0f / (1.0f + expf(-x)); }
DEV float gelu_tanh(float x) { return 0.5f * x * (1.0f + tanhf(0.7978845608028654f * (x + 0.044715f * x * x * x))); }
DEV float log_sigmoid(float x) { return x >= 0.f ? -log1pf(expf(-x)) : x - log1pf(expf(x)); }
DEV void wave_sync() { asm volatile("s_waitcnt lgkmcnt(0)" ::: "memory"); __builtin_amdgcn_wave_barrier(); asm volatile("" ::: "memory"); }
DEV float wave_sum(float v) {
#pragma unroll
    for (int o = 32; o >= 1; o >>= 1) v += __shfl_xor(v, o);
    return v;
}
DEV float wave_max(float v) {
#pragma unroll
    for (int o = 32; o >= 1; o >>= 1) v = fmaxf(v, __shfl_xor(v, o));
    return v;
}

typedef unsigned short bf16_t;
typedef short bf16x8 __attribute__((ext_vector_type(8)));
typedef float f32x2_ __attribute__((ext_vector_type(2)));
typedef __bf16 bf16x2_ __attribute__((ext_vector_type(2)));
DEV unsigned cvt_pk_bf16(float lo, float hi) { const f32x2_ v = {lo, hi}; return __builtin_bit_cast(unsigned, __builtin_convertvector(v, bf16x2_)); }
DEV float bf_lo(unsigned w) { return __uint_as_float(w << 16); }
DEV float bf_hi(unsigned w) { return __uint_as_float(w & 0xffff0000u); }
DEV uint4 pack8(const float* f) { uint4 r; r.x = cvt_pk_bf16(f[0], f[1]); r.y = cvt_pk_bf16(f[2], f[3]); r.z = cvt_pk_bf16(f[4], f[5]); r.w = cvt_pk_bf16(f[6], f[7]); return r; }
DEV void store_bf16x4(bf16_t* p, f32x4 v) { uint2 w; w.x = cvt_pk_bf16(v[0], v[1]); w.y = cvt_pk_bf16(v[2], v[3]); *(uint2*)p = w; }

DEV void transpose_to_bf16(const float* __restrict__ src, const int K, const int N, bf16_t* __restrict__ dst, const size_t gt, const size_t nt) {
    const size_t items = (size_t)N * (K >> 3);
    for (size_t id = gt; id < items; id += nt) {
        const int n = (int)(id % N), k8 = (int)(id / N) * 8;
        float f[8];
#pragma unroll
        for (int i = 0; i < 8; ++i) f[i] = src[(size_t)(k8 + i) * N + n];
        *(uint4*)(dst + (size_t)n * K + k8) = pack8(f);
    }
}

template <int BN, bool TILE_EPI = false, class LA, class LB, class EF>
DEV void gemm_bf16(const int M, const int N, const int K, LA la, LB lb, EF ef, unsigned char* lds, const int toff = 0) {
    constexpr int TJ = BN / 32;
    constexpr int NB = BN / 32;
    constexpr int LDR = 144;
    const int tid = threadIdx.x, lane = tid & 63, w = tid >> 6, wm = w >> 1, wn = w & 1;
    const int tm = (M + 127) >> 7, tn = (N + BN - 1) / BN;
    unsigned char* As = lds;
    unsigned char* Bs = lds + 128 * LDR;
    const int lr = lane & 15, lq = lane >> 4;
    for (int tile = (int)((blockIdx.x + gridDim.x - (unsigned)toff % gridDim.x) % gridDim.x); tile < tm * tn; tile += gridDim.x) {
        const int bm = (tile / tn) * 128, bn = (tile % tn) * BN;
        f32x4 acc[4][TJ];
#pragma unroll
        for (int i = 0; i < 4; ++i)
#pragma unroll
            for (int j = 0; j < TJ; ++j) acc[i][j] = (f32x4){0.f, 0.f, 0.f, 0.f};
        uint4 ra[4], rb[NB];
        int arow[4], brow[NB];
#pragma unroll
        for (int i = 0; i < 4; ++i) { const int r = bm + ((tid + 256 * i) >> 3); arow[i] = r < M ? r : M - 1; }
#pragma unroll
        for (int i = 0; i < NB; ++i) { const int n = bn + ((tid + 256 * i) >> 3); brow[i] = n < N ? n : N - 1; }
        const int kc = (tid & 7) * 8;
#pragma unroll
        for (int i = 0; i < 4; ++i) ra[i] = la(arow[i], kc);
#pragma unroll
        for (int i = 0; i < NB; ++i) rb[i] = lb(brow[i], kc);
        for (int k0_ = 0; k0_ < K; k0_ += 64) {
            int k0 = k0_; asm volatile("" : "+v"(k0));
            __syncthreads();
#pragma unroll
            for (int i = 0; i < 4; ++i) *(uint4*)(As + ((tid + 256 * i) >> 3) * LDR + (tid & 7) * 16) = ra[i];
#pragma unroll
            for (int i = 0; i < NB; ++i) *(uint4*)(Bs + ((tid + 256 * i) >> 3) * LDR + (tid & 7) * 16) = rb[i];
            __syncthreads();
            if (k0_ + 64 < K) {
#pragma unroll
                for (int i = 0; i < 4; ++i) ra[i] = la(arow[i], k0 + 64 + kc);
#pragma unroll
                for (int i = 0; i < NB; ++i) rb[i] = lb(brow[i], k0 + 64 + kc);
            }
#pragma unroll
            for (int kk = 0; kk < 2; ++kk) {
                bf16x8 a[4], b[TJ];
#pragma unroll
                for (int i = 0; i < 4; ++i) a[i] = *(const bf16x8*)(As + (wm * 64 + i * 16 + lr) * LDR + kk * 64 + lq * 16);
#pragma unroll
                for (int j = 0; j < TJ; ++j) b[j] = *(const bf16x8*)(Bs + (wn * (BN / 2) + j * 16 + lr) * LDR + kk * 64 + lq * 16);
#pragma unroll
                for (int i = 0; i < 4; ++i)
#pragma unroll
                    for (int j = 0; j < TJ; ++j) acc[i][j] = __builtin_amdgcn_mfma_f32_16x16x32_bf16(b[j], a[i], acc[i][j], 0, 0, 0);
            }
        }
        if constexpr (TILE_EPI) { ef(acc, bm); }
        else {
#pragma unroll
            for (int i = 0; i < 4; ++i)
#pragma unroll
                for (int j = 0; j < TJ; ++j) {
                    const int r = bm + wm * 64 + i * 16 + lr, c0 = bn + wn * (BN / 2) + j * 16 + lq * 4;
                    if (r < M && c0 < N) ef(r, c0, acc[i][j]);
                }
        }
    }
}

DEV int lds_byte2(int r, int c) { const int st = (r >> 4) * 2 + (c >> 5), ob = (r & 15) * 64 + (c & 31) * 2; return st * 1024 + (ob ^ (((ob >> 9) & 1) << 5)); }
DEV void stage_rc2(int b, int& R, int& C) { const int st = b >> 10, sb = b & 1023, swz = sb ^ (((sb >> 9) & 1) << 5); R = (st >> 1) * 16 + swz / 64; C = (st & 1) * 32 + (swz % 64) / 2; }
struct NoMid { DEV void operator()(int, int, f32x4&, f32x4&) const {} };
template <class PA, class PB, class EF, class MF = NoMid, bool XCDN = false>
DEV void gemm_glds(const int M, const int N, const int K, PA pa, PB pb, EF ef, unsigned char* lds, const int toff = 0, const int ksplit = 0, MF mf = MF()) {
    const int tid = threadIdx.x, lane = tid & 63, w = tid >> 6, wm = w >> 1, wn = w & 1;
    const int tm = (M + 127) >> 7, tn = (N + 127) >> 7;
    const int lr = lane & 15, lq = lane >> 4;
    const int nk = K >> 6;
    int sR[4], sC[4];
#pragma unroll
    for (int i = 0; i < 4; ++i) stage_rc2((w + 4 * i) * 1024 + lane * 16, sR[i], sC[i]);
    const int xc = blockIdx.x & 7, xslots = gridDim.x >> 3, xcnt = (tn - xc + 7) >> 3;
    for (int tile = XCDN ? (int)(blockIdx.x >> 3) : (int)((blockIdx.x + gridDim.x - (unsigned)toff % gridDim.x) % gridDim.x); tile < (XCDN ? tm * xcnt : tm * tn); tile += (XCDN ? xslots : (int)gridDim.x)) {
        const int bm = (XCDN ? tile / xcnt : tile / tn) * 128, bn = (XCDN ? xc + 8 * (tile % xcnt) : tile % tn) * 128;
        f32x4 acc[4][4], keep[4][4];
#pragma unroll
        for (int i = 0; i < 4; ++i)
#pragma unroll
            for (int j = 0; j < 4; ++j) { acc[i][j] = (f32x4){0.f, 0.f, 0.f, 0.f}; keep[i][j] = (f32x4){0.f, 0.f, 0.f, 0.f}; }
        int arow[4], brow[4];
#pragma unroll
        for (int i = 0; i < 4; ++i) { const int r = bm + sR[i], n = bn + sR[i]; arow[i] = r < M ? r : M - 1; brow[i] = n < N ? n : N - 1; }
#define GLDS_STAGE(BUF, KT) { _Pragma("unroll") for (int i = 0; i < 4; ++i) { \
            __builtin_amdgcn_global_load_lds((const unsigned*)pa(arow[i], (KT) * 64 + sC[i]), (LAS unsigned*)(lds + (BUF) * 32768 + (w + 4 * i) * 1024), 16, 0, 0); \
            __builtin_amdgcn_global_load_lds((const unsigned*)pb(brow[i], (KT) * 64 + sC[i]), (LAS unsigned*)(lds + (BUF) * 32768 + 16384 + (w + 4 * i) * 1024), 16, 0, 0); } }
        __syncthreads();
        GLDS_STAGE(0, 0)
        asm volatile("s_waitcnt vmcnt(0)" ::: "memory");
        __syncthreads();
        for (int kt = 0; kt < nk; ++kt) {
            const int cur = kt & 1;
            if (kt + 1 < nk) GLDS_STAGE(cur ^ 1, kt + 1)
            const unsigned char* SA = lds + cur * 32768;
            const unsigned char* SB = SA + 16384;
#pragma unroll
            for (int kk = 0; kk < 2; ++kk) {
                bf16x8 a[4], b[4];
#pragma unroll
                for (int i = 0; i < 4; ++i) a[i] = *(const bf16x8*)(SA + lds_byte2(wm * 64 + i * 16 + lr, kk * 32 + lq * 8));
#pragma unroll
                for (int j = 0; j < 4; ++j) b[j] = *(const bf16x8*)(SB + lds_byte2(wn * 64 + j * 16 + lr, kk * 32 + lq * 8));
#pragma unroll
                for (int i = 0; i < 4; ++i)
#pragma unroll
                    for (int j = 0; j < 4; ++j) acc[i][j] = __builtin_amdgcn_mfma_f32_16x16x32_bf16(b[j], a[i], acc[i][j], 0, 0, 0);
            }
            if constexpr (!__is_same(MF, NoMid)) {
                if (kt + 1 == ksplit) {
#pragma unroll
                    for (int i = 0; i < 4; ++i)
#pragma unroll
                        for (int j = 0; j < 4; ++j) {
                            const int r = bm + wm * 64 + i * 16 + lr, c0 = bn + wn * 64 + j * 16 + lq * 4;
                            if (r < M && c0 < N) mf(r, c0, acc[i][j], keep[i][j]);
                            acc[i][j] = (f32x4){0.f, 0.f, 0.f, 0.f};
                        }
                }
            }
            asm volatile("s_waitcnt vmcnt(0)" ::: "memory");
            __syncthreads();
        }
#undef GLDS_STAGE
#pragma unroll
        for (int i = 0; i < 4; ++i)
#pragma unroll
            for (int j = 0; j < 4; ++j) {
                const int r = bm + wm * 64 + i * 16 + lr, c0 = bn + wn * 64 + j * 16 + lq * 4;
                if (r < M && c0 < N) { if constexpr (!__is_same(MF, NoMid)) ef(r, c0, acc[i][j], keep[i][j]); else ef(r, c0, acc[i][j]); }
            }
    }
}

template <class PA, class PB, class EF>
DEV void gemm_glds_xcd(const int M, const int N, const int K, PA pa, PB pb, EF ef, unsigned char* lds) { gemm_glds<PA, PB, EF, NoMid, true>(M, N, K, pa, pb, ef, lds, 0, 0, NoMid()); }

DEV void mlstm_scan_item(const Params& p, const int item, float* lds) {
    const int tid = threadIdx.x, v = tid >> 1, kh = tid & 1;
    const int seq = item >> 2, h = item & 3;
    const bool pr = seq < 16; const int b = pr ? seq : seq - 16;
    const int T = pr ? 2048 : 1; const int row0 = pr ? b * 2048 : NP + b;
    const float* Z = (const float*)(p.ws + WS_Z);
    const bf16_t* QBp = (const bf16_t*)(p.ws + WS_QB); const bf16_t* KBp = (const bf16_t*)(p.ws + WS_KB); const bf16_t* ZBp = (const bf16_t*)(p.ws + WS_ZB);
    float* HRAW = (float*)(p.ws + WS_HRAW);
    float C[64], n[64]; float m;
    if (pr) {
#pragma unroll
        for (int j = 0; j < 64; ++j) { C[j] = 0.f; n[j] = 0.f; }
        m = 0.f;
    } else {
        const float* c0 = p.state_C + (((size_t)(b * 4 + h) * 128 + v) * 128 + kh * 64);
        const float* n0 = p.state_n + ((size_t)(b * 4 + h) * 128 + kh * 64);
#pragma unroll
        for (int j = 0; j < 64; ++j) { C[j] = c0[j]; n[j] = n0[j]; }
        m = p.state_m[b * 4 + h];
    }
    const float gb_i = p.gate_bias[h], gb_f = p.gate_bias[4 + h];
    auto load_tok = [&](int t, float* dst) {
        const size_t r = (size_t)(row0 + t);
        dst[tid] = bf_lo((unsigned)(tid < 128 ? QBp[r * 512 + h * 128 + tid] : KBp[r * 512 + h * 128 + tid - 128]));
        if (tid < 128) dst[256 + tid] = bf_lo((unsigned)ZBp[r * IN_DIM + C_V + h * 128 + tid]);
        if (tid == 128) dst[384] = Z[r * 32 + h] + gb_i;
        if (tid == 129) dst[385] = log_sigmoid(Z[r * 32 + 4 + h] + gb_f);
    };
    __syncthreads();
    load_tok(0, lds);
    __syncthreads();
    for (int t = 0; t < T; ++t) {
        const float* cur = lds + (t & 1) * 388;
        if (t + 1 < T) load_tok(t + 1, lds + ((t + 1) & 1) * 388);
        const float ig = cur[384], lf = cur[385];
        const float mn = fmaxf(lf + m, ig);
        const float fd = expf(lf + m - mn), iw = expf(ig - mn);
        const float vv = cur[256 + v] * iw;
        float nump = 0.f, denp = 0.f;
#pragma unroll
        for (int j = 0; j < 64; ++j) {
            const float kj = cur[128 + kh * 64 + j], qj = cur[kh * 64 + j];
            C[j] = fd * C[j] + vv * kj; n[j] = fd * n[j] + iw * kj;
            nump += C[j] * qj; denp += n[j] * qj;
        }
        nump += __shfl_xor(nump, 1); denp += __shfl_xor(denp, 1);
        const float hval = nump / fmaxf(fabsf(denp), expf(-mn));
        if (kh == 0) HRAW[(size_t)(row0 + t) * 512 + h * 128 + v] = hval;
        m = mn;
        __syncthreads();
    }
    float* co = p.out + (pr ? O_CP : O_CS) + (((size_t)(b * 4 + h) * 128 + v) * 128 + kh * 64);
#pragma unroll
    for (int j = 0; j < 64; ++j) co[j] = C[j];
    if (v == 0) {
        float* no = p.out + (pr ? O_NP : O_NS) + ((size_t)(b * 4 + h) * 128 + kh * 64);
#pragma unroll
        for (int j = 0; j < 64; ++j) no[j] = n[j];
    }
    if (tid == 0) p.out[(pr ? O_MP : O_MS) + b * 4 + h] = m;
}

DEV void peer_topk_item(const Params& p, const int row, const int h, const int lane) {
    const float* S = (const float*)(p.ws + WS_S) + (size_t)row * 2048 + h * 256;
    int* PIDX = (int*)(p.ws + WS_PIDX); float* PG = (float*)(p.ws + WS_PG);
    float ts[2]; int ti[2];
#pragma unroll
    for (int pp = 0; pp < 2; ++pp) {
        float v0 = S[pp * 128 + lane], v1 = S[pp * 128 + 64 + lane];
        float mys = 0.f; int myi = 0;
        for (int r = 0; r < 16; ++r) {
            float best = fmaxf(v0, v1); int bi = (v0 >= v1) ? lane : lane + 64;
#pragma unroll
            for (int off = 32; off >= 1; off >>= 1) {
                const float ob = __shfl_xor(best, off); const int oi = __shfl_xor(bi, off);
                if (ob > best || (ob == best && oi < bi)) { best = ob; bi = oi; }
            }
            if (lane == r) { mys = best; myi = bi; }
            if (bi == lane) v0 = -INFINITY;
            if (bi == lane + 64) v1 = -INFINITY;
        }
        ts[pp] = mys; ti[pp] = myi;
    }
    float cv[4];
#pragma unroll
    for (int jj = 0; jj < 4; ++jj) { const int c = lane * 4 + jj; cv[jj] = __shfl(ts[0], c >> 4) + __shfl(ts[1], c & 15); }
    float msc = 0.f; int mci = 0;
    for (int r = 0; r < 16; ++r) {
        float best = cv[0]; int bi = lane * 4;
#pragma unroll
        for (int jj = 1; jj < 4; ++jj) if (cv[jj] > best) { best = cv[jj]; bi = lane * 4 + jj; }
#pragma unroll
        for (int off = 32; off >= 1; off >>= 1) {
            const float ob = __shfl_xor(best, off); const int oi = __shfl_xor(bi, off);
            if (ob > best || (ob == best && oi < bi)) { best = ob; bi = oi; }
        }
        if (lane == r) { msc = best; mci = bi; }
#pragma unroll
        for (int jj = 0; jj < 4; ++jj) if (bi == lane * 4 + jj) cv[jj] = -INFINITY;
    }
    const int e = __shfl(ti[0], mci >> 4) * 128 + __shfl(ti[1], mci & 15);
    const float top = __shfl(msc, 0);
    float ex = (lane < 16) ? expf(msc - top) : 0.f;
    const float den = wave_sum(ex);
    if (lane < 16) { PIDX[(size_t)row * 128 + h * 16 + lane] = e; PG[(size_t)row * 128 + h * 16 + lane] = ex / den; }
}

DEV void peer_expert_item(const Params& p, const int row, float* lds) {
    const int tid = threadIdx.x, lane = tid & 63, w = tid >> 6;
    const float* X1 = (const float*)(p.ws + WS_X1) + (size_t)row * 1024;
    const int* PIDX = (const int*)(p.ws + WS_PIDX) + (size_t)row * 128;
    const float* PG = (const float*)(p.ws + WS_PG) + (size_t)row * 128;
    float4 x[4], acc[4];
#pragma unroll
    for (int j = 0; j < 4; ++j) { x[j] = *(const float4*)(X1 + j * 256 + lane * 4); acc[j] = make_float4(0.f, 0.f, 0.f, 0.f); }
    for (int k = 0; k < 32; ++k) {
        const int e = PIDX[w * 32 + k]; const float gk = PG[w * 32 + k];
        const float* ur = p.peer_u + (size_t)e * 1024; const float* vr = p.peer_v + (size_t)e * 1024;
        float d = 0.f;
#pragma unroll
        for (int j = 0; j < 4; ++j) { const float4 u = *(const float4*)(ur + j * 256 + lane * 4); d += u.x * x[j].x + u.y * x[j].y + u.z * x[j].z + u.w * x[j].w; }
        d = wave_sum(d);
        const float coef = gk * gelu_tanh(d);
#pragma unroll
        for (int j = 0; j < 4; ++j) { const float4 vv = *(const float4*)(vr + j * 256 + lane * 4);
            acc[j].x += coef * vv.x; acc[j].y += coef * vv.y; acc[j].z += coef * vv.z; acc[j].w += coef * vv.w; }
    }
    __syncthreads();
#pragma unroll
    for (int j = 0; j < 4; ++j) *(float4*)(lds + w * 1024 + j * 256 + lane * 4) = acc[j];
    __syncthreads();
    float tv[4]; float s = 0.f;
#pragma unroll
    for (int i = 0; i < 4; ++i) { const int c = tid * 4 + i; const float po = (lds[c] + lds[1024 + c]) + (lds[2048 + c] + lds[3072 + c]); tv[i] = DN_ALPHA * X1[c] + po; s += tv[i]; }
    float* red = lds + 4096;
    s = wave_sum(s);
    if (lane == 0) red[w] = s;
    __syncthreads();
    const float mu = (red[0] + red[1] + red[2] + red[3]) * (1.0f / 1024.0f);
    float q = 0.f;
#pragma unroll
    for (int i = 0; i < 4; ++i) { const float d = tv[i] - mu; q += d * d; }
    q = wave_sum(q);
    if (lane == 0) red[8 + w] = q;
    __syncthreads();
    const float var = (red[8] + red[9] + red[10] + red[11]) * (1.0f / 1024.0f);
    const float rstd = 1.0f / sqrtf(var + LN_EPS);
    float* y = p.out + O_Y + (size_t)row * 1024;
#pragma unroll
    for (int i = 0; i < 4; ++i) { const int c = tid * 4 + i; y[c] = (tv[i] - mu) * rstd * p.ln2_g[c] + p.ln2_b[c]; }
}

DEV void mlstm_chunk_item(const Params& p, const int item, unsigned char* lds) {
    int tid_ = threadIdx.x; asm volatile("" : "+v"(tid_));
    const int tid = tid_, lane = tid & 63, w = tid >> 6, lr = lane & 15, lq = lane >> 4;
    const int b = item >> 4, h = (item >> 2) & 3, vs = item & 3;
    bf16_t* Cl = (bf16_t*)lds;
    bf16_t* nl = (bf16_t*)(lds + 8704);
    float* uL = (float*)(lds + 8960); float* ML = uL + 64; float* scin = uL + 128; float* expm = uL + 192; float* wts = uL + 256; float* misc = uL + 320;
    const bf16_t* QB = (const bf16_t*)(p.ws + WS_QB) + (size_t)(b * 2048) * 512 + h * 128;
    const bf16_t* KB = (const bf16_t*)(p.ws + WS_KB) + (size_t)(b * 2048) * 512 + h * 128;
    const bf16_t* KTB = (const bf16_t*)(p.ws + WS_KTB) + (size_t)((b * 4 + h) * 128) * 2048;
    const bf16_t* VTM = (const bf16_t*)(p.ws + WS_VTM) + (size_t)(b * 512 + h * 128 + vs * 32) * 2048;
    const float* Z = (const float*)(p.ws + WS_Z);
    float* HRAW = (float*)(p.ws + WS_HRAW);
    const float gb_i = p.gate_bias[h], gb_f = p.gate_bias[4 + h];
    f32x4 Cm[2][2], nm[2];
#pragma unroll
    for (int i = 0; i < 2; ++i) { nm[i] = (f32x4){0.f, 0.f, 0.f, 0.f};
#pragma unroll
        for (int j = 0; j < 2; ++j) Cm[i][j] = (f32x4){0.f, 0.f, 0.f, 0.f}; }
    float m_prev = 0.f;
    __syncthreads();
    for (int i = tid; i < (8704 + 256) / 4; i += 256) ((unsigned*)lds)[i] = 0u;
    __syncthreads();
    for (int c = 0; c < 32; ++c) {
        const int t0 = c * 64;
        if (w == 0) {
            const size_t row = (size_t)(b * 2048 + t0 + lane);
            const float ig = Z[row * 32 + h] + gb_i;
            const float lf = log_sigmoid(Z[row * 32 + 4 + h] + gb_f);
            float bc = lf;
#pragma unroll
            for (int o = 1; o < 64; o <<= 1) { const float t = __shfl_up(bc, o); if (lane >= o) bc += t; }
            const float u = ig - bc;
            float pm = u;
#pragma unroll
            for (int o = 1; o < 64; o <<= 1) { const float t = __shfl_up(pm, o); if (lane >= o) pm = fmaxf(pm, t); }
            const float M = fmaxf(m_prev, pm);
            const float M63 = __shfl(M, 63), b63 = __shfl(bc, 63);
            uL[lane] = u; ML[lane] = M; scin[lane] = expf(m_prev - M); expm[lane] = expf(-(bc + M)); wts[lane] = expf(u - M63);
            if (lane == 0) { misc[0] = expf(m_prev - M63); misc[1] = b63 + M63; }
        }
        __syncthreads();
        {
            const size_t row_t = (size_t)(t0 + w * 16 + lr);
            bf16x8 Qf[4];
#pragma unroll
            for (int ks = 0; ks < 4; ++ks) Qf[ks] = *(const bf16x8*)(QB + row_t * 512 + ks * 32 + lq * 8);
            const float M_t = ML[w * 16 + lr], sc_in = scin[w * 16 + lr], em = expm[w * 16 + lr];
            f32x4 sw[4];
            float dsum = 0.f;
#pragma unroll
            for (int st = 0; st < 4; ++st) {
                f32x4 a = (f32x4){0.f, 0.f, 0.f, 0.f};
                if (st <= w) {
#pragma unroll
                    for (int ks = 0; ks < 4; ++ks) { const bf16x8 kf = *(const bf16x8*)(KB + (size_t)(t0 + st * 16 + lr) * 512 + ks * 32 + lq * 8); a = __builtin_amdgcn_mfma_f32_16x16x32_bf16(kf, Qf[ks], a, 0, 0, 0); }
#pragma unroll
                    for (int g = 0; g < 4; ++g) {
                        const int sl = st * 16 + lq * 4 + g, tl = w * 16 + lr;
                        const float wg = (sl <= tl) ? __builtin_amdgcn_exp2f((uL[sl] - M_t) * LOG2E) : 0.f;
                        a[g] *= wg; dsum += a[g];
                    }
                }
                sw[st] = a;
            }
            dsum += __shfl_xor(dsum, 16); dsum += __shfl_xor(dsum, 32);
            bf16x8 pf[2];
#pragma unroll
            for (int ks = 0; ks < 2; ++ks) {
                union { bf16x8 v; unsigned u[4]; } pk;
                pk.u[0] = cvt_pk_bf16(sw[2 * ks][0], sw[2 * ks][1]); pk.u[1] = cvt_pk_bf16(sw[2 * ks][2], sw[2 * ks][3]);
                pk.u[2] = cvt_pk_bf16(sw[2 * ks + 1][0], sw[2 * ks + 1][1]); pk.u[3] = cvt_pk_bf16(sw[2 * ks + 1][2], sw[2 * ks + 1][3]);
                pf[ks] = pk.v;
            }
            f32x4 dI = (f32x4){0.f, 0.f, 0.f, 0.f};
#pragma unroll
            for (int ks = 0; ks < 4; ++ks) { const bf16x8 nf = *(const bf16x8*)(nl + ks * 32 + lq * 8); dI = __builtin_amdgcn_mfma_f32_16x16x32_bf16(nf, Qf[ks], dI, 0, 0, 0); }
            const float den = sc_in * dI[0] + dsum;
            const float rdd = 1.0f / fmaxf(fabsf(den), em);
#pragma unroll
            for (int vt = 0; vt < 2; ++vt) {
                f32x4 ni = (f32x4){0.f, 0.f, 0.f, 0.f}, nI = (f32x4){0.f, 0.f, 0.f, 0.f};
#pragma unroll
                for (int ks = 0; ks < 2; ++ks) if (2 * ks <= w) {
                    union { bf16x8 v; uint2 hh[2]; } vf;
                    const bf16_t* vp = VTM + (size_t)(vt * 16 + lr) * 2048 + t0 + 32 * ks + lq * 4;
                    vf.hh[0] = *(const uint2*)vp; vf.hh[1] = *(const uint2*)(vp + 16);
                    ni = __builtin_amdgcn_mfma_f32_16x16x32_bf16(vf.v, pf[ks], ni, 0, 0, 0);
                }
#pragma unroll
                for (int ks = 0; ks < 4; ++ks) { const bf16x8 cf = *(const bf16x8*)(Cl + (vt * 16 + lr) * 136 + ks * 32 + lq * 8); nI = __builtin_amdgcn_mfma_f32_16x16x32_bf16(cf, Qf[ks], nI, 0, 0, 0); }
                const f32x4 hv = (nI * sc_in + ni) * rdd;
                *(f32x4*)(HRAW + ((size_t)(b * 2048) + row_t) * 512 + h * 128 + vs * 32 + vt * 16 + lq * 4) = hv;
            }
        }
        __syncthreads();
        {
            const float decay = misc[0];
            bf16x8 Af[2][2], Wf[2], Kt[2][2];
#pragma unroll
            for (int ks = 0; ks < 2; ++ks) {
                const float4 w0 = *(const float4*)(wts + ks * 32 + lq * 8), w1 = *(const float4*)(wts + ks * 32 + lq * 8 + 4);
                float wv[8] = {w0.x, w0.y, w0.z, w0.w, w1.x, w1.y, w1.z, w1.w};
                { union { bf16x8 v; uint4 q; } t; t.q = pack8(wv); Wf[ks] = t.v; }
#pragma unroll
                for (int vt = 0; vt < 2; ++vt) {
                    const uint4 raw = *(const uint4*)(VTM + (size_t)(vt * 16 + lr) * 2048 + t0 + ks * 32 + lq * 8);
                    float f[8] = {bf_lo(raw.x) * wv[0], bf_hi(raw.x) * wv[1], bf_lo(raw.y) * wv[2], bf_hi(raw.y) * wv[3], bf_lo(raw.z) * wv[4], bf_hi(raw.z) * wv[5], bf_lo(raw.w) * wv[6], bf_hi(raw.w) * wv[7]};
                    union { bf16x8 v; uint4 q; } t; t.q = pack8(f); Af[vt][ks] = t.v;
                }
#pragma unroll
                for (int kt = 0; kt < 2; ++kt) Kt[kt][ks] = *(const bf16x8*)(KTB + (size_t)((2 * w + kt) * 16 + lr) * 2048 + t0 + ks * 32 + lq * 8);
            }
#pragma unroll
            for (int kt = 0; kt < 2; ++kt) {
                nm[kt] = nm[kt] * decay;
#pragma unroll
                for (int ks = 0; ks < 2; ++ks) nm[kt] = __builtin_amdgcn_mfma_f32_16x16x32_bf16(Wf[ks], Kt[kt][ks], nm[kt], 0, 0, 0);
                if (lq == 0) nl[(2 * w + kt) * 16 + lr] = (bf16_t)(cvt_pk_bf16(nm[kt][0], 0.f) & 0xffffu);
#pragma unroll
                for (int vt = 0; vt < 2; ++vt) {
                    Cm[vt][kt] = Cm[vt][kt] * decay;
#pragma unroll
                    for (int ks = 0; ks < 2; ++ks) Cm[vt][kt] = __builtin_amdgcn_mfma_f32_16x16x32_bf16(Af[vt][ks], Kt[kt][ks], Cm[vt][kt], 0, 0, 0);
                    const unsigned c01 = cvt_pk_bf16(Cm[vt][kt][0], Cm[vt][kt][1]), c23 = cvt_pk_bf16(Cm[vt][kt][2], Cm[vt][kt][3]);
                    bf16_t* cp = Cl + (vt * 16 + lq * 4) * 136 + (2 * w + kt) * 16 + lr;
                    cp[0] = (bf16_t)(c01 & 0xffffu); cp[136] = (bf16_t)(c01 >> 16); cp[272] = (bf16_t)(c23 & 0xffffu); cp[408] = (bf16_t)(c23 >> 16);
                }
            }
            m_prev = misc[1];
        }
        __syncthreads();
    }
#pragma unroll
    for (int vt = 0; vt < 2; ++vt)
#pragma unroll
        for (int kt = 0; kt < 2; ++kt)
#pragma unroll
            for (int g = 0; g < 4; ++g)
                p.out[O_CP + ((size_t)((b * 4 + h) * 128) + vs * 32 + vt * 16 + lq * 4 + g) * 128 + (2 * w + kt) * 16 + lr] = Cm[vt][kt][g];
    if (vs == 0) {
        if (lq == 0) { p.out[O_NP + (size_t)(b * 4 + h) * 128 + (2 * w) * 16 + lr] = nm[0][0]; p.out[O_NP + (size_t)(b * 4 + h) * 128 + (2 * w + 1) * 16 + lr] = nm[1][0]; }
        if (tid == 0) p.out[O_MP + b * 4 + h] = m_prev;
    }
}

DEV unsigned dpp_max16(unsigned x) {
    x = max(x, (unsigned)__builtin_amdgcn_update_dpp(0, (int)x, 0xB1, 0xF, 0xF, false));
    x = max(x, (unsigned)__builtin_amdgcn_update_dpp(0, (int)x, 0x4E, 0xF, 0xF, false));
    x = max(x, (unsigned)__builtin_amdgcn_update_dpp(0, (int)x, 0x141, 0xF, 0xF, false));
    x = max(x, (unsigned)__builtin_amdgcn_update_dpp(0, (int)x, 0x140, 0xF, 0xF, false));
    return x;
}
DEV float dpp_sum16(float x) {
    x += __builtin_bit_cast(float, __builtin_amdgcn_update_dpp(0, __builtin_bit_cast(int, x), 0xB1, 0xF, 0xF, false));
    x += __builtin_bit_cast(float, __builtin_amdgcn_update_dpp(0, __builtin_bit_cast(int, x), 0x4E, 0xF, 0xF, false));
    x += __builtin_bit_cast(float, __builtin_amdgcn_update_dpp(0, __builtin_bit_cast(int, x), 0x141, 0xF, 0xF, false));
    x += __builtin_bit_cast(float, __builtin_amdgcn_update_dpp(0, __builtin_bit_cast(int, x), 0x140, 0xF, 0xF, false));
    return x;
}
DEV unsigned mono_key(float v) { const unsigned b = __float_as_uint(v); return (b & 0x80000000u) ? ~b : (b | 0x80000000u); }
#define CE_DESC(a, b) { const unsigned hi_ = max(a, b), lo_ = min(a, b); a = hi_; b = lo_; }

DEV void peer_score_topk_item(const Params& p, const int tile, const int h, unsigned char* lds) {
    int tid_ = threadIdx.x; asm volatile("" : "+v"(tid_));
    const int tid = tid_, lane = tid & 63, w = tid >> 6, lr = lane & 15, lq = lane >> 4;
    float* sc = (float*)(lds + w * 12416);
    float* ts = sc + 16 * 129;
    int* ti = (int*)(ts + 512);
    const bf16_t* QPB = (const bf16_t*)(p.ws + WS_QPB);
    const bf16_t* SUBK = (const bf16_t*)(p.ws + WS_SUBK);
    int* PIDX = (int*)(p.ws + WS_PIDX); float* PG = (float*)(p.ws + WS_PG);
    const int row0 = tile * 64 + w * 16;
    const int arow = (row0 + lr < NR) ? row0 + lr : NR - 1;
    wave_sync();
#pragma unroll 1
    for (int pp = 0; pp < 2; ++pp) {
        bf16x8 qf[4];
#pragma unroll
        for (int ks = 0; ks < 4; ++ks) qf[ks] = *(const bf16x8*)(QPB + (size_t)arow * 2048 + h * 256 + pp * 128 + ks * 32 + lq * 8);
#pragma unroll
        for (int j = 0; j < 8; ++j) {
            f32x4 a = (f32x4){0.f, 0.f, 0.f, 0.f};
#pragma unroll
            for (int ks = 0; ks < 4; ++ks) { const bf16x8 kf = *(const bf16x8*)(SUBK + ((size_t)pp * 128 + j * 16 + lr) * 128 + ks * 32 + lq * 8); a = __builtin_amdgcn_mfma_f32_16x16x32_bf16(qf[ks], kf, a, 0, 0, 0); }
#pragma unroll
            for (int g = 0; g < 4; ++g) sc[(lq * 4 + g) * 129 + j * 16 + lr] = a[g];
        }
        wave_sync();
#pragma unroll 1
        for (int rr = 0; rr < 4; ++rr) {
            const int row = rr * 4 + lq;
            unsigned k0, k1, k2, k3, k4, k5, k6, k7;
            { const float* sr = sc + row * 129 + lr;
              k0 = (mono_key(sr[0]) & ~0x7Fu) | (unsigned)(127 - lr);        k1 = (mono_key(sr[16]) & ~0x7Fu) | (unsigned)(127 - 16 - lr);
              k2 = (mono_key(sr[32]) & ~0x7Fu) | (unsigned)(127 - 32 - lr);  k3 = (mono_key(sr[48]) & ~0x7Fu) | (unsigned)(127 - 48 - lr);
              k4 = (mono_key(sr[64]) & ~0x7Fu) | (unsigned)(127 - 64 - lr);  k5 = (mono_key(sr[80]) & ~0x7Fu) | (unsigned)(127 - 80 - lr);
              k6 = (mono_key(sr[96]) & ~0x7Fu) | (unsigned)(127 - 96 - lr);  k7 = (mono_key(sr[112]) & ~0x7Fu) | (unsigned)(127 - 112 - lr); }
            CE_DESC(k0, k1) CE_DESC(k2, k3) CE_DESC(k4, k5) CE_DESC(k6, k7)
            CE_DESC(k0, k2) CE_DESC(k1, k3) CE_DESC(k4, k6) CE_DESC(k5, k7)
            CE_DESC(k1, k2) CE_DESC(k5, k6)
            CE_DESC(k0, k4) CE_DESC(k1, k5) CE_DESC(k2, k6) CE_DESC(k3, k7)
            CE_DESC(k2, k4) CE_DESC(k3, k5)
            CE_DESC(k1, k2) CE_DESC(k3, k4) CE_DESC(k5, k6)
            unsigned mine = 0u;
#pragma unroll
            for (int r = 0; r < 16; ++r) {
                const unsigned best = dpp_max16(k0);
                if (lr == r) mine = best;
                const bool own = (k0 == best);
                k0 = own ? k1 : k0; k1 = own ? k2 : k1; k2 = own ? k3 : k2; k3 = own ? k4 : k3; k4 = own ? k5 : k4; k5 = own ? k6 : k5; k6 = own ? k7 : k6; k7 = own ? 0u : k7;
            }
            const int idx = 127 - (int)(mine & 0x7Fu);
            ts[(pp * 16 + row) * 16 + lr] = sc[row * 129 + idx];
            ti[(pp * 16 + row) * 16 + lr] = idx;
        }
        wave_sync();
    }
#pragma unroll 1
    for (int rr = 0; rr < 4; ++rr) {
        const int row = rr * 4 + lq;
        const float s1a = ts[row * 16 + lr];
        const float* s2 = ts + (16 + row) * 16;
        int ptr = 0;
        unsigned key = (mono_key(s1a + s2[0]) & ~0xFFu) | (unsigned)(255 - lr * 16);
        unsigned mine = 0u;
#pragma unroll
        for (int r = 0; r < 16; ++r) {
            const unsigned best = dpp_max16(key);
            if (lr == r) mine = best;
            if (key == best) { ++ptr; key = (ptr < 16) ? ((mono_key(s1a + s2[ptr & 15]) & ~0xFFu) | (unsigned)(255 - lr * 16 - ptr)) : 0u; }
        }
        const int ci = 255 - (int)(mine & 0xFFu), a = ci >> 4, bb = ci & 15;
        const float scv = ts[row * 16 + a] + s2[bb];
        const int e = ti[row * 16 + a] * 128 + ti[(16 + row) * 16 + bb];
        float m16 = scv;
        m16 = fmaxf(m16, __builtin_bit_cast(float, __builtin_amdgcn_update_dpp(0, __builtin_bit_cast(int, m16), 0xB1, 0xF, 0xF, false)));
        m16 = fmaxf(m16, __builtin_bit_cast(float, __builtin_amdgcn_update_dpp(0, __builtin_bit_cast(int, m16), 0x4E, 0xF, 0xF, false)));
        m16 = fmaxf(m16, __builtin_bit_cast(float, __builtin_amdgcn_update_dpp(0, __builtin_bit_cast(int, m16), 0x141, 0xF, 0xF, false)));
        m16 = fmaxf(m16, __builtin_bit_cast(float, __builtin_amdgcn_update_dpp(0, __builtin_bit_cast(int, m16), 0x140, 0xF, 0xF, false)));
        const float ex = expf(scv - m16);
        const float den = dpp_sum16(ex);
        const int grow = row0 + row;
        if (grow < NR) { PIDX[(size_t)grow * 128 + h * 16 + lr] = e; PG[(size_t)grow * 128 + h * 16 + lr] = ex / den; }
    }
}

constexpr float PEER_U_SCALE = 64.0f, PEER_V_SCALE = 8.0f;
DEV unsigned pack4_fp8(float a, float b, float c, float d) { int w = 0; w = __builtin_amdgcn_cvt_pk_fp8_f32(a, b, w, false); w = __builtin_amdgcn_cvt_pk_fp8_f32(c, d, w, true); return (unsigned)w; }
DEV void peer_expert_wave(const Params& p, const int row, unsigned char* wl, const int lane_in) {
    int lane = lane_in; asm volatile("" : "+v"(lane));
    const int lr = lane & 15, lq = lane >> 4;
    unsigned char* xh = wl;
    unsigned char* xo = wl + 1024;
    float* coefl = (float*)(wl + 2048);
    int* idxl = (int*)(wl + 2048 + 512);
    const float* X1 = (const float*)(p.ws + WS_X1) + (size_t)row * 1024;
    const int* PIDX = (const int*)(p.ws + WS_PIDX) + (size_t)row * 128;
    const float* PG = (const float*)(p.ws + WS_PG) + (size_t)row * 128;
    const unsigned char* U8 = p.ws + WS_U8;
    const unsigned char* V8 = p.ws + WS_V8;
    float xv[16];
#pragma unroll
    for (int j = 0; j < 4; ++j) { const float4 t = *(const float4*)(X1 + lane * 16 + j * 4); xv[4 * j] = t.x; xv[4 * j + 1] = t.y; xv[4 * j + 2] = t.z; xv[4 * j + 3] = t.w; }
    wave_sync();
    {
        uint4 hi, lo; unsigned* hp = (unsigned*)&hi; unsigned* lp = (unsigned*)&lo;
#pragma unroll
        for (int j = 0; j < 4; ++j) {
            const unsigned hw = pack4_fp8(xv[4 * j], xv[4 * j + 1], xv[4 * j + 2], xv[4 * j + 3]);
            const f32x2_ b0 = __builtin_amdgcn_cvt_pk_f32_fp8((int)hw, false), b1 = __builtin_amdgcn_cvt_pk_f32_fp8((int)hw, true);
            hp[j] = hw;
            lp[j] = pack4_fp8(16.f * (xv[4 * j] - b0[0]), 16.f * (xv[4 * j + 1] - b0[1]), 16.f * (xv[4 * j + 2] - b1[0]), 16.f * (xv[4 * j + 3] - b1[1]));
        }
        *(uint4*)(xh + lane * 16) = hi; *(uint4*)(xo + lane * 16) = lo;
    }
    idxl[lane] = PIDX[lane]; idxl[64 + lane] = PIDX[64 + lane];
    wave_sync();
    uint4 ufa[8], ufb[8];
    f32x4 ah = (f32x4){0.f, 0.f, 0.f, 0.f}, al = (f32x4){0.f, 0.f, 0.f, 0.f};
#define U_LOAD(DST, HH) { const unsigned char* ub_ = U8 + (size_t)idxl[((HH) >> 1) * 16 + lr] * 1024 + ((HH) & 1) * 512 + lq * 16; \
        _Pragma("unroll") for (int i = 0; i < 8; ++i) DST[i] = *(const uint4*)(ub_ + i * 64); }
#define U_HALF(SRC, HH) { \
        _Pragma("unroll") for (int i = 0; i < 8; ++i) { \
            const int off = ((HH) & 1) * 512 + i * 64 + lq * 16; \
            const long b0 = (long)(((unsigned long long)SRC[i].y << 32) | SRC[i].x), b1 = (long)(((unsigned long long)SRC[i].w << 32) | SRC[i].z); \
            const long h0 = *(const long*)(xh + off), h1 = *(const long*)(xh + off + 8), l0 = *(const long*)(xo + off), l1 = *(const long*)(xo + off + 8); \
            ah = __builtin_amdgcn_mfma_f32_16x16x32_fp8_fp8(h0, b0, ah, 0, 0, 0); ah = __builtin_amdgcn_mfma_f32_16x16x32_fp8_fp8(h1, b1, ah, 0, 0, 0); \
            al = __builtin_amdgcn_mfma_f32_16x16x32_fp8_fp8(l0, b0, al, 0, 0, 0); al = __builtin_amdgcn_mfma_f32_16x16x32_fp8_fp8(l1, b1, al, 0, 0, 0); } \
        if ((HH) & 1) { if (lq == 0) coefl[((HH) >> 1) * 16 + lr] = PG[((HH) >> 1) * 16 + lr] * gelu_tanh((ah[0] + al[0] * 0.0625f) * (1.0f / PEER_U_SCALE)) * (1.0f / PEER_V_SCALE); \
            ah = (f32x4){0.f, 0.f, 0.f, 0.f}; al = (f32x4){0.f, 0.f, 0.f, 0.f}; } }
    U_LOAD(ufa, 0)
#pragma unroll 1
    for (int hh = 0; hh < 16; hh += 2) {
        U_LOAD(ufb, hh + 1)
        U_HALF(ufa, hh)
        if (hh + 2 < 16) U_LOAD(ufa, hh + 2)
        U_HALF(ufb, hh + 1)
    }
#undef U_LOAD
#undef U_HALF
    wave_sync();
    float o[16];
#pragma unroll
    for (int i = 0; i < 16; ++i) o[i] = 0.f;
    uint4 vfa[8], vfb[8];
#define V_LOAD(DST, J) { _Pragma("unroll") for (int u = 0; u < 8; ++u) DST[u] = *(const uint4*)(V8 + (size_t)idxl[(J) + u] * 1024 + lane * 16); }
#define V_ACC(SRC, J) { _Pragma("unroll") for (int u = 0; u < 8; ++u) { const float c_ = coefl[(J) + u]; \
            const unsigned w0_ = SRC[u].x, w1_ = SRC[u].y, w2_ = SRC[u].z, w3_ = SRC[u].w; \
            f32x2_ f0, f1; \
            f0 = __builtin_amdgcn_cvt_pk_f32_fp8((int)w0_, false); f1 = __builtin_amdgcn_cvt_pk_f32_fp8((int)w0_, true); o[0] += c_ * f0[0]; o[1] += c_ * f0[1]; o[2] += c_ * f1[0]; o[3] += c_ * f1[1]; \
            f0 = __builtin_amdgcn_cvt_pk_f32_fp8((int)w1_, false); f1 = __builtin_amdgcn_cvt_pk_f32_fp8((int)w1_, true); o[4] += c_ * f0[0]; o[5] += c_ * f0[1]; o[6] += c_ * f1[0]; o[7] += c_ * f1[1]; \
            f0 = __builtin_amdgcn_cvt_pk_f32_fp8((int)w2_, false); f1 = __builtin_amdgcn_cvt_pk_f32_fp8((int)w2_, true); o[8] += c_ * f0[0]; o[9] += c_ * f0[1]; o[10] += c_ * f1[0]; o[11] += c_ * f1[1]; \
            f0 = __builtin_amdgcn_cvt_pk_f32_fp8((int)w3_, false); f1 = __builtin_amdgcn_cvt_pk_f32_fp8((int)w3_, true); o[12] += c_ * f0[0]; o[13] += c_ * f0[1]; o[14] += c_ * f1[0]; o[15] += c_ * f1[1]; } }
    V_LOAD(vfa, 0)
#pragma unroll 1
    for (int j = 0; j < 128; j += 16) {
        V_LOAD(vfb, j + 8)
        V_ACC(vfa, j)
        if (j + 16 < 128) V_LOAD(vfa, j + 16)
        V_ACC(vfb, j + 8)
    }
#undef V_LOAD
#undef V_ACC
    float tv[16]; float s = 0.f;
#pragma unroll
    for (int i = 0; i < 16; ++i) { tv[i] = DN_ALPHA * xv[i] + o[i]; s += tv[i]; }
    const float mu = wave_sum(s) * (1.0f / 1024.0f);
    float q = 0.f;
#pragma unroll
    for (int i = 0; i < 16; ++i) { const float d = tv[i] - mu; q += d * d; }
    const float rstd = 1.0f / sqrtf(wave_sum(q) * (1.0f / 1024.0f) + LN_EPS);
    float* y = p.out + O_Y + (size_t)row * 1024 + lane * 16;
#pragma unroll
    for (int j = 0; j < 4; ++j) {
        const float4 g4 = *(const float4*)(p.ln2_g + lane * 16 + j * 4), b4 = *(const float4*)(p.ln2_b + lane * 16 + j * 4);
        float4 yo;
        yo.x = (tv[4 * j] - mu) * rstd * g4.x + b4.x; yo.y = (tv[4 * j + 1] - mu) * rstd * g4.y + b4.y; yo.z = (tv[4 * j + 2] - mu) * rstd * g4.z + b4.z; yo.w = (tv[4 * j + 3] - mu) * rstd * g4.w + b4.w;
        *(float4*)(y + j * 4) = yo;
    }
}

constexpr int QN = 2;
struct AttnState { f32x4 ot[4][QN]; float m[QN]; float l[QN]; };

DEV void attn_block(const unsigned char* Ks, const unsigned char* VTs, const bf16x8 (&Qf)[QN][2], AttnState& A, const int mode, const int dq, const float* blut,
                    const unsigned selbit0, const unsigned selbit1, const bool slc, const int lr, const int lq, const int t0, const int ci0) {
    f32x4 sc[4][QN];
#pragma unroll
    for (int kt = 0; kt < 4; ++kt) {
        const bf16x8 k0 = *(const bf16x8*)(Ks + (kt * 16 + lr) * 144 + lq * 16), k1 = *(const bf16x8*)(Ks + (kt * 16 + lr) * 144 + 64 + lq * 16);
#pragma unroll
        for (int qi = 0; qi < QN; ++qi) {
            f32x4 a = (f32x4){0.f, 0.f, 0.f, 0.f};
            a = __builtin_amdgcn_mfma_f32_16x16x32_bf16(k0, Qf[qi][0], a, 0, 0, 0);
            a = __builtin_amdgcn_mfma_f32_16x16x32_bf16(k1, Qf[qi][1], a, 0, 0, 0);
            sc[kt][qi] = a;
        }
    }
    asm volatile("" ::: "memory");
    if (mode != 0 || slc) {
#pragma unroll
        for (int kt = 0; kt < 4; ++kt)
#pragma unroll
            for (int qi = 0; qi < QN; ++qi)
#pragma unroll
                for (int g = 0; g < 4; ++g) {
                    const int kl = kt * 16 + lq * 4 + g, ql = qi * 16 + lr;
                    float v = sc[kt][qi][g];
                    bool ok = true;
                    if (mode == 1 || mode == 2) { const int di = dq + ql - kl; v += blut[di < 0 ? 0 : di]; }
                    if (mode == 2) ok = kl <= ql + dq;
                    if (mode == 3) ok = kl > ql + dq - 512;
                    if (mode == 4) { const int ci = ci0 + kl, dist = t0 + ql - (16 * ci + 31); ok = (dist >= 0) && (ci < 127); if (dist >= 0 && dist < 192) v += blut[dist]; }
                    if (mode == 5) { const int dist = dq - ci0 * kl; ok = (kl < t0) && (dist >= 0); if (dist >= 0 && dist < 192) v += blut[dist]; }
                    if (slc) ok = ok && ((qi == 0 ? selbit0 : selbit1) != 0u);
                    sc[kt][qi][g] = ok ? v : NEGF;
                }
    }
    bf16x8 pf[QN][2];
#pragma unroll
    for (int qi = 0; qi < QN; ++qi) {
        float mb = NEGF;
#pragma unroll
        for (int kt = 0; kt < 4; ++kt) mb = fmaxf(mb, fmaxf(fmaxf(sc[kt][qi][0], sc[kt][qi][1]), fmaxf(sc[kt][qi][2], sc[kt][qi][3])));
        mb = fmaxf(mb, __shfl_xor(mb, 16)); mb = fmaxf(mb, __shfl_xor(mb, 32));
        const float mn = fmaxf(A.m[qi], mb);
        const float alpha = __builtin_amdgcn_exp2f(A.m[qi] - mn);
        A.m[qi] = mn;
        float rs = 0.f;
#pragma unroll
        for (int kt = 0; kt < 4; ++kt)
#pragma unroll
            for (int g = 0; g < 4; ++g) { const float v = sc[kt][qi][g]; const float e = (v > -1e29f) ? __builtin_amdgcn_exp2f(v - mn) : 0.f; sc[kt][qi][g] = e; rs += e; }
        A.l[qi] = A.l[qi] * alpha + rs;
#pragma unroll
        for (int dt = 0; dt < 4; ++dt) A.ot[dt][qi] = A.ot[dt][qi] * alpha;
#pragma unroll
        for (int ks = 0; ks < 2; ++ks) {
            union { bf16x8 v; unsigned u[4]; } pk;
            pk.u[0] = cvt_pk_bf16(sc[2 * ks][qi][0], sc[2 * ks][qi][1]); pk.u[1] = cvt_pk_bf16(sc[2 * ks][qi][2], sc[2 * ks][qi][3]);
            pk.u[2] = cvt_pk_bf16(sc[2 * ks + 1][qi][0], sc[2 * ks + 1][qi][1]); pk.u[3] = cvt_pk_bf16(sc[2 * ks + 1][qi][2], sc[2 * ks + 1][qi][3]);
            pf[qi][ks] = pk.v;
        }
    }
    asm volatile("" ::: "memory");
#pragma unroll
    for (int dt = 0; dt < 4; ++dt)
#pragma unroll
        for (int ks = 0; ks < 2; ++ks) {
            asm volatile("" ::: "memory");
            union { bf16x8 v; uint2 h[2]; } vf;
            vf.h[0] = *(const uint2*)(VTs + (dt * 16 + lr) * 144 + (32 * ks + lq * 4) * 2);
            vf.h[1] = *(const uint2*)(VTs + (dt * 16 + lr) * 144 + (32 * ks + 16 + lq * 4) * 2);
#pragma unroll
            for (int qi = 0; qi < QN; ++qi) A.ot[dt][qi] = __builtin_amdgcn_mfma_f32_16x16x32_bf16(vf.v, pf[qi][ks], A.ot[dt][qi], 0, 0, 0);
        }
}

DEV void nsa_prompt_item(const Params& p, const int b, const int hkv, const int q32, unsigned char* lds) {
    int tid_ = threadIdx.x; asm volatile("" : "+v"(tid_));
    const int tid = tid_, lane = tid & 63, g = tid >> 6, lr = lane & 15, lq = lane >> 4;
    const int hq = hkv * 4 + g, t0 = q32 * 32, kd = t0 >> 6;
    unsigned char* Ks = lds; unsigned char* VTs = lds + 9216;
    float* biasl = (float*)(lds + 18432); float* psl = (float*)(lds + 21504); unsigned* selm = (unsigned*)(lds + 29952); unsigned* misc = (unsigned*)(lds + 30208);
    const bf16_t* ZB = (const bf16_t*)(p.ws + WS_ZB);
    const bf16_t* VTS = (const bf16_t*)(p.ws + WS_VTS) + (size_t)(b * 2 + hkv) * 64 * 2048;
    const bf16_t* VTW = (const bf16_t*)(p.ws + WS_VTW) + (size_t)(b * 2 + hkv) * 64 * 2048;
    const bf16_t* KCB = (const bf16_t*)(p.ws + WS_KCB) + (size_t)(b * 2 + hkv) * 128 * 64;
    const bf16_t* VTC = (const bf16_t*)(p.ws + WS_VTC) + (size_t)(b * 2 + hkv) * 64 * 128;
    const float* Z = (const float*)(p.ws + WS_Z);
    float* NOUTF = (float*)(p.ws + WS_NOUTF);
    bf16_t* NOUTB = (bf16_t*)(p.ws + WS_NOUTB);
    __syncthreads();
    for (int i = tid; i < 4 * 192; i += 256) { const int gg = i / 192, d = i % 192; biasl[i] = (p.rel_bias[rel_bucket(d) * 8 + hkv * 4 + gg] - p.rel_bias[31 * 8 + hkv * 4 + gg]) * LOG2E; }
    for (int i = tid; i < 32 * 33; i += 256) psl[i] = 0.f;
    if (tid < 32) selm[tid] = 0u;
    if (tid == 0) misc[0] = 0u;
    const float* blut = biasl + g * 192;
    bf16x8 Qf[QN][2];
#pragma unroll
    for (int qi = 0; qi < QN; ++qi)
#pragma unroll
        for (int kk = 0; kk < 2; ++kk) Qf[qi][kk] = *(const bf16x8*)(ZB + (size_t)(b * 2048 + t0 + qi * 16 + lr) * IN_DIM + C_Q + hq * 64 + kk * 32 + lq * 8);

    uint4 trk0, trk1, trv0, trv1;
    auto load_tiles = [&](int kind, int kb) __attribute__((always_inline)) {
#pragma unroll
        for (int i = 0; i < 2; ++i) {
            const int id = tid + 256 * i, row = id >> 3, ch = id & 7;
            uint4 rk, rv;
            if (kind == 0) { rk = *(const uint4*)(KCB + (size_t)(kb * 64 + row) * 64 + ch * 8); rv = *(const uint4*)(VTC + (size_t)row * 128 + kb * 64 + ch * 8); }
            else {
                rk = *(const uint4*)(ZB + (size_t)(b * 2048 + kb * 64 + row) * IN_DIM + (kind == 1 ? C_KS : C_KW) + hkv * 64 + ch * 8);
                rv = *(const uint4*)((kind == 1 ? VTS : VTW) + (size_t)row * 2048 + kb * 64 + ch * 8);
            }
            if (i == 0) { trk0 = rk; trv0 = rv; } else { trk1 = rk; trv1 = rv; }
        }
    };
    auto store_tiles = [&]() __attribute__((always_inline)) {
#pragma unroll
        for (int i = 0; i < 2; ++i) { const int id = tid + 256 * i, row = id >> 3, ch = id & 7; *(uint4*)(Ks + row * 144 + ch * 16) = (i == 0 ? trk0 : trk1); *(uint4*)(VTs + row * 144 + ch * 16) = (i == 0 ? trv0 : trv1); }
    };
    auto reset = [&](AttnState& A) __attribute__((always_inline)) {
#pragma unroll
        for (int qi = 0; qi < QN; ++qi) { A.m[qi] = NEGF; A.l[qi] = 0.f;
#pragma unroll
            for (int dt = 0; dt < 4; ++dt) A.ot[dt][qi] = (f32x4){0.f, 0.f, 0.f, 0.f}; }
    };
    auto finish = [&](AttnState& A, int br) __attribute__((always_inline)) {
#pragma unroll
        for (int qi = 0; qi < QN; ++qi) {
            float lt = A.l[qi]; lt += __shfl_xor(lt, 16); lt += __shfl_xor(lt, 32);
            const float sc = (lt > 0.f) ? sigmoidf_(Z[(size_t)(b * 2048 + t0 + qi * 16 + lr) * 32 + 8 + br * 8 + hq]) / lt : 0.f;
            const size_t row = (size_t)(b * 2048 + t0 + qi * 16 + lr);
#pragma unroll
            for (int dt = 0; dt < 4; ++dt) {
                const int col = hq * 64 + dt * 16 + lq * 4;
                f32x4 v = A.ot[dt][qi] * sc;
                if (br > 0) v = v + *(const f32x4*)(NOUTF + row * 512 + col);
                if (br < 2) *(f32x4*)(NOUTF + row * 512 + col) = v; else store_bf16x4(NOUTB + row * 512 + col, v);
            }
        }
    };

    AttnState A;
    const int ncb = ((t0 >> 4) >= 64) ? 2 : 1;
    reset(A);
    load_tiles(0, 0);
    for (int kb = 0; kb < ncb; ++kb) {
        __syncthreads(); store_tiles(); __syncthreads();
        if (kb + 1 < ncb) load_tiles(0, kb + 1);
        attn_block(Ks, VTs, Qf, A, 4, 0, blut, 1u, 1u, false, lr, lq, t0, kb * 64);
    }
    finish(A, 0);
    {
        float linv[QN];
#pragma unroll
        for (int qi = 0; qi < QN; ++qi) { float lt = A.l[qi]; lt += __shfl_xor(lt, 16); lt += __shfl_xor(lt, 32); linv[qi] = (lt > 0.f) ? 1.0f / lt : 0.f; }
        for (int kb = 0; kb < ncb; ++kb) {
            if (ncb > 1) { load_tiles(0, kb); __syncthreads(); store_tiles(); __syncthreads(); }
#pragma unroll
            for (int kt = 0; kt < 4; ++kt) {
                const bf16x8 k0 = *(const bf16x8*)(Ks + (kt * 16 + lr) * 144 + lq * 16), k1 = *(const bf16x8*)(Ks + (kt * 16 + lr) * 144 + 64 + lq * 16);
#pragma unroll
                for (int qi = 0; qi < QN; ++qi) {
                    f32x4 a = (f32x4){0.f, 0.f, 0.f, 0.f};
                    a = __builtin_amdgcn_mfma_f32_16x16x32_bf16(k0, Qf[qi][0], a, 0, 0, 0);
                    a = __builtin_amdgcn_mfma_f32_16x16x32_bf16(k1, Qf[qi][1], a, 0, 0, 0);
                    float pr[4];
#pragma unroll
                    for (int gg = 0; gg < 4; ++gg) {
                        const int ci = kb * 64 + kt * 16 + lq * 4 + gg, ql = qi * 16 + lr, dist = t0 + ql - (16 * ci + 31);
                        float v = a[gg];
                        if (dist >= 0 && dist < 192) v += blut[dist];
                        pr[gg] = (dist >= 0 && ci < 127) ? __builtin_amdgcn_exp2f(v - A.m[qi]) * linv[qi] : 0.f;
                    }
                    const int blk = kb * 16 + kt * 4 + lq, ql = qi * 16 + lr;
                    atomicAdd(&psl[ql * 33 + blk], 2.0f * (pr[0] + pr[1] + pr[2]) + pr[3]);
                    atomicAdd(&psl[ql * 33 + blk + 1], pr[3]);
                }
            }
        }
    }
    __syncthreads();
    {
        const int ql = tid >> 3, part = tid & 7, tq = t0 + ql, cur = tq >> 6;
        float scv[32];
#pragma unroll
        for (int j = 0; j < 32; ++j) {
            const bool causal = j * 64 <= tq, forced = (j == 0) || (j == cur) || (j == cur - 1);
            scv[j] = causal ? (forced ? 1e4f : psl[ql * 33 + j]) : NEGF;
        }
        unsigned mbits = 0u;
#pragma unroll
        for (int jj = 0; jj < 4; ++jj) {
            const int j = part * 4 + jj;
            float my = NEGF;
#pragma unroll
            for (int k = 0; k < 32; ++k) my = (k == j) ? scv[k] : my;
            int rank = 0;
#pragma unroll
            for (int k = 0; k < 32; ++k) rank += ((scv[k] > my) || (scv[k] == my && k < j)) ? 1 : 0;
            if (rank < 16 && j * 64 <= tq) mbits |= (1u << j);
        }
        atomicOr(&selm[ql], mbits);
        atomicOr(&misc[0], mbits);
    }
    __syncthreads();
    const unsigned msk0 = selm[lr], msk1 = selm[16 + lr];
    const unsigned anym = misc[0];
    reset(A);
    {
        int kb = kd;
        load_tiles(1, kb);
        for (;;) {
            __syncthreads(); store_tiles(); __syncthreads();
            int nxt = (kb == kd) ? 0 : kb + 1;
            while (nxt < kd && !((anym >> nxt) & 1u)) ++nxt;
            const bool more = nxt < kd;
            if (more) load_tiles(1, nxt);
            const int mode = (kb == kd) ? 2 : ((kb >= kd - 2) ? 1 : 0);
            attn_block(Ks, VTs, Qf, A, mode, t0 - kb * 64, blut, (msk0 >> kb) & 1u, (msk1 >> kb) & 1u, true, lr, lq, t0, 0);
            if (!more) break;
            kb = nxt;
        }
    }
    finish(A, 1);
    reset(A);
    {
        const int klo = (t0 >= 511) ? ((t0 - 511) >> 6) : 0;
        int kb = kd;
        load_tiles(2, kb);
        for (;;) {
            __syncthreads(); store_tiles(); __syncthreads();
            const bool more = kb > klo;
            if (more) load_tiles(2, kb - 1);
            const int dq = t0 - kb * 64;
            const int mode = (kb == kd) ? 2 : ((kb >= kd - 2) ? 1 : ((dq + 31 >= 512) ? 3 : 0));
            attn_block(Ks, VTs, Qf, A, mode, dq, blut, 1u, 1u, false, lr, lq, t0, 0);
            if (!more) break;
            --kb;
        }
    }
    finish(A, 2);
}

DEV void nsa_sample_item(const Params& p, const int b, const int hkv, unsigned char* lds) {
    int tid_ = threadIdx.x; asm volatile("" : "+v"(tid_));
    const int tid = tid_, lane = tid & 63, g = tid >> 6, lr = lane & 15, lq = lane >> 4;
    const int hq = hkv * 4 + g;
    unsigned char* Ks = lds; unsigned char* VTs = lds + 9216;
    float* biasl = (float*)(lds + 18432); float* psl = (float*)(lds + 21504); int* sell = (int*)(lds + 29952); float* scl = (float*)(lds + 30720);
    const bf16_t* ZB = (const bf16_t*)(p.ws + WS_ZB);
    const float* zgate = (const float*)(p.ws + WS_Z) + (size_t)(NP + b) * 32 + 8;
    const bf16_t* zbrow = ZB + (size_t)(NP + b) * IN_DIM;
    const bf16_t* KCSB = (const bf16_t*)(p.ws + WS_KCSB) + (size_t)(b * 2 + hkv) * 1024 * 64;
    const bf16_t* VTCS = (const bf16_t*)(p.ws + WS_VTCS) + (size_t)(b * 2 + hkv) * 64 * 1024;
    bf16_t* NOUTB = (bf16_t*)(p.ws + WS_NOUTB);
    __syncthreads();
    for (int i = tid; i < 4 * 192; i += 256) { const int gg = i / 192, d = i % 192; biasl[i] = (p.rel_bias[rel_bucket(d) * 8 + hkv * 4 + gg] - p.rel_bias[31 * 8 + hkv * 4 + gg]) * LOG2E; }
    for (int i = tid; i < 260; i += 256) psl[i] = 0.f;
    const float* blut = biasl + g * 192;
    bf16x8 Qf[QN][2];
#pragma unroll
    for (int kk = 0; kk < 2; ++kk) { Qf[0][kk] = *(const bf16x8*)(ZB + (size_t)(NP + b) * IN_DIM + C_Q + hq * 64 + kk * 32 + lq * 8); Qf[1][kk] = Qf[0][kk]; }
    AttnState A;
    auto reset = [&](AttnState& S_) __attribute__((always_inline)) {
#pragma unroll
        for (int qi = 0; qi < QN; ++qi) { S_.m[qi] = NEGF; S_.l[qi] = 0.f;
#pragma unroll
            for (int dt = 0; dt < 4; ++dt) S_.ot[dt][qi] = (f32x4){0.f, 0.f, 0.f, 0.f}; }
    };
    f32x4 res[4];
#pragma unroll
    for (int dt = 0; dt < 4; ++dt) res[dt] = (f32x4){0.f, 0.f, 0.f, 0.f};
    auto finish = [&](AttnState& S_, int br) __attribute__((always_inline)) {
        float lt = S_.l[0]; lt += __shfl_xor(lt, 16); lt += __shfl_xor(lt, 32);
        const float sc = (lt > 0.f) ? sigmoidf_(zgate[br * 8 + hq]) / lt : 0.f;
#pragma unroll
        for (int dt = 0; dt < 4; ++dt) res[dt] = res[dt] + S_.ot[dt][0] * sc;
    };
    uint4 trk0, trk1, trv0, trv1;
    auto load_cmp = [&](int kb) __attribute__((always_inline)) {
#pragma unroll
        for (int i = 0; i < 2; ++i) {
            const int id = tid + 256 * i, row = id >> 3, ch = id & 7;
            const uint4 rk = *(const uint4*)(KCSB + (size_t)(kb * 64 + row) * 64 + ch * 8), rv = *(const uint4*)(VTCS + (size_t)row * 1024 + kb * 64 + ch * 8);
            if (i == 0) { trk0 = rk; trv0 = rv; } else { trk1 = rk; trv1 = rv; }
        }
    };
    auto store_cmp = [&]() __attribute__((always_inline)) {
#pragma unroll
        for (int i = 0; i < 2; ++i) { const int id = tid + 256 * i, row = id >> 3, ch = id & 7; *(uint4*)(Ks + row * 144 + ch * 16) = (i == 0 ? trk0 : trk1); *(uint4*)(VTs + row * 144 + ch * 16) = (i == 0 ? trv0 : trv1); }
    };
    reset(A);
    load_cmp(0);
    for (int kb = 0; kb < 16; ++kb) {
        __syncthreads(); store_cmp(); __syncthreads();
        if (kb + 1 < 16) load_cmp(kb + 1);
        attn_block(Ks, VTs, Qf, A, 5, PAST - 31 - 16 * (kb * 64), blut, 1u, 1u, false, lr, lq, (kb == 15) ? 63 : 64, 16);
    }
    finish(A, 0);
    {
        float lt = A.l[0]; lt += __shfl_xor(lt, 16); lt += __shfl_xor(lt, 32);
        const float linv = (lt > 0.f) ? 1.0f / lt : 0.f;
        for (int kb = 0; kb < 16; ++kb) {
            load_cmp(kb); __syncthreads(); store_cmp(); __syncthreads();
#pragma unroll
            for (int kt = 0; kt < 4; ++kt) {
                const bf16x8 k0 = *(const bf16x8*)(Ks + (kt * 16 + lr) * 144 + lq * 16), k1 = *(const bf16x8*)(Ks + (kt * 16 + lr) * 144 + 64 + lq * 16);
                f32x4 a = (f32x4){0.f, 0.f, 0.f, 0.f};
                a = __builtin_amdgcn_mfma_f32_16x16x32_bf16(k0, Qf[0][0], a, 0, 0, 0);
                a = __builtin_amdgcn_mfma_f32_16x16x32_bf16(k1, Qf[0][1], a, 0, 0, 0);
                float pr[4];
#pragma unroll
                for (int gg = 0; gg < 4; ++gg) {
                    const int ci = kb * 64 + kt * 16 + lq * 4 + gg, dist = PAST - 31 - 16 * ci;
                    float v = a[gg];
                    if (dist >= 0 && dist < 192) v += blut[dist];
                    pr[gg] = (ci < 1023) ? __builtin_amdgcn_exp2f(v - A.m[0]) * linv : 0.f;
                }
                if (lr == 0) {
                    const int blk = kb * 16 + kt * 4 + lq;
                    atomicAdd(&psl[blk], 2.0f * (pr[0] + pr[1] + pr[2]) + pr[3]);
                    atomicAdd(&psl[blk + 1], pr[3]);
                }
            }
        }
    }
    __syncthreads();
    for (int j = tid; j < 257; j += 256) scl[j] = (j == 0 || j == 256 || j == 255) ? 1e4f : psl[j];
    __syncthreads();
    for (int j = tid; j < 257; j += 256) {
        const float my = scl[j];
        int rank = 0;
        for (int k = 0; k < 257; ++k) { const float o2 = scl[k]; rank += ((o2 > my) || (o2 == my && k < j)) ? 1 : 0; }
        if (rank < 16) sell[rank] = j;
    }
    __syncthreads();
    uint4 rk0, rk1; unsigned rv0, rv1, rv2, rv3, rv4, rv5, rv6, rv7;
    auto load_rows = [&](const float* src, const bf16_t* srcb) __attribute__((always_inline)) {
        const int seg = tid & 3;
        if (srcb) {
            const bf16_t* kp = srcb + hkv * 64 + seg * 16; const bf16_t* vp = kp + 128;
            rk0 = *(const uint4*)kp; rk1 = *(const uint4*)(kp + 8);
            const uint4 v0 = *(const uint4*)vp, v1 = *(const uint4*)(vp + 8);
            rv0 = v0.x; rv1 = v0.y; rv2 = v0.z; rv3 = v0.w; rv4 = v1.x; rv5 = v1.y; rv6 = v1.z; rv7 = v1.w;
        } else {
            const bool nz = src != nullptr;
            const float* kp = (nz ? src : p.state_win) + hkv * 64 + seg * 16; const float* vp = kp + 128;
            const float4 a0 = *(const float4*)kp, a1 = *(const float4*)(kp + 4), a2 = *(const float4*)(kp + 8), a3 = *(const float4*)(kp + 12);
            const float4 c0 = *(const float4*)vp, c1 = *(const float4*)(vp + 4), c2 = *(const float4*)(vp + 8), c3 = *(const float4*)(vp + 12);
            const unsigned mk = nz ? 0xffffffffu : 0u;
            rk0.x = cvt_pk_bf16(a0.x, a0.y) & mk; rk0.y = cvt_pk_bf16(a0.z, a0.w) & mk; rk0.z = cvt_pk_bf16(a1.x, a1.y) & mk; rk0.w = cvt_pk_bf16(a1.z, a1.w) & mk;
            rk1.x = cvt_pk_bf16(a2.x, a2.y) & mk; rk1.y = cvt_pk_bf16(a2.z, a2.w) & mk; rk1.z = cvt_pk_bf16(a3.x, a3.y) & mk; rk1.w = cvt_pk_bf16(a3.z, a3.w) & mk;
            rv0 = cvt_pk_bf16(c0.x, c0.y) & mk; rv1 = cvt_pk_bf16(c0.z, c0.w) & mk; rv2 = cvt_pk_bf16(c1.x, c1.y) & mk; rv3 = cvt_pk_bf16(c1.z, c1.w) & mk;
            rv4 = cvt_pk_bf16(c2.x, c2.y) & mk; rv5 = cvt_pk_bf16(c2.z, c2.w) & mk; rv6 = cvt_pk_bf16(c3.x, c3.y) & mk; rv7 = cvt_pk_bf16(c3.z, c3.w) & mk;
        }
    };
    auto store_rows = [&]() __attribute__((always_inline)) {
        const int kl = tid >> 2, seg = tid & 3;
        *(uint4*)(Ks + kl * 144 + seg * 32) = rk0; *(uint4*)(Ks + kl * 144 + seg * 32 + 16) = rk1;
#define VT_PUT(i_, w_) { *(bf16_t*)(VTs + (seg * 16 + (i_)) * 144 + kl * 2) = (bf16_t)((w_) & 0xffffu); *(bf16_t*)(VTs + (seg * 16 + (i_) + 1) * 144 + kl * 2) = (bf16_t)((w_) >> 16); }
        VT_PUT(0, rv0) VT_PUT(2, rv1) VT_PUT(4, rv2) VT_PUT(6, rv3) VT_PUT(8, rv4) VT_PUT(10, rv5) VT_PUT(12, rv6) VT_PUT(14, rv7)
#undef VT_PUT
    };
    auto slc_row = [&](int blk) __attribute__((always_inline)) -> const float* {
        const int kl = tid >> 2;
        if (blk < 256) { const int page = p.page_table[b * 128 + (blk >> 1)]; return p.cache_slc + ((size_t)page * 128 + (blk & 1) * 64 + kl) * 256; }
        return nullptr;
    };
    auto slc_rowb = [&](int blk) __attribute__((always_inline)) -> const bf16_t* { return (blk == 256 && (tid >> 2) == 0) ? zbrow + C_KS : nullptr; };
    reset(A);
    load_rows(slc_row(sell[0]), slc_rowb(sell[0]));
    for (int si = 0; si < 16; ++si) {
        const int blk = sell[si];
        __syncthreads(); store_rows(); __syncthreads();
        if (si + 1 < 16) load_rows(slc_row(sell[si + 1]), slc_rowb(sell[si + 1]));
        attn_block(Ks, VTs, Qf, A, 5, PAST - blk * 64, blut, 1u, 1u, false, lr, lq, (blk == 256) ? 1 : 64, 1);
    }
    finish(A, 1);
    auto win_row = [&](int wb) __attribute__((always_inline)) -> const float* {
        const int j = 1 + wb * 64 + (tid >> 2);
        return (j < 512) ? p.state_win + ((size_t)b * 512 + j) * 256 : nullptr;
    };
    auto win_rowb = [&](int wb) __attribute__((always_inline)) -> const bf16_t* { return (1 + wb * 64 + (tid >> 2) == 512) ? zbrow + C_KW : nullptr; };
    reset(A);
    load_rows(win_row(0), win_rowb(0));
    for (int wb = 0; wb < 8; ++wb) {
        __syncthreads(); store_rows(); __syncthreads();
        if (wb + 1 < 8) load_rows(win_row(wb + 1), win_rowb(wb + 1));
        attn_block(Ks, VTs, Qf, A, 5, 511 - wb * 64, blut, 1u, 1u, false, lr, lq, 64, 1);
    }
    finish(A, 2);
    if (lr == 0) {
#pragma unroll
        for (int dt = 0; dt < 4; ++dt) store_bf16x4(NOUTB + (size_t)(NP + b) * 512 + hq * 64 + dt * 16 + lq * 4, res[dt]);
    }
}

#define Z ((float*)(p.ws + WS_Z))
#define QK ((float*)(p.ws + WS_QK))
#define HRAW ((float*)(p.ws + WS_HRAW))
#define MOUTB ((bf16_t*)(p.ws + WS_MOUTB))
#define NOUTB ((bf16_t*)(p.ws + WS_NOUTB))
#define HIDPB ((bf16_t*)(p.ws + WS_HIDPB))
#define HIDSB ((bf16_t*)(p.ws + WS_HIDSB))
#define KCS ((float*)(p.ws + WS_KCS))
#define MIX ((float*)(p.ws + WS_MIX))
#define MIXB ((bf16_t*)(p.ws + WS_MIXB))
#define T1 ((float*)(p.ws + WS_T1))
#define X1 ((float*)(p.ws + WS_X1))
#define X1B ((bf16_t*)(p.ws + WS_X1B))
#define QPB ((bf16_t*)(p.ws + WS_QPB))
#define S ((float*)(p.ws + WS_S))
#define CONVB ((bf16_t*)(p.ws + WS_CONVB))
#define XB ((bf16_t*)(p.ws + WS_XB))
#define WIN_T ((bf16_t*)(p.ws + WS_WIN_T))
#define WUPM_T ((bf16_t*)(p.ws + WS_WUPM_T))
#define WUPN_T ((bf16_t*)(p.ws + WS_WUPN_T))
#define WOUT_T ((bf16_t*)(p.ws + WS_WOUT_T))
#define PWQ_T ((bf16_t*)(p.ws + WS_PWQ_T))
#define WQK_T ((bf16_t*)(p.ws + WS_WQK_T))
#define W1_T ((bf16_t*)(p.ws + WS_W1_T))
#define W2_T ((bf16_t*)(p.ws + WS_W2_T))
#define SUBK ((bf16_t*)(p.ws + WS_SUBK))
#define ZB ((bf16_t*)(p.ws + WS_ZB))
#define VTS ((bf16_t*)(p.ws + WS_VTS))
#define VTW ((bf16_t*)(p.ws + WS_VTW))
#define KCB ((bf16_t*)(p.ws + WS_KCB))
#define VTC ((bf16_t*)(p.ws + WS_VTC))
__global__ void __launch_bounds__(NTHREADS, 2) fwd_kernel(Params p) {
    extern __shared__ __attribute__((aligned(16))) unsigned char smem[];
    if (threadIdx.x == 0) { *(uint4*)smem = make_uint4(0u, 0u, 0u, 0u); }
    __syncthreads();
    XcdBarrier bar = xcd_barrier_post((unsigned*)(p.ws + WS_BAR), (volatile LAS unsigned*)smem);
    float* lds = (float*)(smem + 16);
    unsigned char* ldsb = smem + 16;
    const int tid = threadIdx.x, lane = tid & 63, w = tid >> 6;
    const int gw = blockIdx.x * 4 + w, nw = gridDim.x * 4;
    const size_t gt = (size_t)blockIdx.x * NTHREADS + tid, nt = (size_t)gridDim.x * NTHREADS;


    {
        for (size_t id = gt; id < (size_t)MP * 128; id += nt) {
            const int row = (int)(id >> 7), k8 = (int)(id & 127) * 8;
            float f[8];
            if (row < NR) {
                const float* s = (row < NP ? p.x_prompt + (size_t)row * 1024 : p.x_sample + (size_t)(row - NP) * 1024) + k8;
                const float4 a = *(const float4*)s, b = *(const float4*)(s + 4);
                f[0] = a.x; f[1] = a.y; f[2] = a.z; f[3] = a.w; f[4] = b.x; f[5] = b.y; f[6] = b.z; f[7] = b.w;
            } else {
#pragma unroll
                for (int i = 0; i < 8; ++i) f[i] = 0.f;
            }
            *(uint4*)(XB + (size_t)row * 1024 + k8) = pack8(f);
        }
        transpose_to_bf16(p.w_in, 1024, IN_DIM, WIN_T, gt, nt);
        transpose_to_bf16(p.w_up_m, 512, 1024, WUPM_T, gt, nt);
        transpose_to_bf16(p.w_up_n, 512, 1024, WUPN_T, gt, nt);
        transpose_to_bf16(p.w_out, 1024, 1024, WOUT_T, gt, nt);
        transpose_to_bf16(p.peer_wq, 1024, 2048, PWQ_T, gt, nt);
        for (int h = 0; h < 4; ++h) {
            transpose_to_bf16(p.wq + (size_t)h * 16384, 128, 128, WQK_T + (size_t)(h * 256) * 128, gt, nt);
            transpose_to_bf16(p.wk + (size_t)h * 16384, 128, 128, WQK_T + (size_t)(h * 256 + 128) * 128, gt, nt);
        }
        for (size_t id = gt; id < (size_t)2 * 128 * 128; id += nt) {
            const int k8 = (int)(id & 127) * 8, np = (int)((id >> 7) & 127), c = (int)(id >> 14);
            const int pp = np >> 6, o = np & 63, r = k8 >> 6, d = k8 & 63;
            float f[8];
#pragma unroll
            for (int e = 0; e < 8; ++e) f[e] = p.cmp_w1[((size_t)c * 2048 + (pp * 16 + r) * 64 + d + e) * 64 + o];
            *(uint4*)(W1_T + ((size_t)c * 128 + np) * 1024 + k8) = pack8(f);
        }
        if (gt < 128) {
            const int c = (int)gt >> 6, o = (int)gt & 63;
            float a = 0.f;
            for (int k = 0; k < 2048; ++k) a += p.cmp_pe[c * 2048 + k] * p.cmp_w1[((size_t)c * 2048 + k) * 64 + o];
            ((float*)(p.ws + WS_PESUM))[gt] = a;
        }
        for (int c = 0; c < 2; ++c) transpose_to_bf16(p.cmp_w2 + (size_t)c * 4096, 64, 64, W2_T + (size_t)c * 4096, gt, nt);
        for (size_t id = gt; id < (size_t)2 * 128 * 128 / 8; id += nt) {
            float f[8];
#pragma unroll
            for (int i = 0; i < 8; ++i) f[i] = p.peer_sub[id * 8 + i];
            *(uint4*)(SUBK + id * 8) = pack8(f);
        }
        for (size_t id = gt; id < (size_t)16384 * 64; id += nt) {
            const float* su = p.peer_u + id * 16; const float* sv = p.peer_v + id * 16;
            uint4 ou, ov; unsigned* pu = (unsigned*)&ou; unsigned* pv = (unsigned*)&ov;
#pragma unroll
            for (int j = 0; j < 4; ++j) {
                const float4 a4 = *(const float4*)(su + j * 4), c4 = *(const float4*)(sv + j * 4);
                pu[j] = pack4_fp8(a4.x * PEER_U_SCALE, a4.y * PEER_U_SCALE, a4.z * PEER_U_SCALE, a4.w * PEER_U_SCALE);
                pv[j] = pack4_fp8(c4.x * PEER_V_SCALE, c4.y * PEER_V_SCALE, c4.z * PEER_V_SCALE, c4.w * PEER_V_SCALE);
            }
            *(uint4*)(p.ws + WS_U8 + id * 16) = ou; *(uint4*)(p.ws + WS_V8 + id * 16) = ov;
        }
        for (size_t i = gt; i < (size_t)BS * 511 * 256; i += nt) {
            const int j = (int)(i & 255); const int wv = (int)((i >> 8) % 511); const int b = (int)((i >> 8) / 511);
            p.out[O_WINS + ((size_t)b * 512 + wv) * 256 + j] = p.state_win[((size_t)b * 512 + wv + 1) * 256 + j];
        }
        for (size_t i = gt; i < (size_t)BS * 2 * 512; i += nt) {
            const int ch = (int)(i & 511); const int jj = (int)((i >> 9) & 1); const int b = (int)(i >> 10);
            p.out[O_CVS + ((size_t)b * 3 + jj) * 512 + ch] = p.state_conv[((size_t)b * 3 + jj + 1) * 512 + ch];
        }
    }
    xcd_barrier(bar);

    gemm_glds_xcd(NR, IN_DIM, 1024,
        [&](int r, int k) { return XB + (size_t)r * 1024 + k; },
        [&](int n, int k) { return WIN_T + (size_t)n * 1024 + k; },
        [&](int r, int c0, f32x4 v) {
            if (c0 >= C_I && c0 < C_Q) *(f32x4*)(Z + (size_t)r * 32 + (c0 - C_I)) = v;
            else if (c0 >= C_G && c0 < C_GM) *(f32x4*)(Z + (size_t)r * 32 + 8 + (c0 - C_G)) = v;
            store_bf16x4(ZB + (size_t)r * IN_DIM + c0, (c0 >= C_Q && c0 < C_KC) ? v * (0.125f * LOG2E) : v);
            if (r < NP && ((c0 >= C_KS + 128 && c0 < C_KW) || (c0 >= C_KW + 128 && c0 < C_G))) {
                const bool isw = c0 >= C_KW; const int cc = c0 - (isw ? C_KW : C_KS) - 128;
                bf16_t* vt = (isw ? VTW : VTS) + ((size_t)((r >> 11) * 2) * 64 + cc) * 2048 + (r & 2047);
                const unsigned w0 = cvt_pk_bf16(v[0], v[1]), w1 = cvt_pk_bf16(v[2], v[3]);
                vt[0] = (bf16_t)(w0 & 0xffffu); vt[2048] = (bf16_t)(w0 >> 16); vt[4096] = (bf16_t)(w1 & 0xffffu); vt[6144] = (bf16_t)(w1 >> 16);
            }
            if (r < NP && c0 >= C_V && c0 < C_O) {
                bf16_t* vt = (bf16_t*)(p.ws + WS_VTM) + ((size_t)(r >> 11) * 512 + (c0 - C_V)) * 2048 + (r & 2047);
                const unsigned w0 = cvt_pk_bf16(v[0], v[1]), w1 = cvt_pk_bf16(v[2], v[3]);
                vt[0] = (bf16_t)(w0 & 0xffffu); vt[2048] = (bf16_t)(w0 >> 16); vt[4096] = (bf16_t)(w1 & 0xffffu); vt[6144] = (bf16_t)(w1 >> 16);
            }
            if (c0 >= C_KC && c0 < C_KS) *(f32x4*)(p.out + O_CMPP + (size_t)r * 256 + (c0 - C_KC)) = v;
            else if (c0 >= C_KS && c0 < C_KW) *(f32x4*)(p.out + O_SLCP + (size_t)r * 256 + (c0 - C_KS)) = v;
            else if (c0 >= C_KW && c0 < C_G) {
                if (r < NP) { const int t = r & 2047; if (t >= 1536) *(f32x4*)(p.out + O_WINP + ((size_t)(r >> 11) * 512 + (t - 1536)) * 256 + (c0 - C_KW)) = v; }
                else *(f32x4*)(p.out + O_WINS + ((size_t)(r - NP) * 512 + 511) * 256 + (c0 - C_KW)) = v;
            } else if (c0 < C_V) {
                if (r < NP) { const int t = r & 2047; if (t >= 2045) *(f32x4*)(p.out + O_CVP + ((size_t)(r >> 11) * 3 + (t - 2045)) * 512 + c0) = v; }
                else *(f32x4*)(p.out + O_CVS + ((size_t)(r - NP) * 3 + 2) * 512 + c0) = v;
            }
        }, smem + 1024);
    xcd_barrier(bar);

    for (size_t i = gt; i < (size_t)NR * 64; i += nt) {
        const int ch = (int)(i & 63) * 8; const int r = (int)(i >> 6);
        float a[8];
        { const float4 b0 = *(const float4*)(p.conv_b + ch), b1 = *(const float4*)(p.conv_b + ch + 4); a[0] = b0.x; a[1] = b0.y; a[2] = b0.z; a[3] = b0.w; a[4] = b1.x; a[5] = b1.y; a[6] = b1.z; a[7] = b1.w; }
#pragma unroll
        for (int j = 0; j < 4; ++j) {
            const float4 w0 = *(const float4*)(p.conv_w + j * 512 + ch), w1 = *(const float4*)(p.conv_w + j * 512 + ch + 4);
            float u[8]; bool have = true;
            if (r < NP) {
                const int t = r & 2047;
                if (t + j - 3 >= 0) { const uint4 q = *(const uint4*)(ZB + (size_t)(r + j - 3) * IN_DIM + C_U + ch);
                    u[0] = bf_lo(q.x); u[1] = bf_hi(q.x); u[2] = bf_lo(q.y); u[3] = bf_hi(q.y); u[4] = bf_lo(q.z); u[5] = bf_hi(q.z); u[6] = bf_lo(q.w); u[7] = bf_hi(q.w); }
                else have = false;
            } else if (j < 3) {
                const float* sc = p.state_conv + ((size_t)(r - NP) * 3 + j) * 512 + ch;
                const float4 s0 = *(const float4*)sc, s1 = *(const float4*)(sc + 4);
                u[0] = s0.x; u[1] = s0.y; u[2] = s0.z; u[3] = s0.w; u[4] = s1.x; u[5] = s1.y; u[6] = s1.z; u[7] = s1.w;
            } else { const uint4 q = *(const uint4*)(ZB + (size_t)r * IN_DIM + C_U + ch);
                u[0] = bf_lo(q.x); u[1] = bf_hi(q.x); u[2] = bf_lo(q.y); u[3] = bf_hi(q.y); u[4] = bf_lo(q.z); u[5] = bf_hi(q.z); u[6] = bf_lo(q.w); u[7] = bf_hi(q.w); }
            if (have) { a[0] += w0.x * u[0]; a[1] += w0.y * u[1]; a[2] += w0.z * u[2]; a[3] += w0.w * u[3]; a[4] += w1.x * u[4]; a[5] += w1.y * u[5]; a[6] += w1.z * u[6]; a[7] += w1.w * u[7]; }
        }
#pragma unroll
        for (int e = 0; e < 8; ++e) a[e] = a[e] / (1.0f + expf(-a[e]));
        *(uint4*)(CONVB + (size_t)r * 512 + ch) = pack8(a);
    }
    xcd_barrier(bar);

    for (int h = 0; h < 4; ++h) {
        gemm_glds(NR, 256, 128,
            [&](int r, int k) { return CONVB + (size_t)r * 512 + h * 128 + k; },
            [&](int n, int k) { return WQK_T + (size_t)(h * 256 + n) * 128 + k; },
            [&](int r, int c0, f32x4 v) {
                if (c0 >= 128) v = v * 0.08838834764831845f;
                if (c0 < 128) store_bf16x4((bf16_t*)(p.ws + WS_QB) + (size_t)r * 512 + h * 128 + c0, v);
                else {
                    store_bf16x4((bf16_t*)(p.ws + WS_KB) + (size_t)r * 512 + h * 128 + (c0 - 128), v);
                    if (r < NP) {
                        bf16_t* kt = (bf16_t*)(p.ws + WS_KTB) + ((size_t)((r >> 11) * 4 + h) * 128 + (c0 - 128)) * 2048 + (r & 2047);
                        const unsigned w0 = cvt_pk_bf16(v[0], v[1]), w1 = cvt_pk_bf16(v[2], v[3]);
                        kt[0] = (bf16_t)(w0 & 0xffffu); kt[2048] = (bf16_t)(w0 >> 16); kt[4096] = (bf16_t)(w1 & 0xffffu); kt[6144] = (bf16_t)(w1 >> 16);
                    }
                } }, smem + 1024, h * 514);
    }
    for (int c = 0; c < 2; ++c) {
        for (int grp = 0; grp < 2; ++grp) {
            const int TPB = grp ? 9 : 1, NCH = grp ? 1024 : 128, NBH = grp ? 64 : 32;
            gemm_bf16<128, true>(NBH * TPB * 128, 128, 1024,
                [&](int vrow, int k) {
                    const int tile = vrow >> 7, bh = tile / TPB, n_ = 127 * (tile % TPB) + (vrow & 127), n = n_ < NCH ? n_ : NCH - 1;
                    const int b = bh >> 1, hh = bh & 1, tok = 16 * n + (k >> 6), d0 = k & 63;
                    if (!grp) return *(const uint4*)(ZB + ((size_t)b * 2048 + tok) * IN_DIM + C_KC + c * 128 + hh * 64 + d0);
                    const int page = p.page_table[b * 128 + (tok >> 7)];
                    const float* sp = p.cache_cmp + ((size_t)page * 128 + (tok & 127)) * 256 + c * 128 + hh * 64 + d0;
                    const float4 a0 = *(const float4*)sp, a1 = *(const float4*)(sp + 4);
                    float f[8] = {a0.x, a0.y, a0.z, a0.w, a1.x, a1.y, a1.z, a1.w};
                    return pack8(f); },
                [&](int n, int k) { return *(const uint4*)(W1_T + ((size_t)c * 128 + n) * 1024 + k); },
                [&](f32x4 (&acc)[4][4], int bm) {
                    const int lr = lane & 15, lq = lane >> 4, wm = w >> 1, wn = w & 1;
                    const int tile = bm >> 7, bh = tile / TPB, n0 = 127 * (tile % TPB);
                    float* P1 = (float*)ldsb;
                    bf16_t* HL = (bf16_t*)(ldsb + 128 * 68 * 4);
                    __syncthreads();
                    if (wn == 1) {
#pragma unroll
                        for (int i = 0; i < 4; ++i)
#pragma unroll
                            for (int j = 0; j < 4; ++j) *(f32x4*)(P1 + (wm * 64 + i * 16 + lr) * 68 + j * 16 + lq * 4) = acc[i][j];
                    }
                    __syncthreads();
                    if (wn == 0) {
                        const float* pes = (const float*)(p.ws + WS_PESUM) + c * 64;
#pragma unroll
                        for (int i = 0; i < 4; ++i)
#pragma unroll
                            for (int j = 0; j < 4; ++j) {
                                const int rl = wm * 64 + i * 16 + lr, o0 = j * 16 + lq * 4;
                                const f32x4 nx = (rl < 127) ? *(const f32x4*)(P1 + (rl + 1) * 68 + o0) : (f32x4){0.f, 0.f, 0.f, 0.f};
                                const f32x4 pe4 = *(const f32x4*)(pes + o0);
                                f32x4 hv = acc[i][j] + nx + pe4;
                                hv[0] = gelu_tanh(hv[0]); hv[1] = gelu_tanh(hv[1]); hv[2] = gelu_tanh(hv[2]); hv[3] = gelu_tanh(hv[3]);
                                store_bf16x4(HL + rl * 72 + o0, hv);
                            }
                    }
                    __syncthreads();
                    f32x4 kc[2][4];
#pragma unroll
                    for (int i = 0; i < 2; ++i)
#pragma unroll
                        for (int j = 0; j < 4; ++j) kc[i][j] = (f32x4){0.f, 0.f, 0.f, 0.f};
#pragma unroll
                    for (int ks = 0; ks < 2; ++ks) {
                        bf16x8 hf[2], wf[4];
#pragma unroll
                        for (int i = 0; i < 2; ++i) hf[i] = *(const bf16x8*)(HL + (w * 32 + i * 16 + lr) * 72 + ks * 32 + lq * 8);
#pragma unroll
                        for (int j = 0; j < 4; ++j) wf[j] = *(const bf16x8*)(W2_T + ((size_t)c * 64 + j * 16 + lr) * 64 + ks * 32 + lq * 8);
#pragma unroll
                        for (int i = 0; i < 2; ++i)
#pragma unroll
                            for (int j = 0; j < 4; ++j) kc[i][j] = __builtin_amdgcn_mfma_f32_16x16x32_bf16(wf[j], hf[i], kc[i][j], 0, 0, 0);
                    }
#pragma unroll
                    for (int i = 0; i < 2; ++i) {
                        const int rl = w * 32 + i * 16 + lr, blk = n0 + rl;
                        if (rl < 127 && blk <= NCH - 2) {
#pragma unroll
                            for (int j = 0; j < 4; ++j) {
                                const int o2 = j * 16 + lq * 4;
                                if (c == 0) store_bf16x4((grp ? (bf16_t*)(p.ws + WS_KCSB) : KCB) + ((size_t)bh * NCH + blk) * 64 + o2, kc[i][j]);
                                else { bf16_t* vt = (grp ? (bf16_t*)(p.ws + WS_VTCS) : VTC) + ((size_t)bh * 64 + o2) * NCH + blk;
                                       const unsigned w0 = cvt_pk_bf16(kc[i][j][0], kc[i][j][1]), w1 = cvt_pk_bf16(kc[i][j][2], kc[i][j][3]);
                                       vt[0] = (bf16_t)(w0 & 0xffffu); vt[NCH] = (bf16_t)(w0 >> 16); vt[2 * NCH] = (bf16_t)(w1 & 0xffffu); vt[3 * NCH] = (bf16_t)(w1 >> 16); }
                            }
                        }
                    }
                    __syncthreads();
                }, ldsb, 4 * 514 + c * 608 + grp * 32);
        }
    }
    xcd_barrier(bar);

    for (;;) {
        __syncthreads();
        if (tid == 0) *(volatile int*)(ldsb + 32768) = (int)atomicAdd((unsigned*)(p.ws + WS_BAR) + 2, 1u);
        __syncthreads();
        const int idx = *(volatile int*)(ldsb + 32768);
        if (idx >= 448 + 2048) break;
        if (idx < 256) mlstm_chunk_item(p, idx, ldsb);
        else if (idx < 384) mlstm_scan_item(p, 64 + (idx - 256), lds);
        else if (idx < 448) nsa_sample_item(p, (idx - 384) >> 1, idx & 1, ldsb);
        else { const int i2 = idx - 448; nsa_prompt_item(p, (i2 & 31) >> 1, i2 & 1, 63 - (i2 >> 5), ldsb); }
    }
    xcd_barrier(bar);

    for (int row = gw; row < NR; row += nw) {
        const float* hr = HRAW + (size_t)row * 512 + lane * 8;
        const float4 h0 = *(const float4*)hr, h1 = *(const float4*)(hr + 4);
        float x[8] = {h0.x, h0.y, h0.z, h0.w, h1.x, h1.y, h1.z, h1.w};
        float sm = 0.f;
#pragma unroll
        for (int e = 0; e < 8; ++e) sm += x[e];
        const float mu = dpp_sum16(sm) * (1.0f / 128.0f);
        float q = 0.f;
#pragma unroll
        for (int e = 0; e < 8; ++e) { x[e] -= mu; q += x[e] * x[e]; }
        const float rstd = 1.0f / sqrtf(dpp_sum16(q) * (1.0f / 128.0f) + LN_EPS);
        const uint4 og = *(const uint4*)(ZB + (size_t)row * IN_DIM + C_O + lane * 8);
        const float4 g0 = *(const float4*)(p.norm_g + lane * 8), g1 = *(const float4*)(p.norm_g + lane * 8 + 4);
        float o[8];
        o[0] = sigmoidf_(bf_lo(og.x)) * (x[0] * rstd * g0.x); o[1] = sigmoidf_(bf_hi(og.x)) * (x[1] * rstd * g0.y); o[2] = sigmoidf_(bf_lo(og.y)) * (x[2] * rstd * g0.z); o[3] = sigmoidf_(bf_hi(og.y)) * (x[3] * rstd * g0.w);
        o[4] = sigmoidf_(bf_lo(og.z)) * (x[4] * rstd * g1.x); o[5] = sigmoidf_(bf_hi(og.z)) * (x[5] * rstd * g1.y); o[6] = sigmoidf_(bf_lo(og.w)) * (x[6] * rstd * g1.z); o[7] = sigmoidf_(bf_hi(og.w)) * (x[7] * rstd * g1.w);
        *(uint4*)(MOUTB + (size_t)row * 512 + lane * 8) = pack8(o);
    }
    xcd_barrier(bar);

    gemm_glds(NR, 1024, 1024,
        [&](int r, int k) { return (k < 512) ? MOUTB + (size_t)r * 512 + k : NOUTB + (size_t)r * 512 + (k - 512); },
        [&](int n, int k) { return (k < 512) ? WUPM_T + (size_t)n * 512 + k : WUPN_T + (size_t)n * 512 + (k - 512); },
        [&](int r, int c0, f32x4 v, f32x4 kp) {
            const uint2 gw2 = *(const uint2*)(ZB + (size_t)r * IN_DIM + C_GN + c0);
            f32x4 o; o[0] = kp[0] + sigmoidf_(bf_lo(gw2.x)) * v[0]; o[1] = kp[1] + sigmoidf_(bf_hi(gw2.x)) * v[1]; o[2] = kp[2] + sigmoidf_(bf_lo(gw2.y)) * v[2]; o[3] = kp[3] + sigmoidf_(bf_hi(gw2.y)) * v[3];
            store_bf16x4(MIXB + (size_t)r * 1024 + c0, o); },
        smem + 1024, 0, 8,
        [&](int r, int c0, f32x4& v, f32x4& kp) {
            const uint2 gw2 = *(const uint2*)(ZB + (size_t)r * IN_DIM + C_GM + c0);
            kp[0] = sigmoidf_(bf_lo(gw2.x)) * v[0]; kp[1] = sigmoidf_(bf_hi(gw2.x)) * v[1]; kp[2] = sigmoidf_(bf_lo(gw2.y)) * v[2]; kp[3] = sigmoidf_(bf_hi(gw2.y)) * v[3]; });
    xcd_barrier(bar);

    gemm_glds(NR, 1024, 1024,
        [&](int r, int k) { return MIXB + (size_t)r * 1024 + k; },
        [&](int n, int k) { return WOUT_T + (size_t)n * 1024 + k; },
        [&](int r, int c0, f32x4 v) {
            const f32x4 xv = *(const f32x4*)((r < NP ? p.x_prompt + (size_t)r * 1024 : p.x_sample + (size_t)(r - NP) * 1024) + c0);
            *(f32x4*)(T1 + (size_t)r * 1024 + c0) = xv * DN_ALPHA + v; }, smem + 1024);
    xcd_barrier(bar);

    for (int row = gw; row < NR; row += nw) {
        float tv[16]; float s = 0.f;
#pragma unroll
        for (int j = 0; j < 4; ++j) { const float4 t4 = *(const float4*)(T1 + (size_t)row * 1024 + j * 256 + lane * 4); tv[4 * j] = t4.x; tv[4 * j + 1] = t4.y; tv[4 * j + 2] = t4.z; tv[4 * j + 3] = t4.w; s += (t4.x + t4.y) + (t4.z + t4.w); }
        const float mu = wave_sum(s) * (1.0f / 1024.0f);
        float q = 0.f;
#pragma unroll
        for (int j = 0; j < 16; ++j) { const float d = tv[j] - mu; q += d * d; }
        const float rstd = 1.0f / sqrtf(wave_sum(q) * (1.0f / 1024.0f) + LN_EPS);
#pragma unroll
        for (int j = 0; j < 4; ++j) {
            const int c = j * 256 + lane * 4;
            const float4 g4 = *(const float4*)(p.ln1_g + c), b4 = *(const float4*)(p.ln1_b + c);
            f32x4 o; o[0] = (tv[4 * j] - mu) * rstd * g4.x + b4.x; o[1] = (tv[4 * j + 1] - mu) * rstd * g4.y + b4.y; o[2] = (tv[4 * j + 2] - mu) * rstd * g4.z + b4.z; o[3] = (tv[4 * j + 3] - mu) * rstd * g4.w + b4.w;
            *(f32x4*)(X1 + (size_t)row * 1024 + c) = o;
            store_bf16x4(X1B + (size_t)row * 1024 + c, o);
        }
    }
    xcd_barrier(bar);

    gemm_glds(NR, 2048, 1024,
        [&](int r, int k) { return X1B + (size_t)r * 1024 + k; },
        [&](int n, int k) { return PWQ_T + (size_t)n * 1024 + k; },
        [&](int r, int c0, f32x4 v) { store_bf16x4(QPB + (size_t)r * 2048 + c0, v); }, smem + 1024);
    xcd_barrier(bar);

    for (int it = blockIdx.x; it < 513 * 8; it += gridDim.x) { __syncthreads(); peer_score_topk_item(p, it >> 3, it & 7, ldsb); }
    xcd_barrier(bar);

    for (int row = gw; row < NR; row += nw) peer_expert_wave(p, row, ldsb + w * 3072, lane);
}

extern "C" void kernel_launch(void* const* d_in, const int* in_sizes, int n_in, void* d_out, int out_size, void* d_ws, size_t ws_size, hipStream_t stream) {
    static int grid = 0;
    if (grid == 0) {
        if (n_in != 32 || (size_t)out_size != O_END || ws_size < WS_END) {
            fprintf(stderr, "kernel_launch: unexpected sizes n_in %d out %d ws %zu (need %zu)\n", n_in, out_size, ws_size, (size_t)WS_END); grid = -1; return; }
        int dev = 0, cus = 0, per_cu = 0;
        if (hipGetDevice(&dev) != hipSuccess || hipDeviceGetAttribute(&cus, hipDeviceAttributeMultiprocessorCount, dev) != hipSuccess) { grid = -1; return; }
        if (hipFuncSetAttribute((const void*)fwd_kernel, hipFuncAttributeMaxDynamicSharedMemorySize, LDS_BYTES) != hipSuccess) { fprintf(stderr, "hipFuncSetAttribute failed\n"); grid = -1; return; }
        if (hipOccupancyMaxActiveBlocksPerMultiprocessor(&per_cu, (const void*)fwd_kernel, NTHREADS, LDS_BYTES) != hipSuccess || per_cu < 1) { fprintf(stderr, "occupancy query failed (%d)\n", per_cu); (void)hipGetLastError(); per_cu = 1; }
        if (per_cu > 2) per_cu = 2;
        grid = cus * per_cu;
    }
    if (grid < 0) return;
    (void)hipMemsetAsync((char*)d_ws + WS_BAR, 0, XCD_BAR_WORDS * sizeof(unsigned), stream);
    Params p{};
    p.x_prompt = (const float*)d_in[0]; p.x_sample = (const float*)d_in[1]; p.cache_cmp = (const float*)d_in[2]; p.cache_slc = (const float*)d_in[3];
    p.page_table = (const int*)d_in[4]; p.state_win = (const float*)d_in[5]; p.state_C = (const float*)d_in[6]; p.state_n = (const float*)d_in[7];
    p.state_m = (const float*)d_in[8]; p.state_conv = (const float*)d_in[9]; p.w_in = (const float*)d_in[10]; p.conv_w = (const float*)d_in[11];
    p.conv_b = (const float*)d_in[12]; p.wq = (const float*)d_in[13]; p.wk = (const float*)d_in[14]; p.gate_bias = (const float*)d_in[15];
    p.norm_g = (const float*)d_in[16]; p.cmp_pe = (const float*)d_in[17]; p.cmp_w1 = (const float*)d_in[18]; p.cmp_w2 = (const float*)d_in[19];
    p.rel_bias = (const float*)d_in[20]; p.w_up_m = (const float*)d_in[21]; p.w_up_n = (const float*)d_in[22]; p.w_out = (const float*)d_in[23];
    p.ln1_g = (const float*)d_in[24]; p.ln1_b = (const float*)d_in[25]; p.ln2_g = (const float*)d_in[26]; p.ln2_b = (const float*)d_in[27];
    p.peer_wq = (const float*)d_in[28]; p.peer_sub = (const float*)d_in[29]; p.peer_u = (const float*)d_in[30]; p.peer_v = (const float*)d_in[31];
    p.out = (float*)d_out; p.ws = (unsigned char*)d_ws;
    hipLaunchKernelGGL(fwd_kernel, dim3(grid), dim3(NTHREADS), LDS_BYTES, stream, p);
}
```

```cpp
#include <hip/hip_runtime.h>
#include <stdint.h>
#include <cstdio>

#define DEV __device__ __forceinline__

constexpr int DM = 1024;
constexpr int BP = 16, TP = 2048, BS = 32;
constexpr int NP = BP * TP;
constexpr int NR = NP + BS;
constexpr int MP = 32896;
constexpr int IN_DIM = 4896;
constexpr int C_U = 0, C_V = 512, C_O = 1024, C_I = 1536, C_F = 1540, C_Q = 1544, C_KC = 2056, C_KS = 2312, C_KW = 2568, C_G = 2824, C_GM = 2848, C_GN = 3872;
constexpr int PAST = 16384;
constexpr float NEGF = -1e30f;
constexpr float DN_ALPHA = 1.189207115002721f;
constexpr float LN_EPS = 1e-5f;
constexpr float LOG2E = 1.4426950408889634f;

constexpr size_t O_Y = 0;
constexpr size_t O_CMPP = (size_t)NR * DM;
constexpr size_t O_CMPS = O_CMPP + (size_t)NP * 256;
constexpr size_t O_SLCP = O_CMPS + (size_t)BS * 256;
constexpr size_t O_SLCS = O_SLCP + (size_t)NP * 256;
constexpr size_t O_WINP = O_SLCS + (size_t)BS * 256;
constexpr size_t O_WINS = O_WINP + (size_t)BP * 512 * 256;
constexpr size_t O_CP = O_WINS + (size_t)BS * 512 * 256;
constexpr size_t O_CS = O_CP + (size_t)BP * 4 * 128 * 128;
constexpr size_t O_NP = O_CS + (size_t)BS * 4 * 128 * 128;
constexpr size_t O_NS = O_NP + (size_t)BP * 4 * 128;
constexpr size_t O_MP = O_NS + (size_t)BS * 4 * 128;
constexpr size_t O_MS = O_MP + (size_t)BP * 4;
constexpr size_t O_CVP = O_MS + (size_t)BS * 4;
constexpr size_t O_CVS = O_CVP + (size_t)BP * 3 * 512;
constexpr size_t O_END = O_CVS + (size_t)BS * 3 * 512;
static_assert(O_END == 59916480, "output size");

constexpr size_t al256(size_t x) { return (x + 255) & ~(size_t)255; }
constexpr size_t WS_BAR = 0;
constexpr size_t WS_Z = 16384;
constexpr size_t WS_QK = al256(WS_Z + (size_t)MP * 32 * 4);
constexpr size_t WS_HRAW = al256(WS_QK + 256);
constexpr size_t WS_MOUTB = al256(WS_HRAW + (size_t)MP * 512 * 4);
constexpr size_t WS_NOUTB = al256(WS_MOUTB + (size_t)MP * 512 * 2);
constexpr size_t WS_HIDPB = al256(WS_NOUTB + (size_t)MP * 512 * 2);
constexpr size_t WS_KCP = al256(WS_HIDPB + (size_t)2 * 4096 * 64 * 2);
constexpr size_t WS_HIDSB = al256(WS_KCP + 256);
constexpr size_t WS_KCS = al256(WS_HIDSB + (size_t)2 * 65536 * 64 * 2);
constexpr size_t WS_MIX = al256(WS_KCS + (size_t)2 * 65536 * 64 * 4);
constexpr size_t WS_MIXB = al256(WS_MIX + (size_t)MP * 1024 * 4);
constexpr size_t WS_T1 = al256(WS_MIXB + (size_t)MP * 1024 * 2);
constexpr size_t WS_X1 = al256(WS_T1 + (size_t)MP * 1024 * 4);
constexpr size_t WS_X1B = al256(WS_X1 + (size_t)MP * 1024 * 4);
constexpr size_t WS_QPB = al256(WS_X1B + (size_t)MP * 1024 * 2);
constexpr size_t WS_S = al256(WS_QPB + (size_t)MP * 2048 * 2);
constexpr size_t WS_PIDX = al256(WS_S + (size_t)MP * 2048 * 4);
constexpr size_t WS_PG = al256(WS_PIDX + (size_t)MP * 128 * 4);
constexpr size_t WS_CONVB = al256(WS_PG + (size_t)MP * 128 * 4);
constexpr size_t WS_XB = al256(WS_CONVB + (size_t)MP * 512 * 2);
constexpr size_t WS_WIN_T = al256(WS_XB + (size_t)MP * 1024 * 2);
constexpr size_t WS_WUPM_T = al256(WS_WIN_T + (size_t)IN_DIM * 1024 * 2);
constexpr size_t WS_WUPN_T = al256(WS_WUPM_T + (size_t)1024 * 512 * 2);
constexpr size_t WS_WOUT_T = al256(WS_WUPN_T + (size_t)1024 * 512 * 2);
constexpr size_t WS_PWQ_T = al256(WS_WOUT_T + (size_t)1024 * 1024 * 2);
constexpr size_t WS_WQK_T = al256(WS_PWQ_T + (size_t)2048 * 1024 * 2);
constexpr size_t WS_W1_T = al256(WS_WQK_T + (size_t)4 * 256 * 128 * 2);
constexpr size_t WS_PESUM = al256(WS_W1_T + (size_t)2 * 128 * 1024 * 2);
constexpr size_t WS_W2_T = al256(WS_PESUM + 512);
constexpr size_t WS_SUBK = al256(WS_W2_T + (size_t)2 * 64 * 64 * 2);
constexpr size_t WS_ZB = al256(WS_SUBK + (size_t)2 * 128 * 128 * 2);
constexpr size_t WS_VTS = al256(WS_ZB + (size_t)MP * IN_DIM * 2);
constexpr size_t WS_VTW = al256(WS_VTS + (size_t)16 * 2 * 64 * 2048 * 2);
constexpr size_t WS_KCB = al256(WS_VTW + (size_t)16 * 2 * 64 * 2048 * 2);
constexpr size_t WS_VTC = al256(WS_KCB + (size_t)16 * 2 * 128 * 64 * 2);
constexpr size_t WS_NOUTF = al256(WS_VTC + (size_t)16 * 2 * 64 * 128 * 2);
constexpr size_t WS_U8 = al256(WS_NOUTF + (size_t)NP * 512 * 4);
constexpr size_t WS_V8 = al256(WS_U8 + (size_t)16384 * 1024);
constexpr size_t WS_QB = al256(WS_V8 + (size_t)16384 * 1024);
constexpr size_t WS_KB = al256(WS_QB + (size_t)MP * 512 * 2);
constexpr size_t WS_KTB = al256(WS_KB + (size_t)MP * 512 * 2);
constexpr size_t WS_VTM = al256(WS_KTB + (size_t)16 * 512 * 2048 * 2);
constexpr size_t WS_KCSB = al256(WS_VTM + (size_t)16 * 512 * 2048 * 2);
constexpr size_t WS_VTCS = al256(WS_KCSB + (size_t)32 * 2 * 1024 * 64 * 2);
constexpr size_t WS_END = al256(WS_VTCS + (size_t)32 * 2 * 64 * 1024 * 2);

static_assert(WS_END <= 2684354560ull, "workspace too large");
constexpr int LDS_BYTES = 73728;
constexpr int NTHREADS = 256;

struct Params {
    const float* x_prompt; const float* x_sample; const float* cache_cmp; const float* cache_slc; const int* page_table;
    const float* state_win; const float* state_C; const float* state_n; const float* state_m; const float* state_conv;
    const float* w_in; const float* conv_w; const float* conv_b; const float* wq; const float* wk; const float* gate_bias; const float* norm_g;
    const float* cmp_pe; const float* cmp_w1; const float* cmp_w2; const float* rel_bias; const float* w_up_m; const float* w_up_n; const float* w_out;
    const float* ln1_g; const float* ln1_b; const float* ln2_g; const float* ln2_b; const float* peer_wq; const float* peer_sub; const float* peer_u; const float* peer_v;
    float* out; unsigned char* ws;
};

#define XB_TMO      128
#define XB_XCNT(j)  (256  + 64 * (j))
#define XB_XSUB(j)  (1280 + 64 * (j))
#define XB_XGEN(j)  (2304 + 64 * (j))
#define XB_TOP      3328
#define XB_TOPGEN   3392
#define XCD_BAR_WORDS 3456
#define XB_SPIN_CAP (1u << 22)
#define LAS __attribute__((address_space(3)))

__device__ __forceinline__ unsigned xb_ld(unsigned* p)              { return __hip_atomic_load(p, __ATOMIC_RELAXED, __HIP_MEMORY_SCOPE_AGENT); }
__device__ __forceinline__ unsigned xb_add(unsigned* p, unsigned v) { return __hip_atomic_fetch_add(p, v, __ATOMIC_RELAXED, __HIP_MEMORY_SCOPE_AGENT); }
__device__ __forceinline__ unsigned xb_xcc_id() { return (unsigned)__builtin_amdgcn_s_getreg((3 << 11) | 20) & 0xFu; }
#define XB_SPIN(cond, bar) do { unsigned _sp = 0; while (cond) { __builtin_amdgcn_s_sleep(1); \
    if ((++_sp & 255u) == 0u) { if (xb_ld(&(bar)[XB_TMO])) break; if (_sp > XB_SPIN_CAP) { atomicAdd(&(bar)[XB_TMO], 1u); break; } } } } while (0)

struct XcdBarrier { unsigned* bar; unsigned x; volatile LAS unsigned* st; };

__device__ __forceinline__ XcdBarrier xcd_barrier_post(unsigned* bar, volatile LAS unsigned* st) {
    XcdBarrier b; b.bar = bar; b.x = xb_xcc_id(); b.st = st;
    if (threadIdx.x == 0) (void)xb_add(&bar[XB_XCNT(b.x)], 1u);
    return b;
}
__device__ __forceinline__ void xcd_barrier_complete(unsigned* bar, unsigned x, unsigned& nloc, unsigned& nx) {
    const unsigned G = gridDim.x * gridDim.y * gridDim.z;
    unsigned sum, cnt, mine, sp = 0u;
    for (;;) {
        sum = 0u; cnt = 0u; mine = 0u;
#pragma unroll
        for (unsigned j = 0; j < 16; ++j) { const unsigned c = xb_ld(&bar[XB_XCNT(j)]); sum += c; cnt += (c > 0u) ? 1u : 0u; mine = (j == x) ? c : mine; }
        if (sum == G) break;
        __builtin_amdgcn_s_sleep(1);
        if ((++sp & 255u) == 0u) { if (xb_ld(&bar[XB_TMO])) break; if (sp > XB_SPIN_CAP) { atomicAdd(&bar[XB_TMO], 1u); break; } }
    }
    nloc = mine > 0u ? mine : 1u; nx = cnt > 0u ? cnt : 1u;
}
__device__ __forceinline__ void xcd_barrier(const XcdBarrier& b) {
    asm volatile("s_waitcnt vmcnt(0)" ::: "memory");
    __syncthreads();
    if (threadIdx.x == 0) {
        unsigned* bar = b.bar;
        __builtin_amdgcn_s_waitcnt(0);
        unsigned nloc = b.st[0], nx = b.st[1];
        if (nloc == 0u) { xcd_barrier_complete(bar, b.x, nloc, nx); b.st[0] = nloc; b.st[1] = nx; }
        const unsigned old = xb_add(&bar[XB_XSUB(b.x)], 1u);
        const unsigned gen = old / nloc;
        if (old + 1u == (gen + 1u) * nloc) {
            __builtin_amdgcn_fence(__ATOMIC_RELEASE, "agent");
            asm volatile("s_waitcnt vmcnt(0)" ::: "memory");
            const unsigned og = xb_add(&bar[XB_TOP], 1u);
            const unsigned tg = og / nx;
            if (og + 1u == (tg + 1u) * nx) xb_add(&bar[XB_TOPGEN], 1u);
            else XB_SPIN(xb_ld(&bar[XB_TOPGEN]) == tg, bar);
            __builtin_amdgcn_fence(__ATOMIC_ACQUIRE, "agent");
            xb_add(&bar[XB_XGEN(b.x)], 1u);
            asm volatile("s_waitcnt vmcnt(0)" ::: "memory");
        } else {
            XB_SPIN(xb_ld(&bar[XB_XGEN(b.x)]) == gen, bar);
            __builtin_amdgcn_fence(__ATOMIC_ACQUIRE, "agent");
            asm volatile("s_waitcnt vmcnt(0)" ::: "memory");
        }
    }
    __syncthreads();
}

typedef float f32x4 __attribute__((ext_vector_type(4)));

__device__ const unsigned char REL_LUT[128] = {
    0, 1, 2, 3, 4, 5, 6, 7, 8, 9, 10, 11, 12, 13, 14, 15, 16, 16, 16, 17, 17, 18, 18, 18, 19, 19, 19, 20, 20, 20, 20, 21, 21, 21, 21, 22, 22, 22, 22, 22,
    23, 23, 23, 23, 23, 23, 24, 24, 24, 24, 24, 24, 25, 25, 25, 25, 25, 25, 25, 26, 26, 26, 26, 26, 26, 26, 26, 27, 27, 27, 27, 27, 27, 27, 27, 27, 27,
    28, 28, 28, 28, 28, 28, 28, 28, 28, 28, 29, 29, 29, 29, 29, 29, 29, 29, 29, 29, 29, 29, 30, 30, 30, 30, 30, 30, 30, 30, 30, 30, 30, 30, 30, 30,
    31, 31, 31, 31, 31, 31, 31, 31, 31, 31, 31, 31, 31, 31, 31};
DEV int rel_bucket(int n) { return n < 128 ? (int)REL_LUT[n < 0 ? 0 : n] : 31; }

DEV float sigmoidf_(float x) { return 1.0f / (1.0f + expf(-x)); }
DEV float gelu_tanh(float x) { return 0.5f * x * (1.0f + tanhf(0.7978845608028654f * (x + 0.044715f * x * x * x))); }
DEV float log_sigmoid(float x) { return x >= 0.f ? -log1pf(expf(-x)) : x - log1pf(expf(x)); }
DEV void wave_sync() { asm volatile("s_waitcnt lgkmcnt(0)" ::: "memory"); __builtin_amdgcn_wave_barrier(); asm volatile("" ::: "memory"); }
DEV float wave_sum(float v) {
#pragma unroll
    for (int o = 32; o >= 1; o >>= 1) v += __shfl_xor(v, o);
    return v;
}
DEV float wave_max(float v) {
#pragma unroll
    for (int o = 32; o >= 1; o >>= 1) v = fmaxf(v, __shfl_xor(v, o));
    return v;
}

typedef unsigned short bf16_t;
typedef short bf16x8 __attribute__((ext_vector_type(8)));
typedef float f32x2_ __attribute__((ext_vector_type(2)));
typedef __bf16 bf16x2_ __attribute__((ext_vector_type(2)));
DEV unsigned cvt_pk_bf16(float lo, float hi) { const f32x2_ v = {lo, hi}; return __builtin_bit_cast(unsigned, __builtin_convertvector(v, bf16x2_)); }
DEV float bf_lo(unsigned w) { return __uint_as_float(w << 16); }
DEV float bf_hi(unsigned w) { return __uint_as_float(w & 0xffff0000u); }
DEV uint4 pack8(const float* f) { uint4 r; r.x = cvt_pk_bf16(f[0], f[1]); r.y = cvt_pk_bf16(f[2], f[3]); r.z = cvt_pk_bf16(f[4], f[5]); r.w = cvt_pk_bf16(f[6], f[7]); return r; }
DEV void store_bf16x4(bf16_t* p, f32x4 v) { uint2 w; w.x = cvt_pk_bf16(v[0], v[1]); w.y = cvt_pk_bf16(v[2], v[3]); *(uint2*)p = w; }

DEV void transpose_to_bf16(const float* __restrict__ src, const int K, const int N, bf16_t* __restrict__ dst, const size_t gt, const size_t nt) {
    const size_t items = (size_t)N * (K >> 3);
    for (size_t id = gt; id < items; id += nt) {
        const int n = (int)(id % N), k8 = (int)(id / N) * 8;
        float f[8];
#pragma unroll
        for (int i = 0; i < 8; ++i) f[i] = src[(size_t)(k8 + i) * N + n];
        *(uint4*)(dst + (size_t)n * K + k8) = pack8(f);
    }
}

template <int BN, bool TILE_EPI = false, class LA, class LB, class EF>
DEV void gemm_bf16(const int M, const int N, const int K, LA la, LB lb, EF ef, unsigned char* lds, const int toff = 0) {
    constexpr int TJ = BN / 32;
    constexpr int NB = BN / 32;
    constexpr int LDR = 144;
    const int tid = threadIdx.x, lane = tid & 63, w = tid >> 6, wm = w >> 1, wn = w & 1;
    const int tm = (M + 127) >> 7, tn = (N + BN - 1) / BN;
    unsigned char* As = lds;
    unsigned char* Bs = lds + 128 * LDR;
    const int lr = lane & 15, lq = lane >> 4;
    for (int tile = (int)((blockIdx.x + gridDim.x - (unsigned)toff % gridDim.x) % gridDim.x); tile < tm * tn; tile += gridDim.x) {
        const int bm = (tile / tn) * 128, bn = (tile % tn) * BN;
        f32x4 acc[4][TJ];
#pragma unroll
        for (int i = 0; i < 4; ++i)
#pragma unroll
            for (int j = 0; j < TJ; ++j) acc[i][j] = (f32x4){0.f, 0.f, 0.f, 0.f};
        uint4 ra[4], rb[NB];
        int arow[4], brow[NB];
#pragma unroll
        for (int i = 0; i < 4; ++i) { const int r = bm + ((tid + 256 * i) >> 3); arow[i] = r < M ? r : M - 1; }
#pragma unroll
        for (int i = 0; i < NB; ++i) { const int n = bn + ((tid + 256 * i) >> 3); brow[i] = n < N ? n : N - 1; }
        const int kc = (tid & 7) * 8;
#pragma unroll
        for (int i = 0; i < 4; ++i) ra[i] = la(arow[i], kc);
#pragma unroll
        for (int i = 0; i < NB; ++i) rb[i] = lb(brow[i], kc);
        for (int k0_ = 0; k0_ < K; k0_ += 64) {
            int k0 = k0_; asm volatile("" : "+v"(k0));
            __syncthreads();
#pragma unroll
            for (int i = 0; i < 4; ++i) *(uint4*)(As + ((tid + 256 * i) >> 3) * LDR + (tid & 7) * 16) = ra[i];
#pragma unroll
            for (int i = 0; i < NB; ++i) *(uint4*)(Bs + ((tid + 256 * i) >> 3) * LDR + (tid & 7) * 16) = rb[i];
            __syncthreads();
            if (k0_ + 64 < K) {
#pragma unroll
                for (int i = 0; i < 4; ++i) ra[i] = la(arow[i], k0 + 64 + kc);
#pragma unroll
                for (int i = 0; i < NB; ++i) rb[i] = lb(brow[i], k0 + 64 + kc);
            }
#pragma unroll
            for (int kk = 0; kk < 2; ++kk) {
                bf16x8 a[4], b[TJ];
#pragma unroll
                for (int i = 0; i < 4; ++i) a[i] = *(const bf16x8*)(As + (wm * 64 + i * 16 + lr) * LDR + kk * 64 + lq * 16);
#pragma unroll
                for (int j = 0; j < TJ; ++j) b[j] = *(const bf16x8*)(Bs + (wn * (BN / 2) + j * 16 + lr) * LDR + kk * 64 + lq * 16);
#pragma unroll
                for (int i = 0; i < 4; ++i)
#pragma unroll
                    for (int j = 0; j < TJ; ++j) acc[i][j] = __builtin_amdgcn_mfma_f32_16x16x32_bf16(b[j], a[i], acc[i][j], 0, 0, 0);
            }
        }
        if constexpr (TILE_EPI) { ef(acc, bm); }
        else {
#pragma unroll
            for (int i = 0; i < 4; ++i)
#pragma unroll
                for (int j = 0; j < TJ; ++j) {
                    const int r = bm + wm * 64 + i * 16 + lr, c0 = bn + wn * (BN / 2) + j * 16 + lq * 4;
                    if (r < M && c0 < N) ef(r, c0, acc[i][j]);
                }
        }
    }
}

DEV int lds_byte2(int r, int c) { const int st = (r >> 4) * 2 + (c >> 5), ob = (r & 15) * 64 + (c & 31) * 2; return st * 1024 + (ob ^ (((ob >> 9) & 1) << 5)); }
DEV void stage_rc2(int b, int& R, int& C) { const int st = b >> 10, sb = b & 1023, swz = sb ^ (((sb >> 9) & 1) << 5); R = (st >> 1) * 16 + swz / 64; C = (st & 1) * 32 + (swz % 64) / 2; }
struct NoMid { DEV void operator()(int, int, f32x4&, uint2&) const {} };
template <class PA, class PB, class EF, class MF = NoMid, bool XCDN = false>
DEV void gemm_glds(const int M, const int N, const int K, PA pa, PB pb, EF ef, unsigned char* lds, const int toff = 0, const int ksplit = 0, MF mf = MF()) {
    const int tid = threadIdx.x, lane = tid & 63, w = tid >> 6, wm = w >> 1, wn = w & 1;
    const int tm = (M + 127) >> 7, tn = (N + 127) >> 7;
    const int lr = lane & 15, lq = lane >> 4;
    const int nk = K >> 6;
    int sR[4], sC[4];
#pragma unroll
    for (int i = 0; i < 4; ++i) stage_rc2((w + 4 * i) * 1024 + lane * 16, sR[i], sC[i]);
    const int xc = blockIdx.x & 7, xslots = gridDim.x >> 3, xcnt = (tn - xc + 7) >> 3;
    for (int tile = XCDN ? (int)(blockIdx.x >> 3) : (int)((blockIdx.x + gridDim.x - (unsigned)toff % gridDim.x) % gridDim.x); tile < (XCDN ? tm * xcnt : tm * tn); tile += (XCDN ? xslots : (int)gridDim.x)) {
        const int bm = (XCDN ? tile / xcnt : tile / tn) * 128, bn = (XCDN ? xc + 8 * (tile % xcnt) : tile % tn) * 128;
        f32x4 acc[4][4]; uint2 keep[4][4];
#pragma unroll
        for (int i = 0; i < 4; ++i)
#pragma unroll
            for (int j = 0; j < 4; ++j) { acc[i][j] = (f32x4){0.f, 0.f, 0.f, 0.f}; keep[i][j] = make_uint2(0u, 0u); }
        int arow[4], brow[4];
#pragma unroll
        for (int i = 0; i < 4; ++i) { const int r = bm + sR[i], n = bn + sR[i]; arow[i] = r < M ? r : M - 1; brow[i] = n < N ? n : N - 1; }
#define GLDS_STAGE(BUF, KT) { _Pragma("unroll") for (int i = 0; i < 4; ++i) { \
            __builtin_amdgcn_global_load_lds((const unsigned*)pa(arow[i], (KT) * 64 + sC[i]), (LAS unsigned*)(lds + (BUF) * 32768 + (w + 4 * i) * 1024), 16, 0, 0); \
            __builtin_amdgcn_global_load_lds((const unsigned*)pb(brow[i], (KT) * 64 + sC[i]), (LAS unsigned*)(lds + (BUF) * 32768 + 16384 + (w + 4 * i) * 1024), 16, 0, 0); } }
        __syncthreads();
        GLDS_STAGE(0, 0)
        asm volatile("s_waitcnt vmcnt(0)" ::: "memory");
        __syncthreads();
        for (int kt = 0; kt < nk; ++kt) {
            const int cur = kt & 1;
            if (kt + 1 < nk) GLDS_STAGE(cur ^ 1, kt + 1)
            const unsigned char* SA = lds + cur * 32768;
            const unsigned char* SB = SA + 16384;
#pragma unroll
            for (int kk = 0; kk < 2; ++kk) {
                bf16x8 a[4], b[4];
#pragma unroll
                for (int i = 0; i < 4; ++i) a[i] = *(const bf16x8*)(SA + lds_byte2(wm * 64 + i * 16 + lr, kk * 32 + lq * 8));
#pragma unroll
                for (int j = 0; j < 4; ++j) b[j] = *(const bf16x8*)(SB + lds_byte2(wn * 64 + j * 16 + lr, kk * 32 + lq * 8));
#pragma unroll
                for (int i = 0; i < 4; ++i)
#pragma unroll
                    for (int j = 0; j < 4; ++j) acc[i][j] = __builtin_amdgcn_mfma_f32_16x16x32_bf16(b[j], a[i], acc[i][j], 0, 0, 0);
            }
            if constexpr (!__is_same(MF, NoMid)) {
                if (kt + 1 == ksplit) {
#pragma unroll
                    for (int i = 0; i < 4; ++i)
#pragma unroll
                        for (int j = 0; j < 4; ++j) {
                            const int r = bm + wm * 64 + i * 16 + lr, c0 = bn + wn * 64 + j * 16 + lq * 4;
                            if (r < M && c0 < N) mf(r, c0, acc[i][j], keep[i][j]);
                            acc[i][j] = (f32x4){0.f, 0.f, 0.f, 0.f};
                        }
                }
            }
            asm volatile("s_waitcnt vmcnt(0)" ::: "memory");
            __syncthreads();
        }
#undef GLDS_STAGE
#pragma unroll
        for (int i = 0; i < 4; ++i)
#pragma unroll
            for (int j = 0; j < 4; ++j) {
                const int r = bm + wm * 64 + i * 16 + lr, c0 = bn + wn * 64 + j * 16 + lq * 4;
                if (r < M && c0 < N) { if constexpr (!__is_same(MF, NoMid)) ef(r, c0, acc[i][j], keep[i][j]); else ef(r, c0, acc[i][j]); }
            }
    }
}

template <class PA, class PB, class EF>
DEV void gemm_glds_xcd(const int M, const int N, const int K, PA pa, PB pb, EF ef, unsigned char* lds) { gemm_glds<PA, PB, EF, NoMid, true>(M, N, K, pa, pb, ef, lds, 0, 0, NoMid()); }

DEV void mlstm_step_item(const Params& p, const int item, float* lds) {
    int tid_ = threadIdx.x; asm volatile("" : "+v"(tid_));
    const int tid = tid_, v = tid >> 1, kh = tid & 1;
    const int b = item >> 2, h = item & 3;
    const size_t r = (size_t)(NP + b);
    const float* Z = (const float*)(p.ws + WS_Z);
    const bf16_t* QBp = (const bf16_t*)(p.ws + WS_QB); const bf16_t* KBp = (const bf16_t*)(p.ws + WS_KB); const bf16_t* ZBp = (const bf16_t*)(p.ws + WS_ZB);
    float* HRAW = (float*)(p.ws + WS_HRAW);
    __syncthreads();
    lds[tid] = bf_lo((unsigned)(tid < 128 ? QBp[r * 512 + h * 128 + tid] : KBp[r * 512 + h * 128 + tid - 128]));
    if (tid < 128) lds[256 + tid] = bf_lo((unsigned)ZBp[r * IN_DIM + C_V + h * 128 + tid]);
    __syncthreads();
    const float m0 = p.state_m[b * 4 + h];
    const float ig = Z[r * 32 + h] + p.gate_bias[h], lf = log_sigmoid(Z[r * 32 + 4 + h] + p.gate_bias[4 + h]);
    const float mn = fmaxf(lf + m0, ig);
    const float fd = expf(lf + m0 - mn), iw = expf(ig - mn);
    const float vv = lds[256 + v] * iw;
    const float* c0 = p.state_C + (((size_t)(b * 4 + h) * 128 + v) * 128 + kh * 64);
    const float* n0 = p.state_n + ((size_t)(b * 4 + h) * 128 + kh * 64);
    float* co = p.out + O_CS + (((size_t)(b * 4 + h) * 128 + v) * 128 + kh * 64);
    float* no = p.out + O_NS + ((size_t)(b * 4 + h) * 128 + kh * 64);
    float nump = 0.f, denp = 0.f;
#pragma unroll 4
    for (int j = 0; j < 64; j += 4) {
        const float4 c4 = *(const float4*)(c0 + j), n4 = *(const float4*)(n0 + j);
        const float4 k4 = *(const float4*)(lds + 128 + kh * 64 + j), q4 = *(const float4*)(lds + kh * 64 + j);
        float4 cn, nn;
        cn.x = fd * c4.x + vv * k4.x; cn.y = fd * c4.y + vv * k4.y; cn.z = fd * c4.z + vv * k4.z; cn.w = fd * c4.w + vv * k4.w;
        nn.x = fd * n4.x + iw * k4.x; nn.y = fd * n4.y + iw * k4.y; nn.z = fd * n4.z + iw * k4.z; nn.w = fd * n4.w + iw * k4.w;
        nump += cn.x * q4.x + cn.y * q4.y + cn.z * q4.z + cn.w * q4.w;
        denp += nn.x * q4.x + nn.y * q4.y + nn.z * q4.z + nn.w * q4.w;
        *(float4*)(co + j) = cn;
        if (v == 0) *(float4*)(no + j) = nn;
    }
    nump += __shfl_xor(nump, 1); denp += __shfl_xor(denp, 1);
    if (kh == 0) HRAW[r * 512 + h * 128 + v] = nump / fmaxf(fabsf(denp), expf(-mn));
    if (tid == 0) p.out[O_MS + b * 4 + h] = mn;
}

DEV void mlstm_chunk_item(const Params& p, const int item, unsigned char* lds) {
    int tid_ = threadIdx.x; asm volatile("" : "+v"(tid_));
    const int tid = tid_, lane = tid & 63, w = tid >> 6, lr = lane & 15, lq = lane >> 4;
    const int b = item >> 4, h = (item >> 2) & 3, vs = item & 3;
    bf16_t* Cl = (bf16_t*)lds;
    bf16_t* nl = (bf16_t*)(lds + 8704);
    float* uL = (float*)(lds + 8960); float* ML = uL + 64; float* scin = uL + 128; float* expm = uL + 192; float* wts = uL + 256; float* misc = uL + 320;
    const bf16_t* QB = (const bf16_t*)(p.ws + WS_QB) + (size_t)(b * 2048) * 512 + h * 128;
    const bf16_t* KB = (const bf16_t*)(p.ws + WS_KB) + (size_t)(b * 2048) * 512 + h * 128;
    const bf16_t* KTB = (const bf16_t*)(p.ws + WS_KTB) + (size_t)((b * 4 + h) * 128) * 2048;
    const bf16_t* VTM = (const bf16_t*)(p.ws + WS_VTM) + (size_t)(b * 512 + h * 128 + vs * 32) * 2048;
    const float* Z = (const float*)(p.ws + WS_Z);
    float* HRAW = (float*)(p.ws + WS_HRAW);
    const float gb_i = p.gate_bias[h], gb_f = p.gate_bias[4 + h];
    f32x4 Cm[2][2], nm[2];
#pragma unroll
    for (int i = 0; i < 2; ++i) { nm[i] = (f32x4){0.f, 0.f, 0.f, 0.f};
#pragma unroll
        for (int j = 0; j < 2; ++j) Cm[i][j] = (f32x4){0.f, 0.f, 0.f, 0.f}; }
    float m_prev = 0.f;
    __syncthreads();
    for (int i = tid; i < (8704 + 256) / 4; i += 256) ((unsigned*)lds)[i] = 0u;
    __syncthreads();
    for (int c = 0; c < 32; ++c) {
        const int t0 = c * 64;
        if (w == 0) {
            const size_t row = (size_t)(b * 2048 + t0 + lane);
            const float ig = Z[row * 32 + h] + gb_i;
            const float lf = log_sigmoid(Z[row * 32 + 4 + h] + gb_f);
            float bc = lf;
#pragma unroll
            for (int o = 1; o < 64; o <<= 1) { const float t = __shfl_up(bc, o); if (lane >= o) bc += t; }
            const float u = ig - bc;
            float pm = u;
#pragma unroll
            for (int o = 1; o < 64; o <<= 1) { const float t = __shfl_up(pm, o); if (lane >= o) pm = fmaxf(pm, t); }
            const float M = fmaxf(m_prev, pm);
            const float M63 = __shfl(M, 63), b63 = __shfl(bc, 63);
            uL[lane] = u; ML[lane] = M; scin[lane] = expf(m_prev - M); expm[lane] = expf(-(bc + M)); wts[lane] = expf(u - M63);
            if (lane == 0) { misc[0] = expf(m_prev - M63); misc[1] = b63 + M63; }
        }
        __syncthreads();
        {
            const size_t row_t = (size_t)(t0 + w * 16 + lr);
            bf16x8 Qf[4];
#pragma unroll
            for (int ks = 0; ks < 4; ++ks) Qf[ks] = *(const bf16x8*)(QB + row_t * 512 + ks * 32 + lq * 8);
            const float M_t = ML[w * 16 + lr], sc_in = scin[w * 16 + lr], em = expm[w * 16 + lr];
            f32x4 sw[4];
            float dsum = 0.f;
#pragma unroll
            for (int st = 0; st < 4; ++st) {
                f32x4 a = (f32x4){0.f, 0.f, 0.f, 0.f};
                if (st <= w) {
#pragma unroll
                    for (int ks = 0; ks < 4; ++ks) { const bf16x8 kf = *(const bf16x8*)(KB + (size_t)(t0 + st * 16 + lr) * 512 + ks * 32 + lq * 8); a = __builtin_amdgcn_mfma_f32_16x16x32_bf16(kf, Qf[ks], a, 0, 0, 0); }
#pragma unroll
                    for (int g = 0; g < 4; ++g) {
                        const int sl = st * 16 + lq * 4 + g, tl = w * 16 + lr;
                        const float wg = (sl <= tl) ? __builtin_amdgcn_exp2f((uL[sl] - M_t) * LOG2E) : 0.f;
                        a[g] *= wg; dsum += a[g];
                    }
                }
                sw[st] = a;
            }
            dsum += __shfl_xor(dsum, 16); dsum += __shfl_xor(dsum, 32);
            bf16x8 pf[2];
#pragma unroll
            for (int ks = 0; ks < 2; ++ks) {
                union { bf16x8 v; unsigned u[4]; } pk;
                pk.u[0] = cvt_pk_bf16(sw[2 * ks][0], sw[2 * ks][1]); pk.u[1] = cvt_pk_bf16(sw[2 * ks][2], sw[2 * ks][3]);
                pk.u[2] = cvt_pk_bf16(sw[2 * ks + 1][0], sw[2 * ks + 1][1]); pk.u[3] = cvt_pk_bf16(sw[2 * ks + 1][2], sw[2 * ks + 1][3]);
                pf[ks] = pk.v;
            }
            f32x4 dI = (f32x4){0.f, 0.f, 0.f, 0.f};
#pragma unroll
            for (int ks = 0; ks < 4; ++ks) { const bf16x8 nf = *(const bf16x8*)(nl + ks * 32 + lq * 8); dI = __builtin_amdgcn_mfma_f32_16x16x32_bf16(nf, Qf[ks], dI, 0, 0, 0); }
            const float den = sc_in * dI[0] + dsum;
            const float rdd = 1.0f / fmaxf(fabsf(den), em);
#pragma unroll
            for (int vt = 0; vt < 2; ++vt) {
                f32x4 ni = (f32x4){0.f, 0.f, 0.f, 0.f}, nI = (f32x4){0.f, 0.f, 0.f, 0.f};
#pragma unroll
                for (int ks = 0; ks < 2; ++ks) if (2 * ks <= w) {
                    union { bf16x8 v; uint2 hh[2]; } vf;
                    const bf16_t* vp = VTM + (size_t)(vt * 16 + lr) * 2048 + t0 + 32 * ks + lq * 4;
                    vf.hh[0] = *(const uint2*)vp; vf.hh[1] = *(const uint2*)(vp + 16);
                    ni = __builtin_amdgcn_mfma_f32_16x16x32_bf16(vf.v, pf[ks], ni, 0, 0, 0);
                }
#pragma unroll
                for (int ks = 0; ks < 4; ++ks) { const bf16x8 cf = *(const bf16x8*)(Cl + (vt * 16 + lr) * 136 + ks * 32 + lq * 8); nI = __builtin_amdgcn_mfma_f32_16x16x32_bf16(cf, Qf[ks], nI, 0, 0, 0); }
                const f32x4 hv = (nI * sc_in + ni) * rdd;
                *(f32x4*)(HRAW + ((size_t)(b * 2048) + row_t) * 512 + h * 128 + vs * 32 + vt * 16 + lq * 4) = hv;
            }
        }
        __syncthreads();
        {
            const float decay = misc[0];
            bf16x8 Af[2][2], Wf[2], Kt[2][2];
#pragma unroll
            for (int ks = 0; ks < 2; ++ks) {
                const float4 w0 = *(const float4*)(wts + ks * 32 + lq * 8), w1 = *(const float4*)(wts + ks * 32 + lq * 8 + 4);
                float wv[8] = {w0.x, w0.y, w0.z, w0.w, w1.x, w1.y, w1.z, w1.w};
                { union { bf16x8 v; uint4 q; } t; t.q = pack8(wv); Wf[ks] = t.v; }
#pragma unroll
                for (int vt = 0; vt < 2; ++vt) {
                    const uint4 raw = *(const uint4*)(VTM + (size_t)(vt * 16 + lr) * 2048 + t0 + ks * 32 + lq * 8);
                    float f[8] = {bf_lo(raw.x) * wv[0], bf_hi(raw.x) * wv[1], bf_lo(raw.y) * wv[2], bf_hi(raw.y) * wv[3], bf_lo(raw.z) * wv[4], bf_hi(raw.z) * wv[5], bf_lo(raw.w) * wv[6], bf_hi(raw.w) * wv[7]};
                    union { bf16x8 v; uint4 q; } t; t.q = pack8(f); Af[vt][ks] = t.v;
                }
#pragma unroll
                for (int kt = 0; kt < 2; ++kt) Kt[kt][ks] = *(const bf16x8*)(KTB + (size_t)((2 * w + kt) * 16 + lr) * 2048 + t0 + ks * 32 + lq * 8);
            }
#pragma unroll
            for (int kt = 0; kt < 2; ++kt) {
                nm[kt] = nm[kt] * decay;
#pragma unroll
                for (int ks = 0; ks < 2; ++ks) nm[kt] = __builtin_amdgcn_mfma_f32_16x16x32_bf16(Wf[ks], Kt[kt][ks], nm[kt], 0, 0, 0);
                if (lq == 0) nl[(2 * w + kt) * 16 + lr] = (bf16_t)(cvt_pk_bf16(nm[kt][0], 0.f) & 0xffffu);
#pragma unroll
                for (int vt = 0; vt < 2; ++vt) {
                    Cm[vt][kt] = Cm[vt][kt] * decay;
#pragma unroll
                    for (int ks = 0; ks < 2; ++ks) Cm[vt][kt] = __builtin_amdgcn_mfma_f32_16x16x32_bf16(Af[vt][ks], Kt[kt][ks], Cm[vt][kt], 0, 0, 0);
                    const unsigned c01 = cvt_pk_bf16(Cm[vt][kt][0], Cm[vt][kt][1]), c23 = cvt_pk_bf16(Cm[vt][kt][2], Cm[vt][kt][3]);
                    bf16_t* cp = Cl + (vt * 16 + lq * 4) * 136 + (2 * w + kt) * 16 + lr;
                    cp[0] = (bf16_t)(c01 & 0xffffu); cp[136] = (bf16_t)(c01 >> 16); cp[272] = (bf16_t)(c23 & 0xffffu); cp[408] = (bf16_t)(c23 >> 16);
                }
            }
            m_prev = misc[1];
        }
        __syncthreads();
    }
#pragma unroll
    for (int vt = 0; vt < 2; ++vt)
#pragma unroll
        for (int kt = 0; kt < 2; ++kt)
#pragma unroll
            for (int g = 0; g < 4; ++g)
                p.out[O_CP + ((size_t)((b * 4 + h) * 128) + vs * 32 + vt * 16 + lq * 4 + g) * 128 + (2 * w + kt) * 16 + lr] = Cm[vt][kt][g];
    if (vs == 0) {
        if (lq == 0) { p.out[O_NP + (size_t)(b * 4 + h) * 128 + (2 * w) * 16 + lr] = nm[0][0]; p.out[O_NP + (size_t)(b * 4 + h) * 128 + (2 * w + 1) * 16 + lr] = nm[1][0]; }
        if (tid == 0) p.out[O_MP + b * 4 + h] = m_prev;
    }
}

DEV unsigned dpp_max16(unsigned x) {
    x = max(x, (unsigned)__builtin_amdgcn_update_dpp(0, (int)x, 0xB1, 0xF, 0xF, false));
    x = max(x, (unsigned)__builtin_amdgcn_update_dpp(0, (int)x, 0x4E, 0xF, 0xF, false));
    x = max(x, (unsigned)__builtin_amdgcn_update_dpp(0, (int)x, 0x141, 0xF, 0xF, false));
    x = max(x, (unsigned)__builtin_amdgcn_update_dpp(0, (int)x, 0x140, 0xF, 0xF, false));
    return x;
}
DEV float dpp_sum16(float x) {
    x += __builtin_bit_cast(float, __builtin_amdgcn_update_dpp(0, __builtin_bit_cast(int, x), 0xB1, 0xF, 0xF, false));
    x += __builtin_bit_cast(float, __builtin_amdgcn_update_dpp(0, __builtin_bit_cast(int, x), 0x4E, 0xF, 0xF, false));
    x += __builtin_bit_cast(float, __builtin_amdgcn_update_dpp(0, __builtin_bit_cast(int, x), 0x141, 0xF, 0xF, false));
    x += __builtin_bit_cast(float, __builtin_amdgcn_update_dpp(0, __builtin_bit_cast(int, x), 0x140, 0xF, 0xF, false));
    return x;
}
DEV unsigned mono_key(float v) { const unsigned b = __float_as_uint(v); return (b & 0x80000000u) ? ~b : (b | 0x80000000u); }
#define CE_DESC(a, b) { const unsigned hi_ = max(a, b), lo_ = min(a, b); a = hi_; b = lo_; }

DEV void peer_score_topk_item(const Params& p, const int tile, const int h, unsigned char* lds) {
    int tid_ = threadIdx.x; asm volatile("" : "+v"(tid_));
    const int tid = tid_, lane = tid & 63, w = tid >> 6, lr = lane & 15, lq = lane >> 4;
    float* sc = (float*)(lds + w * 12416);
    float* ts = sc + 16 * 129;
    int* ti = (int*)(ts + 512);
    const bf16_t* QPB = (const bf16_t*)(p.ws + WS_QPB);
    const bf16_t* SUBK = (const bf16_t*)(p.ws + WS_SUBK);
    int* PIDX = (int*)(p.ws + WS_PIDX); float* PG = (float*)(p.ws + WS_PG);
    const int row0 = tile * 64 + w * 16;
    const int arow = (row0 + lr < NR) ? row0 + lr : NR - 1;
    wave_sync();
#pragma unroll 1
    for (int pp = 0; pp < 2; ++pp) {
        bf16x8 qf[4];
#pragma unroll
        for (int ks = 0; ks < 4; ++ks) qf[ks] = *(const bf16x8*)(QPB + (size_t)arow * 2048 + h * 256 + pp * 128 + ks * 32 + lq * 8);
#pragma unroll
        for (int j = 0; j < 8; ++j) {
            f32x4 a = (f32x4){0.f, 0.f, 0.f, 0.f};
#pragma unroll
            for (int ks = 0; ks < 4; ++ks) { const bf16x8 kf = *(const bf16x8*)(SUBK + ((size_t)pp * 128 + j * 16 + lr) * 128 + ks * 32 + lq * 8); a = __builtin_amdgcn_mfma_f32_16x16x32_bf16(qf[ks], kf, a, 0, 0, 0); }
#pragma unroll
            for (int g = 0; g < 4; ++g) sc[(lq * 4 + g) * 129 + j * 16 + lr] = a[g];
        }
        wave_sync();
#pragma unroll 1
        for (int rr = 0; rr < 4; ++rr) {
            const int row = rr * 4 + lq;
            unsigned k0, k1, k2, k3, k4, k5, k6, k7;
            { const float* sr = sc + row * 129 + lr;
              k0 = (mono_key(sr[0]) & ~0x7Fu) | (unsigned)(127 - lr);        k1 = (mono_key(sr[16]) & ~0x7Fu) | (unsigned)(127 - 16 - lr);
              k2 = (mono_key(sr[32]) & ~0x7Fu) | (unsigned)(127 - 32 - lr);  k3 = (mono_key(sr[48]) & ~0x7Fu) | (unsigned)(127 - 48 - lr);
              k4 = (mono_key(sr[64]) & ~0x7Fu) | (unsigned)(127 - 64 - lr);  k5 = (mono_key(sr[80]) & ~0x7Fu) | (unsigned)(127 - 80 - lr);
              k6 = (mono_key(sr[96]) & ~0x7Fu) | (unsigned)(127 - 96 - lr);  k7 = (mono_key(sr[112]) & ~0x7Fu) | (unsigned)(127 - 112 - lr); }
            CE_DESC(k0, k1) CE_DESC(k2, k3) CE_DESC(k4, k5) CE_DESC(k6, k7)
            CE_DESC(k0, k2) CE_DESC(k1, k3) CE_DESC(k4, k6) CE_DESC(k5, k7)
            CE_DESC(k1, k2) CE_DESC(k5, k6)
            CE_DESC(k0, k4) CE_DESC(k1, k5) CE_DESC(k2, k6) CE_DESC(k3, k7)
            CE_DESC(k2, k4) CE_DESC(k3, k5)
            CE_DESC(k1, k2) CE_DESC(k3, k4) CE_DESC(k5, k6)
            unsigned mine = 0u;
#pragma unroll
            for (int r = 0; r < 16; ++r) {
                const unsigned best = dpp_max16(k0);
                if (lr == r) mine = best;
                const bool own = (k0 == best);
                k0 = own ? k1 : k0; k1 = own ? k2 : k1; k2 = own ? k3 : k2; k3 = own ? k4 : k3; k4 = own ? k5 : k4; k5 = own ? k6 : k5; k6 = own ? k7 : k6; k7 = own ? 0u : k7;
            }
            const int idx = 127 - (int)(mine & 0x7Fu);
            ts[(pp * 16 + row) * 16 + lr] = sc[row * 129 + idx];
            ti[(pp * 16 + row) * 16 + lr] = idx;
        }
        wave_sync();
    }
#pragma unroll 1
    for (int rr = 0; rr < 4; ++rr) {
        const int row = rr * 4 + lq;
        const float s1a = ts[row * 16 + lr];
        const float* s2 = ts + (16 + row) * 16;
        int ptr = 0;
        unsigned key = (mono_key(s1a + s2[0]) & ~0xFFu) | (unsigned)(255 - lr * 16);
        unsigned mine = 0u;
#pragma unroll
        for (int r = 0; r < 16; ++r) {
            const unsigned best = dpp_max16(key);
            if (lr == r) mine = best;
            if (key == best) { ++ptr; key = (ptr < 16) ? ((mono_key(s1a + s2[ptr & 15]) & ~0xFFu) | (unsigned)(255 - lr * 16 - ptr)) : 0u; }
        }
        const int ci = 255 - (int)(mine & 0xFFu), a = ci >> 4, bb = ci & 15;
        const float scv = ts[row * 16 + a] + s2[bb];
        const int e = ti[row * 16 + a] * 128 + ti[(16 + row) * 16 + bb];
        float m16 = scv;
        m16 = fmaxf(m16, __builtin_bit_cast(float, __builtin_amdgcn_update_dpp(0, __builtin_bit_cast(int, m16), 0xB1, 0xF, 0xF, false)));
        m16 = fmaxf(m16, __builtin_bit_cast(float, __builtin_amdgcn_update_dpp(0, __builtin_bit_cast(int, m16), 0x4E, 0xF, 0xF, false)));
        m16 = fmaxf(m16, __builtin_bit_cast(float, __builtin_amdgcn_update_dpp(0, __builtin_bit_cast(int, m16), 0x141, 0xF, 0xF, false)));
        m16 = fmaxf(m16, __builtin_bit_cast(float, __builtin_amdgcn_update_dpp(0, __builtin_bit_cast(int, m16), 0x140, 0xF, 0xF, false)));
        const float ex = expf(scv - m16);
        const float den = dpp_sum16(ex);
        const int grow = row0 + row;
        if (grow < NR) { PIDX[(size_t)grow * 128 + h * 16 + lr] = e; PG[(size_t)grow * 128 + h * 16 + lr] = ex / den; }
    }
}

constexpr float PEER_U_SCALE = 64.0f, PEER_V_SCALE = 8.0f;
DEV unsigned pack4_fp8(float a, float b, float c, float d) { int w = 0; w = __builtin_amdgcn_cvt_pk_fp8_f32(a, b, w, false); w = __builtin_amdgcn_cvt_pk_fp8_f32(c, d, w, true); return (unsigned)w; }
DEV void peer_expert_wave(const Params& p, const int row, unsigned char* wl, const int lane_in) {
    int lane = lane_in; asm volatile("" : "+v"(lane));
    const int lr = lane & 15, lq = lane >> 4;
    unsigned char* xh = wl;
    unsigned char* xo = wl + 1024;
    float* coefl = (float*)(wl + 2048);
    int* idxl = (int*)(wl + 2048 + 512);
    const float* T1r = (const float*)(p.ws + WS_T1) + (size_t)row * 1024;
    const int* PIDX = (const int*)(p.ws + WS_PIDX) + (size_t)row * 128;
    const float* PG = (const float*)(p.ws + WS_PG) + (size_t)row * 128;
    const unsigned char* U8 = p.ws + WS_U8;
    const unsigned char* V8 = p.ws + WS_V8;
    float xv[16];
    {
        float s1 = 0.f;
#pragma unroll
        for (int j = 0; j < 4; ++j) { const float4 t = *(const float4*)(T1r + lane * 16 + j * 4); xv[4 * j] = t.x; xv[4 * j + 1] = t.y; xv[4 * j + 2] = t.z; xv[4 * j + 3] = t.w; s1 += (t.x + t.y) + (t.z + t.w); }
        const float mu1 = wave_sum(s1) * (1.0f / 1024.0f);
        float q1 = 0.f;
#pragma unroll
        for (int i = 0; i < 16; ++i) { xv[i] -= mu1; q1 += xv[i] * xv[i]; }
        const float rstd1 = 1.0f / sqrtf(wave_sum(q1) * (1.0f / 1024.0f) + LN_EPS);
#pragma unroll
        for (int j = 0; j < 4; ++j) {
            const float4 g4 = *(const float4*)(p.ln1_g + lane * 16 + j * 4), b4 = *(const float4*)(p.ln1_b + lane * 16 + j * 4);
            xv[4 * j] = xv[4 * j] * rstd1 * g4.x + b4.x; xv[4 * j + 1] = xv[4 * j + 1] * rstd1 * g4.y + b4.y; xv[4 * j + 2] = xv[4 * j + 2] * rstd1 * g4.z + b4.z; xv[4 * j + 3] = xv[4 * j + 3] * rstd1 * g4.w + b4.w;
        }
    }
    wave_sync();
    {
        uint4 hi, lo; unsigned* hp = (unsigned*)&hi; unsigned* lp = (unsigned*)&lo;
#pragma unroll
        for (int j = 0; j < 4; ++j) {
            const unsigned hw = pack4_fp8(xv[4 * j], xv[4 * j + 1], xv[4 * j + 2], xv[4 * j + 3]);
            const f32x2_ b0 = __builtin_amdgcn_cvt_pk_f32_fp8((int)hw, false), b1 = __builtin_amdgcn_cvt_pk_f32_fp8((int)hw, true);
            hp[j] = hw;
            lp[j] = pack4_fp8(16.f * (xv[4 * j] - b0[0]), 16.f * (xv[4 * j + 1] - b0[1]), 16.f * (xv[4 * j + 2] - b1[0]), 16.f * (xv[4 * j + 3] - b1[1]));
        }
        *(uint4*)(xh + lane * 16) = hi; *(uint4*)(xo + lane * 16) = lo;
    }
    idxl[lane] = PIDX[lane]; idxl[64 + lane] = PIDX[64 + lane];
    float* xs = (float*)(wl + 3072);
#pragma unroll
    for (int j = 0; j < 4; ++j) *(float4*)(xs + lane * 16 + j * 4) = make_float4(xv[4 * j], xv[4 * j + 1], xv[4 * j + 2], xv[4 * j + 3]);
    wave_sync();
    uint4 ufa[8], ufb[8];
    f32x4 ah = (f32x4){0.f, 0.f, 0.f, 0.f}, al = (f32x4){0.f, 0.f, 0.f, 0.f};
#define U_LOAD(DST, HH) { const unsigned char* ub_ = U8 + (size_t)idxl[((HH) >> 1) * 16 + lr] * 1024 + ((HH) & 1) * 512 + lq * 16; \
        _Pragma("unroll") for (int i = 0; i < 8; ++i) DST[i] = *(const uint4*)(ub_ + i * 64); }
#define U_HALF(SRC, HH) { \
        _Pragma("unroll") for (int i = 0; i < 8; ++i) { \
            if ((i & 1) == 0) asm volatile("" ::: "memory");        \
            const int off = ((HH) & 1) * 512 + i * 64 + lq * 16; \
            const long b0 = (long)(((unsigned long long)SRC[i].y << 32) | SRC[i].x), b1 = (long)(((unsigned long long)SRC[i].w << 32) | SRC[i].z); \
            const long h0 = *(const long*)(xh + off), h1 = *(const long*)(xh + off + 8), l0 = *(const long*)(xo + off), l1 = *(const long*)(xo + off + 8); \
            ah = __builtin_amdgcn_mfma_f32_16x16x32_fp8_fp8(h0, b0, ah, 0, 0, 0); ah = __builtin_amdgcn_mfma_f32_16x16x32_fp8_fp8(h1, b1, ah, 0, 0, 0); \
            al = __builtin_amdgcn_mfma_f32_16x16x32_fp8_fp8(l0, b0, al, 0, 0, 0); al = __builtin_amdgcn_mfma_f32_16x16x32_fp8_fp8(l1, b1, al, 0, 0, 0); } \
        if ((HH) & 1) { if (lq == 0) coefl[((HH) >> 1) * 16 + lr] = PG[((HH) >> 1) * 16 + lr] * gelu_tanh((ah[0] + al[0] * 0.0625f) * (1.0f / PEER_U_SCALE)) * (1.0f / PEER_V_SCALE); \
            ah = (f32x4){0.f, 0.f, 0.f, 0.f}; al = (f32x4){0.f, 0.f, 0.f, 0.f}; } }
    U_LOAD(ufa, 0)
#pragma unroll 1
    for (int hh = 0; hh < 16; hh += 2) {
        U_LOAD(ufb, hh + 1)
        U_HALF(ufa, hh)
        if (hh + 2 < 16) U_LOAD(ufa, hh + 2)
        U_HALF(ufb, hh + 1)
    }
#undef U_LOAD
#undef U_HALF
    wave_sync();
    float o[16];
#pragma unroll
    for (int i = 0; i < 16; ++i) o[i] = 0.f;
    uint4 vfa[8], vfb[8];
#define V_LOAD(DST, J) { _Pragma("unroll") for (int u = 0; u < 8; ++u) DST[u] = *(const uint4*)(V8 + (size_t)idxl[(J) + u] * 1024 + lane * 16); }
#define V_ACC(SRC, J) { _Pragma("unroll") for (int u = 0; u < 8; ++u) { asm volatile("" ::: "memory"); const float c_ = coefl[(J) + u]; \
            const unsigned w0_ = SRC[u].x, w1_ = SRC[u].y, w2_ = SRC[u].z, w3_ = SRC[u].w; \
            f32x2_ f0, f1; \
            f0 = __builtin_amdgcn_cvt_pk_f32_fp8((int)w0_, false); f1 = __builtin_amdgcn_cvt_pk_f32_fp8((int)w0_, true); o[0] += c_ * f0[0]; o[1] += c_ * f0[1]; o[2] += c_ * f1[0]; o[3] += c_ * f1[1]; \
            f0 = __builtin_amdgcn_cvt_pk_f32_fp8((int)w1_, false); f1 = __builtin_amdgcn_cvt_pk_f32_fp8((int)w1_, true); o[4] += c_ * f0[0]; o[5] += c_ * f0[1]; o[6] += c_ * f1[0]; o[7] += c_ * f1[1]; \
            f0 = __builtin_amdgcn_cvt_pk_f32_fp8((int)w2_, false); f1 = __builtin_amdgcn_cvt_pk_f32_fp8((int)w2_, true); o[8] += c_ * f0[0]; o[9] += c_ * f0[1]; o[10] += c_ * f1[0]; o[11] += c_ * f1[1]; \
            f0 = __builtin_amdgcn_cvt_pk_f32_fp8((int)w3_, false); f1 = __builtin_amdgcn_cvt_pk_f32_fp8((int)w3_, true); o[12] += c_ * f0[0]; o[13] += c_ * f0[1]; o[14] += c_ * f1[0]; o[15] += c_ * f1[1]; } }
    V_LOAD(vfa, 0)
#pragma unroll 1
    for (int j = 0; j < 128; j += 16) {
        V_LOAD(vfb, j + 8)
        V_ACC(vfa, j)
        if (j + 16 < 128) V_LOAD(vfa, j + 16)
        V_ACC(vfb, j + 8)
    }
#undef V_LOAD
#undef V_ACC
    float tv[16]; float s = 0.f;
#pragma unroll
    for (int j = 0; j < 4; ++j) { const float4 x4 = *(const float4*)(xs + lane * 16 + j * 4);
        tv[4 * j] = DN_ALPHA * x4.x + o[4 * j]; tv[4 * j + 1] = DN_ALPHA * x4.y + o[4 * j + 1]; tv[4 * j + 2] = DN_ALPHA * x4.z + o[4 * j + 2]; tv[4 * j + 3] = DN_ALPHA * x4.w + o[4 * j + 3]; }
#pragma unroll
    for (int i = 0; i < 16; ++i) s += tv[i];
    const float mu = wave_sum(s) * (1.0f / 1024.0f);
    float q = 0.f;
#pragma unroll
    for (int i = 0; i < 16; ++i) { const float d = tv[i] - mu; q += d * d; }
    const float rstd = 1.0f / sqrtf(wave_sum(q) * (1.0f / 1024.0f) + LN_EPS);
    float* y = p.out + O_Y + (size_t)row * 1024 + lane * 16;
#pragma unroll
    for (int j = 0; j < 4; ++j) {
        const float4 g4 = *(const float4*)(p.ln2_g + lane * 16 + j * 4), b4 = *(const float4*)(p.ln2_b + lane * 16 + j * 4);
        float4 yo;
        yo.x = (tv[4 * j] - mu) * rstd * g4.x + b4.x; yo.y = (tv[4 * j + 1] - mu) * rstd * g4.y + b4.y; yo.z = (tv[4 * j + 2] - mu) * rstd * g4.z + b4.z; yo.w = (tv[4 * j + 3] - mu) * rstd * g4.w + b4.w;
        *(float4*)(y + j * 4) = yo;
    }
}

constexpr int QN = 2;
struct AttnState { f32x4 ot[4][QN]; float m[QN]; float l[QN]; };

template <bool GUARD = true>
DEV void attn_block(const unsigned char* Ks, const unsigned char* VTs, const bf16x8 (&Qf)[QN][2], AttnState& A, const int mode, const int dq, const float* blut,
                    const unsigned selbit0, const unsigned selbit1, const bool slc, const int lr, const int lq, const int t0, const int ci0) {
    f32x4 sc[4][QN];
    bf16x8 kf[4][2];
#pragma unroll
    for (int kt = 0; kt < 4; ++kt) { kf[kt][0] = *(const bf16x8*)(Ks + (kt * 16 + lr) * 144 + lq * 16); kf[kt][1] = *(const bf16x8*)(Ks + (kt * 16 + lr) * 144 + 64 + lq * 16); }
#pragma unroll
    for (int kt = 0; kt < 4; ++kt) {
#pragma unroll
        for (int qi = 0; qi < QN; ++qi) {
            f32x4 a = (f32x4){0.f, 0.f, 0.f, 0.f};
            a = __builtin_amdgcn_mfma_f32_16x16x32_bf16(kf[kt][0], Qf[qi][0], a, 0, 0, 0);
            a = __builtin_amdgcn_mfma_f32_16x16x32_bf16(kf[kt][1], Qf[qi][1], a, 0, 0, 0);
            sc[kt][qi] = a;
        }
    }
    union VF { bf16x8 v; uint2 h[2]; };
    VF vfa[2][2];
#pragma unroll
    for (int dt = 0; dt < 2; ++dt)
#pragma unroll
        for (int ks = 0; ks < 2; ++ks) {
            vfa[dt][ks].h[0] = *(const uint2*)(VTs + (dt * 16 + lr) * 144 + (32 * ks + lq * 4) * 2);
            vfa[dt][ks].h[1] = *(const uint2*)(VTs + (dt * 16 + lr) * 144 + (32 * ks + 16 + lq * 4) * 2);
        }
    if (mode != 0 || slc) {
#pragma unroll
        for (int kt = 0; kt < 4; ++kt)
#pragma unroll
            for (int qi = 0; qi < QN; ++qi)
#pragma unroll
                for (int g = 0; g < 4; ++g) {
                    const int kl = kt * 16 + lq * 4 + g, ql = qi * 16 + lr;
                    float v = sc[kt][qi][g];
                    bool ok = true;
                    if (mode == 1 || mode == 2) { const int di = dq + ql - kl; v += blut[di < 0 ? 0 : di]; }
                    if (mode == 2) ok = kl <= ql + dq;
                    if (mode == 3) ok = kl > ql + dq - 512;
                    if (mode == 4) { const int ci = ci0 + kl, dist = t0 + ql - (16 * ci + 31); ok = (dist >= 0) && (ci < 127); if (dist >= 0 && dist < 192) v += blut[dist]; }
                    if (mode == 5) { const int dist = dq - ci0 * kl; ok = (kl < t0) && (dist >= 0); if (dist >= 0 && dist < 192) v += blut[dist]; }
                    if (slc) ok = ok && ((qi == 0 ? selbit0 : selbit1) != 0u);
                    sc[kt][qi][g] = ok ? v : NEGF;
                }
    }
    bf16x8 pf[QN][2];
#pragma unroll
    for (int qi = 0; qi < QN; ++qi) {
        float mb = fmaxf(fmaxf(sc[0][qi][0], sc[0][qi][1]), sc[0][qi][2]);
        mb = fmaxf(fmaxf(mb, sc[0][qi][3]), sc[1][qi][0]); mb = fmaxf(fmaxf(mb, sc[1][qi][1]), sc[1][qi][2]); mb = fmaxf(fmaxf(mb, sc[1][qi][3]), sc[2][qi][0]);
        mb = fmaxf(fmaxf(mb, sc[2][qi][1]), sc[2][qi][2]); mb = fmaxf(fmaxf(mb, sc[2][qi][3]), sc[3][qi][0]); mb = fmaxf(fmaxf(mb, sc[3][qi][1]), sc[3][qi][2]); mb = fmaxf(mb, sc[3][qi][3]);
        mb = fmaxf(mb, __shfl_xor(mb, 16)); mb = fmaxf(mb, __shfl_xor(mb, 32));
        const float mn = fmaxf(A.m[qi], mb);
        const float alpha = __builtin_amdgcn_exp2f(A.m[qi] - mn);
        A.m[qi] = mn;
        float rs = 0.f;
#pragma unroll
        for (int kt = 0; kt < 4; ++kt)
#pragma unroll
            for (int g = 0; g < 4; ++g) { const float v = sc[kt][qi][g]; const float e = (!GUARD || v > -1e29f) ? __builtin_amdgcn_exp2f(v - mn) : 0.f; sc[kt][qi][g] = e; rs += e; }
        A.l[qi] = A.l[qi] * alpha + rs;
#pragma unroll
        for (int dt = 0; dt < 4; ++dt) A.ot[dt][qi] = A.ot[dt][qi] * alpha;
#pragma unroll
        for (int ks = 0; ks < 2; ++ks) {
            union { bf16x8 v; unsigned u[4]; } pk;
            pk.u[0] = cvt_pk_bf16(sc[2 * ks][qi][0], sc[2 * ks][qi][1]); pk.u[1] = cvt_pk_bf16(sc[2 * ks][qi][2], sc[2 * ks][qi][3]);
            pk.u[2] = cvt_pk_bf16(sc[2 * ks + 1][qi][0], sc[2 * ks + 1][qi][1]); pk.u[3] = cvt_pk_bf16(sc[2 * ks + 1][qi][2], sc[2 * ks + 1][qi][3]);
            pf[qi][ks] = pk.v;
        }
    }
    VF vfb[2][2];
#pragma unroll
    for (int dt = 0; dt < 2; ++dt)
#pragma unroll
        for (int ks = 0; ks < 2; ++ks) {
            vfb[dt][ks].h[0] = *(const uint2*)(VTs + ((dt + 2) * 16 + lr) * 144 + (32 * ks + lq * 4) * 2);
            vfb[dt][ks].h[1] = *(const uint2*)(VTs + ((dt + 2) * 16 + lr) * 144 + (32 * ks + 16 + lq * 4) * 2);
        }
#pragma unroll
    for (int dt = 0; dt < 2; ++dt)
#pragma unroll
        for (int ks = 0; ks < 2; ++ks)
#pragma unroll
            for (int qi = 0; qi < QN; ++qi) A.ot[dt][qi] = __builtin_amdgcn_mfma_f32_16x16x32_bf16(vfa[dt][ks].v, pf[qi][ks], A.ot[dt][qi], 0, 0, 0);
#pragma unroll
    for (int dt = 0; dt < 2; ++dt)
#pragma unroll
        for (int ks = 0; ks < 2; ++ks)
#pragma unroll
            for (int qi = 0; qi < QN; ++qi) A.ot[dt + 2][qi] = __builtin_amdgcn_mfma_f32_16x16x32_bf16(vfb[dt][ks].v, pf[qi][ks], A.ot[dt + 2][qi], 0, 0, 0);
}

DEV void nsa_prompt_item(const Params& p, const int b, const int hkv, const int q32, unsigned char* lds) {
    int tid_ = threadIdx.x; asm volatile("" : "+v"(tid_));
    const int tid = tid_, lane = tid & 63, g = tid >> 6, lr = lane & 15, lq = lane >> 4;
    const int hq = hkv * 4 + g, t0 = q32 * 32, kd = t0 >> 6;
    unsigned char* Ks = lds; unsigned char* VTs = lds + 9216;
    float* biasl = (float*)(lds + 36864); float* psl = (float*)(lds + 39936); unsigned* selm = (unsigned*)(lds + 44160); unsigned* misc = (unsigned*)(lds + 44288);
    const bf16_t* ZB = (const bf16_t*)(p.ws + WS_ZB);
    const bf16_t* VTS = (const bf16_t*)(p.ws + WS_VTS) + (size_t)(b * 2 + hkv) * 64 * 2048;
    const bf16_t* VTW = (const bf16_t*)(p.ws + WS_VTW) + (size_t)(b * 2 + hkv) * 64 * 2048;
    const bf16_t* KCB = (const bf16_t*)(p.ws + WS_KCB) + (size_t)(b * 2 + hkv) * 128 * 64;
    const bf16_t* VTC = (const bf16_t*)(p.ws + WS_VTC) + (size_t)(b * 2 + hkv) * 64 * 128;
    const float* Z = (const float*)(p.ws + WS_Z);
    float* NOUTF = (float*)(p.ws + WS_NOUTF);
    bf16_t* NOUTB = (bf16_t*)(p.ws + WS_NOUTB);
    __syncthreads();
    for (int i = tid; i < 4 * 192; i += 256) { const int gg = i / 192, d = i % 192; biasl[i] = (p.rel_bias[rel_bucket(d) * 8 + hkv * 4 + gg] - p.rel_bias[31 * 8 + hkv * 4 + gg]) * LOG2E; }
    for (int i = tid; i < 32 * 33; i += 256) psl[i] = 0.f;
    if (tid < 32) selm[tid] = 0u;
    if (tid == 0) misc[0] = 0u;
    const float* blut = biasl + g * 192;
    bf16x8 Qf[QN][2];
#pragma unroll
    for (int qi = 0; qi < QN; ++qi)
#pragma unroll
        for (int kk = 0; kk < 2; ++kk) Qf[qi][kk] = *(const bf16x8*)(ZB + (size_t)(b * 2048 + t0 + qi * 16 + lr) * IN_DIM + C_Q + hq * 64 + kk * 32 + lq * 8);

    unsigned msk0 = 0u, msk1 = 0u;
    uint4 trk0, trk1, trv0, trv1;
    int* blist = (int*)(lds + 44544);
    auto load_tiles = [&](int kind, int kb) __attribute__((always_inline)) {
#pragma unroll
        for (int i = 0; i < 2; ++i) {
            const int id = tid + 256 * i, row = id >> 3, ch = id & 7;
            uint4 rk, rv;
            if (kind == 0) { rk = *(const uint4*)(KCB + (size_t)(kb * 64 + row) * 64 + ch * 8); rv = *(const uint4*)(VTC + (size_t)row * 128 + kb * 64 + ch * 8); }
            else {
                rk = *(const uint4*)(ZB + (size_t)(b * 2048 + kb * 64 + row) * IN_DIM + (kind == 1 ? C_KS : C_KW) + hkv * 64 + ch * 8);
                rv = *(const uint4*)((kind == 1 ? VTS : VTW) + (size_t)row * 2048 + kb * 64 + ch * 8);
            }
            if (i == 0) { trk0 = rk; trv0 = rv; } else { trk1 = rk; trv1 = rv; }
        }
    };
    auto store_tiles = [&]() __attribute__((always_inline)) {
#pragma unroll
        for (int i = 0; i < 2; ++i) { const int id = tid + 256 * i, row = id >> 3, ch = id & 7; *(uint4*)(Ks + row * 144 + ch * 16) = (i == 0 ? trk0 : trk1); *(uint4*)(VTs + row * 144 + ch * 16) = (i == 0 ? trv0 : trv1); }
    };
    auto store_tiles_to = [&](const int off) __attribute__((always_inline)) {
#pragma unroll
        for (int i = 0; i < 2; ++i) { const int id = tid + 256 * i, row = id >> 3, ch = id & 7; *(uint4*)(Ks + off + row * 144 + ch * 16) = (i == 0 ? trk0 : trk1); *(uint4*)(VTs + off + row * 144 + ch * 16) = (i == 0 ? trv0 : trv1); }
    };
    auto run_blocks = [&](const int kind, const int nb, const bool slc, AttnState& A) __attribute__((always_inline)) {
        load_tiles(kind, blist[0]);
        __syncthreads();
        store_tiles_to(0);
        if (nb > 1) load_tiles(kind, blist[1]);
        __syncthreads();
        for (int i = 0; i < nb; ++i) {
            const int kb = blist[i], dq = t0 - kb * 64, cur = (i & 1) * 18432;
            if (i + 1 < nb) { store_tiles_to(18432 - cur); if (i + 2 < nb) load_tiles(kind, blist[i + 2]); }
            const int mode = (kb == kd) ? 2 : ((kb >= kd - 2) ? 1 : ((kind == 2 && dq + 31 >= 512) ? 3 : 0));
            attn_block<false>(Ks + cur, VTs + cur, Qf, A, mode, dq, blut, slc ? ((msk0 >> kb) & 1u) : 1u, slc ? ((msk1 >> kb) & 1u) : 1u, slc, lr, lq, t0, 0);
            __syncthreads();
        }
    };
    auto reset = [&](AttnState& A) __attribute__((always_inline)) {
#pragma unroll
        for (int qi = 0; qi < QN; ++qi) { A.m[qi] = NEGF; A.l[qi] = 0.f;
#pragma unroll
            for (int dt = 0; dt < 4; ++dt) A.ot[dt][qi] = (f32x4){0.f, 0.f, 0.f, 0.f}; }
    };
    auto finish = [&](AttnState& A, int br) __attribute__((always_inline)) {
#pragma unroll
        for (int qi = 0; qi < QN; ++qi) {
            float lt = A.l[qi]; lt += __shfl_xor(lt, 16); lt += __shfl_xor(lt, 32);
            const float sc = (lt > 0.f) ? sigmoidf_(Z[(size_t)(b * 2048 + t0 + qi * 16 + lr) * 32 + 8 + br * 8 + hq]) / lt : 0.f;
            const size_t row = (size_t)(b * 2048 + t0 + qi * 16 + lr);
#pragma unroll
            for (int dt = 0; dt < 4; ++dt) {
                const int col = hq * 64 + dt * 16 + lq * 4;
                f32x4 v = A.ot[dt][qi] * sc;
                if (br > 0) v = v + *(const f32x4*)(NOUTF + row * 512 + col);
                if (br < 2) *(f32x4*)(NOUTF + row * 512 + col) = v; else store_bf16x4(NOUTB + row * 512 + col, v);
            }
        }
    };

    AttnState A;
    const int ncb = ((t0 >> 4) >= 64) ? 2 : 1;
    reset(A);
    load_tiles(0, 0);
    for (int kb = 0; kb < ncb; ++kb) {
        __syncthreads(); store_tiles(); __syncthreads();
        if (kb + 1 < ncb) load_tiles(0, kb + 1);
        attn_block(Ks, VTs, Qf, A, 4, 0, blut, 1u, 1u, false, lr, lq, t0, kb * 64);
    }
    finish(A, 0);
    {
        float linv[QN];
#pragma unroll
        for (int qi = 0; qi < QN; ++qi) { float lt = A.l[qi]; lt += __shfl_xor(lt, 16); lt += __shfl_xor(lt, 32); linv[qi] = (lt > 0.f) ? 1.0f / lt : 0.f; }
        for (int kb = 0; kb < ncb; ++kb) {
            if (ncb > 1) { load_tiles(0, kb); __syncthreads(); store_tiles(); __syncthreads(); }
#pragma unroll
            for (int kt = 0; kt < 4; ++kt) {
                const bf16x8 k0 = *(const bf16x8*)(Ks + (kt * 16 + lr) * 144 + lq * 16), k1 = *(const bf16x8*)(Ks + (kt * 16 + lr) * 144 + 64 + lq * 16);
#pragma unroll
                for (int qi = 0; qi < QN; ++qi) {
                    f32x4 a = (f32x4){0.f, 0.f, 0.f, 0.f};
                    a = __builtin_amdgcn_mfma_f32_16x16x32_bf16(k0, Qf[qi][0], a, 0, 0, 0);
                    a = __builtin_amdgcn_mfma_f32_16x16x32_bf16(k1, Qf[qi][1], a, 0, 0, 0);
                    float pr[4];
#pragma unroll
                    for (int gg = 0; gg < 4; ++gg) {
                        const int ci = kb * 64 + kt * 16 + lq * 4 + gg, ql = qi * 16 + lr, dist = t0 + ql - (16 * ci + 31);
                        float v = a[gg];
                        if (dist >= 0 && dist < 192) v += blut[dist];
                        pr[gg] = (dist >= 0 && ci < 127) ? __builtin_amdgcn_exp2f(v - A.m[qi]) * linv[qi] : 0.f;
                    }
                    const int blk = kb * 16 + kt * 4 + lq, ql = qi * 16 + lr;
                    atomicAdd(&psl[ql * 33 + blk], 2.0f * (pr[0] + pr[1] + pr[2]) + pr[3]);
                    atomicAdd(&psl[ql * 33 + blk + 1], pr[3]);
                }
            }
        }
    }
    __syncthreads();
    {
        const int ql = tid >> 3, part = tid & 7, tq = t0 + ql, cur = tq >> 6;
        float scv[32];
#pragma unroll
        for (int j = 0; j < 32; ++j) {
            const bool causal = j * 64 <= tq, forced = (j == 0) || (j == cur) || (j == cur - 1);
            scv[j] = causal ? (forced ? 1e4f : psl[ql * 33 + j]) : NEGF;
        }
        unsigned mbits = 0u;
#pragma unroll
        for (int jj = 0; jj < 4; ++jj) {
            const int j = part * 4 + jj;
            float my = NEGF;
#pragma unroll
            for (int k = 0; k < 32; ++k) my = (k == j) ? scv[k] : my;
            int rank = 0;
#pragma unroll
            for (int k = 0; k < 32; ++k) rank += ((scv[k] > my) || (scv[k] == my && k < j)) ? 1 : 0;
            if (rank < 16 && j * 64 <= tq) mbits |= (1u << j);
        }
        atomicOr(&selm[ql], mbits);
        atomicOr(&misc[0], mbits);
    }
    __syncthreads();
    msk0 = selm[lr]; msk1 = selm[16 + lr];
    const unsigned anym = misc[0];
    reset(A);
    {
        if (tid == 0) { int n = 0; blist[n++] = kd; for (int j = 0; j < kd; ++j) if ((anym >> j) & 1u) blist[n++] = j; blist[40] = n; }
        __syncthreads();
        run_blocks(1, blist[40], true, A);
    }
    finish(A, 1);
    reset(A);
    {
        const int klo = (t0 >= 511) ? ((t0 - 511) >> 6) : 0;
        __syncthreads();
        if (tid < 33 && tid <= kd - klo) blist[tid] = kd - tid;
        __syncthreads();
        run_blocks(2, kd - klo + 1, false, A);
    }
    finish(A, 2);
}

DEV void nsa_sample_item(const Params& p, const int b, const int hkv, unsigned char* lds) {
    int tid_ = threadIdx.x; asm volatile("" : "+v"(tid_));
    const int tid = tid_, lane = tid & 63, g = tid >> 6, lr = lane & 15, lq = lane >> 4;
    const int hq = hkv * 4 + g;
    unsigned char* Ks = lds; unsigned char* VTs = lds + 9216;
    float* biasl = (float*)(lds + 18432); float* psl = (float*)(lds + 21504); int* sell = (int*)(lds + 29952); float* scl = (float*)(lds + 30720);
    const bf16_t* ZB = (const bf16_t*)(p.ws + WS_ZB);
    const float* zgate = (const float*)(p.ws + WS_Z) + (size_t)(NP + b) * 32 + 8;
    const bf16_t* zbrow = ZB + (size_t)(NP + b) * IN_DIM;
    const bf16_t* KCSB = (const bf16_t*)(p.ws + WS_KCSB) + (size_t)(b * 2 + hkv) * 1024 * 64;
    const bf16_t* VTCS = (const bf16_t*)(p.ws + WS_VTCS) + (size_t)(b * 2 + hkv) * 64 * 1024;
    bf16_t* NOUTB = (bf16_t*)(p.ws + WS_NOUTB);
    __syncthreads();
    for (int i = tid; i < 4 * 192; i += 256) { const int gg = i / 192, d = i % 192; biasl[i] = (p.rel_bias[rel_bucket(d) * 8 + hkv * 4 + gg] - p.rel_bias[31 * 8 + hkv * 4 + gg]) * LOG2E; }
    for (int i = tid; i < 260; i += 256) psl[i] = 0.f;
    const float* blut = biasl + g * 192;
    bf16x8 Qf[QN][2];
#pragma unroll
    for (int kk = 0; kk < 2; ++kk) { Qf[0][kk] = *(const bf16x8*)(ZB + (size_t)(NP + b) * IN_DIM + C_Q + hq * 64 + kk * 32 + lq * 8); Qf[1][kk] = Qf[0][kk]; }
    AttnState A;
    auto reset = [&](AttnState& S_) __attribute__((always_inline)) {
#pragma unroll
        for (int qi = 0; qi < QN; ++qi) { S_.m[qi] = NEGF; S_.l[qi] = 0.f;
#pragma unroll
            for (int dt = 0; dt < 4; ++dt) S_.ot[dt][qi] = (f32x4){0.f, 0.f, 0.f, 0.f}; }
    };
    f32x4 res[4];
#pragma unroll
    for (int dt = 0; dt < 4; ++dt) res[dt] = (f32x4){0.f, 0.f, 0.f, 0.f};
    auto finish = [&](AttnState& S_, int br) __attribute__((always_inline)) {
        float lt = S_.l[0]; lt += __shfl_xor(lt, 16); lt += __shfl_xor(lt, 32);
        const float sc = (lt > 0.f) ? sigmoidf_(zgate[br * 8 + hq]) / lt : 0.f;
#pragma unroll
        for (int dt = 0; dt < 4; ++dt) res[dt] = res[dt] + S_.ot[dt][0] * sc;
    };
    uint4 trk0, trk1, trv0, trv1;
    auto load_cmp = [&](int kb) __attribute__((always_inline)) {
#pragma unroll
        for (int i = 0; i < 2; ++i) {
            const int id = tid + 256 * i, row = id >> 3, ch = id & 7;
            const uint4 rk = *(const uint4*)(KCSB + (size_t)(kb * 64 + row) * 64 + ch * 8), rv = *(const uint4*)(VTCS + (size_t)row * 1024 + kb * 64 + ch * 8);
            if (i == 0) { trk0 = rk; trv0 = rv; } else { trk1 = rk; trv1 = rv; }
        }
    };
    auto store_cmp = [&]() __attribute__((always_inline)) {
#pragma unroll
        for (int i = 0; i < 2; ++i) { const int id = tid + 256 * i, row = id >> 3, ch = id & 7; *(uint4*)(Ks + row * 144 + ch * 16) = (i == 0 ? trk0 : trk1); *(uint4*)(VTs + row * 144 + ch * 16) = (i == 0 ? trv0 : trv1); }
    };
    reset(A);
    load_cmp(0);
    for (int kb = 0; kb < 16; ++kb) {
        __syncthreads(); store_cmp(); __syncthreads();
        if (kb + 1 < 16) load_cmp(kb + 1);
        attn_block<false>(Ks, VTs, Qf, A, 5, PAST - 31 - 16 * (kb * 64), blut, 1u, 1u, false, lr, lq, (kb == 15) ? 63 : 64, 16);
    }
    finish(A, 0);
    {
        float lt = A.l[0]; lt += __shfl_xor(lt, 16); lt += __shfl_xor(lt, 32);
        const float linv = (lt > 0.f) ? 1.0f / lt : 0.f;
        for (int kb = 0; kb < 16; ++kb) {
            load_cmp(kb); __syncthreads(); store_cmp(); __syncthreads();
#pragma unroll
            for (int kt = 0; kt < 4; ++kt) {
                const bf16x8 k0 = *(const bf16x8*)(Ks + (kt * 16 + lr) * 144 + lq * 16), k1 = *(const bf16x8*)(Ks + (kt * 16 + lr) * 144 + 64 + lq * 16);
                f32x4 a = (f32x4){0.f, 0.f, 0.f, 0.f};
                a = __builtin_amdgcn_mfma_f32_16x16x32_bf16(k0, Qf[0][0], a, 0, 0, 0);
                a = __builtin_amdgcn_mfma_f32_16x16x32_bf16(k1, Qf[0][1], a, 0, 0, 0);
                float pr[4];
#pragma unroll
                for (int gg = 0; gg < 4; ++gg) {
                    const int ci = kb * 64 + kt * 16 + lq * 4 + gg, dist = PAST - 31 - 16 * ci;
                    float v = a[gg];
                    if (dist >= 0 && dist < 192) v += blut[dist];
                    pr[gg] = (ci < 1023) ? __builtin_amdgcn_exp2f(v - A.m[0]) * linv : 0.f;
                }
                if (lr == 0) {
                    const int blk = kb * 16 + kt * 4 + lq;
                    atomicAdd(&psl[blk], 2.0f * (pr[0] + pr[1] + pr[2]) + pr[3]);
                    atomicAdd(&psl[blk + 1], pr[3]);
                }
            }
        }
    }
    __syncthreads();
    for (int j = tid; j < 257; j += 256) scl[j] = (j == 0 || j == 256 || j == 255) ? 1e4f : psl[j];
    __syncthreads();
    for (int j = tid; j < 257; j += 256) {
        const float my = scl[j];
        int rank = 0;
        for (int k = 0; k < 257; ++k) { const float o2 = scl[k]; rank += ((o2 > my) || (o2 == my && k < j)) ? 1 : 0; }
        if (rank < 16) sell[rank] = j;
    }
    __syncthreads();
    uint4 rk0, rk1; unsigned rv0, rv1, rv2, rv3, rv4, rv5, rv6, rv7;
    auto load_rows = [&](const float* src, const bf16_t* srcb) __attribute__((always_inline)) {
        const int seg = tid & 3;
        if (srcb) {
            const bf16_t* kp = srcb + hkv * 64 + seg * 16; const bf16_t* vp = kp + 128;
            rk0 = *(const uint4*)kp; rk1 = *(const uint4*)(kp + 8);
            const uint4 v0 = *(const uint4*)vp, v1 = *(const uint4*)(vp + 8);
            rv0 = v0.x; rv1 = v0.y; rv2 = v0.z; rv3 = v0.w; rv4 = v1.x; rv5 = v1.y; rv6 = v1.z; rv7 = v1.w;
        } else {
            const bool nz = src != nullptr;
            const float* kp = (nz ? src : p.state_win) + hkv * 64 + seg * 16; const float* vp = kp + 128;
            const float4 a0 = *(const float4*)kp, a1 = *(const float4*)(kp + 4), a2 = *(const float4*)(kp + 8), a3 = *(const float4*)(kp + 12);
            const float4 c0 = *(const float4*)vp, c1 = *(const float4*)(vp + 4), c2 = *(const float4*)(vp + 8), c3 = *(const float4*)(vp + 12);
            const unsigned mk = nz ? 0xffffffffu : 0u;
            rk0.x = cvt_pk_bf16(a0.x, a0.y) & mk; rk0.y = cvt_pk_bf16(a0.z, a0.w) & mk; rk0.z = cvt_pk_bf16(a1.x, a1.y) & mk; rk0.w = cvt_pk_bf16(a1.z, a1.w) & mk;
            rk1.x = cvt_pk_bf16(a2.x, a2.y) & mk; rk1.y = cvt_pk_bf16(a2.z, a2.w) & mk; rk1.z = cvt_pk_bf16(a3.x, a3.y) & mk; rk1.w = cvt_pk_bf16(a3.z, a3.w) & mk;
            rv0 = cvt_pk_bf16(c0.x, c0.y) & mk; rv1 = cvt_pk_bf16(c0.z, c0.w) & mk; rv2 = cvt_pk_bf16(c1.x, c1.y) & mk; rv3 = cvt_pk_bf16(c1.z, c1.w) & mk;
            rv4 = cvt_pk_bf16(c2.x, c2.y) & mk; rv5 = cvt_pk_bf16(c2.z, c2.w) & mk; rv6 = cvt_pk_bf16(c3.x, c3.y) & mk; rv7 = cvt_pk_bf16(c3.z, c3.w) & mk;
        }
    };
    auto store_rows = [&]() __attribute__((always_inline)) {
        const int kl = tid >> 2, seg = tid & 3;
        *(uint4*)(Ks + kl * 144 + seg * 32) = rk0; *(uint4*)(Ks + kl * 144 + seg * 32 + 16) = rk1;
#define VT_PUT(i_, w_) { *(bf16_t*)(VTs + (seg * 16 + (i_)) * 144 + kl * 2) = (bf16_t)((w_) & 0xffffu); *(bf16_t*)(VTs + (seg * 16 + (i_) + 1) * 144 + kl * 2) = (bf16_t)((w_) >> 16); }
        VT_PUT(0, rv0) VT_PUT(2, rv1) VT_PUT(4, rv2) VT_PUT(6, rv3) VT_PUT(8, rv4) VT_PUT(10, rv5) VT_PUT(12, rv6) VT_PUT(14, rv7)
#undef VT_PUT
    };
    auto slc_row = [&](int blk) __attribute__((always_inline)) -> const float* {
        const int kl = tid >> 2;
        if (blk < 256) { const int page = p.page_table[b * 128 + (blk >> 1)]; return p.cache_slc + ((size_t)page * 128 + (blk & 1) * 64 + kl) * 256; }
        return nullptr;
    };
    auto slc_rowb = [&](int blk) __attribute__((always_inline)) -> const bf16_t* { return (blk == 256 && (tid >> 2) == 0) ? zbrow + C_KS : nullptr; };
    reset(A);
    load_rows(slc_row(sell[0]), slc_rowb(sell[0]));
    for (int si = 0; si < 16; ++si) {
        const int blk = sell[si];
        __syncthreads(); store_rows(); __syncthreads();
        if (si + 1 < 16) load_rows(slc_row(sell[si + 1]), slc_rowb(sell[si + 1]));
        attn_block<false>(Ks, VTs, Qf, A, 5, PAST - blk * 64, blut, 1u, 1u, false, lr, lq, (blk == 256) ? 1 : 64, 1);
    }
    finish(A, 1);
    auto win_row = [&](int wb) __attribute__((always_inline)) -> const float* {
        const int j = 1 + wb * 64 + (tid >> 2);
        return (j < 512) ? p.state_win + ((size_t)b * 512 + j) * 256 : nullptr;
    };
    auto win_rowb = [&](int wb) __attribute__((always_inline)) -> const bf16_t* { return (1 + wb * 64 + (tid >> 2) == 512) ? zbrow + C_KW : nullptr; };
    reset(A);
    load_rows(win_row(0), win_rowb(0));
    for (int wb = 0; wb < 8; ++wb) {
        __syncthreads(); store_rows(); __syncthreads();
        if (wb + 1 < 8) load_rows(win_row(wb + 1), win_rowb(wb + 1));
        attn_block<false>(Ks, VTs, Qf, A, 5, 511 - wb * 64, blut, 1u, 1u, false, lr, lq, 64, 1);
    }
    finish(A, 2);
    if (lr == 0) {
#pragma unroll
        for (int dt = 0; dt < 4; ++dt) store_bf16x4(NOUTB + (size_t)(NP + b) * 512 + hq * 64 + dt * 16 + lq * 4, res[dt]);
    }
}

DEV int otid() { int t = threadIdx.x; asm volatile("" : "+v"(t)); return t; }
#define Z ((float*)(p.ws + WS_Z))
#define QK ((float*)(p.ws + WS_QK))
#define HRAW ((float*)(p.ws + WS_HRAW))
#define MOUTB ((bf16_t*)(p.ws + WS_MOUTB))
#define NOUTB ((bf16_t*)(p.ws + WS_NOUTB))
#define HIDPB ((bf16_t*)(p.ws + WS_HIDPB))
#define HIDSB ((bf16_t*)(p.ws + WS_HIDSB))
#define KCS ((float*)(p.ws + WS_KCS))
#define MIX ((float*)(p.ws + WS_MIX))
#define MIXB ((bf16_t*)(p.ws + WS_MIXB))
#define T1 ((float*)(p.ws + WS_T1))
#define X1 ((float*)(p.ws + WS_X1))
#define X1B ((bf16_t*)(p.ws + WS_X1B))
#define QPB ((bf16_t*)(p.ws + WS_QPB))
#define S ((float*)(p.ws + WS_S))
#define CONVB ((bf16_t*)(p.ws + WS_CONVB))
#define XB ((bf16_t*)(p.ws + WS_XB))
#define WIN_T ((bf16_t*)(p.ws + WS_WIN_T))
#define WUPM_T ((bf16_t*)(p.ws + WS_WUPM_T))
#define WUPN_T ((bf16_t*)(p.ws + WS_WUPN_T))
#define WOUT_T ((bf16_t*)(p.ws + WS_WOUT_T))
#define PWQ_T ((bf16_t*)(p.ws + WS_PWQ_T))
#define WQK_T ((bf16_t*)(p.ws + WS_WQK_T))
#define W1_T ((bf16_t*)(p.ws + WS_W1_T))
#define W2_T ((bf16_t*)(p.ws + WS_W2_T))
#define SUBK ((bf16_t*)(p.ws + WS_SUBK))
#define ZB ((bf16_t*)(p.ws + WS_ZB))
#define VTS ((bf16_t*)(p.ws + WS_VTS))
#define VTW ((bf16_t*)(p.ws + WS_VTW))
#define KCB ((bf16_t*)(p.ws + WS_KCB))
#define VTC ((bf16_t*)(p.ws + WS_VTC))
__global__ void __launch_bounds__(NTHREADS, 2) fwd_kernel(Params p) {
    extern __shared__ __attribute__((aligned(16))) unsigned char smem[];
    if (threadIdx.x == 0) { *(uint4*)smem = make_uint4(0u, 0u, 0u, 0u); }
    __syncthreads();
    XcdBarrier bar = xcd_barrier_post((unsigned*)(p.ws + WS_BAR), (volatile LAS unsigned*)smem);
    float* lds = (float*)(smem + 16);
    unsigned char* ldsb = smem + 16;
#define TID_ (otid())
#define LANE_ (otid() & 63)
#define WV_ (otid() >> 6)
#define GW_ ((int)(blockIdx.x * 4 + (otid() >> 6)))
#define GT_ ((size_t)blockIdx.x * NTHREADS + otid())
    const int nw = gridDim.x * 4;
    const size_t nt = (size_t)gridDim.x * NTHREADS;


    {
        for (size_t id = GT_; id < (size_t)MP * 128; id += nt) {
            const int row = (int)(id >> 7), k8 = (int)(id & 127) * 8;
            float f[8];
            if (row < NR) {
                const float* s = (row < NP ? p.x_prompt + (size_t)row * 1024 : p.x_sample + (size_t)(row - NP) * 1024) + k8;
                const float4 a = *(const float4*)s, b = *(const float4*)(s + 4);
                f[0] = a.x; f[1] = a.y; f[2] = a.z; f[3] = a.w; f[4] = b.x; f[5] = b.y; f[6] = b.z; f[7] = b.w;
            } else {
#pragma unroll
                for (int i = 0; i < 8; ++i) f[i] = 0.f;
            }
            *(uint4*)(XB + (size_t)row * 1024 + k8) = pack8(f);
        }
        transpose_to_bf16(p.w_in, 1024, IN_DIM, WIN_T, GT_, nt);
        transpose_to_bf16(p.w_up_m, 512, 1024, WUPM_T, GT_, nt);
        transpose_to_bf16(p.w_up_n, 512, 1024, WUPN_T, GT_, nt);
        transpose_to_bf16(p.w_out, 1024, 1024, WOUT_T, GT_, nt);
        transpose_to_bf16(p.peer_wq, 1024, 2048, PWQ_T, GT_, nt);
        for (int h = 0; h < 4; ++h) {
            transpose_to_bf16(p.wq + (size_t)h * 16384, 128, 128, WQK_T + (size_t)(h * 256) * 128, GT_, nt);
            transpose_to_bf16(p.wk + (size_t)h * 16384, 128, 128, WQK_T + (size_t)(h * 256 + 128) * 128, GT_, nt);
        }
        for (size_t id = GT_; id < (size_t)2 * 128 * 128; id += nt) {
            const int k8 = (int)(id & 127) * 8, np = (int)((id >> 7) & 127), c = (int)(id >> 14);
            const int pp = np >> 6, o = np & 63, r = k8 >> 6, d = k8 & 63;
            float f[8];
#pragma unroll
            for (int e = 0; e < 8; ++e) f[e] = p.cmp_w1[((size_t)c * 2048 + (pp * 16 + r) * 64 + d + e) * 64 + o];
            *(uint4*)(W1_T + ((size_t)c * 128 + np) * 1024 + k8) = pack8(f);
        }
        if (GT_ < 128) {
            const int c = (int)GT_ >> 6, o = (int)GT_ & 63;
            float a = 0.f;
            for (int k = 0; k < 2048; ++k) a += p.cmp_pe[c * 2048 + k] * p.cmp_w1[((size_t)c * 2048 + k) * 64 + o];
            ((float*)(p.ws + WS_PESUM))[GT_] = a;
        }
        for (int c = 0; c < 2; ++c) transpose_to_bf16(p.cmp_w2 + (size_t)c * 4096, 64, 64, W2_T + (size_t)c * 4096, GT_, nt);
        for (size_t id = GT_; id < (size_t)2 * 128 * 128 / 8; id += nt) {
            float f[8];
#pragma unroll
            for (int i = 0; i < 8; ++i) f[i] = p.peer_sub[id * 8 + i];
            *(uint4*)(SUBK + id * 8) = pack8(f);
        }
        for (size_t id = GT_; id < (size_t)16384 * 64; id += nt) {
            const float* su = p.peer_u + id * 16; const float* sv = p.peer_v + id * 16;
            uint4 ou, ov; unsigned* pu = (unsigned*)&ou; unsigned* pv = (unsigned*)&ov;
#pragma unroll
            for (int j = 0; j < 4; ++j) {
                const float4 a4 = *(const float4*)(su + j * 4), c4 = *(const float4*)(sv + j * 4);
                pu[j] = pack4_fp8(a4.x * PEER_U_SCALE, a4.y * PEER_U_SCALE, a4.z * PEER_U_SCALE, a4.w * PEER_U_SCALE);
                pv[j] = pack4_fp8(c4.x * PEER_V_SCALE, c4.y * PEER_V_SCALE, c4.z * PEER_V_SCALE, c4.w * PEER_V_SCALE);
            }
            *(uint4*)(p.ws + WS_U8 + id * 16) = ou; *(uint4*)(p.ws + WS_V8 + id * 16) = ov;
        }
        for (size_t i = GT_; i < (size_t)BS * 511 * 256; i += nt) {
            const int j = (int)(i & 255); const int wv = (int)((i >> 8) % 511); const int b = (int)((i >> 8) / 511);
            p.out[O_WINS + ((size_t)b * 512 + wv) * 256 + j] = p.state_win[((size_t)b * 512 + wv + 1) * 256 + j];
        }
        for (size_t i = GT_; i < (size_t)BS * 2 * 512; i += nt) {
            const int ch = (int)(i & 511); const int jj = (int)((i >> 9) & 1); const int b = (int)(i >> 10);
            p.out[O_CVS + ((size_t)b * 3 + jj) * 512 + ch] = p.state_conv[((size_t)b * 3 + jj + 1) * 512 + ch];
        }
    }
    xcd_barrier(bar);

    gemm_glds_xcd(NR, IN_DIM, 1024,
        [&](int r, int k) { return XB + (size_t)r * 1024 + k; },
        [&](int n, int k) { return WIN_T + (size_t)n * 1024 + k; },
        [&](int r, int c0, f32x4 v) {
            if (c0 >= C_I && c0 < C_Q) *(f32x4*)(Z + (size_t)r * 32 + (c0 - C_I)) = v;
            else if (c0 >= C_G && c0 < C_GM) *(f32x4*)(Z + (size_t)r * 32 + 8 + (c0 - C_G)) = v;
            store_bf16x4(ZB + (size_t)r * IN_DIM + c0, (c0 >= C_Q && c0 < C_KC) ? v * (0.125f * LOG2E) : v);
            if (r < NP && ((c0 >= C_KS + 128 && c0 < C_KW) || (c0 >= C_KW + 128 && c0 < C_G))) {
                const bool isw = c0 >= C_KW; const int cc = c0 - (isw ? C_KW : C_KS) - 128;
                bf16_t* vt = (isw ? VTW : VTS) + ((size_t)((r >> 11) * 2) * 64 + cc) * 2048 + (r & 2047);
                const unsigned w0 = cvt_pk_bf16(v[0], v[1]), w1 = cvt_pk_bf16(v[2], v[3]);
                vt[0] = (bf16_t)(w0 & 0xffffu); vt[2048] = (bf16_t)(w0 >> 16); vt[4096] = (bf16_t)(w1 & 0xffffu); vt[6144] = (bf16_t)(w1 >> 16);
            }
            if (r < NP && c0 >= C_V && c0 < C_O) {
                bf16_t* vt = (bf16_t*)(p.ws + WS_VTM) + ((size_t)(r >> 11) * 512 + (c0 - C_V)) * 2048 + (r & 2047);
                const unsigned w0 = cvt_pk_bf16(v[0], v[1]), w1 = cvt_pk_bf16(v[2], v[3]);
                vt[0] = (bf16_t)(w0 & 0xffffu); vt[2048] = (bf16_t)(w0 >> 16); vt[4096] = (bf16_t)(w1 & 0xffffu); vt[6144] = (bf16_t)(w1 >> 16);
            }
            if (c0 >= C_KC && c0 < C_KS) *(f32x4*)(p.out + O_CMPP + (size_t)r * 256 + (c0 - C_KC)) = v;
            else if (c0 >= C_KS && c0 < C_KW) *(f32x4*)(p.out + O_SLCP + (size_t)r * 256 + (c0 - C_KS)) = v;
            else if (c0 >= C_KW && c0 < C_G) {
                if (r < NP) { const int t = r & 2047; if (t >= 1536) *(f32x4*)(p.out + O_WINP + ((size_t)(r >> 11) * 512 + (t - 1536)) * 256 + (c0 - C_KW)) = v; }
                else *(f32x4*)(p.out + O_WINS + ((size_t)(r - NP) * 512 + 511) * 256 + (c0 - C_KW)) = v;
            } else if (c0 < C_V) {
                if (r < NP) { const int t = r & 2047; if (t >= 2045) *(f32x4*)(p.out + O_CVP + ((size_t)(r >> 11) * 3 + (t - 2045)) * 512 + c0) = v; }
                else *(f32x4*)(p.out + O_CVS + ((size_t)(r - NP) * 3 + 2) * 512 + c0) = v;
            }
        }, smem + 1024);
    xcd_barrier(bar);

    for (size_t i = GT_; i < (size_t)NR * 64; i += nt) {
        const int ch = (int)(i & 63) * 8; const int r = (int)(i >> 6);
        float a[8];
        { const float4 b0 = *(const float4*)(p.conv_b + ch), b1 = *(const float4*)(p.conv_b + ch + 4); a[0] = b0.x; a[1] = b0.y; a[2] = b0.z; a[3] = b0.w; a[4] = b1.x; a[5] = b1.y; a[6] = b1.z; a[7] = b1.w; }
#pragma unroll
        for (int j = 0; j < 4; ++j) {
            const float4 w0 = *(const float4*)(p.conv_w + j * 512 + ch), w1 = *(const float4*)(p.conv_w + j * 512 + ch + 4);
            float u[8]; bool have = true;
            if (r < NP) {
                const int t = r & 2047;
                if (t + j - 3 >= 0) { const uint4 q = *(const uint4*)(ZB + (size_t)(r + j - 3) * IN_DIM + C_U + ch);
                    u[0] = bf_lo(q.x); u[1] = bf_hi(q.x); u[2] = bf_lo(q.y); u[3] = bf_hi(q.y); u[4] = bf_lo(q.z); u[5] = bf_hi(q.z); u[6] = bf_lo(q.w); u[7] = bf_hi(q.w); }
                else have = false;
            } else if (j < 3) {
                const float* sc = p.state_conv + ((size_t)(r - NP) * 3 + j) * 512 + ch;
                const float4 s0 = *(const float4*)sc, s1 = *(const float4*)(sc + 4);
                u[0] = s0.x; u[1] = s0.y; u[2] = s0.z; u[3] = s0.w; u[4] = s1.x; u[5] = s1.y; u[6] = s1.z; u[7] = s1.w;
            } else { const uint4 q = *(const uint4*)(ZB + (size_t)r * IN_DIM + C_U + ch);
                u[0] = bf_lo(q.x); u[1] = bf_hi(q.x); u[2] = bf_lo(q.y); u[3] = bf_hi(q.y); u[4] = bf_lo(q.z); u[5] = bf_hi(q.z); u[6] = bf_lo(q.w); u[7] = bf_hi(q.w); }
            if (have) { a[0] += w0.x * u[0]; a[1] += w0.y * u[1]; a[2] += w0.z * u[2]; a[3] += w0.w * u[3]; a[4] += w1.x * u[4]; a[5] += w1.y * u[5]; a[6] += w1.z * u[6]; a[7] += w1.w * u[7]; }
        }
#pragma unroll
        for (int e = 0; e < 8; ++e) a[e] = a[e] / (1.0f + expf(-a[e]));
        *(uint4*)(CONVB + (size_t)r * 512 + ch) = pack8(a);
    }
    xcd_barrier(bar);

    for (int h = 0; h < 4; ++h) {
        gemm_glds(NR, 256, 128,
            [&](int r, int k) { return CONVB + (size_t)r * 512 + h * 128 + k; },
            [&](int n, int k) { return WQK_T + (size_t)(h * 256 + n) * 128 + k; },
            [&](int r, int c0, f32x4 v) {
                if (c0 >= 128) v = v * 0.08838834764831845f;
                if (c0 < 128) store_bf16x4((bf16_t*)(p.ws + WS_QB) + (size_t)r * 512 + h * 128 + c0, v);
                else {
                    store_bf16x4((bf16_t*)(p.ws + WS_KB) + (size_t)r * 512 + h * 128 + (c0 - 128), v);
                    if (r < NP) {
                        bf16_t* kt = (bf16_t*)(p.ws + WS_KTB) + ((size_t)((r >> 11) * 4 + h) * 128 + (c0 - 128)) * 2048 + (r & 2047);
                        const unsigned w0 = cvt_pk_bf16(v[0], v[1]), w1 = cvt_pk_bf16(v[2], v[3]);
                        kt[0] = (bf16_t)(w0 & 0xffffu); kt[2048] = (bf16_t)(w0 >> 16); kt[4096] = (bf16_t)(w1 & 0xffffu); kt[6144] = (bf16_t)(w1 >> 16);
                    }
                } }, smem + 1024, h * 514);
    }
    for (int c = 0; c < 2; ++c) {
        for (int grp = 0; grp < 2; ++grp) {
            const int TPB = grp ? 9 : 1, NCH = grp ? 1024 : 128, NBH = grp ? 64 : 32;
            gemm_bf16<128, true>(NBH * TPB * 128, 128, 1024,
                [&](int vrow, int k) {
                    const int tile = vrow >> 7, bh = tile / TPB, n_ = 127 * (tile % TPB) + (vrow & 127), n = n_ < NCH ? n_ : NCH - 1;
                    const int b = bh >> 1, hh = bh & 1, tok = 16 * n + (k >> 6), d0 = k & 63;
                    if (!grp) return *(const uint4*)(ZB + ((size_t)b * 2048 + tok) * IN_DIM + C_KC + c * 128 + hh * 64 + d0);
                    const int page = p.page_table[b * 128 + (tok >> 7)];
                    const float* sp = p.cache_cmp + ((size_t)page * 128 + (tok & 127)) * 256 + c * 128 + hh * 64 + d0;
                    const float4 a0 = *(const float4*)sp, a1 = *(const float4*)(sp + 4);
                    float f[8] = {a0.x, a0.y, a0.z, a0.w, a1.x, a1.y, a1.z, a1.w};
                    return pack8(f); },
                [&](int n, int k) { return *(const uint4*)(W1_T + ((size_t)c * 128 + n) * 1024 + k); },
                [&](f32x4 (&acc)[4][4], int bm) {
                    const int lr = LANE_ & 15, lq = LANE_ >> 4, wm = WV_ >> 1, wn = WV_ & 1;
                    const int tile = bm >> 7, bh = tile / TPB, n0 = 127 * (tile % TPB);
                    float* P1 = (float*)ldsb;
                    bf16_t* HL = (bf16_t*)(ldsb + 128 * 68 * 4);
                    __syncthreads();
                    if (wn == 1) {
#pragma unroll
                        for (int i = 0; i < 4; ++i)
#pragma unroll
                            for (int j = 0; j < 4; ++j) *(f32x4*)(P1 + (wm * 64 + i * 16 + lr) * 68 + j * 16 + lq * 4) = acc[i][j];
                    }
                    __syncthreads();
                    if (wn == 0) {
                        const float* pes = (const float*)(p.ws + WS_PESUM) + c * 64;
#pragma unroll
                        for (int i = 0; i < 4; ++i)
#pragma unroll
                            for (int j = 0; j < 4; ++j) {
                                const int rl = wm * 64 + i * 16 + lr, o0 = j * 16 + lq * 4;
                                const f32x4 nx = (rl < 127) ? *(const f32x4*)(P1 + (rl + 1) * 68 + o0) : (f32x4){0.f, 0.f, 0.f, 0.f};
                                const f32x4 pe4 = *(const f32x4*)(pes + o0);
                                f32x4 hv = acc[i][j] + nx + pe4;
                                hv[0] = gelu_tanh(hv[0]); hv[1] = gelu_tanh(hv[1]); hv[2] = gelu_tanh(hv[2]); hv[3] = gelu_tanh(hv[3]);
                                store_bf16x4(HL + rl * 72 + o0, hv);
                            }
                    }
                    __syncthreads();
                    f32x4 kc[2][4];
#pragma unroll
                    for (int i = 0; i < 2; ++i)
#pragma unroll
                        for (int j = 0; j < 4; ++j) kc[i][j] = (f32x4){0.f, 0.f, 0.f, 0.f};
#pragma unroll
                    for (int ks = 0; ks < 2; ++ks) {
                        bf16x8 hf[2], wf[4];
#pragma unroll
                        for (int i = 0; i < 2; ++i) hf[i] = *(const bf16x8*)(HL + (WV_ * 32 + i * 16 + lr) * 72 + ks * 32 + lq * 8);
#pragma unroll
                        for (int j = 0; j < 4; ++j) wf[j] = *(const bf16x8*)(W2_T + ((size_t)c * 64 + j * 16 + lr) * 64 + ks * 32 + lq * 8);
#pragma unroll
                        for (int i = 0; i < 2; ++i)
#pragma unroll
                            for (int j = 0; j < 4; ++j) kc[i][j] = __builtin_amdgcn_mfma_f32_16x16x32_bf16(wf[j], hf[i], kc[i][j], 0, 0, 0);
                    }
#pragma unroll
                    for (int i = 0; i < 2; ++i) {
                        const int rl = WV_ * 32 + i * 16 + lr, blk = n0 + rl;
                        if (rl < 127 && blk <= NCH - 2) {
#pragma unroll
                            for (int j = 0; j < 4; ++j) {
                                const int o2 = j * 16 + lq * 4;
                                if (c == 0) store_bf16x4((grp ? (bf16_t*)(p.ws + WS_KCSB) : KCB) + ((size_t)bh * NCH + blk) * 64 + o2, kc[i][j]);
                                else { bf16_t* vt = (grp ? (bf16_t*)(p.ws + WS_VTCS) : VTC) + ((size_t)bh * 64 + o2) * NCH + blk;
                                       const unsigned w0 = cvt_pk_bf16(kc[i][j][0], kc[i][j][1]), w1 = cvt_pk_bf16(kc[i][j][2], kc[i][j][3]);
                                       vt[0] = (bf16_t)(w0 & 0xffffu); vt[NCH] = (bf16_t)(w0 >> 16); vt[2 * NCH] = (bf16_t)(w1 & 0xffffu); vt[3 * NCH] = (bf16_t)(w1 >> 16); }
                            }
                        }
                    }
                    __syncthreads();
                }, ldsb, 4 * 514 + c * 608 + grp * 32);
        }
    }
    xcd_barrier(bar);

    for (;;) {
        __syncthreads();
        if (TID_ == 0) *(volatile int*)(ldsb + 45056) = (int)atomicAdd((unsigned*)(p.ws + WS_BAR) + 2, 1u);
        __syncthreads();
        const int idx = *(volatile int*)(ldsb + 45056);
        if (idx >= 448 + 2048) break;
        if (idx < 256) mlstm_chunk_item(p, idx, ldsb);
        else if (idx < 384) mlstm_step_item(p, idx - 256, lds);
        else if (idx < 448) nsa_sample_item(p, (idx - 384) >> 1, idx & 1, ldsb);
        else { const int i2 = idx - 448; nsa_prompt_item(p, (i2 & 31) >> 1, i2 & 1, 63 - (i2 >> 5), ldsb); }
    }
    xcd_barrier(bar);

    for (int row = GW_; row < NR; row += nw) {
        const float* hr = HRAW + (size_t)row * 512 + LANE_ * 8;
        const float4 h0 = *(const float4*)hr, h1 = *(const float4*)(hr + 4);
        float x[8] = {h0.x, h0.y, h0.z, h0.w, h1.x, h1.y, h1.z, h1.w};
        float sm = 0.f;
#pragma unroll
        for (int e = 0; e < 8; ++e) sm += x[e];
        const float mu = dpp_sum16(sm) * (1.0f / 128.0f);
        float q = 0.f;
#pragma unroll
        for (int e = 0; e < 8; ++e) { x[e] -= mu; q += x[e] * x[e]; }
        const float rstd = 1.0f / sqrtf(dpp_sum16(q) * (1.0f / 128.0f) + LN_EPS);
        const uint4 og = *(const uint4*)(ZB + (size_t)row * IN_DIM + C_O + LANE_ * 8);
        const float4 g0 = *(const float4*)(p.norm_g + LANE_ * 8), g1 = *(const float4*)(p.norm_g + LANE_ * 8 + 4);
        float o[8];
        o[0] = sigmoidf_(bf_lo(og.x)) * (x[0] * rstd * g0.x); o[1] = sigmoidf_(bf_hi(og.x)) * (x[1] * rstd * g0.y); o[2] = sigmoidf_(bf_lo(og.y)) * (x[2] * rstd * g0.z); o[3] = sigmoidf_(bf_hi(og.y)) * (x[3] * rstd * g0.w);
        o[4] = sigmoidf_(bf_lo(og.z)) * (x[4] * rstd * g1.x); o[5] = sigmoidf_(bf_hi(og.z)) * (x[5] * rstd * g1.y); o[6] = sigmoidf_(bf_lo(og.w)) * (x[6] * rstd * g1.z); o[7] = sigmoidf_(bf_hi(og.w)) * (x[7] * rstd * g1.w);
        *(uint4*)(MOUTB + (size_t)row * 512 + LANE_ * 8) = pack8(o);
    }
    xcd_barrier(bar);

    gemm_glds(NR, 1024, 1024,
        [&](int r, int k) { return (k < 512) ? MOUTB + (size_t)r * 512 + k : NOUTB + (size_t)r * 512 + (k - 512); },
        [&](int n, int k) { return (k < 512) ? WUPM_T + (size_t)n * 512 + k : WUPN_T + (size_t)n * 512 + (k - 512); },
        [&](int r, int c0, f32x4 v, uint2 kp) {
            const uint2 gw2 = *(const uint2*)(ZB + (size_t)r * IN_DIM + C_GN + c0);
            f32x4 o; o[0] = bf_lo(kp.x) + sigmoidf_(bf_lo(gw2.x)) * v[0]; o[1] = bf_hi(kp.x) + sigmoidf_(bf_hi(gw2.x)) * v[1]; o[2] = bf_lo(kp.y) + sigmoidf_(bf_lo(gw2.y)) * v[2]; o[3] = bf_hi(kp.y) + sigmoidf_(bf_hi(gw2.y)) * v[3];
            store_bf16x4(MIXB + (size_t)r * 1024 + c0, o); },
        smem + 1024, 0, 8,
        [&](int r, int c0, f32x4& v, uint2& kp) {
            const uint2 gw2 = *(const uint2*)(ZB + (size_t)r * IN_DIM + C_GM + c0);
            kp.x = cvt_pk_bf16(sigmoidf_(bf_lo(gw2.x)) * v[0], sigmoidf_(bf_hi(gw2.x)) * v[1]); kp.y = cvt_pk_bf16(sigmoidf_(bf_lo(gw2.y)) * v[2], sigmoidf_(bf_hi(gw2.y)) * v[3]); });
    xcd_barrier(bar);

    gemm_glds(NR, 1024, 1024,
        [&](int r, int k) { return MIXB + (size_t)r * 1024 + k; },
        [&](int n, int k) { return WOUT_T + (size_t)n * 1024 + k; },
        [&](int r, int c0, f32x4 v) {
            const f32x4 xv = *(const f32x4*)((r < NP ? p.x_prompt + (size_t)r * 1024 : p.x_sample + (size_t)(r - NP) * 1024) + c0);
            *(f32x4*)(T1 + (size_t)r * 1024 + c0) = xv * DN_ALPHA + v; }, smem + 1024);
    xcd_barrier(bar);

    for (int row = GW_; row < NR; row += nw) {
        float tv[16]; float s = 0.f;
#pragma unroll
        for (int j = 0; j < 4; ++j) { const float4 t4 = *(const float4*)(T1 + (size_t)row * 1024 + j * 256 + LANE_ * 4); tv[4 * j] = t4.x; tv[4 * j + 1] = t4.y; tv[4 * j + 2] = t4.z; tv[4 * j + 3] = t4.w; s += (t4.x + t4.y) + (t4.z + t4.w); }
        const float mu = wave_sum(s) * (1.0f / 1024.0f);
        float q = 0.f;
#pragma unroll
        for (int j = 0; j < 16; ++j) { const float d = tv[j] - mu; q += d * d; }
        const float rstd = 1.0f / sqrtf(wave_sum(q) * (1.0f / 1024.0f) + LN_EPS);
#pragma unroll
        for (int j = 0; j < 4; ++j) {
            const int c = j * 256 + LANE_ * 4;
            const float4 g4 = *(const float4*)(p.ln1_g + c), b4 = *(const float4*)(p.ln1_b + c);
            f32x4 o; o[0] = (tv[4 * j] - mu) * rstd * g4.x + b4.x; o[1] = (tv[4 * j + 1] - mu) * rstd * g4.y + b4.y; o[2] = (tv[4 * j + 2] - mu) * rstd * g4.z + b4.z; o[3] = (tv[4 * j + 3] - mu) * rstd * g4.w + b4.w;
            store_bf16x4(X1B + (size_t)row * 1024 + c, o);
        }
    }
    xcd_barrier(bar);

    gemm_glds(NR, 2048, 1024,
        [&](int r, int k) { return X1B + (size_t)r * 1024 + k; },
        [&](int n, int k) { return PWQ_T + (size_t)n * 1024 + k; },
        [&](int r, int c0, f32x4 v) { store_bf16x4(QPB + (size_t)r * 2048 + c0, v); }, smem + 1024);
    xcd_barrier(bar);

    for (int it = blockIdx.x; it < 513 * 8; it += gridDim.x) { __syncthreads(); peer_score_topk_item(p, it >> 3, it & 7, ldsb); }
    xcd_barrier(bar);

    for (int row = GW_; row < NR; row += nw) peer_expert_wave(p, row, ldsb + WV_ * 7168, LANE_);
}

#undef TID_
#undef LANE_
#undef WV_
#undef GW_
#undef GT_
extern "C" void kernel_launch(void* const* d_in, const int* in_sizes, int n_in, void* d_out, int out_size, void* d_ws, size_t ws_size, hipStream_t stream) {
    static int grid = 0;
    if (grid == 0) {
        if (n_in != 32 || (size_t)out_size != O_END || ws_size < WS_END) {
            fprintf(stderr, "kernel_launch: unexpected sizes n_in %d out %d ws %zu (need %zu)\n", n_in, out_size, ws_size, (size_t)WS_END); grid = -1; return; }
        int dev = 0, cus = 0, per_cu = 0;
        if (hipGetDevice(&dev) != hipSuccess || hipDeviceGetAttribute(&cus, hipDeviceAttributeMultiprocessorCount, dev) != hipSuccess) { grid = -1; return; }
        if (hipFuncSetAttribute((const void*)fwd_kernel, hipFuncAttributeMaxDynamicSharedMemorySize, LDS_BYTES) != hipSuccess) { fprintf(stderr, "hipFuncSetAttribute failed\n"); grid = -1; return; }
        if (hipOccupancyMaxActiveBlocksPerMultiprocessor(&per_cu, (const void*)fwd_kernel, NTHREADS, LDS_BYTES) != hipSuccess || per_cu < 1) { fprintf(stderr, "occupancy query failed (%d)\n", per_cu); (void)hipGetLastError(); per_cu = 1; }
        if (per_cu > 2) per_cu = 2;
        grid = cus * per_cu;
    }
    if (grid < 0) return;
    (void)hipMemsetAsync((char*)d_ws + WS_BAR, 0, XCD_BAR_WORDS * sizeof(unsigned), stream);
    Params p{};
    p.x_prompt = (const float*)d_in[0]; p.x_sample = (const float*)d_in[1]; p.cache_cmp = (const float*)d_in[2]; p.cache_slc = (const float*)d_in[3];
    p.page_table = (const int*)d_in[4]; p.state_win = (const float*)d_in[5]; p.state_C = (const float*)d_in[6]; p.state_n = (const float*)d_in[7];
    p.state_m = (const float*)d_in[8]; p.state_conv = (const float*)d_in[9]; p.w_in = (const float*)d_in[10]; p.conv_w = (const float*)d_in[11];
    p.conv_b = (const float*)d_in[12]; p.wq = (const float*)d_in[13]; p.wk = (const float*)d_in[14]; p.gate_bias = (const float*)d_in[15];
    p.norm_g = (const float*)d_in[16]; p.cmp_pe = (const float*)d_in[17]; p.cmp_w1 = (const float*)d_in[18]; p.cmp_w2 = (const float*)d_in[19];
    p.rel_bias = (const float*)d_in[20]; p.w_up_m = (const float*)d_in[21]; p.w_up_n = (const float*)d_in[22]; p.w_out = (const float*)d_in[23];
    p.ln1_g = (const float*)d_in[24]; p.ln1_b = (const float*)d_in[25]; p.ln2_g = (const float*)d_in[26]; p.ln2_b = (const float*)d_in[27];
    p.peer_wq = (const float*)d_in[28]; p.peer_sub = (const float*)d_in[29]; p.peer_u = (const float*)d_in[30]; p.peer_v = (const float*)d_in[31];
    p.out = (float*)d_out; p.ws = (unsigned char*)d_ws;
    hipLaunchKernelGGL(fwd_kernel, dim3(grid), dim3(NTHREADS), LDS_BYTES, stream, p);
}
```

```cpp
#include <hip/hip_runtime.h>
#include <stdint.h>
#include <cstdio>

#define DEV __device__ __forceinline__

constexpr int DM = 1024;
constexpr int BP = 16, TP = 2048, BS = 32;
constexpr int NP = BP * TP;
constexpr int NR = NP + BS;
constexpr int MP = 32896;
constexpr int IN_DIM = 4896;
constexpr int C_U = 0, C_V = 512, C_O = 1024, C_I = 1536, C_F = 1540, C_Q = 1544, C_KC = 2056, C_KS = 2312, C_KW = 2568, C_G = 2824, C_GM = 2848, C_GN = 3872;
constexpr int PAST = 16384;
constexpr float NEGF = -1e30f;
constexpr float DN_ALPHA = 1.189207115002721f;
constexpr float LN_EPS = 1e-5f;
constexpr float LOG2E = 1.4426950408889634f;

constexpr size_t O_Y = 0;
constexpr size_t O_CMPP = (size_t)NR * DM;
constexpr size_t O_CMPS = O_CMPP + (size_t)NP * 256;
constexpr size_t O_SLCP = O_CMPS + (size_t)BS * 256;
constexpr size_t O_SLCS = O_SLCP + (size_t)NP * 256;
constexpr size_t O_WINP = O_SLCS + (size_t)BS * 256;
constexpr size_t O_WINS = O_WINP + (size_t)BP * 512 * 256;
constexpr size_t O_CP = O_WINS + (size_t)BS * 512 * 256;
constexpr size_t O_CS = O_CP + (size_t)BP * 4 * 128 * 128;
constexpr size_t O_NP = O_CS + (size_t)BS * 4 * 128 * 128;
constexpr size_t O_NS = O_NP + (size_t)BP * 4 * 128;
constexpr size_t O_MP = O_NS + (size_t)BS * 4 * 128;
constexpr size_t O_MS = O_MP + (size_t)BP * 4;
constexpr size_t O_CVP = O_MS + (size_t)BS * 4;
constexpr size_t O_CVS = O_CVP + (size_t)BP * 3 * 512;
constexpr size_t O_END = O_CVS + (size_t)BS * 3 * 512;
static_assert(O_END == 59916480, "output size");

constexpr size_t al256(size_t x) { return (x + 255) & ~(size_t)255; }
constexpr size_t WS_BAR = 0;
constexpr size_t WS_Z = 16384;
constexpr size_t WS_QK = al256(WS_Z + (size_t)MP * 32 * 4);
constexpr size_t WS_HRAW = al256(WS_QK + 256);
constexpr size_t WS_MOUTB = al256(WS_HRAW + (size_t)MP * 512 * 4);
constexpr size_t WS_NOUTB = al256(WS_MOUTB + (size_t)MP * 512 * 2);
constexpr size_t WS_HIDPB = al256(WS_NOUTB + (size_t)MP * 512 * 2);
constexpr size_t WS_KCP = al256(WS_HIDPB + (size_t)2 * 4096 * 64 * 2);
constexpr size_t WS_HIDSB = al256(WS_KCP + 256);
constexpr size_t WS_KCS = al256(WS_HIDSB + (size_t)2 * 65536 * 64 * 2);
constexpr size_t WS_MIX = al256(WS_KCS + (size_t)2 * 65536 * 64 * 4);
constexpr size_t WS_MIXB = al256(WS_MIX + (size_t)MP * 1024 * 4);
constexpr size_t WS_T1 = al256(WS_MIXB + (size_t)MP * 1024 * 2);
constexpr size_t WS_X1 = al256(WS_T1 + (size_t)MP * 1024 * 4);
constexpr size_t WS_X1B = al256(WS_X1 + (size_t)MP * 1024 * 4);
constexpr size_t WS_QPB = al256(WS_X1B + (size_t)MP * 1024 * 2);
constexpr size_t WS_S = al256(WS_QPB + (size_t)MP * 2048 * 2);
constexpr size_t WS_PIDX = al256(WS_S + (size_t)MP * 2048 * 4);
constexpr size_t WS_PG = al256(WS_PIDX + (size_t)MP * 128 * 4);
constexpr size_t WS_CONVB = al256(WS_PG + (size_t)MP * 128 * 4);
constexpr size_t WS_XB = al256(WS_CONVB + (size_t)MP * 512 * 2);
constexpr size_t WS_WIN_T = al256(WS_XB + (size_t)MP * 1024 * 2);
constexpr size_t WS_WUPM_T = al256(WS_WIN_T + (size_t)IN_DIM * 1024 * 2);
constexpr size_t WS_WUPN_T = al256(WS_WUPM_T + (size_t)1024 * 512 * 2);
constexpr size_t WS_WOUT_T = al256(WS_WUPN_T + (size_t)1024 * 512 * 2);
constexpr size_t WS_PWQ_T = al256(WS_WOUT_T + (size_t)1024 * 1024 * 2);
constexpr size_t WS_WQK_T = al256(WS_PWQ_T + (size_t)2048 * 1024 * 2);
constexpr size_t WS_W1_T = al256(WS_WQK_T + (size_t)4 * 256 * 128 * 2);
constexpr size_t WS_PESUM = al256(WS_W1_T + (size_t)2 * 128 * 1024 * 2);
constexpr size_t WS_W2_T = al256(WS_PESUM + 512);
constexpr size_t WS_SUBK = al256(WS_W2_T + (size_t)2 * 64 * 64 * 2);
constexpr size_t WS_ZB = al256(WS_SUBK + (size_t)2 * 128 * 128 * 2);
constexpr size_t WS_VTS = al256(WS_ZB + (size_t)MP * IN_DIM * 2);
constexpr size_t WS_VTW = al256(WS_VTS + (size_t)16 * 2 * 64 * 2048 * 2);
constexpr size_t WS_KCB = al256(WS_VTW + (size_t)16 * 2 * 64 * 2048 * 2);
constexpr size_t WS_VTC = al256(WS_KCB + (size_t)16 * 2 * 128 * 64 * 2);
constexpr size_t WS_NOUTF = al256(WS_VTC + (size_t)16 * 2 * 64 * 128 * 2);
constexpr size_t WS_U8 = al256(WS_NOUTF + (size_t)NP * 512 * 4);
constexpr size_t WS_V8 = al256(WS_U8 + (size_t)16384 * 1024);
constexpr size_t WS_QB = al256(WS_V8 + (size_t)16384 * 1024);
constexpr size_t WS_KB = al256(WS_QB + (size_t)MP * 512 * 2);
constexpr size_t WS_KTB = al256(WS_KB + (size_t)MP * 512 * 2);
constexpr size_t WS_VTM = al256(WS_KTB + (size_t)16 * 512 * 2048 * 2);
constexpr size_t WS_KCSB = al256(WS_VTM + (size_t)16 * 512 * 2048 * 2);
constexpr size_t WS_VTCS = al256(WS_KCSB + (size_t)32 * 2 * 1024 * 64 * 2);
constexpr size_t WS_END = al256(WS_VTCS + (size_t)32 * 2 * 64 * 1024 * 2);

static_assert(WS_END <= 2684354560ull, "workspace too large");
constexpr int LDS_BYTES = 73728;
constexpr int NTHREADS = 256;

struct Params {
    const float* x_prompt; const float* x_sample; const float* cache_cmp; const float* cache_slc; const int* page_table;
    const float* state_win; const float* state_C; const float* state_n; const float* state_m; const float* state_conv;
    const float* w_in; const float* conv_w; const float* conv_b; const float* wq; const float* wk; const float* gate_bias; const float* norm_g;
    const float* cmp_pe; const float* cmp_w1; const float* cmp_w2; const float* rel_bias; const float* w_up_m; const float* w_up_n; const float* w_out;
    const float* ln1_g; const float* ln1_b; const float* ln2_g; const float* ln2_b; const float* peer_wq; const float* peer_sub; const float* peer_u; const float* peer_v;
    float* out; unsigned char* ws;
};

#define XB_TMO      128
#define XB_XCNT(j)  (256  + 64 * (j))
#define XB_XSUB(j)  (1280 + 64 * (j))
#define XB_XGEN(j)  (2304 + 64 * (j))
#define XB_TOP      3328
#define XB_TOPGEN   3392
#define XCD_BAR_WORDS 3456
#define XB_SPIN_CAP (1u << 22)
#define LAS __attribute__((address_space(3)))

__device__ __forceinline__ unsigned xb_ld(unsigned* p)              { return __hip_atomic_load(p, __ATOMIC_RELAXED, __HIP_MEMORY_SCOPE_AGENT); }
__device__ __forceinline__ unsigned xb_add(unsigned* p, unsigned v) { return __hip_atomic_fetch_add(p, v, __ATOMIC_RELAXED, __HIP_MEMORY_SCOPE_AGENT); }
__device__ __forceinline__ unsigned xb_xcc_id() { return (unsigned)__builtin_amdgcn_s_getreg((3 << 11) | 20) & 0xFu; }
#define XB_SPIN(cond, bar) do { unsigned _sp = 0; while (cond) { __builtin_amdgcn_s_sleep(1); \
    if ((++_sp & 255u) == 0u) { if (xb_ld(&(bar)[XB_TMO])) break; if (_sp > XB_SPIN_CAP) { atomicAdd(&(bar)[XB_TMO], 1u); break; } } } } while (0)

struct XcdBarrier { unsigned* bar; unsigned x; volatile LAS unsigned* st; };

__device__ __forceinline__ XcdBarrier xcd_barrier_post(unsigned* bar, volatile LAS unsigned* st) {
    XcdBarrier b; b.bar = bar; b.x = xb_xcc_id(); b.st = st;
    if (threadIdx.x == 0) (void)xb_add(&bar[XB_XCNT(b.x)], 1u);
    return b;
}
__device__ __forceinline__ void xcd_barrier_complete(unsigned* bar, unsigned x, unsigned& nloc, unsigned& nx) {
    const unsigned G = gridDim.x * gridDim.y * gridDim.z;
    unsigned sum, cnt, mine, sp = 0u;
    for (;;) {
        sum = 0u; cnt = 0u; mine = 0u;
#pragma unroll
        for (unsigned j = 0; j < 16; ++j) { const unsigned c = xb_ld(&bar[XB_XCNT(j)]); sum += c; cnt += (c > 0u) ? 1u : 0u; mine = (j == x) ? c : mine; }
        if (sum == G) break;
        __builtin_amdgcn_s_sleep(1);
        if ((++sp & 255u) == 0u) { if (xb_ld(&bar[XB_TMO])) break; if (sp > XB_SPIN_CAP) { atomicAdd(&bar[XB_TMO], 1u); break; } }
    }
    nloc = mine > 0u ? mine : 1u; nx = cnt > 0u ? cnt : 1u;
}
__device__ __forceinline__ void xcd_barrier(const XcdBarrier& b) {
    asm volatile("s_waitcnt vmcnt(0)" ::: "memory");
    __syncthreads();
    if (threadIdx.x == 0) {
        unsigned* bar = b.bar;
        __builtin_amdgcn_s_waitcnt(0);
        unsigned nloc = b.st[0], nx = b.st[1];
        if (nloc == 0u) { xcd_barrier_complete(bar, b.x, nloc, nx); b.st[0] = nloc; b.st[1] = nx; }
        const unsigned old = xb_add(&bar[XB_XSUB(b.x)], 1u);
        const unsigned gen = old / nloc;
        if (old + 1u == (gen + 1u) * nloc) {
            __builtin_amdgcn_fence(__ATOMIC_RELEASE, "agent");
            asm volatile("s_waitcnt vmcnt(0)" ::: "memory");
            const unsigned og = xb_add(&bar[XB_TOP], 1u);
            const unsigned tg = og / nx;
            if (og + 1u == (tg + 1u) * nx) xb_add(&bar[XB_TOPGEN], 1u);
            else XB_SPIN(xb_ld(&bar[XB_TOPGEN]) == tg, bar);
            __builtin_amdgcn_fence(__ATOMIC_ACQUIRE, "agent");
            xb_add(&bar[XB_XGEN(b.x)], 1u);
            asm volatile("s_waitcnt vmcnt(0)" ::: "memory");
        } else {
            XB_SPIN(xb_ld(&bar[XB_XGEN(b.x)]) == gen, bar);
            __builtin_amdgcn_fence(__ATOMIC_ACQUIRE, "agent");
            asm volatile("s_waitcnt vmcnt(0)" ::: "memory");
        }
    }
    __syncthreads();
}

typedef float f32x4 __attribute__((ext_vector_type(4)));

__device__ const unsigned char REL_LUT[128] = {
    0, 1, 2, 3, 4, 5, 6, 7, 8, 9, 10, 11, 12, 13, 14, 15, 16, 16, 16, 17, 17, 18, 18, 18, 19, 19, 19, 20, 20, 20, 20, 21, 21, 21, 21, 22, 22, 22, 22, 22,
    23, 23, 23, 23, 23, 23, 24, 24, 24, 24, 24, 24, 25, 25, 25, 25, 25, 25, 25, 26, 26, 26, 26, 26, 26, 26, 26, 27, 27, 27, 27, 27, 27, 27, 27, 27, 27,
    28, 28, 28, 28, 28, 28, 28, 28, 28, 28, 29, 29, 29, 29, 29, 29, 29, 29, 29, 29, 29, 29, 30, 30, 30, 30, 30, 30, 30, 30, 30, 30, 30, 30, 30, 30,
    31, 31, 31, 31, 31, 31, 31, 31, 31, 31, 31, 31, 31, 31, 31};
DEV int rel_bucket(int n) { return n < 128 ? (int)REL_LUT[n < 0 ? 0 : n] : 31; }

DEV float sigmoidf_(float x) { return 1.0f / (1.0f + expf(-x)); }
DEV float gelu_tanh(float x) { return 0.5f * x * (1.0f + tanhf(0.7978845608028654f * (x + 0.044715f * x * x * x))); }
DEV float log_sigmoid(float x) { return x >= 0.f ? -log1pf(expf(-x)) : x - log1pf(expf(x)); }
DEV void wave_sync() { asm volatile("s_waitcnt lgkmcnt(0)" ::: "memory"); __builtin_amdgcn_wave_barrier(); asm volatile("" ::: "memory"); }
DEV float wave_sum(float v) {
#pragma unroll
    for (int o = 32; o >= 1; o >>= 1) v += __shfl_xor(v, o);
    return v;
}
DEV float wave_max(float v) {
#pragma unroll
    for (int o = 32; o >= 1; o >>= 1) v = fmaxf(v, __shfl_xor(v, o));
    return v;
}

typedef unsigned short bf16_t;
typedef short bf16x8 __attribute__((ext_vector_type(8)));
typedef float f32x2_ __attribute__((ext_vector_type(2)));
typedef __bf16 bf16x2_ __attribute__((ext_vector_type(2)));
DEV unsigned cvt_pk_bf16(float lo, float hi) { const f32x2_ v = {lo, hi}; return __builtin_bit_cast(unsigned, __builtin_convertvector(v, bf16x2_)); }
DEV float bf_lo(unsigned w) { return __uint_as_float(w << 16); }
DEV float bf_hi(unsigned w) { return __uint_as_float(w & 0xffff0000u); }
DEV uint4 pack8(const float* f) { uint4 r; r.x = cvt_pk_bf16(f[0], f[1]); r.y = cvt_pk_bf16(f[2], f[3]); r.z = cvt_pk_bf16(f[4], f[5]); r.w = cvt_pk_bf16(f[6], f[7]); return r; }
DEV void store_bf16x4(bf16_t* p, f32x4 v) { uint2 w; w.x = cvt_pk_bf16(v[0], v[1]); w.y = cvt_pk_bf16(v[2], v[3]); *(uint2*)p = w; }

DEV void transpose_to_bf16(const float* __restrict__ src, const int K, const int N, bf16_t* __restrict__ dst, const size_t gt, const size_t nt) {
    const size_t items = (size_t)N * (K >> 3);
    for (size_t id = gt; id < items; id += nt) {
        const int n = (int)(id % N), k8 = (int)(id / N) * 8;
        float f[8];
#pragma unroll
        for (int i = 0; i < 8; ++i) f[i] = src[(size_t)(k8 + i) * N + n];
        *(uint4*)(dst + (size_t)n * K + k8) = pack8(f);
    }
}

template <int BN, bool TILE_EPI = false, class LA, class LB, class EF>
DEV void gemm_bf16(const int M, const int N, const int K, LA la, LB lb, EF ef, unsigned char* lds, const int toff = 0) {
    constexpr int TJ = BN / 32;
    constexpr int NB = BN / 32;
    constexpr int LDR = 144;
    const int tid = threadIdx.x, lane = tid & 63, w = tid >> 6, wm = w >> 1, wn = w & 1;
    const int tm = (M + 127) >> 7, tn = (N + BN - 1) / BN;
    unsigned char* As = lds;
    unsigned char* Bs = lds + 128 * LDR;
    const int lr = lane & 15, lq = lane >> 4;
    for (int tile = (int)((blockIdx.x + gridDim.x - (unsigned)toff % gridDim.x) % gridDim.x); tile < tm * tn; tile += gridDim.x) {
        const int bm = (tile / tn) * 128, bn = (tile % tn) * BN;
        f32x4 acc[4][TJ];
#pragma unroll
        for (int i = 0; i < 4; ++i)
#pragma unroll
            for (int j = 0; j < TJ; ++j) acc[i][j] = (f32x4){0.f, 0.f, 0.f, 0.f};
        typename LA::Raw ra[4]; uint4 rb[NB];
        const unsigned char* arow[4]; int brow[NB];
#pragma unroll
        for (int i = 0; i < 4; ++i) { const int r = bm + ((tid + 256 * i) >> 3); arow[i] = la.prep(r < M ? r : M - 1); }
#pragma unroll
        for (int i = 0; i < NB; ++i) { const int n = bn + ((tid + 256 * i) >> 3); brow[i] = n < N ? n : N - 1; }
        const int kc = (tid & 7) * 8;
#pragma unroll
        for (int i = 0; i < 4; ++i) ra[i] = la.load(arow[i], kc);
#pragma unroll
        for (int i = 0; i < NB; ++i) rb[i] = lb(brow[i], kc);
        for (int k0_ = 0; k0_ < K; k0_ += 64) {
            int k0 = k0_; asm volatile("" : "+v"(k0));
            __syncthreads();
#pragma unroll
            for (int i = 0; i < 4; ++i) *(uint4*)(As + ((tid + 256 * i) >> 3) * LDR + (tid & 7) * 16) = la.pack(ra[i]);
#pragma unroll
            for (int i = 0; i < NB; ++i) *(uint4*)(Bs + ((tid + 256 * i) >> 3) * LDR + (tid & 7) * 16) = rb[i];
            __syncthreads();
            if (k0_ + 64 < K) {
#pragma unroll
                for (int i = 0; i < 4; ++i) ra[i] = la.load(arow[i], k0 + 64 + kc);
#pragma unroll
                for (int i = 0; i < NB; ++i) rb[i] = lb(brow[i], k0 + 64 + kc);
            }
#pragma unroll
            for (int kk = 0; kk < 2; ++kk) {
                bf16x8 a[4], b[TJ];
#pragma unroll
                for (int i = 0; i < 4; ++i) a[i] = *(const bf16x8*)(As + (wm * 64 + i * 16 + lr) * LDR + kk * 64 + lq * 16);
#pragma unroll
                for (int j = 0; j < TJ; ++j) b[j] = *(const bf16x8*)(Bs + (wn * (BN / 2) + j * 16 + lr) * LDR + kk * 64 + lq * 16);
#pragma unroll
                for (int i = 0; i < 4; ++i)
#pragma unroll
                    for (int j = 0; j < TJ; ++j) acc[i][j] = __builtin_amdgcn_mfma_f32_16x16x32_bf16(b[j], a[i], acc[i][j], 0, 0, 0);
            }
        }
        if constexpr (TILE_EPI) { ef(acc, bm); }
        else {
#pragma unroll
            for (int i = 0; i < 4; ++i)
#pragma unroll
                for (int j = 0; j < TJ; ++j) {
                    const int r = bm + wm * 64 + i * 16 + lr, c0 = bn + wn * (BN / 2) + j * 16 + lq * 4;
                    if (r < M && c0 < N) ef(r, c0, acc[i][j]);
                }
        }
    }
}

DEV int lds_byte2(int r, int c) { const int st = (r >> 4) * 2 + (c >> 5), ob = (r & 15) * 64 + (c & 31) * 2; return st * 1024 + (ob ^ (((ob >> 9) & 1) << 5)); }
DEV void stage_rc2(int b, int& R, int& C) { const int st = b >> 10, sb = b & 1023, swz = sb ^ (((sb >> 9) & 1) << 5); R = (st >> 1) * 16 + swz / 64; C = (st & 1) * 32 + (swz % 64) / 2; }
struct NoMid { DEV void operator()(int, int, f32x4&, uint2&) const {} };
template <class PA, class PB, class EF, class MF = NoMid, bool XCDN = false>
DEV void gemm_glds(const int M, const int N, const int K, PA pa, PB pb, EF ef, unsigned char* lds, const int toff = 0, const int ksplit = 0, MF mf = MF()) {
    const int tid = threadIdx.x, lane = tid & 63, w = tid >> 6, wm = w >> 1, wn = w & 1;
    const int tm = (M + 127) >> 7, tn = (N + 127) >> 7;
    const int lr = lane & 15, lq = lane >> 4;
    const int nk = K >> 6;
    int sR[4], sC[4];
#pragma unroll
    for (int i = 0; i < 4; ++i) stage_rc2((w + 4 * i) * 1024 + lane * 16, sR[i], sC[i]);
    const int xc = blockIdx.x & 7, xslots = gridDim.x >> 3, xcnt = (tn - xc + 7) >> 3;
    for (int tile = XCDN ? (int)(blockIdx.x >> 3) : (int)((blockIdx.x + gridDim.x - (unsigned)toff % gridDim.x) % gridDim.x); tile < (XCDN ? tm * xcnt : tm * tn); tile += (XCDN ? xslots : (int)gridDim.x)) {
        const int bm = (XCDN ? tile / xcnt : tile / tn) * 128, bn = (XCDN ? xc + 8 * (tile % xcnt) : tile % tn) * 128;
        f32x4 acc[4][4]; uint2 keep[4][4];
#pragma unroll
        for (int i = 0; i < 4; ++i)
#pragma unroll
            for (int j = 0; j < 4; ++j) { acc[i][j] = (f32x4){0.f, 0.f, 0.f, 0.f}; keep[i][j] = make_uint2(0u, 0u); }
        int arow[4], brow[4];
#pragma unroll
        for (int i = 0; i < 4; ++i) { const int r = bm + sR[i], n = bn + sR[i]; arow[i] = r < M ? r : M - 1; brow[i] = n < N ? n : N - 1; }
#define GLDS_STAGE(BUF, KT) { _Pragma("unroll") for (int i = 0; i < 4; ++i) { \
            __builtin_amdgcn_global_load_lds((const unsigned*)pa(arow[i], (KT) * 64 + sC[i]), (LAS unsigned*)(lds + (BUF) * 32768 + (w + 4 * i) * 1024), 16, 0, 0); \
            __builtin_amdgcn_global_load_lds((const unsigned*)pb(brow[i], (KT) * 64 + sC[i]), (LAS unsigned*)(lds + (BUF) * 32768 + 16384 + (w + 4 * i) * 1024), 16, 0, 0); } }
        __syncthreads();
        GLDS_STAGE(0, 0)
        asm volatile("s_waitcnt vmcnt(0)" ::: "memory");
        __syncthreads();
        for (int kt = 0; kt < nk; ++kt) {
            const int cur = kt & 1;
            if (kt + 1 < nk) GLDS_STAGE(cur ^ 1, kt + 1)
            const unsigned char* SA = lds + cur * 32768;
            const unsigned char* SB = SA + 16384;
#pragma unroll
            for (int kk = 0; kk < 2; ++kk) {
                bf16x8 a[4], b[4];
#pragma unroll
                for (int i = 0; i < 4; ++i) a[i] = *(const bf16x8*)(SA + lds_byte2(wm * 64 + i * 16 + lr, kk * 32 + lq * 8));
#pragma unroll
                for (int j = 0; j < 4; ++j) b[j] = *(const bf16x8*)(SB + lds_byte2(wn * 64 + j * 16 + lr, kk * 32 + lq * 8));
#pragma unroll
                for (int i = 0; i < 4; ++i)
#pragma unroll
                    for (int j = 0; j < 4; ++j) acc[i][j] = __builtin_amdgcn_mfma_f32_16x16x32_bf16(b[j], a[i], acc[i][j], 0, 0, 0);
            }
            if constexpr (!__is_same(MF, NoMid)) {
                if (kt + 1 == ksplit) {
#pragma unroll
                    for (int i = 0; i < 4; ++i)
#pragma unroll
                        for (int j = 0; j < 4; ++j) {
                            const int r = bm + wm * 64 + i * 16 + lr, c0 = bn + wn * 64 + j * 16 + lq * 4;
                            if (r < M && c0 < N) mf(r, c0, acc[i][j], keep[i][j]);
                            acc[i][j] = (f32x4){0.f, 0.f, 0.f, 0.f};
                        }
                }
            }
            asm volatile("s_waitcnt vmcnt(0)" ::: "memory");
            __syncthreads();
        }
#undef GLDS_STAGE
#pragma unroll
        for (int i = 0; i < 4; ++i)
#pragma unroll
            for (int j = 0; j < 4; ++j) {
                const int r = bm + wm * 64 + i * 16 + lr, c0 = bn + wn * 64 + j * 16 + lq * 4;
                if (r < M && c0 < N) { if constexpr (!__is_same(MF, NoMid)) ef(r, c0, acc[i][j], keep[i][j]); else ef(r, c0, acc[i][j]); }
            }
    }
}

template <class PA, class PB, class EF>
DEV void gemm_glds_xcd(const int M, const int N, const int K, PA pa, PB pb, EF ef, unsigned char* lds) { gemm_glds<PA, PB, EF, NoMid, true>(M, N, K, pa, pb, ef, lds, 0, 0, NoMid()); }

DEV void mlstm_step_item(const Params& p, const int item, float* lds) {
    int tid_ = threadIdx.x; asm volatile("" : "+v"(tid_));
    const int tid = tid_, v = tid >> 1, kh = tid & 1;
    const int b = item >> 2, h = item & 3;
    const size_t r = (size_t)(NP + b);
    const float* Z = (const float*)(p.ws + WS_Z);
    const bf16_t* QBp = (const bf16_t*)(p.ws + WS_QB); const bf16_t* KBp = (const bf16_t*)(p.ws + WS_KB); const bf16_t* ZBp = (const bf16_t*)(p.ws + WS_ZB);
    float* HRAW = (float*)(p.ws + WS_HRAW);
    __syncthreads();
    lds[tid] = bf_lo((unsigned)(tid < 128 ? QBp[r * 512 + h * 128 + tid] : KBp[r * 512 + h * 128 + tid - 128]));
    if (tid < 128) lds[256 + tid] = bf_lo((unsigned)ZBp[r * IN_DIM + C_V + h * 128 + tid]);
    __syncthreads();
    const float m0 = p.state_m[b * 4 + h];
    const float ig = Z[r * 32 + h] + p.gate_bias[h], lf = log_sigmoid(Z[r * 32 + 4 + h] + p.gate_bias[4 + h]);
    const float mn = fmaxf(lf + m0, ig);
    const float fd = expf(lf + m0 - mn), iw = expf(ig - mn);
    const float vv = lds[256 + v] * iw;
    const float* c0 = p.state_C + (((size_t)(b * 4 + h) * 128 + v) * 128 + kh * 64);
    const float* n0 = p.state_n + ((size_t)(b * 4 + h) * 128 + kh * 64);
    float* co = p.out + O_CS + (((size_t)(b * 4 + h) * 128 + v) * 128 + kh * 64);
    float* no = p.out + O_NS + ((size_t)(b * 4 + h) * 128 + kh * 64);
    float nump = 0.f, denp = 0.f;
#pragma unroll 4
    for (int j = 0; j < 64; j += 4) {
        const float4 c4 = *(const float4*)(c0 + j), n4 = *(const float4*)(n0 + j);
        const float4 k4 = *(const float4*)(lds + 128 + kh * 64 + j), q4 = *(const float4*)(lds + kh * 64 + j);
        float4 cn, nn;
        cn.x = fd * c4.x + vv * k4.x; cn.y = fd * c4.y + vv * k4.y; cn.z = fd * c4.z + vv * k4.z; cn.w = fd * c4.w + vv * k4.w;
        nn.x = fd * n4.x + iw * k4.x; nn.y = fd * n4.y + iw * k4.y; nn.z = fd * n4.z + iw * k4.z; nn.w = fd * n4.w + iw * k4.w;
        nump += cn.x * q4.x + cn.y * q4.y + cn.z * q4.z + cn.w * q4.w;
        denp += nn.x * q4.x + nn.y * q4.y + nn.z * q4.z + nn.w * q4.w;
        *(float4*)(co + j) = cn;
        if (v == 0) *(float4*)(no + j) = nn;
    }
    nump += __shfl_xor(nump, 1); denp += __shfl_xor(denp, 1);
    if (kh == 0) HRAW[r * 512 + h * 128 + v] = nump / fmaxf(fabsf(denp), expf(-mn));
    if (tid == 0) p.out[O_MS + b * 4 + h] = mn;
}

DEV void mlstm_chunk_item(const Params& p, const int item, unsigned char* lds) {
    int tid_ = threadIdx.x; asm volatile("" : "+v"(tid_));
    const int tid = tid_, lane = tid & 63, w = tid >> 6, lr = lane & 15, lq = lane >> 4;
    const int b = item >> 4, h = (item >> 2) & 3, vs = item & 3;
    bf16_t* Cl = (bf16_t*)lds;
    bf16_t* nl = (bf16_t*)(lds + 8704);
    float* uL = (float*)(lds + 8960); float* ML = uL + 64; float* scin = uL + 128; float* expm = uL + 192; float* wts = uL + 256; float* misc = uL + 320;
    const bf16_t* QB = (const bf16_t*)(p.ws + WS_QB) + (size_t)(b * 2048) * 512 + h * 128;
    const bf16_t* KB = (const bf16_t*)(p.ws + WS_KB) + (size_t)(b * 2048) * 512 + h * 128;
    const bf16_t* KTB = (const bf16_t*)(p.ws + WS_KTB) + (size_t)((b * 4 + h) * 128) * 2048;
    const bf16_t* VTM = (const bf16_t*)(p.ws + WS_VTM) + (size_t)(b * 512 + h * 128 + vs * 32) * 2048;
    const float* Z = (const float*)(p.ws + WS_Z);
    float* HRAW = (float*)(p.ws + WS_HRAW);
    const float gb_i = p.gate_bias[h], gb_f = p.gate_bias[4 + h];
    f32x4 Cm[2][2], nm[2];
#pragma unroll
    for (int i = 0; i < 2; ++i) { nm[i] = (f32x4){0.f, 0.f, 0.f, 0.f};
#pragma unroll
        for (int j = 0; j < 2; ++j) Cm[i][j] = (f32x4){0.f, 0.f, 0.f, 0.f}; }
    float m_prev = 0.f;
    __syncthreads();
    for (int i = tid; i < (8704 + 256) / 4; i += 256) ((unsigned*)lds)[i] = 0u;
    __syncthreads();
    for (int c = 0; c < 32; ++c) {
        const int t0 = c * 64;
        if (w == 0) {
            const size_t row = (size_t)(b * 2048 + t0 + lane);
            const float ig = Z[row * 32 + h] + gb_i;
            const float lf = log_sigmoid(Z[row * 32 + 4 + h] + gb_f);
            float bc = lf;
#pragma unroll
            for (int o = 1; o < 64; o <<= 1) { const float t = __shfl_up(bc, o); if (lane >= o) bc += t; }
            const float u = ig - bc;
            float pm = u;
#pragma unroll
            for (int o = 1; o < 64; o <<= 1) { const float t = __shfl_up(pm, o); if (lane >= o) pm = fmaxf(pm, t); }
            const float M = fmaxf(m_prev, pm);
            const float M63 = __shfl(M, 63), b63 = __shfl(bc, 63);
            uL[lane] = u; ML[lane] = M; scin[lane] = expf(m_prev - M); expm[lane] = expf(-(bc + M)); wts[lane] = expf(u - M63);
            if (lane == 0) { misc[0] = expf(m_prev - M63); misc[1] = b63 + M63; }
        }
        __syncthreads();
        {
            const size_t row_t = (size_t)(t0 + w * 16 + lr);
            bf16x8 Qf[4];
#pragma unroll
            for (int ks = 0; ks < 4; ++ks) Qf[ks] = *(const bf16x8*)(QB + row_t * 512 + ks * 32 + lq * 8);
            const float M_t = ML[w * 16 + lr], sc_in = scin[w * 16 + lr], em = expm[w * 16 + lr];
            f32x4 sw[4];
            float dsum = 0.f;
#pragma unroll
            for (int st = 0; st < 4; ++st) {
                f32x4 a = (f32x4){0.f, 0.f, 0.f, 0.f};
                if (st <= w) {
#pragma unroll
                    for (int ks = 0; ks < 4; ++ks) { const bf16x8 kf = *(const bf16x8*)(KB + (size_t)(t0 + st * 16 + lr) * 512 + ks * 32 + lq * 8); a = __builtin_amdgcn_mfma_f32_16x16x32_bf16(kf, Qf[ks], a, 0, 0, 0); }
#pragma unroll
                    for (int g = 0; g < 4; ++g) {
                        const int sl = st * 16 + lq * 4 + g, tl = w * 16 + lr;
                        const float wg = (sl <= tl) ? __builtin_amdgcn_exp2f((uL[sl] - M_t) * LOG2E) : 0.f;
                        a[g] *= wg; dsum += a[g];
                    }
                }
                sw[st] = a;
            }
            dsum += __shfl_xor(dsum, 16); dsum += __shfl_xor(dsum, 32);
            bf16x8 pf[2];
#pragma unroll
            for (int ks = 0; ks < 2; ++ks) {
                union { bf16x8 v; unsigned u[4]; } pk;
                pk.u[0] = cvt_pk_bf16(sw[2 * ks][0], sw[2 * ks][1]); pk.u[1] = cvt_pk_bf16(sw[2 * ks][2], sw[2 * ks][3]);
                pk.u[2] = cvt_pk_bf16(sw[2 * ks + 1][0], sw[2 * ks + 1][1]); pk.u[3] = cvt_pk_bf16(sw[2 * ks + 1][2], sw[2 * ks + 1][3]);
                pf[ks] = pk.v;
            }
            f32x4 dI = (f32x4){0.f, 0.f, 0.f, 0.f};
#pragma unroll
            for (int ks = 0; ks < 4; ++ks) { const bf16x8 nf = *(const bf16x8*)(nl + ks * 32 + lq * 8); dI = __builtin_amdgcn_mfma_f32_16x16x32_bf16(nf, Qf[ks], dI, 0, 0, 0); }
            const float den = sc_in * dI[0] + dsum;
            const float rdd = 1.0f / fmaxf(fabsf(den), em);
#pragma unroll
            for (int vt = 0; vt < 2; ++vt) {
                f32x4 ni = (f32x4){0.f, 0.f, 0.f, 0.f}, nI = (f32x4){0.f, 0.f, 0.f, 0.f};
#pragma unroll
                for (int ks = 0; ks < 2; ++ks) if (2 * ks <= w) {
                    union { bf16x8 v; uint2 hh[2]; } vf;
                    const bf16_t* vp = VTM + (size_t)(vt * 16 + lr) * 2048 + t0 + 32 * ks + lq * 4;
                    vf.hh[0] = *(const uint2*)vp; vf.hh[1] = *(const uint2*)(vp + 16);
                    ni = __builtin_amdgcn_mfma_f32_16x16x32_bf16(vf.v, pf[ks], ni, 0, 0, 0);
                }
#pragma unroll
                for (int ks = 0; ks < 4; ++ks) { const bf16x8 cf = *(const bf16x8*)(Cl + (vt * 16 + lr) * 136 + ks * 32 + lq * 8); nI = __builtin_amdgcn_mfma_f32_16x16x32_bf16(cf, Qf[ks], nI, 0, 0, 0); }
                const f32x4 hv = (nI * sc_in + ni) * rdd;
                *(f32x4*)(HRAW + ((size_t)(b * 2048) + row_t) * 512 + h * 128 + vs * 32 + vt * 16 + lq * 4) = hv;
            }
        }
        __syncthreads();
        {
            const float decay = misc[0];
            bf16x8 Af[2][2], Wf[2], Kt[2][2];
#pragma unroll
            for (int ks = 0; ks < 2; ++ks) {
                const float4 w0 = *(const float4*)(wts + ks * 32 + lq * 8), w1 = *(const float4*)(wts + ks * 32 + lq * 8 + 4);
                float wv[8] = {w0.x, w0.y, w0.z, w0.w, w1.x, w1.y, w1.z, w1.w};
                { union { bf16x8 v; uint4 q; } t; t.q = pack8(wv); Wf[ks] = t.v; }
#pragma unroll
                for (int vt = 0; vt < 2; ++vt) {
                    const uint4 raw = *(const uint4*)(VTM + (size_t)(vt * 16 + lr) * 2048 + t0 + ks * 32 + lq * 8);
                    float f[8] = {bf_lo(raw.x) * wv[0], bf_hi(raw.x) * wv[1], bf_lo(raw.y) * wv[2], bf_hi(raw.y) * wv[3], bf_lo(raw.z) * wv[4], bf_hi(raw.z) * wv[5], bf_lo(raw.w) * wv[6], bf_hi(raw.w) * wv[7]};
                    union { bf16x8 v; uint4 q; } t; t.q = pack8(f); Af[vt][ks] = t.v;
                }
#pragma unroll
                for (int kt = 0; kt < 2; ++kt) Kt[kt][ks] = *(const bf16x8*)(KTB + (size_t)((2 * w + kt) * 16 + lr) * 2048 + t0 + ks * 32 + lq * 8);
            }
#pragma unroll
            for (int kt = 0; kt < 2; ++kt) {
                nm[kt] = nm[kt] * decay;
#pragma unroll
                for (int ks = 0; ks < 2; ++ks) nm[kt] = __builtin_amdgcn_mfma_f32_16x16x32_bf16(Wf[ks], Kt[kt][ks], nm[kt], 0, 0, 0);
                if (lq == 0) nl[(2 * w + kt) * 16 + lr] = (bf16_t)(cvt_pk_bf16(nm[kt][0], 0.f) & 0xffffu);
#pragma unroll
                for (int vt = 0; vt < 2; ++vt) {
                    Cm[vt][kt] = Cm[vt][kt] * decay;
#pragma unroll
                    for (int ks = 0; ks < 2; ++ks) Cm[vt][kt] = __builtin_amdgcn_mfma_f32_16x16x32_bf16(Af[vt][ks], Kt[kt][ks], Cm[vt][kt], 0, 0, 0);
                    const unsigned c01 = cvt_pk_bf16(Cm[vt][kt][0], Cm[vt][kt][1]), c23 = cvt_pk_bf16(Cm[vt][kt][2], Cm[vt][kt][3]);
                    bf16_t* cp = Cl + (vt * 16 + lq * 4) * 136 + (2 * w + kt) * 16 + lr;
                    cp[0] = (bf16_t)(c01 & 0xffffu); cp[136] = (bf16_t)(c01 >> 16); cp[272] = (bf16_t)(c23 & 0xffffu); cp[408] = (bf16_t)(c23 >> 16);
                }
            }
            m_prev = misc[1];
        }
        __syncthreads();
    }
#pragma unroll
    for (int vt = 0; vt < 2; ++vt)
#pragma unroll
        for (int kt = 0; kt < 2; ++kt)
#pragma unroll
            for (int g = 0; g < 4; ++g)
                p.out[O_CP + ((size_t)((b * 4 + h) * 128) + vs * 32 + vt * 16 + lq * 4 + g) * 128 + (2 * w + kt) * 16 + lr] = Cm[vt][kt][g];
    if (vs == 0) {
        if (lq == 0) { p.out[O_NP + (size_t)(b * 4 + h) * 128 + (2 * w) * 16 + lr] = nm[0][0]; p.out[O_NP + (size_t)(b * 4 + h) * 128 + (2 * w + 1) * 16 + lr] = nm[1][0]; }
        if (tid == 0) p.out[O_MP + b * 4 + h] = m_prev;
    }
}

DEV unsigned dpp_max16(unsigned x) {
    x = max(x, (unsigned)__builtin_amdgcn_update_dpp(0, (int)x, 0xB1, 0xF, 0xF, false));
    x = max(x, (unsigned)__builtin_amdgcn_update_dpp(0, (int)x, 0x4E, 0xF, 0xF, false));
    x = max(x, (unsigned)__builtin_amdgcn_update_dpp(0, (int)x, 0x141, 0xF, 0xF, false));
    x = max(x, (unsigned)__builtin_amdgcn_update_dpp(0, (int)x, 0x140, 0xF, 0xF, false));
    return x;
}
DEV float dpp_sum16(float x) {
    x += __builtin_bit_cast(float, __builtin_amdgcn_update_dpp(0, __builtin_bit_cast(int, x), 0xB1, 0xF, 0xF, false));
    x += __builtin_bit_cast(float, __builtin_amdgcn_update_dpp(0, __builtin_bit_cast(int, x), 0x4E, 0xF, 0xF, false));
    x += __builtin_bit_cast(float, __builtin_amdgcn_update_dpp(0, __builtin_bit_cast(int, x), 0x141, 0xF, 0xF, false));
    x += __builtin_bit_cast(float, __builtin_amdgcn_update_dpp(0, __builtin_bit_cast(int, x), 0x140, 0xF, 0xF, false));
    return x;
}
DEV unsigned mono_key(float v) { const unsigned b = __float_as_uint(v); return (b & 0x80000000u) ? ~b : (b | 0x80000000u); }
#define CE_DESC(a, b) { const unsigned hi_ = max(a, b), lo_ = min(a, b); a = hi_; b = lo_; }

DEV void peer_score_topk_item(const Params& p, const int tile, const int h, unsigned char* lds) {
    int tid_ = threadIdx.x; asm volatile("" : "+v"(tid_));
    const int tid = tid_, lane = tid & 63, w = tid >> 6, lr = lane & 15, lq = lane >> 4;
    float* sc = (float*)(lds + w * 12416);
    float* ts = sc + 16 * 129;
    int* ti = (int*)(ts + 512);
    const bf16_t* QPB = (const bf16_t*)(p.ws + WS_QPB);
    const bf16_t* SUBK = (const bf16_t*)(p.ws + WS_SUBK);
    int* PIDX = (int*)(p.ws + WS_PIDX); float* PG = (float*)(p.ws + WS_PG);
    const int row0 = tile * 64 + w * 16;
    const int arow = (row0 + lr < NR) ? row0 + lr : NR - 1;
    wave_sync();
#pragma unroll 1
    for (int pp = 0; pp < 2; ++pp) {
        bf16x8 qf[4];
#pragma unroll
        for (int ks = 0; ks < 4; ++ks) qf[ks] = *(const bf16x8*)(QPB + (size_t)arow * 2048 + h * 256 + pp * 128 + ks * 32 + lq * 8);
#pragma unroll
        for (int j = 0; j < 8; ++j) {
            f32x4 a = (f32x4){0.f, 0.f, 0.f, 0.f};
#pragma unroll
            for (int ks = 0; ks < 4; ++ks) { const bf16x8 kf = *(const bf16x8*)(SUBK + ((size_t)pp * 128 + j * 16 + lr) * 128 + ks * 32 + lq * 8); a = __builtin_amdgcn_mfma_f32_16x16x32_bf16(qf[ks], kf, a, 0, 0, 0); }
#pragma unroll
            for (int g = 0; g < 4; ++g) sc[(lq * 4 + g) * 129 + j * 16 + lr] = a[g];
        }
        wave_sync();
#pragma unroll 1
        for (int rr = 0; rr < 4; ++rr) {
            const int row = rr * 4 + lq;
            unsigned k0, k1, k2, k3, k4, k5, k6, k7;
            { const float* sr = sc + row * 129 + lr;
              k0 = (mono_key(sr[0]) & ~0x7Fu) | (unsigned)(127 - lr);        k1 = (mono_key(sr[16]) & ~0x7Fu) | (unsigned)(127 - 16 - lr);
              k2 = (mono_key(sr[32]) & ~0x7Fu) | (unsigned)(127 - 32 - lr);  k3 = (mono_key(sr[48]) & ~0x7Fu) | (unsigned)(127 - 48 - lr);
              k4 = (mono_key(sr[64]) & ~0x7Fu) | (unsigned)(127 - 64 - lr);  k5 = (mono_key(sr[80]) & ~0x7Fu) | (unsigned)(127 - 80 - lr);
              k6 = (mono_key(sr[96]) & ~0x7Fu) | (unsigned)(127 - 96 - lr);  k7 = (mono_key(sr[112]) & ~0x7Fu) | (unsigned)(127 - 112 - lr); }
            CE_DESC(k0, k1) CE_DESC(k2, k3) CE_DESC(k4, k5) CE_DESC(k6, k7)
            CE_DESC(k0, k2) CE_DESC(k1, k3) CE_DESC(k4, k6) CE_DESC(k5, k7)
            CE_DESC(k1, k2) CE_DESC(k5, k6)
            CE_DESC(k0, k4) CE_DESC(k1, k5) CE_DESC(k2, k6) CE_DESC(k3, k7)
            CE_DESC(k2, k4) CE_DESC(k3, k5)
            CE_DESC(k1, k2) CE_DESC(k3, k4) CE_DESC(k5, k6)
            unsigned mine = 0u;
#pragma unroll
            for (int r = 0; r < 16; ++r) {
                const unsigned best = dpp_max16(k0);
                if (lr == r) mine = best;
                const bool own = (k0 == best);
                k0 = own ? k1 : k0; k1 = own ? k2 : k1; k2 = own ? k3 : k2; k3 = own ? k4 : k3; k4 = own ? k5 : k4; k5 = own ? k6 : k5; k6 = own ? k7 : k6; k7 = own ? 0u : k7;
            }
            const int idx = 127 - (int)(mine & 0x7Fu);
            ts[(pp * 16 + row) * 16 + lr] = sc[row * 129 + idx];
            ti[(pp * 16 + row) * 16 + lr] = idx;
        }
        wave_sync();
    }
#pragma unroll 1
    for (int rr = 0; rr < 4; ++rr) {
        const int row = rr * 4 + lq;
        const float s1a = ts[row * 16 + lr];
        const float* s2 = ts + (16 + row) * 16;
        int ptr = 0;
        unsigned key = (mono_key(s1a + s2[0]) & ~0xFFu) | (unsigned)(255 - lr * 16);
        unsigned mine = 0u;
#pragma unroll
        for (int r = 0; r < 16; ++r) {
            const unsigned best = dpp_max16(key);
            if (lr == r) mine = best;
            if (key == best) { ++ptr; key = (ptr < 16) ? ((mono_key(s1a + s2[ptr & 15]) & ~0xFFu) | (unsigned)(255 - lr * 16 - ptr)) : 0u; }
        }
        const int ci = 255 - (int)(mine & 0xFFu), a = ci >> 4, bb = ci & 15;
        const float scv = ts[row * 16 + a] + s2[bb];
        const int e = ti[row * 16 + a] * 128 + ti[(16 + row) * 16 + bb];
        float m16 = scv;
        m16 = fmaxf(m16, __builtin_bit_cast(float, __builtin_amdgcn_update_dpp(0, __builtin_bit_cast(int, m16), 0xB1, 0xF, 0xF, false)));
        m16 = fmaxf(m16, __builtin_bit_cast(float, __builtin_amdgcn_update_dpp(0, __builtin_bit_cast(int, m16), 0x4E, 0xF, 0xF, false)));
        m16 = fmaxf(m16, __builtin_bit_cast(float, __builtin_amdgcn_update_dpp(0, __builtin_bit_cast(int, m16), 0x141, 0xF, 0xF, false)));
        m16 = fmaxf(m16, __builtin_bit_cast(float, __builtin_amdgcn_update_dpp(0, __builtin_bit_cast(int, m16), 0x140, 0xF, 0xF, false)));
        const float ex = expf(scv - m16);
        const float den = dpp_sum16(ex);
        const int grow = row0 + row;
        if (grow < NR) { PIDX[(size_t)grow * 128 + h * 16 + lr] = e; PG[(size_t)grow * 128 + h * 16 + lr] = ex / den; }
    }
}

constexpr float PEER_U_SCALE = 64.0f, PEER_V_SCALE = 8.0f;
DEV unsigned pack4_fp8(float a, float b, float c, float d) { int w = 0; w = __builtin_amdgcn_cvt_pk_fp8_f32(a, b, w, false); w = __builtin_amdgcn_cvt_pk_fp8_f32(c, d, w, true); return (unsigned)w; }
DEV void peer_expert_wave(const Params& p, const int row, unsigned char* wl, const int lane_in) {
    int lane = lane_in; asm volatile("" : "+v"(lane));
    const int lr = lane & 15, lq = lane >> 4;
    unsigned char* xh = wl;
    unsigned char* xo = wl + 1024;
    float* coefl = (float*)(wl + 2048);
    int* idxl = (int*)(wl + 2048 + 512);
    const float* T1r = (const float*)(p.ws + WS_T1) + (size_t)row * 1024;
    const int* PIDX = (const int*)(p.ws + WS_PIDX) + (size_t)row * 128;
    const float* PG = (const float*)(p.ws + WS_PG) + (size_t)row * 128;
    const unsigned char* U8 = p.ws + WS_U8;
    const unsigned char* V8 = p.ws + WS_V8;
    float xv[16];
    {
        float s1 = 0.f;
#pragma unroll
        for (int j = 0; j < 4; ++j) { const float4 t = *(const float4*)(T1r + lane * 16 + j * 4); xv[4 * j] = t.x; xv[4 * j + 1] = t.y; xv[4 * j + 2] = t.z; xv[4 * j + 3] = t.w; s1 += (t.x + t.y) + (t.z + t.w); }
        const float mu1 = wave_sum(s1) * (1.0f / 1024.0f);
        float q1 = 0.f;
#pragma unroll
        for (int i = 0; i < 16; ++i) { xv[i] -= mu1; q1 += xv[i] * xv[i]; }
        const float rstd1 = 1.0f / sqrtf(wave_sum(q1) * (1.0f / 1024.0f) + LN_EPS);
#pragma unroll
        for (int j = 0; j < 4; ++j) {
            const float4 g4 = *(const float4*)(p.ln1_g + lane * 16 + j * 4), b4 = *(const float4*)(p.ln1_b + lane * 16 + j * 4);
            xv[4 * j] = xv[4 * j] * rstd1 * g4.x + b4.x; xv[4 * j + 1] = xv[4 * j + 1] * rstd1 * g4.y + b4.y; xv[4 * j + 2] = xv[4 * j + 2] * rstd1 * g4.z + b4.z; xv[4 * j + 3] = xv[4 * j + 3] * rstd1 * g4.w + b4.w;
        }
    }
    wave_sync();
    {
        uint4 hi, lo; unsigned* hp = (unsigned*)&hi; unsigned* lp = (unsigned*)&lo;
#pragma unroll
        for (int j = 0; j < 4; ++j) {
            const unsigned hw = pack4_fp8(xv[4 * j], xv[4 * j + 1], xv[4 * j + 2], xv[4 * j + 3]);
            const f32x2_ b0 = __builtin_amdgcn_cvt_pk_f32_fp8((int)hw, false), b1 = __builtin_amdgcn_cvt_pk_f32_fp8((int)hw, true);
            hp[j] = hw;
            lp[j] = pack4_fp8(16.f * (xv[4 * j] - b0[0]), 16.f * (xv[4 * j + 1] - b0[1]), 16.f * (xv[4 * j + 2] - b1[0]), 16.f * (xv[4 * j + 3] - b1[1]));
        }
        *(uint4*)(xh + lane * 16) = hi; *(uint4*)(xo + lane * 16) = lo;
    }
    idxl[lane] = PIDX[lane]; idxl[64 + lane] = PIDX[64 + lane];
    float* xs = (float*)(wl + 3072);
#pragma unroll
    for (int j = 0; j < 4; ++j) *(float4*)(xs + lane * 16 + j * 4) = make_float4(xv[4 * j], xv[4 * j + 1], xv[4 * j + 2], xv[4 * j + 3]);
    wave_sync();
    uint4 ufa[8], ufb[8];
    f32x4 ah = (f32x4){0.f, 0.f, 0.f, 0.f}, al = (f32x4){0.f, 0.f, 0.f, 0.f};
#define U_LOAD(DST, HH) { const unsigned char* ub_ = U8 + (size_t)idxl[((HH) >> 1) * 16 + lr] * 1024 + ((HH) & 1) * 512 + lq * 16; \
        _Pragma("unroll") for (int i = 0; i < 8; ++i) DST[i] = *(const uint4*)(ub_ + i * 64); }
#define U_HALF(SRC, HH) { \
        _Pragma("unroll") for (int i = 0; i < 8; ++i) { \
            if ((i & 1) == 0) asm volatile("" ::: "memory");        \
            const int off = ((HH) & 1) * 512 + i * 64 + lq * 16; \
            const long b0 = (long)(((unsigned long long)SRC[i].y << 32) | SRC[i].x), b1 = (long)(((unsigned long long)SRC[i].w << 32) | SRC[i].z); \
            const long h0 = *(const long*)(xh + off), h1 = *(const long*)(xh + off + 8), l0 = *(const long*)(xo + off), l1 = *(const long*)(xo + off + 8); \
            ah = __builtin_amdgcn_mfma_f32_16x16x32_fp8_fp8(h0, b0, ah, 0, 0, 0); ah = __builtin_amdgcn_mfma_f32_16x16x32_fp8_fp8(h1, b1, ah, 0, 0, 0); \
            al = __builtin_amdgcn_mfma_f32_16x16x32_fp8_fp8(l0, b0, al, 0, 0, 0); al = __builtin_amdgcn_mfma_f32_16x16x32_fp8_fp8(l1, b1, al, 0, 0, 0); } \
        if ((HH) & 1) { if (lq == 0) coefl[((HH) >> 1) * 16 + lr] = PG[((HH) >> 1) * 16 + lr] * gelu_tanh((ah[0] + al[0] * 0.0625f) * (1.0f / PEER_U_SCALE)) * (1.0f / PEER_V_SCALE); \
            ah = (f32x4){0.f, 0.f, 0.f, 0.f}; al = (f32x4){0.f, 0.f, 0.f, 0.f}; } }
    U_LOAD(ufa, 0)
#pragma unroll 1
    for (int hh = 0; hh < 16; hh += 2) {
        U_LOAD(ufb, hh + 1)
        U_HALF(ufa, hh)
        if (hh + 2 < 16) U_LOAD(ufa, hh + 2)
        U_HALF(ufb, hh + 1)
    }
#undef U_LOAD
#undef U_HALF
    wave_sync();
    float o[16];
#pragma unroll
    for (int i = 0; i < 16; ++i) o[i] = 0.f;
    uint4 vfa[8], vfb[8];
#define V_LOAD(DST, J) { _Pragma("unroll") for (int u = 0; u < 8; ++u) DST[u] = *(const uint4*)(V8 + (size_t)idxl[(J) + u] * 1024 + lane * 16); }
#define V_ACC(SRC, J) { _Pragma("unroll") for (int u = 0; u < 8; ++u) { asm volatile("" ::: "memory"); const float c_ = coefl[(J) + u]; \
            const unsigned w0_ = SRC[u].x, w1_ = SRC[u].y, w2_ = SRC[u].z, w3_ = SRC[u].w; \
            f32x2_ f0, f1; \
            f0 = __builtin_amdgcn_cvt_pk_f32_fp8((int)w0_, false); f1 = __builtin_amdgcn_cvt_pk_f32_fp8((int)w0_, true); o[0] += c_ * f0[0]; o[1] += c_ * f0[1]; o[2] += c_ * f1[0]; o[3] += c_ * f1[1]; \
            f0 = __builtin_amdgcn_cvt_pk_f32_fp8((int)w1_, false); f1 = __builtin_amdgcn_cvt_pk_f32_fp8((int)w1_, true); o[4] += c_ * f0[0]; o[5] += c_ * f0[1]; o[6] += c_ * f1[0]; o[7] += c_ * f1[1]; \
            f0 = __builtin_amdgcn_cvt_pk_f32_fp8((int)w2_, false); f1 = __builtin_amdgcn_cvt_pk_f32_fp8((int)w2_, true); o[8] += c_ * f0[0]; o[9] += c_ * f0[1]; o[10] += c_ * f1[0]; o[11] += c_ * f1[1]; \
            f0 = __builtin_amdgcn_cvt_pk_f32_fp8((int)w3_, false); f1 = __builtin_amdgcn_cvt_pk_f32_fp8((int)w3_, true); o[12] += c_ * f0[0]; o[13] += c_ * f0[1]; o[14] += c_ * f1[0]; o[15] += c_ * f1[1]; } }
    V_LOAD(vfa, 0)
#pragma unroll 1
    for (int j = 0; j < 128; j += 16) {
        V_LOAD(vfb, j + 8)
        V_ACC(vfa, j)
        if (j + 16 < 128) V_LOAD(vfa, j + 16)
        V_ACC(vfb, j + 8)
    }
#undef V_LOAD
#undef V_ACC
    float tv[16]; float s = 0.f;
#pragma unroll
    for (int j = 0; j < 4; ++j) { const float4 x4 = *(const float4*)(xs + lane * 16 + j * 4);
        tv[4 * j] = DN_ALPHA * x4.x + o[4 * j]; tv[4 * j + 1] = DN_ALPHA * x4.y + o[4 * j + 1]; tv[4 * j + 2] = DN_ALPHA * x4.z + o[4 * j + 2]; tv[4 * j + 3] = DN_ALPHA * x4.w + o[4 * j + 3]; }
#pragma unroll
    for (int i = 0; i < 16; ++i) s += tv[i];
    const float mu = wave_sum(s) * (1.0f / 1024.0f);
    float q = 0.f;
#pragma unroll
    for (int i = 0; i < 16; ++i) { const float d = tv[i] - mu; q += d * d; }
    const float rstd = 1.0f / sqrtf(wave_sum(q) * (1.0f / 1024.0f) + LN_EPS);
    float* y = p.out + O_Y + (size_t)row * 1024 + lane * 16;
#pragma unroll
    for (int j = 0; j < 4; ++j) {
        const float4 g4 = *(const float4*)(p.ln2_g + lane * 16 + j * 4), b4 = *(const float4*)(p.ln2_b + lane * 16 + j * 4);
        float4 yo;
        yo.x = (tv[4 * j] - mu) * rstd * g4.x + b4.x; yo.y = (tv[4 * j + 1] - mu) * rstd * g4.y + b4.y; yo.z = (tv[4 * j + 2] - mu) * rstd * g4.z + b4.z; yo.w = (tv[4 * j + 3] - mu) * rstd * g4.w + b4.w;
        *(float4*)(y + j * 4) = yo;
    }
}

constexpr int QN = 2;
struct AttnState { f32x4 ot[4][QN]; float m[QN]; float l[QN]; };

template <bool GUARD = true>
DEV void attn_block(const unsigned char* Ks, const unsigned char* VTs, const bf16x8 (&Qf)[QN][2], AttnState& A, const int mode, const int dq, const float* blut,
                    const unsigned selbit0, const unsigned selbit1, const bool slc, const int lr, const int lq, const int t0, const int ci0) {
    f32x4 sc[4][QN];
    bf16x8 kf[4][2];
#pragma unroll
    for (int kt = 0; kt < 4; ++kt) { kf[kt][0] = *(const bf16x8*)(Ks + (kt * 16 + lr) * 144 + lq * 16); kf[kt][1] = *(const bf16x8*)(Ks + (kt * 16 + lr) * 144 + 64 + lq * 16); }
#pragma unroll
    for (int kt = 0; kt < 4; ++kt) {
#pragma unroll
        for (int qi = 0; qi < QN; ++qi) {
            f32x4 a = (f32x4){0.f, 0.f, 0.f, 0.f};
            a = __builtin_amdgcn_mfma_f32_16x16x32_bf16(kf[kt][0], Qf[qi][0], a, 0, 0, 0);
            a = __builtin_amdgcn_mfma_f32_16x16x32_bf16(kf[kt][1], Qf[qi][1], a, 0, 0, 0);
            sc[kt][qi] = a;
        }
    }
    union VF { bf16x8 v; uint2 h[2]; };
    VF vfa[2][2];
#pragma unroll
    for (int dt = 0; dt < 2; ++dt)
#pragma unroll
        for (int ks = 0; ks < 2; ++ks) {
            vfa[dt][ks].h[0] = *(const uint2*)(VTs + (dt * 16 + lr) * 144 + (32 * ks + lq * 4) * 2);
            vfa[dt][ks].h[1] = *(const uint2*)(VTs + (dt * 16 + lr) * 144 + (32 * ks + 16 + lq * 4) * 2);
        }
    if (mode != 0 || slc) {
#pragma unroll
        for (int kt = 0; kt < 4; ++kt)
#pragma unroll
            for (int qi = 0; qi < QN; ++qi)
#pragma unroll
                for (int g = 0; g < 4; ++g) {
                    const int kl = kt * 16 + lq * 4 + g, ql = qi * 16 + lr;
                    float v = sc[kt][qi][g];
                    bool ok = true;
                    if (mode == 1 || mode == 2) { const int di = dq + ql - kl; v += blut[di < 0 ? 0 : di]; }
                    if (mode == 2) ok = kl <= ql + dq;
                    if (mode == 3) ok = kl > ql + dq - 512;
                    if (mode == 4) { const int ci = ci0 + kl, dist = t0 + ql - (16 * ci + 31); ok = (dist >= 0) && (ci < 127); if (dist >= 0 && dist < 192) v += blut[dist]; }
                    if (mode == 5) { const int dist = dq - ci0 * kl; ok = (kl < t0) && (dist >= 0); if (dist >= 0 && dist < 192) v += blut[dist]; }
                    if (slc) ok = ok && ((qi == 0 ? selbit0 : selbit1) != 0u);
                    sc[kt][qi][g] = ok ? v : NEGF;
                }
    }
    bf16x8 pf[QN][2];
#pragma unroll
    for (int qi = 0; qi < QN; ++qi) {
        float mb = fmaxf(fmaxf(sc[0][qi][0], sc[0][qi][1]), sc[0][qi][2]);
        mb = fmaxf(fmaxf(mb, sc[0][qi][3]), sc[1][qi][0]); mb = fmaxf(fmaxf(mb, sc[1][qi][1]), sc[1][qi][2]); mb = fmaxf(fmaxf(mb, sc[1][qi][3]), sc[2][qi][0]);
        mb = fmaxf(fmaxf(mb, sc[2][qi][1]), sc[2][qi][2]); mb = fmaxf(fmaxf(mb, sc[2][qi][3]), sc[3][qi][0]); mb = fmaxf(fmaxf(mb, sc[3][qi][1]), sc[3][qi][2]); mb = fmaxf(mb, sc[3][qi][3]);
        mb = fmaxf(mb, __shfl_xor(mb, 16)); mb = fmaxf(mb, __shfl_xor(mb, 32));
        const float mn = fmaxf(A.m[qi], mb);
        const float alpha = __builtin_amdgcn_exp2f(A.m[qi] - mn);
        A.m[qi] = mn;
        float rs = 0.f;
#pragma unroll
        for (int kt = 0; kt < 4; ++kt)
#pragma unroll
            for (int g = 0; g < 4; ++g) { const float v = sc[kt][qi][g]; const float e = (!GUARD || v > -1e29f) ? __builtin_amdgcn_exp2f(v - mn) : 0.f; sc[kt][qi][g] = e; rs += e; }
        A.l[qi] = A.l[qi] * alpha + rs;
#pragma unroll
        for (int dt = 0; dt < 4; ++dt) A.ot[dt][qi] = A.ot[dt][qi] * alpha;
#pragma unroll
        for (int ks = 0; ks < 2; ++ks) {
            union { bf16x8 v; unsigned u[4]; } pk;
            pk.u[0] = cvt_pk_bf16(sc[2 * ks][qi][0], sc[2 * ks][qi][1]); pk.u[1] = cvt_pk_bf16(sc[2 * ks][qi][2], sc[2 * ks][qi][3]);
            pk.u[2] = cvt_pk_bf16(sc[2 * ks + 1][qi][0], sc[2 * ks + 1][qi][1]); pk.u[3] = cvt_pk_bf16(sc[2 * ks + 1][qi][2], sc[2 * ks + 1][qi][3]);
            pf[qi][ks] = pk.v;
        }
    }
    VF vfb[2][2];
#pragma unroll
    for (int dt = 0; dt < 2; ++dt)
#pragma unroll
        for (int ks = 0; ks < 2; ++ks) {
            vfb[dt][ks].h[0] = *(const uint2*)(VTs + ((dt + 2) * 16 + lr) * 144 + (32 * ks + lq * 4) * 2);
            vfb[dt][ks].h[1] = *(const uint2*)(VTs + ((dt + 2) * 16 + lr) * 144 + (32 * ks + 16 + lq * 4) * 2);
        }
#pragma unroll
    for (int dt = 0; dt < 2; ++dt)
#pragma unroll
        for (int ks = 0; ks < 2; ++ks)
#pragma unroll
            for (int qi = 0; qi < QN; ++qi) A.ot[dt][qi] = __builtin_amdgcn_mfma_f32_16x16x32_bf16(vfa[dt][ks].v, pf[qi][ks], A.ot[dt][qi], 0, 0, 0);
#pragma unroll
    for (int dt = 0; dt < 2; ++dt)
#pragma unroll
        for (int ks = 0; ks < 2; ++ks)
#pragma unroll
            for (int qi = 0; qi < QN; ++qi) A.ot[dt + 2][qi] = __builtin_amdgcn_mfma_f32_16x16x32_bf16(vfb[dt][ks].v, pf[qi][ks], A.ot[dt + 2][qi], 0, 0, 0);
}

DEV void nsa_prompt_item(const Params& p, const int b, const int hkv, const int q32, unsigned char* lds) {
    int tid_ = threadIdx.x; asm volatile("" : "+v"(tid_));
    const int tid = tid_, lane = tid & 63, g = tid >> 6, lr = lane & 15, lq = lane >> 4;
    const int hq = hkv * 4 + g, t0 = q32 * 32, kd = t0 >> 6;
    unsigned char* Ks = lds; unsigned char* VTs = lds + 9216;
    float* biasl = (float*)(lds + 36864); float* psl = (float*)(lds + 39936); unsigned* selm = (unsigned*)(lds + 44160); unsigned* misc = (unsigned*)(lds + 44288);
    const bf16_t* ZB = (const bf16_t*)(p.ws + WS_ZB);
    const bf16_t* VTS = (const bf16_t*)(p.ws + WS_VTS) + (size_t)(b * 2 + hkv) * 64 * 2048;
    const bf16_t* VTW = (const bf16_t*)(p.ws + WS_VTW) + (size_t)(b * 2 + hkv) * 64 * 2048;
    const bf16_t* KCB = (const bf16_t*)(p.ws + WS_KCB) + (size_t)(b * 2 + hkv) * 128 * 64;
    const bf16_t* VTC = (const bf16_t*)(p.ws + WS_VTC) + (size_t)(b * 2 + hkv) * 64 * 128;
    const float* Z = (const float*)(p.ws + WS_Z);
    float* NOUTF = (float*)(p.ws + WS_NOUTF);
    bf16_t* NOUTB = (bf16_t*)(p.ws + WS_NOUTB);
    __syncthreads();
    for (int i = tid; i < 4 * 192; i += 256) { const int gg = i / 192, d = i % 192; biasl[i] = (p.rel_bias[rel_bucket(d) * 8 + hkv * 4 + gg] - p.rel_bias[31 * 8 + hkv * 4 + gg]) * LOG2E; }
    for (int i = tid; i < 32 * 33; i += 256) psl[i] = 0.f;
    if (tid < 32) selm[tid] = 0u;
    if (tid == 0) misc[0] = 0u;
    const float* blut = biasl + g * 192;
    bf16x8 Qf[QN][2];
#pragma unroll
    for (int qi = 0; qi < QN; ++qi)
#pragma unroll
        for (int kk = 0; kk < 2; ++kk) Qf[qi][kk] = *(const bf16x8*)(ZB + (size_t)(b * 2048 + t0 + qi * 16 + lr) * IN_DIM + C_Q + hq * 64 + kk * 32 + lq * 8);

    unsigned msk0 = 0u, msk1 = 0u;
    uint4 trk0, trk1, trv0, trv1;
    int* blist = (int*)(lds + 44544);
    auto load_tiles = [&](int kind, int kb) __attribute__((always_inline)) {
#pragma unroll
        for (int i = 0; i < 2; ++i) {
            const int id = tid + 256 * i, row = id >> 3, ch = id & 7;
            uint4 rk, rv;
            if (kind == 0) { rk = *(const uint4*)(KCB + (size_t)(kb * 64 + row) * 64 + ch * 8); rv = *(const uint4*)(VTC + (size_t)row * 128 + kb * 64 + ch * 8); }
            else {
                rk = *(const uint4*)(ZB + (size_t)(b * 2048 + kb * 64 + row) * IN_DIM + (kind == 1 ? C_KS : C_KW) + hkv * 64 + ch * 8);
                rv = *(const uint4*)((kind == 1 ? VTS : VTW) + (size_t)row * 2048 + kb * 64 + ch * 8);
            }
            if (i == 0) { trk0 = rk; trv0 = rv; } else { trk1 = rk; trv1 = rv; }
        }
    };
    auto store_tiles = [&]() __attribute__((always_inline)) {
#pragma unroll
        for (int i = 0; i < 2; ++i) { const int id = tid + 256 * i, row = id >> 3, ch = id & 7; *(uint4*)(Ks + row * 144 + ch * 16) = (i == 0 ? trk0 : trk1); *(uint4*)(VTs + row * 144 + ch * 16) = (i == 0 ? trv0 : trv1); }
    };
    auto store_tiles_to = [&](const int off) __attribute__((always_inline)) {
#pragma unroll
        for (int i = 0; i < 2; ++i) { const int id = tid + 256 * i, row = id >> 3, ch = id & 7; *(uint4*)(Ks + off + row * 144 + ch * 16) = (i == 0 ? trk0 : trk1); *(uint4*)(VTs + off + row * 144 + ch * 16) = (i == 0 ? trv0 : trv1); }
    };
    auto run_blocks = [&](const int kind, const int nb, const bool slc, AttnState& A) __attribute__((always_inline)) {
        load_tiles(kind, blist[0]);
        __syncthreads();
        store_tiles_to(0);
        if (nb > 1) load_tiles(kind, blist[1]);
        __syncthreads();
        for (int i = 0; i < nb; ++i) {
            const int kb = blist[i], dq = t0 - kb * 64, cur = (i & 1) * 18432;
            if (i + 1 < nb) { store_tiles_to(18432 - cur); if (i + 2 < nb) load_tiles(kind, blist[i + 2]); }
            const int mode = (kb == kd) ? 2 : ((kb >= kd - 2) ? 1 : ((kind == 2 && dq + 31 >= 512) ? 3 : 0));
            attn_block<false>(Ks + cur, VTs + cur, Qf, A, mode, dq, blut, slc ? ((msk0 >> kb) & 1u) : 1u, slc ? ((msk1 >> kb) & 1u) : 1u, slc, lr, lq, t0, 0);
            __syncthreads();
        }
    };
    auto reset = [&](AttnState& A) __attribute__((always_inline)) {
#pragma unroll
        for (int qi = 0; qi < QN; ++qi) { A.m[qi] = NEGF; A.l[qi] = 0.f;
#pragma unroll
            for (int dt = 0; dt < 4; ++dt) A.ot[dt][qi] = (f32x4){0.f, 0.f, 0.f, 0.f}; }
    };
    auto finish = [&](AttnState& A, int br) __attribute__((always_inline)) {
#pragma unroll
        for (int qi = 0; qi < QN; ++qi) {
            float lt = A.l[qi]; lt += __shfl_xor(lt, 16); lt += __shfl_xor(lt, 32);
            const float sc = (lt > 0.f) ? sigmoidf_(Z[(size_t)(b * 2048 + t0 + qi * 16 + lr) * 32 + 8 + br * 8 + hq]) / lt : 0.f;
            const size_t row = (size_t)(b * 2048 + t0 + qi * 16 + lr);
#pragma unroll
            for (int dt = 0; dt < 4; ++dt) {
                const int col = hq * 64 + dt * 16 + lq * 4;
                f32x4 v = A.ot[dt][qi] * sc;
                if (br > 0) v = v + *(const f32x4*)(NOUTF + row * 512 + col);
                if (br < 2) *(f32x4*)(NOUTF + row * 512 + col) = v; else store_bf16x4(NOUTB + row * 512 + col, v);
            }
        }
    };

    AttnState A;
    const int ncb = ((t0 >> 4) >= 64) ? 2 : 1;
    reset(A);
    load_tiles(0, 0);
    for (int kb = 0; kb < ncb; ++kb) {
        __syncthreads(); store_tiles(); __syncthreads();
        if (kb + 1 < ncb) load_tiles(0, kb + 1);
        attn_block(Ks, VTs, Qf, A, 4, 0, blut, 1u, 1u, false, lr, lq, t0, kb * 64);
    }
    finish(A, 0);
    {
        float linv[QN];
#pragma unroll
        for (int qi = 0; qi < QN; ++qi) { float lt = A.l[qi]; lt += __shfl_xor(lt, 16); lt += __shfl_xor(lt, 32); linv[qi] = (lt > 0.f) ? 1.0f / lt : 0.f; }
        for (int kb = 0; kb < ncb; ++kb) {
            if (ncb > 1) { load_tiles(0, kb); __syncthreads(); store_tiles(); __syncthreads(); }
#pragma unroll
            for (int kt = 0; kt < 4; ++kt) {
                const bf16x8 k0 = *(const bf16x8*)(Ks + (kt * 16 + lr) * 144 + lq * 16), k1 = *(const bf16x8*)(Ks + (kt * 16 + lr) * 144 + 64 + lq * 16);
#pragma unroll
                for (int qi = 0; qi < QN; ++qi) {
                    f32x4 a = (f32x4){0.f, 0.f, 0.f, 0.f};
                    a = __builtin_amdgcn_mfma_f32_16x16x32_bf16(k0, Qf[qi][0], a, 0, 0, 0);
                    a = __builtin_amdgcn_mfma_f32_16x16x32_bf16(k1, Qf[qi][1], a, 0, 0, 0);
                    float pr[4];
#pragma unroll
                    for (int gg = 0; gg < 4; ++gg) {
                        const int ci = kb * 64 + kt * 16 + lq * 4 + gg, ql = qi * 16 + lr, dist = t0 + ql - (16 * ci + 31);
                        float v = a[gg];
                        if (dist >= 0 && dist < 192) v += blut[dist];
                        pr[gg] = (dist >= 0 && ci < 127) ? __builtin_amdgcn_exp2f(v - A.m[qi]) * linv[qi] : 0.f;
                    }
                    const int blk = kb * 16 + kt * 4 + lq, ql = qi * 16 + lr;
                    atomicAdd(&psl[ql * 33 + blk], 2.0f * (pr[0] + pr[1] + pr[2]) + pr[3]);
                    atomicAdd(&psl[ql * 33 + blk + 1], pr[3]);
                }
            }
        }
    }
    __syncthreads();
    {
        const int ql = tid >> 3, part = tid & 7, tq = t0 + ql, cur = tq >> 6;
        float scv[32];
#pragma unroll
        for (int j = 0; j < 32; ++j) {
            const bool causal = j * 64 <= tq, forced = (j == 0) || (j == cur) || (j == cur - 1);
            scv[j] = causal ? (forced ? 1e4f : psl[ql * 33 + j]) : NEGF;
        }
        unsigned mbits = 0u;
#pragma unroll
        for (int jj = 0; jj < 4; ++jj) {
            const int j = part * 4 + jj;
            float my = NEGF;
#pragma unroll
            for (int k = 0; k < 32; ++k) my = (k == j) ? scv[k] : my;
            int rank = 0;
#pragma unroll
            for (int k = 0; k < 32; ++k) rank += ((scv[k] > my) || (scv[k] == my && k < j)) ? 1 : 0;
            if (rank < 16 && j * 64 <= tq) mbits |= (1u << j);
        }
        atomicOr(&selm[ql], mbits);
        atomicOr(&misc[0], mbits);
    }
    __syncthreads();
    msk0 = selm[lr]; msk1 = selm[16 + lr];
    const unsigned anym = misc[0];
    reset(A);
    {
        if (tid == 0) { int n = 0; blist[n++] = kd; for (int j = 0; j < kd; ++j) if ((anym >> j) & 1u) blist[n++] = j; blist[40] = n; }
        __syncthreads();
        run_blocks(1, blist[40], true, A);
    }
    finish(A, 1);
    reset(A);
    {
        const int klo = (t0 >= 511) ? ((t0 - 511) >> 6) : 0;
        __syncthreads();
        if (tid < 33 && tid <= kd - klo) blist[tid] = kd - tid;
        __syncthreads();
        run_blocks(2, kd - klo + 1, false, A);
    }
    finish(A, 2);
}

DEV void nsa_sample_item(const Params& p, const int b, const int hkv, unsigned char* lds) {
    int tid_ = threadIdx.x; asm volatile("" : "+v"(tid_));
    const int tid = tid_, lane = tid & 63, g = tid >> 6, lr = lane & 15, lq = lane >> 4;
    const int hq = hkv * 4 + g;
    unsigned char* Ks = lds; unsigned char* VTs = lds + 9216;
    float* biasl = (float*)(lds + 18432); float* psl = (float*)(lds + 21504); int* sell = (int*)(lds + 29952); float* scl = (float*)(lds + 30720);
    const bf16_t* ZB = (const bf16_t*)(p.ws + WS_ZB);
    const float* zgate = (const float*)(p.ws + WS_Z) + (size_t)(NP + b) * 32 + 8;
    const bf16_t* zbrow = ZB + (size_t)(NP + b) * IN_DIM;
    const bf16_t* KCSB = (const bf16_t*)(p.ws + WS_KCSB) + (size_t)(b * 2 + hkv) * 1024 * 64;
    const bf16_t* VTCS = (const bf16_t*)(p.ws + WS_VTCS) + (size_t)(b * 2 + hkv) * 64 * 1024;
    bf16_t* NOUTB = (bf16_t*)(p.ws + WS_NOUTB);
    __syncthreads();
    for (int i = tid; i < 4 * 192; i += 256) { const int gg = i / 192, d = i % 192; biasl[i] = (p.rel_bias[rel_bucket(d) * 8 + hkv * 4 + gg] - p.rel_bias[31 * 8 + hkv * 4 + gg]) * LOG2E; }
    for (int i = tid; i < 260; i += 256) psl[i] = 0.f;
    const float* blut = biasl + g * 192;
    bf16x8 Qf[QN][2];
#pragma unroll
    for (int kk = 0; kk < 2; ++kk) { Qf[0][kk] = *(const bf16x8*)(ZB + (size_t)(NP + b) * IN_DIM + C_Q + hq * 64 + kk * 32 + lq * 8); Qf[1][kk] = Qf[0][kk]; }
    AttnState A;
    auto reset = [&](AttnState& S_) __attribute__((always_inline)) {
#pragma unroll
        for (int qi = 0; qi < QN; ++qi) { S_.m[qi] = NEGF; S_.l[qi] = 0.f;
#pragma unroll
            for (int dt = 0; dt < 4; ++dt) S_.ot[dt][qi] = (f32x4){0.f, 0.f, 0.f, 0.f}; }
    };
    f32x4 res[4];
#pragma unroll
    for (int dt = 0; dt < 4; ++dt) res[dt] = (f32x4){0.f, 0.f, 0.f, 0.f};
    auto finish = [&](AttnState& S_, int br) __attribute__((always_inline)) {
        float lt = S_.l[0]; lt += __shfl_xor(lt, 16); lt += __shfl_xor(lt, 32);
        const float sc = (lt > 0.f) ? sigmoidf_(zgate[br * 8 + hq]) / lt : 0.f;
#pragma unroll
        for (int dt = 0; dt < 4; ++dt) res[dt] = res[dt] + S_.ot[dt][0] * sc;
    };
    uint4 trk0, trk1, trv0, trv1;
    auto load_cmp = [&](int kb) __attribute__((always_inline)) {
#pragma unroll
        for (int i = 0; i < 2; ++i) {
            const int id = tid + 256 * i, row = id >> 3, ch = id & 7;
            const uint4 rk = *(const uint4*)(KCSB + (size_t)(kb * 64 + row) * 64 + ch * 8), rv = *(const uint4*)(VTCS + (size_t)row * 1024 + kb * 64 + ch * 8);
            if (i == 0) { trk0 = rk; trv0 = rv; } else { trk1 = rk; trv1 = rv; }
        }
    };
    auto store_cmp = [&]() __attribute__((always_inline)) {
#pragma unroll
        for (int i = 0; i < 2; ++i) { const int id = tid + 256 * i, row = id >> 3, ch = id & 7; *(uint4*)(Ks + row * 144 + ch * 16) = (i == 0 ? trk0 : trk1); *(uint4*)(VTs + row * 144 + ch * 16) = (i == 0 ? trv0 : trv1); }
    };
    reset(A);
    load_cmp(0);
    for (int kb = 0; kb < 16; ++kb) {
        __syncthreads(); store_cmp(); __syncthreads();
        if (kb + 1 < 16) load_cmp(kb + 1);
        attn_block<false>(Ks, VTs, Qf, A, 5, PAST - 31 - 16 * (kb * 64), blut, 1u, 1u, false, lr, lq, (kb == 15) ? 63 : 64, 16);
    }
    finish(A, 0);
    {
        float lt = A.l[0]; lt += __shfl_xor(lt, 16); lt += __shfl_xor(lt, 32);
        const float linv = (lt > 0.f) ? 1.0f / lt : 0.f;
        for (int kb = 0; kb < 16; ++kb) {
            load_cmp(kb); __syncthreads(); store_cmp(); __syncthreads();
#pragma unroll
            for (int kt = 0; kt < 4; ++kt) {
                const bf16x8 k0 = *(const bf16x8*)(Ks + (kt * 16 + lr) * 144 + lq * 16), k1 = *(const bf16x8*)(Ks + (kt * 16 + lr) * 144 + 64 + lq * 16);
                f32x4 a = (f32x4){0.f, 0.f, 0.f, 0.f};
                a = __builtin_amdgcn_mfma_f32_16x16x32_bf16(k0, Qf[0][0], a, 0, 0, 0);
                a = __builtin_amdgcn_mfma_f32_16x16x32_bf16(k1, Qf[0][1], a, 0, 0, 0);
                float pr[4];
#pragma unroll
                for (int gg = 0; gg < 4; ++gg) {
                    const int ci = kb * 64 + kt * 16 + lq * 4 + gg, dist = PAST - 31 - 16 * ci;
                    float v = a[gg];
                    if (dist >= 0 && dist < 192) v += blut[dist];
                    pr[gg] = (ci < 1023) ? __builtin_amdgcn_exp2f(v - A.m[0]) * linv : 0.f;
                }
                if (lr == 0) {
                    const int blk = kb * 16 + kt * 4 + lq;
                    atomicAdd(&psl[blk], 2.0f * (pr[0] + pr[1] + pr[2]) + pr[3]);
                    atomicAdd(&psl[blk + 1], pr[3]);
                }
            }
        }
    }
    __syncthreads();
    for (int j = tid; j < 257; j += 256) scl[j] = (j == 0 || j == 256 || j == 255) ? 1e4f : psl[j];
    __syncthreads();
    for (int j = tid; j < 257; j += 256) {
        const float my = scl[j];
        int rank = 0;
        for (int k = 0; k < 257; ++k) { const float o2 = scl[k]; rank += ((o2 > my) || (o2 == my && k < j)) ? 1 : 0; }
        if (rank < 16) sell[rank] = j;
    }
    __syncthreads();
    uint4 rk0, rk1; unsigned rv0, rv1, rv2, rv3, rv4, rv5, rv6, rv7;
    auto load_rows = [&](const float* src, const bf16_t* srcb) __attribute__((always_inline)) {
        const int seg = tid & 3;
        if (srcb) {
            const bf16_t* kp = srcb + hkv * 64 + seg * 16; const bf16_t* vp = kp + 128;
            rk0 = *(const uint4*)kp; rk1 = *(const uint4*)(kp + 8);
            const uint4 v0 = *(const uint4*)vp, v1 = *(const uint4*)(vp + 8);
            rv0 = v0.x; rv1 = v0.y; rv2 = v0.z; rv3 = v0.w; rv4 = v1.x; rv5 = v1.y; rv6 = v1.z; rv7 = v1.w;
        } else {
            const bool nz = src != nullptr;
            const float* kp = (nz ? src : p.state_win) + hkv * 64 + seg * 16; const float* vp = kp + 128;
            const float4 a0 = *(const float4*)kp, a1 = *(const float4*)(kp + 4), a2 = *(const float4*)(kp + 8), a3 = *(const float4*)(kp + 12);
            const float4 c0 = *(const float4*)vp, c1 = *(const float4*)(vp + 4), c2 = *(const float4*)(vp + 8), c3 = *(const float4*)(vp + 12);
            const unsigned mk = nz ? 0xffffffffu : 0u;
            rk0.x = cvt_pk_bf16(a0.x, a0.y) & mk; rk0.y = cvt_pk_bf16(a0.z, a0.w) & mk; rk0.z = cvt_pk_bf16(a1.x, a1.y) & mk; rk0.w = cvt_pk_bf16(a1.z, a1.w) & mk;
            rk1.x = cvt_pk_bf16(a2.x, a2.y) & mk; rk1.y = cvt_pk_bf16(a2.z, a2.w) & mk; rk1.z = cvt_pk_bf16(a3.x, a3.y) & mk; rk1.w = cvt_pk_bf16(a3.z, a3.w) & mk;
            rv0 = cvt_pk_bf16(c0.x, c0.y) & mk; rv1 = cvt_pk_bf16(c0.z, c0.w) & mk; rv2 = cvt_pk_bf16(c1.x, c1.y) & mk; rv3 = cvt_pk_bf16(c1.z, c1.w) & mk;
            rv4 = cvt_pk_bf16(c2.x, c2.y) & mk; rv5 = cvt_pk_bf16(c2.z, c2.w) & mk; rv6 = cvt_pk_bf16(c3.x, c3.y) & mk; rv7 = cvt_pk_bf16(c3.z, c3.w) & mk;
        }
    };
    auto store_rows = [&]() __attribute__((always_inline)) {
        const int kl = tid >> 2, seg = tid & 3;
        *(uint4*)(Ks + kl * 144 + seg * 32) = rk0; *(uint4*)(Ks + kl * 144 + seg * 32 + 16) = rk1;
#define VT_PUT(i_, w_) { *(bf16_t*)(VTs + (seg * 16 + (i_)) * 144 + kl * 2) = (bf16_t)((w_) & 0xffffu); *(bf16_t*)(VTs + (seg * 16 + (i_) + 1) * 144 + kl * 2) = (bf16_t)((w_) >> 16); }
        VT_PUT(0, rv0) VT_PUT(2, rv1) VT_PUT(4, rv2) VT_PUT(6, rv3) VT_PUT(8, rv4) VT_PUT(10, rv5) VT_PUT(12, rv6) VT_PUT(14, rv7)
#undef VT_PUT
    };
    auto slc_row = [&](int blk) __attribute__((always_inline)) -> const float* {
        const int kl = tid >> 2;
        if (blk < 256) { const int page = p.page_table[b * 128 + (blk >> 1)]; return p.cache_slc + ((size_t)page * 128 + (blk & 1) * 64 + kl) * 256; }
        return nullptr;
    };
    auto slc_rowb = [&](int blk) __attribute__((always_inline)) -> const bf16_t* { return (blk == 256 && (tid >> 2) == 0) ? zbrow + C_KS : nullptr; };
    reset(A);
    load_rows(slc_row(sell[0]), slc_rowb(sell[0]));
    for (int si = 0; si < 16; ++si) {
        const int blk = sell[si];
        __syncthreads(); store_rows(); __syncthreads();
        if (si + 1 < 16) load_rows(slc_row(sell[si + 1]), slc_rowb(sell[si + 1]));
        attn_block<false>(Ks, VTs, Qf, A, 5, PAST - blk * 64, blut, 1u, 1u, false, lr, lq, (blk == 256) ? 1 : 64, 1);
    }
    finish(A, 1);
    auto win_row = [&](int wb) __attribute__((always_inline)) -> const float* {
        const int j = 1 + wb * 64 + (tid >> 2);
        return (j < 512) ? p.state_win + ((size_t)b * 512 + j) * 256 : nullptr;
    };
    auto win_rowb = [&](int wb) __attribute__((always_inline)) -> const bf16_t* { return (1 + wb * 64 + (tid >> 2) == 512) ? zbrow + C_KW : nullptr; };
    reset(A);
    load_rows(win_row(0), win_rowb(0));
    for (int wb = 0; wb < 8; ++wb) {
        __syncthreads(); store_rows(); __syncthreads();
        if (wb + 1 < 8) load_rows(win_row(wb + 1), win_rowb(wb + 1));
        attn_block<false>(Ks, VTs, Qf, A, 5, 511 - wb * 64, blut, 1u, 1u, false, lr, lq, 64, 1);
    }
    finish(A, 2);
    if (lr == 0) {
#pragma unroll
        for (int dt = 0; dt < 4; ++dt) store_bf16x4(NOUTB + (size_t)(NP + b) * 512 + hq * 64 + dt * 16 + lq * 4, res[dt]);
    }
}

DEV int otid() { int t = threadIdx.x; asm volatile("" : "+v"(t)); return t; }
#define Z ((float*)(p.ws + WS_Z))
#define QK ((float*)(p.ws + WS_QK))
#define HRAW ((float*)(p.ws + WS_HRAW))
#define MOUTB ((bf16_t*)(p.ws + WS_MOUTB))
#define NOUTB ((bf16_t*)(p.ws + WS_NOUTB))
#define HIDPB ((bf16_t*)(p.ws + WS_HIDPB))
#define HIDSB ((bf16_t*)(p.ws + WS_HIDSB))
#define KCS ((float*)(p.ws + WS_KCS))
#define MIX ((float*)(p.ws + WS_MIX))
#define MIXB ((bf16_t*)(p.ws + WS_MIXB))
#define T1 ((float*)(p.ws + WS_T1))
#define X1 ((float*)(p.ws + WS_X1))
#define X1B ((bf16_t*)(p.ws + WS_X1B))
#define QPB ((bf16_t*)(p.ws + WS_QPB))
#define S ((float*)(p.ws + WS_S))
#define CONVB ((bf16_t*)(p.ws + WS_CONVB))
#define XB ((bf16_t*)(p.ws + WS_XB))
#define WIN_T ((bf16_t*)(p.ws + WS_WIN_T))
#define WUPM_T ((bf16_t*)(p.ws + WS_WUPM_T))
#define WUPN_T ((bf16_t*)(p.ws + WS_WUPN_T))
#define WOUT_T ((bf16_t*)(p.ws + WS_WOUT_T))
#define PWQ_T ((bf16_t*)(p.ws + WS_PWQ_T))
#define WQK_T ((bf16_t*)(p.ws + WS_WQK_T))
#define W1_T ((bf16_t*)(p.ws + WS_W1_T))
#define W2_T ((bf16_t*)(p.ws + WS_W2_T))
#define SUBK ((bf16_t*)(p.ws + WS_SUBK))
#define ZB ((bf16_t*)(p.ws + WS_ZB))
#define VTS ((bf16_t*)(p.ws + WS_VTS))
#define VTW ((bf16_t*)(p.ws + WS_VTW))
#define KCB ((bf16_t*)(p.ws + WS_KCB))
#define VTC ((bf16_t*)(p.ws + WS_VTC))
__global__ void __launch_bounds__(NTHREADS, 2) fwd_kernel(Params p) {
    extern __shared__ __attribute__((aligned(16))) unsigned char smem[];
    if (threadIdx.x == 0) { *(uint4*)smem = make_uint4(0u, 0u, 0u, 0u); }
    __syncthreads();
    XcdBarrier bar = xcd_barrier_post((unsigned*)(p.ws + WS_BAR), (volatile LAS unsigned*)smem);
    float* lds = (float*)(smem + 16);
    unsigned char* ldsb = smem + 16;
#define TID_ (otid())
#define LANE_ (otid() & 63)
#define WV_ (otid() >> 6)
#define GW_ ((int)(blockIdx.x * 4 + (otid() >> 6)))
#define GT_ ((size_t)blockIdx.x * NTHREADS + otid())
    const int nw = gridDim.x * 4;
    const size_t nt = (size_t)gridDim.x * NTHREADS;


    {
        for (size_t id = GT_; id < (size_t)MP * 128; id += nt) {
            const int row = (int)(id >> 7), k8 = (int)(id & 127) * 8;
            float f[8];
            if (row < NR) {
                const float* s = (row < NP ? p.x_prompt + (size_t)row * 1024 : p.x_sample + (size_t)(row - NP) * 1024) + k8;
                const float4 a = *(const float4*)s, b = *(const float4*)(s + 4);
                f[0] = a.x; f[1] = a.y; f[2] = a.z; f[3] = a.w; f[4] = b.x; f[5] = b.y; f[6] = b.z; f[7] = b.w;
            } else {
#pragma unroll
                for (int i = 0; i < 8; ++i) f[i] = 0.f;
            }
            *(uint4*)(XB + (size_t)row * 1024 + k8) = pack8(f);
        }
        transpose_to_bf16(p.w_in, 1024, IN_DIM, WIN_T, GT_, nt);
        transpose_to_bf16(p.w_up_m, 512, 1024, WUPM_T, GT_, nt);
        transpose_to_bf16(p.w_up_n, 512, 1024, WUPN_T, GT_, nt);
        transpose_to_bf16(p.w_out, 1024, 1024, WOUT_T, GT_, nt);
        transpose_to_bf16(p.peer_wq, 1024, 2048, PWQ_T, GT_, nt);
        for (int h = 0; h < 4; ++h) {
            transpose_to_bf16(p.wq + (size_t)h * 16384, 128, 128, WQK_T + (size_t)(h * 256) * 128, GT_, nt);
            transpose_to_bf16(p.wk + (size_t)h * 16384, 128, 128, WQK_T + (size_t)(h * 256 + 128) * 128, GT_, nt);
        }
        for (size_t id = GT_; id < (size_t)2 * 128 * 128; id += nt) {
            const int k8 = (int)(id & 127) * 8, np = (int)((id >> 7) & 127), c = (int)(id >> 14);
            const int pp = np >> 6, o = np & 63, r = k8 >> 6, d = k8 & 63;
            float f[8];
#pragma unroll
            for (int e = 0; e < 8; ++e) f[e] = p.cmp_w1[((size_t)c * 2048 + (pp * 16 + r) * 64 + d + e) * 64 + o];
            *(uint4*)(W1_T + ((size_t)c * 128 + np) * 1024 + k8) = pack8(f);
        }
        if (GT_ < 128) {
            const int c = (int)GT_ >> 6, o = (int)GT_ & 63;
            float a = 0.f;
            for (int k = 0; k < 2048; ++k) a += p.cmp_pe[c * 2048 + k] * p.cmp_w1[((size_t)c * 2048 + k) * 64 + o];
            ((float*)(p.ws + WS_PESUM))[GT_] = a;
        }
        for (int c = 0; c < 2; ++c) transpose_to_bf16(p.cmp_w2 + (size_t)c * 4096, 64, 64, W2_T + (size_t)c * 4096, GT_, nt);
        for (size_t id = GT_; id < (size_t)2 * 128 * 128 / 8; id += nt) {
            float f[8];
#pragma unroll
            for (int i = 0; i < 8; ++i) f[i] = p.peer_sub[id * 8 + i];
            *(uint4*)(SUBK + id * 8) = pack8(f);
        }
        for (size_t id = GT_; id < (size_t)16384 * 64; id += nt) {
            const float* su = p.peer_u + id * 16; const float* sv = p.peer_v + id * 16;
            uint4 ou, ov; unsigned* pu = (unsigned*)&ou; unsigned* pv = (unsigned*)&ov;
#pragma unroll
            for (int j = 0; j < 4; ++j) {
                const float4 a4 = *(const float4*)(su + j * 4), c4 = *(const float4*)(sv + j * 4);
                pu[j] = pack4_fp8(a4.x * PEER_U_SCALE, a4.y * PEER_U_SCALE, a4.z * PEER_U_SCALE, a4.w * PEER_U_SCALE);
                pv[j] = pack4_fp8(c4.x * PEER_V_SCALE, c4.y * PEER_V_SCALE, c4.z * PEER_V_SCALE, c4.w * PEER_V_SCALE);
            }
            *(uint4*)(p.ws + WS_U8 + id * 16) = ou; *(uint4*)(p.ws + WS_V8 + id * 16) = ov;
        }
        for (size_t i = GT_; i < (size_t)BS * 511 * 256; i += nt) {
            const int j = (int)(i & 255); const int wv = (int)((i >> 8) % 511); const int b = (int)((i >> 8) / 511);
            p.out[O_WINS + ((size_t)b * 512 + wv) * 256 + j] = p.state_win[((size_t)b * 512 + wv + 1) * 256 + j];
        }
        for (size_t i = GT_; i < (size_t)BS * 2 * 512; i += nt) {
            const int ch = (int)(i & 511); const int jj = (int)((i >> 9) & 1); const int b = (int)(i >> 10);
            p.out[O_CVS + ((size_t)b * 3 + jj) * 512 + ch] = p.state_conv[((size_t)b * 3 + jj + 1) * 512 + ch];
        }
    }
    xcd_barrier(bar);

    gemm_glds_xcd(NR, IN_DIM, 1024,
        [&](int r, int k) { return XB + (size_t)r * 1024 + k; },
        [&](int n, int k) { return WIN_T + (size_t)n * 1024 + k; },
        [&](int r, int c0, f32x4 v) {
            if (c0 >= C_I && c0 < C_Q) *(f32x4*)(Z + (size_t)r * 32 + (c0 - C_I)) = v;
            else if (c0 >= C_G && c0 < C_GM) *(f32x4*)(Z + (size_t)r * 32 + 8 + (c0 - C_G)) = v;
            store_bf16x4(ZB + (size_t)r * IN_DIM + c0, (c0 >= C_Q && c0 < C_KC) ? v * (0.125f * LOG2E) : v);
            if (r < NP && ((c0 >= C_KS + 128 && c0 < C_KW) || (c0 >= C_KW + 128 && c0 < C_G))) {
                const bool isw = c0 >= C_KW; const int cc = c0 - (isw ? C_KW : C_KS) - 128;
                bf16_t* vt = (isw ? VTW : VTS) + ((size_t)((r >> 11) * 2) * 64 + cc) * 2048 + (r & 2047);
                const unsigned w0 = cvt_pk_bf16(v[0], v[1]), w1 = cvt_pk_bf16(v[2], v[3]);
                vt[0] = (bf16_t)(w0 & 0xffffu); vt[2048] = (bf16_t)(w0 >> 16); vt[4096] = (bf16_t)(w1 & 0xffffu); vt[6144] = (bf16_t)(w1 >> 16);
            }
            if (r < NP && c0 >= C_V && c0 < C_O) {
                bf16_t* vt = (bf16_t*)(p.ws + WS_VTM) + ((size_t)(r >> 11) * 512 + (c0 - C_V)) * 2048 + (r & 2047);
                const unsigned w0 = cvt_pk_bf16(v[0], v[1]), w1 = cvt_pk_bf16(v[2], v[3]);
                vt[0] = (bf16_t)(w0 & 0xffffu); vt[2048] = (bf16_t)(w0 >> 16); vt[4096] = (bf16_t)(w1 & 0xffffu); vt[6144] = (bf16_t)(w1 >> 16);
            }
            if (c0 >= C_KC && c0 < C_KS) *(f32x4*)(p.out + O_CMPP + (size_t)r * 256 + (c0 - C_KC)) = v;
            else if (c0 >= C_KS && c0 < C_KW) *(f32x4*)(p.out + O_SLCP + (size_t)r * 256 + (c0 - C_KS)) = v;
            else if (c0 >= C_KW && c0 < C_G) {
                if (r < NP) { const int t = r & 2047; if (t >= 1536) *(f32x4*)(p.out + O_WINP + ((size_t)(r >> 11) * 512 + (t - 1536)) * 256 + (c0 - C_KW)) = v; }
                else *(f32x4*)(p.out + O_WINS + ((size_t)(r - NP) * 512 + 511) * 256 + (c0 - C_KW)) = v;
            } else if (c0 < C_V) {
                if (r < NP) { const int t = r & 2047; if (t >= 2045) *(f32x4*)(p.out + O_CVP + ((size_t)(r >> 11) * 3 + (t - 2045)) * 512 + c0) = v; }
                else *(f32x4*)(p.out + O_CVS + ((size_t)(r - NP) * 3 + 2) * 512 + c0) = v;
            }
        }, smem + 1024);
    xcd_barrier(bar);

    for (size_t i = GT_; i < (size_t)NR * 64; i += nt) {
        const int ch = (int)(i & 63) * 8; const int r = (int)(i >> 6);
        float a[8];
        { const float4 b0 = *(const float4*)(p.conv_b + ch), b1 = *(const float4*)(p.conv_b + ch + 4); a[0] = b0.x; a[1] = b0.y; a[2] = b0.z; a[3] = b0.w; a[4] = b1.x; a[5] = b1.y; a[6] = b1.z; a[7] = b1.w; }
#pragma unroll
        for (int j = 0; j < 4; ++j) {
            const float4 w0 = *(const float4*)(p.conv_w + j * 512 + ch), w1 = *(const float4*)(p.conv_w + j * 512 + ch + 4);
            float u[8]; bool have = true;
            if (r < NP) {
                const int t = r & 2047;
                if (t + j - 3 >= 0) { const uint4 q = *(const uint4*)(ZB + (size_t)(r + j - 3) * IN_DIM + C_U + ch);
                    u[0] = bf_lo(q.x); u[1] = bf_hi(q.x); u[2] = bf_lo(q.y); u[3] = bf_hi(q.y); u[4] = bf_lo(q.z); u[5] = bf_hi(q.z); u[6] = bf_lo(q.w); u[7] = bf_hi(q.w); }
                else have = false;
            } else if (j < 3) {
                const float* sc = p.state_conv + ((size_t)(r - NP) * 3 + j) * 512 + ch;
                const float4 s0 = *(const float4*)sc, s1 = *(const float4*)(sc + 4);
                u[0] = s0.x; u[1] = s0.y; u[2] = s0.z; u[3] = s0.w; u[4] = s1.x; u[5] = s1.y; u[6] = s1.z; u[7] = s1.w;
            } else { const uint4 q = *(const uint4*)(ZB + (size_t)r * IN_DIM + C_U + ch);
                u[0] = bf_lo(q.x); u[1] = bf_hi(q.x); u[2] = bf_lo(q.y); u[3] = bf_hi(q.y); u[4] = bf_lo(q.z); u[5] = bf_hi(q.z); u[6] = bf_lo(q.w); u[7] = bf_hi(q.w); }
            if (have) { a[0] += w0.x * u[0]; a[1] += w0.y * u[1]; a[2] += w0.z * u[2]; a[3] += w0.w * u[3]; a[4] += w1.x * u[4]; a[5] += w1.y * u[5]; a[6] += w1.z * u[6]; a[7] += w1.w * u[7]; }
        }
#pragma unroll
        for (int e = 0; e < 8; ++e) a[e] = a[e] / (1.0f + expf(-a[e]));
        *(uint4*)(CONVB + (size_t)r * 512 + ch) = pack8(a);
    }
    xcd_barrier(bar);

    for (int h = 0; h < 4; ++h) {
        gemm_glds(NR, 256, 128,
            [&](int r, int k) { return CONVB + (size_t)r * 512 + h * 128 + k; },
            [&](int n, int k) { return WQK_T + (size_t)(h * 256 + n) * 128 + k; },
            [&](int r, int c0, f32x4 v) {
                if (c0 >= 128) v = v * 0.08838834764831845f;
                if (c0 < 128) store_bf16x4((bf16_t*)(p.ws + WS_QB) + (size_t)r * 512 + h * 128 + c0, v);
                else {
                    store_bf16x4((bf16_t*)(p.ws + WS_KB) + (size_t)r * 512 + h * 128 + (c0 - 128), v);
                    if (r < NP) {
                        bf16_t* kt = (bf16_t*)(p.ws + WS_KTB) + ((size_t)((r >> 11) * 4 + h) * 128 + (c0 - 128)) * 2048 + (r & 2047);
                        const unsigned w0 = cvt_pk_bf16(v[0], v[1]), w1 = cvt_pk_bf16(v[2], v[3]);
                        kt[0] = (bf16_t)(w0 & 0xffffu); kt[2048] = (bf16_t)(w0 >> 16); kt[4096] = (bf16_t)(w1 & 0xffffu); kt[6144] = (bf16_t)(w1 >> 16);
                    }
                } }, smem + 1024, h * 514);
    }
    for (int c = 0; c < 2; ++c) {
        for (int grp = 0; grp < 2; ++grp) {
            const int TPB = grp ? 9 : 1, NCH = grp ? 1024 : 128, NBH = grp ? 64 : 32;
            struct CmpLoader {
                const Params& p; const bf16_t* zb; int c, grp, TPB, NCH;
                DEV const unsigned char* prep(int vrow) const {
                    const int tile = vrow >> 7, bh = tile / TPB, n_ = 127 * (tile % TPB) + (vrow & 127), n = n_ < NCH ? n_ : NCH - 1;
                    const int b = bh >> 1, hh = bh & 1, tok = 16 * n;
                    if (!grp) return (const unsigned char*)(zb + ((size_t)b * 2048 + tok) * IN_DIM + C_KC + c * 128 + hh * 64);
                    const int page = p.page_table[b * 128 + (tok >> 7)];
                    return (const unsigned char*)(p.cache_cmp + ((size_t)page * 128 + (tok & 127)) * 256 + c * 128 + hh * 64);
                }
                struct Raw { float4 a0, a1; };
                DEV Raw load(const unsigned char* ctx, int k) const {
                    const int r = k >> 6, d0 = k & 63;
                    Raw q;
                    if (!grp) { const uint4 u = *(const uint4*)((const bf16_t*)ctx + (size_t)r * IN_DIM + d0); q.a0 = make_float4(__uint_as_float(u.x), __uint_as_float(u.y), __uint_as_float(u.z), __uint_as_float(u.w)); q.a1 = q.a0; }
                    else { const float* sp = (const float*)ctx + r * 256 + d0; q.a0 = *(const float4*)sp; q.a1 = *(const float4*)(sp + 4); }
                    return q;
                }
                DEV uint4 pack(const Raw& q) const {
                    if (!grp) return make_uint4(__float_as_uint(q.a0.x), __float_as_uint(q.a0.y), __float_as_uint(q.a0.z), __float_as_uint(q.a0.w));
                    float f[8] = {q.a0.x, q.a0.y, q.a0.z, q.a0.w, q.a1.x, q.a1.y, q.a1.z, q.a1.w};
                    return pack8(f);
                }
            };
            gemm_bf16<128, true>(NBH * TPB * 128, 128, 1024,
                CmpLoader{p, ZB, c, grp, TPB, NCH},
                [&](int n, int k) { return *(const uint4*)(W1_T + ((size_t)c * 128 + n) * 1024 + k); },
                [&](f32x4 (&acc)[4][4], int bm) {
                    const int lr = LANE_ & 15, lq = LANE_ >> 4, wm = WV_ >> 1, wn = WV_ & 1;
                    const int tile = bm >> 7, bh = tile / TPB, n0 = 127 * (tile % TPB);
                    float* P1 = (float*)ldsb;
                    bf16_t* HL = (bf16_t*)(ldsb + 128 * 68 * 4);
                    __syncthreads();
                    if (wn == 1) {
#pragma unroll
                        for (int i = 0; i < 4; ++i)
#pragma unroll
                            for (int j = 0; j < 4; ++j) *(f32x4*)(P1 + (wm * 64 + i * 16 + lr) * 68 + j * 16 + lq * 4) = acc[i][j];
                    }
                    __syncthreads();
                    if (wn == 0) {
                        const float* pes = (const float*)(p.ws + WS_PESUM) + c * 64;
#pragma unroll
                        for (int i = 0; i < 4; ++i)
#pragma unroll
                            for (int j = 0; j < 4; ++j) {
                                const int rl = wm * 64 + i * 16 + lr, o0 = j * 16 + lq * 4;
                                const f32x4 nx = (rl < 127) ? *(const f32x4*)(P1 + (rl + 1) * 68 + o0) : (f32x4){0.f, 0.f, 0.f, 0.f};
                                const f32x4 pe4 = *(const f32x4*)(pes + o0);
                                f32x4 hv = acc[i][j] + nx + pe4;
                                hv[0] = gelu_tanh(hv[0]); hv[1] = gelu_tanh(hv[1]); hv[2] = gelu_tanh(hv[2]); hv[3] = gelu_tanh(hv[3]);
                                store_bf16x4(HL + rl * 72 + o0, hv);
                            }
                    }
                    __syncthreads();
                    f32x4 kc[2][4];
#pragma unroll
                    for (int i = 0; i < 2; ++i)
#pragma unroll
                        for (int j = 0; j < 4; ++j) kc[i][j] = (f32x4){0.f, 0.f, 0.f, 0.f};
#pragma unroll
                    for (int ks = 0; ks < 2; ++ks) {
                        bf16x8 hf[2], wf[4];
#pragma unroll
                        for (int i = 0; i < 2; ++i) hf[i] = *(const bf16x8*)(HL + (WV_ * 32 + i * 16 + lr) * 72 + ks * 32 + lq * 8);
#pragma unroll
                        for (int j = 0; j < 4; ++j) wf[j] = *(const bf16x8*)(W2_T + ((size_t)c * 64 + j * 16 + lr) * 64 + ks * 32 + lq * 8);
#pragma unroll
                        for (int i = 0; i < 2; ++i)
#pragma unroll
                            for (int j = 0; j < 4; ++j) kc[i][j] = __builtin_amdgcn_mfma_f32_16x16x32_bf16(wf[j], hf[i], kc[i][j], 0, 0, 0);
                    }
#pragma unroll
                    for (int i = 0; i < 2; ++i) {
                        const int rl = WV_ * 32 + i * 16 + lr, blk = n0 + rl;
                        if (rl < 127 && blk <= NCH - 2) {
#pragma unroll
                            for (int j = 0; j < 4; ++j) {
                                const int o2 = j * 16 + lq * 4;
                                if (c == 0) store_bf16x4((grp ? (bf16_t*)(p.ws + WS_KCSB) : KCB) + ((size_t)bh * NCH + blk) * 64 + o2, kc[i][j]);
                                else { bf16_t* vt = (grp ? (bf16_t*)(p.ws + WS_VTCS) : VTC) + ((size_t)bh * 64 + o2) * NCH + blk;
                                       const unsigned w0 = cvt_pk_bf16(kc[i][j][0], kc[i][j][1]), w1 = cvt_pk_bf16(kc[i][j][2], kc[i][j][3]);
                                       vt[0] = (bf16_t)(w0 & 0xffffu); vt[NCH] = (bf16_t)(w0 >> 16); vt[2 * NCH] = (bf16_t)(w1 & 0xffffu); vt[3 * NCH] = (bf16_t)(w1 >> 16); }
                            }
                        }
                    }
                    __syncthreads();
                }, ldsb, 4 * 514 + c * 608 + grp * 32);
        }
    }
    xcd_barrier(bar);

    for (;;) {
        __syncthreads();
        if (TID_ == 0) *(volatile int*)(ldsb + 45056) = (int)atomicAdd((unsigned*)(p.ws + WS_BAR) + 2, 1u);
        __syncthreads();
        const int idx = *(volatile int*)(ldsb + 45056);
        if (idx >= 448 + 2048) break;
        if (idx < 256) mlstm_chunk_item(p, idx, ldsb);
        else if (idx < 384) mlstm_step_item(p, idx - 256, lds);
        else if (idx < 448) nsa_sample_item(p, (idx - 384) >> 1, idx & 1, ldsb);
        else { const int i2 = idx - 448; nsa_prompt_item(p, (i2 & 31) >> 1, i2 & 1, 63 - (i2 >> 5), ldsb); }
    }
    xcd_barrier(bar);

    for (int row = GW_; row < NR; row += nw) {
        const float* hr = HRAW + (size_t)row * 512 + LANE_ * 8;
        const float4 h0 = *(const float4*)hr, h1 = *(const float4*)(hr + 4);
        float x[8] = {h0.x, h0.y, h0.z, h0.w, h1.x, h1.y, h1.z, h1.w};
        float sm = 0.f;
#pragma unroll
        for (int e = 0; e < 8; ++e) sm += x[e];
        const float mu = dpp_sum16(sm) * (1.0f / 128.0f);
        float q = 0.f;
#pragma unroll
        for (int e = 0; e < 8; ++e) { x[e] -= mu; q += x[e] * x[e]; }
        const float rstd = 1.0f / sqrtf(dpp_sum16(q) * (1.0f / 128.0f) + LN_EPS);
        const uint4 og = *(const uint4*)(ZB + (size_t)row * IN_DIM + C_O + LANE_ * 8);
        const float4 g0 = *(const float4*)(p.norm_g + LANE_ * 8), g1 = *(const float4*)(p.norm_g + LANE_ * 8 + 4);
        float o[8];
        o[0] = sigmoidf_(bf_lo(og.x)) * (x[0] * rstd * g0.x); o[1] = sigmoidf_(bf_hi(og.x)) * (x[1] * rstd * g0.y); o[2] = sigmoidf_(bf_lo(og.y)) * (x[2] * rstd * g0.z); o[3] = sigmoidf_(bf_hi(og.y)) * (x[3] * rstd * g0.w);
        o[4] = sigmoidf_(bf_lo(og.z)) * (x[4] * rstd * g1.x); o[5] = sigmoidf_(bf_hi(og.z)) * (x[5] * rstd * g1.y); o[6] = sigmoidf_(bf_lo(og.w)) * (x[6] * rstd * g1.z); o[7] = sigmoidf_(bf_hi(og.w)) * (x[7] * rstd * g1.w);
        *(uint4*)(MOUTB + (size_t)row * 512 + LANE_ * 8) = pack8(o);
    }
    xcd_barrier(bar);

    gemm_glds(NR, 1024, 1024,
        [&](int r, int k) { return (k < 512) ? MOUTB + (size_t)r * 512 + k : NOUTB + (size_t)r * 512 + (k - 512); },
        [&](int n, int k) { return (k < 512) ? WUPM_T + (size_t)n * 512 + k : WUPN_T + (size_t)n * 512 + (k - 512); },
        [&](int r, int c0, f32x4 v, uint2 kp) {
            const uint2 gw2 = *(const uint2*)(ZB + (size_t)r * IN_DIM + C_GN + c0);
            f32x4 o; o[0] = bf_lo(kp.x) + sigmoidf_(bf_lo(gw2.x)) * v[0]; o[1] = bf_hi(kp.x) + sigmoidf_(bf_hi(gw2.x)) * v[1]; o[2] = bf_lo(kp.y) + sigmoidf_(bf_lo(gw2.y)) * v[2]; o[3] = bf_hi(kp.y) + sigmoidf_(bf_hi(gw2.y)) * v[3];
            store_bf16x4(MIXB + (size_t)r * 1024 + c0, o); },
        smem + 1024, 0, 8,
        [&](int r, int c0, f32x4& v, uint2& kp) {
            const uint2 gw2 = *(const uint2*)(ZB + (size_t)r * IN_DIM + C_GM + c0);
            kp.x = cvt_pk_bf16(sigmoidf_(bf_lo(gw2.x)) * v[0], sigmoidf_(bf_hi(gw2.x)) * v[1]); kp.y = cvt_pk_bf16(sigmoidf_(bf_lo(gw2.y)) * v[2], sigmoidf_(bf_hi(gw2.y)) * v[3]); });
    xcd_barrier(bar);

    gemm_glds(NR, 1024, 1024,
        [&](int r, int k) { return MIXB + (size_t)r * 1024 + k; },
        [&](int n, int k) { return WOUT_T + (size_t)n * 1024 + k; },
        [&](int r, int c0, f32x4 v) {
            const f32x4 xv = *(const f32x4*)((r < NP ? p.x_prompt + (size_t)r * 1024 : p.x_sample + (size_t)(r - NP) * 1024) + c0);
            *(f32x4*)(T1 + (size_t)r * 1024 + c0) = xv * DN_ALPHA + v; }, smem + 1024);
    xcd_barrier(bar);

    for (int row = GW_; row < NR; row += nw) {
        float tv[16]; float s = 0.f;
#pragma unroll
        for (int j = 0; j < 4; ++j) { const float4 t4 = *(const float4*)(T1 + (size_t)row * 1024 + j * 256 + LANE_ * 4); tv[4 * j] = t4.x; tv[4 * j + 1] = t4.y; tv[4 * j + 2] = t4.z; tv[4 * j + 3] = t4.w; s += (t4.x + t4.y) + (t4.z + t4.w); }
        const float mu = wave_sum(s) * (1.0f / 1024.0f);
        float q = 0.f;
#pragma unroll
        for (int j = 0; j < 16; ++j) { const float d = tv[j] - mu; q += d * d; }
        const float rstd = 1.0f / sqrtf(wave_sum(q) * (1.0f / 1024.0f) + LN_EPS);
#pragma unroll
        for (int j = 0; j < 4; ++j) {
            const int c = j * 256 + LANE_ * 4;
            const float4 g4 = *(const float4*)(p.ln1_g + c), b4 = *(const float4*)(p.ln1_b + c);
            f32x4 o; o[0] = (tv[4 * j] - mu) * rstd * g4.x + b4.x; o[1] = (tv[4 * j + 1] - mu) * rstd * g4.y + b4.y; o[2] = (tv[4 * j + 2] - mu) * rstd * g4.z + b4.z; o[3] = (tv[4 * j + 3] - mu) * rstd * g4.w + b4.w;
            store_bf16x4(X1B + (size_t)row * 1024 + c, o);
        }
    }
    xcd_barrier(bar);

    gemm_glds(NR, 2048, 1024,
        [&](int r, int k) { return X1B + (size_t)r * 1024 + k; },
        [&](int n, int k) { return PWQ_T + (size_t)n * 1024 + k; },
        [&](int r, int c0, f32x4 v) { store_bf16x4(QPB + (size_t)r * 2048 + c0, v); }, smem + 1024);
    xcd_barrier(bar);

    for (int it = blockIdx.x; it < 513 * 8; it += gridDim.x) { __syncthreads(); peer_score_topk_item(p, it >> 3, it & 7, ldsb); }
    xcd_barrier(bar);

    for (int row = GW_; row < NR; row += nw) peer_expert_wave(p, row, ldsb + WV_ * 7168, LANE_);
}

#undef TID_
#undef LANE_
#undef WV_
#undef GW_
#undef GT_
extern "C" void kernel_launch(void* const* d_in, const int* in_sizes, int n_in, void* d_out, int out_size, void* d_ws, size_t ws_size, hipStream_t stream) {
    static int grid = 0;
    if (grid == 0) {
        if (n_in != 32 || (size_t)out_size != O_END || ws_size < WS_END) {
            fprintf(stderr, "kernel_launch: unexpected sizes n_in %d out %d ws %zu (need %zu)\n", n_in, out_size, ws_size, (size_t)WS_END); grid = -1; return; }
        int dev = 0, cus = 0, per_cu = 0;
        if (hipGetDevice(&dev) != hipSuccess || hipDeviceGetAttribute(&cus, hipDeviceAttributeMultiprocessorCount, dev) != hipSuccess) { grid = -1; return; }
        if (hipFuncSetAttribute((const void*)fwd_kernel, hipFuncAttributeMaxDynamicSharedMemorySize, LDS_BYTES) != hipSuccess) { fprintf(stderr, "hipFuncSetAttribute failed\n"); grid = -1; return; }
        if (hipOccupancyMaxActiveBlocksPerMultiprocessor(&per_cu, (const void*)fwd_kernel, NTHREADS, LDS_BYTES) != hipSuccess || per_cu < 1) { fprintf(stderr, "occupancy query failed (%d)\n", per_cu); (void)hipGetLastError(); per_cu = 1; }
        if (per_cu > 2) per_cu = 2;
        grid = cus * per_cu;
    }
    if (grid < 0) return;
    (void)hipMemsetAsync((char*)d_ws + WS_BAR, 0, XCD_BAR_WORDS * sizeof(unsigned), stream);
    Params p{};
    p.x_prompt = (const float*)d_in[0]; p.x_sample = (const float*)d_in[1]; p.cache_cmp = (const float*)d_in[2]; p.cache_slc = (const float*)d_in[3];
    p.page_table = (const int*)d_in[4]; p.state_win = (const float*)d_in[5]; p.state_C = (const float*)d_in[6]; p.state_n = (const float*)d_in[7];
    p.state_m = (const float*)d_in[8]; p.state_conv = (const float*)d_in[9]; p.w_in = (const float*)d_in[10]; p.conv_w = (const float*)d_in[11];
    p.conv_b = (const float*)d_in[12]; p.wq = (const float*)d_in[13]; p.wk = (const float*)d_in[14]; p.gate_bias = (const float*)d_in[15];
    p.norm_g = (const float*)d_in[16]; p.cmp_pe = (const float*)d_in[17]; p.cmp_w1 = (const float*)d_in[18]; p.cmp_w2 = (const float*)d_in[19];
    p.rel_bias = (const float*)d_in[20]; p.w_up_m = (const float*)d_in[21]; p.w_up_n = (const float*)d_in[22]; p.w_out = (const float*)d_in[23];
    p.ln1_g = (const float*)d_in[24]; p.ln1_b = (const float*)d_in[25]; p.ln2_g = (const float*)d_in[26]; p.ln2_b = (const float*)d_in[27];
    p.peer_wq = (const float*)d_in[28]; p.peer_sub = (const float*)d_in[29]; p.peer_u = (const float*)d_in[30]; p.peer_v = (const float*)d_in[31];
    p.out = (float*)d_out; p.ws = (unsigned char*)d_ws;
    hipLaunchKernelGGL(fwd_kernel, dim3(grid), dim3(NTHREADS), LDS_BYTES, stream, p);
}
```

```cpp
#include <hip/hip_runtime.h>
#include <stdint.h>
#include <cstdio>

#define DEV __device__ __forceinline__

constexpr int DM = 1024;
constexpr int BP = 16, TP = 2048, BS = 32;
constexpr int NP = BP * TP;
constexpr int NR = NP + BS;
constexpr int MP = 32896;
constexpr int IN_DIM = 4896;
constexpr int C_U = 0, C_V = 512, C_O = 1024, C_I = 1536, C_F = 1540, C_Q = 1544, C_KC = 2056, C_KS = 2312, C_KW = 2568, C_G = 2824, C_GM = 2848, C_GN = 3872;
constexpr int PAST = 16384;
constexpr float NEGF = -1e30f;
constexpr float DN_ALPHA = 1.189207115002721f;
constexpr float LN_EPS = 1e-5f;
constexpr float LOG2E = 1.4426950408889634f;

constexpr size_t O_Y = 0;
constexpr size_t O_CMPP = (size_t)NR * DM;
constexpr size_t O_CMPS = O_CMPP + (size_t)NP * 256;
constexpr size_t O_SLCP = O_CMPS + (size_t)BS * 256;
constexpr size_t O_SLCS = O_SLCP + (size_t)NP * 256;
constexpr size_t O_WINP = O_SLCS + (size_t)BS * 256;
constexpr size_t O_WINS = O_WINP + (size_t)BP * 512 * 256;
constexpr size_t O_CP = O_WINS + (size_t)BS * 512 * 256;
constexpr size_t O_CS = O_CP + (size_t)BP * 4 * 128 * 128;
constexpr size_t O_NP = O_CS + (size_t)BS * 4 * 128 * 128;
constexpr size_t O_NS = O_NP + (size_t)BP * 4 * 128;
constexpr size_t O_MP = O_NS + (size_t)BS * 4 * 128;
constexpr size_t O_MS = O_MP + (size_t)BP * 4;
constexpr size_t O_CVP = O_MS + (size_t)BS * 4;
constexpr size_t O_CVS = O_CVP + (size_t)BP * 3 * 512;
constexpr size_t O_END = O_CVS + (size_t)BS * 3 * 512;
static_assert(O_END == 59916480, "output size");

constexpr size_t al256(size_t x) { return (x + 255) & ~(size_t)255; }
constexpr size_t WS_BAR = 0;
constexpr size_t WS_Z = 16384;
constexpr size_t WS_HRAW = al256(WS_Z + (size_t)MP * 32 * 4);
constexpr size_t WS_MOUTB = al256(WS_HRAW + (size_t)MP * 512 * 4);
constexpr size_t WS_NOUTB = al256(WS_MOUTB + (size_t)MP * 512 * 2);
constexpr size_t WS_MIXB = al256(WS_NOUTB + (size_t)MP * 512 * 2);
constexpr size_t WS_T1 = al256(WS_MIXB + (size_t)MP * 1024 * 2);
constexpr size_t WS_X1B = al256(WS_T1 + (size_t)MP * 1024 * 4);
constexpr size_t WS_QPB = al256(WS_X1B + (size_t)MP * 1024 * 2);
constexpr size_t WS_PIDX = al256(WS_QPB + (size_t)MP * 2048 * 2);
constexpr size_t WS_PG = al256(WS_PIDX + (size_t)MP * 128 * 4);
constexpr size_t WS_CONVB = al256(WS_PG + (size_t)MP * 128 * 4);
constexpr size_t WS_XB = al256(WS_CONVB + (size_t)MP * 512 * 2);
constexpr size_t WS_WIN_T = al256(WS_XB + (size_t)MP * 1024 * 2);
constexpr size_t WS_WUPM_T = al256(WS_WIN_T + (size_t)IN_DIM * 1024 * 2);
constexpr size_t WS_WUPN_T = al256(WS_WUPM_T + (size_t)1024 * 512 * 2);
constexpr size_t WS_WOUT_T = al256(WS_WUPN_T + (size_t)1024 * 512 * 2);
constexpr size_t WS_PWQ_T = al256(WS_WOUT_T + (size_t)1024 * 1024 * 2);
constexpr size_t WS_WQK_T = al256(WS_PWQ_T + (size_t)2048 * 1024 * 2);
constexpr size_t WS_W1_T = al256(WS_WQK_T + (size_t)4 * 256 * 128 * 2);
constexpr size_t WS_PESUM = al256(WS_W1_T + (size_t)2 * 128 * 1024 * 2);
constexpr size_t WS_W2_T = al256(WS_PESUM + 512);
constexpr size_t WS_SUBK = al256(WS_W2_T + (size_t)2 * 64 * 64 * 2);
constexpr size_t WS_ZB = al256(WS_SUBK + (size_t)2 * 128 * 128 * 2);
constexpr size_t WS_VTS = al256(WS_ZB + (size_t)MP * IN_DIM * 2);
constexpr size_t WS_VTW = al256(WS_VTS + (size_t)16 * 2 * 64 * 2048 * 2);
constexpr size_t WS_KCB = al256(WS_VTW + (size_t)16 * 2 * 64 * 2048 * 2);
constexpr size_t WS_VTC = al256(WS_KCB + (size_t)16 * 2 * 128 * 64 * 2);
constexpr size_t WS_NOUTF = al256(WS_VTC + (size_t)16 * 2 * 64 * 128 * 2);
constexpr size_t WS_U8 = al256(WS_NOUTF + (size_t)NP * 512 * 4);
constexpr size_t WS_V8 = al256(WS_U8 + (size_t)16384 * 1024);
constexpr size_t WS_QB = al256(WS_V8 + (size_t)16384 * 1024);
constexpr size_t WS_KB = al256(WS_QB + (size_t)MP * 512 * 2);
constexpr size_t WS_KTB = al256(WS_KB + (size_t)MP * 512 * 2);
constexpr size_t WS_VTM = al256(WS_KTB + (size_t)16 * 512 * 2048 * 2);
constexpr size_t WS_KCSB = al256(WS_VTM + (size_t)16 * 512 * 2048 * 2);
constexpr size_t WS_VTCS = al256(WS_KCSB + (size_t)32 * 2 * 1024 * 64 * 2);
constexpr size_t WS_END = al256(WS_VTCS + (size_t)32 * 2 * 64 * 1024 * 2);

static_assert(WS_END <= 2684354560ull, "workspace too large");
constexpr int LDS_BYTES = 73728 + 256;
constexpr int NTHREADS = 256;

struct Params {
    const float* x_prompt; const float* x_sample; const float* cache_cmp; const float* cache_slc; const int* page_table;
    const float* state_win; const float* state_C; const float* state_n; const float* state_m; const float* state_conv;
    const float* w_in; const float* conv_w; const float* conv_b; const float* wq; const float* wk; const float* gate_bias; const float* norm_g;
    const float* cmp_pe; const float* cmp_w1; const float* cmp_w2; const float* rel_bias; const float* w_up_m; const float* w_up_n; const float* w_out;
    const float* ln1_g; const float* ln1_b; const float* ln2_g; const float* ln2_b; const float* peer_wq; const float* peer_sub; const float* peer_u; const float* peer_v;
    float* out; unsigned char* ws;
};

#define XB_TMO      128
#define XB_XCNT(j)  (256  + 64 * (j))
#define XB_XSUB(j)  (1280 + 64 * (j))
#define XB_XGEN(j)  (2304 + 64 * (j))
#define XB_TOP      3328
#define XB_TOPGEN   3392
#define XCD_BAR_WORDS 3456
#define XB_SPIN_CAP (1u << 22)
#define LAS __attribute__((address_space(3)))

__device__ __forceinline__ unsigned xb_ld(unsigned* p)              { return __hip_atomic_load(p, __ATOMIC_RELAXED, __HIP_MEMORY_SCOPE_AGENT); }
__device__ __forceinline__ unsigned xb_add(unsigned* p, unsigned v) { return __hip_atomic_fetch_add(p, v, __ATOMIC_RELAXED, __HIP_MEMORY_SCOPE_AGENT); }
__device__ __forceinline__ unsigned xb_xcc_id() { return (unsigned)__builtin_amdgcn_s_getreg((3 << 11) | 20) & 0xFu; }
#define XB_SPIN(cond, bar) do { unsigned _sp = 0; while (cond) { __builtin_amdgcn_s_sleep(1); \
    if ((++_sp & 255u) == 0u) { if (xb_ld(&(bar)[XB_TMO])) break; if (_sp > XB_SPIN_CAP) { atomicAdd(&(bar)[XB_TMO], 1u); break; } } } } while (0)

struct XcdBarrier { unsigned* bar; unsigned x; volatile LAS unsigned* st; };

__device__ __forceinline__ XcdBarrier xcd_barrier_post(unsigned* bar, volatile LAS unsigned* st) {
    XcdBarrier b; b.bar = bar; b.x = xb_xcc_id(); b.st = st;
    if (threadIdx.x == 0) (void)xb_add(&bar[XB_XCNT(b.x)], 1u);
    return b;
}
__device__ __forceinline__ void xcd_barrier_complete(unsigned* bar, unsigned x, unsigned& nloc, unsigned& nx) {
    const unsigned G = gridDim.x * gridDim.y * gridDim.z;
    unsigned sum, cnt, mine, sp = 0u;
    for (;;) {
        sum = 0u; cnt = 0u; mine = 0u;
#pragma unroll
        for (unsigned j = 0; j < 16; ++j) { const unsigned c = xb_ld(&bar[XB_XCNT(j)]); sum += c; cnt += (c > 0u) ? 1u : 0u; mine = (j == x) ? c : mine; }
        if (sum == G) break;
        __builtin_amdgcn_s_sleep(1);
        if ((++sp & 255u) == 0u) { if (xb_ld(&bar[XB_TMO])) break; if (sp > XB_SPIN_CAP) { atomicAdd(&bar[XB_TMO], 1u); break; } }
    }
    nloc = mine > 0u ? mine : 1u; nx = cnt > 0u ? cnt : 1u;
}
__device__ __forceinline__ void xcd_barrier(const XcdBarrier& b) {
    asm volatile("s_waitcnt vmcnt(0)" ::: "memory");
    __syncthreads();
    if (threadIdx.x == 0) {
        unsigned* bar = b.bar;
        __builtin_amdgcn_s_waitcnt(0);
        unsigned nloc = b.st[0], nx = b.st[1];
        if (nloc == 0u) { xcd_barrier_complete(bar, b.x, nloc, nx); b.st[0] = nloc; b.st[1] = nx; }
        const unsigned old = xb_add(&bar[XB_XSUB(b.x)], 1u);
        const unsigned gen = old / nloc;
        if (old + 1u == (gen + 1u) * nloc) {
            __builtin_amdgcn_fence(__ATOMIC_RELEASE, "agent");
            asm volatile("s_waitcnt vmcnt(0)" ::: "memory");
            const unsigned og = xb_add(&bar[XB_TOP], 1u);
            const unsigned tg = og / nx;
            if (og + 1u == (tg + 1u) * nx) xb_add(&bar[XB_TOPGEN], 1u);
            else XB_SPIN(xb_ld(&bar[XB_TOPGEN]) == tg, bar);
            __builtin_amdgcn_fence(__ATOMIC_ACQUIRE, "agent");
            xb_add(&bar[XB_XGEN(b.x)], 1u);
            asm volatile("s_waitcnt vmcnt(0)" ::: "memory");
        } else {
            XB_SPIN(xb_ld(&bar[XB_XGEN(b.x)]) == gen, bar);
            __builtin_amdgcn_fence(__ATOMIC_ACQUIRE, "agent");
            asm volatile("s_waitcnt vmcnt(0)" ::: "memory");
        }
    }
    __syncthreads();
}

typedef float f32x4 __attribute__((ext_vector_type(4)));

__device__ const unsigned char REL_LUT[128] = {
    0, 1, 2, 3, 4, 5, 6, 7, 8, 9, 10, 11, 12, 13, 14, 15, 16, 16, 16, 17, 17, 18, 18, 18, 19, 19, 19, 20, 20, 20, 20, 21, 21, 21, 21, 22, 22, 22, 22, 22,
    23, 23, 23, 23, 23, 23, 24, 24, 24, 24, 24, 24, 25, 25, 25, 25, 25, 25, 25, 26, 26, 26, 26, 26, 26, 26, 26, 27, 27, 27, 27, 27, 27, 27, 27, 27, 27,
    28, 28, 28, 28, 28, 28, 28, 28, 28, 28, 29, 29, 29, 29, 29, 29, 29, 29, 29, 29, 29, 29, 30, 30, 30, 30, 30, 30, 30, 30, 30, 30, 30, 30, 30, 30,
    31, 31, 31, 31, 31, 31, 31, 31, 31, 31, 31, 31, 31, 31, 31};
DEV int rel_bucket(int n) { return n < 128 ? (int)REL_LUT[n < 0 ? 0 : n] : 31; }

DEV float sigmoidf_(float x) { return __builtin_amdgcn_rcpf(1.0f + __builtin_amdgcn_exp2f(-1.4426950408889634f * x)); }
DEV float gelu_tanh(float x) { return x * sigmoidf_(1.5957691216057308f * (x + 0.044715f * x * x * x)); }
DEV float log_sigmoid(float x) { return x >= 0.f ? -log1pf(expf(-x)) : x - log1pf(expf(x)); }
DEV void wave_sync() { asm volatile("s_waitcnt lgkmcnt(0)" ::: "memory"); __builtin_amdgcn_wave_barrier(); asm volatile("" ::: "memory"); }
DEV float wave_sum(float v) {
#pragma unroll
    for (int o = 32; o >= 1; o >>= 1) v += __shfl_xor(v, o);
    return v;
}
DEV float wave_max(float v) {
#pragma unroll
    for (int o = 32; o >= 1; o >>= 1) v = fmaxf(v, __shfl_xor(v, o));
    return v;
}

typedef unsigned short bf16_t;
typedef short bf16x8 __attribute__((ext_vector_type(8)));
typedef float f32x2_ __attribute__((ext_vector_type(2)));
typedef __bf16 bf16x2_ __attribute__((ext_vector_type(2)));
DEV unsigned cvt_pk_bf16(float lo, float hi) { const f32x2_ v = {lo, hi}; return __builtin_bit_cast(unsigned, __builtin_convertvector(v, bf16x2_)); }
DEV float bf_lo(unsigned w) { return __uint_as_float(w << 16); }
DEV float bf_hi(unsigned w) { return __uint_as_float(w & 0xffff0000u); }
DEV uint4 pack8(const float* f) { uint4 r; r.x = cvt_pk_bf16(f[0], f[1]); r.y = cvt_pk_bf16(f[2], f[3]); r.z = cvt_pk_bf16(f[4], f[5]); r.w = cvt_pk_bf16(f[6], f[7]); return r; }
DEV void store_bf16x8(bf16_t* p, f32x4 a, f32x4 b) { uint4 w; w.x = cvt_pk_bf16(a[0], a[1]); w.y = cvt_pk_bf16(a[2], a[3]); w.z = cvt_pk_bf16(b[0], b[1]); w.w = cvt_pk_bf16(b[2], b[3]); *(uint4*)p = w; }
DEV void store_bf16x4(bf16_t* p, f32x4 v) { uint2 w; w.x = cvt_pk_bf16(v[0], v[1]); w.y = cvt_pk_bf16(v[2], v[3]); *(uint2*)p = w; }

DEV void transpose_to_bf16(const float* __restrict__ src, const int K, const int N, bf16_t* __restrict__ dst, const size_t gt, const size_t nt) {
    const size_t items = (size_t)N * (K >> 3);
    for (size_t id = gt; id < items; id += nt) {
        const int n = (int)(id % N), k8 = (int)(id / N) * 8;
        float f[8];
#pragma unroll
        for (int i = 0; i < 8; ++i) f[i] = src[(size_t)(k8 + i) * N + n];
        *(uint4*)(dst + (size_t)n * K + k8) = pack8(f);
    }
}

template <int BN, bool TILE_EPI = false, class LA, class LB, class EF>
DEV void gemm_bf16(const int M, const int N, const int K, LA la, LB lb, EF ef, unsigned char* lds, const int toff = 0) {
    constexpr int TJ = BN / 32;
    constexpr int NB = BN / 32;
    constexpr int LDR = 144;
    const int tid = threadIdx.x, lane = tid & 63, w = tid >> 6, wm = w >> 1, wn = w & 1;
    const int tm = (M + 127) >> 7, tn = (N + BN - 1) / BN;
    unsigned char* As = lds;
    unsigned char* Bs = lds + 128 * LDR;
    const int lr = lane & 15, lq = lane >> 4;
    for (int tile = (int)((blockIdx.x + gridDim.x - (unsigned)toff % gridDim.x) % gridDim.x); tile < tm * tn; tile += gridDim.x) {
        const int bm = (tile / tn) * 128, bn = (tile % tn) * BN;
        f32x4 acc[4][TJ];
#pragma unroll
        for (int i = 0; i < 4; ++i)
#pragma unroll
            for (int j = 0; j < TJ; ++j) acc[i][j] = (f32x4){0.f, 0.f, 0.f, 0.f};
        typename LA::Raw ra[4]; uint4 rb[NB];
        const unsigned char* arow[4]; int brow[NB];
#pragma unroll
        for (int i = 0; i < 4; ++i) { const int r = bm + ((tid + 256 * i) >> 3); arow[i] = la.prep(r < M ? r : M - 1); }
#pragma unroll
        for (int i = 0; i < NB; ++i) { const int n = bn + ((tid + 256 * i) >> 3); brow[i] = n < N ? n : N - 1; }
        const int kc = (tid & 7) * 8;
#pragma unroll
        for (int i = 0; i < 4; ++i) ra[i] = la.load(arow[i], kc);
#pragma unroll
        for (int i = 0; i < NB; ++i) rb[i] = lb(brow[i], kc);
        for (int k0_ = 0; k0_ < K; k0_ += 64) {
            int k0 = k0_; asm volatile("" : "+v"(k0));
            __syncthreads();
#pragma unroll
            for (int i = 0; i < 4; ++i) *(uint4*)(As + ((tid + 256 * i) >> 3) * LDR + (tid & 7) * 16) = la.pack(ra[i]);
#pragma unroll
            for (int i = 0; i < NB; ++i) *(uint4*)(Bs + ((tid + 256 * i) >> 3) * LDR + (tid & 7) * 16) = rb[i];
            __syncthreads();
            if (k0_ + 64 < K) {
#pragma unroll
                for (int i = 0; i < 4; ++i) ra[i] = la.load(arow[i], k0 + 64 + kc);
#pragma unroll
                for (int i = 0; i < NB; ++i) rb[i] = lb(brow[i], k0 + 64 + kc);
            }
#pragma unroll
            for (int kk = 0; kk < 2; ++kk) {
                bf16x8 a[4], b[TJ];
#pragma unroll
                for (int i = 0; i < 4; ++i) a[i] = *(const bf16x8*)(As + (wm * 64 + i * 16 + lr) * LDR + kk * 64 + lq * 16);
#pragma unroll
                for (int j = 0; j < TJ; ++j) b[j] = *(const bf16x8*)(Bs + (wn * (BN / 2) + j * 16 + lr) * LDR + kk * 64 + lq * 16);
#pragma unroll
                for (int i = 0; i < 4; ++i)
#pragma unroll
                    for (int j = 0; j < TJ; ++j) acc[i][j] = __builtin_amdgcn_mfma_f32_16x16x32_bf16(b[j], a[i], acc[i][j], 0, 0, 0);
            }
        }
        if constexpr (TILE_EPI) { ef(acc, bm); }
        else {
#pragma unroll
            for (int i = 0; i < 4; ++i)
#pragma unroll
                for (int j = 0; j < TJ; ++j) {
                    const int r = bm + wm * 64 + i * 16 + lr, c0 = bn + wn * (BN / 2) + j * 16 + lq * 4;
                    if (r < M && c0 < N) ef(r, c0, acc[i][j]);
                }
        }
    }
}

DEV int lds_byte3(int rho, int ck) { return (rho >> 3) * 1024 + (rho & 7) * 128 + ((ck ^ (2 * ((rho >> 1) & 3))) << 4); }
struct NoMid { DEV void operator()(int, int, f32x4&, f32x4&, uint2&, uint2&) const {} };
template <class PA, class PB, class EF, class MF = NoMid, bool XCDN = false, int MI = 5>
DEV void gemm_glds(const int M, const int N, const int K, PA pa, PB pb, EF ef, unsigned char* lds, const int toff = 0, const int ksplit = 0, MF mf = MF(), const int gfirst = 0, const int gcount = 0) {
    constexpr int BM = 32 * MI, ABYTES = BM * 128, STG = ABYTES + 16384;
    const int tid = threadIdx.x, lane = tid & 63, w = tid >> 6, wm = w >> 1, wn = w & 1;
    const int tm = (M + BM - 1) / BM, tn = (N + 127) >> 7;
    const int lr = lane & 15, lq = lane >> 4;
    const int nk = K >> 6;
    const int sC = ((lane & 7) ^ (2 * ((lane >> 4) & 3))) << 3;
    int sRb[4];
#pragma unroll
    for (int i = 0; i < 4; ++i) { const int rho = 8 * (w + 4 * i) + (lane >> 3); sRb[i] = (rho & 64) + 32 * ((rho >> 5) & 1) + 8 * ((rho >> 2) & 3) + 4 * ((rho >> 4) & 1) + (rho & 3); }
    const int xc = blockIdx.x & 7, xslots = gridDim.x >> 3, xcnt = (tn - xc + 7) >> 3;
    const int vgrid = gcount > 0 ? gcount : (int)gridDim.x, vb = (int)blockIdx.x - gfirst;
    if (!XCDN && (vb < 0 || vb >= vgrid)) return;
    for (int tile = XCDN ? (int)(blockIdx.x >> 3) : (vb + vgrid - toff % vgrid) % vgrid; tile < (XCDN ? tm * xcnt : tm * tn); tile += (XCDN ? xslots : vgrid)) {
        const int bm = (XCDN ? tile / xcnt : tile / tn) * BM, bn = (XCDN ? xc + 8 * (tile % xcnt) : tile % tn) * 128;
        f32x4 acc[MI][4]; uint2 keep[MI][4];
#pragma unroll
        for (int i = 0; i < MI; ++i)
#pragma unroll
            for (int j = 0; j < 4; ++j) { acc[i][j] = (f32x4){0.f, 0.f, 0.f, 0.f}; keep[i][j] = make_uint2(0u, 0u); }
        int arow[MI], brow[4];
#pragma unroll
        for (int i = 0; i < MI; ++i) { const int r = bm + 8 * (w + 4 * i) + (lane >> 3); arow[i] = r < M ? r : M - 1; }
#pragma unroll
        for (int i = 0; i < 4; ++i) { const int n = bn + sRb[i]; brow[i] = n < N ? n : N - 1; }
#define GLDS_STAGE(BUF, KT) { _Pragma("unroll") for (int i = 0; i < MI; ++i) \
            __builtin_amdgcn_global_load_lds((const unsigned*)pa(arow[i], (KT) * 64 + sC), (LAS unsigned*)(lds + (BUF) * STG + (w + 4 * i) * 1024), 16, 0, 0); \
        _Pragma("unroll") for (int i = 0; i < 4; ++i) \
            __builtin_amdgcn_global_load_lds((const unsigned*)pb(brow[i], (KT) * 64 + sC), (LAS unsigned*)(lds + (BUF) * STG + ABYTES + (w + 4 * i) * 1024), 16, 0, 0); }
        __syncthreads();
        GLDS_STAGE(0, 0)
        asm volatile("s_waitcnt vmcnt(0)" ::: "memory");
        __syncthreads();
        for (int kt = 0; kt < nk; ++kt) {
            const int cur = kt & 1;
            if (kt + 1 < nk) GLDS_STAGE(cur ^ 1, kt + 1)
            const unsigned char* SA = lds + cur * STG;
            const unsigned char* SB = SA + ABYTES;
            {
                bf16x8 a0[MI], b0[4], a1[MI], b1[4];
#pragma unroll
                for (int i = 0; i < MI; ++i) a0[i] = *(const bf16x8*)(SA + lds_byte3(wm * (16 * MI) + i * 16 + lr, lq));
#pragma unroll
                for (int j = 0; j < 4; ++j) b0[j] = *(const bf16x8*)(SB + lds_byte3(wn * 64 + j * 16 + lr, lq));
                __builtin_amdgcn_sched_barrier(0);
#pragma unroll
                for (int i = 0; i < MI; ++i) a1[i] = *(const bf16x8*)(SA + lds_byte3(wm * (16 * MI) + i * 16 + lr, 4 + lq));
#pragma unroll
                for (int j = 0; j < 4; ++j) b1[j] = *(const bf16x8*)(SB + lds_byte3(wn * 64 + j * 16 + lr, 4 + lq));
                __builtin_amdgcn_sched_barrier(0);
                __builtin_amdgcn_s_setprio(1);
#pragma unroll
                for (int i = 0; i < MI; ++i)
#pragma unroll
                    for (int j = 0; j < 4; ++j) acc[i][j] = __builtin_amdgcn_mfma_f32_16x16x32_bf16(b0[j], a0[i], acc[i][j], 0, 0, 0);
                __builtin_amdgcn_sched_barrier(0);
#pragma unroll
                for (int i = 0; i < MI; ++i)
#pragma unroll
                    for (int j = 0; j < 4; ++j) acc[i][j] = __builtin_amdgcn_mfma_f32_16x16x32_bf16(b1[j], a1[i], acc[i][j], 0, 0, 0);
                __builtin_amdgcn_s_setprio(0);
                __builtin_amdgcn_sched_barrier(0);
            }
            if constexpr (!__is_same(MF, NoMid)) {
                if (kt + 1 == ksplit) {
#pragma unroll
                    for (int i = 0; i < MI; ++i)
#pragma unroll
                        for (int k2 = 0; k2 < 2; ++k2) {
                            const int r = bm + wm * (16 * MI) + i * 16 + lr, c0 = bn + wn * 64 + 32 * k2 + 8 * lq;
                            if (r < M && c0 < N) mf(r, c0, acc[i][2 * k2], acc[i][2 * k2 + 1], keep[i][2 * k2], keep[i][2 * k2 + 1]);
                            acc[i][2 * k2] = (f32x4){0.f, 0.f, 0.f, 0.f}; acc[i][2 * k2 + 1] = (f32x4){0.f, 0.f, 0.f, 0.f};
                        }
                }
            }
            asm volatile("s_waitcnt vmcnt(0)" ::: "memory");
            __syncthreads();
        }
#undef GLDS_STAGE
#pragma unroll
        for (int i = 0; i < MI; ++i)
#pragma unroll
            for (int k2 = 0; k2 < 2; ++k2) {
                const int r = bm + wm * (16 * MI) + i * 16 + lr, c0 = bn + wn * 64 + 32 * k2 + 8 * lq;
                if (r < M && c0 < N) { if constexpr (!__is_same(MF, NoMid)) ef(r, c0, acc[i][2 * k2], acc[i][2 * k2 + 1], keep[i][2 * k2], keep[i][2 * k2 + 1]); else ef(r, c0, acc[i][2 * k2], acc[i][2 * k2 + 1]); }
            }
    }
}

template <int MI, class PA, class PB, class EF, class MF>
DEV void gemm_glds_mi(const int M, const int N, const int K, PA pa, PB pb, EF ef, unsigned char* lds, const int toff, const int ksplit, MF mf) { gemm_glds<PA, PB, EF, MF, false, MI>(M, N, K, pa, pb, ef, lds, toff, ksplit, mf); }
template <class PA, class PB, class EF>
DEV void gemm_glds_xcd(const int M, const int N, const int K, PA pa, PB pb, EF ef, unsigned char* lds) { gemm_glds<PA, PB, EF, NoMid, true>(M, N, K, pa, pb, ef, lds, 0, 0, NoMid()); }

DEV void mlstm_step_item(const Params& p, const int item, float* lds) {
    int tid_ = threadIdx.x; asm volatile("" : "+v"(tid_));
    const int tid = tid_, v = tid >> 1, kh = tid & 1;
    const int b = item >> 2, h = item & 3;
    const size_t r = (size_t)(NP + b);
    const float* Z = (const float*)(p.ws + WS_Z);
    const bf16_t* QBp = (const bf16_t*)(p.ws + WS_QB); const bf16_t* KBp = (const bf16_t*)(p.ws + WS_KB); const bf16_t* ZBp = (const bf16_t*)(p.ws + WS_ZB);
    float* HRAW = (float*)(p.ws + WS_HRAW);
    __syncthreads();
    lds[tid] = bf_lo((unsigned)(tid < 128 ? QBp[r * 512 + h * 128 + tid] : KBp[r * 512 + h * 128 + tid - 128]));
    if (tid < 128) lds[256 + tid] = bf_lo((unsigned)ZBp[r * IN_DIM + C_V + h * 128 + tid]);
    __syncthreads();
    const float m0 = p.state_m[b * 4 + h];
    const float ig = Z[r * 32 + h] + p.gate_bias[h], lf = log_sigmoid(Z[r * 32 + 4 + h] + p.gate_bias[4 + h]);
    const float mn = fmaxf(lf + m0, ig);
    const float fd = expf(lf + m0 - mn), iw = expf(ig - mn);
    const float vv = lds[256 + v] * iw;
    const float* c0 = p.state_C + (((size_t)(b * 4 + h) * 128 + v) * 128 + kh * 64);
    const float* n0 = p.state_n + ((size_t)(b * 4 + h) * 128 + kh * 64);
    float* co = p.out + O_CS + (((size_t)(b * 4 + h) * 128 + v) * 128 + kh * 64);
    float* no = p.out + O_NS + ((size_t)(b * 4 + h) * 128 + kh * 64);
    float nump = 0.f, denp = 0.f;
#pragma unroll 4
    for (int j = 0; j < 64; j += 4) {
        const float4 c4 = *(const float4*)(c0 + j), n4 = *(const float4*)(n0 + j);
        const float4 k4 = *(const float4*)(lds + 128 + kh * 64 + j), q4 = *(const float4*)(lds + kh * 64 + j);
        float4 cn, nn;
        cn.x = fd * c4.x + vv * k4.x; cn.y = fd * c4.y + vv * k4.y; cn.z = fd * c4.z + vv * k4.z; cn.w = fd * c4.w + vv * k4.w;
        nn.x = fd * n4.x + iw * k4.x; nn.y = fd * n4.y + iw * k4.y; nn.z = fd * n4.z + iw * k4.z; nn.w = fd * n4.w + iw * k4.w;
        nump += cn.x * q4.x + cn.y * q4.y + cn.z * q4.z + cn.w * q4.w;
        denp += nn.x * q4.x + nn.y * q4.y + nn.z * q4.z + nn.w * q4.w;
        *(float4*)(co + j) = cn;
        if (v == 0) *(float4*)(no + j) = nn;
    }
    nump += __shfl_xor(nump, 1); denp += __shfl_xor(denp, 1);
    if (kh == 0) HRAW[r * 512 + h * 128 + v] = nump / fmaxf(fabsf(denp), expf(-mn));
    if (tid == 0) p.out[O_MS + b * 4 + h] = mn;
}

DEV void mlstm_chunk_item(const Params& p, const int item, unsigned char* lds) {
    int tid_ = threadIdx.x; asm volatile("" : "+v"(tid_));
    const int tid = tid_, lane = tid & 63, w = tid >> 6, lr = lane & 15, lq = lane >> 4;
    constexpr int NVT = 4, VW = NVT * 16, NVS = 128 / VW;
    const int b = item / (4 * NVS), h = (item / NVS) & 3, vs = item % NVS;
    bf16_t* Cl = (bf16_t*)lds;
    bf16_t* nl = (bf16_t*)(lds + VW * 272);
    float* uL = (float*)(lds + VW * 272 + 256); float* ML = uL + 64; float* scin = uL + 128; float* expm = uL + 192; float* wts = uL + 256; float* misc = uL + 320;
    const bf16_t* QB = (const bf16_t*)(p.ws + WS_QB) + (size_t)(b * 2048) * 512 + h * 128;
    const bf16_t* KB = (const bf16_t*)(p.ws + WS_KB) + (size_t)(b * 2048) * 512 + h * 128;
    const bf16_t* KTB = (const bf16_t*)(p.ws + WS_KTB) + (size_t)((b * 4 + h) * 128) * 2048;
    const bf16_t* VTM = (const bf16_t*)(p.ws + WS_VTM) + (size_t)(b * 512 + h * 128 + vs * VW) * 2048;
    const float* Z = (const float*)(p.ws + WS_Z);
    float* HRAW = (float*)(p.ws + WS_HRAW);
    const float gb_i = p.gate_bias[h], gb_f = p.gate_bias[4 + h];
    f32x4 Cm[NVT][2], nm[2];
#pragma unroll
    for (int j = 0; j < 2; ++j) { nm[j] = (f32x4){0.f, 0.f, 0.f, 0.f};
#pragma unroll
        for (int i = 0; i < NVT; ++i) Cm[i][j] = (f32x4){0.f, 0.f, 0.f, 0.f}; }
    float m_prev = 0.f;
    __syncthreads();
    for (int i = tid; i < (VW * 272 + 256) / 4; i += 256) ((unsigned*)lds)[i] = 0u;
    __syncthreads();
    for (int c = 0; c < 32; ++c) {
        const int t0 = c * 64;
        if (w == 0) {
            const size_t row = (size_t)(b * 2048 + t0 + lane);
            const float ig = Z[row * 32 + h] + gb_i;
            const float lf = log_sigmoid(Z[row * 32 + 4 + h] + gb_f);
            float bc = lf;
#pragma unroll
            for (int o = 1; o < 64; o <<= 1) { const float t = __shfl_up(bc, o); if (lane >= o) bc += t; }
            const float u = ig - bc;
            float pm = u;
#pragma unroll
            for (int o = 1; o < 64; o <<= 1) { const float t = __shfl_up(pm, o); if (lane >= o) pm = fmaxf(pm, t); }
            const float M = fmaxf(m_prev, pm);
            const float M63 = __shfl(M, 63), b63 = __shfl(bc, 63);
            uL[lane] = u; ML[lane] = M; scin[lane] = expf(m_prev - M); expm[lane] = expf(-(bc + M)); wts[lane] = expf(u - M63);
            if (lane == 0) { misc[0] = expf(m_prev - M63); misc[1] = b63 + M63; }
        }
        __syncthreads();
        {
            const size_t row_t = (size_t)(t0 + w * 16 + lr);
            bf16x8 Qf[4];
#pragma unroll
            for (int ks = 0; ks < 4; ++ks) Qf[ks] = *(const bf16x8*)(QB + row_t * 512 + ks * 32 + lq * 8);
            const float M_t = ML[w * 16 + lr], sc_in = scin[w * 16 + lr], em = expm[w * 16 + lr];
            f32x4 sw[4];
            float dsum = 0.f;
#pragma unroll
            for (int st = 0; st < 4; ++st) {
                f32x4 a = (f32x4){0.f, 0.f, 0.f, 0.f};
                if (st <= w) {
#pragma unroll
                    for (int ks = 0; ks < 4; ++ks) { const bf16x8 kf = *(const bf16x8*)(KB + (size_t)(t0 + st * 16 + lr) * 512 + ks * 32 + lq * 8); a = __builtin_amdgcn_mfma_f32_16x16x32_bf16(kf, Qf[ks], a, 0, 0, 0); }
#pragma unroll
                    for (int g = 0; g < 4; ++g) {
                        const int sl = st * 16 + lq * 4 + g, tl = w * 16 + lr;
                        const float wg = (sl <= tl) ? __builtin_amdgcn_exp2f((uL[sl] - M_t) * LOG2E) : 0.f;
                        a[g] *= wg; dsum += a[g];
                    }
                }
                sw[st] = a;
            }
            dsum += __shfl_xor(dsum, 16); dsum += __shfl_xor(dsum, 32);
            bf16x8 pf[2];
#pragma unroll
            for (int ks = 0; ks < 2; ++ks) {
                union { bf16x8 v; unsigned u[4]; } pk;
                pk.u[0] = cvt_pk_bf16(sw[2 * ks][0], sw[2 * ks][1]); pk.u[1] = cvt_pk_bf16(sw[2 * ks][2], sw[2 * ks][3]);
                pk.u[2] = cvt_pk_bf16(sw[2 * ks + 1][0], sw[2 * ks + 1][1]); pk.u[3] = cvt_pk_bf16(sw[2 * ks + 1][2], sw[2 * ks + 1][3]);
                pf[ks] = pk.v;
            }
            f32x4 dI = (f32x4){0.f, 0.f, 0.f, 0.f};
#pragma unroll
            for (int ks = 0; ks < 4; ++ks) { const bf16x8 nf = *(const bf16x8*)(nl + ks * 32 + lq * 8); dI = __builtin_amdgcn_mfma_f32_16x16x32_bf16(nf, Qf[ks], dI, 0, 0, 0); }
            const float den = sc_in * dI[0] + dsum;
            const float rdd = 1.0f / fmaxf(fabsf(den), em);
#pragma unroll
            for (int vt = 0; vt < NVT; ++vt) {
                f32x4 ni = (f32x4){0.f, 0.f, 0.f, 0.f}, nI = (f32x4){0.f, 0.f, 0.f, 0.f};
#pragma unroll
                for (int ks = 0; ks < 2; ++ks) if (2 * ks <= w) {
                    union { bf16x8 v; uint2 hh[2]; } vf;
                    const bf16_t* vp = VTM + (size_t)(vt * 16 + lr) * 2048 + t0 + 32 * ks + lq * 4;
                    vf.hh[0] = *(const uint2*)vp; vf.hh[1] = *(const uint2*)(vp + 16);
                    ni = __builtin_amdgcn_mfma_f32_16x16x32_bf16(vf.v, pf[ks], ni, 0, 0, 0);
                }
#pragma unroll
                for (int ks = 0; ks < 4; ++ks) { const bf16x8 cf = *(const bf16x8*)(Cl + (vt * 16 + lr) * 136 + ks * 32 + lq * 8); nI = __builtin_amdgcn_mfma_f32_16x16x32_bf16(cf, Qf[ks], nI, 0, 0, 0); }
                const f32x4 hv = (nI * sc_in + ni) * rdd;
                *(f32x4*)(HRAW + ((size_t)(b * 2048) + row_t) * 512 + h * 128 + vs * VW + vt * 16 + lq * 4) = hv;
            }
        }
        __syncthreads();
        {
            const float decay = misc[0];
            bf16x8 Af[NVT][2], Wf[2], Kt[2][2];
#pragma unroll
            for (int ks = 0; ks < 2; ++ks) {
                const float4 w0 = *(const float4*)(wts + ks * 32 + lq * 8), w1 = *(const float4*)(wts + ks * 32 + lq * 8 + 4);
                float wv[8] = {w0.x, w0.y, w0.z, w0.w, w1.x, w1.y, w1.z, w1.w};
                { union { bf16x8 v; uint4 q; } t; t.q = pack8(wv); Wf[ks] = t.v; }
#pragma unroll
                for (int vt = 0; vt < NVT; ++vt) {
                    const uint4 raw = *(const uint4*)(VTM + (size_t)(vt * 16 + lr) * 2048 + t0 + ks * 32 + lq * 8);
                    float f[8] = {bf_lo(raw.x) * wv[0], bf_hi(raw.x) * wv[1], bf_lo(raw.y) * wv[2], bf_hi(raw.y) * wv[3], bf_lo(raw.z) * wv[4], bf_hi(raw.z) * wv[5], bf_lo(raw.w) * wv[6], bf_hi(raw.w) * wv[7]};
                    union { bf16x8 v; uint4 q; } t; t.q = pack8(f); Af[vt][ks] = t.v;
                }
#pragma unroll
                for (int kt = 0; kt < 2; ++kt) Kt[kt][ks] = *(const bf16x8*)(KTB + (size_t)((2 * w + kt) * 16 + lr) * 2048 + t0 + ks * 32 + lq * 8);
            }
#pragma unroll
            for (int kt = 0; kt < 2; ++kt) {
                nm[kt] = nm[kt] * decay;
#pragma unroll
                for (int ks = 0; ks < 2; ++ks) nm[kt] = __builtin_amdgcn_mfma_f32_16x16x32_bf16(Wf[ks], Kt[kt][ks], nm[kt], 0, 0, 0);
                if (lq == 0) nl[(2 * w + kt) * 16 + lr] = (bf16_t)(cvt_pk_bf16(nm[kt][0], 0.f) & 0xffffu);
#pragma unroll
                for (int vt = 0; vt < NVT; ++vt) {
                    Cm[vt][kt] = Cm[vt][kt] * decay;
#pragma unroll
                    for (int ks = 0; ks < 2; ++ks) Cm[vt][kt] = __builtin_amdgcn_mfma_f32_16x16x32_bf16(Af[vt][ks], Kt[kt][ks], Cm[vt][kt], 0, 0, 0);
                    const unsigned c01 = cvt_pk_bf16(Cm[vt][kt][0], Cm[vt][kt][1]), c23 = cvt_pk_bf16(Cm[vt][kt][2], Cm[vt][kt][3]);
                    bf16_t* cp = Cl + (vt * 16 + lq * 4) * 136 + (2 * w + kt) * 16 + lr;
                    cp[0] = (bf16_t)(c01 & 0xffffu); cp[136] = (bf16_t)(c01 >> 16); cp[272] = (bf16_t)(c23 & 0xffffu); cp[408] = (bf16_t)(c23 >> 16);
                }
            }
            m_prev = misc[1];
        }
        __syncthreads();
    }
#pragma unroll
    for (int vt = 0; vt < NVT; ++vt)
#pragma unroll
        for (int kt = 0; kt < 2; ++kt)
#pragma unroll
            for (int g = 0; g < 4; ++g)
                p.out[O_CP + ((size_t)((b * 4 + h) * 128) + vs * VW + vt * 16 + lq * 4 + g) * 128 + (2 * w + kt) * 16 + lr] = Cm[vt][kt][g];
    if (vs == 0) {
        if (lq == 0) { p.out[O_NP + (size_t)(b * 4 + h) * 128 + (2 * w) * 16 + lr] = nm[0][0]; p.out[O_NP + (size_t)(b * 4 + h) * 128 + (2 * w + 1) * 16 + lr] = nm[1][0]; }
        if (tid == 0) p.out[O_MP + b * 4 + h] = m_prev;
    }
}

DEV unsigned dpp_max16(unsigned x) {
    x = max(x, (unsigned)__builtin_amdgcn_update_dpp(0, (int)x, 0xB1, 0xF, 0xF, false));
    x = max(x, (unsigned)__builtin_amdgcn_update_dpp(0, (int)x, 0x4E, 0xF, 0xF, false));
    x = max(x, (unsigned)__builtin_amdgcn_update_dpp(0, (int)x, 0x141, 0xF, 0xF, false));
    x = max(x, (unsigned)__builtin_amdgcn_update_dpp(0, (int)x, 0x140, 0xF, 0xF, false));
    return x;
}
DEV float dpp_sum16(float x) {
    x += __builtin_bit_cast(float, __builtin_amdgcn_update_dpp(0, __builtin_bit_cast(int, x), 0xB1, 0xF, 0xF, false));
    x += __builtin_bit_cast(float, __builtin_amdgcn_update_dpp(0, __builtin_bit_cast(int, x), 0x4E, 0xF, 0xF, false));
    x += __builtin_bit_cast(float, __builtin_amdgcn_update_dpp(0, __builtin_bit_cast(int, x), 0x141, 0xF, 0xF, false));
    x += __builtin_bit_cast(float, __builtin_amdgcn_update_dpp(0, __builtin_bit_cast(int, x), 0x140, 0xF, 0xF, false));
    return x;
}
DEV unsigned mono_key(float v) { const unsigned b = __float_as_uint(v); return (b & 0x80000000u) ? ~b : (b | 0x80000000u); }
#define CE_DESC(a, b) { const unsigned hi_ = max(a, b), lo_ = min(a, b); a = hi_; b = lo_; }

DEV void peer_score_topk_item(const Params& p, const int tile, const int h, unsigned char* lds) {
    int tid_ = threadIdx.x; asm volatile("" : "+v"(tid_));
    const int tid = tid_, lane = tid & 63, w = tid >> 6, lr = lane & 15, lq = lane >> 4;
    float* sc = (float*)(lds + w * 12416);
    float* ts = sc + 16 * 129;
    int* ti = (int*)(ts + 512);
    const bf16_t* QPB = (const bf16_t*)(p.ws + WS_QPB);
    const bf16_t* SUBK = (const bf16_t*)(p.ws + WS_SUBK);
    int* PIDX = (int*)(p.ws + WS_PIDX); float* PG = (float*)(p.ws + WS_PG);
    const int row0 = tile * 64 + w * 16;
    const int arow = (row0 + lr < NR) ? row0 + lr : NR - 1;
    wave_sync();
#pragma unroll 1
    for (int pp = 0; pp < 2; ++pp) {
        bf16x8 qf[4];
#pragma unroll
        for (int ks = 0; ks < 4; ++ks) qf[ks] = *(const bf16x8*)(QPB + (size_t)arow * 2048 + h * 256 + pp * 128 + ks * 32 + lq * 8);
#pragma unroll
        for (int j = 0; j < 8; ++j) {
            f32x4 a = (f32x4){0.f, 0.f, 0.f, 0.f};
#pragma unroll
            for (int ks = 0; ks < 4; ++ks) { const bf16x8 kf = *(const bf16x8*)(SUBK + ((size_t)pp * 128 + j * 16 + lr) * 128 + ks * 32 + lq * 8); a = __builtin_amdgcn_mfma_f32_16x16x32_bf16(qf[ks], kf, a, 0, 0, 0); }
#pragma unroll
            for (int g = 0; g < 4; ++g) sc[(lq * 4 + g) * 129 + j * 16 + lr] = a[g];
        }
        wave_sync();
#pragma unroll 1
        for (int rr = 0; rr < 4; ++rr) {
            const int row = rr * 4 + lq;
            unsigned k0, k1, k2, k3, k4, k5, k6, k7;
            { const float* sr = sc + row * 129 + lr;
              k0 = (mono_key(sr[0]) & ~0x7Fu) | (unsigned)(127 - lr);        k1 = (mono_key(sr[16]) & ~0x7Fu) | (unsigned)(127 - 16 - lr);
              k2 = (mono_key(sr[32]) & ~0x7Fu) | (unsigned)(127 - 32 - lr);  k3 = (mono_key(sr[48]) & ~0x7Fu) | (unsigned)(127 - 48 - lr);
              k4 = (mono_key(sr[64]) & ~0x7Fu) | (unsigned)(127 - 64 - lr);  k5 = (mono_key(sr[80]) & ~0x7Fu) | (unsigned)(127 - 80 - lr);
              k6 = (mono_key(sr[96]) & ~0x7Fu) | (unsigned)(127 - 96 - lr);  k7 = (mono_key(sr[112]) & ~0x7Fu) | (unsigned)(127 - 112 - lr); }
            CE_DESC(k0, k1) CE_DESC(k2, k3) CE_DESC(k4, k5) CE_DESC(k6, k7)
            CE_DESC(k0, k2) CE_DESC(k1, k3) CE_DESC(k4, k6) CE_DESC(k5, k7)
            CE_DESC(k1, k2) CE_DESC(k5, k6)
            CE_DESC(k0, k4) CE_DESC(k1, k5) CE_DESC(k2, k6) CE_DESC(k3, k7)
            CE_DESC(k2, k4) CE_DESC(k3, k5)
            CE_DESC(k1, k2) CE_DESC(k3, k4) CE_DESC(k5, k6)
            unsigned mine = 0u;
#pragma unroll
            for (int r = 0; r < 16; ++r) {
                const unsigned best = dpp_max16(k0);
                if (lr == r) mine = best;
                const bool own = (k0 == best);
                k0 = own ? k1 : k0; k1 = own ? k2 : k1; k2 = own ? k3 : k2; k3 = own ? k4 : k3; k4 = own ? k5 : k4; k5 = own ? k6 : k5; k6 = own ? k7 : k6; k7 = own ? 0u : k7;
            }
            const int idx = 127 - (int)(mine & 0x7Fu);
            ts[(pp * 16 + row) * 16 + lr] = sc[row * 129 + idx];
            ti[(pp * 16 + row) * 16 + lr] = idx;
        }
        wave_sync();
    }
#pragma unroll 1
    for (int rr = 0; rr < 4; ++rr) {
        const int row = rr * 4 + lq;
        const float s1a = ts[row * 16 + lr];
        const float* s2 = ts + (16 + row) * 16;
        int ptr = 0;
        unsigned key = (mono_key(s1a + s2[0]) & ~0xFFu) | (unsigned)(255 - lr * 16);
        unsigned mine = 0u;
#pragma unroll
        for (int r = 0; r < 16; ++r) {
            const unsigned best = dpp_max16(key);
            if (lr == r) mine = best;
            if (key == best) { ++ptr; key = (ptr < 16) ? ((mono_key(s1a + s2[ptr & 15]) & ~0xFFu) | (unsigned)(255 - lr * 16 - ptr)) : 0u; }
        }
        const int ci = 255 - (int)(mine & 0xFFu), a = ci >> 4, bb = ci & 15;
        const float scv = ts[row * 16 + a] + s2[bb];
        const int e = ti[row * 16 + a] * 128 + ti[(16 + row) * 16 + bb];
        float m16 = scv;
        m16 = fmaxf(m16, __builtin_bit_cast(float, __builtin_amdgcn_update_dpp(0, __builtin_bit_cast(int, m16), 0xB1, 0xF, 0xF, false)));
        m16 = fmaxf(m16, __builtin_bit_cast(float, __builtin_amdgcn_update_dpp(0, __builtin_bit_cast(int, m16), 0x4E, 0xF, 0xF, false)));
        m16 = fmaxf(m16, __builtin_bit_cast(float, __builtin_amdgcn_update_dpp(0, __builtin_bit_cast(int, m16), 0x141, 0xF, 0xF, false)));
        m16 = fmaxf(m16, __builtin_bit_cast(float, __builtin_amdgcn_update_dpp(0, __builtin_bit_cast(int, m16), 0x140, 0xF, 0xF, false)));
        const float ex = expf(scv - m16);
        const float den = dpp_sum16(ex);
        const int grow = row0 + row;
        if (grow < NR) {
            __hip_atomic_store(&PIDX[(size_t)grow * 128 + h * 16 + lr], e, __ATOMIC_RELAXED, __HIP_MEMORY_SCOPE_AGENT);
            __hip_atomic_store(&PG[(size_t)grow * 128 + h * 16 + lr], ex / den, __ATOMIC_RELAXED, __HIP_MEMORY_SCOPE_AGENT);
        }
    }
}

constexpr float PEER_U_SCALE = 64.0f;
DEV unsigned pack4_fp8(float a, float b, float c, float d) { int w = 0; w = __builtin_amdgcn_cvt_pk_fp8_f32(a, b, w, false); w = __builtin_amdgcn_cvt_pk_fp8_f32(c, d, w, true); return (unsigned)w; }
DEV void peer_expert_wave(const Params& p, const int row, unsigned char* wl, const int lane_in) {
    int lane = lane_in; asm volatile("" : "+v"(lane));
    const int lr = lane & 15, lq = lane >> 4;
    unsigned char* xh = wl;
    unsigned char* xo = wl + 1024;
    float* coefl = (float*)(wl + 2048);
    int* idxl = (int*)(wl + 2048 + 512);
    const float* T1r = (const float*)(p.ws + WS_T1) + (size_t)row * 1024;
    const int* PIDX = (const int*)(p.ws + WS_PIDX) + (size_t)row * 128;
    const float* PG = (const float*)(p.ws + WS_PG) + (size_t)row * 128;
    const unsigned char* U8 = p.ws + WS_U8;
    const unsigned char* V4 = p.ws + WS_V8;
    const float* VSC = (const float*)(p.ws + WS_V8 + 8388608);
    uint4 ufa[8], ufb[8];
    {
        const unsigned char* ub_ = U8 + (size_t)PIDX[lr] * 1024 + lq * 16;
#pragma unroll
        for (int i = 0; i < 8; ++i) ufa[i] = *(const uint4*)(ub_ + i * 64);
    }
    float xv[16];
    {
        float s1 = 0.f;
#pragma unroll
        for (int j = 0; j < 4; ++j) { const float4 t = *(const float4*)(T1r + lane * 16 + j * 4); xv[4 * j] = t.x; xv[4 * j + 1] = t.y; xv[4 * j + 2] = t.z; xv[4 * j + 3] = t.w; s1 += (t.x + t.y) + (t.z + t.w); }
        const float mu1 = wave_sum(s1) * (1.0f / 1024.0f);
        float q1 = 0.f;
#pragma unroll
        for (int i = 0; i < 16; ++i) { xv[i] -= mu1; q1 += xv[i] * xv[i]; }
        const float rstd1 = 1.0f / sqrtf(wave_sum(q1) * (1.0f / 1024.0f) + LN_EPS);
#pragma unroll
        for (int j = 0; j < 4; ++j) {
            const float4 g4 = *(const float4*)(p.ln1_g + lane * 16 + j * 4), b4 = *(const float4*)(p.ln1_b + lane * 16 + j * 4);
            xv[4 * j] = xv[4 * j] * rstd1 * g4.x + b4.x; xv[4 * j + 1] = xv[4 * j + 1] * rstd1 * g4.y + b4.y; xv[4 * j + 2] = xv[4 * j + 2] * rstd1 * g4.z + b4.z; xv[4 * j + 3] = xv[4 * j + 3] * rstd1 * g4.w + b4.w;
        }
    }
    wave_sync();
    {
        uint4 hi, lo; unsigned* hp = (unsigned*)&hi; unsigned* lp = (unsigned*)&lo;
#pragma unroll
        for (int j = 0; j < 4; ++j) {
            const unsigned hw = pack4_fp8(xv[4 * j], xv[4 * j + 1], xv[4 * j + 2], xv[4 * j + 3]);
            const f32x2_ b0 = __builtin_amdgcn_cvt_pk_f32_fp8((int)hw, false), b1 = __builtin_amdgcn_cvt_pk_f32_fp8((int)hw, true);
            hp[j] = hw;
            lp[j] = pack4_fp8(16.f * (xv[4 * j] - b0[0]), 16.f * (xv[4 * j + 1] - b0[1]), 16.f * (xv[4 * j + 2] - b1[0]), 16.f * (xv[4 * j + 3] - b1[1]));
        }
        *(uint4*)(xh + lane * 16) = hi; *(uint4*)(xo + lane * 16) = lo;
    }
    { const int e0 = PIDX[lane], e1 = PIDX[64 + lane]; idxl[lane] = e0; idxl[64 + lane] = e1;
      coefl[lane] = PG[lane] * VSC[e0]; coefl[64 + lane] = PG[64 + lane] * VSC[e1]; }
    float* xs = (float*)(wl + 3072);
#pragma unroll
    for (int j = 0; j < 4; ++j) *(float4*)(xs + lane * 16 + j * 4) = make_float4(xv[4 * j], xv[4 * j + 1], xv[4 * j + 2], xv[4 * j + 3]);
    wave_sync();
    f32x4 ah = (f32x4){0.f, 0.f, 0.f, 0.f}, al = (f32x4){0.f, 0.f, 0.f, 0.f};
#define U_LOAD(DST, HH) { const unsigned char* ub_ = U8 + (size_t)idxl[((HH) >> 1) * 16 + lr] * 1024 + ((HH) & 1) * 512 + lq * 16; \
        _Pragma("unroll") for (int i = 0; i < 8; ++i) DST[i] = *(const uint4*)(ub_ + i * 64); }
#define U_HALF(SRC, HH) { \
        _Pragma("unroll") for (int i = 0; i < 8; ++i) { \
            if ((i & 1) == 0) asm volatile("" ::: "memory");        \
            const int off = ((HH) & 1) * 512 + i * 64 + lq * 16; \
            const long b0 = (long)(((unsigned long long)SRC[i].y << 32) | SRC[i].x), b1 = (long)(((unsigned long long)SRC[i].w << 32) | SRC[i].z); \
            const long h0 = *(const long*)(xh + off), h1 = *(const long*)(xh + off + 8), l0 = *(const long*)(xo + off), l1 = *(const long*)(xo + off + 8); \
            ah = __builtin_amdgcn_mfma_f32_16x16x32_fp8_fp8(h0, b0, ah, 0, 0, 0); ah = __builtin_amdgcn_mfma_f32_16x16x32_fp8_fp8(h1, b1, ah, 0, 0, 0); \
            al = __builtin_amdgcn_mfma_f32_16x16x32_fp8_fp8(l0, b0, al, 0, 0, 0); al = __builtin_amdgcn_mfma_f32_16x16x32_fp8_fp8(l1, b1, al, 0, 0, 0); } \
        if ((HH) & 1) { if (lq == 0) coefl[((HH) >> 1) * 16 + lr] *= gelu_tanh((ah[0] + al[0] * 0.0625f) * (1.0f / PEER_U_SCALE)); \
            ah = (f32x4){0.f, 0.f, 0.f, 0.f}; al = (f32x4){0.f, 0.f, 0.f, 0.f}; } }
    uint2 vfa[8], vfb[8];
#define V_LOAD(DST, J) { _Pragma("unroll") for (int u = 0; u < 8; ++u) DST[u] = *(const uint2*)(V4 + (size_t)idxl[(J) + u] * 512 + lane * 8); }
#pragma unroll 1
    for (int hh = 0; hh < 16; hh += 2) {
        U_LOAD(ufb, hh + 1)
        U_HALF(ufa, hh)
        if (hh + 2 < 16) U_LOAD(ufa, hh + 2) else V_LOAD(vfa, 0)
        U_HALF(ufb, hh + 1)
    }
#undef U_LOAD
#undef U_HALF
    wave_sync();
    float o[16];
#pragma unroll
    for (int i = 0; i < 16; ++i) o[i] = 0.f;
#define V_ACC(SRC, J) { _Pragma("unroll") for (int u = 0; u < 8; ++u) { asm volatile("" ::: "memory"); const float c_ = coefl[(J) + u]; \
            const unsigned w0_ = SRC[u].x, w1_ = SRC[u].y; \
            f32x2_ f0, f1; \
            f0 = __builtin_amdgcn_cvt_scalef32_pk_f32_fp4(w0_, 1.0f, 0); f1 = __builtin_amdgcn_cvt_scalef32_pk_f32_fp4(w0_, 1.0f, 1); o[0] += c_ * f0[0]; o[1] += c_ * f0[1]; o[2] += c_ * f1[0]; o[3] += c_ * f1[1]; \
            f0 = __builtin_amdgcn_cvt_scalef32_pk_f32_fp4(w0_, 1.0f, 2); f1 = __builtin_amdgcn_cvt_scalef32_pk_f32_fp4(w0_, 1.0f, 3); o[4] += c_ * f0[0]; o[5] += c_ * f0[1]; o[6] += c_ * f1[0]; o[7] += c_ * f1[1]; \
            f0 = __builtin_amdgcn_cvt_scalef32_pk_f32_fp4(w1_, 1.0f, 0); f1 = __builtin_amdgcn_cvt_scalef32_pk_f32_fp4(w1_, 1.0f, 1); o[8] += c_ * f0[0]; o[9] += c_ * f0[1]; o[10] += c_ * f1[0]; o[11] += c_ * f1[1]; \
            f0 = __builtin_amdgcn_cvt_scalef32_pk_f32_fp4(w1_, 1.0f, 2); f1 = __builtin_amdgcn_cvt_scalef32_pk_f32_fp4(w1_, 1.0f, 3); o[12] += c_ * f0[0]; o[13] += c_ * f0[1]; o[14] += c_ * f1[0]; o[15] += c_ * f1[1]; } }
#pragma unroll 1
    for (int j = 0; j < 128; j += 16) {
        V_LOAD(vfb, j + 8)
        V_ACC(vfa, j)
        if (j + 16 < 128) V_LOAD(vfa, j + 16)
        V_ACC(vfb, j + 8)
    }
#undef V_LOAD
#undef V_ACC
    float tv[16]; float s = 0.f;
#pragma unroll
    for (int j = 0; j < 4; ++j) { const float4 x4 = *(const float4*)(xs + lane * 16 + j * 4);
        tv[4 * j] = DN_ALPHA * x4.x + o[4 * j]; tv[4 * j + 1] = DN_ALPHA * x4.y + o[4 * j + 1]; tv[4 * j + 2] = DN_ALPHA * x4.z + o[4 * j + 2]; tv[4 * j + 3] = DN_ALPHA * x4.w + o[4 * j + 3]; }
#pragma unroll
    for (int i = 0; i < 16; ++i) s += tv[i];
    const float mu = wave_sum(s) * (1.0f / 1024.0f);
    float q = 0.f;
#pragma unroll
    for (int i = 0; i < 16; ++i) { const float d = tv[i] - mu; q += d * d; }
    const float rstd = 1.0f / sqrtf(wave_sum(q) * (1.0f / 1024.0f) + LN_EPS);
    float* y = p.out + O_Y + (size_t)row * 1024 + lane * 16;
#pragma unroll
    for (int j = 0; j < 4; ++j) {
        const float4 g4 = *(const float4*)(p.ln2_g + lane * 16 + j * 4), b4 = *(const float4*)(p.ln2_b + lane * 16 + j * 4);
        float4 yo;
        yo.x = (tv[4 * j] - mu) * rstd * g4.x + b4.x; yo.y = (tv[4 * j + 1] - mu) * rstd * g4.y + b4.y; yo.z = (tv[4 * j + 2] - mu) * rstd * g4.z + b4.z; yo.w = (tv[4 * j + 3] - mu) * rstd * g4.w + b4.w;
        *(float4*)(y + j * 4) = yo;
    }
}

constexpr int QN = 2;
struct AttnState { f32x4 ot[4][QN]; float m[QN]; float l[QN]; };

template <bool GUARD = true>
DEV void attn_block(const unsigned char* Ks, const unsigned char* VTs, const bf16x8 (&Qf)[QN][2], AttnState& A, const int mode, const int dq, const float* blut,
                    const unsigned selbit0, const unsigned selbit1, const bool slc, const int lr, const int lq, const int t0, const int ci0) {
    f32x4 sc[4][QN];
    bf16x8 kf[4][2];
#pragma unroll
    for (int kt = 0; kt < 4; ++kt) { kf[kt][0] = *(const bf16x8*)(Ks + (kt * 16 + lr) * 144 + lq * 16); kf[kt][1] = *(const bf16x8*)(Ks + (kt * 16 + lr) * 144 + 64 + lq * 16); }
#pragma unroll
    for (int kt = 0; kt < 4; ++kt) {
#pragma unroll
        for (int qi = 0; qi < QN; ++qi) {
            f32x4 a = (f32x4){0.f, 0.f, 0.f, 0.f};
            a = __builtin_amdgcn_mfma_f32_16x16x32_bf16(kf[kt][0], Qf[qi][0], a, 0, 0, 0);
            a = __builtin_amdgcn_mfma_f32_16x16x32_bf16(kf[kt][1], Qf[qi][1], a, 0, 0, 0);
            sc[kt][qi] = a;
        }
    }
    union VF { bf16x8 v; uint2 h[2]; };
    VF vfa[2][2];
#pragma unroll
    for (int dt = 0; dt < 2; ++dt)
#pragma unroll
        for (int ks = 0; ks < 2; ++ks) {
            vfa[dt][ks].h[0] = *(const uint2*)(VTs + (dt * 16 + lr) * 144 + (32 * ks + lq * 4) * 2);
            vfa[dt][ks].h[1] = *(const uint2*)(VTs + (dt * 16 + lr) * 144 + (32 * ks + 16 + lq * 4) * 2);
        }
    if (mode != 0 || slc) {
#pragma unroll
        for (int kt = 0; kt < 4; ++kt)
#pragma unroll
            for (int qi = 0; qi < QN; ++qi)
#pragma unroll
                for (int g = 0; g < 4; ++g) {
                    const int kl = kt * 16 + lq * 4 + g, ql = qi * 16 + lr;
                    float v = sc[kt][qi][g];
                    bool ok = true;
                    if (mode == 1 || mode == 2) { const int di = dq + ql - kl; v += blut[di < 0 ? 0 : di]; }
                    if (mode == 2) ok = kl <= ql + dq;
                    if (mode == 3) ok = kl > ql + dq - 512;
                    if (mode == 4) { const int ci = ci0 + kl, dist = t0 + ql - (16 * ci + 31); ok = (dist >= 0) && (ci < 127); if (dist >= 0 && dist < 192) v += blut[dist]; }
                    if (mode == 5) { const int dist = dq - ci0 * kl; ok = (kl < t0) && (dist >= 0); if (dist >= 0 && dist < 192) v += blut[dist]; }
                    if (slc) ok = ok && ((qi == 0 ? selbit0 : selbit1) != 0u);
                    sc[kt][qi][g] = ok ? v : NEGF;
                }
    }
    bf16x8 pf[QN][2];
#pragma unroll
    for (int qi = 0; qi < QN; ++qi) {
        float mb = fmaxf(fmaxf(sc[0][qi][0], sc[0][qi][1]), sc[0][qi][2]);
        mb = fmaxf(fmaxf(mb, sc[0][qi][3]), sc[1][qi][0]); mb = fmaxf(fmaxf(mb, sc[1][qi][1]), sc[1][qi][2]); mb = fmaxf(fmaxf(mb, sc[1][qi][3]), sc[2][qi][0]);
        mb = fmaxf(fmaxf(mb, sc[2][qi][1]), sc[2][qi][2]); mb = fmaxf(fmaxf(mb, sc[2][qi][3]), sc[3][qi][0]); mb = fmaxf(fmaxf(mb, sc[3][qi][1]), sc[3][qi][2]); mb = fmaxf(mb, sc[3][qi][3]);
        mb = fmaxf(mb, __shfl_xor(mb, 16)); mb = fmaxf(mb, __shfl_xor(mb, 32));
        const float mn = fmaxf(A.m[qi], mb);
        const float alpha = __builtin_amdgcn_exp2f(A.m[qi] - mn);
        A.m[qi] = mn;
        float rs = 0.f;
#pragma unroll
        for (int kt = 0; kt < 4; ++kt)
#pragma unroll
            for (int g = 0; g < 4; ++g) { const float v = sc[kt][qi][g]; const float e = (!GUARD || v > -1e29f) ? __builtin_amdgcn_exp2f(v - mn) : 0.f; sc[kt][qi][g] = e; rs += e; }
        A.l[qi] = A.l[qi] * alpha + rs;
#pragma unroll
        for (int dt = 0; dt < 4; ++dt) A.ot[dt][qi] = A.ot[dt][qi] * alpha;
#pragma unroll
        for (int ks = 0; ks < 2; ++ks) {
            union { bf16x8 v; unsigned u[4]; } pk;
            pk.u[0] = cvt_pk_bf16(sc[2 * ks][qi][0], sc[2 * ks][qi][1]); pk.u[1] = cvt_pk_bf16(sc[2 * ks][qi][2], sc[2 * ks][qi][3]);
            pk.u[2] = cvt_pk_bf16(sc[2 * ks + 1][qi][0], sc[2 * ks + 1][qi][1]); pk.u[3] = cvt_pk_bf16(sc[2 * ks + 1][qi][2], sc[2 * ks + 1][qi][3]);
            pf[qi][ks] = pk.v;
        }
    }
    VF vfb[2][2];
#pragma unroll
    for (int dt = 0; dt < 2; ++dt)
#pragma unroll
        for (int ks = 0; ks < 2; ++ks) {
            vfb[dt][ks].h[0] = *(const uint2*)(VTs + ((dt + 2) * 16 + lr) * 144 + (32 * ks + lq * 4) * 2);
            vfb[dt][ks].h[1] = *(const uint2*)(VTs + ((dt + 2) * 16 + lr) * 144 + (32 * ks + 16 + lq * 4) * 2);
        }
#pragma unroll
    for (int dt = 0; dt < 2; ++dt)
#pragma unroll
        for (int ks = 0; ks < 2; ++ks)
#pragma unroll
            for (int qi = 0; qi < QN; ++qi) A.ot[dt][qi] = __builtin_amdgcn_mfma_f32_16x16x32_bf16(vfa[dt][ks].v, pf[qi][ks], A.ot[dt][qi], 0, 0, 0);
#pragma unroll
    for (int dt = 0; dt < 2; ++dt)
#pragma unroll
        for (int ks = 0; ks < 2; ++ks)
#pragma unroll
            for (int qi = 0; qi < QN; ++qi) A.ot[dt + 2][qi] = __builtin_amdgcn_mfma_f32_16x16x32_bf16(vfb[dt][ks].v, pf[qi][ks], A.ot[dt + 2][qi], 0, 0, 0);
}

DEV void nsa_prompt_item(const Params& p, const int b, const int hkv, const int q32, unsigned char* lds) {
    int tid_ = threadIdx.x; asm volatile("" : "+v"(tid_));
    const int tid = tid_, lane = tid & 63, g = tid >> 6, lr = lane & 15, lq = lane >> 4;
    const int hq = hkv * 4 + g, t0 = q32 * 32, kd = t0 >> 6;
    unsigned char* Ks = lds; unsigned char* VTs = lds + 9216;
    float* biasl = (float*)(lds + 36864); float* psl = (float*)(lds + 39936); unsigned* selm = (unsigned*)(lds + 44160); unsigned* misc = (unsigned*)(lds + 44288);
    const bf16_t* ZB = (const bf16_t*)(p.ws + WS_ZB);
    const bf16_t* VTS = (const bf16_t*)(p.ws + WS_VTS) + (size_t)(b * 2 + hkv) * 64 * 2048;
    const bf16_t* VTW = (const bf16_t*)(p.ws + WS_VTW) + (size_t)(b * 2 + hkv) * 64 * 2048;
    const bf16_t* KCB = (const bf16_t*)(p.ws + WS_KCB) + (size_t)(b * 2 + hkv) * 128 * 64;
    const bf16_t* VTC = (const bf16_t*)(p.ws + WS_VTC) + (size_t)(b * 2 + hkv) * 64 * 128;
    const float* Z = (const float*)(p.ws + WS_Z);
    float* NOUTF = (float*)(p.ws + WS_NOUTF);
    bf16_t* NOUTB = (bf16_t*)(p.ws + WS_NOUTB);
    __syncthreads();
    for (int i = tid; i < 4 * 192; i += 256) { const int gg = i / 192, d = i % 192; biasl[i] = (p.rel_bias[rel_bucket(d) * 8 + hkv * 4 + gg] - p.rel_bias[31 * 8 + hkv * 4 + gg]) * LOG2E; }
    for (int i = tid; i < 32 * 33; i += 256) psl[i] = 0.f;
    if (tid < 32) selm[tid] = 0u;
    if (tid == 0) misc[0] = 0u;
    const float* blut = biasl + g * 192;
    bf16x8 Qf[QN][2];
#pragma unroll
    for (int qi = 0; qi < QN; ++qi)
#pragma unroll
        for (int kk = 0; kk < 2; ++kk) Qf[qi][kk] = *(const bf16x8*)(ZB + (size_t)(b * 2048 + t0 + qi * 16 + lr) * IN_DIM + C_Q + hq * 64 + kk * 32 + lq * 8);

    unsigned msk0 = 0u, msk1 = 0u;
    uint4 trk0, trk1, trv0, trv1;
    int* blist = (int*)(lds + 44544);
    auto load_tiles = [&](int kind, int kb) __attribute__((always_inline)) {
#pragma unroll
        for (int i = 0; i < 2; ++i) {
            const int id = tid + 256 * i, row = id >> 3, ch = id & 7;
            uint4 rk, rv;
            if (kind == 0) { rk = *(const uint4*)(KCB + (size_t)(kb * 64 + row) * 64 + ch * 8); rv = *(const uint4*)(VTC + (size_t)row * 128 + kb * 64 + ch * 8); }
            else {
                rk = *(const uint4*)(ZB + (size_t)(b * 2048 + kb * 64 + row) * IN_DIM + (kind == 1 ? C_KS : C_KW) + hkv * 64 + ch * 8);
                rv = *(const uint4*)((kind == 1 ? VTS : VTW) + (size_t)row * 2048 + kb * 64 + ch * 8);
            }
            if (i == 0) { trk0 = rk; trv0 = rv; } else { trk1 = rk; trv1 = rv; }
        }
    };
    auto store_tiles = [&]() __attribute__((always_inline)) {
#pragma unroll
        for (int i = 0; i < 2; ++i) { const int id = tid + 256 * i, row = id >> 3, ch = id & 7; *(uint4*)(Ks + row * 144 + ch * 16) = (i == 0 ? trk0 : trk1); *(uint4*)(VTs + row * 144 + ch * 16) = (i == 0 ? trv0 : trv1); }
    };
    auto store_tiles_to = [&](const int off) __attribute__((always_inline)) {
#pragma unroll
        for (int i = 0; i < 2; ++i) { const int id = tid + 256 * i, row = id >> 3, ch = id & 7; *(uint4*)(Ks + off + row * 144 + ch * 16) = (i == 0 ? trk0 : trk1); *(uint4*)(VTs + off + row * 144 + ch * 16) = (i == 0 ? trv0 : trv1); }
    };
    auto run_blocks = [&](const int kind, const int nb, const bool slc, AttnState& A) __attribute__((always_inline)) {
        load_tiles(kind, blist[0]);
        __syncthreads();
        store_tiles_to(0);
        if (nb > 1) load_tiles(kind, blist[1]);
        __syncthreads();
        for (int i = 0; i < nb; ++i) {
            const int kb = blist[i], dq = t0 - kb * 64, cur = (i & 1) * 18432;
            if (i + 1 < nb) { store_tiles_to(18432 - cur); if (i + 2 < nb) load_tiles(kind, blist[i + 2]); }
            const int mode = (kb == kd) ? 2 : ((kb >= kd - 2) ? 1 : ((kind == 2 && dq + 31 >= 512) ? 3 : 0));
            attn_block<false>(Ks + cur, VTs + cur, Qf, A, mode, dq, blut, slc ? ((msk0 >> kb) & 1u) : 1u, slc ? ((msk1 >> kb) & 1u) : 1u, slc, lr, lq, t0, 0);
            __syncthreads();
        }
    };
    auto reset = [&](AttnState& A) __attribute__((always_inline)) {
#pragma unroll
        for (int qi = 0; qi < QN; ++qi) { A.m[qi] = NEGF; A.l[qi] = 0.f;
#pragma unroll
            for (int dt = 0; dt < 4; ++dt) A.ot[dt][qi] = (f32x4){0.f, 0.f, 0.f, 0.f}; }
    };
    auto finish = [&](AttnState& A, int br) __attribute__((always_inline)) {
#pragma unroll
        for (int qi = 0; qi < QN; ++qi) {
            float lt = A.l[qi]; lt += __shfl_xor(lt, 16); lt += __shfl_xor(lt, 32);
            const float sc = (lt > 0.f) ? sigmoidf_(Z[(size_t)(b * 2048 + t0 + qi * 16 + lr) * 32 + 8 + br * 8 + hq]) / lt : 0.f;
            const size_t row = (size_t)(b * 2048 + t0 + qi * 16 + lr);
#pragma unroll
            for (int dt = 0; dt < 4; ++dt) {
                const int col = hq * 64 + dt * 16 + lq * 4;
                f32x4 v = A.ot[dt][qi] * sc;
                if (br > 0) v = v + *(const f32x4*)(NOUTF + row * 512 + col);
                if (br < 2) *(f32x4*)(NOUTF + row * 512 + col) = v; else store_bf16x4(NOUTB + row * 512 + col, v);
            }
        }
    };

    AttnState A;
    const int ncb = ((t0 >> 4) >= 64) ? 2 : 1;
    reset(A);
    load_tiles(0, 0);
    for (int kb = 0; kb < ncb; ++kb) {
        __syncthreads(); store_tiles(); __syncthreads();
        if (kb + 1 < ncb) load_tiles(0, kb + 1);
        attn_block(Ks, VTs, Qf, A, 4, 0, blut, 1u, 1u, false, lr, lq, t0, kb * 64);
    }
    finish(A, 0);
    {
        float linv[QN];
#pragma unroll
        for (int qi = 0; qi < QN; ++qi) { float lt = A.l[qi]; lt += __shfl_xor(lt, 16); lt += __shfl_xor(lt, 32); linv[qi] = (lt > 0.f) ? 1.0f / lt : 0.f; }
        for (int kb = 0; kb < ncb; ++kb) {
            if (ncb > 1) { load_tiles(0, kb); __syncthreads(); store_tiles(); __syncthreads(); }
#pragma unroll
            for (int kt = 0; kt < 4; ++kt) {
                const bf16x8 k0 = *(const bf16x8*)(Ks + (kt * 16 + lr) * 144 + lq * 16), k1 = *(const bf16x8*)(Ks + (kt * 16 + lr) * 144 + 64 + lq * 16);
#pragma unroll
                for (int qi = 0; qi < QN; ++qi) {
                    f32x4 a = (f32x4){0.f, 0.f, 0.f, 0.f};
                    a = __builtin_amdgcn_mfma_f32_16x16x32_bf16(k0, Qf[qi][0], a, 0, 0, 0);
                    a = __builtin_amdgcn_mfma_f32_16x16x32_bf16(k1, Qf[qi][1], a, 0, 0, 0);
                    float pr[4];
#pragma unroll
                    for (int gg = 0; gg < 4; ++gg) {
                        const int ci = kb * 64 + kt * 16 + lq * 4 + gg, ql = qi * 16 + lr, dist = t0 + ql - (16 * ci + 31);
                        float v = a[gg];
                        if (dist >= 0 && dist < 192) v += blut[dist];
                        pr[gg] = (dist >= 0 && ci < 127) ? __builtin_amdgcn_exp2f(v - A.m[qi]) * linv[qi] : 0.f;
                    }
                    const int blk = kb * 16 + kt * 4 + lq, ql = qi * 16 + lr;
                    atomicAdd(&psl[ql * 33 + blk], 2.0f * (pr[0] + pr[1] + pr[2]) + pr[3]);
                    atomicAdd(&psl[ql * 33 + blk + 1], pr[3]);
                }
            }
        }
    }
    __syncthreads();
    {
        const int ql = tid >> 3, part = tid & 7, tq = t0 + ql, cur = tq >> 6;
        float scv[32];
#pragma unroll
        for (int j = 0; j < 32; ++j) {
            const bool causal = j * 64 <= tq, forced = (j == 0) || (j == cur) || (j == cur - 1);
            scv[j] = causal ? (forced ? 1e4f : psl[ql * 33 + j]) : NEGF;
        }
        unsigned mbits = 0u;
#pragma unroll
        for (int jj = 0; jj < 4; ++jj) {
            const int j = part * 4 + jj;
            float my = NEGF;
#pragma unroll
            for (int k = 0; k < 32; ++k) my = (k == j) ? scv[k] : my;
            int rank = 0;
#pragma unroll
            for (int k = 0; k < 32; ++k) rank += ((scv[k] > my) || (scv[k] == my && k < j)) ? 1 : 0;
            if (rank < 16 && j * 64 <= tq) mbits |= (1u << j);
        }
        atomicOr(&selm[ql], mbits);
        atomicOr(&misc[0], mbits);
    }
    __syncthreads();
    msk0 = selm[lr]; msk1 = selm[16 + lr];
    const unsigned anym = misc[0];
    reset(A);
    {
        if (tid == 0) { int n = 0; blist[n++] = kd; for (int j = 0; j < kd; ++j) if ((anym >> j) & 1u) blist[n++] = j; blist[40] = n; }
        __syncthreads();
        run_blocks(1, blist[40], true, A);
    }
    finish(A, 1);
    reset(A);
    {
        const int klo = (t0 >= 511) ? ((t0 - 511) >> 6) : 0;
        __syncthreads();
        if (tid < 33 && tid <= kd - klo) blist[tid] = kd - tid;
        __syncthreads();
        run_blocks(2, kd - klo + 1, false, A);
    }
    finish(A, 2);
}

DEV void nsa_sample_item(const Params& p, const int b, const int hkv, unsigned char* lds) {
    int tid_ = threadIdx.x; asm volatile("" : "+v"(tid_));
    const int tid = tid_, lane = tid & 63, g = tid >> 6, lr = lane & 15, lq = lane >> 4;
    const int hq = hkv * 4 + g;
    unsigned char* Ks = lds; unsigned char* VTs = lds + 9216;
    float* biasl = (float*)(lds + 18432); float* psl = (float*)(lds + 21504); int* sell = (int*)(lds + 29952); float* scl = (float*)(lds + 30720);
    const bf16_t* ZB = (const bf16_t*)(p.ws + WS_ZB);
    const float* zgate = (const float*)(p.ws + WS_Z) + (size_t)(NP + b) * 32 + 8;
    const bf16_t* zbrow = ZB + (size_t)(NP + b) * IN_DIM;
    const bf16_t* KCSB = (const bf16_t*)(p.ws + WS_KCSB) + (size_t)(b * 2 + hkv) * 1024 * 64;
    const bf16_t* VTCS = (const bf16_t*)(p.ws + WS_VTCS) + (size_t)(b * 2 + hkv) * 64 * 1024;
    bf16_t* NOUTB = (bf16_t*)(p.ws + WS_NOUTB);
    __syncthreads();
    for (int i = tid; i < 4 * 192; i += 256) { const int gg = i / 192, d = i % 192; biasl[i] = (p.rel_bias[rel_bucket(d) * 8 + hkv * 4 + gg] - p.rel_bias[31 * 8 + hkv * 4 + gg]) * LOG2E; }
    for (int i = tid; i < 260; i += 256) psl[i] = 0.f;
    const float* blut = biasl + g * 192;
    bf16x8 Qf[QN][2];
#pragma unroll
    for (int kk = 0; kk < 2; ++kk) { Qf[0][kk] = *(const bf16x8*)(ZB + (size_t)(NP + b) * IN_DIM + C_Q + hq * 64 + kk * 32 + lq * 8); Qf[1][kk] = Qf[0][kk]; }
    AttnState A;
    auto reset = [&](AttnState& S_) __attribute__((always_inline)) {
#pragma unroll
        for (int qi = 0; qi < QN; ++qi) { S_.m[qi] = NEGF; S_.l[qi] = 0.f;
#pragma unroll
            for (int dt = 0; dt < 4; ++dt) S_.ot[dt][qi] = (f32x4){0.f, 0.f, 0.f, 0.f}; }
    };
    f32x4 res[4];
#pragma unroll
    for (int dt = 0; dt < 4; ++dt) res[dt] = (f32x4){0.f, 0.f, 0.f, 0.f};
    auto finish = [&](AttnState& S_, int br) __attribute__((always_inline)) {
        float lt = S_.l[0]; lt += __shfl_xor(lt, 16); lt += __shfl_xor(lt, 32);
        const float sc = (lt > 0.f) ? sigmoidf_(zgate[br * 8 + hq]) / lt : 0.f;
#pragma unroll
        for (int dt = 0; dt < 4; ++dt) res[dt] = res[dt] + S_.ot[dt][0] * sc;
    };
    uint4 trk0, trk1, trv0, trv1;
    auto load_cmp = [&](int kb) __attribute__((always_inline)) {
#pragma unroll
        for (int i = 0; i < 2; ++i) {
            const int id = tid + 256 * i, row = id >> 3, ch = id & 7;
            const uint4 rk = *(const uint4*)(KCSB + (size_t)(kb * 64 + row) * 64 + ch * 8), rv = *(const uint4*)(VTCS + (size_t)row * 1024 + kb * 64 + ch * 8);
            if (i == 0) { trk0 = rk; trv0 = rv; } else { trk1 = rk; trv1 = rv; }
        }
    };
    auto store_cmp = [&]() __attribute__((always_inline)) {
#pragma unroll
        for (int i = 0; i < 2; ++i) { const int id = tid + 256 * i, row = id >> 3, ch = id & 7; *(uint4*)(Ks + row * 144 + ch * 16) = (i == 0 ? trk0 : trk1); *(uint4*)(VTs + row * 144 + ch * 16) = (i == 0 ? trv0 : trv1); }
    };
    reset(A);
    load_cmp(0);
    for (int kb = 0; kb < 16; ++kb) {
        __syncthreads(); store_cmp(); __syncthreads();
        if (kb + 1 < 16) load_cmp(kb + 1);
        attn_block<false>(Ks, VTs, Qf, A, 5, PAST - 31 - 16 * (kb * 64), blut, 1u, 1u, false, lr, lq, (kb == 15) ? 63 : 64, 16);
    }
    finish(A, 0);
    {
        float lt = A.l[0]; lt += __shfl_xor(lt, 16); lt += __shfl_xor(lt, 32);
        const float linv = (lt > 0.f) ? 1.0f / lt : 0.f;
        for (int kb = 0; kb < 16; ++kb) {
            load_cmp(kb); __syncthreads(); store_cmp(); __syncthreads();
#pragma unroll
            for (int kt = 0; kt < 4; ++kt) {
                const bf16x8 k0 = *(const bf16x8*)(Ks + (kt * 16 + lr) * 144 + lq * 16), k1 = *(const bf16x8*)(Ks + (kt * 16 + lr) * 144 + 64 + lq * 16);
                f32x4 a = (f32x4){0.f, 0.f, 0.f, 0.f};
                a = __builtin_amdgcn_mfma_f32_16x16x32_bf16(k0, Qf[0][0], a, 0, 0, 0);
                a = __builtin_amdgcn_mfma_f32_16x16x32_bf16(k1, Qf[0][1], a, 0, 0, 0);
                float pr[4];
#pragma unroll
                for (int gg = 0; gg < 4; ++gg) {
                    const int ci = kb * 64 + kt * 16 + lq * 4 + gg, dist = PAST - 31 - 16 * ci;
                    float v = a[gg];
                    if (dist >= 0 && dist < 192) v += blut[dist];
                    pr[gg] = (ci < 1023) ? __builtin_amdgcn_exp2f(v - A.m[0]) * linv : 0.f;
                }
                if (lr == 0) {
                    const int blk = kb * 16 + kt * 4 + lq;
                    atomicAdd(&psl[blk], 2.0f * (pr[0] + pr[1] + pr[2]) + pr[3]);
                    atomicAdd(&psl[blk + 1], pr[3]);
                }
            }
        }
    }
    __syncthreads();
    for (int j = tid; j < 257; j += 256) scl[j] = (j == 0 || j == 256 || j == 255) ? 1e4f : psl[j];
    __syncthreads();
    for (int j = tid; j < 257; j += 256) {
        const float my = scl[j];
        int rank = 0;
        for (int k = 0; k < 257; ++k) { const float o2 = scl[k]; rank += ((o2 > my) || (o2 == my && k < j)) ? 1 : 0; }
        if (rank < 16) sell[rank] = j;
    }
    __syncthreads();
    uint4 rk0, rk1; unsigned rv0, rv1, rv2, rv3, rv4, rv5, rv6, rv7;
    auto load_rows = [&](const float* src, const bf16_t* srcb) __attribute__((always_inline)) {
        const int seg = tid & 3;
        if (srcb) {
            const bf16_t* kp = srcb + hkv * 64 + seg * 16; const bf16_t* vp = kp + 128;
            rk0 = *(const uint4*)kp; rk1 = *(const uint4*)(kp + 8);
            const uint4 v0 = *(const uint4*)vp, v1 = *(const uint4*)(vp + 8);
            rv0 = v0.x; rv1 = v0.y; rv2 = v0.z; rv3 = v0.w; rv4 = v1.x; rv5 = v1.y; rv6 = v1.z; rv7 = v1.w;
        } else {
            const bool nz = src != nullptr;
            const float* kp = (nz ? src : p.state_win) + hkv * 64 + seg * 16; const float* vp = kp + 128;
            const float4 a0 = *(const float4*)kp, a1 = *(const float4*)(kp + 4), a2 = *(const float4*)(kp + 8), a3 = *(const float4*)(kp + 12);
            const float4 c0 = *(const float4*)vp, c1 = *(const float4*)(vp + 4), c2 = *(const float4*)(vp + 8), c3 = *(const float4*)(vp + 12);
            const unsigned mk = nz ? 0xffffffffu : 0u;
            rk0.x = cvt_pk_bf16(a0.x, a0.y) & mk; rk0.y = cvt_pk_bf16(a0.z, a0.w) & mk; rk0.z = cvt_pk_bf16(a1.x, a1.y) & mk; rk0.w = cvt_pk_bf16(a1.z, a1.w) & mk;
            rk1.x = cvt_pk_bf16(a2.x, a2.y) & mk; rk1.y = cvt_pk_bf16(a2.z, a2.w) & mk; rk1.z = cvt_pk_bf16(a3.x, a3.y) & mk; rk1.w = cvt_pk_bf16(a3.z, a3.w) & mk;
            rv0 = cvt_pk_bf16(c0.x, c0.y) & mk; rv1 = cvt_pk_bf16(c0.z, c0.w) & mk; rv2 = cvt_pk_bf16(c1.x, c1.y) & mk; rv3 = cvt_pk_bf16(c1.z, c1.w) & mk;
            rv4 = cvt_pk_bf16(c2.x, c2.y) & mk; rv5 = cvt_pk_bf16(c2.z, c2.w) & mk; rv6 = cvt_pk_bf16(c3.x, c3.y) & mk; rv7 = cvt_pk_bf16(c3.z, c3.w) & mk;
        }
    };
    auto store_rows = [&]() __attribute__((always_inline)) {
        const int kl = tid >> 2, seg = tid & 3;
        *(uint4*)(Ks + kl * 144 + seg * 32) = rk0; *(uint4*)(Ks + kl * 144 + seg * 32 + 16) = rk1;
#define VT_PUT(i_, w_) { *(bf16_t*)(VTs + (seg * 16 + (i_)) * 144 + kl * 2) = (bf16_t)((w_) & 0xffffu); *(bf16_t*)(VTs + (seg * 16 + (i_) + 1) * 144 + kl * 2) = (bf16_t)((w_) >> 16); }
        VT_PUT(0, rv0) VT_PUT(2, rv1) VT_PUT(4, rv2) VT_PUT(6, rv3) VT_PUT(8, rv4) VT_PUT(10, rv5) VT_PUT(12, rv6) VT_PUT(14, rv7)
#undef VT_PUT
    };
    auto slc_row = [&](int blk) __attribute__((always_inline)) -> const float* {
        const int kl = tid >> 2;
        if (blk < 256) { const int page = p.page_table[b * 128 + (blk >> 1)]; return p.cache_slc + ((size_t)page * 128 + (blk & 1) * 64 + kl) * 256; }
        return nullptr;
    };
    auto slc_rowb = [&](int blk) __attribute__((always_inline)) -> const bf16_t* { return (blk == 256 && (tid >> 2) == 0) ? zbrow + C_KS : nullptr; };
    reset(A);
    load_rows(slc_row(sell[0]), slc_rowb(sell[0]));
    for (int si = 0; si < 16; ++si) {
        const int blk = sell[si];
        __syncthreads(); store_rows(); __syncthreads();
        if (si + 1 < 16) load_rows(slc_row(sell[si + 1]), slc_rowb(sell[si + 1]));
        attn_block<false>(Ks, VTs, Qf, A, 5, PAST - blk * 64, blut, 1u, 1u, false, lr, lq, (blk == 256) ? 1 : 64, 1);
    }
    finish(A, 1);
    auto win_row = [&](int wb) __attribute__((always_inline)) -> const float* {
        const int j = 1 + wb * 64 + (tid >> 2);
        return (j < 512) ? p.state_win + ((size_t)b * 512 + j) * 256 : nullptr;
    };
    auto win_rowb = [&](int wb) __attribute__((always_inline)) -> const bf16_t* { return (1 + wb * 64 + (tid >> 2) == 512) ? zbrow + C_KW : nullptr; };
    reset(A);
    load_rows(win_row(0), win_rowb(0));
    for (int wb = 0; wb < 8; ++wb) {
        __syncthreads(); store_rows(); __syncthreads();
        if (wb + 1 < 8) load_rows(win_row(wb + 1), win_rowb(wb + 1));
        attn_block<false>(Ks, VTs, Qf, A, 5, 511 - wb * 64, blut, 1u, 1u, false, lr, lq, 64, 1);
    }
    finish(A, 2);
    if (lr == 0) {
#pragma unroll
        for (int dt = 0; dt < 4; ++dt) store_bf16x4(NOUTB + (size_t)(NP + b) * 512 + hq * 64 + dt * 16 + lq * 4, res[dt]);
    }
}

DEV int otid() { int t = threadIdx.x; asm volatile("" : "+v"(t)); return t; }
#define Z ((float*)(p.ws + WS_Z))
#define HRAW ((float*)(p.ws + WS_HRAW))
#define MOUTB ((bf16_t*)(p.ws + WS_MOUTB))
#define NOUTB ((bf16_t*)(p.ws + WS_NOUTB))
#define MIXB ((bf16_t*)(p.ws + WS_MIXB))
#define T1 ((float*)(p.ws + WS_T1))
#define X1B ((bf16_t*)(p.ws + WS_X1B))
#define QPB ((bf16_t*)(p.ws + WS_QPB))
#define CONVB ((bf16_t*)(p.ws + WS_CONVB))
#define XB ((bf16_t*)(p.ws + WS_XB))
#define WIN_T ((bf16_t*)(p.ws + WS_WIN_T))
#define WUPM_T ((bf16_t*)(p.ws + WS_WUPM_T))
#define WUPN_T ((bf16_t*)(p.ws + WS_WUPN_T))
#define WOUT_T ((bf16_t*)(p.ws + WS_WOUT_T))
#define PWQ_T ((bf16_t*)(p.ws + WS_PWQ_T))
#define WQK_T ((bf16_t*)(p.ws + WS_WQK_T))
#define W1_T ((bf16_t*)(p.ws + WS_W1_T))
#define W2_T ((bf16_t*)(p.ws + WS_W2_T))
#define SUBK ((bf16_t*)(p.ws + WS_SUBK))
#define ZB ((bf16_t*)(p.ws + WS_ZB))
#define VTS ((bf16_t*)(p.ws + WS_VTS))
#define VTW ((bf16_t*)(p.ws + WS_VTW))
#define KCB ((bf16_t*)(p.ws + WS_KCB))
#define VTC ((bf16_t*)(p.ws + WS_VTC))
__global__ void __launch_bounds__(NTHREADS, 2) fwd_kernel(Params p) {
    extern __shared__ __attribute__((aligned(16))) unsigned char smem[];
    if (threadIdx.x == 0) { *(uint4*)smem = make_uint4(0u, 0u, 0u, 0u); }
    __syncthreads();
    XcdBarrier bar = xcd_barrier_post((unsigned*)(p.ws + WS_BAR), (volatile LAS unsigned*)smem);
    float* lds = (float*)(smem + 16);
    unsigned char* ldsb = smem + 16;
#define TID_ (otid())
#define LANE_ (otid() & 63)
#define WV_ (otid() >> 6)
#define GW_ ((int)(blockIdx.x * 4 + (otid() >> 6)))
#define GT_ ((size_t)blockIdx.x * NTHREADS + otid())
    const int nw = gridDim.x * 4;
    const size_t nt = (size_t)gridDim.x * NTHREADS;


    {
        for (size_t id = GT_; id < (size_t)MP * 128; id += nt) {
            const int row = (int)(id >> 7), k8 = (int)(id & 127) * 8;
            float f[8];
            if (row < NR) {
                const float* s = (row < NP ? p.x_prompt + (size_t)row * 1024 : p.x_sample + (size_t)(row - NP) * 1024) + k8;
                const float4 a = *(const float4*)s, b = *(const float4*)(s + 4);
                f[0] = a.x; f[1] = a.y; f[2] = a.z; f[3] = a.w; f[4] = b.x; f[5] = b.y; f[6] = b.z; f[7] = b.w;
            } else {
#pragma unroll
                for (int i = 0; i < 8; ++i) f[i] = 0.f;
            }
            *(uint4*)(XB + (size_t)row * 1024 + k8) = pack8(f);
        }
        transpose_to_bf16(p.w_in, 1024, IN_DIM, WIN_T, GT_, nt);
        for (int h = 0; h < 4; ++h) {
            transpose_to_bf16(p.wq + (size_t)h * 16384, 128, 128, WQK_T + (size_t)(h * 256) * 128, GT_, nt);
            transpose_to_bf16(p.wk + (size_t)h * 16384, 128, 128, WQK_T + (size_t)(h * 256 + 128) * 128, GT_, nt);
        }
        for (size_t id = GT_; id < (size_t)2 * 128 * 128; id += nt) {
            const int k8 = (int)(id & 127) * 8, np = (int)((id >> 7) & 127), c = (int)(id >> 14);
            const int pp = np >> 6, o = np & 63, r = k8 >> 6, d = k8 & 63;
            float f[8];
#pragma unroll
            for (int e = 0; e < 8; ++e) f[e] = p.cmp_w1[((size_t)c * 2048 + (pp * 16 + r) * 64 + d + e) * 64 + o];
            *(uint4*)(W1_T + ((size_t)c * 128 + np) * 1024 + k8) = pack8(f);
        }
        if (GT_ < 128) {
            const int c = (int)GT_ >> 6, o = (int)GT_ & 63;
            float a = 0.f;
            for (int k = 0; k < 2048; ++k) a += p.cmp_pe[c * 2048 + k] * p.cmp_w1[((size_t)c * 2048 + k) * 64 + o];
            ((float*)(p.ws + WS_PESUM))[GT_] = a;
        }
        for (int c = 0; c < 2; ++c) transpose_to_bf16(p.cmp_w2 + (size_t)c * 4096, 64, 64, W2_T + (size_t)c * 4096, GT_, nt);
    }
    xcd_barrier(bar);

    gemm_glds_xcd(NR, IN_DIM, 1024,
        [&](int r, int k) { return XB + (size_t)r * 1024 + k; },
        [&](int n, int k) { return WIN_T + (size_t)n * 1024 + k; },
        [&](int r, int c8, f32x4 va, f32x4 vb) {
            { const float qs = (c8 >= C_Q && c8 < C_KC) ? (0.125f * LOG2E) : 1.0f; store_bf16x8(ZB + (size_t)r * IN_DIM + c8, va * qs, vb * qs); }
            { const int c32 = __builtin_amdgcn_readfirstlane(c8) & ~31;
              if (c32 >= C_GM || (c32 >= C_O && c32 < C_I) || (c32 >= C_Q + 24 && c32 < C_KC - 8)) return; }
#pragma unroll
          for (int hf = 0; hf < 2; ++hf) {
            const int c0 = c8 + 4 * hf; const f32x4 v = hf ? vb : va;
            if (c0 >= C_I && c0 < C_Q) *(f32x4*)(Z + (size_t)r * 32 + (c0 - C_I)) = v;
            else if (c0 >= C_G && c0 < C_GM) *(f32x4*)(Z + (size_t)r * 32 + 8 + (c0 - C_G)) = v;
            if (r < NP && ((c0 >= C_KS + 128 && c0 < C_KW) || (c0 >= C_KW + 128 && c0 < C_G))) {
                const bool isw = c0 >= C_KW; const int cc = c0 - (isw ? C_KW : C_KS) - 128;
                bf16_t* vt = (isw ? VTW : VTS) + ((size_t)((r >> 11) * 2) * 64 + cc) * 2048 + (r & 2047);
                const unsigned w0 = cvt_pk_bf16(v[0], v[1]), w1 = cvt_pk_bf16(v[2], v[3]);
                vt[0] = (bf16_t)(w0 & 0xffffu); vt[2048] = (bf16_t)(w0 >> 16); vt[4096] = (bf16_t)(w1 & 0xffffu); vt[6144] = (bf16_t)(w1 >> 16);
            }
            if (r < NP && c0 >= C_V && c0 < C_O) {
                bf16_t* vt = (bf16_t*)(p.ws + WS_VTM) + ((size_t)(r >> 11) * 512 + (c0 - C_V)) * 2048 + (r & 2047);
                const unsigned w0 = cvt_pk_bf16(v[0], v[1]), w1 = cvt_pk_bf16(v[2], v[3]);
                vt[0] = (bf16_t)(w0 & 0xffffu); vt[2048] = (bf16_t)(w0 >> 16); vt[4096] = (bf16_t)(w1 & 0xffffu); vt[6144] = (bf16_t)(w1 >> 16);
            }
            if (c0 >= C_KC && c0 < C_KS) *(f32x4*)(p.out + O_CMPP + (size_t)r * 256 + (c0 - C_KC)) = v;
            else if (c0 >= C_KS && c0 < C_KW) *(f32x4*)(p.out + O_SLCP + (size_t)r * 256 + (c0 - C_KS)) = v;
            else if (c0 >= C_KW && c0 < C_G) {
                if (r < NP) { const int t = r & 2047; if (t >= 1536) *(f32x4*)(p.out + O_WINP + ((size_t)(r >> 11) * 512 + (t - 1536)) * 256 + (c0 - C_KW)) = v; }
                else *(f32x4*)(p.out + O_WINS + ((size_t)(r - NP) * 512 + 511) * 256 + (c0 - C_KW)) = v;
            } else if (c0 < C_V) {
                if (r < NP) { const int t = r & 2047; if (t >= 2045) *(f32x4*)(p.out + O_CVP + ((size_t)(r >> 11) * 3 + (t - 2045)) * 512 + c0) = v; }
                else *(f32x4*)(p.out + O_CVS + ((size_t)(r - NP) * 3 + 2) * 512 + c0) = v;
            }
          }
        }, smem + 256);
    xcd_barrier(bar);

    for (size_t i = GT_; i < (size_t)NR * 64; i += nt) {
        const int ch = (int)(i & 63) * 8; const int r = (int)(i >> 6);
        float a[8];
        { const float4 b0 = *(const float4*)(p.conv_b + ch), b1 = *(const float4*)(p.conv_b + ch + 4); a[0] = b0.x; a[1] = b0.y; a[2] = b0.z; a[3] = b0.w; a[4] = b1.x; a[5] = b1.y; a[6] = b1.z; a[7] = b1.w; }
#pragma unroll
        for (int j = 0; j < 4; ++j) {
            const float4 w0 = *(const float4*)(p.conv_w + j * 512 + ch), w1 = *(const float4*)(p.conv_w + j * 512 + ch + 4);
            float u[8]; bool have = true;
            if (r < NP) {
                const int t = r & 2047;
                if (t + j - 3 >= 0) { const uint4 q = *(const uint4*)(ZB + (size_t)(r + j - 3) * IN_DIM + C_U + ch);
                    u[0] = bf_lo(q.x); u[1] = bf_hi(q.x); u[2] = bf_lo(q.y); u[3] = bf_hi(q.y); u[4] = bf_lo(q.z); u[5] = bf_hi(q.z); u[6] = bf_lo(q.w); u[7] = bf_hi(q.w); }
                else have = false;
            } else if (j < 3) {
                const float* sc = p.state_conv + ((size_t)(r - NP) * 3 + j) * 512 + ch;
                const float4 s0 = *(const float4*)sc, s1 = *(const float4*)(sc + 4);
                u[0] = s0.x; u[1] = s0.y; u[2] = s0.z; u[3] = s0.w; u[4] = s1.x; u[5] = s1.y; u[6] = s1.z; u[7] = s1.w;
            } else { const uint4 q = *(const uint4*)(ZB + (size_t)r * IN_DIM + C_U + ch);
                u[0] = bf_lo(q.x); u[1] = bf_hi(q.x); u[2] = bf_lo(q.y); u[3] = bf_hi(q.y); u[4] = bf_lo(q.z); u[5] = bf_hi(q.z); u[6] = bf_lo(q.w); u[7] = bf_hi(q.w); }
            if (have) { a[0] += w0.x * u[0]; a[1] += w0.y * u[1]; a[2] += w0.z * u[2]; a[3] += w0.w * u[3]; a[4] += w1.x * u[4]; a[5] += w1.y * u[5]; a[6] += w1.z * u[6]; a[7] += w1.w * u[7]; }
        }
#pragma unroll
        for (int e = 0; e < 8; ++e) a[e] = a[e] * sigmoidf_(a[e]);
        *(uint4*)(CONVB + (size_t)r * 512 + ch) = pack8(a);
    }
    xcd_barrier(bar);

    const int QK_FIRST = (gridDim.x == 512) ? 192 : 0;
    for (int c = 0; c < 2; ++c) {
    for (int h = 2 * c; h < 2 * c + 2; ++h) {
        gemm_glds(NR, 256, 128,
            [&](int r, int k) { return CONVB + (size_t)r * 512 + h * 128 + k; },
            [&](int n, int k) { return WQK_T + (size_t)(h * 256 + n) * 128 + k; },
            [&](int r, int c8, f32x4 va, f32x4 vb) {
                if (c8 >= 128) { va = va * 0.08838834764831845f; vb = vb * 0.08838834764831845f; }
                if (c8 < 128) store_bf16x8((bf16_t*)(p.ws + WS_QB) + (size_t)r * 512 + h * 128 + c8, va, vb);
                else {
                    store_bf16x8((bf16_t*)(p.ws + WS_KB) + (size_t)r * 512 + h * 128 + (c8 - 128), va, vb);
                    if (r < NP) {
                        bf16_t* kt = (bf16_t*)(p.ws + WS_KTB) + ((size_t)((r >> 11) * 4 + h) * 128 + (c8 - 128)) * 2048 + (r & 2047);
                        const unsigned w0 = cvt_pk_bf16(va[0], va[1]), w1 = cvt_pk_bf16(va[2], va[3]), w2 = cvt_pk_bf16(vb[0], vb[1]), w3 = cvt_pk_bf16(vb[2], vb[3]);
                        kt[0] = (bf16_t)(w0 & 0xffffu); kt[2048] = (bf16_t)(w0 >> 16); kt[4096] = (bf16_t)(w1 & 0xffffu); kt[6144] = (bf16_t)(w1 >> 16);
                        kt[8192] = (bf16_t)(w2 & 0xffffu); kt[10240] = (bf16_t)(w2 >> 16); kt[12288] = (bf16_t)(w3 & 0xffffu); kt[14336] = (bf16_t)(w3 >> 16);
                    }
                } }, smem + 256, h * 410, 0, NoMid(), QK_FIRST, (int)gridDim.x - QK_FIRST);
    }
        for (int grp = 0; grp < 2; ++grp) {
            const int TPB = grp ? 9 : 1, NCH = grp ? 1024 : 128, NBH = grp ? 64 : 32;
            struct CmpLoader0 {
                const Params& p; const bf16_t* zb; int c, TPB, NCH;
                DEV const unsigned char* prep(int vrow) const {
                    const int tile = vrow >> 7, bh = tile / TPB, n_ = 127 * (tile % TPB) + (vrow & 127), n = n_ < NCH ? n_ : NCH - 1;
                    const int b = bh >> 1, hh = bh & 1, tok = 16 * n;
                    return (const unsigned char*)(zb + ((size_t)b * 2048 + tok) * IN_DIM + C_KC + c * 128 + hh * 64);
                }
                struct Raw { uint4 u; };
                DEV Raw load(const unsigned char* ctx, int k) const { const int r = k >> 6, d0 = k & 63; Raw q; q.u = *(const uint4*)((const bf16_t*)ctx + (size_t)r * IN_DIM + d0); return q; }
                DEV uint4 pack(const Raw& q) const { return q.u; }
            };
            struct CmpLoader1 {
                const Params& p; const bf16_t* zb; int c, TPB, NCH;
                DEV const unsigned char* prep(int vrow) const {
                    const int tile = vrow >> 7, bh = tile < 512 ? tile >> 3 : tile - 512, tt = tile < 512 ? (tile & 7) : 8, n_ = 127 * tt + (vrow & 127), n = n_ < NCH ? n_ : NCH - 1;
                    const int b = bh >> 1, hh = bh & 1, tok = 16 * n;
                    const int page = p.page_table[b * 128 + (tok >> 7)];
                    return (const unsigned char*)(p.cache_cmp + ((size_t)page * 128 + (tok & 127)) * 256 + c * 128 + hh * 64);
                }
                struct Raw { float4 a0, a1; };
                DEV Raw load(const unsigned char* ctx, int k) const { const int r = k >> 6, d0 = k & 63; const float* sp = (const float*)ctx + r * 256 + d0; Raw q; q.a0 = *(const float4*)sp; q.a1 = *(const float4*)(sp + 4); return q; }
                DEV uint4 pack(const Raw& q) const { float f[8] = {q.a0.x, q.a0.y, q.a0.z, q.a0.w, q.a1.x, q.a1.y, q.a1.z, q.a1.w}; return pack8(f); }
            };
            auto cmp_lb = [&](int n, int k) { return *(const uint4*)(W1_T + ((size_t)c * 128 + n) * 1024 + k); };
            auto cmp_epi = [&](f32x4 (&acc)[4][4], int bm) {
                    const int lr = LANE_ & 15, lq = LANE_ >> 4, wm = WV_ >> 1, wn = WV_ & 1;
                    const int tile = bm >> 7, bh = grp ? (tile < 512 ? tile >> 3 : tile - 512) : tile, n0 = grp ? 127 * (tile < 512 ? (tile & 7) : 8) : 0;
                    float* P1 = (float*)ldsb;
                    bf16_t* HL = (bf16_t*)(ldsb + 128 * 68 * 4);
                    __syncthreads();
                    if (wn == 1) {
#pragma unroll
                        for (int i = 0; i < 4; ++i)
#pragma unroll
                            for (int j = 0; j < 4; ++j) *(f32x4*)(P1 + (wm * 64 + i * 16 + lr) * 68 + j * 16 + lq * 4) = acc[i][j];
                    }
                    __syncthreads();
                    if (wn == 0) {
                        const float* pes = (const float*)(p.ws + WS_PESUM) + c * 64;
#pragma unroll
                        for (int i = 0; i < 4; ++i)
#pragma unroll
                            for (int j = 0; j < 4; ++j) {
                                const int rl = wm * 64 + i * 16 + lr, o0 = j * 16 + lq * 4;
                                const f32x4 nx = (rl < 127) ? *(const f32x4*)(P1 + (rl + 1) * 68 + o0) : (f32x4){0.f, 0.f, 0.f, 0.f};
                                const f32x4 pe4 = *(const f32x4*)(pes + o0);
                                f32x4 hv = acc[i][j] + nx + pe4;
                                hv[0] = gelu_tanh(hv[0]); hv[1] = gelu_tanh(hv[1]); hv[2] = gelu_tanh(hv[2]); hv[3] = gelu_tanh(hv[3]);
                                store_bf16x4(HL + rl * 72 + o0, hv);
                            }
                    }
                    __syncthreads();
                    f32x4 kc[2][4];
#pragma unroll
                    for (int i = 0; i < 2; ++i)
#pragma unroll
                        for (int j = 0; j < 4; ++j) kc[i][j] = (f32x4){0.f, 0.f, 0.f, 0.f};
#pragma unroll
                    for (int ks = 0; ks < 2; ++ks) {
                        bf16x8 hf[2], wf[4];
#pragma unroll
                        for (int i = 0; i < 2; ++i) hf[i] = *(const bf16x8*)(HL + (WV_ * 32 + i * 16 + lr) * 72 + ks * 32 + lq * 8);
#pragma unroll
                        for (int j = 0; j < 4; ++j) wf[j] = *(const bf16x8*)(W2_T + ((size_t)c * 64 + j * 16 + lr) * 64 + ks * 32 + lq * 8);
#pragma unroll
                        for (int i = 0; i < 2; ++i)
#pragma unroll
                            for (int j = 0; j < 4; ++j) kc[i][j] = __builtin_amdgcn_mfma_f32_16x16x32_bf16(wf[j], hf[i], kc[i][j], 0, 0, 0);
                    }
#pragma unroll
                    for (int i = 0; i < 2; ++i) {
                        const int rl = WV_ * 32 + i * 16 + lr, blk = n0 + rl;
                        if (rl < 127 && blk <= NCH - 2) {
#pragma unroll
                            for (int j = 0; j < 4; ++j) {
                                const int o2 = j * 16 + lq * 4;
                                if (c == 0) store_bf16x4((grp ? (bf16_t*)(p.ws + WS_KCSB) : KCB) + ((size_t)bh * NCH + blk) * 64 + o2, kc[i][j]);
                                else { bf16_t* vt = (grp ? (bf16_t*)(p.ws + WS_VTCS) : VTC) + ((size_t)bh * 64 + o2) * NCH + blk;
                                       const unsigned w0 = cvt_pk_bf16(kc[i][j][0], kc[i][j][1]), w1 = cvt_pk_bf16(kc[i][j][2], kc[i][j][3]);
                                       vt[0] = (bf16_t)(w0 & 0xffffu); vt[NCH] = (bf16_t)(w0 >> 16); vt[2 * NCH] = (bf16_t)(w1 & 0xffffu); vt[3 * NCH] = (bf16_t)(w1 >> 16); }
                            }
                        }
                    }
                    __syncthreads();
                };
            if (grp == 0) gemm_bf16<128, true>(NBH * TPB * 128, 128, 1024, CmpLoader0{p, ZB, c, TPB, NCH}, cmp_lb, cmp_epi, ldsb, c * 608 + grp * 32);
            else gemm_bf16<128, true>(NBH * TPB * 128, 128, 1024, CmpLoader1{p, ZB, c, TPB, NCH}, cmp_lb, cmp_epi, ldsb, c * 608 + grp * 32);
        }
    }
    xcd_barrier(bar);

    for (;;) {
        __syncthreads();
        if (TID_ == 0) *(volatile int*)(ldsb + 45056) = (int)atomicAdd((unsigned*)(p.ws + WS_BAR) + 2, 1u);
        __syncthreads();
        const int raw = *(volatile int*)(ldsb + 45056);
        if (raw >= 320 + 2048 + 512) break;
        int idx = raw;
        if (raw >= 320) { const int k = raw - 320, k5 = k / 5, kr = k - 5 * k5; idx = (kr == 4) ? 2368 + k5 : 320 + 4 * k5 + kr; }
        if (idx >= 320 + 2048) {
            const size_t cgt = (size_t)(idx - 2368) * NTHREADS + TID_, cnt_ = (size_t)512 * NTHREADS;
        transpose_to_bf16(p.w_up_m, 512, 1024, WUPM_T, cgt, cnt_);
        transpose_to_bf16(p.w_up_n, 512, 1024, WUPN_T, cgt, cnt_);
        transpose_to_bf16(p.w_out, 1024, 1024, WOUT_T, cgt, cnt_);
        transpose_to_bf16(p.peer_wq, 1024, 2048, PWQ_T, cgt, cnt_);
        for (size_t id = cgt; id < (size_t)2 * 128 * 128 / 8; id += cnt_) {
            float f[8];
#pragma unroll
            for (int i = 0; i < 8; ++i) f[i] = p.peer_sub[id * 8 + i];
            *(uint4*)(SUBK + id * 8) = pack8(f);
        }
        for (size_t id = cgt; id < (size_t)16384 * 64; id += cnt_) {
            const float* su = p.peer_u + id * 16; const float* sv = p.peer_v + id * 16;
            uint4 ou; unsigned* pu = (unsigned*)&ou; float vv[16]; float mx = 0.f;
#pragma unroll
            for (int j = 0; j < 4; ++j) {
                const float4 a4 = *(const float4*)(su + j * 4), c4 = *(const float4*)(sv + j * 4);
                pu[j] = pack4_fp8(a4.x * PEER_U_SCALE, a4.y * PEER_U_SCALE, a4.z * PEER_U_SCALE, a4.w * PEER_U_SCALE);
                vv[4 * j] = c4.x; vv[4 * j + 1] = c4.y; vv[4 * j + 2] = c4.z; vv[4 * j + 3] = c4.w;
                mx = fmaxf(fmaxf(mx, fmaxf(fabsf(c4.x), fabsf(c4.y))), fmaxf(fabsf(c4.z), fabsf(c4.w)));
            }
            mx = wave_max(mx);
            const float vs = mx > 0.f ? mx * (1.0f / 6.0f) : 1.0f, vinv = 1.0f / vs;
            unsigned w0 = 0u, w1 = 0u;
            w0 = __builtin_amdgcn_cvt_scalef32_pk_fp4_f32(w0, vv[0] * vinv, vv[1] * vinv, 1.0f, 0); w1 = __builtin_amdgcn_cvt_scalef32_pk_fp4_f32(w1, vv[8] * vinv, vv[9] * vinv, 1.0f, 0);
            w0 = __builtin_amdgcn_cvt_scalef32_pk_fp4_f32(w0, vv[2] * vinv, vv[3] * vinv, 1.0f, 1); w1 = __builtin_amdgcn_cvt_scalef32_pk_fp4_f32(w1, vv[10] * vinv, vv[11] * vinv, 1.0f, 1);
            w0 = __builtin_amdgcn_cvt_scalef32_pk_fp4_f32(w0, vv[4] * vinv, vv[5] * vinv, 1.0f, 2); w1 = __builtin_amdgcn_cvt_scalef32_pk_fp4_f32(w1, vv[12] * vinv, vv[13] * vinv, 1.0f, 2);
            w0 = __builtin_amdgcn_cvt_scalef32_pk_fp4_f32(w0, vv[6] * vinv, vv[7] * vinv, 1.0f, 3); w1 = __builtin_amdgcn_cvt_scalef32_pk_fp4_f32(w1, vv[14] * vinv, vv[15] * vinv, 1.0f, 3);
            *(uint4*)(p.ws + WS_U8 + id * 16) = ou; *(uint2*)(p.ws + WS_V8 + id * 8) = make_uint2(w0, w1);
            if ((id & 63) == 0) ((float*)(p.ws + WS_V8 + 8388608))[id >> 6] = vs;
        }
        for (size_t i = cgt; i < (size_t)BS * 511 * 256; i += cnt_) {
            const int j = (int)(i & 255); const int wv = (int)((i >> 8) % 511); const int b = (int)((i >> 8) / 511);
            p.out[O_WINS + ((size_t)b * 512 + wv) * 256 + j] = p.state_win[((size_t)b * 512 + wv + 1) * 256 + j];
        }
        for (size_t i = cgt; i < (size_t)BS * 2 * 512; i += cnt_) {
            const int ch = (int)(i & 511); const int jj = (int)((i >> 9) & 1); const int b = (int)(i >> 10);
            p.out[O_CVS + ((size_t)b * 3 + jj) * 512 + ch] = p.state_conv[((size_t)b * 3 + jj + 1) * 512 + ch];
        }
            continue;
        }
        if (idx < 128) mlstm_chunk_item(p, idx, ldsb);
        else if (idx < 256) mlstm_step_item(p, idx - 128, lds);
        else if (idx < 320) nsa_sample_item(p, (idx - 256) >> 1, idx & 1, ldsb);
        else { const int i2 = idx - 320; nsa_prompt_item(p, (i2 & 31) >> 1, i2 & 1, 63 - (i2 >> 5), ldsb); }
    }
    xcd_barrier(bar);

    {
        float4 h0, h1; uint4 og;
        { const int r0 = GW_ < NR ? GW_ : NR - 1; const float* hr = HRAW + (size_t)r0 * 512 + LANE_ * 8; h0 = *(const float4*)hr; h1 = *(const float4*)(hr + 4); og = *(const uint4*)(ZB + (size_t)r0 * IN_DIM + C_O + LANE_ * 8); }
        const float4 g0 = *(const float4*)(p.norm_g + LANE_ * 8), g1 = *(const float4*)(p.norm_g + LANE_ * 8 + 4);
        for (int row = GW_; row < NR; row += nw) {
            const int nr = row + nw < NR ? row + nw : row;
            const float* hr = HRAW + (size_t)nr * 512 + LANE_ * 8;
            const float4 n0 = *(const float4*)hr, n1 = *(const float4*)(hr + 4);
            const uint4 nog = *(const uint4*)(ZB + (size_t)nr * IN_DIM + C_O + LANE_ * 8);
            float x[8] = {h0.x, h0.y, h0.z, h0.w, h1.x, h1.y, h1.z, h1.w};
            float sm = 0.f;
#pragma unroll
            for (int e = 0; e < 8; ++e) sm += x[e];
            const float mu = dpp_sum16(sm) * (1.0f / 128.0f);
            float q = 0.f;
#pragma unroll
            for (int e = 0; e < 8; ++e) { x[e] -= mu; q += x[e] * x[e]; }
            const float rstd = 1.0f / sqrtf(dpp_sum16(q) * (1.0f / 128.0f) + LN_EPS);
            float o[8];
            o[0] = sigmoidf_(bf_lo(og.x)) * (x[0] * rstd * g0.x); o[1] = sigmoidf_(bf_hi(og.x)) * (x[1] * rstd * g0.y); o[2] = sigmoidf_(bf_lo(og.y)) * (x[2] * rstd * g0.z); o[3] = sigmoidf_(bf_hi(og.y)) * (x[3] * rstd * g0.w);
            o[4] = sigmoidf_(bf_lo(og.z)) * (x[4] * rstd * g1.x); o[5] = sigmoidf_(bf_hi(og.z)) * (x[5] * rstd * g1.y); o[6] = sigmoidf_(bf_lo(og.w)) * (x[6] * rstd * g1.z); o[7] = sigmoidf_(bf_hi(og.w)) * (x[7] * rstd * g1.w);
            *(uint4*)(MOUTB + (size_t)row * 512 + LANE_ * 8) = pack8(o);
            h0 = n0; h1 = n1; og = nog;
        }
    }
    xcd_barrier(bar);

    gemm_glds_mi<4>(NR, 1024, 1024,
        [&](int r, int k) { return (k < 512) ? MOUTB + (size_t)r * 512 + k : NOUTB + (size_t)r * 512 + (k - 512); },
        [&](int n, int k) { return (k < 512) ? WUPM_T + (size_t)n * 512 + k : WUPN_T + (size_t)n * 512 + (k - 512); },
        [&](int r, int c0, f32x4 va, f32x4 vb, uint2 ka, uint2 kb) {
            const uint4 gw = *(const uint4*)(ZB + (size_t)r * IN_DIM + C_GN + c0);
            f32x4 oa, ob;
            oa[0] = bf_lo(ka.x) + sigmoidf_(bf_lo(gw.x)) * va[0]; oa[1] = bf_hi(ka.x) + sigmoidf_(bf_hi(gw.x)) * va[1]; oa[2] = bf_lo(ka.y) + sigmoidf_(bf_lo(gw.y)) * va[2]; oa[3] = bf_hi(ka.y) + sigmoidf_(bf_hi(gw.y)) * va[3];
            ob[0] = bf_lo(kb.x) + sigmoidf_(bf_lo(gw.z)) * vb[0]; ob[1] = bf_hi(kb.x) + sigmoidf_(bf_hi(gw.z)) * vb[1]; ob[2] = bf_lo(kb.y) + sigmoidf_(bf_lo(gw.w)) * vb[2]; ob[3] = bf_hi(kb.y) + sigmoidf_(bf_hi(gw.w)) * vb[3];
            store_bf16x8(MIXB + (size_t)r * 1024 + c0, oa, ob); },
        smem + 256, 0, 8,
        [&](int r, int c0, f32x4& va, f32x4& vb, uint2& ka, uint2& kb) {
            const uint4 gw = *(const uint4*)(ZB + (size_t)r * IN_DIM + C_GM + c0);
            ka.x = cvt_pk_bf16(sigmoidf_(bf_lo(gw.x)) * va[0], sigmoidf_(bf_hi(gw.x)) * va[1]); ka.y = cvt_pk_bf16(sigmoidf_(bf_lo(gw.y)) * va[2], sigmoidf_(bf_hi(gw.y)) * va[3]);
            kb.x = cvt_pk_bf16(sigmoidf_(bf_lo(gw.z)) * vb[0], sigmoidf_(bf_hi(gw.z)) * vb[1]); kb.y = cvt_pk_bf16(sigmoidf_(bf_lo(gw.w)) * vb[2], sigmoidf_(bf_hi(gw.w)) * vb[3]); });
    xcd_barrier(bar);

    gemm_glds(NR, 1024, 1024,
        [&](int r, int k) { return MIXB + (size_t)r * 1024 + k; },
        [&](int n, int k) { return WOUT_T + (size_t)n * 1024 + k; },
        [&](int r, int c0, f32x4 va, f32x4 vb) {
            const float* xr = (r < NP ? p.x_prompt + (size_t)r * 1024 : p.x_sample + (size_t)(r - NP) * 1024) + c0;
            *(f32x4*)(T1 + (size_t)r * 1024 + c0) = *(const f32x4*)xr * DN_ALPHA + va; *(f32x4*)(T1 + (size_t)r * 1024 + c0 + 4) = *(const f32x4*)(xr + 4) * DN_ALPHA + vb; }, smem + 256);
    xcd_barrier(bar);

    {
        float4 cu0, cu1, cu2, cu3;
        { const int r0 = GW_ < NR ? GW_ : NR - 1; const float* tp = T1 + (size_t)r0 * 1024 + LANE_ * 4; cu0 = *(const float4*)tp; cu1 = *(const float4*)(tp + 256); cu2 = *(const float4*)(tp + 512); cu3 = *(const float4*)(tp + 768); }
        for (int row = GW_; row < NR; row += nw) {
            const int nr = row + nw < NR ? row + nw : row;
            const float* tp = T1 + (size_t)nr * 1024 + LANE_ * 4;
            const float4 nx0 = *(const float4*)tp, nx1 = *(const float4*)(tp + 256), nx2 = *(const float4*)(tp + 512), nx3 = *(const float4*)(tp + 768);
            float tv[16] = {cu0.x, cu0.y, cu0.z, cu0.w, cu1.x, cu1.y, cu1.z, cu1.w, cu2.x, cu2.y, cu2.z, cu2.w, cu3.x, cu3.y, cu3.z, cu3.w};
            float s = 0.f;
#pragma unroll
            for (int j = 0; j < 4; ++j) s += (tv[4 * j] + tv[4 * j + 1]) + (tv[4 * j + 2] + tv[4 * j + 3]);
            const float mu = wave_sum(s) * (1.0f / 1024.0f);
            float q = 0.f;
#pragma unroll
            for (int j = 0; j < 16; ++j) { const float d = tv[j] - mu; q += d * d; }
            const float rstd = 1.0f / sqrtf(wave_sum(q) * (1.0f / 1024.0f) + LN_EPS);
#pragma unroll
            for (int j = 0; j < 4; ++j) {
                const int c = j * 256 + LANE_ * 4;
                const float4 g4 = *(const float4*)(p.ln1_g + c), b4 = *(const float4*)(p.ln1_b + c);
                f32x4 o; o[0] = (tv[4 * j] - mu) * rstd * g4.x + b4.x; o[1] = (tv[4 * j + 1] - mu) * rstd * g4.y + b4.y; o[2] = (tv[4 * j + 2] - mu) * rstd * g4.z + b4.z; o[3] = (tv[4 * j + 3] - mu) * rstd * g4.w + b4.w;
                store_bf16x4(X1B + (size_t)row * 1024 + c, o);
            }
            cu0 = nx0; cu1 = nx1; cu2 = nx2; cu3 = nx3;
        }
    }
    xcd_barrier(bar);

    gemm_glds(NR, 2048, 1024,
        [&](int r, int k) { return X1B + (size_t)r * 1024 + k; },
        [&](int n, int k) { return PWQ_T + (size_t)n * 1024 + k; },
        [&](int r, int c0, f32x4 va, f32x4 vb) { store_bf16x8(QPB + (size_t)r * 2048 + c0, va, vb); }, smem + 256);
    xcd_barrier(bar);

    {
        constexpr int PLAG = 64, NTIL = 513;
        unsigned* qhead = (unsigned*)(p.ws + WS_BAR) + 4;
        unsigned* tcnt = (unsigned*)(p.ws + WS_BAR) + XCD_BAR_WORDS;
        int nxt = 0;
        if (TID_ == 0) nxt = (int)atomicAdd(qhead, 1u);
        for (;;) {
            __syncthreads();
            if (TID_ == 0) *(volatile int*)(ldsb + 57344) = nxt;
            __syncthreads();
            const int idx = *(volatile int*)(ldsb + 57344);
            const int rnd = idx / 24, j = idx - rnd * 24;
            if (rnd >= NTIL + PLAG) break;
            if (TID_ == 0) nxt = (int)atomicAdd(qhead, 1u);
            if (j < 8) {
                if (rnd < NTIL) {
                    peer_score_topk_item(p, rnd, j, ldsb);
                    asm volatile("s_waitcnt vmcnt(0)" ::: "memory");
                    __syncthreads();
                    if (TID_ == 0) __hip_atomic_fetch_add(&tcnt[rnd], 1u, __ATOMIC_RELAXED, __HIP_MEMORY_SCOPE_AGENT);
                }
            } else {
                const int tile = rnd - PLAG;
                if (tile >= 0 && tile < NTIL) {
                    if (TID_ == 0) {
                        unsigned sp = 0;
                        while (__hip_atomic_load(&tcnt[tile], __ATOMIC_RELAXED, __HIP_MEMORY_SCOPE_AGENT) < 8u) { __builtin_amdgcn_s_sleep(2); if (++sp > (1u << 22)) break; }
                        __builtin_amdgcn_fence(__ATOMIC_ACQUIRE, "agent");
                        asm volatile("s_waitcnt vmcnt(0)" ::: "memory");
                    }
                    __syncthreads();
                    const int row = tile * 64 + (j - 8) * 4 + WV_;
                    if (row < NR) peer_expert_wave(p, row, ldsb + WV_ * 7168, LANE_);
                }
            }
        }
    }
}
#undef TID_
#undef LANE_
#undef WV_
#undef GW_
#undef GT_
extern "C" void kernel_launch(void* const* d_in, const int* in_sizes, int n_in, void* d_out, int out_size, void* d_ws, size_t ws_size, hipStream_t stream) {
    static int grid = 0;
    if (grid == 0) {
        if (n_in != 32 || (size_t)out_size != O_END || ws_size < WS_END) {
            fprintf(stderr, "kernel_launch: unexpected sizes n_in %d out %d ws %zu (need %zu)\n", n_in, out_size, ws_size, (size_t)WS_END); grid = -1; return; }
        int dev = 0, cus = 0, per_cu = 0;
        if (hipGetDevice(&dev) != hipSuccess || hipDeviceGetAttribute(&cus, hipDeviceAttributeMultiprocessorCount, dev) != hipSuccess) { grid = -1; return; }
        if (hipFuncSetAttribute((const void*)fwd_kernel, hipFuncAttributeMaxDynamicSharedMemorySize, LDS_BYTES) != hipSuccess) { fprintf(stderr, "hipFuncSetAttribute failed\n"); grid = -1; return; }
        if (hipOccupancyMaxActiveBlocksPerMultiprocessor(&per_cu, (const void*)fwd_kernel, NTHREADS, LDS_BYTES) != hipSuccess || per_cu < 1) { fprintf(stderr, "occupancy query failed (%d)\n", per_cu); (void)hipGetLastError(); per_cu = 1; }
        if (per_cu > 2) per_cu = 2;
        grid = cus * per_cu;
    }
    if (grid < 0) return;
    (void)hipMemsetAsync((char*)d_ws + WS_BAR, 0, 16384, stream);
    Params p{};
    p.x_prompt = (const float*)d_in[0]; p.x_sample = (const float*)d_in[1]; p.cache_cmp = (const float*)d_in[2]; p.cache_slc = (const float*)d_in[3];
    p.page_table = (const int*)d_in[4]; p.state_win = (const float*)d_in[5]; p.state_C = (const float*)d_in[6]; p.state_n = (const float*)d_in[7];
    p.state_m = (const float*)d_in[8]; p.state_conv = (const float*)d_in[9]; p.w_in = (const float*)d_in[10]; p.conv_w = (const float*)d_in[11];
    p.conv_b = (const float*)d_in[12]; p.wq = (const float*)d_in[13]; p.wk = (const float*)d_in[14]; p.gate_bias = (const float*)d_in[15];
    p.norm_g = (const float*)d_in[16]; p.cmp_pe = (const float*)d_in[17]; p.cmp_w1 = (const float*)d_in[18]; p.cmp_w2 = (const float*)d_in[19];
    p.rel_bias = (const float*)d_in[20]; p.w_up_m = (const float*)d_in[21]; p.w_up_n = (const float*)d_in[22]; p.w_out = (const float*)d_in[23];
    p.ln1_g = (const float*)d_in[24]; p.ln1_b = (const float*)d_in[25]; p.ln2_g = (const float*)d_in[26]; p.ln2_b = (const float*)d_in[27];
    p.peer_wq = (const float*)d_in[28]; p.peer_sub = (const float*)d_in[29]; p.peer_u = (const float*)d_in[30]; p.peer_v = (const float*)d_in[31];
    p.out = (float*)d_out; p.ws = (unsigned char*)d_ws;
    hipLaunchKernelGGL(fwd_kernel, dim3(grid), dim3(NTHREADS), LDS_BYTES, stream, p);
}
```

```cpp
#include <hip/hip_runtime.h>
#include <stdint.h>
#include <cstdio>

#define DEV __device__ __forceinline__

constexpr int DM = 1024;
constexpr int BP = 16, TP = 2048, BS = 32;
constexpr int NP = BP * TP;
constexpr int NR = NP + BS;
constexpr int MP = 32896;
constexpr int IN_DIM = 4896;
constexpr int C_U = 0, C_V = 512, C_O = 1024, C_I = 1536, C_F = 1540, C_Q = 1544, C_KC = 2056, C_KS = 2312, C_KW = 2568, C_G = 2824, C_GM = 2848, C_GN = 3872;
constexpr int PAST = 16384;
constexpr float NEGF = -1e30f;
constexpr float DN_ALPHA = 1.189207115002721f;
constexpr float LN_EPS = 1e-5f;
constexpr float LOG2E = 1.4426950408889634f;

constexpr size_t O_Y = 0;
constexpr size_t O_CMPP = (size_t)NR * DM;
constexpr size_t O_CMPS = O_CMPP + (size_t)NP * 256;
constexpr size_t O_SLCP = O_CMPS + (size_t)BS * 256;
constexpr size_t O_SLCS = O_SLCP + (size_t)NP * 256;
constexpr size_t O_WINP = O_SLCS + (size_t)BS * 256;
constexpr size_t O_WINS = O_WINP + (size_t)BP * 512 * 256;
constexpr size_t O_CP = O_WINS + (size_t)BS * 512 * 256;
constexpr size_t O_CS = O_CP + (size_t)BP * 4 * 128 * 128;
constexpr size_t O_NP = O_CS + (size_t)BS * 4 * 128 * 128;
constexpr size_t O_NS = O_NP + (size_t)BP * 4 * 128;
constexpr size_t O_MP = O_NS + (size_t)BS * 4 * 128;
constexpr size_t O_MS = O_MP + (size_t)BP * 4;
constexpr size_t O_CVP = O_MS + (size_t)BS * 4;
constexpr size_t O_CVS = O_CVP + (size_t)BP * 3 * 512;
constexpr size_t O_END = O_CVS + (size_t)BS * 3 * 512;
static_assert(O_END == 59916480, "output size");

constexpr size_t al256(size_t x) { return (x + 255) & ~(size_t)255; }
constexpr size_t WS_BAR = 0;
constexpr size_t WS_Z = 16384;
constexpr size_t WS_HRAW = al256(WS_Z + (size_t)MP * 32 * 4);
constexpr size_t WS_MOUTB = al256(WS_HRAW + (size_t)MP * 512 * 4);
constexpr size_t WS_NOUTB = al256(WS_MOUTB + (size_t)MP * 512 * 2);
constexpr size_t WS_MIXB = al256(WS_NOUTB + (size_t)MP * 512 * 2);
constexpr size_t WS_T1 = al256(WS_MIXB + (size_t)MP * 1024 * 2);
constexpr size_t WS_X1B = al256(WS_T1 + (size_t)MP * 1024 * 4);
constexpr size_t WS_QPB = al256(WS_X1B + (size_t)MP * 1024 * 2);
constexpr size_t WS_PIDX = al256(WS_QPB + (size_t)MP * 2048 * 2);
constexpr size_t WS_PG = al256(WS_PIDX + (size_t)MP * 128 * 4);
constexpr size_t WS_CONVB = al256(WS_PG + (size_t)MP * 128 * 4);
constexpr size_t WS_XB = al256(WS_CONVB + (size_t)MP * 512 * 2);
constexpr size_t WS_WIN_T = al256(WS_XB + (size_t)MP * 1024 * 2);
constexpr size_t WS_WUPM_T = al256(WS_WIN_T + (size_t)IN_DIM * 1024 * 2);
constexpr size_t WS_WUPN_T = al256(WS_WUPM_T + (size_t)1024 * 512 * 2);
constexpr size_t WS_WOUT_T = al256(WS_WUPN_T + (size_t)1024 * 512 * 2);
constexpr size_t WS_PWQ_T = al256(WS_WOUT_T + (size_t)1024 * 1024 * 2);
constexpr size_t WS_WQK_T = al256(WS_PWQ_T + (size_t)2048 * 1024 * 2);
constexpr size_t WS_W1_T = al256(WS_WQK_T + (size_t)4 * 256 * 128 * 2);
constexpr size_t WS_PESUM = al256(WS_W1_T + (size_t)2 * 128 * 1024 * 2);
constexpr size_t WS_W2_T = al256(WS_PESUM + 512);
constexpr size_t WS_SUBK = al256(WS_W2_T + (size_t)2 * 64 * 64 * 2);
constexpr size_t WS_ZB = al256(WS_SUBK + (size_t)2 * 128 * 128 * 2);
constexpr size_t WS_VTS = al256(WS_ZB + (size_t)MP * IN_DIM * 2);
constexpr size_t WS_VTW = al256(WS_VTS + (size_t)16 * 2 * 64 * 2048 * 2);
constexpr size_t WS_KCB = al256(WS_VTW + (size_t)16 * 2 * 64 * 2048 * 2);
constexpr size_t WS_VTC = al256(WS_KCB + (size_t)16 * 2 * 128 * 64 * 2);
constexpr size_t WS_NOUTF = al256(WS_VTC + (size_t)16 * 2 * 64 * 128 * 2);
constexpr size_t WS_U8 = al256(WS_NOUTF + (size_t)NP * 512 * 4);
constexpr size_t WS_V8 = al256(WS_U8 + (size_t)16384 * 1024);
constexpr size_t WS_QB = al256(WS_V8 + (size_t)16384 * 1024);
constexpr size_t WS_KB = al256(WS_QB + (size_t)MP * 512 * 2);
constexpr size_t WS_KTB = al256(WS_KB + (size_t)MP * 512 * 2);
constexpr size_t WS_VTM = al256(WS_KTB + (size_t)16 * 512 * 2048 * 2);
constexpr size_t WS_KCSB = al256(WS_VTM + (size_t)16 * 512 * 2048 * 2);
constexpr size_t WS_VTCS = al256(WS_KCSB + (size_t)32 * 2 * 1024 * 64 * 2);
constexpr size_t WS_END = al256(WS_VTCS + (size_t)32 * 2 * 64 * 1024 * 2);

static_assert(WS_END <= 2684354560ull, "workspace too large");
constexpr int LDS_BYTES = 73728 + 256;
constexpr int NTHREADS = 256;

struct Params {
    const float* x_prompt; const float* x_sample; const float* cache_cmp; const float* cache_slc; const int* page_table;
    const float* state_win; const float* state_C; const float* state_n; const float* state_m; const float* state_conv;
    const float* w_in; const float* conv_w; const float* conv_b; const float* wq; const float* wk; const float* gate_bias; const float* norm_g;
    const float* cmp_pe; const float* cmp_w1; const float* cmp_w2; const float* rel_bias; const float* w_up_m; const float* w_up_n; const float* w_out;
    const float* ln1_g; const float* ln1_b; const float* ln2_g; const float* ln2_b; const float* peer_wq; const float* peer_sub; const float* peer_u; const float* peer_v;
    float* out; unsigned char* ws;
};

#define XB_TMO      128
#define XB_XCNT(j)  (256  + 64 * (j))
#define XB_XSUB(j)  (1280 + 64 * (j))
#define XB_XGEN(j)  (2304 + 64 * (j))
#define XB_TOP      3328
#define XB_TOPGEN   3392
#define XCD_BAR_WORDS 3456
#define XB_SPIN_CAP (1u << 22)
#define LAS __attribute__((address_space(3)))

__device__ __forceinline__ unsigned xb_ld(unsigned* p)              { return __hip_atomic_load(p, __ATOMIC_RELAXED, __HIP_MEMORY_SCOPE_AGENT); }
__device__ __forceinline__ unsigned xb_add(unsigned* p, unsigned v) { return __hip_atomic_fetch_add(p, v, __ATOMIC_RELAXED, __HIP_MEMORY_SCOPE_AGENT); }
__device__ __forceinline__ unsigned xb_xcc_id() { return (unsigned)__builtin_amdgcn_s_getreg((3 << 11) | 20) & 0xFu; }
#define XB_SPIN(cond, bar) do { unsigned _sp = 0; while (cond) { __builtin_amdgcn_s_sleep(1); \
    if ((++_sp & 255u) == 0u) { if (xb_ld(&(bar)[XB_TMO])) break; if (_sp > XB_SPIN_CAP) { atomicAdd(&(bar)[XB_TMO], 1u); break; } } } } while (0)

struct XcdBarrier { unsigned* bar; unsigned x; volatile LAS unsigned* st; };

__device__ __forceinline__ XcdBarrier xcd_barrier_post(unsigned* bar, volatile LAS unsigned* st) {
    XcdBarrier b; b.bar = bar; b.x = xb_xcc_id(); b.st = st;
    if (threadIdx.x == 0) (void)xb_add(&bar[XB_XCNT(b.x)], 1u);
    return b;
}
__device__ __forceinline__ void xcd_barrier_complete(unsigned* bar, unsigned x, unsigned& nloc, unsigned& nx) {
    const unsigned G = gridDim.x * gridDim.y * gridDim.z;
    unsigned sum, cnt, mine, sp = 0u;
    for (;;) {
        sum = 0u; cnt = 0u; mine = 0u;
#pragma unroll
        for (unsigned j = 0; j < 16; ++j) { const unsigned c = xb_ld(&bar[XB_XCNT(j)]); sum += c; cnt += (c > 0u) ? 1u : 0u; mine = (j == x) ? c : mine; }
        if (sum == G) break;
        __builtin_amdgcn_s_sleep(1);
        if ((++sp & 255u) == 0u) { if (xb_ld(&bar[XB_TMO])) break; if (sp > XB_SPIN_CAP) { atomicAdd(&bar[XB_TMO], 1u); break; } }
    }
    nloc = mine > 0u ? mine : 1u; nx = cnt > 0u ? cnt : 1u;
}
__device__ __forceinline__ void xcd_barrier(const XcdBarrier& b) {
    asm volatile("s_waitcnt vmcnt(0)" ::: "memory");
    __syncthreads();
    if (threadIdx.x == 0) {
        unsigned* bar = b.bar;
        __builtin_amdgcn_s_waitcnt(0);
        unsigned nloc = b.st[0], nx = b.st[1];
        if (nloc == 0u) { xcd_barrier_complete(bar, b.x, nloc, nx); b.st[0] = nloc; b.st[1] = nx; }
        const unsigned old = xb_add(&bar[XB_XSUB(b.x)], 1u);
        const unsigned gen = old / nloc;
        if (old + 1u == (gen + 1u) * nloc) {
            __builtin_amdgcn_fence(__ATOMIC_RELEASE, "agent");
            asm volatile("s_waitcnt vmcnt(0)" ::: "memory");
            const unsigned og = xb_add(&bar[XB_TOP], 1u);
            const unsigned tg = og / nx;
            if (og + 1u == (tg + 1u) * nx) xb_add(&bar[XB_TOPGEN], 1u);
            else XB_SPIN(xb_ld(&bar[XB_TOPGEN]) == tg, bar);
            __builtin_amdgcn_fence(__ATOMIC_ACQUIRE, "agent");
            xb_add(&bar[XB_XGEN(b.x)], 1u);
            asm volatile("s_waitcnt vmcnt(0)" ::: "memory");
        } else {
            XB_SPIN(xb_ld(&bar[XB_XGEN(b.x)]) == gen, bar);
            __builtin_amdgcn_fence(__ATOMIC_ACQUIRE, "agent");
            asm volatile("s_waitcnt vmcnt(0)" ::: "memory");
        }
    }
    __syncthreads();
}

typedef float f32x4 __attribute__((ext_vector_type(4)));

__device__ const unsigned char REL_LUT[128] = {
    0, 1, 2, 3, 4, 5, 6, 7, 8, 9, 10, 11, 12, 13, 14, 15, 16, 16, 16, 17, 17, 18, 18, 18, 19, 19, 19, 20, 20, 20, 20, 21, 21, 21, 21, 22, 22, 22, 22, 22,
    23, 23, 23, 23, 23, 23, 24, 24, 24, 24, 24, 24, 25, 25, 25, 25, 25, 25, 25, 26, 26, 26, 26, 26, 26, 26, 26, 27, 27, 27, 27, 27, 27, 27, 27, 27, 27,
    28, 28, 28, 28, 28, 28, 28, 28, 28, 28, 29, 29, 29, 29, 29, 29, 29, 29, 29, 29, 29, 29, 30, 30, 30, 30, 30, 30, 30, 30, 30, 30, 30, 30, 30, 30,
    31, 31, 31, 31, 31, 31, 31, 31, 31, 31, 31, 31, 31, 31, 31};
DEV int rel_bucket(int n) { return n < 128 ? (int)REL_LUT[n < 0 ? 0 : n] : 31; }

DEV float sigmoidf_(float x) { return __builtin_amdgcn_rcpf(1.0f + __builtin_amdgcn_exp2f(-1.4426950408889634f * x)); }
DEV float gelu_tanh(float x) { return x * sigmoidf_(1.5957691216057308f * (x + 0.044715f * x * x * x)); }
DEV float log_sigmoid(float x) { return x >= 0.f ? -log1pf(expf(-x)) : x - log1pf(expf(x)); }
DEV void wave_sync() { asm volatile("s_waitcnt lgkmcnt(0)" ::: "memory"); __builtin_amdgcn_wave_barrier(); asm volatile("" ::: "memory"); }
DEV float wave_sum(float v) {
#pragma unroll
    for (int o = 32; o >= 1; o >>= 1) v += __shfl_xor(v, o);
    return v;
}
DEV float wave_max(float v) {
#pragma unroll
    for (int o = 32; o >= 1; o >>= 1) v = fmaxf(v, __shfl_xor(v, o));
    return v;
}

typedef unsigned short bf16_t;
typedef short bf16x8 __attribute__((ext_vector_type(8)));
typedef float f32x2_ __attribute__((ext_vector_type(2)));
typedef __bf16 bf16x2_ __attribute__((ext_vector_type(2)));
DEV unsigned cvt_pk_bf16(float lo, float hi) { const f32x2_ v = {lo, hi}; return __builtin_bit_cast(unsigned, __builtin_convertvector(v, bf16x2_)); }
DEV float bf_lo(unsigned w) { return __uint_as_float(w << 16); }
DEV float bf_hi(unsigned w) { return __uint_as_float(w & 0xffff0000u); }
DEV uint4 pack8(const float* f) { uint4 r; r.x = cvt_pk_bf16(f[0], f[1]); r.y = cvt_pk_bf16(f[2], f[3]); r.z = cvt_pk_bf16(f[4], f[5]); r.w = cvt_pk_bf16(f[6], f[7]); return r; }
DEV void store_bf16x8(bf16_t* p, f32x4 a, f32x4 b) { uint4 w; w.x = cvt_pk_bf16(a[0], a[1]); w.y = cvt_pk_bf16(a[2], a[3]); w.z = cvt_pk_bf16(b[0], b[1]); w.w = cvt_pk_bf16(b[2], b[3]); *(uint4*)p = w; }
DEV void store_bf16x4(bf16_t* p, f32x4 v) { uint2 w; w.x = cvt_pk_bf16(v[0], v[1]); w.y = cvt_pk_bf16(v[2], v[3]); *(uint2*)p = w; }

DEV void transpose_to_bf16(const float* __restrict__ src, const int K, const int N, bf16_t* __restrict__ dst, const size_t gt, const size_t nt) {
    const size_t items = (size_t)N * (K >> 3);
    for (size_t id = gt; id < items; id += nt) {
        const int n = (int)(id % N), k8 = (int)(id / N) * 8;
        float f[8];
#pragma unroll
        for (int i = 0; i < 8; ++i) f[i] = src[(size_t)(k8 + i) * N + n];
        *(uint4*)(dst + (size_t)n * K + k8) = pack8(f);
    }
}

template <int BN, bool TILE_EPI = false, class LA, class LB, class EF>
DEV void gemm_bf16(const int M, const int N, const int K, LA la, LB lb, EF ef, unsigned char* lds, const int toff = 0) {
    constexpr int TJ = BN / 32;
    constexpr int NB = BN / 32;
    constexpr int LDR = 144;
    const int tid = threadIdx.x, lane = tid & 63, w = tid >> 6, wm = w >> 1, wn = w & 1;
    const int tm = (M + 127) >> 7, tn = (N + BN - 1) / BN;
    unsigned char* As = lds;
    unsigned char* Bs = lds + 128 * LDR;
    const int lr = lane & 15, lq = lane >> 4;
    for (int tile = (int)((blockIdx.x + gridDim.x - (unsigned)toff % gridDim.x) % gridDim.x); tile < tm * tn; tile += gridDim.x) {
        const int bm = (tile / tn) * 128, bn = (tile % tn) * BN;
        f32x4 acc[4][TJ];
#pragma unroll
        for (int i = 0; i < 4; ++i)
#pragma unroll
            for (int j = 0; j < TJ; ++j) acc[i][j] = (f32x4){0.f, 0.f, 0.f, 0.f};
        typename LA::Raw ra[4]; uint4 rb[NB];
        const unsigned char* arow[4]; int brow[NB];
#pragma unroll
        for (int i = 0; i < 4; ++i) { const int r = bm + ((tid + 256 * i) >> 3); arow[i] = la.prep(r < M ? r : M - 1); }
#pragma unroll
        for (int i = 0; i < NB; ++i) { const int n = bn + ((tid + 256 * i) >> 3); brow[i] = n < N ? n : N - 1; }
        const int kc = (tid & 7) * 8;
#pragma unroll
        for (int i = 0; i < 4; ++i) ra[i] = la.load(arow[i], kc);
#pragma unroll
        for (int i = 0; i < NB; ++i) rb[i] = lb(brow[i], kc);
        for (int k0_ = 0; k0_ < K; k0_ += 64) {
            int k0 = k0_; asm volatile("" : "+v"(k0));
            __syncthreads();
#pragma unroll
            for (int i = 0; i < 4; ++i) *(uint4*)(As + ((tid + 256 * i) >> 3) * LDR + (tid & 7) * 16) = la.pack(ra[i]);
#pragma unroll
            for (int i = 0; i < NB; ++i) *(uint4*)(Bs + ((tid + 256 * i) >> 3) * LDR + (tid & 7) * 16) = rb[i];
            __syncthreads();
            if (k0_ + 64 < K) {
#pragma unroll
                for (int i = 0; i < 4; ++i) ra[i] = la.load(arow[i], k0 + 64 + kc);
#pragma unroll
                for (int i = 0; i < NB; ++i) rb[i] = lb(brow[i], k0 + 64 + kc);
            }
#pragma unroll
            for (int kk = 0; kk < 2; ++kk) {
                bf16x8 a[4], b[TJ];
#pragma unroll
                for (int i = 0; i < 4; ++i) a[i] = *(const bf16x8*)(As + (wm * 64 + i * 16 + lr) * LDR + kk * 64 + lq * 16);
#pragma unroll
                for (int j = 0; j < TJ; ++j) b[j] = *(const bf16x8*)(Bs + (wn * (BN / 2) + j * 16 + lr) * LDR + kk * 64 + lq * 16);
#pragma unroll
                for (int i = 0; i < 4; ++i)
#pragma unroll
                    for (int j = 0; j < TJ; ++j) acc[i][j] = __builtin_amdgcn_mfma_f32_16x16x32_bf16(b[j], a[i], acc[i][j], 0, 0, 0);
            }
        }
        if constexpr (TILE_EPI) { ef(acc, bm); }
        else {
#pragma unroll
            for (int i = 0; i < 4; ++i)
#pragma unroll
                for (int j = 0; j < TJ; ++j) {
                    const int r = bm + wm * 64 + i * 16 + lr, c0 = bn + wn * (BN / 2) + j * 16 + lq * 4;
                    if (r < M && c0 < N) ef(r, c0, acc[i][j]);
                }
        }
    }
}

DEV int lds_byte3(int rho, int ck) { return (rho >> 3) * 1024 + (rho & 7) * 128 + ((ck ^ (2 * ((rho >> 1) & 3))) << 4); }
struct NoMid { DEV void operator()(int, int, f32x4&, f32x4&, uint2&, uint2&) const {} };
template <class PA, class PB, class EF, class MF = NoMid, bool XCDN = false, int MI = 5>
DEV void gemm_glds(const int M, const int N, const int K, PA pa, PB pb, EF ef, unsigned char* lds, const int toff = 0, const int ksplit = 0, MF mf = MF(), const int gfirst = 0, const int gcount = 0) {
    constexpr int BM = 32 * MI, ABYTES = BM * 128, STG = ABYTES + 16384;
    const int tid = threadIdx.x, lane = tid & 63, w = tid >> 6, wm = w >> 1, wn = w & 1;
    const int tm = (M + BM - 1) / BM, tn = (N + 127) >> 7;
    const int lr = lane & 15, lq = lane >> 4;
    const int nk = K >> 6;
    const int sC = ((lane & 7) ^ (2 * ((lane >> 4) & 3))) << 3;
    int sRb[4];
#pragma unroll
    for (int i = 0; i < 4; ++i) { const int rho = 8 * (w + 4 * i) + (lane >> 3); sRb[i] = (rho & 64) + 32 * ((rho >> 5) & 1) + 8 * ((rho >> 2) & 3) + 4 * ((rho >> 4) & 1) + (rho & 3); }
    const int xc = blockIdx.x & 7, xslots = gridDim.x >> 3, xcnt = (tn - xc + 7) >> 3;
    const int vgrid = gcount > 0 ? gcount : (int)gridDim.x, vb = (int)blockIdx.x - gfirst;
    if (!XCDN && (vb < 0 || vb >= vgrid)) return;
    for (int tile = XCDN ? (int)(blockIdx.x >> 3) : (vb + vgrid - toff % vgrid) % vgrid; tile < (XCDN ? tm * xcnt : tm * tn); tile += (XCDN ? xslots : vgrid)) {
        const int bm = (XCDN ? tile / xcnt : tile / tn) * BM, bn = (XCDN ? xc + 8 * (tile % xcnt) : tile % tn) * 128;
        f32x4 acc[MI][4]; uint2 keep[MI][4];
#pragma unroll
        for (int i = 0; i < MI; ++i)
#pragma unroll
            for (int j = 0; j < 4; ++j) { acc[i][j] = (f32x4){0.f, 0.f, 0.f, 0.f}; keep[i][j] = make_uint2(0u, 0u); }
        int arow[MI], brow[4];
#pragma unroll
        for (int i = 0; i < MI; ++i) { const int r = bm + 8 * (w + 4 * i) + (lane >> 3); arow[i] = r < M ? r : M - 1; }
#pragma unroll
        for (int i = 0; i < 4; ++i) { const int n = bn + sRb[i]; brow[i] = n < N ? n : N - 1; }
#define GLDS_STAGE(BUF, KT) { _Pragma("unroll") for (int i = 0; i < MI; ++i) \
            __builtin_amdgcn_global_load_lds((const unsigned*)pa(arow[i], (KT) * 64 + sC), (LAS unsigned*)(lds + (BUF) * STG + (w + 4 * i) * 1024), 16, 0, 0); \
        _Pragma("unroll") for (int i = 0; i < 4; ++i) \
            __builtin_amdgcn_global_load_lds((const unsigned*)pb(brow[i], (KT) * 64 + sC), (LAS unsigned*)(lds + (BUF) * STG + ABYTES + (w + 4 * i) * 1024), 16, 0, 0); }
        __syncthreads();
        GLDS_STAGE(0, 0)
        asm volatile("s_waitcnt vmcnt(0)" ::: "memory");
        __syncthreads();
        for (int kt = 0; kt < nk; ++kt) {
            const int cur = kt & 1;
            if (kt + 1 < nk) GLDS_STAGE(cur ^ 1, kt + 1)
            const unsigned char* SA = lds + cur * STG;
            const unsigned char* SB = SA + ABYTES;
            {
                bf16x8 a0[MI], b0[4], a1[MI], b1[4];
#pragma unroll
                for (int i = 0; i < MI; ++i) a0[i] = *(const bf16x8*)(SA + lds_byte3(wm * (16 * MI) + i * 16 + lr, lq));
#pragma unroll
                for (int j = 0; j < 4; ++j) b0[j] = *(const bf16x8*)(SB + lds_byte3(wn * 64 + j * 16 + lr, lq));
                __builtin_amdgcn_sched_barrier(0);
#pragma unroll
                for (int i = 0; i < MI; ++i) a1[i] = *(const bf16x8*)(SA + lds_byte3(wm * (16 * MI) + i * 16 + lr, 4 + lq));
#pragma unroll
                for (int j = 0; j < 4; ++j) b1[j] = *(const bf16x8*)(SB + lds_byte3(wn * 64 + j * 16 + lr, 4 + lq));
                __builtin_amdgcn_sched_barrier(0);
                __builtin_amdgcn_s_setprio(1);
#pragma unroll
                for (int i = 0; i < MI; ++i)
#pragma unroll
                    for (int j = 0; j < 4; ++j) acc[i][j] = __builtin_amdgcn_mfma_f32_16x16x32_bf16(b0[j], a0[i], acc[i][j], 0, 0, 0);
                __builtin_amdgcn_sched_barrier(0);
#pragma unroll
                for (int i = 0; i < MI; ++i)
#pragma unroll
                    for (int j = 0; j < 4; ++j) acc[i][j] = __builtin_amdgcn_mfma_f32_16x16x32_bf16(b1[j], a1[i], acc[i][j], 0, 0, 0);
                __builtin_amdgcn_s_setprio(0);
                __builtin_amdgcn_sched_barrier(0);
            }
            if constexpr (!__is_same(MF, NoMid)) {
                if (kt + 1 == ksplit) {
#pragma unroll
                    for (int i = 0; i < MI; ++i)
#pragma unroll
                        for (int k2 = 0; k2 < 2; ++k2) {
                            const int r = bm + wm * (16 * MI) + i * 16 + lr, c0 = bn + wn * 64 + 32 * k2 + 8 * lq;
                            if (r < M && c0 < N) mf(r, c0, acc[i][2 * k2], acc[i][2 * k2 + 1], keep[i][2 * k2], keep[i][2 * k2 + 1]);
                            acc[i][2 * k2] = (f32x4){0.f, 0.f, 0.f, 0.f}; acc[i][2 * k2 + 1] = (f32x4){0.f, 0.f, 0.f, 0.f};
                        }
                }
            }
            asm volatile("s_waitcnt vmcnt(0)" ::: "memory");
            __syncthreads();
        }
#undef GLDS_STAGE
#pragma unroll
        for (int i = 0; i < MI; ++i)
#pragma unroll
            for (int k2 = 0; k2 < 2; ++k2) {
                const int r = bm + wm * (16 * MI) + i * 16 + lr, c0 = bn + wn * 64 + 32 * k2 + 8 * lq;
                if (r < M && c0 < N) { if constexpr (!__is_same(MF, NoMid)) ef(r, c0, acc[i][2 * k2], acc[i][2 * k2 + 1], keep[i][2 * k2], keep[i][2 * k2 + 1]); else ef(r, c0, acc[i][2 * k2], acc[i][2 * k2 + 1]); }
            }
    }
}

template <int MI, class PA, class PB, class EF, class MF>
DEV void gemm_glds_mi(const int M, const int N, const int K, PA pa, PB pb, EF ef, unsigned char* lds, const int toff, const int ksplit, MF mf) { gemm_glds<PA, PB, EF, MF, false, MI>(M, N, K, pa, pb, ef, lds, toff, ksplit, mf); }
template <class PA, class PB, class EF>
DEV void gemm_glds_xcd(const int M, const int N, const int K, PA pa, PB pb, EF ef, unsigned char* lds) { gemm_glds<PA, PB, EF, NoMid, true>(M, N, K, pa, pb, ef, lds, 0, 0, NoMid()); }

DEV void mlstm_step_item(const Params& p, const int item, float* lds) {
    int tid_ = threadIdx.x; asm volatile("" : "+v"(tid_));
    const int tid = tid_, v = tid >> 1, kh = tid & 1;
    const int b = item >> 2, h = item & 3;
    const size_t r = (size_t)(NP + b);
    const float* Z = (const float*)(p.ws + WS_Z);
    const bf16_t* QBp = (const bf16_t*)(p.ws + WS_QB); const bf16_t* KBp = (const bf16_t*)(p.ws + WS_KB); const bf16_t* ZBp = (const bf16_t*)(p.ws + WS_ZB);
    float* HRAW = (float*)(p.ws + WS_HRAW);
    __syncthreads();
    lds[tid] = bf_lo((unsigned)(tid < 128 ? QBp[r * 512 + h * 128 + tid] : KBp[r * 512 + h * 128 + tid - 128]));
    if (tid < 128) lds[256 + tid] = bf_lo((unsigned)ZBp[r * IN_DIM + C_V + h * 128 + tid]);
    __syncthreads();
    const float m0 = p.state_m[b * 4 + h];
    const float ig = Z[r * 32 + h] + p.gate_bias[h], lf = log_sigmoid(Z[r * 32 + 4 + h] + p.gate_bias[4 + h]);
    const float mn = fmaxf(lf + m0, ig);
    const float fd = expf(lf + m0 - mn), iw = expf(ig - mn);
    const float vv = lds[256 + v] * iw;
    const float* c0 = p.state_C + (((size_t)(b * 4 + h) * 128 + v) * 128 + kh * 64);
    const float* n0 = p.state_n + ((size_t)(b * 4 + h) * 128 + kh * 64);
    float* co = p.out + O_CS + (((size_t)(b * 4 + h) * 128 + v) * 128 + kh * 64);
    float* no = p.out + O_NS + ((size_t)(b * 4 + h) * 128 + kh * 64);
    float nump = 0.f, denp = 0.f;
#pragma unroll 4
    for (int j = 0; j < 64; j += 4) {
        const float4 c4 = *(const float4*)(c0 + j), n4 = *(const float4*)(n0 + j);
        const float4 k4 = *(const float4*)(lds + 128 + kh * 64 + j), q4 = *(const float4*)(lds + kh * 64 + j);
        float4 cn, nn;
        cn.x = fd * c4.x + vv * k4.x; cn.y = fd * c4.y + vv * k4.y; cn.z = fd * c4.z + vv * k4.z; cn.w = fd * c4.w + vv * k4.w;
        nn.x = fd * n4.x + iw * k4.x; nn.y = fd * n4.y + iw * k4.y; nn.z = fd * n4.z + iw * k4.z; nn.w = fd * n4.w + iw * k4.w;
        nump += cn.x * q4.x + cn.y * q4.y + cn.z * q4.z + cn.w * q4.w;
        denp += nn.x * q4.x + nn.y * q4.y + nn.z * q4.z + nn.w * q4.w;
        *(float4*)(co + j) = cn;
        if (v == 0) *(float4*)(no + j) = nn;
    }
    nump += __shfl_xor(nump, 1); denp += __shfl_xor(denp, 1);
    if (kh == 0) HRAW[r * 512 + h * 128 + v] = nump / fmaxf(fabsf(denp), expf(-mn));
    if (tid == 0) p.out[O_MS + b * 4 + h] = mn;
}

DEV void mlstm_chunk_item(const Params& p, const int item, unsigned char* lds) {
    int tid_ = threadIdx.x; asm volatile("" : "+v"(tid_));
    const int tid = tid_, lane = tid & 63, w = tid >> 6, lr = lane & 15, lq = lane >> 4;
    constexpr int NVT = 4, VW = NVT * 16, NVS = 128 / VW;
    const int b = item / (4 * NVS), h = (item / NVS) & 3, vs = item % NVS;
    bf16_t* Cl = (bf16_t*)lds;
    bf16_t* nl = (bf16_t*)(lds + VW * 272);
    float* uL = (float*)(lds + VW * 272 + 256); float* ML = uL + 64; float* scin = uL + 128; float* expm = uL + 192; float* wts = uL + 256; float* misc = uL + 320;
    const bf16_t* QB = (const bf16_t*)(p.ws + WS_QB) + (size_t)(b * 2048) * 512 + h * 128;
    const bf16_t* KB = (const bf16_t*)(p.ws + WS_KB) + (size_t)(b * 2048) * 512 + h * 128;
    const bf16_t* KTB = (const bf16_t*)(p.ws + WS_KTB) + (size_t)((b * 4 + h) * 128) * 2048;
    const bf16_t* VTM = (const bf16_t*)(p.ws + WS_VTM) + (size_t)(b * 512 + h * 128 + vs * VW) * 2048;
    const float* Z = (const float*)(p.ws + WS_Z);
    float* HRAW = (float*)(p.ws + WS_HRAW);
    const float gb_i = p.gate_bias[h], gb_f = p.gate_bias[4 + h];
    f32x4 Cm[NVT][2], nm[2];
#pragma unroll
    for (int j = 0; j < 2; ++j) { nm[j] = (f32x4){0.f, 0.f, 0.f, 0.f};
#pragma unroll
        for (int i = 0; i < NVT; ++i) Cm[i][j] = (f32x4){0.f, 0.f, 0.f, 0.f}; }
    float m_prev = 0.f;
    __syncthreads();
    for (int i = tid; i < (VW * 272 + 256) / 4; i += 256) ((unsigned*)lds)[i] = 0u;
    __syncthreads();
    for (int c = 0; c < 32; ++c) {
        const int t0 = c * 64;
        if (w == 0) {
            const size_t row = (size_t)(b * 2048 + t0 + lane);
            const float ig = Z[row * 32 + h] + gb_i;
            const float lf = log_sigmoid(Z[row * 32 + 4 + h] + gb_f);
            float bc = lf;
#pragma unroll
            for (int o = 1; o < 64; o <<= 1) { const float t = __shfl_up(bc, o); if (lane >= o) bc += t; }
            const float u = ig - bc;
            float pm = u;
#pragma unroll
            for (int o = 1; o < 64; o <<= 1) { const float t = __shfl_up(pm, o); if (lane >= o) pm = fmaxf(pm, t); }
            const float M = fmaxf(m_prev, pm);
            const float M63 = __shfl(M, 63), b63 = __shfl(bc, 63);
            uL[lane] = u; ML[lane] = M; scin[lane] = expf(m_prev - M); expm[lane] = expf(-(bc + M)); wts[lane] = expf(u - M63);
            if (lane == 0) { misc[0] = expf(m_prev - M63); misc[1] = b63 + M63; }
        }
        __syncthreads();
        {
            const size_t row_t = (size_t)(t0 + w * 16 + lr);
            bf16x8 Qf[4];
#pragma unroll
            for (int ks = 0; ks < 4; ++ks) Qf[ks] = *(const bf16x8*)(QB + row_t * 512 + ks * 32 + lq * 8);
            const float M_t = ML[w * 16 + lr], sc_in = scin[w * 16 + lr], em = expm[w * 16 + lr];
            f32x4 sw[4];
            float dsum = 0.f;
#pragma unroll
            for (int st = 0; st < 4; ++st) {
                f32x4 a = (f32x4){0.f, 0.f, 0.f, 0.f};
                if (st <= w) {
#pragma unroll
                    for (int ks = 0; ks < 4; ++ks) { const bf16x8 kf = *(const bf16x8*)(KB + (size_t)(t0 + st * 16 + lr) * 512 + ks * 32 + lq * 8); a = __builtin_amdgcn_mfma_f32_16x16x32_bf16(kf, Qf[ks], a, 0, 0, 0); }
#pragma unroll
                    for (int g = 0; g < 4; ++g) {
                        const int sl = st * 16 + lq * 4 + g, tl = w * 16 + lr;
                        const float wg = (sl <= tl) ? __builtin_amdgcn_exp2f((uL[sl] - M_t) * LOG2E) : 0.f;
                        a[g] *= wg; dsum += a[g];
                    }
                }
                sw[st] = a;
            }
            dsum += __shfl_xor(dsum, 16); dsum += __shfl_xor(dsum, 32);
            bf16x8 pf[2];
#pragma unroll
            for (int ks = 0; ks < 2; ++ks) {
                union { bf16x8 v; unsigned u[4]; } pk;
                pk.u[0] = cvt_pk_bf16(sw[2 * ks][0], sw[2 * ks][1]); pk.u[1] = cvt_pk_bf16(sw[2 * ks][2], sw[2 * ks][3]);
                pk.u[2] = cvt_pk_bf16(sw[2 * ks + 1][0], sw[2 * ks + 1][1]); pk.u[3] = cvt_pk_bf16(sw[2 * ks + 1][2], sw[2 * ks + 1][3]);
                pf[ks] = pk.v;
            }
            f32x4 dI = (f32x4){0.f, 0.f, 0.f, 0.f};
#pragma unroll
            for (int ks = 0; ks < 4; ++ks) { const bf16x8 nf = *(const bf16x8*)(nl + ks * 32 + lq * 8); dI = __builtin_amdgcn_mfma_f32_16x16x32_bf16(nf, Qf[ks], dI, 0, 0, 0); }
            const float den = sc_in * dI[0] + dsum;
            const float rdd = 1.0f / fmaxf(fabsf(den), em);
#pragma unroll
            for (int vt = 0; vt < NVT; ++vt) {
                f32x4 ni = (f32x4){0.f, 0.f, 0.f, 0.f}, nI = (f32x4){0.f, 0.f, 0.f, 0.f};
#pragma unroll
                for (int ks = 0; ks < 2; ++ks) if (2 * ks <= w) {
                    union { bf16x8 v; uint2 hh[2]; } vf;
                    const bf16_t* vp = VTM + (size_t)(vt * 16 + lr) * 2048 + t0 + 32 * ks + lq * 4;
                    vf.hh[0] = *(const uint2*)vp; vf.hh[1] = *(const uint2*)(vp + 16);
                    ni = __builtin_amdgcn_mfma_f32_16x16x32_bf16(vf.v, pf[ks], ni, 0, 0, 0);
                }
#pragma unroll
                for (int ks = 0; ks < 4; ++ks) { const bf16x8 cf = *(const bf16x8*)(Cl + (vt * 16 + lr) * 136 + ks * 32 + lq * 8); nI = __builtin_amdgcn_mfma_f32_16x16x32_bf16(cf, Qf[ks], nI, 0, 0, 0); }
                const f32x4 hv = (nI * sc_in + ni) * rdd;
                *(f32x4*)(HRAW + ((size_t)(b * 2048) + row_t) * 512 + h * 128 + vs * VW + vt * 16 + lq * 4) = hv;
            }
        }
        __syncthreads();
        {
            const float decay = misc[0];
            bf16x8 Af[NVT][2], Wf[2], Kt[2][2];
#pragma unroll
            for (int ks = 0; ks < 2; ++ks) {
                const float4 w0 = *(const float4*)(wts + ks * 32 + lq * 8), w1 = *(const float4*)(wts + ks * 32 + lq * 8 + 4);
                float wv[8] = {w0.x, w0.y, w0.z, w0.w, w1.x, w1.y, w1.z, w1.w};
                { union { bf16x8 v; uint4 q; } t; t.q = pack8(wv); Wf[ks] = t.v; }
#pragma unroll
                for (int vt = 0; vt < NVT; ++vt) {
                    const uint4 raw = *(const uint4*)(VTM + (size_t)(vt * 16 + lr) * 2048 + t0 + ks * 32 + lq * 8);
                    float f[8] = {bf_lo(raw.x) * wv[0], bf_hi(raw.x) * wv[1], bf_lo(raw.y) * wv[2], bf_hi(raw.y) * wv[3], bf_lo(raw.z) * wv[4], bf_hi(raw.z) * wv[5], bf_lo(raw.w) * wv[6], bf_hi(raw.w) * wv[7]};
                    union { bf16x8 v; uint4 q; } t; t.q = pack8(f); Af[vt][ks] = t.v;
                }
#pragma unroll
                for (int kt = 0; kt < 2; ++kt) Kt[kt][ks] = *(const bf16x8*)(KTB + (size_t)((2 * w + kt) * 16 + lr) * 2048 + t0 + ks * 32 + lq * 8);
            }
#pragma unroll
            for (int kt = 0; kt < 2; ++kt) {
                nm[kt] = nm[kt] * decay;
#pragma unroll
                for (int ks = 0; ks < 2; ++ks) nm[kt] = __builtin_amdgcn_mfma_f32_16x16x32_bf16(Wf[ks], Kt[kt][ks], nm[kt], 0, 0, 0);
                if (lq == 0) nl[(2 * w + kt) * 16 + lr] = (bf16_t)(cvt_pk_bf16(nm[kt][0], 0.f) & 0xffffu);
#pragma unroll
                for (int vt = 0; vt < NVT; ++vt) {
                    Cm[vt][kt] = Cm[vt][kt] * decay;
#pragma unroll
                    for (int ks = 0; ks < 2; ++ks) Cm[vt][kt] = __builtin_amdgcn_mfma_f32_16x16x32_bf16(Af[vt][ks], Kt[kt][ks], Cm[vt][kt], 0, 0, 0);
                    const unsigned c01 = cvt_pk_bf16(Cm[vt][kt][0], Cm[vt][kt][1]), c23 = cvt_pk_bf16(Cm[vt][kt][2], Cm[vt][kt][3]);
                    bf16_t* cp = Cl + (vt * 16 + lq * 4) * 136 + (2 * w + kt) * 16 + lr;
                    cp[0] = (bf16_t)(c01 & 0xffffu); cp[136] = (bf16_t)(c01 >> 16); cp[272] = (bf16_t)(c23 & 0xffffu); cp[408] = (bf16_t)(c23 >> 16);
                }
            }
            m_prev = misc[1];
        }
        __syncthreads();
    }
#pragma unroll
    for (int vt = 0; vt < NVT; ++vt)
#pragma unroll
        for (int kt = 0; kt < 2; ++kt)
#pragma unroll
            for (int g = 0; g < 4; ++g)
                p.out[O_CP + ((size_t)((b * 4 + h) * 128) + vs * VW + vt * 16 + lq * 4 + g) * 128 + (2 * w + kt) * 16 + lr] = Cm[vt][kt][g];
    if (vs == 0) {
        if (lq == 0) { p.out[O_NP + (size_t)(b * 4 + h) * 128 + (2 * w) * 16 + lr] = nm[0][0]; p.out[O_NP + (size_t)(b * 4 + h) * 128 + (2 * w + 1) * 16 + lr] = nm[1][0]; }
        if (tid == 0) p.out[O_MP + b * 4 + h] = m_prev;
    }
}

DEV unsigned dpp_max16(unsigned x) {
    x = max(x, (unsigned)__builtin_amdgcn_update_dpp(0, (int)x, 0xB1, 0xF, 0xF, false));
    x = max(x, (unsigned)__builtin_amdgcn_update_dpp(0, (int)x, 0x4E, 0xF, 0xF, false));
    x = max(x, (unsigned)__builtin_amdgcn_update_dpp(0, (int)x, 0x141, 0xF, 0xF, false));
    x = max(x, (unsigned)__builtin_amdgcn_update_dpp(0, (int)x, 0x140, 0xF, 0xF, false));
    return x;
}
DEV float dpp_sum16(float x) {
    x += __builtin_bit_cast(float, __builtin_amdgcn_update_dpp(0, __builtin_bit_cast(int, x), 0xB1, 0xF, 0xF, false));
    x += __builtin_bit_cast(float, __builtin_amdgcn_update_dpp(0, __builtin_bit_cast(int, x), 0x4E, 0xF, 0xF, false));
    x += __builtin_bit_cast(float, __builtin_amdgcn_update_dpp(0, __builtin_bit_cast(int, x), 0x141, 0xF, 0xF, false));
    x += __builtin_bit_cast(float, __builtin_amdgcn_update_dpp(0, __builtin_bit_cast(int, x), 0x140, 0xF, 0xF, false));
    return x;
}
DEV unsigned mono_key(float v) { const unsigned b = __float_as_uint(v); return (b & 0x80000000u) ? ~b : (b | 0x80000000u); }
#define CE_DESC(a, b) { const unsigned hi_ = max(a, b), lo_ = min(a, b); a = hi_; b = lo_; }

DEV void peer_score_topk_item(const Params& p, const int tile, const int h, unsigned char* lds) {
    int tid_ = threadIdx.x; asm volatile("" : "+v"(tid_));
    const int tid = tid_, lane = tid & 63, w = tid >> 6, lr = lane & 15, lq = lane >> 4;
    float* sc = (float*)(lds + w * 12416);
    float* ts = sc + 16 * 129;
    int* ti = (int*)(ts + 512);
    const bf16_t* QPB = (const bf16_t*)(p.ws + WS_QPB);
    const bf16_t* SUBK = (const bf16_t*)(p.ws + WS_SUBK);
    int* PIDX = (int*)(p.ws + WS_PIDX); float* PG = (float*)(p.ws + WS_PG);
    const int row0 = tile * 64 + w * 16;
    const int arow = (row0 + lr < NR) ? row0 + lr : NR - 1;
    wave_sync();
#pragma unroll 1
    for (int pp = 0; pp < 2; ++pp) {
        bf16x8 qf[4];
#pragma unroll
        for (int ks = 0; ks < 4; ++ks) qf[ks] = *(const bf16x8*)(QPB + (size_t)arow * 2048 + h * 256 + pp * 128 + ks * 32 + lq * 8);
#pragma unroll
        for (int j = 0; j < 8; ++j) {
            f32x4 a = (f32x4){0.f, 0.f, 0.f, 0.f};
#pragma unroll
            for (int ks = 0; ks < 4; ++ks) { const bf16x8 kf = *(const bf16x8*)(SUBK + ((size_t)pp * 128 + j * 16 + lr) * 128 + ks * 32 + lq * 8); a = __builtin_amdgcn_mfma_f32_16x16x32_bf16(qf[ks], kf, a, 0, 0, 0); }
#pragma unroll
            for (int g = 0; g < 4; ++g) sc[(lq * 4 + g) * 129 + j * 16 + lr] = a[g];
        }
        wave_sync();
#pragma unroll 1
        for (int rr = 0; rr < 4; ++rr) {
            const int row = rr * 4 + lq;
            unsigned k0, k1, k2, k3, k4, k5, k6, k7;
            { const float* sr = sc + row * 129 + lr;
              k0 = (mono_key(sr[0]) & ~0x7Fu) | (unsigned)(127 - lr);        k1 = (mono_key(sr[16]) & ~0x7Fu) | (unsigned)(127 - 16 - lr);
              k2 = (mono_key(sr[32]) & ~0x7Fu) | (unsigned)(127 - 32 - lr);  k3 = (mono_key(sr[48]) & ~0x7Fu) | (unsigned)(127 - 48 - lr);
              k4 = (mono_key(sr[64]) & ~0x7Fu) | (unsigned)(127 - 64 - lr);  k5 = (mono_key(sr[80]) & ~0x7Fu) | (unsigned)(127 - 80 - lr);
              k6 = (mono_key(sr[96]) & ~0x7Fu) | (unsigned)(127 - 96 - lr);  k7 = (mono_key(sr[112]) & ~0x7Fu) | (unsigned)(127 - 112 - lr); }
            CE_DESC(k0, k1) CE_DESC(k2, k3) CE_DESC(k4, k5) CE_DESC(k6, k7)
            CE_DESC(k0, k2) CE_DESC(k1, k3) CE_DESC(k4, k6) CE_DESC(k5, k7)
            CE_DESC(k1, k2) CE_DESC(k5, k6)
            CE_DESC(k0, k4) CE_DESC(k1, k5) CE_DESC(k2, k6) CE_DESC(k3, k7)
            CE_DESC(k2, k4) CE_DESC(k3, k5)
            CE_DESC(k1, k2) CE_DESC(k3, k4) CE_DESC(k5, k6)
            unsigned mine = 0u;
#pragma unroll
            for (int r = 0; r < 16; ++r) {
                const unsigned best = dpp_max16(k0);
                if (lr == r) mine = best;
                const bool own = (k0 == best);
                k0 = own ? k1 : k0; k1 = own ? k2 : k1; k2 = own ? k3 : k2; k3 = own ? k4 : k3; k4 = own ? k5 : k4; k5 = own ? k6 : k5; k6 = own ? k7 : k6; k7 = own ? 0u : k7;
            }
            const int idx = 127 - (int)(mine & 0x7Fu);
            ts[(pp * 16 + row) * 16 + lr] = sc[row * 129 + idx];
            ti[(pp * 16 + row) * 16 + lr] = idx;
        }
        wave_sync();
    }
#pragma unroll 1
    for (int rr = 0; rr < 4; ++rr) {
        const int row = rr * 4 + lq;
        const float s1a = ts[row * 16 + lr];
        const float* s2 = ts + (16 + row) * 16;
        int ptr = 0;
        unsigned key = (mono_key(s1a + s2[0]) & ~0xFFu) | (unsigned)(255 - lr * 16);
        unsigned mine = 0u;
#pragma unroll
        for (int r = 0; r < 16; ++r) {
            const unsigned best = dpp_max16(key);
            if (lr == r) mine = best;
            if (key == best) { ++ptr; key = (ptr < 16) ? ((mono_key(s1a + s2[ptr & 15]) & ~0xFFu) | (unsigned)(255 - lr * 16 - ptr)) : 0u; }
        }
        const int ci = 255 - (int)(mine & 0xFFu), a = ci >> 4, bb = ci & 15;
        const float scv = ts[row * 16 + a] + s2[bb];
        const int e = ti[row * 16 + a] * 128 + ti[(16 + row) * 16 + bb];
        float m16 = scv;
        m16 = fmaxf(m16, __builtin_bit_cast(float, __builtin_amdgcn_update_dpp(0, __builtin_bit_cast(int, m16), 0xB1, 0xF, 0xF, false)));
        m16 = fmaxf(m16, __builtin_bit_cast(float, __builtin_amdgcn_update_dpp(0, __builtin_bit_cast(int, m16), 0x4E, 0xF, 0xF, false)));
        m16 = fmaxf(m16, __builtin_bit_cast(float, __builtin_amdgcn_update_dpp(0, __builtin_bit_cast(int, m16), 0x141, 0xF, 0xF, false)));
        m16 = fmaxf(m16, __builtin_bit_cast(float, __builtin_amdgcn_update_dpp(0, __builtin_bit_cast(int, m16), 0x140, 0xF, 0xF, false)));
        const float ex = expf(scv - m16);
        const float den = dpp_sum16(ex);
        const int grow = row0 + row;
        if (grow < NR) {
            __hip_atomic_store(&PIDX[(size_t)grow * 128 + h * 16 + lr], e, __ATOMIC_RELAXED, __HIP_MEMORY_SCOPE_AGENT);
            __hip_atomic_store(&PG[(size_t)grow * 128 + h * 16 + lr], ex / den, __ATOMIC_RELAXED, __HIP_MEMORY_SCOPE_AGENT);
        }
    }
}

constexpr float PEER_U_SCALE = 64.0f;
DEV unsigned pack4_fp8(float a, float b, float c, float d) { int w = 0; w = __builtin_amdgcn_cvt_pk_fp8_f32(a, b, w, false); w = __builtin_amdgcn_cvt_pk_fp8_f32(c, d, w, true); return (unsigned)w; }
DEV void peer_expert_wave(const Params& p, const int row, unsigned char* wl, const int lane_in) {
    int lane = lane_in; asm volatile("" : "+v"(lane));
    const int lr = lane & 15, lq = lane >> 4;
    unsigned char* xh = wl;
    unsigned char* xo = wl + 1024;
    float* coefl = (float*)(wl + 2048);
    int* idxl = (int*)(wl + 2048 + 512);
    const float* T1r = (const float*)(p.ws + WS_T1) + (size_t)row * 1024;
    const int* PIDX = (const int*)(p.ws + WS_PIDX) + (size_t)row * 128;
    const float* PG = (const float*)(p.ws + WS_PG) + (size_t)row * 128;
    const unsigned char* U8 = p.ws + WS_U8;
    const unsigned char* V4 = p.ws + WS_V8;
    const float* VSC = (const float*)(p.ws + WS_V8 + 8388608);
    uint4 ufa[8], ufb[8];
    {
        const unsigned char* ub_ = U8 + (size_t)PIDX[lr] * 1024 + lq * 16;
#pragma unroll
        for (int i = 0; i < 8; ++i) ufa[i] = *(const uint4*)(ub_ + i * 64);
    }
    float xv[16];
    {
        float s1 = 0.f;
#pragma unroll
        for (int j = 0; j < 4; ++j) { const float4 t = *(const float4*)(T1r + lane * 16 + j * 4); xv[4 * j] = t.x; xv[4 * j + 1] = t.y; xv[4 * j + 2] = t.z; xv[4 * j + 3] = t.w; s1 += (t.x + t.y) + (t.z + t.w); }
        const float mu1 = wave_sum(s1) * (1.0f / 1024.0f);
        float q1 = 0.f;
#pragma unroll
        for (int i = 0; i < 16; ++i) { xv[i] -= mu1; q1 += xv[i] * xv[i]; }
        const float rstd1 = 1.0f / sqrtf(wave_sum(q1) * (1.0f / 1024.0f) + LN_EPS);
#pragma unroll
        for (int j = 0; j < 4; ++j) {
            const float4 g4 = *(const float4*)(p.ln1_g + lane * 16 + j * 4), b4 = *(const float4*)(p.ln1_b + lane * 16 + j * 4);
            xv[4 * j] = xv[4 * j] * rstd1 * g4.x + b4.x; xv[4 * j + 1] = xv[4 * j + 1] * rstd1 * g4.y + b4.y; xv[4 * j + 2] = xv[4 * j + 2] * rstd1 * g4.z + b4.z; xv[4 * j + 3] = xv[4 * j + 3] * rstd1 * g4.w + b4.w;
        }
    }
    wave_sync();
    {
        uint4 hi, lo; unsigned* hp = (unsigned*)&hi; unsigned* lp = (unsigned*)&lo;
#pragma unroll
        for (int j = 0; j < 4; ++j) {
            const unsigned hw = pack4_fp8(xv[4 * j], xv[4 * j + 1], xv[4 * j + 2], xv[4 * j + 3]);
            const f32x2_ b0 = __builtin_amdgcn_cvt_pk_f32_fp8((int)hw, false), b1 = __builtin_amdgcn_cvt_pk_f32_fp8((int)hw, true);
            hp[j] = hw;
            lp[j] = pack4_fp8(16.f * (xv[4 * j] - b0[0]), 16.f * (xv[4 * j + 1] - b0[1]), 16.f * (xv[4 * j + 2] - b1[0]), 16.f * (xv[4 * j + 3] - b1[1]));
        }
        *(uint4*)(xh + lane * 16) = hi; *(uint4*)(xo + lane * 16) = lo;
    }
    { const int e0 = PIDX[lane], e1 = PIDX[64 + lane]; idxl[lane] = e0; idxl[64 + lane] = e1;
      coefl[lane] = PG[lane] * VSC[e0]; coefl[64 + lane] = PG[64 + lane] * VSC[e1]; }
    float* xs = (float*)(wl + 3072);
#pragma unroll
    for (int j = 0; j < 4; ++j) *(float4*)(xs + lane * 16 + j * 4) = make_float4(xv[4 * j], xv[4 * j + 1], xv[4 * j + 2], xv[4 * j + 3]);
    wave_sync();
    f32x4 ah = (f32x4){0.f, 0.f, 0.f, 0.f}, al = (f32x4){0.f, 0.f, 0.f, 0.f};
#define U_LOAD(DST, HH) { const unsigned char* ub_ = U8 + (size_t)idxl[((HH) >> 1) * 16 + lr] * 1024 + ((HH) & 1) * 512 + lq * 16; \
        _Pragma("unroll") for (int i = 0; i < 8; ++i) DST[i] = *(const uint4*)(ub_ + i * 64); }
#define U_HALF(SRC, HH) { \
        _Pragma("unroll") for (int i = 0; i < 8; ++i) { \
            if ((i & 1) == 0) asm volatile("" ::: "memory");        \
            const int off = ((HH) & 1) * 512 + i * 64 + lq * 16; \
            const long b0 = (long)(((unsigned long long)SRC[i].y << 32) | SRC[i].x), b1 = (long)(((unsigned long long)SRC[i].w << 32) | SRC[i].z); \
            const long h0 = *(const long*)(xh + off), h1 = *(const long*)(xh + off + 8), l0 = *(const long*)(xo + off), l1 = *(const long*)(xo + off + 8); \
            ah = __builtin_amdgcn_mfma_f32_16x16x32_fp8_fp8(h0, b0, ah, 0, 0, 0); ah = __builtin_amdgcn_mfma_f32_16x16x32_fp8_fp8(h1, b1, ah, 0, 0, 0); \
            al = __builtin_amdgcn_mfma_f32_16x16x32_fp8_fp8(l0, b0, al, 0, 0, 0); al = __builtin_amdgcn_mfma_f32_16x16x32_fp8_fp8(l1, b1, al, 0, 0, 0); } \
        if ((HH) & 1) { if (lq == 0) coefl[((HH) >> 1) * 16 + lr] *= gelu_tanh((ah[0] + al[0] * 0.0625f) * (1.0f / PEER_U_SCALE)); \
            ah = (f32x4){0.f, 0.f, 0.f, 0.f}; al = (f32x4){0.f, 0.f, 0.f, 0.f}; } }
    uint2 vfa[8], vfb[8];
#define V_LOAD(DST, J) { _Pragma("unroll") for (int u = 0; u < 8; ++u) DST[u] = *(const uint2*)(V4 + (size_t)idxl[(J) + u] * 512 + lane * 8); }
#pragma unroll 1
    for (int hh = 0; hh < 16; hh += 2) {
        U_LOAD(ufb, hh + 1)
        U_HALF(ufa, hh)
        if (hh + 2 < 16) U_LOAD(ufa, hh + 2) else V_LOAD(vfa, 0)
        U_HALF(ufb, hh + 1)
    }
#undef U_LOAD
#undef U_HALF
    wave_sync();
    float o[16];
#pragma unroll
    for (int i = 0; i < 16; ++i) o[i] = 0.f;
#define V_ACC(SRC, J) { _Pragma("unroll") for (int u = 0; u < 8; ++u) { asm volatile("" ::: "memory"); const float c_ = coefl[(J) + u]; \
            const unsigned w0_ = SRC[u].x, w1_ = SRC[u].y; \
            f32x2_ f0, f1; \
            f0 = __builtin_amdgcn_cvt_scalef32_pk_f32_fp4(w0_, 1.0f, 0); f1 = __builtin_amdgcn_cvt_scalef32_pk_f32_fp4(w0_, 1.0f, 1); o[0] += c_ * f0[0]; o[1] += c_ * f0[1]; o[2] += c_ * f1[0]; o[3] += c_ * f1[1]; \
            f0 = __builtin_amdgcn_cvt_scalef32_pk_f32_fp4(w0_, 1.0f, 2); f1 = __builtin_amdgcn_cvt_scalef32_pk_f32_fp4(w0_, 1.0f, 3); o[4] += c_ * f0[0]; o[5] += c_ * f0[1]; o[6] += c_ * f1[0]; o[7] += c_ * f1[1]; \
            f0 = __builtin_amdgcn_cvt_scalef32_pk_f32_fp4(w1_, 1.0f, 0); f1 = __builtin_amdgcn_cvt_scalef32_pk_f32_fp4(w1_, 1.0f, 1); o[8] += c_ * f0[0]; o[9] += c_ * f0[1]; o[10] += c_ * f1[0]; o[11] += c_ * f1[1]; \
            f0 = __builtin_amdgcn_cvt_scalef32_pk_f32_fp4(w1_, 1.0f, 2); f1 = __builtin_amdgcn_cvt_scalef32_pk_f32_fp4(w1_, 1.0f, 3); o[12] += c_ * f0[0]; o[13] += c_ * f0[1]; o[14] += c_ * f1[0]; o[15] += c_ * f1[1]; } }
#pragma unroll 1
    for (int j = 0; j < 128; j += 16) {
        V_LOAD(vfb, j + 8)
        V_ACC(vfa, j)
        if (j + 16 < 128) V_LOAD(vfa, j + 16)
        V_ACC(vfb, j + 8)
    }
#undef V_LOAD
#undef V_ACC
    float tv[16]; float s = 0.f;
#pragma unroll
    for (int j = 0; j < 4; ++j) { const float4 x4 = *(const float4*)(xs + lane * 16 + j * 4);
        tv[4 * j] = DN_ALPHA * x4.x + o[4 * j]; tv[4 * j + 1] = DN_ALPHA * x4.y + o[4 * j + 1]; tv[4 * j + 2] = DN_ALPHA * x4.z + o[4 * j + 2]; tv[4 * j + 3] = DN_ALPHA * x4.w + o[4 * j + 3]; }
#pragma unroll
    for (int i = 0; i < 16; ++i) s += tv[i];
    const float mu = wave_sum(s) * (1.0f / 1024.0f);
    float q = 0.f;
#pragma unroll
    for (int i = 0; i < 16; ++i) { const float d = tv[i] - mu; q += d * d; }
    const float rstd = 1.0f / sqrtf(wave_sum(q) * (1.0f / 1024.0f) + LN_EPS);
    float* y = p.out + O_Y + (size_t)row * 1024 + lane * 16;
#pragma unroll
    for (int j = 0; j < 4; ++j) {
        const float4 g4 = *(const float4*)(p.ln2_g + lane * 16 + j * 4), b4 = *(const float4*)(p.ln2_b + lane * 16 + j * 4);
        float4 yo;
        yo.x = (tv[4 * j] - mu) * rstd * g4.x + b4.x; yo.y = (tv[4 * j + 1] - mu) * rstd * g4.y + b4.y; yo.z = (tv[4 * j + 2] - mu) * rstd * g4.z + b4.z; yo.w = (tv[4 * j + 3] - mu) * rstd * g4.w + b4.w;
        *(float4*)(y + j * 4) = yo;
    }
}

constexpr int QN = 2;
struct AttnState { f32x4 ot[4][QN]; float m[QN]; float l[QN]; };

template <bool GUARD = true>
DEV void attn_block(const unsigned char* Ks, const unsigned char* VTs, const bf16x8 (&Qf)[QN][2], AttnState& A, const int mode, const int dq, const float* blut,
                    const unsigned selbit0, const unsigned selbit1, const bool slc, const int lr, const int lq, const int t0, const int ci0) {
    f32x4 sc[4][QN];
    bf16x8 kf[4][2];
#pragma unroll
    for (int kt = 0; kt < 4; ++kt) { kf[kt][0] = *(const bf16x8*)(Ks + (kt * 16 + lr) * 144 + lq * 16); kf[kt][1] = *(const bf16x8*)(Ks + (kt * 16 + lr) * 144 + 64 + lq * 16); }
#pragma unroll
    for (int kt = 0; kt < 4; ++kt) {
#pragma unroll
        for (int qi = 0; qi < QN; ++qi) {
            f32x4 a = (f32x4){0.f, 0.f, 0.f, 0.f};
            a = __builtin_amdgcn_mfma_f32_16x16x32_bf16(kf[kt][0], Qf[qi][0], a, 0, 0, 0);
            a = __builtin_amdgcn_mfma_f32_16x16x32_bf16(kf[kt][1], Qf[qi][1], a, 0, 0, 0);
            sc[kt][qi] = a;
        }
    }
    union VF { bf16x8 v; uint2 h[2]; };
    VF vfa[2][2];
#pragma unroll
    for (int dt = 0; dt < 2; ++dt)
#pragma unroll
        for (int ks = 0; ks < 2; ++ks) {
            vfa[dt][ks].h[0] = *(const uint2*)(VTs + (dt * 16 + lr) * 144 + (32 * ks + lq * 4) * 2);
            vfa[dt][ks].h[1] = *(const uint2*)(VTs + (dt * 16 + lr) * 144 + (32 * ks + 16 + lq * 4) * 2);
        }
    if (mode != 0 || slc) {
#pragma unroll
        for (int kt = 0; kt < 4; ++kt)
#pragma unroll
            for (int qi = 0; qi < QN; ++qi)
#pragma unroll
                for (int g = 0; g < 4; ++g) {
                    const int kl = kt * 16 + lq * 4 + g, ql = qi * 16 + lr;
                    float v = sc[kt][qi][g];
                    bool ok = true;
                    if (mode == 1 || mode == 2) { const int di = dq + ql - kl; v += blut[di < 0 ? 0 : di]; }
                    if (mode == 2) ok = kl <= ql + dq;
                    if (mode == 3) ok = kl > ql + dq - 512;
                    if (mode == 4) { const int ci = ci0 + kl, dist = t0 + ql - (16 * ci + 31); ok = (dist >= 0) && (ci < 127); if (dist >= 0 && dist < 192) v += blut[dist]; }
                    if (mode == 5) { const int dist = dq - ci0 * kl; ok = (kl < t0) && (dist >= 0); if (dist >= 0 && dist < 192) v += blut[dist]; }
                    if (slc) ok = ok && ((qi == 0 ? selbit0 : selbit1) != 0u);
                    sc[kt][qi][g] = ok ? v : NEGF;
                }
    }
    bf16x8 pf[QN][2];
#pragma unroll
    for (int qi = 0; qi < QN; ++qi) {
        float mb = fmaxf(fmaxf(sc[0][qi][0], sc[0][qi][1]), sc[0][qi][2]);
        mb = fmaxf(fmaxf(mb, sc[0][qi][3]), sc[1][qi][0]); mb = fmaxf(fmaxf(mb, sc[1][qi][1]), sc[1][qi][2]); mb = fmaxf(fmaxf(mb, sc[1][qi][3]), sc[2][qi][0]);
        mb = fmaxf(fmaxf(mb, sc[2][qi][1]), sc[2][qi][2]); mb = fmaxf(fmaxf(mb, sc[2][qi][3]), sc[3][qi][0]); mb = fmaxf(fmaxf(mb, sc[3][qi][1]), sc[3][qi][2]); mb = fmaxf(mb, sc[3][qi][3]);
        mb = fmaxf(mb, __shfl_xor(mb, 16)); mb = fmaxf(mb, __shfl_xor(mb, 32));
        const float mn = fmaxf(A.m[qi], mb);
        const float alpha = __builtin_amdgcn_exp2f(A.m[qi] - mn);
        A.m[qi] = mn;
        float rs = 0.f;
#pragma unroll
        for (int kt = 0; kt < 4; ++kt)
#pragma unroll
            for (int g = 0; g < 4; ++g) { const float v = sc[kt][qi][g]; const float e = (!GUARD || v > -1e29f) ? __builtin_amdgcn_exp2f(v - mn) : 0.f; sc[kt][qi][g] = e; rs += e; }
        A.l[qi] = A.l[qi] * alpha + rs;
#pragma unroll
        for (int dt = 0; dt < 4; ++dt) A.ot[dt][qi] = A.ot[dt][qi] * alpha;
#pragma unroll
        for (int ks = 0; ks < 2; ++ks) {
            union { bf16x8 v; unsigned u[4]; } pk;
            pk.u[0] = cvt_pk_bf16(sc[2 * ks][qi][0], sc[2 * ks][qi][1]); pk.u[1] = cvt_pk_bf16(sc[2 * ks][qi][2], sc[2 * ks][qi][3]);
            pk.u[2] = cvt_pk_bf16(sc[2 * ks + 1][qi][0], sc[2 * ks + 1][qi][1]); pk.u[3] = cvt_pk_bf16(sc[2 * ks + 1][qi][2], sc[2 * ks + 1][qi][3]);
            pf[qi][ks] = pk.v;
        }
    }
    VF vfb[2][2];
#pragma unroll
    for (int dt = 0; dt < 2; ++dt)
#pragma unroll
        for (int ks = 0; ks < 2; ++ks) {
            vfb[dt][ks].h[0] = *(const uint2*)(VTs + ((dt + 2) * 16 + lr) * 144 + (32 * ks + lq * 4) * 2);
            vfb[dt][ks].h[1] = *(const uint2*)(VTs + ((dt + 2) * 16 + lr) * 144 + (32 * ks + 16 + lq * 4) * 2);
        }
#pragma unroll
    for (int dt = 0; dt < 2; ++dt)
#pragma unroll
        for (int ks = 0; ks < 2; ++ks)
#pragma unroll
            for (int qi = 0; qi < QN; ++qi) A.ot[dt][qi] = __builtin_amdgcn_mfma_f32_16x16x32_bf16(vfa[dt][ks].v, pf[qi][ks], A.ot[dt][qi], 0, 0, 0);
#pragma unroll
    for (int dt = 0; dt < 2; ++dt)
#pragma unroll
        for (int ks = 0; ks < 2; ++ks)
#pragma unroll
            for (int qi = 0; qi < QN; ++qi) A.ot[dt + 2][qi] = __builtin_amdgcn_mfma_f32_16x16x32_bf16(vfb[dt][ks].v, pf[qi][ks], A.ot[dt + 2][qi], 0, 0, 0);
}

DEV void nsa_prompt_item(const Params& p, const int b, const int hkv, const int q32, unsigned char* lds) {
    int tid_ = threadIdx.x; asm volatile("" : "+v"(tid_));
    const int tid = tid_, lane = tid & 63, g = tid >> 6, lr = lane & 15, lq = lane >> 4;
    const int hq = hkv * 4 + g, t0 = q32 * 32, kd = t0 >> 6;
    unsigned char* Ks = lds; unsigned char* VTs = lds + 9216;
    float* biasl = (float*)(lds + 36864); float* psl = (float*)(lds + 39936); unsigned* selm = (unsigned*)(lds + 44160); unsigned* misc = (unsigned*)(lds + 44288);
    const bf16_t* ZB = (const bf16_t*)(p.ws + WS_ZB);
    const bf16_t* VTS = (const bf16_t*)(p.ws + WS_VTS) + (size_t)(b * 2 + hkv) * 64 * 2048;
    const bf16_t* VTW = (const bf16_t*)(p.ws + WS_VTW) + (size_t)(b * 2 + hkv) * 64 * 2048;
    const bf16_t* KCB = (const bf16_t*)(p.ws + WS_KCB) + (size_t)(b * 2 + hkv) * 128 * 64;
    const bf16_t* VTC = (const bf16_t*)(p.ws + WS_VTC) + (size_t)(b * 2 + hkv) * 64 * 128;
    const float* Z = (const float*)(p.ws + WS_Z);
    float* NOUTF = (float*)(p.ws + WS_NOUTF);
    bf16_t* NOUTB = (bf16_t*)(p.ws + WS_NOUTB);
    __syncthreads();
    for (int i = tid; i < 4 * 192; i += 256) { const int gg = i / 192, d = i % 192; biasl[i] = (p.rel_bias[rel_bucket(d) * 8 + hkv * 4 + gg] - p.rel_bias[31 * 8 + hkv * 4 + gg]) * LOG2E; }
    for (int i = tid; i < 32 * 33; i += 256) psl[i] = 0.f;
    if (tid < 32) selm[tid] = 0u;
    if (tid == 0) misc[0] = 0u;
    const float* blut = biasl + g * 192;
    bf16x8 Qf[QN][2];
#pragma unroll
    for (int qi = 0; qi < QN; ++qi)
#pragma unroll
        for (int kk = 0; kk < 2; ++kk) Qf[qi][kk] = *(const bf16x8*)(ZB + (size_t)(b * 2048 + t0 + qi * 16 + lr) * IN_DIM + C_Q + hq * 64 + kk * 32 + lq * 8);

    unsigned msk0 = 0u, msk1 = 0u;
    uint4 trk0, trk1, trv0, trv1;
    int* blist = (int*)(lds + 44544);
    auto load_tiles = [&](int kind, int kb) __attribute__((always_inline)) {
#pragma unroll
        for (int i = 0; i < 2; ++i) {
            const int id = tid + 256 * i, row = id >> 3, ch = id & 7;
            uint4 rk, rv;
            if (kind == 0) { rk = *(const uint4*)(KCB + (size_t)(kb * 64 + row) * 64 + ch * 8); rv = *(const uint4*)(VTC + (size_t)row * 128 + kb * 64 + ch * 8); }
            else {
                rk = *(const uint4*)(ZB + (size_t)(b * 2048 + kb * 64 + row) * IN_DIM + (kind == 1 ? C_KS : C_KW) + hkv * 64 + ch * 8);
                rv = *(const uint4*)((kind == 1 ? VTS : VTW) + (size_t)row * 2048 + kb * 64 + ch * 8);
            }
            if (i == 0) { trk0 = rk; trv0 = rv; } else { trk1 = rk; trv1 = rv; }
        }
    };
    auto store_tiles = [&]() __attribute__((always_inline)) {
#pragma unroll
        for (int i = 0; i < 2; ++i) { const int id = tid + 256 * i, row = id >> 3, ch = id & 7; *(uint4*)(Ks + row * 144 + ch * 16) = (i == 0 ? trk0 : trk1); *(uint4*)(VTs + row * 144 + ch * 16) = (i == 0 ? trv0 : trv1); }
    };
    auto store_tiles_to = [&](const int off) __attribute__((always_inline)) {
#pragma unroll
        for (int i = 0; i < 2; ++i) { const int id = tid + 256 * i, row = id >> 3, ch = id & 7; *(uint4*)(Ks + off + row * 144 + ch * 16) = (i == 0 ? trk0 : trk1); *(uint4*)(VTs + off + row * 144 + ch * 16) = (i == 0 ? trv0 : trv1); }
    };
    auto run_blocks = [&](const int kind, const int nb, const bool slc, AttnState& A) __attribute__((always_inline)) {
        load_tiles(kind, blist[0]);
        __syncthreads();
        store_tiles_to(0);
        if (nb > 1) load_tiles(kind, blist[1]);
        __syncthreads();
        for (int i = 0; i < nb; ++i) {
            const int kb = blist[i], dq = t0 - kb * 64, cur = (i & 1) * 18432;
            if (i + 1 < nb) { store_tiles_to(18432 - cur); if (i + 2 < nb) load_tiles(kind, blist[i + 2]); }
            const int mode = (kb == kd) ? 2 : ((kb >= kd - 2) ? 1 : ((kind == 2 && dq + 31 >= 512) ? 3 : 0));
            attn_block<false>(Ks + cur, VTs + cur, Qf, A, mode, dq, blut, slc ? ((msk0 >> kb) & 1u) : 1u, slc ? ((msk1 >> kb) & 1u) : 1u, slc, lr, lq, t0, 0);
            __syncthreads();
        }
    };
    auto reset = [&](AttnState& A) __attribute__((always_inline)) {
#pragma unroll
        for (int qi = 0; qi < QN; ++qi) { A.m[qi] = NEGF; A.l[qi] = 0.f;
#pragma unroll
            for (int dt = 0; dt < 4; ++dt) A.ot[dt][qi] = (f32x4){0.f, 0.f, 0.f, 0.f}; }
    };
    auto finish = [&](AttnState& A, int br) __attribute__((always_inline)) {
#pragma unroll
        for (int qi = 0; qi < QN; ++qi) {
            float lt = A.l[qi]; lt += __shfl_xor(lt, 16); lt += __shfl_xor(lt, 32);
            const float sc = (lt > 0.f) ? sigmoidf_(Z[(size_t)(b * 2048 + t0 + qi * 16 + lr) * 32 + 8 + br * 8 + hq]) / lt : 0.f;
            const size_t row = (size_t)(b * 2048 + t0 + qi * 16 + lr);
#pragma unroll
            for (int dt = 0; dt < 4; ++dt) {
                const int col = hq * 64 + dt * 16 + lq * 4;
                f32x4 v = A.ot[dt][qi] * sc;
                if (br > 0) v = v + *(const f32x4*)(NOUTF + row * 512 + col);
                if (br < 2) *(f32x4*)(NOUTF + row * 512 + col) = v; else store_bf16x4(NOUTB + row * 512 + col, v);
            }
        }
    };

    AttnState A;
    const int ncb = ((t0 >> 4) >= 64) ? 2 : 1;
    reset(A);
    load_tiles(0, 0);
    for (int kb = 0; kb < ncb; ++kb) {
        __syncthreads(); store_tiles(); __syncthreads();
        if (kb + 1 < ncb) load_tiles(0, kb + 1);
        attn_block(Ks, VTs, Qf, A, 4, 0, blut, 1u, 1u, false, lr, lq, t0, kb * 64);
    }
    finish(A, 0);
    {
        float linv[QN];
#pragma unroll
        for (int qi = 0; qi < QN; ++qi) { float lt = A.l[qi]; lt += __shfl_xor(lt, 16); lt += __shfl_xor(lt, 32); linv[qi] = (lt > 0.f) ? 1.0f / lt : 0.f; }
        for (int kb = 0; kb < ncb; ++kb) {
            if (ncb > 1) { load_tiles(0, kb); __syncthreads(); store_tiles(); __syncthreads(); }
#pragma unroll
            for (int kt = 0; kt < 4; ++kt) {
                const bf16x8 k0 = *(const bf16x8*)(Ks + (kt * 16 + lr) * 144 + lq * 16), k1 = *(const bf16x8*)(Ks + (kt * 16 + lr) * 144 + 64 + lq * 16);
#pragma unroll
                for (int qi = 0; qi < QN; ++qi) {
                    f32x4 a = (f32x4){0.f, 0.f, 0.f, 0.f};
                    a = __builtin_amdgcn_mfma_f32_16x16x32_bf16(k0, Qf[qi][0], a, 0, 0, 0);
                    a = __builtin_amdgcn_mfma_f32_16x16x32_bf16(k1, Qf[qi][1], a, 0, 0, 0);
                    float pr[4];
#pragma unroll
                    for (int gg = 0; gg < 4; ++gg) {
                        const int ci = kb * 64 + kt * 16 + lq * 4 + gg, ql = qi * 16 + lr, dist = t0 + ql - (16 * ci + 31);
                        float v = a[gg];
                        if (dist >= 0 && dist < 192) v += blut[dist];
                        pr[gg] = (dist >= 0 && ci < 127) ? __builtin_amdgcn_exp2f(v - A.m[qi]) * linv[qi] : 0.f;
                    }
                    const int blk = kb * 16 + kt * 4 + lq, ql = qi * 16 + lr;
                    atomicAdd(&psl[ql * 33 + blk], 2.0f * (pr[0] + pr[1] + pr[2]) + pr[3]);
                    atomicAdd(&psl[ql * 33 + blk + 1], pr[3]);
                }
            }
        }
    }
    __syncthreads();
    {
        const int ql = tid >> 3, part = tid & 7, tq = t0 + ql, cur = tq >> 6;
        float scv[32];
#pragma unroll
        for (int j = 0; j < 32; ++j) {
            const bool causal = j * 64 <= tq, forced = (j == 0) || (j == cur) || (j == cur - 1);
            scv[j] = causal ? (forced ? 1e4f : psl[ql * 33 + j]) : NEGF;
        }
        unsigned mbits = 0u;
#pragma unroll
        for (int jj = 0; jj < 4; ++jj) {
            const int j = part * 4 + jj;
            float my = NEGF;
#pragma unroll
            for (int k = 0; k < 32; ++k) my = (k == j) ? scv[k] : my;
            int rank = 0;
#pragma unroll
            for (int k = 0; k < 32; ++k) rank += ((scv[k] > my) || (scv[k] == my && k < j)) ? 1 : 0;
            if (rank < 16 && j * 64 <= tq) mbits |= (1u << j);
        }
        atomicOr(&selm[ql], mbits);
        atomicOr(&misc[0], mbits);
    }
    __syncthreads();
    msk0 = selm[lr]; msk1 = selm[16 + lr];
    const unsigned anym = misc[0];
    reset(A);
    {
        if (tid == 0) { int n = 0; blist[n++] = kd; for (int j = 0; j < kd; ++j) if ((anym >> j) & 1u) blist[n++] = j; blist[40] = n; }
        __syncthreads();
        run_blocks(1, blist[40], true, A);
    }
    finish(A, 1);
    reset(A);
    {
        const int klo = (t0 >= 511) ? ((t0 - 511) >> 6) : 0;
        __syncthreads();
        if (tid < 33 && tid <= kd - klo) blist[tid] = kd - tid;
        __syncthreads();
        run_blocks(2, kd - klo + 1, false, A);
    }
    finish(A, 2);
}

DEV void nsa_sample_item(const Params& p, const int b, const int hkv, unsigned char* lds) {
    int tid_ = threadIdx.x; asm volatile("" : "+v"(tid_));
    const int tid = tid_, lane = tid & 63, g = tid >> 6, lr = lane & 15, lq = lane >> 4;
    const int hq = hkv * 4 + g;
    unsigned char* Ks = lds; unsigned char* VTs = lds + 9216;
    float* biasl = (float*)(lds + 18432); float* psl = (float*)(lds + 21504); int* sell = (int*)(lds + 29952); float* scl = (float*)(lds + 30720);
    const bf16_t* ZB = (const bf16_t*)(p.ws + WS_ZB);
    const float* zgate = (const float*)(p.ws + WS_Z) + (size_t)(NP + b) * 32 + 8;
    const bf16_t* zbrow = ZB + (size_t)(NP + b) * IN_DIM;
    const bf16_t* KCSB = (const bf16_t*)(p.ws + WS_KCSB) + (size_t)(b * 2 + hkv) * 1024 * 64;
    const bf16_t* VTCS = (const bf16_t*)(p.ws + WS_VTCS) + (size_t)(b * 2 + hkv) * 64 * 1024;
    bf16_t* NOUTB = (bf16_t*)(p.ws + WS_NOUTB);
    __syncthreads();
    for (int i = tid; i < 4 * 192; i += 256) { const int gg = i / 192, d = i % 192; biasl[i] = (p.rel_bias[rel_bucket(d) * 8 + hkv * 4 + gg] - p.rel_bias[31 * 8 + hkv * 4 + gg]) * LOG2E; }
    for (int i = tid; i < 260; i += 256) psl[i] = 0.f;
    const float* blut = biasl + g * 192;
    bf16x8 Qf[QN][2];
#pragma unroll
    for (int kk = 0; kk < 2; ++kk) { Qf[0][kk] = *(const bf16x8*)(ZB + (size_t)(NP + b) * IN_DIM + C_Q + hq * 64 + kk * 32 + lq * 8); Qf[1][kk] = Qf[0][kk]; }
    AttnState A;
    auto reset = [&](AttnState& S_) __attribute__((always_inline)) {
#pragma unroll
        for (int qi = 0; qi < QN; ++qi) { S_.m[qi] = NEGF; S_.l[qi] = 0.f;
#pragma unroll
            for (int dt = 0; dt < 4; ++dt) S_.ot[dt][qi] = (f32x4){0.f, 0.f, 0.f, 0.f}; }
    };
    f32x4 res[4];
#pragma unroll
    for (int dt = 0; dt < 4; ++dt) res[dt] = (f32x4){0.f, 0.f, 0.f, 0.f};
    auto finish = [&](AttnState& S_, int br) __attribute__((always_inline)) {
        float lt = S_.l[0]; lt += __shfl_xor(lt, 16); lt += __shfl_xor(lt, 32);
        const float sc = (lt > 0.f) ? sigmoidf_(zgate[br * 8 + hq]) / lt : 0.f;
#pragma unroll
        for (int dt = 0; dt < 4; ++dt) res[dt] = res[dt] + S_.ot[dt][0] * sc;
    };
    uint4 trk0, trk1, trv0, trv1;
    auto load_cmp = [&](int kb) __attribute__((always_inline)) {
#pragma unroll
        for (int i = 0; i < 2; ++i) {
            const int id = tid + 256 * i, row = id >> 3, ch = id & 7;
            const uint4 rk = *(const uint4*)(KCSB + (size_t)(kb * 64 + row) * 64 + ch * 8), rv = *(const uint4*)(VTCS + (size_t)row * 1024 + kb * 64 + ch * 8);
            if (i == 0) { trk0 = rk; trv0 = rv; } else { trk1 = rk; trv1 = rv; }
        }
    };
    auto store_cmp = [&]() __attribute__((always_inline)) {
#pragma unroll
        for (int i = 0; i < 2; ++i) { const int id = tid + 256 * i, row = id >> 3, ch = id & 7; *(uint4*)(Ks + row * 144 + ch * 16) = (i == 0 ? trk0 : trk1); *(uint4*)(VTs + row * 144 + ch * 16) = (i == 0 ? trv0 : trv1); }
    };
    reset(A);
    load_cmp(0);
    for (int kb = 0; kb < 16; ++kb) {
        __syncthreads(); store_cmp(); __syncthreads();
        if (kb + 1 < 16) load_cmp(kb + 1);
        attn_block<false>(Ks, VTs, Qf, A, 5, PAST - 31 - 16 * (kb * 64), blut, 1u, 1u, false, lr, lq, (kb == 15) ? 63 : 64, 16);
    }
    finish(A, 0);
    {
        float lt = A.l[0]; lt += __shfl_xor(lt, 16); lt += __shfl_xor(lt, 32);
        const float linv = (lt > 0.f) ? 1.0f / lt : 0.f;
        for (int kb = 0; kb < 16; ++kb) {
            load_cmp(kb); __syncthreads(); store_cmp(); __syncthreads();
#pragma unroll
            for (int kt = 0; kt < 4; ++kt) {
                const bf16x8 k0 = *(const bf16x8*)(Ks + (kt * 16 + lr) * 144 + lq * 16), k1 = *(const bf16x8*)(Ks + (kt * 16 + lr) * 144 + 64 + lq * 16);
                f32x4 a = (f32x4){0.f, 0.f, 0.f, 0.f};
                a = __builtin_amdgcn_mfma_f32_16x16x32_bf16(k0, Qf[0][0], a, 0, 0, 0);
                a = __builtin_amdgcn_mfma_f32_16x16x32_bf16(k1, Qf[0][1], a, 0, 0, 0);
                float pr[4];
#pragma unroll
                for (int gg = 0; gg < 4; ++gg) {
                    const int ci = kb * 64 + kt * 16 + lq * 4 + gg, dist = PAST - 31 - 16 * ci;
                    float v = a[gg];
                    if (dist >= 0 && dist < 192) v += blut[dist];
                    pr[gg] = (ci < 1023) ? __builtin_amdgcn_exp2f(v - A.m[0]) * linv : 0.f;
                }
                if (lr == 0) {
                    const int blk = kb * 16 + kt * 4 + lq;
                    atomicAdd(&psl[blk], 2.0f * (pr[0] + pr[1] + pr[2]) + pr[3]);
                    atomicAdd(&psl[blk + 1], pr[3]);
                }
            }
        }
    }
    __syncthreads();
    for (int j = tid; j < 257; j += 256) scl[j] = (j == 0 || j == 256 || j == 255) ? 1e4f : psl[j];
    __syncthreads();
    for (int j = tid; j < 257; j += 256) {
        const float my = scl[j];
        int rank = 0;
        for (int k = 0; k < 257; ++k) { const float o2 = scl[k]; rank += ((o2 > my) || (o2 == my && k < j)) ? 1 : 0; }
        if (rank < 16) sell[rank] = j;
    }
    __syncthreads();
    uint4 rk0, rk1; unsigned rv0, rv1, rv2, rv3, rv4, rv5, rv6, rv7;
    auto load_rows = [&](const float* src, const bf16_t* srcb) __attribute__((always_inline)) {
        const int seg = tid & 3;
        if (srcb) {
            const bf16_t* kp = srcb + hkv * 64 + seg * 16; const bf16_t* vp = kp + 128;
            rk0 = *(const uint4*)kp; rk1 = *(const uint4*)(kp + 8);
            const uint4 v0 = *(const uint4*)vp, v1 = *(const uint4*)(vp + 8);
            rv0 = v0.x; rv1 = v0.y; rv2 = v0.z; rv3 = v0.w; rv4 = v1.x; rv5 = v1.y; rv6 = v1.z; rv7 = v1.w;
        } else {
            const bool nz = src != nullptr;
            const float* kp = (nz ? src : p.state_win) + hkv * 64 + seg * 16; const float* vp = kp + 128;
            const float4 a0 = *(const float4*)kp, a1 = *(const float4*)(kp + 4), a2 = *(const float4*)(kp + 8), a3 = *(const float4*)(kp + 12);
            const float4 c0 = *(const float4*)vp, c1 = *(const float4*)(vp + 4), c2 = *(const float4*)(vp + 8), c3 = *(const float4*)(vp + 12);
            const unsigned mk = nz ? 0xffffffffu : 0u;
            rk0.x = cvt_pk_bf16(a0.x, a0.y) & mk; rk0.y = cvt_pk_bf16(a0.z, a0.w) & mk; rk0.z = cvt_pk_bf16(a1.x, a1.y) & mk; rk0.w = cvt_pk_bf16(a1.z, a1.w) & mk;
            rk1.x = cvt_pk_bf16(a2.x, a2.y) & mk; rk1.y = cvt_pk_bf16(a2.z, a2.w) & mk; rk1.z = cvt_pk_bf16(a3.x, a3.y) & mk; rk1.w = cvt_pk_bf16(a3.z, a3.w) & mk;
            rv0 = cvt_pk_bf16(c0.x, c0.y) & mk; rv1 = cvt_pk_bf16(c0.z, c0.w) & mk; rv2 = cvt_pk_bf16(c1.x, c1.y) & mk; rv3 = cvt_pk_bf16(c1.z, c1.w) & mk;
            rv4 = cvt_pk_bf16(c2.x, c2.y) & mk; rv5 = cvt_pk_bf16(c2.z, c2.w) & mk; rv6 = cvt_pk_bf16(c3.x, c3.y) & mk; rv7 = cvt_pk_bf16(c3.z, c3.w) & mk;
        }
    };
    auto store_rows = [&]() __attribute__((always_inline)) {
        const int kl = tid >> 2, seg = tid & 3;
        *(uint4*)(Ks + kl * 144 + seg * 32) = rk0; *(uint4*)(Ks + kl * 144 + seg * 32 + 16) = rk1;
#define VT_PUT(i_, w_) { *(bf16_t*)(VTs + (seg * 16 + (i_)) * 144 + kl * 2) = (bf16_t)((w_) & 0xffffu); *(bf16_t*)(VTs + (seg * 16 + (i_) + 1) * 144 + kl * 2) = (bf16_t)((w_) >> 16); }
        VT_PUT(0, rv0) VT_PUT(2, rv1) VT_PUT(4, rv2) VT_PUT(6, rv3) VT_PUT(8, rv4) VT_PUT(10, rv5) VT_PUT(12, rv6) VT_PUT(14, rv7)
#undef VT_PUT
    };
    auto slc_row = [&](int blk) __attribute__((always_inline)) -> const float* {
        const int kl = tid >> 2;
        if (blk < 256) { const int page = p.page_table[b * 128 + (blk >> 1)]; return p.cache_slc + ((size_t)page * 128 + (blk & 1) * 64 + kl) * 256; }
        return nullptr;
    };
    auto slc_rowb = [&](int blk) __attribute__((always_inline)) -> const bf16_t* { return (blk == 256 && (tid >> 2) == 0) ? zbrow + C_KS : nullptr; };
    reset(A);
    load_rows(slc_row(sell[0]), slc_rowb(sell[0]));
    for (int si = 0; si < 16; ++si) {
        const int blk = sell[si];
        __syncthreads(); store_rows(); __syncthreads();
        if (si + 1 < 16) load_rows(slc_row(sell[si + 1]), slc_rowb(sell[si + 1]));
        attn_block<false>(Ks, VTs, Qf, A, 5, PAST - blk * 64, blut, 1u, 1u, false, lr, lq, (blk == 256) ? 1 : 64, 1);
    }
    finish(A, 1);
    auto win_row = [&](int wb) __attribute__((always_inline)) -> const float* {
        const int j = 1 + wb * 64 + (tid >> 2);
        return (j < 512) ? p.state_win + ((size_t)b * 512 + j) * 256 : nullptr;
    };
    auto win_rowb = [&](int wb) __attribute__((always_inline)) -> const bf16_t* { return (1 + wb * 64 + (tid >> 2) == 512) ? zbrow + C_KW : nullptr; };
    reset(A);
    load_rows(win_row(0), win_rowb(0));
    for (int wb = 0; wb < 8; ++wb) {
        __syncthreads(); store_rows(); __syncthreads();
        if (wb + 1 < 8) load_rows(win_row(wb + 1), win_rowb(wb + 1));
        attn_block<false>(Ks, VTs, Qf, A, 5, 511 - wb * 64, blut, 1u, 1u, false, lr, lq, 64, 1);
    }
    finish(A, 2);
    if (lr == 0) {
#pragma unroll
        for (int dt = 0; dt < 4; ++dt) store_bf16x4(NOUTB + (size_t)(NP + b) * 512 + hq * 64 + dt * 16 + lq * 4, res[dt]);
    }
}

DEV int otid() { int t = threadIdx.x; asm volatile("" : "+v"(t)); return t; }
#define Z ((float*)(p.ws + WS_Z))
#define HRAW ((float*)(p.ws + WS_HRAW))
#define MOUTB ((bf16_t*)(p.ws + WS_MOUTB))
#define NOUTB ((bf16_t*)(p.ws + WS_NOUTB))
#define MIXB ((bf16_t*)(p.ws + WS_MIXB))
#define T1 ((float*)(p.ws + WS_T1))
#define X1B ((bf16_t*)(p.ws + WS_X1B))
#define QPB ((bf16_t*)(p.ws + WS_QPB))
#define CONVB ((bf16_t*)(p.ws + WS_CONVB))
#define XB ((bf16_t*)(p.ws + WS_XB))
#define WIN_T ((bf16_t*)(p.ws + WS_WIN_T))
#define WUPM_T ((bf16_t*)(p.ws + WS_WUPM_T))
#define WUPN_T ((bf16_t*)(p.ws + WS_WUPN_T))
#define WOUT_T ((bf16_t*)(p.ws + WS_WOUT_T))
#define PWQ_T ((bf16_t*)(p.ws + WS_PWQ_T))
#define WQK_T ((bf16_t*)(p.ws + WS_WQK_T))
#define W1_T ((bf16_t*)(p.ws + WS_W1_T))
#define W2_T ((bf16_t*)(p.ws + WS_W2_T))
#define SUBK ((bf16_t*)(p.ws + WS_SUBK))
#define ZB ((bf16_t*)(p.ws + WS_ZB))
#define VTS ((bf16_t*)(p.ws + WS_VTS))
#define VTW ((bf16_t*)(p.ws + WS_VTW))
#define KCB ((bf16_t*)(p.ws + WS_KCB))
#define VTC ((bf16_t*)(p.ws + WS_VTC))
__global__ void __launch_bounds__(NTHREADS, 2) fwd_kernel(Params p) {
    extern __shared__ __attribute__((aligned(16))) unsigned char smem[];
    if (threadIdx.x == 0) { *(uint4*)smem = make_uint4(0u, 0u, 0u, 0u); }
    __syncthreads();
    XcdBarrier bar = xcd_barrier_post((unsigned*)(p.ws + WS_BAR), (volatile LAS unsigned*)smem);
    float* lds = (float*)(smem + 16);
    unsigned char* ldsb = smem + 16;
#define TID_ (otid())
#define LANE_ (otid() & 63)
#define WV_ (otid() >> 6)
#define GW_ ((int)(blockIdx.x * 4 + (otid() >> 6)))
#define GT_ ((size_t)blockIdx.x * NTHREADS + otid())
    const int nw = gridDim.x * 4;
    const size_t nt = (size_t)gridDim.x * NTHREADS;


    {
        for (size_t id = GT_; id < (size_t)MP * 128; id += nt) {
            const int row = (int)(id >> 7), k8 = (int)(id & 127) * 8;
            float f[8];
            if (row < NR) {
                const float* s = (row < NP ? p.x_prompt + (size_t)row * 1024 : p.x_sample + (size_t)(row - NP) * 1024) + k8;
                const float4 a = *(const float4*)s, b = *(const float4*)(s + 4);
                f[0] = a.x; f[1] = a.y; f[2] = a.z; f[3] = a.w; f[4] = b.x; f[5] = b.y; f[6] = b.z; f[7] = b.w;
            } else {
#pragma unroll
                for (int i = 0; i < 8; ++i) f[i] = 0.f;
            }
            *(uint4*)(XB + (size_t)row * 1024 + k8) = pack8(f);
        }
        transpose_to_bf16(p.w_in, 1024, IN_DIM, WIN_T, GT_, nt);
        for (int h = 0; h < 4; ++h) {
            transpose_to_bf16(p.wq + (size_t)h * 16384, 128, 128, WQK_T + (size_t)(h * 256) * 128, GT_, nt);
            transpose_to_bf16(p.wk + (size_t)h * 16384, 128, 128, WQK_T + (size_t)(h * 256 + 128) * 128, GT_, nt);
        }
        for (size_t id = GT_; id < (size_t)2 * 128 * 128; id += nt) {
            const int k8 = (int)(id & 127) * 8, np = (int)((id >> 7) & 127), c = (int)(id >> 14);
            const int pp = np >> 6, o = np & 63, r = k8 >> 6, d = k8 & 63;
            float f[8];
#pragma unroll
            for (int e = 0; e < 8; ++e) f[e] = p.cmp_w1[((size_t)c * 2048 + (pp * 16 + r) * 64 + d + e) * 64 + o];
            *(uint4*)(W1_T + ((size_t)c * 128 + np) * 1024 + k8) = pack8(f);
        }
        if (GT_ < 128) {
            const int c = (int)GT_ >> 6, o = (int)GT_ & 63;
            float a = 0.f;
            for (int k = 0; k < 2048; ++k) a += p.cmp_pe[c * 2048 + k] * p.cmp_w1[((size_t)c * 2048 + k) * 64 + o];
            ((float*)(p.ws + WS_PESUM))[GT_] = a;
        }
        for (int c = 0; c < 2; ++c) transpose_to_bf16(p.cmp_w2 + (size_t)c * 4096, 64, 64, W2_T + (size_t)c * 4096, GT_, nt);
    }
    xcd_barrier(bar);

    gemm_glds_xcd(NR, IN_DIM, 1024,
        [&](int r, int k) { return XB + (size_t)r * 1024 + k; },
        [&](int n, int k) { return WIN_T + (size_t)n * 1024 + k; },
        [&](int r, int c8, f32x4 va, f32x4 vb) {
            { const float qs = (c8 >= C_Q && c8 < C_KC) ? (0.125f * LOG2E) : 1.0f; store_bf16x8(ZB + (size_t)r * IN_DIM + c8, va * qs, vb * qs); }
            { const int c32 = __builtin_amdgcn_readfirstlane(c8) & ~31;
              if (c32 >= C_GM || (c32 >= C_O && c32 < C_I) || (c32 >= C_Q + 24 && c32 < C_KC - 8)) return;
              if (c32 < C_V) {
                  if (r < NP) { const int t = r & 2047; if (t >= 2045) { float* d = p.out + O_CVP + ((size_t)(r >> 11) * 3 + (t - 2045)) * 512 + c8; *(f32x4*)d = va; *(f32x4*)(d + 4) = vb; } }
                  else { float* d = p.out + O_CVS + ((size_t)(r - NP) * 3 + 2) * 512 + c8; *(f32x4*)d = va; *(f32x4*)(d + 4) = vb; }
                  return;
              }
              if (c32 < C_O) {
                  if (r < NP) {
                      bf16_t* vt = (bf16_t*)(p.ws + WS_VTM) + ((size_t)(r >> 11) * 512 + (c8 - C_V)) * 2048 + (r & 2047);
                      const unsigned w0 = cvt_pk_bf16(va[0], va[1]), w1 = cvt_pk_bf16(va[2], va[3]), w2 = cvt_pk_bf16(vb[0], vb[1]), w3 = cvt_pk_bf16(vb[2], vb[3]);
                      vt[0] = (bf16_t)(w0 & 0xffffu); vt[2048] = (bf16_t)(w0 >> 16); vt[4096] = (bf16_t)(w1 & 0xffffu); vt[6144] = (bf16_t)(w1 >> 16);
                      vt[8192] = (bf16_t)(w2 & 0xffffu); vt[10240] = (bf16_t)(w2 >> 16); vt[12288] = (bf16_t)(w3 & 0xffffu); vt[14336] = (bf16_t)(w3 >> 16);
                  }
                  return;
              } }
#pragma unroll
          for (int hf = 0; hf < 2; ++hf) {
            const int c0 = c8 + 4 * hf; const f32x4 v = hf ? vb : va;
            if (c0 >= C_I && c0 < C_Q) *(f32x4*)(Z + (size_t)r * 32 + (c0 - C_I)) = v;
            else if (c0 >= C_G && c0 < C_GM) *(f32x4*)(Z + (size_t)r * 32 + 8 + (c0 - C_G)) = v;
            if (r < NP && ((c0 >= C_KS + 128 && c0 < C_KW) || (c0 >= C_KW + 128 && c0 < C_G))) {
                const bool isw = c0 >= C_KW; const int cc = c0 - (isw ? C_KW : C_KS) - 128;
                bf16_t* vt = (isw ? VTW : VTS) + ((size_t)((r >> 11) * 2) * 64 + cc) * 2048 + (r & 2047);
                const unsigned w0 = cvt_pk_bf16(v[0], v[1]), w1 = cvt_pk_bf16(v[2], v[3]);
                vt[0] = (bf16_t)(w0 & 0xffffu); vt[2048] = (bf16_t)(w0 >> 16); vt[4096] = (bf16_t)(w1 & 0xffffu); vt[6144] = (bf16_t)(w1 >> 16);
            }
            if (r < NP && c0 >= C_V && c0 < C_O) {
                bf16_t* vt = (bf16_t*)(p.ws + WS_VTM) + ((size_t)(r >> 11) * 512 + (c0 - C_V)) * 2048 + (r & 2047);
                const unsigned w0 = cvt_pk_bf16(v[0], v[1]), w1 = cvt_pk_bf16(v[2], v[3]);
                vt[0] = (bf16_t)(w0 & 0xffffu); vt[2048] = (bf16_t)(w0 >> 16); vt[4096] = (bf16_t)(w1 & 0xffffu); vt[6144] = (bf16_t)(w1 >> 16);
            }
            if (c0 >= C_KC && c0 < C_KS) *(f32x4*)(p.out + O_CMPP + (size_t)r * 256 + (c0 - C_KC)) = v;
            else if (c0 >= C_KS && c0 < C_KW) *(f32x4*)(p.out + O_SLCP + (size_t)r * 256 + (c0 - C_KS)) = v;
            else if (c0 >= C_KW && c0 < C_G) {
                if (r < NP) { const int t = r & 2047; if (t >= 1536) *(f32x4*)(p.out + O_WINP + ((size_t)(r >> 11) * 512 + (t - 1536)) * 256 + (c0 - C_KW)) = v; }
                else *(f32x4*)(p.out + O_WINS + ((size_t)(r - NP) * 512 + 511) * 256 + (c0 - C_KW)) = v;
            } else if (c0 < C_V) {
                if (r < NP) { const int t = r & 2047; if (t >= 2045) *(f32x4*)(p.out + O_CVP + ((size_t)(r >> 11) * 3 + (t - 2045)) * 512 + c0) = v; }
                else *(f32x4*)(p.out + O_CVS + ((size_t)(r - NP) * 3 + 2) * 512 + c0) = v;
            }
          }
        }, smem + 256);
    xcd_barrier(bar);

    for (size_t i = GT_; i < (size_t)NR * 64; i += nt) {
        const int ch = (int)(i & 63) * 8; const int r = (int)(i >> 6);
        float a[8];
        { const float4 b0 = *(const float4*)(p.conv_b + ch), b1 = *(const float4*)(p.conv_b + ch + 4); a[0] = b0.x; a[1] = b0.y; a[2] = b0.z; a[3] = b0.w; a[4] = b1.x; a[5] = b1.y; a[6] = b1.z; a[7] = b1.w; }
#pragma unroll
        for (int j = 0; j < 4; ++j) {
            const float4 w0 = *(const float4*)(p.conv_w + j * 512 + ch), w1 = *(const float4*)(p.conv_w + j * 512 + ch + 4);
            float u[8]; bool have = true;
            if (r < NP) {
                const int t = r & 2047;
                if (t + j - 3 >= 0) { const uint4 q = *(const uint4*)(ZB + (size_t)(r + j - 3) * IN_DIM + C_U + ch);
                    u[0] = bf_lo(q.x); u[1] = bf_hi(q.x); u[2] = bf_lo(q.y); u[3] = bf_hi(q.y); u[4] = bf_lo(q.z); u[5] = bf_hi(q.z); u[6] = bf_lo(q.w); u[7] = bf_hi(q.w); }
                else have = false;
            } else if (j < 3) {
                const float* sc = p.state_conv + ((size_t)(r - NP) * 3 + j) * 512 + ch;
                const float4 s0 = *(const float4*)sc, s1 = *(const float4*)(sc + 4);
                u[0] = s0.x; u[1] = s0.y; u[2] = s0.z; u[3] = s0.w; u[4] = s1.x; u[5] = s1.y; u[6] = s1.z; u[7] = s1.w;
            } else { const uint4 q = *(const uint4*)(ZB + (size_t)r * IN_DIM + C_U + ch);
                u[0] = bf_lo(q.x); u[1] = bf_hi(q.x); u[2] = bf_lo(q.y); u[3] = bf_hi(q.y); u[4] = bf_lo(q.z); u[5] = bf_hi(q.z); u[6] = bf_lo(q.w); u[7] = bf_hi(q.w); }
            if (have) { a[0] += w0.x * u[0]; a[1] += w0.y * u[1]; a[2] += w0.z * u[2]; a[3] += w0.w * u[3]; a[4] += w1.x * u[4]; a[5] += w1.y * u[5]; a[6] += w1.z * u[6]; a[7] += w1.w * u[7]; }
        }
#pragma unroll
        for (int e = 0; e < 8; ++e) a[e] = a[e] * sigmoidf_(a[e]);
        *(uint4*)(CONVB + (size_t)r * 512 + ch) = pack8(a);
    }
    xcd_barrier(bar);

    const int QK_FIRST = (gridDim.x == 512) ? 192 : 0;
    for (int c = 0; c < 2; ++c) {
    for (int h = 2 * c; h < 2 * c + 2; ++h) {
        gemm_glds(NR, 256, 128,
            [&](int r, int k) { return CONVB + (size_t)r * 512 + h * 128 + k; },
            [&](int n, int k) { return WQK_T + (size_t)(h * 256 + n) * 128 + k; },
            [&](int r, int c8, f32x4 va, f32x4 vb) {
                if (c8 >= 128) { va = va * 0.08838834764831845f; vb = vb * 0.08838834764831845f; }
                if (c8 < 128) store_bf16x8((bf16_t*)(p.ws + WS_QB) + (size_t)r * 512 + h * 128 + c8, va, vb);
                else {
                    store_bf16x8((bf16_t*)(p.ws + WS_KB) + (size_t)r * 512 + h * 128 + (c8 - 128), va, vb);
                    if (r < NP) {
                        bf16_t* kt = (bf16_t*)(p.ws + WS_KTB) + ((size_t)((r >> 11) * 4 + h) * 128 + (c8 - 128)) * 2048 + (r & 2047);
                        const unsigned w0 = cvt_pk_bf16(va[0], va[1]), w1 = cvt_pk_bf16(va[2], va[3]), w2 = cvt_pk_bf16(vb[0], vb[1]), w3 = cvt_pk_bf16(vb[2], vb[3]);
                        kt[0] = (bf16_t)(w0 & 0xffffu); kt[2048] = (bf16_t)(w0 >> 16); kt[4096] = (bf16_t)(w1 & 0xffffu); kt[6144] = (bf16_t)(w1 >> 16);
                        kt[8192] = (bf16_t)(w2 & 0xffffu); kt[10240] = (bf16_t)(w2 >> 16); kt[12288] = (bf16_t)(w3 & 0xffffu); kt[14336] = (bf16_t)(w3 >> 16);
                    }
                } }, smem + 256, h * 410, 0, NoMid(), QK_FIRST, (int)gridDim.x - QK_FIRST);
    }
        for (int grp = 0; grp < 2; ++grp) {
            const int TPB = grp ? 9 : 1, NCH = grp ? 1024 : 128, NBH = grp ? 64 : 32;
            struct CmpLoader0 {
                const Params& p; const bf16_t* zb; int c, TPB, NCH;
                DEV const unsigned char* prep(int vrow) const {
                    const int tile = vrow >> 7, bh = tile / TPB, n_ = 127 * (tile % TPB) + (vrow & 127), n = n_ < NCH ? n_ : NCH - 1;
                    const int b = bh >> 1, hh = bh & 1, tok = 16 * n;
                    return (const unsigned char*)(zb + ((size_t)b * 2048 + tok) * IN_DIM + C_KC + c * 128 + hh * 64);
                }
                struct Raw { uint4 u; };
                DEV Raw load(const unsigned char* ctx, int k) const { const int r = k >> 6, d0 = k & 63; Raw q; q.u = *(const uint4*)((const bf16_t*)ctx + (size_t)r * IN_DIM + d0); return q; }
                DEV uint4 pack(const Raw& q) const { return q.u; }
            };
            struct CmpLoader1 {
                const Params& p; const bf16_t* zb; int c, TPB, NCH;
                DEV const unsigned char* prep(int vrow) const {
                    const int tile = vrow >> 7, bh = tile < 512 ? tile >> 3 : tile - 512, tt = tile < 512 ? (tile & 7) : 8, n_ = 127 * tt + (vrow & 127), n = n_ < NCH ? n_ : NCH - 1;
                    const int b = bh >> 1, hh = bh & 1, tok = 16 * n;
                    const int page = p.page_table[b * 128 + (tok >> 7)];
                    return (const unsigned char*)(p.cache_cmp + ((size_t)page * 128 + (tok & 127)) * 256 + c * 128 + hh * 64);
                }
                struct Raw { float4 a0, a1; };
                DEV Raw load(const unsigned char* ctx, int k) const { const int r = k >> 6, d0 = k & 63; const float* sp = (const float*)ctx + r * 256 + d0; Raw q; q.a0 = *(const float4*)sp; q.a1 = *(const float4*)(sp + 4); return q; }
                DEV uint4 pack(const Raw& q) const { float f[8] = {q.a0.x, q.a0.y, q.a0.z, q.a0.w, q.a1.x, q.a1.y, q.a1.z, q.a1.w}; return pack8(f); }
            };
            auto cmp_lb = [&](int n, int k) { return *(const uint4*)(W1_T + ((size_t)c * 128 + n) * 1024 + k); };
            auto cmp_epi = [&](f32x4 (&acc)[4][4], int bm) {
                    const int lr = LANE_ & 15, lq = LANE_ >> 4, wm = WV_ >> 1, wn = WV_ & 1;
                    const int tile = bm >> 7, bh = grp ? (tile < 512 ? tile >> 3 : tile - 512) : tile, n0 = grp ? 127 * (tile < 512 ? (tile & 7) : 8) : 0;
                    float* P1 = (float*)ldsb;
                    bf16_t* HL = (bf16_t*)(ldsb + 128 * 68 * 4);
                    __syncthreads();
                    if (wn == 1) {
#pragma unroll
                        for (int i = 0; i < 4; ++i)
#pragma unroll
                            for (int j = 0; j < 4; ++j) *(f32x4*)(P1 + (wm * 64 + i * 16 + lr) * 68 + j * 16 + lq * 4) = acc[i][j];
                    }
                    __syncthreads();
                    if (wn == 0) {
                        const float* pes = (const float*)(p.ws + WS_PESUM) + c * 64;
#pragma unroll
                        for (int i = 0; i < 4; ++i)
#pragma unroll
                            for (int j = 0; j < 4; ++j) {
                                const int rl = wm * 64 + i * 16 + lr, o0 = j * 16 + lq * 4;
                                const f32x4 nx = (rl < 127) ? *(const f32x4*)(P1 + (rl + 1) * 68 + o0) : (f32x4){0.f, 0.f, 0.f, 0.f};
                                const f32x4 pe4 = *(const f32x4*)(pes + o0);
                                f32x4 hv = acc[i][j] + nx + pe4;
                                hv[0] = gelu_tanh(hv[0]); hv[1] = gelu_tanh(hv[1]); hv[2] = gelu_tanh(hv[2]); hv[3] = gelu_tanh(hv[3]);
                                store_bf16x4(HL + rl * 72 + o0, hv);
                            }
                    }
                    __syncthreads();
                    f32x4 kc[2][4];
#pragma unroll
                    for (int i = 0; i < 2; ++i)
#pragma unroll
                        for (int j = 0; j < 4; ++j) kc[i][j] = (f32x4){0.f, 0.f, 0.f, 0.f};
#pragma unroll
                    for (int ks = 0; ks < 2; ++ks) {
                        bf16x8 hf[2], wf[4];
#pragma unroll
                        for (int i = 0; i < 2; ++i) hf[i] = *(const bf16x8*)(HL + (WV_ * 32 + i * 16 + lr) * 72 + ks * 32 + lq * 8);
#pragma unroll
                        for (int j = 0; j < 4; ++j) wf[j] = *(const bf16x8*)(W2_T + ((size_t)c * 64 + j * 16 + lr) * 64 + ks * 32 + lq * 8);
#pragma unroll
                        for (int i = 0; i < 2; ++i)
#pragma unroll
                            for (int j = 0; j < 4; ++j) kc[i][j] = __builtin_amdgcn_mfma_f32_16x16x32_bf16(wf[j], hf[i], kc[i][j], 0, 0, 0);
                    }
#pragma unroll
                    for (int i = 0; i < 2; ++i) {
                        const int rl = WV_ * 32 + i * 16 + lr, blk = n0 + rl;
                        if (rl < 127 && blk <= NCH - 2) {
#pragma unroll
                            for (int j = 0; j < 4; ++j) {
                                const int o2 = j * 16 + lq * 4;
                                if (c == 0) store_bf16x4((grp ? (bf16_t*)(p.ws + WS_KCSB) : KCB) + ((size_t)bh * NCH + blk) * 64 + o2, kc[i][j]);
                                else { bf16_t* vt = (grp ? (bf16_t*)(p.ws + WS_VTCS) : VTC) + ((size_t)bh * 64 + o2) * NCH + blk;
                                       const unsigned w0 = cvt_pk_bf16(kc[i][j][0], kc[i][j][1]), w1 = cvt_pk_bf16(kc[i][j][2], kc[i][j][3]);
                                       vt[0] = (bf16_t)(w0 & 0xffffu); vt[NCH] = (bf16_t)(w0 >> 16); vt[2 * NCH] = (bf16_t)(w1 & 0xffffu); vt[3 * NCH] = (bf16_t)(w1 >> 16); }
                            }
                        }
                    }
                    __syncthreads();
                };
            if (grp == 0) gemm_bf16<128, true>(NBH * TPB * 128, 128, 1024, CmpLoader0{p, ZB, c, TPB, NCH}, cmp_lb, cmp_epi, ldsb, c * 608 + grp * 32);
            else gemm_bf16<128, true>(NBH * TPB * 128, 128, 1024, CmpLoader1{p, ZB, c, TPB, NCH}, cmp_lb, cmp_epi, ldsb, c * 608 + grp * 32);
        }
    }
    xcd_barrier(bar);

    for (;;) {
        __syncthreads();
        if (TID_ == 0) *(volatile int*)(ldsb + 45056) = (int)atomicAdd((unsigned*)(p.ws + WS_BAR) + 2, 1u);
        __syncthreads();
        const int raw = *(volatile int*)(ldsb + 45056);
        if (raw >= 320 + 2048 + 512) break;
        int idx = raw;
        if (raw >= 320) { const int k = raw - 320, k5 = k / 5, kr = k - 5 * k5; idx = (kr == 4) ? 2368 + k5 : 320 + 4 * k5 + kr; }
        if (idx >= 320 + 2048) {
            const size_t cgt = (size_t)(idx - 2368) * NTHREADS + TID_, cnt_ = (size_t)512 * NTHREADS;
        transpose_to_bf16(p.w_up_m, 512, 1024, WUPM_T, cgt, cnt_);
        transpose_to_bf16(p.w_up_n, 512, 1024, WUPN_T, cgt, cnt_);
        transpose_to_bf16(p.w_out, 1024, 1024, WOUT_T, cgt, cnt_);
        transpose_to_bf16(p.peer_wq, 1024, 2048, PWQ_T, cgt, cnt_);
        for (size_t id = cgt; id < (size_t)2 * 128 * 128 / 8; id += cnt_) {
            float f[8];
#pragma unroll
            for (int i = 0; i < 8; ++i) f[i] = p.peer_sub[id * 8 + i];
            *(uint4*)(SUBK + id * 8) = pack8(f);
        }
        for (size_t id = cgt; id < (size_t)16384 * 64; id += cnt_) {
            const float* su = p.peer_u + id * 16; const float* sv = p.peer_v + id * 16;
            uint4 ou; unsigned* pu = (unsigned*)&ou; float vv[16]; float mx = 0.f;
#pragma unroll
            for (int j = 0; j < 4; ++j) {
                const float4 a4 = *(const float4*)(su + j * 4), c4 = *(const float4*)(sv + j * 4);
                pu[j] = pack4_fp8(a4.x * PEER_U_SCALE, a4.y * PEER_U_SCALE, a4.z * PEER_U_SCALE, a4.w * PEER_U_SCALE);
                vv[4 * j] = c4.x; vv[4 * j + 1] = c4.y; vv[4 * j + 2] = c4.z; vv[4 * j + 3] = c4.w;
                mx = fmaxf(fmaxf(mx, fmaxf(fabsf(c4.x), fabsf(c4.y))), fmaxf(fabsf(c4.z), fabsf(c4.w)));
            }
            mx = wave_max(mx);
            const float vs = mx > 0.f ? mx * (1.0f / 6.0f) : 1.0f, vinv = 1.0f / vs;
            unsigned w0 = 0u, w1 = 0u;
            w0 = __builtin_amdgcn_cvt_scalef32_pk_fp4_f32(w0, vv[0] * vinv, vv[1] * vinv, 1.0f, 0); w1 = __builtin_amdgcn_cvt_scalef32_pk_fp4_f32(w1, vv[8] * vinv, vv[9] * vinv, 1.0f, 0);
            w0 = __builtin_amdgcn_cvt_scalef32_pk_fp4_f32(w0, vv[2] * vinv, vv[3] * vinv, 1.0f, 1); w1 = __builtin_amdgcn_cvt_scalef32_pk_fp4_f32(w1, vv[10] * vinv, vv[11] * vinv, 1.0f, 1);
            w0 = __builtin_amdgcn_cvt_scalef32_pk_fp4_f32(w0, vv[4] * vinv, vv[5] * vinv, 1.0f, 2); w1 = __builtin_amdgcn_cvt_scalef32_pk_fp4_f32(w1, vv[12] * vinv, vv[13] * vinv, 1.0f, 2);
            w0 = __builtin_amdgcn_cvt_scalef32_pk_fp4_f32(w0, vv[6] * vinv, vv[7] * vinv, 1.0f, 3); w1 = __builtin_amdgcn_cvt_scalef32_pk_fp4_f32(w1, vv[14] * vinv, vv[15] * vinv, 1.0f, 3);
            *(uint4*)(p.ws + WS_U8 + id * 16) = ou; *(uint2*)(p.ws + WS_V8 + id * 8) = make_uint2(w0, w1);
            if ((id & 63) == 0) ((float*)(p.ws + WS_V8 + 8388608))[id >> 6] = vs;
        }
        for (size_t i = cgt; i < (size_t)BS * 511 * 256; i += cnt_) {
            const int j = (int)(i & 255); const int wv = (int)((i >> 8) % 511); const int b = (int)((i >> 8) / 511);
            p.out[O_WINS + ((size_t)b * 512 + wv) * 256 + j] = p.state_win[((size_t)b * 512 + wv + 1) * 256 + j];
        }
        for (size_t i = cgt; i < (size_t)BS * 2 * 512; i += cnt_) {
            const int ch = (int)(i & 511); const int jj = (int)((i >> 9) & 1); const int b = (int)(i >> 10);
            p.out[O_CVS + ((size_t)b * 3 + jj) * 512 + ch] = p.state_conv[((size_t)b * 3 + jj + 1) * 512 + ch];
        }
            continue;
        }
        if (idx < 128) mlstm_chunk_item(p, idx, ldsb);
        else if (idx < 256) mlstm_step_item(p, idx - 128, lds);
        else if (idx < 320) nsa_sample_item(p, (idx - 256) >> 1, idx & 1, ldsb);
        else { const int i2 = idx - 320; nsa_prompt_item(p, (i2 & 31) >> 1, i2 & 1, 63 - (i2 >> 5), ldsb); }
    }
    xcd_barrier(bar);

    {
        float4 h0, h1; uint4 og;
        { const int r0 = GW_ < NR ? GW_ : NR - 1; const float* hr = HRAW + (size_t)r0 * 512 + LANE_ * 8; h0 = *(const float4*)hr; h1 = *(const float4*)(hr + 4); og = *(const uint4*)(ZB + (size_t)r0 * IN_DIM + C_O + LANE_ * 8); }
        const float4 g0 = *(const float4*)(p.norm_g + LANE_ * 8), g1 = *(const float4*)(p.norm_g + LANE_ * 8 + 4);
        for (int row = GW_; row < NR; row += nw) {
            const int nr = row + nw < NR ? row + nw : row;
            const float* hr = HRAW + (size_t)nr * 512 + LANE_ * 8;
            const float4 n0 = *(const float4*)hr, n1 = *(const float4*)(hr + 4);
            const uint4 nog = *(const uint4*)(ZB + (size_t)nr * IN_DIM + C_O + LANE_ * 8);
            float x[8] = {h0.x, h0.y, h0.z, h0.w, h1.x, h1.y, h1.z, h1.w};
            float sm = 0.f;
#pragma unroll
            for (int e = 0; e < 8; ++e) sm += x[e];
            const float mu = dpp_sum16(sm) * (1.0f / 128.0f);
            float q = 0.f;
#pragma unroll
            for (int e = 0; e < 8; ++e) { x[e] -= mu; q += x[e] * x[e]; }
            const float rstd = 1.0f / sqrtf(dpp_sum16(q) * (1.0f / 128.0f) + LN_EPS);
            float o[8];
            o[0] = sigmoidf_(bf_lo(og.x)) * (x[0] * rstd * g0.x); o[1] = sigmoidf_(bf_hi(og.x)) * (x[1] * rstd * g0.y); o[2] = sigmoidf_(bf_lo(og.y)) * (x[2] * rstd * g0.z); o[3] = sigmoidf_(bf_hi(og.y)) * (x[3] * rstd * g0.w);
            o[4] = sigmoidf_(bf_lo(og.z)) * (x[4] * rstd * g1.x); o[5] = sigmoidf_(bf_hi(og.z)) * (x[5] * rstd * g1.y); o[6] = sigmoidf_(bf_lo(og.w)) * (x[6] * rstd * g1.z); o[7] = sigmoidf_(bf_hi(og.w)) * (x[7] * rstd * g1.w);
            *(uint4*)(MOUTB + (size_t)row * 512 + LANE_ * 8) = pack8(o);
            h0 = n0; h1 = n1; og = nog;
        }
    }
    xcd_barrier(bar);

    gemm_glds_mi<4>(NR, 1024, 1024,
        [&](int r, int k) { return (k < 512) ? MOUTB + (size_t)r * 512 + k : NOUTB + (size_t)r * 512 + (k - 512); },
        [&](int n, int k) { return (k < 512) ? WUPM_T + (size_t)n * 512 + k : WUPN_T + (size_t)n * 512 + (k - 512); },
        [&](int r, int c0, f32x4 va, f32x4 vb, uint2 ka, uint2 kb) {
            const uint4 gw = *(const uint4*)(ZB + (size_t)r * IN_DIM + C_GN + c0);
            f32x4 oa, ob;
            oa[0] = bf_lo(ka.x) + sigmoidf_(bf_lo(gw.x)) * va[0]; oa[1] = bf_hi(ka.x) + sigmoidf_(bf_hi(gw.x)) * va[1]; oa[2] = bf_lo(ka.y) + sigmoidf_(bf_lo(gw.y)) * va[2]; oa[3] = bf_hi(ka.y) + sigmoidf_(bf_hi(gw.y)) * va[3];
            ob[0] = bf_lo(kb.x) + sigmoidf_(bf_lo(gw.z)) * vb[0]; ob[1] = bf_hi(kb.x) + sigmoidf_(bf_hi(gw.z)) * vb[1]; ob[2] = bf_lo(kb.y) + sigmoidf_(bf_lo(gw.w)) * vb[2]; ob[3] = bf_hi(kb.y) + sigmoidf_(bf_hi(gw.w)) * vb[3];
            store_bf16x8(MIXB + (size_t)r * 1024 + c0, oa, ob); },
        smem + 256, 0, 8,
        [&](int r, int c0, f32x4& va, f32x4& vb, uint2& ka, uint2& kb) {
            const uint4 gw = *(const uint4*)(ZB + (size_t)r * IN_DIM + C_GM + c0);
            ka.x = cvt_pk_bf16(sigmoidf_(bf_lo(gw.x)) * va[0], sigmoidf_(bf_hi(gw.x)) * va[1]); ka.y = cvt_pk_bf16(sigmoidf_(bf_lo(gw.y)) * va[2], sigmoidf_(bf_hi(gw.y)) * va[3]);
            kb.x = cvt_pk_bf16(sigmoidf_(bf_lo(gw.z)) * vb[0], sigmoidf_(bf_hi(gw.z)) * vb[1]); kb.y = cvt_pk_bf16(sigmoidf_(bf_lo(gw.w)) * vb[2], sigmoidf_(bf_hi(gw.w)) * vb[3]); });
    xcd_barrier(bar);

    gemm_glds(NR, 1024, 1024,
        [&](int r, int k) { return MIXB + (size_t)r * 1024 + k; },
        [&](int n, int k) { return WOUT_T + (size_t)n * 1024 + k; },
        [&](int r, int c0, f32x4 va, f32x4 vb) {
            const float* xr = (r < NP ? p.x_prompt + (size_t)r * 1024 : p.x_sample + (size_t)(r - NP) * 1024) + c0;
            *(f32x4*)(T1 + (size_t)r * 1024 + c0) = *(const f32x4*)xr * DN_ALPHA + va; *(f32x4*)(T1 + (size_t)r * 1024 + c0 + 4) = *(const f32x4*)(xr + 4) * DN_ALPHA + vb; }, smem + 256);
    xcd_barrier(bar);

    {
        float4 cu0, cu1, cu2, cu3;
        { const int r0 = GW_ < NR ? GW_ : NR - 1; const float* tp = T1 + (size_t)r0 * 1024 + LANE_ * 4; cu0 = *(const float4*)tp; cu1 = *(const float4*)(tp + 256); cu2 = *(const float4*)(tp + 512); cu3 = *(const float4*)(tp + 768); }
        for (int row = GW_; row < NR; row += nw) {
            const int nr = row + nw < NR ? row + nw : row;
            const float* tp = T1 + (size_t)nr * 1024 + LANE_ * 4;
            const float4 nx0 = *(const float4*)tp, nx1 = *(const float4*)(tp + 256), nx2 = *(const float4*)(tp + 512), nx3 = *(const float4*)(tp + 768);
            float tv[16] = {cu0.x, cu0.y, cu0.z, cu0.w, cu1.x, cu1.y, cu1.z, cu1.w, cu2.x, cu2.y, cu2.z, cu2.w, cu3.x, cu3.y, cu3.z, cu3.w};
            float s = 0.f;
#pragma unroll
            for (int j = 0; j < 4; ++j) s += (tv[4 * j] + tv[4 * j + 1]) + (tv[4 * j + 2] + tv[4 * j + 3]);
            const float mu = wave_sum(s) * (1.0f / 1024.0f);
            float q = 0.f;
#pragma unroll
            for (int j = 0; j < 16; ++j) { const float d = tv[j] - mu; q += d * d; }
            const float rstd = 1.0f / sqrtf(wave_sum(q) * (1.0f / 1024.0f) + LN_EPS);
#pragma unroll
            for (int j = 0; j < 4; ++j) {
                const int c = j * 256 + LANE_ * 4;
                const float4 g4 = *(const float4*)(p.ln1_g + c), b4 = *(const float4*)(p.ln1_b + c);
                f32x4 o; o[0] = (tv[4 * j] - mu) * rstd * g4.x + b4.x; o[1] = (tv[4 * j + 1] - mu) * rstd * g4.y + b4.y; o[2] = (tv[4 * j + 2] - mu) * rstd * g4.z + b4.z; o[3] = (tv[4 * j + 3] - mu) * rstd * g4.w + b4.w;
                store_bf16x4(X1B + (size_t)row * 1024 + c, o);
            }
            cu0 = nx0; cu1 = nx1; cu2 = nx2; cu3 = nx3;
        }
    }
    xcd_barrier(bar);

    gemm_glds(NR, 2048, 1024,
        [&](int r, int k) { return X1B + (size_t)r * 1024 + k; },
        [&](int n, int k) { return PWQ_T + (size_t)n * 1024 + k; },
        [&](int r, int c0, f32x4 va, f32x4 vb) { store_bf16x8(QPB + (size_t)r * 2048 + c0, va, vb); }, smem + 256);
    xcd_barrier(bar);

    {
        constexpr int PLAG = 64, NTIL = 513;
        unsigned* qhead = (unsigned*)(p.ws + WS_BAR) + 4;
        unsigned* tcnt = (unsigned*)(p.ws + WS_BAR) + XCD_BAR_WORDS;
        for (;;) {
            __syncthreads();
            if (TID_ == 0) *(volatile int*)(ldsb + 57344) = (int)atomicAdd(qhead, 1u);
            __syncthreads();
            const int idx = *(volatile int*)(ldsb + 57344);
            const int rnd = idx / 24, j = idx - rnd * 24;
            if (rnd >= NTIL + PLAG) break;
            if (j < 8) {
                if (rnd < NTIL) {
                    peer_score_topk_item(p, rnd, j, ldsb);
                    asm volatile("s_waitcnt vmcnt(0)" ::: "memory");
                    __syncthreads();
                    if (TID_ == 0) __hip_atomic_fetch_add(&tcnt[rnd], 1u, __ATOMIC_RELAXED, __HIP_MEMORY_SCOPE_AGENT);
                }
            } else {
                const int tile = rnd - PLAG;
                if (tile >= 0 && tile < NTIL) {
                    if (TID_ == 0) {
                        unsigned sp = 0;
                        while (__hip_atomic_load(&tcnt[tile], __ATOMIC_RELAXED, __HIP_MEMORY_SCOPE_AGENT) < 8u) { __builtin_amdgcn_s_sleep(2); if (++sp > (1u << 22)) break; }
                        __builtin_amdgcn_fence(__ATOMIC_ACQUIRE, "agent");
                        asm volatile("s_waitcnt vmcnt(0)" ::: "memory");
                    }
                    __syncthreads();
                    const int row = tile * 64 + (j - 8) * 4 + WV_;
                    if (row < NR) peer_expert_wave(p, row, ldsb + WV_ * 7168, LANE_);
                }
            }
        }
    }
}
#undef TID_
#undef LANE_
#undef WV_
#undef GW_
#undef GT_
extern "C" void kernel_launch(void* const* d_in, const int* in_sizes, int n_in, void* d_out, int out_size, void* d_ws, size_t ws_size, hipStream_t stream) {
    static int grid = 0;
    if (grid == 0) {
        if (n_in != 32 || (size_t)out_size != O_END || ws_size < WS_END) {
            fprintf(stderr, "kernel_launch: unexpected sizes n_in %d out %d ws %zu (need %zu)\n", n_in, out_size, ws_size, (size_t)WS_END); grid = -1; return; }
        int dev = 0, cus = 0, per_cu = 0;
        if (hipGetDevice(&dev) != hipSuccess || hipDeviceGetAttribute(&cus, hipDeviceAttributeMultiprocessorCount, dev) != hipSuccess) { grid = -1; return; }
        if (hipFuncSetAttribute((const void*)fwd_kernel, hipFuncAttributeMaxDynamicSharedMemorySize, LDS_BYTES) != hipSuccess) { fprintf(stderr, "hipFuncSetAttribute failed\n"); grid = -1; return; }
        if (hipOccupancyMaxActiveBlocksPerMultiprocessor(&per_cu, (const void*)fwd_kernel, NTHREADS, LDS_BYTES) != hipSuccess || per_cu < 1) { fprintf(stderr, "occupancy query failed (%d)\n", per_cu); (void)hipGetLastError(); per_cu = 1; }
        if (per_cu > 2) per_cu = 2;
        grid = cus * per_cu;
    }
    if (grid < 0) return;
    (void)hipMemsetAsync((char*)d_ws + WS_BAR, 0, 16384, stream);
    Params p{};
    p.x_prompt = (const float*)d_in[0]; p.x_sample = (const float*)d_in[1]; p.cache_cmp = (const float*)d_in[2]; p.cache_slc = (const float*)d_in[3];
    p.page_table = (const int*)d_in[4]; p.state_win = (const float*)d_in[5]; p.state_C = (const float*)d_in[6]; p.state_n = (const float*)d_in[7];
    p.state_m = (const float*)d_in[8]; p.state_conv = (const float*)d_in[9]; p.w_in = (const float*)d_in[10]; p.conv_w = (const float*)d_in[11];
    p.conv_b = (const float*)d_in[12]; p.wq = (const float*)d_in[13]; p.wk = (const float*)d_in[14]; p.gate_bias = (const float*)d_in[15];
    p.norm_g = (const float*)d_in[16]; p.cmp_pe = (const float*)d_in[17]; p.cmp_w1 = (const float*)d_in[18]; p.cmp_w2 = (const float*)d_in[19];
    p.rel_bias = (const float*)d_in[20]; p.w_up_m = (const float*)d_in[21]; p.w_up_n = (const float*)d_in[22]; p.w_out = (const float*)d_in[23];
    p.ln1_g = (const float*)d_in[24]; p.ln1_b = (const float*)d_in[25]; p.ln2_g = (const float*)d_in[26]; p.ln2_b = (const float*)d_in[27];
    p.peer_wq = (const float*)d_in[28]; p.peer_sub = (const float*)d_in[29]; p.peer_u = (const float*)d_in[30]; p.peer_v = (const float*)d_in[31];
    p.out = (float*)d_out; p.ws = (unsigned char*)d_ws;
    hipLaunchKernelGGL(fwd_kernel, dim3(grid), dim3(NTHREADS), LDS_BYTES, stream, p);
}
```
